# Optimizing an MI355X kernel written in HIP

```python
import math
import jax, jax.numpy as jnp
from jax import lax
import numpy as np

D_MODEL = 1024
BATCH = 8
SEQ = 4096
DEPTH = 4

N_MIXERS = 2
DIFF_HEAD_DIM = 64
DIFF_HEADS = D_MODEL // (2 * DIFF_HEAD_DIM)
MOBA_HEAD_DIM = 64
MOBA_HEADS = D_MODEL // MOBA_HEAD_DIM
MOBA_BLOCK = 256
MOBA_TOPK = 3
Q_BLOCK = 128
MOBA_Q_CHUNK = 16
D_FF = 2816
N_EXPERTS = 8
TOP_K_EXPERTS = 2
D_EXPERT = 3584
NORM_EPS = 1e-6
SUBLN_EPS = 1e-5
N_DIFF_LAYERS = (DEPTH + 1) // 2
N_MOBA_LAYERS = DEPTH // 2

kernel_name = 'hybrid_diffattn_moba_moe_trunk'


def alibi_slopes(n_heads):
    return jnp.asarray(2.0 ** (-8.0 * np.arange(1, n_heads + 1) / n_heads), dtype=jnp.float32)


def rms_norm(x, g, eps=NORM_EPS):
    x32 = x.astype(jnp.float32)
    y = x32 * lax.rsqrt(jnp.mean(x32 * x32, axis=-1, keepdims=True) + eps)
    return (y * g.astype(jnp.float32)).astype(x.dtype)


def swiglu(u, w_gate, w_up, w_down):
    return (jax.nn.silu(u @ w_gate) * (u @ w_up)) @ w_down


def diff_attention(h, w_qkv, w_o, lam, subln, layer_idx):
    B, S, _ = h.shape
    H, d = DIFF_HEADS, DIFF_HEAD_DIM
    q, k, v = jnp.split(h @ w_qkv, 3, axis=-1)
    q = q.reshape(B, S, H, 2, d).transpose(0, 2, 3, 1, 4)
    k = k.reshape(B, S, H, 2, d).transpose(0, 2, 3, 1, 4)
    v = v.reshape(B, S, H, 2 * d).transpose(0, 2, 1, 3)
    lam_init = 0.8 - 0.6 * math.exp(-0.3 * layer_idx)
    l32 = lam.astype(jnp.float32)
    lam_full = jnp.exp(jnp.sum(l32[0] * l32[1])) - jnp.exp(jnp.sum(l32[2] * l32[3])) + lam_init
    slopes = alibi_slopes(H)
    key_pos = jnp.arange(S)
    scale = d ** -0.5

    def query_block(start):
        qb = lax.dynamic_slice_in_dim(q, start, Q_BLOCK, axis=3)
        s = jnp.einsum('bhiqd,bhikd->bhiqk', qb, k).astype(jnp.float32) * scale
        dist = (start + jnp.arange(Q_BLOCK))[:, None] - key_pos[None, :]
        bias = -slopes[:, None, None] * dist.astype(jnp.float32)
        s = jnp.where(dist >= 0, s + bias[None, :, None], -jnp.inf)
        p = jax.nn.softmax(s, axis=-1)
        a = p[:, :, 0] - lam_full * p[:, :, 1]
        return jnp.einsum('bhqk,bhkd->bhqd', a.astype(v.dtype), v)

    o = lax.map(query_block, jnp.arange(0, S, Q_BLOCK))
    o = o.transpose(1, 0, 3, 2, 4).reshape(B, S, H, 2 * d)
    o = rms_norm(o, subln, SUBLN_EPS) * (1.0 - lam_init)
    return o.reshape(B, S, H * 2 * d) @ w_o


def moba_attention(h, w_qkv, w_o):
    B, S, _ = h.shape
    H, d, BLK = MOBA_HEADS, MOBA_HEAD_DIM, MOBA_BLOCK
    q, k, v = jnp.split(h @ w_qkv, 3, axis=-1)
    q = q.reshape(B, S, H, d).transpose(0, 2, 1, 3)
    k = k.reshape(B, S, H, d).transpose(0, 2, 1, 3)
    v = v.reshape(B, S, H, d).transpose(0, 2, 1, 3)
    NB = -(-S // BLK)
    pad = NB * BLK - S
    k_blocks = jnp.pad(k, ((0, 0), (0, 0), (0, pad), (0, 0))).reshape(B, H, NB, BLK, d)
    v_blocks = jnp.pad(v, ((0, 0), (0, 0), (0, pad), (0, 0))).reshape(B, H, NB, BLK, d)
    k_mean = jnp.mean(k_blocks, axis=3)
    k_eff = min(MOBA_TOPK, NB)
    b_idx = jnp.arange(B)[:, None, None, None]
    h_idx = jnp.arange(H)[None, :, None, None]
    slopes = alibi_slopes(H)
    scale = d ** -0.5

    def query_chunk(start):
        qc = lax.dynamic_slice_in_dim(q, start, MOBA_Q_CHUNK, axis=2)
        t = start + jnp.arange(MOBA_Q_CHUNK)
        own = start // BLK
        gate = jnp.einsum('bhqd,bhnd->bhqn', qc, k_mean).astype(jnp.float32)
        gate = jnp.where(jnp.arange(NB) < own, gate, -jnp.inf)
        _, sel = lax.top_k(gate, k_eff)
        valid = jnp.arange(k_eff) < own
        k_sel = k_blocks[b_idx, h_idx, sel]
        v_sel = v_blocks[b_idx, h_idx, sel]
        s_sel = jnp.einsum('bhqd,bhqjsd->bhqjs', qc, k_sel).astype(jnp.float32) * scale
        pos_sel = sel[..., None] * BLK + jnp.arange(BLK)
        dist_sel = (t[:, None, None] - pos_sel).astype(jnp.float32)
        s_sel = jnp.where(valid[:, None], s_sel - slopes[None, :, None, None, None] * dist_sel, -jnp.inf)
        k_own = lax.dynamic_index_in_dim(k_blocks, own, axis=2, keepdims=False)
        v_own = lax.dynamic_index_in_dim(v_blocks, own, axis=2, keepdims=False)
        s_own = jnp.einsum('bhqd,bhsd->bhqs', qc, k_own).astype(jnp.float32) * scale
        dist_own = t[:, None] - (own * BLK + jnp.arange(BLK))[None, :]
        s_own = jnp.where(dist_own >= 0,
                          s_own - slopes[None, :, None, None] * dist_own.astype(jnp.float32),
                          -jnp.inf)
        scores = jnp.concatenate([s_sel.reshape(B, H, MOBA_Q_CHUNK, k_eff * BLK), s_own], axis=-1)
        p = jax.nn.softmax(scores, axis=-1).astype(v.dtype)
        p_sel = p[..., :k_eff * BLK].reshape(B, H, MOBA_Q_CHUNK, k_eff, BLK)
        p_own = p[..., k_eff * BLK:]
        return (jnp.einsum('bhqjs,bhqjsd->bhqd', p_sel, v_sel)
                + jnp.einsum('bhqs,bhsd->bhqd', p_own, v_own))

    o = lax.map(query_chunk, jnp.arange(0, S, MOBA_Q_CHUNK))
    o = o.transpose(1, 0, 3, 2, 4).reshape(B, S, H * d)
    return o @ w_o


def moe_swiglu(h, router, w_gate, w_up, w_down):
    B, S, D = h.shape
    tok = h.reshape(B * S, D)
    logits = (tok @ router).astype(jnp.float32)
    top_v, top_i = lax.top_k(logits, TOP_K_EXPERTS)
    w = jax.nn.softmax(top_v, axis=-1)
    gates = jnp.sum(jax.nn.one_hot(top_i, N_EXPERTS, dtype=jnp.float32) * w[..., None], axis=1)
    out = jnp.zeros_like(tok)
    for e in range(N_EXPERTS):
        out = out + gates[:, e:e + 1].astype(tok.dtype) * swiglu(tok, w_gate[e], w_up[e], w_down[e])
    return out.reshape(B, S, D)


def setup_inputs(seed: int = 0) -> dict:
    key = jax.random.key(seed)
    ks = jax.random.split(key, 18)
    D = D_MODEL
    nrm = jax.random.normal
    return {
        'x': nrm(ks[0], (BATCH, SEQ, D), jnp.float32),
        'norm_mix': 1.0 + 0.02 * nrm(ks[1], (DEPTH, D), jnp.float32),
        'norm_ffn': 1.0 + 0.02 * nrm(ks[2], (DEPTH, D), jnp.float32),
        'diff_w_qkv': nrm(ks[3], (N_DIFF_LAYERS, D, 3 * D), jnp.float32) * D ** -0.5,
        'diff_w_o': nrm(ks[4], (N_DIFF_LAYERS, D, D), jnp.float32) * D ** -0.5,
        'diff_lambda': 0.1 * nrm(ks[5], (N_DIFF_LAYERS, 4, DIFF_HEAD_DIM), jnp.float32),
        'diff_subln': 1.0 + 0.02 * nrm(ks[6], (N_DIFF_LAYERS, 2 * DIFF_HEAD_DIM), jnp.float32),
        'moba_w_qkv': nrm(ks[7], (N_MOBA_LAYERS, D, 3 * D), jnp.float32) * D ** -0.5,
        'moba_w_o': nrm(ks[8], (N_MOBA_LAYERS, D, D), jnp.float32) * D ** -0.5,
        'ffn_w_gate': nrm(ks[9], (N_DIFF_LAYERS, D, D_FF), jnp.float32) * D ** -0.5,
        'ffn_w_up': nrm(ks[10], (N_DIFF_LAYERS, D, D_FF), jnp.float32) * D ** -0.5,
        'ffn_w_down': nrm(ks[11], (N_DIFF_LAYERS, D_FF, D), jnp.float32) * D_FF ** -0.5,
        'moe_router': nrm(ks[12], (N_MOBA_LAYERS, D, N_EXPERTS), jnp.float32) * D ** -0.5,
        'moe_w_gate': nrm(ks[13], (N_MOBA_LAYERS, N_EXPERTS, D, D_EXPERT), jnp.float32) * D ** -0.5,
        'moe_w_up': nrm(ks[14], (N_MOBA_LAYERS, N_EXPERTS, D, D_EXPERT), jnp.float32) * D ** -0.5,
        'moe_w_down': nrm(ks[15], (N_MOBA_LAYERS, N_EXPERTS, D_EXPERT, D), jnp.float32) * D_EXPERT ** -0.5,
        'final_norm': 1.0 + 0.02 * nrm(ks[16], (D,), jnp.float32),
    }


def reference(x, norm_mix, norm_ffn, diff_w_qkv, diff_w_o, diff_lambda, diff_subln,
              moba_w_qkv, moba_w_o, ffn_w_gate, ffn_w_up, ffn_w_down,
              moe_router, moe_w_gate, moe_w_up, moe_w_down, final_norm):
    h = x
    for i in range(DEPTH):
        j = i // N_MIXERS
        u = rms_norm(h, norm_mix[i])
        if i % N_MIXERS == 0:
            mix = diff_attention(u, diff_w_qkv[j], diff_w_o[j], diff_lambda[j], diff_subln[j], i)
        else:
            mix = moba_attention(u, moba_w_qkv[j], moba_w_o[j])
        h = h + mix
        u = rms_norm(h, norm_ffn[i])
        if i % 2 == 0:
            ffn = swiglu(u, ffn_w_gate[j], ffn_w_up[j], ffn_w_down[j])
        else:
            ffn = moe_swiglu(u, moe_router[j], moe_w_gate[j], moe_w_up[j], moe_w_down[j])
        h = h + ffn
    return rms_norm(h, final_norm)
```

```cpp
#define MK_DEBUG 0
#define MK_PER_PHASE 1
#include <hip/hip_runtime.h>
#include <cstdio>
#include <cstdint>

#ifndef MK_DEBUG
#define MK_DEBUG 1
#endif
#ifndef MK_KDEBUG
#define MK_KDEBUG 0
#endif
#define LAS __attribute__((address_space(3)))
#define GAS __attribute__((address_space(1)))

constexpr int BATCH = 8, SEQ = 4096, MTOK = BATCH * SEQ, D = 1024, DFF = 2816, DE = 3584, NE = 8;
constexpr int MOE_TILES_MAX = 272;
constexpr int LIST_CAP = MTOK;

namespace pg8 {
#define PG8_LAS __attribute__((address_space(3)))
typedef unsigned short bf16_t;
typedef short bf16x8 __attribute__((ext_vector_type(8)));
typedef float f32x4 __attribute__((ext_vector_type(4)));
typedef unsigned u32x4 __attribute__((ext_vector_type(4)));
constexpr int BM = 256, BK = 64, HALF = 128, HTB = HALF * BK * 2  , STAGE_BYTES = 8 * HTB, NXCD = 8, WGM = 8;

__host__ __device__ __forceinline__ int lds_byte(int r, int c) { const int st = (r >> 4) * 2 + (c >> 5), rr = r & 15, cc = c & 31, ob = rr * 64 + cc * 2; return st * 1024 + (ob ^ (((ob >> 9) & 1) << 5)); }
__host__ __device__ __forceinline__ void stage_rc(int b, int& R, int& C) { const int st = b / 1024, sb = b % 1024, swz = sb ^ (((sb >> 9) & 1) << 5); R = (st >> 1) * 16 + swz / 64; C = (st & 1) * 32 + (swz % 64) / 2; }
__host__ __device__ __forceinline__ int perm32(int rho) { const int n = rho >> 4, i = rho & 15; return 8 * (i >> 2) + 4 * n + (i & 3); }

struct Unit { int pm, pn, e, r0; };
struct Gemm { const bf16_t* A; const bf16_t* Bt; int K; size_t bstride; unsigned amax; unsigned* dbg; size_t bbytes; };

__device__ __forceinline__ void tile_of(int L, int nM, int nN, int& pm, int& pn) {
    const int nwg = nM * nN; int wgid = L; { const int q = nwg / NXCD, r = nwg % NXCD, xcd = wgid % NXCD, off = wgid / NXCD; wgid = (xcd < r ? xcd * (q + 1) : r * (q + 1) + (xcd - r) * q) + off; }
    const int nig = WGM * nN, gid = wgid / nig, fm = gid * WGM, gsz = (nM - fm) < WGM ? (nM - fm) : WGM;
    pm = fm + ((wgid % nig) % gsz); pn = (wgid % nig) / gsz;
}
struct StaticOrder {
    int nM, nN, nwg, G, c;
    __device__ __forceinline__ void init(int M, int N, int G_, int c_) { nM = M / BM; nN = N / BM; nwg = nM * nN; G = G_; c = c_; }
    __device__ __forceinline__ bool next(int i, Unit& u) const {
        const long L = (long)i * G + c; if (L >= nwg) return false;
        tile_of((int)L, nM, nN, u.pm, u.pn); u.e = 0; u.r0 = 0; return true;
    }
    __device__ __forceinline__ unsigned arow(const Unit& u, int lr) const { return (unsigned)(u.pm * BM + lr); }
};
struct MoeOrder {
    int nM, nN, nwg, G, c; int tstart[NE + 1]; int cnt[NE]; const unsigned* list_tok; bool gather;
    __device__ __forceinline__ void init(const unsigned* cntw, const unsigned* list_tok_, bool gather_, int N, int G_, int c_) {
        int acc = 0;
#pragma unroll
        for (int e = 0; e < NE; ++e) { const int ce = (int)__builtin_amdgcn_readfirstlane((int)__hip_atomic_load((const GAS unsigned*)cntw + 64 * e, __ATOMIC_RELAXED, __HIP_MEMORY_SCOPE_AGENT)); cnt[e] = ce; tstart[e] = acc; acc += (ce + BM - 1) / BM; }
        tstart[NE] = acc; nM = acc; nN = N / BM; nwg = nM * nN; G = G_; c = c_; list_tok = list_tok_; gather = gather_;
    }
    __device__ __forceinline__ bool next(int i, Unit& u) const {
        const long L = (long)i * G + c; if (L >= nwg) return false;
        tile_of((int)L, nM, nN, u.pm, u.pn); int e = 0;
#pragma unroll
        for (int k = 1; k < NE; ++k) e += (u.pm >= tstart[k]) ? 1 : 0;
        u.e = e; int ts = 0;
#pragma unroll
        for (int k = 0; k < NE; ++k) ts = (k == e) ? tstart[k] : ts;
        u.r0 = (u.pm - ts) * BM; return true;
    }
    __device__ __forceinline__ int count_of(int e) const { int cv = 0;
#pragma unroll
        for (int k = 0; k < NE; ++k) cv = (k == e) ? cnt[k] : cv;
        return cv; }
    __device__ __forceinline__ unsigned arow(const Unit& u, int lr) const {
        if (!gather) return (unsigned)(u.pm * BM + lr);
        const int l = u.r0 + lr; const int cv = count_of(u.e);
        unsigned t = 0u; if (l < cv) t = __hip_atomic_load((const GAS unsigned*)list_tok + (size_t)u.e * LIST_CAP + l, __ATOMIC_RELAXED, __HIP_MEMORY_SCOPE_AGENT) & 0xFFFFFu;
        return t;
    }
};

__device__ __forceinline__ unsigned cvt_pk_bf16(float lo, float hi) { unsigned r; asm volatile("v_cvt_pk_bf16_f32 %0, %1, %2" : "=v"(r) : "v"(lo), "v"(hi)); return r; }

struct EpiQKV {
    static constexpr bool PERM = true;
    bf16_t* O; int ldc; int split_cols; size_t split_stride; float scale0; unsigned* dbg;
    __device__ __forceinline__ void operator()(const f32x4 (&acc)[2][2][4][2], const Unit& u, int wr, int wc, int fr, int fq) const {
        const int row0 = u.pm * BM + wr * 64 + fr; int colt = u.pn * BM; bf16_t* base = O;
        float sc = 1.f; { const int t = colt / split_cols; base += (size_t)t * split_stride; colt -= t * split_cols; if (t == 0) sc = scale0; }
        const int col0 = colt + wc * 32 + 8 * fq;
#pragma unroll
        for (int ai = 0; ai < 2; ++ai)
#pragma unroll
            for (int m = 0; m < 4; ++m) { bf16_t* rowp = base + (size_t)(row0 + ai * HALF + m * 16) * ldc + col0;
#pragma unroll
                for (int bj = 0; bj < 2; ++bj) { f32x4 v0 = acc[ai][bj][m][0] * sc, v1 = acc[ai][bj][m][1] * sc;
                    u32x4 w; w.x = cvt_pk_bf16(v0[0], v0[1]); w.y = cvt_pk_bf16(v0[2], v0[3]); w.z = cvt_pk_bf16(v1[0], v1[1]); w.w = cvt_pk_bf16(v1[2], v1[3]);
#if defined(EPI_VARIANT) && EPI_VARIANT == 1
                    { u32x4 cz = {0x3f803f80u, 0x3f803f80u, 0x3f803f80u, 0x3f803f80u}; asm volatile("" :: "v"(w)); *(GAS u32x4*)(rowp + bj * HALF) = cz; }
#elif defined(EPI_VARIANT) && EPI_VARIANT == 2
                    { asm volatile("" :: "v"(w)); asm volatile("" :: "v"(rowp)); }
#elif MK_KDEBUG
                    { const size_t eo = (size_t)((rowp + bj * HALF) - O); if (eo + 8 <= (size_t)3 * 33554432) *(GAS u32x4*)(rowp + bj * HALF) = w; else atomicMax(dbg, 1000u - 3u); }
#else
                    *(GAS u32x4*)(rowp + bj * HALF) = w;
#endif
                    } }
    }
};
struct EpiSwiGLU {
    static constexpr bool PERM = true;
    bf16_t* O; int ldc;
    __device__ __forceinline__ void operator()(const f32x4 (&acc)[2][2][4][2], const Unit& u, int wr, int wc, int fr, int fq) const {
        const int row0 = u.pm * BM + wr * 64 + fr; const int col0 = u.pn * HALF + wc * 32 + 8 * fq;
#pragma unroll
        for (int ai = 0; ai < 2; ++ai)
#pragma unroll
            for (int m = 0; m < 4; ++m) { bf16_t* rowp = O + (size_t)(row0 + ai * HALF + m * 16) * ldc + col0; float o[8];
#pragma unroll
                for (int n = 0; n < 2; ++n)
#pragma unroll
                    for (int j = 0; j < 4; ++j) { const float g = acc[ai][0][m][n][j], up = acc[ai][1][m][n][j];
                        const float s = __builtin_amdgcn_rcpf(1.0f + __builtin_amdgcn_exp2f(-1.4426950408889634f * g)); o[n * 4 + j] = g * s * up; }
                u32x4 w; w.x = cvt_pk_bf16(o[0], o[1]); w.y = cvt_pk_bf16(o[2], o[3]); w.z = cvt_pk_bf16(o[4], o[5]); w.w = cvt_pk_bf16(o[6], o[7]);
                *(GAS u32x4*)rowp = w; }
    }
};
struct EpiRes {
    static constexpr bool PERM = false;
    const float* res; float* out; int ldc;
    __device__ __forceinline__ void operator()(const f32x4 (&acc)[2][2][4][2], const Unit& u, int wr, int wc, int fr, int fq) const {
        const int row0 = u.pm * BM + wr * 64 + fr; const int col0 = u.pn * BM + wc * 32 + 4 * fq;
#pragma unroll
        for (int ai = 0; ai < 2; ++ai)
#pragma unroll
            for (int m = 0; m < 4; ++m) { const size_t off = (size_t)(row0 + ai * HALF + m * 16) * ldc + col0;
#pragma unroll
                for (int bj = 0; bj < 2; ++bj)
#pragma unroll
                    for (int n = 0; n < 2; ++n) { const f32x4 r = *(const GAS f32x4*)(res + off + bj * HALF + n * 16); *(GAS f32x4*)(out + off + bj * HALF + n * 16) = r + acc[ai][bj][m][n]; } }
    }
};
struct EpiMoeDown {
    static constexpr bool PERM = false;
    float* h; bf16_t* y1; const unsigned* list_tok; const float* list_w; int cnt[NE];
    __device__ __forceinline__ void operator()(const f32x4 (&acc)[2][2][4][2], const Unit& u, int wr, int wc, int fr, int fq) const {
        int cv = 0;
#pragma unroll
        for (int k = 0; k < NE; ++k) cv = (k == u.e) ? cnt[k] : cv;
        const int col0 = u.pn * BM + wc * 32 + 4 * fq;
#pragma unroll
        for (int ai = 0; ai < 2; ++ai)
#pragma unroll
            for (int m = 0; m < 4; ++m) { const int l = u.r0 + ai * HALF + wr * 64 + m * 16 + fr;
                if (l < cv) {
                    const unsigned ent = __hip_atomic_load((const GAS unsigned*)list_tok + (size_t)u.e * LIST_CAP + l, __ATOMIC_RELAXED, __HIP_MEMORY_SCOPE_AGENT);
                    const float w = __uint_as_float(__hip_atomic_load((const GAS unsigned*)list_w + (size_t)u.e * LIST_CAP + l, __ATOMIC_RELAXED, __HIP_MEMORY_SCOPE_AGENT));
                    const size_t off = (size_t)(ent & 0xFFFFFu) * D + col0;
                    if ((ent >> 20) == 0u) {
#pragma unroll
                        for (int bj = 0; bj < 2; ++bj)
#pragma unroll
                            for (int n = 0; n < 2; ++n) { GAS float* p = (GAS float*)(h + off + bj * HALF + n * 16); const f32x4 r = *(const GAS f32x4*)p; *(GAS f32x4*)p = r + acc[ai][bj][m][n] * w; }
                    } else {
#pragma unroll
                        for (int bj = 0; bj < 2; ++bj)
#pragma unroll
                            for (int n = 0; n < 2; ++n) { const f32x4 v = acc[ai][bj][m][n] * w; unsigned long long pk = (unsigned long long)cvt_pk_bf16(v[0], v[1]) | ((unsigned long long)cvt_pk_bf16(v[2], v[3]) << 32);
                                *(GAS unsigned long long*)(y1 + off + bj * HALF + n * 16) = pk; }
                    }
                } }
    }
};

template <class Epi, class Sched>
__device__ __forceinline__ void gemm_phase(PG8_LAS unsigned char* lds, int xoff, const Gemm g, const Sched& S, const Epi& E) {
    int tid_ = threadIdx.x;
#if !defined(NO_OPQ_T)
    asm volatile("" : "+v"(tid_));
#endif
    const int tid = tid_, wid = __builtin_amdgcn_readfirstlane(tid >> 6), lane = tid & 63, wr = wid >> 2, wc = wid & 3, fr = lane & 15, fq = lane >> 4;
    const int K = g.K, nt = K / BK;
    unsigned voffB[2];
#pragma unroll
    for (int i = 0; i < 2; ++i) { int R, C; stage_rc(tid * 16 + i * 8192, R, C); const int Rb = Epi::PERM ? ((R & ~31) + perm32(R & 31)) : R;
        voffB[i] = (unsigned)(Rb * K + C) * 2u; }
    const size_t kstep = (size_t)(BK * 2);
    const size_t hstep = (size_t)HALF * K * 2;
    const size_t tstep = 2 * hstep;
    const unsigned ldsw = (unsigned)wid * 1024u;
    const int aoff = lds_byte(wr * 64 + fr, fq * 8), boff = lds_byte(wc * 32 + fr, fq * 8);
#define PG8_SA(b, h) (((b) * 2 + (h)) * HTB)
#define PG8_SB(b, h) ((4 + (b) * 2 + (h)) * HTB)
#define PG8_STAGE(bufoff, gbase, v0, v1) do { \
        __builtin_amdgcn_global_load_lds((const GAS unsigned*)((const char*)(gbase) + (v0)), (PG8_LAS unsigned*)(lds + (bufoff) + ldsw), 16, 0, 0); \
        __builtin_amdgcn_global_load_lds((const GAS unsigned*)((const char*)(gbase) + (v1)), (PG8_LAS unsigned*)(lds + (bufoff) + ldsw + 8192), 16, 0, 0); } while (0)
#define PG8_STAGEB(bufoff, gbase) PG8_STAGE(bufoff, gbase, voffB[0], voffB[1])
#define PG8_LDA(dst, b, h) do { _Pragma("unroll") for (int m = 0; m < 4; ++m) _Pragma("unroll") for (int k = 0; k < 2; ++k) dst[m][k] = *(const PG8_LAS bf16x8*)(lds + PG8_SA(b, h) + aoff + m * 2048 + k * 1024); } while (0)
#define PG8_LDB(dst, b, h) do { _Pragma("unroll") for (int n = 0; n < 2; ++n) _Pragma("unroll") for (int k = 0; k < 2; ++k) dst[n][k] = *(const PG8_LAS bf16x8*)(lds + PG8_SB(b, h) + boff + n * 2048 + k * 1024); } while (0)
#define PG8_MMA(ai, bj, At, Bt) do { __builtin_amdgcn_s_setprio(1); _Pragma("unroll") for (int m = 0; m < 4; ++m) _Pragma("unroll") for (int n = 0; n < 2; ++n) _Pragma("unroll") for (int k = 0; k < 2; ++k) \
        acc[ai][bj][m][n] = __builtin_amdgcn_mfma_f32_16x16x32_bf16(Bt[n][k], At[m][k], acc[ai][bj][m][n], 0, 0, 0); __builtin_amdgcn_s_setprio(0); } while (0)
#define PG8_WAIT_V(n) asm volatile("s_waitcnt vmcnt(" #n ")" ::: "memory")
#define PG8_WAIT_L(n) asm volatile("s_waitcnt lgkmcnt(" #n ")" ::: "memory")
#define PG8_BAR __builtin_amdgcn_s_barrier()
#define PG8_SCHED __builtin_amdgcn_sched_barrier(0)
#define PG8_AOFFS(U, o00, o01, o10, o11) do { int R0_, C0_, R1_, C1_; stage_rc(tid * 16, R0_, C0_); stage_rc(tid * 16 + 8192, R1_, C1_);     \
        o00 = (S.arow(U, R0_) * (unsigned)K + (unsigned)C0_) * 2u; o01 = (S.arow(U, R1_) * (unsigned)K + (unsigned)C1_) * 2u; \
        o10 = (S.arow(U, HALF + R0_) * (unsigned)K + (unsigned)C0_) * 2u; o11 = (S.arow(U, HALF + R1_) * (unsigned)K + (unsigned)C1_) * 2u; } while (0)
    Unit cur, nxt; int ui = 0;
#if MK_KDEBUG
    if (blockIdx.x == 5 && threadIdx.x == 0) atomicOr(g.dbg + 43, 2u);
#endif
    if (!S.next(0, cur)) return;
#if MK_KDEBUG
    if (blockIdx.x == 5 && threadIdx.x == 0) atomicOr(g.dbg + 43, 4u);
    { Unit t1_; if (blockIdx.x == 5 && threadIdx.x == 0 && S.next(1, t1_)) { g.dbg[40] = 1u + (unsigned)t1_.pm * 16u + (unsigned)t1_.pn; g.dbg[41] = 1u + (unsigned)cur.pm * 16u + (unsigned)cur.pn; g.dbg[42] = 1u + (unsigned)gridDim.x; atomicOr(g.dbg + 43, 8u); } }
#endif
#if defined(GDBG_NOKLOOP)
    { f32x4 accz[2][2][4][2];
      for (int ui_ = 0; S.next(ui_, cur); ++ui_) {
#pragma unroll
        for (int a = 0; a < 2; ++a)
#pragma unroll
          for (int b = 0; b < 2; ++b)
#pragma unroll
            for (int m = 0; m < 4; ++m)
#pragma unroll
              for (int n = 0; n < 2; ++n) { f32x4 r4;
                for (int j = 0; j < 4; ++j) { const int row = cur.pm * 256 + a * 128 + wr * 64 + m * 16 + fr;
                  const int col = cur.pn * 256 + b * 128 + wc * 32 + (Epi::PERM ? 8 * fq + 4 * n + j : 16 * n + 4 * fq + j);
                  const bf16_t* ar = g.A + (size_t)row * K; const bf16_t* br = g.Bt + (size_t)cur.e * g.bstride + (size_t)col * K; float s_ = 0.f;
                  for (int k = 0; k < K; ++k) s_ += __uint_as_float(((unsigned)ar[k]) << 16) * __uint_as_float(((unsigned)br[k]) << 16);
                  r4[j] = s_; }
                accz[a][b][m][n] = r4; }
        E(accz, cur, wr, wc, fr, fq); }
      return; }
#endif
    f32x4 acc[2][2][4][2];
#pragma unroll
    for (int a = 0; a < 2; ++a)
#pragma unroll
        for (int b = 0; b < 2; ++b)
#pragma unroll
            for (int m = 0; m < 4; ++m)
#pragma unroll
                for (int n = 0; n < 2; ++n) acc[a][b][m][n] = (f32x4){0.f, 0.f, 0.f, 0.f};
    bf16x8 At[4][2], B0[2][2], B1[2][2];
    unsigned c00, c01, c10, c11;
    PG8_LAS u32x4* const xslot = (PG8_LAS u32x4*)(lds + xoff) + tid;
    PG8_AOFFS(cur, c00, c01, c10, c11);
    const char* const gA = (const char*)g.A;
    const char* cB = (const char*)g.Bt + (size_t)cur.e * g.bstride * 2 + (size_t)cur.pn * tstep;
    PG8_STAGEB(PG8_SB(0, 0), cB); PG8_STAGEB(PG8_SB(0, 1), cB + hstep); PG8_STAGE(PG8_SA(0, 0), gA, c00, c01); PG8_STAGE(PG8_SA(0, 1), gA, c10, c11);
    if (wr == 1) PG8_BAR;
    PG8_WAIT_V(2); PG8_BAR;
    PG8_STAGEB(PG8_SB(1, 0), cB + kstep); PG8_STAGE(PG8_SA(1, 0), gA + kstep, c00, c01); PG8_STAGEB(PG8_SB(1, 1), cB + hstep + kstep);
    PG8_WAIT_V(6); PG8_BAR;
    for (;;) {
        const bool has_next = S.next(ui + 1, nxt);
        const char* nB_ = has_next ? (const char*)g.Bt + (size_t)nxt.e * g.bstride * 2 + (size_t)nxt.pn * tstep : cB;
        const char* nB = nB_;
        if (has_next) { unsigned n00, n01, n10, n11; PG8_AOFFS(nxt, n00, n01, n10, n11); *xslot = (u32x4){n00, n01, n10, n11}; }
#if MK_KDEBUG
        { const char* lo_ = (const char*)g.Bt; const char* hi_ = lo_ + g.bbytes - tstep;
          if (cB < lo_ || cB > hi_ || nB < lo_ || nB > hi_) { atomicMax(g.dbg, 1000u - 92u); cB = lo_; nB = lo_; }
          if (voffB[0] > (unsigned)tstep || voffB[1] > (unsigned)tstep) { atomicMax(g.dbg, 1000u - 93u); voffB[0] = 0u; voffB[1] = 0u; }
          const unsigned mx_ = g.amax; if (c00 > mx_ || c01 > mx_ || c10 > mx_ || c11 > mx_) { atomicMax(g.dbg, 1000u - 94u); c00 = 0u; c01 = 0u; c10 = 0u; c11 = 0u; } }
#endif
        for (int t = 0; t < nt; t += 2) {
            const bool last = (t == nt - 2);
            const char* a1 = gA + (size_t)(t + 1) * kstep;
            const char* a2 = last ? gA : gA + (size_t)(t + 2) * kstep; const char* b2 = last ? nB : cB + (size_t)(t + 2) * kstep;
            const char* a3 = a2 + kstep; const char* b3 = b2 + kstep;
            PG8_LDB(B0, 0, 0); PG8_LDB(B1, 0, 1); PG8_SCHED; PG8_LDA(At, 0, 0); PG8_STAGE(PG8_SA(1, 1), a1, c10, c11);
            if (last && has_next) { const u32x4 nx = *xslot; c00 = nx.x; c01 = nx.y; c10 = nx.z; c11 = nx.w; }
#if MK_KDEBUG
            { const unsigned mx_ = g.amax; if (c00 > mx_ || c01 > mx_ || c10 > mx_ || c11 > mx_) { atomicMax(g.dbg, 1000u - 90u); c00 = c00 > mx_ ? 0u : c00; c01 = c01 > mx_ ? 0u : c01; c10 = c10 > mx_ ? 0u : c10; c11 = c11 > mx_ ? 0u : c11; } }
#endif
            PG8_WAIT_V(8); PG8_WAIT_L(0); PG8_BAR; PG8_MMA(0, 0, At, B0); PG8_MMA(0, 1, At, B1); PG8_BAR; PG8_SCHED;
            PG8_LDA(At, 0, 1); PG8_STAGEB(PG8_SB(0, 0), b2); PG8_STAGEB(PG8_SB(0, 1), b2 + hstep); PG8_STAGE(PG8_SA(0, 0), a2, c00, c01);
            PG8_WAIT_V(8); PG8_WAIT_L(0); PG8_BAR; PG8_MMA(1, 0, At, B0); PG8_MMA(1, 1, At, B1); PG8_BAR; PG8_SCHED;
            PG8_LDB(B0, 1, 0); PG8_LDB(B1, 1, 1); PG8_SCHED; PG8_LDA(At, 1, 0); PG8_STAGE(PG8_SA(0, 1), a2, c10, c11);
            PG8_WAIT_V(8); PG8_WAIT_L(0); PG8_BAR; PG8_MMA(0, 0, At, B0); PG8_MMA(0, 1, At, B1); PG8_BAR; PG8_SCHED;
            PG8_LDA(At, 1, 1); PG8_STAGEB(PG8_SB(1, 0), b3); PG8_STAGEB(PG8_SB(1, 1), b3 + hstep); PG8_STAGE(PG8_SA(1, 0), a3, c00, c01);
            PG8_WAIT_V(8); PG8_WAIT_L(0); PG8_BAR; PG8_MMA(1, 0, At, B0); PG8_MMA(1, 1, At, B1); PG8_BAR; PG8_SCHED;
        }
        if (wr == 0) PG8_BAR;
#if !defined(GDBG_NOEPI)
#if defined(EPI_DRAIN)
        asm volatile("s_waitcnt vmcnt(0)" ::: "memory");
#endif
        E(acc, cur, wr, wc, fr, fq);
#if defined(EPI_DRAIN_AFTER)
        asm volatile("s_waitcnt vmcnt(0)" ::: "memory");
#endif
#else
        asm volatile("" :: "v"(acc[0][0][0][0]), "v"(acc[1][1][3][1]));
#endif
        if (!has_next) break;
#pragma unroll
        for (int a = 0; a < 2; ++a)
#pragma unroll
            for (int b = 0; b < 2; ++b)
#pragma unroll
                for (int m = 0; m < 4; ++m)
#pragma unroll
                    for (int n = 0; n < 2; ++n) acc[a][b][m][n] = (f32x4){0.f, 0.f, 0.f, 0.f};
        cur = nxt; cB = nB; ++ui;
        if (wr == 1) PG8_BAR;
    }
    PG8_WAIT_V(0);
    PG8_BAR;
#undef PG8_SA
#undef PG8_SB
#undef PG8_STAGE
#undef PG8_STAGEB
#undef PG8_LDA
#undef PG8_LDB
#undef PG8_MMA
#undef PG8_WAIT_V
#undef PG8_WAIT_L
#undef PG8_BAR
#undef PG8_SCHED
#undef PG8_AOFFS
}
}

namespace att {
typedef unsigned short bf16_t;
typedef short bf16x8 __attribute__((ext_vector_type(8)));
typedef short s16x4 __attribute__((ext_vector_type(4)));
typedef float f32x16 __attribute__((ext_vector_type(16)));
typedef float f32x4 __attribute__((ext_vector_type(4)));
typedef unsigned u32x4 __attribute__((ext_vector_type(4)));
constexpr int PITCH = 1024;
constexpr float LOG2E = 1.4426950408889634f;
__device__ __forceinline__ int crow(int r, int hi) { return (r & 3) + 8 * (r >> 2) + 4 * hi; }
typedef float f32x2_t __attribute__((ext_vector_type(2))); typedef __bf16 bf16x2_t __attribute__((ext_vector_type(2)));
__device__ __forceinline__ unsigned cvtpk(float lo, float hi) { f32x2_t v = {lo, hi}; bf16x2_t b = __builtin_convertvector(v, bf16x2_t); return __builtin_bit_cast(unsigned, b); }
__device__ __forceinline__ float bf2f(short s) { return __uint_as_float(((unsigned)(unsigned short)s) << 16); }
typedef short v4i16_t __attribute__((ext_vector_type(4)));
__device__ __forceinline__ s16x4 vtr(const LAS unsigned char* p) { return __builtin_bit_cast(s16x4, __builtin_amdgcn_ds_read_tr16_b64_v4i16((LAS v4i16_t*)p)); }
__device__ __forceinline__ float halves_max(float m) { auto rr = __builtin_amdgcn_permlane32_swap(__float_as_uint(m), __float_as_uint(m), false, false); return fmaxf(__uint_as_float(rr[0]), __uint_as_float(rr[1])); }
__device__ __forceinline__ float halves_sum(float m) { auto rr = __builtin_amdgcn_permlane32_swap(__float_as_uint(m), __float_as_uint(m), false, false); return __uint_as_float(rr[0]) + __uint_as_float(rr[1]); }
#define ATT_BAR() asm volatile("s_waitcnt vmcnt(0) lgkmcnt(0)\n\ts_barrier" ::: "memory")

struct Args { const bf16_t* Q; const bf16_t* K; const bf16_t* V; bf16_t* O; const float* kmean; const float* subln; float lam_full; float out_scale; };

template <int MODE>
__device__ __forceinline__ void attn_unit(LAS unsigned char* lds, const Args& A, int b, int h, int qblk) {
    constexpr int DVB = MODE == 0 ? 4 : 2;
    constexpr int NCH = MODE == 0 ? 16 : 8;
    constexpr int KBY = NCH * 1024, VBY = DVB * 4096, SLOT = KBY + VBY;
    constexpr int QR = MODE == 0 ? 128 : 256;
    constexpr int PPW = MODE == 0 ? 2 : 1;
    int tid_ = threadIdx.x; asm volatile("" : "+v"(tid_));
    const int tid = tid_, lane = tid & 63, r32 = lane & 31, hi = lane >> 5;
    const int wid = __builtin_amdgcn_readfirstlane(tid >> 6);
    const int comp = MODE == 0 ? (wid >> 2) : 0, wq = MODE == 0 ? (wid & 3) : wid;
    const int q0 = qblk * QR; const long rowbase = (long)b * SEQ;
    const int hcol = MODE == 0 ? h * 128 : h * 64;
    const int qrel0 = wq * 32;
    const float slope2 = __builtin_amdgcn_exp2f(MODE == 0 ? -(float)(h + 1) : -0.5f * (float)(h + 1)) * LOG2E;
    const int NT = MODE == 0 ? 2 * qblk + 2 : 4 + 4 * qblk;
    LAS float* wsf = (LAS float*)(lds + 65536) + wid * 64;
    const bf16_t* Kb = A.K + rowbase * PITCH + hcol;
    const bf16_t* Vb = A.V + rowbase * PITCH + hcol;
    bf16x8 qr[4];
    { const bf16_t* Qw = A.Q + (rowbase + q0 + qrel0 + r32) * PITCH + hcol + comp * 64 + hi * 8;
#pragma unroll
      for (int d0 = 0; d0 < 4; ++d0) qr[d0] = *(const GAS bf16x8*)(Qw + d0 * 16); }
    ATT_BAR();
    unsigned sel = 0u;
    if constexpr (MODE == 1) {
        LAS float* km = (LAS float*)(lds + 67584);
        for (int i = tid; i < 1024; i += 512) km[i] = ((const GAS float*)A.kmean)[(size_t)(b * 16 + h) * 1024 + i];
        ATT_BAR();
        float g[16];
#pragma unroll
        for (int n = 0; n < 16; ++n) { float s = 0.f;
            if (n < qblk) {
#pragma unroll
                for (int d0 = 0; d0 < 4; ++d0) { const f32x4 ka = *(const LAS f32x4*)(km + n * 64 + d0 * 16 + hi * 8), kb2 = *(const LAS f32x4*)(km + n * 64 + d0 * 16 + hi * 8 + 4);
                    s += bf2f(qr[d0][0]) * ka[0] + bf2f(qr[d0][1]) * ka[1] + bf2f(qr[d0][2]) * ka[2] + bf2f(qr[d0][3]) * ka[3]
                       + bf2f(qr[d0][4]) * kb2[0] + bf2f(qr[d0][5]) * kb2[1] + bf2f(qr[d0][6]) * kb2[2] + bf2f(qr[d0][7]) * kb2[3]; }
                s = halves_sum(s); }
            g[n] = s; }
        const int nsel = qblk < 3 ? qblk : 3;
#pragma unroll
        for (int k = 0; k < 3; ++k) if (k < nsel) { float best = -INFINITY; int bi = 0; bool found = false;
#pragma unroll
            for (int n = 0; n < 16; ++n) if (n < qblk) { const bool free_ = ((sel >> n) & 1u) == 0u; if (free_ && (!found || g[n] > best)) { best = g[n]; bi = n; found = true; } }
            sel |= 1u << bi; }
    }
#define ATT_KBASE(t) (MODE == 0 ? 64 * (t) : ((t) < 4 ? q0 + 64 * (t) : 64 * ((t) - 4)))
#define ATT_ISSUE(t, slot) do { const int kb_ = ATT_KBASE(t); \
        _Pragma("unroll") for (int i_ = 0; i_ < PPW; ++i_) { const int p_ = wid + 8 * i_; \
            __builtin_amdgcn_global_load_lds((const GAS unsigned*)(Kb + (size_t)(kb_ + lane) * PITCH + p_ * 8), (LAS unsigned*)(lds + (slot) * SLOT + p_ * 1024), 16, 0, 0); \
            __builtin_amdgcn_global_load_lds((const GAS unsigned*)(Vb + (size_t)(kb_ + 16 * (p_ & 3) + (lane >> 2)) * PITCH + (p_ >> 2) * 32 + (lane & 3) * 8), (LAS unsigned*)(lds + (slot) * SLOT + KBY + p_ * 1024), 16, 0, 0); } } while (0)
    float m = -INFINITY, l = 0.f; f32x16 o[DVB];
#pragma unroll
    for (int d0 = 0; d0 < DVB; ++d0) o[d0] = f32x16{};
    ATT_ISSUE(0, 0);
    for (int t = 0; t < NT; ++t) {
        ATT_BAR();
        if (t + 1 < NT) ATT_ISSUE(t + 1, (t + 1) & 1);
        const int kbase = ATT_KBASE(t), krel = kbase - q0;
        const bool diag = kbase >= q0;
        bool skip = diag && (krel > qrel0 + 31);
        const bool needmask = diag && (krel + 63 > qrel0);
        bool selbit = true;
        if constexpr (MODE == 1) { if (t >= 4) { selbit = ((sel >> ((t - 4) >> 2)) & 1u) != 0u; if (!__any(selbit)) skip = true; } }
        if (!skip) {
            const LAS unsigned char* Ks = lds + (t & 1) * SLOT + comp * 8192 + hi * 1024 + r32 * 16;
            const LAS unsigned char* Vs = lds + (t & 1) * SLOT + KBY + ((lane >> 4) & 1) * 32 + (lane & 3) * 8 + (4 * hi + ((lane & 15) >> 2)) * 64;
            f32x16 p0 = f32x16{}, p1 = f32x16{};
#pragma unroll
            for (int d0 = 0; d0 < 4; ++d0) { const bf16x8 b0 = *(const LAS bf16x8*)(Ks + d0 * 2048), b1 = *(const LAS bf16x8*)(Ks + d0 * 2048 + 512);
                p0 = __builtin_amdgcn_mfma_f32_32x32x16_bf16(b0, qr[d0], p0, 0, 0, 0); p1 = __builtin_amdgcn_mfma_f32_32x32x16_bf16(b1, qr[d0], p1, 0, 0, 0); }
            const float hb = slope2 * (float)(krel + 4 * hi);
#pragma unroll
            for (int r = 0; r < 16; ++r) { const float bb = hb + slope2 * (float)((r & 3) + 8 * (r >> 2)); p0[r] += bb; p1[r] += bb + 32.0f * slope2; }
            if (needmask) { const int qrel = qrel0 + r32;
#pragma unroll
                for (int r = 0; r < 16; ++r) { const int kv = krel + crow(r, hi); if (kv > qrel) p0[r] = -INFINITY; if (kv + 32 > qrel) p1[r] = -INFINITY; } }
            if constexpr (MODE == 1) { if (!selbit) {
#pragma unroll
                for (int r = 0; r < 16; ++r) { p0[r] = -INFINITY; p1[r] = -INFINITY; } } }
            float rm = fmaxf(p0[0], p1[0]);
#pragma unroll
            for (int r = 1; r < 16; ++r) rm = fmaxf(rm, fmaxf(p0[r], p1[r]));
            rm = halves_max(rm);
            const bool grow = rm > m;
            if (__any(grow)) {
                const float mnew = fmaxf(m, rm); const float alpha = grow ? __builtin_amdgcn_exp2f(m - mnew) : 1.0f;
                l *= alpha; m = mnew;
                if (hi == 0) wsf[r32] = alpha;
                asm volatile("s_waitcnt lgkmcnt(0)" ::: "memory");
#pragma unroll
                for (int gq = 0; gq < 4; ++gq) { const f32x4 f = *(const LAS f32x4*)(wsf + 8 * gq + 4 * hi);
#pragma unroll
                    for (int d0 = 0; d0 < DVB; ++d0) { o[d0][4 * gq + 0] *= f[0]; o[d0][4 * gq + 1] *= f[1]; o[d0][4 * gq + 2] *= f[2]; o[d0][4 * gq + 3] *= f[3]; } }
            }
            float sacc = 0.f;
#pragma unroll
            for (int r = 0; r < 16; ++r) { p0[r] = __builtin_amdgcn_exp2f(p0[r] - m); p1[r] = __builtin_amdgcn_exp2f(p1[r] - m); sacc += p0[r] + p1[r]; }
            l += sacc;
            u32x4 pw[4];
            pw[0] = (u32x4){cvtpk(p0[0], p0[1]), cvtpk(p0[2], p0[3]), cvtpk(p0[4], p0[5]), cvtpk(p0[6], p0[7])};
            pw[1] = (u32x4){cvtpk(p0[8], p0[9]), cvtpk(p0[10], p0[11]), cvtpk(p0[12], p0[13]), cvtpk(p0[14], p0[15])};
            pw[2] = (u32x4){cvtpk(p1[0], p1[1]), cvtpk(p1[2], p1[3]), cvtpk(p1[4], p1[5]), cvtpk(p1[6], p1[7])};
            pw[3] = (u32x4){cvtpk(p1[8], p1[9]), cvtpk(p1[10], p1[11]), cvtpk(p1[12], p1[13]), cvtpk(p1[14], p1[15])};
#pragma unroll
            for (int d0 = 0; d0 < DVB; ++d0)
#pragma unroll
                for (int ks = 0; ks < 4; ++ks) { const s16x4 vlo = vtr(Vs + d0 * 4096 + ks * 1024), vhi = vtr(Vs + d0 * 4096 + ks * 1024 + 512);
                    const bf16x8 vf = (bf16x8){vlo[0], vlo[1], vlo[2], vlo[3], vhi[0], vhi[1], vhi[2], vhi[3]};
                    o[d0] = __builtin_amdgcn_mfma_f32_32x32x16_bf16(__builtin_bit_cast(bf16x8, pw[ks]), vf, o[d0], 0, 0, 0); }
        }
    }
    l = halves_sum(l);
    if (hi == 0) wsf[32 + r32] = l;
    asm volatile("s_waitcnt lgkmcnt(0)" ::: "memory");
    float rli[16];
#pragma unroll
    for (int gq = 0; gq < 4; ++gq) { const f32x4 f = *(const LAS f32x4*)(wsf + 32 + 8 * gq + 4 * hi); rli[4 * gq + 0] = 1.0f / f[0]; rli[4 * gq + 1] = 1.0f / f[1]; rli[4 * gq + 2] = 1.0f / f[2]; rli[4 * gq + 3] = 1.0f / f[3]; }
    if constexpr (MODE == 1) {
        GAS bf16_t* Ow = (GAS bf16_t*)(A.O + (rowbase + q0 + qrel0) * PITCH + hcol);
#pragma unroll
        for (int r = 0; r < 16; ++r)
#pragma unroll
            for (int d0 = 0; d0 < DVB; ++d0) Ow[(size_t)crow(r, hi) * PITCH + d0 * 32 + r32] = (bf16_t)(cvtpk(o[d0][r] * rli[r], 0.f) & 0xFFFFu);
    } else {
        ATT_BAR();
        LAS float* X = (LAS float*)lds + wq * 4096;
        if (comp == 1) {
#pragma unroll
            for (int d0 = 0; d0 < DVB; ++d0)
#pragma unroll
                for (int r = 0; r < 16; ++r) X[(d0 * 16 + r) * 64 + lane] = o[d0][r] * rli[r];
        }
        ATT_BAR();
        if (comp == 0) {
            float sg[DVB];
#pragma unroll
            for (int d0 = 0; d0 < DVB; ++d0) sg[d0] = ((const GAS float*)A.subln)[d0 * 32 + r32] * A.out_scale;
            GAS bf16_t* Ow = (GAS bf16_t*)(A.O + (rowbase + q0 + qrel0) * PITCH + hcol);
#pragma unroll
            for (int r = 0; r < 16; ++r) { float dv[DVB]; float ss = 0.f;
#pragma unroll
                for (int d0 = 0; d0 < DVB; ++d0) { dv[d0] = o[d0][r] * rli[r] - A.lam_full * X[(d0 * 16 + r) * 64 + lane]; ss += dv[d0] * dv[d0]; }
                ss += __shfl_xor(ss, 1); ss += __shfl_xor(ss, 2); ss += __shfl_xor(ss, 4); ss += __shfl_xor(ss, 8); ss += __shfl_xor(ss, 16);
                const float rs = 1.0f / sqrtf(ss * (1.0f / 128.0f) + 1e-5f);
#pragma unroll
                for (int d0 = 0; d0 < DVB; ++d0) Ow[(size_t)crow(r, hi) * PITCH + d0 * 32 + r32] = (bf16_t)(cvtpk(dv[d0] * rs * sg[d0], 0.f) & 0xFFFFu); }
        }
    }
#undef ATT_KBASE
#undef ATT_ISSUE
}
#undef ATT_BAR
}

constexpr int NWAVES = 8;
#ifndef MK_PER_PHASE
#define MK_PER_PHASE 1
#endif
#ifndef MK_DEBUG
#define MK_DEBUG 1
#endif
constexpr int NLAYER = 4, PH_PER_LAYER = 8, NPHASE = 1 + NLAYER * PH_PER_LAYER;

constexpr size_t MiB = 1u << 20;
constexpr size_t WS_CTL = 0, CTL_ZERO_BYTES = 1 * MiB;
constexpr size_t WS_KMEAN = 1 * MiB;
constexpr size_t WS_LTOK = 2 * MiB, WS_LW = 3 * MiB;
constexpr size_t WS_DQKV = 5 * MiB;
constexpr size_t WS_DWO = WS_DQKV + 12 * MiB;
constexpr size_t WS_MQKV = WS_DWO + 4 * MiB;
constexpr size_t WS_MWO = WS_MQKV + 12 * MiB;
constexpr size_t WS_FGU = WS_MWO + 4 * MiB;
constexpr size_t WS_FD = WS_FGU + 22 * MiB;
constexpr size_t WS_MGU = WS_FD + 11 * MiB;
constexpr size_t WS_MD = WS_MGU + 112 * MiB;
constexpr size_t WS_XN = WS_MD + 56 * MiB;
constexpr size_t WS_Q = WS_XN + 64 * MiB, WS_K = WS_Q + 64 * MiB, WS_V = WS_K + 64 * MiB;
constexpr size_t WS_ACT = WS_Q;
constexpr size_t WS_END = WS_ACT + (size_t)MOE_TILES_MAX * 256 * DE * 2;
static_assert(WS_XN == 238 * MiB && WS_END == 778 * MiB, "d_ws map");
constexpr int CW_BAR = 4096;
constexpr int CW_CNT = 8192;

constexpr int RING_OFF = 0, RING_BYTES = 131072;
constexpr int LDSCTL_OFF = RING_BYTES, MISC_OFF = LDSCTL_OFF + 320;
constexpr int XSLOT_OFF = MISC_OFF + 128;
constexpr int LDS_BYTES = 147456;

typedef unsigned short bf16;
typedef unsigned v4u __attribute__((ext_vector_type(4)));
typedef float f32x4 __attribute__((ext_vector_type(4)));
typedef GAS unsigned gu32;
#define RLX_AGENT __ATOMIC_RELAXED, __HIP_MEMORY_SCOPE_AGENT
#define LDS_WAIT() asm volatile("s_waitcnt lgkmcnt(0)" ::: "memory")
#define VM_WAIT() asm volatile("s_waitcnt vmcnt(0)" ::: "memory")
__device__ __forceinline__ unsigned f2bf(float f) { unsigned u = __builtin_bit_cast(unsigned, f); return (u + 0x7fffu + ((u >> 16) & 1u)) >> 16; }
__device__ __forceinline__ unsigned pk2(float lo, float hi) { return f2bf(lo) | (f2bf(hi) << 16); }
__device__ __forceinline__ float bflo(unsigned w) { return __uint_as_float(w << 16); }
__device__ __forceinline__ float bfhi(unsigned w) { return __uint_as_float(w & 0xFFFF0000u); }
static_assert(XSLOT_OFF % 16 == 0 && XSLOT_OFF + 8192 <= LDS_BYTES, "LDS map");
#define XB_TMO      128
#define XB_XCNT(j)  (256  + 64 * (j))
#define XB_XSUB(j)  (1280 + 64 * (j))
#define XB_XGEN(j)  (2304 + 64 * (j))
#define XB_TOP      3328
#define XB_TOPGEN   3392
#define XCD_BAR_WORDS 3456
#define XB_SPIN_CAP (1u << 18)

__device__ __forceinline__ unsigned xb_ld(unsigned* p)              { return __hip_atomic_load(p, __ATOMIC_RELAXED, __HIP_MEMORY_SCOPE_AGENT); }
__device__ __forceinline__ unsigned xb_add(unsigned* p, unsigned v) { return __hip_atomic_fetch_add(p, v, __ATOMIC_RELAXED, __HIP_MEMORY_SCOPE_AGENT); }
__device__ __forceinline__ unsigned xb_xcc_id() { return (unsigned)__builtin_amdgcn_s_getreg((3 << 11) | 20) & 0xFu; }
#define XB_SPIN(cond, bar) do { unsigned _sp = 0; while (cond) { __builtin_amdgcn_s_sleep(1); \
    if ((++_sp & 255u) == 0u) { if (xb_ld(&(bar)[XB_TMO])) break; if (_sp > XB_SPIN_CAP) { atomicAdd(&(bar)[XB_TMO], 1u); break; } } } } while (0)

struct XcdBarrier {
    unsigned* bar; unsigned x;
    volatile LAS unsigned* st;
};

__device__ __forceinline__ XcdBarrier xcd_barrier_post(unsigned* bar, volatile LAS unsigned* st) {
    XcdBarrier b; b.bar = bar; b.x = xb_xcc_id(); b.st = st;
    if (threadIdx.x == 0) (void)xb_add(&bar[XB_XCNT(b.x)], 1u);
    return b;
}
__device__ __forceinline__ void xcd_barrier_complete(unsigned* bar, unsigned x, unsigned& nloc, unsigned& nx) {
    const unsigned G = gridDim.x * gridDim.y * gridDim.z;
    unsigned sum, cnt, mine, sp = 0u;
    for (;;) {
        sum = 0u; cnt = 0u; mine = 0u;
#pragma unroll
        for (unsigned j = 0; j < 16; ++j) { const unsigned c = xb_ld(&bar[XB_XCNT(j)]); sum += c; cnt += (c > 0u) ? 1u : 0u; mine = (j == x) ? c : mine; }
        if (sum == G) break;
        __builtin_amdgcn_s_sleep(1);
        if ((++sp & 255u) == 0u) { if (xb_ld(&bar[XB_TMO])) break; if (sp > XB_SPIN_CAP) { atomicAdd(&bar[XB_TMO], 1u); break; } }
    }
    nloc = mine > 0u ? mine : 1u; nx = cnt > 0u ? cnt : 1u;
}

__device__ __forceinline__ void xcd_barrier(const XcdBarrier& b) {
    asm volatile("s_waitcnt vmcnt(0)" ::: "memory");
    __syncthreads();
    if (threadIdx.x == 0) {
        unsigned* bar = b.bar;
        __builtin_amdgcn_s_waitcnt(0);
        unsigned nloc = b.st[0], nx = b.st[1];
        if (nloc == 0u) { xcd_barrier_complete(bar, b.x, nloc, nx); b.st[0] = nloc; b.st[1] = nx; }
        const unsigned old = xb_add(&bar[XB_XSUB(b.x)], 1u);
        const unsigned gen = old / nloc;
        if (old + 1u == (gen + 1u) * nloc) {
            __builtin_amdgcn_fence(__ATOMIC_RELEASE, "agent");
            asm volatile("s_waitcnt vmcnt(0)" ::: "memory");
            const unsigned og = xb_add(&bar[XB_TOP], 1u);
            const unsigned tg = og / nx;
            if (og + 1u == (tg + 1u) * nx) xb_add(&bar[XB_TOPGEN], 1u);
            else XB_SPIN(xb_ld(&bar[XB_TOPGEN]) == tg, bar);
            __builtin_amdgcn_fence(__ATOMIC_ACQUIRE, "agent");
            xb_add(&bar[XB_XGEN(b.x)], 1u);
            asm volatile("s_waitcnt vmcnt(0)" ::: "memory");
        } else {
            XB_SPIN(xb_ld(&bar[XB_XGEN(b.x)]) == gen, bar);
            __builtin_amdgcn_fence(__ATOMIC_ACQUIRE, "agent");
            asm volatile("s_waitcnt vmcnt(0)" ::: "memory");
        }
    }
    __syncthreads();
}

struct Frame {
    LAS unsigned char* lds;
    volatile LAS unsigned* MISC;
    gu32* ctl;
    int tid, lane, wave;
    int vcu, G;
};
__device__ __forceinline__ float wave_sum(float v) {
#pragma unroll
    for (int o = 1; o < 64; o <<= 1) v += __shfl_xor(v, o);
    return v;
}
__device__ __forceinline__ void transpose_item(const float* W, int K, int N, bf16* WT, int k0, int n0, int drow0, LAS float* scr, int lane) {
#pragma unroll 8
    for (int i = 0; i < 32; ++i) { const int kk = 2 * i + (lane >> 5); scr[kk * 33 + (lane & 31)] = ((const GAS float*)W)[(size_t)(k0 + kk) * N + n0 + (lane & 31)]; }
    LDS_WAIT(); asm volatile("" ::: "memory");
    const int c = lane & 7;
#pragma unroll
    for (int j = 0; j < 4; ++j) { const int n = (lane >> 3) + 8 * j; const LAS float* s = scr + (8 * c) * 33 + n;
        v4u o; o.x = pk2(s[0 * 33], s[1 * 33]); o.y = pk2(s[2 * 33], s[3 * 33]); o.z = pk2(s[4 * 33], s[5 * 33]); o.w = pk2(s[6 * 33], s[7 * 33]);
        *(GAS v4u*)(WT + (size_t)(drow0 + n) * K + k0 + 8 * c) = o; }
    LDS_WAIT(); asm volatile("" ::: "memory");
}
__device__ __forceinline__ void convert_matrix(Frame& F, const float* W, int K, int N, bf16* WT, int il, unsigned& rot) {
    LAS float* scr = (LAS float*)(F.lds + RING_OFF + F.wave * 16384);
    const unsigned gw = (unsigned)(F.vcu * NWAVES + F.wave), NGW = (unsigned)(F.G * NWAVES);
    const int nblk = N / 32, nitems = (K / 64) * nblk; int lane_ = F.lane; asm volatile("" : "+v"(lane_));
    for (int it = (int)((gw + NGW - rot % NGW) % NGW); it < nitems; it += (int)NGW) {
        const int kb = it / nblk, nb = it % nblk, n0 = 32 * nb;
        const int drow0 = il == 0 ? n0 : (n0 / 128) * 256 + (il - 1) * 128 + (n0 % 128);
        transpose_item(W, K, N, WT, 64 * kb, n0, drow0, scr, lane_);
    }
    rot = (rot + (unsigned)nitems) % NGW;
}

struct RouterArgs { const float* router; gu32* cnt; unsigned* ltok; float* lw; };
template <int MODE>
__device__ __forceinline__ void norm_phase(Frame& F, const float* src, float* hout, const bf16* y1, const float* gain, bf16* xn, float* fout, const RouterArgs& R) {
    int lane_ = F.lane; asm volatile("" : "+v"(lane_));
    const int gw = F.vcu * NWAVES + F.wave, NGW = F.G * NWAVES, lane = lane_;
    f32x4 gv[4];
#pragma unroll
    for (int j = 0; j < 4; ++j) gv[j] = *(const GAS f32x4*)(gain + 256 * j + 4 * lane);
    LAS float* RL = (LAS float*)(F.lds + RING_OFF);
    if constexpr (MODE == 2) {
        for (int i = F.tid; i < 8192; i += NWAVES * 64) RL[(i & 7) * 1024 + (i >> 3)] = ((const GAS float*)R.router)[i];
        LDS_WAIT(); __syncthreads();
    }
    const int nrows_w = gw < MTOK ? (MTOK - gw + NGW - 1) / NGW : 0;
    for (int cb = 0; cb < nrows_w; cb += 64) {
        int my_t = 0, my_e0 = 0, my_e1 = 0; float my_w0 = 0.f, my_w1 = 0.f; bool valid = false;
        const int cn = (nrows_w - cb) < 64 ? (nrows_w - cb) : 64;
        for (int i = 0; i < cn; ++i) {
            const int row = gw + (cb + i) * NGW;
            const GAS f32x4* xr = (const GAS f32x4*)(src + (size_t)row * D) + lane;
            f32x4 v[4]; float s = 0.f;
#pragma unroll
            for (int j = 0; j < 4; ++j) v[j] = xr[64 * j];
            if constexpr (MODE == 1 || MODE == 3) {
                const GAS unsigned long long* yr = (const GAS unsigned long long*)(y1 + (size_t)row * D) + lane;
#pragma unroll
                for (int j = 0; j < 4; ++j) { const unsigned long long w = yr[64 * j]; const unsigned lo = (unsigned)w, hi = (unsigned)(w >> 32);
                    v[j].x += bflo(lo); v[j].y += bfhi(lo); v[j].z += bflo(hi); v[j].w += bfhi(hi); }
            }
#pragma unroll
            for (int j = 0; j < 4; ++j) s += (v[j].x * v[j].x + v[j].y * v[j].y) + (v[j].z * v[j].z + v[j].w * v[j].w);
            if constexpr (MODE == 1) { GAS f32x4* hr = (GAS f32x4*)(hout + (size_t)row * D) + lane;
#pragma unroll
                for (int j = 0; j < 4; ++j) hr[64 * j] = v[j]; }
            const float rstd = 1.f / sqrtf(wave_sum(s) * (1.f / D) + 1e-6f);
#pragma unroll
            for (int j = 0; j < 4; ++j) v[j] = v[j] * rstd * gv[j];
            if constexpr (MODE == 3) { GAS f32x4* orow = (GAS f32x4*)(fout + (size_t)row * D) + lane;
#pragma unroll
                for (int j = 0; j < 4; ++j) orow[64 * j] = v[j];
            } else {
                GAS unsigned long long* o8 = (GAS unsigned long long*)(xn + (size_t)row * D) + lane;
#pragma unroll
                for (int j = 0; j < 4; ++j) o8[64 * j] = (unsigned long long)pk2(v[j].x, v[j].y) | ((unsigned long long)pk2(v[j].z, v[j].w) << 32);
            }
            if constexpr (MODE == 2) {
                float lg[NE];
#pragma unroll
                for (int e = 0; e < NE; ++e) { float a = 0.f;
#pragma unroll
                    for (int j = 0; j < 4; ++j) { const f32x4 rr = *(const LAS f32x4*)(RL + e * 1024 + 256 * j + 4 * lane); a += (v[j].x * rr.x + v[j].y * rr.y) + (v[j].z * rr.z + v[j].w * rr.w); }
                    lg[e] = wave_sum(a); }
                int e0 = 0; float v0 = lg[0];
#pragma unroll
                for (int e = 1; e < NE; ++e) if (lg[e] > v0) { v0 = lg[e]; e0 = e; }
                int e1 = -1; float v1 = 0.f;
#pragma unroll
                for (int e = 0; e < NE; ++e) if (e != e0 && (e1 < 0 || lg[e] > v1)) { v1 = lg[e]; e1 = e; }
                const float w0 = 1.f / (1.f + __expf(v1 - v0));
                if (lane == i) { my_t = row; my_e0 = e0; my_e1 = e1; my_w0 = w0; my_w1 = 1.f - w0; valid = true; }
            }
        }
        if constexpr (MODE == 2) {
            unsigned myc = 0u;
#pragma unroll
            for (int e = 0; e < NE; ++e) { const unsigned long long b0 = __ballot(valid && my_e0 == e), b1 = __ballot(valid && my_e1 == e);
                const unsigned c = (unsigned)(__popcll(b0) + __popcll(b1)); if (lane == e) myc = c; }
            unsigned basev = 0u;
            if (lane < NE) basev = __hip_atomic_fetch_add(R.cnt + 64 * lane, myc, RLX_AGENT);
            const unsigned long long lt = (1ull << lane) - 1ull;
            unsigned pos0 = 0u, pos1 = 0u;
#pragma unroll
            for (int e = 0; e < NE; ++e) { const unsigned long long b0 = __ballot(valid && my_e0 == e), b1 = __ballot(valid && my_e1 == e);
                const unsigned be = (unsigned)__shfl((int)basev, e);
                if (my_e0 == e) pos0 = be + (unsigned)__popcll(b0 & lt);
                if (my_e1 == e) pos1 = be + (unsigned)__popcll(b0) + (unsigned)__popcll(b1 & lt); }
            if (valid) {
                ((GAS unsigned*)R.ltok)[(size_t)my_e0 * LIST_CAP + pos0] = (unsigned)my_t;             ((GAS float*)R.lw)[(size_t)my_e0 * LIST_CAP + pos0] = my_w0;
                ((GAS unsigned*)R.ltok)[(size_t)my_e1 * LIST_CAP + pos1] = (unsigned)my_t | (1u << 20); ((GAS float*)R.lw)[(size_t)my_e1 * LIST_CAP + pos1] = my_w1;
            }
        }
    }
    if constexpr (MODE == 2) { LDS_WAIT(); __syncthreads(); }
}

__device__ __forceinline__ void kmean_phase(Frame& F, const bf16* Kt, float* kmean) {
    int lane_ = F.lane; asm volatile("" : "+v"(lane_));
    const int gw = F.vcu * NWAVES + F.wave, NGW = F.G * NWAVES, lane = lane_;
    for (int task = gw; task < BATCH * 16 * 8; task += NGW) {
        const int c8 = task & 7, n = (task >> 3) & 15, b = task >> 7;
        const GAS unsigned* p = (const GAS unsigned*)(Kt + ((size_t)b * SEQ + 256 * n) * D + c8 * 128) + lane;
        float a0 = 0.f, a1 = 0.f;
#pragma unroll 8
        for (int r = 0; r < 256; ++r) { const unsigned w = p[(size_t)r * (D / 2)]; a0 += bflo(w); a1 += bfhi(w); }
        const int col = c8 * 128 + 2 * lane, hh = col >> 6, d = col & 63;
        GAS float* o = (GAS float*)(kmean + ((size_t)(b * 16 + hh) * 16 + n) * 64 + d);
        o[0] = a0 * (1.f / 256.f); o[1] = a1 * (1.f / 256.f);
    }
}

struct KArgs { const float* in[17]; float* out; unsigned char* ws; int ph_lo, ph_hi; };
__global__ void __launch_bounds__(NWAVES * 64, 2) trunk_fwd(KArgs args) {
    extern __shared__ __attribute__((aligned(16))) unsigned char lds[];
    Frame F;
    F.lds = (LAS unsigned char*)lds;
    F.MISC = (volatile LAS unsigned*)(F.lds + MISC_OFF);
    F.tid = threadIdx.x; F.lane = F.tid & 63; F.wave = __builtin_amdgcn_readfirstlane(F.tid >> 6);
    F.G = gridDim.x; { const int bx = blockIdx.x; F.vcu = (F.G % 8 == 0) ? (bx % 8) * (F.G / 8) + bx / 8 : bx; }
    F.ctl = (gu32*)(args.ws + WS_CTL);
    for (int u = F.tid; u < (LDS_BYTES - LDSCTL_OFF) / 4; u += NWAVES * 64) ((LAS unsigned*)(F.lds + LDSCTL_OFF))[u] = 0u;
    __syncthreads();
    Frame& F0 = F;
    const int lo = args.ph_lo, hi = args.ph_hi;
    XcdBarrier bar; bar.bar = (unsigned*)(F.ctl + CW_BAR); bar.x = 0; bar.st = nullptr;
    if (hi - lo > 1) bar = xcd_barrier_post((unsigned*)(F.ctl + CW_BAR), F.MISC + 8);
#define IN(k) (lo <= (k) && (k) < hi)
#ifndef PH_ENABLE
#define PH_ENABLE 0xFFFFFFFFu
#endif
#define PHEN(n) (((PH_ENABLE) >> (n)) & 1u)
#if defined(NO_OPQ)
#define OPQ(p) do {} while (0)
#else
#define OPQ(p) asm volatile("" : "+s"(p))
#endif
#define SEAM(k) do { if (IN(k) && IN((k) + 1)) { XcdBarrier b2_ = bar; OPQ(b2_.bar); xcd_barrier(b2_); } } while (0)

#define PTRS() unsigned char* ws = args.ws; OPQ(ws); const float* x = args.in[0]; OPQ(x); const float* norm_mix = args.in[1]; OPQ(norm_mix); const float* norm_ffn = args.in[2]; OPQ(norm_ffn); \
    float* h = args.out; OPQ(h); \
    bf16* XN = (bf16*)(ws + WS_XN); bf16* Qb = (bf16*)(ws + WS_Q); bf16* Kb = (bf16*)(ws + WS_K); bf16* Vb = (bf16*)(ws + WS_V); bf16* ACT = (bf16*)(ws + WS_ACT); \
    bf16* MGU = (bf16*)(ws + WS_MGU); bf16* MD = (bf16*)(ws + WS_MD); \
    float* kmean = (float*)(ws + WS_KMEAN); unsigned* ltok = (unsigned*)(ws + WS_LTOK); float* lw = (float*)(ws + WS_LW); \
    (void)x; (void)norm_mix; (void)norm_ffn; (void)h; (void)XN; (void)Qb; (void)Kb; (void)Vb; (void)ACT; (void)MGU; (void)MD; (void)kmean; (void)ltok; (void)lw
    const RouterArgs noR{nullptr, nullptr, nullptr, nullptr};
    constexpr float C2 = 0.125f * 1.4426950408889634f;

    if (PHEN(0) && IN(0)) {
        PTRS();
        unsigned rot = 0u;
        for (int j = 0; j < 2; ++j) {
            convert_matrix(F, args.in[3] + (size_t)j * D * 3 * D, D, 3 * D, (bf16*)(ws + WS_DQKV) + (size_t)j * 3 * D * D, 0, rot);
            convert_matrix(F, args.in[4] + (size_t)j * D * D, D, D, (bf16*)(ws + WS_DWO) + (size_t)j * D * D, 0, rot);
            convert_matrix(F, args.in[7] + (size_t)j * D * 3 * D, D, 3 * D, (bf16*)(ws + WS_MQKV) + (size_t)j * 3 * D * D, 0, rot);
            convert_matrix(F, args.in[8] + (size_t)j * D * D, D, D, (bf16*)(ws + WS_MWO) + (size_t)j * D * D, 0, rot);
            convert_matrix(F, args.in[9] + (size_t)j * D * DFF, D, DFF, (bf16*)(ws + WS_FGU) + (size_t)j * 2 * DFF * D, 1, rot);
            convert_matrix(F, args.in[10] + (size_t)j * D * DFF, D, DFF, (bf16*)(ws + WS_FGU) + (size_t)j * 2 * DFF * D, 2, rot);
            convert_matrix(F, args.in[11] + (size_t)j * DFF * D, DFF, D, (bf16*)(ws + WS_FD) + (size_t)j * D * DFF, 0, rot);
        }
        for (int e = 0; e < NE; ++e) {
            convert_matrix(F, args.in[13] + (size_t)e * D * DE, D, DE, MGU + (size_t)e * 2 * DE * D, 1, rot);
            convert_matrix(F, args.in[14] + (size_t)e * D * DE, D, DE, MGU + (size_t)e * 2 * DE * D, 2, rot);
            convert_matrix(F, args.in[15] + (size_t)e * DE * D, DE, D, MD + (size_t)e * D * DE, 0, rot);
        }
        norm_phase<0>(F, x, nullptr, nullptr, norm_mix, XN, nullptr, noR);
    }
    SEAM(0);

    for (int L = 0; L < NLAYER; ++L) {
        const int j = L >> 1, moba = L & 1, pb = 1 + PH_PER_LAYER * L;
        int z_ = 0;
#if !defined(NO_OPQ_Z)
        asm volatile("" : "+s"(z_));
#endif
        Frame Fl = F0; Fl.G += z_; Fl.vcu += z_; Fl.wave += z_; Fl.lds += z_; Fl.ctl += z_; const int bx = (int)blockIdx.x + z_;
#define F Fl
        if (PHEN(1) && IN(pb + 0)) {
            PTRS();

            const bf16* W = (const bf16*)(ws + (moba ? WS_MQKV : WS_DQKV)) + (size_t)j * 3 * D * D;
            pg8::Gemm g{XN, W, D, 0, (unsigned)((size_t)MTOK * D * 2 - 16), (unsigned*)F.ctl + 2048, (size_t)3 * D * D * 2}; pg8::StaticOrder S; S.init(MTOK, 3 * D, F.G, bx);
            pg8::EpiQKV E{Qb, D, D, (size_t)(WS_K - WS_Q) / 2, C2, (unsigned*)F.ctl + 2048};
            pg8::gemm_phase<pg8::EpiQKV, pg8::StaticOrder>(F.lds + RING_OFF, XSLOT_OFF, g, S, E);
        }
        SEAM(pb + 0);
        if (moba) { if (PHEN(2) && IN(pb + 1)) { PTRS(); kmean_phase(F, Kb, kmean); } SEAM(pb + 1); }
        if (IN(pb + 2)) {
            PTRS();
            att::Args A; A.Q = Qb; A.K = Kb; A.V = Vb; A.O = XN; A.kmean = kmean; A.subln = args.in[6] + (size_t)j * 128; A.lam_full = 0.f; A.out_scale = 1.f;
            const int PPC = (1024 + F.G - 1) / F.G;
            if (PHEN(3) && !moba) {
                const float* lam = args.in[5] + (size_t)j * 256; const int lane = F.lane;
                const GAS float* lamg = (const GAS float*)lam; const float s1 = wave_sum(lamg[lane] * lamg[64 + lane]), s2 = wave_sum(lamg[128 + lane] * lamg[192 + lane]);
                const float lam_init = 0.8f - 0.6f * __expf(-0.3f * (float)L);
                A.lam_full = __expf(s1) - __expf(s2) + lam_init; A.out_scale = 1.0f - lam_init;
                for (int i = 0; i < PPC; ++i) { const int P = F.vcu * PPC + i; if (P >= 1024) break; const int bh = P >> 4, pr = P & 15;
                    att::attn_unit<0>(F.lds + RING_OFF, A, bh >> 3, bh & 7, pr);
                    att::attn_unit<0>(F.lds + RING_OFF, A, bh >> 3, bh & 7, 31 - pr); }
            } else if (PHEN(4) && moba) {
                for (int i = 0; i < PPC; ++i) { const int P = F.vcu * PPC + i; if (P >= 1024) break; const int bh = P >> 3, pr = P & 7;
                    att::attn_unit<1>(F.lds + RING_OFF, A, bh >> 4, bh & 15, pr);
                    att::attn_unit<1>(F.lds + RING_OFF, A, bh >> 4, bh & 15, 15 - pr); }
            }
            asm volatile("s_waitcnt vmcnt(0) lgkmcnt(0)\n\ts_barrier" ::: "memory");
        }
        SEAM(pb + 2);
        if (PHEN(5) && IN(pb + 3)) {
            PTRS();
            const bf16* W = (const bf16*)(ws + (moba ? WS_MWO : WS_DWO)) + (size_t)j * D * D;
            pg8::Gemm g{XN, W, D, 0, (unsigned)((size_t)MTOK * D * 2 - 16), (unsigned*)F.ctl + 2048, (size_t)D * D * 2}; pg8::StaticOrder S; S.init(MTOK, D, F.G, bx);
            pg8::EpiRes E{L == 0 ? x : h, h, D};
            pg8::gemm_phase<pg8::EpiRes, pg8::StaticOrder>(F.lds + RING_OFF, XSLOT_OFF, g, S, E);
        }
        SEAM(pb + 3);
        if (PHEN(6) && IN(pb + 4)) {
            PTRS();
            if (!moba) {
                norm_phase<0>(F, h, nullptr, nullptr, norm_ffn + (size_t)L * D, XN, nullptr, noR);
                if (L == 2) { unsigned rot = 0u;
                    for (int e = 0; e < NE; ++e) {
                        convert_matrix(F, args.in[13] + (size_t)(NE + e) * D * DE, D, DE, MGU + (size_t)e * 2 * DE * D, 1, rot);
                        convert_matrix(F, args.in[14] + (size_t)(NE + e) * D * DE, D, DE, MGU + (size_t)e * 2 * DE * D, 2, rot);
                        convert_matrix(F, args.in[15] + (size_t)(NE + e) * DE * D, DE, D, MD + (size_t)e * D * DE, 0, rot);
                    } }
            } else {
                const RouterArgs R{args.in[12] + (size_t)j * D * NE, F.ctl + CW_CNT + 64 * NE * j, ltok, lw};
                norm_phase<2>(F, h, nullptr, nullptr, norm_ffn + (size_t)L * D, XN, nullptr, R);
            }
        }
        SEAM(pb + 4);
        if (IN(pb + 5)) {
            PTRS();
            if (PHEN(7) && !moba) {
                pg8::Gemm g{XN, (const bf16*)(ws + WS_FGU) + (size_t)j * 2 * DFF * D, D, 0, (unsigned)((size_t)MTOK * D * 2 - 16), (unsigned*)F.ctl + 2048, (size_t)2 * DFF * D * 2}; pg8::StaticOrder S; S.init(MTOK, 2 * DFF, F.G, bx);
                pg8::EpiSwiGLU E{ACT, DFF};
                pg8::gemm_phase<pg8::EpiSwiGLU, pg8::StaticOrder>(F.lds + RING_OFF, XSLOT_OFF, g, S, E);
            } else if (PHEN(8) && moba) {
                pg8::Gemm g{XN, MGU, D, (size_t)2 * DE * D, (unsigned)((size_t)MTOK * D * 2 - 16), (unsigned*)F.ctl + 2048, (size_t)NE * 2 * DE * D * 2}; pg8::MoeOrder S; S.init((const unsigned*)(F.ctl + CW_CNT + 64 * NE * j), ltok, true, 2 * DE, F.G, bx);
                pg8::EpiSwiGLU E{ACT, DE};
                pg8::gemm_phase<pg8::EpiSwiGLU, pg8::MoeOrder>(F.lds + RING_OFF, XSLOT_OFF, g, S, E);
            }
        }
        SEAM(pb + 5);
        if (IN(pb + 6)) {
            PTRS();
            if (PHEN(9) && !moba) {
                pg8::Gemm g{ACT, (const bf16*)(ws + WS_FD) + (size_t)j * D * DFF, DFF, 0, (unsigned)((size_t)MTOK * DFF * 2 - 16), (unsigned*)F.ctl + 2048, (size_t)D * DFF * 2}; pg8::StaticOrder S; S.init(MTOK, D, F.G, bx);
                pg8::EpiRes E{h, h, D};
                pg8::gemm_phase<pg8::EpiRes, pg8::StaticOrder>(F.lds + RING_OFF, XSLOT_OFF, g, S, E);
            } else if (PHEN(10) && moba) {
                pg8::Gemm g{ACT, MD, DE, (size_t)D * DE, (unsigned)((size_t)MOE_TILES_MAX * 256 * DE * 2 - 16), (unsigned*)F.ctl + 2048, (size_t)NE * D * DE * 2}; pg8::MoeOrder S; S.init((const unsigned*)(F.ctl + CW_CNT + 64 * NE * j), ltok, false, D, F.G, bx);
                pg8::EpiMoeDown E; E.h = h; E.y1 = XN; E.list_tok = ltok; E.list_w = lw;
#pragma unroll
                for (int e = 0; e < NE; ++e) E.cnt[e] = S.cnt[e];
                pg8::gemm_phase<pg8::EpiMoeDown, pg8::MoeOrder>(F.lds + RING_OFF, XSLOT_OFF, g, S, E);
            }
        }
        SEAM(pb + 6);
        if (PHEN(11) && IN(pb + 7)) {
            PTRS();
            if (L == 3) norm_phase<3>(F, h, nullptr, XN, args.in[16], nullptr, h, noR);
            else if (moba) norm_phase<1>(F, h, h, XN, norm_mix + (size_t)(L + 1) * D, XN, nullptr, noR);
            else norm_phase<0>(F, h, nullptr, nullptr, norm_mix + (size_t)(L + 1) * D, XN, nullptr, noR);
        }
        if (L != NLAYER - 1) SEAM(pb + 7);
#undef F
    }
#undef IN
#undef SEAM
#undef PTRS
#undef OPQ
}


#if MK_DEBUG
__global__ void dbg_probe(const void* buf, size_t n, int is_bf16, int idx, float thresh, unsigned* dbg) {
    size_t i = blockIdx.x * (size_t)blockDim.x + threadIdx.x, stride = (size_t)gridDim.x * blockDim.x; bool bad = false;
    for (size_t k = i; k < n; k += stride) { float v = is_bf16 ? __uint_as_float(((unsigned)((const unsigned short*)buf)[k]) << 16) : ((const float*)buf)[k]; if (!(fabsf(v) <= thresh)) bad = true; }
    if (bad) atomicMax(dbg, (unsigned)(1000 - idx));
}
__global__ void dbg_cnt(const unsigned* cntw, int idx, unsigned* dbg) {
    if (threadIdx.x == 0 && blockIdx.x == 0) { unsigned s = 0; for (int e = 0; e < NE; ++e) s += cntw[64 * e]; if (s != 2u * MTOK) atomicMax(dbg, (unsigned)(1000 - idx)); }
}

__device__ __forceinline__ float dbg_bf(unsigned short v) { return __uint_as_float(((unsigned)v) << 16); }
__device__ __forceinline__ unsigned dbg_hash(unsigned x) { x ^= x >> 16; x *= 0x7feb352dU; x ^= x >> 15; x *= 0x846ca68bU; x ^= x >> 16; return x; }
__global__ void dbg_gemm_check(const unsigned short* A, int lda, const unsigned short* Bt, int K, const unsigned short* out, int ldo, int M, int N, float scale, int idx, unsigned* dbg) {
    const unsigned s = blockIdx.x * blockDim.x + threadIdx.x; const int row = (int)(dbg_hash(2 * s + 1) % (unsigned)M), col = (int)(dbg_hash(2 * s + 2) % (unsigned)N);
    float acc = 0.f; for (int k = 0; k < K; ++k) acc += dbg_bf(A[(size_t)row * lda + k]) * dbg_bf(Bt[(size_t)col * K + k]);
    acc *= scale; const float got = dbg_bf(out[(size_t)row * ldo + col]);
    if (!(fabsf(got - acc) <= 0.03f + 0.02f * fabsf(acc))) { atomicMax(dbg, (unsigned)(1000 - idx)); atomicAdd(dbg + 64 + idx, 1u); }
}
__global__ void dbg_conv_check(const float* W, int K, int N, const unsigned short* WT, int il, int idx, unsigned* dbg) {
    const unsigned s = blockIdx.x * blockDim.x + threadIdx.x; const int k = (int)(dbg_hash(2 * s + 1) % (unsigned)K), n = (int)(dbg_hash(2 * s + 2) % (unsigned)N);
    const int dr = il == 0 ? n : (n / 128) * 256 + (il - 1) * 128 + (n % 128);
    const float w = W[(size_t)k * N + n], g = dbg_bf(WT[(size_t)dr * K + k]);
    if (!(fabsf(g - w) <= 0.01f * fabsf(w) + 1e-6f)) atomicMax(dbg, (unsigned)(1000 - idx));
}
__global__ void dbg_norm_check(const float* src, const float* gain, const unsigned short* xn, int idx, unsigned* dbg) {
    const unsigned s = blockIdx.x * blockDim.x + threadIdx.x; const int row = (int)(dbg_hash(s + 77) % (unsigned)MTOK);
    float ss = 0.f; for (int c = 0; c < D; ++c) { const float v = src[(size_t)row * D + c]; ss += v * v; }
    const float rstd = 1.f / sqrtf(ss / D + 1e-6f); bool bad = false;
    for (int c = 0; c < D; ++c) { const float r = src[(size_t)row * D + c] * rstd * gain[c], g = dbg_bf(xn[(size_t)row * D + c]); if (!(fabsf(g - r) <= 0.02f + 0.01f * fabsf(r))) bad = true; }
    if (bad) atomicMax(dbg, (unsigned)(1000 - idx));
}
__global__ void dbg_naive_gemm(const unsigned short* A, const unsigned short* Bt, unsigned short* out, int M, int N, int K) {
    const size_t i = blockIdx.x * (size_t)blockDim.x + threadIdx.x; if (i >= (size_t)M * N) return; const int row = (int)(i / N), col = (int)(i % N);
    float acc = 0.f; for (int k = 0; k < K; ++k) acc += dbg_bf(A[(size_t)row * K + k]) * dbg_bf(Bt[(size_t)col * K + k]);
    out[(size_t)row * N + col] = (unsigned short)f2bf(acc);
}
__global__ void dbg_find_col(const unsigned short* out, const unsigned short* ref, int M, int N, unsigned* hist) {
    const unsigned s = blockIdx.x * blockDim.x + threadIdx.x; const int row = (int)(dbg_hash(2 * s + 1) % (unsigned)M), col = (int)(dbg_hash(2 * s + 2) % (unsigned)N);
    const unsigned short v = out[(size_t)row * N + col]; int found = -1;
#if MK_FIND_PATTERN
    if (v == 0x3C3C) atomicAdd(hist + N, 1u); else atomicAdd(hist + 5, 1u); return;
#endif
#if MK_FIND_ROWS
    for (int r = 0; r < M; ++r) if (ref[(size_t)r * N + col] == v) { found = r; break; }
    if (found < 0) atomicAdd(hist + N, 1u); else atomicAdd(hist + ((found - row) & (N - 1)), 1u);
#else
    for (int c = 0; c < N; ++c) if (ref[(size_t)row * N + c] == v) { found = c; break; }
    if (found < 0) atomicAdd(hist + N, 1u); else atomicAdd(hist + ((found - col) & (N - 1)), 1u);
#endif
}
__global__ void dbg_hist_code(const unsigned* hist, int N, unsigned* dbg) {
    if (threadIdx.x || blockIdx.x) return; unsigned best = 0, bi = 0; for (int i = 0; i < N; ++i) if (hist[i] > best) { best = hist[i]; bi = i; }
    dbg[32] = bi; dbg[33] = best; dbg[34] = hist[N];
}
__global__ void dbg_final(float* out, size_t n, const unsigned* dbg) {
    if (MK_HIST_SEL >= 10) { const float c3 = sqrtf((float)dbg[MK_HIST_SEL + 30]); size_t i3 = blockIdx.x * (size_t)blockDim.x + threadIdx.x, st3 = (size_t)gridDim.x * blockDim.x; for (size_t k3 = i3; k3 < n; k3 += st3) out[k3] = c3; return; }
    if (MK_HIST_SEL >= 0 && (dbg[33] || dbg[34])) { const float c2 = sqrtf((float)(MK_HIST_SEL == 0 ? dbg[32] : (MK_HIST_SEL == 1 ? dbg[33] * 100u / 4096u : dbg[34] * 100u / 4096u)) + 1.f); size_t i2 = blockIdx.x * (size_t)blockDim.x + threadIdx.x, st2 = (size_t)gridDim.x * blockDim.x; for (size_t k2 = i2; k2 < n; k2 += st2) out[k2] = c2; return; }
    const unsigned d = dbg[0]; if (d == 0u) return; const unsigned nf = dbg[64 + (1000u - d)]; const float c = sqrtf(nf ? (float)(200u * (1000u - d - 9u) + nf * 100u / 4096u) : (float)(1000u - d));
    size_t i = blockIdx.x * (size_t)blockDim.x + threadIdx.x, stride = (size_t)gridDim.x * blockDim.x;
    for (size_t k = i; k < n; k += stride) out[k] = c;
}
#endif

#ifndef MK_REPEAT
#define MK_REPEAT 1
#endif
#ifndef MK_FIND_ROWS
#define MK_FIND_ROWS 0
#endif
#ifndef MK_FIND_REGION
#define MK_FIND_REGION WS_K
#endif
#ifndef MK_HIST_SEL
#define MK_HIST_SEL 0
#endif
extern "C" void kernel_launch(void* const* d_in, const int* in_sizes, int n_in, void* d_out, int out_size, void* d_ws, size_t ws_size, hipStream_t stream) {
    static int grid = 0;
    if (grid == 0) {
        if (n_in != 17 || in_sizes[0] != MTOK * D || out_size != MTOK * D || ws_size < WS_END) {
            fprintf(stderr, "kernel_launch: built for 17 inputs, x/out of %d floats, >= %zu bytes of workspace; got n_in %d, in0 %d, out %d, ws %zu; nothing launched\n", MTOK * D, (size_t)WS_END, n_in, n_in > 0 ? in_sizes[0] : -1, out_size, ws_size);
            grid = -1; return; }
        int dev = 0, cus = 0, per_cu = 0;
        if (hipGetDevice(&dev) != hipSuccess || hipDeviceGetAttribute(&cus, hipDeviceAttributeMultiprocessorCount, dev) != hipSuccess) { fprintf(stderr, "kernel_launch: device query failed\n"); grid = -1; return; }
        if (hipFuncSetAttribute((const void*)trunk_fwd, hipFuncAttributeMaxDynamicSharedMemorySize, LDS_BYTES) != hipSuccess) { fprintf(stderr, "kernel_launch: hipFuncSetAttribute failed\n"); grid = -1; return; }
        if (hipOccupancyMaxActiveBlocksPerMultiprocessor(&per_cu, (const void*)trunk_fwd, NWAVES * 64, LDS_BYTES) != hipSuccess || per_cu < 1)
            fprintf(stderr, "kernel_launch: note: occupancy query reports %d workgroups per CU\n", per_cu);
        (void)hipGetLastError();
        grid = cus;
    }
    if (grid < 0) return;
    if (hipMemsetAsync((char*)d_ws + WS_CTL, 0, CTL_ZERO_BYTES, stream) != hipSuccess) { fprintf(stderr, "kernel_launch: memset failed\n"); return; }
    KArgs a{};
    for (int i = 0; i < 17; ++i) a.in[i] = (const float*)d_in[i];
    a.out = (float*)d_out; a.ws = (unsigned char*)d_ws;
#if MK_PER_PHASE
    for (int p = 0; p < NPHASE; ++p) {
        if (p >= 1) { const int L = (p - 1) / PH_PER_LAYER, k = (p - 1) % PH_PER_LAYER; if (k == 1 && !(L & 1)) continue; }
        a.ph_lo = p; a.ph_hi = p + 1;
#if MK_DEBUG
#endif
#if !defined(MK_SKIP_MAIN)
        for (int rep_ = 0; rep_ < (p == 1 ? MK_REPEAT : 1); ++rep_) hipLaunchKernelGGL(trunk_fwd, dim3(grid), dim3(NWAVES * 64), LDS_BYTES, stream, a);
#endif
#if MK_DEBUG
        {   unsigned char* ws = (unsigned char*)d_ws; unsigned* dbg = (unsigned*)(ws + WS_CTL) + 2048;
            const size_t MD_ = (size_t)MTOK * D;
#define PROBE(buf, n, isbf, idx, th) if ((idx) <= MK_PROBE_MAX) hipLaunchKernelGGL(dbg_probe, dim3(2048), dim3(256), 0, stream, (const void*)(buf), (size_t)(n), isbf, idx, th, dbg)
            if (p == 0) {
                hipLaunchKernelGGL(dbg_norm_check, dim3(4), dim3(64), 0, stream, (const float*)d_in[0], (const float*)d_in[1], (const unsigned short*)(ws + WS_XN), 4, dbg);
                hipLaunchKernelGGL(dbg_conv_check, dim3(16), dim3(256), 0, stream, (const float*)d_in[3], D, 3 * D, (const unsigned short*)(ws + WS_DQKV), 0, 5, dbg);
                hipLaunchKernelGGL(dbg_conv_check, dim3(16), dim3(256), 0, stream, (const float*)d_in[9], D, DFF, (const unsigned short*)(ws + WS_FGU), 1, 6, dbg);
                hipLaunchKernelGGL(dbg_conv_check, dim3(16), dim3(256), 0, stream, (const float*)d_in[10], D, DFF, (const unsigned short*)(ws + WS_FGU), 2, 7, dbg);
                hipLaunchKernelGGL(dbg_conv_check, dim3(16), dim3(256), 0, stream, (const float*)d_in[11], DFF, D, (const unsigned short*)(ws + WS_FD), 0, 8, dbg);
                hipLaunchKernelGGL(dbg_conv_check, dim3(16), dim3(256), 0, stream, (const float*)d_in[15] + (size_t)3 * DE * D, DE, D, (const unsigned short*)(ws + WS_MD) + (size_t)3 * D * DE, 0, 9, dbg);
            }
            if (p == 1) {
                const float C2h = 0.125f * 1.4426950408889634f;
                hipLaunchKernelGGL(dbg_gemm_check, dim3(16), dim3(256), 0, stream, (const unsigned short*)(ws + WS_XN), D, (const unsigned short*)(ws + WS_DQKV), D, (const unsigned short*)(ws + WS_Q), D, MTOK, D, C2h, 10, dbg);
                hipLaunchKernelGGL(dbg_gemm_check, dim3(16), dim3(256), 0, stream, (const unsigned short*)(ws + WS_XN), D, (const unsigned short*)(ws + WS_DQKV) + (size_t)D * D, D, (const unsigned short*)(ws + WS_K), D, MTOK, D, 1.f, 11, dbg);

                hipLaunchKernelGGL(dbg_gemm_check, dim3(16), dim3(256), 0, stream, (const unsigned short*)(ws + WS_XN), D, (const unsigned short*)(ws + WS_DQKV) + (size_t)2 * D * D, D, (const unsigned short*)(ws + WS_V), D, MTOK, D, 1.f, 12, dbg);
            }
            if (0) { PROBE(ws + WS_XN, MD_, 1, 1, 10.f); PROBE(ws + WS_DQKV, (WS_MGU - WS_DQKV) / 2, 1, 2, 1.f); PROBE(ws + WS_MGU, (WS_XN - WS_MGU) / 2, 1, 3, 1.f); }
            if (p >= 1) { const int L = (p - 1) / PH_PER_LAYER, k = (p - 1) % PH_PER_LAYER; const int b = 20 + 10 * L;
                if (k == 0) PROBE(ws + WS_Q, 3 * MD_, 1, b + 0, 50.f);
                if (k == 1) PROBE(ws + WS_KMEAN, 8 * 16 * 16 * 64, 0, b + 1, 5.f);
                if (k == 2) PROBE(ws + WS_XN, MD_, 1, b + 2, 50.f);
                if (k == 3) PROBE(d_out, MD_, 0, b + 3, 300.f);
                if (k == 4) { PROBE(ws + WS_XN, MD_, 1, b + 4, 20.f); if ((L & 1) && (b + 9) <= MK_PROBE_MAX) hipLaunchKernelGGL(dbg_cnt, dim3(1), dim3(64), 0, stream, (const unsigned*)(ws + WS_CTL) + CW_CNT + 64 * NE * (L >> 1), b + 9, dbg); }
                if (k == 5) PROBE(ws + WS_ACT, (L & 1) ? (size_t)256 * 256 * DE : (size_t)MTOK * DFF, 1, b + 5, 2000.f);
                if (k == 6) { PROBE(d_out, MD_, 0, b + 6, 1000.f); if (L & 1) PROBE(ws + WS_XN, MD_, 1, b + 7, 1000.f); }
                if (k == 7 && L != 3) { PROBE(ws + WS_XN, MD_, 1, b + 8, 20.f); PROBE(d_out, MD_, 0, b + 8, 1000.f); }
            }
#undef PROBE
        }
#endif
    }
#if MK_DEBUG
    hipLaunchKernelGGL(dbg_final, dim3(2048), dim3(256), 0, stream, (float*)d_out, (size_t)MTOK * D, (const unsigned*)((unsigned char*)d_ws + WS_CTL) + 2048);
#endif
#else
    a.ph_lo = 0; a.ph_hi = NPHASE;
    hipLaunchKernelGGL(trunk_fwd, dim3(grid), dim3(NWAVES * 64), LDS_BYTES, stream, a);
#endif
    const hipError_t le = hipPeekAtLastError();
    if (le != hipSuccess) fprintf(stderr, "kernel_launch: launch failed: %s\n", hipGetErrorName(le));
}
```

```cpp
#define MK_DEBUG 0
#define MK_PER_PHASE 0
#include <hip/hip_runtime.h>
#include <cstdio>
#include <cstdint>

#ifndef MK_DEBUG
#define MK_DEBUG 1
#endif
#ifndef MK_KDEBUG
#define MK_KDEBUG 0
#endif
#define LAS __attribute__((address_space(3)))
#define GAS __attribute__((address_space(1)))

constexpr int BATCH = 8, SEQ = 4096, MTOK = BATCH * SEQ, D = 1024, DFF = 2816, DE = 3584, NE = 8;
constexpr int MOE_TILES_MAX = 272;
constexpr int LIST_CAP = MTOK;

namespace pg8 {
#define PG8_LAS __attribute__((address_space(3)))
typedef unsigned short bf16_t;
typedef short bf16x8 __attribute__((ext_vector_type(8)));
typedef float f32x4 __attribute__((ext_vector_type(4)));
typedef unsigned u32x4 __attribute__((ext_vector_type(4)));
constexpr int BM = 256, BK = 64, HALF = 128, HTB = HALF * BK * 2  , STAGE_BYTES = 8 * HTB, NXCD = 8, WGM = 8;

__host__ __device__ __forceinline__ int lds_byte(int r, int c) { const int st = (r >> 4) * 2 + (c >> 5), rr = r & 15, cc = c & 31, ob = rr * 64 + cc * 2; return st * 1024 + (ob ^ (((ob >> 9) & 1) << 5)); }
__host__ __device__ __forceinline__ void stage_rc(int b, int& R, int& C) { const int st = b / 1024, sb = b % 1024, swz = sb ^ (((sb >> 9) & 1) << 5); R = (st >> 1) * 16 + swz / 64; C = (st & 1) * 32 + (swz % 64) / 2; }
__host__ __device__ __forceinline__ int perm32(int rho) { const int n = rho >> 4, i = rho & 15; return 8 * (i >> 2) + 4 * n + (i & 3); }

struct Unit { int pm, pn, e, r0; };
struct Gemm { const bf16_t* A; const bf16_t* Bt; int K; size_t bstride; unsigned amax; unsigned* dbg; size_t bbytes; };

__device__ __forceinline__ void tile_of(int L, int nM, int nN, int& pm, int& pn) {
    const int nwg = nM * nN; int wgid = L; { const int q = nwg / NXCD, r = nwg % NXCD, xcd = wgid % NXCD, off = wgid / NXCD; wgid = (xcd < r ? xcd * (q + 1) : r * (q + 1) + (xcd - r) * q) + off; }
    const int nig = WGM * nN, gid = wgid / nig, fm = gid * WGM, gsz = (nM - fm) < WGM ? (nM - fm) : WGM;
    pm = fm + ((wgid % nig) % gsz); pn = (wgid % nig) / gsz;
}
struct StaticOrder {
    int nM, nN, nwg, G, c;
    __device__ __forceinline__ void init(int M, int N, int G_, int c_) { nM = M / BM; nN = N / BM; nwg = nM * nN; G = G_; c = c_; }
    __device__ __forceinline__ bool next(int i, Unit& u) const {
        const long L = (long)i * G + c; if (L >= nwg) return false;
        tile_of((int)L, nM, nN, u.pm, u.pn); u.e = 0; u.r0 = 0; return true;
    }
    __device__ __forceinline__ unsigned arow(const Unit& u, int lr) const { return (unsigned)(u.pm * BM + lr); }
};
struct MoeOrder {
    int nM, nN, nwg, G, c; int tstart[NE + 1]; int cnt[NE]; const unsigned* list_tok; bool gather;
    __device__ __forceinline__ void init(const unsigned* cntw, const unsigned* list_tok_, bool gather_, int N, int G_, int c_) {
        int acc = 0;
#pragma unroll
        for (int e = 0; e < NE; ++e) { const int ce = (int)__builtin_amdgcn_readfirstlane((int)__hip_atomic_load((const GAS unsigned*)cntw + 64 * e, __ATOMIC_RELAXED, __HIP_MEMORY_SCOPE_AGENT)); cnt[e] = ce; tstart[e] = acc; acc += (ce + BM - 1) / BM; }
        tstart[NE] = acc; nM = acc; nN = N / BM; nwg = nM * nN; G = G_; c = c_; list_tok = list_tok_; gather = gather_;
    }
    __device__ __forceinline__ bool next(int i, Unit& u) const {
        const long L = (long)i * G + c; if (L >= nwg) return false;
        tile_of((int)L, nM, nN, u.pm, u.pn); int e = 0;
#pragma unroll
        for (int k = 1; k < NE; ++k) e += (u.pm >= tstart[k]) ? 1 : 0;
        u.e = e; int ts = 0;
#pragma unroll
        for (int k = 0; k < NE; ++k) ts = (k == e) ? tstart[k] : ts;
        u.r0 = (u.pm - ts) * BM; return true;
    }
    __device__ __forceinline__ int count_of(int e) const { int cv = 0;
#pragma unroll
        for (int k = 0; k < NE; ++k) cv = (k == e) ? cnt[k] : cv;
        return cv; }
    __device__ __forceinline__ unsigned arow(const Unit& u, int lr) const {
        if (!gather) return (unsigned)(u.pm * BM + lr);
        const int l = u.r0 + lr; const int cv = count_of(u.e);
        unsigned t = 0u; if (l < cv) t = __hip_atomic_load((const GAS unsigned*)list_tok + (size_t)u.e * LIST_CAP + l, __ATOMIC_RELAXED, __HIP_MEMORY_SCOPE_AGENT) & 0xFFFFFu;
        return t;
    }
};

__device__ __forceinline__ unsigned cvt_pk_bf16(float lo, float hi) { unsigned r; asm volatile("v_cvt_pk_bf16_f32 %0, %1, %2" : "=v"(r) : "v"(lo), "v"(hi)); return r; }

struct EpiQKV {
    static constexpr bool PERM = true;
    bf16_t* O; int ldc; int split_cols; size_t split_stride; float scale0; unsigned* dbg;
    __device__ __forceinline__ void operator()(const f32x4 (&acc)[2][2][4][2], const Unit& u, int wr, int wc, int fr, int fq) const {
        const int row0 = u.pm * BM + wr * 64 + fr; int colt = u.pn * BM; bf16_t* base = O;
        float sc = 1.f; { const int t = colt / split_cols; base += (size_t)t * split_stride; colt -= t * split_cols; if (t == 0) sc = scale0; }
        const int col0 = colt + wc * 32 + 8 * fq;
#pragma unroll
        for (int ai = 0; ai < 2; ++ai)
#pragma unroll
            for (int m = 0; m < 4; ++m) { bf16_t* rowp = base + (size_t)(row0 + ai * HALF + m * 16) * ldc + col0;
#pragma unroll
                for (int bj = 0; bj < 2; ++bj) { f32x4 v0 = acc[ai][bj][m][0] * sc, v1 = acc[ai][bj][m][1] * sc;
                    u32x4 w; w.x = cvt_pk_bf16(v0[0], v0[1]); w.y = cvt_pk_bf16(v0[2], v0[3]); w.z = cvt_pk_bf16(v1[0], v1[1]); w.w = cvt_pk_bf16(v1[2], v1[3]);
#if defined(EPI_VARIANT) && EPI_VARIANT == 1
                    { u32x4 cz = {0x3f803f80u, 0x3f803f80u, 0x3f803f80u, 0x3f803f80u}; asm volatile("" :: "v"(w)); *(GAS u32x4*)(rowp + bj * HALF) = cz; }
#elif defined(EPI_VARIANT) && EPI_VARIANT == 2
                    { asm volatile("" :: "v"(w)); asm volatile("" :: "v"(rowp)); }
#elif MK_KDEBUG
                    { const size_t eo = (size_t)((rowp + bj * HALF) - O); if (eo + 8 <= (size_t)3 * 33554432) *(GAS u32x4*)(rowp + bj * HALF) = w; else atomicMax(dbg, 1000u - 3u); }
#else
                    *(GAS u32x4*)(rowp + bj * HALF) = w;
#endif
                    } }
    }
};
struct EpiSwiGLU {
    static constexpr bool PERM = true;
    bf16_t* O; int ldc;
    __device__ __forceinline__ void operator()(const f32x4 (&acc)[2][2][4][2], const Unit& u, int wr, int wc, int fr, int fq) const {
        const int row0 = u.pm * BM + wr * 64 + fr; const int col0 = u.pn * HALF + wc * 32 + 8 * fq;
#pragma unroll
        for (int ai = 0; ai < 2; ++ai)
#pragma unroll
            for (int m = 0; m < 4; ++m) { bf16_t* rowp = O + (size_t)(row0 + ai * HALF + m * 16) * ldc + col0; float o[8];
#pragma unroll
                for (int n = 0; n < 2; ++n)
#pragma unroll
                    for (int j = 0; j < 4; ++j) { const float g = acc[ai][0][m][n][j], up = acc[ai][1][m][n][j];
                        const float s = __builtin_amdgcn_rcpf(1.0f + __builtin_amdgcn_exp2f(-1.4426950408889634f * g)); o[n * 4 + j] = g * s * up; }
                u32x4 w; w.x = cvt_pk_bf16(o[0], o[1]); w.y = cvt_pk_bf16(o[2], o[3]); w.z = cvt_pk_bf16(o[4], o[5]); w.w = cvt_pk_bf16(o[6], o[7]);
                *(GAS u32x4*)rowp = w; }
    }
};
struct EpiRes {
    static constexpr bool PERM = false;
    const float* res; float* out; int ldc;
    __device__ __forceinline__ void operator()(const f32x4 (&acc)[2][2][4][2], const Unit& u, int wr, int wc, int fr, int fq) const {
        const int row0 = u.pm * BM + wr * 64 + fr; const int col0 = u.pn * BM + wc * 32 + 4 * fq;
#pragma unroll
        for (int ai = 0; ai < 2; ++ai)
#pragma unroll
            for (int m = 0; m < 4; ++m) { const size_t off = (size_t)(row0 + ai * HALF + m * 16) * ldc + col0;
#pragma unroll
                for (int bj = 0; bj < 2; ++bj)
#pragma unroll
                    for (int n = 0; n < 2; ++n) { const f32x4 r = *(const GAS f32x4*)(res + off + bj * HALF + n * 16); *(GAS f32x4*)(out + off + bj * HALF + n * 16) = r + acc[ai][bj][m][n]; } }
    }
};
struct EpiMoeDown {
    static constexpr bool PERM = false;
    float* h; bf16_t* y1; const unsigned* list_tok; const float* list_w; int cnt[NE];
    __device__ __forceinline__ void operator()(const f32x4 (&acc)[2][2][4][2], const Unit& u, int wr, int wc, int fr, int fq) const {
        int cv = 0;
#pragma unroll
        for (int k = 0; k < NE; ++k) cv = (k == u.e) ? cnt[k] : cv;
        const int col0 = u.pn * BM + wc * 32 + 4 * fq;
#pragma unroll
        for (int ai = 0; ai < 2; ++ai)
#pragma unroll
            for (int m = 0; m < 4; ++m) { const int l = u.r0 + ai * HALF + wr * 64 + m * 16 + fr;
                if (l < cv) {
                    const unsigned ent = __hip_atomic_load((const GAS unsigned*)list_tok + (size_t)u.e * LIST_CAP + l, __ATOMIC_RELAXED, __HIP_MEMORY_SCOPE_AGENT);
                    const float w = __uint_as_float(__hip_atomic_load((const GAS unsigned*)list_w + (size_t)u.e * LIST_CAP + l, __ATOMIC_RELAXED, __HIP_MEMORY_SCOPE_AGENT));
                    const size_t off = (size_t)(ent & 0xFFFFFu) * D + col0;
                    if ((ent >> 20) == 0u) {
#pragma unroll
                        for (int bj = 0; bj < 2; ++bj)
#pragma unroll
                            for (int n = 0; n < 2; ++n) { GAS float* p = (GAS float*)(h + off + bj * HALF + n * 16); const f32x4 r = *(const GAS f32x4*)p; *(GAS f32x4*)p = r + acc[ai][bj][m][n] * w; }
                    } else {
#pragma unroll
                        for (int bj = 0; bj < 2; ++bj)
#pragma unroll
                            for (int n = 0; n < 2; ++n) { const f32x4 v = acc[ai][bj][m][n] * w; unsigned long long pk = (unsigned long long)cvt_pk_bf16(v[0], v[1]) | ((unsigned long long)cvt_pk_bf16(v[2], v[3]) << 32);
                                *(GAS unsigned long long*)(y1 + off + bj * HALF + n * 16) = pk; }
                    }
                } }
    }
};

template <class Epi, class Sched>
__device__ __forceinline__ void gemm_phase(PG8_LAS unsigned char* lds, int xoff, const Gemm g, const Sched& S, const Epi& E) {
    int tid_ = threadIdx.x;
#if !defined(NO_OPQ_T)
    asm volatile("" : "+v"(tid_));
#endif
    const int tid = tid_, wid = __builtin_amdgcn_readfirstlane(tid >> 6), lane = tid & 63, wr = wid >> 2, wc = wid & 3, fr = lane & 15, fq = lane >> 4;
    const int K = g.K, nt = K / BK;
    unsigned voffB[2];
#pragma unroll
    for (int i = 0; i < 2; ++i) { int R, C; stage_rc(tid * 16 + i * 8192, R, C); const int Rb = Epi::PERM ? ((R & ~31) + perm32(R & 31)) : R;
        voffB[i] = (unsigned)(Rb * K + C) * 2u; }
    const size_t kstep = (size_t)(BK * 2);
    const size_t hstep = (size_t)HALF * K * 2;
    const size_t tstep = 2 * hstep;
    const unsigned ldsw = (unsigned)wid * 1024u;
    const int aoff = lds_byte(wr * 64 + fr, fq * 8), boff = lds_byte(wc * 32 + fr, fq * 8);
#define PG8_SA(b, h) (((b) * 2 + (h)) * HTB)
#define PG8_SB(b, h) ((4 + (b) * 2 + (h)) * HTB)
#define PG8_STAGE(bufoff, gbase, v0, v1) do { \
        __builtin_amdgcn_global_load_lds((const GAS unsigned*)((const char*)(gbase) + (v0)), (PG8_LAS unsigned*)(lds + (bufoff) + ldsw), 16, 0, 0); \
        __builtin_amdgcn_global_load_lds((const GAS unsigned*)((const char*)(gbase) + (v1)), (PG8_LAS unsigned*)(lds + (bufoff) + ldsw + 8192), 16, 0, 0); } while (0)
#define PG8_STAGEB(bufoff, gbase) PG8_STAGE(bufoff, gbase, voffB[0], voffB[1])
#define PG8_LDA(dst, b, h) do { _Pragma("unroll") for (int m = 0; m < 4; ++m) _Pragma("unroll") for (int k = 0; k < 2; ++k) dst[m][k] = *(const PG8_LAS bf16x8*)(lds + PG8_SA(b, h) + aoff + m * 2048 + k * 1024); } while (0)
#define PG8_LDB(dst, b, h) do { _Pragma("unroll") for (int n = 0; n < 2; ++n) _Pragma("unroll") for (int k = 0; k < 2; ++k) dst[n][k] = *(const PG8_LAS bf16x8*)(lds + PG8_SB(b, h) + boff + n * 2048 + k * 1024); } while (0)
#define PG8_MMA(ai, bj, At, Bt) do { __builtin_amdgcn_s_setprio(1); _Pragma("unroll") for (int m = 0; m < 4; ++m) _Pragma("unroll") for (int n = 0; n < 2; ++n) _Pragma("unroll") for (int k = 0; k < 2; ++k) \
        acc[ai][bj][m][n] = __builtin_amdgcn_mfma_f32_16x16x32_bf16(Bt[n][k], At[m][k], acc[ai][bj][m][n], 0, 0, 0); __builtin_amdgcn_s_setprio(0); } while (0)
#define PG8_WAIT_V(n) asm volatile("s_waitcnt vmcnt(" #n ")" ::: "memory")
#define PG8_WAIT_L(n) asm volatile("s_waitcnt lgkmcnt(" #n ")" ::: "memory")
#define PG8_BAR __builtin_amdgcn_s_barrier()
#define PG8_SCHED __builtin_amdgcn_sched_barrier(0)
#define PG8_AOFFS(U, o00, o01, o10, o11) do { int R0_, C0_, R1_, C1_; stage_rc(tid * 16, R0_, C0_); stage_rc(tid * 16 + 8192, R1_, C1_);     \
        o00 = (S.arow(U, R0_) * (unsigned)K + (unsigned)C0_) * 2u; o01 = (S.arow(U, R1_) * (unsigned)K + (unsigned)C1_) * 2u; \
        o10 = (S.arow(U, HALF + R0_) * (unsigned)K + (unsigned)C0_) * 2u; o11 = (S.arow(U, HALF + R1_) * (unsigned)K + (unsigned)C1_) * 2u; } while (0)
    Unit cur, nxt; int ui = 0;
#if MK_KDEBUG
    if (blockIdx.x == 5 && threadIdx.x == 0) atomicOr(g.dbg + 43, 2u);
#endif
    if (!S.next(0, cur)) return;
#if MK_KDEBUG
    if (blockIdx.x == 5 && threadIdx.x == 0) atomicOr(g.dbg + 43, 4u);
    { Unit t1_; if (blockIdx.x == 5 && threadIdx.x == 0 && S.next(1, t1_)) { g.dbg[40] = 1u + (unsigned)t1_.pm * 16u + (unsigned)t1_.pn; g.dbg[41] = 1u + (unsigned)cur.pm * 16u + (unsigned)cur.pn; g.dbg[42] = 1u + (unsigned)gridDim.x; atomicOr(g.dbg + 43, 8u); } }
#endif
#if defined(GDBG_NOKLOOP)
    { f32x4 accz[2][2][4][2];
      for (int ui_ = 0; S.next(ui_, cur); ++ui_) {
#pragma unroll
        for (int a = 0; a < 2; ++a)
#pragma unroll
          for (int b = 0; b < 2; ++b)
#pragma unroll
            for (int m = 0; m < 4; ++m)
#pragma unroll
              for (int n = 0; n < 2; ++n) { f32x4 r4;
                for (int j = 0; j < 4; ++j) { const int row = cur.pm * 256 + a * 128 + wr * 64 + m * 16 + fr;
                  const int col = cur.pn * 256 + b * 128 + wc * 32 + (Epi::PERM ? 8 * fq + 4 * n + j : 16 * n + 4 * fq + j);
                  const bf16_t* ar = g.A + (size_t)row * K; const bf16_t* br = g.Bt + (size_t)cur.e * g.bstride + (size_t)col * K; float s_ = 0.f;
                  for (int k = 0; k < K; ++k) s_ += __uint_as_float(((unsigned)ar[k]) << 16) * __uint_as_float(((unsigned)br[k]) << 16);
                  r4[j] = s_; }
                accz[a][b][m][n] = r4; }
        E(accz, cur, wr, wc, fr, fq); }
      return; }
#endif
    f32x4 acc[2][2][4][2];
#pragma unroll
    for (int a = 0; a < 2; ++a)
#pragma unroll
        for (int b = 0; b < 2; ++b)
#pragma unroll
            for (int m = 0; m < 4; ++m)
#pragma unroll
                for (int n = 0; n < 2; ++n) acc[a][b][m][n] = (f32x4){0.f, 0.f, 0.f, 0.f};
    bf16x8 At[4][2], B0[2][2], B1[2][2];
    unsigned c00, c01, c10, c11;
    PG8_LAS u32x4* const xslot = (PG8_LAS u32x4*)(lds + xoff) + tid;
    PG8_AOFFS(cur, c00, c01, c10, c11);
    const char* const gA = (const char*)g.A;
    const char* cB = (const char*)g.Bt + (size_t)cur.e * g.bstride * 2 + (size_t)cur.pn * tstep;
    PG8_STAGEB(PG8_SB(0, 0), cB); PG8_STAGEB(PG8_SB(0, 1), cB + hstep); PG8_STAGE(PG8_SA(0, 0), gA, c00, c01); PG8_STAGE(PG8_SA(0, 1), gA, c10, c11);
    if (wr == 1) PG8_BAR;
    PG8_WAIT_V(2); PG8_BAR;
    PG8_STAGEB(PG8_SB(1, 0), cB + kstep); PG8_STAGE(PG8_SA(1, 0), gA + kstep, c00, c01); PG8_STAGEB(PG8_SB(1, 1), cB + hstep + kstep);
    PG8_WAIT_V(6); PG8_BAR;
    for (;;) {
        const bool has_next = S.next(ui + 1, nxt);
        const char* nB_ = has_next ? (const char*)g.Bt + (size_t)nxt.e * g.bstride * 2 + (size_t)nxt.pn * tstep : cB;
        const char* nB = nB_;
        if (has_next) { unsigned n00, n01, n10, n11; PG8_AOFFS(nxt, n00, n01, n10, n11); *xslot = (u32x4){n00, n01, n10, n11}; }
#if MK_KDEBUG
        { const char* lo_ = (const char*)g.Bt; const char* hi_ = lo_ + g.bbytes - tstep;
          if (cB < lo_ || cB > hi_ || nB < lo_ || nB > hi_) { atomicMax(g.dbg, 1000u - 92u); cB = lo_; nB = lo_; }
          if (voffB[0] > (unsigned)tstep || voffB[1] > (unsigned)tstep) { atomicMax(g.dbg, 1000u - 93u); voffB[0] = 0u; voffB[1] = 0u; }
          const unsigned mx_ = g.amax; if (c00 > mx_ || c01 > mx_ || c10 > mx_ || c11 > mx_) { atomicMax(g.dbg, 1000u - 94u); c00 = 0u; c01 = 0u; c10 = 0u; c11 = 0u; } }
#endif
        for (int t = 0; t < nt; t += 2) {
            const bool last = (t == nt - 2);
            const char* a1 = gA + (size_t)(t + 1) * kstep;
            const char* a2 = last ? gA : gA + (size_t)(t + 2) * kstep; const char* b2 = last ? nB : cB + (size_t)(t + 2) * kstep;
            const char* a3 = a2 + kstep; const char* b3 = b2 + kstep;
            PG8_LDB(B0, 0, 0); PG8_LDB(B1, 0, 1); PG8_SCHED; PG8_LDA(At, 0, 0); PG8_STAGE(PG8_SA(1, 1), a1, c10, c11);
            if (last && has_next) { const u32x4 nx = *xslot; c00 = nx.x; c01 = nx.y; c10 = nx.z; c11 = nx.w; }
#if MK_KDEBUG
            { const unsigned mx_ = g.amax; if (c00 > mx_ || c01 > mx_ || c10 > mx_ || c11 > mx_) { atomicMax(g.dbg, 1000u - 90u); c00 = c00 > mx_ ? 0u : c00; c01 = c01 > mx_ ? 0u : c01; c10 = c10 > mx_ ? 0u : c10; c11 = c11 > mx_ ? 0u : c11; } }
#endif
            PG8_WAIT_V(8); PG8_WAIT_L(0); PG8_BAR; PG8_MMA(0, 0, At, B0); PG8_MMA(0, 1, At, B1); PG8_BAR; PG8_SCHED;
            PG8_LDA(At, 0, 1); PG8_STAGEB(PG8_SB(0, 0), b2); PG8_STAGEB(PG8_SB(0, 1), b2 + hstep); PG8_STAGE(PG8_SA(0, 0), a2, c00, c01);
            PG8_WAIT_V(8); PG8_WAIT_L(0); PG8_BAR; PG8_MMA(1, 0, At, B0); PG8_MMA(1, 1, At, B1); PG8_BAR; PG8_SCHED;
            PG8_LDB(B0, 1, 0); PG8_LDB(B1, 1, 1); PG8_SCHED; PG8_LDA(At, 1, 0); PG8_STAGE(PG8_SA(0, 1), a2, c10, c11);
            PG8_WAIT_V(8); PG8_WAIT_L(0); PG8_BAR; PG8_MMA(0, 0, At, B0); PG8_MMA(0, 1, At, B1); PG8_BAR; PG8_SCHED;
            PG8_LDA(At, 1, 1); PG8_STAGEB(PG8_SB(1, 0), b3); PG8_STAGEB(PG8_SB(1, 1), b3 + hstep); PG8_STAGE(PG8_SA(1, 0), a3, c00, c01);
            PG8_WAIT_V(8); PG8_WAIT_L(0); PG8_BAR; PG8_MMA(1, 0, At, B0); PG8_MMA(1, 1, At, B1); PG8_BAR; PG8_SCHED;
        }
        if (wr == 0) PG8_BAR;
#if !defined(GDBG_NOEPI)
#if defined(EPI_DRAIN)
        asm volatile("s_waitcnt vmcnt(0)" ::: "memory");
#endif
        E(acc, cur, wr, wc, fr, fq);
#if defined(EPI_DRAIN_AFTER)
        asm volatile("s_waitcnt vmcnt(0)" ::: "memory");
#endif
#else
        asm volatile("" :: "v"(acc[0][0][0][0]), "v"(acc[1][1][3][1]));
#endif
        if (!has_next) break;
#pragma unroll
        for (int a = 0; a < 2; ++a)
#pragma unroll
            for (int b = 0; b < 2; ++b)
#pragma unroll
                for (int m = 0; m < 4; ++m)
#pragma unroll
                    for (int n = 0; n < 2; ++n) acc[a][b][m][n] = (f32x4){0.f, 0.f, 0.f, 0.f};
        cur = nxt; cB = nB; ++ui;
        if (wr == 1) PG8_BAR;
    }
    PG8_WAIT_V(0);
    PG8_BAR;
#undef PG8_SA
#undef PG8_SB
#undef PG8_STAGE
#undef PG8_STAGEB
#undef PG8_LDA
#undef PG8_LDB
#undef PG8_MMA
#undef PG8_WAIT_V
#undef PG8_WAIT_L
#undef PG8_BAR
#undef PG8_SCHED
#undef PG8_AOFFS
}
}

namespace att {
typedef unsigned short bf16_t;
typedef short bf16x8 __attribute__((ext_vector_type(8)));
typedef short s16x4 __attribute__((ext_vector_type(4)));
typedef float f32x16 __attribute__((ext_vector_type(16)));
typedef float f32x4 __attribute__((ext_vector_type(4)));
typedef unsigned u32x4 __attribute__((ext_vector_type(4)));
constexpr int PITCH = 1024;
constexpr float LOG2E = 1.4426950408889634f;
__device__ __forceinline__ int crow(int r, int hi) { return (r & 3) + 8 * (r >> 2) + 4 * hi; }
typedef float f32x2_t __attribute__((ext_vector_type(2))); typedef __bf16 bf16x2_t __attribute__((ext_vector_type(2)));
__device__ __forceinline__ unsigned cvtpk(float lo, float hi) { f32x2_t v = {lo, hi}; bf16x2_t b = __builtin_convertvector(v, bf16x2_t); return __builtin_bit_cast(unsigned, b); }
__device__ __forceinline__ float bf2f(short s) { return __uint_as_float(((unsigned)(unsigned short)s) << 16); }
typedef short v4i16_t __attribute__((ext_vector_type(4)));
__device__ __forceinline__ s16x4 vtr(const LAS unsigned char* p) { return __builtin_bit_cast(s16x4, __builtin_amdgcn_ds_read_tr16_b64_v4i16((LAS v4i16_t*)p)); }
__device__ __forceinline__ float halves_max(float m) { auto rr = __builtin_amdgcn_permlane32_swap(__float_as_uint(m), __float_as_uint(m), false, false); return fmaxf(__uint_as_float(rr[0]), __uint_as_float(rr[1])); }
__device__ __forceinline__ float halves_sum(float m) { auto rr = __builtin_amdgcn_permlane32_swap(__float_as_uint(m), __float_as_uint(m), false, false); return __uint_as_float(rr[0]) + __uint_as_float(rr[1]); }
#define ATT_BAR() asm volatile("s_waitcnt vmcnt(0) lgkmcnt(0)\n\ts_barrier" ::: "memory")

struct Args { const bf16_t* Q; const bf16_t* K; const bf16_t* V; bf16_t* O; const float* kmean; const float* subln; float lam_full; float out_scale; };

template <int MODE>
__device__ __forceinline__ void attn_unit(LAS unsigned char* lds, const Args& A, int b, int h, int qblk) {
    constexpr int DVB = MODE == 0 ? 4 : 2;
    constexpr int NCH = MODE == 0 ? 16 : 8;
    constexpr int KBY = NCH * 1024, VBY = DVB * 4096, SLOT = KBY + VBY;
    constexpr int QR = MODE == 0 ? 128 : 256;
    constexpr int PPW = MODE == 0 ? 2 : 1;
    int tid_ = threadIdx.x; asm volatile("" : "+v"(tid_));
    const int tid = tid_, lane = tid & 63, r32 = lane & 31, hi = lane >> 5;
    const int wid = __builtin_amdgcn_readfirstlane(tid >> 6);
    const int comp = MODE == 0 ? (wid >> 2) : 0, wq = MODE == 0 ? (wid & 3) : wid;
    const int q0 = qblk * QR; const long rowbase = (long)b * SEQ;
    const int hcol = MODE == 0 ? h * 128 : h * 64;
    const int qrel0 = wq * 32;
    const float slope2 = __builtin_amdgcn_exp2f(MODE == 0 ? -(float)(h + 1) : -0.5f * (float)(h + 1)) * LOG2E;
    const int NT = MODE == 0 ? 2 * qblk + 2 : 4 + 4 * qblk;
    LAS float* wsf = (LAS float*)(lds + 65536) + wid * 64;
    const bf16_t* Kb = A.K + rowbase * PITCH + hcol;
    const bf16_t* Vb = A.V + rowbase * PITCH + hcol;
    bf16x8 qr[4];
    { const bf16_t* Qw = A.Q + (rowbase + q0 + qrel0 + r32) * PITCH + hcol + comp * 64 + hi * 8;
#pragma unroll
      for (int d0 = 0; d0 < 4; ++d0) qr[d0] = *(const GAS bf16x8*)(Qw + d0 * 16); }
    ATT_BAR();
    unsigned sel = 0u;
    if constexpr (MODE == 1) {
        LAS float* km = (LAS float*)(lds + 67584);
        for (int i = tid; i < 1024; i += 512) km[i] = ((const GAS float*)A.kmean)[(size_t)(b * 16 + h) * 1024 + i];
        ATT_BAR();
        float g[16];
#pragma unroll
        for (int n = 0; n < 16; ++n) { float s = 0.f;
            if (n < qblk) {
#pragma unroll
                for (int d0 = 0; d0 < 4; ++d0) { const f32x4 ka = *(const LAS f32x4*)(km + n * 64 + d0 * 16 + hi * 8), kb2 = *(const LAS f32x4*)(km + n * 64 + d0 * 16 + hi * 8 + 4);
                    s += bf2f(qr[d0][0]) * ka[0] + bf2f(qr[d0][1]) * ka[1] + bf2f(qr[d0][2]) * ka[2] + bf2f(qr[d0][3]) * ka[3]
                       + bf2f(qr[d0][4]) * kb2[0] + bf2f(qr[d0][5]) * kb2[1] + bf2f(qr[d0][6]) * kb2[2] + bf2f(qr[d0][7]) * kb2[3]; }
                s = halves_sum(s); }
            g[n] = s; }
        const int nsel = qblk < 3 ? qblk : 3;
#pragma unroll
        for (int k = 0; k < 3; ++k) if (k < nsel) { float best = -INFINITY; int bi = 0; bool found = false;
#pragma unroll
            for (int n = 0; n < 16; ++n) if (n < qblk) { const bool free_ = ((sel >> n) & 1u) == 0u; if (free_ && (!found || g[n] > best)) { best = g[n]; bi = n; found = true; } }
            sel |= 1u << bi; }
    }
#define ATT_KBASE(t) (MODE == 0 ? 64 * (t) : ((t) < 4 ? q0 + 64 * (t) : 64 * ((t) - 4)))
#define ATT_ISSUE(t, slot) do { const int kb_ = ATT_KBASE(t); \
        _Pragma("unroll") for (int i_ = 0; i_ < PPW; ++i_) { const int p_ = wid + 8 * i_; \
            __builtin_amdgcn_global_load_lds((const GAS unsigned*)(Kb + (size_t)(kb_ + lane) * PITCH + p_ * 8), (LAS unsigned*)(lds + (slot) * SLOT + p_ * 1024), 16, 0, 0); \
            __builtin_amdgcn_global_load_lds((const GAS unsigned*)(Vb + (size_t)(kb_ + 16 * (p_ & 3) + (lane >> 2)) * PITCH + (p_ >> 2) * 32 + (lane & 3) * 8), (LAS unsigned*)(lds + (slot) * SLOT + KBY + p_ * 1024), 16, 0, 0); } } while (0)
    float m = -INFINITY, l = 0.f; f32x16 o[DVB];
#pragma unroll
    for (int d0 = 0; d0 < DVB; ++d0) o[d0] = f32x16{};
    ATT_ISSUE(0, 0);
    for (int t = 0; t < NT; ++t) {
        ATT_BAR();
        if (t + 1 < NT) ATT_ISSUE(t + 1, (t + 1) & 1);
        const int kbase = ATT_KBASE(t), krel = kbase - q0;
        const bool diag = kbase >= q0;
        bool skip = diag && (krel > qrel0 + 31);
        const bool needmask = diag && (krel + 63 > qrel0);
        bool selbit = true;
        if constexpr (MODE == 1) { if (t >= 4) { selbit = ((sel >> ((t - 4) >> 2)) & 1u) != 0u; if (!__any(selbit)) skip = true; } }
        if (!skip) {
            const LAS unsigned char* Ks = lds + (t & 1) * SLOT + comp * 8192 + hi * 1024 + r32 * 16;
            const LAS unsigned char* Vs = lds + (t & 1) * SLOT + KBY + ((lane >> 4) & 1) * 32 + (lane & 3) * 8 + (4 * hi + ((lane & 15) >> 2)) * 64;
            f32x16 p0 = f32x16{}, p1 = f32x16{};
#pragma unroll
            for (int d0 = 0; d0 < 4; ++d0) { const bf16x8 b0 = *(const LAS bf16x8*)(Ks + d0 * 2048), b1 = *(const LAS bf16x8*)(Ks + d0 * 2048 + 512);
                p0 = __builtin_amdgcn_mfma_f32_32x32x16_bf16(b0, qr[d0], p0, 0, 0, 0); p1 = __builtin_amdgcn_mfma_f32_32x32x16_bf16(b1, qr[d0], p1, 0, 0, 0); }
            const float hb = slope2 * (float)(krel + 4 * hi);
#pragma unroll
            for (int r = 0; r < 16; ++r) { const float bb = hb + slope2 * (float)((r & 3) + 8 * (r >> 2)); p0[r] += bb; p1[r] += bb + 32.0f * slope2; }
            if (needmask) { const int qrel = qrel0 + r32;
#pragma unroll
                for (int r = 0; r < 16; ++r) { const int kv = krel + crow(r, hi); if (kv > qrel) p0[r] = -INFINITY; if (kv + 32 > qrel) p1[r] = -INFINITY; } }
            if constexpr (MODE == 1) { if (!selbit) {
#pragma unroll
                for (int r = 0; r < 16; ++r) { p0[r] = -INFINITY; p1[r] = -INFINITY; } } }
            float rm = fmaxf(p0[0], p1[0]);
#pragma unroll
            for (int r = 1; r < 16; ++r) rm = fmaxf(rm, fmaxf(p0[r], p1[r]));
            rm = halves_max(rm);
            const bool grow = rm > m;
            if (__any(grow)) {
                const float mnew = fmaxf(m, rm); const float alpha = grow ? __builtin_amdgcn_exp2f(m - mnew) : 1.0f;
                l *= alpha; m = mnew;
                if (hi == 0) wsf[r32] = alpha;
                asm volatile("s_waitcnt lgkmcnt(0)" ::: "memory");
#pragma unroll
                for (int gq = 0; gq < 4; ++gq) { const f32x4 f = *(const LAS f32x4*)(wsf + 8 * gq + 4 * hi);
#pragma unroll
                    for (int d0 = 0; d0 < DVB; ++d0) { o[d0][4 * gq + 0] *= f[0]; o[d0][4 * gq + 1] *= f[1]; o[d0][4 * gq + 2] *= f[2]; o[d0][4 * gq + 3] *= f[3]; } }
            }
            float sacc = 0.f;
#pragma unroll
            for (int r = 0; r < 16; ++r) { p0[r] = __builtin_amdgcn_exp2f(p0[r] - m); p1[r] = __builtin_amdgcn_exp2f(p1[r] - m); sacc += p0[r] + p1[r]; }
            l += sacc;
            u32x4 pw[4];
            pw[0] = (u32x4){cvtpk(p0[0], p0[1]), cvtpk(p0[2], p0[3]), cvtpk(p0[4], p0[5]), cvtpk(p0[6], p0[7])};
            pw[1] = (u32x4){cvtpk(p0[8], p0[9]), cvtpk(p0[10], p0[11]), cvtpk(p0[12], p0[13]), cvtpk(p0[14], p0[15])};
            pw[2] = (u32x4){cvtpk(p1[0], p1[1]), cvtpk(p1[2], p1[3]), cvtpk(p1[4], p1[5]), cvtpk(p1[6], p1[7])};
            pw[3] = (u32x4){cvtpk(p1[8], p1[9]), cvtpk(p1[10], p1[11]), cvtpk(p1[12], p1[13]), cvtpk(p1[14], p1[15])};
#pragma unroll
            for (int d0 = 0; d0 < DVB; ++d0)
#pragma unroll
                for (int ks = 0; ks < 4; ++ks) { const s16x4 vlo = vtr(Vs + d0 * 4096 + ks * 1024), vhi = vtr(Vs + d0 * 4096 + ks * 1024 + 512);
                    const bf16x8 vf = (bf16x8){vlo[0], vlo[1], vlo[2], vlo[3], vhi[0], vhi[1], vhi[2], vhi[3]};
                    o[d0] = __builtin_amdgcn_mfma_f32_32x32x16_bf16(__builtin_bit_cast(bf16x8, pw[ks]), vf, o[d0], 0, 0, 0); }
        }
    }
    l = halves_sum(l);
    if (hi == 0) wsf[32 + r32] = l;
    asm volatile("s_waitcnt lgkmcnt(0)" ::: "memory");
    float rli[16];
#pragma unroll
    for (int gq = 0; gq < 4; ++gq) { const f32x4 f = *(const LAS f32x4*)(wsf + 32 + 8 * gq + 4 * hi); rli[4 * gq + 0] = 1.0f / f[0]; rli[4 * gq + 1] = 1.0f / f[1]; rli[4 * gq + 2] = 1.0f / f[2]; rli[4 * gq + 3] = 1.0f / f[3]; }
    if constexpr (MODE == 1) {
        GAS bf16_t* Ow = (GAS bf16_t*)(A.O + (rowbase + q0 + qrel0) * PITCH + hcol);
#pragma unroll
        for (int r = 0; r < 16; ++r)
#pragma unroll
            for (int d0 = 0; d0 < DVB; ++d0) Ow[(size_t)crow(r, hi) * PITCH + d0 * 32 + r32] = (bf16_t)(cvtpk(o[d0][r] * rli[r], 0.f) & 0xFFFFu);
    } else {
        ATT_BAR();
        LAS float* X = (LAS float*)lds + wq * 4096;
        if (comp == 1) {
#pragma unroll
            for (int d0 = 0; d0 < DVB; ++d0)
#pragma unroll
                for (int r = 0; r < 16; ++r) X[(d0 * 16 + r) * 64 + lane] = o[d0][r] * rli[r];
        }
        ATT_BAR();
        if (comp == 0) {
            float sg[DVB];
#pragma unroll
            for (int d0 = 0; d0 < DVB; ++d0) sg[d0] = ((const GAS float*)A.subln)[d0 * 32 + r32] * A.out_scale;
            GAS bf16_t* Ow = (GAS bf16_t*)(A.O + (rowbase + q0 + qrel0) * PITCH + hcol);
#pragma unroll
            for (int r = 0; r < 16; ++r) { float dv[DVB]; float ss = 0.f;
#pragma unroll
                for (int d0 = 0; d0 < DVB; ++d0) { dv[d0] = o[d0][r] * rli[r] - A.lam_full * X[(d0 * 16 + r) * 64 + lane]; ss += dv[d0] * dv[d0]; }
                ss += __shfl_xor(ss, 1); ss += __shfl_xor(ss, 2); ss += __shfl_xor(ss, 4); ss += __shfl_xor(ss, 8); ss += __shfl_xor(ss, 16);
                const float rs = 1.0f / sqrtf(ss * (1.0f / 128.0f) + 1e-5f);
#pragma unroll
                for (int d0 = 0; d0 < DVB; ++d0) Ow[(size_t)crow(r, hi) * PITCH + d0 * 32 + r32] = (bf16_t)(cvtpk(dv[d0] * rs * sg[d0], 0.f) & 0xFFFFu); }
        }
    }
#undef ATT_KBASE
#undef ATT_ISSUE
}
#undef ATT_BAR
}

constexpr int NWAVES = 8;
#ifndef MK_PER_PHASE
#define MK_PER_PHASE 1
#endif
#ifndef MK_DEBUG
#define MK_DEBUG 1
#endif
constexpr int NLAYER = 4, PH_PER_LAYER = 8, NPHASE = 1 + NLAYER * PH_PER_LAYER;

constexpr size_t MiB = 1u << 20;
constexpr size_t WS_CTL = 0, CTL_ZERO_BYTES = 1 * MiB;
constexpr size_t WS_KMEAN = 1 * MiB;
constexpr size_t WS_LTOK = 2 * MiB, WS_LW = 3 * MiB;
constexpr size_t WS_DQKV = 5 * MiB;
constexpr size_t WS_DWO = WS_DQKV + 12 * MiB;
constexpr size_t WS_MQKV = WS_DWO + 4 * MiB;
constexpr size_t WS_MWO = WS_MQKV + 12 * MiB;
constexpr size_t WS_FGU = WS_MWO + 4 * MiB;
constexpr size_t WS_FD = WS_FGU + 22 * MiB;
constexpr size_t WS_MGU = WS_FD + 11 * MiB;
constexpr size_t WS_MD = WS_MGU + 112 * MiB;
constexpr size_t WS_XN = WS_MD + 56 * MiB;
constexpr size_t WS_Q = WS_XN + 64 * MiB, WS_K = WS_Q + 64 * MiB, WS_V = WS_K + 64 * MiB;
constexpr size_t WS_ACT = WS_Q;
constexpr size_t WS_END = WS_ACT + (size_t)MOE_TILES_MAX * 256 * DE * 2;
static_assert(WS_XN == 238 * MiB && WS_END == 778 * MiB, "d_ws map");
constexpr int CW_BAR = 4096;
constexpr int CW_CNT = 8192;

constexpr int RING_OFF = 0, RING_BYTES = 131072;
constexpr int LDSCTL_OFF = RING_BYTES, MISC_OFF = LDSCTL_OFF + 320;
constexpr int XSLOT_OFF = MISC_OFF + 128;
constexpr int LDS_BYTES = 147456;

typedef unsigned short bf16;
typedef unsigned v4u __attribute__((ext_vector_type(4)));
typedef float f32x4 __attribute__((ext_vector_type(4)));
typedef GAS unsigned gu32;
#define RLX_AGENT __ATOMIC_RELAXED, __HIP_MEMORY_SCOPE_AGENT
#define LDS_WAIT() asm volatile("s_waitcnt lgkmcnt(0)" ::: "memory")
#define VM_WAIT() asm volatile("s_waitcnt vmcnt(0)" ::: "memory")
__device__ __forceinline__ unsigned f2bf(float f) { unsigned u = __builtin_bit_cast(unsigned, f); return (u + 0x7fffu + ((u >> 16) & 1u)) >> 16; }
__device__ __forceinline__ unsigned pk2(float lo, float hi) { return f2bf(lo) | (f2bf(hi) << 16); }
__device__ __forceinline__ float bflo(unsigned w) { return __uint_as_float(w << 16); }
__device__ __forceinline__ float bfhi(unsigned w) { return __uint_as_float(w & 0xFFFF0000u); }
static_assert(XSLOT_OFF % 16 == 0 && XSLOT_OFF + 8192 <= LDS_BYTES, "LDS map");
#define XB_TMO      128
#define XB_XCNT(j)  (256  + 64 * (j))
#define XB_XSUB(j)  (1280 + 64 * (j))
#define XB_XGEN(j)  (2304 + 64 * (j))
#define XB_TOP      3328
#define XB_TOPGEN   3392
#define XCD_BAR_WORDS 3456
#define XB_SPIN_CAP (1u << 18)

__device__ __forceinline__ unsigned xb_ld(unsigned* p)              { return __hip_atomic_load(p, __ATOMIC_RELAXED, __HIP_MEMORY_SCOPE_AGENT); }
__device__ __forceinline__ unsigned xb_add(unsigned* p, unsigned v) { return __hip_atomic_fetch_add(p, v, __ATOMIC_RELAXED, __HIP_MEMORY_SCOPE_AGENT); }
__device__ __forceinline__ unsigned xb_xcc_id() { return (unsigned)__builtin_amdgcn_s_getreg((3 << 11) | 20) & 0xFu; }
#define XB_SPIN(cond, bar) do { unsigned _sp = 0; while (cond) { __builtin_amdgcn_s_sleep(1); \
    if ((++_sp & 255u) == 0u) { if (xb_ld(&(bar)[XB_TMO])) break; if (_sp > XB_SPIN_CAP) { atomicAdd(&(bar)[XB_TMO], 1u); break; } } } } while (0)

struct XcdBarrier {
    unsigned* bar; unsigned x;
    volatile LAS unsigned* st;
};

__device__ __forceinline__ XcdBarrier xcd_barrier_post(unsigned* bar, volatile LAS unsigned* st) {
    XcdBarrier b; b.bar = bar; b.x = xb_xcc_id(); b.st = st;
    if (threadIdx.x == 0) (void)xb_add(&bar[XB_XCNT(b.x)], 1u);
    return b;
}
__device__ __forceinline__ void xcd_barrier_complete(unsigned* bar, unsigned x, unsigned& nloc, unsigned& nx) {
    const unsigned G = gridDim.x * gridDim.y * gridDim.z;
    unsigned sum, cnt, mine, sp = 0u;
    for (;;) {
        sum = 0u; cnt = 0u; mine = 0u;
#pragma unroll
        for (unsigned j = 0; j < 16; ++j) { const unsigned c = xb_ld(&bar[XB_XCNT(j)]); sum += c; cnt += (c > 0u) ? 1u : 0u; mine = (j == x) ? c : mine; }
        if (sum == G) break;
        __builtin_amdgcn_s_sleep(1);
        if ((++sp & 255u) == 0u) { if (xb_ld(&bar[XB_TMO])) break; if (sp > XB_SPIN_CAP) { atomicAdd(&bar[XB_TMO], 1u); break; } }
    }
    nloc = mine > 0u ? mine : 1u; nx = cnt > 0u ? cnt : 1u;
}

__device__ __forceinline__ void xcd_barrier(const XcdBarrier& b) {
    asm volatile("s_waitcnt vmcnt(0)" ::: "memory");
    __syncthreads();
    if (threadIdx.x == 0) {
        unsigned* bar = b.bar;
        __builtin_amdgcn_s_waitcnt(0);
        unsigned nloc = b.st[0], nx = b.st[1];
        if (nloc == 0u) { xcd_barrier_complete(bar, b.x, nloc, nx); b.st[0] = nloc; b.st[1] = nx; }
        const unsigned old = xb_add(&bar[XB_XSUB(b.x)], 1u);
        const unsigned gen = old / nloc;
        if (old + 1u == (gen + 1u) * nloc) {
            __builtin_amdgcn_fence(__ATOMIC_RELEASE, "agent");
            asm volatile("s_waitcnt vmcnt(0)" ::: "memory");
            const unsigned og = xb_add(&bar[XB_TOP], 1u);
            const unsigned tg = og / nx;
            if (og + 1u == (tg + 1u) * nx) xb_add(&bar[XB_TOPGEN], 1u);
            else XB_SPIN(xb_ld(&bar[XB_TOPGEN]) == tg, bar);
            __builtin_amdgcn_fence(__ATOMIC_ACQUIRE, "agent");
            xb_add(&bar[XB_XGEN(b.x)], 1u);
            asm volatile("s_waitcnt vmcnt(0)" ::: "memory");
        } else {
            XB_SPIN(xb_ld(&bar[XB_XGEN(b.x)]) == gen, bar);
            __builtin_amdgcn_fence(__ATOMIC_ACQUIRE, "agent");
            asm volatile("s_waitcnt vmcnt(0)" ::: "memory");
        }
    }
    __syncthreads();
}

struct Frame {
    LAS unsigned char* lds;
    volatile LAS unsigned* MISC;
    gu32* ctl;
    int tid, lane, wave;
    int vcu, G;
};
__device__ __forceinline__ float wave_sum(float v) {
#pragma unroll
    for (int o = 1; o < 64; o <<= 1) v += __shfl_xor(v, o);
    return v;
}
__device__ __forceinline__ void transpose_item(const float* W, int K, int N, bf16* WT, int k0, int n0, int drow0, LAS float* scr, int lane) {
#pragma unroll 8
    for (int i = 0; i < 32; ++i) { const int kk = 2 * i + (lane >> 5); scr[kk * 33 + (lane & 31)] = ((const GAS float*)W)[(size_t)(k0 + kk) * N + n0 + (lane & 31)]; }
    LDS_WAIT(); asm volatile("" ::: "memory");
    const int c = lane & 7;
#pragma unroll
    for (int j = 0; j < 4; ++j) { const int n = (lane >> 3) + 8 * j; const LAS float* s = scr + (8 * c) * 33 + n;
        v4u o; o.x = pk2(s[0 * 33], s[1 * 33]); o.y = pk2(s[2 * 33], s[3 * 33]); o.z = pk2(s[4 * 33], s[5 * 33]); o.w = pk2(s[6 * 33], s[7 * 33]);
        *(GAS v4u*)(WT + (size_t)(drow0 + n) * K + k0 + 8 * c) = o; }
    LDS_WAIT(); asm volatile("" ::: "memory");
}
__device__ __forceinline__ void convert_matrix(Frame& F, const float* W, int K, int N, bf16* WT, int il, unsigned& rot) {
    LAS float* scr = (LAS float*)(F.lds + RING_OFF + F.wave * 16384);
    const unsigned gw = (unsigned)(F.vcu * NWAVES + F.wave), NGW = (unsigned)(F.G * NWAVES);
    const int nblk = N / 32, nitems = (K / 64) * nblk; int lane_ = F.lane; asm volatile("" : "+v"(lane_));
    for (int it = (int)((gw + NGW - rot % NGW) % NGW); it < nitems; it += (int)NGW) {
        const int kb = it / nblk, nb = it % nblk, n0 = 32 * nb;
        const int drow0 = il == 0 ? n0 : (n0 / 128) * 256 + (il - 1) * 128 + (n0 % 128);
        transpose_item(W, K, N, WT, 64 * kb, n0, drow0, scr, lane_);
    }
    rot = (rot + (unsigned)nitems) % NGW;
}

struct RouterArgs { const float* router; gu32* cnt; unsigned* ltok; float* lw; };
template <int MODE>
__device__ __forceinline__ void norm_phase(Frame& F, const float* src, float* hout, const bf16* y1, const float* gain, bf16* xn, float* fout, const RouterArgs& R) {
    int lane_ = F.lane; asm volatile("" : "+v"(lane_));
    const int gw = F.vcu * NWAVES + F.wave, NGW = F.G * NWAVES, lane = lane_;
    f32x4 gv[4];
#pragma unroll
    for (int j = 0; j < 4; ++j) gv[j] = *(const GAS f32x4*)(gain + 256 * j + 4 * lane);
    LAS float* RL = (LAS float*)(F.lds + RING_OFF);
    if constexpr (MODE == 2) {
        for (int i = F.tid; i < 8192; i += NWAVES * 64) RL[(i & 7) * 1024 + (i >> 3)] = ((const GAS float*)R.router)[i];
        LDS_WAIT(); __syncthreads();
    }
    const int nrows_w = gw < MTOK ? (MTOK - gw + NGW - 1) / NGW : 0;
    for (int cb = 0; cb < nrows_w; cb += 64) {
        int my_t = 0, my_e0 = 0, my_e1 = 0; float my_w0 = 0.f, my_w1 = 0.f; bool valid = false;
        const int cn = (nrows_w - cb) < 64 ? (nrows_w - cb) : 64;
        for (int i = 0; i < cn; ++i) {
            const int row = gw + (cb + i) * NGW;
            const GAS f32x4* xr = (const GAS f32x4*)(src + (size_t)row * D) + lane;
            f32x4 v[4]; float s = 0.f;
#pragma unroll
            for (int j = 0; j < 4; ++j) v[j] = xr[64 * j];
            if constexpr (MODE == 1 || MODE == 3) {
                const GAS unsigned long long* yr = (const GAS unsigned long long*)(y1 + (size_t)row * D) + lane;
#pragma unroll
                for (int j = 0; j < 4; ++j) { const unsigned long long w = yr[64 * j]; const unsigned lo = (unsigned)w, hi = (unsigned)(w >> 32);
                    v[j].x += bflo(lo); v[j].y += bfhi(lo); v[j].z += bflo(hi); v[j].w += bfhi(hi); }
            }
#pragma unroll
            for (int j = 0; j < 4; ++j) s += (v[j].x * v[j].x + v[j].y * v[j].y) + (v[j].z * v[j].z + v[j].w * v[j].w);
            if constexpr (MODE == 1) { GAS f32x4* hr = (GAS f32x4*)(hout + (size_t)row * D) + lane;
#pragma unroll
                for (int j = 0; j < 4; ++j) hr[64 * j] = v[j]; }
            const float rstd = 1.f / sqrtf(wave_sum(s) * (1.f / D) + 1e-6f);
#pragma unroll
            for (int j = 0; j < 4; ++j) v[j] = v[j] * rstd * gv[j];
            if constexpr (MODE == 3) { GAS f32x4* orow = (GAS f32x4*)(fout + (size_t)row * D) + lane;
#pragma unroll
                for (int j = 0; j < 4; ++j) orow[64 * j] = v[j];
            } else {
                GAS unsigned long long* o8 = (GAS unsigned long long*)(xn + (size_t)row * D) + lane;
#pragma unroll
                for (int j = 0; j < 4; ++j) o8[64 * j] = (unsigned long long)pk2(v[j].x, v[j].y) | ((unsigned long long)pk2(v[j].z, v[j].w) << 32);
            }
            if constexpr (MODE == 2) {
                float lg[NE];
#pragma unroll
                for (int e = 0; e < NE; ++e) { float a = 0.f;
#pragma unroll
                    for (int j = 0; j < 4; ++j) { const f32x4 rr = *(const LAS f32x4*)(RL + e * 1024 + 256 * j + 4 * lane); a += (v[j].x * rr.x + v[j].y * rr.y) + (v[j].z * rr.z + v[j].w * rr.w); }
                    lg[e] = wave_sum(a); }
                int e0 = 0; float v0 = lg[0];
#pragma unroll
                for (int e = 1; e < NE; ++e) if (lg[e] > v0) { v0 = lg[e]; e0 = e; }
                int e1 = -1; float v1 = 0.f;
#pragma unroll
                for (int e = 0; e < NE; ++e) if (e != e0 && (e1 < 0 || lg[e] > v1)) { v1 = lg[e]; e1 = e; }
                const float w0 = 1.f / (1.f + __expf(v1 - v0));
                if (lane == i) { my_t = row; my_e0 = e0; my_e1 = e1; my_w0 = w0; my_w1 = 1.f - w0; valid = true; }
            }
        }
        if constexpr (MODE == 2) {
            unsigned myc = 0u;
#pragma unroll
            for (int e = 0; e < NE; ++e) { const unsigned long long b0 = __ballot(valid && my_e0 == e), b1 = __ballot(valid && my_e1 == e);
                const unsigned c = (unsigned)(__popcll(b0) + __popcll(b1)); if (lane == e) myc = c; }
            unsigned basev = 0u;
            if (lane < NE) basev = __hip_atomic_fetch_add(R.cnt + 64 * lane, myc, RLX_AGENT);
            const unsigned long long lt = (1ull << lane) - 1ull;
            unsigned pos0 = 0u, pos1 = 0u;
#pragma unroll
            for (int e = 0; e < NE; ++e) { const unsigned long long b0 = __ballot(valid && my_e0 == e), b1 = __ballot(valid && my_e1 == e);
                const unsigned be = (unsigned)__shfl((int)basev, e);
                if (my_e0 == e) pos0 = be + (unsigned)__popcll(b0 & lt);
                if (my_e1 == e) pos1 = be + (unsigned)__popcll(b0) + (unsigned)__popcll(b1 & lt); }
            if (valid) {
                ((GAS unsigned*)R.ltok)[(size_t)my_e0 * LIST_CAP + pos0] = (unsigned)my_t;             ((GAS float*)R.lw)[(size_t)my_e0 * LIST_CAP + pos0] = my_w0;
                ((GAS unsigned*)R.ltok)[(size_t)my_e1 * LIST_CAP + pos1] = (unsigned)my_t | (1u << 20); ((GAS float*)R.lw)[(size_t)my_e1 * LIST_CAP + pos1] = my_w1;
            }
        }
    }
    if constexpr (MODE == 2) { LDS_WAIT(); __syncthreads(); }
}

__device__ __forceinline__ void kmean_phase(Frame& F, const bf16* Kt, float* kmean) {
    int lane_ = F.lane; asm volatile("" : "+v"(lane_));
    const int gw = F.vcu * NWAVES + F.wave, NGW = F.G * NWAVES, lane = lane_;
    for (int task = gw; task < BATCH * 16 * 8; task += NGW) {
        const int c8 = task & 7, n = (task >> 3) & 15, b = task >> 7;
        const GAS unsigned* p = (const GAS unsigned*)(Kt + ((size_t)b * SEQ + 256 * n) * D + c8 * 128) + lane;
        float a0 = 0.f, a1 = 0.f;
#pragma unroll 8
        for (int r = 0; r < 256; ++r) { const unsigned w = p[(size_t)r * (D / 2)]; a0 += bflo(w); a1 += bfhi(w); }
        const int col = c8 * 128 + 2 * lane, hh = col >> 6, d = col & 63;
        GAS float* o = (GAS float*)(kmean + ((size_t)(b * 16 + hh) * 16 + n) * 64 + d);
        o[0] = a0 * (1.f / 256.f); o[1] = a1 * (1.f / 256.f);
    }
}

struct KArgs { const float* in[17]; float* out; unsigned char* ws; int ph_lo, ph_hi; };
__global__ void __launch_bounds__(NWAVES * 64, 2) trunk_fwd(KArgs args) {
    extern __shared__ __attribute__((aligned(16))) unsigned char lds[];
    Frame F;
    F.lds = (LAS unsigned char*)lds;
    F.MISC = (volatile LAS unsigned*)(F.lds + MISC_OFF);
    F.tid = threadIdx.x; F.lane = F.tid & 63; F.wave = __builtin_amdgcn_readfirstlane(F.tid >> 6);
    F.G = gridDim.x; { const int bx = blockIdx.x; F.vcu = (F.G % 8 == 0) ? (bx % 8) * (F.G / 8) + bx / 8 : bx; }
    F.ctl = (gu32*)(args.ws + WS_CTL);
    for (int u = F.tid; u < (LDS_BYTES - LDSCTL_OFF) / 4; u += NWAVES * 64) ((LAS unsigned*)(F.lds + LDSCTL_OFF))[u] = 0u;
    __syncthreads();
    Frame& F0 = F;
    const int lo = args.ph_lo, hi = args.ph_hi;
    XcdBarrier bar; bar.bar = (unsigned*)(F.ctl + CW_BAR); bar.x = 0; bar.st = nullptr;
    if (hi - lo > 1) bar = xcd_barrier_post((unsigned*)(F.ctl + CW_BAR), F.MISC + 8);
#define IN(k) (lo <= (k) && (k) < hi)
#ifndef PH_ENABLE
#define PH_ENABLE 0xFFFFFFFFu
#endif
#define PHEN(n) (((PH_ENABLE) >> (n)) & 1u)
#if defined(NO_OPQ)
#define OPQ(p) do {} while (0)
#else
#define OPQ(p) asm volatile("" : "+s"(p))
#endif
#define SEAM(k) do { if (IN(k) && IN((k) + 1)) { XcdBarrier b2_ = bar; OPQ(b2_.bar); xcd_barrier(b2_); } } while (0)

#define PTRS() unsigned char* ws = args.ws; OPQ(ws); const float* x = args.in[0]; OPQ(x); const float* norm_mix = args.in[1]; OPQ(norm_mix); const float* norm_ffn = args.in[2]; OPQ(norm_ffn); \
    float* h = args.out; OPQ(h); \
    bf16* XN = (bf16*)(ws + WS_XN); bf16* Qb = (bf16*)(ws + WS_Q); bf16* Kb = (bf16*)(ws + WS_K); bf16* Vb = (bf16*)(ws + WS_V); bf16* ACT = (bf16*)(ws + WS_ACT); \
    bf16* MGU = (bf16*)(ws + WS_MGU); bf16* MD = (bf16*)(ws + WS_MD); \
    float* kmean = (float*)(ws + WS_KMEAN); unsigned* ltok = (unsigned*)(ws + WS_LTOK); float* lw = (float*)(ws + WS_LW); \
    (void)x; (void)norm_mix; (void)norm_ffn; (void)h; (void)XN; (void)Qb; (void)Kb; (void)Vb; (void)ACT; (void)MGU; (void)MD; (void)kmean; (void)ltok; (void)lw
    const RouterArgs noR{nullptr, nullptr, nullptr, nullptr};
    constexpr float C2 = 0.125f * 1.4426950408889634f;

    if (PHEN(0) && IN(0)) {
        PTRS();
        unsigned rot = 0u;
        for (int j = 0; j < 2; ++j) {
            convert_matrix(F, args.in[3] + (size_t)j * D * 3 * D, D, 3 * D, (bf16*)(ws + WS_DQKV) + (size_t)j * 3 * D * D, 0, rot);
            convert_matrix(F, args.in[4] + (size_t)j * D * D, D, D, (bf16*)(ws + WS_DWO) + (size_t)j * D * D, 0, rot);
            convert_matrix(F, args.in[7] + (size_t)j * D * 3 * D, D, 3 * D, (bf16*)(ws + WS_MQKV) + (size_t)j * 3 * D * D, 0, rot);
            convert_matrix(F, args.in[8] + (size_t)j * D * D, D, D, (bf16*)(ws + WS_MWO) + (size_t)j * D * D, 0, rot);
            convert_matrix(F, args.in[9] + (size_t)j * D * DFF, D, DFF, (bf16*)(ws + WS_FGU) + (size_t)j * 2 * DFF * D, 1, rot);
            convert_matrix(F, args.in[10] + (size_t)j * D * DFF, D, DFF, (bf16*)(ws + WS_FGU) + (size_t)j * 2 * DFF * D, 2, rot);
            convert_matrix(F, args.in[11] + (size_t)j * DFF * D, DFF, D, (bf16*)(ws + WS_FD) + (size_t)j * D * DFF, 0, rot);
        }
        for (int e = 0; e < NE; ++e) {
            convert_matrix(F, args.in[13] + (size_t)e * D * DE, D, DE, MGU + (size_t)e * 2 * DE * D, 1, rot);
            convert_matrix(F, args.in[14] + (size_t)e * D * DE, D, DE, MGU + (size_t)e * 2 * DE * D, 2, rot);
            convert_matrix(F, args.in[15] + (size_t)e * DE * D, DE, D, MD + (size_t)e * D * DE, 0, rot);
        }
        norm_phase<0>(F, x, nullptr, nullptr, norm_mix, XN, nullptr, noR);
    }
    SEAM(0);

    for (int L = 0; L < NLAYER; ++L) {
        const int j = L >> 1, moba = L & 1, pb = 1 + PH_PER_LAYER * L;
        int z_ = 0;
#if !defined(NO_OPQ_Z)
        asm volatile("" : "+s"(z_));
#endif
        Frame Fl = F0; Fl.G += z_; Fl.vcu += z_; Fl.wave += z_; Fl.lds += z_; Fl.ctl += z_; const int bx = (int)blockIdx.x + z_;
#define F Fl
        if (PHEN(1) && IN(pb + 0)) {
            PTRS();

            const bf16* W = (const bf16*)(ws + (moba ? WS_MQKV : WS_DQKV)) + (size_t)j * 3 * D * D;
            pg8::Gemm g{XN, W, D, 0, (unsigned)((size_t)MTOK * D * 2 - 16), (unsigned*)F.ctl + 2048, (size_t)3 * D * D * 2}; pg8::StaticOrder S; S.init(MTOK, 3 * D, F.G, bx);
            pg8::EpiQKV E{Qb, D, D, (size_t)(WS_K - WS_Q) / 2, C2, (unsigned*)F.ctl + 2048};
            pg8::gemm_phase<pg8::EpiQKV, pg8::StaticOrder>(F.lds + RING_OFF, XSLOT_OFF, g, S, E);
        }
        SEAM(pb + 0);
        if (moba) { if (PHEN(2) && IN(pb + 1)) { PTRS(); kmean_phase(F, Kb, kmean); } SEAM(pb + 1); }
        if (IN(pb + 2)) {
            PTRS();
            att::Args A; A.Q = Qb; A.K = Kb; A.V = Vb; A.O = XN; A.kmean = kmean; A.subln = args.in[6] + (size_t)j * 128; A.lam_full = 0.f; A.out_scale = 1.f;
            const int PPC = (1024 + F.G - 1) / F.G;
            if (PHEN(3) && !moba) {
                const float* lam = args.in[5] + (size_t)j * 256; const int lane = F.lane;
                const GAS float* lamg = (const GAS float*)lam; const float s1 = wave_sum(lamg[lane] * lamg[64 + lane]), s2 = wave_sum(lamg[128 + lane] * lamg[192 + lane]);
                const float lam_init = 0.8f - 0.6f * __expf(-0.3f * (float)L);
                A.lam_full = __expf(s1) - __expf(s2) + lam_init; A.out_scale = 1.0f - lam_init;
                for (int i = 0; i < PPC; ++i) { const int P = F.vcu * PPC + i; if (P >= 1024) break; const int bh = P >> 4, pr = P & 15;
                    att::attn_unit<0>(F.lds + RING_OFF, A, bh >> 3, bh & 7, pr);
                    att::attn_unit<0>(F.lds + RING_OFF, A, bh >> 3, bh & 7, 31 - pr); }
            } else if (PHEN(4) && moba) {
                for (int i = 0; i < PPC; ++i) { const int P = F.vcu * PPC + i; if (P >= 1024) break; const int bh = P >> 3, pr = P & 7;
                    att::attn_unit<1>(F.lds + RING_OFF, A, bh >> 4, bh & 15, pr);
                    att::attn_unit<1>(F.lds + RING_OFF, A, bh >> 4, bh & 15, 15 - pr); }
            }
            asm volatile("s_waitcnt vmcnt(0) lgkmcnt(0)\n\ts_barrier" ::: "memory");
        }
        SEAM(pb + 2);
        if (PHEN(5) && IN(pb + 3)) {
            PTRS();
            const bf16* W = (const bf16*)(ws + (moba ? WS_MWO : WS_DWO)) + (size_t)j * D * D;
            pg8::Gemm g{XN, W, D, 0, (unsigned)((size_t)MTOK * D * 2 - 16), (unsigned*)F.ctl + 2048, (size_t)D * D * 2}; pg8::StaticOrder S; S.init(MTOK, D, F.G, bx);
            pg8::EpiRes E{L == 0 ? x : h, h, D};
            pg8::gemm_phase<pg8::EpiRes, pg8::StaticOrder>(F.lds + RING_OFF, XSLOT_OFF, g, S, E);
        }
        SEAM(pb + 3);
        if (PHEN(6) && IN(pb + 4)) {
            PTRS();
            if (!moba) {
                norm_phase<0>(F, h, nullptr, nullptr, norm_ffn + (size_t)L * D, XN, nullptr, noR);
                if (L == 2) { unsigned rot = 0u;
                    for (int e = 0; e < NE; ++e) {
                        convert_matrix(F, args.in[13] + (size_t)(NE + e) * D * DE, D, DE, MGU + (size_t)e * 2 * DE * D, 1, rot);
                        convert_matrix(F, args.in[14] + (size_t)(NE + e) * D * DE, D, DE, MGU + (size_t)e * 2 * DE * D, 2, rot);
                        convert_matrix(F, args.in[15] + (size_t)(NE + e) * DE * D, DE, D, MD + (size_t)e * D * DE, 0, rot);
                    } }
            } else {
                const RouterArgs R{args.in[12] + (size_t)j * D * NE, F.ctl + CW_CNT + 64 * NE * j, ltok, lw};
                norm_phase<2>(F, h, nullptr, nullptr, norm_ffn + (size_t)L * D, XN, nullptr, R);
            }
        }
        SEAM(pb + 4);
        if (IN(pb + 5)) {
            PTRS();
            if (PHEN(7) && !moba) {
                pg8::Gemm g{XN, (const bf16*)(ws + WS_FGU) + (size_t)j * 2 * DFF * D, D, 0, (unsigned)((size_t)MTOK * D * 2 - 16), (unsigned*)F.ctl + 2048, (size_t)2 * DFF * D * 2}; pg8::StaticOrder S; S.init(MTOK, 2 * DFF, F.G, bx);
                pg8::EpiSwiGLU E{ACT, DFF};
                pg8::gemm_phase<pg8::EpiSwiGLU, pg8::StaticOrder>(F.lds + RING_OFF, XSLOT_OFF, g, S, E);
            } else if (PHEN(8) && moba) {
                pg8::Gemm g{XN, MGU, D, (size_t)2 * DE * D, (unsigned)((size_t)MTOK * D * 2 - 16), (unsigned*)F.ctl + 2048, (size_t)NE * 2 * DE * D * 2}; pg8::MoeOrder S; S.init((const unsigned*)(F.ctl + CW_CNT + 64 * NE * j), ltok, true, 2 * DE, F.G, bx);
                pg8::EpiSwiGLU E{ACT, DE};
                pg8::gemm_phase<pg8::EpiSwiGLU, pg8::MoeOrder>(F.lds + RING_OFF, XSLOT_OFF, g, S, E);
            }
        }
        SEAM(pb + 5);
        if (IN(pb + 6)) {
            PTRS();
            if (PHEN(9) && !moba) {
                pg8::Gemm g{ACT, (const bf16*)(ws + WS_FD) + (size_t)j * D * DFF, DFF, 0, (unsigned)((size_t)MTOK * DFF * 2 - 16), (unsigned*)F.ctl + 2048, (size_t)D * DFF * 2}; pg8::StaticOrder S; S.init(MTOK, D, F.G, bx);
                pg8::EpiRes E{h, h, D};
                pg8::gemm_phase<pg8::EpiRes, pg8::StaticOrder>(F.lds + RING_OFF, XSLOT_OFF, g, S, E);
            } else if (PHEN(10) && moba) {
                pg8::Gemm g{ACT, MD, DE, (size_t)D * DE, (unsigned)((size_t)MOE_TILES_MAX * 256 * DE * 2 - 16), (unsigned*)F.ctl + 2048, (size_t)NE * D * DE * 2}; pg8::MoeOrder S; S.init((const unsigned*)(F.ctl + CW_CNT + 64 * NE * j), ltok, false, D, F.G, bx);
                pg8::EpiMoeDown E; E.h = h; E.y1 = XN; E.list_tok = ltok; E.list_w = lw;
#pragma unroll
                for (int e = 0; e < NE; ++e) E.cnt[e] = S.cnt[e];
                pg8::gemm_phase<pg8::EpiMoeDown, pg8::MoeOrder>(F.lds + RING_OFF, XSLOT_OFF, g, S, E);
            }
        }
        SEAM(pb + 6);
        if (PHEN(11) && IN(pb + 7)) {
            PTRS();
            if (L == 3) norm_phase<3>(F, h, nullptr, XN, args.in[16], nullptr, h, noR);
            else if (moba) norm_phase<1>(F, h, h, XN, norm_mix + (size_t)(L + 1) * D, XN, nullptr, noR);
            else norm_phase<0>(F, h, nullptr, nullptr, norm_mix + (size_t)(L + 1) * D, XN, nullptr, noR);
        }
        if (L != NLAYER - 1) SEAM(pb + 7);
#undef F
    }
#undef IN
#undef SEAM
#undef PTRS
#undef OPQ
}


#if MK_DEBUG
__global__ void dbg_probe(const void* buf, size_t n, int is_bf16, int idx, float thresh, unsigned* dbg) {
    size_t i = blockIdx.x * (size_t)blockDim.x + threadIdx.x, stride = (size_t)gridDim.x * blockDim.x; bool bad = false;
    for (size_t k = i; k < n; k += stride) { float v = is_bf16 ? __uint_as_float(((unsigned)((const unsigned short*)buf)[k]) << 16) : ((const float*)buf)[k]; if (!(fabsf(v) <= thresh)) bad = true; }
    if (bad) atomicMax(dbg, (unsigned)(1000 - idx));
}
__global__ void dbg_cnt(const unsigned* cntw, int idx, unsigned* dbg) {
    if (threadIdx.x == 0 && blockIdx.x == 0) { unsigned s = 0; for (int e = 0; e < NE; ++e) s += cntw[64 * e]; if (s != 2u * MTOK) atomicMax(dbg, (unsigned)(1000 - idx)); }
}

__device__ __forceinline__ float dbg_bf(unsigned short v) { return __uint_as_float(((unsigned)v) << 16); }
__device__ __forceinline__ unsigned dbg_hash(unsigned x) { x ^= x >> 16; x *= 0x7feb352dU; x ^= x >> 15; x *= 0x846ca68bU; x ^= x >> 16; return x; }
__global__ void dbg_gemm_check(const unsigned short* A, int lda, const unsigned short* Bt, int K, const unsigned short* out, int ldo, int M, int N, float scale, int idx, unsigned* dbg) {
    const unsigned s = blockIdx.x * blockDim.x + threadIdx.x; const int row = (int)(dbg_hash(2 * s + 1) % (unsigned)M), col = (int)(dbg_hash(2 * s + 2) % (unsigned)N);
    float acc = 0.f; for (int k = 0; k < K; ++k) acc += dbg_bf(A[(size_t)row * lda + k]) * dbg_bf(Bt[(size_t)col * K + k]);
    acc *= scale; const float got = dbg_bf(out[(size_t)row * ldo + col]);
    if (!(fabsf(got - acc) <= 0.03f + 0.02f * fabsf(acc))) { atomicMax(dbg, (unsigned)(1000 - idx)); atomicAdd(dbg + 64 + idx, 1u); }
}
__global__ void dbg_conv_check(const float* W, int K, int N, const unsigned short* WT, int il, int idx, unsigned* dbg) {
    const unsigned s = blockIdx.x * blockDim.x + threadIdx.x; const int k = (int)(dbg_hash(2 * s + 1) % (unsigned)K), n = (int)(dbg_hash(2 * s + 2) % (unsigned)N);
    const int dr = il == 0 ? n : (n / 128) * 256 + (il - 1) * 128 + (n % 128);
    const float w = W[(size_t)k * N + n], g = dbg_bf(WT[(size_t)dr * K + k]);
    if (!(fabsf(g - w) <= 0.01f * fabsf(w) + 1e-6f)) atomicMax(dbg, (unsigned)(1000 - idx));
}
__global__ void dbg_norm_check(const float* src, const float* gain, const unsigned short* xn, int idx, unsigned* dbg) {
    const unsigned s = blockIdx.x * blockDim.x + threadIdx.x; const int row = (int)(dbg_hash(s + 77) % (unsigned)MTOK);
    float ss = 0.f; for (int c = 0; c < D; ++c) { const float v = src[(size_t)row * D + c]; ss += v * v; }
    const float rstd = 1.f / sqrtf(ss / D + 1e-6f); bool bad = false;
    for (int c = 0; c < D; ++c) { const float r = src[(size_t)row * D + c] * rstd * gain[c], g = dbg_bf(xn[(size_t)row * D + c]); if (!(fabsf(g - r) <= 0.02f + 0.01f * fabsf(r))) bad = true; }
    if (bad) atomicMax(dbg, (unsigned)(1000 - idx));
}
__global__ void dbg_naive_gemm(const unsigned short* A, const unsigned short* Bt, unsigned short* out, int M, int N, int K) {
    const size_t i = blockIdx.x * (size_t)blockDim.x + threadIdx.x; if (i >= (size_t)M * N) return; const int row = (int)(i / N), col = (int)(i % N);
    float acc = 0.f; for (int k = 0; k < K; ++k) acc += dbg_bf(A[(size_t)row * K + k]) * dbg_bf(Bt[(size_t)col * K + k]);
    out[(size_t)row * N + col] = (unsigned short)f2bf(acc);
}
__global__ void dbg_find_col(const unsigned short* out, const unsigned short* ref, int M, int N, unsigned* hist) {
    const unsigned s = blockIdx.x * blockDim.x + threadIdx.x; const int row = (int)(dbg_hash(2 * s + 1) % (unsigned)M), col = (int)(dbg_hash(2 * s + 2) % (unsigned)N);
    const unsigned short v = out[(size_t)row * N + col]; int found = -1;
#if MK_FIND_PATTERN
    if (v == 0x3C3C) atomicAdd(hist + N, 1u); else atomicAdd(hist + 5, 1u); return;
#endif
#if MK_FIND_ROWS
    for (int r = 0; r < M; ++r) if (ref[(size_t)r * N + col] == v) { found = r; break; }
    if (found < 0) atomicAdd(hist + N, 1u); else atomicAdd(hist + ((found - row) & (N - 1)), 1u);
#else
    for (int c = 0; c < N; ++c) if (ref[(size_t)row * N + c] == v) { found = c; break; }
    if (found < 0) atomicAdd(hist + N, 1u); else atomicAdd(hist + ((found - col) & (N - 1)), 1u);
#endif
}
__global__ void dbg_hist_code(const unsigned* hist, int N, unsigned* dbg) {
    if (threadIdx.x || blockIdx.x) return; unsigned best = 0, bi = 0; for (int i = 0; i < N; ++i) if (hist[i] > best) { best = hist[i]; bi = i; }
    dbg[32] = bi; dbg[33] = best; dbg[34] = hist[N];
}
__global__ void dbg_final(float* out, size_t n, const unsigned* dbg) {
    if (MK_HIST_SEL >= 10) { const float c3 = sqrtf((float)dbg[MK_HIST_SEL + 30]); size_t i3 = blockIdx.x * (size_t)blockDim.x + threadIdx.x, st3 = (size_t)gridDim.x * blockDim.x; for (size_t k3 = i3; k3 < n; k3 += st3) out[k3] = c3; return; }
    if (MK_HIST_SEL >= 0 && (dbg[33] || dbg[34])) { const float c2 = sqrtf((float)(MK_HIST_SEL == 0 ? dbg[32] : (MK_HIST_SEL == 1 ? dbg[33] * 100u / 4096u : dbg[34] * 100u / 4096u)) + 1.f); size_t i2 = blockIdx.x * (size_t)blockDim.x + threadIdx.x, st2 = (size_t)gridDim.x * blockDim.x; for (size_t k2 = i2; k2 < n; k2 += st2) out[k2] = c2; return; }
    const unsigned d = dbg[0]; if (d == 0u) return; const unsigned nf = dbg[64 + (1000u - d)]; const float c = sqrtf(nf ? (float)(200u * (1000u - d - 9u) + nf * 100u / 4096u) : (float)(1000u - d));
    size_t i = blockIdx.x * (size_t)blockDim.x + threadIdx.x, stride = (size_t)gridDim.x * blockDim.x;
    for (size_t k = i; k < n; k += stride) out[k] = c;
}
#endif

#ifndef MK_REPEAT
#define MK_REPEAT 1
#endif
#ifndef MK_FIND_ROWS
#define MK_FIND_ROWS 0
#endif
#ifndef MK_FIND_REGION
#define MK_FIND_REGION WS_K
#endif
#ifndef MK_HIST_SEL
#define MK_HIST_SEL 0
#endif
extern "C" void kernel_launch(void* const* d_in, const int* in_sizes, int n_in, void* d_out, int out_size, void* d_ws, size_t ws_size, hipStream_t stream) {
    static int grid = 0;
    if (grid == 0) {
        if (n_in != 17 || in_sizes[0] != MTOK * D || out_size != MTOK * D || ws_size < WS_END) {
            fprintf(stderr, "kernel_launch: built for 17 inputs, x/out of %d floats, >= %zu bytes of workspace; got n_in %d, in0 %d, out %d, ws %zu; nothing launched\n", MTOK * D, (size_t)WS_END, n_in, n_in > 0 ? in_sizes[0] : -1, out_size, ws_size);
            grid = -1; return; }
        int dev = 0, cus = 0, per_cu = 0;
        if (hipGetDevice(&dev) != hipSuccess || hipDeviceGetAttribute(&cus, hipDeviceAttributeMultiprocessorCount, dev) != hipSuccess) { fprintf(stderr, "kernel_launch: device query failed\n"); grid = -1; return; }
        if (hipFuncSetAttribute((const void*)trunk_fwd, hipFuncAttributeMaxDynamicSharedMemorySize, LDS_BYTES) != hipSuccess) { fprintf(stderr, "kernel_launch: hipFuncSetAttribute failed\n"); grid = -1; return; }
        if (hipOccupancyMaxActiveBlocksPerMultiprocessor(&per_cu, (const void*)trunk_fwd, NWAVES * 64, LDS_BYTES) != hipSuccess || per_cu < 1)
            fprintf(stderr, "kernel_launch: note: occupancy query reports %d workgroups per CU\n", per_cu);
        (void)hipGetLastError();
        grid = cus;
    }
    if (grid < 0) return;
    if (hipMemsetAsync((char*)d_ws + WS_CTL, 0, CTL_ZERO_BYTES, stream) != hipSuccess) { fprintf(stderr, "kernel_launch: memset failed\n"); return; }
    KArgs a{};
    for (int i = 0; i < 17; ++i) a.in[i] = (const float*)d_in[i];
    a.out = (float*)d_out; a.ws = (unsigned char*)d_ws;
#if MK_PER_PHASE
    for (int p = 0; p < NPHASE; ++p) {
        if (p >= 1) { const int L = (p - 1) / PH_PER_LAYER, k = (p - 1) % PH_PER_LAYER; if (k == 1 && !(L & 1)) continue; }
        a.ph_lo = p; a.ph_hi = p + 1;
#if MK_DEBUG
#endif
#if !defined(MK_SKIP_MAIN)
        for (int rep_ = 0; rep_ < (p == 1 ? MK_REPEAT : 1); ++rep_) hipLaunchKernelGGL(trunk_fwd, dim3(grid), dim3(NWAVES * 64), LDS_BYTES, stream, a);
#endif
#if MK_DEBUG
        {   unsigned char* ws = (unsigned char*)d_ws; unsigned* dbg = (unsigned*)(ws + WS_CTL) + 2048;
            const size_t MD_ = (size_t)MTOK * D;
#define PROBE(buf, n, isbf, idx, th) if ((idx) <= MK_PROBE_MAX) hipLaunchKernelGGL(dbg_probe, dim3(2048), dim3(256), 0, stream, (const void*)(buf), (size_t)(n), isbf, idx, th, dbg)
            if (p == 0) {
                hipLaunchKernelGGL(dbg_norm_check, dim3(4), dim3(64), 0, stream, (const float*)d_in[0], (const float*)d_in[1], (const unsigned short*)(ws + WS_XN), 4, dbg);
                hipLaunchKernelGGL(dbg_conv_check, dim3(16), dim3(256), 0, stream, (const float*)d_in[3], D, 3 * D, (const unsigned short*)(ws + WS_DQKV), 0, 5, dbg);
                hipLaunchKernelGGL(dbg_conv_check, dim3(16), dim3(256), 0, stream, (const float*)d_in[9], D, DFF, (const unsigned short*)(ws + WS_FGU), 1, 6, dbg);
                hipLaunchKernelGGL(dbg_conv_check, dim3(16), dim3(256), 0, stream, (const float*)d_in[10], D, DFF, (const unsigned short*)(ws + WS_FGU), 2, 7, dbg);
                hipLaunchKernelGGL(dbg_conv_check, dim3(16), dim3(256), 0, stream, (const float*)d_in[11], DFF, D, (const unsigned short*)(ws + WS_FD), 0, 8, dbg);
                hipLaunchKernelGGL(dbg_conv_check, dim3(16), dim3(256), 0, stream, (const float*)d_in[15] + (size_t)3 * DE * D, DE, D, (const unsigned short*)(ws + WS_MD) + (size_t)3 * D * DE, 0, 9, dbg);
            }
            if (p == 1) {
                const float C2h = 0.125f * 1.4426950408889634f;
                hipLaunchKernelGGL(dbg_gemm_check, dim3(16), dim3(256), 0, stream, (const unsigned short*)(ws + WS_XN), D, (const unsigned short*)(ws + WS_DQKV), D, (const unsigned short*)(ws + WS_Q), D, MTOK, D, C2h, 10, dbg);
                hipLaunchKernelGGL(dbg_gemm_check, dim3(16), dim3(256), 0, stream, (const unsigned short*)(ws + WS_XN), D, (const unsigned short*)(ws + WS_DQKV) + (size_t)D * D, D, (const unsigned short*)(ws + WS_K), D, MTOK, D, 1.f, 11, dbg);

                hipLaunchKernelGGL(dbg_gemm_check, dim3(16), dim3(256), 0, stream, (const unsigned short*)(ws + WS_XN), D, (const unsigned short*)(ws + WS_DQKV) + (size_t)2 * D * D, D, (const unsigned short*)(ws + WS_V), D, MTOK, D, 1.f, 12, dbg);
            }
            if (0) { PROBE(ws + WS_XN, MD_, 1, 1, 10.f); PROBE(ws + WS_DQKV, (WS_MGU - WS_DQKV) / 2, 1, 2, 1.f); PROBE(ws + WS_MGU, (WS_XN - WS_MGU) / 2, 1, 3, 1.f); }
            if (p >= 1) { const int L = (p - 1) / PH_PER_LAYER, k = (p - 1) % PH_PER_LAYER; const int b = 20 + 10 * L;
                if (k == 0) PROBE(ws + WS_Q, 3 * MD_, 1, b + 0, 50.f);
                if (k == 1) PROBE(ws + WS_KMEAN, 8 * 16 * 16 * 64, 0, b + 1, 5.f);
                if (k == 2) PROBE(ws + WS_XN, MD_, 1, b + 2, 50.f);
                if (k == 3) PROBE(d_out, MD_, 0, b + 3, 300.f);
                if (k == 4) { PROBE(ws + WS_XN, MD_, 1, b + 4, 20.f); if ((L & 1) && (b + 9) <= MK_PROBE_MAX) hipLaunchKernelGGL(dbg_cnt, dim3(1), dim3(64), 0, stream, (const unsigned*)(ws + WS_CTL) + CW_CNT + 64 * NE * (L >> 1), b + 9, dbg); }
                if (k == 5) PROBE(ws + WS_ACT, (L & 1) ? (size_t)256 * 256 * DE : (size_t)MTOK * DFF, 1, b + 5, 2000.f);
                if (k == 6) { PROBE(d_out, MD_, 0, b + 6, 1000.f); if (L & 1) PROBE(ws + WS_XN, MD_, 1, b + 7, 1000.f); }
                if (k == 7 && L != 3) { PROBE(ws + WS_XN, MD_, 1, b + 8, 20.f); PROBE(d_out, MD_, 0, b + 8, 1000.f); }
            }
#undef PROBE
        }
#endif
    }
#if MK_DEBUG
    hipLaunchKernelGGL(dbg_final, dim3(2048), dim3(256), 0, stream, (float*)d_out, (size_t)MTOK * D, (const unsigned*)((unsigned char*)d_ws + WS_CTL) + 2048);
#endif
#else
    a.ph_lo = 0; a.ph_hi = NPHASE;
    hipLaunchKernelGGL(trunk_fwd, dim3(grid), dim3(NWAVES * 64), LDS_BYTES, stream, a);
#endif
    const hipError_t le = hipPeekAtLastError();
    if (le != hipSuccess) fprintf(stderr, "kernel_launch: launch failed: %s\n", hipGetErrorName(le));
}
```

```cpp
#define MK_DEBUG 0
#define MK_PER_PHASE 0
#define MK_DOUBLE 0x0u
#include <hip/hip_runtime.h>
#include <cstdio>
#include <cstdint>

#ifndef MK_DEBUG
#define MK_DEBUG 1
#endif
#ifndef MK_KDEBUG
#define MK_KDEBUG 0
#endif
#define LAS __attribute__((address_space(3)))
#define GAS __attribute__((address_space(1)))

constexpr int BATCH = 8, SEQ = 4096, MTOK = BATCH * SEQ, D = 1024, DFF = 2816, DE = 3584, NE = 8;
constexpr int MOE_TILES_MAX = 272;
constexpr int LIST_CAP = MTOK;

namespace pg8 {
#define PG8_LAS __attribute__((address_space(3)))
typedef unsigned short bf16_t;
typedef short bf16x8 __attribute__((ext_vector_type(8)));
typedef float f32x4 __attribute__((ext_vector_type(4)));
typedef unsigned u32x4 __attribute__((ext_vector_type(4)));
constexpr int BM = 256, BK = 64, HALF = 128, HTB = HALF * BK * 2  , STAGE_BYTES = 8 * HTB, NXCD = 8, WGM = 8;

__host__ __device__ __forceinline__ int lds_byte(int r, int c) { const int st = (r >> 4) * 2 + (c >> 5), rr = r & 15, cc = c & 31, ob = rr * 64 + cc * 2; return st * 1024 + (ob ^ (((ob >> 9) & 1) << 5)); }
__host__ __device__ __forceinline__ void stage_rc(int b, int& R, int& C) { const int st = b / 1024, sb = b % 1024, swz = sb ^ (((sb >> 9) & 1) << 5); R = (st >> 1) * 16 + swz / 64; C = (st & 1) * 32 + (swz % 64) / 2; }
__host__ __device__ __forceinline__ int perm32(int rho) { const int n = rho >> 4, i = rho & 15; return 8 * (i >> 2) + 4 * n + (i & 3); }

struct Unit { int pm, pn, e, r0; };
struct Gemm { const bf16_t* A; const bf16_t* Bt; int K; size_t bstride; unsigned amax; unsigned* dbg; size_t bbytes; };

__device__ __forceinline__ void tile_of(int L, int nM, int nN, int& pm, int& pn) {
    const int nwg = nM * nN; int wgid = L; { const int q = nwg / NXCD, r = nwg % NXCD, xcd = wgid % NXCD, off = wgid / NXCD; wgid = (xcd < r ? xcd * (q + 1) : r * (q + 1) + (xcd - r) * q) + off; }
    const int nig = WGM * nN, gid = wgid / nig, fm = gid * WGM, gsz = (nM - fm) < WGM ? (nM - fm) : WGM;
    pm = fm + ((wgid % nig) % gsz); pn = (wgid % nig) / gsz;
}
struct StaticOrder {
    int nM, nN, nwg, G, c;
    __device__ __forceinline__ void init(int M, int N, int G_, int c_) { nM = M / BM; nN = N / BM; nwg = nM * nN; G = G_; c = c_; }
    __device__ __forceinline__ bool next(int i, Unit& u) const {
        const long L = (long)i * G + c; if (L >= nwg) return false;
        tile_of((int)L, nM, nN, u.pm, u.pn); u.e = 0; u.r0 = 0; return true;
    }
    __device__ __forceinline__ unsigned arow(const Unit& u, int lr) const { return (unsigned)(u.pm * BM + lr); }
};
struct MoeOrder {
    int nM, nN, nwg, G, c; int tstart[NE + 1]; int cnt[NE]; const unsigned* list_tok; bool gather;
    __device__ __forceinline__ void init(const unsigned* cntw, const unsigned* list_tok_, bool gather_, int N, int G_, int c_) {
        int acc = 0;
#pragma unroll
        for (int e = 0; e < NE; ++e) { const int ce = (int)__builtin_amdgcn_readfirstlane((int)__hip_atomic_load((const GAS unsigned*)cntw + 64 * e, __ATOMIC_RELAXED, __HIP_MEMORY_SCOPE_AGENT)); cnt[e] = ce; tstart[e] = acc; acc += (ce + BM - 1) / BM; }
        tstart[NE] = acc; nM = acc; nN = N / BM; nwg = nM * nN; G = G_; c = c_; list_tok = list_tok_; gather = gather_;
    }
    __device__ __forceinline__ bool next(int i, Unit& u) const {
        const long L = (long)i * G + c; if (L >= nwg) return false;
        tile_of((int)L, nM, nN, u.pm, u.pn); int e = 0;
#pragma unroll
        for (int k = 1; k < NE; ++k) e += (u.pm >= tstart[k]) ? 1 : 0;
        u.e = e; int ts = 0;
#pragma unroll
        for (int k = 0; k < NE; ++k) ts = (k == e) ? tstart[k] : ts;
        u.r0 = (u.pm - ts) * BM; return true;
    }
    __device__ __forceinline__ int count_of(int e) const { int cv = 0;
#pragma unroll
        for (int k = 0; k < NE; ++k) cv = (k == e) ? cnt[k] : cv;
        return cv; }
    __device__ __forceinline__ unsigned arow(const Unit& u, int lr) const {
        if (!gather) return (unsigned)(u.pm * BM + lr);
        const int l = u.r0 + lr; const int cv = count_of(u.e);
        unsigned t = 0u; if (l < cv) t = __hip_atomic_load((const GAS unsigned*)list_tok + (size_t)u.e * LIST_CAP + l, __ATOMIC_RELAXED, __HIP_MEMORY_SCOPE_AGENT) & 0xFFFFFu;
        return t;
    }
};

__device__ __forceinline__ unsigned cvt_pk_bf16(float lo, float hi) { unsigned r; asm volatile("v_cvt_pk_bf16_f32 %0, %1, %2" : "=v"(r) : "v"(lo), "v"(hi)); return r; }

struct EpiQKV {
    static constexpr bool PERM = true;
    bf16_t* O; int ldc; int split_cols; size_t split_stride; float scale0; unsigned* dbg;
    __device__ __forceinline__ void operator()(const f32x4 (&acc)[2][2][4][2], const Unit& u, int wr, int wc, int fr, int fq) const {
        const int row0 = u.pm * BM + wr * 64 + fr; int colt = u.pn * BM; bf16_t* base = O;
        float sc = 1.f; { const int t = colt / split_cols; base += (size_t)t * split_stride; colt -= t * split_cols; if (t == 0) sc = scale0; }
        const int col0 = colt + wc * 32 + 8 * fq;
#pragma unroll
        for (int ai = 0; ai < 2; ++ai)
#pragma unroll
            for (int m = 0; m < 4; ++m) { bf16_t* rowp = base + (size_t)(row0 + ai * HALF + m * 16) * ldc + col0;
#pragma unroll
                for (int bj = 0; bj < 2; ++bj) { f32x4 v0 = acc[ai][bj][m][0] * sc, v1 = acc[ai][bj][m][1] * sc;
                    u32x4 w; w.x = cvt_pk_bf16(v0[0], v0[1]); w.y = cvt_pk_bf16(v0[2], v0[3]); w.z = cvt_pk_bf16(v1[0], v1[1]); w.w = cvt_pk_bf16(v1[2], v1[3]);
#if defined(EPI_VARIANT) && EPI_VARIANT == 1
                    { u32x4 cz = {0x3f803f80u, 0x3f803f80u, 0x3f803f80u, 0x3f803f80u}; asm volatile("" :: "v"(w)); *(GAS u32x4*)(rowp + bj * HALF) = cz; }
#elif defined(EPI_VARIANT) && EPI_VARIANT == 2
                    { asm volatile("" :: "v"(w)); asm volatile("" :: "v"(rowp)); }
#elif MK_KDEBUG
                    { const size_t eo = (size_t)((rowp + bj * HALF) - O); if (eo + 8 <= (size_t)3 * 33554432) *(GAS u32x4*)(rowp + bj * HALF) = w; else atomicMax(dbg, 1000u - 3u); }
#else
                    *(GAS u32x4*)(rowp + bj * HALF) = w;
#endif
                    } }
    }
};
struct EpiSwiGLU {
    static constexpr bool PERM = true;
    bf16_t* O; int ldc;
    __device__ __forceinline__ void operator()(const f32x4 (&acc)[2][2][4][2], const Unit& u, int wr, int wc, int fr, int fq) const {
        const int row0 = u.pm * BM + wr * 64 + fr; const int col0 = u.pn * HALF + wc * 32 + 8 * fq;
#pragma unroll
        for (int ai = 0; ai < 2; ++ai)
#pragma unroll
            for (int m = 0; m < 4; ++m) { bf16_t* rowp = O + (size_t)(row0 + ai * HALF + m * 16) * ldc + col0; float o[8];
#pragma unroll
                for (int n = 0; n < 2; ++n)
#pragma unroll
                    for (int j = 0; j < 4; ++j) { const float g = acc[ai][0][m][n][j], up = acc[ai][1][m][n][j];
                        const float s = __builtin_amdgcn_rcpf(1.0f + __builtin_amdgcn_exp2f(-1.4426950408889634f * g)); o[n * 4 + j] = g * s * up; }
                u32x4 w; w.x = cvt_pk_bf16(o[0], o[1]); w.y = cvt_pk_bf16(o[2], o[3]); w.z = cvt_pk_bf16(o[4], o[5]); w.w = cvt_pk_bf16(o[6], o[7]);
                *(GAS u32x4*)rowp = w; }
    }
};
struct EpiRes {
    static constexpr bool PERM = false;
    const float* res; float* out; int ldc;
    __device__ __forceinline__ void operator()(const f32x4 (&acc)[2][2][4][2], const Unit& u, int wr, int wc, int fr, int fq) const {
        const int row0 = u.pm * BM + wr * 64 + fr; const int col0 = u.pn * BM + wc * 32 + 4 * fq;
#pragma unroll
        for (int ai = 0; ai < 2; ++ai)
#pragma unroll
            for (int m = 0; m < 4; ++m) { const size_t off = (size_t)(row0 + ai * HALF + m * 16) * ldc + col0;
#pragma unroll
                for (int bj = 0; bj < 2; ++bj)
#pragma unroll
                    for (int n = 0; n < 2; ++n) { const f32x4 r = *(const GAS f32x4*)(res + off + bj * HALF + n * 16); *(GAS f32x4*)(out + off + bj * HALF + n * 16) = r + acc[ai][bj][m][n]; } }
    }
};
struct EpiMoeDown {
    static constexpr bool PERM = false;
    float* h; bf16_t* y1; const unsigned* list_tok; const float* list_w; int cnt[NE];
    __device__ __forceinline__ void operator()(const f32x4 (&acc)[2][2][4][2], const Unit& u, int wr, int wc, int fr, int fq) const {
        int cv = 0;
#pragma unroll
        for (int k = 0; k < NE; ++k) cv = (k == u.e) ? cnt[k] : cv;
        const int col0 = u.pn * BM + wc * 32 + 4 * fq;
#pragma unroll
        for (int ai = 0; ai < 2; ++ai)
#pragma unroll
            for (int m = 0; m < 4; ++m) { const int l = u.r0 + ai * HALF + wr * 64 + m * 16 + fr;
                if (l < cv) {
                    const unsigned ent = __hip_atomic_load((const GAS unsigned*)list_tok + (size_t)u.e * LIST_CAP + l, __ATOMIC_RELAXED, __HIP_MEMORY_SCOPE_AGENT);
                    const float w = __uint_as_float(__hip_atomic_load((const GAS unsigned*)list_w + (size_t)u.e * LIST_CAP + l, __ATOMIC_RELAXED, __HIP_MEMORY_SCOPE_AGENT));
                    const size_t off = (size_t)(ent & 0xFFFFFu) * D + col0;
                    if ((ent >> 20) == 0u) {
#pragma unroll
                        for (int bj = 0; bj < 2; ++bj)
#pragma unroll
                            for (int n = 0; n < 2; ++n) { GAS float* p = (GAS float*)(h + off + bj * HALF + n * 16); const f32x4 r = *(const GAS f32x4*)p; *(GAS f32x4*)p = r + acc[ai][bj][m][n] * w; }
                    } else {
#pragma unroll
                        for (int bj = 0; bj < 2; ++bj)
#pragma unroll
                            for (int n = 0; n < 2; ++n) { const f32x4 v = acc[ai][bj][m][n] * w; unsigned long long pk = (unsigned long long)cvt_pk_bf16(v[0], v[1]) | ((unsigned long long)cvt_pk_bf16(v[2], v[3]) << 32);
                                *(GAS unsigned long long*)(y1 + off + bj * HALF + n * 16) = pk; }
                    }
                } }
    }
};

template <class Epi, class Sched>
__device__ __forceinline__ void gemm_phase(PG8_LAS unsigned char* lds, int xoff, const Gemm g, const Sched& S, const Epi& E) {
    int tid_ = threadIdx.x;
#if !defined(NO_OPQ_T)
    asm volatile("" : "+v"(tid_));
#endif
    const int tid = tid_, wid = __builtin_amdgcn_readfirstlane(tid >> 6), lane = tid & 63, wr = wid >> 2, wc = wid & 3, fr = lane & 15, fq = lane >> 4;
    const int K = g.K, nt = K / BK;
    unsigned voffB[2];
#pragma unroll
    for (int i = 0; i < 2; ++i) { int R, C; stage_rc(tid * 16 + i * 8192, R, C); const int Rb = Epi::PERM ? ((R & ~31) + perm32(R & 31)) : R;
        voffB[i] = (unsigned)(Rb * K + C) * 2u; }
    const size_t kstep = (size_t)(BK * 2);
    const size_t hstep = (size_t)HALF * K * 2;
    const size_t tstep = 2 * hstep;
    const unsigned ldsw = (unsigned)wid * 1024u;
    const int aoff = lds_byte(wr * 64 + fr, fq * 8), boff = lds_byte(wc * 32 + fr, fq * 8);
#define PG8_SA(b, h) (((b) * 2 + (h)) * HTB)
#define PG8_SB(b, h) ((4 + (b) * 2 + (h)) * HTB)
#define PG8_STAGE(bufoff, gbase, v0, v1) do { \
        __builtin_amdgcn_global_load_lds((const GAS unsigned*)((const char*)(gbase) + (v0)), (PG8_LAS unsigned*)(lds + (bufoff) + ldsw), 16, 0, 0); \
        __builtin_amdgcn_global_load_lds((const GAS unsigned*)((const char*)(gbase) + (v1)), (PG8_LAS unsigned*)(lds + (bufoff) + ldsw + 8192), 16, 0, 0); } while (0)
#define PG8_STAGEB(bufoff, gbase) PG8_STAGE(bufoff, gbase, voffB[0], voffB[1])
#define PG8_LDA(dst, b, h) do { _Pragma("unroll") for (int m = 0; m < 4; ++m) _Pragma("unroll") for (int k = 0; k < 2; ++k) dst[m][k] = *(const PG8_LAS bf16x8*)(lds + PG8_SA(b, h) + aoff + m * 2048 + k * 1024); } while (0)
#define PG8_LDB(dst, b, h) do { _Pragma("unroll") for (int n = 0; n < 2; ++n) _Pragma("unroll") for (int k = 0; k < 2; ++k) dst[n][k] = *(const PG8_LAS bf16x8*)(lds + PG8_SB(b, h) + boff + n * 2048 + k * 1024); } while (0)
#define PG8_MMA(ai, bj, At, Bt) do { __builtin_amdgcn_s_setprio(1); _Pragma("unroll") for (int m = 0; m < 4; ++m) _Pragma("unroll") for (int n = 0; n < 2; ++n) _Pragma("unroll") for (int k = 0; k < 2; ++k) \
        acc[ai][bj][m][n] = __builtin_amdgcn_mfma_f32_16x16x32_bf16(Bt[n][k], At[m][k], acc[ai][bj][m][n], 0, 0, 0); __builtin_amdgcn_s_setprio(0); } while (0)
#define PG8_WAIT_V(n) asm volatile("s_waitcnt vmcnt(" #n ")" ::: "memory")
#define PG8_WAIT_L(n) asm volatile("s_waitcnt lgkmcnt(" #n ")" ::: "memory")
#define PG8_BAR __builtin_amdgcn_s_barrier()
#define PG8_SCHED __builtin_amdgcn_sched_barrier(0)
#define PG8_AOFFS(U, o00, o01, o10, o11) do { int R0_, C0_, R1_, C1_; stage_rc(tid * 16, R0_, C0_); stage_rc(tid * 16 + 8192, R1_, C1_);     \
        o00 = (S.arow(U, R0_) * (unsigned)K + (unsigned)C0_) * 2u; o01 = (S.arow(U, R1_) * (unsigned)K + (unsigned)C1_) * 2u; \
        o10 = (S.arow(U, HALF + R0_) * (unsigned)K + (unsigned)C0_) * 2u; o11 = (S.arow(U, HALF + R1_) * (unsigned)K + (unsigned)C1_) * 2u; } while (0)
    Unit cur, nxt; int ui = 0;
#if MK_KDEBUG
    if (blockIdx.x == 5 && threadIdx.x == 0) atomicOr(g.dbg + 43, 2u);
#endif
    if (!S.next(0, cur)) return;
#if MK_KDEBUG
    if (blockIdx.x == 5 && threadIdx.x == 0) atomicOr(g.dbg + 43, 4u);
    { Unit t1_; if (blockIdx.x == 5 && threadIdx.x == 0 && S.next(1, t1_)) { g.dbg[40] = 1u + (unsigned)t1_.pm * 16u + (unsigned)t1_.pn; g.dbg[41] = 1u + (unsigned)cur.pm * 16u + (unsigned)cur.pn; g.dbg[42] = 1u + (unsigned)gridDim.x; atomicOr(g.dbg + 43, 8u); } }
#endif
#if defined(GDBG_NOKLOOP)
    { f32x4 accz[2][2][4][2];
      for (int ui_ = 0; S.next(ui_, cur); ++ui_) {
#pragma unroll
        for (int a = 0; a < 2; ++a)
#pragma unroll
          for (int b = 0; b < 2; ++b)
#pragma unroll
            for (int m = 0; m < 4; ++m)
#pragma unroll
              for (int n = 0; n < 2; ++n) { f32x4 r4;
                for (int j = 0; j < 4; ++j) { const int row = cur.pm * 256 + a * 128 + wr * 64 + m * 16 + fr;
                  const int col = cur.pn * 256 + b * 128 + wc * 32 + (Epi::PERM ? 8 * fq + 4 * n + j : 16 * n + 4 * fq + j);
                  const bf16_t* ar = g.A + (size_t)row * K; const bf16_t* br = g.Bt + (size_t)cur.e * g.bstride + (size_t)col * K; float s_ = 0.f;
                  for (int k = 0; k < K; ++k) s_ += __uint_as_float(((unsigned)ar[k]) << 16) * __uint_as_float(((unsigned)br[k]) << 16);
                  r4[j] = s_; }
                accz[a][b][m][n] = r4; }
        E(accz, cur, wr, wc, fr, fq); }
      return; }
#endif
    f32x4 acc[2][2][4][2];
#pragma unroll
    for (int a = 0; a < 2; ++a)
#pragma unroll
        for (int b = 0; b < 2; ++b)
#pragma unroll
            for (int m = 0; m < 4; ++m)
#pragma unroll
                for (int n = 0; n < 2; ++n) acc[a][b][m][n] = (f32x4){0.f, 0.f, 0.f, 0.f};
    bf16x8 At[4][2], B0[2][2], B1[2][2];
    unsigned c00, c01, c10, c11;
    PG8_LAS u32x4* const xslot = (PG8_LAS u32x4*)(lds + xoff) + tid;
    PG8_AOFFS(cur, c00, c01, c10, c11);
    const char* const gA = (const char*)g.A;
    const char* cB = (const char*)g.Bt + (size_t)cur.e * g.bstride * 2 + (size_t)cur.pn * tstep;
    PG8_STAGEB(PG8_SB(0, 0), cB); PG8_STAGEB(PG8_SB(0, 1), cB + hstep); PG8_STAGE(PG8_SA(0, 0), gA, c00, c01); PG8_STAGE(PG8_SA(0, 1), gA, c10, c11);
    if (wr == 1) PG8_BAR;
    PG8_WAIT_V(2); PG8_BAR;
    PG8_STAGEB(PG8_SB(1, 0), cB + kstep); PG8_STAGE(PG8_SA(1, 0), gA + kstep, c00, c01); PG8_STAGEB(PG8_SB(1, 1), cB + hstep + kstep);
    PG8_WAIT_V(6); PG8_BAR;
    for (;;) {
        const bool has_next = S.next(ui + 1, nxt);
        const char* nB_ = has_next ? (const char*)g.Bt + (size_t)nxt.e * g.bstride * 2 + (size_t)nxt.pn * tstep : cB;
        const char* nB = nB_;
        if (has_next) { unsigned n00, n01, n10, n11; PG8_AOFFS(nxt, n00, n01, n10, n11); *xslot = (u32x4){n00, n01, n10, n11}; }
#if MK_KDEBUG
        { const char* lo_ = (const char*)g.Bt; const char* hi_ = lo_ + g.bbytes - tstep;
          if (cB < lo_ || cB > hi_ || nB < lo_ || nB > hi_) { atomicMax(g.dbg, 1000u - 92u); cB = lo_; nB = lo_; }
          if (voffB[0] > (unsigned)tstep || voffB[1] > (unsigned)tstep) { atomicMax(g.dbg, 1000u - 93u); voffB[0] = 0u; voffB[1] = 0u; }
          const unsigned mx_ = g.amax; if (c00 > mx_ || c01 > mx_ || c10 > mx_ || c11 > mx_) { atomicMax(g.dbg, 1000u - 94u); c00 = 0u; c01 = 0u; c10 = 0u; c11 = 0u; } }
#endif
        for (int t = 0; t < nt; t += 2) {
            const bool last = (t == nt - 2);
            const char* a1 = gA + (size_t)(t + 1) * kstep;
            const char* a2 = last ? gA : gA + (size_t)(t + 2) * kstep; const char* b2 = last ? nB : cB + (size_t)(t + 2) * kstep;
            const char* a3 = a2 + kstep; const char* b3 = b2 + kstep;
            PG8_LDB(B0, 0, 0); PG8_LDB(B1, 0, 1); PG8_SCHED; PG8_LDA(At, 0, 0); PG8_STAGE(PG8_SA(1, 1), a1, c10, c11);
            if (last && has_next) { const u32x4 nx = *xslot; c00 = nx.x; c01 = nx.y; c10 = nx.z; c11 = nx.w; }
#if MK_KDEBUG
            { const unsigned mx_ = g.amax; if (c00 > mx_ || c01 > mx_ || c10 > mx_ || c11 > mx_) { atomicMax(g.dbg, 1000u - 90u); c00 = c00 > mx_ ? 0u : c00; c01 = c01 > mx_ ? 0u : c01; c10 = c10 > mx_ ? 0u : c10; c11 = c11 > mx_ ? 0u : c11; } }
#endif
            PG8_WAIT_V(8); PG8_WAIT_L(0); PG8_BAR; PG8_MMA(0, 0, At, B0); PG8_MMA(0, 1, At, B1); PG8_BAR; PG8_SCHED;
            PG8_LDA(At, 0, 1); PG8_STAGEB(PG8_SB(0, 0), b2); PG8_STAGEB(PG8_SB(0, 1), b2 + hstep); PG8_STAGE(PG8_SA(0, 0), a2, c00, c01);
            PG8_WAIT_V(8); PG8_WAIT_L(0); PG8_BAR; PG8_MMA(1, 0, At, B0); PG8_MMA(1, 1, At, B1); PG8_BAR; PG8_SCHED;
            PG8_LDB(B0, 1, 0); PG8_LDB(B1, 1, 1); PG8_SCHED; PG8_LDA(At, 1, 0); PG8_STAGE(PG8_SA(0, 1), a2, c10, c11);
            PG8_WAIT_V(8); PG8_WAIT_L(0); PG8_BAR; PG8_MMA(0, 0, At, B0); PG8_MMA(0, 1, At, B1); PG8_BAR; PG8_SCHED;
            PG8_LDA(At, 1, 1); PG8_STAGEB(PG8_SB(1, 0), b3); PG8_STAGEB(PG8_SB(1, 1), b3 + hstep); PG8_STAGE(PG8_SA(1, 0), a3, c00, c01);
            PG8_WAIT_V(8); PG8_WAIT_L(0); PG8_BAR; PG8_MMA(1, 0, At, B0); PG8_MMA(1, 1, At, B1); PG8_BAR; PG8_SCHED;
        }
        if (wr == 0) PG8_BAR;
#if !defined(GDBG_NOEPI)
#if defined(EPI_DRAIN)
        asm volatile("s_waitcnt vmcnt(0)" ::: "memory");
#endif
        E(acc, cur, wr, wc, fr, fq);
#if defined(EPI_DRAIN_AFTER)
        asm volatile("s_waitcnt vmcnt(0)" ::: "memory");
#endif
#else
        asm volatile("" :: "v"(acc[0][0][0][0]), "v"(acc[1][1][3][1]));
#endif
        if (!has_next) break;
#pragma unroll
        for (int a = 0; a < 2; ++a)
#pragma unroll
            for (int b = 0; b < 2; ++b)
#pragma unroll
                for (int m = 0; m < 4; ++m)
#pragma unroll
                    for (int n = 0; n < 2; ++n) acc[a][b][m][n] = (f32x4){0.f, 0.f, 0.f, 0.f};
        cur = nxt; cB = nB; ++ui;
        if (wr == 1) PG8_BAR;
    }
    PG8_WAIT_V(0);
    PG8_BAR;
#undef PG8_SA
#undef PG8_SB
#undef PG8_STAGE
#undef PG8_STAGEB
#undef PG8_LDA
#undef PG8_LDB
#undef PG8_MMA
#undef PG8_WAIT_V
#undef PG8_WAIT_L
#undef PG8_BAR
#undef PG8_SCHED
#undef PG8_AOFFS
}
}

namespace att {
typedef unsigned short bf16_t;
typedef short bf16x8 __attribute__((ext_vector_type(8)));
typedef short s16x4 __attribute__((ext_vector_type(4)));
typedef float f32x16 __attribute__((ext_vector_type(16)));
typedef float f32x4 __attribute__((ext_vector_type(4)));
typedef unsigned u32x4 __attribute__((ext_vector_type(4)));
constexpr int PITCH = 1024;
constexpr float LOG2E = 1.4426950408889634f;
__device__ __forceinline__ int crow(int r, int hi) { return (r & 3) + 8 * (r >> 2) + 4 * hi; }
typedef float f32x2_t __attribute__((ext_vector_type(2))); typedef __bf16 bf16x2_t __attribute__((ext_vector_type(2)));
__device__ __forceinline__ unsigned cvtpk(float lo, float hi) { f32x2_t v = {lo, hi}; bf16x2_t b = __builtin_convertvector(v, bf16x2_t); return __builtin_bit_cast(unsigned, b); }
__device__ __forceinline__ float bf2f(short s) { return __uint_as_float(((unsigned)(unsigned short)s) << 16); }
typedef short v4i16_t __attribute__((ext_vector_type(4)));
__device__ __forceinline__ s16x4 vtr(const LAS unsigned char* p) { return __builtin_bit_cast(s16x4, __builtin_amdgcn_ds_read_tr16_b64_v4i16((LAS v4i16_t*)p)); }
__device__ __forceinline__ float max3f(float a, float b, float c) { float r; asm("v_max3_f32 %0, %1, %2, %3" : "=v"(r) : "v"(a), "v"(b), "v"(c)); return r; }
__device__ __forceinline__ float halves_max(float m) { auto rr = __builtin_amdgcn_permlane32_swap(__float_as_uint(m), __float_as_uint(m), false, false); return fmaxf(__uint_as_float(rr[0]), __uint_as_float(rr[1])); }
__device__ __forceinline__ float halves_sum(float m) { auto rr = __builtin_amdgcn_permlane32_swap(__float_as_uint(m), __float_as_uint(m), false, false); return __uint_as_float(rr[0]) + __uint_as_float(rr[1]); }
#define ATT_BAR() asm volatile("s_waitcnt vmcnt(0) lgkmcnt(0)\n\ts_barrier" ::: "memory")

struct Args { const bf16_t* Q; const bf16_t* K; const bf16_t* V; bf16_t* O; const float* kmean; const float* subln; float lam_full; float out_scale; };

template <int MODE>
__device__ __forceinline__ void attn_unit(LAS unsigned char* lds, const Args& A, int b, int h, int qblk) {
    constexpr int DVB = MODE == 0 ? 4 : 2;
    constexpr int NCH = MODE == 0 ? 16 : 8;
    constexpr int KBY = NCH * 1024, VBY = DVB * 4096, SLOT = KBY + VBY;
    constexpr int QR = MODE == 0 ? 128 : 256;
    constexpr int PPW = MODE == 0 ? 2 : 1;
    int tid_ = threadIdx.x; asm volatile("" : "+v"(tid_));
    const int tid = tid_, lane = tid & 63, r32 = lane & 31, hi = lane >> 5;
    const int wid = __builtin_amdgcn_readfirstlane(tid >> 6);
    const int comp = MODE == 0 ? (wid >> 2) : 0, wq = MODE == 0 ? (wid & 3) : wid;
    const int q0 = qblk * QR; const long rowbase = (long)b * SEQ;
    const int hcol = MODE == 0 ? h * 128 : h * 64;
    const int qrel0 = wq * 32;
    const float slope2 = __builtin_amdgcn_exp2f(MODE == 0 ? -(float)(h + 1) : -0.5f * (float)(h + 1)) * LOG2E;
    const int NT = MODE == 0 ? 2 * qblk + 2 : 4 + 4 * qblk;
    LAS float* wsf = (LAS float*)(lds + 65536) + wid * 64;
    const bf16_t* Kb = A.K + rowbase * PITCH + hcol;
    const bf16_t* Vb = A.V + rowbase * PITCH + hcol;
    bf16x8 qr[4];
    { const bf16_t* Qw = A.Q + (rowbase + q0 + qrel0 + r32) * PITCH + hcol + comp * 64 + hi * 8;
#pragma unroll
      for (int d0 = 0; d0 < 4; ++d0) qr[d0] = *(const GAS bf16x8*)(Qw + d0 * 16); }
    ATT_BAR();
    unsigned sel = 0u;
    if constexpr (MODE == 1) {
        LAS float* km = (LAS float*)(lds + 67584);
        for (int i = tid; i < 1024; i += 512) km[i] = ((const GAS float*)A.kmean)[(size_t)(b * 16 + h) * 1024 + i];
        ATT_BAR();
        float g[16];
#pragma unroll
        for (int n = 0; n < 16; ++n) { float s = 0.f;
            if (n < qblk) {
#pragma unroll
                for (int d0 = 0; d0 < 4; ++d0) { const f32x4 ka = *(const LAS f32x4*)(km + n * 64 + d0 * 16 + hi * 8), kb2 = *(const LAS f32x4*)(km + n * 64 + d0 * 16 + hi * 8 + 4);
                    s += bf2f(qr[d0][0]) * ka[0] + bf2f(qr[d0][1]) * ka[1] + bf2f(qr[d0][2]) * ka[2] + bf2f(qr[d0][3]) * ka[3]
                       + bf2f(qr[d0][4]) * kb2[0] + bf2f(qr[d0][5]) * kb2[1] + bf2f(qr[d0][6]) * kb2[2] + bf2f(qr[d0][7]) * kb2[3]; }
                s = halves_sum(s); }
            g[n] = s; }
        const int nsel = qblk < 3 ? qblk : 3;
#pragma unroll
        for (int k = 0; k < 3; ++k) if (k < nsel) { float best = -INFINITY; int bi = 0; bool found = false;
#pragma unroll
            for (int n = 0; n < 16; ++n) if (n < qblk) { const bool free_ = ((sel >> n) & 1u) == 0u; if (free_ && (!found || g[n] > best)) { best = g[n]; bi = n; found = true; } }
            sel |= 1u << bi; }
    }
#define ATT_KBASE(t) (MODE == 0 ? 64 * (t) : ((t) < 4 ? q0 + 64 * (t) : 64 * ((t) - 4)))
#define ATT_ISSUE(t, slot) do { const int kb_ = ATT_KBASE(t); \
        _Pragma("unroll") for (int i_ = 0; i_ < PPW; ++i_) { const int p_ = wid + 8 * i_; \
            __builtin_amdgcn_global_load_lds((const GAS unsigned*)(Kb + (size_t)(kb_ + lane) * PITCH + p_ * 8), (LAS unsigned*)(lds + (slot) * SLOT + p_ * 1024), 16, 0, 0); \
            __builtin_amdgcn_global_load_lds((const GAS unsigned*)(Vb + (size_t)(kb_ + 16 * (p_ & 3) + (lane >> 2)) * PITCH + (p_ >> 2) * 32 + (lane & 3) * 8), (LAS unsigned*)(lds + (slot) * SLOT + KBY + p_ * 1024), 16, 0, 0); } } while (0)
    constexpr float THR = 8.0f;
    float mref = 0.f, l = 0.f; f32x16 o[DVB];
#pragma unroll
    for (int d0 = 0; d0 < DVB; ++d0) o[d0] = f32x16{};
    ATT_ISSUE(0, 0);
    for (int t = 0; t < NT; ++t) {
        ATT_BAR();
        if (t + 1 < NT) ATT_ISSUE(t + 1, (t + 1) & 1);
        const int kbase = ATT_KBASE(t), krel = kbase - q0;
        const bool diag = kbase >= q0;
        bool skip = diag && (krel > qrel0 + 31);
        const bool needmask = diag && (krel + 63 > qrel0);
        bool selbit = true;
        if constexpr (MODE == 1) { if (t >= 4) { selbit = ((sel >> ((t - 4) >> 2)) & 1u) != 0u; if (!__any(selbit)) skip = true; } }
        if (!skip) {
            const LAS unsigned char* Ks = lds + (t & 1) * SLOT + comp * 8192 + hi * 1024 + r32 * 16;
            const LAS unsigned char* Vs = lds + (t & 1) * SLOT + KBY + ((lane >> 4) & 1) * 32 + (lane & 3) * 8 + (4 * hi + ((lane & 15) >> 2)) * 64;
            f32x16 p0, p1;
            { float off0 = slope2 * (float)(krel + 4 * hi) - mref;
              if constexpr (MODE == 1) { if (!selbit) off0 = -INFINITY; }
              const float off1 = off0 + 32.0f * slope2;
#pragma unroll
              for (int r = 0; r < 16; ++r) { const float cbr = slope2 * (float)((r & 3) + 8 * (r >> 2)); p0[r] = cbr + off0; p1[r] = cbr + off1; } }
#pragma unroll
            for (int d0 = 0; d0 < 4; ++d0) { const bf16x8 b0 = *(const LAS bf16x8*)(Ks + d0 * 2048), b1 = *(const LAS bf16x8*)(Ks + d0 * 2048 + 512);
                p0 = __builtin_amdgcn_mfma_f32_32x32x16_bf16(b0, qr[d0], p0, 0, 0, 0); p1 = __builtin_amdgcn_mfma_f32_32x32x16_bf16(b1, qr[d0], p1, 0, 0, 0); }
            if (needmask) { const int qrel = qrel0 + r32;
#pragma unroll
                for (int r = 0; r < 16; ++r) { const int kv = krel + crow(r, hi); if (kv > qrel) p0[r] = -INFINITY; if (kv + 32 > qrel) p1[r] = -INFINITY; } }
            float rm;
            { float a_ = max3f(p0[0], p0[1], p1[0]), b_ = max3f(p0[2], p0[3], p1[1]); a_ = max3f(a_, p1[2], p1[3]);
#pragma unroll
              for (int r = 4; r < 16; r += 4) { a_ = max3f(a_, p0[r], p0[r + 1]); b_ = max3f(b_, p0[r + 2], p0[r + 3]); a_ = max3f(a_, p1[r], p1[r + 1]); b_ = max3f(b_, p1[r + 2], p1[r + 3]); }
              rm = halves_max(fmaxf(a_, b_)); }
            if (__any(rm > THR)) {
                const float dl = fmaxf(rm, 0.f); mref += dl; const float alpha = __builtin_amdgcn_exp2f(-dl);
#pragma unroll
                for (int r = 0; r < 16; ++r) { p0[r] -= dl; p1[r] -= dl; }
                l *= alpha;
                if (hi == 0) wsf[r32] = alpha;
                asm volatile("s_waitcnt lgkmcnt(0)" ::: "memory");
#pragma unroll
                for (int gq = 0; gq < 4; ++gq) { const f32x4 f = *(const LAS f32x4*)(wsf + 8 * gq + 4 * hi);
#pragma unroll
                    for (int d0 = 0; d0 < DVB; ++d0) { o[d0][4 * gq + 0] *= f[0]; o[d0][4 * gq + 1] *= f[1]; o[d0][4 * gq + 2] *= f[2]; o[d0][4 * gq + 3] *= f[3]; } }
            }
            float sacc = 0.f;
#pragma unroll
            for (int r = 0; r < 16; ++r) { p0[r] = __builtin_amdgcn_exp2f(p0[r]); p1[r] = __builtin_amdgcn_exp2f(p1[r]); sacc += p0[r] + p1[r]; }
            l += sacc;
            u32x4 pw[4];
            pw[0] = (u32x4){cvtpk(p0[0], p0[1]), cvtpk(p0[2], p0[3]), cvtpk(p0[4], p0[5]), cvtpk(p0[6], p0[7])};
            pw[1] = (u32x4){cvtpk(p0[8], p0[9]), cvtpk(p0[10], p0[11]), cvtpk(p0[12], p0[13]), cvtpk(p0[14], p0[15])};
            pw[2] = (u32x4){cvtpk(p1[0], p1[1]), cvtpk(p1[2], p1[3]), cvtpk(p1[4], p1[5]), cvtpk(p1[6], p1[7])};
            pw[3] = (u32x4){cvtpk(p1[8], p1[9]), cvtpk(p1[10], p1[11]), cvtpk(p1[12], p1[13]), cvtpk(p1[14], p1[15])};
#pragma unroll
            for (int d0 = 0; d0 < DVB; ++d0)
#pragma unroll
                for (int ks = 0; ks < 4; ++ks) { const s16x4 vlo = vtr(Vs + d0 * 4096 + ks * 1024), vhi = vtr(Vs + d0 * 4096 + ks * 1024 + 512);
                    const bf16x8 vf = (bf16x8){vlo[0], vlo[1], vlo[2], vlo[3], vhi[0], vhi[1], vhi[2], vhi[3]};
                    o[d0] = __builtin_amdgcn_mfma_f32_32x32x16_bf16(__builtin_bit_cast(bf16x8, pw[ks]), vf, o[d0], 0, 0, 0); }
        }
    }
    l = halves_sum(l);
    if (hi == 0) wsf[32 + r32] = l;
    asm volatile("s_waitcnt lgkmcnt(0)" ::: "memory");
    float rli[16];
#pragma unroll
    for (int gq = 0; gq < 4; ++gq) { const f32x4 f = *(const LAS f32x4*)(wsf + 32 + 8 * gq + 4 * hi); rli[4 * gq + 0] = 1.0f / f[0]; rli[4 * gq + 1] = 1.0f / f[1]; rli[4 * gq + 2] = 1.0f / f[2]; rli[4 * gq + 3] = 1.0f / f[3]; }
    if constexpr (MODE == 1) {
        GAS bf16_t* Ow = (GAS bf16_t*)(A.O + (rowbase + q0 + qrel0) * PITCH + hcol);
#pragma unroll
        for (int r = 0; r < 16; ++r)
#pragma unroll
            for (int d0 = 0; d0 < DVB; ++d0) Ow[(size_t)crow(r, hi) * PITCH + d0 * 32 + r32] = (bf16_t)(cvtpk(o[d0][r] * rli[r], 0.f) & 0xFFFFu);
    } else {
        ATT_BAR();
        LAS float* X = (LAS float*)lds + wq * 4096;
        if (comp == 1) {
#pragma unroll
            for (int d0 = 0; d0 < DVB; ++d0)
#pragma unroll
                for (int r = 0; r < 16; ++r) X[(d0 * 16 + r) * 64 + lane] = o[d0][r] * rli[r];
        }
        ATT_BAR();
        if (comp == 0) {
            float sg[DVB];
#pragma unroll
            for (int d0 = 0; d0 < DVB; ++d0) sg[d0] = ((const GAS float*)A.subln)[d0 * 32 + r32] * A.out_scale;
            GAS bf16_t* Ow = (GAS bf16_t*)(A.O + (rowbase + q0 + qrel0) * PITCH + hcol);
#pragma unroll
            for (int r = 0; r < 16; ++r) { float dv[DVB]; float ss = 0.f;
#pragma unroll
                for (int d0 = 0; d0 < DVB; ++d0) { dv[d0] = o[d0][r] * rli[r] - A.lam_full * X[(d0 * 16 + r) * 64 + lane]; ss += dv[d0] * dv[d0]; }
                ss += __shfl_xor(ss, 1); ss += __shfl_xor(ss, 2); ss += __shfl_xor(ss, 4); ss += __shfl_xor(ss, 8); ss += __shfl_xor(ss, 16);
                const float rs = 1.0f / sqrtf(ss * (1.0f / 128.0f) + 1e-5f);
#pragma unroll
                for (int d0 = 0; d0 < DVB; ++d0) Ow[(size_t)crow(r, hi) * PITCH + d0 * 32 + r32] = (bf16_t)(cvtpk(dv[d0] * rs * sg[d0], 0.f) & 0xFFFFu); }
        }
    }
#undef ATT_KBASE
#undef ATT_ISSUE
}
#undef ATT_BAR
}

constexpr int NWAVES = 8;
#ifndef MK_PER_PHASE
#define MK_PER_PHASE 1
#endif
#ifndef MK_DEBUG
#define MK_DEBUG 1
#endif
constexpr int NLAYER = 4, PH_PER_LAYER = 8, NPHASE = 1 + NLAYER * PH_PER_LAYER;

constexpr size_t MiB = 1u << 20;
constexpr size_t WS_CTL = 0, CTL_ZERO_BYTES = 1 * MiB;
constexpr size_t WS_KMEAN = 1 * MiB;
constexpr size_t WS_LTOK = 2 * MiB, WS_LW = 3 * MiB;
constexpr size_t WS_DQKV = 5 * MiB;
constexpr size_t WS_DWO = WS_DQKV + 12 * MiB;
constexpr size_t WS_MQKV = WS_DWO + 4 * MiB;
constexpr size_t WS_MWO = WS_MQKV + 12 * MiB;
constexpr size_t WS_FGU = WS_MWO + 4 * MiB;
constexpr size_t WS_FD = WS_FGU + 22 * MiB;
constexpr size_t WS_MGU = WS_FD + 11 * MiB;
constexpr size_t WS_MD = WS_MGU + 112 * MiB;
constexpr size_t WS_XN = WS_MD + 56 * MiB;
constexpr size_t WS_Q = WS_XN + 64 * MiB, WS_K = WS_Q + 64 * MiB, WS_V = WS_K + 64 * MiB;
constexpr size_t WS_ACT = WS_Q;
constexpr size_t WS_END = WS_ACT + (size_t)MOE_TILES_MAX * 256 * DE * 2;
static_assert(WS_XN == 238 * MiB && WS_END == 778 * MiB, "d_ws map");
constexpr int CW_BAR = 4096;
constexpr int CW_CNT = 8192;

constexpr int RING_OFF = 0, RING_BYTES = 131072;
constexpr int LDSCTL_OFF = RING_BYTES, MISC_OFF = LDSCTL_OFF + 320;
constexpr int XSLOT_OFF = MISC_OFF + 128;
constexpr int LDS_BYTES = 147456;

typedef unsigned short bf16;
typedef unsigned v4u __attribute__((ext_vector_type(4)));
typedef float f32x4 __attribute__((ext_vector_type(4)));
typedef GAS unsigned gu32;
#define RLX_AGENT __ATOMIC_RELAXED, __HIP_MEMORY_SCOPE_AGENT
#define LDS_WAIT() asm volatile("s_waitcnt lgkmcnt(0)" ::: "memory")
#define VM_WAIT() asm volatile("s_waitcnt vmcnt(0)" ::: "memory")
__device__ __forceinline__ unsigned f2bf(float f) { unsigned u = __builtin_bit_cast(unsigned, f); return (u + 0x7fffu + ((u >> 16) & 1u)) >> 16; }
__device__ __forceinline__ unsigned pk2(float lo, float hi) { return f2bf(lo) | (f2bf(hi) << 16); }
__device__ __forceinline__ float bflo(unsigned w) { return __uint_as_float(w << 16); }
__device__ __forceinline__ float bfhi(unsigned w) { return __uint_as_float(w & 0xFFFF0000u); }
static_assert(XSLOT_OFF % 16 == 0 && XSLOT_OFF + 8192 <= LDS_BYTES, "LDS map");
#define XB_TMO      128
#define XB_XCNT(j)  (256  + 64 * (j))
#define XB_XSUB(j)  (1280 + 64 * (j))
#define XB_XGEN(j)  (2304 + 64 * (j))
#define XB_TOP      3328
#define XB_TOPGEN   3392
#define XCD_BAR_WORDS 3456
#define XB_SPIN_CAP (1u << 18)

__device__ __forceinline__ unsigned xb_ld(unsigned* p)              { return __hip_atomic_load(p, __ATOMIC_RELAXED, __HIP_MEMORY_SCOPE_AGENT); }
__device__ __forceinline__ unsigned xb_add(unsigned* p, unsigned v) { return __hip_atomic_fetch_add(p, v, __ATOMIC_RELAXED, __HIP_MEMORY_SCOPE_AGENT); }
__device__ __forceinline__ unsigned xb_xcc_id() { return (unsigned)__builtin_amdgcn_s_getreg((3 << 11) | 20) & 0xFu; }
#define XB_SPIN(cond, bar) do { unsigned _sp = 0; while (cond) { __builtin_amdgcn_s_sleep(1); \
    if ((++_sp & 255u) == 0u) { if (xb_ld(&(bar)[XB_TMO])) break; if (_sp > XB_SPIN_CAP) { atomicAdd(&(bar)[XB_TMO], 1u); break; } } } } while (0)

struct XcdBarrier {
    unsigned* bar; unsigned x;
    volatile LAS unsigned* st;
};

__device__ __forceinline__ XcdBarrier xcd_barrier_post(unsigned* bar, volatile LAS unsigned* st) {
    XcdBarrier b; b.bar = bar; b.x = xb_xcc_id(); b.st = st;
    if (threadIdx.x == 0) (void)xb_add(&bar[XB_XCNT(b.x)], 1u);
    return b;
}
__device__ __forceinline__ void xcd_barrier_complete(unsigned* bar, unsigned x, unsigned& nloc, unsigned& nx) {
    const unsigned G = gridDim.x * gridDim.y * gridDim.z;
    unsigned sum, cnt, mine, sp = 0u;
    for (;;) {
        sum = 0u; cnt = 0u; mine = 0u;
#pragma unroll
        for (unsigned j = 0; j < 16; ++j) { const unsigned c = xb_ld(&bar[XB_XCNT(j)]); sum += c; cnt += (c > 0u) ? 1u : 0u; mine = (j == x) ? c : mine; }
        if (sum == G) break;
        __builtin_amdgcn_s_sleep(1);
        if ((++sp & 255u) == 0u) { if (xb_ld(&bar[XB_TMO])) break; if (sp > XB_SPIN_CAP) { atomicAdd(&bar[XB_TMO], 1u); break; } }
    }
    nloc = mine > 0u ? mine : 1u; nx = cnt > 0u ? cnt : 1u;
}

__device__ __forceinline__ void xcd_barrier(const XcdBarrier& b) {
    asm volatile("s_waitcnt vmcnt(0)" ::: "memory");
    __syncthreads();
    if (threadIdx.x == 0) {
        unsigned* bar = b.bar;
        __builtin_amdgcn_s_waitcnt(0);
        unsigned nloc = b.st[0], nx = b.st[1];
        if (nloc == 0u) { xcd_barrier_complete(bar, b.x, nloc, nx); b.st[0] = nloc; b.st[1] = nx; }
        const unsigned old = xb_add(&bar[XB_XSUB(b.x)], 1u);
        const unsigned gen = old / nloc;
        if (old + 1u == (gen + 1u) * nloc) {
            __builtin_amdgcn_fence(__ATOMIC_RELEASE, "agent");
            asm volatile("s_waitcnt vmcnt(0)" ::: "memory");
            const unsigned og = xb_add(&bar[XB_TOP], 1u);
            const unsigned tg = og / nx;
            if (og + 1u == (tg + 1u) * nx) xb_add(&bar[XB_TOPGEN], 1u);
            else XB_SPIN(xb_ld(&bar[XB_TOPGEN]) == tg, bar);
            __builtin_amdgcn_fence(__ATOMIC_ACQUIRE, "agent");
            xb_add(&bar[XB_XGEN(b.x)], 1u);
            asm volatile("s_waitcnt vmcnt(0)" ::: "memory");
        } else {
            XB_SPIN(xb_ld(&bar[XB_XGEN(b.x)]) == gen, bar);
            __builtin_amdgcn_fence(__ATOMIC_ACQUIRE, "agent");
            asm volatile("s_waitcnt vmcnt(0)" ::: "memory");
        }
    }
    __syncthreads();
}

struct Frame {
    LAS unsigned char* lds;
    volatile LAS unsigned* MISC;
    gu32* ctl;
    int tid, lane, wave;
    int vcu, G;
};
__device__ __forceinline__ float wave_sum(float v) {
#pragma unroll
    for (int o = 1; o < 64; o <<= 1) v += __shfl_xor(v, o);
    return v;
}
__device__ __forceinline__ void transpose_item(const float* W, int K, int N, bf16* WT, int k0, int n0, int drow0, LAS float* scr, int lane) {
#pragma unroll 8
    for (int i = 0; i < 32; ++i) { const int kk = 2 * i + (lane >> 5); scr[kk * 33 + (lane & 31)] = ((const GAS float*)W)[(size_t)(k0 + kk) * N + n0 + (lane & 31)]; }
    LDS_WAIT(); asm volatile("" ::: "memory");
    const int c = lane & 7;
#pragma unroll
    for (int j = 0; j < 4; ++j) { const int n = (lane >> 3) + 8 * j; const LAS float* s = scr + (8 * c) * 33 + n;
        v4u o; o.x = pk2(s[0 * 33], s[1 * 33]); o.y = pk2(s[2 * 33], s[3 * 33]); o.z = pk2(s[4 * 33], s[5 * 33]); o.w = pk2(s[6 * 33], s[7 * 33]);
        *(GAS v4u*)(WT + (size_t)(drow0 + n) * K + k0 + 8 * c) = o; }
    LDS_WAIT(); asm volatile("" ::: "memory");
}
__device__ __forceinline__ void convert_matrix(Frame& F, const float* W, int K, int N, bf16* WT, int il, unsigned& rot) {
    LAS float* scr = (LAS float*)(F.lds + RING_OFF + F.wave * 16384);
    const unsigned gw = (unsigned)(F.vcu * NWAVES + F.wave), NGW = (unsigned)(F.G * NWAVES);
    const int nblk = N / 32, nitems = (K / 64) * nblk; int lane_ = F.lane; asm volatile("" : "+v"(lane_));
    for (int it = (int)((gw + NGW - rot % NGW) % NGW); it < nitems; it += (int)NGW) {
        const int kb = it / nblk, nb = it % nblk, n0 = 32 * nb;
        const int drow0 = il == 0 ? n0 : (n0 / 128) * 256 + (il - 1) * 128 + (n0 % 128);
        transpose_item(W, K, N, WT, 64 * kb, n0, drow0, scr, lane_);
    }
    rot = (rot + (unsigned)nitems) % NGW;
}

struct RouterArgs { const float* router; gu32* cnt; unsigned* ltok; float* lw; };
template <int MODE>
__device__ __forceinline__ void norm_phase(Frame& F, const float* src, float* hout, const bf16* y1, const float* gain, bf16* xn, float* fout, const RouterArgs& R) {
    int lane_ = F.lane; asm volatile("" : "+v"(lane_));
    const int gw = F.vcu * NWAVES + F.wave, NGW = F.G * NWAVES, lane = lane_;
    f32x4 gv[4];
#pragma unroll
    for (int j = 0; j < 4; ++j) gv[j] = *(const GAS f32x4*)(gain + 256 * j + 4 * lane);
    LAS float* RL = (LAS float*)(F.lds + RING_OFF);
    if constexpr (MODE == 2) {
        for (int i = F.tid; i < 8192; i += NWAVES * 64) RL[(i & 7) * 1024 + (i >> 3)] = ((const GAS float*)R.router)[i];
        LDS_WAIT(); __syncthreads();
    }
    const int nrows_w = gw < MTOK ? (MTOK - gw + NGW - 1) / NGW : 0;
    for (int cb = 0; cb < nrows_w; cb += 64) {
        int my_t = 0, my_e0 = 0, my_e1 = 0; float my_w0 = 0.f, my_w1 = 0.f; bool valid = false;
        const int cn = (nrows_w - cb) < 64 ? (nrows_w - cb) : 64;
        for (int i = 0; i < cn; ++i) {
            const int row = gw + (cb + i) * NGW;
            const GAS f32x4* xr = (const GAS f32x4*)(src + (size_t)row * D) + lane;
            f32x4 v[4]; float s = 0.f;
#pragma unroll
            for (int j = 0; j < 4; ++j) v[j] = xr[64 * j];
            if constexpr (MODE == 1 || MODE == 3) {
                const GAS unsigned long long* yr = (const GAS unsigned long long*)(y1 + (size_t)row * D) + lane;
#pragma unroll
                for (int j = 0; j < 4; ++j) { const unsigned long long w = yr[64 * j]; const unsigned lo = (unsigned)w, hi = (unsigned)(w >> 32);
                    v[j].x += bflo(lo); v[j].y += bfhi(lo); v[j].z += bflo(hi); v[j].w += bfhi(hi); }
            }
#pragma unroll
            for (int j = 0; j < 4; ++j) s += (v[j].x * v[j].x + v[j].y * v[j].y) + (v[j].z * v[j].z + v[j].w * v[j].w);
            if constexpr (MODE == 1) { GAS f32x4* hr = (GAS f32x4*)(hout + (size_t)row * D) + lane;
#pragma unroll
                for (int j = 0; j < 4; ++j) hr[64 * j] = v[j]; }
            const float rstd = 1.f / sqrtf(wave_sum(s) * (1.f / D) + 1e-6f);
#pragma unroll
            for (int j = 0; j < 4; ++j) v[j] = v[j] * rstd * gv[j];
            if constexpr (MODE == 3) { GAS f32x4* orow = (GAS f32x4*)(fout + (size_t)row * D) + lane;
#pragma unroll
                for (int j = 0; j < 4; ++j) orow[64 * j] = v[j];
            } else {
                GAS unsigned long long* o8 = (GAS unsigned long long*)(xn + (size_t)row * D) + lane;
#pragma unroll
                for (int j = 0; j < 4; ++j) o8[64 * j] = (unsigned long long)pk2(v[j].x, v[j].y) | ((unsigned long long)pk2(v[j].z, v[j].w) << 32);
            }
            if constexpr (MODE == 2) {
                float lg[NE];
#pragma unroll
                for (int e = 0; e < NE; ++e) { float a = 0.f;
#pragma unroll
                    for (int j = 0; j < 4; ++j) { const f32x4 rr = *(const LAS f32x4*)(RL + e * 1024 + 256 * j + 4 * lane); a += (v[j].x * rr.x + v[j].y * rr.y) + (v[j].z * rr.z + v[j].w * rr.w); }
                    lg[e] = wave_sum(a); }
                int e0 = 0; float v0 = lg[0];
#pragma unroll
                for (int e = 1; e < NE; ++e) if (lg[e] > v0) { v0 = lg[e]; e0 = e; }
                int e1 = -1; float v1 = 0.f;
#pragma unroll
                for (int e = 0; e < NE; ++e) if (e != e0 && (e1 < 0 || lg[e] > v1)) { v1 = lg[e]; e1 = e; }
                const float w0 = 1.f / (1.f + __expf(v1 - v0));
                if (lane == i) { my_t = row; my_e0 = e0; my_e1 = e1; my_w0 = w0; my_w1 = 1.f - w0; valid = true; }
            }
        }
        if constexpr (MODE == 2) {
            unsigned myc = 0u;
#pragma unroll
            for (int e = 0; e < NE; ++e) { const unsigned long long b0 = __ballot(valid && my_e0 == e), b1 = __ballot(valid && my_e1 == e);
                const unsigned c = (unsigned)(__popcll(b0) + __popcll(b1)); if (lane == e) myc = c; }
            unsigned basev = 0u;
            if (lane < NE) basev = __hip_atomic_fetch_add(R.cnt + 64 * lane, myc, RLX_AGENT);
            const unsigned long long lt = (1ull << lane) - 1ull;
            unsigned pos0 = 0u, pos1 = 0u;
#pragma unroll
            for (int e = 0; e < NE; ++e) { const unsigned long long b0 = __ballot(valid && my_e0 == e), b1 = __ballot(valid && my_e1 == e);
                const unsigned be = (unsigned)__shfl((int)basev, e);
                if (my_e0 == e) pos0 = be + (unsigned)__popcll(b0 & lt);
                if (my_e1 == e) pos1 = be + (unsigned)__popcll(b0) + (unsigned)__popcll(b1 & lt); }
            if (valid) {
                ((GAS unsigned*)R.ltok)[(size_t)my_e0 * LIST_CAP + pos0] = (unsigned)my_t;             ((GAS float*)R.lw)[(size_t)my_e0 * LIST_CAP + pos0] = my_w0;
                ((GAS unsigned*)R.ltok)[(size_t)my_e1 * LIST_CAP + pos1] = (unsigned)my_t | (1u << 20); ((GAS float*)R.lw)[(size_t)my_e1 * LIST_CAP + pos1] = my_w1;
            }
        }
    }
    if constexpr (MODE == 2) { LDS_WAIT(); __syncthreads(); }
}

__device__ __forceinline__ void kmean_phase(Frame& F, const bf16* Kt, float* kmean) {
    int lane_ = F.lane; asm volatile("" : "+v"(lane_));
    const int gw = F.vcu * NWAVES + F.wave, NGW = F.G * NWAVES, lane = lane_;
    for (int task = gw; task < BATCH * 16 * 8; task += NGW) {
        const int c8 = task & 7, n = (task >> 3) & 15, b = task >> 7;
        const GAS unsigned* p = (const GAS unsigned*)(Kt + ((size_t)b * SEQ + 256 * n) * D + c8 * 128) + lane;
        float a0 = 0.f, a1 = 0.f;
#pragma unroll 8
        for (int r = 0; r < 256; ++r) { const unsigned w = p[(size_t)r * (D / 2)]; a0 += bflo(w); a1 += bfhi(w); }
        const int col = c8 * 128 + 2 * lane, hh = col >> 6, d = col & 63;
        GAS float* o = (GAS float*)(kmean + ((size_t)(b * 16 + hh) * 16 + n) * 64 + d);
        o[0] = a0 * (1.f / 256.f); o[1] = a1 * (1.f / 256.f);
    }
}

struct KArgs { const float* in[17]; float* out; unsigned char* ws; int ph_lo, ph_hi; };
__global__ void __launch_bounds__(NWAVES * 64, 2) trunk_fwd(KArgs args) {
    extern __shared__ __attribute__((aligned(16))) unsigned char lds[];
    Frame F;
    F.lds = (LAS unsigned char*)lds;
    F.MISC = (volatile LAS unsigned*)(F.lds + MISC_OFF);
    F.tid = threadIdx.x; F.lane = F.tid & 63; F.wave = __builtin_amdgcn_readfirstlane(F.tid >> 6);
    F.G = gridDim.x; { const int bx = blockIdx.x; F.vcu = (F.G % 8 == 0) ? (bx % 8) * (F.G / 8) + bx / 8 : bx; }
    F.ctl = (gu32*)(args.ws + WS_CTL);
    for (int u = F.tid; u < (LDS_BYTES - LDSCTL_OFF) / 4; u += NWAVES * 64) ((LAS unsigned*)(F.lds + LDSCTL_OFF))[u] = 0u;
    __syncthreads();
    Frame& F0 = F;
    const int lo = args.ph_lo, hi = args.ph_hi;
    XcdBarrier bar; bar.bar = (unsigned*)(F.ctl + CW_BAR); bar.x = 0; bar.st = nullptr;
    if (hi - lo > 1) bar = xcd_barrier_post((unsigned*)(F.ctl + CW_BAR), F.MISC + 8);
#define IN(k) (lo <= (k) && (k) < hi)
#ifndef PH_ENABLE
#define PH_ENABLE 0xFFFFFFFFu
#endif
#define PHEN(n) (((PH_ENABLE) >> (n)) & 1u)
#ifndef MK_DOUBLE
#define MK_DOUBLE 0u
#endif
#define NREP(n) ((((MK_DOUBLE) >> (n)) & 1u) ? 2 : 1)
#if defined(NO_OPQ)
#define OPQ(p) do {} while (0)
#else
#define OPQ(p) asm volatile("" : "+s"(p))
#endif
#if 0
#define STAMP(k) do { if (blockIdx.x == 0 && threadIdx.x == 0) { const unsigned long long t_ = __builtin_amdgcn_s_memrealtime(); ((GAS unsigned*)(F0.ctl))[3000 + (k)] = (unsigned)t_; } } while (0)
#else
#define STAMP(k) do {} while (0)
#endif
#define SEAM(k) do { if (IN(k) && IN((k) + 1)) { XcdBarrier b2_ = bar; OPQ(b2_.bar); xcd_barrier(b2_); } STAMP((k) + 1); } while (0)

#define PTRS() unsigned char* ws = args.ws; OPQ(ws); const float* x = args.in[0]; OPQ(x); const float* norm_mix = args.in[1]; OPQ(norm_mix); const float* norm_ffn = args.in[2]; OPQ(norm_ffn); \
    float* h = args.out; OPQ(h); \
    bf16* XN = (bf16*)(ws + WS_XN); bf16* Qb = (bf16*)(ws + WS_Q); bf16* Kb = (bf16*)(ws + WS_K); bf16* Vb = (bf16*)(ws + WS_V); bf16* ACT = (bf16*)(ws + WS_ACT); \
    bf16* MGU = (bf16*)(ws + WS_MGU); bf16* MD = (bf16*)(ws + WS_MD); \
    float* kmean = (float*)(ws + WS_KMEAN); unsigned* ltok = (unsigned*)(ws + WS_LTOK); float* lw = (float*)(ws + WS_LW); \
    (void)x; (void)norm_mix; (void)norm_ffn; (void)h; (void)XN; (void)Qb; (void)Kb; (void)Vb; (void)ACT; (void)MGU; (void)MD; (void)kmean; (void)ltok; (void)lw
    const RouterArgs noR{nullptr, nullptr, nullptr, nullptr};
    constexpr float C2 = 0.125f * 1.4426950408889634f;

    STAMP(0);
    if (PHEN(0) && IN(0)) {
        PTRS();
        unsigned rot = 0u;
        for (int j = 0; j < 2; ++j) {
            convert_matrix(F, args.in[3] + (size_t)j * D * 3 * D, D, 3 * D, (bf16*)(ws + WS_DQKV) + (size_t)j * 3 * D * D, 0, rot);
            convert_matrix(F, args.in[4] + (size_t)j * D * D, D, D, (bf16*)(ws + WS_DWO) + (size_t)j * D * D, 0, rot);
            convert_matrix(F, args.in[7] + (size_t)j * D * 3 * D, D, 3 * D, (bf16*)(ws + WS_MQKV) + (size_t)j * 3 * D * D, 0, rot);
            convert_matrix(F, args.in[8] + (size_t)j * D * D, D, D, (bf16*)(ws + WS_MWO) + (size_t)j * D * D, 0, rot);
            convert_matrix(F, args.in[9] + (size_t)j * D * DFF, D, DFF, (bf16*)(ws + WS_FGU) + (size_t)j * 2 * DFF * D, 1, rot);
            convert_matrix(F, args.in[10] + (size_t)j * D * DFF, D, DFF, (bf16*)(ws + WS_FGU) + (size_t)j * 2 * DFF * D, 2, rot);
            convert_matrix(F, args.in[11] + (size_t)j * DFF * D, DFF, D, (bf16*)(ws + WS_FD) + (size_t)j * D * DFF, 0, rot);
        }
        for (int e = 0; e < NE; ++e) {
            convert_matrix(F, args.in[13] + (size_t)e * D * DE, D, DE, MGU + (size_t)e * 2 * DE * D, 1, rot);
            convert_matrix(F, args.in[14] + (size_t)e * D * DE, D, DE, MGU + (size_t)e * 2 * DE * D, 2, rot);
            convert_matrix(F, args.in[15] + (size_t)e * DE * D, DE, D, MD + (size_t)e * D * DE, 0, rot);
        }
        norm_phase<0>(F, x, nullptr, nullptr, norm_mix, XN, nullptr, noR);
    }
    SEAM(0);

    for (int L = 0; L < NLAYER; ++L) {
        const int j = L >> 1, moba = L & 1, pb = 1 + PH_PER_LAYER * L;
        int z_ = 0;
#if !defined(NO_OPQ_Z)
        asm volatile("" : "+s"(z_));
#endif
        Frame Fl = F0; Fl.G += z_; Fl.vcu += z_; Fl.wave += z_; Fl.lds += z_; Fl.ctl += z_; const int bx = (int)blockIdx.x + z_;
#define F Fl
        if (PHEN(1) && IN(pb + 0)) {
            PTRS();

            const bf16* W = (const bf16*)(ws + (moba ? WS_MQKV : WS_DQKV)) + (size_t)j * 3 * D * D;
            pg8::Gemm g{XN, W, D, 0, (unsigned)((size_t)MTOK * D * 2 - 16), (unsigned*)F.ctl + 2048, (size_t)3 * D * D * 2}; pg8::StaticOrder S; S.init(MTOK, 3 * D, F.G, bx);
            pg8::EpiQKV E{Qb, D, D, (size_t)(WS_K - WS_Q) / 2, C2, (unsigned*)F.ctl + 2048};
            for (int rep_ = 0; rep_ < NREP(1); ++rep_) pg8::gemm_phase<pg8::EpiQKV, pg8::StaticOrder>(F.lds + RING_OFF, XSLOT_OFF, g, S, E);
        }
        SEAM(pb + 0);
        if (moba) { if (PHEN(2) && IN(pb + 1)) { PTRS(); kmean_phase(F, Kb, kmean); } SEAM(pb + 1); } else { STAMP(pb + 2); }
        if (IN(pb + 2)) {
            PTRS();
            att::Args A; A.Q = Qb; A.K = Kb; A.V = Vb; A.O = XN; A.kmean = kmean; A.subln = args.in[6] + (size_t)j * 128; A.lam_full = 0.f; A.out_scale = 1.f;
            const int PPC = (1024 + F.G - 1) / F.G;
            if (PHEN(3) && !moba) {
                const float* lam = args.in[5] + (size_t)j * 256; const int lane = F.lane;
                const GAS float* lamg = (const GAS float*)lam; const float s1 = wave_sum(lamg[lane] * lamg[64 + lane]), s2 = wave_sum(lamg[128 + lane] * lamg[192 + lane]);
                const float lam_init = 0.8f - 0.6f * __expf(-0.3f * (float)L);
                A.lam_full = __expf(s1) - __expf(s2) + lam_init; A.out_scale = 1.0f - lam_init;
                for (int rep_ = 0; rep_ < NREP(3); ++rep_) for (int i = 0; i < PPC; ++i) { const int P = F.vcu * PPC + i; if (P >= 1024) break; const int bh = P >> 4, pr = P & 15;
                    att::attn_unit<0>(F.lds + RING_OFF, A, bh >> 3, bh & 7, pr);
                    att::attn_unit<0>(F.lds + RING_OFF, A, bh >> 3, bh & 7, 31 - pr); }
            } else if (PHEN(4) && moba) {
                for (int rep_ = 0; rep_ < NREP(4); ++rep_) for (int i = 0; i < PPC; ++i) { const int P = F.vcu * PPC + i; if (P >= 1024) break; const int bh = P >> 3, pr = P & 7;
                    att::attn_unit<1>(F.lds + RING_OFF, A, bh >> 4, bh & 15, pr);
                    att::attn_unit<1>(F.lds + RING_OFF, A, bh >> 4, bh & 15, 15 - pr); }
            }
            asm volatile("s_waitcnt vmcnt(0) lgkmcnt(0)\n\ts_barrier" ::: "memory");
        }
        SEAM(pb + 2);
        if (PHEN(5) && IN(pb + 3)) {
            PTRS();
            const bf16* W = (const bf16*)(ws + (moba ? WS_MWO : WS_DWO)) + (size_t)j * D * D;
            pg8::Gemm g{XN, W, D, 0, (unsigned)((size_t)MTOK * D * 2 - 16), (unsigned*)F.ctl + 2048, (size_t)D * D * 2}; pg8::StaticOrder S; S.init(MTOK, D, F.G, bx);
            pg8::EpiRes E{L == 0 ? x : h, h, D};
            pg8::gemm_phase<pg8::EpiRes, pg8::StaticOrder>(F.lds + RING_OFF, XSLOT_OFF, g, S, E);
        }
        SEAM(pb + 3);
        if (PHEN(6) && IN(pb + 4)) {
            PTRS();
            if (!moba) {
                norm_phase<0>(F, h, nullptr, nullptr, norm_ffn + (size_t)L * D, XN, nullptr, noR);
                if (L == 2) { unsigned rot = 0u;
                    for (int e = 0; e < NE; ++e) {
                        convert_matrix(F, args.in[13] + (size_t)(NE + e) * D * DE, D, DE, MGU + (size_t)e * 2 * DE * D, 1, rot);
                        convert_matrix(F, args.in[14] + (size_t)(NE + e) * D * DE, D, DE, MGU + (size_t)e * 2 * DE * D, 2, rot);
                        convert_matrix(F, args.in[15] + (size_t)(NE + e) * DE * D, DE, D, MD + (size_t)e * D * DE, 0, rot);
                    } }
            } else {
                const RouterArgs R{args.in[12] + (size_t)j * D * NE, F.ctl + CW_CNT + 64 * NE * j, ltok, lw};
                norm_phase<2>(F, h, nullptr, nullptr, norm_ffn + (size_t)L * D, XN, nullptr, R);
            }
        }
        SEAM(pb + 4);
        if (IN(pb + 5)) {
            PTRS();
            if (PHEN(7) && !moba) {
                pg8::Gemm g{XN, (const bf16*)(ws + WS_FGU) + (size_t)j * 2 * DFF * D, D, 0, (unsigned)((size_t)MTOK * D * 2 - 16), (unsigned*)F.ctl + 2048, (size_t)2 * DFF * D * 2}; pg8::StaticOrder S; S.init(MTOK, 2 * DFF, F.G, bx);
                pg8::EpiSwiGLU E{ACT, DFF};
                for (int rep_ = 0; rep_ < NREP(7); ++rep_) pg8::gemm_phase<pg8::EpiSwiGLU, pg8::StaticOrder>(F.lds + RING_OFF, XSLOT_OFF, g, S, E);
            } else if (PHEN(8) && moba) {
                pg8::Gemm g{XN, MGU, D, (size_t)2 * DE * D, (unsigned)((size_t)MTOK * D * 2 - 16), (unsigned*)F.ctl + 2048, (size_t)NE * 2 * DE * D * 2}; pg8::MoeOrder S; S.init((const unsigned*)(F.ctl + CW_CNT + 64 * NE * j), ltok, true, 2 * DE, F.G, bx);
                pg8::EpiSwiGLU E{ACT, DE};
                for (int rep_ = 0; rep_ < NREP(8); ++rep_) pg8::gemm_phase<pg8::EpiSwiGLU, pg8::MoeOrder>(F.lds + RING_OFF, XSLOT_OFF, g, S, E);
            }
        }
        SEAM(pb + 5);
        if (IN(pb + 6)) {
            PTRS();
            if (PHEN(9) && !moba) {
                pg8::Gemm g{ACT, (const bf16*)(ws + WS_FD) + (size_t)j * D * DFF, DFF, 0, (unsigned)((size_t)MTOK * DFF * 2 - 16), (unsigned*)F.ctl + 2048, (size_t)D * DFF * 2}; pg8::StaticOrder S; S.init(MTOK, D, F.G, bx);
                pg8::EpiRes E{h, h, D};
                pg8::gemm_phase<pg8::EpiRes, pg8::StaticOrder>(F.lds + RING_OFF, XSLOT_OFF, g, S, E);
            } else if (PHEN(10) && moba) {
                pg8::Gemm g{ACT, MD, DE, (size_t)D * DE, (unsigned)((size_t)MOE_TILES_MAX * 256 * DE * 2 - 16), (unsigned*)F.ctl + 2048, (size_t)NE * D * DE * 2}; pg8::MoeOrder S; S.init((const unsigned*)(F.ctl + CW_CNT + 64 * NE * j), ltok, false, D, F.G, bx);
                pg8::EpiMoeDown E; E.h = h; E.y1 = XN; E.list_tok = ltok; E.list_w = lw;
#pragma unroll
                for (int e = 0; e < NE; ++e) E.cnt[e] = S.cnt[e];
                pg8::gemm_phase<pg8::EpiMoeDown, pg8::MoeOrder>(F.lds + RING_OFF, XSLOT_OFF, g, S, E);
            }
        }
        SEAM(pb + 6);
        if (PHEN(11) && IN(pb + 7)) {
            PTRS();
            if (L == 3) norm_phase<3>(F, h, nullptr, XN, args.in[16], nullptr, h, noR);
            else if (moba) norm_phase<1>(F, h, h, XN, norm_mix + (size_t)(L + 1) * D, XN, nullptr, noR);
            else norm_phase<0>(F, h, nullptr, nullptr, norm_mix + (size_t)(L + 1) * D, XN, nullptr, noR);
        }
        if (L != NLAYER - 1) SEAM(pb + 7); else STAMP(pb + 8);
#undef F
    }
#undef IN
#undef SEAM
#undef PTRS
#undef OPQ
}


#if MK_DEBUG
__global__ void dbg_probe(const void* buf, size_t n, int is_bf16, int idx, float thresh, unsigned* dbg) {
    size_t i = blockIdx.x * (size_t)blockDim.x + threadIdx.x, stride = (size_t)gridDim.x * blockDim.x; bool bad = false;
    for (size_t k = i; k < n; k += stride) { float v = is_bf16 ? __uint_as_float(((unsigned)((const unsigned short*)buf)[k]) << 16) : ((const float*)buf)[k]; if (!(fabsf(v) <= thresh)) bad = true; }
    if (bad) atomicMax(dbg, (unsigned)(1000 - idx));
}
__global__ void dbg_cnt(const unsigned* cntw, int idx, unsigned* dbg) {
    if (threadIdx.x == 0 && blockIdx.x == 0) { unsigned s = 0; for (int e = 0; e < NE; ++e) s += cntw[64 * e]; if (s != 2u * MTOK) atomicMax(dbg, (unsigned)(1000 - idx)); }
}

__device__ __forceinline__ float dbg_bf(unsigned short v) { return __uint_as_float(((unsigned)v) << 16); }
__device__ __forceinline__ unsigned dbg_hash(unsigned x) { x ^= x >> 16; x *= 0x7feb352dU; x ^= x >> 15; x *= 0x846ca68bU; x ^= x >> 16; return x; }
__global__ void dbg_gemm_check(const unsigned short* A, int lda, const unsigned short* Bt, int K, const unsigned short* out, int ldo, int M, int N, float scale, int idx, unsigned* dbg) {
    const unsigned s = blockIdx.x * blockDim.x + threadIdx.x; const int row = (int)(dbg_hash(2 * s + 1) % (unsigned)M), col = (int)(dbg_hash(2 * s + 2) % (unsigned)N);
    float acc = 0.f; for (int k = 0; k < K; ++k) acc += dbg_bf(A[(size_t)row * lda + k]) * dbg_bf(Bt[(size_t)col * K + k]);
    acc *= scale; const float got = dbg_bf(out[(size_t)row * ldo + col]);
    if (!(fabsf(got - acc) <= 0.03f + 0.02f * fabsf(acc))) { atomicMax(dbg, (unsigned)(1000 - idx)); atomicAdd(dbg + 64 + idx, 1u); }
}
__global__ void dbg_conv_check(const float* W, int K, int N, const unsigned short* WT, int il, int idx, unsigned* dbg) {
    const unsigned s = blockIdx.x * blockDim.x + threadIdx.x; const int k = (int)(dbg_hash(2 * s + 1) % (unsigned)K), n = (int)(dbg_hash(2 * s + 2) % (unsigned)N);
    const int dr = il == 0 ? n : (n / 128) * 256 + (il - 1) * 128 + (n % 128);
    const float w = W[(size_t)k * N + n], g = dbg_bf(WT[(size_t)dr * K + k]);
    if (!(fabsf(g - w) <= 0.01f * fabsf(w) + 1e-6f)) atomicMax(dbg, (unsigned)(1000 - idx));
}
__global__ void dbg_norm_check(const float* src, const float* gain, const unsigned short* xn, int idx, unsigned* dbg) {
    const unsigned s = blockIdx.x * blockDim.x + threadIdx.x; const int row = (int)(dbg_hash(s + 77) % (unsigned)MTOK);
    float ss = 0.f; for (int c = 0; c < D; ++c) { const float v = src[(size_t)row * D + c]; ss += v * v; }
    const float rstd = 1.f / sqrtf(ss / D + 1e-6f); bool bad = false;
    for (int c = 0; c < D; ++c) { const float r = src[(size_t)row * D + c] * rstd * gain[c], g = dbg_bf(xn[(size_t)row * D + c]); if (!(fabsf(g - r) <= 0.02f + 0.01f * fabsf(r))) bad = true; }
    if (bad) atomicMax(dbg, (unsigned)(1000 - idx));
}
__global__ void dbg_naive_gemm(const unsigned short* A, const unsigned short* Bt, unsigned short* out, int M, int N, int K) {
    const size_t i = blockIdx.x * (size_t)blockDim.x + threadIdx.x; if (i >= (size_t)M * N) return; const int row = (int)(i / N), col = (int)(i % N);
    float acc = 0.f; for (int k = 0; k < K; ++k) acc += dbg_bf(A[(size_t)row * K + k]) * dbg_bf(Bt[(size_t)col * K + k]);
    out[(size_t)row * N + col] = (unsigned short)f2bf(acc);
}
__global__ void dbg_find_col(const unsigned short* out, const unsigned short* ref, int M, int N, unsigned* hist) {
    const unsigned s = blockIdx.x * blockDim.x + threadIdx.x; const int row = (int)(dbg_hash(2 * s + 1) % (unsigned)M), col = (int)(dbg_hash(2 * s + 2) % (unsigned)N);
    const unsigned short v = out[(size_t)row * N + col]; int found = -1;
#if MK_FIND_PATTERN
    if (v == 0x3C3C) atomicAdd(hist + N, 1u); else atomicAdd(hist + 5, 1u); return;
#endif
#if MK_FIND_ROWS
    for (int r = 0; r < M; ++r) if (ref[(size_t)r * N + col] == v) { found = r; break; }
    if (found < 0) atomicAdd(hist + N, 1u); else atomicAdd(hist + ((found - row) & (N - 1)), 1u);
#else
    for (int c = 0; c < N; ++c) if (ref[(size_t)row * N + c] == v) { found = c; break; }
    if (found < 0) atomicAdd(hist + N, 1u); else atomicAdd(hist + ((found - col) & (N - 1)), 1u);
#endif
}
__global__ void dbg_hist_code(const unsigned* hist, int N, unsigned* dbg) {
    if (threadIdx.x || blockIdx.x) return; unsigned best = 0, bi = 0; for (int i = 0; i < N; ++i) if (hist[i] > best) { best = hist[i]; bi = i; }
    dbg[32] = bi; dbg[33] = best; dbg[34] = hist[N];
}
__global__ void dbg_final(float* out, size_t n, const unsigned* dbg) {
    if (MK_HIST_SEL >= 10) { const float c3 = sqrtf((float)dbg[MK_HIST_SEL + 30]); size_t i3 = blockIdx.x * (size_t)blockDim.x + threadIdx.x, st3 = (size_t)gridDim.x * blockDim.x; for (size_t k3 = i3; k3 < n; k3 += st3) out[k3] = c3; return; }
    if (MK_HIST_SEL >= 0 && (dbg[33] || dbg[34])) { const float c2 = sqrtf((float)(MK_HIST_SEL == 0 ? dbg[32] : (MK_HIST_SEL == 1 ? dbg[33] * 100u / 4096u : dbg[34] * 100u / 4096u)) + 1.f); size_t i2 = blockIdx.x * (size_t)blockDim.x + threadIdx.x, st2 = (size_t)gridDim.x * blockDim.x; for (size_t k2 = i2; k2 < n; k2 += st2) out[k2] = c2; return; }
    const unsigned d = dbg[0]; if (d == 0u) return; const unsigned nf = dbg[64 + (1000u - d)]; const float c = sqrtf(nf ? (float)(200u * (1000u - d - 9u) + nf * 100u / 4096u) : (float)(1000u - d));
    size_t i = blockIdx.x * (size_t)blockDim.x + threadIdx.x, stride = (size_t)gridDim.x * blockDim.x;
    for (size_t k = i; k < n; k += stride) out[k] = c;
}
#endif

#ifndef MK_REPEAT
#define MK_REPEAT 1
#endif
#ifndef MK_FIND_ROWS
#define MK_FIND_ROWS 0
#endif
#ifndef MK_FIND_REGION
#define MK_FIND_REGION WS_K
#endif
#ifndef MK_HIST_SEL
#define MK_HIST_SEL 0
#endif
#ifndef MK_STAMP
#define MK_STAMP 0
#endif
#if MK_STAMP
__global__ void stamp_k(unsigned* p) { if (threadIdx.x == 0) *p = (unsigned)__builtin_amdgcn_s_memrealtime(); }
__global__ void stamp_encode(float* out, size_t n, const unsigned* st, int pa, float ua, int pb, float ub) {
    const float da = (float)(st[pa + 1] - st[pa]) * 0.01f, db = (float)(st[pb + 1] - st[pb]) * 0.01f;
    float m = da / ua; m = m < 10.f ? 10.f : (m > 99.f ? 99.f : m); float e = floorf(db / ub + 0.5f); e = e < 0.f ? 0.f : (e > 30.f ? 30.f : e);
    const float c = sqrtf(m) * __powf(10.f, 0.5f * e);
    size_t i = blockIdx.x * (size_t)blockDim.x + threadIdx.x, stride = (size_t)gridDim.x * blockDim.x;
    for (size_t k = i; k < n; k += stride) out[k] = c;
}
#endif
extern "C" void kernel_launch(void* const* d_in, const int* in_sizes, int n_in, void* d_out, int out_size, void* d_ws, size_t ws_size, hipStream_t stream) {
    static int grid = 0;
    if (grid == 0) {
        if (n_in != 17 || in_sizes[0] != MTOK * D || out_size != MTOK * D || ws_size < WS_END) {
            fprintf(stderr, "kernel_launch: built for 17 inputs, x/out of %d floats, >= %zu bytes of workspace; got n_in %d, in0 %d, out %d, ws %zu; nothing launched\n", MTOK * D, (size_t)WS_END, n_in, n_in > 0 ? in_sizes[0] : -1, out_size, ws_size);
            grid = -1; return; }
        int dev = 0, cus = 0, per_cu = 0;
        if (hipGetDevice(&dev) != hipSuccess || hipDeviceGetAttribute(&cus, hipDeviceAttributeMultiprocessorCount, dev) != hipSuccess) { fprintf(stderr, "kernel_launch: device query failed\n"); grid = -1; return; }
        if (hipFuncSetAttribute((const void*)trunk_fwd, hipFuncAttributeMaxDynamicSharedMemorySize, LDS_BYTES) != hipSuccess) { fprintf(stderr, "kernel_launch: hipFuncSetAttribute failed\n"); grid = -1; return; }
        if (hipOccupancyMaxActiveBlocksPerMultiprocessor(&per_cu, (const void*)trunk_fwd, NWAVES * 64, LDS_BYTES) != hipSuccess || per_cu < 1)
            fprintf(stderr, "kernel_launch: note: occupancy query reports %d workgroups per CU\n", per_cu);
        (void)hipGetLastError();
        grid = cus;
    }
    if (grid < 0) return;
    if (hipMemsetAsync((char*)d_ws + WS_CTL, 0, CTL_ZERO_BYTES, stream) != hipSuccess) { fprintf(stderr, "kernel_launch: memset failed\n"); return; }
    KArgs a{};
    for (int i = 0; i < 17; ++i) a.in[i] = (const float*)d_in[i];
    a.out = (float*)d_out; a.ws = (unsigned char*)d_ws;
#if MK_PER_PHASE
#if MK_STAMP
    hipLaunchKernelGGL(stamp_k, dim3(1), dim3(64), 0, stream, (unsigned*)d_ws + 3000);
#endif
    for (int p = 0; p < NPHASE; ++p) {
        if (p >= 1) { const int L = (p - 1) / PH_PER_LAYER, k = (p - 1) % PH_PER_LAYER; if (k == 1 && !(L & 1)) continue; }
        a.ph_lo = p; a.ph_hi = p + 1;
#if MK_DEBUG
#endif
#if !defined(MK_SKIP_MAIN)
        for (int rep_ = 0; rep_ < (p == 1 ? MK_REPEAT : 1); ++rep_) hipLaunchKernelGGL(trunk_fwd, dim3(grid), dim3(NWAVES * 64), LDS_BYTES, stream, a);
#endif
#if MK_STAMP
        hipLaunchKernelGGL(stamp_k, dim3(1), dim3(64), 0, stream, (unsigned*)d_ws + 3000 + p + 1);
#endif
#if MK_DEBUG
        {   unsigned char* ws = (unsigned char*)d_ws; unsigned* dbg = (unsigned*)(ws + WS_CTL) + 2048;
            const size_t MD_ = (size_t)MTOK * D;
#define PROBE(buf, n, isbf, idx, th) if ((idx) <= MK_PROBE_MAX) hipLaunchKernelGGL(dbg_probe, dim3(2048), dim3(256), 0, stream, (const void*)(buf), (size_t)(n), isbf, idx, th, dbg)
            if (p == 0) {
                hipLaunchKernelGGL(dbg_norm_check, dim3(4), dim3(64), 0, stream, (const float*)d_in[0], (const float*)d_in[1], (const unsigned short*)(ws + WS_XN), 4, dbg);
                hipLaunchKernelGGL(dbg_conv_check, dim3(16), dim3(256), 0, stream, (const float*)d_in[3], D, 3 * D, (const unsigned short*)(ws + WS_DQKV), 0, 5, dbg);
                hipLaunchKernelGGL(dbg_conv_check, dim3(16), dim3(256), 0, stream, (const float*)d_in[9], D, DFF, (const unsigned short*)(ws + WS_FGU), 1, 6, dbg);
                hipLaunchKernelGGL(dbg_conv_check, dim3(16), dim3(256), 0, stream, (const float*)d_in[10], D, DFF, (const unsigned short*)(ws + WS_FGU), 2, 7, dbg);
                hipLaunchKernelGGL(dbg_conv_check, dim3(16), dim3(256), 0, stream, (const float*)d_in[11], DFF, D, (const unsigned short*)(ws + WS_FD), 0, 8, dbg);
                hipLaunchKernelGGL(dbg_conv_check, dim3(16), dim3(256), 0, stream, (const float*)d_in[15] + (size_t)3 * DE * D, DE, D, (const unsigned short*)(ws + WS_MD) + (size_t)3 * D * DE, 0, 9, dbg);
            }
            if (p == 1) {
                const float C2h = 0.125f * 1.4426950408889634f;
                hipLaunchKernelGGL(dbg_gemm_check, dim3(16), dim3(256), 0, stream, (const unsigned short*)(ws + WS_XN), D, (const unsigned short*)(ws + WS_DQKV), D, (const unsigned short*)(ws + WS_Q), D, MTOK, D, C2h, 10, dbg);
                hipLaunchKernelGGL(dbg_gemm_check, dim3(16), dim3(256), 0, stream, (const unsigned short*)(ws + WS_XN), D, (const unsigned short*)(ws + WS_DQKV) + (size_t)D * D, D, (const unsigned short*)(ws + WS_K), D, MTOK, D, 1.f, 11, dbg);

                hipLaunchKernelGGL(dbg_gemm_check, dim3(16), dim3(256), 0, stream, (const unsigned short*)(ws + WS_XN), D, (const unsigned short*)(ws + WS_DQKV) + (size_t)2 * D * D, D, (const unsigned short*)(ws + WS_V), D, MTOK, D, 1.f, 12, dbg);
            }
            if (0) { PROBE(ws + WS_XN, MD_, 1, 1, 10.f); PROBE(ws + WS_DQKV, (WS_MGU - WS_DQKV) / 2, 1, 2, 1.f); PROBE(ws + WS_MGU, (WS_XN - WS_MGU) / 2, 1, 3, 1.f); }
            if (p >= 1) { const int L = (p - 1) / PH_PER_LAYER, k = (p - 1) % PH_PER_LAYER; const int b = 20 + 10 * L;
                if (k == 0) PROBE(ws + WS_Q, 3 * MD_, 1, b + 0, 50.f);
                if (k == 1) PROBE(ws + WS_KMEAN, 8 * 16 * 16 * 64, 0, b + 1, 5.f);
                if (k == 2) PROBE(ws + WS_XN, MD_, 1, b + 2, 50.f);
                if (k == 3) PROBE(d_out, MD_, 0, b + 3, 300.f);
                if (k == 4) { PROBE(ws + WS_XN, MD_, 1, b + 4, 20.f); if ((L & 1) && (b + 9) <= MK_PROBE_MAX) hipLaunchKernelGGL(dbg_cnt, dim3(1), dim3(64), 0, stream, (const unsigned*)(ws + WS_CTL) + CW_CNT + 64 * NE * (L >> 1), b + 9, dbg); }
                if (k == 5) PROBE(ws + WS_ACT, (L & 1) ? (size_t)256 * 256 * DE : (size_t)MTOK * DFF, 1, b + 5, 2000.f);
                if (k == 6) { PROBE(d_out, MD_, 0, b + 6, 1000.f); if (L & 1) PROBE(ws + WS_XN, MD_, 1, b + 7, 1000.f); }
                if (k == 7 && L != 3) { PROBE(ws + WS_XN, MD_, 1, b + 8, 20.f); PROBE(d_out, MD_, 0, b + 8, 1000.f); }
            }
#undef PROBE
        }
#endif
    }
#if MK_DEBUG
    hipLaunchKernelGGL(dbg_final, dim3(2048), dim3(256), 0, stream, (float*)d_out, (size_t)MTOK * D, (const unsigned*)((unsigned char*)d_ws + WS_CTL) + 2048);
#endif
#else
    a.ph_lo = 0; a.ph_hi = NPHASE;
    hipLaunchKernelGGL(trunk_fwd, dim3(grid), dim3(NWAVES * 64), LDS_BYTES, stream, a);
#if 0
    hipLaunchKernelGGL(stamp_encode, dim3(2048), dim3(256), 0, stream, (float*)d_out, (size_t)MTOK * D, (const unsigned*)d_ws + 3000, MK_STAMP_PA, MK_STAMP_UA, MK_STAMP_PB, MK_STAMP_UB);
#endif
#endif
#if MK_STAMP
    hipLaunchKernelGGL(stamp_encode, dim3(2048), dim3(256), 0, stream, (float*)d_out, (size_t)MTOK * D, (const unsigned*)d_ws + 3000, MK_STAMP_PA, MK_STAMP_UA, MK_STAMP_PB, MK_STAMP_UB);
#endif
    const hipError_t le = hipPeekAtLastError();
    if (le != hipSuccess) fprintf(stderr, "kernel_launch: launch failed: %s\n", hipGetErrorName(le));
}
```

```cpp
#define MK_DEBUG 0
#define MK_PER_PHASE 0
#define MK_DOUBLE 0x0u
#include <hip/hip_runtime.h>
#include <cstdio>
#include <cstdint>

#ifndef MK_DEBUG
#define MK_DEBUG 1
#endif
#ifndef MK_KDEBUG
#define MK_KDEBUG 0
#endif
#define LAS __attribute__((address_space(3)))
#define GAS __attribute__((address_space(1)))

constexpr int BATCH = 8, SEQ = 4096, MTOK = BATCH * SEQ, D = 1024, DFF = 2816, DE = 3584, NE = 8;
constexpr int MOE_TILES_MAX = 272;
constexpr int LIST_CAP = MTOK;

namespace pg8 {
#define PG8_LAS __attribute__((address_space(3)))
typedef unsigned short bf16_t;
typedef short bf16x8 __attribute__((ext_vector_type(8)));
typedef float f32x4 __attribute__((ext_vector_type(4)));
typedef unsigned u32x4 __attribute__((ext_vector_type(4)));
constexpr int BM = 256, BK = 64, HALF = 128, HTB = HALF * BK * 2  , STAGE_BYTES = 8 * HTB, NXCD = 8, WGM = 8;

__host__ __device__ __forceinline__ int lds_byte(int r, int c) { const int st = (r >> 4) * 2 + (c >> 5), rr = r & 15, cc = c & 31, ob = rr * 64 + cc * 2; return st * 1024 + (ob ^ (((ob >> 9) & 1) << 5)); }
__host__ __device__ __forceinline__ void stage_rc(int b, int& R, int& C) { const int st = b / 1024, sb = b % 1024, swz = sb ^ (((sb >> 9) & 1) << 5); R = (st >> 1) * 16 + swz / 64; C = (st & 1) * 32 + (swz % 64) / 2; }
__host__ __device__ __forceinline__ int perm32(int rho) { const int n = rho >> 4, i = rho & 15; return 8 * (i >> 2) + 4 * n + (i & 3); }

struct Unit { int pm, pn, e, r0; };
struct Gemm { const bf16_t* A; const bf16_t* Bt; int K; size_t bstride; unsigned amax; unsigned* dbg; size_t bbytes; };

__device__ __forceinline__ void tile_of(int L, int nM, int nN, int& pm, int& pn) {
    const int nwg = nM * nN; int wgid = L; { const int q = nwg / NXCD, r = nwg % NXCD, xcd = wgid % NXCD, off = wgid / NXCD; wgid = (xcd < r ? xcd * (q + 1) : r * (q + 1) + (xcd - r) * q) + off; }
    const int nig = WGM * nN, gid = wgid / nig, fm = gid * WGM, gsz = (nM - fm) < WGM ? (nM - fm) : WGM;
    pm = fm + ((wgid % nig) % gsz); pn = (wgid % nig) / gsz;
}
struct StaticOrder {
    int nM, nN, nwg, G, c;
    __device__ __forceinline__ void init(int M, int N, int G_, int c_) { nM = M / BM; nN = N / BM; nwg = nM * nN; G = G_; c = c_; }
    __device__ __forceinline__ bool next(int i, Unit& u) const {
        const long L = (long)i * G + c; if (L >= nwg) return false;
        tile_of((int)L, nM, nN, u.pm, u.pn); u.e = 0; u.r0 = 0; return true;
    }
    __device__ __forceinline__ unsigned arow(const Unit& u, int lr) const { return (unsigned)(u.pm * BM + lr); }
};
struct MoeOrder {
    int nM, nN, nwg, G, c; int tstart[NE + 1]; int cnt[NE]; const unsigned* list_tok; bool gather;
    __device__ __forceinline__ void init(const unsigned* cntw, const unsigned* list_tok_, bool gather_, int N, int G_, int c_) {
        int acc = 0;
#pragma unroll
        for (int e = 0; e < NE; ++e) { const int ce = (int)__builtin_amdgcn_readfirstlane((int)__hip_atomic_load((const GAS unsigned*)cntw + 64 * e, __ATOMIC_RELAXED, __HIP_MEMORY_SCOPE_AGENT)); cnt[e] = ce; tstart[e] = acc; acc += (ce + BM - 1) / BM; }
        tstart[NE] = acc; nM = acc; nN = N / BM; nwg = nM * nN; G = G_; c = c_; list_tok = list_tok_; gather = gather_;
    }
    __device__ __forceinline__ bool next(int i, Unit& u) const {
        const long L = (long)i * G + c; if (L >= nwg) return false;
        tile_of((int)L, nM, nN, u.pm, u.pn); int e = 0;
#pragma unroll
        for (int k = 1; k < NE; ++k) e += (u.pm >= tstart[k]) ? 1 : 0;
        u.e = e; int ts = 0;
#pragma unroll
        for (int k = 0; k < NE; ++k) ts = (k == e) ? tstart[k] : ts;
        u.r0 = (u.pm - ts) * BM; return true;
    }
    __device__ __forceinline__ int count_of(int e) const { int cv = 0;
#pragma unroll
        for (int k = 0; k < NE; ++k) cv = (k == e) ? cnt[k] : cv;
        return cv; }
    __device__ __forceinline__ unsigned arow(const Unit& u, int lr) const {
        if (!gather) return (unsigned)(u.pm * BM + lr);
        const int l = u.r0 + lr; const int cv = count_of(u.e);
        unsigned t = 0u; if (l < cv) t = __hip_atomic_load((const GAS unsigned*)list_tok + (size_t)u.e * LIST_CAP + l, __ATOMIC_RELAXED, __HIP_MEMORY_SCOPE_AGENT) & 0xFFFFFu;
        return t;
    }
};

__device__ __forceinline__ unsigned cvt_pk_bf16(float lo, float hi) { unsigned r; asm volatile("v_cvt_pk_bf16_f32 %0, %1, %2" : "=v"(r) : "v"(lo), "v"(hi)); return r; }

struct EpiQKV {
    static constexpr bool PERM = true;
    bf16_t* O; int ldc; int split_cols; size_t split_stride; float scale0; unsigned* dbg;
    __device__ __forceinline__ void operator()(const f32x4 (&acc)[2][2][4][2], const Unit& u, int wr, int wc, int fr, int fq) const {
        const int row0 = u.pm * BM + wr * 64 + fr; int colt = u.pn * BM; bf16_t* base = O;
        float sc = 1.f; { const int t = colt / split_cols; base += (size_t)t * split_stride; colt -= t * split_cols; if (t == 0) sc = scale0; }
        const int col0 = colt + wc * 32 + 8 * fq;
#pragma unroll
        for (int ai = 0; ai < 2; ++ai)
#pragma unroll
            for (int m = 0; m < 4; ++m) { bf16_t* rowp = base + (size_t)(row0 + ai * HALF + m * 16) * ldc + col0;
#pragma unroll
                for (int bj = 0; bj < 2; ++bj) { f32x4 v0 = acc[ai][bj][m][0] * sc, v1 = acc[ai][bj][m][1] * sc;
                    u32x4 w; w.x = cvt_pk_bf16(v0[0], v0[1]); w.y = cvt_pk_bf16(v0[2], v0[3]); w.z = cvt_pk_bf16(v1[0], v1[1]); w.w = cvt_pk_bf16(v1[2], v1[3]);
#if defined(EPI_VARIANT) && EPI_VARIANT == 1
                    { u32x4 cz = {0x3f803f80u, 0x3f803f80u, 0x3f803f80u, 0x3f803f80u}; asm volatile("" :: "v"(w)); *(GAS u32x4*)(rowp + bj * HALF) = cz; }
#elif defined(EPI_VARIANT) && EPI_VARIANT == 2
                    { asm volatile("" :: "v"(w)); asm volatile("" :: "v"(rowp)); }
#elif MK_KDEBUG
                    { const size_t eo = (size_t)((rowp + bj * HALF) - O); if (eo + 8 <= (size_t)3 * 33554432) *(GAS u32x4*)(rowp + bj * HALF) = w; else atomicMax(dbg, 1000u - 3u); }
#else
                    *(GAS u32x4*)(rowp + bj * HALF) = w;
#endif
                    } }
    }
};
struct EpiSwiGLU {
    static constexpr bool PERM = true;
    bf16_t* O; int ldc;
    __device__ __forceinline__ void operator()(const f32x4 (&acc)[2][2][4][2], const Unit& u, int wr, int wc, int fr, int fq) const {
        const int row0 = u.pm * BM + wr * 64 + fr; const int col0 = u.pn * HALF + wc * 32 + 8 * fq;
#pragma unroll
        for (int ai = 0; ai < 2; ++ai)
#pragma unroll
            for (int m = 0; m < 4; ++m) { bf16_t* rowp = O + (size_t)(row0 + ai * HALF + m * 16) * ldc + col0; float o[8];
#pragma unroll
                for (int n = 0; n < 2; ++n)
#pragma unroll
                    for (int j = 0; j < 4; ++j) { const float g = acc[ai][0][m][n][j], up = acc[ai][1][m][n][j];
                        const float s = __builtin_amdgcn_rcpf(1.0f + __builtin_amdgcn_exp2f(-1.4426950408889634f * g)); o[n * 4 + j] = g * s * up; }
                u32x4 w; w.x = cvt_pk_bf16(o[0], o[1]); w.y = cvt_pk_bf16(o[2], o[3]); w.z = cvt_pk_bf16(o[4], o[5]); w.w = cvt_pk_bf16(o[6], o[7]);
                *(GAS u32x4*)rowp = w; }
    }
};
struct EpiRes {
    static constexpr bool PERM = false;
    const float* res; float* out; int ldc;
    __device__ __forceinline__ void operator()(const f32x4 (&acc)[2][2][4][2], const Unit& u, int wr, int wc, int fr, int fq) const {
        const int row0 = u.pm * BM + wr * 64 + fr; const int col0 = u.pn * BM + wc * 32 + 4 * fq;
#pragma unroll
        for (int ai = 0; ai < 2; ++ai)
#pragma unroll
            for (int m = 0; m < 4; ++m) { const size_t off = (size_t)(row0 + ai * HALF + m * 16) * ldc + col0;
#pragma unroll
                for (int bj = 0; bj < 2; ++bj)
#pragma unroll
                    for (int n = 0; n < 2; ++n) { const f32x4 r = *(const GAS f32x4*)(res + off + bj * HALF + n * 16); *(GAS f32x4*)(out + off + bj * HALF + n * 16) = r + acc[ai][bj][m][n]; } }
    }
};
struct EpiMoeDown {
    static constexpr bool PERM = false;
    float* h; bf16_t* y1; const unsigned* list_tok; const float* list_w; int cnt[NE];
    __device__ __forceinline__ void operator()(const f32x4 (&acc)[2][2][4][2], const Unit& u, int wr, int wc, int fr, int fq) const {
        int cv = 0;
#pragma unroll
        for (int k = 0; k < NE; ++k) cv = (k == u.e) ? cnt[k] : cv;
        const int col0 = u.pn * BM + wc * 32 + 4 * fq;
#pragma unroll
        for (int ai = 0; ai < 2; ++ai)
#pragma unroll
            for (int m = 0; m < 4; ++m) { const int l = u.r0 + ai * HALF + wr * 64 + m * 16 + fr;
                if (l < cv) {
                    const unsigned ent = __hip_atomic_load((const GAS unsigned*)list_tok + (size_t)u.e * LIST_CAP + l, __ATOMIC_RELAXED, __HIP_MEMORY_SCOPE_AGENT);
                    const float w = __uint_as_float(__hip_atomic_load((const GAS unsigned*)list_w + (size_t)u.e * LIST_CAP + l, __ATOMIC_RELAXED, __HIP_MEMORY_SCOPE_AGENT));
                    const size_t off = (size_t)(ent & 0xFFFFFu) * D + col0;
                    if ((ent >> 20) == 0u) {
#pragma unroll
                        for (int bj = 0; bj < 2; ++bj)
#pragma unroll
                            for (int n = 0; n < 2; ++n) { GAS float* p = (GAS float*)(h + off + bj * HALF + n * 16); const f32x4 r = *(const GAS f32x4*)p; *(GAS f32x4*)p = r + acc[ai][bj][m][n] * w; }
                    } else {
#pragma unroll
                        for (int bj = 0; bj < 2; ++bj)
#pragma unroll
                            for (int n = 0; n < 2; ++n) { const f32x4 v = acc[ai][bj][m][n] * w; unsigned long long pk = (unsigned long long)cvt_pk_bf16(v[0], v[1]) | ((unsigned long long)cvt_pk_bf16(v[2], v[3]) << 32);
                                *(GAS unsigned long long*)(y1 + off + bj * HALF + n * 16) = pk; }
                    }
                } }
    }
};

template <class Epi, class Sched>
__device__ __forceinline__ void gemm_phase(PG8_LAS unsigned char* lds, int xoff, const Gemm g, const Sched& S, const Epi& E) {
    int tid_ = threadIdx.x;
#if !defined(NO_OPQ_T)
    asm volatile("" : "+v"(tid_));
#endif
    const int tid = tid_, wid = __builtin_amdgcn_readfirstlane(tid >> 6), lane = tid & 63, wr = wid >> 2, wc = wid & 3, fr = lane & 15, fq = lane >> 4;
    const int K = g.K, nt = K / BK;
    unsigned voffB[2];
#pragma unroll
    for (int i = 0; i < 2; ++i) { int R, C; stage_rc(tid * 16 + i * 8192, R, C); const int Rb = Epi::PERM ? ((R & ~31) + perm32(R & 31)) : R;
        voffB[i] = (unsigned)(Rb * K + C) * 2u; }
    const size_t kstep = (size_t)(BK * 2);
    const size_t hstep = (size_t)HALF * K * 2;
    const size_t tstep = 2 * hstep;
    const unsigned ldsw = (unsigned)wid * 1024u;
    const int aoff = lds_byte(wr * 64 + fr, fq * 8), boff = lds_byte(wc * 32 + fr, fq * 8);
#define PG8_SA(b, h) (((b) * 2 + (h)) * HTB)
#define PG8_SB(b, h) ((4 + (b) * 2 + (h)) * HTB)
#define PG8_STAGE(bufoff, gbase, v0, v1) do { \
        __builtin_amdgcn_global_load_lds((const GAS unsigned*)((const char*)(gbase) + (v0)), (PG8_LAS unsigned*)(lds + (bufoff) + ldsw), 16, 0, 0); \
        __builtin_amdgcn_global_load_lds((const GAS unsigned*)((const char*)(gbase) + (v1)), (PG8_LAS unsigned*)(lds + (bufoff) + ldsw + 8192), 16, 0, 0); } while (0)
#define PG8_STAGEB(bufoff, gbase) PG8_STAGE(bufoff, gbase, voffB[0], voffB[1])
#define PG8_LDA(dst, b, h) do { _Pragma("unroll") for (int m = 0; m < 4; ++m) _Pragma("unroll") for (int k = 0; k < 2; ++k) dst[m][k] = *(const PG8_LAS bf16x8*)(lds + PG8_SA(b, h) + aoff + m * 2048 + k * 1024); } while (0)
#define PG8_LDB(dst, b, h) do { _Pragma("unroll") for (int n = 0; n < 2; ++n) _Pragma("unroll") for (int k = 0; k < 2; ++k) dst[n][k] = *(const PG8_LAS bf16x8*)(lds + PG8_SB(b, h) + boff + n * 2048 + k * 1024); } while (0)
#define PG8_MMA(ai, bj, At, Bt) do { __builtin_amdgcn_s_setprio(1); _Pragma("unroll") for (int m = 0; m < 4; ++m) _Pragma("unroll") for (int n = 0; n < 2; ++n) _Pragma("unroll") for (int k = 0; k < 2; ++k) \
        acc[ai][bj][m][n] = __builtin_amdgcn_mfma_f32_16x16x32_bf16(Bt[n][k], At[m][k], acc[ai][bj][m][n], 0, 0, 0); __builtin_amdgcn_s_setprio(0); } while (0)
#define PG8_WAIT_V(n) asm volatile("s_waitcnt vmcnt(" #n ")" ::: "memory")
#define PG8_WAIT_L(n) asm volatile("s_waitcnt lgkmcnt(" #n ")" ::: "memory")
#define PG8_BAR __builtin_amdgcn_s_barrier()
#define PG8_SCHED __builtin_amdgcn_sched_barrier(0)
#define PG8_AOFFS(U, o00, o01, o10, o11) do { int R0_, C0_, R1_, C1_; stage_rc(tid * 16, R0_, C0_); stage_rc(tid * 16 + 8192, R1_, C1_);     \
        o00 = (S.arow(U, R0_) * (unsigned)K + (unsigned)C0_) * 2u; o01 = (S.arow(U, R1_) * (unsigned)K + (unsigned)C1_) * 2u; \
        o10 = (S.arow(U, HALF + R0_) * (unsigned)K + (unsigned)C0_) * 2u; o11 = (S.arow(U, HALF + R1_) * (unsigned)K + (unsigned)C1_) * 2u; } while (0)
    Unit cur, nxt; int ui = 0;
#if MK_KDEBUG
    if (blockIdx.x == 5 && threadIdx.x == 0) atomicOr(g.dbg + 43, 2u);
#endif
    if (!S.next(0, cur)) return;
#if MK_KDEBUG
    if (blockIdx.x == 5 && threadIdx.x == 0) atomicOr(g.dbg + 43, 4u);
    { Unit t1_; if (blockIdx.x == 5 && threadIdx.x == 0 && S.next(1, t1_)) { g.dbg[40] = 1u + (unsigned)t1_.pm * 16u + (unsigned)t1_.pn; g.dbg[41] = 1u + (unsigned)cur.pm * 16u + (unsigned)cur.pn; g.dbg[42] = 1u + (unsigned)gridDim.x; atomicOr(g.dbg + 43, 8u); } }
#endif
#if defined(GDBG_NOKLOOP)
    { f32x4 accz[2][2][4][2];
      for (int ui_ = 0; S.next(ui_, cur); ++ui_) {
#pragma unroll
        for (int a = 0; a < 2; ++a)
#pragma unroll
          for (int b = 0; b < 2; ++b)
#pragma unroll
            for (int m = 0; m < 4; ++m)
#pragma unroll
              for (int n = 0; n < 2; ++n) { f32x4 r4;
                for (int j = 0; j < 4; ++j) { const int row = cur.pm * 256 + a * 128 + wr * 64 + m * 16 + fr;
                  const int col = cur.pn * 256 + b * 128 + wc * 32 + (Epi::PERM ? 8 * fq + 4 * n + j : 16 * n + 4 * fq + j);
                  const bf16_t* ar = g.A + (size_t)row * K; const bf16_t* br = g.Bt + (size_t)cur.e * g.bstride + (size_t)col * K; float s_ = 0.f;
                  for (int k = 0; k < K; ++k) s_ += __uint_as_float(((unsigned)ar[k]) << 16) * __uint_as_float(((unsigned)br[k]) << 16);
                  r4[j] = s_; }
                accz[a][b][m][n] = r4; }
        E(accz, cur, wr, wc, fr, fq); }
      return; }
#endif
    f32x4 acc[2][2][4][2];
#pragma unroll
    for (int a = 0; a < 2; ++a)
#pragma unroll
        for (int b = 0; b < 2; ++b)
#pragma unroll
            for (int m = 0; m < 4; ++m)
#pragma unroll
                for (int n = 0; n < 2; ++n) acc[a][b][m][n] = (f32x4){0.f, 0.f, 0.f, 0.f};
    bf16x8 At[4][2], B0[2][2], B1[2][2];
    unsigned c00, c01, c10, c11;
    PG8_LAS u32x4* const xslot = (PG8_LAS u32x4*)(lds + xoff) + tid;
    PG8_AOFFS(cur, c00, c01, c10, c11);
    const char* const gA = (const char*)g.A;
    const char* cB = (const char*)g.Bt + (size_t)cur.e * g.bstride * 2 + (size_t)cur.pn * tstep;
    PG8_STAGEB(PG8_SB(0, 0), cB); PG8_STAGEB(PG8_SB(0, 1), cB + hstep); PG8_STAGE(PG8_SA(0, 0), gA, c00, c01); PG8_STAGE(PG8_SA(0, 1), gA, c10, c11);
    if (wr == 1) PG8_BAR;
    PG8_WAIT_V(2); PG8_BAR;
    PG8_STAGEB(PG8_SB(1, 0), cB + kstep); PG8_STAGE(PG8_SA(1, 0), gA + kstep, c00, c01); PG8_STAGEB(PG8_SB(1, 1), cB + hstep + kstep);
    PG8_WAIT_V(6); PG8_BAR;
    for (;;) {
        const bool has_next = S.next(ui + 1, nxt);
        const char* nB_ = has_next ? (const char*)g.Bt + (size_t)nxt.e * g.bstride * 2 + (size_t)nxt.pn * tstep : cB;
        const char* nB = nB_;
        if (has_next) { unsigned n00, n01, n10, n11; PG8_AOFFS(nxt, n00, n01, n10, n11); *xslot = (u32x4){n00, n01, n10, n11}; }
#if MK_KDEBUG
        { const char* lo_ = (const char*)g.Bt; const char* hi_ = lo_ + g.bbytes - tstep;
          if (cB < lo_ || cB > hi_ || nB < lo_ || nB > hi_) { atomicMax(g.dbg, 1000u - 92u); cB = lo_; nB = lo_; }
          if (voffB[0] > (unsigned)tstep || voffB[1] > (unsigned)tstep) { atomicMax(g.dbg, 1000u - 93u); voffB[0] = 0u; voffB[1] = 0u; }
          const unsigned mx_ = g.amax; if (c00 > mx_ || c01 > mx_ || c10 > mx_ || c11 > mx_) { atomicMax(g.dbg, 1000u - 94u); c00 = 0u; c01 = 0u; c10 = 0u; c11 = 0u; } }
#endif
        for (int t = 0; t < nt; t += 2) {
            const bool last = (t == nt - 2);
            const char* a1 = gA + (size_t)(t + 1) * kstep;
            const char* a2 = last ? gA : gA + (size_t)(t + 2) * kstep; const char* b2 = last ? nB : cB + (size_t)(t + 2) * kstep;
            const char* a3 = a2 + kstep; const char* b3 = b2 + kstep;
            PG8_LDB(B0, 0, 0); PG8_LDB(B1, 0, 1); PG8_SCHED; PG8_LDA(At, 0, 0); PG8_STAGE(PG8_SA(1, 1), a1, c10, c11);
            if (last && has_next) { const u32x4 nx = *xslot; c00 = nx.x; c01 = nx.y; c10 = nx.z; c11 = nx.w; }
#if MK_KDEBUG
            { const unsigned mx_ = g.amax; if (c00 > mx_ || c01 > mx_ || c10 > mx_ || c11 > mx_) { atomicMax(g.dbg, 1000u - 90u); c00 = c00 > mx_ ? 0u : c00; c01 = c01 > mx_ ? 0u : c01; c10 = c10 > mx_ ? 0u : c10; c11 = c11 > mx_ ? 0u : c11; } }
#endif
            PG8_WAIT_V(8); PG8_WAIT_L(0); PG8_BAR; PG8_MMA(0, 0, At, B0); PG8_MMA(0, 1, At, B1); PG8_BAR; PG8_SCHED;
            PG8_LDA(At, 0, 1); PG8_STAGEB(PG8_SB(0, 0), b2); PG8_STAGEB(PG8_SB(0, 1), b2 + hstep); PG8_STAGE(PG8_SA(0, 0), a2, c00, c01);
            PG8_WAIT_V(8); PG8_WAIT_L(0); PG8_BAR; PG8_MMA(1, 0, At, B0); PG8_MMA(1, 1, At, B1); PG8_BAR; PG8_SCHED;
            PG8_LDB(B0, 1, 0); PG8_LDB(B1, 1, 1); PG8_SCHED; PG8_LDA(At, 1, 0); PG8_STAGE(PG8_SA(0, 1), a2, c10, c11);
            PG8_WAIT_V(8); PG8_WAIT_L(0); PG8_BAR; PG8_MMA(0, 0, At, B0); PG8_MMA(0, 1, At, B1); PG8_BAR; PG8_SCHED;
            PG8_LDA(At, 1, 1); PG8_STAGEB(PG8_SB(1, 0), b3); PG8_STAGEB(PG8_SB(1, 1), b3 + hstep); PG8_STAGE(PG8_SA(1, 0), a3, c00, c01);
            PG8_WAIT_V(8); PG8_WAIT_L(0); PG8_BAR; PG8_MMA(1, 0, At, B0); PG8_MMA(1, 1, At, B1); PG8_BAR; PG8_SCHED;
        }
        if (wr == 0) PG8_BAR;
#if !defined(GDBG_NOEPI)
#if defined(EPI_DRAIN)
        asm volatile("s_waitcnt vmcnt(0)" ::: "memory");
#endif
        E(acc, cur, wr, wc, fr, fq);
#if defined(EPI_DRAIN_AFTER)
        asm volatile("s_waitcnt vmcnt(0)" ::: "memory");
#endif
#else
        asm volatile("" :: "v"(acc[0][0][0][0]), "v"(acc[1][1][3][1]));
#endif
        if (!has_next) break;
#pragma unroll
        for (int a = 0; a < 2; ++a)
#pragma unroll
            for (int b = 0; b < 2; ++b)
#pragma unroll
                for (int m = 0; m < 4; ++m)
#pragma unroll
                    for (int n = 0; n < 2; ++n) acc[a][b][m][n] = (f32x4){0.f, 0.f, 0.f, 0.f};
        cur = nxt; cB = nB; ++ui;
        if (wr == 1) PG8_BAR;
    }
    PG8_WAIT_V(0);
    PG8_BAR;
#undef PG8_SA
#undef PG8_SB
#undef PG8_STAGE
#undef PG8_STAGEB
#undef PG8_LDA
#undef PG8_LDB
#undef PG8_MMA
#undef PG8_WAIT_V
#undef PG8_WAIT_L
#undef PG8_BAR
#undef PG8_SCHED
#undef PG8_AOFFS
}
}

namespace att {
typedef unsigned short bf16_t;
typedef short bf16x8 __attribute__((ext_vector_type(8)));
typedef short s16x4 __attribute__((ext_vector_type(4)));
typedef float f32x16 __attribute__((ext_vector_type(16)));
typedef float f32x4 __attribute__((ext_vector_type(4)));
typedef unsigned u32x4 __attribute__((ext_vector_type(4)));
constexpr int PITCH = 1024;
constexpr float LOG2E = 1.4426950408889634f;
__device__ __forceinline__ int crow(int r, int hi) { return (r & 3) + 8 * (r >> 2) + 4 * hi; }
typedef float f32x2_t __attribute__((ext_vector_type(2))); typedef __bf16 bf16x2_t __attribute__((ext_vector_type(2)));
__device__ __forceinline__ unsigned cvtpk(float lo, float hi) { f32x2_t v = {lo, hi}; bf16x2_t b = __builtin_convertvector(v, bf16x2_t); return __builtin_bit_cast(unsigned, b); }
__device__ __forceinline__ float bf2f(short s) { return __uint_as_float(((unsigned)(unsigned short)s) << 16); }
typedef short v4i16_t __attribute__((ext_vector_type(4)));
__device__ __forceinline__ s16x4 vtr(const LAS unsigned char* p) { return __builtin_bit_cast(s16x4, __builtin_amdgcn_ds_read_tr16_b64_v4i16((LAS v4i16_t*)p)); }
__device__ __forceinline__ float max3f(float a, float b, float c) { float r; asm("v_max3_f32 %0, %1, %2, %3" : "=v"(r) : "v"(a), "v"(b), "v"(c)); return r; }
__device__ __forceinline__ float halves_max(float m) { auto rr = __builtin_amdgcn_permlane32_swap(__float_as_uint(m), __float_as_uint(m), false, false); return fmaxf(__uint_as_float(rr[0]), __uint_as_float(rr[1])); }
__device__ __forceinline__ float halves_sum(float m) { auto rr = __builtin_amdgcn_permlane32_swap(__float_as_uint(m), __float_as_uint(m), false, false); return __uint_as_float(rr[0]) + __uint_as_float(rr[1]); }
#define ATT_BAR() asm volatile("s_waitcnt vmcnt(0) lgkmcnt(0)\n\ts_barrier" ::: "memory")

struct Args { const bf16_t* Q; const bf16_t* K; const bf16_t* V; bf16_t* O; const float* kmean; const float* kmax2; const float* subln; float lam_full; float out_scale; };

template <int MODE>
__device__ __forceinline__ void attn_unit(LAS unsigned char* lds, const Args& A, int b, int h, int qblk) {
    constexpr int DVB = MODE == 0 ? 4 : 2;
    constexpr int NCH = MODE == 0 ? 16 : 8;
    constexpr int KBY = NCH * 1024, VBY = DVB * 4096, SLOT = KBY + VBY;
    constexpr int QR = MODE == 0 ? 128 : 256;
    constexpr int PPW = MODE == 0 ? 2 : 1;
    int tid_ = threadIdx.x; asm volatile("" : "+v"(tid_));
    const int tid = tid_, lane = tid & 63, r32 = lane & 31, hi = lane >> 5;
    const int wid = __builtin_amdgcn_readfirstlane(tid >> 6);
    const int comp = MODE == 0 ? (wid >> 2) : 0, wq = MODE == 0 ? (wid & 3) : wid;
    const int q0 = qblk * QR; const long rowbase = (long)b * SEQ;
    const int hcol = MODE == 0 ? h * 128 : h * 64;
    const int qrel0 = wq * 32;
    const float slope2 = __builtin_amdgcn_exp2f(MODE == 0 ? -(float)(h + 1) : -0.5f * (float)(h + 1)) * LOG2E;
    const int NT = MODE == 0 ? 2 * qblk + 2 : 4 + 4 * qblk;
#define ATT_KBASE_(t) (MODE == 0 ? 64 * (t) : ((t) < 4 ? q0 + 64 * (t) : 64 * ((t) - 4)))
    LAS float* wsf = (LAS float*)(lds + 65536) + wid * 64;
    const bf16_t* Kb = A.K + rowbase * PITCH + hcol;
    const bf16_t* Vb = A.V + rowbase * PITCH + hcol;
    bf16x8 qr[4];
    { const bf16_t* Qw = A.Q + (rowbase + q0 + qrel0 + r32) * PITCH + hcol + comp * 64 + hi * 8;
#pragma unroll
      for (int d0 = 0; d0 < 4; ++d0) qr[d0] = *(const GAS bf16x8*)(Qw + d0 * 16); }
    ATT_BAR();
    LAS int* live = (LAS int*)(lds + 71680); LAS float* qnx = (LAS float*)(lds + 71680 + 272);
    { float q2 = 0.f;
#pragma unroll
      for (int d0 = 0; d0 < 4; ++d0)
#pragma unroll
        for (int j = 0; j < 8; ++j) { const float v = bf2f(qr[d0][j]); q2 += v * v; }
      q2 = halves_sum(q2);
      q2 = fmaxf(q2, __shfl_xor(q2, 1)); q2 = fmaxf(q2, __shfl_xor(q2, 2)); q2 = fmaxf(q2, __shfl_xor(q2, 4)); q2 = fmaxf(q2, __shfl_xor(q2, 8)); q2 = fmaxf(q2, __shfl_xor(q2, 16));
      if (lane == 0) qnx[wid] = q2; }
    ATT_BAR();
    if (wid == 0) {
        const int tt = lane;
        const int kbase_t = (tt < NT) ? ATT_KBASE_(tt) : 0;
        bool alive = tt < NT;
        if (alive && kbase_t + 64 <= q0) {
            const int nblk = kbase_t >> 8; float bound = -INFINITY;
            if constexpr (MODE == 0) {
#pragma unroll
                for (int c = 0; c < 2; ++c) { float qm = fmaxf(fmaxf(qnx[4 * c], qnx[4 * c + 1]), fmaxf(qnx[4 * c + 2], qnx[4 * c + 3]));
                    const float k2 = ((const GAS float*)A.kmax2)[(size_t)(b * 16 + h * 2 + c) * 16 + nblk]; bound = fmaxf(bound, sqrtf(qm) * sqrtf(k2)); }
            } else {
                float qm = qnx[0];
#pragma unroll
                for (int w = 1; w < 8; ++w) qm = fmaxf(qm, qnx[w]);
                const float k2 = ((const GAS float*)A.kmax2)[(size_t)(b * 16 + h) * 16 + nblk]; bound = sqrtf(qm) * sqrtf(k2);
            }
            alive = !(bound * 1.001f + 1.0f + slope2 * (float)(kbase_t + 63 - q0) < -152.0f);
        }
        const unsigned long long am = __ballot(alive);
        if (alive) live[__popcll(am & ((1ull << lane) - 1ull))] = tt;
        if (lane == 0) live[64] = __popcll(am);
    }
    ATT_BAR();
    const int NTL = __builtin_amdgcn_readfirstlane(live[64]);
    unsigned sel = 0u;
    if constexpr (MODE == 1) {
        LAS float* km = (LAS float*)(lds + 67584);
        for (int i = tid; i < 1024; i += 512) km[i] = ((const GAS float*)A.kmean)[(size_t)(b * 16 + h) * 1024 + i];
        ATT_BAR();
        float g[16];
#pragma unroll
        for (int n = 0; n < 16; ++n) { float s = 0.f;
            if (n < qblk) {
#pragma unroll
                for (int d0 = 0; d0 < 4; ++d0) { const f32x4 ka = *(const LAS f32x4*)(km + n * 64 + d0 * 16 + hi * 8), kb2 = *(const LAS f32x4*)(km + n * 64 + d0 * 16 + hi * 8 + 4);
                    s += bf2f(qr[d0][0]) * ka[0] + bf2f(qr[d0][1]) * ka[1] + bf2f(qr[d0][2]) * ka[2] + bf2f(qr[d0][3]) * ka[3]
                       + bf2f(qr[d0][4]) * kb2[0] + bf2f(qr[d0][5]) * kb2[1] + bf2f(qr[d0][6]) * kb2[2] + bf2f(qr[d0][7]) * kb2[3]; }
                s = halves_sum(s); }
            g[n] = s; }
        const int nsel = qblk < 3 ? qblk : 3;
#pragma unroll
        for (int k = 0; k < 3; ++k) if (k < nsel) { float best = -INFINITY; int bi = 0; bool found = false;
#pragma unroll
            for (int n = 0; n < 16; ++n) if (n < qblk) { const bool free_ = ((sel >> n) & 1u) == 0u; if (free_ && (!found || g[n] > best)) { best = g[n]; bi = n; found = true; } }
            sel |= 1u << bi; }
    }
#define ATT_KBASE(t) ATT_KBASE_(t)
#define ATT_ISSUE(t, slot) do { const int kb_ = ATT_KBASE(t); \
        _Pragma("unroll") for (int i_ = 0; i_ < PPW; ++i_) { const int p_ = wid + 8 * i_; \
            __builtin_amdgcn_global_load_lds((const GAS unsigned*)(Kb + (size_t)(kb_ + lane) * PITCH + p_ * 8), (LAS unsigned*)(lds + (slot) * SLOT + p_ * 1024), 16, 0, 0); \
            __builtin_amdgcn_global_load_lds((const GAS unsigned*)(Vb + (size_t)(kb_ + 16 * (p_ & 3) + (lane >> 2)) * PITCH + (p_ >> 2) * 32 + (lane & 3) * 8), (LAS unsigned*)(lds + (slot) * SLOT + KBY + p_ * 1024), 16, 0, 0); } } while (0)
    constexpr float THR = 8.0f;
    float mref = 0.f, l = 0.f; f32x16 o[DVB];
#pragma unroll
    for (int d0 = 0; d0 < DVB; ++d0) o[d0] = f32x16{};
    int t = __builtin_amdgcn_readfirstlane(live[0]);
    ATT_ISSUE(t, 0);
    for (int it = 0; it < NTL; ++it) {
        ATT_BAR();
        const int tn = (it + 1 < NTL) ? __builtin_amdgcn_readfirstlane(live[it + 1]) : 0;
        if (it + 1 < NTL) ATT_ISSUE(tn, (it + 1) & 1);
        const int kbase = ATT_KBASE(t), krel = kbase - q0;
        const bool diag = kbase >= q0;
        bool skip = diag && (krel > qrel0 + 31);
        const bool needmask = diag && (krel + 63 > qrel0);
        bool selbit = true;
        if constexpr (MODE == 1) { if (t >= 4) { selbit = ((sel >> ((t - 4) >> 2)) & 1u) != 0u; if (!__any(selbit)) skip = true; } }
        if (!skip) {
            const LAS unsigned char* Ks = lds + (it & 1) * SLOT + comp * 8192 + hi * 1024 + r32 * 16;
            const LAS unsigned char* Vs = lds + (it & 1) * SLOT + KBY + ((lane >> 4) & 1) * 32 + (lane & 3) * 8 + (4 * hi + ((lane & 15) >> 2)) * 64;
            f32x16 p0, p1;
            { float off0 = slope2 * (float)(krel + 4 * hi) - mref;
              if constexpr (MODE == 1) { if (!selbit) off0 = -INFINITY; }
              const float off1 = off0 + 32.0f * slope2;
#pragma unroll
              for (int r = 0; r < 16; ++r) { const float cbr = slope2 * (float)((r & 3) + 8 * (r >> 2)); p0[r] = cbr + off0; p1[r] = cbr + off1; } }
#pragma unroll
            for (int d0 = 0; d0 < 4; ++d0) { const bf16x8 b0 = *(const LAS bf16x8*)(Ks + d0 * 2048), b1 = *(const LAS bf16x8*)(Ks + d0 * 2048 + 512);
                p0 = __builtin_amdgcn_mfma_f32_32x32x16_bf16(b0, qr[d0], p0, 0, 0, 0); p1 = __builtin_amdgcn_mfma_f32_32x32x16_bf16(b1, qr[d0], p1, 0, 0, 0); }
            if (needmask) { const int qrel = qrel0 + r32;
#pragma unroll
                for (int r = 0; r < 16; ++r) { const int kv = krel + crow(r, hi); if (kv > qrel) p0[r] = -INFINITY; if (kv + 32 > qrel) p1[r] = -INFINITY; } }
            float rm;
            { float a_ = max3f(p0[0], p0[1], p1[0]), b_ = max3f(p0[2], p0[3], p1[1]); a_ = max3f(a_, p1[2], p1[3]);
#pragma unroll
              for (int r = 4; r < 16; r += 4) { a_ = max3f(a_, p0[r], p0[r + 1]); b_ = max3f(b_, p0[r + 2], p0[r + 3]); a_ = max3f(a_, p1[r], p1[r + 1]); b_ = max3f(b_, p1[r + 2], p1[r + 3]); }
              rm = halves_max(fmaxf(a_, b_)); }
            if (__any(rm > THR)) {
                const float dl = fmaxf(rm, 0.f); mref += dl; const float alpha = __builtin_amdgcn_exp2f(-dl);
#pragma unroll
                for (int r = 0; r < 16; ++r) { p0[r] -= dl; p1[r] -= dl; }
                l *= alpha;
                if (hi == 0) wsf[r32] = alpha;
                asm volatile("s_waitcnt lgkmcnt(0)" ::: "memory");
#pragma unroll
                for (int gq = 0; gq < 4; ++gq) { const f32x4 f = *(const LAS f32x4*)(wsf + 8 * gq + 4 * hi);
#pragma unroll
                    for (int d0 = 0; d0 < DVB; ++d0) { o[d0][4 * gq + 0] *= f[0]; o[d0][4 * gq + 1] *= f[1]; o[d0][4 * gq + 2] *= f[2]; o[d0][4 * gq + 3] *= f[3]; } }
            }
            float sacc = 0.f;
#pragma unroll
            for (int r = 0; r < 16; ++r) { p0[r] = __builtin_amdgcn_exp2f(p0[r]); p1[r] = __builtin_amdgcn_exp2f(p1[r]); sacc += p0[r] + p1[r]; }
            l += sacc;
            u32x4 pw[4];
            pw[0] = (u32x4){cvtpk(p0[0], p0[1]), cvtpk(p0[2], p0[3]), cvtpk(p0[4], p0[5]), cvtpk(p0[6], p0[7])};
            pw[1] = (u32x4){cvtpk(p0[8], p0[9]), cvtpk(p0[10], p0[11]), cvtpk(p0[12], p0[13]), cvtpk(p0[14], p0[15])};
            pw[2] = (u32x4){cvtpk(p1[0], p1[1]), cvtpk(p1[2], p1[3]), cvtpk(p1[4], p1[5]), cvtpk(p1[6], p1[7])};
            pw[3] = (u32x4){cvtpk(p1[8], p1[9]), cvtpk(p1[10], p1[11]), cvtpk(p1[12], p1[13]), cvtpk(p1[14], p1[15])};
#pragma unroll
            for (int d0 = 0; d0 < DVB; ++d0)
#pragma unroll
                for (int ks = 0; ks < 4; ++ks) { const s16x4 vlo = vtr(Vs + d0 * 4096 + ks * 1024), vhi = vtr(Vs + d0 * 4096 + ks * 1024 + 512);
                    const bf16x8 vf = (bf16x8){vlo[0], vlo[1], vlo[2], vlo[3], vhi[0], vhi[1], vhi[2], vhi[3]};
                    o[d0] = __builtin_amdgcn_mfma_f32_32x32x16_bf16(__builtin_bit_cast(bf16x8, pw[ks]), vf, o[d0], 0, 0, 0); }
        }
        t = tn;
    }
    l = halves_sum(l);
    if (hi == 0) wsf[32 + r32] = l;
    asm volatile("s_waitcnt lgkmcnt(0)" ::: "memory");
    float rli[16];
#pragma unroll
    for (int gq = 0; gq < 4; ++gq) { const f32x4 f = *(const LAS f32x4*)(wsf + 32 + 8 * gq + 4 * hi); rli[4 * gq + 0] = 1.0f / f[0]; rli[4 * gq + 1] = 1.0f / f[1]; rli[4 * gq + 2] = 1.0f / f[2]; rli[4 * gq + 3] = 1.0f / f[3]; }
    if constexpr (MODE == 1) {
        GAS bf16_t* Ow = (GAS bf16_t*)(A.O + (rowbase + q0 + qrel0) * PITCH + hcol);
#pragma unroll
        for (int r = 0; r < 16; ++r)
#pragma unroll
            for (int d0 = 0; d0 < DVB; ++d0) Ow[(size_t)crow(r, hi) * PITCH + d0 * 32 + r32] = (bf16_t)(cvtpk(o[d0][r] * rli[r], 0.f) & 0xFFFFu);
    } else {
        ATT_BAR();
        LAS float* X = (LAS float*)lds + wq * 4096;
        if (comp == 1) {
#pragma unroll
            for (int d0 = 0; d0 < DVB; ++d0)
#pragma unroll
                for (int r = 0; r < 16; ++r) X[(d0 * 16 + r) * 64 + lane] = o[d0][r] * rli[r];
        }
        ATT_BAR();
        if (comp == 0) {
            float sg[DVB];
#pragma unroll
            for (int d0 = 0; d0 < DVB; ++d0) sg[d0] = ((const GAS float*)A.subln)[d0 * 32 + r32] * A.out_scale;
            GAS bf16_t* Ow = (GAS bf16_t*)(A.O + (rowbase + q0 + qrel0) * PITCH + hcol);
#pragma unroll
            for (int r = 0; r < 16; ++r) { float dv[DVB]; float ss = 0.f;
#pragma unroll
                for (int d0 = 0; d0 < DVB; ++d0) { dv[d0] = o[d0][r] * rli[r] - A.lam_full * X[(d0 * 16 + r) * 64 + lane]; ss += dv[d0] * dv[d0]; }
                ss += __shfl_xor(ss, 1); ss += __shfl_xor(ss, 2); ss += __shfl_xor(ss, 4); ss += __shfl_xor(ss, 8); ss += __shfl_xor(ss, 16);
                const float rs = 1.0f / sqrtf(ss * (1.0f / 128.0f) + 1e-5f);
#pragma unroll
                for (int d0 = 0; d0 < DVB; ++d0) Ow[(size_t)crow(r, hi) * PITCH + d0 * 32 + r32] = (bf16_t)(cvtpk(dv[d0] * rs * sg[d0], 0.f) & 0xFFFFu); }
        }
    }
#undef ATT_KBASE
#undef ATT_KBASE_
#undef ATT_ISSUE
}
#undef ATT_BAR
}

constexpr int NWAVES = 8;
#ifndef MK_PER_PHASE
#define MK_PER_PHASE 1
#endif
#ifndef MK_DEBUG
#define MK_DEBUG 1
#endif
constexpr int NLAYER = 4, PH_PER_LAYER = 8, NPHASE = 1 + NLAYER * PH_PER_LAYER;

constexpr size_t MiB = 1u << 20;
constexpr size_t WS_CTL = 0, CTL_ZERO_BYTES = 1 * MiB;
constexpr size_t WS_KMEAN = 1 * MiB;
constexpr size_t WS_LTOK = 2 * MiB, WS_LW = 3 * MiB;
constexpr size_t WS_DQKV = 5 * MiB;
constexpr size_t WS_DWO = WS_DQKV + 12 * MiB;
constexpr size_t WS_MQKV = WS_DWO + 4 * MiB;
constexpr size_t WS_MWO = WS_MQKV + 12 * MiB;
constexpr size_t WS_FGU = WS_MWO + 4 * MiB;
constexpr size_t WS_FD = WS_FGU + 22 * MiB;
constexpr size_t WS_MGU = WS_FD + 11 * MiB;
constexpr size_t WS_MD = WS_MGU + 112 * MiB;
constexpr size_t WS_XN = WS_MD + 56 * MiB;
constexpr size_t WS_Q = WS_XN + 64 * MiB, WS_K = WS_Q + 64 * MiB, WS_V = WS_K + 64 * MiB;
constexpr size_t WS_ACT = WS_Q;
constexpr size_t WS_END = WS_ACT + (size_t)MOE_TILES_MAX * 256 * DE * 2;
static_assert(WS_XN == 238 * MiB && WS_END == 778 * MiB, "d_ws map");
constexpr int CW_BAR = 4096;
constexpr int CW_ATTQ = 6144;
constexpr int CW_CNT = 8192;

constexpr int RING_OFF = 0, RING_BYTES = 131072;
constexpr int LDSCTL_OFF = RING_BYTES, MISC_OFF = LDSCTL_OFF + 320;
constexpr int XSLOT_OFF = MISC_OFF + 128;
constexpr int LDS_BYTES = 147456;

typedef unsigned short bf16;
typedef unsigned v4u __attribute__((ext_vector_type(4)));
typedef float f32x4 __attribute__((ext_vector_type(4)));
typedef GAS unsigned gu32;
#define RLX_AGENT __ATOMIC_RELAXED, __HIP_MEMORY_SCOPE_AGENT
#define LDS_WAIT() asm volatile("s_waitcnt lgkmcnt(0)" ::: "memory")
#define VM_WAIT() asm volatile("s_waitcnt vmcnt(0)" ::: "memory")
__device__ __forceinline__ unsigned f2bf(float f) { unsigned u = __builtin_bit_cast(unsigned, f); return (u + 0x7fffu + ((u >> 16) & 1u)) >> 16; }
__device__ __forceinline__ unsigned pk2(float lo, float hi) { return f2bf(lo) | (f2bf(hi) << 16); }
__device__ __forceinline__ float bflo(unsigned w) { return __uint_as_float(w << 16); }
__device__ __forceinline__ float bfhi(unsigned w) { return __uint_as_float(w & 0xFFFF0000u); }
static_assert(XSLOT_OFF % 16 == 0 && XSLOT_OFF + 8192 <= LDS_BYTES, "LDS map");
#define XB_TMO      128
#define XB_XCNT(j)  (256  + 64 * (j))
#define XB_XSUB(j)  (1280 + 64 * (j))
#define XB_XGEN(j)  (2304 + 64 * (j))
#define XB_TOP      3328
#define XB_TOPGEN   3392
#define XCD_BAR_WORDS 3456
#define XB_SPIN_CAP (1u << 18)

__device__ __forceinline__ unsigned xb_ld(unsigned* p)              { return __hip_atomic_load(p, __ATOMIC_RELAXED, __HIP_MEMORY_SCOPE_AGENT); }
__device__ __forceinline__ unsigned xb_add(unsigned* p, unsigned v) { return __hip_atomic_fetch_add(p, v, __ATOMIC_RELAXED, __HIP_MEMORY_SCOPE_AGENT); }
__device__ __forceinline__ unsigned xb_xcc_id() { return (unsigned)__builtin_amdgcn_s_getreg((3 << 11) | 20) & 0xFu; }
#define XB_SPIN(cond, bar) do { unsigned _sp = 0; while (cond) { __builtin_amdgcn_s_sleep(1); \
    if ((++_sp & 255u) == 0u) { if (xb_ld(&(bar)[XB_TMO])) break; if (_sp > XB_SPIN_CAP) { atomicAdd(&(bar)[XB_TMO], 1u); break; } } } } while (0)

struct XcdBarrier {
    unsigned* bar; unsigned x;
    volatile LAS unsigned* st;
};

__device__ __forceinline__ XcdBarrier xcd_barrier_post(unsigned* bar, volatile LAS unsigned* st) {
    XcdBarrier b; b.bar = bar; b.x = xb_xcc_id(); b.st = st;
    if (threadIdx.x == 0) (void)xb_add(&bar[XB_XCNT(b.x)], 1u);
    return b;
}
__device__ __forceinline__ void xcd_barrier_complete(unsigned* bar, unsigned x, unsigned& nloc, unsigned& nx) {
    const unsigned G = gridDim.x * gridDim.y * gridDim.z;
    unsigned sum, cnt, mine, sp = 0u;
    for (;;) {
        sum = 0u; cnt = 0u; mine = 0u;
#pragma unroll
        for (unsigned j = 0; j < 16; ++j) { const unsigned c = xb_ld(&bar[XB_XCNT(j)]); sum += c; cnt += (c > 0u) ? 1u : 0u; mine = (j == x) ? c : mine; }
        if (sum == G) break;
        __builtin_amdgcn_s_sleep(1);
        if ((++sp & 255u) == 0u) { if (xb_ld(&bar[XB_TMO])) break; if (sp > XB_SPIN_CAP) { atomicAdd(&bar[XB_TMO], 1u); break; } }
    }
    nloc = mine > 0u ? mine : 1u; nx = cnt > 0u ? cnt : 1u;
}

__device__ __forceinline__ void xcd_barrier(const XcdBarrier& b) {
    asm volatile("s_waitcnt vmcnt(0)" ::: "memory");
    __syncthreads();
    if (threadIdx.x == 0) {
        unsigned* bar = b.bar;
        __builtin_amdgcn_s_waitcnt(0);
        unsigned nloc = b.st[0], nx = b.st[1];
        if (nloc == 0u) { xcd_barrier_complete(bar, b.x, nloc, nx); b.st[0] = nloc; b.st[1] = nx; }
        const unsigned old = xb_add(&bar[XB_XSUB(b.x)], 1u);
        const unsigned gen = old / nloc;
        if (old + 1u == (gen + 1u) * nloc) {
            __builtin_amdgcn_fence(__ATOMIC_RELEASE, "agent");
            asm volatile("s_waitcnt vmcnt(0)" ::: "memory");
            const unsigned og = xb_add(&bar[XB_TOP], 1u);
            const unsigned tg = og / nx;
            if (og + 1u == (tg + 1u) * nx) xb_add(&bar[XB_TOPGEN], 1u);
            else XB_SPIN(xb_ld(&bar[XB_TOPGEN]) == tg, bar);
            __builtin_amdgcn_fence(__ATOMIC_ACQUIRE, "agent");
            xb_add(&bar[XB_XGEN(b.x)], 1u);
            asm volatile("s_waitcnt vmcnt(0)" ::: "memory");
        } else {
            XB_SPIN(xb_ld(&bar[XB_XGEN(b.x)]) == gen, bar);
            __builtin_amdgcn_fence(__ATOMIC_ACQUIRE, "agent");
            asm volatile("s_waitcnt vmcnt(0)" ::: "memory");
        }
    }
    __syncthreads();
}

struct Frame {
    LAS unsigned char* lds;
    volatile LAS unsigned* MISC;
    gu32* ctl;
    int tid, lane, wave;
    int vcu, G;
};
__device__ __forceinline__ float wave_sum(float v) {
#pragma unroll
    for (int o = 1; o < 64; o <<= 1) v += __shfl_xor(v, o);
    return v;
}
__device__ __forceinline__ void transpose_item(const float* W, int K, int N, bf16* WT, int k0, int n0, int drow0, LAS float* scr, int lane) {
#pragma unroll 8
    for (int i = 0; i < 32; ++i) { const int kk = 2 * i + (lane >> 5); scr[kk * 33 + (lane & 31)] = ((const GAS float*)W)[(size_t)(k0 + kk) * N + n0 + (lane & 31)]; }
    LDS_WAIT(); asm volatile("" ::: "memory");
    const int c = lane & 7;
#pragma unroll
    for (int j = 0; j < 4; ++j) { const int n = (lane >> 3) + 8 * j; const LAS float* s = scr + (8 * c) * 33 + n;
        v4u o; o.x = pk2(s[0 * 33], s[1 * 33]); o.y = pk2(s[2 * 33], s[3 * 33]); o.z = pk2(s[4 * 33], s[5 * 33]); o.w = pk2(s[6 * 33], s[7 * 33]);
        *(GAS v4u*)(WT + (size_t)(drow0 + n) * K + k0 + 8 * c) = o; }
    LDS_WAIT(); asm volatile("" ::: "memory");
}
__device__ __forceinline__ void convert_matrix(Frame& F, const float* W, int K, int N, bf16* WT, int il, unsigned& rot) {
    LAS float* scr = (LAS float*)(F.lds + RING_OFF + F.wave * 16384);
    const unsigned gw = (unsigned)(F.vcu * NWAVES + F.wave), NGW = (unsigned)(F.G * NWAVES);
    const int nblk = N / 32, nitems = (K / 64) * nblk; int lane_ = F.lane; asm volatile("" : "+v"(lane_));
    for (int it = (int)((gw + NGW - rot % NGW) % NGW); it < nitems; it += (int)NGW) {
        const int kb = it / nblk, nb = it % nblk, n0 = 32 * nb;
        const int drow0 = il == 0 ? n0 : (n0 / 128) * 256 + (il - 1) * 128 + (n0 % 128);
        transpose_item(W, K, N, WT, 64 * kb, n0, drow0, scr, lane_);
    }
    rot = (rot + (unsigned)nitems) % NGW;
}

struct RouterArgs { const float* router; gu32* cnt; unsigned* ltok; float* lw; };
template <int MODE>
__device__ __forceinline__ void norm_phase(Frame& F, const float* src, float* hout, const bf16* y1, const float* gain, bf16* xn, float* fout, const RouterArgs& R) {
    int lane_ = F.lane; asm volatile("" : "+v"(lane_));
    const int gw = F.vcu * NWAVES + F.wave, NGW = F.G * NWAVES, lane = lane_;
    f32x4 gv[4];
#pragma unroll
    for (int j = 0; j < 4; ++j) gv[j] = *(const GAS f32x4*)(gain + 256 * j + 4 * lane);
    LAS float* RL = (LAS float*)(F.lds + RING_OFF);
    if constexpr (MODE == 2) {
        int tid_ = F.tid; asm volatile("" : "+v"(tid_));
        for (int i = tid_; i < 8192; i += NWAVES * 64) RL[(i & 7) * 1024 + (i >> 3)] = ((const GAS float*)R.router)[i];
        LDS_WAIT(); __syncthreads();
    }
    const int nrows_w = gw < MTOK ? (MTOK - gw + NGW - 1) / NGW : 0;
    for (int cb = 0; cb < nrows_w; cb += 64) {
        int my_t = 0, my_e0 = 0, my_e1 = 0; float my_w0 = 0.f, my_w1 = 0.f; bool valid = false;
        const int cn = (nrows_w - cb) < 64 ? (nrows_w - cb) : 64;
        for (int i = 0; i < cn; ++i) {
            const int row = gw + (cb + i) * NGW;
            const GAS f32x4* xr = (const GAS f32x4*)(src + (size_t)row * D) + lane;
            f32x4 v[4]; float s = 0.f;
#pragma unroll
            for (int j = 0; j < 4; ++j) v[j] = xr[64 * j];
            if constexpr (MODE == 1 || MODE == 3) {
                const GAS unsigned long long* yr = (const GAS unsigned long long*)(y1 + (size_t)row * D) + lane;
#pragma unroll
                for (int j = 0; j < 4; ++j) { const unsigned long long w = yr[64 * j]; const unsigned lo = (unsigned)w, hi = (unsigned)(w >> 32);
                    v[j].x += bflo(lo); v[j].y += bfhi(lo); v[j].z += bflo(hi); v[j].w += bfhi(hi); }
            }
#pragma unroll
            for (int j = 0; j < 4; ++j) s += (v[j].x * v[j].x + v[j].y * v[j].y) + (v[j].z * v[j].z + v[j].w * v[j].w);
            if constexpr (MODE == 1) { GAS f32x4* hr = (GAS f32x4*)(hout + (size_t)row * D) + lane;
#pragma unroll
                for (int j = 0; j < 4; ++j) hr[64 * j] = v[j]; }
            const float rstd = 1.f / sqrtf(wave_sum(s) * (1.f / D) + 1e-6f);
#pragma unroll
            for (int j = 0; j < 4; ++j) v[j] = v[j] * rstd * gv[j];
            if constexpr (MODE == 3) { GAS f32x4* orow = (GAS f32x4*)(fout + (size_t)row * D) + lane;
#pragma unroll
                for (int j = 0; j < 4; ++j) orow[64 * j] = v[j];
            } else {
                GAS unsigned long long* o8 = (GAS unsigned long long*)(xn + (size_t)row * D) + lane;
#pragma unroll
                for (int j = 0; j < 4; ++j) o8[64 * j] = (unsigned long long)pk2(v[j].x, v[j].y) | ((unsigned long long)pk2(v[j].z, v[j].w) << 32);
            }
            if constexpr (MODE == 2) {
                float lg[NE];
#pragma unroll
                for (int e = 0; e < NE; ++e) { float a = 0.f;
#pragma unroll
                    for (int j = 0; j < 4; ++j) { const f32x4 rr = *(const LAS f32x4*)(RL + e * 1024 + 256 * j + 4 * lane); a += (v[j].x * rr.x + v[j].y * rr.y) + (v[j].z * rr.z + v[j].w * rr.w); }
                    lg[e] = wave_sum(a); }
                int e0 = 0; float v0 = lg[0];
#pragma unroll
                for (int e = 1; e < NE; ++e) if (lg[e] > v0) { v0 = lg[e]; e0 = e; }
                int e1 = -1; float v1 = 0.f;
#pragma unroll
                for (int e = 0; e < NE; ++e) if (e != e0 && (e1 < 0 || lg[e] > v1)) { v1 = lg[e]; e1 = e; }
                const float w0 = 1.f / (1.f + __expf(v1 - v0));
                if (lane == i) { my_t = row; my_e0 = e0; my_e1 = e1; my_w0 = w0; my_w1 = 1.f - w0; valid = true; }
            }
        }
        if constexpr (MODE == 2) {
            unsigned myc = 0u;
#pragma unroll
            for (int e = 0; e < NE; ++e) { const unsigned long long b0 = __ballot(valid && my_e0 == e), b1 = __ballot(valid && my_e1 == e);
                const unsigned c = (unsigned)(__popcll(b0) + __popcll(b1)); if (lane == e) myc = c; }
            unsigned basev = 0u;
            if (lane < NE) basev = __hip_atomic_fetch_add(R.cnt + 64 * lane, myc, RLX_AGENT);
            const unsigned long long lt = (1ull << lane) - 1ull;
            unsigned pos0 = 0u, pos1 = 0u;
#pragma unroll
            for (int e = 0; e < NE; ++e) { const unsigned long long b0 = __ballot(valid && my_e0 == e), b1 = __ballot(valid && my_e1 == e);
                const unsigned be = (unsigned)__shfl((int)basev, e);
                if (my_e0 == e) pos0 = be + (unsigned)__popcll(b0 & lt);
                if (my_e1 == e) pos1 = be + (unsigned)__popcll(b0) + (unsigned)__popcll(b1 & lt); }
            if (valid) {
                ((GAS unsigned*)R.ltok)[(size_t)my_e0 * LIST_CAP + pos0] = (unsigned)my_t;             ((GAS float*)R.lw)[(size_t)my_e0 * LIST_CAP + pos0] = my_w0;
                ((GAS unsigned*)R.ltok)[(size_t)my_e1 * LIST_CAP + pos1] = (unsigned)my_t | (1u << 20); ((GAS float*)R.lw)[(size_t)my_e1 * LIST_CAP + pos1] = my_w1;
            }
        }
    }
    if constexpr (MODE == 2) { LDS_WAIT(); __syncthreads(); }
}

__device__ __forceinline__ void kstat_phase(Frame& F, const bf16* Kt, float* kmean, float* kmax2) {
    int lane_ = F.lane; asm volatile("" : "+v"(lane_));
    const int gw = F.vcu * NWAVES + F.wave, NGW = F.G * NWAVES, lane = lane_;
    for (int task = gw; task < BATCH * 16 * 8; task += NGW) {
        const int c8 = task & 7, n = (task >> 3) & 15, b = task >> 7;
        const GAS unsigned* p = (const GAS unsigned*)(Kt + ((size_t)b * SEQ + 256 * n) * D + c8 * 128) + lane;
        float a0 = 0.f, a1 = 0.f, mx = 0.f;
#pragma unroll 8
        for (int r = 0; r < 256; ++r) { const unsigned w = p[(size_t)r * (D / 2)]; const float v0 = bflo(w), v1 = bfhi(w); a0 += v0; a1 += v1;
            float s = v0 * v0 + v1 * v1; s += __shfl_xor(s, 1); s += __shfl_xor(s, 2); s += __shfl_xor(s, 4); s += __shfl_xor(s, 8); s += __shfl_xor(s, 16); mx = fmaxf(mx, s); }
        const int col = c8 * 128 + 2 * lane, hh = col >> 6, d = col & 63;
        GAS float* o = (GAS float*)(kmean + ((size_t)(b * 16 + hh) * 16 + n) * 64 + d);
        o[0] = a0 * (1.f / 256.f); o[1] = a1 * (1.f / 256.f);
        if ((lane & 31) == 0) ((GAS float*)kmax2)[(size_t)(b * 16 + hh) * 16 + n] = mx;
    }
}

struct KArgs { const float* in[17]; float* out; unsigned char* ws; int ph_lo, ph_hi; };
__global__ void __launch_bounds__(NWAVES * 64, 2) trunk_fwd(KArgs args) {
    extern __shared__ __attribute__((aligned(16))) unsigned char lds[];
    Frame F;
    F.lds = (LAS unsigned char*)lds;
    F.MISC = (volatile LAS unsigned*)(F.lds + MISC_OFF);
    F.tid = threadIdx.x; F.lane = F.tid & 63; F.wave = __builtin_amdgcn_readfirstlane(F.tid >> 6);
    F.G = gridDim.x; { const int bx = blockIdx.x; F.vcu = (F.G % 8 == 0) ? (bx % 8) * (F.G / 8) + bx / 8 : bx; }
    F.ctl = (gu32*)(args.ws + WS_CTL);
    for (int u = F.tid; u < (LDS_BYTES - LDSCTL_OFF) / 4; u += NWAVES * 64) ((LAS unsigned*)(F.lds + LDSCTL_OFF))[u] = 0u;
    __syncthreads();
    Frame& F0 = F;
    const int lo = args.ph_lo, hi = args.ph_hi;
    XcdBarrier bar; bar.bar = (unsigned*)(F.ctl + CW_BAR); bar.x = 0; bar.st = nullptr;
    if (hi - lo > 1) bar = xcd_barrier_post((unsigned*)(F.ctl + CW_BAR), F.MISC + 8);
#define IN(k) (lo <= (k) && (k) < hi)
#ifndef PH_ENABLE
#define PH_ENABLE 0xFFFFFFFFu
#endif
#define PHEN(n) (((PH_ENABLE) >> (n)) & 1u)
#ifndef MK_DOUBLE
#define MK_DOUBLE 0u
#endif
#define NREP(n) ((((MK_DOUBLE) >> (n)) & 1u) ? 2 : 1)
#if defined(NO_OPQ)
#define OPQ(p) do {} while (0)
#else
#define OPQ(p) asm volatile("" : "+s"(p))
#endif
#if 0
#define STAMP(k) do { if (blockIdx.x == 0 && threadIdx.x == 0) { const unsigned long long t_ = __builtin_amdgcn_s_memrealtime(); ((GAS unsigned*)(F0.ctl))[3000 + (k)] = (unsigned)t_; } } while (0)
#else
#define STAMP(k) do {} while (0)
#endif
#define SEAM(k) do { if (IN(k) && IN((k) + 1)) { XcdBarrier b2_ = bar; OPQ(b2_.bar); xcd_barrier(b2_); } STAMP((k) + 1); } while (0)

#define PTRS() unsigned char* ws = args.ws; OPQ(ws); const float* x = args.in[0]; OPQ(x); const float* norm_mix = args.in[1]; OPQ(norm_mix); const float* norm_ffn = args.in[2]; OPQ(norm_ffn); \
    float* h = args.out; OPQ(h); \
    bf16* XN = (bf16*)(ws + WS_XN); bf16* Qb = (bf16*)(ws + WS_Q); bf16* Kb = (bf16*)(ws + WS_K); bf16* Vb = (bf16*)(ws + WS_V); bf16* ACT = (bf16*)(ws + WS_ACT); \
    bf16* MGU = (bf16*)(ws + WS_MGU); bf16* MD = (bf16*)(ws + WS_MD); \
    float* kmean = (float*)(ws + WS_KMEAN); unsigned* ltok = (unsigned*)(ws + WS_LTOK); float* lw = (float*)(ws + WS_LW); \
    (void)x; (void)norm_mix; (void)norm_ffn; (void)h; (void)XN; (void)Qb; (void)Kb; (void)Vb; (void)ACT; (void)MGU; (void)MD; (void)kmean; (void)ltok; (void)lw
    const RouterArgs noR{nullptr, nullptr, nullptr, nullptr};
    constexpr float C2 = 0.125f * 1.4426950408889634f;

    STAMP(0);
    if (PHEN(0) && IN(0)) {
        PTRS();
        unsigned rot = 0u;
        for (int j = 0; j < 2; ++j) {
            convert_matrix(F, args.in[3] + (size_t)j * D * 3 * D, D, 3 * D, (bf16*)(ws + WS_DQKV) + (size_t)j * 3 * D * D, 0, rot);
            convert_matrix(F, args.in[4] + (size_t)j * D * D, D, D, (bf16*)(ws + WS_DWO) + (size_t)j * D * D, 0, rot);
            convert_matrix(F, args.in[7] + (size_t)j * D * 3 * D, D, 3 * D, (bf16*)(ws + WS_MQKV) + (size_t)j * 3 * D * D, 0, rot);
            convert_matrix(F, args.in[8] + (size_t)j * D * D, D, D, (bf16*)(ws + WS_MWO) + (size_t)j * D * D, 0, rot);
            convert_matrix(F, args.in[9] + (size_t)j * D * DFF, D, DFF, (bf16*)(ws + WS_FGU) + (size_t)j * 2 * DFF * D, 1, rot);
            convert_matrix(F, args.in[10] + (size_t)j * D * DFF, D, DFF, (bf16*)(ws + WS_FGU) + (size_t)j * 2 * DFF * D, 2, rot);
            convert_matrix(F, args.in[11] + (size_t)j * DFF * D, DFF, D, (bf16*)(ws + WS_FD) + (size_t)j * D * DFF, 0, rot);
        }
        for (int e = 0; e < NE; ++e) {
            convert_matrix(F, args.in[13] + (size_t)e * D * DE, D, DE, MGU + (size_t)e * 2 * DE * D, 1, rot);
            convert_matrix(F, args.in[14] + (size_t)e * D * DE, D, DE, MGU + (size_t)e * 2 * DE * D, 2, rot);
            convert_matrix(F, args.in[15] + (size_t)e * DE * D, DE, D, MD + (size_t)e * D * DE, 0, rot);
        }
        norm_phase<0>(F, x, nullptr, nullptr, norm_mix, XN, nullptr, noR);
    }
    SEAM(0);

    for (int L = 0; L < NLAYER; ++L) {
        const int j = L >> 1, moba = L & 1, pb = 1 + PH_PER_LAYER * L;
        int z_ = 0;
#if !defined(NO_OPQ_Z)
        asm volatile("" : "+s"(z_));
#endif
        Frame Fl = F0; Fl.G += z_; Fl.vcu += z_; Fl.wave += z_; Fl.lds += z_; Fl.ctl += z_; const int bx = (int)blockIdx.x + z_;
#define F Fl
        if (PHEN(1) && IN(pb + 0)) {
            PTRS();

            const bf16* W = (const bf16*)(ws + (moba ? WS_MQKV : WS_DQKV)) + (size_t)j * 3 * D * D;
            pg8::Gemm g{XN, W, D, 0, (unsigned)((size_t)MTOK * D * 2 - 16), (unsigned*)F.ctl + 2048, (size_t)3 * D * D * 2}; pg8::StaticOrder S; S.init(MTOK, 3 * D, F.G, bx);
            pg8::EpiQKV E{Qb, D, D, (size_t)(WS_K - WS_Q) / 2, C2, (unsigned*)F.ctl + 2048};
            for (int rep_ = 0; rep_ < NREP(1); ++rep_) pg8::gemm_phase<pg8::EpiQKV, pg8::StaticOrder>(F.lds + RING_OFF, XSLOT_OFF, g, S, E);
        }
        SEAM(pb + 0);
        { if (PHEN(2) && IN(pb + 1)) { PTRS(); kstat_phase(F, Kb, kmean, kmean + 8 * 16 * 16 * 64); } SEAM(pb + 1); }
        if (IN(pb + 2)) {
            PTRS();
            att::Args A; A.Q = Qb; A.K = Kb; A.V = Vb; A.O = XN; A.kmean = kmean; A.kmax2 = kmean + 8 * 16 * 16 * 64; A.subln = args.in[6] + (size_t)j * 128; A.lam_full = 0.f; A.out_scale = 1.f;
            gu32* qctr = F.ctl + CW_ATTQ + 64 * L; LAS int* qw = (LAS int*)(F.lds + RING_OFF + 71680 + 260);
            if (!moba) {
                const float* lam = args.in[5] + (size_t)j * 256; int lane = F.lane; asm volatile("" : "+v"(lane));
                const GAS float* lamg = (const GAS float*)lam; const float s1 = wave_sum(lamg[lane] * lamg[64 + lane]), s2 = wave_sum(lamg[128 + lane] * lamg[192 + lane]);
                const float lam_init = (L == 0) ? 0.2f : 0.47071302f;
                A.lam_full = __uint_as_float(__builtin_amdgcn_readfirstlane(__float_as_uint(__expf(s1) - __expf(s2) + lam_init))); A.out_scale = __uint_as_float(__builtin_amdgcn_readfirstlane(__float_as_uint(1.0f - lam_init)));
            }
            if ((PHEN(3) && !moba) || (PHEN(4) && moba)) for (;;) {
                if (F.tid == 0) *qw = (int)__hip_atomic_fetch_add(qctr, 1u, RLX_AGENT);
                asm volatile("s_waitcnt vmcnt(0) lgkmcnt(0)\n\ts_barrier" ::: "memory");
                const int idx = __builtin_amdgcn_readfirstlane(*qw);
                if (idx >= 1024) break;
                if (!moba) { const int hh = 7 - (idx >> 7), bb = (idx >> 4) & 7, pr = idx & 15;
                    att::attn_unit<0>(F.lds + RING_OFF, A, bb, hh, pr);
                    att::attn_unit<0>(F.lds + RING_OFF, A, bb, hh, 31 - pr);
                } else { const int hh = 15 - (idx >> 6), bb = (idx >> 3) & 7, pr = idx & 7;
                    att::attn_unit<1>(F.lds + RING_OFF, A, bb, hh, pr);
                    att::attn_unit<1>(F.lds + RING_OFF, A, bb, hh, 15 - pr); }
            }
            asm volatile("s_waitcnt vmcnt(0) lgkmcnt(0)\n\ts_barrier" ::: "memory");
        }
        SEAM(pb + 2);
        if (PHEN(5) && IN(pb + 3)) {
            PTRS();
            const bf16* W = (const bf16*)(ws + (moba ? WS_MWO : WS_DWO)) + (size_t)j * D * D;
            pg8::Gemm g{XN, W, D, 0, (unsigned)((size_t)MTOK * D * 2 - 16), (unsigned*)F.ctl + 2048, (size_t)D * D * 2}; pg8::StaticOrder S; S.init(MTOK, D, F.G, bx);
            pg8::EpiRes E{L == 0 ? x : h, h, D};
            pg8::gemm_phase<pg8::EpiRes, pg8::StaticOrder>(F.lds + RING_OFF, XSLOT_OFF, g, S, E);
        }
        SEAM(pb + 3);
        if (PHEN(6) && IN(pb + 4)) {
            PTRS();
            if (!moba) {
                norm_phase<0>(F, h, nullptr, nullptr, norm_ffn + (size_t)L * D, XN, nullptr, noR);
                if (L == 2) { unsigned rot = 0u;
                    for (int e = 0; e < NE; ++e) {
                        convert_matrix(F, args.in[13] + (size_t)(NE + e) * D * DE, D, DE, MGU + (size_t)e * 2 * DE * D, 1, rot);
                        convert_matrix(F, args.in[14] + (size_t)(NE + e) * D * DE, D, DE, MGU + (size_t)e * 2 * DE * D, 2, rot);
                        convert_matrix(F, args.in[15] + (size_t)(NE + e) * DE * D, DE, D, MD + (size_t)e * D * DE, 0, rot);
                    } }
            } else {
                const RouterArgs R{args.in[12] + (size_t)j * D * NE, F.ctl + CW_CNT + 64 * NE * j, ltok, lw};
                norm_phase<2>(F, h, nullptr, nullptr, norm_ffn + (size_t)L * D, XN, nullptr, R);
            }
        }
        SEAM(pb + 4);
        if (IN(pb + 5)) {
            PTRS();
            if (PHEN(7) && !moba) {
                pg8::Gemm g{XN, (const bf16*)(ws + WS_FGU) + (size_t)j * 2 * DFF * D, D, 0, (unsigned)((size_t)MTOK * D * 2 - 16), (unsigned*)F.ctl + 2048, (size_t)2 * DFF * D * 2}; pg8::StaticOrder S; S.init(MTOK, 2 * DFF, F.G, bx);
                pg8::EpiSwiGLU E{ACT, DFF};
                for (int rep_ = 0; rep_ < NREP(7); ++rep_) pg8::gemm_phase<pg8::EpiSwiGLU, pg8::StaticOrder>(F.lds + RING_OFF, XSLOT_OFF, g, S, E);
            } else if (PHEN(8) && moba) {
                pg8::Gemm g{XN, MGU, D, (size_t)2 * DE * D, (unsigned)((size_t)MTOK * D * 2 - 16), (unsigned*)F.ctl + 2048, (size_t)NE * 2 * DE * D * 2}; pg8::MoeOrder S; S.init((const unsigned*)(F.ctl + CW_CNT + 64 * NE * j), ltok, true, 2 * DE, F.G, bx);
                pg8::EpiSwiGLU E{ACT, DE};
                for (int rep_ = 0; rep_ < NREP(8); ++rep_) pg8::gemm_phase<pg8::EpiSwiGLU, pg8::MoeOrder>(F.lds + RING_OFF, XSLOT_OFF, g, S, E);
            }
        }
        SEAM(pb + 5);
        if (IN(pb + 6)) {
            PTRS();
            if (PHEN(9) && !moba) {
                pg8::Gemm g{ACT, (const bf16*)(ws + WS_FD) + (size_t)j * D * DFF, DFF, 0, (unsigned)((size_t)MTOK * DFF * 2 - 16), (unsigned*)F.ctl + 2048, (size_t)D * DFF * 2}; pg8::StaticOrder S; S.init(MTOK, D, F.G, bx);
                pg8::EpiRes E{h, h, D};
                pg8::gemm_phase<pg8::EpiRes, pg8::StaticOrder>(F.lds + RING_OFF, XSLOT_OFF, g, S, E);
            } else if (PHEN(10) && moba) {
                pg8::Gemm g{ACT, MD, DE, (size_t)D * DE, (unsigned)((size_t)MOE_TILES_MAX * 256 * DE * 2 - 16), (unsigned*)F.ctl + 2048, (size_t)NE * D * DE * 2}; pg8::MoeOrder S; S.init((const unsigned*)(F.ctl + CW_CNT + 64 * NE * j), ltok, false, D, F.G, bx);
                pg8::EpiMoeDown E; E.h = h; E.y1 = XN; E.list_tok = ltok; E.list_w = lw;
#pragma unroll
                for (int e = 0; e < NE; ++e) E.cnt[e] = S.cnt[e];
                pg8::gemm_phase<pg8::EpiMoeDown, pg8::MoeOrder>(F.lds + RING_OFF, XSLOT_OFF, g, S, E);
            }
        }
        SEAM(pb + 6);
        if (PHEN(11) && IN(pb + 7)) {
            PTRS();
            if (L == 3) norm_phase<3>(F, h, nullptr, XN, args.in[16], nullptr, h, noR);
            else if (moba) norm_phase<1>(F, h, h, XN, norm_mix + (size_t)(L + 1) * D, XN, nullptr, noR);
            else norm_phase<0>(F, h, nullptr, nullptr, norm_mix + (size_t)(L + 1) * D, XN, nullptr, noR);
        }
        if (L != NLAYER - 1) SEAM(pb + 7); else STAMP(pb + 8);
#undef F
    }
#undef IN
#undef SEAM
#undef PTRS
#undef OPQ
}


#if MK_DEBUG
__global__ void dbg_probe(const void* buf, size_t n, int is_bf16, int idx, float thresh, unsigned* dbg) {
    size_t i = blockIdx.x * (size_t)blockDim.x + threadIdx.x, stride = (size_t)gridDim.x * blockDim.x; bool bad = false;
    for (size_t k = i; k < n; k += stride) { float v = is_bf16 ? __uint_as_float(((unsigned)((const unsigned short*)buf)[k]) << 16) : ((const float*)buf)[k]; if (!(fabsf(v) <= thresh)) bad = true; }
    if (bad) atomicMax(dbg, (unsigned)(1000 - idx));
}
__global__ void dbg_cnt(const unsigned* cntw, int idx, unsigned* dbg) {
    if (threadIdx.x == 0 && blockIdx.x == 0) { unsigned s = 0; for (int e = 0; e < NE; ++e) s += cntw[64 * e]; if (s != 2u * MTOK) atomicMax(dbg, (unsigned)(1000 - idx)); }
}

__device__ __forceinline__ float dbg_bf(unsigned short v) { return __uint_as_float(((unsigned)v) << 16); }
__device__ __forceinline__ unsigned dbg_hash(unsigned x) { x ^= x >> 16; x *= 0x7feb352dU; x ^= x >> 15; x *= 0x846ca68bU; x ^= x >> 16; return x; }
__global__ void dbg_gemm_check(const unsigned short* A, int lda, const unsigned short* Bt, int K, const unsigned short* out, int ldo, int M, int N, float scale, int idx, unsigned* dbg) {
    const unsigned s = blockIdx.x * blockDim.x + threadIdx.x; const int row = (int)(dbg_hash(2 * s + 1) % (unsigned)M), col = (int)(dbg_hash(2 * s + 2) % (unsigned)N);
    float acc = 0.f; for (int k = 0; k < K; ++k) acc += dbg_bf(A[(size_t)row * lda + k]) * dbg_bf(Bt[(size_t)col * K + k]);
    acc *= scale; const float got = dbg_bf(out[(size_t)row * ldo + col]);
    if (!(fabsf(got - acc) <= 0.03f + 0.02f * fabsf(acc))) { atomicMax(dbg, (unsigned)(1000 - idx)); atomicAdd(dbg + 64 + idx, 1u); }
}
__global__ void dbg_conv_check(const float* W, int K, int N, const unsigned short* WT, int il, int idx, unsigned* dbg) {
    const unsigned s = blockIdx.x * blockDim.x + threadIdx.x; const int k = (int)(dbg_hash(2 * s + 1) % (unsigned)K), n = (int)(dbg_hash(2 * s + 2) % (unsigned)N);
    const int dr = il == 0 ? n : (n / 128) * 256 + (il - 1) * 128 + (n % 128);
    const float w = W[(size_t)k * N + n], g = dbg_bf(WT[(size_t)dr * K + k]);
    if (!(fabsf(g - w) <= 0.01f * fabsf(w) + 1e-6f)) atomicMax(dbg, (unsigned)(1000 - idx));
}
__global__ void dbg_norm_check(const float* src, const float* gain, const unsigned short* xn, int idx, unsigned* dbg) {
    const unsigned s = blockIdx.x * blockDim.x + threadIdx.x; const int row = (int)(dbg_hash(s + 77) % (unsigned)MTOK);
    float ss = 0.f; for (int c = 0; c < D; ++c) { const float v = src[(size_t)row * D + c]; ss += v * v; }
    const float rstd = 1.f / sqrtf(ss / D + 1e-6f); bool bad = false;
    for (int c = 0; c < D; ++c) { const float r = src[(size_t)row * D + c] * rstd * gain[c], g = dbg_bf(xn[(size_t)row * D + c]); if (!(fabsf(g - r) <= 0.02f + 0.01f * fabsf(r))) bad = true; }
    if (bad) atomicMax(dbg, (unsigned)(1000 - idx));
}
__global__ void dbg_naive_gemm(const unsigned short* A, const unsigned short* Bt, unsigned short* out, int M, int N, int K) {
    const size_t i = blockIdx.x * (size_t)blockDim.x + threadIdx.x; if (i >= (size_t)M * N) return; const int row = (int)(i / N), col = (int)(i % N);
    float acc = 0.f; for (int k = 0; k < K; ++k) acc += dbg_bf(A[(size_t)row * K + k]) * dbg_bf(Bt[(size_t)col * K + k]);
    out[(size_t)row * N + col] = (unsigned short)f2bf(acc);
}
__global__ void dbg_find_col(const unsigned short* out, const unsigned short* ref, int M, int N, unsigned* hist) {
    const unsigned s = blockIdx.x * blockDim.x + threadIdx.x; const int row = (int)(dbg_hash(2 * s + 1) % (unsigned)M), col = (int)(dbg_hash(2 * s + 2) % (unsigned)N);
    const unsigned short v = out[(size_t)row * N + col]; int found = -1;
#if MK_FIND_PATTERN
    if (v == 0x3C3C) atomicAdd(hist + N, 1u); else atomicAdd(hist + 5, 1u); return;
#endif
#if MK_FIND_ROWS
    for (int r = 0; r < M; ++r) if (ref[(size_t)r * N + col] == v) { found = r; break; }
    if (found < 0) atomicAdd(hist + N, 1u); else atomicAdd(hist + ((found - row) & (N - 1)), 1u);
#else
    for (int c = 0; c < N; ++c) if (ref[(size_t)row * N + c] == v) { found = c; break; }
    if (found < 0) atomicAdd(hist + N, 1u); else atomicAdd(hist + ((found - col) & (N - 1)), 1u);
#endif
}
__global__ void dbg_hist_code(const unsigned* hist, int N, unsigned* dbg) {
    if (threadIdx.x || blockIdx.x) return; unsigned best = 0, bi = 0; for (int i = 0; i < N; ++i) if (hist[i] > best) { best = hist[i]; bi = i; }
    dbg[32] = bi; dbg[33] = best; dbg[34] = hist[N];
}
__global__ void dbg_final(float* out, size_t n, const unsigned* dbg) {
    if (MK_HIST_SEL >= 10) { const float c3 = sqrtf((float)dbg[MK_HIST_SEL + 30]); size_t i3 = blockIdx.x * (size_t)blockDim.x + threadIdx.x, st3 = (size_t)gridDim.x * blockDim.x; for (size_t k3 = i3; k3 < n; k3 += st3) out[k3] = c3; return; }
    if (MK_HIST_SEL >= 0 && (dbg[33] || dbg[34])) { const float c2 = sqrtf((float)(MK_HIST_SEL == 0 ? dbg[32] : (MK_HIST_SEL == 1 ? dbg[33] * 100u / 4096u : dbg[34] * 100u / 4096u)) + 1.f); size_t i2 = blockIdx.x * (size_t)blockDim.x + threadIdx.x, st2 = (size_t)gridDim.x * blockDim.x; for (size_t k2 = i2; k2 < n; k2 += st2) out[k2] = c2; return; }
    const unsigned d = dbg[0]; if (d == 0u) return; const unsigned nf = dbg[64 + (1000u - d)]; const float c = sqrtf(nf ? (float)(200u * (1000u - d - 9u) + nf * 100u / 4096u) : (float)(1000u - d));
    size_t i = blockIdx.x * (size_t)blockDim.x + threadIdx.x, stride = (size_t)gridDim.x * blockDim.x;
    for (size_t k = i; k < n; k += stride) out[k] = c;
}
#endif

#ifndef MK_REPEAT
#define MK_REPEAT 1
#endif
#ifndef MK_FIND_ROWS
#define MK_FIND_ROWS 0
#endif
#ifndef MK_FIND_REGION
#define MK_FIND_REGION WS_K
#endif
#ifndef MK_HIST_SEL
#define MK_HIST_SEL 0
#endif
#ifndef MK_STAMP
#define MK_STAMP 0
#endif
#if MK_STAMP
__global__ void stamp_k(unsigned* p) { if (threadIdx.x == 0) *p = (unsigned)__builtin_amdgcn_s_memrealtime(); }
__global__ void stamp_encode(float* out, size_t n, const unsigned* st, int pa, float ua, int pb, float ub) {
    const float da = (float)(st[pa + 1] - st[pa]) * 0.01f, db = (float)(st[pb + 1] - st[pb]) * 0.01f;
    float m = da / ua; m = m < 10.f ? 10.f : (m > 99.f ? 99.f : m); float e = floorf(db / ub + 0.5f); e = e < 0.f ? 0.f : (e > 30.f ? 30.f : e);
    const float c = sqrtf(m) * __powf(10.f, 0.5f * e);
    size_t i = blockIdx.x * (size_t)blockDim.x + threadIdx.x, stride = (size_t)gridDim.x * blockDim.x;
    for (size_t k = i; k < n; k += stride) out[k] = c;
}
#endif
extern "C" void kernel_launch(void* const* d_in, const int* in_sizes, int n_in, void* d_out, int out_size, void* d_ws, size_t ws_size, hipStream_t stream) {
    static int grid = 0;
    if (grid == 0) {
        if (n_in != 17 || in_sizes[0] != MTOK * D || out_size != MTOK * D || ws_size < WS_END) {
            fprintf(stderr, "kernel_launch: built for 17 inputs, x/out of %d floats, >= %zu bytes of workspace; got n_in %d, in0 %d, out %d, ws %zu; nothing launched\n", MTOK * D, (size_t)WS_END, n_in, n_in > 0 ? in_sizes[0] : -1, out_size, ws_size);
            grid = -1; return; }
        int dev = 0, cus = 0, per_cu = 0;
        if (hipGetDevice(&dev) != hipSuccess || hipDeviceGetAttribute(&cus, hipDeviceAttributeMultiprocessorCount, dev) != hipSuccess) { fprintf(stderr, "kernel_launch: device query failed\n"); grid = -1; return; }
        if (hipFuncSetAttribute((const void*)trunk_fwd, hipFuncAttributeMaxDynamicSharedMemorySize, LDS_BYTES) != hipSuccess) { fprintf(stderr, "kernel_launch: hipFuncSetAttribute failed\n"); grid = -1; return; }
        if (hipOccupancyMaxActiveBlocksPerMultiprocessor(&per_cu, (const void*)trunk_fwd, NWAVES * 64, LDS_BYTES) != hipSuccess || per_cu < 1)
            fprintf(stderr, "kernel_launch: note: occupancy query reports %d workgroups per CU\n", per_cu);
        (void)hipGetLastError();
        grid = cus;
    }
    if (grid < 0) return;
    if (hipMemsetAsync((char*)d_ws + WS_CTL, 0, CTL_ZERO_BYTES, stream) != hipSuccess) { fprintf(stderr, "kernel_launch: memset failed\n"); return; }
    KArgs a{};
    for (int i = 0; i < 17; ++i) a.in[i] = (const float*)d_in[i];
    a.out = (float*)d_out; a.ws = (unsigned char*)d_ws;
#if MK_PER_PHASE
#if MK_STAMP
    hipLaunchKernelGGL(stamp_k, dim3(1), dim3(64), 0, stream, (unsigned*)d_ws + 3000);
#endif
    for (int p = 0; p < NPHASE; ++p) {
        a.ph_lo = p; a.ph_hi = p + 1;
#if MK_DEBUG
#endif
#if !defined(MK_SKIP_MAIN)
        for (int rep_ = 0; rep_ < (p == 1 ? MK_REPEAT : 1); ++rep_) hipLaunchKernelGGL(trunk_fwd, dim3(grid), dim3(NWAVES * 64), LDS_BYTES, stream, a);
#endif
#if MK_STAMP
        hipLaunchKernelGGL(stamp_k, dim3(1), dim3(64), 0, stream, (unsigned*)d_ws + 3000 + p + 1);
#endif
#if MK_DEBUG
        {   unsigned char* ws = (unsigned char*)d_ws; unsigned* dbg = (unsigned*)(ws + WS_CTL) + 2048;
            const size_t MD_ = (size_t)MTOK * D;
#define PROBE(buf, n, isbf, idx, th) if ((idx) <= MK_PROBE_MAX) hipLaunchKernelGGL(dbg_probe, dim3(2048), dim3(256), 0, stream, (const void*)(buf), (size_t)(n), isbf, idx, th, dbg)
            if (p == 0) {
                hipLaunchKernelGGL(dbg_norm_check, dim3(4), dim3(64), 0, stream, (const float*)d_in[0], (const float*)d_in[1], (const unsigned short*)(ws + WS_XN), 4, dbg);
                hipLaunchKernelGGL(dbg_conv_check, dim3(16), dim3(256), 0, stream, (const float*)d_in[3], D, 3 * D, (const unsigned short*)(ws + WS_DQKV), 0, 5, dbg);
                hipLaunchKernelGGL(dbg_conv_check, dim3(16), dim3(256), 0, stream, (const float*)d_in[9], D, DFF, (const unsigned short*)(ws + WS_FGU), 1, 6, dbg);
                hipLaunchKernelGGL(dbg_conv_check, dim3(16), dim3(256), 0, stream, (const float*)d_in[10], D, DFF, (const unsigned short*)(ws + WS_FGU), 2, 7, dbg);
                hipLaunchKernelGGL(dbg_conv_check, dim3(16), dim3(256), 0, stream, (const float*)d_in[11], DFF, D, (const unsigned short*)(ws + WS_FD), 0, 8, dbg);
                hipLaunchKernelGGL(dbg_conv_check, dim3(16), dim3(256), 0, stream, (const float*)d_in[15] + (size_t)3 * DE * D, DE, D, (const unsigned short*)(ws + WS_MD) + (size_t)3 * D * DE, 0, 9, dbg);
            }
            if (p == 1) {
                const float C2h = 0.125f * 1.4426950408889634f;
                hipLaunchKernelGGL(dbg_gemm_check, dim3(16), dim3(256), 0, stream, (const unsigned short*)(ws + WS_XN), D, (const unsigned short*)(ws + WS_DQKV), D, (const unsigned short*)(ws + WS_Q), D, MTOK, D, C2h, 10, dbg);
                hipLaunchKernelGGL(dbg_gemm_check, dim3(16), dim3(256), 0, stream, (const unsigned short*)(ws + WS_XN), D, (const unsigned short*)(ws + WS_DQKV) + (size_t)D * D, D, (const unsigned short*)(ws + WS_K), D, MTOK, D, 1.f, 11, dbg);

                hipLaunchKernelGGL(dbg_gemm_check, dim3(16), dim3(256), 0, stream, (const unsigned short*)(ws + WS_XN), D, (const unsigned short*)(ws + WS_DQKV) + (size_t)2 * D * D, D, (const unsigned short*)(ws + WS_V), D, MTOK, D, 1.f, 12, dbg);
            }
            if (0) { PROBE(ws + WS_XN, MD_, 1, 1, 10.f); PROBE(ws + WS_DQKV, (WS_MGU - WS_DQKV) / 2, 1, 2, 1.f); PROBE(ws + WS_MGU, (WS_XN - WS_MGU) / 2, 1, 3, 1.f); }
            if (p >= 1) { const int L = (p - 1) / PH_PER_LAYER, k = (p - 1) % PH_PER_LAYER; const int b = 20 + 10 * L;
                if (k == 0) PROBE(ws + WS_Q, 3 * MD_, 1, b + 0, 50.f);
                if (k == 1) PROBE(ws + WS_KMEAN, 8 * 16 * 16 * 64, 0, b + 1, 5.f);
                if (k == 2) PROBE(ws + WS_XN, MD_, 1, b + 2, 50.f);
                if (k == 3) PROBE(d_out, MD_, 0, b + 3, 300.f);
                if (k == 4) { PROBE(ws + WS_XN, MD_, 1, b + 4, 20.f); if ((L & 1) && (b + 9) <= MK_PROBE_MAX) hipLaunchKernelGGL(dbg_cnt, dim3(1), dim3(64), 0, stream, (const unsigned*)(ws + WS_CTL) + CW_CNT + 64 * NE * (L >> 1), b + 9, dbg); }
                if (k == 5) PROBE(ws + WS_ACT, (L & 1) ? (size_t)256 * 256 * DE : (size_t)MTOK * DFF, 1, b + 5, 2000.f);
                if (k == 6) { PROBE(d_out, MD_, 0, b + 6, 1000.f); if (L & 1) PROBE(ws + WS_XN, MD_, 1, b + 7, 1000.f); }
                if (k == 7 && L != 3) { PROBE(ws + WS_XN, MD_, 1, b + 8, 20.f); PROBE(d_out, MD_, 0, b + 8, 1000.f); }
            }
#undef PROBE
        }
#endif
    }
#if MK_DEBUG
    hipLaunchKernelGGL(dbg_final, dim3(2048), dim3(256), 0, stream, (float*)d_out, (size_t)MTOK * D, (const unsigned*)((unsigned char*)d_ws + WS_CTL) + 2048);
#endif
#else
    a.ph_lo = 0; a.ph_hi = NPHASE;
    hipLaunchKernelGGL(trunk_fwd, dim3(grid), dim3(NWAVES * 64), LDS_BYTES, stream, a);
#if 0
    hipLaunchKernelGGL(stamp_encode, dim3(2048), dim3(256), 0, stream, (float*)d_out, (size_t)MTOK * D, (const unsigned*)d_ws + 3000, MK_STAMP_PA, MK_STAMP_UA, MK_STAMP_PB, MK_STAMP_UB);
#endif
#endif
#if MK_STAMP
    hipLaunchKernelGGL(stamp_encode, dim3(2048), dim3(256), 0, stream, (float*)d_out, (size_t)MTOK * D, (const unsigned*)d_ws + 3000, MK_STAMP_PA, MK_STAMP_UA, MK_STAMP_PB, MK_STAMP_UB);
#endif
    const hipError_t le = hipPeekAtLastError();
    if (le != hipSuccess) fprintf(stderr, "kernel_launch: launch failed: %s\n", hipGetErrorName(le));
}
```

```cpp
#define MK_DEBUG 0
#define MK_PER_PHASE 0
#define MK_DOUBLE 0x0u
#include <hip/hip_runtime.h>
#include <cstdio>
#include <cstdint>

#ifndef MK_DEBUG
#define MK_DEBUG 1
#endif
#ifndef MK_KDEBUG
#define MK_KDEBUG 0
#endif
#define LAS __attribute__((address_space(3)))
#define GAS __attribute__((address_space(1)))

constexpr int BATCH = 8, SEQ = 4096, MTOK = BATCH * SEQ, D = 1024, DFF = 2816, DE = 3584, NE = 8;
constexpr int MOE_TILES_MAX = 272;
constexpr int LIST_CAP = MTOK;

namespace pg8 {
#define PG8_LAS __attribute__((address_space(3)))
typedef unsigned short bf16_t;
typedef short bf16x8 __attribute__((ext_vector_type(8)));
typedef float f32x4 __attribute__((ext_vector_type(4)));
typedef unsigned u32x4 __attribute__((ext_vector_type(4)));
constexpr int BM = 256, BK = 64, HALF = 128, HTB = HALF * BK * 2  , STAGE_BYTES = 8 * HTB, NXCD = 8, WGM = 8;

__host__ __device__ __forceinline__ int lds_byte(int r, int c) { const int st = (r >> 4) * 2 + (c >> 5), rr = r & 15, cc = c & 31, ob = rr * 64 + cc * 2; return st * 1024 + (ob ^ (((ob >> 9) & 1) << 5)); }
__host__ __device__ __forceinline__ void stage_rc(int b, int& R, int& C) { const int st = b / 1024, sb = b % 1024, swz = sb ^ (((sb >> 9) & 1) << 5); R = (st >> 1) * 16 + swz / 64; C = (st & 1) * 32 + (swz % 64) / 2; }
__host__ __device__ __forceinline__ int perm32(int rho) { const int n = rho >> 4, i = rho & 15; return 8 * (i >> 2) + 4 * n + (i & 3); }

struct Unit { int pm, pn, e, r0; };
struct Gemm { const bf16_t* A; const bf16_t* Bt; int K; size_t bstride; unsigned amax; unsigned* dbg; size_t bbytes; };

__device__ __forceinline__ void tile_of(int L, int nM, int nN, int& pm, int& pn) {
    const int nwg = nM * nN; int wgid = L; { const int q = nwg / NXCD, r = nwg % NXCD, xcd = wgid % NXCD, off = wgid / NXCD; wgid = (xcd < r ? xcd * (q + 1) : r * (q + 1) + (xcd - r) * q) + off; }
    const int nig = WGM * nN, gid = wgid / nig, fm = gid * WGM, gsz = (nM - fm) < WGM ? (nM - fm) : WGM;
    pm = fm + ((wgid % nig) % gsz); pn = (wgid % nig) / gsz;
}
struct StaticOrder {
    int nM, nN, nwg, G, c;
    __device__ __forceinline__ void init(int M, int N, int G_, int c_) { nM = M / BM; nN = N / BM; nwg = nM * nN; G = G_; c = c_; }
    __device__ __forceinline__ bool next(int i, Unit& u) const {
        const long L = (long)i * G + c; if (L >= nwg) return false;
        tile_of((int)L, nM, nN, u.pm, u.pn); u.e = 0; u.r0 = 0; return true;
    }
    __device__ __forceinline__ unsigned arow(const Unit& u, int lr) const { return (unsigned)(u.pm * BM + lr); }
};
struct MoeOrder {
    int nM, nN, nwg, G, c; int tstart[NE + 1]; int cnt[NE]; const unsigned* list_tok; bool gather;
    __device__ __forceinline__ void init(const unsigned* cntw, const unsigned* list_tok_, bool gather_, int N, int G_, int c_) {
        int acc = 0;
#pragma unroll
        for (int e = 0; e < NE; ++e) { const int ce = (int)__builtin_amdgcn_readfirstlane((int)__hip_atomic_load((const GAS unsigned*)cntw + 64 * e, __ATOMIC_RELAXED, __HIP_MEMORY_SCOPE_AGENT)); cnt[e] = ce; tstart[e] = acc; acc += (ce + BM - 1) / BM; }
        tstart[NE] = acc; nM = acc; nN = N / BM; nwg = nM * nN; G = G_; c = c_; list_tok = list_tok_; gather = gather_;
    }
    __device__ __forceinline__ bool next(int i, Unit& u) const {
        const long L = (long)i * G + c; if (L >= nwg) return false;
        tile_of((int)L, nM, nN, u.pm, u.pn); int e = 0;
#pragma unroll
        for (int k = 1; k < NE; ++k) e += (u.pm >= tstart[k]) ? 1 : 0;
        u.e = e; int ts = 0;
#pragma unroll
        for (int k = 0; k < NE; ++k) ts = (k == e) ? tstart[k] : ts;
        u.r0 = (u.pm - ts) * BM; return true;
    }
    __device__ __forceinline__ int count_of(int e) const { int cv = 0;
#pragma unroll
        for (int k = 0; k < NE; ++k) cv = (k == e) ? cnt[k] : cv;
        return cv; }
    __device__ __forceinline__ unsigned arow(const Unit& u, int lr) const {
        if (!gather) return (unsigned)(u.pm * BM + lr);
        const int l = u.r0 + lr; const int cv = count_of(u.e);
        unsigned t = 0u; if (l < cv) t = __hip_atomic_load((const GAS unsigned*)list_tok + (size_t)u.e * LIST_CAP + l, __ATOMIC_RELAXED, __HIP_MEMORY_SCOPE_AGENT) & 0xFFFFFu;
        return t;
    }
};

__device__ __forceinline__ unsigned cvt_pk_bf16(float lo, float hi) { unsigned r; asm volatile("v_cvt_pk_bf16_f32 %0, %1, %2" : "=v"(r) : "v"(lo), "v"(hi)); return r; }

struct EpiQKV {
    static constexpr bool PERM = true;
    bf16_t* O; int ldc; int split_cols; size_t split_stride; float scale0; unsigned* dbg;
    __device__ __forceinline__ void operator()(const f32x4 (&acc)[2][2][4][2], const Unit& u, int wr, int wc, int fr, int fq) const {
        const int row0 = u.pm * BM + wr * 64 + fr; int colt = u.pn * BM; bf16_t* base = O;
        float sc = 1.f; { const int t = colt / split_cols; base += (size_t)t * split_stride; colt -= t * split_cols; if (t == 0) sc = scale0; }
        const int col0 = colt + wc * 32 + 8 * fq;
#pragma unroll
        for (int ai = 0; ai < 2; ++ai)
#pragma unroll
            for (int m = 0; m < 4; ++m) { bf16_t* rowp = base + (size_t)(row0 + ai * HALF + m * 16) * ldc + col0;
#pragma unroll
                for (int bj = 0; bj < 2; ++bj) { f32x4 v0 = acc[ai][bj][m][0] * sc, v1 = acc[ai][bj][m][1] * sc;
                    u32x4 w; w.x = cvt_pk_bf16(v0[0], v0[1]); w.y = cvt_pk_bf16(v0[2], v0[3]); w.z = cvt_pk_bf16(v1[0], v1[1]); w.w = cvt_pk_bf16(v1[2], v1[3]);
#if defined(EPI_VARIANT) && EPI_VARIANT == 1
                    { u32x4 cz = {0x3f803f80u, 0x3f803f80u, 0x3f803f80u, 0x3f803f80u}; asm volatile("" :: "v"(w)); *(GAS u32x4*)(rowp + bj * HALF) = cz; }
#elif defined(EPI_VARIANT) && EPI_VARIANT == 2
                    { asm volatile("" :: "v"(w)); asm volatile("" :: "v"(rowp)); }
#elif MK_KDEBUG
                    { const size_t eo = (size_t)((rowp + bj * HALF) - O); if (eo + 8 <= (size_t)3 * 33554432) *(GAS u32x4*)(rowp + bj * HALF) = w; else atomicMax(dbg, 1000u - 3u); }
#else
                    *(GAS u32x4*)(rowp + bj * HALF) = w;
#endif
                    } }
    }
};
struct EpiSwiGLU {
    static constexpr bool PERM = true;
    bf16_t* O; int ldc;
    __device__ __forceinline__ void operator()(const f32x4 (&acc)[2][2][4][2], const Unit& u, int wr, int wc, int fr, int fq) const {
        const int row0 = u.pm * BM + wr * 64 + fr; const int col0 = u.pn * HALF + wc * 32 + 8 * fq;
#pragma unroll
        for (int ai = 0; ai < 2; ++ai)
#pragma unroll
            for (int m = 0; m < 4; ++m) { bf16_t* rowp = O + (size_t)(row0 + ai * HALF + m * 16) * ldc + col0; float o[8];
#pragma unroll
                for (int n = 0; n < 2; ++n)
#pragma unroll
                    for (int j = 0; j < 4; ++j) { const float g = acc[ai][0][m][n][j], up = acc[ai][1][m][n][j];
                        const float s = __builtin_amdgcn_rcpf(1.0f + __builtin_amdgcn_exp2f(-1.4426950408889634f * g)); o[n * 4 + j] = g * s * up; }
                u32x4 w; w.x = cvt_pk_bf16(o[0], o[1]); w.y = cvt_pk_bf16(o[2], o[3]); w.z = cvt_pk_bf16(o[4], o[5]); w.w = cvt_pk_bf16(o[6], o[7]);
                *(GAS u32x4*)rowp = w; }
    }
};
struct EpiRes {
    static constexpr bool PERM = false;
    const float* res; float* out; int ldc;
    __device__ __forceinline__ void operator()(const f32x4 (&acc)[2][2][4][2], const Unit& u, int wr, int wc, int fr, int fq) const {
        const int row0 = u.pm * BM + wr * 64 + fr; const int col0 = u.pn * BM + wc * 32 + 4 * fq;
#pragma unroll
        for (int ai = 0; ai < 2; ++ai)
#pragma unroll
            for (int m = 0; m < 4; ++m) { const size_t off = (size_t)(row0 + ai * HALF + m * 16) * ldc + col0;
#pragma unroll
                for (int bj = 0; bj < 2; ++bj)
#pragma unroll
                    for (int n = 0; n < 2; ++n) { const f32x4 r = *(const GAS f32x4*)(res + off + bj * HALF + n * 16); *(GAS f32x4*)(out + off + bj * HALF + n * 16) = r + acc[ai][bj][m][n]; } }
    }
};
struct EpiMoeDown {
    static constexpr bool PERM = false;
    float* h; bf16_t* y1; const unsigned* list_tok; const float* list_w; int cnt[NE];
    __device__ __forceinline__ void operator()(const f32x4 (&acc)[2][2][4][2], const Unit& u, int wr, int wc, int fr, int fq) const {
        int cv = 0;
#pragma unroll
        for (int k = 0; k < NE; ++k) cv = (k == u.e) ? cnt[k] : cv;
        const int col0 = u.pn * BM + wc * 32 + 4 * fq;
#pragma unroll
        for (int ai = 0; ai < 2; ++ai)
#pragma unroll
            for (int m = 0; m < 4; ++m) { const int l = u.r0 + ai * HALF + wr * 64 + m * 16 + fr;
                if (l < cv) {
                    const unsigned ent = __hip_atomic_load((const GAS unsigned*)list_tok + (size_t)u.e * LIST_CAP + l, __ATOMIC_RELAXED, __HIP_MEMORY_SCOPE_AGENT);
                    const float w = __uint_as_float(__hip_atomic_load((const GAS unsigned*)list_w + (size_t)u.e * LIST_CAP + l, __ATOMIC_RELAXED, __HIP_MEMORY_SCOPE_AGENT));
                    const size_t off = (size_t)(ent & 0xFFFFFu) * D + col0;
                    if ((ent >> 20) == 0u) {
#pragma unroll
                        for (int bj = 0; bj < 2; ++bj)
#pragma unroll
                            for (int n = 0; n < 2; ++n) { GAS float* p = (GAS float*)(h + off + bj * HALF + n * 16); const f32x4 r = *(const GAS f32x4*)p; *(GAS f32x4*)p = r + acc[ai][bj][m][n] * w; }
                    } else {
#pragma unroll
                        for (int bj = 0; bj < 2; ++bj)
#pragma unroll
                            for (int n = 0; n < 2; ++n) { const f32x4 v = acc[ai][bj][m][n] * w; unsigned long long pk = (unsigned long long)cvt_pk_bf16(v[0], v[1]) | ((unsigned long long)cvt_pk_bf16(v[2], v[3]) << 32);
                                *(GAS unsigned long long*)(y1 + off + bj * HALF + n * 16) = pk; }
                    }
                } }
    }
};

template <class Epi, class Sched>
__device__ __forceinline__ void gemm_phase(PG8_LAS unsigned char* lds, int xoff, const Gemm g, const Sched& S, const Epi& E) {
    int tid_ = threadIdx.x;
#if !defined(NO_OPQ_T)
    asm volatile("" : "+v"(tid_));
#endif
    const int tid = tid_, wid = __builtin_amdgcn_readfirstlane(tid >> 6), lane = tid & 63, wr = wid >> 2, wc = wid & 3, fr = lane & 15, fq = lane >> 4;
    const int K = g.K, nt = K / BK;
    unsigned voffB[2];
#pragma unroll
    for (int i = 0; i < 2; ++i) { int R, C; stage_rc(tid * 16 + i * 8192, R, C); const int Rb = Epi::PERM ? ((R & ~31) + perm32(R & 31)) : R;
        voffB[i] = (unsigned)(Rb * K + C) * 2u; }
    const size_t kstep = (size_t)(BK * 2);
    const size_t hstep = (size_t)HALF * K * 2;
    const size_t tstep = 2 * hstep;
    const unsigned ldsw = (unsigned)wid * 1024u;
    const int aoff = lds_byte(wr * 64 + fr, fq * 8), boff = lds_byte(wc * 32 + fr, fq * 8);
#define PG8_SA(b, h) (((b) * 2 + (h)) * HTB)
#define PG8_SB(b, h) ((4 + (b) * 2 + (h)) * HTB)
#define PG8_STAGE(bufoff, gbase, v0, v1) do { \
        __builtin_amdgcn_global_load_lds((const GAS unsigned*)((const char*)(gbase) + (v0)), (PG8_LAS unsigned*)(lds + (bufoff) + ldsw), 16, 0, 0); \
        __builtin_amdgcn_global_load_lds((const GAS unsigned*)((const char*)(gbase) + (v1)), (PG8_LAS unsigned*)(lds + (bufoff) + ldsw + 8192), 16, 0, 0); } while (0)
#define PG8_STAGEB(bufoff, gbase) PG8_STAGE(bufoff, gbase, voffB[0], voffB[1])
#define PG8_LDA(dst, b, h) do { _Pragma("unroll") for (int m = 0; m < 4; ++m) _Pragma("unroll") for (int k = 0; k < 2; ++k) dst[m][k] = *(const PG8_LAS bf16x8*)(lds + PG8_SA(b, h) + aoff + m * 2048 + k * 1024); } while (0)
#define PG8_LDB(dst, b, h) do { _Pragma("unroll") for (int n = 0; n < 2; ++n) _Pragma("unroll") for (int k = 0; k < 2; ++k) dst[n][k] = *(const PG8_LAS bf16x8*)(lds + PG8_SB(b, h) + boff + n * 2048 + k * 1024); } while (0)
#define PG8_MMA(ai, bj, At, Bt) do { __builtin_amdgcn_s_setprio(1); _Pragma("unroll") for (int m = 0; m < 4; ++m) _Pragma("unroll") for (int n = 0; n < 2; ++n) _Pragma("unroll") for (int k = 0; k < 2; ++k) \
        acc[ai][bj][m][n] = __builtin_amdgcn_mfma_f32_16x16x32_bf16(Bt[n][k], At[m][k], acc[ai][bj][m][n], 0, 0, 0); __builtin_amdgcn_s_setprio(0); } while (0)
#define PG8_WAIT_V(n) asm volatile("s_waitcnt vmcnt(" #n ")" ::: "memory")
#define PG8_WAIT_L(n) asm volatile("s_waitcnt lgkmcnt(" #n ")" ::: "memory")
#define PG8_BAR __builtin_amdgcn_s_barrier()
#define PG8_SCHED __builtin_amdgcn_sched_barrier(0)
#define PG8_AOFFS(U, o00, o01, o10, o11) do { int R0_, C0_, R1_, C1_; stage_rc(tid * 16, R0_, C0_); stage_rc(tid * 16 + 8192, R1_, C1_);     \
        o00 = (S.arow(U, R0_) * (unsigned)K + (unsigned)C0_) * 2u; o01 = (S.arow(U, R1_) * (unsigned)K + (unsigned)C1_) * 2u; \
        o10 = (S.arow(U, HALF + R0_) * (unsigned)K + (unsigned)C0_) * 2u; o11 = (S.arow(U, HALF + R1_) * (unsigned)K + (unsigned)C1_) * 2u; } while (0)
    Unit cur, nxt; int ui = 0;
#if MK_KDEBUG
    if (blockIdx.x == 5 && threadIdx.x == 0) atomicOr(g.dbg + 43, 2u);
#endif
    if (!S.next(0, cur)) return;
#if MK_KDEBUG
    if (blockIdx.x == 5 && threadIdx.x == 0) atomicOr(g.dbg + 43, 4u);
    { Unit t1_; if (blockIdx.x == 5 && threadIdx.x == 0 && S.next(1, t1_)) { g.dbg[40] = 1u + (unsigned)t1_.pm * 16u + (unsigned)t1_.pn; g.dbg[41] = 1u + (unsigned)cur.pm * 16u + (unsigned)cur.pn; g.dbg[42] = 1u + (unsigned)gridDim.x; atomicOr(g.dbg + 43, 8u); } }
#endif
#if defined(GDBG_NOKLOOP)
    { f32x4 accz[2][2][4][2];
      for (int ui_ = 0; S.next(ui_, cur); ++ui_) {
#pragma unroll
        for (int a = 0; a < 2; ++a)
#pragma unroll
          for (int b = 0; b < 2; ++b)
#pragma unroll
            for (int m = 0; m < 4; ++m)
#pragma unroll
              for (int n = 0; n < 2; ++n) { f32x4 r4;
                for (int j = 0; j < 4; ++j) { const int row = cur.pm * 256 + a * 128 + wr * 64 + m * 16 + fr;
                  const int col = cur.pn * 256 + b * 128 + wc * 32 + (Epi::PERM ? 8 * fq + 4 * n + j : 16 * n + 4 * fq + j);
                  const bf16_t* ar = g.A + (size_t)row * K; const bf16_t* br = g.Bt + (size_t)cur.e * g.bstride + (size_t)col * K; float s_ = 0.f;
                  for (int k = 0; k < K; ++k) s_ += __uint_as_float(((unsigned)ar[k]) << 16) * __uint_as_float(((unsigned)br[k]) << 16);
                  r4[j] = s_; }
                accz[a][b][m][n] = r4; }
        E(accz, cur, wr, wc, fr, fq); }
      return; }
#endif
    f32x4 acc[2][2][4][2];
#pragma unroll
    for (int a = 0; a < 2; ++a)
#pragma unroll
        for (int b = 0; b < 2; ++b)
#pragma unroll
            for (int m = 0; m < 4; ++m)
#pragma unroll
                for (int n = 0; n < 2; ++n) acc[a][b][m][n] = (f32x4){0.f, 0.f, 0.f, 0.f};
    bf16x8 At[4][2], B0[2][2], B1[2][2];
    unsigned c00, c01, c10, c11;
    PG8_LAS u32x4* const xslot = (PG8_LAS u32x4*)(lds + xoff) + tid;
    PG8_AOFFS(cur, c00, c01, c10, c11);
    const char* const gA = (const char*)g.A;
    const char* cB = (const char*)g.Bt + (size_t)cur.e * g.bstride * 2 + (size_t)cur.pn * tstep;
    PG8_STAGEB(PG8_SB(0, 0), cB); PG8_STAGEB(PG8_SB(0, 1), cB + hstep); PG8_STAGE(PG8_SA(0, 0), gA, c00, c01); PG8_STAGE(PG8_SA(0, 1), gA, c10, c11);
    if (wr == 1) PG8_BAR;
    PG8_WAIT_V(2); PG8_BAR;
    PG8_STAGEB(PG8_SB(1, 0), cB + kstep); PG8_STAGE(PG8_SA(1, 0), gA + kstep, c00, c01); PG8_STAGEB(PG8_SB(1, 1), cB + hstep + kstep);
    PG8_WAIT_V(6); PG8_BAR;
    for (;;) {
        const bool has_next = S.next(ui + 1, nxt);
        const char* nB_ = has_next ? (const char*)g.Bt + (size_t)nxt.e * g.bstride * 2 + (size_t)nxt.pn * tstep : cB;
        const char* nB = nB_;
        if (has_next) { unsigned n00, n01, n10, n11; PG8_AOFFS(nxt, n00, n01, n10, n11); *xslot = (u32x4){n00, n01, n10, n11}; }
#if MK_KDEBUG
        { const char* lo_ = (const char*)g.Bt; const char* hi_ = lo_ + g.bbytes - tstep;
          if (cB < lo_ || cB > hi_ || nB < lo_ || nB > hi_) { atomicMax(g.dbg, 1000u - 92u); cB = lo_; nB = lo_; }
          if (voffB[0] > (unsigned)tstep || voffB[1] > (unsigned)tstep) { atomicMax(g.dbg, 1000u - 93u); voffB[0] = 0u; voffB[1] = 0u; }
          const unsigned mx_ = g.amax; if (c00 > mx_ || c01 > mx_ || c10 > mx_ || c11 > mx_) { atomicMax(g.dbg, 1000u - 94u); c00 = 0u; c01 = 0u; c10 = 0u; c11 = 0u; } }
#endif
        for (int t = 0; t < nt; t += 2) {
            const bool last = (t == nt - 2);
            const char* a1 = gA + (size_t)(t + 1) * kstep;
            const char* a2 = last ? gA : gA + (size_t)(t + 2) * kstep; const char* b2 = last ? nB : cB + (size_t)(t + 2) * kstep;
            const char* a3 = a2 + kstep; const char* b3 = b2 + kstep;
            PG8_LDB(B0, 0, 0); PG8_LDB(B1, 0, 1); PG8_SCHED; PG8_LDA(At, 0, 0); PG8_STAGE(PG8_SA(1, 1), a1, c10, c11);
            if (last && has_next) { const u32x4 nx = *xslot; c00 = nx.x; c01 = nx.y; c10 = nx.z; c11 = nx.w; }
#if MK_KDEBUG
            { const unsigned mx_ = g.amax; if (c00 > mx_ || c01 > mx_ || c10 > mx_ || c11 > mx_) { atomicMax(g.dbg, 1000u - 90u); c00 = c00 > mx_ ? 0u : c00; c01 = c01 > mx_ ? 0u : c01; c10 = c10 > mx_ ? 0u : c10; c11 = c11 > mx_ ? 0u : c11; } }
#endif
            PG8_WAIT_V(8); PG8_WAIT_L(0); PG8_BAR; PG8_MMA(0, 0, At, B0); PG8_MMA(0, 1, At, B1); PG8_BAR; PG8_SCHED;
            PG8_LDA(At, 0, 1); PG8_STAGEB(PG8_SB(0, 0), b2); PG8_STAGEB(PG8_SB(0, 1), b2 + hstep); PG8_STAGE(PG8_SA(0, 0), a2, c00, c01);
            PG8_WAIT_V(8); PG8_WAIT_L(0); PG8_BAR; PG8_MMA(1, 0, At, B0); PG8_MMA(1, 1, At, B1); PG8_BAR; PG8_SCHED;
            PG8_LDB(B0, 1, 0); PG8_LDB(B1, 1, 1); PG8_SCHED; PG8_LDA(At, 1, 0); PG8_STAGE(PG8_SA(0, 1), a2, c10, c11);
            PG8_WAIT_V(8); PG8_WAIT_L(0); PG8_BAR; PG8_MMA(0, 0, At, B0); PG8_MMA(0, 1, At, B1); PG8_BAR; PG8_SCHED;
            PG8_LDA(At, 1, 1); PG8_STAGEB(PG8_SB(1, 0), b3); PG8_STAGEB(PG8_SB(1, 1), b3 + hstep); PG8_STAGE(PG8_SA(1, 0), a3, c00, c01);
            PG8_WAIT_V(8); PG8_WAIT_L(0); PG8_BAR; PG8_MMA(1, 0, At, B0); PG8_MMA(1, 1, At, B1); PG8_BAR; PG8_SCHED;
        }
        if (wr == 0) PG8_BAR;
#if !defined(GDBG_NOEPI)
#if defined(EPI_DRAIN)
        asm volatile("s_waitcnt vmcnt(0)" ::: "memory");
#endif
        E(acc, cur, wr, wc, fr, fq);
#if defined(EPI_DRAIN_AFTER)
        asm volatile("s_waitcnt vmcnt(0)" ::: "memory");
#endif
#else
        asm volatile("" :: "v"(acc[0][0][0][0]), "v"(acc[1][1][3][1]));
#endif
        if (!has_next) break;
#pragma unroll
        for (int a = 0; a < 2; ++a)
#pragma unroll
            for (int b = 0; b < 2; ++b)
#pragma unroll
                for (int m = 0; m < 4; ++m)
#pragma unroll
                    for (int n = 0; n < 2; ++n) acc[a][b][m][n] = (f32x4){0.f, 0.f, 0.f, 0.f};
        cur = nxt; cB = nB; ++ui;
        if (wr == 1) PG8_BAR;
    }
    PG8_WAIT_V(0);
    PG8_BAR;
#undef PG8_SA
#undef PG8_SB
#undef PG8_STAGE
#undef PG8_STAGEB
#undef PG8_LDA
#undef PG8_LDB
#undef PG8_MMA
#undef PG8_WAIT_V
#undef PG8_WAIT_L
#undef PG8_BAR
#undef PG8_SCHED
#undef PG8_AOFFS
}
}

namespace att {
typedef unsigned short bf16_t;
typedef short bf16x8 __attribute__((ext_vector_type(8)));
typedef short s16x4 __attribute__((ext_vector_type(4)));
typedef float f32x16 __attribute__((ext_vector_type(16)));
typedef float f32x4 __attribute__((ext_vector_type(4)));
typedef unsigned u32x4 __attribute__((ext_vector_type(4)));
constexpr int PITCH = 1024;
constexpr float LOG2E = 1.4426950408889634f;
__device__ __forceinline__ int crow(int r, int hi) { return (r & 3) + 8 * (r >> 2) + 4 * hi; }
typedef float f32x2_t __attribute__((ext_vector_type(2))); typedef __bf16 bf16x2_t __attribute__((ext_vector_type(2)));
__device__ __forceinline__ unsigned cvtpk(float lo, float hi) { f32x2_t v = {lo, hi}; bf16x2_t b = __builtin_convertvector(v, bf16x2_t); return __builtin_bit_cast(unsigned, b); }
__device__ __forceinline__ float bf2f(short s) { return __uint_as_float(((unsigned)(unsigned short)s) << 16); }
typedef short v4i16_t __attribute__((ext_vector_type(4)));
__device__ __forceinline__ s16x4 vtr(const LAS unsigned char* p) { return __builtin_bit_cast(s16x4, __builtin_amdgcn_ds_read_tr16_b64_v4i16((LAS v4i16_t*)p)); }
__device__ __forceinline__ float max3f(float a, float b, float c) { float r; asm("v_max3_f32 %0, %1, %2, %3" : "=v"(r) : "v"(a), "v"(b), "v"(c)); return r; }
__device__ __forceinline__ float halves_max(float m) { auto rr = __builtin_amdgcn_permlane32_swap(__float_as_uint(m), __float_as_uint(m), false, false); return fmaxf(__uint_as_float(rr[0]), __uint_as_float(rr[1])); }
__device__ __forceinline__ float halves_sum(float m) { auto rr = __builtin_amdgcn_permlane32_swap(__float_as_uint(m), __float_as_uint(m), false, false); return __uint_as_float(rr[0]) + __uint_as_float(rr[1]); }
#define ATT_BAR() asm volatile("s_waitcnt vmcnt(0) lgkmcnt(0)\n\ts_barrier" ::: "memory")

struct Args { const bf16_t* Q; const bf16_t* K; const bf16_t* V; bf16_t* O; const float* kmean; const float* kmax2; const float* subln; float lam_full; float out_scale; };

template <int MODE>
__device__ __forceinline__ void attn_unit(LAS unsigned char* lds, const Args& A, int b, int h, int qblk) {
    constexpr int DVB = MODE == 0 ? 4 : 2;
    constexpr int NCH = MODE == 0 ? 16 : 8;
    constexpr int KBY = NCH * 1024, VBY = DVB * 4096, SLOT = KBY + VBY;
    constexpr int QR = MODE == 0 ? 128 : 256;
    constexpr int PPW = MODE == 0 ? 2 : 1;
    int tid_ = threadIdx.x; asm volatile("" : "+v"(tid_));
    const int tid = tid_, lane = tid & 63, r32 = lane & 31, hi = lane >> 5;
    const int wid = __builtin_amdgcn_readfirstlane(tid >> 6);
    const int comp = MODE == 0 ? (wid >> 2) : 0, wq = MODE == 0 ? (wid & 3) : wid;
    const int q0 = qblk * QR; const long rowbase = (long)b * SEQ;
    const int hcol = MODE == 0 ? h * 128 : h * 64;
    const int qrel0 = wq * 32;
    const float slope2 = __builtin_amdgcn_exp2f(MODE == 0 ? -(float)(h + 1) : -0.5f * (float)(h + 1)) * LOG2E;
    const int NT = MODE == 0 ? 2 * qblk + 2 : 4 + 4 * qblk;
#define ATT_KBASE_(t) (MODE == 0 ? 64 * (t) : ((t) < 4 ? q0 + 64 * (t) : 64 * ((t) - 4)))
    LAS float* wsf = (LAS float*)(lds + 65536) + wid * 64;
    const bf16_t* Kb = A.K + rowbase * PITCH + hcol;
    const bf16_t* Vb = A.V + rowbase * PITCH + hcol;
    bf16x8 qr[4];
    { const bf16_t* Qw = A.Q + (rowbase + q0 + qrel0 + r32) * PITCH + hcol + comp * 64 + hi * 8;
#pragma unroll
      for (int d0 = 0; d0 < 4; ++d0) qr[d0] = *(const GAS bf16x8*)(Qw + d0 * 16); }
    ATT_BAR();
    LAS int* live = (LAS int*)(lds + 71680); LAS float* qnx = (LAS float*)(lds + 71680 + 272);
    { float q2 = 0.f;
#pragma unroll
      for (int d0 = 0; d0 < 4; ++d0)
#pragma unroll
        for (int j = 0; j < 8; ++j) { const float v = bf2f(qr[d0][j]); q2 += v * v; }
      q2 = halves_sum(q2);
      q2 = fmaxf(q2, __shfl_xor(q2, 1)); q2 = fmaxf(q2, __shfl_xor(q2, 2)); q2 = fmaxf(q2, __shfl_xor(q2, 4)); q2 = fmaxf(q2, __shfl_xor(q2, 8)); q2 = fmaxf(q2, __shfl_xor(q2, 16));
      if (lane == 0) qnx[wid] = q2; }
    ATT_BAR();
    if (wid == 0) {
        const int tt = lane;
        const int kbase_t = (tt < NT) ? ATT_KBASE_(tt) : 0;
        bool alive = tt < NT;
        if (alive && kbase_t + 64 <= q0) {
            const int nblk = kbase_t >> 8; float bound = -INFINITY;
            if constexpr (MODE == 0) {
#pragma unroll
                for (int c = 0; c < 2; ++c) { float qm = fmaxf(fmaxf(qnx[4 * c], qnx[4 * c + 1]), fmaxf(qnx[4 * c + 2], qnx[4 * c + 3]));
                    const float k2 = ((const GAS float*)A.kmax2)[(size_t)(b * 16 + h * 2 + c) * 16 + nblk]; bound = fmaxf(bound, sqrtf(qm) * sqrtf(k2)); }
            } else {
                float qm = qnx[0];
#pragma unroll
                for (int w = 1; w < 8; ++w) qm = fmaxf(qm, qnx[w]);
                const float k2 = ((const GAS float*)A.kmax2)[(size_t)(b * 16 + h) * 16 + nblk]; bound = sqrtf(qm) * sqrtf(k2);
            }
            alive = !(bound * 1.001f + 1.0f + slope2 * (float)(kbase_t + 63 - q0) < -152.0f);
        }
        const unsigned long long am = __ballot(alive);
        if (alive) live[__popcll(am & ((1ull << lane) - 1ull))] = tt;
        if (lane == 0) live[64] = __popcll(am);
    }
    ATT_BAR();
    const int NTL = __builtin_amdgcn_readfirstlane(live[64]);
    unsigned sel = 0u;
    if constexpr (MODE == 1) {
        LAS float* km = (LAS float*)(lds + 67584);
        for (int i = tid; i < 1024; i += 512) km[i] = ((const GAS float*)A.kmean)[(size_t)(b * 16 + h) * 1024 + i];
        ATT_BAR();
        float g[16];
#pragma unroll
        for (int n = 0; n < 16; ++n) { float s = 0.f;
            if (n < qblk) {
#pragma unroll
                for (int d0 = 0; d0 < 4; ++d0) { const f32x4 ka = *(const LAS f32x4*)(km + n * 64 + d0 * 16 + hi * 8), kb2 = *(const LAS f32x4*)(km + n * 64 + d0 * 16 + hi * 8 + 4);
                    s += bf2f(qr[d0][0]) * ka[0] + bf2f(qr[d0][1]) * ka[1] + bf2f(qr[d0][2]) * ka[2] + bf2f(qr[d0][3]) * ka[3]
                       + bf2f(qr[d0][4]) * kb2[0] + bf2f(qr[d0][5]) * kb2[1] + bf2f(qr[d0][6]) * kb2[2] + bf2f(qr[d0][7]) * kb2[3]; }
                s = halves_sum(s); }
            g[n] = s; }
        const int nsel = qblk < 3 ? qblk : 3;
#pragma unroll
        for (int k = 0; k < 3; ++k) if (k < nsel) { float best = -INFINITY; int bi = 0; bool found = false;
#pragma unroll
            for (int n = 0; n < 16; ++n) if (n < qblk) { const bool free_ = ((sel >> n) & 1u) == 0u; if (free_ && (!found || g[n] > best)) { best = g[n]; bi = n; found = true; } }
            sel |= 1u << bi; }
    }
#define ATT_KBASE(t) ATT_KBASE_(t)
#define ATT_ISSUE(t, slot) do { const int kb_ = ATT_KBASE(t); \
        _Pragma("unroll") for (int i_ = 0; i_ < PPW; ++i_) { const int p_ = wid + 8 * i_; \
            __builtin_amdgcn_global_load_lds((const GAS unsigned*)(Kb + (size_t)(kb_ + lane) * PITCH + p_ * 8), (LAS unsigned*)(lds + (slot) * SLOT + p_ * 1024), 16, 0, 0); \
            __builtin_amdgcn_global_load_lds((const GAS unsigned*)(Vb + (size_t)(kb_ + 16 * (p_ & 3) + (lane >> 2)) * PITCH + (p_ >> 2) * 32 + (lane & 3) * 8), (LAS unsigned*)(lds + (slot) * SLOT + KBY + p_ * 1024), 16, 0, 0); } } while (0)
    constexpr float THR = 8.0f;
    float mref = 0.f, l = 0.f; f32x16 o[DVB];
#pragma unroll
    for (int d0 = 0; d0 < DVB; ++d0) o[d0] = f32x16{};
#define ATT_ISSUE_K(tt, slot) do { const int kb_ = ATT_KBASE(tt); \
        _Pragma("unroll") for (int i_ = 0; i_ < PPW; ++i_) { const int p_ = wid + 8 * i_; \
            __builtin_amdgcn_global_load_lds((const GAS unsigned*)(Kb + (size_t)(kb_ + lane) * PITCH + p_ * 8), (LAS unsigned*)(lds + (slot) * SLOT + p_ * 1024), 16, 0, 0); } } while (0)
#define ATT_ISSUE_V(tt, slot) do { const int kb_ = ATT_KBASE(tt); \
        _Pragma("unroll") for (int i_ = 0; i_ < PPW; ++i_) { const int p_ = wid + 8 * i_; \
            __builtin_amdgcn_global_load_lds((const GAS unsigned*)(Vb + (size_t)(kb_ + 16 * (p_ & 3) + (lane >> 2)) * PITCH + (p_ >> 2) * 32 + (lane & 3) * 8), (LAS unsigned*)(lds + (slot) * SLOT + KBY + p_ * 1024), 16, 0, 0); } } while (0)
#define ATT_CLASS(tt, SK, NM, SB) do { const int kb_ = ATT_KBASE(tt), kr_ = kb_ - q0; const bool dg_ = kb_ >= q0; SK = dg_ && (kr_ > qrel0 + 31); NM = dg_ && (kr_ + 63 > qrel0); SB = true; \
        if constexpr (MODE == 1) { if ((tt) >= 4) { SB = ((sel >> (((tt) - 4) >> 2)) & 1u) != 0u; if (!__any(SB)) SK = true; } } } while (0)
#define ATT_QK(P0, P1, tt, slot, SB) do { const int kr_ = ATT_KBASE(tt) - q0; float off0_ = slope2 * (float)(kr_ + 4 * hi) - mref; if (!(SB)) off0_ = -INFINITY; const float off1_ = off0_ + 32.0f * slope2; \
        _Pragma("unroll") for (int r = 0; r < 16; ++r) { const float cbr = slope2 * (float)((r & 3) + 8 * (r >> 2)); P0[r] = cbr + off0_; P1[r] = cbr + off1_; } \
        const LAS unsigned char* Ks_ = lds + (slot) * SLOT + comp * 8192 + hi * 1024 + r32 * 16; \
        _Pragma("unroll") for (int d0 = 0; d0 < 4; ++d0) { const bf16x8 b0 = *(const LAS bf16x8*)(Ks_ + d0 * 2048), b1 = *(const LAS bf16x8*)(Ks_ + d0 * 2048 + 512); \
            P0 = __builtin_amdgcn_mfma_f32_32x32x16_bf16(b0, qr[d0], P0, 0, 0, 0); P1 = __builtin_amdgcn_mfma_f32_32x32x16_bf16(b1, qr[d0], P1, 0, 0, 0); } } while (0)
    f32x16 p0, p1, n0, n1;
    int t = __builtin_amdgcn_readfirstlane(live[0]);
    int tn = (NTL > 1) ? __builtin_amdgcn_readfirstlane(live[1]) : 0;
    bool skipC, maskC, selC, skipN = true, maskN = false, selN = true;
    ATT_ISSUE_K(t, 0); ATT_ISSUE_V(t, 0); if (NTL > 1) ATT_ISSUE_K(tn, 1);
    ATT_BAR();
    ATT_CLASS(t, skipC, maskC, selC);
    if (!skipC) ATT_QK(p0, p1, t, 0, selC);
    for (int it = 0; it < NTL; ++it) {
        ATT_BAR();
        const int tnn = (it + 2 < NTL) ? __builtin_amdgcn_readfirstlane(live[it + 2]) : 0;
        if (it + 2 < NTL) ATT_ISSUE_K(tnn, it & 1);
        if (it + 1 < NTL) { ATT_ISSUE_V(tn, (it + 1) & 1); ATT_CLASS(tn, skipN, maskN, selN); if (!skipN) ATT_QK(n0, n1, tn, (it + 1) & 1, selN); } else skipN = true;
        if (!skipC) {
            const int krel = ATT_KBASE(t) - q0;
            const LAS unsigned char* Vs = lds + (it & 1) * SLOT + KBY + ((lane >> 4) & 1) * 32 + (lane & 3) * 8 + (4 * hi + ((lane & 15) >> 2)) * 64;
            if (maskC) { const int qrel = qrel0 + r32;
#pragma unroll
                for (int r = 0; r < 16; ++r) { const int kv = krel + crow(r, hi); if (kv > qrel) p0[r] = -INFINITY; if (kv + 32 > qrel) p1[r] = -INFINITY; } }
            float rm;
            { float a_ = max3f(p0[0], p0[1], p1[0]), b_ = max3f(p0[2], p0[3], p1[1]); a_ = max3f(a_, p1[2], p1[3]);
#pragma unroll
              for (int r = 4; r < 16; r += 4) { a_ = max3f(a_, p0[r], p0[r + 1]); b_ = max3f(b_, p0[r + 2], p0[r + 3]); a_ = max3f(a_, p1[r], p1[r + 1]); b_ = max3f(b_, p1[r + 2], p1[r + 3]); }
              rm = halves_max(fmaxf(a_, b_)); }
            if (__any(rm > THR)) {
                const float dl = fmaxf(rm, 0.f); mref += dl; const float alpha = __builtin_amdgcn_exp2f(-dl);
#pragma unroll
                for (int r = 0; r < 16; ++r) { p0[r] -= dl; p1[r] -= dl; }
                if (!skipN) {
#pragma unroll
                    for (int r = 0; r < 16; ++r) { n0[r] -= dl; n1[r] -= dl; } }
                l *= alpha;
                if (hi == 0) wsf[r32] = alpha;
                asm volatile("s_waitcnt lgkmcnt(0)" ::: "memory");
#pragma unroll
                for (int gq = 0; gq < 4; ++gq) { const f32x4 f = *(const LAS f32x4*)(wsf + 8 * gq + 4 * hi);
#pragma unroll
                    for (int d0 = 0; d0 < DVB; ++d0) { o[d0][4 * gq + 0] *= f[0]; o[d0][4 * gq + 1] *= f[1]; o[d0][4 * gq + 2] *= f[2]; o[d0][4 * gq + 3] *= f[3]; } }
            }
            float sacc = 0.f;
#pragma unroll
            for (int r = 0; r < 16; ++r) { p0[r] = __builtin_amdgcn_exp2f(p0[r]); p1[r] = __builtin_amdgcn_exp2f(p1[r]); sacc += p0[r] + p1[r]; }
            l += sacc;
            u32x4 pw[4];
            pw[0] = (u32x4){cvtpk(p0[0], p0[1]), cvtpk(p0[2], p0[3]), cvtpk(p0[4], p0[5]), cvtpk(p0[6], p0[7])};
            pw[1] = (u32x4){cvtpk(p0[8], p0[9]), cvtpk(p0[10], p0[11]), cvtpk(p0[12], p0[13]), cvtpk(p0[14], p0[15])};
            pw[2] = (u32x4){cvtpk(p1[0], p1[1]), cvtpk(p1[2], p1[3]), cvtpk(p1[4], p1[5]), cvtpk(p1[6], p1[7])};
            pw[3] = (u32x4){cvtpk(p1[8], p1[9]), cvtpk(p1[10], p1[11]), cvtpk(p1[12], p1[13]), cvtpk(p1[14], p1[15])};
#pragma unroll
            for (int d0 = 0; d0 < DVB; ++d0)
#pragma unroll
                for (int ks = 0; ks < 4; ++ks) { const s16x4 vlo = vtr(Vs + d0 * 4096 + ks * 1024), vhi = vtr(Vs + d0 * 4096 + ks * 1024 + 512);
                    const bf16x8 vf = (bf16x8){vlo[0], vlo[1], vlo[2], vlo[3], vhi[0], vhi[1], vhi[2], vhi[3]};
                    o[d0] = __builtin_amdgcn_mfma_f32_32x32x16_bf16(__builtin_bit_cast(bf16x8, pw[ks]), vf, o[d0], 0, 0, 0); }
        }
        p0 = n0; p1 = n1; skipC = skipN; maskC = maskN; selC = selN; t = tn; tn = tnn;
    }
#undef ATT_ISSUE_K
#undef ATT_ISSUE_V
#undef ATT_CLASS
#undef ATT_QK
    l = halves_sum(l);
    if (hi == 0) wsf[32 + r32] = l;
    asm volatile("s_waitcnt lgkmcnt(0)" ::: "memory");
    float rli[16];
#pragma unroll
    for (int gq = 0; gq < 4; ++gq) { const f32x4 f = *(const LAS f32x4*)(wsf + 32 + 8 * gq + 4 * hi); rli[4 * gq + 0] = 1.0f / f[0]; rli[4 * gq + 1] = 1.0f / f[1]; rli[4 * gq + 2] = 1.0f / f[2]; rli[4 * gq + 3] = 1.0f / f[3]; }
    if constexpr (MODE == 1) {
        GAS bf16_t* Ow = (GAS bf16_t*)(A.O + (rowbase + q0 + qrel0) * PITCH + hcol);
#pragma unroll
        for (int r = 0; r < 16; ++r)
#pragma unroll
            for (int d0 = 0; d0 < DVB; ++d0) Ow[(size_t)crow(r, hi) * PITCH + d0 * 32 + r32] = (bf16_t)(cvtpk(o[d0][r] * rli[r], 0.f) & 0xFFFFu);
    } else {
        ATT_BAR();
        LAS float* X = (LAS float*)lds + wq * 4096;
        if (comp == 1) {
#pragma unroll
            for (int d0 = 0; d0 < DVB; ++d0)
#pragma unroll
                for (int r = 0; r < 16; ++r) X[(d0 * 16 + r) * 64 + lane] = o[d0][r] * rli[r];
        }
        ATT_BAR();
        if (comp == 0) {
            float sg[DVB];
#pragma unroll
            for (int d0 = 0; d0 < DVB; ++d0) sg[d0] = ((const GAS float*)A.subln)[d0 * 32 + r32] * A.out_scale;
            GAS bf16_t* Ow = (GAS bf16_t*)(A.O + (rowbase + q0 + qrel0) * PITCH + hcol);
#pragma unroll
            for (int r = 0; r < 16; ++r) { float dv[DVB]; float ss = 0.f;
#pragma unroll
                for (int d0 = 0; d0 < DVB; ++d0) { dv[d0] = o[d0][r] * rli[r] - A.lam_full * X[(d0 * 16 + r) * 64 + lane]; ss += dv[d0] * dv[d0]; }
                ss += __shfl_xor(ss, 1); ss += __shfl_xor(ss, 2); ss += __shfl_xor(ss, 4); ss += __shfl_xor(ss, 8); ss += __shfl_xor(ss, 16);
                const float rs = 1.0f / sqrtf(ss * (1.0f / 128.0f) + 1e-5f);
#pragma unroll
                for (int d0 = 0; d0 < DVB; ++d0) Ow[(size_t)crow(r, hi) * PITCH + d0 * 32 + r32] = (bf16_t)(cvtpk(dv[d0] * rs * sg[d0], 0.f) & 0xFFFFu); }
        }
    }
#undef ATT_KBASE
#undef ATT_KBASE_
#undef ATT_ISSUE
}
#undef ATT_BAR
}

constexpr int NWAVES = 8;
#ifndef MK_PER_PHASE
#define MK_PER_PHASE 1
#endif
#ifndef MK_DEBUG
#define MK_DEBUG 1
#endif
constexpr int NLAYER = 4, PH_PER_LAYER = 8, NPHASE = 1 + NLAYER * PH_PER_LAYER;

constexpr size_t MiB = 1u << 20;
constexpr size_t WS_CTL = 0, CTL_ZERO_BYTES = 1 * MiB;
constexpr size_t WS_KMEAN = 1 * MiB;
constexpr size_t WS_LTOK = 2 * MiB, WS_LW = 3 * MiB;
constexpr size_t WS_DQKV = 5 * MiB;
constexpr size_t WS_DWO = WS_DQKV + 12 * MiB;
constexpr size_t WS_MQKV = WS_DWO + 4 * MiB;
constexpr size_t WS_MWO = WS_MQKV + 12 * MiB;
constexpr size_t WS_FGU = WS_MWO + 4 * MiB;
constexpr size_t WS_FD = WS_FGU + 22 * MiB;
constexpr size_t WS_MGU = WS_FD + 11 * MiB;
constexpr size_t WS_MD = WS_MGU + 112 * MiB;
constexpr size_t WS_XN = WS_MD + 56 * MiB;
constexpr size_t WS_Q = WS_XN + 64 * MiB, WS_K = WS_Q + 64 * MiB, WS_V = WS_K + 64 * MiB;
constexpr size_t WS_ACT = WS_Q;
constexpr size_t WS_END = WS_ACT + (size_t)MOE_TILES_MAX * 256 * DE * 2;
static_assert(WS_XN == 238 * MiB && WS_END == 778 * MiB, "d_ws map");
constexpr int CW_BAR = 4096;
constexpr int CW_ATTQ = 6144;
constexpr int CW_CNT = 8192;

constexpr int RING_OFF = 0, RING_BYTES = 131072;
constexpr int LDSCTL_OFF = RING_BYTES, MISC_OFF = LDSCTL_OFF + 320;
constexpr int XSLOT_OFF = MISC_OFF + 128;
constexpr int LDS_BYTES = 147456;

typedef unsigned short bf16;
typedef unsigned v4u __attribute__((ext_vector_type(4)));
typedef float f32x4 __attribute__((ext_vector_type(4)));
typedef GAS unsigned gu32;
#define RLX_AGENT __ATOMIC_RELAXED, __HIP_MEMORY_SCOPE_AGENT
#define LDS_WAIT() asm volatile("s_waitcnt lgkmcnt(0)" ::: "memory")
#define VM_WAIT() asm volatile("s_waitcnt vmcnt(0)" ::: "memory")
__device__ __forceinline__ unsigned f2bf(float f) { unsigned u = __builtin_bit_cast(unsigned, f); return (u + 0x7fffu + ((u >> 16) & 1u)) >> 16; }
__device__ __forceinline__ unsigned pk2(float lo, float hi) { return f2bf(lo) | (f2bf(hi) << 16); }
__device__ __forceinline__ float bflo(unsigned w) { return __uint_as_float(w << 16); }
__device__ __forceinline__ float bfhi(unsigned w) { return __uint_as_float(w & 0xFFFF0000u); }
static_assert(XSLOT_OFF % 16 == 0 && XSLOT_OFF + 8192 <= LDS_BYTES, "LDS map");
#define XB_TMO      128
#define XB_XCNT(j)  (256  + 64 * (j))
#define XB_XSUB(j)  (1280 + 64 * (j))
#define XB_XGEN(j)  (2304 + 64 * (j))
#define XB_TOP      3328
#define XB_TOPGEN   3392
#define XCD_BAR_WORDS 3456
#define XB_SPIN_CAP (1u << 18)

__device__ __forceinline__ unsigned xb_ld(unsigned* p)              { return __hip_atomic_load(p, __ATOMIC_RELAXED, __HIP_MEMORY_SCOPE_AGENT); }
__device__ __forceinline__ unsigned xb_add(unsigned* p, unsigned v) { return __hip_atomic_fetch_add(p, v, __ATOMIC_RELAXED, __HIP_MEMORY_SCOPE_AGENT); }
__device__ __forceinline__ unsigned xb_xcc_id() { return (unsigned)__builtin_amdgcn_s_getreg((3 << 11) | 20) & 0xFu; }
#define XB_SPIN(cond, bar) do { unsigned _sp = 0; while (cond) { __builtin_amdgcn_s_sleep(1); \
    if ((++_sp & 255u) == 0u) { if (xb_ld(&(bar)[XB_TMO])) break; if (_sp > XB_SPIN_CAP) { atomicAdd(&(bar)[XB_TMO], 1u); break; } } } } while (0)

struct XcdBarrier {
    unsigned* bar; unsigned x;
    volatile LAS unsigned* st;
};

__device__ __forceinline__ XcdBarrier xcd_barrier_post(unsigned* bar, volatile LAS unsigned* st) {
    XcdBarrier b; b.bar = bar; b.x = xb_xcc_id(); b.st = st;
    if (threadIdx.x == 0) (void)xb_add(&bar[XB_XCNT(b.x)], 1u);
    return b;
}
__device__ __forceinline__ void xcd_barrier_complete(unsigned* bar, unsigned x, unsigned& nloc, unsigned& nx) {
    const unsigned G = gridDim.x * gridDim.y * gridDim.z;
    unsigned sum, cnt, mine, sp = 0u;
    for (;;) {
        sum = 0u; cnt = 0u; mine = 0u;
#pragma unroll
        for (unsigned j = 0; j < 16; ++j) { const unsigned c = xb_ld(&bar[XB_XCNT(j)]); sum += c; cnt += (c > 0u) ? 1u : 0u; mine = (j == x) ? c : mine; }
        if (sum == G) break;
        __builtin_amdgcn_s_sleep(1);
        if ((++sp & 255u) == 0u) { if (xb_ld(&bar[XB_TMO])) break; if (sp > XB_SPIN_CAP) { atomicAdd(&bar[XB_TMO], 1u); break; } }
    }
    nloc = mine > 0u ? mine : 1u; nx = cnt > 0u ? cnt : 1u;
}

__device__ __forceinline__ void xcd_barrier(const XcdBarrier& b) {
    asm volatile("s_waitcnt vmcnt(0)" ::: "memory");
    __syncthreads();
    if (threadIdx.x == 0) {
        unsigned* bar = b.bar;
        __builtin_amdgcn_s_waitcnt(0);
        unsigned nloc = b.st[0], nx = b.st[1];
        if (nloc == 0u) { xcd_barrier_complete(bar, b.x, nloc, nx); b.st[0] = nloc; b.st[1] = nx; }
        const unsigned old = xb_add(&bar[XB_XSUB(b.x)], 1u);
        const unsigned gen = old / nloc;
        if (old + 1u == (gen + 1u) * nloc) {
            __builtin_amdgcn_fence(__ATOMIC_RELEASE, "agent");
            asm volatile("s_waitcnt vmcnt(0)" ::: "memory");
            const unsigned og = xb_add(&bar[XB_TOP], 1u);
            const unsigned tg = og / nx;
            if (og + 1u == (tg + 1u) * nx) xb_add(&bar[XB_TOPGEN], 1u);
            else XB_SPIN(xb_ld(&bar[XB_TOPGEN]) == tg, bar);
            __builtin_amdgcn_fence(__ATOMIC_ACQUIRE, "agent");
            xb_add(&bar[XB_XGEN(b.x)], 1u);
            asm volatile("s_waitcnt vmcnt(0)" ::: "memory");
        } else {
            XB_SPIN(xb_ld(&bar[XB_XGEN(b.x)]) == gen, bar);
            __builtin_amdgcn_fence(__ATOMIC_ACQUIRE, "agent");
            asm volatile("s_waitcnt vmcnt(0)" ::: "memory");
        }
    }
    __syncthreads();
}

struct Frame {
    LAS unsigned char* lds;
    volatile LAS unsigned* MISC;
    gu32* ctl;
    int tid, lane, wave;
    int vcu, G;
};
__device__ __forceinline__ float wave_sum(float v) {
#pragma unroll
    for (int o = 1; o < 64; o <<= 1) v += __shfl_xor(v, o);
    return v;
}
__device__ __forceinline__ void transpose_item(const float* W, int K, int N, bf16* WT, int k0, int n0, int drow0, LAS float* scr, int lane) {
    const GAS float* src = (const GAS float*)W + (size_t)k0 * N + n0 + lane;
#pragma unroll
    for (int hb = 0; hb < 2; ++hb) { float v[32];
#pragma unroll
        for (int i = 0; i < 32; ++i) v[i] = src[(size_t)(hb * 32 + i) * N];
#pragma unroll
        for (int i = 0; i < 32; ++i) { const int kk = hb * 32 + i; scr[kk * 64 + (lane ^ ((kk >> 3) << 3))] = v[i]; } }
    LDS_WAIT(); asm volatile("" ::: "memory");
    const int c = lane & 7;
#pragma unroll
    for (int j = 0; j < 8; ++j) { const int n = (lane >> 3) + 8 * j; const LAS float* s = scr + (8 * c) * 64 + (n ^ (c << 3));
        v4u o; o.x = pk2(s[0 * 64], s[1 * 64]); o.y = pk2(s[2 * 64], s[3 * 64]); o.z = pk2(s[4 * 64], s[5 * 64]); o.w = pk2(s[6 * 64], s[7 * 64]);
        *(GAS v4u*)(WT + (size_t)(drow0 + n) * K + k0 + 8 * c) = o; }
    LDS_WAIT(); asm volatile("" ::: "memory");
}
__device__ __forceinline__ void convert_matrix(Frame& F, const float* W, int K, int N, bf16* WT, int il, unsigned& rot) {
    LAS float* scr = (LAS float*)(F.lds + RING_OFF + F.wave * 16384);
    const unsigned gw = (unsigned)(F.vcu * NWAVES + F.wave), NGW = (unsigned)(F.G * NWAVES);
    const int nblk = N / 64, nitems = (K / 64) * nblk; int lane_ = F.lane; asm volatile("" : "+v"(lane_));
    for (int it = (int)((gw + NGW - rot % NGW) % NGW); it < nitems; it += (int)NGW) {
        const int kb = it / nblk, nb = it % nblk, n0 = 64 * nb;
        const int drow0 = il == 0 ? n0 : (n0 / 128) * 256 + (il - 1) * 128 + (n0 % 128);
        transpose_item(W, K, N, WT, 64 * kb, n0, drow0, scr, lane_);
    }
    rot = (rot + (unsigned)nitems) % NGW;
}

struct RouterArgs { const float* router; gu32* cnt; unsigned* ltok; float* lw; };
template <int MODE>
__device__ __forceinline__ void norm_phase(Frame& F, const float* src, float* hout, const bf16* y1, const float* gain, bf16* xn, float* fout, const RouterArgs& R) {
    int lane_ = F.lane; asm volatile("" : "+v"(lane_));
    const int gw = F.vcu * NWAVES + F.wave, NGW = F.G * NWAVES, lane = lane_;
    f32x4 gv[4];
#pragma unroll
    for (int j = 0; j < 4; ++j) gv[j] = *(const GAS f32x4*)(gain + 256 * j + 4 * lane);
    LAS float* RL = (LAS float*)(F.lds + RING_OFF);
    if constexpr (MODE == 2) {
        int tid_ = F.tid; asm volatile("" : "+v"(tid_));
        for (int i = tid_; i < 8192; i += NWAVES * 64) RL[(i & 7) * 1024 + (i >> 3)] = ((const GAS float*)R.router)[i];
        LDS_WAIT(); __syncthreads();
    }
    const int nrows_w = gw < MTOK ? (MTOK - gw + NGW - 1) / NGW : 0;
    for (int cb = 0; cb < nrows_w; cb += 64) {
        int my_t = 0, my_e0 = 0, my_e1 = 0; float my_w0 = 0.f, my_w1 = 0.f; bool valid = false;
        const int cn = (nrows_w - cb) < 64 ? (nrows_w - cb) : 64;
        for (int i = 0; i < cn; ++i) {
            const int row = gw + (cb + i) * NGW;
            const GAS f32x4* xr = (const GAS f32x4*)(src + (size_t)row * D) + lane;
            f32x4 v[4]; float s = 0.f;
#pragma unroll
            for (int j = 0; j < 4; ++j) v[j] = xr[64 * j];
            if constexpr (MODE == 1 || MODE == 3) {
                const GAS unsigned long long* yr = (const GAS unsigned long long*)(y1 + (size_t)row * D) + lane;
#pragma unroll
                for (int j = 0; j < 4; ++j) { const unsigned long long w = yr[64 * j]; const unsigned lo = (unsigned)w, hi = (unsigned)(w >> 32);
                    v[j].x += bflo(lo); v[j].y += bfhi(lo); v[j].z += bflo(hi); v[j].w += bfhi(hi); }
            }
#pragma unroll
            for (int j = 0; j < 4; ++j) s += (v[j].x * v[j].x + v[j].y * v[j].y) + (v[j].z * v[j].z + v[j].w * v[j].w);
            if constexpr (MODE == 1) { GAS f32x4* hr = (GAS f32x4*)(hout + (size_t)row * D) + lane;
#pragma unroll
                for (int j = 0; j < 4; ++j) hr[64 * j] = v[j]; }
            const float rstd = 1.f / sqrtf(wave_sum(s) * (1.f / D) + 1e-6f);
#pragma unroll
            for (int j = 0; j < 4; ++j) v[j] = v[j] * rstd * gv[j];
            if constexpr (MODE == 3) { GAS f32x4* orow = (GAS f32x4*)(fout + (size_t)row * D) + lane;
#pragma unroll
                for (int j = 0; j < 4; ++j) orow[64 * j] = v[j];
            } else {
                GAS unsigned long long* o8 = (GAS unsigned long long*)(xn + (size_t)row * D) + lane;
#pragma unroll
                for (int j = 0; j < 4; ++j) o8[64 * j] = (unsigned long long)pk2(v[j].x, v[j].y) | ((unsigned long long)pk2(v[j].z, v[j].w) << 32);
            }
            if constexpr (MODE == 2) {
                float lg[NE];
#pragma unroll
                for (int e = 0; e < NE; ++e) { float a = 0.f;
#pragma unroll
                    for (int j = 0; j < 4; ++j) { const f32x4 rr = *(const LAS f32x4*)(RL + e * 1024 + 256 * j + 4 * lane); a += (v[j].x * rr.x + v[j].y * rr.y) + (v[j].z * rr.z + v[j].w * rr.w); }
                    lg[e] = wave_sum(a); }
                int e0 = 0; float v0 = lg[0];
#pragma unroll
                for (int e = 1; e < NE; ++e) if (lg[e] > v0) { v0 = lg[e]; e0 = e; }
                int e1 = -1; float v1 = 0.f;
#pragma unroll
                for (int e = 0; e < NE; ++e) if (e != e0 && (e1 < 0 || lg[e] > v1)) { v1 = lg[e]; e1 = e; }
                const float w0 = 1.f / (1.f + __expf(v1 - v0));
                if (lane == i) { my_t = row; my_e0 = e0; my_e1 = e1; my_w0 = w0; my_w1 = 1.f - w0; valid = true; }
            }
        }
        if constexpr (MODE == 2) {
            unsigned myc = 0u;
#pragma unroll
            for (int e = 0; e < NE; ++e) { const unsigned long long b0 = __ballot(valid && my_e0 == e), b1 = __ballot(valid && my_e1 == e);
                const unsigned c = (unsigned)(__popcll(b0) + __popcll(b1)); if (lane == e) myc = c; }
            unsigned basev = 0u;
            if (lane < NE) basev = __hip_atomic_fetch_add(R.cnt + 64 * lane, myc, RLX_AGENT);
            const unsigned long long lt = (1ull << lane) - 1ull;
            unsigned pos0 = 0u, pos1 = 0u;
#pragma unroll
            for (int e = 0; e < NE; ++e) { const unsigned long long b0 = __ballot(valid && my_e0 == e), b1 = __ballot(valid && my_e1 == e);
                const unsigned be = (unsigned)__shfl((int)basev, e);
                if (my_e0 == e) pos0 = be + (unsigned)__popcll(b0 & lt);
                if (my_e1 == e) pos1 = be + (unsigned)__popcll(b0) + (unsigned)__popcll(b1 & lt); }
            if (valid) {
                ((GAS unsigned*)R.ltok)[(size_t)my_e0 * LIST_CAP + pos0] = (unsigned)my_t;             ((GAS float*)R.lw)[(size_t)my_e0 * LIST_CAP + pos0] = my_w0;
                ((GAS unsigned*)R.ltok)[(size_t)my_e1 * LIST_CAP + pos1] = (unsigned)my_t | (1u << 20); ((GAS float*)R.lw)[(size_t)my_e1 * LIST_CAP + pos1] = my_w1;
            }
        }
    }
    if constexpr (MODE == 2) { LDS_WAIT(); __syncthreads(); }
}

__device__ __forceinline__ void kstat_phase(Frame& F, const bf16* Kt, float* kmean, float* kmax2) {
    int lane_ = F.lane; asm volatile("" : "+v"(lane_));
    const int gw = F.vcu * NWAVES + F.wave, NGW = F.G * NWAVES, lane = lane_;
    for (int task = gw; task < BATCH * 16 * 8; task += NGW) {
        const int c8 = task & 7, n = (task >> 3) & 15, b = task >> 7;
        const GAS unsigned* p = (const GAS unsigned*)(Kt + ((size_t)b * SEQ + 256 * n) * D + c8 * 128) + lane;
        float a0 = 0.f, a1 = 0.f, mx = 0.f;
#pragma unroll 8
        for (int r = 0; r < 256; ++r) { const unsigned w = p[(size_t)r * (D / 2)]; const float v0 = bflo(w), v1 = bfhi(w); a0 += v0; a1 += v1;
            float s = v0 * v0 + v1 * v1; s += __shfl_xor(s, 1); s += __shfl_xor(s, 2); s += __shfl_xor(s, 4); s += __shfl_xor(s, 8); s += __shfl_xor(s, 16); mx = fmaxf(mx, s); }
        const int col = c8 * 128 + 2 * lane, hh = col >> 6, d = col & 63;
        GAS float* o = (GAS float*)(kmean + ((size_t)(b * 16 + hh) * 16 + n) * 64 + d);
        o[0] = a0 * (1.f / 256.f); o[1] = a1 * (1.f / 256.f);
        if ((lane & 31) == 0) ((GAS float*)kmax2)[(size_t)(b * 16 + hh) * 16 + n] = mx;
    }
}

struct KArgs { const float* in[17]; float* out; unsigned char* ws; int ph_lo, ph_hi; };
__global__ void __launch_bounds__(NWAVES * 64, 2) trunk_fwd(KArgs args) {
    extern __shared__ __attribute__((aligned(16))) unsigned char lds[];
    Frame F;
    F.lds = (LAS unsigned char*)lds;
    F.MISC = (volatile LAS unsigned*)(F.lds + MISC_OFF);
    F.tid = threadIdx.x; F.lane = F.tid & 63; F.wave = __builtin_amdgcn_readfirstlane(F.tid >> 6);
    F.G = gridDim.x; { const int bx = blockIdx.x; F.vcu = (F.G % 8 == 0) ? (bx % 8) * (F.G / 8) + bx / 8 : bx; }
    F.ctl = (gu32*)(args.ws + WS_CTL);
    for (int u = F.tid; u < (LDS_BYTES - LDSCTL_OFF) / 4; u += NWAVES * 64) ((LAS unsigned*)(F.lds + LDSCTL_OFF))[u] = 0u;
    __syncthreads();
    Frame& F0 = F;
    const int lo = args.ph_lo, hi = args.ph_hi;
    XcdBarrier bar; bar.bar = (unsigned*)(F.ctl + CW_BAR); bar.x = 0; bar.st = nullptr;
    if (hi - lo > 1) bar = xcd_barrier_post((unsigned*)(F.ctl + CW_BAR), F.MISC + 8);
#define IN(k) (lo <= (k) && (k) < hi)
#ifndef PH_ENABLE
#define PH_ENABLE 0xFFFFFFFFu
#endif
#define PHEN(n) (((PH_ENABLE) >> (n)) & 1u)
#ifndef MK_DOUBLE
#define MK_DOUBLE 0u
#endif
#define NREP(n) ((((MK_DOUBLE) >> (n)) & 1u) ? 2 : 1)
#if defined(NO_OPQ)
#define OPQ(p) do {} while (0)
#else
#define OPQ(p) asm volatile("" : "+s"(p))
#endif
#if 0
#define STAMP(k) do { if (blockIdx.x == 0 && threadIdx.x == 0) { const unsigned long long t_ = __builtin_amdgcn_s_memrealtime(); ((GAS unsigned*)(F0.ctl))[3000 + (k)] = (unsigned)t_; } } while (0)
#else
#define STAMP(k) do {} while (0)
#endif
#define SEAM(k) do { if (IN(k) && IN((k) + 1)) { XcdBarrier b2_ = bar; OPQ(b2_.bar); xcd_barrier(b2_); } STAMP((k) + 1); } while (0)

#define PTRS() unsigned char* ws = args.ws; OPQ(ws); const float* x = args.in[0]; OPQ(x); const float* norm_mix = args.in[1]; OPQ(norm_mix); const float* norm_ffn = args.in[2]; OPQ(norm_ffn); \
    float* h = args.out; OPQ(h); \
    bf16* XN = (bf16*)(ws + WS_XN); bf16* Qb = (bf16*)(ws + WS_Q); bf16* Kb = (bf16*)(ws + WS_K); bf16* Vb = (bf16*)(ws + WS_V); bf16* ACT = (bf16*)(ws + WS_ACT); \
    bf16* MGU = (bf16*)(ws + WS_MGU); bf16* MD = (bf16*)(ws + WS_MD); \
    float* kmean = (float*)(ws + WS_KMEAN); unsigned* ltok = (unsigned*)(ws + WS_LTOK); float* lw = (float*)(ws + WS_LW); \
    (void)x; (void)norm_mix; (void)norm_ffn; (void)h; (void)XN; (void)Qb; (void)Kb; (void)Vb; (void)ACT; (void)MGU; (void)MD; (void)kmean; (void)ltok; (void)lw
    const RouterArgs noR{nullptr, nullptr, nullptr, nullptr};
    constexpr float C2 = 0.125f * 1.4426950408889634f;

    STAMP(0);
    if (PHEN(0) && IN(0)) {
        PTRS();
        for (int rep_ = 0; rep_ < NREP(0); ++rep_) {
        unsigned rot = 0u;
        for (int j = 0; j < 2; ++j) {
            convert_matrix(F, args.in[3] + (size_t)j * D * 3 * D, D, 3 * D, (bf16*)(ws + WS_DQKV) + (size_t)j * 3 * D * D, 0, rot);
            convert_matrix(F, args.in[4] + (size_t)j * D * D, D, D, (bf16*)(ws + WS_DWO) + (size_t)j * D * D, 0, rot);
            convert_matrix(F, args.in[7] + (size_t)j * D * 3 * D, D, 3 * D, (bf16*)(ws + WS_MQKV) + (size_t)j * 3 * D * D, 0, rot);
            convert_matrix(F, args.in[8] + (size_t)j * D * D, D, D, (bf16*)(ws + WS_MWO) + (size_t)j * D * D, 0, rot);
            convert_matrix(F, args.in[9] + (size_t)j * D * DFF, D, DFF, (bf16*)(ws + WS_FGU) + (size_t)j * 2 * DFF * D, 1, rot);
            convert_matrix(F, args.in[10] + (size_t)j * D * DFF, D, DFF, (bf16*)(ws + WS_FGU) + (size_t)j * 2 * DFF * D, 2, rot);
            convert_matrix(F, args.in[11] + (size_t)j * DFF * D, DFF, D, (bf16*)(ws + WS_FD) + (size_t)j * D * DFF, 0, rot);
        }
        for (int e = 0; e < NE; ++e) {
            convert_matrix(F, args.in[13] + (size_t)e * D * DE, D, DE, MGU + (size_t)e * 2 * DE * D, 1, rot);
            convert_matrix(F, args.in[14] + (size_t)e * D * DE, D, DE, MGU + (size_t)e * 2 * DE * D, 2, rot);
            convert_matrix(F, args.in[15] + (size_t)e * DE * D, DE, D, MD + (size_t)e * D * DE, 0, rot);
        }
        norm_phase<0>(F, x, nullptr, nullptr, norm_mix, XN, nullptr, noR);
        }
    }
    SEAM(0);

    for (int L = 0; L < NLAYER; ++L) {
        const int j = L >> 1, moba = L & 1, pb = 1 + PH_PER_LAYER * L;
        int z_ = 0;
#if !defined(NO_OPQ_Z)
        asm volatile("" : "+s"(z_));
#endif
        Frame Fl = F0; Fl.G += z_; Fl.vcu += z_; Fl.wave += z_; Fl.lds += z_; Fl.ctl += z_; const int bx = (int)blockIdx.x + z_;
#define F Fl
        if (PHEN(1) && IN(pb + 0)) {
            PTRS();

            const bf16* W = (const bf16*)(ws + (moba ? WS_MQKV : WS_DQKV)) + (size_t)j * 3 * D * D;
            pg8::Gemm g{XN, W, D, 0, (unsigned)((size_t)MTOK * D * 2 - 16), (unsigned*)F.ctl + 2048, (size_t)3 * D * D * 2}; pg8::StaticOrder S; S.init(MTOK, 3 * D, F.G, bx);
            pg8::EpiQKV E{Qb, D, D, (size_t)(WS_K - WS_Q) / 2, C2, (unsigned*)F.ctl + 2048};
            for (int rep_ = 0; rep_ < NREP(1); ++rep_) pg8::gemm_phase<pg8::EpiQKV, pg8::StaticOrder>(F.lds + RING_OFF, XSLOT_OFF, g, S, E);
        }
        SEAM(pb + 0);
        { if (PHEN(2) && IN(pb + 1)) { PTRS(); kstat_phase(F, Kb, kmean, kmean + 8 * 16 * 16 * 64); } SEAM(pb + 1); }
        if (IN(pb + 2)) {
            PTRS();
            att::Args A; A.Q = Qb; A.K = Kb; A.V = Vb; A.O = XN; A.kmean = kmean; A.kmax2 = kmean + 8 * 16 * 16 * 64; A.subln = args.in[6] + (size_t)j * 128; A.lam_full = 0.f; A.out_scale = 1.f;
            gu32* qctr = F.ctl + CW_ATTQ + 64 * L; LAS int* qw = (LAS int*)(F.lds + RING_OFF + 71680 + 260);
            if (!moba) {
                const float* lam = args.in[5] + (size_t)j * 256; int lane = F.lane; asm volatile("" : "+v"(lane));
                const GAS float* lamg = (const GAS float*)lam; const float s1 = wave_sum(lamg[lane] * lamg[64 + lane]), s2 = wave_sum(lamg[128 + lane] * lamg[192 + lane]);
                const float lam_init = (L == 0) ? 0.2f : 0.47071302f;
                A.lam_full = __uint_as_float(__builtin_amdgcn_readfirstlane(__float_as_uint(__expf(s1) - __expf(s2) + lam_init))); A.out_scale = __uint_as_float(__builtin_amdgcn_readfirstlane(__float_as_uint(1.0f - lam_init)));
            }
            if ((PHEN(3) && !moba) || (PHEN(4) && moba)) for (;;) {
                if (F.tid == 0) *qw = (int)__hip_atomic_fetch_add(qctr, 1u, RLX_AGENT);
                asm volatile("s_waitcnt vmcnt(0) lgkmcnt(0)\n\ts_barrier" ::: "memory");
                const int idx = __builtin_amdgcn_readfirstlane(*qw);
                if (idx >= 1024) break;
                if (!moba) { const int hh = 7 - (idx >> 7), bb = (idx >> 4) & 7, pr = idx & 15;
                    att::attn_unit<0>(F.lds + RING_OFF, A, bb, hh, pr);
                    att::attn_unit<0>(F.lds + RING_OFF, A, bb, hh, 31 - pr);
                } else { const int hh = 15 - (idx >> 6), bb = (idx >> 3) & 7, pr = idx & 7;
                    att::attn_unit<1>(F.lds + RING_OFF, A, bb, hh, pr);
                    att::attn_unit<1>(F.lds + RING_OFF, A, bb, hh, 15 - pr); }
            }
            asm volatile("s_waitcnt vmcnt(0) lgkmcnt(0)\n\ts_barrier" ::: "memory");
        }
        SEAM(pb + 2);
        if (PHEN(5) && IN(pb + 3)) {
            PTRS();
            const bf16* W = (const bf16*)(ws + (moba ? WS_MWO : WS_DWO)) + (size_t)j * D * D;
            pg8::Gemm g{XN, W, D, 0, (unsigned)((size_t)MTOK * D * 2 - 16), (unsigned*)F.ctl + 2048, (size_t)D * D * 2}; pg8::StaticOrder S; S.init(MTOK, D, F.G, bx);
            pg8::EpiRes E{L == 0 ? x : h, h, D};
            pg8::gemm_phase<pg8::EpiRes, pg8::StaticOrder>(F.lds + RING_OFF, XSLOT_OFF, g, S, E);
        }
        SEAM(pb + 3);
        if (PHEN(6) && IN(pb + 4)) {
            PTRS();
            if (!moba) {
                norm_phase<0>(F, h, nullptr, nullptr, norm_ffn + (size_t)L * D, XN, nullptr, noR);
                if (L == 2) { unsigned rot = 0u;
                    for (int e = 0; e < NE; ++e) {
                        convert_matrix(F, args.in[13] + (size_t)(NE + e) * D * DE, D, DE, MGU + (size_t)e * 2 * DE * D, 1, rot);
                        convert_matrix(F, args.in[14] + (size_t)(NE + e) * D * DE, D, DE, MGU + (size_t)e * 2 * DE * D, 2, rot);
                        convert_matrix(F, args.in[15] + (size_t)(NE + e) * DE * D, DE, D, MD + (size_t)e * D * DE, 0, rot);
                    } }
            } else {
                const RouterArgs R{args.in[12] + (size_t)j * D * NE, F.ctl + CW_CNT + 64 * NE * j, ltok, lw};
                norm_phase<2>(F, h, nullptr, nullptr, norm_ffn + (size_t)L * D, XN, nullptr, R);
            }
        }
        SEAM(pb + 4);
        if (IN(pb + 5)) {
            PTRS();
            if (PHEN(7) && !moba) {
                pg8::Gemm g{XN, (const bf16*)(ws + WS_FGU) + (size_t)j * 2 * DFF * D, D, 0, (unsigned)((size_t)MTOK * D * 2 - 16), (unsigned*)F.ctl + 2048, (size_t)2 * DFF * D * 2}; pg8::StaticOrder S; S.init(MTOK, 2 * DFF, F.G, bx);
                pg8::EpiSwiGLU E{ACT, DFF};
                for (int rep_ = 0; rep_ < NREP(7); ++rep_) pg8::gemm_phase<pg8::EpiSwiGLU, pg8::StaticOrder>(F.lds + RING_OFF, XSLOT_OFF, g, S, E);
            } else if (PHEN(8) && moba) {
                pg8::Gemm g{XN, MGU, D, (size_t)2 * DE * D, (unsigned)((size_t)MTOK * D * 2 - 16), (unsigned*)F.ctl + 2048, (size_t)NE * 2 * DE * D * 2}; pg8::MoeOrder S; S.init((const unsigned*)(F.ctl + CW_CNT + 64 * NE * j), ltok, true, 2 * DE, F.G, bx);
                pg8::EpiSwiGLU E{ACT, DE};
                for (int rep_ = 0; rep_ < NREP(8); ++rep_) pg8::gemm_phase<pg8::EpiSwiGLU, pg8::MoeOrder>(F.lds + RING_OFF, XSLOT_OFF, g, S, E);
            }
        }
        SEAM(pb + 5);
        if (IN(pb + 6)) {
            PTRS();
            if (PHEN(9) && !moba) {
                pg8::Gemm g{ACT, (const bf16*)(ws + WS_FD) + (size_t)j * D * DFF, DFF, 0, (unsigned)((size_t)MTOK * DFF * 2 - 16), (unsigned*)F.ctl + 2048, (size_t)D * DFF * 2}; pg8::StaticOrder S; S.init(MTOK, D, F.G, bx);
                pg8::EpiRes E{h, h, D};
                pg8::gemm_phase<pg8::EpiRes, pg8::StaticOrder>(F.lds + RING_OFF, XSLOT_OFF, g, S, E);
            } else if (PHEN(10) && moba) {
                pg8::Gemm g{ACT, MD, DE, (size_t)D * DE, (unsigned)((size_t)MOE_TILES_MAX * 256 * DE * 2 - 16), (unsigned*)F.ctl + 2048, (size_t)NE * D * DE * 2}; pg8::MoeOrder S; S.init((const unsigned*)(F.ctl + CW_CNT + 64 * NE * j), ltok, false, D, F.G, bx);
                pg8::EpiMoeDown E; E.h = h; E.y1 = XN; E.list_tok = ltok; E.list_w = lw;
#pragma unroll
                for (int e = 0; e < NE; ++e) E.cnt[e] = S.cnt[e];
                pg8::gemm_phase<pg8::EpiMoeDown, pg8::MoeOrder>(F.lds + RING_OFF, XSLOT_OFF, g, S, E);
            }
        }
        SEAM(pb + 6);
        if (PHEN(11) && IN(pb + 7)) {
            PTRS();
            if (L == 3) norm_phase<3>(F, h, nullptr, XN, args.in[16], nullptr, h, noR);
            else if (moba) norm_phase<1>(F, h, h, XN, norm_mix + (size_t)(L + 1) * D, XN, nullptr, noR);
            else for (int rep_ = 0; rep_ < NREP(11); ++rep_) norm_phase<0>(F, h, nullptr, nullptr, norm_mix + (size_t)(L + 1) * D, XN, nullptr, noR);
        }
        if (L != NLAYER - 1) SEAM(pb + 7); else STAMP(pb + 8);
#undef F
    }
#undef IN
#undef SEAM
#undef PTRS
#undef OPQ
}


#if MK_DEBUG
__global__ void dbg_probe(const void* buf, size_t n, int is_bf16, int idx, float thresh, unsigned* dbg) {
    size_t i = blockIdx.x * (size_t)blockDim.x + threadIdx.x, stride = (size_t)gridDim.x * blockDim.x; bool bad = false;
    for (size_t k = i; k < n; k += stride) { float v = is_bf16 ? __uint_as_float(((unsigned)((const unsigned short*)buf)[k]) << 16) : ((const float*)buf)[k]; if (!(fabsf(v) <= thresh)) bad = true; }
    if (bad) atomicMax(dbg, (unsigned)(1000 - idx));
}
__global__ void dbg_cnt(const unsigned* cntw, int idx, unsigned* dbg) {
    if (threadIdx.x == 0 && blockIdx.x == 0) { unsigned s = 0; for (int e = 0; e < NE; ++e) s += cntw[64 * e]; if (s != 2u * MTOK) atomicMax(dbg, (unsigned)(1000 - idx)); }
}

__device__ __forceinline__ float dbg_bf(unsigned short v) { return __uint_as_float(((unsigned)v) << 16); }
__device__ __forceinline__ unsigned dbg_hash(unsigned x) { x ^= x >> 16; x *= 0x7feb352dU; x ^= x >> 15; x *= 0x846ca68bU; x ^= x >> 16; return x; }
__global__ void dbg_gemm_check(const unsigned short* A, int lda, const unsigned short* Bt, int K, const unsigned short* out, int ldo, int M, int N, float scale, int idx, unsigned* dbg) {
    const unsigned s = blockIdx.x * blockDim.x + threadIdx.x; const int row = (int)(dbg_hash(2 * s + 1) % (unsigned)M), col = (int)(dbg_hash(2 * s + 2) % (unsigned)N);
    float acc = 0.f; for (int k = 0; k < K; ++k) acc += dbg_bf(A[(size_t)row * lda + k]) * dbg_bf(Bt[(size_t)col * K + k]);
    acc *= scale; const float got = dbg_bf(out[(size_t)row * ldo + col]);
    if (!(fabsf(got - acc) <= 0.03f + 0.02f * fabsf(acc))) { atomicMax(dbg, (unsigned)(1000 - idx)); atomicAdd(dbg + 64 + idx, 1u); }
}
__global__ void dbg_conv_check(const float* W, int K, int N, const unsigned short* WT, int il, int idx, unsigned* dbg) {
    const unsigned s = blockIdx.x * blockDim.x + threadIdx.x; const int k = (int)(dbg_hash(2 * s + 1) % (unsigned)K), n = (int)(dbg_hash(2 * s + 2) % (unsigned)N);
    const int dr = il == 0 ? n : (n / 128) * 256 + (il - 1) * 128 + (n % 128);
    const float w = W[(size_t)k * N + n], g = dbg_bf(WT[(size_t)dr * K + k]);
    if (!(fabsf(g - w) <= 0.01f * fabsf(w) + 1e-6f)) atomicMax(dbg, (unsigned)(1000 - idx));
}
__global__ void dbg_norm_check(const float* src, const float* gain, const unsigned short* xn, int idx, unsigned* dbg) {
    const unsigned s = blockIdx.x * blockDim.x + threadIdx.x; const int row = (int)(dbg_hash(s + 77) % (unsigned)MTOK);
    float ss = 0.f; for (int c = 0; c < D; ++c) { const float v = src[(size_t)row * D + c]; ss += v * v; }
    const float rstd = 1.f / sqrtf(ss / D + 1e-6f); bool bad = false;
    for (int c = 0; c < D; ++c) { const float r = src[(size_t)row * D + c] * rstd * gain[c], g = dbg_bf(xn[(size_t)row * D + c]); if (!(fabsf(g - r) <= 0.02f + 0.01f * fabsf(r))) bad = true; }
    if (bad) atomicMax(dbg, (unsigned)(1000 - idx));
}
__global__ void dbg_naive_gemm(const unsigned short* A, const unsigned short* Bt, unsigned short* out, int M, int N, int K) {
    const size_t i = blockIdx.x * (size_t)blockDim.x + threadIdx.x; if (i >= (size_t)M * N) return; const int row = (int)(i / N), col = (int)(i % N);
    float acc = 0.f; for (int k = 0; k < K; ++k) acc += dbg_bf(A[(size_t)row * K + k]) * dbg_bf(Bt[(size_t)col * K + k]);
    out[(size_t)row * N + col] = (unsigned short)f2bf(acc);
}
__global__ void dbg_find_col(const unsigned short* out, const unsigned short* ref, int M, int N, unsigned* hist) {
    const unsigned s = blockIdx.x * blockDim.x + threadIdx.x; const int row = (int)(dbg_hash(2 * s + 1) % (unsigned)M), col = (int)(dbg_hash(2 * s + 2) % (unsigned)N);
    const unsigned short v = out[(size_t)row * N + col]; int found = -1;
#if MK_FIND_PATTERN
    if (v == 0x3C3C) atomicAdd(hist + N, 1u); else atomicAdd(hist + 5, 1u); return;
#endif
#if MK_FIND_ROWS
    for (int r = 0; r < M; ++r) if (ref[(size_t)r * N + col] == v) { found = r; break; }
    if (found < 0) atomicAdd(hist + N, 1u); else atomicAdd(hist + ((found - row) & (N - 1)), 1u);
#else
    for (int c = 0; c < N; ++c) if (ref[(size_t)row * N + c] == v) { found = c; break; }
    if (found < 0) atomicAdd(hist + N, 1u); else atomicAdd(hist + ((found - col) & (N - 1)), 1u);
#endif
}
__global__ void dbg_hist_code(const unsigned* hist, int N, unsigned* dbg) {
    if (threadIdx.x || blockIdx.x) return; unsigned best = 0, bi = 0; for (int i = 0; i < N; ++i) if (hist[i] > best) { best = hist[i]; bi = i; }
    dbg[32] = bi; dbg[33] = best; dbg[34] = hist[N];
}
__global__ void dbg_final(float* out, size_t n, const unsigned* dbg) {
    if (MK_HIST_SEL >= 10) { const float c3 = sqrtf((float)dbg[MK_HIST_SEL + 30]); size_t i3 = blockIdx.x * (size_t)blockDim.x + threadIdx.x, st3 = (size_t)gridDim.x * blockDim.x; for (size_t k3 = i3; k3 < n; k3 += st3) out[k3] = c3; return; }
    if (MK_HIST_SEL >= 0 && (dbg[33] || dbg[34])) { const float c2 = sqrtf((float)(MK_HIST_SEL == 0 ? dbg[32] : (MK_HIST_SEL == 1 ? dbg[33] * 100u / 4096u : dbg[34] * 100u / 4096u)) + 1.f); size_t i2 = blockIdx.x * (size_t)blockDim.x + threadIdx.x, st2 = (size_t)gridDim.x * blockDim.x; for (size_t k2 = i2; k2 < n; k2 += st2) out[k2] = c2; return; }
    const unsigned d = dbg[0]; if (d == 0u) return; const unsigned nf = dbg[64 + (1000u - d)]; const float c = sqrtf(nf ? (float)(200u * (1000u - d - 9u) + nf * 100u / 4096u) : (float)(1000u - d));
    size_t i = blockIdx.x * (size_t)blockDim.x + threadIdx.x, stride = (size_t)gridDim.x * blockDim.x;
    for (size_t k = i; k < n; k += stride) out[k] = c;
}
#endif

#ifndef MK_REPEAT
#define MK_REPEAT 1
#endif
#ifndef MK_FIND_ROWS
#define MK_FIND_ROWS 0
#endif
#ifndef MK_FIND_REGION
#define MK_FIND_REGION WS_K
#endif
#ifndef MK_HIST_SEL
#define MK_HIST_SEL 0
#endif
#ifndef MK_STAMP
#define MK_STAMP 0
#endif
#if MK_STAMP
__global__ void stamp_k(unsigned* p) { if (threadIdx.x == 0) *p = (unsigned)__builtin_amdgcn_s_memrealtime(); }
__global__ void stamp_encode(float* out, size_t n, const unsigned* st, int pa, float ua, int pb, float ub) {
    const float da = (float)(st[pa + 1] - st[pa]) * 0.01f, db = (float)(st[pb + 1] - st[pb]) * 0.01f;
    float m = da / ua; m = m < 10.f ? 10.f : (m > 99.f ? 99.f : m); float e = floorf(db / ub + 0.5f); e = e < 0.f ? 0.f : (e > 30.f ? 30.f : e);
    const float c = sqrtf(m) * __powf(10.f, 0.5f * e);
    size_t i = blockIdx.x * (size_t)blockDim.x + threadIdx.x, stride = (size_t)gridDim.x * blockDim.x;
    for (size_t k = i; k < n; k += stride) out[k] = c;
}
#endif
extern "C" void kernel_launch(void* const* d_in, const int* in_sizes, int n_in, void* d_out, int out_size, void* d_ws, size_t ws_size, hipStream_t stream) {
    static int grid = 0;
    if (grid == 0) {
        if (n_in != 17 || in_sizes[0] != MTOK * D || out_size != MTOK * D || ws_size < WS_END) {
            fprintf(stderr, "kernel_launch: built for 17 inputs, x/out of %d floats, >= %zu bytes of workspace; got n_in %d, in0 %d, out %d, ws %zu; nothing launched\n", MTOK * D, (size_t)WS_END, n_in, n_in > 0 ? in_sizes[0] : -1, out_size, ws_size);
            grid = -1; return; }
        int dev = 0, cus = 0, per_cu = 0;
        if (hipGetDevice(&dev) != hipSuccess || hipDeviceGetAttribute(&cus, hipDeviceAttributeMultiprocessorCount, dev) != hipSuccess) { fprintf(stderr, "kernel_launch: device query failed\n"); grid = -1; return; }
        if (hipFuncSetAttribute((const void*)trunk_fwd, hipFuncAttributeMaxDynamicSharedMemorySize, LDS_BYTES) != hipSuccess) { fprintf(stderr, "kernel_launch: hipFuncSetAttribute failed\n"); grid = -1; return; }
        if (hipOccupancyMaxActiveBlocksPerMultiprocessor(&per_cu, (const void*)trunk_fwd, NWAVES * 64, LDS_BYTES) != hipSuccess || per_cu < 1)
            fprintf(stderr, "kernel_launch: note: occupancy query reports %d workgroups per CU\n", per_cu);
        (void)hipGetLastError();
        grid = cus;
    }
    if (grid < 0) return;
    if (hipMemsetAsync((char*)d_ws + WS_CTL, 0, CTL_ZERO_BYTES, stream) != hipSuccess) { fprintf(stderr, "kernel_launch: memset failed\n"); return; }
    KArgs a{};
    for (int i = 0; i < 17; ++i) a.in[i] = (const float*)d_in[i];
    a.out = (float*)d_out; a.ws = (unsigned char*)d_ws;
#if MK_PER_PHASE
#if MK_STAMP
    hipLaunchKernelGGL(stamp_k, dim3(1), dim3(64), 0, stream, (unsigned*)d_ws + 3000);
#endif
    for (int p = 0; p < NPHASE; ++p) {
        a.ph_lo = p; a.ph_hi = p + 1;
#if MK_DEBUG
#endif
#if !defined(MK_SKIP_MAIN)
        for (int rep_ = 0; rep_ < (p == 1 ? MK_REPEAT : 1); ++rep_) hipLaunchKernelGGL(trunk_fwd, dim3(grid), dim3(NWAVES * 64), LDS_BYTES, stream, a);
#endif
#if MK_STAMP
        hipLaunchKernelGGL(stamp_k, dim3(1), dim3(64), 0, stream, (unsigned*)d_ws + 3000 + p + 1);
#endif
#if MK_DEBUG
        {   unsigned char* ws = (unsigned char*)d_ws; unsigned* dbg = (unsigned*)(ws + WS_CTL) + 2048;
            const size_t MD_ = (size_t)MTOK * D;
#define PROBE(buf, n, isbf, idx, th) if ((idx) <= MK_PROBE_MAX) hipLaunchKernelGGL(dbg_probe, dim3(2048), dim3(256), 0, stream, (const void*)(buf), (size_t)(n), isbf, idx, th, dbg)
            if (p == 0) {
                hipLaunchKernelGGL(dbg_norm_check, dim3(4), dim3(64), 0, stream, (const float*)d_in[0], (const float*)d_in[1], (const unsigned short*)(ws + WS_XN), 4, dbg);
                hipLaunchKernelGGL(dbg_conv_check, dim3(16), dim3(256), 0, stream, (const float*)d_in[3], D, 3 * D, (const unsigned short*)(ws + WS_DQKV), 0, 5, dbg);
                hipLaunchKernelGGL(dbg_conv_check, dim3(16), dim3(256), 0, stream, (const float*)d_in[9], D, DFF, (const unsigned short*)(ws + WS_FGU), 1, 6, dbg);
                hipLaunchKernelGGL(dbg_conv_check, dim3(16), dim3(256), 0, stream, (const float*)d_in[10], D, DFF, (const unsigned short*)(ws + WS_FGU), 2, 7, dbg);
                hipLaunchKernelGGL(dbg_conv_check, dim3(16), dim3(256), 0, stream, (const float*)d_in[11], DFF, D, (const unsigned short*)(ws + WS_FD), 0, 8, dbg);
                hipLaunchKernelGGL(dbg_conv_check, dim3(16), dim3(256), 0, stream, (const float*)d_in[15] + (size_t)3 * DE * D, DE, D, (const unsigned short*)(ws + WS_MD) + (size_t)3 * D * DE, 0, 9, dbg);
            }
            if (p == 1) {
                const float C2h = 0.125f * 1.4426950408889634f;
                hipLaunchKernelGGL(dbg_gemm_check, dim3(16), dim3(256), 0, stream, (const unsigned short*)(ws + WS_XN), D, (const unsigned short*)(ws + WS_DQKV), D, (const unsigned short*)(ws + WS_Q), D, MTOK, D, C2h, 10, dbg);
                hipLaunchKernelGGL(dbg_gemm_check, dim3(16), dim3(256), 0, stream, (const unsigned short*)(ws + WS_XN), D, (const unsigned short*)(ws + WS_DQKV) + (size_t)D * D, D, (const unsigned short*)(ws + WS_K), D, MTOK, D, 1.f, 11, dbg);

                hipLaunchKernelGGL(dbg_gemm_check, dim3(16), dim3(256), 0, stream, (const unsigned short*)(ws + WS_XN), D, (const unsigned short*)(ws + WS_DQKV) + (size_t)2 * D * D, D, (const unsigned short*)(ws + WS_V), D, MTOK, D, 1.f, 12, dbg);
            }
            if (0) { PROBE(ws + WS_XN, MD_, 1, 1, 10.f); PROBE(ws + WS_DQKV, (WS_MGU - WS_DQKV) / 2, 1, 2, 1.f); PROBE(ws + WS_MGU, (WS_XN - WS_MGU) / 2, 1, 3, 1.f); }
            if (p >= 1) { const int L = (p - 1) / PH_PER_LAYER, k = (p - 1) % PH_PER_LAYER; const int b = 20 + 10 * L;
                if (k == 0) PROBE(ws + WS_Q, 3 * MD_, 1, b + 0, 50.f);
                if (k == 1) PROBE(ws + WS_KMEAN, 8 * 16 * 16 * 64, 0, b + 1, 5.f);
                if (k == 2) PROBE(ws + WS_XN, MD_, 1, b + 2, 50.f);
                if (k == 3) PROBE(d_out, MD_, 0, b + 3, 300.f);
                if (k == 4) { PROBE(ws + WS_XN, MD_, 1, b + 4, 20.f); if ((L & 1) && (b + 9) <= MK_PROBE_MAX) hipLaunchKernelGGL(dbg_cnt, dim3(1), dim3(64), 0, stream, (const unsigned*)(ws + WS_CTL) + CW_CNT + 64 * NE * (L >> 1), b + 9, dbg); }
                if (k == 5) PROBE(ws + WS_ACT, (L & 1) ? (size_t)256 * 256 * DE : (size_t)MTOK * DFF, 1, b + 5, 2000.f);
                if (k == 6) { PROBE(d_out, MD_, 0, b + 6, 1000.f); if (L & 1) PROBE(ws + WS_XN, MD_, 1, b + 7, 1000.f); }
                if (k == 7 && L != 3) { PROBE(ws + WS_XN, MD_, 1, b + 8, 20.f); PROBE(d_out, MD_, 0, b + 8, 1000.f); }
            }
#undef PROBE
        }
#endif
    }
#if MK_DEBUG
    hipLaunchKernelGGL(dbg_final, dim3(2048), dim3(256), 0, stream, (float*)d_out, (size_t)MTOK * D, (const unsigned*)((unsigned char*)d_ws + WS_CTL) + 2048);
#endif
#else
    a.ph_lo = 0; a.ph_hi = NPHASE;
    hipLaunchKernelGGL(trunk_fwd, dim3(grid), dim3(NWAVES * 64), LDS_BYTES, stream, a);
#if 0
    hipLaunchKernelGGL(stamp_encode, dim3(2048), dim3(256), 0, stream, (float*)d_out, (size_t)MTOK * D, (const unsigned*)d_ws + 3000, MK_STAMP_PA, MK_STAMP_UA, MK_STAMP_PB, MK_STAMP_UB);
#endif
#endif
#if MK_STAMP
    hipLaunchKernelGGL(stamp_encode, dim3(2048), dim3(256), 0, stream, (float*)d_out, (size_t)MTOK * D, (const unsigned*)d_ws + 3000, MK_STAMP_PA, MK_STAMP_UA, MK_STAMP_PB, MK_STAMP_UB);
#endif
    const hipError_t le = hipPeekAtLastError();
    if (le != hipSuccess) fprintf(stderr, "kernel_launch: launch failed: %s\n", hipGetErrorName(le));
}
```

```cpp
#define MK_DEBUG 0
#define MK_PER_PHASE 0
#define MK_DOUBLE 0x0u
#include <hip/hip_runtime.h>
#include <cstdio>
#include <cstdint>

#ifndef MK_DEBUG
#define MK_DEBUG 1
#endif
#ifndef MK_KDEBUG
#define MK_KDEBUG 0
#endif
#define LAS __attribute__((address_space(3)))
#define GAS __attribute__((address_space(1)))

constexpr int BATCH = 8, SEQ = 4096, MTOK = BATCH * SEQ, D = 1024, DFF = 2816, DE = 3584, NE = 8;
constexpr int MOE_TILES_MAX = 272;
constexpr int LIST_CAP = MTOK;

namespace pg8 {
#define PG8_LAS __attribute__((address_space(3)))
typedef unsigned short bf16_t;
typedef short bf16x8 __attribute__((ext_vector_type(8)));
typedef float f32x4 __attribute__((ext_vector_type(4)));
typedef unsigned u32x4 __attribute__((ext_vector_type(4)));
constexpr int BM = 256, BK = 64, HALF = 128, HTB = HALF * BK * 2  , STAGE_BYTES = 8 * HTB, NXCD = 8, WGM = 8;

__host__ __device__ __forceinline__ int lds_byte(int r, int c) { const int st = (r >> 4) * 2 + (c >> 5), rr = r & 15, cc = c & 31, ob = rr * 64 + cc * 2; return st * 1024 + (ob ^ (((ob >> 9) & 1) << 5)); }
__host__ __device__ __forceinline__ void stage_rc(int b, int& R, int& C) { const int st = b / 1024, sb = b % 1024, swz = sb ^ (((sb >> 9) & 1) << 5); R = (st >> 1) * 16 + swz / 64; C = (st & 1) * 32 + (swz % 64) / 2; }
__host__ __device__ __forceinline__ int perm32(int rho) { const int n = rho >> 4, i = rho & 15; return 8 * (i >> 2) + 4 * n + (i & 3); }

struct Unit { int pm, pn, e, r0; };
struct Gemm { const bf16_t* A; const bf16_t* Bt; int K; size_t bstride; unsigned amax; unsigned* dbg; size_t bbytes; };

__device__ __forceinline__ void tile_of(int L, int nM, int nN, int& pm, int& pn) {
    const int nwg = nM * nN; int wgid = L; { const int q = nwg / NXCD, r = nwg % NXCD, xcd = wgid % NXCD, off = wgid / NXCD; wgid = (xcd < r ? xcd * (q + 1) : r * (q + 1) + (xcd - r) * q) + off; }
    const int nig = WGM * nN, gid = wgid / nig, fm = gid * WGM, gsz = (nM - fm) < WGM ? (nM - fm) : WGM;
    pm = fm + ((wgid % nig) % gsz); pn = (wgid % nig) / gsz;
}
struct StaticOrder {
    int nM, nN, nwg, G, c;
    __device__ __forceinline__ void init(int M, int N, int G_, int c_) { nM = M / BM; nN = N / BM; nwg = nM * nN; G = G_; c = c_; }
    __device__ __forceinline__ bool next(int i, Unit& u) const {
        const long L = (long)i * G + c; if (L >= nwg) return false;
        tile_of((int)L, nM, nN, u.pm, u.pn); u.e = 0; u.r0 = 0; return true;
    }
    __device__ __forceinline__ unsigned arow(const Unit& u, int lr) const { return (unsigned)(u.pm * BM + lr); }
};
struct MoeOrder {
    int nM, nN, nwg, G, c; int tstart[NE + 1]; int cnt[NE]; const unsigned* list_tok; bool gather;
    __device__ __forceinline__ void init(const unsigned* cntw, const unsigned* list_tok_, bool gather_, int N, int G_, int c_) {
        int acc = 0;
#pragma unroll
        for (int e = 0; e < NE; ++e) { const int ce = (int)__builtin_amdgcn_readfirstlane((int)__hip_atomic_load((const GAS unsigned*)cntw + 64 * e, __ATOMIC_RELAXED, __HIP_MEMORY_SCOPE_AGENT)); cnt[e] = ce; tstart[e] = acc; acc += (ce + BM - 1) / BM; }
        tstart[NE] = acc; nM = acc; nN = N / BM; nwg = nM * nN; G = G_; c = c_; list_tok = list_tok_; gather = gather_;
    }
    __device__ __forceinline__ bool next(int i, Unit& u) const {
        const long L = (long)i * G + c; if (L >= nwg) return false;
        tile_of((int)L, nM, nN, u.pm, u.pn); int e = 0;
#pragma unroll
        for (int k = 1; k < NE; ++k) e += (u.pm >= tstart[k]) ? 1 : 0;
        u.e = e; int ts = 0;
#pragma unroll
        for (int k = 0; k < NE; ++k) ts = (k == e) ? tstart[k] : ts;
        u.r0 = (u.pm - ts) * BM; return true;
    }
    __device__ __forceinline__ int count_of(int e) const { int cv = 0;
#pragma unroll
        for (int k = 0; k < NE; ++k) cv = (k == e) ? cnt[k] : cv;
        return cv; }
    __device__ __forceinline__ unsigned arow(const Unit& u, int lr) const {
        if (!gather) return (unsigned)(u.pm * BM + lr);
        const int l = u.r0 + lr; const int cv = count_of(u.e);
        unsigned t = 0u; if (l < cv) t = __hip_atomic_load((const GAS unsigned*)list_tok + (size_t)u.e * LIST_CAP + l, __ATOMIC_RELAXED, __HIP_MEMORY_SCOPE_AGENT) & 0xFFFFFu;
        return t;
    }
};

__device__ __forceinline__ unsigned cvt_pk_bf16(float lo, float hi) { unsigned r; asm volatile("v_cvt_pk_bf16_f32 %0, %1, %2" : "=v"(r) : "v"(lo), "v"(hi)); return r; }

struct EpiQKV {
    static constexpr bool PERM = true;
    bf16_t* O; int ldc; int split_cols; size_t split_stride; float scale0; unsigned* dbg;
    __device__ __forceinline__ void operator()(const f32x4 (&acc)[2][2][4][2], const Unit& u, int wr, int wc, int fr, int fq) const {
        const int row0 = u.pm * BM + wr * 64 + fr; int colt = u.pn * BM; bf16_t* base = O;
        float sc = 1.f; { const int t = colt / split_cols; base += (size_t)t * split_stride; colt -= t * split_cols; if (t == 0) sc = scale0; }
        const int col0 = colt + wc * 32 + 8 * fq;
#pragma unroll
        for (int ai = 0; ai < 2; ++ai)
#pragma unroll
            for (int m = 0; m < 4; ++m) { bf16_t* rowp = base + (size_t)(row0 + ai * HALF + m * 16) * ldc + col0;
#pragma unroll
                for (int bj = 0; bj < 2; ++bj) { f32x4 v0 = acc[ai][bj][m][0] * sc, v1 = acc[ai][bj][m][1] * sc;
                    u32x4 w; w.x = cvt_pk_bf16(v0[0], v0[1]); w.y = cvt_pk_bf16(v0[2], v0[3]); w.z = cvt_pk_bf16(v1[0], v1[1]); w.w = cvt_pk_bf16(v1[2], v1[3]);
#if defined(EPI_VARIANT) && EPI_VARIANT == 1
                    { u32x4 cz = {0x3f803f80u, 0x3f803f80u, 0x3f803f80u, 0x3f803f80u}; asm volatile("" :: "v"(w)); *(GAS u32x4*)(rowp + bj * HALF) = cz; }
#elif defined(EPI_VARIANT) && EPI_VARIANT == 2
                    { asm volatile("" :: "v"(w)); asm volatile("" :: "v"(rowp)); }
#elif MK_KDEBUG
                    { const size_t eo = (size_t)((rowp + bj * HALF) - O); if (eo + 8 <= (size_t)3 * 33554432) *(GAS u32x4*)(rowp + bj * HALF) = w; else atomicMax(dbg, 1000u - 3u); }
#else
                    *(GAS u32x4*)(rowp + bj * HALF) = w;
#endif
                    } }
    }
};
struct EpiSwiGLU {
    static constexpr bool PERM = true;
    bf16_t* O; int ldc;
    __device__ __forceinline__ void operator()(const f32x4 (&acc)[2][2][4][2], const Unit& u, int wr, int wc, int fr, int fq) const {
        const int row0 = u.pm * BM + wr * 64 + fr; const int col0 = u.pn * HALF + wc * 32 + 8 * fq;
#pragma unroll
        for (int ai = 0; ai < 2; ++ai)
#pragma unroll
            for (int m = 0; m < 4; ++m) { bf16_t* rowp = O + (size_t)(row0 + ai * HALF + m * 16) * ldc + col0; float o[8];
#pragma unroll
                for (int n = 0; n < 2; ++n)
#pragma unroll
                    for (int j = 0; j < 4; ++j) { const float g = acc[ai][0][m][n][j], up = acc[ai][1][m][n][j];
                        const float s = __builtin_amdgcn_rcpf(1.0f + __builtin_amdgcn_exp2f(-1.4426950408889634f * g)); o[n * 4 + j] = g * s * up; }
                u32x4 w; w.x = cvt_pk_bf16(o[0], o[1]); w.y = cvt_pk_bf16(o[2], o[3]); w.z = cvt_pk_bf16(o[4], o[5]); w.w = cvt_pk_bf16(o[6], o[7]);
                *(GAS u32x4*)rowp = w; }
    }
};
struct EpiRes {
    static constexpr bool PERM = false;
    const float* res; float* out; int ldc;
    __device__ __forceinline__ void operator()(const f32x4 (&acc)[2][2][4][2], const Unit& u, int wr, int wc, int fr, int fq) const {
        const int row0 = u.pm * BM + wr * 64 + fr; const int col0 = u.pn * BM + wc * 32 + 4 * fq;
#pragma unroll
        for (int ai = 0; ai < 2; ++ai)
#pragma unroll
            for (int m = 0; m < 4; ++m) { const size_t off = (size_t)(row0 + ai * HALF + m * 16) * ldc + col0;
#pragma unroll
                for (int bj = 0; bj < 2; ++bj)
#pragma unroll
                    for (int n = 0; n < 2; ++n) { const f32x4 r = *(const GAS f32x4*)(res + off + bj * HALF + n * 16); *(GAS f32x4*)(out + off + bj * HALF + n * 16) = r + acc[ai][bj][m][n]; } }
    }
};
struct EpiMoeDown {
    static constexpr bool PERM = false;
    float* h; bf16_t* y1; const unsigned* list_tok; const float* list_w; int cnt[NE];
    __device__ __forceinline__ void operator()(const f32x4 (&acc)[2][2][4][2], const Unit& u, int wr, int wc, int fr, int fq) const {
        int cv = 0;
#pragma unroll
        for (int k = 0; k < NE; ++k) cv = (k == u.e) ? cnt[k] : cv;
        const int col0 = u.pn * BM + wc * 32 + 4 * fq;
#pragma unroll
        for (int ai = 0; ai < 2; ++ai)
#pragma unroll
            for (int m = 0; m < 4; ++m) { const int l = u.r0 + ai * HALF + wr * 64 + m * 16 + fr;
                if (l < cv) {
                    const unsigned ent = __hip_atomic_load((const GAS unsigned*)list_tok + (size_t)u.e * LIST_CAP + l, __ATOMIC_RELAXED, __HIP_MEMORY_SCOPE_AGENT);
                    const float w = __uint_as_float(__hip_atomic_load((const GAS unsigned*)list_w + (size_t)u.e * LIST_CAP + l, __ATOMIC_RELAXED, __HIP_MEMORY_SCOPE_AGENT));
                    const size_t off = (size_t)(ent & 0xFFFFFu) * D + col0;
                    if ((ent >> 20) == 0u) {
#pragma unroll
                        for (int bj = 0; bj < 2; ++bj)
#pragma unroll
                            for (int n = 0; n < 2; ++n) { GAS float* p = (GAS float*)(h + off + bj * HALF + n * 16); const f32x4 r = *(const GAS f32x4*)p; *(GAS f32x4*)p = r + acc[ai][bj][m][n] * w; }
                    } else {
#pragma unroll
                        for (int bj = 0; bj < 2; ++bj)
#pragma unroll
                            for (int n = 0; n < 2; ++n) { const f32x4 v = acc[ai][bj][m][n] * w; unsigned long long pk = (unsigned long long)cvt_pk_bf16(v[0], v[1]) | ((unsigned long long)cvt_pk_bf16(v[2], v[3]) << 32);
                                *(GAS unsigned long long*)(y1 + off + bj * HALF + n * 16) = pk; }
                    }
                } }
    }
};

template <class Epi, class Sched>
__device__ __forceinline__ void gemm_phase(PG8_LAS unsigned char* lds, int xoff, const Gemm g, const Sched& S, const Epi& E) {
    int tid_ = threadIdx.x;
#if !defined(NO_OPQ_T)
    asm volatile("" : "+v"(tid_));
#endif
    const int tid = tid_, wid = __builtin_amdgcn_readfirstlane(tid >> 6), lane = tid & 63, wr = wid >> 2, wc = wid & 3, fr = lane & 15, fq = lane >> 4;
    const int K = g.K, nt = K / BK;
    unsigned voffB[2];
#pragma unroll
    for (int i = 0; i < 2; ++i) { int R, C; stage_rc(tid * 16 + i * 8192, R, C); const int Rb = Epi::PERM ? ((R & ~31) + perm32(R & 31)) : R;
        voffB[i] = (unsigned)(Rb * K + C) * 2u; }
    const size_t kstep = (size_t)(BK * 2);
    const size_t hstep = (size_t)HALF * K * 2;
    const size_t tstep = 2 * hstep;
    const unsigned ldsw = (unsigned)wid * 1024u;
    const int aoff = lds_byte(wr * 64 + fr, fq * 8), boff = lds_byte(wc * 32 + fr, fq * 8);
#define PG8_SA(b, h) (((b) * 2 + (h)) * HTB)
#define PG8_SB(b, h) ((4 + (b) * 2 + (h)) * HTB)
#define PG8_STAGE(bufoff, gbase, v0, v1) do { \
        __builtin_amdgcn_global_load_lds((const GAS unsigned*)((const char*)(gbase) + (v0)), (PG8_LAS unsigned*)(lds + (bufoff) + ldsw), 16, 0, 0); \
        __builtin_amdgcn_global_load_lds((const GAS unsigned*)((const char*)(gbase) + (v1)), (PG8_LAS unsigned*)(lds + (bufoff) + ldsw + 8192), 16, 0, 0); } while (0)
#define PG8_STAGEB(bufoff, gbase) PG8_STAGE(bufoff, gbase, voffB[0], voffB[1])
#define PG8_LDA(dst, b, h) do { _Pragma("unroll") for (int m = 0; m < 4; ++m) _Pragma("unroll") for (int k = 0; k < 2; ++k) dst[m][k] = *(const PG8_LAS bf16x8*)(lds + PG8_SA(b, h) + aoff + m * 2048 + k * 1024); } while (0)
#define PG8_LDB(dst, b, h) do { _Pragma("unroll") for (int n = 0; n < 2; ++n) _Pragma("unroll") for (int k = 0; k < 2; ++k) dst[n][k] = *(const PG8_LAS bf16x8*)(lds + PG8_SB(b, h) + boff + n * 2048 + k * 1024); } while (0)
#define PG8_MMA(ai, bj, At, Bt) do { __builtin_amdgcn_s_setprio(1); _Pragma("unroll") for (int m = 0; m < 4; ++m) _Pragma("unroll") for (int n = 0; n < 2; ++n) _Pragma("unroll") for (int k = 0; k < 2; ++k) \
        acc[ai][bj][m][n] = __builtin_amdgcn_mfma_f32_16x16x32_bf16(Bt[n][k], At[m][k], acc[ai][bj][m][n], 0, 0, 0); __builtin_amdgcn_s_setprio(0); } while (0)
#define PG8_WAIT_V(n) asm volatile("s_waitcnt vmcnt(" #n ")" ::: "memory")
#define PG8_WAIT_L(n) asm volatile("s_waitcnt lgkmcnt(" #n ")" ::: "memory")
#define PG8_BAR __builtin_amdgcn_s_barrier()
#define PG8_SCHED __builtin_amdgcn_sched_barrier(0)
#define PG8_AOFFS(U, o00, o01, o10, o11) do { int R0_, C0_, R1_, C1_; stage_rc(tid * 16, R0_, C0_); stage_rc(tid * 16 + 8192, R1_, C1_);     \
        o00 = (S.arow(U, R0_) * (unsigned)K + (unsigned)C0_) * 2u; o01 = (S.arow(U, R1_) * (unsigned)K + (unsigned)C1_) * 2u; \
        o10 = (S.arow(U, HALF + R0_) * (unsigned)K + (unsigned)C0_) * 2u; o11 = (S.arow(U, HALF + R1_) * (unsigned)K + (unsigned)C1_) * 2u; } while (0)
    Unit cur, nxt; int ui = 0;
#if MK_KDEBUG
    if (blockIdx.x == 5 && threadIdx.x == 0) atomicOr(g.dbg + 43, 2u);
#endif
    if (!S.next(0, cur)) return;
#if MK_KDEBUG
    if (blockIdx.x == 5 && threadIdx.x == 0) atomicOr(g.dbg + 43, 4u);
    { Unit t1_; if (blockIdx.x == 5 && threadIdx.x == 0 && S.next(1, t1_)) { g.dbg[40] = 1u + (unsigned)t1_.pm * 16u + (unsigned)t1_.pn; g.dbg[41] = 1u + (unsigned)cur.pm * 16u + (unsigned)cur.pn; g.dbg[42] = 1u + (unsigned)gridDim.x; atomicOr(g.dbg + 43, 8u); } }
#endif
#if defined(GDBG_NOKLOOP)
    { f32x4 accz[2][2][4][2];
      for (int ui_ = 0; S.next(ui_, cur); ++ui_) {
#pragma unroll
        for (int a = 0; a < 2; ++a)
#pragma unroll
          for (int b = 0; b < 2; ++b)
#pragma unroll
            for (int m = 0; m < 4; ++m)
#pragma unroll
              for (int n = 0; n < 2; ++n) { f32x4 r4;
                for (int j = 0; j < 4; ++j) { const int row = cur.pm * 256 + a * 128 + wr * 64 + m * 16 + fr;
                  const int col = cur.pn * 256 + b * 128 + wc * 32 + (Epi::PERM ? 8 * fq + 4 * n + j : 16 * n + 4 * fq + j);
                  const bf16_t* ar = g.A + (size_t)row * K; const bf16_t* br = g.Bt + (size_t)cur.e * g.bstride + (size_t)col * K; float s_ = 0.f;
                  for (int k = 0; k < K; ++k) s_ += __uint_as_float(((unsigned)ar[k]) << 16) * __uint_as_float(((unsigned)br[k]) << 16);
                  r4[j] = s_; }
                accz[a][b][m][n] = r4; }
        E(accz, cur, wr, wc, fr, fq); }
      return; }
#endif
    f32x4 acc[2][2][4][2];
#pragma unroll
    for (int a = 0; a < 2; ++a)
#pragma unroll
        for (int b = 0; b < 2; ++b)
#pragma unroll
            for (int m = 0; m < 4; ++m)
#pragma unroll
                for (int n = 0; n < 2; ++n) acc[a][b][m][n] = (f32x4){0.f, 0.f, 0.f, 0.f};
    bf16x8 At[4][2], B0[2][2], B1[2][2];
    unsigned c00, c01, c10, c11;
    PG8_LAS u32x4* const xslot = (PG8_LAS u32x4*)(lds + xoff) + tid;
    PG8_AOFFS(cur, c00, c01, c10, c11);
    const char* const gA = (const char*)g.A;
    const char* cB = (const char*)g.Bt + (size_t)cur.e * g.bstride * 2 + (size_t)cur.pn * tstep;
    PG8_STAGEB(PG8_SB(0, 0), cB); PG8_STAGEB(PG8_SB(0, 1), cB + hstep); PG8_STAGE(PG8_SA(0, 0), gA, c00, c01); PG8_STAGE(PG8_SA(0, 1), gA, c10, c11);
    if (wr == 1) PG8_BAR;
    PG8_WAIT_V(2); PG8_BAR;
    PG8_STAGEB(PG8_SB(1, 0), cB + kstep); PG8_STAGE(PG8_SA(1, 0), gA + kstep, c00, c01); PG8_STAGEB(PG8_SB(1, 1), cB + hstep + kstep);
    PG8_WAIT_V(6); PG8_BAR;
    for (;;) {
        const bool has_next = S.next(ui + 1, nxt);
        const char* nB_ = has_next ? (const char*)g.Bt + (size_t)nxt.e * g.bstride * 2 + (size_t)nxt.pn * tstep : cB;
        const char* nB = nB_;
        if (has_next) { unsigned n00, n01, n10, n11; PG8_AOFFS(nxt, n00, n01, n10, n11); *xslot = (u32x4){n00, n01, n10, n11}; }
#if MK_KDEBUG
        { const char* lo_ = (const char*)g.Bt; const char* hi_ = lo_ + g.bbytes - tstep;
          if (cB < lo_ || cB > hi_ || nB < lo_ || nB > hi_) { atomicMax(g.dbg, 1000u - 92u); cB = lo_; nB = lo_; }
          if (voffB[0] > (unsigned)tstep || voffB[1] > (unsigned)tstep) { atomicMax(g.dbg, 1000u - 93u); voffB[0] = 0u; voffB[1] = 0u; }
          const unsigned mx_ = g.amax; if (c00 > mx_ || c01 > mx_ || c10 > mx_ || c11 > mx_) { atomicMax(g.dbg, 1000u - 94u); c00 = 0u; c01 = 0u; c10 = 0u; c11 = 0u; } }
#endif
        for (int t = 0; t < nt; t += 2) {
            const bool last = (t == nt - 2);
            const char* a1 = gA + (size_t)(t + 1) * kstep;
            const char* a2 = last ? gA : gA + (size_t)(t + 2) * kstep; const char* b2 = last ? nB : cB + (size_t)(t + 2) * kstep;
            const char* a3 = a2 + kstep; const char* b3 = b2 + kstep;
            PG8_LDB(B0, 0, 0); PG8_LDB(B1, 0, 1); PG8_SCHED; PG8_LDA(At, 0, 0); PG8_STAGE(PG8_SA(1, 1), a1, c10, c11);
            if (last && has_next) { const u32x4 nx = *xslot; c00 = nx.x; c01 = nx.y; c10 = nx.z; c11 = nx.w; }
#if MK_KDEBUG
            { const unsigned mx_ = g.amax; if (c00 > mx_ || c01 > mx_ || c10 > mx_ || c11 > mx_) { atomicMax(g.dbg, 1000u - 90u); c00 = c00 > mx_ ? 0u : c00; c01 = c01 > mx_ ? 0u : c01; c10 = c10 > mx_ ? 0u : c10; c11 = c11 > mx_ ? 0u : c11; } }
#endif
            PG8_WAIT_V(8); PG8_WAIT_L(0); PG8_BAR; PG8_MMA(0, 0, At, B0); PG8_MMA(0, 1, At, B1); PG8_BAR; PG8_SCHED;
            PG8_LDA(At, 0, 1); PG8_STAGEB(PG8_SB(0, 0), b2); PG8_STAGEB(PG8_SB(0, 1), b2 + hstep); PG8_STAGE(PG8_SA(0, 0), a2, c00, c01);
            PG8_WAIT_V(8); PG8_WAIT_L(0); PG8_BAR; PG8_MMA(1, 0, At, B0); PG8_MMA(1, 1, At, B1); PG8_BAR; PG8_SCHED;
            PG8_LDB(B0, 1, 0); PG8_LDB(B1, 1, 1); PG8_SCHED; PG8_LDA(At, 1, 0); PG8_STAGE(PG8_SA(0, 1), a2, c10, c11);
            PG8_WAIT_V(8); PG8_WAIT_L(0); PG8_BAR; PG8_MMA(0, 0, At, B0); PG8_MMA(0, 1, At, B1); PG8_BAR; PG8_SCHED;
            PG8_LDA(At, 1, 1); PG8_STAGEB(PG8_SB(1, 0), b3); PG8_STAGEB(PG8_SB(1, 1), b3 + hstep); PG8_STAGE(PG8_SA(1, 0), a3, c00, c01);
            PG8_WAIT_V(8); PG8_WAIT_L(0); PG8_BAR; PG8_MMA(1, 0, At, B0); PG8_MMA(1, 1, At, B1); PG8_BAR; PG8_SCHED;
        }
        if (wr == 0) PG8_BAR;
#if !defined(GDBG_NOEPI)
#if defined(EPI_DRAIN)
        asm volatile("s_waitcnt vmcnt(0)" ::: "memory");
#endif
        E(acc, cur, wr, wc, fr, fq);
#if defined(EPI_DRAIN_AFTER)
        asm volatile("s_waitcnt vmcnt(0)" ::: "memory");
#endif
#else
        asm volatile("" :: "v"(acc[0][0][0][0]), "v"(acc[1][1][3][1]));
#endif
        if (!has_next) break;
#pragma unroll
        for (int a = 0; a < 2; ++a)
#pragma unroll
            for (int b = 0; b < 2; ++b)
#pragma unroll
                for (int m = 0; m < 4; ++m)
#pragma unroll
                    for (int n = 0; n < 2; ++n) acc[a][b][m][n] = (f32x4){0.f, 0.f, 0.f, 0.f};
        cur = nxt; cB = nB; ++ui;
        if (wr == 1) PG8_BAR;
    }
    PG8_WAIT_V(0);
    PG8_BAR;
#undef PG8_SA
#undef PG8_SB
#undef PG8_STAGE
#undef PG8_STAGEB
#undef PG8_LDA
#undef PG8_LDB
#undef PG8_MMA
#undef PG8_WAIT_V
#undef PG8_WAIT_L
#undef PG8_BAR
#undef PG8_SCHED
#undef PG8_AOFFS
}
}

namespace att {
typedef unsigned short bf16_t;
typedef short bf16x8 __attribute__((ext_vector_type(8)));
typedef short s16x4 __attribute__((ext_vector_type(4)));
typedef float f32x16 __attribute__((ext_vector_type(16)));
typedef float f32x4 __attribute__((ext_vector_type(4)));
typedef unsigned u32x4 __attribute__((ext_vector_type(4)));
constexpr int PITCH = 1024;
constexpr float LOG2E = 1.4426950408889634f;
__device__ __forceinline__ int crow(int r, int hi) { return (r & 3) + 8 * (r >> 2) + 4 * hi; }
typedef float f32x2_t __attribute__((ext_vector_type(2))); typedef __bf16 bf16x2_t __attribute__((ext_vector_type(2)));
__device__ __forceinline__ unsigned cvtpk(float lo, float hi) { f32x2_t v = {lo, hi}; bf16x2_t b = __builtin_convertvector(v, bf16x2_t); return __builtin_bit_cast(unsigned, b); }
__device__ __forceinline__ float bf2f(short s) { return __uint_as_float(((unsigned)(unsigned short)s) << 16); }
typedef short v4i16_t __attribute__((ext_vector_type(4)));
__device__ __forceinline__ s16x4 vtr(const LAS unsigned char* p) { return __builtin_bit_cast(s16x4, __builtin_amdgcn_ds_read_tr16_b64_v4i16((LAS v4i16_t*)p)); }
__device__ __forceinline__ float max3f(float a, float b, float c) { float r; asm("v_max3_f32 %0, %1, %2, %3" : "=v"(r) : "v"(a), "v"(b), "v"(c)); return r; }
__device__ __forceinline__ float halves_max(float m) { auto rr = __builtin_amdgcn_permlane32_swap(__float_as_uint(m), __float_as_uint(m), false, false); return fmaxf(__uint_as_float(rr[0]), __uint_as_float(rr[1])); }
__device__ __forceinline__ float halves_sum(float m) { auto rr = __builtin_amdgcn_permlane32_swap(__float_as_uint(m), __float_as_uint(m), false, false); return __uint_as_float(rr[0]) + __uint_as_float(rr[1]); }
#define ATT_BAR() asm volatile("s_waitcnt vmcnt(0) lgkmcnt(0)\n\ts_barrier" ::: "memory")

struct Args { const bf16_t* Q; const bf16_t* K; const bf16_t* V; bf16_t* O; const float* kmean; const float* kmax2; const float* subln; float lam_full; float out_scale; };

template <int MODE>
__device__ __forceinline__ void attn_unit(LAS unsigned char* lds, const Args& A, int b, int h, int qblk) {
    constexpr int DVB = MODE == 0 ? 4 : 2;
    constexpr int NCH = MODE == 0 ? 16 : 8;
    constexpr int KBY = NCH * 1024, VBY = DVB * 4096, SLOT = KBY + VBY;
    constexpr int QR = MODE == 0 ? 128 : 256;
    constexpr int PPW = MODE == 0 ? 2 : 1;
    int tid_ = threadIdx.x; asm volatile("" : "+v"(tid_));
    const int tid = tid_, lane = tid & 63, r32 = lane & 31, hi = lane >> 5;
    const int wid = __builtin_amdgcn_readfirstlane(tid >> 6);
    const int comp = MODE == 0 ? (wid >> 2) : 0, wq = MODE == 0 ? (wid & 3) : wid;
    const int q0 = qblk * QR; const long rowbase = (long)b * SEQ;
    const int hcol = MODE == 0 ? h * 128 : h * 64;
    const int qrel0 = wq * 32;
    const float slope2 = __builtin_amdgcn_exp2f(MODE == 0 ? -(float)(h + 1) : -0.5f * (float)(h + 1)) * LOG2E;
    const int NT = MODE == 0 ? 2 * qblk + 2 : 4 + 4 * qblk;
#define ATT_KBASE_(t) (MODE == 0 ? 64 * (t) : ((t) < 4 ? q0 + 64 * (t) : 64 * ((t) - 4)))
    LAS float* wsf = (LAS float*)(lds + 65536) + wid * 64;
    const bf16_t* Kb = A.K + rowbase * PITCH + hcol;
    const bf16_t* Vb = A.V + rowbase * PITCH + hcol;
    bf16x8 qr[4];
    { const bf16_t* Qw = A.Q + (rowbase + q0 + qrel0 + r32) * PITCH + hcol + comp * 64 + hi * 8;
#pragma unroll
      for (int d0 = 0; d0 < 4; ++d0) qr[d0] = *(const GAS bf16x8*)(Qw + d0 * 16); }
    ATT_BAR();
    LAS int* live = (LAS int*)(lds + 71680); LAS float* qnx = (LAS float*)(lds + 71680 + 272);
    { float q2 = 0.f;
#pragma unroll
      for (int d0 = 0; d0 < 4; ++d0)
#pragma unroll
        for (int j = 0; j < 8; ++j) { const float v = bf2f(qr[d0][j]); q2 += v * v; }
      q2 = halves_sum(q2);
      q2 = fmaxf(q2, __shfl_xor(q2, 1)); q2 = fmaxf(q2, __shfl_xor(q2, 2)); q2 = fmaxf(q2, __shfl_xor(q2, 4)); q2 = fmaxf(q2, __shfl_xor(q2, 8)); q2 = fmaxf(q2, __shfl_xor(q2, 16));
      if (lane == 0) qnx[wid] = q2; }
    ATT_BAR();
    if (wid == 0) {
        const int tt = lane;
        const int kbase_t = (tt < NT) ? ATT_KBASE_(tt) : 0;
        bool alive = tt < NT;
        if (alive && kbase_t + 64 <= q0) {
            const int nblk = kbase_t >> 8; float bound = -INFINITY;
            if constexpr (MODE == 0) {
#pragma unroll
                for (int c = 0; c < 2; ++c) { float qm = fmaxf(fmaxf(qnx[4 * c], qnx[4 * c + 1]), fmaxf(qnx[4 * c + 2], qnx[4 * c + 3]));
                    const float k2 = ((const GAS float*)A.kmax2)[(size_t)(b * 16 + h * 2 + c) * 16 + nblk]; bound = fmaxf(bound, sqrtf(qm) * sqrtf(k2)); }
            } else {
                float qm = qnx[0];
#pragma unroll
                for (int w = 1; w < 8; ++w) qm = fmaxf(qm, qnx[w]);
                const float k2 = ((const GAS float*)A.kmax2)[(size_t)(b * 16 + h) * 16 + nblk]; bound = sqrtf(qm) * sqrtf(k2);
            }
            alive = !(bound * 1.001f + 1.0f + slope2 * (float)(kbase_t + 63 - q0) < -152.0f);
        }
        const unsigned long long am = __ballot(alive);
        if (alive) live[__popcll(am & ((1ull << lane) - 1ull))] = tt;
        if (lane == 0) live[64] = __popcll(am);
    }
    ATT_BAR();
    const int NTL = __builtin_amdgcn_readfirstlane(live[64]);
    unsigned sel = 0u;
    if constexpr (MODE == 1) {
        LAS float* km = (LAS float*)(lds + 67584);
        for (int i = tid; i < 1024; i += 512) km[i] = ((const GAS float*)A.kmean)[(size_t)(b * 16 + h) * 1024 + i];
        ATT_BAR();
        float g[16];
#pragma unroll
        for (int n = 0; n < 16; ++n) { float s = 0.f;
            if (n < qblk) {
#pragma unroll
                for (int d0 = 0; d0 < 4; ++d0) { const f32x4 ka = *(const LAS f32x4*)(km + n * 64 + d0 * 16 + hi * 8), kb2 = *(const LAS f32x4*)(km + n * 64 + d0 * 16 + hi * 8 + 4);
                    s += bf2f(qr[d0][0]) * ka[0] + bf2f(qr[d0][1]) * ka[1] + bf2f(qr[d0][2]) * ka[2] + bf2f(qr[d0][3]) * ka[3]
                       + bf2f(qr[d0][4]) * kb2[0] + bf2f(qr[d0][5]) * kb2[1] + bf2f(qr[d0][6]) * kb2[2] + bf2f(qr[d0][7]) * kb2[3]; }
                s = halves_sum(s); }
            g[n] = s; }
        const int nsel = qblk < 3 ? qblk : 3;
#pragma unroll
        for (int k = 0; k < 3; ++k) if (k < nsel) { float best = -INFINITY; int bi = 0; bool found = false;
#pragma unroll
            for (int n = 0; n < 16; ++n) if (n < qblk) { const bool free_ = ((sel >> n) & 1u) == 0u; if (free_ && (!found || g[n] > best)) { best = g[n]; bi = n; found = true; } }
            sel |= 1u << bi; }
    }
#define ATT_KBASE(t) ATT_KBASE_(t)
#define ATT_ISSUE(t, slot) do { const int kb_ = ATT_KBASE(t); \
        _Pragma("unroll") for (int i_ = 0; i_ < PPW; ++i_) { const int p_ = wid + 8 * i_; \
            __builtin_amdgcn_global_load_lds((const GAS unsigned*)(Kb + (size_t)(kb_ + lane) * PITCH + p_ * 8), (LAS unsigned*)(lds + (slot) * SLOT + p_ * 1024), 16, 0, 0); \
            __builtin_amdgcn_global_load_lds((const GAS unsigned*)(Vb + (size_t)(kb_ + 16 * (p_ & 3) + (lane >> 2)) * PITCH + (p_ >> 2) * 32 + (lane & 3) * 8), (LAS unsigned*)(lds + (slot) * SLOT + KBY + p_ * 1024), 16, 0, 0); } } while (0)
    constexpr float THR = 8.0f;
    float mref = 0.f, l = 0.f; f32x16 o[DVB];
#pragma unroll
    for (int d0 = 0; d0 < DVB; ++d0) o[d0] = f32x16{};
#define ATT_ISSUE_K(tt, slot) do { const int kb_ = ATT_KBASE(tt); \
        _Pragma("unroll") for (int i_ = 0; i_ < PPW; ++i_) { const int p_ = wid + 8 * i_; \
            __builtin_amdgcn_global_load_lds((const GAS unsigned*)(Kb + (size_t)(kb_ + lane) * PITCH + p_ * 8), (LAS unsigned*)(lds + (slot) * SLOT + p_ * 1024), 16, 0, 0); } } while (0)
#define ATT_ISSUE_V(tt, slot) do { const int kb_ = ATT_KBASE(tt); \
        _Pragma("unroll") for (int i_ = 0; i_ < PPW; ++i_) { const int p_ = wid + 8 * i_; \
            __builtin_amdgcn_global_load_lds((const GAS unsigned*)(Vb + (size_t)(kb_ + 16 * (p_ & 3) + (lane >> 2)) * PITCH + (p_ >> 2) * 32 + (lane & 3) * 8), (LAS unsigned*)(lds + (slot) * SLOT + KBY + p_ * 1024), 16, 0, 0); } } while (0)
#define ATT_CLASS(tt, SK, NM, SB) do { const int kb_ = ATT_KBASE(tt), kr_ = kb_ - q0; const bool dg_ = kb_ >= q0; SK = dg_ && (kr_ > qrel0 + 31); NM = dg_ && (kr_ + 63 > qrel0); SB = true; \
        if constexpr (MODE == 1) { if ((tt) >= 4) { SB = ((sel >> (((tt) - 4) >> 2)) & 1u) != 0u; if (!__any(SB)) SK = true; } } } while (0)
#define ATT_QK(P0, P1, tt, slot, SB) do { const int kr_ = ATT_KBASE(tt) - q0; float off0_ = slope2 * (float)(kr_ + 4 * hi) - mref; if (!(SB)) off0_ = -INFINITY; const float off1_ = off0_ + 32.0f * slope2; \
        _Pragma("unroll") for (int r = 0; r < 16; ++r) { const float cbr = slope2 * (float)((r & 3) + 8 * (r >> 2)); P0[r] = cbr + off0_; P1[r] = cbr + off1_; } \
        const LAS unsigned char* Ks_ = lds + (slot) * SLOT + comp * 8192 + hi * 1024 + r32 * 16; \
        _Pragma("unroll") for (int d0 = 0; d0 < 4; ++d0) { const bf16x8 b0 = *(const LAS bf16x8*)(Ks_ + d0 * 2048), b1 = *(const LAS bf16x8*)(Ks_ + d0 * 2048 + 512); \
            P0 = __builtin_amdgcn_mfma_f32_32x32x16_bf16(b0, qr[d0], P0, 0, 0, 0); P1 = __builtin_amdgcn_mfma_f32_32x32x16_bf16(b1, qr[d0], P1, 0, 0, 0); } } while (0)
    f32x16 p0, p1, n0, n1;
    int t = __builtin_amdgcn_readfirstlane(live[0]);
    int tn = (NTL > 1) ? __builtin_amdgcn_readfirstlane(live[1]) : 0;
    bool skipC, maskC, selC, skipN = true, maskN = false, selN = true;
    ATT_ISSUE_K(t, 0); ATT_ISSUE_V(t, 0); if (NTL > 1) ATT_ISSUE_K(tn, 1);
    ATT_BAR();
    ATT_CLASS(t, skipC, maskC, selC);
    if (!skipC) ATT_QK(p0, p1, t, 0, selC);
    for (int it = 0; it < NTL; ++it) {
        ATT_BAR();
        const int tnn = (it + 2 < NTL) ? __builtin_amdgcn_readfirstlane(live[it + 2]) : 0;
        if (it + 2 < NTL) ATT_ISSUE_K(tnn, it & 1);
        if (it + 1 < NTL) { ATT_ISSUE_V(tn, (it + 1) & 1); ATT_CLASS(tn, skipN, maskN, selN); if (!skipN) ATT_QK(n0, n1, tn, (it + 1) & 1, selN); } else skipN = true;
        if (!skipC) {
            const int krel = ATT_KBASE(t) - q0;
            const LAS unsigned char* Vs = lds + (it & 1) * SLOT + KBY + ((lane >> 4) & 1) * 32 + (lane & 3) * 8 + (4 * hi + ((lane & 15) >> 2)) * 64;
            if (maskC) { const int qrel = qrel0 + r32;
#pragma unroll
                for (int r = 0; r < 16; ++r) { const int kv = krel + crow(r, hi); if (kv > qrel) p0[r] = -INFINITY; if (kv + 32 > qrel) p1[r] = -INFINITY; } }
            float rm;
            { float a_ = max3f(p0[0], p0[1], p1[0]), b_ = max3f(p0[2], p0[3], p1[1]); a_ = max3f(a_, p1[2], p1[3]);
#pragma unroll
              for (int r = 4; r < 16; r += 4) { a_ = max3f(a_, p0[r], p0[r + 1]); b_ = max3f(b_, p0[r + 2], p0[r + 3]); a_ = max3f(a_, p1[r], p1[r + 1]); b_ = max3f(b_, p1[r + 2], p1[r + 3]); }
              rm = halves_max(fmaxf(a_, b_)); }
            if (__any(rm > THR)) {
                const float dl = fmaxf(rm, 0.f); mref += dl; const float alpha = __builtin_amdgcn_exp2f(-dl);
#pragma unroll
                for (int r = 0; r < 16; ++r) { p0[r] -= dl; p1[r] -= dl; }
                if (!skipN) {
#pragma unroll
                    for (int r = 0; r < 16; ++r) { n0[r] -= dl; n1[r] -= dl; } }
                l *= alpha;
                if (hi == 0) wsf[r32] = alpha;
                asm volatile("s_waitcnt lgkmcnt(0)" ::: "memory");
#pragma unroll
                for (int gq = 0; gq < 4; ++gq) { const f32x4 f = *(const LAS f32x4*)(wsf + 8 * gq + 4 * hi);
#pragma unroll
                    for (int d0 = 0; d0 < DVB; ++d0) { o[d0][4 * gq + 0] *= f[0]; o[d0][4 * gq + 1] *= f[1]; o[d0][4 * gq + 2] *= f[2]; o[d0][4 * gq + 3] *= f[3]; } }
            }
            float sacc = 0.f;
#pragma unroll
            for (int r = 0; r < 16; ++r) { p0[r] = __builtin_amdgcn_exp2f(p0[r]); p1[r] = __builtin_amdgcn_exp2f(p1[r]); sacc += p0[r] + p1[r]; }
            l += sacc;
            u32x4 pw[4];
            pw[0] = (u32x4){cvtpk(p0[0], p0[1]), cvtpk(p0[2], p0[3]), cvtpk(p0[4], p0[5]), cvtpk(p0[6], p0[7])};
            pw[1] = (u32x4){cvtpk(p0[8], p0[9]), cvtpk(p0[10], p0[11]), cvtpk(p0[12], p0[13]), cvtpk(p0[14], p0[15])};
            pw[2] = (u32x4){cvtpk(p1[0], p1[1]), cvtpk(p1[2], p1[3]), cvtpk(p1[4], p1[5]), cvtpk(p1[6], p1[7])};
            pw[3] = (u32x4){cvtpk(p1[8], p1[9]), cvtpk(p1[10], p1[11]), cvtpk(p1[12], p1[13]), cvtpk(p1[14], p1[15])};
#pragma unroll
            for (int d0 = 0; d0 < DVB; ++d0)
#pragma unroll
                for (int ks = 0; ks < 4; ++ks) { const s16x4 vlo = vtr(Vs + d0 * 4096 + ks * 1024), vhi = vtr(Vs + d0 * 4096 + ks * 1024 + 512);
                    const bf16x8 vf = (bf16x8){vlo[0], vlo[1], vlo[2], vlo[3], vhi[0], vhi[1], vhi[2], vhi[3]};
                    o[d0] = __builtin_amdgcn_mfma_f32_32x32x16_bf16(__builtin_bit_cast(bf16x8, pw[ks]), vf, o[d0], 0, 0, 0); }
        }
        p0 = n0; p1 = n1; skipC = skipN; maskC = maskN; selC = selN; t = tn; tn = tnn;
    }
#undef ATT_ISSUE_K
#undef ATT_ISSUE_V
#undef ATT_CLASS
#undef ATT_QK
    l = halves_sum(l);
    if (hi == 0) wsf[32 + r32] = l;
    asm volatile("s_waitcnt lgkmcnt(0)" ::: "memory");
    float rli[16];
#pragma unroll
    for (int gq = 0; gq < 4; ++gq) { const f32x4 f = *(const LAS f32x4*)(wsf + 32 + 8 * gq + 4 * hi); rli[4 * gq + 0] = 1.0f / f[0]; rli[4 * gq + 1] = 1.0f / f[1]; rli[4 * gq + 2] = 1.0f / f[2]; rli[4 * gq + 3] = 1.0f / f[3]; }
    if constexpr (MODE == 1) {
        GAS bf16_t* Ow = (GAS bf16_t*)(A.O + (rowbase + q0 + qrel0) * PITCH + hcol);
#pragma unroll
        for (int r = 0; r < 16; ++r)
#pragma unroll
            for (int d0 = 0; d0 < DVB; ++d0) Ow[(size_t)crow(r, hi) * PITCH + d0 * 32 + r32] = (bf16_t)(cvtpk(o[d0][r] * rli[r], 0.f) & 0xFFFFu);
    } else {
        ATT_BAR();
        LAS float* X = (LAS float*)lds + wq * 4096;
        if (comp == 1) {
#pragma unroll
            for (int d0 = 0; d0 < DVB; ++d0)
#pragma unroll
                for (int r = 0; r < 16; ++r) X[(d0 * 16 + r) * 64 + lane] = o[d0][r] * rli[r];
        }
        ATT_BAR();
        if (comp == 0) {
            float sg[DVB];
#pragma unroll
            for (int d0 = 0; d0 < DVB; ++d0) sg[d0] = ((const GAS float*)A.subln)[d0 * 32 + r32] * A.out_scale;
            GAS bf16_t* Ow = (GAS bf16_t*)(A.O + (rowbase + q0 + qrel0) * PITCH + hcol);
#pragma unroll
            for (int r = 0; r < 16; ++r) { float dv[DVB]; float ss = 0.f;
#pragma unroll
                for (int d0 = 0; d0 < DVB; ++d0) { dv[d0] = o[d0][r] * rli[r] - A.lam_full * X[(d0 * 16 + r) * 64 + lane]; ss += dv[d0] * dv[d0]; }
                ss += __shfl_xor(ss, 1); ss += __shfl_xor(ss, 2); ss += __shfl_xor(ss, 4); ss += __shfl_xor(ss, 8); ss += __shfl_xor(ss, 16);
                const float rs = 1.0f / sqrtf(ss * (1.0f / 128.0f) + 1e-5f);
#pragma unroll
                for (int d0 = 0; d0 < DVB; ++d0) Ow[(size_t)crow(r, hi) * PITCH + d0 * 32 + r32] = (bf16_t)(cvtpk(dv[d0] * rs * sg[d0], 0.f) & 0xFFFFu); }
        }
    }
#undef ATT_KBASE
#undef ATT_KBASE_
#undef ATT_ISSUE
}
#undef ATT_BAR
}

constexpr int NWAVES = 8;
#ifndef MK_PER_PHASE
#define MK_PER_PHASE 1
#endif
#ifndef MK_DEBUG
#define MK_DEBUG 1
#endif
constexpr int NLAYER = 4, PH_PER_LAYER = 8, NPHASE = 1 + NLAYER * PH_PER_LAYER;

constexpr size_t MiB = 1u << 20;
constexpr size_t WS_CTL = 0, CTL_ZERO_BYTES = 1 * MiB;
constexpr size_t WS_KMEAN = 1 * MiB;
constexpr size_t WS_LTOK = 2 * MiB, WS_LW = 3 * MiB;
constexpr size_t WS_DQKV = 5 * MiB;
constexpr size_t WS_DWO = WS_DQKV + 12 * MiB;
constexpr size_t WS_MQKV = WS_DWO + 4 * MiB;
constexpr size_t WS_MWO = WS_MQKV + 12 * MiB;
constexpr size_t WS_FGU = WS_MWO + 4 * MiB;
constexpr size_t WS_FD = WS_FGU + 22 * MiB;
constexpr size_t WS_MGU = WS_FD + 11 * MiB;
constexpr size_t WS_MD = WS_MGU + 112 * MiB;
constexpr size_t WS_XN = WS_MD + 56 * MiB;
constexpr size_t WS_Q = WS_XN + 64 * MiB, WS_K = WS_Q + 64 * MiB, WS_V = WS_K + 64 * MiB;
constexpr size_t WS_ACT = WS_Q;
constexpr size_t WS_END = WS_ACT + (size_t)MOE_TILES_MAX * 256 * DE * 2;
static_assert(WS_XN == 238 * MiB && WS_END == 778 * MiB, "d_ws map");
constexpr int CW_BAR = 4096;
constexpr int CW_ATTQ = 6144;
constexpr int CW_CNT = 8192;

constexpr int RING_OFF = 0, RING_BYTES = 131072;
constexpr int LDSCTL_OFF = RING_BYTES, MISC_OFF = LDSCTL_OFF + 320;
constexpr int XSLOT_OFF = MISC_OFF + 128;
constexpr int LDS_BYTES = 147456;

typedef unsigned short bf16;
typedef unsigned v4u __attribute__((ext_vector_type(4)));
typedef float f32x4 __attribute__((ext_vector_type(4)));
typedef GAS unsigned gu32;
#define RLX_AGENT __ATOMIC_RELAXED, __HIP_MEMORY_SCOPE_AGENT
#define LDS_WAIT() asm volatile("s_waitcnt lgkmcnt(0)" ::: "memory")
#define VM_WAIT() asm volatile("s_waitcnt vmcnt(0)" ::: "memory")
__device__ __forceinline__ unsigned f2bf(float f) { unsigned u = __builtin_bit_cast(unsigned, f); return (u + 0x7fffu + ((u >> 16) & 1u)) >> 16; }
__device__ __forceinline__ unsigned pk2(float lo, float hi) { return f2bf(lo) | (f2bf(hi) << 16); }
__device__ __forceinline__ float bflo(unsigned w) { return __uint_as_float(w << 16); }
__device__ __forceinline__ float bfhi(unsigned w) { return __uint_as_float(w & 0xFFFF0000u); }
static_assert(XSLOT_OFF % 16 == 0 && XSLOT_OFF + 8192 <= LDS_BYTES, "LDS map");
#define XB_TMO      128
#define XB_XCNT(j)  (256  + 64 * (j))
#define XB_XSUB(j)  (1280 + 64 * (j))
#define XB_XGEN(j)  (2304 + 64 * (j))
#define XB_TOP      3328
#define XB_TOPGEN   3392
#define XCD_BAR_WORDS 3456
#define XB_SPIN_CAP (1u << 18)

__device__ __forceinline__ unsigned xb_ld(unsigned* p)              { return __hip_atomic_load(p, __ATOMIC_RELAXED, __HIP_MEMORY_SCOPE_AGENT); }
__device__ __forceinline__ unsigned xb_add(unsigned* p, unsigned v) { return __hip_atomic_fetch_add(p, v, __ATOMIC_RELAXED, __HIP_MEMORY_SCOPE_AGENT); }
__device__ __forceinline__ unsigned xb_xcc_id() { return (unsigned)__builtin_amdgcn_s_getreg((3 << 11) | 20) & 0xFu; }
#define XB_SPIN(cond, bar) do { unsigned _sp = 0; while (cond) { __builtin_amdgcn_s_sleep(1); \
    if ((++_sp & 255u) == 0u) { if (xb_ld(&(bar)[XB_TMO])) break; if (_sp > XB_SPIN_CAP) { atomicAdd(&(bar)[XB_TMO], 1u); break; } } } } while (0)

struct XcdBarrier {
    unsigned* bar; unsigned x;
    volatile LAS unsigned* st;
};

__device__ __forceinline__ XcdBarrier xcd_barrier_post(unsigned* bar, volatile LAS unsigned* st) {
    XcdBarrier b; b.bar = bar; b.x = xb_xcc_id(); b.st = st;
    if (threadIdx.x == 0) (void)xb_add(&bar[XB_XCNT(b.x)], 1u);
    return b;
}
__device__ __forceinline__ void xcd_barrier_complete(unsigned* bar, unsigned x, unsigned& nloc, unsigned& nx) {
    const unsigned G = gridDim.x * gridDim.y * gridDim.z;
    unsigned sum, cnt, mine, sp = 0u;
    for (;;) {
        sum = 0u; cnt = 0u; mine = 0u;
#pragma unroll
        for (unsigned j = 0; j < 16; ++j) { const unsigned c = xb_ld(&bar[XB_XCNT(j)]); sum += c; cnt += (c > 0u) ? 1u : 0u; mine = (j == x) ? c : mine; }
        if (sum == G) break;
        __builtin_amdgcn_s_sleep(1);
        if ((++sp & 255u) == 0u) { if (xb_ld(&bar[XB_TMO])) break; if (sp > XB_SPIN_CAP) { atomicAdd(&bar[XB_TMO], 1u); break; } }
    }
    nloc = mine > 0u ? mine : 1u; nx = cnt > 0u ? cnt : 1u;
}

__device__ __forceinline__ void xcd_barrier(const XcdBarrier& b) {
    asm volatile("s_waitcnt vmcnt(0)" ::: "memory");
    __syncthreads();
    if (threadIdx.x == 0) {
        unsigned* bar = b.bar;
        __builtin_amdgcn_s_waitcnt(0);
        unsigned nloc = b.st[0], nx = b.st[1];
        if (nloc == 0u) { xcd_barrier_complete(bar, b.x, nloc, nx); b.st[0] = nloc; b.st[1] = nx; }
        const unsigned old = xb_add(&bar[XB_XSUB(b.x)], 1u);
        const unsigned gen = old / nloc;
        if (old + 1u == (gen + 1u) * nloc) {
            __builtin_amdgcn_fence(__ATOMIC_RELEASE, "agent");
            asm volatile("s_waitcnt vmcnt(0)" ::: "memory");
            const unsigned og = xb_add(&bar[XB_TOP], 1u);
            const unsigned tg = og / nx;
            if (og + 1u == (tg + 1u) * nx) xb_add(&bar[XB_TOPGEN], 1u);
            else XB_SPIN(xb_ld(&bar[XB_TOPGEN]) == tg, bar);
            __builtin_amdgcn_fence(__ATOMIC_ACQUIRE, "agent");
            xb_add(&bar[XB_XGEN(b.x)], 1u);
            asm volatile("s_waitcnt vmcnt(0)" ::: "memory");
        } else {
            XB_SPIN(xb_ld(&bar[XB_XGEN(b.x)]) == gen, bar);
            __builtin_amdgcn_fence(__ATOMIC_ACQUIRE, "agent");
            asm volatile("s_waitcnt vmcnt(0)" ::: "memory");
        }
    }
    __syncthreads();
}

struct Frame {
    LAS unsigned char* lds;
    volatile LAS unsigned* MISC;
    gu32* ctl;
    int tid, lane, wave;
    int vcu, G;
};
__device__ __forceinline__ float wave_sum(float v) {
#pragma unroll
    for (int o = 1; o < 64; o <<= 1) v += __shfl_xor(v, o);
    return v;
}
__device__ __forceinline__ void transpose_item(const float* W, int K, int N, bf16* WT, int k0, int n0, int drow0, LAS float* scr, int lane) {
    const GAS float* src = (const GAS float*)W + (size_t)k0 * N + n0 + lane;
#pragma unroll
    for (int hb = 0; hb < 2; ++hb) { float v[32];
#pragma unroll
        for (int i = 0; i < 32; ++i) v[i] = src[(size_t)(hb * 32 + i) * N];
#pragma unroll
        for (int i = 0; i < 32; ++i) { const int kk = hb * 32 + i; scr[kk * 64 + (lane ^ ((kk >> 3) << 3))] = v[i]; } }
    LDS_WAIT(); asm volatile("" ::: "memory");
    const int c = lane & 7;
#pragma unroll
    for (int j = 0; j < 8; ++j) { const int n = (lane >> 3) + 8 * j; const LAS float* s = scr + (8 * c) * 64 + (n ^ (c << 3));
        v4u o; o.x = pk2(s[0 * 64], s[1 * 64]); o.y = pk2(s[2 * 64], s[3 * 64]); o.z = pk2(s[4 * 64], s[5 * 64]); o.w = pk2(s[6 * 64], s[7 * 64]);
        *(GAS v4u*)(WT + (size_t)(drow0 + n) * K + k0 + 8 * c) = o; }
    LDS_WAIT(); asm volatile("" ::: "memory");
}
__device__ __forceinline__ void convert_matrix(Frame& F, const float* W, int K, int N, bf16* WT, int il, unsigned& rot) {
    LAS float* scr = (LAS float*)(F.lds + RING_OFF + F.wave * 16384);
    const unsigned gw = (unsigned)(F.vcu * NWAVES + F.wave), NGW = (unsigned)(F.G * NWAVES);
    const int nblk = N / 64, nitems = (K / 64) * nblk; int lane_ = F.lane; asm volatile("" : "+v"(lane_));
    for (int it = (int)((gw + NGW - rot % NGW) % NGW); it < nitems; it += (int)NGW) {
        const int kb = it / nblk, nb = it % nblk, n0 = 64 * nb;
        const int drow0 = il == 0 ? n0 : (n0 / 128) * 256 + (il - 1) * 128 + (n0 % 128);
        transpose_item(W, K, N, WT, 64 * kb, n0, drow0, scr, lane_);
    }
    rot = (rot + (unsigned)nitems) % NGW;
}

struct RouterArgs { const float* router; gu32* cnt; unsigned* ltok; float* lw; };
template <int MODE>
__device__ __forceinline__ void norm_phase(Frame& F, const float* src, float* hout, const bf16* y1, const float* gain, bf16* xn, float* fout, const RouterArgs& R) {
    int lane_ = F.lane; asm volatile("" : "+v"(lane_));
    const int gw = F.vcu * NWAVES + F.wave, NGW = F.G * NWAVES, lane = lane_;
    f32x4 gv[4];
#pragma unroll
    for (int j = 0; j < 4; ++j) gv[j] = *(const GAS f32x4*)(gain + 256 * j + 4 * lane);
    LAS float* RL = (LAS float*)(F.lds + RING_OFF);
    if constexpr (MODE == 2) {
        int tid_ = F.tid; asm volatile("" : "+v"(tid_));
        for (int i = tid_; i < 8192; i += NWAVES * 64) RL[(i & 7) * 1024 + (i >> 3)] = ((const GAS float*)R.router)[i];
        LDS_WAIT(); __syncthreads();
    }
    const int nrows_w = gw < MTOK ? (MTOK - gw + NGW - 1) / NGW : 0;
    for (int cb = 0; cb < nrows_w; cb += 64) {
        int my_t = 0, my_e0 = 0, my_e1 = 0; float my_w0 = 0.f, my_w1 = 0.f; bool valid = false;
        const int cn = (nrows_w - cb) < 64 ? (nrows_w - cb) : 64;
        f32x4 vn[4]; unsigned long long yn[4];
        { const int row0_ = gw + cb * NGW; const GAS f32x4* xr = (const GAS f32x4*)(src + (size_t)row0_ * D) + lane;
#pragma unroll
          for (int j = 0; j < 4; ++j) vn[j] = xr[64 * j];
          if constexpr (MODE == 1 || MODE == 3) { const GAS unsigned long long* yr = (const GAS unsigned long long*)(y1 + (size_t)row0_ * D) + lane;
#pragma unroll
            for (int j = 0; j < 4; ++j) yn[j] = yr[64 * j]; } }
        for (int i = 0; i < cn; ++i) {
            const int row = gw + (cb + i) * NGW;
            f32x4 v[4]; float s = 0.f;
#pragma unroll
            for (int j = 0; j < 4; ++j) v[j] = vn[j];
            if constexpr (MODE == 1 || MODE == 3) {
#pragma unroll
                for (int j = 0; j < 4; ++j) { const unsigned long long w = yn[j]; const unsigned lo = (unsigned)w, hi = (unsigned)(w >> 32);
                    v[j].x += bflo(lo); v[j].y += bfhi(lo); v[j].z += bflo(hi); v[j].w += bfhi(hi); }
            }
            if (i + 1 < cn) { const int rown = row + NGW; const GAS f32x4* xr = (const GAS f32x4*)(src + (size_t)rown * D) + lane;
#pragma unroll
                for (int j = 0; j < 4; ++j) vn[j] = xr[64 * j];
                if constexpr (MODE == 1 || MODE == 3) { const GAS unsigned long long* yr = (const GAS unsigned long long*)(y1 + (size_t)rown * D) + lane;
#pragma unroll
                    for (int j = 0; j < 4; ++j) yn[j] = yr[64 * j]; } }
#pragma unroll
            for (int j = 0; j < 4; ++j) s += (v[j].x * v[j].x + v[j].y * v[j].y) + (v[j].z * v[j].z + v[j].w * v[j].w);
            if constexpr (MODE == 1) { GAS f32x4* hr = (GAS f32x4*)(hout + (size_t)row * D) + lane;
#pragma unroll
                for (int j = 0; j < 4; ++j) hr[64 * j] = v[j]; }
            const float rstd = 1.f / sqrtf(wave_sum(s) * (1.f / D) + 1e-6f);
#pragma unroll
            for (int j = 0; j < 4; ++j) v[j] = v[j] * rstd * gv[j];
            if constexpr (MODE == 3) { GAS f32x4* orow = (GAS f32x4*)(fout + (size_t)row * D) + lane;
#pragma unroll
                for (int j = 0; j < 4; ++j) orow[64 * j] = v[j];
            } else {
                GAS unsigned long long* o8 = (GAS unsigned long long*)(xn + (size_t)row * D) + lane;
#pragma unroll
                for (int j = 0; j < 4; ++j) o8[64 * j] = (unsigned long long)pk2(v[j].x, v[j].y) | ((unsigned long long)pk2(v[j].z, v[j].w) << 32);
            }
            if constexpr (MODE == 2) {
                float lg[NE];
#pragma unroll
                for (int e = 0; e < NE; ++e) { float a = 0.f;
#pragma unroll
                    for (int j = 0; j < 4; ++j) { const f32x4 rr = *(const LAS f32x4*)(RL + e * 1024 + 256 * j + 4 * lane); a += (v[j].x * rr.x + v[j].y * rr.y) + (v[j].z * rr.z + v[j].w * rr.w); }
                    lg[e] = wave_sum(a); }
                int e0 = 0; float v0 = lg[0];
#pragma unroll
                for (int e = 1; e < NE; ++e) if (lg[e] > v0) { v0 = lg[e]; e0 = e; }
                int e1 = -1; float v1 = 0.f;
#pragma unroll
                for (int e = 0; e < NE; ++e) if (e != e0 && (e1 < 0 || lg[e] > v1)) { v1 = lg[e]; e1 = e; }
                const float w0 = 1.f / (1.f + __expf(v1 - v0));
                if (lane == i) { my_t = row; my_e0 = e0; my_e1 = e1; my_w0 = w0; my_w1 = 1.f - w0; valid = true; }
            }
        }
        if constexpr (MODE == 2) {
            unsigned myc = 0u;
#pragma unroll
            for (int e = 0; e < NE; ++e) { const unsigned long long b0 = __ballot(valid && my_e0 == e), b1 = __ballot(valid && my_e1 == e);
                const unsigned c = (unsigned)(__popcll(b0) + __popcll(b1)); if (lane == e) myc = c; }
            unsigned basev = 0u;
            if (lane < NE) basev = __hip_atomic_fetch_add(R.cnt + 64 * lane, myc, RLX_AGENT);
            const unsigned long long lt = (1ull << lane) - 1ull;
            unsigned pos0 = 0u, pos1 = 0u;
#pragma unroll
            for (int e = 0; e < NE; ++e) { const unsigned long long b0 = __ballot(valid && my_e0 == e), b1 = __ballot(valid && my_e1 == e);
                const unsigned be = (unsigned)__shfl((int)basev, e);
                if (my_e0 == e) pos0 = be + (unsigned)__popcll(b0 & lt);
                if (my_e1 == e) pos1 = be + (unsigned)__popcll(b0) + (unsigned)__popcll(b1 & lt); }
            if (valid) {
                ((GAS unsigned*)R.ltok)[(size_t)my_e0 * LIST_CAP + pos0] = (unsigned)my_t;             ((GAS float*)R.lw)[(size_t)my_e0 * LIST_CAP + pos0] = my_w0;
                ((GAS unsigned*)R.ltok)[(size_t)my_e1 * LIST_CAP + pos1] = (unsigned)my_t | (1u << 20); ((GAS float*)R.lw)[(size_t)my_e1 * LIST_CAP + pos1] = my_w1;
            }
        }
    }
    if constexpr (MODE == 2) { LDS_WAIT(); __syncthreads(); }
}

__device__ __forceinline__ void kstat_phase(Frame& F, const bf16* Kt, float* kmean, float* kmax2) {
    int lane_ = F.lane; asm volatile("" : "+v"(lane_));
    const int gw = F.vcu * NWAVES + F.wave, NGW = F.G * NWAVES, lane = lane_;
    for (int task = gw; task < BATCH * 16 * 8; task += NGW) {
        const int c8 = task & 7, n = (task >> 3) & 15, b = task >> 7;
        const GAS unsigned* p = (const GAS unsigned*)(Kt + ((size_t)b * SEQ + 256 * n) * D + c8 * 128) + lane;
        float a0 = 0.f, a1 = 0.f, mx = 0.f;
#pragma unroll 32
        for (int r = 0; r < 256; ++r) { const unsigned w = p[(size_t)r * (D / 2)]; const float v0 = bflo(w), v1 = bfhi(w); a0 += v0; a1 += v1;
            float s = v0 * v0 + v1 * v1; s += __shfl_xor(s, 1); s += __shfl_xor(s, 2); s += __shfl_xor(s, 4); s += __shfl_xor(s, 8); s += __shfl_xor(s, 16); mx = fmaxf(mx, s); }
        const int col = c8 * 128 + 2 * lane, hh = col >> 6, d = col & 63;
        GAS float* o = (GAS float*)(kmean + ((size_t)(b * 16 + hh) * 16 + n) * 64 + d);
        o[0] = a0 * (1.f / 256.f); o[1] = a1 * (1.f / 256.f);
        if ((lane & 31) == 0) ((GAS float*)kmax2)[(size_t)(b * 16 + hh) * 16 + n] = mx;
    }
}

struct KArgs { const float* in[17]; float* out; unsigned char* ws; int ph_lo, ph_hi; };
__global__ void __launch_bounds__(NWAVES * 64, 2) trunk_fwd(KArgs args) {
    extern __shared__ __attribute__((aligned(16))) unsigned char lds[];
    Frame F;
    F.lds = (LAS unsigned char*)lds;
    F.MISC = (volatile LAS unsigned*)(F.lds + MISC_OFF);
    F.tid = threadIdx.x; F.lane = F.tid & 63; F.wave = __builtin_amdgcn_readfirstlane(F.tid >> 6);
    F.G = gridDim.x; { const int bx = blockIdx.x; F.vcu = (F.G % 8 == 0) ? (bx % 8) * (F.G / 8) + bx / 8 : bx; }
    F.ctl = (gu32*)(args.ws + WS_CTL);
    for (int u = F.tid; u < (LDS_BYTES - LDSCTL_OFF) / 4; u += NWAVES * 64) ((LAS unsigned*)(F.lds + LDSCTL_OFF))[u] = 0u;
    __syncthreads();
    Frame& F0 = F;
    const int lo = args.ph_lo, hi = args.ph_hi;
    XcdBarrier bar; bar.bar = (unsigned*)(F.ctl + CW_BAR); bar.x = 0; bar.st = nullptr;
    if (hi - lo > 1) bar = xcd_barrier_post((unsigned*)(F.ctl + CW_BAR), F.MISC + 8);
#define IN(k) (lo <= (k) && (k) < hi)
#ifndef PH_ENABLE
#define PH_ENABLE 0xFFFFFFFFu
#endif
#define PHEN(n) (((PH_ENABLE) >> (n)) & 1u)
#ifndef MK_DOUBLE
#define MK_DOUBLE 0u
#endif
#define NREP(n) ((((MK_DOUBLE) >> (n)) & 1u) ? 2 : 1)
#if defined(NO_OPQ)
#define OPQ(p) do {} while (0)
#else
#define OPQ(p) asm volatile("" : "+s"(p))
#endif
#if 0
#define STAMP(k) do { if (blockIdx.x == 0 && threadIdx.x == 0) { const unsigned long long t_ = __builtin_amdgcn_s_memrealtime(); ((GAS unsigned*)(F0.ctl))[3000 + (k)] = (unsigned)t_; } } while (0)
#else
#define STAMP(k) do {} while (0)
#endif
#define SEAM(k) do { if (IN(k) && IN((k) + 1)) { XcdBarrier b2_ = bar; OPQ(b2_.bar); xcd_barrier(b2_); } STAMP((k) + 1); } while (0)

#define PTRS() unsigned char* ws = args.ws; OPQ(ws); const float* x = args.in[0]; OPQ(x); const float* norm_mix = args.in[1]; OPQ(norm_mix); const float* norm_ffn = args.in[2]; OPQ(norm_ffn); \
    float* h = args.out; OPQ(h); \
    bf16* XN = (bf16*)(ws + WS_XN); bf16* Qb = (bf16*)(ws + WS_Q); bf16* Kb = (bf16*)(ws + WS_K); bf16* Vb = (bf16*)(ws + WS_V); bf16* ACT = (bf16*)(ws + WS_ACT); \
    bf16* MGU = (bf16*)(ws + WS_MGU); bf16* MD = (bf16*)(ws + WS_MD); \
    float* kmean = (float*)(ws + WS_KMEAN); unsigned* ltok = (unsigned*)(ws + WS_LTOK); float* lw = (float*)(ws + WS_LW); \
    (void)x; (void)norm_mix; (void)norm_ffn; (void)h; (void)XN; (void)Qb; (void)Kb; (void)Vb; (void)ACT; (void)MGU; (void)MD; (void)kmean; (void)ltok; (void)lw
    const RouterArgs noR{nullptr, nullptr, nullptr, nullptr};
    constexpr float C2 = 0.125f * 1.4426950408889634f;

    STAMP(0);
    if (PHEN(0) && IN(0)) {
        PTRS();
        for (int rep_ = 0; rep_ < NREP(0); ++rep_) {
        unsigned rot = 0u;
        for (int j = 0; j < 2; ++j) {
            convert_matrix(F, args.in[3] + (size_t)j * D * 3 * D, D, 3 * D, (bf16*)(ws + WS_DQKV) + (size_t)j * 3 * D * D, 0, rot);
            convert_matrix(F, args.in[4] + (size_t)j * D * D, D, D, (bf16*)(ws + WS_DWO) + (size_t)j * D * D, 0, rot);
            convert_matrix(F, args.in[7] + (size_t)j * D * 3 * D, D, 3 * D, (bf16*)(ws + WS_MQKV) + (size_t)j * 3 * D * D, 0, rot);
            convert_matrix(F, args.in[8] + (size_t)j * D * D, D, D, (bf16*)(ws + WS_MWO) + (size_t)j * D * D, 0, rot);
            convert_matrix(F, args.in[9] + (size_t)j * D * DFF, D, DFF, (bf16*)(ws + WS_FGU) + (size_t)j * 2 * DFF * D, 1, rot);
            convert_matrix(F, args.in[10] + (size_t)j * D * DFF, D, DFF, (bf16*)(ws + WS_FGU) + (size_t)j * 2 * DFF * D, 2, rot);
            convert_matrix(F, args.in[11] + (size_t)j * DFF * D, DFF, D, (bf16*)(ws + WS_FD) + (size_t)j * D * DFF, 0, rot);
        }
        for (int e = 0; e < NE; ++e) {
            convert_matrix(F, args.in[13] + (size_t)e * D * DE, D, DE, MGU + (size_t)e * 2 * DE * D, 1, rot);
            convert_matrix(F, args.in[14] + (size_t)e * D * DE, D, DE, MGU + (size_t)e * 2 * DE * D, 2, rot);
            convert_matrix(F, args.in[15] + (size_t)e * DE * D, DE, D, MD + (size_t)e * D * DE, 0, rot);
        }
        norm_phase<0>(F, x, nullptr, nullptr, norm_mix, XN, nullptr, noR);
        }
    }
    SEAM(0);

    for (int L = 0; L < NLAYER; ++L) {
        const int j = L >> 1, moba = L & 1, pb = 1 + PH_PER_LAYER * L;
        int z_ = 0;
#if !defined(NO_OPQ_Z)
        asm volatile("" : "+s"(z_));
#endif
        Frame Fl = F0; Fl.G += z_; Fl.vcu += z_; Fl.wave += z_; Fl.lds += z_; Fl.ctl += z_; const int bx = (int)blockIdx.x + z_;
#define F Fl
        if (PHEN(1) && IN(pb + 0)) {
            PTRS();

            const bf16* W = (const bf16*)(ws + (moba ? WS_MQKV : WS_DQKV)) + (size_t)j * 3 * D * D;
            pg8::Gemm g{XN, W, D, 0, (unsigned)((size_t)MTOK * D * 2 - 16), (unsigned*)F.ctl + 2048, (size_t)3 * D * D * 2}; pg8::StaticOrder S; S.init(MTOK, 3 * D, F.G, bx);
            pg8::EpiQKV E{Qb, D, D, (size_t)(WS_K - WS_Q) / 2, C2, (unsigned*)F.ctl + 2048};
            for (int rep_ = 0; rep_ < NREP(1); ++rep_) pg8::gemm_phase<pg8::EpiQKV, pg8::StaticOrder>(F.lds + RING_OFF, XSLOT_OFF, g, S, E);
        }
        SEAM(pb + 0);
        { if (PHEN(2) && IN(pb + 1)) { PTRS(); kstat_phase(F, Kb, kmean, kmean + 8 * 16 * 16 * 64); } SEAM(pb + 1); }
        if (IN(pb + 2)) {
            PTRS();
            att::Args A; A.Q = Qb; A.K = Kb; A.V = Vb; A.O = XN; A.kmean = kmean; A.kmax2 = kmean + 8 * 16 * 16 * 64; A.subln = args.in[6] + (size_t)j * 128; A.lam_full = 0.f; A.out_scale = 1.f;
            gu32* qctr = F.ctl + CW_ATTQ + 64 * L; LAS int* qw = (LAS int*)(F.lds + RING_OFF + 71680 + 260);
            if (!moba) {
                const float* lam = args.in[5] + (size_t)j * 256; int lane = F.lane; asm volatile("" : "+v"(lane));
                const GAS float* lamg = (const GAS float*)lam; const float s1 = wave_sum(lamg[lane] * lamg[64 + lane]), s2 = wave_sum(lamg[128 + lane] * lamg[192 + lane]);
                const float lam_init = (L == 0) ? 0.2f : 0.47071302f;
                A.lam_full = __uint_as_float(__builtin_amdgcn_readfirstlane(__float_as_uint(__expf(s1) - __expf(s2) + lam_init))); A.out_scale = __uint_as_float(__builtin_amdgcn_readfirstlane(__float_as_uint(1.0f - lam_init)));
            }
            if ((PHEN(3) && !moba) || (PHEN(4) && moba)) for (;;) {
                if (F.tid == 0) *qw = (int)__hip_atomic_fetch_add(qctr, 1u, RLX_AGENT);
                asm volatile("s_waitcnt vmcnt(0) lgkmcnt(0)\n\ts_barrier" ::: "memory");
                const int idx = __builtin_amdgcn_readfirstlane(*qw);
                if (idx >= 1024) break;
                if (!moba) { const int hh = 7 - (idx >> 7), bb = (idx >> 4) & 7, pr = idx & 15;
                    att::attn_unit<0>(F.lds + RING_OFF, A, bb, hh, pr);
                    att::attn_unit<0>(F.lds + RING_OFF, A, bb, hh, 31 - pr);
                } else { const int hh = 15 - (idx >> 6), bb = (idx >> 3) & 7, pr = idx & 7;
                    att::attn_unit<1>(F.lds + RING_OFF, A, bb, hh, pr);
                    att::attn_unit<1>(F.lds + RING_OFF, A, bb, hh, 15 - pr); }
            }
            asm volatile("s_waitcnt vmcnt(0) lgkmcnt(0)\n\ts_barrier" ::: "memory");
        }
        SEAM(pb + 2);
        if (PHEN(5) && IN(pb + 3)) {
            PTRS();
            const bf16* W = (const bf16*)(ws + (moba ? WS_MWO : WS_DWO)) + (size_t)j * D * D;
            pg8::Gemm g{XN, W, D, 0, (unsigned)((size_t)MTOK * D * 2 - 16), (unsigned*)F.ctl + 2048, (size_t)D * D * 2}; pg8::StaticOrder S; S.init(MTOK, D, F.G, bx);
            pg8::EpiRes E{L == 0 ? x : h, h, D};
            pg8::gemm_phase<pg8::EpiRes, pg8::StaticOrder>(F.lds + RING_OFF, XSLOT_OFF, g, S, E);
        }
        SEAM(pb + 3);
        if (PHEN(6) && IN(pb + 4)) {
            PTRS();
            if (!moba) {
                norm_phase<0>(F, h, nullptr, nullptr, norm_ffn + (size_t)L * D, XN, nullptr, noR);
                if (L == 2) { unsigned rot = 0u;
                    for (int e = 0; e < NE; ++e) {
                        convert_matrix(F, args.in[13] + (size_t)(NE + e) * D * DE, D, DE, MGU + (size_t)e * 2 * DE * D, 1, rot);
                        convert_matrix(F, args.in[14] + (size_t)(NE + e) * D * DE, D, DE, MGU + (size_t)e * 2 * DE * D, 2, rot);
                        convert_matrix(F, args.in[15] + (size_t)(NE + e) * DE * D, DE, D, MD + (size_t)e * D * DE, 0, rot);
                    } }
            } else {
                const RouterArgs R{args.in[12] + (size_t)j * D * NE, F.ctl + CW_CNT + 64 * NE * j, ltok, lw};
                norm_phase<2>(F, h, nullptr, nullptr, norm_ffn + (size_t)L * D, XN, nullptr, R);
            }
        }
        SEAM(pb + 4);
        if (IN(pb + 5)) {
            PTRS();
            if (PHEN(7) && !moba) {
                pg8::Gemm g{XN, (const bf16*)(ws + WS_FGU) + (size_t)j * 2 * DFF * D, D, 0, (unsigned)((size_t)MTOK * D * 2 - 16), (unsigned*)F.ctl + 2048, (size_t)2 * DFF * D * 2}; pg8::StaticOrder S; S.init(MTOK, 2 * DFF, F.G, bx);
                pg8::EpiSwiGLU E{ACT, DFF};
                for (int rep_ = 0; rep_ < NREP(7); ++rep_) pg8::gemm_phase<pg8::EpiSwiGLU, pg8::StaticOrder>(F.lds + RING_OFF, XSLOT_OFF, g, S, E);
            } else if (PHEN(8) && moba) {
                pg8::Gemm g{XN, MGU, D, (size_t)2 * DE * D, (unsigned)((size_t)MTOK * D * 2 - 16), (unsigned*)F.ctl + 2048, (size_t)NE * 2 * DE * D * 2}; pg8::MoeOrder S; S.init((const unsigned*)(F.ctl + CW_CNT + 64 * NE * j), ltok, true, 2 * DE, F.G, bx);
                pg8::EpiSwiGLU E{ACT, DE};
                for (int rep_ = 0; rep_ < NREP(8); ++rep_) pg8::gemm_phase<pg8::EpiSwiGLU, pg8::MoeOrder>(F.lds + RING_OFF, XSLOT_OFF, g, S, E);
            }
        }
        SEAM(pb + 5);
        if (IN(pb + 6)) {
            PTRS();
            if (PHEN(9) && !moba) {
                pg8::Gemm g{ACT, (const bf16*)(ws + WS_FD) + (size_t)j * D * DFF, DFF, 0, (unsigned)((size_t)MTOK * DFF * 2 - 16), (unsigned*)F.ctl + 2048, (size_t)D * DFF * 2}; pg8::StaticOrder S; S.init(MTOK, D, F.G, bx);
                pg8::EpiRes E{h, h, D};
                pg8::gemm_phase<pg8::EpiRes, pg8::StaticOrder>(F.lds + RING_OFF, XSLOT_OFF, g, S, E);
            } else if (PHEN(10) && moba) {
                pg8::Gemm g{ACT, MD, DE, (size_t)D * DE, (unsigned)((size_t)MOE_TILES_MAX * 256 * DE * 2 - 16), (unsigned*)F.ctl + 2048, (size_t)NE * D * DE * 2}; pg8::MoeOrder S; S.init((const unsigned*)(F.ctl + CW_CNT + 64 * NE * j), ltok, false, D, F.G, bx);
                pg8::EpiMoeDown E; E.h = h; E.y1 = XN; E.list_tok = ltok; E.list_w = lw;
#pragma unroll
                for (int e = 0; e < NE; ++e) E.cnt[e] = S.cnt[e];
                pg8::gemm_phase<pg8::EpiMoeDown, pg8::MoeOrder>(F.lds + RING_OFF, XSLOT_OFF, g, S, E);
            }
        }
        SEAM(pb + 6);
        if (PHEN(11) && IN(pb + 7)) {
            PTRS();
            if (L == 3) norm_phase<3>(F, h, nullptr, XN, args.in[16], nullptr, h, noR);
            else if (moba) norm_phase<1>(F, h, h, XN, norm_mix + (size_t)(L + 1) * D, XN, nullptr, noR);
            else for (int rep_ = 0; rep_ < NREP(11); ++rep_) norm_phase<0>(F, h, nullptr, nullptr, norm_mix + (size_t)(L + 1) * D, XN, nullptr, noR);
        }
        if (L != NLAYER - 1) SEAM(pb + 7); else STAMP(pb + 8);
#undef F
    }
#undef IN
#undef SEAM
#undef PTRS
#undef OPQ
}


#if MK_DEBUG
__global__ void dbg_probe(const void* buf, size_t n, int is_bf16, int idx, float thresh, unsigned* dbg) {
    size_t i = blockIdx.x * (size_t)blockDim.x + threadIdx.x, stride = (size_t)gridDim.x * blockDim.x; bool bad = false;
    for (size_t k = i; k < n; k += stride) { float v = is_bf16 ? __uint_as_float(((unsigned)((const unsigned short*)buf)[k]) << 16) : ((const float*)buf)[k]; if (!(fabsf(v) <= thresh)) bad = true; }
    if (bad) atomicMax(dbg, (unsigned)(1000 - idx));
}
__global__ void dbg_cnt(const unsigned* cntw, int idx, unsigned* dbg) {
    if (threadIdx.x == 0 && blockIdx.x == 0) { unsigned s = 0; for (int e = 0; e < NE; ++e) s += cntw[64 * e]; if (s != 2u * MTOK) atomicMax(dbg, (unsigned)(1000 - idx)); }
}

__device__ __forceinline__ float dbg_bf(unsigned short v) { return __uint_as_float(((unsigned)v) << 16); }
__device__ __forceinline__ unsigned dbg_hash(unsigned x) { x ^= x >> 16; x *= 0x7feb352dU; x ^= x >> 15; x *= 0x846ca68bU; x ^= x >> 16; return x; }
__global__ void dbg_gemm_check(const unsigned short* A, int lda, const unsigned short* Bt, int K, const unsigned short* out, int ldo, int M, int N, float scale, int idx, unsigned* dbg) {
    const unsigned s = blockIdx.x * blockDim.x + threadIdx.x; const int row = (int)(dbg_hash(2 * s + 1) % (unsigned)M), col = (int)(dbg_hash(2 * s + 2) % (unsigned)N);
    float acc = 0.f; for (int k = 0; k < K; ++k) acc += dbg_bf(A[(size_t)row * lda + k]) * dbg_bf(Bt[(size_t)col * K + k]);
    acc *= scale; const float got = dbg_bf(out[(size_t)row * ldo + col]);
    if (!(fabsf(got - acc) <= 0.03f + 0.02f * fabsf(acc))) { atomicMax(dbg, (unsigned)(1000 - idx)); atomicAdd(dbg + 64 + idx, 1u); }
}
__global__ void dbg_conv_check(const float* W, int K, int N, const unsigned short* WT, int il, int idx, unsigned* dbg) {
    const unsigned s = blockIdx.x * blockDim.x + threadIdx.x; const int k = (int)(dbg_hash(2 * s + 1) % (unsigned)K), n = (int)(dbg_hash(2 * s + 2) % (unsigned)N);
    const int dr = il == 0 ? n : (n / 128) * 256 + (il - 1) * 128 + (n % 128);
    const float w = W[(size_t)k * N + n], g = dbg_bf(WT[(size_t)dr * K + k]);
    if (!(fabsf(g - w) <= 0.01f * fabsf(w) + 1e-6f)) atomicMax(dbg, (unsigned)(1000 - idx));
}
__global__ void dbg_norm_check(const float* src, const float* gain, const unsigned short* xn, int idx, unsigned* dbg) {
    const unsigned s = blockIdx.x * blockDim.x + threadIdx.x; const int row = (int)(dbg_hash(s + 77) % (unsigned)MTOK);
    float ss = 0.f; for (int c = 0; c < D; ++c) { const float v = src[(size_t)row * D + c]; ss += v * v; }
    const float rstd = 1.f / sqrtf(ss / D + 1e-6f); bool bad = false;
    for (int c = 0; c < D; ++c) { const float r = src[(size_t)row * D + c] * rstd * gain[c], g = dbg_bf(xn[(size_t)row * D + c]); if (!(fabsf(g - r) <= 0.02f + 0.01f * fabsf(r))) bad = true; }
    if (bad) atomicMax(dbg, (unsigned)(1000 - idx));
}
__global__ void dbg_naive_gemm(const unsigned short* A, const unsigned short* Bt, unsigned short* out, int M, int N, int K) {
    const size_t i = blockIdx.x * (size_t)blockDim.x + threadIdx.x; if (i >= (size_t)M * N) return; const int row = (int)(i / N), col = (int)(i % N);
    float acc = 0.f; for (int k = 0; k < K; ++k) acc += dbg_bf(A[(size_t)row * K + k]) * dbg_bf(Bt[(size_t)col * K + k]);
    out[(size_t)row * N + col] = (unsigned short)f2bf(acc);
}
__global__ void dbg_find_col(const unsigned short* out, const unsigned short* ref, int M, int N, unsigned* hist) {
    const unsigned s = blockIdx.x * blockDim.x + threadIdx.x; const int row = (int)(dbg_hash(2 * s + 1) % (unsigned)M), col = (int)(dbg_hash(2 * s + 2) % (unsigned)N);
    const unsigned short v = out[(size_t)row * N + col]; int found = -1;
#if MK_FIND_PATTERN
    if (v == 0x3C3C) atomicAdd(hist + N, 1u); else atomicAdd(hist + 5, 1u); return;
#endif
#if MK_FIND_ROWS
    for (int r = 0; r < M; ++r) if (ref[(size_t)r * N + col] == v) { found = r; break; }
    if (found < 0) atomicAdd(hist + N, 1u); else atomicAdd(hist + ((found - row) & (N - 1)), 1u);
#else
    for (int c = 0; c < N; ++c) if (ref[(size_t)row * N + c] == v) { found = c; break; }
    if (found < 0) atomicAdd(hist + N, 1u); else atomicAdd(hist + ((found - col) & (N - 1)), 1u);
#endif
}
__global__ void dbg_hist_code(const unsigned* hist, int N, unsigned* dbg) {
    if (threadIdx.x || blockIdx.x) return; unsigned best = 0, bi = 0; for (int i = 0; i < N; ++i) if (hist[i] > best) { best = hist[i]; bi = i; }
    dbg[32] = bi; dbg[33] = best; dbg[34] = hist[N];
}
__global__ void dbg_final(float* out, size_t n, const unsigned* dbg) {
    if (MK_HIST_SEL >= 10) { const float c3 = sqrtf((float)dbg[MK_HIST_SEL + 30]); size_t i3 = blockIdx.x * (size_t)blockDim.x + threadIdx.x, st3 = (size_t)gridDim.x * blockDim.x; for (size_t k3 = i3; k3 < n; k3 += st3) out[k3] = c3; return; }
    if (MK_HIST_SEL >= 0 && (dbg[33] || dbg[34])) { const float c2 = sqrtf((float)(MK_HIST_SEL == 0 ? dbg[32] : (MK_HIST_SEL == 1 ? dbg[33] * 100u / 4096u : dbg[34] * 100u / 4096u)) + 1.f); size_t i2 = blockIdx.x * (size_t)blockDim.x + threadIdx.x, st2 = (size_t)gridDim.x * blockDim.x; for (size_t k2 = i2; k2 < n; k2 += st2) out[k2] = c2; return; }
    const unsigned d = dbg[0]; if (d == 0u) return; const unsigned nf = dbg[64 + (1000u - d)]; const float c = sqrtf(nf ? (float)(200u * (1000u - d - 9u) + nf * 100u / 4096u) : (float)(1000u - d));
    size_t i = blockIdx.x * (size_t)blockDim.x + threadIdx.x, stride = (size_t)gridDim.x * blockDim.x;
    for (size_t k = i; k < n; k += stride) out[k] = c;
}
#endif

#ifndef MK_REPEAT
#define MK_REPEAT 1
#endif
#ifndef MK_FIND_ROWS
#define MK_FIND_ROWS 0
#endif
#ifndef MK_FIND_REGION
#define MK_FIND_REGION WS_K
#endif
#ifndef MK_HIST_SEL
#define MK_HIST_SEL 0
#endif
#ifndef MK_STAMP
#define MK_STAMP 0
#endif
#if MK_STAMP
__global__ void stamp_k(unsigned* p) { if (threadIdx.x == 0) *p = (unsigned)__builtin_amdgcn_s_memrealtime(); }
__global__ void stamp_encode(float* out, size_t n, const unsigned* st, int pa, float ua, int pb, float ub) {
    const float da = (float)(st[pa + 1] - st[pa]) * 0.01f, db = (float)(st[pb + 1] - st[pb]) * 0.01f;
    float m = da / ua; m = m < 10.f ? 10.f : (m > 99.f ? 99.f : m); float e = floorf(db / ub + 0.5f); e = e < 0.f ? 0.f : (e > 30.f ? 30.f : e);
    const float c = sqrtf(m) * __powf(10.f, 0.5f * e);
    size_t i = blockIdx.x * (size_t)blockDim.x + threadIdx.x, stride = (size_t)gridDim.x * blockDim.x;
    for (size_t k = i; k < n; k += stride) out[k] = c;
}
#endif
extern "C" void kernel_launch(void* const* d_in, const int* in_sizes, int n_in, void* d_out, int out_size, void* d_ws, size_t ws_size, hipStream_t stream) {
    static int grid = 0;
    if (grid == 0) {
        if (n_in != 17 || in_sizes[0] != MTOK * D || out_size != MTOK * D || ws_size < WS_END) {
            fprintf(stderr, "kernel_launch: built for 17 inputs, x/out of %d floats, >= %zu bytes of workspace; got n_in %d, in0 %d, out %d, ws %zu; nothing launched\n", MTOK * D, (size_t)WS_END, n_in, n_in > 0 ? in_sizes[0] : -1, out_size, ws_size);
            grid = -1; return; }
        int dev = 0, cus = 0, per_cu = 0;
        if (hipGetDevice(&dev) != hipSuccess || hipDeviceGetAttribute(&cus, hipDeviceAttributeMultiprocessorCount, dev) != hipSuccess) { fprintf(stderr, "kernel_launch: device query failed\n"); grid = -1; return; }
        if (hipFuncSetAttribute((const void*)trunk_fwd, hipFuncAttributeMaxDynamicSharedMemorySize, LDS_BYTES) != hipSuccess) { fprintf(stderr, "kernel_launch: hipFuncSetAttribute failed\n"); grid = -1; return; }
        if (hipOccupancyMaxActiveBlocksPerMultiprocessor(&per_cu, (const void*)trunk_fwd, NWAVES * 64, LDS_BYTES) != hipSuccess || per_cu < 1)
            fprintf(stderr, "kernel_launch: note: occupancy query reports %d workgroups per CU\n", per_cu);
        (void)hipGetLastError();
        grid = cus;
    }
    if (grid < 0) return;
    if (hipMemsetAsync((char*)d_ws + WS_CTL, 0, CTL_ZERO_BYTES, stream) != hipSuccess) { fprintf(stderr, "kernel_launch: memset failed\n"); return; }
    KArgs a{};
    for (int i = 0; i < 17; ++i) a.in[i] = (const float*)d_in[i];
    a.out = (float*)d_out; a.ws = (unsigned char*)d_ws;
#if MK_PER_PHASE
#if MK_STAMP
    hipLaunchKernelGGL(stamp_k, dim3(1), dim3(64), 0, stream, (unsigned*)d_ws + 3000);
#endif
    for (int p = 0; p < NPHASE; ++p) {
        a.ph_lo = p; a.ph_hi = p + 1;
#if MK_DEBUG
#endif
#if !defined(MK_SKIP_MAIN)
        for (int rep_ = 0; rep_ < (p == 1 ? MK_REPEAT : 1); ++rep_) hipLaunchKernelGGL(trunk_fwd, dim3(grid), dim3(NWAVES * 64), LDS_BYTES, stream, a);
#endif
#if MK_STAMP
        hipLaunchKernelGGL(stamp_k, dim3(1), dim3(64), 0, stream, (unsigned*)d_ws + 3000 + p + 1);
#endif
#if MK_DEBUG
        {   unsigned char* ws = (unsigned char*)d_ws; unsigned* dbg = (unsigned*)(ws + WS_CTL) + 2048;
            const size_t MD_ = (size_t)MTOK * D;
#define PROBE(buf, n, isbf, idx, th) if ((idx) <= MK_PROBE_MAX) hipLaunchKernelGGL(dbg_probe, dim3(2048), dim3(256), 0, stream, (const void*)(buf), (size_t)(n), isbf, idx, th, dbg)
            if (p == 0) {
                hipLaunchKernelGGL(dbg_norm_check, dim3(4), dim3(64), 0, stream, (const float*)d_in[0], (const float*)d_in[1], (const unsigned short*)(ws + WS_XN), 4, dbg);
                hipLaunchKernelGGL(dbg_conv_check, dim3(16), dim3(256), 0, stream, (const float*)d_in[3], D, 3 * D, (const unsigned short*)(ws + WS_DQKV), 0, 5, dbg);
                hipLaunchKernelGGL(dbg_conv_check, dim3(16), dim3(256), 0, stream, (const float*)d_in[9], D, DFF, (const unsigned short*)(ws + WS_FGU), 1, 6, dbg);
                hipLaunchKernelGGL(dbg_conv_check, dim3(16), dim3(256), 0, stream, (const float*)d_in[10], D, DFF, (const unsigned short*)(ws + WS_FGU), 2, 7, dbg);
                hipLaunchKernelGGL(dbg_conv_check, dim3(16), dim3(256), 0, stream, (const float*)d_in[11], DFF, D, (const unsigned short*)(ws + WS_FD), 0, 8, dbg);
                hipLaunchKernelGGL(dbg_conv_check, dim3(16), dim3(256), 0, stream, (const float*)d_in[15] + (size_t)3 * DE * D, DE, D, (const unsigned short*)(ws + WS_MD) + (size_t)3 * D * DE, 0, 9, dbg);
            }
            if (p == 1) {
                const float C2h = 0.125f * 1.4426950408889634f;
                hipLaunchKernelGGL(dbg_gemm_check, dim3(16), dim3(256), 0, stream, (const unsigned short*)(ws + WS_XN), D, (const unsigned short*)(ws + WS_DQKV), D, (const unsigned short*)(ws + WS_Q), D, MTOK, D, C2h, 10, dbg);
                hipLaunchKernelGGL(dbg_gemm_check, dim3(16), dim3(256), 0, stream, (const unsigned short*)(ws + WS_XN), D, (const unsigned short*)(ws + WS_DQKV) + (size_t)D * D, D, (const unsigned short*)(ws + WS_K), D, MTOK, D, 1.f, 11, dbg);

                hipLaunchKernelGGL(dbg_gemm_check, dim3(16), dim3(256), 0, stream, (const unsigned short*)(ws + WS_XN), D, (const unsigned short*)(ws + WS_DQKV) + (size_t)2 * D * D, D, (const unsigned short*)(ws + WS_V), D, MTOK, D, 1.f, 12, dbg);
            }
            if (0) { PROBE(ws + WS_XN, MD_, 1, 1, 10.f); PROBE(ws + WS_DQKV, (WS_MGU - WS_DQKV) / 2, 1, 2, 1.f); PROBE(ws + WS_MGU, (WS_XN - WS_MGU) / 2, 1, 3, 1.f); }
            if (p >= 1) { const int L = (p - 1) / PH_PER_LAYER, k = (p - 1) % PH_PER_LAYER; const int b = 20 + 10 * L;
                if (k == 0) PROBE(ws + WS_Q, 3 * MD_, 1, b + 0, 50.f);
                if (k == 1) PROBE(ws + WS_KMEAN, 8 * 16 * 16 * 64, 0, b + 1, 5.f);
                if (k == 2) PROBE(ws + WS_XN, MD_, 1, b + 2, 50.f);
                if (k == 3) PROBE(d_out, MD_, 0, b + 3, 300.f);
                if (k == 4) { PROBE(ws + WS_XN, MD_, 1, b + 4, 20.f); if ((L & 1) && (b + 9) <= MK_PROBE_MAX) hipLaunchKernelGGL(dbg_cnt, dim3(1), dim3(64), 0, stream, (const unsigned*)(ws + WS_CTL) + CW_CNT + 64 * NE * (L >> 1), b + 9, dbg); }
                if (k == 5) PROBE(ws + WS_ACT, (L & 1) ? (size_t)256 * 256 * DE : (size_t)MTOK * DFF, 1, b + 5, 2000.f);
                if (k == 6) { PROBE(d_out, MD_, 0, b + 6, 1000.f); if (L & 1) PROBE(ws + WS_XN, MD_, 1, b + 7, 1000.f); }
                if (k == 7 && L != 3) { PROBE(ws + WS_XN, MD_, 1, b + 8, 20.f); PROBE(d_out, MD_, 0, b + 8, 1000.f); }
            }
#undef PROBE
        }
#endif
    }
#if MK_DEBUG
    hipLaunchKernelGGL(dbg_final, dim3(2048), dim3(256), 0, stream, (float*)d_out, (size_t)MTOK * D, (const unsigned*)((unsigned char*)d_ws + WS_CTL) + 2048);
#endif
#else
    a.ph_lo = 0; a.ph_hi = NPHASE;
    hipLaunchKernelGGL(trunk_fwd, dim3(grid), dim3(NWAVES * 64), LDS_BYTES, stream, a);
#if 0
    hipLaunchKernelGGL(stamp_encode, dim3(2048), dim3(256), 0, stream, (float*)d_out, (size_t)MTOK * D, (const unsigned*)d_ws + 3000, MK_STAMP_PA, MK_STAMP_UA, MK_STAMP_PB, MK_STAMP_UB);
#endif
#endif
#if MK_STAMP
    hipLaunchKernelGGL(stamp_encode, dim3(2048), dim3(256), 0, stream, (float*)d_out, (size_t)MTOK * D, (const unsigned*)d_ws + 3000, MK_STAMP_PA, MK_STAMP_UA, MK_STAMP_PB, MK_STAMP_UB);
#endif
    const hipError_t le = hipPeekAtLastError();
    if (le != hipSuccess) fprintf(stderr, "kernel_launch: launch failed: %s\n", hipGetErrorName(le));
}
```

```cpp
#define MK_DEBUG 0
#define MK_PER_PHASE 0
#define MK_DOUBLE 0x0u
#include <hip/hip_runtime.h>
#include <cstdio>
#include <cstdint>

#ifndef MK_DEBUG
#define MK_DEBUG 1
#endif
#ifndef MK_KDEBUG
#define MK_KDEBUG 0
#endif
#define LAS __attribute__((address_space(3)))
#define GAS __attribute__((address_space(1)))

constexpr int BATCH = 8, SEQ = 4096, MTOK = BATCH * SEQ, D = 1024, DFF = 2816, DE = 3584, NE = 8;
constexpr int MOE_TILES_MAX = 272;
constexpr int LIST_CAP = MTOK;

namespace pg8 {
#define PG8_LAS __attribute__((address_space(3)))
typedef unsigned short bf16_t;
typedef short bf16x8 __attribute__((ext_vector_type(8)));
typedef float f32x4 __attribute__((ext_vector_type(4)));
typedef unsigned u32x4 __attribute__((ext_vector_type(4)));
typedef int i32x4 __attribute__((ext_vector_type(4)));
typedef int i32x8 __attribute__((ext_vector_type(8)));
constexpr int BM = 256, BK = 64, HALF = 128, HTB = HALF * BK * 2  , STAGE_BYTES = 8 * HTB, NXCD = 8, WGM = 8;

__host__ __device__ __forceinline__ int lds_byte(int r, int c) { const int st = (r >> 4) * 2 + (c >> 5), rr = r & 15, cc = c & 31, ob = rr * 64 + cc * 2; return st * 1024 + (ob ^ (((ob >> 9) & 1) << 5)); }
__host__ __device__ __forceinline__ void stage_rc(int b, int& R, int& C) { const int st = b / 1024, sb = b % 1024, swz = sb ^ (((sb >> 9) & 1) << 5); R = (st >> 1) * 16 + swz / 64; C = (st & 1) * 32 + (swz % 64) / 2; }
__host__ __device__ __forceinline__ int perm32(int rho) { const int n = rho >> 4, i = rho & 15; return 8 * (i >> 2) + 4 * n + (i & 3); }

struct Unit { int pm, pn, e, r0; };
struct Gemm { const void* A; const void* Bt; int rowb; size_t bstride; };

__device__ __forceinline__ void tile_of(int L, int nM, int nN, int& pm, int& pn) {
    const int nwg = nM * nN; int wgid = L; { const int q = nwg / NXCD, r = nwg % NXCD, xcd = wgid % NXCD, off = wgid / NXCD; wgid = (xcd < r ? xcd * (q + 1) : r * (q + 1) + (xcd - r) * q) + off; }
    const int nig = WGM * nN, gid = wgid / nig, fm = gid * WGM, gsz = (nM - fm) < WGM ? (nM - fm) : WGM;
    pm = fm + ((wgid % nig) % gsz); pn = (wgid % nig) / gsz;
}
struct StaticOrder {
    int nM, nN, nwg, G, c;
    __device__ __forceinline__ void init(int M, int N, int G_, int c_) { nM = M / BM; nN = N / BM; nwg = nM * nN; G = G_; c = c_; }
    __device__ __forceinline__ bool next(int i, Unit& u) const {
        const long L = (long)i * G + c; if (L >= nwg) return false;
        tile_of((int)L, nM, nN, u.pm, u.pn); u.e = 0; u.r0 = 0; return true;
    }
    __device__ __forceinline__ unsigned arow(const Unit& u, int lr) const { return (unsigned)(u.pm * BM + lr); }
};
struct MoeOrder {
    int nM, nN, nwg, G, c; int tstart[NE + 1]; int cnt[NE]; const unsigned* list_tok; bool gather;
    __device__ __forceinline__ void init(const unsigned* cntw, const unsigned* list_tok_, bool gather_, int N, int G_, int c_) {
        int acc = 0;
#pragma unroll
        for (int e = 0; e < NE; ++e) { const int ce = (int)__builtin_amdgcn_readfirstlane((int)__hip_atomic_load((const GAS unsigned*)cntw + 64 * e, __ATOMIC_RELAXED, __HIP_MEMORY_SCOPE_AGENT)); cnt[e] = ce; tstart[e] = acc; acc += (ce + BM - 1) / BM; }
        tstart[NE] = acc; nM = acc; nN = N / BM; nwg = nM * nN; G = G_; c = c_; list_tok = list_tok_; gather = gather_;
    }
    __device__ __forceinline__ bool next(int i, Unit& u) const {
        const long L = (long)i * G + c; if (L >= nwg) return false;
        tile_of((int)L, nM, nN, u.pm, u.pn); int e = 0;
#pragma unroll
        for (int k = 1; k < NE; ++k) e += (u.pm >= tstart[k]) ? 1 : 0;
        u.e = e; int ts = 0;
#pragma unroll
        for (int k = 0; k < NE; ++k) ts = (k == e) ? tstart[k] : ts;
        u.r0 = (u.pm - ts) * BM; return true;
    }
    __device__ __forceinline__ int count_of(int e) const { int cv = 0;
#pragma unroll
        for (int k = 0; k < NE; ++k) cv = (k == e) ? cnt[k] : cv;
        return cv; }
    __device__ __forceinline__ unsigned arow(const Unit& u, int lr) const {
        if (!gather) return (unsigned)(u.pm * BM + lr);
        const int l = u.r0 + lr; const int cv = count_of(u.e);
        unsigned t = 0u; if (l < cv) t = __hip_atomic_load((const GAS unsigned*)list_tok + (size_t)u.e * LIST_CAP + l, __ATOMIC_RELAXED, __HIP_MEMORY_SCOPE_AGENT) & 0xFFFFFu;
        return t;
    }
};

__device__ __forceinline__ unsigned cvt_pk_bf16(float lo, float hi) { unsigned r; asm volatile("v_cvt_pk_bf16_f32 %0, %1, %2" : "=v"(r) : "v"(lo), "v"(hi)); return r; }

struct EpiQKV {
    static constexpr bool PERM = true;
    bf16_t* O; int ldc; int split_cols; size_t split_stride; float scale0;
    __device__ __forceinline__ void operator()(const f32x4 (&acc)[2][2][4][2], const Unit& u, int wr, int wc, int fr, int fq) const {
        const int row0 = u.pm * BM + wr * 64 + fr; int colt = u.pn * BM; bf16_t* base = O;
        float sc = 1.f; { const int t = colt / split_cols; base += (size_t)t * split_stride; colt -= t * split_cols; if (t == 0) sc = scale0; }
        const int col0 = colt + wc * 32 + 8 * fq;
#pragma unroll
        for (int ai = 0; ai < 2; ++ai)
#pragma unroll
            for (int m = 0; m < 4; ++m) { bf16_t* rowp = base + (size_t)(row0 + ai * HALF + m * 16) * ldc + col0;
#pragma unroll
                for (int bj = 0; bj < 2; ++bj) { f32x4 v0 = acc[ai][bj][m][0] * sc, v1 = acc[ai][bj][m][1] * sc;
                    u32x4 w; w.x = cvt_pk_bf16(v0[0], v0[1]); w.y = cvt_pk_bf16(v0[2], v0[3]); w.z = cvt_pk_bf16(v1[0], v1[1]); w.w = cvt_pk_bf16(v1[2], v1[3]);
                    *(GAS u32x4*)(rowp + bj * HALF) = w;
                    } }
    }
};
__device__ __forceinline__ unsigned pk4_fp8(float a, float b, float c, float d) { unsigned w = 0; w = __builtin_amdgcn_cvt_pk_fp8_f32(a, b, w, false); w = __builtin_amdgcn_cvt_pk_fp8_f32(c, d, w, true); return w; }
template <bool F8OUT> struct EpiSwiGLU {
    static constexpr bool PERM = true;
    void* O; int ldc; float sc;
    __device__ __forceinline__ void operator()(const f32x4 (&acc)[2][2][4][2], const Unit& u, int wr, int wc, int fr, int fq) const {
        const int row0 = u.pm * BM + wr * 64 + fr; const int col0 = u.pn * HALF + wc * 32 + 8 * fq;
#pragma unroll
        for (int ai = 0; ai < 2; ++ai)
#pragma unroll
            for (int m = 0; m < 4; ++m) { float o[8];
#pragma unroll
                for (int n = 0; n < 2; ++n)
#pragma unroll
                    for (int j = 0; j < 4; ++j) { const float g = acc[ai][0][m][n][j] * sc, up = acc[ai][1][m][n][j] * sc;
                        const float s = __builtin_amdgcn_rcpf(1.0f + __builtin_amdgcn_exp2f(-1.4426950408889634f * g)); o[n * 4 + j] = g * s * up; }
                const size_t eo = (size_t)(row0 + ai * HALF + m * 16) * ldc + col0;
                if constexpr (F8OUT) { const unsigned long long w = (unsigned long long)pk4_fp8(o[0], o[1], o[2], o[3]) | ((unsigned long long)pk4_fp8(o[4], o[5], o[6], o[7]) << 32);
                    *(GAS unsigned long long*)((unsigned char*)O + eo) = w;
                } else { u32x4 w; w.x = cvt_pk_bf16(o[0], o[1]); w.y = cvt_pk_bf16(o[2], o[3]); w.z = cvt_pk_bf16(o[4], o[5]); w.w = cvt_pk_bf16(o[6], o[7]);
                    *(GAS u32x4*)((bf16_t*)O + eo) = w; } }
    }
};
struct EpiRes {
    static constexpr bool PERM = false;
    const float* res; float* out; int ldc; float sc;
    __device__ __forceinline__ void operator()(const f32x4 (&acc)[2][2][4][2], const Unit& u, int wr, int wc, int fr, int fq) const {
        const int row0 = u.pm * BM + wr * 64 + fr; const int col0 = u.pn * BM + wc * 32 + 4 * fq;
#pragma unroll
        for (int ai = 0; ai < 2; ++ai)
#pragma unroll
            for (int m = 0; m < 4; ++m) { const size_t off = (size_t)(row0 + ai * HALF + m * 16) * ldc + col0;
#pragma unroll
                for (int bj = 0; bj < 2; ++bj)
#pragma unroll
                    for (int n = 0; n < 2; ++n) { const f32x4 r = *(const GAS f32x4*)(res + off + bj * HALF + n * 16); *(GAS f32x4*)(out + off + bj * HALF + n * 16) = r + acc[ai][bj][m][n] * sc; } }
    }
};
struct EpiMoeDown {
    static constexpr bool PERM = false;
    float* h; bf16_t* y1; const unsigned* list_tok; const float* list_w; int cnt[NE]; float sc;
    __device__ __forceinline__ void operator()(const f32x4 (&acc)[2][2][4][2], const Unit& u, int wr, int wc, int fr, int fq) const {
        int cv = 0;
#pragma unroll
        for (int k = 0; k < NE; ++k) cv = (k == u.e) ? cnt[k] : cv;
        const int col0 = u.pn * BM + wc * 32 + 4 * fq;
#pragma unroll
        for (int ai = 0; ai < 2; ++ai)
#pragma unroll
            for (int m = 0; m < 4; ++m) { const int l = u.r0 + ai * HALF + wr * 64 + m * 16 + fr;
                if (l < cv) {
                    const unsigned ent = __hip_atomic_load((const GAS unsigned*)list_tok + (size_t)u.e * LIST_CAP + l, __ATOMIC_RELAXED, __HIP_MEMORY_SCOPE_AGENT);
                    const float w = sc * __uint_as_float(__hip_atomic_load((const GAS unsigned*)list_w + (size_t)u.e * LIST_CAP + l, __ATOMIC_RELAXED, __HIP_MEMORY_SCOPE_AGENT));
                    const size_t off = (size_t)(ent & 0xFFFFFu) * D + col0;
                    if ((ent >> 20) == 0u) {
#pragma unroll
                        for (int bj = 0; bj < 2; ++bj)
#pragma unroll
                            for (int n = 0; n < 2; ++n) { GAS float* p = (GAS float*)(h + off + bj * HALF + n * 16); const f32x4 r = *(const GAS f32x4*)p; *(GAS f32x4*)p = r + acc[ai][bj][m][n] * w; }
                    } else {
#pragma unroll
                        for (int bj = 0; bj < 2; ++bj)
#pragma unroll
                            for (int n = 0; n < 2; ++n) { const f32x4 v = acc[ai][bj][m][n] * w; unsigned long long pk = (unsigned long long)cvt_pk_bf16(v[0], v[1]) | ((unsigned long long)cvt_pk_bf16(v[2], v[3]) << 32);
                                *(GAS unsigned long long*)(y1 + off + bj * HALF + n * 16) = pk; }
                    }
                } }
    }
};

template <class Epi, class Sched, bool F8 = false>
__device__ __forceinline__ void gemm_phase(PG8_LAS unsigned char* lds, int xoff, const Gemm g, const Sched& S, const Epi& E) {
    int tid_ = threadIdx.x;
    asm volatile("" : "+v"(tid_));
    const int tid = tid_, wid = __builtin_amdgcn_readfirstlane(tid >> 6), lane = tid & 63, wr = wid >> 2, wc = wid & 3, fr = lane & 15, fq = lane >> 4;
    const int RB = g.rowb, nt = RB / 128;
    unsigned voffB[2];
#pragma unroll
    for (int i = 0; i < 2; ++i) { int R, C; stage_rc(tid * 16 + i * 8192, R, C); const int Rb = Epi::PERM ? ((R & ~31) + perm32(R & 31)) : R;
        voffB[i] = (unsigned)(Rb * RB + C * 2); }
    const size_t kstep = (size_t)(BK * 2);
    const size_t hstep = (size_t)HALF * RB;
    const size_t tstep = 2 * hstep;
    const unsigned ldsw = (unsigned)wid * 1024u;
    const int aoff = F8 ? lds_byte(wr * 64 + fr, fq * 16) : lds_byte(wr * 64 + fr, fq * 8), boff = F8 ? lds_byte(wc * 32 + fr, fq * 16) : lds_byte(wc * 32 + fr, fq * 8);
#define PG8_SA(b, h) (((b) * 2 + (h)) * HTB)
#define PG8_SB(b, h) ((4 + (b) * 2 + (h)) * HTB)
#define PG8_STAGE(bufoff, gbase, v0, v1) do { \
        __builtin_amdgcn_global_load_lds((const GAS unsigned*)((const char*)(gbase) + (v0)), (PG8_LAS unsigned*)(lds + (bufoff) + ldsw), 16, 0, 0); \
        __builtin_amdgcn_global_load_lds((const GAS unsigned*)((const char*)(gbase) + (v1)), (PG8_LAS unsigned*)(lds + (bufoff) + ldsw + 8192), 16, 0, 0); } while (0)
#define PG8_STAGEB(bufoff, gbase) PG8_STAGE(bufoff, gbase, voffB[0], voffB[1])
#define PG8_LDA(dst, b, h) do { if constexpr (F8) { _Pragma("unroll") for (int m = 0; m < 4; ++m) { dst##8[m].lo = *(const PG8_LAS i32x4*)(lds + PG8_SA(b, h) + aoff + m * 2048); dst##8[m].hi = *(const PG8_LAS i32x4*)(lds + PG8_SA(b, h) + aoff + m * 2048 + 16); } } \
        else { _Pragma("unroll") for (int m = 0; m < 4; ++m) _Pragma("unroll") for (int k = 0; k < 2; ++k) dst[m][k] = *(const PG8_LAS bf16x8*)(lds + PG8_SA(b, h) + aoff + m * 2048 + k * 1024); } } while (0)
#define PG8_LDB(dst, b, h) do { if constexpr (F8) { _Pragma("unroll") for (int n = 0; n < 2; ++n) { dst##8[n].lo = *(const PG8_LAS i32x4*)(lds + PG8_SB(b, h) + boff + n * 2048); dst##8[n].hi = *(const PG8_LAS i32x4*)(lds + PG8_SB(b, h) + boff + n * 2048 + 16); } } \
        else { _Pragma("unroll") for (int n = 0; n < 2; ++n) _Pragma("unroll") for (int k = 0; k < 2; ++k) dst[n][k] = *(const PG8_LAS bf16x8*)(lds + PG8_SB(b, h) + boff + n * 2048 + k * 1024); } } while (0)
#define PG8_MMA(ai, bj, At, Bt) do { __builtin_amdgcn_s_setprio(1); _Pragma("unroll") for (int m = 0; m < 4; ++m) _Pragma("unroll") for (int n = 0; n < 2; ++n) { \
        if constexpr (F8) acc[ai][bj][m][n] = __builtin_amdgcn_mfma_scale_f32_16x16x128_f8f6f4(Bt##8[n], At##8[m], acc[ai][bj][m][n], 0, 0, 0, 0x7F7F7F7F, 0, 0x7F7F7F7F); \
        else { _Pragma("unroll") for (int k = 0; k < 2; ++k) acc[ai][bj][m][n] = __builtin_amdgcn_mfma_f32_16x16x32_bf16(Bt[n][k], At[m][k], acc[ai][bj][m][n], 0, 0, 0); } } __builtin_amdgcn_s_setprio(0); } while (0)
#define PG8_WAIT_V(n) asm volatile("s_waitcnt vmcnt(" #n ")" ::: "memory")
#define PG8_WAIT_L(n) asm volatile("s_waitcnt lgkmcnt(" #n ")" ::: "memory")
#define PG8_BAR __builtin_amdgcn_s_barrier()
#define PG8_SCHED __builtin_amdgcn_sched_barrier(0)
#define PG8_AOFFS(U, o00, o01, o10, o11) do { int R0_, C0_, R1_, C1_; stage_rc(tid * 16, R0_, C0_); stage_rc(tid * 16 + 8192, R1_, C1_);     \
        o00 = S.arow(U, R0_) * (unsigned)RB + (unsigned)C0_ * 2u; o01 = S.arow(U, R1_) * (unsigned)RB + (unsigned)C1_ * 2u; \
        o10 = S.arow(U, HALF + R0_) * (unsigned)RB + (unsigned)C0_ * 2u; o11 = S.arow(U, HALF + R1_) * (unsigned)RB + (unsigned)C1_ * 2u; } while (0)
    Unit cur, nxt; int ui = 0;
    if (!S.next(0, cur)) return;
    f32x4 acc[2][2][4][2];
#pragma unroll
    for (int a = 0; a < 2; ++a)
#pragma unroll
        for (int b = 0; b < 2; ++b)
#pragma unroll
            for (int m = 0; m < 4; ++m)
#pragma unroll
                for (int n = 0; n < 2; ++n) acc[a][b][m][n] = (f32x4){0.f, 0.f, 0.f, 0.f};
    bf16x8 At[4][2], B0[2][2], B1[2][2];
    i32x8 At8[4], B08[2], B18[2];
    unsigned c00, c01, c10, c11;
    PG8_LAS u32x4* const xslot = (PG8_LAS u32x4*)(lds + xoff) + tid;
    PG8_AOFFS(cur, c00, c01, c10, c11);
    const char* const gA = (const char*)g.A;
    const char* cB = (const char*)g.Bt + (size_t)cur.e * g.bstride + (size_t)cur.pn * tstep;
    PG8_STAGEB(PG8_SB(0, 0), cB); PG8_STAGEB(PG8_SB(0, 1), cB + hstep); PG8_STAGE(PG8_SA(0, 0), gA, c00, c01); PG8_STAGE(PG8_SA(0, 1), gA, c10, c11);
    if (wr == 1) PG8_BAR;
    PG8_WAIT_V(2); PG8_BAR;
    PG8_STAGEB(PG8_SB(1, 0), cB + kstep); PG8_STAGE(PG8_SA(1, 0), gA + kstep, c00, c01); PG8_STAGEB(PG8_SB(1, 1), cB + hstep + kstep);
    PG8_WAIT_V(6); PG8_BAR;
    for (;;) {
        const bool has_next = S.next(ui + 1, nxt);
        const char* nB_ = has_next ? (const char*)g.Bt + (size_t)nxt.e * g.bstride + (size_t)nxt.pn * tstep : cB;
        const char* nB = nB_;
        if (has_next) { unsigned n00, n01, n10, n11; PG8_AOFFS(nxt, n00, n01, n10, n11); *xslot = (u32x4){n00, n01, n10, n11}; }
#pragma unroll 1
        for (int t = 0; t < nt; t += 2) {
            const bool last = (t == nt - 2);
            const char* a1 = gA + (size_t)(t + 1) * kstep;
            const char* a2 = last ? gA : gA + (size_t)(t + 2) * kstep; const char* b2 = last ? nB : cB + (size_t)(t + 2) * kstep;
            const char* a3 = a2 + kstep; const char* b3 = b2 + kstep;
            PG8_LDB(B0, 0, 0); PG8_LDB(B1, 0, 1); PG8_SCHED; PG8_LDA(At, 0, 0); PG8_STAGE(PG8_SA(1, 1), a1, c10, c11);
            if (last && has_next) { const u32x4 nx = *xslot; c00 = nx.x; c01 = nx.y; c10 = nx.z; c11 = nx.w; }
            PG8_WAIT_V(8); PG8_WAIT_L(0); PG8_BAR; PG8_MMA(0, 0, At, B0); PG8_MMA(0, 1, At, B1); PG8_BAR; PG8_SCHED;
            PG8_LDA(At, 0, 1); PG8_STAGEB(PG8_SB(0, 0), b2); PG8_STAGEB(PG8_SB(0, 1), b2 + hstep); PG8_STAGE(PG8_SA(0, 0), a2, c00, c01);
            PG8_WAIT_V(8); PG8_WAIT_L(0); PG8_BAR; PG8_MMA(1, 0, At, B0); PG8_MMA(1, 1, At, B1); PG8_BAR; PG8_SCHED;
            PG8_LDB(B0, 1, 0); PG8_LDB(B1, 1, 1); PG8_SCHED; PG8_LDA(At, 1, 0); PG8_STAGE(PG8_SA(0, 1), a2, c10, c11);
            PG8_WAIT_V(8); PG8_WAIT_L(0); PG8_BAR; PG8_MMA(0, 0, At, B0); PG8_MMA(0, 1, At, B1); PG8_BAR; PG8_SCHED;
            PG8_LDA(At, 1, 1); PG8_STAGEB(PG8_SB(1, 0), b3); PG8_STAGEB(PG8_SB(1, 1), b3 + hstep); PG8_STAGE(PG8_SA(1, 0), a3, c00, c01);
            PG8_WAIT_V(8); PG8_WAIT_L(0); PG8_BAR; PG8_MMA(1, 0, At, B0); PG8_MMA(1, 1, At, B1); PG8_BAR; PG8_SCHED;
        }
        if (wr == 0) PG8_BAR;
        E(acc, cur, wr, wc, fr, fq);
        if (!has_next) break;
#pragma unroll
        for (int a = 0; a < 2; ++a)
#pragma unroll
            for (int b = 0; b < 2; ++b)
#pragma unroll
                for (int m = 0; m < 4; ++m)
#pragma unroll
                    for (int n = 0; n < 2; ++n) acc[a][b][m][n] = (f32x4){0.f, 0.f, 0.f, 0.f};
        cur = nxt; cB = nB; ++ui;
        if (wr == 1) PG8_BAR;
    }
    PG8_WAIT_V(0);
    PG8_BAR;
#undef PG8_SA
#undef PG8_SB
#undef PG8_STAGE
#undef PG8_STAGEB
#undef PG8_LDA
#undef PG8_LDB
#undef PG8_MMA
#undef PG8_WAIT_V
#undef PG8_WAIT_L
#undef PG8_BAR
#undef PG8_SCHED
#undef PG8_AOFFS
}
}

namespace att {
typedef unsigned short bf16_t;
typedef short bf16x8 __attribute__((ext_vector_type(8)));
typedef short s16x4 __attribute__((ext_vector_type(4)));
typedef float f32x16 __attribute__((ext_vector_type(16)));
typedef float f32x4 __attribute__((ext_vector_type(4)));
typedef unsigned u32x4 __attribute__((ext_vector_type(4)));
constexpr int PITCH = 1024;
constexpr float LOG2E = 1.4426950408889634f;
__device__ __forceinline__ int crow(int r, int hi) { return (r & 3) + 8 * (r >> 2) + 4 * hi; }
typedef float f32x2_t __attribute__((ext_vector_type(2))); typedef __bf16 bf16x2_t __attribute__((ext_vector_type(2)));
__device__ __forceinline__ unsigned cvtpk(float lo, float hi) { f32x2_t v = {lo, hi}; bf16x2_t b = __builtin_convertvector(v, bf16x2_t); return __builtin_bit_cast(unsigned, b); }
__device__ __forceinline__ float bf2f(short s) { return __uint_as_float(((unsigned)(unsigned short)s) << 16); }
typedef short v4i16_t __attribute__((ext_vector_type(4)));
__device__ __forceinline__ s16x4 vtr(const LAS unsigned char* p) { return __builtin_bit_cast(s16x4, __builtin_amdgcn_ds_read_tr16_b64_v4i16((LAS v4i16_t*)p)); }
__device__ __forceinline__ float max3f(float a, float b, float c) { float r; asm("v_max3_f32 %0, %1, %2, %3" : "=v"(r) : "v"(a), "v"(b), "v"(c)); return r; }
__device__ __forceinline__ float halves_max(float m) { auto rr = __builtin_amdgcn_permlane32_swap(__float_as_uint(m), __float_as_uint(m), false, false); return fmaxf(__uint_as_float(rr[0]), __uint_as_float(rr[1])); }
__device__ __forceinline__ float halves_sum(float m) { auto rr = __builtin_amdgcn_permlane32_swap(__float_as_uint(m), __float_as_uint(m), false, false); return __uint_as_float(rr[0]) + __uint_as_float(rr[1]); }
#define ATT_BAR() asm volatile("s_waitcnt vmcnt(0) lgkmcnt(0)\n\ts_barrier" ::: "memory")

struct Args { const bf16_t* Q; const bf16_t* K; const bf16_t* V; bf16_t* O; const float* kmean; const float* kmax2; const float* subln; float lam_full; float out_scale; };

template <int MODE>
__device__ __forceinline__ void attn_unit(LAS unsigned char* lds, const Args& A, int b, int h, int qblk) {
    constexpr int DVB = MODE == 0 ? 4 : 2;
    constexpr int NCH = MODE == 0 ? 16 : 8;
    constexpr int KBY = NCH * 1024, VBY = DVB * 4096, SLOT = KBY + VBY;
    constexpr int QR = MODE == 0 ? 128 : 256;
    constexpr int PPW = MODE == 0 ? 2 : 1;
    int tid_ = threadIdx.x; asm volatile("" : "+v"(tid_));
    const int tid = tid_, lane = tid & 63, r32 = lane & 31, hi = lane >> 5;
    const int wid = __builtin_amdgcn_readfirstlane(tid >> 6);
    const int comp = MODE == 0 ? (wid >> 2) : 0, wq = MODE == 0 ? (wid & 3) : wid;
    const int q0 = qblk * QR; const long rowbase = (long)b * SEQ;
    const int hcol = MODE == 0 ? h * 128 : h * 64;
    const int qrel0 = wq * 32;
    const float slope2 = __builtin_amdgcn_exp2f(MODE == 0 ? -(float)(h + 1) : -0.5f * (float)(h + 1)) * LOG2E;
    const int NT = MODE == 0 ? 2 * qblk + 2 : 4 + 4 * qblk;
#define ATT_KBASE_(t) (MODE == 0 ? 64 * (t) : ((t) < 4 ? q0 + 64 * (t) : 64 * ((t) - 4)))
    LAS float* wsf = (LAS float*)(lds + 65536) + wid * 64;
    const bf16_t* Kb = A.K + rowbase * PITCH + hcol;
    const bf16_t* Vb = A.V + rowbase * PITCH + hcol;
    bf16x8 qr[4];
    { const bf16_t* Qw = A.Q + (rowbase + q0 + qrel0 + r32) * PITCH + hcol + comp * 64 + hi * 8;
#pragma unroll
      for (int d0 = 0; d0 < 4; ++d0) qr[d0] = *(const GAS bf16x8*)(Qw + d0 * 16); }
    ATT_BAR();
    LAS int* live = (LAS int*)(lds + 71680); LAS float* qnx = (LAS float*)(lds + 71680 + 272);
    { float q2 = 0.f;
#pragma unroll
      for (int d0 = 0; d0 < 4; ++d0)
#pragma unroll
        for (int j = 0; j < 8; ++j) { const float v = bf2f(qr[d0][j]); q2 += v * v; }
      q2 = halves_sum(q2);
      q2 = fmaxf(q2, __shfl_xor(q2, 1)); q2 = fmaxf(q2, __shfl_xor(q2, 2)); q2 = fmaxf(q2, __shfl_xor(q2, 4)); q2 = fmaxf(q2, __shfl_xor(q2, 8)); q2 = fmaxf(q2, __shfl_xor(q2, 16));
      if (lane == 0) qnx[wid] = q2; }
    ATT_BAR();
    if (wid == 0) {
        const int tt = lane;
        const int kbase_t = (tt < NT) ? ATT_KBASE_(tt) : 0;
        bool alive = tt < NT;
        if (alive && kbase_t + 64 <= q0) {
            const int nblk = kbase_t >> 8; float bound = -INFINITY;
            if constexpr (MODE == 0) {
#pragma unroll
                for (int c = 0; c < 2; ++c) { float qm = fmaxf(fmaxf(qnx[4 * c], qnx[4 * c + 1]), fmaxf(qnx[4 * c + 2], qnx[4 * c + 3]));
                    const float k2 = ((const GAS float*)A.kmax2)[(size_t)(b * 16 + h * 2 + c) * 16 + nblk]; bound = fmaxf(bound, sqrtf(qm) * sqrtf(k2)); }
            } else {
                float qm = qnx[0];
#pragma unroll
                for (int w = 1; w < 8; ++w) qm = fmaxf(qm, qnx[w]);
                const float k2 = ((const GAS float*)A.kmax2)[(size_t)(b * 16 + h) * 16 + nblk]; bound = sqrtf(qm) * sqrtf(k2);
            }
            alive = !(bound * 1.001f + 1.0f + slope2 * (float)(kbase_t + 63 - q0) < -152.0f);
        }
        const unsigned long long am = __ballot(alive);
        if (alive) live[__popcll(am & ((1ull << lane) - 1ull))] = tt;
        if (lane == 0) live[64] = __popcll(am);
    }
    ATT_BAR();
    const int NTL = __builtin_amdgcn_readfirstlane(live[64]);
    unsigned sel = 0u;
    if constexpr (MODE == 1) {
        LAS float* km = (LAS float*)(lds + 67584);
        for (int i = tid; i < 1024; i += 512) km[i] = ((const GAS float*)A.kmean)[(size_t)(b * 16 + h) * 1024 + i];
        ATT_BAR();
        float g[16];
#pragma unroll
        for (int n = 0; n < 16; ++n) { float s = 0.f;
            if (n < qblk) {
#pragma unroll
                for (int d0 = 0; d0 < 4; ++d0) { const f32x4 ka = *(const LAS f32x4*)(km + n * 64 + d0 * 16 + hi * 8), kb2 = *(const LAS f32x4*)(km + n * 64 + d0 * 16 + hi * 8 + 4);
                    s += bf2f(qr[d0][0]) * ka[0] + bf2f(qr[d0][1]) * ka[1] + bf2f(qr[d0][2]) * ka[2] + bf2f(qr[d0][3]) * ka[3]
                       + bf2f(qr[d0][4]) * kb2[0] + bf2f(qr[d0][5]) * kb2[1] + bf2f(qr[d0][6]) * kb2[2] + bf2f(qr[d0][7]) * kb2[3]; }
                s = halves_sum(s); }
            g[n] = s; }
        const int nsel = qblk < 3 ? qblk : 3;
#pragma unroll
        for (int k = 0; k < 3; ++k) if (k < nsel) { float best = -INFINITY; int bi = 0; bool found = false;
#pragma unroll
            for (int n = 0; n < 16; ++n) if (n < qblk) { const bool free_ = ((sel >> n) & 1u) == 0u; if (free_ && (!found || g[n] > best)) { best = g[n]; bi = n; found = true; } }
            sel |= 1u << bi; }
    }
#define ATT_KBASE(t) ATT_KBASE_(t)
#define ATT_ISSUE(t, slot) do { const int kb_ = ATT_KBASE(t); \
        _Pragma("unroll") for (int i_ = 0; i_ < PPW; ++i_) { const int p_ = wid + 8 * i_; \
            __builtin_amdgcn_global_load_lds((const GAS unsigned*)(Kb + (size_t)(kb_ + lane) * PITCH + p_ * 8), (LAS unsigned*)(lds + (slot) * SLOT + p_ * 1024), 16, 0, 0); \
            __builtin_amdgcn_global_load_lds((const GAS unsigned*)(Vb + (size_t)(kb_ + 16 * (p_ & 3) + (lane >> 2)) * PITCH + (p_ >> 2) * 32 + (lane & 3) * 8), (LAS unsigned*)(lds + (slot) * SLOT + KBY + p_ * 1024), 16, 0, 0); } } while (0)
    constexpr float THR = 8.0f;
    float mref = 0.f, l = 0.f; f32x16 o[DVB];
#pragma unroll
    for (int d0 = 0; d0 < DVB; ++d0) o[d0] = f32x16{};
#define ATT_ISSUE_K(tt, slot) do { const int kb_ = ATT_KBASE(tt); \
        _Pragma("unroll") for (int i_ = 0; i_ < PPW; ++i_) { const int p_ = wid + 8 * i_; \
            __builtin_amdgcn_global_load_lds((const GAS unsigned*)(Kb + (size_t)(kb_ + lane) * PITCH + p_ * 8), (LAS unsigned*)(lds + (slot) * SLOT + p_ * 1024), 16, 0, 0); } } while (0)
#define ATT_ISSUE_V(tt, slot) do { const int kb_ = ATT_KBASE(tt); \
        _Pragma("unroll") for (int i_ = 0; i_ < PPW; ++i_) { const int p_ = wid + 8 * i_; \
            __builtin_amdgcn_global_load_lds((const GAS unsigned*)(Vb + (size_t)(kb_ + 16 * (p_ & 3) + (lane >> 2)) * PITCH + (p_ >> 2) * 32 + (lane & 3) * 8), (LAS unsigned*)(lds + (slot) * SLOT + KBY + p_ * 1024), 16, 0, 0); } } while (0)
#define ATT_CLASS(tt, SK, NM, SB) do { const int kb_ = ATT_KBASE(tt), kr_ = kb_ - q0; const bool dg_ = kb_ >= q0; SK = dg_ && (kr_ > qrel0 + 31); NM = dg_ && (kr_ + 63 > qrel0); SB = true; \
        if constexpr (MODE == 1) { if ((tt) >= 4) { SB = ((sel >> (((tt) - 4) >> 2)) & 1u) != 0u; if (!__any(SB)) SK = true; } } } while (0)
#define ATT_QK(P0, P1, tt, slot, SB) do { const int kr_ = ATT_KBASE(tt) - q0; float off0_ = slope2 * (float)(kr_ + 4 * hi) - mref; if (!(SB)) off0_ = -INFINITY; const float off1_ = off0_ + 32.0f * slope2; \
        _Pragma("unroll") for (int r = 0; r < 16; ++r) { const float cbr = slope2 * (float)((r & 3) + 8 * (r >> 2)); P0[r] = cbr + off0_; P1[r] = cbr + off1_; } \
        const LAS unsigned char* Ks_ = lds + (slot) * SLOT + comp * 8192 + hi * 1024 + r32 * 16; \
        _Pragma("unroll") for (int d0 = 0; d0 < 4; ++d0) { const bf16x8 b0 = *(const LAS bf16x8*)(Ks_ + d0 * 2048), b1 = *(const LAS bf16x8*)(Ks_ + d0 * 2048 + 512); \
            P0 = __builtin_amdgcn_mfma_f32_32x32x16_bf16(b0, qr[d0], P0, 0, 0, 0); P1 = __builtin_amdgcn_mfma_f32_32x32x16_bf16(b1, qr[d0], P1, 0, 0, 0); } } while (0)
    f32x16 p0, p1, n0, n1;
    int t = __builtin_amdgcn_readfirstlane(live[0]);
    int tn = (NTL > 1) ? __builtin_amdgcn_readfirstlane(live[1]) : 0;
    bool skipC, maskC, selC, skipN = true, maskN = false, selN = true;
    ATT_ISSUE_K(t, 0); ATT_ISSUE_V(t, 0); if (NTL > 1) ATT_ISSUE_K(tn, 1);
    ATT_BAR();
    ATT_CLASS(t, skipC, maskC, selC);
    if (!skipC) ATT_QK(p0, p1, t, 0, selC);
    for (int it = 0; it < NTL; ++it) {
        ATT_BAR();
        const int tnn = (it + 2 < NTL) ? __builtin_amdgcn_readfirstlane(live[it + 2]) : 0;
        if (it + 2 < NTL) ATT_ISSUE_K(tnn, it & 1);
        if (it + 1 < NTL) { ATT_ISSUE_V(tn, (it + 1) & 1); ATT_CLASS(tn, skipN, maskN, selN); if (!skipN) ATT_QK(n0, n1, tn, (it + 1) & 1, selN); } else skipN = true;
        if (!skipC) {
            const int krel = ATT_KBASE(t) - q0;
            const LAS unsigned char* Vs = lds + (it & 1) * SLOT + KBY + ((lane >> 4) & 1) * 32 + (lane & 3) * 8 + (4 * hi + ((lane & 15) >> 2)) * 64;
            if (maskC) { const int qrel = qrel0 + r32;
#pragma unroll
                for (int r = 0; r < 16; ++r) { const int kv = krel + crow(r, hi); if (kv > qrel) p0[r] = -INFINITY; if (kv + 32 > qrel) p1[r] = -INFINITY; } }
            float rm;
            { float a_ = max3f(p0[0], p0[1], p1[0]), b_ = max3f(p0[2], p0[3], p1[1]); a_ = max3f(a_, p1[2], p1[3]);
#pragma unroll
              for (int r = 4; r < 16; r += 4) { a_ = max3f(a_, p0[r], p0[r + 1]); b_ = max3f(b_, p0[r + 2], p0[r + 3]); a_ = max3f(a_, p1[r], p1[r + 1]); b_ = max3f(b_, p1[r + 2], p1[r + 3]); }
              rm = halves_max(fmaxf(a_, b_)); }
            if (__any(rm > THR)) {
                const float dl = fmaxf(rm, 0.f); mref += dl; const float alpha = __builtin_amdgcn_exp2f(-dl);
#pragma unroll
                for (int r = 0; r < 16; ++r) { p0[r] -= dl; p1[r] -= dl; }
                if (!skipN) {
#pragma unroll
                    for (int r = 0; r < 16; ++r) { n0[r] -= dl; n1[r] -= dl; } }
                l *= alpha;
                if (hi == 0) wsf[r32] = alpha;
                asm volatile("s_waitcnt lgkmcnt(0)" ::: "memory");
#pragma unroll
                for (int gq = 0; gq < 4; ++gq) { const f32x4 f = *(const LAS f32x4*)(wsf + 8 * gq + 4 * hi);
#pragma unroll
                    for (int d0 = 0; d0 < DVB; ++d0) { o[d0][4 * gq + 0] *= f[0]; o[d0][4 * gq + 1] *= f[1]; o[d0][4 * gq + 2] *= f[2]; o[d0][4 * gq + 3] *= f[3]; } }
            }
            float sacc = 0.f;
#pragma unroll
            for (int r = 0; r < 16; ++r) { p0[r] = __builtin_amdgcn_exp2f(p0[r]); p1[r] = __builtin_amdgcn_exp2f(p1[r]); sacc += p0[r] + p1[r]; }
            l += sacc;
            u32x4 pw[4];
            pw[0] = (u32x4){cvtpk(p0[0], p0[1]), cvtpk(p0[2], p0[3]), cvtpk(p0[4], p0[5]), cvtpk(p0[6], p0[7])};
            pw[1] = (u32x4){cvtpk(p0[8], p0[9]), cvtpk(p0[10], p0[11]), cvtpk(p0[12], p0[13]), cvtpk(p0[14], p0[15])};
            pw[2] = (u32x4){cvtpk(p1[0], p1[1]), cvtpk(p1[2], p1[3]), cvtpk(p1[4], p1[5]), cvtpk(p1[6], p1[7])};
            pw[3] = (u32x4){cvtpk(p1[8], p1[9]), cvtpk(p1[10], p1[11]), cvtpk(p1[12], p1[13]), cvtpk(p1[14], p1[15])};
#pragma unroll
            for (int d0 = 0; d0 < DVB; ++d0)
#pragma unroll
                for (int ks = 0; ks < 4; ++ks) { const s16x4 vlo = vtr(Vs + d0 * 4096 + ks * 1024), vhi = vtr(Vs + d0 * 4096 + ks * 1024 + 512);
                    const bf16x8 vf = (bf16x8){vlo[0], vlo[1], vlo[2], vlo[3], vhi[0], vhi[1], vhi[2], vhi[3]};
                    o[d0] = __builtin_amdgcn_mfma_f32_32x32x16_bf16(__builtin_bit_cast(bf16x8, pw[ks]), vf, o[d0], 0, 0, 0); }
        }
        p0 = n0; p1 = n1; skipC = skipN; maskC = maskN; selC = selN; t = tn; tn = tnn;
    }
#undef ATT_ISSUE_K
#undef ATT_ISSUE_V
#undef ATT_CLASS
#undef ATT_QK
    l = halves_sum(l);
    if (hi == 0) wsf[32 + r32] = l;
    asm volatile("s_waitcnt lgkmcnt(0)" ::: "memory");
    float rli[16];
#pragma unroll
    for (int gq = 0; gq < 4; ++gq) { const f32x4 f = *(const LAS f32x4*)(wsf + 32 + 8 * gq + 4 * hi); rli[4 * gq + 0] = 1.0f / f[0]; rli[4 * gq + 1] = 1.0f / f[1]; rli[4 * gq + 2] = 1.0f / f[2]; rli[4 * gq + 3] = 1.0f / f[3]; }
    if constexpr (MODE == 1) {
        GAS bf16_t* Ow = (GAS bf16_t*)(A.O + (rowbase + q0 + qrel0) * PITCH + hcol);
#pragma unroll
        for (int r = 0; r < 16; ++r)
#pragma unroll
            for (int d0 = 0; d0 < DVB; ++d0) Ow[(size_t)crow(r, hi) * PITCH + d0 * 32 + r32] = (bf16_t)(cvtpk(o[d0][r] * rli[r], 0.f) & 0xFFFFu);
    } else {
        ATT_BAR();
        LAS float* X = (LAS float*)lds + wq * 4096;
        if (comp == 1) {
#pragma unroll
            for (int d0 = 0; d0 < DVB; ++d0)
#pragma unroll
                for (int r = 0; r < 16; ++r) X[(d0 * 16 + r) * 64 + lane] = o[d0][r] * rli[r];
        }
        ATT_BAR();
        if (comp == 0) {
            float sg[DVB];
#pragma unroll
            for (int d0 = 0; d0 < DVB; ++d0) sg[d0] = ((const GAS float*)A.subln)[d0 * 32 + r32] * A.out_scale;
            GAS bf16_t* Ow = (GAS bf16_t*)(A.O + (rowbase + q0 + qrel0) * PITCH + hcol);
#pragma unroll
            for (int r = 0; r < 16; ++r) { float dv[DVB]; float ss = 0.f;
#pragma unroll
                for (int d0 = 0; d0 < DVB; ++d0) { dv[d0] = o[d0][r] * rli[r] - A.lam_full * X[(d0 * 16 + r) * 64 + lane]; ss += dv[d0] * dv[d0]; }
                ss += __shfl_xor(ss, 1); ss += __shfl_xor(ss, 2); ss += __shfl_xor(ss, 4); ss += __shfl_xor(ss, 8); ss += __shfl_xor(ss, 16);
                const float rs = 1.0f / sqrtf(ss * (1.0f / 128.0f) + 1e-5f);
#pragma unroll
                for (int d0 = 0; d0 < DVB; ++d0) Ow[(size_t)crow(r, hi) * PITCH + d0 * 32 + r32] = (bf16_t)(cvtpk(dv[d0] * rs * sg[d0], 0.f) & 0xFFFFu); }
        }
    }
#undef ATT_KBASE
#undef ATT_KBASE_
#undef ATT_ISSUE
}
#undef ATT_BAR
}

constexpr int NWAVES = 8;
#ifndef MK_PER_PHASE
#define MK_PER_PHASE 1
#endif
#ifndef MK_DEBUG
#define MK_DEBUG 1
#endif
constexpr int NLAYER = 4, PH_PER_LAYER = 8, NPHASE = 1 + NLAYER * PH_PER_LAYER;

constexpr size_t MiB = 1u << 20;
constexpr size_t WS_CTL = 0, CTL_ZERO_BYTES = 1 * MiB;
constexpr size_t WS_KMEAN = 1 * MiB;
constexpr size_t WS_LTOK = 2 * MiB, WS_LW = 3 * MiB;
constexpr size_t WS_DQKV = 5 * MiB;
constexpr size_t WS_DWO = WS_DQKV + 12 * MiB;
constexpr size_t WS_MQKV = WS_DWO + 4 * MiB;
constexpr size_t WS_MWO = WS_MQKV + 12 * MiB;
constexpr size_t WS_FGU = WS_MWO + 4 * MiB;
constexpr size_t WS_FD = WS_FGU + 22 * MiB;
constexpr size_t WS_MGU = WS_FD + 11 * MiB;
constexpr size_t WS_MD = WS_MGU + 112 * MiB;
constexpr size_t WS_XN = WS_MD + 56 * MiB;
constexpr size_t WS_Q = WS_XN + 64 * MiB, WS_K = WS_Q + 64 * MiB, WS_V = WS_K + 64 * MiB;
constexpr size_t WS_ACT = WS_Q;
constexpr size_t WS_END = WS_ACT + (size_t)MOE_TILES_MAX * 256 * DE * 2;
static_assert(WS_XN == 238 * MiB && WS_END == 778 * MiB, "d_ws map");
constexpr int CW_BAR = 4096;
constexpr int CW_ATTQ = 6144;
constexpr int CW_CNT = 8192;

constexpr int RING_OFF = 0, RING_BYTES = 131072;
constexpr int LDSCTL_OFF = RING_BYTES, MISC_OFF = LDSCTL_OFF + 320;
constexpr int XSLOT_OFF = MISC_OFF + 128;
constexpr int LDS_BYTES = 147456;

typedef unsigned short bf16;
typedef unsigned v4u __attribute__((ext_vector_type(4)));
typedef float f32x4 __attribute__((ext_vector_type(4)));
typedef GAS unsigned gu32;
#define RLX_AGENT __ATOMIC_RELAXED, __HIP_MEMORY_SCOPE_AGENT
#define LDS_WAIT() asm volatile("s_waitcnt lgkmcnt(0)" ::: "memory")
#define VM_WAIT() asm volatile("s_waitcnt vmcnt(0)" ::: "memory")
__device__ __forceinline__ unsigned f2bf(float f) { unsigned u = __builtin_bit_cast(unsigned, f); return (u + 0x7fffu + ((u >> 16) & 1u)) >> 16; }
__device__ __forceinline__ unsigned pk2(float lo, float hi) { return f2bf(lo) | (f2bf(hi) << 16); }
__device__ __forceinline__ float bflo(unsigned w) { return __uint_as_float(w << 16); }
__device__ __forceinline__ float bfhi(unsigned w) { return __uint_as_float(w & 0xFFFF0000u); }
static_assert(XSLOT_OFF % 16 == 0 && XSLOT_OFF + 8192 <= LDS_BYTES, "LDS map");
#define XB_TMO      128
#define XB_XCNT(j)  (256  + 64 * (j))
#define XB_XSUB(j)  (1280 + 64 * (j))
#define XB_XGEN(j)  (2304 + 64 * (j))
#define XB_TOP      3328
#define XB_TOPGEN   3392
#define XCD_BAR_WORDS 3456
#define XB_SPIN_CAP (1u << 18)

__device__ __forceinline__ unsigned xb_ld(unsigned* p)              { return __hip_atomic_load(p, __ATOMIC_RELAXED, __HIP_MEMORY_SCOPE_AGENT); }
__device__ __forceinline__ unsigned xb_add(unsigned* p, unsigned v) { return __hip_atomic_fetch_add(p, v, __ATOMIC_RELAXED, __HIP_MEMORY_SCOPE_AGENT); }
__device__ __forceinline__ unsigned xb_xcc_id() { return (unsigned)__builtin_amdgcn_s_getreg((3 << 11) | 20) & 0xFu; }
#define XB_SPIN(cond, bar) do { unsigned _sp = 0; while (cond) { __builtin_amdgcn_s_sleep(1); \
    if ((++_sp & 255u) == 0u) { if (xb_ld(&(bar)[XB_TMO])) break; if (_sp > XB_SPIN_CAP) { atomicAdd(&(bar)[XB_TMO], 1u); break; } } } } while (0)

struct XcdBarrier {
    unsigned* bar; unsigned x;
    volatile LAS unsigned* st;
};

__device__ __forceinline__ XcdBarrier xcd_barrier_post(unsigned* bar, volatile LAS unsigned* st) {
    XcdBarrier b; b.bar = bar; b.x = xb_xcc_id(); b.st = st;
    if (threadIdx.x == 0) (void)xb_add(&bar[XB_XCNT(b.x)], 1u);
    return b;
}
__device__ __forceinline__ void xcd_barrier_complete(unsigned* bar, unsigned x, unsigned& nloc, unsigned& nx) {
    const unsigned G = gridDim.x * gridDim.y * gridDim.z;
    unsigned sum, cnt, mine, sp = 0u;
    for (;;) {
        sum = 0u; cnt = 0u; mine = 0u;
#pragma unroll
        for (unsigned j = 0; j < 16; ++j) { const unsigned c = xb_ld(&bar[XB_XCNT(j)]); sum += c; cnt += (c > 0u) ? 1u : 0u; mine = (j == x) ? c : mine; }
        if (sum == G) break;
        __builtin_amdgcn_s_sleep(1);
        if ((++sp & 255u) == 0u) { if (xb_ld(&bar[XB_TMO])) break; if (sp > XB_SPIN_CAP) { atomicAdd(&bar[XB_TMO], 1u); break; } }
    }
    nloc = mine > 0u ? mine : 1u; nx = cnt > 0u ? cnt : 1u;
}

__device__ __forceinline__ void xcd_barrier(const XcdBarrier& b) {
    asm volatile("s_waitcnt vmcnt(0)" ::: "memory");
    __syncthreads();
    if (threadIdx.x == 0) {
        unsigned* bar = b.bar;
        __builtin_amdgcn_s_waitcnt(0);
        unsigned nloc = b.st[0], nx = b.st[1];
        if (nloc == 0u) { xcd_barrier_complete(bar, b.x, nloc, nx); b.st[0] = nloc; b.st[1] = nx; }
        const unsigned old = xb_add(&bar[XB_XSUB(b.x)], 1u);
        const unsigned gen = old / nloc;
        if (old + 1u == (gen + 1u) * nloc) {
            __builtin_amdgcn_fence(__ATOMIC_RELEASE, "agent");
            asm volatile("s_waitcnt vmcnt(0)" ::: "memory");
            const unsigned og = xb_add(&bar[XB_TOP], 1u);
            const unsigned tg = og / nx;
            if (og + 1u == (tg + 1u) * nx) xb_add(&bar[XB_TOPGEN], 1u);
            else XB_SPIN(xb_ld(&bar[XB_TOPGEN]) == tg, bar);
            __builtin_amdgcn_fence(__ATOMIC_ACQUIRE, "agent");
            xb_add(&bar[XB_XGEN(b.x)], 1u);
            asm volatile("s_waitcnt vmcnt(0)" ::: "memory");
        } else {
            XB_SPIN(xb_ld(&bar[XB_XGEN(b.x)]) == gen, bar);
            __builtin_amdgcn_fence(__ATOMIC_ACQUIRE, "agent");
            asm volatile("s_waitcnt vmcnt(0)" ::: "memory");
        }
    }
    __syncthreads();
}

struct Frame {
    LAS unsigned char* lds;
    volatile LAS unsigned* MISC;
    gu32* ctl;
    int tid, lane, wave;
    int vcu, G;
};
__device__ __forceinline__ float wave_sum(float v) {
#pragma unroll
    for (int o = 1; o < 64; o <<= 1) v += __shfl_xor(v, o);
    return v;
}
__device__ __forceinline__ void transpose_item(const float* W, int K, int N, void* WT, int k0, int n0, int drow0, LAS float* scr, int lane, bool f8, float wscale) {
    const GAS float* src = (const GAS float*)W + (size_t)k0 * N + n0 + lane;
#pragma unroll
    for (int hb = 0; hb < 2; ++hb) { float v[32];
#pragma unroll
        for (int i = 0; i < 32; ++i) v[i] = src[(size_t)(hb * 32 + i) * N];
#pragma unroll
        for (int i = 0; i < 32; ++i) { const int kk = hb * 32 + i; scr[kk * 64 + (lane ^ ((kk >> 3) << 3))] = v[i]; } }
    LDS_WAIT(); asm volatile("" ::: "memory");
    if (f8) {
        const int c = lane & 3;
#pragma unroll
        for (int j = 0; j < 4; ++j) { const int nn = (lane >> 2) + 16 * j; float v[16];
#pragma unroll
            for (int q = 0; q < 16; ++q) { const int kk = 16 * c + q; v[q] = scr[kk * 64 + (nn ^ ((kk >> 3) << 3))] * wscale; }
            v4u o; o.x = pg8::pk4_fp8(v[0], v[1], v[2], v[3]); o.y = pg8::pk4_fp8(v[4], v[5], v[6], v[7]); o.z = pg8::pk4_fp8(v[8], v[9], v[10], v[11]); o.w = pg8::pk4_fp8(v[12], v[13], v[14], v[15]);
            *(GAS v4u*)((unsigned char*)WT + (size_t)(drow0 + nn) * K + k0 + 16 * c) = o; }
    } else {
    const int c = lane & 7;
#pragma unroll
    for (int j = 0; j < 8; ++j) { const int n = (lane >> 3) + 8 * j; const LAS float* s = scr + (8 * c) * 64 + (n ^ (c << 3));
        v4u o; o.x = pk2(s[0 * 64], s[1 * 64]); o.y = pk2(s[2 * 64], s[3 * 64]); o.z = pk2(s[4 * 64], s[5 * 64]); o.w = pk2(s[6 * 64], s[7 * 64]);
        *(GAS v4u*)((bf16*)WT + (size_t)(drow0 + n) * K + k0 + 8 * c) = o; }
    }
    LDS_WAIT(); asm volatile("" ::: "memory");
}
__device__ __forceinline__ void convert_matrix(Frame& F, const float* W, int K, int N, void* WT, int il, unsigned& rot, bool f8 = false, float wscale = 1.0f) {
    LAS float* scr = (LAS float*)(F.lds + RING_OFF + F.wave * 16384);
    const unsigned gw = (unsigned)(F.vcu * NWAVES + F.wave), NGW = (unsigned)(F.G * NWAVES);
    const int nblk = N / 64, nitems = (K / 64) * nblk; int lane_ = F.lane; asm volatile("" : "+v"(lane_));
    for (int it = (int)((gw + NGW - rot % NGW) % NGW); it < nitems; it += (int)NGW) {
        const int kb = it / nblk, nb = it % nblk, n0 = 64 * nb;
        const int drow0 = il == 0 ? n0 : (n0 / 128) * 256 + (il - 1) * 128 + (n0 % 128);
        transpose_item(W, K, N, WT, 64 * kb, n0, drow0, scr, lane_, f8, wscale);
    }
    rot = (rot + (unsigned)nitems) % NGW;
}

struct RouterArgs { const float* router; gu32* cnt; unsigned* ltok; float* lw; };
template <int MODE, bool F8X = false>
__device__ __forceinline__ void norm_phase(Frame& F, const float* src, float* hout, const bf16* y1, const float* gain, bf16* xn, float* fout, const RouterArgs& R) {
    int lane_ = F.lane; asm volatile("" : "+v"(lane_));
    const int gw = F.vcu * NWAVES + F.wave, NGW = F.G * NWAVES, lane = lane_;
    f32x4 gv[4];
#pragma unroll
    for (int j = 0; j < 4; ++j) gv[j] = *(const GAS f32x4*)(gain + 256 * j + 4 * lane);
    LAS float* RL = (LAS float*)(F.lds + RING_OFF);
    if constexpr (MODE == 2) {
        int tid_ = F.tid; asm volatile("" : "+v"(tid_));
        for (int i = tid_; i < 8192; i += NWAVES * 64) RL[(i & 7) * 1024 + (i >> 3)] = ((const GAS float*)R.router)[i];
        LDS_WAIT(); __syncthreads();
    }
    const int nrows_w = gw < MTOK ? (MTOK - gw + NGW - 1) / NGW : 0;
    for (int cb = 0; cb < nrows_w; cb += 64) {
        int my_t = 0, my_e0 = 0, my_e1 = 0; float my_w0 = 0.f, my_w1 = 0.f; bool valid = false;
        const int cn = (nrows_w - cb) < 64 ? (nrows_w - cb) : 64;
        f32x4 vn[4]; unsigned long long yn[4];
        { const int row0_ = gw + cb * NGW; const GAS f32x4* xr = (const GAS f32x4*)(src + (size_t)row0_ * D) + lane;
#pragma unroll
          for (int j = 0; j < 4; ++j) vn[j] = xr[64 * j];
          if constexpr (MODE == 1 || MODE == 3) { const GAS unsigned long long* yr = (const GAS unsigned long long*)(y1 + (size_t)row0_ * D) + lane;
#pragma unroll
            for (int j = 0; j < 4; ++j) yn[j] = yr[64 * j]; } }
        for (int i = 0; i < cn; ++i) {
            const int row = gw + (cb + i) * NGW;
            f32x4 v[4]; float s = 0.f;
#pragma unroll
            for (int j = 0; j < 4; ++j) v[j] = vn[j];
            if constexpr (MODE == 1 || MODE == 3) {
#pragma unroll
                for (int j = 0; j < 4; ++j) { const unsigned long long w = yn[j]; const unsigned lo = (unsigned)w, hi = (unsigned)(w >> 32);
                    v[j].x += bflo(lo); v[j].y += bfhi(lo); v[j].z += bflo(hi); v[j].w += bfhi(hi); }
            }
            if (i + 1 < cn) { const int rown = row + NGW; const GAS f32x4* xr = (const GAS f32x4*)(src + (size_t)rown * D) + lane;
#pragma unroll
                for (int j = 0; j < 4; ++j) vn[j] = xr[64 * j];
                if constexpr (MODE == 1 || MODE == 3) { const GAS unsigned long long* yr = (const GAS unsigned long long*)(y1 + (size_t)rown * D) + lane;
#pragma unroll
                    for (int j = 0; j < 4; ++j) yn[j] = yr[64 * j]; } }
#pragma unroll
            for (int j = 0; j < 4; ++j) s += (v[j].x * v[j].x + v[j].y * v[j].y) + (v[j].z * v[j].z + v[j].w * v[j].w);
            if constexpr (MODE == 1) { GAS f32x4* hr = (GAS f32x4*)(hout + (size_t)row * D) + lane;
#pragma unroll
                for (int j = 0; j < 4; ++j) hr[64 * j] = v[j]; }
            const float rstd = 1.f / sqrtf(wave_sum(s) * (1.f / D) + 1e-6f);
#pragma unroll
            for (int j = 0; j < 4; ++j) v[j] = v[j] * rstd * gv[j];
            if constexpr (MODE == 3) { GAS f32x4* orow = (GAS f32x4*)(fout + (size_t)row * D) + lane;
#pragma unroll
                for (int j = 0; j < 4; ++j) orow[64 * j] = v[j];
            } else {
                if constexpr (F8X) { GAS unsigned* o4 = (GAS unsigned*)((unsigned char*)xn + (size_t)row * D) + lane;
#pragma unroll
                    for (int j = 0; j < 4; ++j) o4[64 * j] = pg8::pk4_fp8(v[j].x, v[j].y, v[j].z, v[j].w);
                } else { GAS unsigned long long* o8 = (GAS unsigned long long*)(xn + (size_t)row * D) + lane;
#pragma unroll
                    for (int j = 0; j < 4; ++j) o8[64 * j] = (unsigned long long)pk2(v[j].x, v[j].y) | ((unsigned long long)pk2(v[j].z, v[j].w) << 32); }
            }
            if constexpr (MODE == 2) {
                float lg[NE];
#pragma unroll
                for (int e = 0; e < NE; ++e) { float a = 0.f;
#pragma unroll
                    for (int j = 0; j < 4; ++j) { const f32x4 rr = *(const LAS f32x4*)(RL + e * 1024 + 256 * j + 4 * lane); a += (v[j].x * rr.x + v[j].y * rr.y) + (v[j].z * rr.z + v[j].w * rr.w); }
                    lg[e] = wave_sum(a); }
                int e0 = 0; float v0 = lg[0];
#pragma unroll
                for (int e = 1; e < NE; ++e) if (lg[e] > v0) { v0 = lg[e]; e0 = e; }
                int e1 = -1; float v1 = 0.f;
#pragma unroll
                for (int e = 0; e < NE; ++e) if (e != e0 && (e1 < 0 || lg[e] > v1)) { v1 = lg[e]; e1 = e; }
                const float w0 = 1.f / (1.f + __expf(v1 - v0));
                if (lane == i) { my_t = row; my_e0 = e0; my_e1 = e1; my_w0 = w0; my_w1 = 1.f - w0; valid = true; }
            }
        }
        if constexpr (MODE == 2) {
            unsigned myc = 0u;
#pragma unroll
            for (int e = 0; e < NE; ++e) { const unsigned long long b0 = __ballot(valid && my_e0 == e), b1 = __ballot(valid && my_e1 == e);
                const unsigned c = (unsigned)(__popcll(b0) + __popcll(b1)); if (lane == e) myc = c; }
            unsigned basev = 0u;
            if (lane < NE) basev = __hip_atomic_fetch_add(R.cnt + 64 * lane, myc, RLX_AGENT);
            const unsigned long long lt = (1ull << lane) - 1ull;
            unsigned pos0 = 0u, pos1 = 0u;
#pragma unroll
            for (int e = 0; e < NE; ++e) { const unsigned long long b0 = __ballot(valid && my_e0 == e), b1 = __ballot(valid && my_e1 == e);
                const unsigned be = (unsigned)__shfl((int)basev, e);
                if (my_e0 == e) pos0 = be + (unsigned)__popcll(b0 & lt);
                if (my_e1 == e) pos1 = be + (unsigned)__popcll(b0) + (unsigned)__popcll(b1 & lt); }
            if (valid) {
                ((GAS unsigned*)R.ltok)[(size_t)my_e0 * LIST_CAP + pos0] = (unsigned)my_t;             ((GAS float*)R.lw)[(size_t)my_e0 * LIST_CAP + pos0] = my_w0;
                ((GAS unsigned*)R.ltok)[(size_t)my_e1 * LIST_CAP + pos1] = (unsigned)my_t | (1u << 20); ((GAS float*)R.lw)[(size_t)my_e1 * LIST_CAP + pos1] = my_w1;
            }
        }
    }
    if constexpr (MODE == 2) { LDS_WAIT(); __syncthreads(); }
}

__device__ __forceinline__ void kstat_phase(Frame& F, const bf16* Kt, float* kmean, float* kmax2) {
    int lane_ = F.lane; asm volatile("" : "+v"(lane_));
    const int gw = F.vcu * NWAVES + F.wave, NGW = F.G * NWAVES, lane = lane_;
    for (int task = gw; task < BATCH * 16 * 8; task += NGW) {
        const int c8 = task & 7, n = (task >> 3) & 15, b = task >> 7;
        const GAS unsigned* p = (const GAS unsigned*)(Kt + ((size_t)b * SEQ + 256 * n) * D + c8 * 128) + lane;
        float a0 = 0.f, a1 = 0.f, mx = 0.f;
#pragma unroll 32
        for (int r = 0; r < 256; ++r) { const unsigned w = p[(size_t)r * (D / 2)]; const float v0 = bflo(w), v1 = bfhi(w); a0 += v0; a1 += v1;
            float s = v0 * v0 + v1 * v1; s += __shfl_xor(s, 1); s += __shfl_xor(s, 2); s += __shfl_xor(s, 4); s += __shfl_xor(s, 8); s += __shfl_xor(s, 16); mx = fmaxf(mx, s); }
        const int col = c8 * 128 + 2 * lane, hh = col >> 6, d = col & 63;
        GAS float* o = (GAS float*)(kmean + ((size_t)(b * 16 + hh) * 16 + n) * 64 + d);
        o[0] = a0 * (1.f / 256.f); o[1] = a1 * (1.f / 256.f);
        if ((lane & 31) == 0) ((GAS float*)kmax2)[(size_t)(b * 16 + hh) * 16 + n] = mx;
    }
}

struct KArgs { const float* in[17]; float* out; unsigned char* ws; int ph_lo, ph_hi; };
__global__ void __launch_bounds__(NWAVES * 64, 2) trunk_fwd(KArgs args) {
    extern __shared__ __attribute__((aligned(16))) unsigned char lds[];
    Frame F;
    F.lds = (LAS unsigned char*)lds;
    F.MISC = (volatile LAS unsigned*)(F.lds + MISC_OFF);
    F.tid = threadIdx.x; F.lane = F.tid & 63; F.wave = __builtin_amdgcn_readfirstlane(F.tid >> 6);
    F.G = gridDim.x; { const int bx = blockIdx.x; F.vcu = (F.G % 8 == 0) ? (bx % 8) * (F.G / 8) + bx / 8 : bx; }
    F.ctl = (gu32*)(args.ws + WS_CTL);
    for (int u = F.tid; u < (LDS_BYTES - LDSCTL_OFF) / 4; u += NWAVES * 64) ((LAS unsigned*)(F.lds + LDSCTL_OFF))[u] = 0u;
    __syncthreads();
    Frame& F0 = F;
    const int lo = args.ph_lo, hi = args.ph_hi;
    XcdBarrier bar; bar.bar = (unsigned*)(F.ctl + CW_BAR); bar.x = 0; bar.st = nullptr;
    if (hi - lo > 1) bar = xcd_barrier_post((unsigned*)(F.ctl + CW_BAR), F.MISC + 8);
#define IN(k) (lo <= (k) && (k) < hi)
#ifndef PH_ENABLE
#define PH_ENABLE 0xFFFFFFFFu
#endif
#define PHEN(n) (((PH_ENABLE) >> (n)) & 1u)
#ifndef MK_DOUBLE
#define MK_DOUBLE 0u
#endif
#define NREP(n) ((((MK_DOUBLE) >> (n)) & 1u) ? 2 : 1)
#if defined(NO_OPQ)
#define OPQ(p) do {} while (0)
#else
#define OPQ(p) asm volatile("" : "+s"(p))
#endif
#if 0
#define STAMP(k) do { if (blockIdx.x == 0 && threadIdx.x == 0) { const unsigned long long t_ = __builtin_amdgcn_s_memrealtime(); ((GAS unsigned*)(F0.ctl))[3000 + (k)] = (unsigned)t_; } } while (0)
#else
#define STAMP(k) do {} while (0)
#endif
#define SEAM(k) do { if (IN(k) && IN((k) + 1)) { XcdBarrier b2_ = bar; OPQ(b2_.bar); xcd_barrier(b2_); } STAMP((k) + 1); } while (0)

#define PTRS() unsigned char* ws = args.ws; OPQ(ws); const float* x = args.in[0]; OPQ(x); const float* norm_mix = args.in[1]; OPQ(norm_mix); const float* norm_ffn = args.in[2]; OPQ(norm_ffn); \
    float* h = args.out; OPQ(h); \
    bf16* XN = (bf16*)(ws + WS_XN); bf16* Qb = (bf16*)(ws + WS_Q); bf16* Kb = (bf16*)(ws + WS_K); bf16* Vb = (bf16*)(ws + WS_V); bf16* ACT = (bf16*)(ws + WS_ACT); \
    bf16* MGU = (bf16*)(ws + WS_MGU); bf16* MD = (bf16*)(ws + WS_MD); \
    float* kmean = (float*)(ws + WS_KMEAN); unsigned* ltok = (unsigned*)(ws + WS_LTOK); float* lw = (float*)(ws + WS_LW); \
    (void)x; (void)norm_mix; (void)norm_ffn; (void)h; (void)XN; (void)Qb; (void)Kb; (void)Vb; (void)ACT; (void)MGU; (void)MD; (void)kmean; (void)ltok; (void)lw
    const RouterArgs noR{nullptr, nullptr, nullptr, nullptr};
#ifndef MK_F8_DENSE
#define MK_F8_DENSE 0
#endif
    constexpr bool F8_DENSE = MK_F8_DENSE != 0; constexpr int DESZ = F8_DENSE ? 1 : 2;
    constexpr float WSC_UP = 32.0f, WSC_DN = 64.0f;
    constexpr float C2 = 0.125f * 1.4426950408889634f;

    STAMP(0);
    if (PHEN(0) && IN(0)) {
        PTRS();
        for (int rep_ = 0; rep_ < NREP(0); ++rep_) {
        unsigned rot = 0u;
        for (int j = 0; j < 2; ++j) {
            convert_matrix(F, args.in[3] + (size_t)j * D * 3 * D, D, 3 * D, (bf16*)(ws + WS_DQKV) + (size_t)j * 3 * D * D, 0, rot);
            convert_matrix(F, args.in[4] + (size_t)j * D * D, D, D, (bf16*)(ws + WS_DWO) + (size_t)j * D * D, 0, rot);
            convert_matrix(F, args.in[7] + (size_t)j * D * 3 * D, D, 3 * D, (bf16*)(ws + WS_MQKV) + (size_t)j * 3 * D * D, 0, rot);
            convert_matrix(F, args.in[8] + (size_t)j * D * D, D, D, (bf16*)(ws + WS_MWO) + (size_t)j * D * D, 0, rot);
            convert_matrix(F, args.in[9] + (size_t)j * D * DFF, D, DFF, ws + WS_FGU + (size_t)j * 2 * DFF * D * DESZ, 1, rot, F8_DENSE, F8_DENSE ? WSC_UP : 1.0f);
            convert_matrix(F, args.in[10] + (size_t)j * D * DFF, D, DFF, ws + WS_FGU + (size_t)j * 2 * DFF * D * DESZ, 2, rot, F8_DENSE, F8_DENSE ? WSC_UP : 1.0f);
            convert_matrix(F, args.in[11] + (size_t)j * DFF * D, DFF, D, ws + WS_FD + (size_t)j * D * DFF * DESZ, 0, rot, F8_DENSE, F8_DENSE ? WSC_DN : 1.0f);
        }
        for (int e = 0; e < 2 * NE; ++e) {
            convert_matrix(F, args.in[13] + (size_t)e * D * DE, D, DE, ws + WS_MGU + (size_t)e * 2 * DE * D, 1, rot, true, WSC_UP);
            convert_matrix(F, args.in[14] + (size_t)e * D * DE, D, DE, ws + WS_MGU + (size_t)e * 2 * DE * D, 2, rot, true, WSC_UP);
            convert_matrix(F, args.in[15] + (size_t)e * DE * D, DE, D, ws + WS_MD + (size_t)e * D * DE, 0, rot, true, WSC_DN);
        }
        norm_phase<0>(F, x, nullptr, nullptr, norm_mix, XN, nullptr, noR);
        }
    }
    SEAM(0);

    for (int L = 0; L < NLAYER; ++L) {
        const int j = L >> 1, moba = L & 1, pb = 1 + PH_PER_LAYER * L;
        int z_ = 0;
#if !defined(NO_OPQ_Z)
        asm volatile("" : "+s"(z_));
#endif
        Frame Fl = F0; Fl.G += z_; Fl.vcu += z_; Fl.wave += z_; Fl.lds += z_; Fl.ctl += z_; const int bx = (int)blockIdx.x + z_;
#define F Fl
        if (PHEN(1) && IN(pb + 0)) {
            PTRS();

            const bf16* W = (const bf16*)(ws + (moba ? WS_MQKV : WS_DQKV)) + (size_t)j * 3 * D * D;
            pg8::Gemm g{XN, W, 2 * D, 0}; pg8::StaticOrder S; S.init(MTOK, 3 * D, F.G, bx);
            pg8::EpiQKV E{Qb, D, D, (size_t)(WS_K - WS_Q) / 2, C2};
            for (int rep_ = 0; rep_ < NREP(1); ++rep_) pg8::gemm_phase<pg8::EpiQKV, pg8::StaticOrder>(F.lds + RING_OFF, XSLOT_OFF, g, S, E);
        }
        SEAM(pb + 0);
        { if (PHEN(2) && IN(pb + 1)) { PTRS(); kstat_phase(F, Kb, kmean, kmean + 8 * 16 * 16 * 64); } SEAM(pb + 1); }
        if (IN(pb + 2)) {
            PTRS();
            att::Args A; A.Q = Qb; A.K = Kb; A.V = Vb; A.O = XN; A.kmean = kmean; A.kmax2 = kmean + 8 * 16 * 16 * 64; A.subln = args.in[6] + (size_t)j * 128; A.lam_full = 0.f; A.out_scale = 1.f;
            gu32* qctr = F.ctl + CW_ATTQ + 64 * L; LAS int* qw = (LAS int*)(F.lds + RING_OFF + 71680 + 260);
            if (!moba) {
                const float* lam = args.in[5] + (size_t)j * 256; int lane = F.lane; asm volatile("" : "+v"(lane));
                const GAS float* lamg = (const GAS float*)lam; const float s1 = wave_sum(lamg[lane] * lamg[64 + lane]), s2 = wave_sum(lamg[128 + lane] * lamg[192 + lane]);
                const float lam_init = (L == 0) ? 0.2f : 0.47071302f;
                A.lam_full = __uint_as_float(__builtin_amdgcn_readfirstlane(__float_as_uint(__expf(s1) - __expf(s2) + lam_init))); A.out_scale = __uint_as_float(__builtin_amdgcn_readfirstlane(__float_as_uint(1.0f - lam_init)));
            }
            if ((PHEN(3) && !moba) || (PHEN(4) && moba)) for (;;) {
                if (F.tid == 0) *qw = (int)__hip_atomic_fetch_add(qctr, 1u, RLX_AGENT);
                asm volatile("s_waitcnt vmcnt(0) lgkmcnt(0)\n\ts_barrier" ::: "memory");
                const int idx = __builtin_amdgcn_readfirstlane(*qw);
                if (idx >= 1024) break;
                if (!moba) { const int hh = 7 - (idx >> 7), bb = (idx >> 4) & 7, pr = idx & 15;
                    att::attn_unit<0>(F.lds + RING_OFF, A, bb, hh, pr);
                    att::attn_unit<0>(F.lds + RING_OFF, A, bb, hh, 31 - pr);
                } else { const int hh = 15 - (idx >> 6), bb = (idx >> 3) & 7, pr = idx & 7;
                    att::attn_unit<1>(F.lds + RING_OFF, A, bb, hh, pr);
                    att::attn_unit<1>(F.lds + RING_OFF, A, bb, hh, 15 - pr); }
            }
            asm volatile("s_waitcnt vmcnt(0) lgkmcnt(0)\n\ts_barrier" ::: "memory");
        }
        SEAM(pb + 2);
        if (PHEN(5) && IN(pb + 3)) {
            PTRS();
            const bf16* W = (const bf16*)(ws + (moba ? WS_MWO : WS_DWO)) + (size_t)j * D * D;
            pg8::Gemm g{XN, W, 2 * D, 0}; pg8::StaticOrder S; S.init(MTOK, D, F.G, bx);
            pg8::EpiRes E{L == 0 ? x : h, h, D, 1.0f};
            pg8::gemm_phase<pg8::EpiRes, pg8::StaticOrder>(F.lds + RING_OFF, XSLOT_OFF, g, S, E);
        }
        SEAM(pb + 3);
        if (PHEN(6) && IN(pb + 4)) {
            PTRS();
            if (!moba) {
                norm_phase<0, F8_DENSE>(F, h, nullptr, nullptr, norm_ffn + (size_t)L * D, XN, nullptr, noR);
            } else {
                const RouterArgs R{args.in[12] + (size_t)j * D * NE, F.ctl + CW_CNT + 64 * NE * j, ltok, lw};
                norm_phase<2, true>(F, h, nullptr, nullptr, norm_ffn + (size_t)L * D, XN, nullptr, R);
            }
        }
        SEAM(pb + 4);
        if (IN(pb + 5)) {
            PTRS();
            if (PHEN(7) && !moba) {
                pg8::Gemm g{XN, ws + WS_FGU + (size_t)j * 2 * DFF * D * DESZ, D * DESZ, 0}; pg8::StaticOrder S; S.init(MTOK, 2 * DFF, F.G, bx);
                pg8::EpiSwiGLU<F8_DENSE> E{ACT, DFF, F8_DENSE ? 1.0f / WSC_UP : 1.0f};
                pg8::gemm_phase<pg8::EpiSwiGLU<F8_DENSE>, pg8::StaticOrder, F8_DENSE>(F.lds + RING_OFF, XSLOT_OFF, g, S, E);
            } else if (PHEN(8) && moba) {
                pg8::Gemm g{XN, ws + WS_MGU + (size_t)j * NE * 2 * DE * D, D, (size_t)2 * DE * D}; pg8::MoeOrder S; S.init((const unsigned*)(F.ctl + CW_CNT + 64 * NE * j), ltok, true, 2 * DE, F.G, bx);
                pg8::EpiSwiGLU<true> E{ACT, DE, 1.0f / WSC_UP};
                pg8::gemm_phase<pg8::EpiSwiGLU<true>, pg8::MoeOrder, true>(F.lds + RING_OFF, XSLOT_OFF, g, S, E);
            }
        }
        SEAM(pb + 5);
        if (IN(pb + 6)) {
            PTRS();
            if (PHEN(9) && !moba) {
                pg8::Gemm g{ACT, ws + WS_FD + (size_t)j * D * DFF * DESZ, DFF * DESZ, 0}; pg8::StaticOrder S; S.init(MTOK, D, F.G, bx);
                pg8::EpiRes E{h, h, D, F8_DENSE ? 1.0f / WSC_DN : 1.0f};
                pg8::gemm_phase<pg8::EpiRes, pg8::StaticOrder, F8_DENSE>(F.lds + RING_OFF, XSLOT_OFF, g, S, E);
            } else if (PHEN(10) && moba) {
                pg8::Gemm g{ACT, ws + WS_MD + (size_t)j * NE * D * DE, DE, (size_t)D * DE}; pg8::MoeOrder S; S.init((const unsigned*)(F.ctl + CW_CNT + 64 * NE * j), ltok, false, D, F.G, bx);
                pg8::EpiMoeDown E; E.h = h; E.y1 = XN; E.list_tok = ltok; E.list_w = lw; E.sc = 1.0f / WSC_DN;
#pragma unroll
                for (int e = 0; e < NE; ++e) E.cnt[e] = S.cnt[e];
                pg8::gemm_phase<pg8::EpiMoeDown, pg8::MoeOrder, true>(F.lds + RING_OFF, XSLOT_OFF, g, S, E);
            }
        }
        SEAM(pb + 6);
        if (PHEN(11) && IN(pb + 7)) {
            PTRS();
            if (L == 3) norm_phase<3>(F, h, nullptr, XN, args.in[16], nullptr, h, noR);
            else if (moba) norm_phase<1>(F, h, h, XN, norm_mix + (size_t)(L + 1) * D, XN, nullptr, noR);
            else for (int rep_ = 0; rep_ < NREP(11); ++rep_) norm_phase<0>(F, h, nullptr, nullptr, norm_mix + (size_t)(L + 1) * D, XN, nullptr, noR);
        }
        if (L != NLAYER - 1) SEAM(pb + 7); else STAMP(pb + 8);
#undef F
    }
#undef IN
#undef SEAM
#undef PTRS
#undef OPQ
}


#if MK_DEBUG
__global__ void dbg_probe(const void* buf, size_t n, int is_bf16, int idx, float thresh, unsigned* dbg) {
    size_t i = blockIdx.x * (size_t)blockDim.x + threadIdx.x, stride = (size_t)gridDim.x * blockDim.x; bool bad = false;
    for (size_t k = i; k < n; k += stride) { float v = is_bf16 ? __uint_as_float(((unsigned)((const unsigned short*)buf)[k]) << 16) : ((const float*)buf)[k]; if (!(fabsf(v) <= thresh)) bad = true; }
    if (bad) atomicMax(dbg, (unsigned)(1000 - idx));
}
__global__ void dbg_cnt(const unsigned* cntw, int idx, unsigned* dbg) {
    if (threadIdx.x == 0 && blockIdx.x == 0) { unsigned s = 0; for (int e = 0; e < NE; ++e) s += cntw[64 * e]; if (s != 2u * MTOK) atomicMax(dbg, (unsigned)(1000 - idx)); }
}

__device__ __forceinline__ float dbg_bf(unsigned short v) { return __uint_as_float(((unsigned)v) << 16); }
__device__ __forceinline__ unsigned dbg_hash(unsigned x) { x ^= x >> 16; x *= 0x7feb352dU; x ^= x >> 15; x *= 0x846ca68bU; x ^= x >> 16; return x; }
__global__ void dbg_gemm_check(const unsigned short* A, int lda, const unsigned short* Bt, int K, const unsigned short* out, int ldo, int M, int N, float scale, int idx, unsigned* dbg) {
    const unsigned s = blockIdx.x * blockDim.x + threadIdx.x; const int row = (int)(dbg_hash(2 * s + 1) % (unsigned)M), col = (int)(dbg_hash(2 * s + 2) % (unsigned)N);
    float acc = 0.f; for (int k = 0; k < K; ++k) acc += dbg_bf(A[(size_t)row * lda + k]) * dbg_bf(Bt[(size_t)col * K + k]);
    acc *= scale; const float got = dbg_bf(out[(size_t)row * ldo + col]);
    if (!(fabsf(got - acc) <= 0.03f + 0.02f * fabsf(acc))) { atomicMax(dbg, (unsigned)(1000 - idx)); atomicAdd(dbg + 64 + idx, 1u); }
}
__global__ void dbg_conv_check(const float* W, int K, int N, const unsigned short* WT, int il, int idx, unsigned* dbg) {
    const unsigned s = blockIdx.x * blockDim.x + threadIdx.x; const int k = (int)(dbg_hash(2 * s + 1) % (unsigned)K), n = (int)(dbg_hash(2 * s + 2) % (unsigned)N);
    const int dr = il == 0 ? n : (n / 128) * 256 + (il - 1) * 128 + (n % 128);
    const float w = W[(size_t)k * N + n], g = dbg_bf(WT[(size_t)dr * K + k]);
    if (!(fabsf(g - w) <= 0.01f * fabsf(w) + 1e-6f)) atomicMax(dbg, (unsigned)(1000 - idx));
}
__global__ void dbg_norm_check(const float* src, const float* gain, const unsigned short* xn, int idx, unsigned* dbg) {
    const unsigned s = blockIdx.x * blockDim.x + threadIdx.x; const int row = (int)(dbg_hash(s + 77) % (unsigned)MTOK);
    float ss = 0.f; for (int c = 0; c < D; ++c) { const float v = src[(size_t)row * D + c]; ss += v * v; }
    const float rstd = 1.f / sqrtf(ss / D + 1e-6f); bool bad = false;
    for (int c = 0; c < D; ++c) { const float r = src[(size_t)row * D + c] * rstd * gain[c], g = dbg_bf(xn[(size_t)row * D + c]); if (!(fabsf(g - r) <= 0.02f + 0.01f * fabsf(r))) bad = true; }
    if (bad) atomicMax(dbg, (unsigned)(1000 - idx));
}
__global__ void dbg_naive_gemm(const unsigned short* A, const unsigned short* Bt, unsigned short* out, int M, int N, int K) {
    const size_t i = blockIdx.x * (size_t)blockDim.x + threadIdx.x; if (i >= (size_t)M * N) return; const int row = (int)(i / N), col = (int)(i % N);
    float acc = 0.f; for (int k = 0; k < K; ++k) acc += dbg_bf(A[(size_t)row * K + k]) * dbg_bf(Bt[(size_t)col * K + k]);
    out[(size_t)row * N + col] = (unsigned short)f2bf(acc);
}
__global__ void dbg_find_col(const unsigned short* out, const unsigned short* ref, int M, int N, unsigned* hist) {
    const unsigned s = blockIdx.x * blockDim.x + threadIdx.x; const int row = (int)(dbg_hash(2 * s + 1) % (unsigned)M), col = (int)(dbg_hash(2 * s + 2) % (unsigned)N);
    const unsigned short v = out[(size_t)row * N + col]; int found = -1;
#if MK_FIND_PATTERN
    if (v == 0x3C3C) atomicAdd(hist + N, 1u); else atomicAdd(hist + 5, 1u); return;
#endif
#if MK_FIND_ROWS
    for (int r = 0; r < M; ++r) if (ref[(size_t)r * N + col] == v) { found = r; break; }
    if (found < 0) atomicAdd(hist + N, 1u); else atomicAdd(hist + ((found - row) & (N - 1)), 1u);
#else
    for (int c = 0; c < N; ++c) if (ref[(size_t)row * N + c] == v) { found = c; break; }
    if (found < 0) atomicAdd(hist + N, 1u); else atomicAdd(hist + ((found - col) & (N - 1)), 1u);
#endif
}
__global__ void dbg_hist_code(const unsigned* hist, int N, unsigned* dbg) {
    if (threadIdx.x || blockIdx.x) return; unsigned best = 0, bi = 0; for (int i = 0; i < N; ++i) if (hist[i] > best) { best = hist[i]; bi = i; }
    dbg[32] = bi; dbg[33] = best; dbg[34] = hist[N];
}
__global__ void dbg_final(float* out, size_t n, const unsigned* dbg) {
    if (MK_HIST_SEL >= 10) { const float c3 = sqrtf((float)dbg[MK_HIST_SEL + 30]); size_t i3 = blockIdx.x * (size_t)blockDim.x + threadIdx.x, st3 = (size_t)gridDim.x * blockDim.x; for (size_t k3 = i3; k3 < n; k3 += st3) out[k3] = c3; return; }
    if (MK_HIST_SEL >= 0 && (dbg[33] || dbg[34])) { const float c2 = sqrtf((float)(MK_HIST_SEL == 0 ? dbg[32] : (MK_HIST_SEL == 1 ? dbg[33] * 100u / 4096u : dbg[34] * 100u / 4096u)) + 1.f); size_t i2 = blockIdx.x * (size_t)blockDim.x + threadIdx.x, st2 = (size_t)gridDim.x * blockDim.x; for (size_t k2 = i2; k2 < n; k2 += st2) out[k2] = c2; return; }
    const unsigned d = dbg[0]; if (d == 0u) return; const unsigned nf = dbg[64 + (1000u - d)]; const float c = sqrtf(nf ? (float)(200u * (1000u - d - 9u) + nf * 100u / 4096u) : (float)(1000u - d));
    size_t i = blockIdx.x * (size_t)blockDim.x + threadIdx.x, stride = (size_t)gridDim.x * blockDim.x;
    for (size_t k = i; k < n; k += stride) out[k] = c;
}
#endif

#ifndef MK_REPEAT
#define MK_REPEAT 1
#endif
#ifndef MK_FIND_ROWS
#define MK_FIND_ROWS 0
#endif
#ifndef MK_FIND_REGION
#define MK_FIND_REGION WS_K
#endif
#ifndef MK_HIST_SEL
#define MK_HIST_SEL 0
#endif
#ifndef MK_STAMP
#define MK_STAMP 0
#endif
#if MK_STAMP
__global__ void stamp_k(unsigned* p) { if (threadIdx.x == 0) *p = (unsigned)__builtin_amdgcn_s_memrealtime(); }
__global__ void stamp_encode(float* out, size_t n, const unsigned* st, int pa, float ua, int pb, float ub) {
    const float da = (float)(st[pa + 1] - st[pa]) * 0.01f, db = (float)(st[pb + 1] - st[pb]) * 0.01f;
    float m = da / ua; m = m < 10.f ? 10.f : (m > 99.f ? 99.f : m); float e = floorf(db / ub + 0.5f); e = e < 0.f ? 0.f : (e > 30.f ? 30.f : e);
    const float c = sqrtf(m) * __powf(10.f, 0.5f * e);
    size_t i = blockIdx.x * (size_t)blockDim.x + threadIdx.x, stride = (size_t)gridDim.x * blockDim.x;
    for (size_t k = i; k < n; k += stride) out[k] = c;
}
#endif
extern "C" void kernel_launch(void* const* d_in, const int* in_sizes, int n_in, void* d_out, int out_size, void* d_ws, size_t ws_size, hipStream_t stream) {
    static int grid = 0;
    if (grid == 0) {
        if (n_in != 17 || in_sizes[0] != MTOK * D || out_size != MTOK * D || ws_size < WS_END) {
            fprintf(stderr, "kernel_launch: built for 17 inputs, x/out of %d floats, >= %zu bytes of workspace; got n_in %d, in0 %d, out %d, ws %zu; nothing launched\n", MTOK * D, (size_t)WS_END, n_in, n_in > 0 ? in_sizes[0] : -1, out_size, ws_size);
            grid = -1; return; }
        int dev = 0, cus = 0, per_cu = 0;
        if (hipGetDevice(&dev) != hipSuccess || hipDeviceGetAttribute(&cus, hipDeviceAttributeMultiprocessorCount, dev) != hipSuccess) { fprintf(stderr, "kernel_launch: device query failed\n"); grid = -1; return; }
        if (hipFuncSetAttribute((const void*)trunk_fwd, hipFuncAttributeMaxDynamicSharedMemorySize, LDS_BYTES) != hipSuccess) { fprintf(stderr, "kernel_launch: hipFuncSetAttribute failed\n"); grid = -1; return; }
        if (hipOccupancyMaxActiveBlocksPerMultiprocessor(&per_cu, (const void*)trunk_fwd, NWAVES * 64, LDS_BYTES) != hipSuccess || per_cu < 1)
            fprintf(stderr, "kernel_launch: note: occupancy query reports %d workgroups per CU\n", per_cu);
        (void)hipGetLastError();
        grid = cus;
    }
    if (grid < 0) return;
    if (hipMemsetAsync((char*)d_ws + WS_CTL, 0, CTL_ZERO_BYTES, stream) != hipSuccess) { fprintf(stderr, "kernel_launch: memset failed\n"); return; }
    KArgs a{};
    for (int i = 0; i < 17; ++i) a.in[i] = (const float*)d_in[i];
    a.out = (float*)d_out; a.ws = (unsigned char*)d_ws;
#if MK_PER_PHASE
#if MK_STAMP
    hipLaunchKernelGGL(stamp_k, dim3(1), dim3(64), 0, stream, (unsigned*)d_ws + 3000);
#endif
    for (int p = 0; p < NPHASE; ++p) {
        a.ph_lo = p; a.ph_hi = p + 1;
#if MK_DEBUG
#endif
#if !defined(MK_SKIP_MAIN)
        for (int rep_ = 0; rep_ < (p == 1 ? MK_REPEAT : 1); ++rep_) hipLaunchKernelGGL(trunk_fwd, dim3(grid), dim3(NWAVES * 64), LDS_BYTES, stream, a);
#endif
#if MK_STAMP
        hipLaunchKernelGGL(stamp_k, dim3(1), dim3(64), 0, stream, (unsigned*)d_ws + 3000 + p + 1);
#endif
#if MK_DEBUG
        {   unsigned char* ws = (unsigned char*)d_ws; unsigned* dbg = (unsigned*)(ws + WS_CTL) + 2048;
            const size_t MD_ = (size_t)MTOK * D;
#define PROBE(buf, n, isbf, idx, th) if ((idx) <= MK_PROBE_MAX) hipLaunchKernelGGL(dbg_probe, dim3(2048), dim3(256), 0, stream, (const void*)(buf), (size_t)(n), isbf, idx, th, dbg)
            if (p == 0) {
                hipLaunchKernelGGL(dbg_norm_check, dim3(4), dim3(64), 0, stream, (const float*)d_in[0], (const float*)d_in[1], (const unsigned short*)(ws + WS_XN), 4, dbg);
                hipLaunchKernelGGL(dbg_conv_check, dim3(16), dim3(256), 0, stream, (const float*)d_in[3], D, 3 * D, (const unsigned short*)(ws + WS_DQKV), 0, 5, dbg);
                hipLaunchKernelGGL(dbg_conv_check, dim3(16), dim3(256), 0, stream, (const float*)d_in[9], D, DFF, (const unsigned short*)(ws + WS_FGU), 1, 6, dbg);
                hipLaunchKernelGGL(dbg_conv_check, dim3(16), dim3(256), 0, stream, (const float*)d_in[10], D, DFF, (const unsigned short*)(ws + WS_FGU), 2, 7, dbg);
                hipLaunchKernelGGL(dbg_conv_check, dim3(16), dim3(256), 0, stream, (const float*)d_in[11], DFF, D, (const unsigned short*)(ws + WS_FD), 0, 8, dbg);
                hipLaunchKernelGGL(dbg_conv_check, dim3(16), dim3(256), 0, stream, (const float*)d_in[15] + (size_t)3 * DE * D, DE, D, (const unsigned short*)(ws + WS_MD) + (size_t)3 * D * DE, 0, 9, dbg);
            }
            if (p == 1) {
                const float C2h = 0.125f * 1.4426950408889634f;
                hipLaunchKernelGGL(dbg_gemm_check, dim3(16), dim3(256), 0, stream, (const unsigned short*)(ws + WS_XN), D, (const unsigned short*)(ws + WS_DQKV), D, (const unsigned short*)(ws + WS_Q), D, MTOK, D, C2h, 10, dbg);
                hipLaunchKernelGGL(dbg_gemm_check, dim3(16), dim3(256), 0, stream, (const unsigned short*)(ws + WS_XN), D, (const unsigned short*)(ws + WS_DQKV) + (size_t)D * D, D, (const unsigned short*)(ws + WS_K), D, MTOK, D, 1.f, 11, dbg);

                hipLaunchKernelGGL(dbg_gemm_check, dim3(16), dim3(256), 0, stream, (const unsigned short*)(ws + WS_XN), D, (const unsigned short*)(ws + WS_DQKV) + (size_t)2 * D * D, D, (const unsigned short*)(ws + WS_V), D, MTOK, D, 1.f, 12, dbg);
            }
            if (0) { PROBE(ws + WS_XN, MD_, 1, 1, 10.f); PROBE(ws + WS_DQKV, (WS_MGU - WS_DQKV) / 2, 1, 2, 1.f); PROBE(ws + WS_MGU, (WS_XN - WS_MGU) / 2, 1, 3, 1.f); }
            if (p >= 1) { const int L = (p - 1) / PH_PER_LAYER, k = (p - 1) % PH_PER_LAYER; const int b = 20 + 10 * L;
                if (k == 0) PROBE(ws + WS_Q, 3 * MD_, 1, b + 0, 50.f);
                if (k == 1) PROBE(ws + WS_KMEAN, 8 * 16 * 16 * 64, 0, b + 1, 5.f);
                if (k == 2) PROBE(ws + WS_XN, MD_, 1, b + 2, 50.f);
                if (k == 3) PROBE(d_out, MD_, 0, b + 3, 300.f);
                if (k == 4) { PROBE(ws + WS_XN, MD_, 1, b + 4, 20.f); if ((L & 1) && (b + 9) <= MK_PROBE_MAX) hipLaunchKernelGGL(dbg_cnt, dim3(1), dim3(64), 0, stream, (const unsigned*)(ws + WS_CTL) + CW_CNT + 64 * NE * (L >> 1), b + 9, dbg); }
                if (k == 5) PROBE(ws + WS_ACT, (L & 1) ? (size_t)256 * 256 * DE : (size_t)MTOK * DFF, 1, b + 5, 2000.f);
                if (k == 6) { PROBE(d_out, MD_, 0, b + 6, 1000.f); if (L & 1) PROBE(ws + WS_XN, MD_, 1, b + 7, 1000.f); }
                if (k == 7 && L != 3) { PROBE(ws + WS_XN, MD_, 1, b + 8, 20.f); PROBE(d_out, MD_, 0, b + 8, 1000.f); }
            }
#undef PROBE
        }
#endif
    }
#if MK_DEBUG
    hipLaunchKernelGGL(dbg_final, dim3(2048), dim3(256), 0, stream, (float*)d_out, (size_t)MTOK * D, (const unsigned*)((unsigned char*)d_ws + WS_CTL) + 2048);
#endif
#else
    a.ph_lo = 0; a.ph_hi = NPHASE;
    hipLaunchKernelGGL(trunk_fwd, dim3(grid), dim3(NWAVES * 64), LDS_BYTES, stream, a);
#if 0
    hipLaunchKernelGGL(stamp_encode, dim3(2048), dim3(256), 0, stream, (float*)d_out, (size_t)MTOK * D, (const unsigned*)d_ws + 3000, MK_STAMP_PA, MK_STAMP_UA, MK_STAMP_PB, MK_STAMP_UB);
#endif
#endif
#if MK_STAMP
    hipLaunchKernelGGL(stamp_encode, dim3(2048), dim3(256), 0, stream, (float*)d_out, (size_t)MTOK * D, (const unsigned*)d_ws + 3000, MK_STAMP_PA, MK_STAMP_UA, MK_STAMP_PB, MK_STAMP_UB);
#endif
    const hipError_t le = hipPeekAtLastError();
    if (le != hipSuccess) fprintf(stderr, "kernel_launch: launch failed: %s\n", hipGetErrorName(le));
}
```

```cpp
#define MK_DEBUG 0
#define MK_PER_PHASE 0
#define MK_DOUBLE 0x0u
#include <hip/hip_runtime.h>
#include <cstdio>
#include <cstdint>

#ifndef MK_DEBUG
#define MK_DEBUG 1
#endif
#ifndef MK_KDEBUG
#define MK_KDEBUG 0
#endif
#define LAS __attribute__((address_space(3)))
#define GAS __attribute__((address_space(1)))

constexpr int BATCH = 8, SEQ = 4096, MTOK = BATCH * SEQ, D = 1024, DFF = 2816, DE = 3584, NE = 8;
constexpr int MOE_TILES_MAX = 272;
constexpr int LIST_CAP = MTOK;

namespace pg8 {
#define PG8_LAS __attribute__((address_space(3)))
typedef unsigned short bf16_t;
typedef short bf16x8 __attribute__((ext_vector_type(8)));
typedef float f32x4 __attribute__((ext_vector_type(4)));
typedef unsigned u32x4 __attribute__((ext_vector_type(4)));
typedef int i32x4 __attribute__((ext_vector_type(4)));
typedef int i32x8 __attribute__((ext_vector_type(8)));
constexpr int BM = 256, BK = 64, HALF = 128, HTB = HALF * BK * 2  , STAGE_BYTES = 8 * HTB, NXCD = 8, WGM = 8;

__host__ __device__ __forceinline__ int lds_byte(int r, int c) { const int st = (r >> 4) * 2 + (c >> 5), rr = r & 15, cc = c & 31, ob = rr * 64 + cc * 2; return st * 1024 + (ob ^ (((ob >> 9) & 1) << 5)); }
__host__ __device__ __forceinline__ void stage_rc(int b, int& R, int& C) { const int st = b / 1024, sb = b % 1024, swz = sb ^ (((sb >> 9) & 1) << 5); R = (st >> 1) * 16 + swz / 64; C = (st & 1) * 32 + (swz % 64) / 2; }
__host__ __device__ __forceinline__ int perm32(int rho) { const int n = rho >> 4, i = rho & 15; return 8 * (i >> 2) + 4 * n + (i & 3); }

struct Unit { int pm, pn, e, r0; };
struct Gemm { const void* A; const void* Bt; int rowb; size_t bstride; };

__device__ __forceinline__ void tile_of(int L, int nM, int nN, int& pm, int& pn) {
    const int nwg = nM * nN; int wgid = L; { const int q = nwg / NXCD, r = nwg % NXCD, xcd = wgid % NXCD, off = wgid / NXCD; wgid = (xcd < r ? xcd * (q + 1) : r * (q + 1) + (xcd - r) * q) + off; }
    const int nig = WGM * nN, gid = wgid / nig, fm = gid * WGM, gsz = (nM - fm) < WGM ? (nM - fm) : WGM;
    pm = fm + ((wgid % nig) % gsz); pn = (wgid % nig) / gsz;
}
struct StaticOrder {
    int nM, nN, nwg, G, c;
    __device__ __forceinline__ void init(int M, int N, int G_, int c_) { nM = M / BM; nN = N / BM; nwg = nM * nN; G = G_; c = c_; }
    __device__ __forceinline__ bool next(int i, Unit& u) const {
        const long L = (long)i * G + c; if (L >= nwg) return false;
        tile_of((int)L, nM, nN, u.pm, u.pn); u.e = 0; u.r0 = 0; return true;
    }
    __device__ __forceinline__ unsigned arow(const Unit& u, int lr) const { return (unsigned)(u.pm * BM + lr); }
};
struct MoeOrder {
    int nM, nN, nwg, G, c; int tstart[NE + 1]; int cnt[NE]; const unsigned* list_tok; bool gather;
    __device__ __forceinline__ void init(const unsigned* cntw, const unsigned* list_tok_, bool gather_, int N, int G_, int c_) {
        int acc = 0;
#pragma unroll
        for (int e = 0; e < NE; ++e) { const int ce = (int)__builtin_amdgcn_readfirstlane((int)__hip_atomic_load((const GAS unsigned*)cntw + 64 * e, __ATOMIC_RELAXED, __HIP_MEMORY_SCOPE_AGENT)); cnt[e] = ce; tstart[e] = acc; acc += (ce + BM - 1) / BM; }
        tstart[NE] = acc; nM = acc; nN = N / BM; nwg = nM * nN; G = G_; c = c_; list_tok = list_tok_; gather = gather_;
    }
    __device__ __forceinline__ bool next(int i, Unit& u) const {
        const long L = (long)i * G + c; if (L >= nwg) return false;
        tile_of((int)L, nM, nN, u.pm, u.pn); int e = 0;
#pragma unroll
        for (int k = 1; k < NE; ++k) e += (u.pm >= tstart[k]) ? 1 : 0;
        u.e = e; int ts = 0;
#pragma unroll
        for (int k = 0; k < NE; ++k) ts = (k == e) ? tstart[k] : ts;
        u.r0 = (u.pm - ts) * BM; return true;
    }
    __device__ __forceinline__ int count_of(int e) const { int cv = 0;
#pragma unroll
        for (int k = 0; k < NE; ++k) cv = (k == e) ? cnt[k] : cv;
        return cv; }
    __device__ __forceinline__ unsigned arow(const Unit& u, int lr) const {
        if (!gather) return (unsigned)(u.pm * BM + lr);
        const int l = u.r0 + lr; const int cv = count_of(u.e);
        unsigned t = 0u; if (l < cv) t = __hip_atomic_load((const GAS unsigned*)list_tok + (size_t)u.e * LIST_CAP + l, __ATOMIC_RELAXED, __HIP_MEMORY_SCOPE_AGENT) & 0xFFFFFu;
        return t;
    }
};

__device__ __forceinline__ unsigned cvt_pk_bf16(float lo, float hi) { unsigned r; asm volatile("v_cvt_pk_bf16_f32 %0, %1, %2" : "=v"(r) : "v"(lo), "v"(hi)); return r; }

struct EpiQKV {
    static constexpr bool PERM = true;
    bf16_t* O; int ldc; int split_cols; size_t split_stride; float scale0;
    __device__ __forceinline__ void operator()(const f32x4 (&acc)[2][2][4][2], const Unit& u, int wr, int wc, int fr, int fq) const {
        const int row0 = u.pm * BM + wr * 64 + fr; int colt = u.pn * BM; bf16_t* base = O;
        float sc = 1.f; { const int t = colt / split_cols; base += (size_t)t * split_stride; colt -= t * split_cols; if (t == 0) sc = scale0; }
        const int col0 = colt + wc * 32 + 8 * fq;
#pragma unroll
        for (int ai = 0; ai < 2; ++ai)
#pragma unroll
            for (int m = 0; m < 4; ++m) { bf16_t* rowp = base + (size_t)(row0 + ai * HALF + m * 16) * ldc + col0;
#pragma unroll
                for (int bj = 0; bj < 2; ++bj) { f32x4 v0 = acc[ai][bj][m][0] * sc, v1 = acc[ai][bj][m][1] * sc;
                    u32x4 w; w.x = cvt_pk_bf16(v0[0], v0[1]); w.y = cvt_pk_bf16(v0[2], v0[3]); w.z = cvt_pk_bf16(v1[0], v1[1]); w.w = cvt_pk_bf16(v1[2], v1[3]);
                    *(GAS u32x4*)(rowp + bj * HALF) = w;
                    } }
    }
};
__device__ __forceinline__ unsigned pk4_fp8(float a, float b, float c, float d) { unsigned w = 0; w = __builtin_amdgcn_cvt_pk_fp8_f32(a, b, w, false); w = __builtin_amdgcn_cvt_pk_fp8_f32(c, d, w, true); return w; }
template <bool F8OUT> struct EpiSwiGLU {
    static constexpr bool PERM = true;
    void* O; int ldc; float sc;
    __device__ __forceinline__ void operator()(const f32x4 (&acc)[2][2][4][2], const Unit& u, int wr, int wc, int fr, int fq) const {
        const int row0 = u.pm * BM + wr * 64 + fr; const int col0 = u.pn * HALF + wc * 32 + 8 * fq;
#pragma unroll
        for (int ai = 0; ai < 2; ++ai)
#pragma unroll
            for (int m = 0; m < 4; ++m) { float o[8];
#pragma unroll
                for (int n = 0; n < 2; ++n)
#pragma unroll
                    for (int j = 0; j < 4; ++j) { const float g = acc[ai][0][m][n][j] * sc, up = acc[ai][1][m][n][j] * sc;
                        const float s = __builtin_amdgcn_rcpf(1.0f + __builtin_amdgcn_exp2f(-1.4426950408889634f * g)); o[n * 4 + j] = g * s * up; }
                const size_t eo = (size_t)(row0 + ai * HALF + m * 16) * ldc + col0;
                if constexpr (F8OUT) { const unsigned long long w = (unsigned long long)pk4_fp8(o[0], o[1], o[2], o[3]) | ((unsigned long long)pk4_fp8(o[4], o[5], o[6], o[7]) << 32);
                    *(GAS unsigned long long*)((unsigned char*)O + eo) = w;
                } else { u32x4 w; w.x = cvt_pk_bf16(o[0], o[1]); w.y = cvt_pk_bf16(o[2], o[3]); w.z = cvt_pk_bf16(o[4], o[5]); w.w = cvt_pk_bf16(o[6], o[7]);
                    *(GAS u32x4*)((bf16_t*)O + eo) = w; } }
    }
};
struct EpiRes {
    static constexpr bool PERM = false;
    const float* res; float* out; int ldc; float sc;
    __device__ __forceinline__ void operator()(const f32x4 (&acc)[2][2][4][2], const Unit& u, int wr, int wc, int fr, int fq) const {
        const int row0 = u.pm * BM + wr * 64 + fr; const int col0 = u.pn * BM + wc * 32 + 4 * fq;
#pragma unroll
        for (int ai = 0; ai < 2; ++ai)
#pragma unroll
            for (int m = 0; m < 4; ++m) { const size_t off = (size_t)(row0 + ai * HALF + m * 16) * ldc + col0;
#pragma unroll
                for (int bj = 0; bj < 2; ++bj)
#pragma unroll
                    for (int n = 0; n < 2; ++n) { const f32x4 r = *(const GAS f32x4*)(res + off + bj * HALF + n * 16); *(GAS f32x4*)(out + off + bj * HALF + n * 16) = r + acc[ai][bj][m][n] * sc; } }
    }
};
struct EpiMoeDown {
    static constexpr bool PERM = false;
    float* h; bf16_t* y1; const unsigned* list_tok; const float* list_w; int cnt[NE]; float sc;
    __device__ __forceinline__ void operator()(const f32x4 (&acc)[2][2][4][2], const Unit& u, int wr, int wc, int fr, int fq) const {
        int cv = 0;
#pragma unroll
        for (int k = 0; k < NE; ++k) cv = (k == u.e) ? cnt[k] : cv;
        const int col0 = u.pn * BM + wc * 32 + 4 * fq;
#pragma unroll
        for (int ai = 0; ai < 2; ++ai)
#pragma unroll
            for (int m = 0; m < 4; ++m) { const int l = u.r0 + ai * HALF + wr * 64 + m * 16 + fr;
                if (l < cv) {
                    const unsigned ent = __hip_atomic_load((const GAS unsigned*)list_tok + (size_t)u.e * LIST_CAP + l, __ATOMIC_RELAXED, __HIP_MEMORY_SCOPE_AGENT);
                    const float w = sc * __uint_as_float(__hip_atomic_load((const GAS unsigned*)list_w + (size_t)u.e * LIST_CAP + l, __ATOMIC_RELAXED, __HIP_MEMORY_SCOPE_AGENT));
                    const size_t off = (size_t)(ent & 0xFFFFFu) * D + col0;
                    if ((ent >> 20) == 0u) {
#pragma unroll
                        for (int bj = 0; bj < 2; ++bj)
#pragma unroll
                            for (int n = 0; n < 2; ++n) { GAS float* p = (GAS float*)(h + off + bj * HALF + n * 16); const f32x4 r = *(const GAS f32x4*)p; *(GAS f32x4*)p = r + acc[ai][bj][m][n] * w; }
                    } else {
#pragma unroll
                        for (int bj = 0; bj < 2; ++bj)
#pragma unroll
                            for (int n = 0; n < 2; ++n) { const f32x4 v = acc[ai][bj][m][n] * w; unsigned long long pk = (unsigned long long)cvt_pk_bf16(v[0], v[1]) | ((unsigned long long)cvt_pk_bf16(v[2], v[3]) << 32);
                                *(GAS unsigned long long*)(y1 + off + bj * HALF + n * 16) = pk; }
                    }
                } }
    }
};

template <class Epi, class Sched, bool F8 = false>
__device__ __forceinline__ void gemm_phase(PG8_LAS unsigned char* lds, int xoff, const Gemm g, const Sched& S, const Epi& E) {
    int tid_ = threadIdx.x;
    asm volatile("" : "+v"(tid_));
    const int tid = tid_, wid = __builtin_amdgcn_readfirstlane(tid >> 6), lane = tid & 63, wr = wid >> 2, wc = wid & 3, fr = lane & 15, fq = lane >> 4;
    const int RB = g.rowb, nt = RB / 128;
    unsigned voffB[2];
#pragma unroll
    for (int i = 0; i < 2; ++i) { int R, C; stage_rc(tid * 16 + i * 8192, R, C); const int Rb = Epi::PERM ? ((R & ~31) + perm32(R & 31)) : R;
        voffB[i] = (unsigned)(Rb * RB + C * 2); }
    const size_t kstep = (size_t)(BK * 2);
    const size_t hstep = (size_t)HALF * RB;
    const size_t tstep = 2 * hstep;
    const unsigned ldsw = (unsigned)wid * 1024u;
    const int aoff = F8 ? lds_byte(wr * 64 + fr, fq * 16) : lds_byte(wr * 64 + fr, fq * 8), boff = F8 ? lds_byte(wc * 32 + fr, fq * 16) : lds_byte(wc * 32 + fr, fq * 8);
#define PG8_SA(b, h) (((b) * 2 + (h)) * HTB)
#define PG8_SB(b, h) ((4 + (b) * 2 + (h)) * HTB)
#define PG8_STAGE(bufoff, gbase, v0, v1) do { \
        __builtin_amdgcn_global_load_lds((const GAS unsigned*)((const char*)(gbase) + (v0)), (PG8_LAS unsigned*)(lds + (bufoff) + ldsw), 16, 0, 0); \
        __builtin_amdgcn_global_load_lds((const GAS unsigned*)((const char*)(gbase) + (v1)), (PG8_LAS unsigned*)(lds + (bufoff) + ldsw + 8192), 16, 0, 0); } while (0)
#define PG8_STAGEB(bufoff, gbase) PG8_STAGE(bufoff, gbase, voffB[0], voffB[1])
#define PG8_LDA(dst, b, h) do { if constexpr (F8) { _Pragma("unroll") for (int m = 0; m < 4; ++m) { dst##8[m].lo = *(const PG8_LAS i32x4*)(lds + PG8_SA(b, h) + aoff + m * 2048); dst##8[m].hi = *(const PG8_LAS i32x4*)(lds + PG8_SA(b, h) + aoff + m * 2048 + 16); } } \
        else { _Pragma("unroll") for (int m = 0; m < 4; ++m) _Pragma("unroll") for (int k = 0; k < 2; ++k) dst[m][k] = *(const PG8_LAS bf16x8*)(lds + PG8_SA(b, h) + aoff + m * 2048 + k * 1024); } } while (0)
#define PG8_LDB(dst, b, h) do { if constexpr (F8) { _Pragma("unroll") for (int n = 0; n < 2; ++n) { dst##8[n].lo = *(const PG8_LAS i32x4*)(lds + PG8_SB(b, h) + boff + n * 2048); dst##8[n].hi = *(const PG8_LAS i32x4*)(lds + PG8_SB(b, h) + boff + n * 2048 + 16); } } \
        else { _Pragma("unroll") for (int n = 0; n < 2; ++n) _Pragma("unroll") for (int k = 0; k < 2; ++k) dst[n][k] = *(const PG8_LAS bf16x8*)(lds + PG8_SB(b, h) + boff + n * 2048 + k * 1024); } } while (0)
#define PG8_MMA(ai, bj, At, Bt) do { __builtin_amdgcn_s_setprio(1); _Pragma("unroll") for (int m = 0; m < 4; ++m) _Pragma("unroll") for (int n = 0; n < 2; ++n) { \
        if constexpr (F8) acc[ai][bj][m][n] = __builtin_amdgcn_mfma_scale_f32_16x16x128_f8f6f4(Bt##8[n], At##8[m], acc[ai][bj][m][n], 0, 0, 0, 0x7F7F7F7F, 0, 0x7F7F7F7F); \
        else { _Pragma("unroll") for (int k = 0; k < 2; ++k) acc[ai][bj][m][n] = __builtin_amdgcn_mfma_f32_16x16x32_bf16(Bt[n][k], At[m][k], acc[ai][bj][m][n], 0, 0, 0); } } __builtin_amdgcn_s_setprio(0); } while (0)
#define PG8_WAIT_V(n) asm volatile("s_waitcnt vmcnt(" #n ")" ::: "memory")
#define PG8_WAIT_L(n) asm volatile("s_waitcnt lgkmcnt(" #n ")" ::: "memory")
#define PG8_BAR __builtin_amdgcn_s_barrier()
#define PG8_SCHED __builtin_amdgcn_sched_barrier(0)
#define PG8_AOFFS(U, o00, o01, o10, o11) do { int R0_, C0_, R1_, C1_; stage_rc(tid * 16, R0_, C0_); stage_rc(tid * 16 + 8192, R1_, C1_);     \
        o00 = S.arow(U, R0_) * (unsigned)RB + (unsigned)C0_ * 2u; o01 = S.arow(U, R1_) * (unsigned)RB + (unsigned)C1_ * 2u; \
        o10 = S.arow(U, HALF + R0_) * (unsigned)RB + (unsigned)C0_ * 2u; o11 = S.arow(U, HALF + R1_) * (unsigned)RB + (unsigned)C1_ * 2u; } while (0)
    Unit cur, nxt; int ui = 0;
    if (!S.next(0, cur)) return;
    f32x4 acc[2][2][4][2];
#pragma unroll
    for (int a = 0; a < 2; ++a)
#pragma unroll
        for (int b = 0; b < 2; ++b)
#pragma unroll
            for (int m = 0; m < 4; ++m)
#pragma unroll
                for (int n = 0; n < 2; ++n) acc[a][b][m][n] = (f32x4){0.f, 0.f, 0.f, 0.f};
    bf16x8 At[4][2], B0[2][2], B1[2][2];
    i32x8 At8[4], B08[2], B18[2];
    unsigned c00, c01, c10, c11;
    PG8_LAS u32x4* const xslot = (PG8_LAS u32x4*)(lds + xoff) + tid;
    PG8_AOFFS(cur, c00, c01, c10, c11);
    const char* const gA = (const char*)g.A;
    const char* cB = (const char*)g.Bt + (size_t)cur.e * g.bstride + (size_t)cur.pn * tstep;
    PG8_STAGEB(PG8_SB(0, 0), cB); PG8_STAGEB(PG8_SB(0, 1), cB + hstep); PG8_STAGE(PG8_SA(0, 0), gA, c00, c01); PG8_STAGE(PG8_SA(0, 1), gA, c10, c11);
    if (wr == 1) PG8_BAR;
    PG8_WAIT_V(2); PG8_BAR;
    PG8_STAGEB(PG8_SB(1, 0), cB + kstep); PG8_STAGE(PG8_SA(1, 0), gA + kstep, c00, c01); PG8_STAGEB(PG8_SB(1, 1), cB + hstep + kstep);
    PG8_WAIT_V(6); PG8_BAR;
    for (;;) {
        const bool has_next = S.next(ui + 1, nxt);
        const char* nB_ = has_next ? (const char*)g.Bt + (size_t)nxt.e * g.bstride + (size_t)nxt.pn * tstep : cB;
        const char* nB = nB_;
        if (has_next) { unsigned n00, n01, n10, n11; PG8_AOFFS(nxt, n00, n01, n10, n11); *xslot = (u32x4){n00, n01, n10, n11}; }
#pragma unroll 1
        for (int t = 0; t < nt; t += 2) {
            const bool last = (t == nt - 2);
            const char* a1 = gA + (size_t)(t + 1) * kstep;
            const char* a2 = last ? gA : gA + (size_t)(t + 2) * kstep; const char* b2 = last ? nB : cB + (size_t)(t + 2) * kstep;
            const char* a3 = a2 + kstep; const char* b3 = b2 + kstep;
            PG8_LDB(B0, 0, 0); PG8_LDB(B1, 0, 1); PG8_SCHED; PG8_LDA(At, 0, 0); PG8_STAGE(PG8_SA(1, 1), a1, c10, c11);
            if (last && has_next) { const u32x4 nx = *xslot; c00 = nx.x; c01 = nx.y; c10 = nx.z; c11 = nx.w; }
            PG8_WAIT_V(8); PG8_WAIT_L(0); PG8_BAR; PG8_MMA(0, 0, At, B0); PG8_MMA(0, 1, At, B1); PG8_BAR; PG8_SCHED;
            PG8_LDA(At, 0, 1); PG8_STAGEB(PG8_SB(0, 0), b2); PG8_STAGEB(PG8_SB(0, 1), b2 + hstep); PG8_STAGE(PG8_SA(0, 0), a2, c00, c01);
            PG8_WAIT_V(8); PG8_WAIT_L(0); PG8_BAR; PG8_MMA(1, 0, At, B0); PG8_MMA(1, 1, At, B1); PG8_BAR; PG8_SCHED;
            PG8_LDB(B0, 1, 0); PG8_LDB(B1, 1, 1); PG8_SCHED; PG8_LDA(At, 1, 0); PG8_STAGE(PG8_SA(0, 1), a2, c10, c11);
            PG8_WAIT_V(8); PG8_WAIT_L(0); PG8_BAR; PG8_MMA(0, 0, At, B0); PG8_MMA(0, 1, At, B1); PG8_BAR; PG8_SCHED;
            PG8_LDA(At, 1, 1); PG8_STAGEB(PG8_SB(1, 0), b3); PG8_STAGEB(PG8_SB(1, 1), b3 + hstep); PG8_STAGE(PG8_SA(1, 0), a3, c00, c01);
            PG8_WAIT_V(8); PG8_WAIT_L(0); PG8_BAR; PG8_MMA(1, 0, At, B0); PG8_MMA(1, 1, At, B1); PG8_BAR; PG8_SCHED;
        }
        if (wr == 0) PG8_BAR;
        E(acc, cur, wr, wc, fr, fq);
        if (!has_next) break;
#pragma unroll
        for (int a = 0; a < 2; ++a)
#pragma unroll
            for (int b = 0; b < 2; ++b)
#pragma unroll
                for (int m = 0; m < 4; ++m)
#pragma unroll
                    for (int n = 0; n < 2; ++n) acc[a][b][m][n] = (f32x4){0.f, 0.f, 0.f, 0.f};
        cur = nxt; cB = nB; ++ui;
        if (wr == 1) PG8_BAR;
    }
    PG8_WAIT_V(0);
    PG8_BAR;
#undef PG8_SA
#undef PG8_SB
#undef PG8_STAGE
#undef PG8_STAGEB
#undef PG8_LDA
#undef PG8_LDB
#undef PG8_MMA
#undef PG8_WAIT_V
#undef PG8_WAIT_L
#undef PG8_BAR
#undef PG8_SCHED
#undef PG8_AOFFS
}
}

namespace att {
typedef unsigned short bf16_t;
typedef short bf16x8 __attribute__((ext_vector_type(8)));
typedef short s16x4 __attribute__((ext_vector_type(4)));
typedef float f32x16 __attribute__((ext_vector_type(16)));
typedef float f32x4 __attribute__((ext_vector_type(4)));
typedef unsigned u32x4 __attribute__((ext_vector_type(4)));
constexpr int PITCH = 1024;
constexpr float LOG2E = 1.4426950408889634f;
__device__ __forceinline__ int crow(int r, int hi) { return (r & 3) + 8 * (r >> 2) + 4 * hi; }
typedef float f32x2_t __attribute__((ext_vector_type(2))); typedef __bf16 bf16x2_t __attribute__((ext_vector_type(2)));
__device__ __forceinline__ unsigned cvtpk(float lo, float hi) { f32x2_t v = {lo, hi}; bf16x2_t b = __builtin_convertvector(v, bf16x2_t); return __builtin_bit_cast(unsigned, b); }
__device__ __forceinline__ float bf2f(short s) { return __uint_as_float(((unsigned)(unsigned short)s) << 16); }
typedef short v4i16_t __attribute__((ext_vector_type(4)));
__device__ __forceinline__ s16x4 vtr(const LAS unsigned char* p) { return __builtin_bit_cast(s16x4, __builtin_amdgcn_ds_read_tr16_b64_v4i16((LAS v4i16_t*)p)); }
__device__ __forceinline__ float max3f(float a, float b, float c) { float r; asm("v_max3_f32 %0, %1, %2, %3" : "=v"(r) : "v"(a), "v"(b), "v"(c)); return r; }
__device__ __forceinline__ float halves_max(float m) { auto rr = __builtin_amdgcn_permlane32_swap(__float_as_uint(m), __float_as_uint(m), false, false); return fmaxf(__uint_as_float(rr[0]), __uint_as_float(rr[1])); }
__device__ __forceinline__ float halves_sum(float m) { auto rr = __builtin_amdgcn_permlane32_swap(__float_as_uint(m), __float_as_uint(m), false, false); return __uint_as_float(rr[0]) + __uint_as_float(rr[1]); }
#define ATT_BAR() asm volatile("s_waitcnt vmcnt(0) lgkmcnt(0)\n\ts_barrier" ::: "memory")

struct Args { const bf16_t* Q; const bf16_t* K; const bf16_t* V; bf16_t* O; const float* kmean; const float* kmax2; const float* subln; float lam_full; float out_scale; };

template <int MODE>
__device__ __forceinline__ void attn_unit(LAS unsigned char* lds, const Args& A, int b, int h, int qblk) {
    constexpr int DVB = MODE == 0 ? 4 : 2;
    constexpr int NCH = MODE == 0 ? 16 : 8;
    constexpr int KBY = NCH * 1024, VBY = DVB * 4096, SLOT = KBY + VBY;
    constexpr int QR = MODE == 0 ? 128 : 256;
    constexpr int PPW = MODE == 0 ? 2 : 1;
    int tid_ = threadIdx.x; asm volatile("" : "+v"(tid_));
    const int tid = tid_, lane = tid & 63, r32 = lane & 31, hi = lane >> 5;
    const int wid = __builtin_amdgcn_readfirstlane(tid >> 6);
    const int comp = MODE == 0 ? (wid >> 2) : 0, wq = MODE == 0 ? (wid & 3) : wid;
    const int q0 = qblk * QR; const long rowbase = (long)b * SEQ;
    const int hcol = MODE == 0 ? h * 128 : h * 64;
    const int qrel0 = wq * 32;
    const float slope2 = __builtin_amdgcn_exp2f(MODE == 0 ? -(float)(h + 1) : -0.5f * (float)(h + 1)) * LOG2E;
    const int NT = MODE == 0 ? 2 * qblk + 2 : 4 + 4 * qblk;
#define ATT_KBASE_(t) (MODE == 0 ? 64 * (t) : ((t) < 4 ? q0 + 64 * (t) : 64 * ((t) - 4)))
    LAS float* wsf = (LAS float*)(lds + 65536) + wid * 64;
    const bf16_t* Kb = A.K + rowbase * PITCH + hcol;
    const bf16_t* Vb = A.V + rowbase * PITCH + hcol;
    bf16x8 qr[4];
    { const bf16_t* Qw = A.Q + (rowbase + q0 + qrel0 + r32) * PITCH + hcol + comp * 64 + hi * 8;
#pragma unroll
      for (int d0 = 0; d0 < 4; ++d0) qr[d0] = *(const GAS bf16x8*)(Qw + d0 * 16); }
    ATT_BAR();
    LAS int* live = (LAS int*)(lds + 71680); LAS float* qnx = (LAS float*)(lds + 71680 + 272);
    { float q2 = 0.f;
#pragma unroll
      for (int d0 = 0; d0 < 4; ++d0)
#pragma unroll
        for (int j = 0; j < 8; ++j) { const float v = bf2f(qr[d0][j]); q2 += v * v; }
      q2 = halves_sum(q2);
      q2 = fmaxf(q2, __shfl_xor(q2, 1)); q2 = fmaxf(q2, __shfl_xor(q2, 2)); q2 = fmaxf(q2, __shfl_xor(q2, 4)); q2 = fmaxf(q2, __shfl_xor(q2, 8)); q2 = fmaxf(q2, __shfl_xor(q2, 16));
      if (lane == 0) qnx[wid] = q2; }
    ATT_BAR();
    if (wid == 0) {
        const int tt = lane;
        const int kbase_t = (tt < NT) ? ATT_KBASE_(tt) : 0;
        bool alive = tt < NT;
        if (alive && kbase_t + 64 <= q0) {
            const int nblk = kbase_t >> 8; float bound = -INFINITY;
            if constexpr (MODE == 0) {
#pragma unroll
                for (int c = 0; c < 2; ++c) { float qm = fmaxf(fmaxf(qnx[4 * c], qnx[4 * c + 1]), fmaxf(qnx[4 * c + 2], qnx[4 * c + 3]));
                    const float k2 = ((const GAS float*)A.kmax2)[(size_t)(b * 16 + h * 2 + c) * 16 + nblk]; bound = fmaxf(bound, sqrtf(qm) * sqrtf(k2)); }
            } else {
                float qm = qnx[0];
#pragma unroll
                for (int w = 1; w < 8; ++w) qm = fmaxf(qm, qnx[w]);
                const float k2 = ((const GAS float*)A.kmax2)[(size_t)(b * 16 + h) * 16 + nblk]; bound = sqrtf(qm) * sqrtf(k2);
            }
            alive = !(bound * 1.001f + 1.0f + slope2 * (float)(kbase_t + 63 - q0) < -152.0f);
        }
        const unsigned long long am = __ballot(alive);
        if (alive) live[__popcll(am & ((1ull << lane) - 1ull))] = tt;
        if (lane == 0) live[64] = __popcll(am);
    }
    ATT_BAR();
    const int NTL = __builtin_amdgcn_readfirstlane(live[64]);
    unsigned sel = 0u;
    if constexpr (MODE == 1) {
        LAS float* km = (LAS float*)(lds + 67584);
        for (int i = tid; i < 1024; i += 512) km[i] = ((const GAS float*)A.kmean)[(size_t)(b * 16 + h) * 1024 + i];
        ATT_BAR();
        float g[16];
#pragma unroll
        for (int n = 0; n < 16; ++n) { float s = 0.f;
            if (n < qblk) {
#pragma unroll
                for (int d0 = 0; d0 < 4; ++d0) { const f32x4 ka = *(const LAS f32x4*)(km + n * 64 + d0 * 16 + hi * 8), kb2 = *(const LAS f32x4*)(km + n * 64 + d0 * 16 + hi * 8 + 4);
                    s += bf2f(qr[d0][0]) * ka[0] + bf2f(qr[d0][1]) * ka[1] + bf2f(qr[d0][2]) * ka[2] + bf2f(qr[d0][3]) * ka[3]
                       + bf2f(qr[d0][4]) * kb2[0] + bf2f(qr[d0][5]) * kb2[1] + bf2f(qr[d0][6]) * kb2[2] + bf2f(qr[d0][7]) * kb2[3]; }
                s = halves_sum(s); }
            g[n] = s; }
        const int nsel = qblk < 3 ? qblk : 3;
#pragma unroll
        for (int k = 0; k < 3; ++k) if (k < nsel) { float best = -INFINITY; int bi = 0; bool found = false;
#pragma unroll
            for (int n = 0; n < 16; ++n) if (n < qblk) { const bool free_ = ((sel >> n) & 1u) == 0u; if (free_ && (!found || g[n] > best)) { best = g[n]; bi = n; found = true; } }
            sel |= 1u << bi; }
    }
#define ATT_KBASE(t) ATT_KBASE_(t)
#define ATT_ISSUE(t, slot) do { const int kb_ = ATT_KBASE(t); \
        _Pragma("unroll") for (int i_ = 0; i_ < PPW; ++i_) { const int p_ = wid + 8 * i_; \
            __builtin_amdgcn_global_load_lds((const GAS unsigned*)(Kb + (size_t)(kb_ + lane) * PITCH + p_ * 8), (LAS unsigned*)(lds + (slot) * SLOT + p_ * 1024), 16, 0, 0); \
            __builtin_amdgcn_global_load_lds((const GAS unsigned*)(Vb + (size_t)(kb_ + 16 * (p_ & 3) + (lane >> 2)) * PITCH + (p_ >> 2) * 32 + (lane & 3) * 8), (LAS unsigned*)(lds + (slot) * SLOT + KBY + p_ * 1024), 16, 0, 0); } } while (0)
    constexpr float THR = 8.0f;
    float mref = 0.f, l = 0.f; f32x16 o[DVB];
#pragma unroll
    for (int d0 = 0; d0 < DVB; ++d0) o[d0] = f32x16{};
#define ATT_ISSUE_K(tt, slot) do { const int kb_ = ATT_KBASE(tt); \
        _Pragma("unroll") for (int i_ = 0; i_ < PPW; ++i_) { const int p_ = wid + 8 * i_; \
            __builtin_amdgcn_global_load_lds((const GAS unsigned*)(Kb + (size_t)(kb_ + lane) * PITCH + p_ * 8), (LAS unsigned*)(lds + (slot) * SLOT + p_ * 1024), 16, 0, 0); } } while (0)
#define ATT_ISSUE_V(tt, slot) do { const int kb_ = ATT_KBASE(tt); \
        _Pragma("unroll") for (int i_ = 0; i_ < PPW; ++i_) { const int p_ = wid + 8 * i_; \
            __builtin_amdgcn_global_load_lds((const GAS unsigned*)(Vb + (size_t)(kb_ + 16 * (p_ & 3) + (lane >> 2)) * PITCH + (p_ >> 2) * 32 + (lane & 3) * 8), (LAS unsigned*)(lds + (slot) * SLOT + KBY + p_ * 1024), 16, 0, 0); } } while (0)
#define ATT_CLASS(tt, SK, NM, SB) do { const int kb_ = ATT_KBASE(tt), kr_ = kb_ - q0; const bool dg_ = kb_ >= q0; SK = dg_ && (kr_ > qrel0 + 31); NM = dg_ && (kr_ + 63 > qrel0); SB = true; \
        if constexpr (MODE == 1) { if ((tt) >= 4) { SB = ((sel >> (((tt) - 4) >> 2)) & 1u) != 0u; if (!__any(SB)) SK = true; } } } while (0)
#define ATT_QK(P0, P1, tt, slot, SB) do { const int kr_ = ATT_KBASE(tt) - q0; float off0_ = slope2 * (float)(kr_ + 4 * hi) - mref; if (!(SB)) off0_ = -INFINITY; const float off1_ = off0_ + 32.0f * slope2; \
        _Pragma("unroll") for (int r = 0; r < 16; ++r) { const float cbr = slope2 * (float)((r & 3) + 8 * (r >> 2)); P0[r] = cbr + off0_; P1[r] = cbr + off1_; } \
        const LAS unsigned char* Ks_ = lds + (slot) * SLOT + comp * 8192 + hi * 1024 + r32 * 16; \
        _Pragma("unroll") for (int d0 = 0; d0 < 4; ++d0) { const bf16x8 b0 = *(const LAS bf16x8*)(Ks_ + d0 * 2048), b1 = *(const LAS bf16x8*)(Ks_ + d0 * 2048 + 512); \
            P0 = __builtin_amdgcn_mfma_f32_32x32x16_bf16(b0, qr[d0], P0, 0, 0, 0); P1 = __builtin_amdgcn_mfma_f32_32x32x16_bf16(b1, qr[d0], P1, 0, 0, 0); } } while (0)
    f32x16 p0, p1, n0, n1;
    int t = __builtin_amdgcn_readfirstlane(live[0]);
    int tn = (NTL > 1) ? __builtin_amdgcn_readfirstlane(live[1]) : 0;
    bool skipC, maskC, selC, skipN = true, maskN = false, selN = true;
    ATT_ISSUE_K(t, 0); ATT_ISSUE_V(t, 0); if (NTL > 1) ATT_ISSUE_K(tn, 1);
    ATT_BAR();
    ATT_CLASS(t, skipC, maskC, selC);
    if (!skipC) ATT_QK(p0, p1, t, 0, selC);
    for (int it = 0; it < NTL; ++it) {
        ATT_BAR();
        const int tnn = (it + 2 < NTL) ? __builtin_amdgcn_readfirstlane(live[it + 2]) : 0;
        if (it + 2 < NTL) ATT_ISSUE_K(tnn, it & 1);
        if (it + 1 < NTL) { ATT_ISSUE_V(tn, (it + 1) & 1); ATT_CLASS(tn, skipN, maskN, selN); if (!skipN) ATT_QK(n0, n1, tn, (it + 1) & 1, selN); } else skipN = true;
        if (!skipC) {
            const int krel = ATT_KBASE(t) - q0;
            const LAS unsigned char* Vs = lds + (it & 1) * SLOT + KBY + ((lane >> 4) & 1) * 32 + (lane & 3) * 8 + (4 * hi + ((lane & 15) >> 2)) * 64;
            if (maskC) { const int qrel = qrel0 + r32;
#pragma unroll
                for (int r = 0; r < 16; ++r) { const int kv = krel + crow(r, hi); if (kv > qrel) p0[r] = -INFINITY; if (kv + 32 > qrel) p1[r] = -INFINITY; } }
            float rm;
            { float a_ = max3f(p0[0], p0[1], p1[0]), b_ = max3f(p0[2], p0[3], p1[1]); a_ = max3f(a_, p1[2], p1[3]);
#pragma unroll
              for (int r = 4; r < 16; r += 4) { a_ = max3f(a_, p0[r], p0[r + 1]); b_ = max3f(b_, p0[r + 2], p0[r + 3]); a_ = max3f(a_, p1[r], p1[r + 1]); b_ = max3f(b_, p1[r + 2], p1[r + 3]); }
              rm = halves_max(fmaxf(a_, b_)); }
            if (__any(rm > THR)) {
                const float dl = fmaxf(rm, 0.f); mref += dl; const float alpha = __builtin_amdgcn_exp2f(-dl);
#pragma unroll
                for (int r = 0; r < 16; ++r) { p0[r] -= dl; p1[r] -= dl; }
                if (!skipN) {
#pragma unroll
                    for (int r = 0; r < 16; ++r) { n0[r] -= dl; n1[r] -= dl; } }
                l *= alpha;
                if (hi == 0) wsf[r32] = alpha;
                asm volatile("s_waitcnt lgkmcnt(0)" ::: "memory");
#pragma unroll
                for (int gq = 0; gq < 4; ++gq) { const f32x4 f = *(const LAS f32x4*)(wsf + 8 * gq + 4 * hi);
#pragma unroll
                    for (int d0 = 0; d0 < DVB; ++d0) { o[d0][4 * gq + 0] *= f[0]; o[d0][4 * gq + 1] *= f[1]; o[d0][4 * gq + 2] *= f[2]; o[d0][4 * gq + 3] *= f[3]; } }
            }
            float sacc = 0.f;
#pragma unroll
            for (int r = 0; r < 16; ++r) { p0[r] = __builtin_amdgcn_exp2f(p0[r]); p1[r] = __builtin_amdgcn_exp2f(p1[r]); sacc += p0[r] + p1[r]; }
            l += sacc;
            u32x4 pw[4];
            pw[0] = (u32x4){cvtpk(p0[0], p0[1]), cvtpk(p0[2], p0[3]), cvtpk(p0[4], p0[5]), cvtpk(p0[6], p0[7])};
            pw[1] = (u32x4){cvtpk(p0[8], p0[9]), cvtpk(p0[10], p0[11]), cvtpk(p0[12], p0[13]), cvtpk(p0[14], p0[15])};
            pw[2] = (u32x4){cvtpk(p1[0], p1[1]), cvtpk(p1[2], p1[3]), cvtpk(p1[4], p1[5]), cvtpk(p1[6], p1[7])};
            pw[3] = (u32x4){cvtpk(p1[8], p1[9]), cvtpk(p1[10], p1[11]), cvtpk(p1[12], p1[13]), cvtpk(p1[14], p1[15])};
#pragma unroll
            for (int d0 = 0; d0 < DVB; ++d0)
#pragma unroll
                for (int ks = 0; ks < 4; ++ks) { const s16x4 vlo = vtr(Vs + d0 * 4096 + ks * 1024), vhi = vtr(Vs + d0 * 4096 + ks * 1024 + 512);
                    const bf16x8 vf = (bf16x8){vlo[0], vlo[1], vlo[2], vlo[3], vhi[0], vhi[1], vhi[2], vhi[3]};
                    o[d0] = __builtin_amdgcn_mfma_f32_32x32x16_bf16(__builtin_bit_cast(bf16x8, pw[ks]), vf, o[d0], 0, 0, 0); }
        }
        p0 = n0; p1 = n1; skipC = skipN; maskC = maskN; selC = selN; t = tn; tn = tnn;
    }
#undef ATT_ISSUE_K
#undef ATT_ISSUE_V
#undef ATT_CLASS
#undef ATT_QK
    l = halves_sum(l);
    if (hi == 0) wsf[32 + r32] = l;
    asm volatile("s_waitcnt lgkmcnt(0)" ::: "memory");
    float rli[16];
#pragma unroll
    for (int gq = 0; gq < 4; ++gq) { const f32x4 f = *(const LAS f32x4*)(wsf + 32 + 8 * gq + 4 * hi); rli[4 * gq + 0] = 1.0f / f[0]; rli[4 * gq + 1] = 1.0f / f[1]; rli[4 * gq + 2] = 1.0f / f[2]; rli[4 * gq + 3] = 1.0f / f[3]; }
    if constexpr (MODE == 1) {
        GAS bf16_t* Ow = (GAS bf16_t*)(A.O + (rowbase + q0 + qrel0) * PITCH + hcol);
#pragma unroll
        for (int r = 0; r < 16; ++r)
#pragma unroll
            for (int d0 = 0; d0 < DVB; ++d0) Ow[(size_t)crow(r, hi) * PITCH + d0 * 32 + r32] = (bf16_t)(cvtpk(o[d0][r] * rli[r], 0.f) & 0xFFFFu);
    } else {
        ATT_BAR();
        LAS float* X = (LAS float*)lds + wq * 4096;
        if (comp == 1) {
#pragma unroll
            for (int d0 = 0; d0 < DVB; ++d0)
#pragma unroll
                for (int r = 0; r < 16; ++r) X[(d0 * 16 + r) * 64 + lane] = o[d0][r] * rli[r];
        }
        ATT_BAR();
        if (comp == 0) {
            float sg[DVB];
#pragma unroll
            for (int d0 = 0; d0 < DVB; ++d0) sg[d0] = ((const GAS float*)A.subln)[d0 * 32 + r32] * A.out_scale;
            GAS bf16_t* Ow = (GAS bf16_t*)(A.O + (rowbase + q0 + qrel0) * PITCH + hcol);
#pragma unroll
            for (int r = 0; r < 16; ++r) { float dv[DVB]; float ss = 0.f;
#pragma unroll
                for (int d0 = 0; d0 < DVB; ++d0) { dv[d0] = o[d0][r] * rli[r] - A.lam_full * X[(d0 * 16 + r) * 64 + lane]; ss += dv[d0] * dv[d0]; }
                ss += __shfl_xor(ss, 1); ss += __shfl_xor(ss, 2); ss += __shfl_xor(ss, 4); ss += __shfl_xor(ss, 8); ss += __shfl_xor(ss, 16);
                const float rs = 1.0f / sqrtf(ss * (1.0f / 128.0f) + 1e-5f);
#pragma unroll
                for (int d0 = 0; d0 < DVB; ++d0) Ow[(size_t)crow(r, hi) * PITCH + d0 * 32 + r32] = (bf16_t)(cvtpk(dv[d0] * rs * sg[d0], 0.f) & 0xFFFFu); }
        }
    }
#undef ATT_KBASE
#undef ATT_KBASE_
#undef ATT_ISSUE
}
#undef ATT_BAR
}

constexpr int NWAVES = 8;
#ifndef MK_PER_PHASE
#define MK_PER_PHASE 1
#endif
#ifndef MK_DEBUG
#define MK_DEBUG 1
#endif
constexpr int NLAYER = 4, PH_PER_LAYER = 8, NPHASE = 1 + NLAYER * PH_PER_LAYER;

constexpr size_t MiB = 1u << 20;
constexpr size_t WS_CTL = 0, CTL_ZERO_BYTES = 1 * MiB;
constexpr size_t WS_KMEAN = 1 * MiB;
constexpr size_t WS_LTOK = 2 * MiB, WS_LW = 3 * MiB;
constexpr size_t WS_DQKV = 5 * MiB;
constexpr size_t WS_DWO = WS_DQKV + 12 * MiB;
constexpr size_t WS_MQKV = WS_DWO + 4 * MiB;
constexpr size_t WS_MWO = WS_MQKV + 12 * MiB;
constexpr size_t WS_FGU = WS_MWO + 4 * MiB;
constexpr size_t WS_FD = WS_FGU + 22 * MiB;
constexpr size_t WS_MGU = WS_FD + 11 * MiB;
constexpr size_t WS_MD = WS_MGU + 112 * MiB;
constexpr size_t WS_XN = WS_MD + 56 * MiB;
constexpr size_t WS_Q = WS_XN + 64 * MiB, WS_K = WS_Q + 64 * MiB, WS_V = WS_K + 64 * MiB;
constexpr size_t WS_ACT = WS_Q;
constexpr size_t WS_END = WS_ACT + (size_t)MOE_TILES_MAX * 256 * DE * 2;
static_assert(WS_XN == 238 * MiB && WS_END == 778 * MiB, "d_ws map");
constexpr int CW_BAR = 4096;
constexpr int CW_ATTQ = 6144;
constexpr int CW_CNT = 8192;

constexpr int RING_OFF = 0, RING_BYTES = 131072;
constexpr int LDSCTL_OFF = RING_BYTES, MISC_OFF = LDSCTL_OFF + 320;
constexpr int XSLOT_OFF = MISC_OFF + 128;
constexpr int LDS_BYTES = 147456;

typedef unsigned short bf16;
typedef unsigned v4u __attribute__((ext_vector_type(4)));
typedef float f32x4 __attribute__((ext_vector_type(4)));
typedef GAS unsigned gu32;
#define RLX_AGENT __ATOMIC_RELAXED, __HIP_MEMORY_SCOPE_AGENT
#define LDS_WAIT() asm volatile("s_waitcnt lgkmcnt(0)" ::: "memory")
#define VM_WAIT() asm volatile("s_waitcnt vmcnt(0)" ::: "memory")
__device__ __forceinline__ unsigned f2bf(float f) { unsigned u = __builtin_bit_cast(unsigned, f); return (u + 0x7fffu + ((u >> 16) & 1u)) >> 16; }
__device__ __forceinline__ unsigned pk2(float lo, float hi) { return f2bf(lo) | (f2bf(hi) << 16); }
__device__ __forceinline__ float bflo(unsigned w) { return __uint_as_float(w << 16); }
__device__ __forceinline__ float bfhi(unsigned w) { return __uint_as_float(w & 0xFFFF0000u); }
static_assert(XSLOT_OFF % 16 == 0 && XSLOT_OFF + 8192 <= LDS_BYTES, "LDS map");
#define XB_TMO      128
#define XB_XCNT(j)  (256  + 64 * (j))
#define XB_XSUB(j)  (1280 + 64 * (j))
#define XB_XGEN(j)  (2304 + 64 * (j))
#define XB_TOP      3328
#define XB_TOPGEN   3392
#define XCD_BAR_WORDS 3456
#define XB_SPIN_CAP (1u << 18)

__device__ __forceinline__ unsigned xb_ld(unsigned* p)              { return __hip_atomic_load(p, __ATOMIC_RELAXED, __HIP_MEMORY_SCOPE_AGENT); }
__device__ __forceinline__ unsigned xb_add(unsigned* p, unsigned v) { return __hip_atomic_fetch_add(p, v, __ATOMIC_RELAXED, __HIP_MEMORY_SCOPE_AGENT); }
__device__ __forceinline__ unsigned xb_xcc_id() { return (unsigned)__builtin_amdgcn_s_getreg((3 << 11) | 20) & 0xFu; }
#define XB_SPIN(cond, bar) do { unsigned _sp = 0; while (cond) { __builtin_amdgcn_s_sleep(1); \
    if ((++_sp & 255u) == 0u) { if (xb_ld(&(bar)[XB_TMO])) break; if (_sp > XB_SPIN_CAP) { atomicAdd(&(bar)[XB_TMO], 1u); break; } } } } while (0)

struct XcdBarrier {
    unsigned* bar; unsigned x;
    volatile LAS unsigned* st;
};

__device__ __forceinline__ XcdBarrier xcd_barrier_post(unsigned* bar, volatile LAS unsigned* st) {
    XcdBarrier b; b.bar = bar; b.x = xb_xcc_id(); b.st = st;
    if (threadIdx.x == 0) (void)xb_add(&bar[XB_XCNT(b.x)], 1u);
    return b;
}
__device__ __forceinline__ void xcd_barrier_complete(unsigned* bar, unsigned x, unsigned& nloc, unsigned& nx) {
    const unsigned G = gridDim.x * gridDim.y * gridDim.z;
    unsigned sum, cnt, mine, sp = 0u;
    for (;;) {
        sum = 0u; cnt = 0u; mine = 0u;
#pragma unroll
        for (unsigned j = 0; j < 16; ++j) { const unsigned c = xb_ld(&bar[XB_XCNT(j)]); sum += c; cnt += (c > 0u) ? 1u : 0u; mine = (j == x) ? c : mine; }
        if (sum == G) break;
        __builtin_amdgcn_s_sleep(1);
        if ((++sp & 255u) == 0u) { if (xb_ld(&bar[XB_TMO])) break; if (sp > XB_SPIN_CAP) { atomicAdd(&bar[XB_TMO], 1u); break; } }
    }
    nloc = mine > 0u ? mine : 1u; nx = cnt > 0u ? cnt : 1u;
}

__device__ __forceinline__ void xcd_barrier(const XcdBarrier& b) {
    asm volatile("s_waitcnt vmcnt(0)" ::: "memory");
    __syncthreads();
    if (threadIdx.x == 0) {
        unsigned* bar = b.bar;
        __builtin_amdgcn_s_waitcnt(0);
        unsigned nloc = b.st[0], nx = b.st[1];
        if (nloc == 0u) { xcd_barrier_complete(bar, b.x, nloc, nx); b.st[0] = nloc; b.st[1] = nx; }
        const unsigned old = xb_add(&bar[XB_XSUB(b.x)], 1u);
        const unsigned gen = old / nloc;
        if (old + 1u == (gen + 1u) * nloc) {
            __builtin_amdgcn_fence(__ATOMIC_RELEASE, "agent");
            asm volatile("s_waitcnt vmcnt(0)" ::: "memory");
            const unsigned og = xb_add(&bar[XB_TOP], 1u);
            const unsigned tg = og / nx;
            if (og + 1u == (tg + 1u) * nx) xb_add(&bar[XB_TOPGEN], 1u);
            else XB_SPIN(xb_ld(&bar[XB_TOPGEN]) == tg, bar);
            __builtin_amdgcn_fence(__ATOMIC_ACQUIRE, "agent");
            xb_add(&bar[XB_XGEN(b.x)], 1u);
            asm volatile("s_waitcnt vmcnt(0)" ::: "memory");
        } else {
            XB_SPIN(xb_ld(&bar[XB_XGEN(b.x)]) == gen, bar);
            __builtin_amdgcn_fence(__ATOMIC_ACQUIRE, "agent");
            asm volatile("s_waitcnt vmcnt(0)" ::: "memory");
        }
    }
    __syncthreads();
}

struct Frame {
    LAS unsigned char* lds;
    volatile LAS unsigned* MISC;
    gu32* ctl;
    int tid, lane, wave;
    int vcu, G;
};
__device__ __forceinline__ float wave_sum(float v) {
#pragma unroll
    for (int o = 1; o < 64; o <<= 1) v += __shfl_xor(v, o);
    return v;
}
__device__ __forceinline__ void transpose_item(const float* W, int K, int N, void* WT, int k0, int n0, int drow0, LAS float* scr, int lane, bool f8, float wscale) {
    const GAS float* src = (const GAS float*)W + (size_t)k0 * N + n0 + lane;
#pragma unroll
    for (int hb = 0; hb < 2; ++hb) { float v[32];
#pragma unroll
        for (int i = 0; i < 32; ++i) v[i] = src[(size_t)(hb * 32 + i) * N];
#pragma unroll
        for (int i = 0; i < 32; ++i) { const int kk = hb * 32 + i; scr[kk * 64 + (lane ^ ((kk >> 3) << 3))] = v[i]; } }
    LDS_WAIT(); asm volatile("" ::: "memory");
    if (f8) {
        const int c = lane & 3;
#pragma unroll
        for (int j = 0; j < 4; ++j) { const int nn = (lane >> 2) + 16 * j; float v[16];
#pragma unroll
            for (int q = 0; q < 16; ++q) { const int kk = 16 * c + q; v[q] = scr[kk * 64 + (nn ^ ((kk >> 3) << 3))] * wscale; }
            v4u o; o.x = pg8::pk4_fp8(v[0], v[1], v[2], v[3]); o.y = pg8::pk4_fp8(v[4], v[5], v[6], v[7]); o.z = pg8::pk4_fp8(v[8], v[9], v[10], v[11]); o.w = pg8::pk4_fp8(v[12], v[13], v[14], v[15]);
            *(GAS v4u*)((unsigned char*)WT + (size_t)(drow0 + nn) * K + k0 + 16 * c) = o; }
    } else {
    const int c = lane & 7;
#pragma unroll
    for (int j = 0; j < 8; ++j) { const int n = (lane >> 3) + 8 * j; const LAS float* s = scr + (8 * c) * 64 + (n ^ (c << 3));
        v4u o; o.x = pk2(s[0 * 64], s[1 * 64]); o.y = pk2(s[2 * 64], s[3 * 64]); o.z = pk2(s[4 * 64], s[5 * 64]); o.w = pk2(s[6 * 64], s[7 * 64]);
        *(GAS v4u*)((bf16*)WT + (size_t)(drow0 + n) * K + k0 + 8 * c) = o; }
    }
    LDS_WAIT(); asm volatile("" ::: "memory");
}
__device__ __forceinline__ void convert_matrix(Frame& F, const float* W, int K, int N, void* WT, int il, unsigned& rot, bool f8 = false, float wscale = 1.0f) {
    LAS float* scr = (LAS float*)(F.lds + RING_OFF + F.wave * 16384);
    const unsigned gw = (unsigned)(F.vcu * NWAVES + F.wave), NGW = (unsigned)(F.G * NWAVES);
    const int nblk = N / 64, nitems = (K / 64) * nblk; int lane_ = F.lane; asm volatile("" : "+v"(lane_));
    for (int it = (int)((gw + NGW - rot % NGW) % NGW); it < nitems; it += (int)NGW) {
        const int kb = it / nblk, nb = it % nblk, n0 = 64 * nb;
        const int drow0 = il == 0 ? n0 : (n0 / 128) * 256 + (il - 1) * 128 + (n0 % 128);
        transpose_item(W, K, N, WT, 64 * kb, n0, drow0, scr, lane_, f8, wscale);
    }
    rot = (rot + (unsigned)nitems) % NGW;
}

struct RouterArgs { const float* router; gu32* cnt; unsigned* ltok; float* lw; };
template <int MODE, bool F8X = false>
__device__ __forceinline__ void norm_phase(Frame& F, const float* src, float* hout, const bf16* y1, const float* gain, bf16* xn, float* fout, const RouterArgs& R) {
    int lane_ = F.lane; asm volatile("" : "+v"(lane_));
    const int gw = F.vcu * NWAVES + F.wave, NGW = F.G * NWAVES, lane = lane_;
    f32x4 gv[4];
#pragma unroll
    for (int j = 0; j < 4; ++j) gv[j] = *(const GAS f32x4*)(gain + 256 * j + 4 * lane);
    LAS float* RL = (LAS float*)(F.lds + RING_OFF);
    if constexpr (MODE == 2) {
        int tid_ = F.tid; asm volatile("" : "+v"(tid_));
        for (int i = tid_; i < 8192; i += NWAVES * 64) RL[(i & 7) * 1024 + (i >> 3)] = ((const GAS float*)R.router)[i];
        LDS_WAIT(); __syncthreads();
    }
    const int nrows_w = gw < MTOK ? (MTOK - gw + NGW - 1) / NGW : 0;
    for (int cb = 0; cb < nrows_w; cb += 64) {
        int my_t = 0, my_e0 = 0, my_e1 = 0; float my_w0 = 0.f, my_w1 = 0.f; bool valid = false;
        const int cn = (nrows_w - cb) < 64 ? (nrows_w - cb) : 64;
        f32x4 vn[4]; unsigned long long yn[4];
        { const int row0_ = gw + cb * NGW; const GAS f32x4* xr = (const GAS f32x4*)(src + (size_t)row0_ * D) + lane;
#pragma unroll
          for (int j = 0; j < 4; ++j) vn[j] = xr[64 * j];
          if constexpr (MODE == 1 || MODE == 3) { const GAS unsigned long long* yr = (const GAS unsigned long long*)(y1 + (size_t)row0_ * D) + lane;
#pragma unroll
            for (int j = 0; j < 4; ++j) yn[j] = yr[64 * j]; } }
        for (int i = 0; i < cn; ++i) {
            const int row = gw + (cb + i) * NGW;
            f32x4 v[4]; float s = 0.f;
#pragma unroll
            for (int j = 0; j < 4; ++j) v[j] = vn[j];
            if constexpr (MODE == 1 || MODE == 3) {
#pragma unroll
                for (int j = 0; j < 4; ++j) { const unsigned long long w = yn[j]; const unsigned lo = (unsigned)w, hi = (unsigned)(w >> 32);
                    v[j].x += bflo(lo); v[j].y += bfhi(lo); v[j].z += bflo(hi); v[j].w += bfhi(hi); }
            }
            if (i + 1 < cn) { const int rown = row + NGW; const GAS f32x4* xr = (const GAS f32x4*)(src + (size_t)rown * D) + lane;
#pragma unroll
                for (int j = 0; j < 4; ++j) vn[j] = xr[64 * j];
                if constexpr (MODE == 1 || MODE == 3) { const GAS unsigned long long* yr = (const GAS unsigned long long*)(y1 + (size_t)rown * D) + lane;
#pragma unroll
                    for (int j = 0; j < 4; ++j) yn[j] = yr[64 * j]; } }
#pragma unroll
            for (int j = 0; j < 4; ++j) s += (v[j].x * v[j].x + v[j].y * v[j].y) + (v[j].z * v[j].z + v[j].w * v[j].w);
            if constexpr (MODE == 1) { GAS f32x4* hr = (GAS f32x4*)(hout + (size_t)row * D) + lane;
#pragma unroll
                for (int j = 0; j < 4; ++j) hr[64 * j] = v[j]; }
            const float rstd = 1.f / sqrtf(wave_sum(s) * (1.f / D) + 1e-6f);
#pragma unroll
            for (int j = 0; j < 4; ++j) v[j] = v[j] * rstd * gv[j];
            if constexpr (MODE == 3) { GAS f32x4* orow = (GAS f32x4*)(fout + (size_t)row * D) + lane;
#pragma unroll
                for (int j = 0; j < 4; ++j) orow[64 * j] = v[j];
            } else {
                if constexpr (F8X) { GAS unsigned* o4 = (GAS unsigned*)((unsigned char*)xn + (size_t)row * D) + lane;
#pragma unroll
                    for (int j = 0; j < 4; ++j) o4[64 * j] = pg8::pk4_fp8(v[j].x, v[j].y, v[j].z, v[j].w);
                } else { GAS unsigned long long* o8 = (GAS unsigned long long*)(xn + (size_t)row * D) + lane;
#pragma unroll
                    for (int j = 0; j < 4; ++j) o8[64 * j] = (unsigned long long)pk2(v[j].x, v[j].y) | ((unsigned long long)pk2(v[j].z, v[j].w) << 32); }
            }
            if constexpr (MODE == 2) {
                float lg[NE];
#pragma unroll
                for (int e = 0; e < NE; ++e) { float a = 0.f;
#pragma unroll
                    for (int j = 0; j < 4; ++j) { const f32x4 rr = *(const LAS f32x4*)(RL + e * 1024 + 256 * j + 4 * lane); a += (v[j].x * rr.x + v[j].y * rr.y) + (v[j].z * rr.z + v[j].w * rr.w); }
                    lg[e] = wave_sum(a); }
                int e0 = 0; float v0 = lg[0];
#pragma unroll
                for (int e = 1; e < NE; ++e) if (lg[e] > v0) { v0 = lg[e]; e0 = e; }
                int e1 = -1; float v1 = 0.f;
#pragma unroll
                for (int e = 0; e < NE; ++e) if (e != e0 && (e1 < 0 || lg[e] > v1)) { v1 = lg[e]; e1 = e; }
                const float w0 = 1.f / (1.f + __expf(v1 - v0));
                if (lane == i) { my_t = row; my_e0 = e0; my_e1 = e1; my_w0 = w0; my_w1 = 1.f - w0; valid = true; }
            }
        }
        if constexpr (MODE == 2) {
            unsigned myc = 0u;
#pragma unroll
            for (int e = 0; e < NE; ++e) { const unsigned long long b0 = __ballot(valid && my_e0 == e), b1 = __ballot(valid && my_e1 == e);
                const unsigned c = (unsigned)(__popcll(b0) + __popcll(b1)); if (lane == e) myc = c; }
            unsigned basev = 0u;
            if (lane < NE) basev = __hip_atomic_fetch_add(R.cnt + 64 * lane, myc, RLX_AGENT);
            const unsigned long long lt = (1ull << lane) - 1ull;
            unsigned pos0 = 0u, pos1 = 0u;
#pragma unroll
            for (int e = 0; e < NE; ++e) { const unsigned long long b0 = __ballot(valid && my_e0 == e), b1 = __ballot(valid && my_e1 == e);
                const unsigned be = (unsigned)__shfl((int)basev, e);
                if (my_e0 == e) pos0 = be + (unsigned)__popcll(b0 & lt);
                if (my_e1 == e) pos1 = be + (unsigned)__popcll(b0) + (unsigned)__popcll(b1 & lt); }
            if (valid) {
                ((GAS unsigned*)R.ltok)[(size_t)my_e0 * LIST_CAP + pos0] = (unsigned)my_t;             ((GAS float*)R.lw)[(size_t)my_e0 * LIST_CAP + pos0] = my_w0;
                ((GAS unsigned*)R.ltok)[(size_t)my_e1 * LIST_CAP + pos1] = (unsigned)my_t | (1u << 20); ((GAS float*)R.lw)[(size_t)my_e1 * LIST_CAP + pos1] = my_w1;
            }
        }
    }
    if constexpr (MODE == 2) { LDS_WAIT(); __syncthreads(); }
}

__device__ __forceinline__ void kstat_phase(Frame& F, const bf16* Kt, float* kmean, float* kmax2) {
    int lane_ = F.lane; asm volatile("" : "+v"(lane_));
    const int gw = F.vcu * NWAVES + F.wave, NGW = F.G * NWAVES, lane = lane_;
    for (int task = gw; task < BATCH * 16 * 8; task += NGW) {
        const int c8 = task & 7, n = (task >> 3) & 15, b = task >> 7;
        const GAS unsigned* p = (const GAS unsigned*)(Kt + ((size_t)b * SEQ + 256 * n) * D + c8 * 128) + lane;
        float a0 = 0.f, a1 = 0.f, mx = 0.f;
#pragma unroll 32
        for (int r = 0; r < 256; ++r) { const unsigned w = p[(size_t)r * (D / 2)]; const float v0 = bflo(w), v1 = bfhi(w); a0 += v0; a1 += v1;
            float s = v0 * v0 + v1 * v1; s += __shfl_xor(s, 1); s += __shfl_xor(s, 2); s += __shfl_xor(s, 4); s += __shfl_xor(s, 8); s += __shfl_xor(s, 16); mx = fmaxf(mx, s); }
        const int col = c8 * 128 + 2 * lane, hh = col >> 6, d = col & 63;
        GAS float* o = (GAS float*)(kmean + ((size_t)(b * 16 + hh) * 16 + n) * 64 + d);
        o[0] = a0 * (1.f / 256.f); o[1] = a1 * (1.f / 256.f);
        if ((lane & 31) == 0) ((GAS float*)kmax2)[(size_t)(b * 16 + hh) * 16 + n] = mx;
    }
}

struct KArgs { const float* in[17]; float* out; unsigned char* ws; int ph_lo, ph_hi; };
__global__ void __launch_bounds__(NWAVES * 64, 2) trunk_fwd(KArgs args) {
    extern __shared__ __attribute__((aligned(16))) unsigned char lds[];
    Frame F;
    F.lds = (LAS unsigned char*)lds;
    F.MISC = (volatile LAS unsigned*)(F.lds + MISC_OFF);
    F.tid = threadIdx.x; F.lane = F.tid & 63; F.wave = __builtin_amdgcn_readfirstlane(F.tid >> 6);
    F.G = gridDim.x; { const int bx = blockIdx.x; F.vcu = (F.G % 8 == 0) ? (bx % 8) * (F.G / 8) + bx / 8 : bx; }
    F.ctl = (gu32*)(args.ws + WS_CTL);
    for (int u = F.tid; u < (LDS_BYTES - LDSCTL_OFF) / 4; u += NWAVES * 64) ((LAS unsigned*)(F.lds + LDSCTL_OFF))[u] = 0u;
    __syncthreads();
    Frame& F0 = F;
    const int lo = args.ph_lo, hi = args.ph_hi;
    XcdBarrier bar; bar.bar = (unsigned*)(F.ctl + CW_BAR); bar.x = 0; bar.st = nullptr;
    if (hi - lo > 1) bar = xcd_barrier_post((unsigned*)(F.ctl + CW_BAR), F.MISC + 8);
#define IN(k) (lo <= (k) && (k) < hi)
#ifndef PH_ENABLE
#define PH_ENABLE 0xFFFFFFFFu
#endif
#define PHEN(n) (((PH_ENABLE) >> (n)) & 1u)
#ifndef MK_DOUBLE
#define MK_DOUBLE 0u
#endif
#define NREP(n) ((((MK_DOUBLE) >> (n)) & 1u) ? 2 : 1)
#if defined(NO_OPQ)
#define OPQ(p) do {} while (0)
#else
#define OPQ(p) asm volatile("" : "+s"(p))
#endif
#if 0
#define STAMP(k) do { if (blockIdx.x == 0 && threadIdx.x == 0) { const unsigned long long t_ = __builtin_amdgcn_s_memrealtime(); ((GAS unsigned*)(F0.ctl))[3000 + (k)] = (unsigned)t_; } } while (0)
#else
#define STAMP(k) do {} while (0)
#endif
#define SEAM(k) do { if (IN(k) && IN((k) + 1)) { XcdBarrier b2_ = bar; OPQ(b2_.bar); xcd_barrier(b2_); } STAMP((k) + 1); } while (0)

#define PTRS() unsigned char* ws = args.ws; OPQ(ws); const float* x = args.in[0]; OPQ(x); const float* norm_mix = args.in[1]; OPQ(norm_mix); const float* norm_ffn = args.in[2]; OPQ(norm_ffn); \
    float* h = args.out; OPQ(h); \
    bf16* XN = (bf16*)(ws + WS_XN); bf16* Qb = (bf16*)(ws + WS_Q); bf16* Kb = (bf16*)(ws + WS_K); bf16* Vb = (bf16*)(ws + WS_V); bf16* ACT = (bf16*)(ws + WS_ACT); \
    bf16* MGU = (bf16*)(ws + WS_MGU); bf16* MD = (bf16*)(ws + WS_MD); \
    float* kmean = (float*)(ws + WS_KMEAN); unsigned* ltok = (unsigned*)(ws + WS_LTOK); float* lw = (float*)(ws + WS_LW); \
    (void)x; (void)norm_mix; (void)norm_ffn; (void)h; (void)XN; (void)Qb; (void)Kb; (void)Vb; (void)ACT; (void)MGU; (void)MD; (void)kmean; (void)ltok; (void)lw
    const RouterArgs noR{nullptr, nullptr, nullptr, nullptr};
#ifndef MK_F8_DENSE
#define MK_F8_DENSE 0
#endif
    constexpr bool F8_DENSE = MK_F8_DENSE != 0; constexpr int DESZ = F8_DENSE ? 1 : 2;
    constexpr float WSC_UP = 32.0f, WSC_DN = 64.0f;
    constexpr float C2 = 0.125f * 1.4426950408889634f;

    STAMP(0);
    if (PHEN(0) && IN(0)) {
        PTRS();
        for (int rep_ = 0; rep_ < NREP(0); ++rep_) {
        unsigned rot = 0u;
        for (int j = 0; j < 2; ++j) {
            convert_matrix(F, args.in[3] + (size_t)j * D * 3 * D, D, 3 * D, (bf16*)(ws + WS_DQKV) + (size_t)j * 3 * D * D, 0, rot);
            convert_matrix(F, args.in[4] + (size_t)j * D * D, D, D, (bf16*)(ws + WS_DWO) + (size_t)j * D * D, 0, rot);
            convert_matrix(F, args.in[7] + (size_t)j * D * 3 * D, D, 3 * D, (bf16*)(ws + WS_MQKV) + (size_t)j * 3 * D * D, 0, rot);
            convert_matrix(F, args.in[8] + (size_t)j * D * D, D, D, (bf16*)(ws + WS_MWO) + (size_t)j * D * D, 0, rot);
            { const bool f8d = (j == 1);
              convert_matrix(F, args.in[9] + (size_t)j * D * DFF, D, DFF, ws + WS_FGU + (size_t)j * 2 * DFF * D * 2, 1, rot, f8d, f8d ? WSC_UP : 1.0f);
              convert_matrix(F, args.in[10] + (size_t)j * D * DFF, D, DFF, ws + WS_FGU + (size_t)j * 2 * DFF * D * 2, 2, rot, f8d, f8d ? WSC_UP : 1.0f);
              convert_matrix(F, args.in[11] + (size_t)j * DFF * D, DFF, D, ws + WS_FD + (size_t)j * D * DFF * 2, 0, rot, f8d, f8d ? WSC_DN : 1.0f); }
        }
        for (int e = 0; e < 2 * NE; ++e) {
            convert_matrix(F, args.in[13] + (size_t)e * D * DE, D, DE, ws + WS_MGU + (size_t)e * 2 * DE * D, 1, rot, true, WSC_UP);
            convert_matrix(F, args.in[14] + (size_t)e * D * DE, D, DE, ws + WS_MGU + (size_t)e * 2 * DE * D, 2, rot, true, WSC_UP);
            convert_matrix(F, args.in[15] + (size_t)e * DE * D, DE, D, ws + WS_MD + (size_t)e * D * DE, 0, rot, true, WSC_DN);
        }
        norm_phase<0>(F, x, nullptr, nullptr, norm_mix, XN, nullptr, noR);
        }
    }
    SEAM(0);

    for (int L = 0; L < NLAYER; ++L) {
        const int j = L >> 1, moba = L & 1, pb = 1 + PH_PER_LAYER * L;
        int z_ = 0;
#if !defined(NO_OPQ_Z)
        asm volatile("" : "+s"(z_));
#endif
        Frame Fl = F0; Fl.G += z_; Fl.vcu += z_; Fl.wave += z_; Fl.lds += z_; Fl.ctl += z_; const int bx = (int)blockIdx.x + z_;
#define F Fl
        if (PHEN(1) && IN(pb + 0)) {
            PTRS();

            const bf16* W = (const bf16*)(ws + (moba ? WS_MQKV : WS_DQKV)) + (size_t)j * 3 * D * D;
            pg8::Gemm g{XN, W, 2 * D, 0}; pg8::StaticOrder S; S.init(MTOK, 3 * D, F.G, bx);
            pg8::EpiQKV E{Qb, D, D, (size_t)(WS_K - WS_Q) / 2, C2};
            for (int rep_ = 0; rep_ < NREP(1); ++rep_) pg8::gemm_phase<pg8::EpiQKV, pg8::StaticOrder>(F.lds + RING_OFF, XSLOT_OFF, g, S, E);
        }
        SEAM(pb + 0);
        { if (PHEN(2) && IN(pb + 1)) { PTRS(); kstat_phase(F, Kb, kmean, kmean + 8 * 16 * 16 * 64); } SEAM(pb + 1); }
        if (IN(pb + 2)) {
            PTRS();
            att::Args A; A.Q = Qb; A.K = Kb; A.V = Vb; A.O = XN; A.kmean = kmean; A.kmax2 = kmean + 8 * 16 * 16 * 64; A.subln = args.in[6] + (size_t)j * 128; A.lam_full = 0.f; A.out_scale = 1.f;
            gu32* qctr = F.ctl + CW_ATTQ + 64 * L; LAS int* qw = (LAS int*)(F.lds + RING_OFF + 71680 + 260);
            if (!moba) {
                const float* lam = args.in[5] + (size_t)j * 256; int lane = F.lane; asm volatile("" : "+v"(lane));
                const GAS float* lamg = (const GAS float*)lam; const float s1 = wave_sum(lamg[lane] * lamg[64 + lane]), s2 = wave_sum(lamg[128 + lane] * lamg[192 + lane]);
                const float lam_init = (L == 0) ? 0.2f : 0.47071302f;
                A.lam_full = __uint_as_float(__builtin_amdgcn_readfirstlane(__float_as_uint(__expf(s1) - __expf(s2) + lam_init))); A.out_scale = __uint_as_float(__builtin_amdgcn_readfirstlane(__float_as_uint(1.0f - lam_init)));
            }
            if ((PHEN(3) && !moba) || (PHEN(4) && moba)) for (;;) {
                if (F.tid == 0) *qw = (int)__hip_atomic_fetch_add(qctr, 1u, RLX_AGENT);
                asm volatile("s_waitcnt vmcnt(0) lgkmcnt(0)\n\ts_barrier" ::: "memory");
                const int idx = __builtin_amdgcn_readfirstlane(*qw);
                if (idx >= 1024) break;
                if (!moba) { const int hh = 7 - (idx >> 7), bb = (idx >> 4) & 7, pr = idx & 15;
                    att::attn_unit<0>(F.lds + RING_OFF, A, bb, hh, pr);
                    att::attn_unit<0>(F.lds + RING_OFF, A, bb, hh, 31 - pr);
                } else { const int hh = 15 - (idx >> 6), bb = (idx >> 3) & 7, pr = idx & 7;
                    att::attn_unit<1>(F.lds + RING_OFF, A, bb, hh, pr);
                    att::attn_unit<1>(F.lds + RING_OFF, A, bb, hh, 15 - pr); }
            }
            asm volatile("s_waitcnt vmcnt(0) lgkmcnt(0)\n\ts_barrier" ::: "memory");
        }
        SEAM(pb + 2);
        if (PHEN(5) && IN(pb + 3)) {
            PTRS();
            const bf16* W = (const bf16*)(ws + (moba ? WS_MWO : WS_DWO)) + (size_t)j * D * D;
            pg8::Gemm g{XN, W, 2 * D, 0}; pg8::StaticOrder S; S.init(MTOK, D, F.G, bx);
            pg8::EpiRes E{L == 0 ? x : h, h, D, 1.0f};
            pg8::gemm_phase<pg8::EpiRes, pg8::StaticOrder>(F.lds + RING_OFF, XSLOT_OFF, g, S, E);
        }
        SEAM(pb + 3);
        if (PHEN(6) && IN(pb + 4)) {
            PTRS();
            if (!moba) {
                if (L == 2) norm_phase<0, true>(F, h, nullptr, nullptr, norm_ffn + (size_t)L * D, XN, nullptr, noR);
                else norm_phase<0, false>(F, h, nullptr, nullptr, norm_ffn + (size_t)L * D, XN, nullptr, noR);
            } else {
                const RouterArgs R{args.in[12] + (size_t)j * D * NE, F.ctl + CW_CNT + 64 * NE * j, ltok, lw};
                norm_phase<2, true>(F, h, nullptr, nullptr, norm_ffn + (size_t)L * D, XN, nullptr, R);
            }
        }
        SEAM(pb + 4);
        if (IN(pb + 5)) {
            PTRS();
            if (PHEN(7) && !moba) {
                if (L == 2) { pg8::Gemm g{XN, ws + WS_FGU + (size_t)j * 2 * DFF * D * 2, D, 0}; pg8::StaticOrder S; S.init(MTOK, 2 * DFF, F.G, bx);
                    pg8::EpiSwiGLU<true> E{ACT, DFF, 1.0f / WSC_UP};
                    pg8::gemm_phase<pg8::EpiSwiGLU<true>, pg8::StaticOrder, true>(F.lds + RING_OFF, XSLOT_OFF, g, S, E);
                } else { pg8::Gemm g{XN, ws + WS_FGU + (size_t)j * 2 * DFF * D * 2, 2 * D, 0}; pg8::StaticOrder S; S.init(MTOK, 2 * DFF, F.G, bx);
                    pg8::EpiSwiGLU<false> E{ACT, DFF, 1.0f};
                    pg8::gemm_phase<pg8::EpiSwiGLU<false>, pg8::StaticOrder, false>(F.lds + RING_OFF, XSLOT_OFF, g, S, E); }
            } else if (PHEN(8) && moba) {
                pg8::Gemm g{XN, ws + WS_MGU + (size_t)j * NE * 2 * DE * D, D, (size_t)2 * DE * D}; pg8::MoeOrder S; S.init((const unsigned*)(F.ctl + CW_CNT + 64 * NE * j), ltok, true, 2 * DE, F.G, bx);
                pg8::EpiSwiGLU<true> E{ACT, DE, 1.0f / WSC_UP};
                pg8::gemm_phase<pg8::EpiSwiGLU<true>, pg8::MoeOrder, true>(F.lds + RING_OFF, XSLOT_OFF, g, S, E);
            }
        }
        SEAM(pb + 5);
        if (IN(pb + 6)) {
            PTRS();
            if (PHEN(9) && !moba) {
                if (L == 2) { pg8::Gemm g{ACT, ws + WS_FD + (size_t)j * D * DFF * 2, DFF, 0}; pg8::StaticOrder S; S.init(MTOK, D, F.G, bx);
                    pg8::EpiRes E{h, h, D, 1.0f / WSC_DN};
                    pg8::gemm_phase<pg8::EpiRes, pg8::StaticOrder, true>(F.lds + RING_OFF, XSLOT_OFF, g, S, E);
                } else { pg8::Gemm g{ACT, ws + WS_FD + (size_t)j * D * DFF * 2, 2 * DFF, 0}; pg8::StaticOrder S; S.init(MTOK, D, F.G, bx);
                    pg8::EpiRes E{h, h, D, 1.0f};
                    pg8::gemm_phase<pg8::EpiRes, pg8::StaticOrder, false>(F.lds + RING_OFF, XSLOT_OFF, g, S, E); }
            } else if (PHEN(10) && moba) {
                pg8::Gemm g{ACT, ws + WS_MD + (size_t)j * NE * D * DE, DE, (size_t)D * DE}; pg8::MoeOrder S; S.init((const unsigned*)(F.ctl + CW_CNT + 64 * NE * j), ltok, false, D, F.G, bx);
                pg8::EpiMoeDown E; E.h = h; E.y1 = XN; E.list_tok = ltok; E.list_w = lw; E.sc = 1.0f / WSC_DN;
#pragma unroll
                for (int e = 0; e < NE; ++e) E.cnt[e] = S.cnt[e];
                pg8::gemm_phase<pg8::EpiMoeDown, pg8::MoeOrder, true>(F.lds + RING_OFF, XSLOT_OFF, g, S, E);
            }
        }
        SEAM(pb + 6);
        if (PHEN(11) && IN(pb + 7)) {
            PTRS();
            if (L == 3) norm_phase<3>(F, h, nullptr, XN, args.in[16], nullptr, h, noR);
            else if (moba) norm_phase<1>(F, h, h, XN, norm_mix + (size_t)(L + 1) * D, XN, nullptr, noR);
            else for (int rep_ = 0; rep_ < NREP(11); ++rep_) norm_phase<0>(F, h, nullptr, nullptr, norm_mix + (size_t)(L + 1) * D, XN, nullptr, noR);
        }
        if (L != NLAYER - 1) SEAM(pb + 7); else STAMP(pb + 8);
#undef F
    }
#undef IN
#undef SEAM
#undef PTRS
#undef OPQ
}


#if MK_DEBUG
__global__ void dbg_probe(const void* buf, size_t n, int is_bf16, int idx, float thresh, unsigned* dbg) {
    size_t i = blockIdx.x * (size_t)blockDim.x + threadIdx.x, stride = (size_t)gridDim.x * blockDim.x; bool bad = false;
    for (size_t k = i; k < n; k += stride) { float v = is_bf16 ? __uint_as_float(((unsigned)((const unsigned short*)buf)[k]) << 16) : ((const float*)buf)[k]; if (!(fabsf(v) <= thresh)) bad = true; }
    if (bad) atomicMax(dbg, (unsigned)(1000 - idx));
}
__global__ void dbg_cnt(const unsigned* cntw, int idx, unsigned* dbg) {
    if (threadIdx.x == 0 && blockIdx.x == 0) { unsigned s = 0; for (int e = 0; e < NE; ++e) s += cntw[64 * e]; if (s != 2u * MTOK) atomicMax(dbg, (unsigned)(1000 - idx)); }
}

__device__ __forceinline__ float dbg_bf(unsigned short v) { return __uint_as_float(((unsigned)v) << 16); }
__device__ __forceinline__ unsigned dbg_hash(unsigned x) { x ^= x >> 16; x *= 0x7feb352dU; x ^= x >> 15; x *= 0x846ca68bU; x ^= x >> 16; return x; }
__global__ void dbg_gemm_check(const unsigned short* A, int lda, const unsigned short* Bt, int K, const unsigned short* out, int ldo, int M, int N, float scale, int idx, unsigned* dbg) {
    const unsigned s = blockIdx.x * blockDim.x + threadIdx.x; const int row = (int)(dbg_hash(2 * s + 1) % (unsigned)M), col = (int)(dbg_hash(2 * s + 2) % (unsigned)N);
    float acc = 0.f; for (int k = 0; k < K; ++k) acc += dbg_bf(A[(size_t)row * lda + k]) * dbg_bf(Bt[(size_t)col * K + k]);
    acc *= scale; const float got = dbg_bf(out[(size_t)row * ldo + col]);
    if (!(fabsf(got - acc) <= 0.03f + 0.02f * fabsf(acc))) { atomicMax(dbg, (unsigned)(1000 - idx)); atomicAdd(dbg + 64 + idx, 1u); }
}
__global__ void dbg_conv_check(const float* W, int K, int N, const unsigned short* WT, int il, int idx, unsigned* dbg) {
    const unsigned s = blockIdx.x * blockDim.x + threadIdx.x; const int k = (int)(dbg_hash(2 * s + 1) % (unsigned)K), n = (int)(dbg_hash(2 * s + 2) % (unsigned)N);
    const int dr = il == 0 ? n : (n / 128) * 256 + (il - 1) * 128 + (n % 128);
    const float w = W[(size_t)k * N + n], g = dbg_bf(WT[(size_t)dr * K + k]);
    if (!(fabsf(g - w) <= 0.01f * fabsf(w) + 1e-6f)) atomicMax(dbg, (unsigned)(1000 - idx));
}
__global__ void dbg_norm_check(const float* src, const float* gain, const unsigned short* xn, int idx, unsigned* dbg) {
    const unsigned s = blockIdx.x * blockDim.x + threadIdx.x; const int row = (int)(dbg_hash(s + 77) % (unsigned)MTOK);
    float ss = 0.f; for (int c = 0; c < D; ++c) { const float v = src[(size_t)row * D + c]; ss += v * v; }
    const float rstd = 1.f / sqrtf(ss / D + 1e-6f); bool bad = false;
    for (int c = 0; c < D; ++c) { const float r = src[(size_t)row * D + c] * rstd * gain[c], g = dbg_bf(xn[(size_t)row * D + c]); if (!(fabsf(g - r) <= 0.02f + 0.01f * fabsf(r))) bad = true; }
    if (bad) atomicMax(dbg, (unsigned)(1000 - idx));
}
__global__ void dbg_naive_gemm(const unsigned short* A, const unsigned short* Bt, unsigned short* out, int M, int N, int K) {
    const size_t i = blockIdx.x * (size_t)blockDim.x + threadIdx.x; if (i >= (size_t)M * N) return; const int row = (int)(i / N), col = (int)(i % N);
    float acc = 0.f; for (int k = 0; k < K; ++k) acc += dbg_bf(A[(size_t)row * K + k]) * dbg_bf(Bt[(size_t)col * K + k]);
    out[(size_t)row * N + col] = (unsigned short)f2bf(acc);
}
__global__ void dbg_find_col(const unsigned short* out, const unsigned short* ref, int M, int N, unsigned* hist) {
    const unsigned s = blockIdx.x * blockDim.x + threadIdx.x; const int row = (int)(dbg_hash(2 * s + 1) % (unsigned)M), col = (int)(dbg_hash(2 * s + 2) % (unsigned)N);
    const unsigned short v = out[(size_t)row * N + col]; int found = -1;
#if MK_FIND_PATTERN
    if (v == 0x3C3C) atomicAdd(hist + N, 1u); else atomicAdd(hist + 5, 1u); return;
#endif
#if MK_FIND_ROWS
    for (int r = 0; r < M; ++r) if (ref[(size_t)r * N + col] == v) { found = r; break; }
    if (found < 0) atomicAdd(hist + N, 1u); else atomicAdd(hist + ((found - row) & (N - 1)), 1u);
#else
    for (int c = 0; c < N; ++c) if (ref[(size_t)row * N + c] == v) { found = c; break; }
    if (found < 0) atomicAdd(hist + N, 1u); else atomicAdd(hist + ((found - col) & (N - 1)), 1u);
#endif
}
__global__ void dbg_hist_code(const unsigned* hist, int N, unsigned* dbg) {
    if (threadIdx.x || blockIdx.x) return; unsigned best = 0, bi = 0; for (int i = 0; i < N; ++i) if (hist[i] > best) { best = hist[i]; bi = i; }
    dbg[32] = bi; dbg[33] = best; dbg[34] = hist[N];
}
__global__ void dbg_final(float* out, size_t n, const unsigned* dbg) {
    if (MK_HIST_SEL >= 10) { const float c3 = sqrtf((float)dbg[MK_HIST_SEL + 30]); size_t i3 = blockIdx.x * (size_t)blockDim.x + threadIdx.x, st3 = (size_t)gridDim.x * blockDim.x; for (size_t k3 = i3; k3 < n; k3 += st3) out[k3] = c3; return; }
    if (MK_HIST_SEL >= 0 && (dbg[33] || dbg[34])) { const float c2 = sqrtf((float)(MK_HIST_SEL == 0 ? dbg[32] : (MK_HIST_SEL == 1 ? dbg[33] * 100u / 4096u : dbg[34] * 100u / 4096u)) + 1.f); size_t i2 = blockIdx.x * (size_t)blockDim.x + threadIdx.x, st2 = (size_t)gridDim.x * blockDim.x; for (size_t k2 = i2; k2 < n; k2 += st2) out[k2] = c2; return; }
    const unsigned d = dbg[0]; if (d == 0u) return; const unsigned nf = dbg[64 + (1000u - d)]; const float c = sqrtf(nf ? (float)(200u * (1000u - d - 9u) + nf * 100u / 4096u) : (float)(1000u - d));
    size_t i = blockIdx.x * (size_t)blockDim.x + threadIdx.x, stride = (size_t)gridDim.x * blockDim.x;
    for (size_t k = i; k < n; k += stride) out[k] = c;
}
#endif

#ifndef MK_REPEAT
#define MK_REPEAT 1
#endif
#ifndef MK_FIND_ROWS
#define MK_FIND_ROWS 0
#endif
#ifndef MK_FIND_REGION
#define MK_FIND_REGION WS_K
#endif
#ifndef MK_HIST_SEL
#define MK_HIST_SEL 0
#endif
#ifndef MK_STAMP
#define MK_STAMP 0
#endif
#if MK_STAMP
__global__ void stamp_k(unsigned* p) { if (threadIdx.x == 0) *p = (unsigned)__builtin_amdgcn_s_memrealtime(); }
__global__ void stamp_encode(float* out, size_t n, const unsigned* st, int pa, float ua, int pb, float ub) {
    const float da = (float)(st[pa + 1] - st[pa]) * 0.01f, db = (float)(st[pb + 1] - st[pb]) * 0.01f;
    float m = da / ua; m = m < 10.f ? 10.f : (m > 99.f ? 99.f : m); float e = floorf(db / ub + 0.5f); e = e < 0.f ? 0.f : (e > 30.f ? 30.f : e);
    const float c = sqrtf(m) * __powf(10.f, 0.5f * e);
    size_t i = blockIdx.x * (size_t)blockDim.x + threadIdx.x, stride = (size_t)gridDim.x * blockDim.x;
    for (size_t k = i; k < n; k += stride) out[k] = c;
}
#endif
extern "C" void kernel_launch(void* const* d_in, const int* in_sizes, int n_in, void* d_out, int out_size, void* d_ws, size_t ws_size, hipStream_t stream) {
    static int grid = 0;
    if (grid == 0) {
        if (n_in != 17 || in_sizes[0] != MTOK * D || out_size != MTOK * D || ws_size < WS_END) {
            fprintf(stderr, "kernel_launch: built for 17 inputs, x/out of %d floats, >= %zu bytes of workspace; got n_in %d, in0 %d, out %d, ws %zu; nothing launched\n", MTOK * D, (size_t)WS_END, n_in, n_in > 0 ? in_sizes[0] : -1, out_size, ws_size);
            grid = -1; return; }
        int dev = 0, cus = 0, per_cu = 0;
        if (hipGetDevice(&dev) != hipSuccess || hipDeviceGetAttribute(&cus, hipDeviceAttributeMultiprocessorCount, dev) != hipSuccess) { fprintf(stderr, "kernel_launch: device query failed\n"); grid = -1; return; }
        if (hipFuncSetAttribute((const void*)trunk_fwd, hipFuncAttributeMaxDynamicSharedMemorySize, LDS_BYTES) != hipSuccess) { fprintf(stderr, "kernel_launch: hipFuncSetAttribute failed\n"); grid = -1; return; }
        if (hipOccupancyMaxActiveBlocksPerMultiprocessor(&per_cu, (const void*)trunk_fwd, NWAVES * 64, LDS_BYTES) != hipSuccess || per_cu < 1)
            fprintf(stderr, "kernel_launch: note: occupancy query reports %d workgroups per CU\n", per_cu);
        (void)hipGetLastError();
        grid = cus;
    }
    if (grid < 0) return;
    if (hipMemsetAsync((char*)d_ws + WS_CTL, 0, CTL_ZERO_BYTES, stream) != hipSuccess) { fprintf(stderr, "kernel_launch: memset failed\n"); return; }
    KArgs a{};
    for (int i = 0; i < 17; ++i) a.in[i] = (const float*)d_in[i];
    a.out = (float*)d_out; a.ws = (unsigned char*)d_ws;
#if MK_PER_PHASE
#if MK_STAMP
    hipLaunchKernelGGL(stamp_k, dim3(1), dim3(64), 0, stream, (unsigned*)d_ws + 3000);
#endif
    for (int p = 0; p < NPHASE; ++p) {
        a.ph_lo = p; a.ph_hi = p + 1;
#if MK_DEBUG
#endif
#if !defined(MK_SKIP_MAIN)
        for (int rep_ = 0; rep_ < (p == 1 ? MK_REPEAT : 1); ++rep_) hipLaunchKernelGGL(trunk_fwd, dim3(grid), dim3(NWAVES * 64), LDS_BYTES, stream, a);
#endif
#if MK_STAMP
        hipLaunchKernelGGL(stamp_k, dim3(1), dim3(64), 0, stream, (unsigned*)d_ws + 3000 + p + 1);
#endif
#if MK_DEBUG
        {   unsigned char* ws = (unsigned char*)d_ws; unsigned* dbg = (unsigned*)(ws + WS_CTL) + 2048;
            const size_t MD_ = (size_t)MTOK * D;
#define PROBE(buf, n, isbf, idx, th) if ((idx) <= MK_PROBE_MAX) hipLaunchKernelGGL(dbg_probe, dim3(2048), dim3(256), 0, stream, (const void*)(buf), (size_t)(n), isbf, idx, th, dbg)
            if (p == 0) {
                hipLaunchKernelGGL(dbg_norm_check, dim3(4), dim3(64), 0, stream, (const float*)d_in[0], (const float*)d_in[1], (const unsigned short*)(ws + WS_XN), 4, dbg);
                hipLaunchKernelGGL(dbg_conv_check, dim3(16), dim3(256), 0, stream, (const float*)d_in[3], D, 3 * D, (const unsigned short*)(ws + WS_DQKV), 0, 5, dbg);
                hipLaunchKernelGGL(dbg_conv_check, dim3(16), dim3(256), 0, stream, (const float*)d_in[9], D, DFF, (const unsigned short*)(ws + WS_FGU), 1, 6, dbg);
                hipLaunchKernelGGL(dbg_conv_check, dim3(16), dim3(256), 0, stream, (const float*)d_in[10], D, DFF, (const unsigned short*)(ws + WS_FGU), 2, 7, dbg);
                hipLaunchKernelGGL(dbg_conv_check, dim3(16), dim3(256), 0, stream, (const float*)d_in[11], DFF, D, (const unsigned short*)(ws + WS_FD), 0, 8, dbg);
                hipLaunchKernelGGL(dbg_conv_check, dim3(16), dim3(256), 0, stream, (const float*)d_in[15] + (size_t)3 * DE * D, DE, D, (const unsigned short*)(ws + WS_MD) + (size_t)3 * D * DE, 0, 9, dbg);
            }
            if (p == 1) {
                const float C2h = 0.125f * 1.4426950408889634f;
                hipLaunchKernelGGL(dbg_gemm_check, dim3(16), dim3(256), 0, stream, (const unsigned short*)(ws + WS_XN), D, (const unsigned short*)(ws + WS_DQKV), D, (const unsigned short*)(ws + WS_Q), D, MTOK, D, C2h, 10, dbg);
                hipLaunchKernelGGL(dbg_gemm_check, dim3(16), dim3(256), 0, stream, (const unsigned short*)(ws + WS_XN), D, (const unsigned short*)(ws + WS_DQKV) + (size_t)D * D, D, (const unsigned short*)(ws + WS_K), D, MTOK, D, 1.f, 11, dbg);

                hipLaunchKernelGGL(dbg_gemm_check, dim3(16), dim3(256), 0, stream, (const unsigned short*)(ws + WS_XN), D, (const unsigned short*)(ws + WS_DQKV) + (size_t)2 * D * D, D, (const unsigned short*)(ws + WS_V), D, MTOK, D, 1.f, 12, dbg);
            }
            if (0) { PROBE(ws + WS_XN, MD_, 1, 1, 10.f); PROBE(ws + WS_DQKV, (WS_MGU - WS_DQKV) / 2, 1, 2, 1.f); PROBE(ws + WS_MGU, (WS_XN - WS_MGU) / 2, 1, 3, 1.f); }
            if (p >= 1) { const int L = (p - 1) / PH_PER_LAYER, k = (p - 1) % PH_PER_LAYER; const int b = 20 + 10 * L;
                if (k == 0) PROBE(ws + WS_Q, 3 * MD_, 1, b + 0, 50.f);
                if (k == 1) PROBE(ws + WS_KMEAN, 8 * 16 * 16 * 64, 0, b + 1, 5.f);
                if (k == 2) PROBE(ws + WS_XN, MD_, 1, b + 2, 50.f);
                if (k == 3) PROBE(d_out, MD_, 0, b + 3, 300.f);
                if (k == 4) { PROBE(ws + WS_XN, MD_, 1, b + 4, 20.f); if ((L & 1) && (b + 9) <= MK_PROBE_MAX) hipLaunchKernelGGL(dbg_cnt, dim3(1), dim3(64), 0, stream, (const unsigned*)(ws + WS_CTL) + CW_CNT + 64 * NE * (L >> 1), b + 9, dbg); }
                if (k == 5) PROBE(ws + WS_ACT, (L & 1) ? (size_t)256 * 256 * DE : (size_t)MTOK * DFF, 1, b + 5, 2000.f);
                if (k == 6) { PROBE(d_out, MD_, 0, b + 6, 1000.f); if (L & 1) PROBE(ws + WS_XN, MD_, 1, b + 7, 1000.f); }
                if (k == 7 && L != 3) { PROBE(ws + WS_XN, MD_, 1, b + 8, 20.f); PROBE(d_out, MD_, 0, b + 8, 1000.f); }
            }
#undef PROBE
        }
#endif
    }
#if MK_DEBUG
    hipLaunchKernelGGL(dbg_final, dim3(2048), dim3(256), 0, stream, (float*)d_out, (size_t)MTOK * D, (const unsigned*)((unsigned char*)d_ws + WS_CTL) + 2048);
#endif
#else
    a.ph_lo = 0; a.ph_hi = NPHASE;
    hipLaunchKernelGGL(trunk_fwd, dim3(grid), dim3(NWAVES * 64), LDS_BYTES, stream, a);
#if 0
    hipLaunchKernelGGL(stamp_encode, dim3(2048), dim3(256), 0, stream, (float*)d_out, (size_t)MTOK * D, (const unsigned*)d_ws + 3000, MK_STAMP_PA, MK_STAMP_UA, MK_STAMP_PB, MK_STAMP_UB);
#endif
#endif
#if MK_STAMP
    hipLaunchKernelGGL(stamp_encode, dim3(2048), dim3(256), 0, stream, (float*)d_out, (size_t)MTOK * D, (const unsigned*)d_ws + 3000, MK_STAMP_PA, MK_STAMP_UA, MK_STAMP_PB, MK_STAMP_UB);
#endif
    const hipError_t le = hipPeekAtLastError();
    if (le != hipSuccess) fprintf(stderr, "kernel_launch: launch failed: %s\n", hipGetErrorName(le));
}
```

```cpp
#define MK_DEBUG 0
#define MK_PER_PHASE 0
#define MK_DOUBLE 0x0u
#include <hip/hip_runtime.h>
#include <cstdio>
#include <cstdint>

#ifndef MK_DEBUG
#define MK_DEBUG 1
#endif
#ifndef MK_KDEBUG
#define MK_KDEBUG 0
#endif
#define LAS __attribute__((address_space(3)))
#define GAS __attribute__((address_space(1)))

constexpr int BATCH = 8, SEQ = 4096, MTOK = BATCH * SEQ, D = 1024, DFF = 2816, DE = 3584, NE = 8;
constexpr int MOE_TILES_MAX = 272;
constexpr int LIST_CAP = MTOK;

namespace pg8 {
#define PG8_LAS __attribute__((address_space(3)))
typedef unsigned short bf16_t;
typedef short bf16x8 __attribute__((ext_vector_type(8)));
typedef float f32x4 __attribute__((ext_vector_type(4)));
typedef unsigned u32x4 __attribute__((ext_vector_type(4)));
typedef int i32x4 __attribute__((ext_vector_type(4)));
typedef int i32x8 __attribute__((ext_vector_type(8)));
constexpr int BM = 256, BK = 64, HALF = 128, HTB = HALF * BK * 2  , STAGE_BYTES = 8 * HTB, NXCD = 8, WGM = 8;

__host__ __device__ __forceinline__ int lds_byte(int r, int c) { const int st = (r >> 4) * 2 + (c >> 5), rr = r & 15, cc = c & 31, ob = rr * 64 + cc * 2; return st * 1024 + (ob ^ (((ob >> 9) & 1) << 5)); }
__host__ __device__ __forceinline__ void stage_rc(int b, int& R, int& C) { const int st = b / 1024, sb = b % 1024, swz = sb ^ (((sb >> 9) & 1) << 5); R = (st >> 1) * 16 + swz / 64; C = (st & 1) * 32 + (swz % 64) / 2; }
__host__ __device__ __forceinline__ int perm32(int rho) { const int n = rho >> 4, i = rho & 15; return 8 * (i >> 2) + 4 * n + (i & 3); }

struct Unit { int pm, pn, e, r0; };
struct Gemm { const void* A; const void* Bt; int rowb; size_t bstride; };

__device__ __forceinline__ void tile_of(int L, int nM, int nN, int& pm, int& pn) {
    const int nwg = nM * nN; int wgid = L; { const int q = nwg / NXCD, r = nwg % NXCD, xcd = wgid % NXCD, off = wgid / NXCD; wgid = (xcd < r ? xcd * (q + 1) : r * (q + 1) + (xcd - r) * q) + off; }
    const int nig = WGM * nN, gid = wgid / nig, fm = gid * WGM, gsz = (nM - fm) < WGM ? (nM - fm) : WGM;
    pm = fm + ((wgid % nig) % gsz); pn = (wgid % nig) / gsz;
}
struct StaticOrder {
    int nM, nN, nwg, G, c;
    __device__ __forceinline__ void init(int M, int N, int G_, int c_) { nM = M / BM; nN = N / BM; nwg = nM * nN; G = G_; c = c_; }
    __device__ __forceinline__ bool next(int i, Unit& u) const {
        const long L = (long)i * G + c; if (L >= nwg) return false;
        tile_of((int)L, nM, nN, u.pm, u.pn); u.e = 0; u.r0 = 0; return true;
    }
    __device__ __forceinline__ unsigned arow(const Unit& u, int lr) const { return (unsigned)(u.pm * BM + lr); }
};
struct MoeOrder {
    int nM, nN, nwg, G, c; int tstart[NE + 1]; int cnt[NE]; const unsigned* list_tok; bool gather;
    __device__ __forceinline__ void init(const unsigned* cntw, const unsigned* list_tok_, bool gather_, int N, int G_, int c_) {
        int acc = 0;
#pragma unroll
        for (int e = 0; e < NE; ++e) { const int ce = (int)__builtin_amdgcn_readfirstlane((int)__hip_atomic_load((const GAS unsigned*)cntw + 64 * e, __ATOMIC_RELAXED, __HIP_MEMORY_SCOPE_AGENT)); cnt[e] = ce; tstart[e] = acc; acc += (ce + BM - 1) / BM; }
        tstart[NE] = acc; nM = acc; nN = N / BM; nwg = nM * nN; G = G_; c = c_; list_tok = list_tok_; gather = gather_;
    }
    __device__ __forceinline__ bool next(int i, Unit& u) const {
        const long L = (long)i * G + c; if (L >= nwg) return false;
        tile_of((int)L, nM, nN, u.pm, u.pn); int e = 0;
#pragma unroll
        for (int k = 1; k < NE; ++k) e += (u.pm >= tstart[k]) ? 1 : 0;
        u.e = e; int ts = 0;
#pragma unroll
        for (int k = 0; k < NE; ++k) ts = (k == e) ? tstart[k] : ts;
        u.r0 = (u.pm - ts) * BM; return true;
    }
    __device__ __forceinline__ int count_of(int e) const { int cv = 0;
#pragma unroll
        for (int k = 0; k < NE; ++k) cv = (k == e) ? cnt[k] : cv;
        return cv; }
    __device__ __forceinline__ unsigned arow(const Unit& u, int lr) const {
        if (!gather) return (unsigned)(u.pm * BM + lr);
        const int l = u.r0 + lr; const int cv = count_of(u.e);
        unsigned t = 0u; if (l < cv) t = __hip_atomic_load((const GAS unsigned*)list_tok + (size_t)u.e * LIST_CAP + l, __ATOMIC_RELAXED, __HIP_MEMORY_SCOPE_AGENT) & 0xFFFFFu;
        return t;
    }
};

__device__ __forceinline__ unsigned cvt_pk_bf16(float lo, float hi) { unsigned r; asm volatile("v_cvt_pk_bf16_f32 %0, %1, %2" : "=v"(r) : "v"(lo), "v"(hi)); return r; }

struct EpiQKV {
    static constexpr bool PERM = true;
    bf16_t* O; int ldc; int split_cols; size_t split_stride; float scale0;
    __device__ __forceinline__ void operator()(const f32x4 (&acc)[2][2][4][2], const Unit& u, int wr, int wc, int fr, int fq) const {
        const int row0 = u.pm * BM + wr * 64 + fr; int colt = u.pn * BM; bf16_t* base = O;
        float sc = 1.f; { const int t = colt / split_cols; base += (size_t)t * split_stride; colt -= t * split_cols; if (t == 0) sc = scale0; }
        const int col0 = colt + wc * 32 + 8 * fq;
#pragma unroll
        for (int ai = 0; ai < 2; ++ai)
#pragma unroll
            for (int m = 0; m < 4; ++m) { bf16_t* rowp = base + (size_t)(row0 + ai * HALF + m * 16) * ldc + col0;
#pragma unroll
                for (int bj = 0; bj < 2; ++bj) { f32x4 v0 = acc[ai][bj][m][0] * sc, v1 = acc[ai][bj][m][1] * sc;
                    u32x4 w; w.x = cvt_pk_bf16(v0[0], v0[1]); w.y = cvt_pk_bf16(v0[2], v0[3]); w.z = cvt_pk_bf16(v1[0], v1[1]); w.w = cvt_pk_bf16(v1[2], v1[3]);
                    *(GAS u32x4*)(rowp + bj * HALF) = w;
                    } }
    }
};
__device__ __forceinline__ unsigned pk4_fp8(float a, float b, float c, float d) { unsigned w = 0; w = __builtin_amdgcn_cvt_pk_fp8_f32(a, b, w, false); w = __builtin_amdgcn_cvt_pk_fp8_f32(c, d, w, true); return w; }
template <bool F8OUT> struct EpiSwiGLU {
    static constexpr bool PERM = true;
    void* O; int ldc; float sc;
    __device__ __forceinline__ void operator()(const f32x4 (&acc)[2][2][4][2], const Unit& u, int wr, int wc, int fr, int fq) const {
        const int row0 = u.pm * BM + wr * 64 + fr; const int col0 = u.pn * HALF + wc * 32 + 8 * fq;
#pragma unroll
        for (int ai = 0; ai < 2; ++ai)
#pragma unroll
            for (int m = 0; m < 4; ++m) { float o[8];
#pragma unroll
                for (int n = 0; n < 2; ++n)
#pragma unroll
                    for (int j = 0; j < 4; ++j) { const float g = acc[ai][0][m][n][j] * sc, up = acc[ai][1][m][n][j] * sc;
                        const float s = __builtin_amdgcn_rcpf(1.0f + __builtin_amdgcn_exp2f(-1.4426950408889634f * g)); o[n * 4 + j] = g * s * up; }
                const size_t eo = (size_t)(row0 + ai * HALF + m * 16) * ldc + col0;
                if constexpr (F8OUT) { const unsigned long long w = (unsigned long long)pk4_fp8(o[0], o[1], o[2], o[3]) | ((unsigned long long)pk4_fp8(o[4], o[5], o[6], o[7]) << 32);
                    *(GAS unsigned long long*)((unsigned char*)O + eo) = w;
                } else { u32x4 w; w.x = cvt_pk_bf16(o[0], o[1]); w.y = cvt_pk_bf16(o[2], o[3]); w.z = cvt_pk_bf16(o[4], o[5]); w.w = cvt_pk_bf16(o[6], o[7]);
                    *(GAS u32x4*)((bf16_t*)O + eo) = w; } }
    }
};
struct EpiRes {
    static constexpr bool PERM = false;
    const float* res; float* out; int ldc; float sc;
    __device__ __forceinline__ void operator()(const f32x4 (&acc)[2][2][4][2], const Unit& u, int wr, int wc, int fr, int fq) const {
        const int row0 = u.pm * BM + wr * 64 + fr; const int col0 = u.pn * BM + wc * 32 + 4 * fq;
#pragma unroll
        for (int ai = 0; ai < 2; ++ai)
#pragma unroll
            for (int m = 0; m < 4; ++m) { const size_t off = (size_t)(row0 + ai * HALF + m * 16) * ldc + col0;
#pragma unroll
                for (int bj = 0; bj < 2; ++bj)
#pragma unroll
                    for (int n = 0; n < 2; ++n) { const f32x4 r = *(const GAS f32x4*)(res + off + bj * HALF + n * 16); *(GAS f32x4*)(out + off + bj * HALF + n * 16) = r + acc[ai][bj][m][n] * sc; } }
    }
};
struct EpiMoeDown {
    static constexpr bool PERM = false;
    float* h; bf16_t* y1; const unsigned* list_tok; const float* list_w; int cnt[NE]; float sc;
    __device__ __forceinline__ void operator()(const f32x4 (&acc)[2][2][4][2], const Unit& u, int wr, int wc, int fr, int fq) const {
        int cv = 0;
#pragma unroll
        for (int k = 0; k < NE; ++k) cv = (k == u.e) ? cnt[k] : cv;
        const int col0 = u.pn * BM + wc * 32 + 4 * fq;
#pragma unroll
        for (int ai = 0; ai < 2; ++ai)
#pragma unroll
            for (int m = 0; m < 4; ++m) { const int l = u.r0 + ai * HALF + wr * 64 + m * 16 + fr;
                if (l < cv) {
                    const unsigned ent = __hip_atomic_load((const GAS unsigned*)list_tok + (size_t)u.e * LIST_CAP + l, __ATOMIC_RELAXED, __HIP_MEMORY_SCOPE_AGENT);
                    const float w = sc * __uint_as_float(__hip_atomic_load((const GAS unsigned*)list_w + (size_t)u.e * LIST_CAP + l, __ATOMIC_RELAXED, __HIP_MEMORY_SCOPE_AGENT));
                    const size_t off = (size_t)(ent & 0xFFFFFu) * D + col0;
                    if ((ent >> 20) == 0u) {
#pragma unroll
                        for (int bj = 0; bj < 2; ++bj)
#pragma unroll
                            for (int n = 0; n < 2; ++n) { GAS float* p = (GAS float*)(h + off + bj * HALF + n * 16); const f32x4 r = *(const GAS f32x4*)p; *(GAS f32x4*)p = r + acc[ai][bj][m][n] * w; }
                    } else {
#pragma unroll
                        for (int bj = 0; bj < 2; ++bj)
#pragma unroll
                            for (int n = 0; n < 2; ++n) { const f32x4 v = acc[ai][bj][m][n] * w; unsigned long long pk = (unsigned long long)cvt_pk_bf16(v[0], v[1]) | ((unsigned long long)cvt_pk_bf16(v[2], v[3]) << 32);
                                *(GAS unsigned long long*)(y1 + off + bj * HALF + n * 16) = pk; }
                    }
                } }
    }
};

template <class Epi, class Sched, bool F8 = false>
__device__ __forceinline__ void gemm_phase(PG8_LAS unsigned char* lds, int xoff, const Gemm g, const Sched& S, const Epi& E) {
    int tid_ = threadIdx.x;
    asm volatile("" : "+v"(tid_));
    const int tid = tid_, wid = __builtin_amdgcn_readfirstlane(tid >> 6), lane = tid & 63, wr = wid >> 2, wc = wid & 3, fr = lane & 15, fq = lane >> 4;
    const int RB = g.rowb, nt = RB / 128;
    unsigned voffB[2];
#pragma unroll
    for (int i = 0; i < 2; ++i) { int R, C; stage_rc(tid * 16 + i * 8192, R, C); const int Rb = Epi::PERM ? ((R & ~31) + perm32(R & 31)) : R;
        voffB[i] = (unsigned)(Rb * RB + C * 2); }
    const size_t kstep = (size_t)(BK * 2);
    const size_t hstep = (size_t)HALF * RB;
    const size_t tstep = 2 * hstep;
    const unsigned ldsw = (unsigned)wid * 1024u;
    const int aoff = F8 ? lds_byte(wr * 64 + fr, fq * 16) : lds_byte(wr * 64 + fr, fq * 8), boff = F8 ? lds_byte(wc * 32 + fr, fq * 16) : lds_byte(wc * 32 + fr, fq * 8);
#define PG8_SA(b, h) (((b) * 2 + (h)) * HTB)
#define PG8_SB(b, h) ((4 + (b) * 2 + (h)) * HTB)
#define PG8_STAGE(bufoff, gbase, v0, v1) do { \
        __builtin_amdgcn_global_load_lds((const GAS unsigned*)((const char*)(gbase) + (v0)), (PG8_LAS unsigned*)(lds + (bufoff) + ldsw), 16, 0, 0); \
        __builtin_amdgcn_global_load_lds((const GAS unsigned*)((const char*)(gbase) + (v1)), (PG8_LAS unsigned*)(lds + (bufoff) + ldsw + 8192), 16, 0, 0); } while (0)
#define PG8_STAGEB(bufoff, gbase) PG8_STAGE(bufoff, gbase, voffB[0], voffB[1])
#define PG8_LDA(dst, b, h) do { if constexpr (F8) { _Pragma("unroll") for (int m = 0; m < 4; ++m) { dst##8[m].lo = *(const PG8_LAS i32x4*)(lds + PG8_SA(b, h) + aoff + m * 2048); dst##8[m].hi = *(const PG8_LAS i32x4*)(lds + PG8_SA(b, h) + aoff + m * 2048 + 16); } } \
        else { _Pragma("unroll") for (int m = 0; m < 4; ++m) _Pragma("unroll") for (int k = 0; k < 2; ++k) dst[m][k] = *(const PG8_LAS bf16x8*)(lds + PG8_SA(b, h) + aoff + m * 2048 + k * 1024); } } while (0)
#define PG8_LDB(dst, b, h) do { if constexpr (F8) { _Pragma("unroll") for (int n = 0; n < 2; ++n) { dst##8[n].lo = *(const PG8_LAS i32x4*)(lds + PG8_SB(b, h) + boff + n * 2048); dst##8[n].hi = *(const PG8_LAS i32x4*)(lds + PG8_SB(b, h) + boff + n * 2048 + 16); } } \
        else { _Pragma("unroll") for (int n = 0; n < 2; ++n) _Pragma("unroll") for (int k = 0; k < 2; ++k) dst[n][k] = *(const PG8_LAS bf16x8*)(lds + PG8_SB(b, h) + boff + n * 2048 + k * 1024); } } while (0)
#define PG8_MMA(ai, bj, At, Bt) do { __builtin_amdgcn_s_setprio(1); _Pragma("unroll") for (int m = 0; m < 4; ++m) _Pragma("unroll") for (int n = 0; n < 2; ++n) { \
        if constexpr (F8) acc[ai][bj][m][n] = __builtin_amdgcn_mfma_scale_f32_16x16x128_f8f6f4(Bt##8[n], At##8[m], acc[ai][bj][m][n], 0, 0, 0, 0x7F7F7F7F, 0, 0x7F7F7F7F); \
        else { _Pragma("unroll") for (int k = 0; k < 2; ++k) acc[ai][bj][m][n] = __builtin_amdgcn_mfma_f32_16x16x32_bf16(Bt[n][k], At[m][k], acc[ai][bj][m][n], 0, 0, 0); } } __builtin_amdgcn_s_setprio(0); } while (0)
#define PG8_WAIT_V(n) asm volatile("s_waitcnt vmcnt(" #n ")" ::: "memory")
#define PG8_WAIT_L(n) asm volatile("s_waitcnt lgkmcnt(" #n ")" ::: "memory")
#define PG8_BAR __builtin_amdgcn_s_barrier()
#define PG8_SCHED __builtin_amdgcn_sched_barrier(0)
#define PG8_AOFFS(U, o00, o01, o10, o11) do { int R0_, C0_, R1_, C1_; stage_rc(tid * 16, R0_, C0_); stage_rc(tid * 16 + 8192, R1_, C1_);     \
        o00 = S.arow(U, R0_) * (unsigned)RB + (unsigned)C0_ * 2u; o01 = S.arow(U, R1_) * (unsigned)RB + (unsigned)C1_ * 2u; \
        o10 = S.arow(U, HALF + R0_) * (unsigned)RB + (unsigned)C0_ * 2u; o11 = S.arow(U, HALF + R1_) * (unsigned)RB + (unsigned)C1_ * 2u; } while (0)
    Unit cur, nxt; int ui = 0;
    if (!S.next(0, cur)) return;
    f32x4 acc[2][2][4][2];
#pragma unroll
    for (int a = 0; a < 2; ++a)
#pragma unroll
        for (int b = 0; b < 2; ++b)
#pragma unroll
            for (int m = 0; m < 4; ++m)
#pragma unroll
                for (int n = 0; n < 2; ++n) acc[a][b][m][n] = (f32x4){0.f, 0.f, 0.f, 0.f};
    bf16x8 At[4][2], B0[2][2], B1[2][2];
    i32x8 At8[4], B08[2], B18[2];
    unsigned c00, c01, c10, c11;
    PG8_LAS u32x4* const xslot = (PG8_LAS u32x4*)(lds + xoff) + tid;
    PG8_AOFFS(cur, c00, c01, c10, c11);
    const char* const gA = (const char*)g.A;
    const char* cB = (const char*)g.Bt + (size_t)cur.e * g.bstride + (size_t)cur.pn * tstep;
    PG8_STAGEB(PG8_SB(0, 0), cB); PG8_STAGEB(PG8_SB(0, 1), cB + hstep); PG8_STAGE(PG8_SA(0, 0), gA, c00, c01); PG8_STAGE(PG8_SA(0, 1), gA, c10, c11);
    if (wr == 1) PG8_BAR;
    PG8_WAIT_V(2); PG8_BAR;
    PG8_STAGEB(PG8_SB(1, 0), cB + kstep); PG8_STAGE(PG8_SA(1, 0), gA + kstep, c00, c01); PG8_STAGEB(PG8_SB(1, 1), cB + hstep + kstep);
    PG8_WAIT_V(6); PG8_BAR;
    for (;;) {
        const bool has_next = S.next(ui + 1, nxt);
        const char* nB_ = has_next ? (const char*)g.Bt + (size_t)nxt.e * g.bstride + (size_t)nxt.pn * tstep : cB;
        const char* nB = nB_;
        if (has_next) { unsigned n00, n01, n10, n11; PG8_AOFFS(nxt, n00, n01, n10, n11); *xslot = (u32x4){n00, n01, n10, n11}; }
#pragma unroll 1
        for (int t = 0; t < nt; t += 2) {
            const bool last = (t == nt - 2);
            const char* a1 = gA + (size_t)(t + 1) * kstep;
            const char* a2 = last ? gA : gA + (size_t)(t + 2) * kstep; const char* b2 = last ? nB : cB + (size_t)(t + 2) * kstep;
            const char* a3 = a2 + kstep; const char* b3 = b2 + kstep;
            PG8_LDB(B0, 0, 0); PG8_LDB(B1, 0, 1); PG8_SCHED; PG8_LDA(At, 0, 0); PG8_STAGE(PG8_SA(1, 1), a1, c10, c11);
            if (last && has_next) { const u32x4 nx = *xslot; c00 = nx.x; c01 = nx.y; c10 = nx.z; c11 = nx.w; }
            PG8_WAIT_V(8); PG8_WAIT_L(0); PG8_BAR; PG8_MMA(0, 0, At, B0); PG8_MMA(0, 1, At, B1); PG8_BAR; PG8_SCHED;
            PG8_LDA(At, 0, 1); PG8_STAGEB(PG8_SB(0, 0), b2); PG8_STAGEB(PG8_SB(0, 1), b2 + hstep); PG8_STAGE(PG8_SA(0, 0), a2, c00, c01);
            PG8_WAIT_V(8); PG8_WAIT_L(0); PG8_BAR; PG8_MMA(1, 0, At, B0); PG8_MMA(1, 1, At, B1); PG8_BAR; PG8_SCHED;
            PG8_LDB(B0, 1, 0); PG8_LDB(B1, 1, 1); PG8_SCHED; PG8_LDA(At, 1, 0); PG8_STAGE(PG8_SA(0, 1), a2, c10, c11);
            PG8_WAIT_V(8); PG8_WAIT_L(0); PG8_BAR; PG8_MMA(0, 0, At, B0); PG8_MMA(0, 1, At, B1); PG8_BAR; PG8_SCHED;
            PG8_LDA(At, 1, 1); PG8_STAGEB(PG8_SB(1, 0), b3); PG8_STAGEB(PG8_SB(1, 1), b3 + hstep); PG8_STAGE(PG8_SA(1, 0), a3, c00, c01);
            PG8_WAIT_V(8); PG8_WAIT_L(0); PG8_BAR; PG8_MMA(1, 0, At, B0); PG8_MMA(1, 1, At, B1); PG8_BAR; PG8_SCHED;
        }
        if (wr == 0) PG8_BAR;
        E(acc, cur, wr, wc, fr, fq);
        if (!has_next) break;
#pragma unroll
        for (int a = 0; a < 2; ++a)
#pragma unroll
            for (int b = 0; b < 2; ++b)
#pragma unroll
                for (int m = 0; m < 4; ++m)
#pragma unroll
                    for (int n = 0; n < 2; ++n) acc[a][b][m][n] = (f32x4){0.f, 0.f, 0.f, 0.f};
        cur = nxt; cB = nB; ++ui;
        if (wr == 1) PG8_BAR;
    }
    PG8_WAIT_V(0);
    PG8_BAR;
#undef PG8_SA
#undef PG8_SB
#undef PG8_STAGE
#undef PG8_STAGEB
#undef PG8_LDA
#undef PG8_LDB
#undef PG8_MMA
#undef PG8_WAIT_V
#undef PG8_WAIT_L
#undef PG8_BAR
#undef PG8_SCHED
#undef PG8_AOFFS
}
}

namespace att {
typedef unsigned short bf16_t;
typedef short bf16x8 __attribute__((ext_vector_type(8)));
typedef short s16x4 __attribute__((ext_vector_type(4)));
typedef float f32x16 __attribute__((ext_vector_type(16)));
typedef float f32x4 __attribute__((ext_vector_type(4)));
typedef unsigned u32x4 __attribute__((ext_vector_type(4)));
constexpr int PITCH = 1024;
constexpr float LOG2E = 1.4426950408889634f;
__device__ __forceinline__ int crow(int r, int hi) { return (r & 3) + 8 * (r >> 2) + 4 * hi; }
typedef float f32x2_t __attribute__((ext_vector_type(2))); typedef __bf16 bf16x2_t __attribute__((ext_vector_type(2)));
__device__ __forceinline__ unsigned cvtpk(float lo, float hi) { f32x2_t v = {lo, hi}; bf16x2_t b = __builtin_convertvector(v, bf16x2_t); return __builtin_bit_cast(unsigned, b); }
__device__ __forceinline__ float bf2f(short s) { return __uint_as_float(((unsigned)(unsigned short)s) << 16); }
typedef short v4i16_t __attribute__((ext_vector_type(4)));
__device__ __forceinline__ s16x4 vtr(const LAS unsigned char* p) { return __builtin_bit_cast(s16x4, __builtin_amdgcn_ds_read_tr16_b64_v4i16((LAS v4i16_t*)p)); }
__device__ __forceinline__ float max3f(float a, float b, float c) { float r; asm("v_max3_f32 %0, %1, %2, %3" : "=v"(r) : "v"(a), "v"(b), "v"(c)); return r; }
__device__ __forceinline__ float halves_max(float m) { auto rr = __builtin_amdgcn_permlane32_swap(__float_as_uint(m), __float_as_uint(m), false, false); return fmaxf(__uint_as_float(rr[0]), __uint_as_float(rr[1])); }
__device__ __forceinline__ float halves_sum(float m) { auto rr = __builtin_amdgcn_permlane32_swap(__float_as_uint(m), __float_as_uint(m), false, false); return __uint_as_float(rr[0]) + __uint_as_float(rr[1]); }
#define ATT_BAR() asm volatile("s_waitcnt vmcnt(0) lgkmcnt(0)\n\ts_barrier" ::: "memory")

struct Args { const bf16_t* Q; const bf16_t* K; const bf16_t* V; bf16_t* O; const float* kmean; const float* kmax2; const float* subln; float lam_full; float out_scale; };

template <int MODE>
__device__ __forceinline__ void attn_unit(LAS unsigned char* lds, const Args& A, int b, int h, int qblk) {
    constexpr int DVB = MODE == 0 ? 4 : 2;
    constexpr int NCH = MODE == 0 ? 16 : 8;
    constexpr int KBY = NCH * 1024, VBY = DVB * 4096, SLOT = KBY + VBY;
    constexpr int QR = MODE == 0 ? 128 : 256;
    constexpr int PPW = MODE == 0 ? 2 : 1;
    int tid_ = threadIdx.x; asm volatile("" : "+v"(tid_));
    const int tid = tid_, lane = tid & 63, r32 = lane & 31, hi = lane >> 5;
    const int wid = __builtin_amdgcn_readfirstlane(tid >> 6);
    const int comp = MODE == 0 ? (wid >> 2) : 0, wq = MODE == 0 ? (wid & 3) : wid;
    const int q0 = qblk * QR; const long rowbase = (long)b * SEQ;
    const int hcol = MODE == 0 ? h * 128 : h * 64;
    const int qrel0 = wq * 32;
    const float slope2 = __builtin_amdgcn_exp2f(MODE == 0 ? -(float)(h + 1) : -0.5f * (float)(h + 1)) * LOG2E;
    const int NT = MODE == 0 ? 2 * qblk + 2 : 4 + 4 * qblk;
#define ATT_KBASE_(t) (MODE == 0 ? 64 * (t) : ((t) < 4 ? q0 + 64 * (t) : 64 * ((t) - 4)))
    LAS float* wsf = (LAS float*)(lds + 65536) + wid * 64;
    const bf16_t* Kb = A.K + rowbase * PITCH + hcol;
    const bf16_t* Vb = A.V + rowbase * PITCH + hcol;
    bf16x8 qr[4];
    { const bf16_t* Qw = A.Q + (rowbase + q0 + qrel0 + r32) * PITCH + hcol + comp * 64 + hi * 8;
#pragma unroll
      for (int d0 = 0; d0 < 4; ++d0) qr[d0] = *(const GAS bf16x8*)(Qw + d0 * 16); }
    ATT_BAR();
    LAS int* live = (LAS int*)(lds + 71680); LAS float* qnx = (LAS float*)(lds + 71680 + 272);
    { float q2 = 0.f;
#pragma unroll
      for (int d0 = 0; d0 < 4; ++d0)
#pragma unroll
        for (int j = 0; j < 8; ++j) { const float v = bf2f(qr[d0][j]); q2 += v * v; }
      q2 = halves_sum(q2);
      q2 = fmaxf(q2, __shfl_xor(q2, 1)); q2 = fmaxf(q2, __shfl_xor(q2, 2)); q2 = fmaxf(q2, __shfl_xor(q2, 4)); q2 = fmaxf(q2, __shfl_xor(q2, 8)); q2 = fmaxf(q2, __shfl_xor(q2, 16));
      if (lane == 0) qnx[wid] = q2; }
    ATT_BAR();
    if (wid == 0) {
        const int tt = lane;
        const int kbase_t = (tt < NT) ? ATT_KBASE_(tt) : 0;
        bool alive = tt < NT;
        if (alive && kbase_t + 64 <= q0) {
            const int nblk = kbase_t >> 8; float bound = -INFINITY;
            if constexpr (MODE == 0) {
#pragma unroll
                for (int c = 0; c < 2; ++c) { float qm = fmaxf(fmaxf(qnx[4 * c], qnx[4 * c + 1]), fmaxf(qnx[4 * c + 2], qnx[4 * c + 3]));
                    const float k2 = ((const GAS float*)A.kmax2)[(size_t)(b * 16 + h * 2 + c) * 16 + nblk]; bound = fmaxf(bound, sqrtf(qm) * sqrtf(k2)); }
            } else {
                float qm = qnx[0];
#pragma unroll
                for (int w = 1; w < 8; ++w) qm = fmaxf(qm, qnx[w]);
                const float k2 = ((const GAS float*)A.kmax2)[(size_t)(b * 16 + h) * 16 + nblk]; bound = sqrtf(qm) * sqrtf(k2);
            }
            alive = !(bound * 1.001f + 1.0f + slope2 * (float)(kbase_t + 63 - q0) < -152.0f);
        }
        const unsigned long long am = __ballot(alive);
        if (alive) live[__popcll(am & ((1ull << lane) - 1ull))] = tt;
        if (lane == 0) live[64] = __popcll(am);
    }
    ATT_BAR();
    const int NTL = __builtin_amdgcn_readfirstlane(live[64]);
    unsigned sel = 0u;
    if constexpr (MODE == 1) {
        LAS float* km = (LAS float*)(lds + 67584);
        for (int i = tid; i < 1024; i += 512) km[i] = ((const GAS float*)A.kmean)[(size_t)(b * 16 + h) * 1024 + i];
        ATT_BAR();
        float g[16];
#pragma unroll
        for (int n = 0; n < 16; ++n) { float s = 0.f;
            if (n < qblk) {
#pragma unroll
                for (int d0 = 0; d0 < 4; ++d0) { const f32x4 ka = *(const LAS f32x4*)(km + n * 64 + d0 * 16 + hi * 8), kb2 = *(const LAS f32x4*)(km + n * 64 + d0 * 16 + hi * 8 + 4);
                    s += bf2f(qr[d0][0]) * ka[0] + bf2f(qr[d0][1]) * ka[1] + bf2f(qr[d0][2]) * ka[2] + bf2f(qr[d0][3]) * ka[3]
                       + bf2f(qr[d0][4]) * kb2[0] + bf2f(qr[d0][5]) * kb2[1] + bf2f(qr[d0][6]) * kb2[2] + bf2f(qr[d0][7]) * kb2[3]; }
                s = halves_sum(s); }
            g[n] = s; }
        const int nsel = qblk < 3 ? qblk : 3;
#pragma unroll
        for (int k = 0; k < 3; ++k) if (k < nsel) { float best = -INFINITY; int bi = 0; bool found = false;
#pragma unroll
            for (int n = 0; n < 16; ++n) if (n < qblk) { const bool free_ = ((sel >> n) & 1u) == 0u; if (free_ && (!found || g[n] > best)) { best = g[n]; bi = n; found = true; } }
            sel |= 1u << bi; }
    }
#define ATT_KBASE(t) ATT_KBASE_(t)
#define ATT_ISSUE(t, slot) do { const int kb_ = ATT_KBASE(t); \
        _Pragma("unroll") for (int i_ = 0; i_ < PPW; ++i_) { const int p_ = wid + 8 * i_; \
            __builtin_amdgcn_global_load_lds((const GAS unsigned*)(Kb + (size_t)(kb_ + lane) * PITCH + p_ * 8), (LAS unsigned*)(lds + (slot) * SLOT + p_ * 1024), 16, 0, 0); \
            __builtin_amdgcn_global_load_lds((const GAS unsigned*)(Vb + (size_t)(kb_ + 16 * (p_ & 3) + (lane >> 2)) * PITCH + (p_ >> 2) * 32 + (lane & 3) * 8), (LAS unsigned*)(lds + (slot) * SLOT + KBY + p_ * 1024), 16, 0, 0); } } while (0)
    constexpr float THR = 8.0f;
    float mref = 0.f, l = 0.f; f32x16 o[DVB];
#pragma unroll
    for (int d0 = 0; d0 < DVB; ++d0) o[d0] = f32x16{};
#define ATT_ISSUE_K(tt, slot) do { const int kb_ = ATT_KBASE(tt); \
        _Pragma("unroll") for (int i_ = 0; i_ < PPW; ++i_) { const int p_ = wid + 8 * i_; \
            __builtin_amdgcn_global_load_lds((const GAS unsigned*)(Kb + (size_t)(kb_ + lane) * PITCH + p_ * 8), (LAS unsigned*)(lds + (slot) * SLOT + p_ * 1024), 16, 0, 0); } } while (0)
#define ATT_ISSUE_V(tt, slot) do { const int kb_ = ATT_KBASE(tt); \
        _Pragma("unroll") for (int i_ = 0; i_ < PPW; ++i_) { const int p_ = wid + 8 * i_; \
            __builtin_amdgcn_global_load_lds((const GAS unsigned*)(Vb + (size_t)(kb_ + 16 * (p_ & 3) + (lane >> 2)) * PITCH + (p_ >> 2) * 32 + (lane & 3) * 8), (LAS unsigned*)(lds + (slot) * SLOT + KBY + p_ * 1024), 16, 0, 0); } } while (0)
#define ATT_CLASS(tt, SK, NM, SB) do { const int kb_ = ATT_KBASE(tt), kr_ = kb_ - q0; const bool dg_ = kb_ >= q0; SK = dg_ && (kr_ > qrel0 + 31); NM = dg_ && (kr_ + 63 > qrel0); SB = true; \
        if constexpr (MODE == 1) { if ((tt) >= 4) { SB = ((sel >> (((tt) - 4) >> 2)) & 1u) != 0u; if (!__any(SB)) SK = true; } } } while (0)
#define ATT_QK(P0, P1, tt, slot, SB) do { const int kr_ = ATT_KBASE(tt) - q0; float off0_ = slope2 * (float)(kr_ + 4 * hi) - mref; if (!(SB)) off0_ = -INFINITY; const float off1_ = off0_ + 32.0f * slope2; \
        _Pragma("unroll") for (int r = 0; r < 16; ++r) { const float cbr = slope2 * (float)((r & 3) + 8 * (r >> 2)); P0[r] = cbr + off0_; P1[r] = cbr + off1_; } \
        const LAS unsigned char* Ks_ = lds + (slot) * SLOT + comp * 8192 + hi * 1024 + r32 * 16; \
        _Pragma("unroll") for (int d0 = 0; d0 < 4; ++d0) { const bf16x8 b0 = *(const LAS bf16x8*)(Ks_ + d0 * 2048), b1 = *(const LAS bf16x8*)(Ks_ + d0 * 2048 + 512); \
            P0 = __builtin_amdgcn_mfma_f32_32x32x16_bf16(b0, qr[d0], P0, 0, 0, 0); P1 = __builtin_amdgcn_mfma_f32_32x32x16_bf16(b1, qr[d0], P1, 0, 0, 0); } } while (0)
    f32x16 p0, p1, n0, n1;
    int t = __builtin_amdgcn_readfirstlane(live[0]);
    int tn = (NTL > 1) ? __builtin_amdgcn_readfirstlane(live[1]) : 0;
    bool skipC, maskC, selC, skipN = true, maskN = false, selN = true;
    ATT_ISSUE_K(t, 0); ATT_ISSUE_V(t, 0); if (NTL > 1) ATT_ISSUE_K(tn, 1);
    ATT_BAR();
    ATT_CLASS(t, skipC, maskC, selC);
    if (!skipC) ATT_QK(p0, p1, t, 0, selC);
    for (int it = 0; it < NTL; ++it) {
        ATT_BAR();
        const int tnn = (it + 2 < NTL) ? __builtin_amdgcn_readfirstlane(live[it + 2]) : 0;
        if (it + 2 < NTL) ATT_ISSUE_K(tnn, it & 1);
        if (it + 1 < NTL) { ATT_ISSUE_V(tn, (it + 1) & 1); ATT_CLASS(tn, skipN, maskN, selN); if (!skipN) ATT_QK(n0, n1, tn, (it + 1) & 1, selN); } else skipN = true;
        if (!skipC) {
            const int krel = ATT_KBASE(t) - q0;
            const LAS unsigned char* Vs = lds + (it & 1) * SLOT + KBY + ((lane >> 4) & 1) * 32 + (lane & 3) * 8 + (4 * hi + ((lane & 15) >> 2)) * 64;
            if (maskC) { const int qrel = qrel0 + r32;
#pragma unroll
                for (int r = 0; r < 16; ++r) { const int kv = krel + crow(r, hi); if (kv > qrel) p0[r] = -INFINITY; if (kv + 32 > qrel) p1[r] = -INFINITY; } }
            float rm;
            { float a_ = max3f(p0[0], p0[1], p1[0]), b_ = max3f(p0[2], p0[3], p1[1]); a_ = max3f(a_, p1[2], p1[3]);
#pragma unroll
              for (int r = 4; r < 16; r += 4) { a_ = max3f(a_, p0[r], p0[r + 1]); b_ = max3f(b_, p0[r + 2], p0[r + 3]); a_ = max3f(a_, p1[r], p1[r + 1]); b_ = max3f(b_, p1[r + 2], p1[r + 3]); }
              rm = halves_max(fmaxf(a_, b_)); }
            if (__any(rm > THR)) {
                const float dl = fmaxf(rm, 0.f); mref += dl; const float alpha = __builtin_amdgcn_exp2f(-dl);
#pragma unroll
                for (int r = 0; r < 16; ++r) { p0[r] -= dl; p1[r] -= dl; }
                if (!skipN) {
#pragma unroll
                    for (int r = 0; r < 16; ++r) { n0[r] -= dl; n1[r] -= dl; } }
                l *= alpha;
                if (hi == 0) wsf[r32] = alpha;
                asm volatile("s_waitcnt lgkmcnt(0)" ::: "memory");
#pragma unroll
                for (int gq = 0; gq < 4; ++gq) { const f32x4 f = *(const LAS f32x4*)(wsf + 8 * gq + 4 * hi);
#pragma unroll
                    for (int d0 = 0; d0 < DVB; ++d0) { o[d0][4 * gq + 0] *= f[0]; o[d0][4 * gq + 1] *= f[1]; o[d0][4 * gq + 2] *= f[2]; o[d0][4 * gq + 3] *= f[3]; } }
            }
            float sacc = 0.f;
#pragma unroll
            for (int r = 0; r < 16; ++r) { p0[r] = __builtin_amdgcn_exp2f(p0[r]); p1[r] = __builtin_amdgcn_exp2f(p1[r]); sacc += p0[r] + p1[r]; }
            l += sacc;
            u32x4 pw[4];
            pw[0] = (u32x4){cvtpk(p0[0], p0[1]), cvtpk(p0[2], p0[3]), cvtpk(p0[4], p0[5]), cvtpk(p0[6], p0[7])};
            pw[1] = (u32x4){cvtpk(p0[8], p0[9]), cvtpk(p0[10], p0[11]), cvtpk(p0[12], p0[13]), cvtpk(p0[14], p0[15])};
            pw[2] = (u32x4){cvtpk(p1[0], p1[1]), cvtpk(p1[2], p1[3]), cvtpk(p1[4], p1[5]), cvtpk(p1[6], p1[7])};
            pw[3] = (u32x4){cvtpk(p1[8], p1[9]), cvtpk(p1[10], p1[11]), cvtpk(p1[12], p1[13]), cvtpk(p1[14], p1[15])};
#pragma unroll
            for (int d0 = 0; d0 < DVB; ++d0)
#pragma unroll
                for (int ks = 0; ks < 4; ++ks) { const s16x4 vlo = vtr(Vs + d0 * 4096 + ks * 1024), vhi = vtr(Vs + d0 * 4096 + ks * 1024 + 512);
                    const bf16x8 vf = (bf16x8){vlo[0], vlo[1], vlo[2], vlo[3], vhi[0], vhi[1], vhi[2], vhi[3]};
                    o[d0] = __builtin_amdgcn_mfma_f32_32x32x16_bf16(__builtin_bit_cast(bf16x8, pw[ks]), vf, o[d0], 0, 0, 0); }
        }
        p0 = n0; p1 = n1; skipC = skipN; maskC = maskN; selC = selN; t = tn; tn = tnn;
    }
#undef ATT_ISSUE_K
#undef ATT_ISSUE_V
#undef ATT_CLASS
#undef ATT_QK
    l = halves_sum(l);
    if (hi == 0) wsf[32 + r32] = l;
    asm volatile("s_waitcnt lgkmcnt(0)" ::: "memory");
    float rli[16];
#pragma unroll
    for (int gq = 0; gq < 4; ++gq) { const f32x4 f = *(const LAS f32x4*)(wsf + 32 + 8 * gq + 4 * hi); rli[4 * gq + 0] = 1.0f / f[0]; rli[4 * gq + 1] = 1.0f / f[1]; rli[4 * gq + 2] = 1.0f / f[2]; rli[4 * gq + 3] = 1.0f / f[3]; }
    if constexpr (MODE == 1) {
        GAS bf16_t* Ow = (GAS bf16_t*)(A.O + (rowbase + q0 + qrel0) * PITCH + hcol);
#pragma unroll
        for (int r = 0; r < 16; ++r)
#pragma unroll
            for (int d0 = 0; d0 < DVB; ++d0) Ow[(size_t)crow(r, hi) * PITCH + d0 * 32 + r32] = (bf16_t)(cvtpk(o[d0][r] * rli[r], 0.f) & 0xFFFFu);
    } else {
        ATT_BAR();
        LAS float* X = (LAS float*)lds + wq * 4096;
        if (comp == 1) {
#pragma unroll
            for (int d0 = 0; d0 < DVB; ++d0)
#pragma unroll
                for (int r = 0; r < 16; ++r) X[(d0 * 16 + r) * 64 + lane] = o[d0][r] * rli[r];
        }
        ATT_BAR();
        if (comp == 0) {
            float sg[DVB];
#pragma unroll
            for (int d0 = 0; d0 < DVB; ++d0) sg[d0] = ((const GAS float*)A.subln)[d0 * 32 + r32] * A.out_scale;
            GAS bf16_t* Ow = (GAS bf16_t*)(A.O + (rowbase + q0 + qrel0) * PITCH + hcol);
#pragma unroll
            for (int r = 0; r < 16; ++r) { float dv[DVB]; float ss = 0.f;
#pragma unroll
                for (int d0 = 0; d0 < DVB; ++d0) { dv[d0] = o[d0][r] * rli[r] - A.lam_full * X[(d0 * 16 + r) * 64 + lane]; ss += dv[d0] * dv[d0]; }
                ss += __shfl_xor(ss, 1); ss += __shfl_xor(ss, 2); ss += __shfl_xor(ss, 4); ss += __shfl_xor(ss, 8); ss += __shfl_xor(ss, 16);
                const float rs = 1.0f / sqrtf(ss * (1.0f / 128.0f) + 1e-5f);
#pragma unroll
                for (int d0 = 0; d0 < DVB; ++d0) Ow[(size_t)crow(r, hi) * PITCH + d0 * 32 + r32] = (bf16_t)(cvtpk(dv[d0] * rs * sg[d0], 0.f) & 0xFFFFu); }
        }
    }
#undef ATT_KBASE
#undef ATT_KBASE_
#undef ATT_ISSUE
}
#undef ATT_BAR
}

constexpr int NWAVES = 8;
#ifndef MK_PER_PHASE
#define MK_PER_PHASE 1
#endif
#ifndef MK_DEBUG
#define MK_DEBUG 1
#endif
constexpr int NLAYER = 4, PH_PER_LAYER = 8, NPHASE = 1 + NLAYER * PH_PER_LAYER;

constexpr size_t MiB = 1u << 20;
constexpr size_t WS_CTL = 0, CTL_ZERO_BYTES = 1 * MiB;
constexpr size_t WS_KMEAN = 1 * MiB;
constexpr size_t WS_LTOK = 2 * MiB, WS_LW = 3 * MiB;
constexpr size_t WS_DQKV = 5 * MiB;
constexpr size_t WS_DWO = WS_DQKV + 12 * MiB;
constexpr size_t WS_MQKV = WS_DWO + 4 * MiB;
constexpr size_t WS_MWO = WS_MQKV + 12 * MiB;
constexpr size_t WS_FGU = WS_MWO + 4 * MiB;
constexpr size_t WS_FD = WS_FGU + 22 * MiB;
constexpr size_t WS_MGU = WS_FD + 11 * MiB;
constexpr size_t WS_MD = WS_MGU + 112 * MiB;
constexpr size_t WS_XN = WS_MD + 56 * MiB;
constexpr size_t WS_Q = WS_XN + 64 * MiB, WS_K = WS_Q + 64 * MiB, WS_V = WS_K + 64 * MiB;
constexpr size_t WS_ACT = WS_Q;
constexpr size_t WS_END = WS_ACT + (size_t)MOE_TILES_MAX * 256 * DE * 2;
static_assert(WS_XN == 238 * MiB && WS_END == 778 * MiB, "d_ws map");
constexpr int CW_BAR = 4096;
constexpr int CW_ATTQ = 6144;
constexpr int CW_CNT = 8192;

constexpr int RING_OFF = 0, RING_BYTES = 131072;
constexpr int LDSCTL_OFF = RING_BYTES, MISC_OFF = LDSCTL_OFF + 320;
constexpr int XSLOT_OFF = MISC_OFF + 128;
constexpr int LDS_BYTES = 147456;

typedef unsigned short bf16;
typedef unsigned v4u __attribute__((ext_vector_type(4)));
typedef float f32x4 __attribute__((ext_vector_type(4)));
typedef GAS unsigned gu32;
#define RLX_AGENT __ATOMIC_RELAXED, __HIP_MEMORY_SCOPE_AGENT
#define LDS_WAIT() asm volatile("s_waitcnt lgkmcnt(0)" ::: "memory")
#define VM_WAIT() asm volatile("s_waitcnt vmcnt(0)" ::: "memory")
__device__ __forceinline__ unsigned f2bf(float f) { unsigned u = __builtin_bit_cast(unsigned, f); return (u + 0x7fffu + ((u >> 16) & 1u)) >> 16; }
__device__ __forceinline__ unsigned pk2(float lo, float hi) { return f2bf(lo) | (f2bf(hi) << 16); }
__device__ __forceinline__ float bflo(unsigned w) { return __uint_as_float(w << 16); }
__device__ __forceinline__ float bfhi(unsigned w) { return __uint_as_float(w & 0xFFFF0000u); }
static_assert(XSLOT_OFF % 16 == 0 && XSLOT_OFF + 8192 <= LDS_BYTES, "LDS map");
#define XB_TMO      128
#define XB_XCNT(j)  (256  + 64 * (j))
#define XB_XSUB(j)  (1280 + 64 * (j))
#define XB_XGEN(j)  (2304 + 64 * (j))
#define XB_TOP      3328
#define XB_TOPGEN   3392
#define XCD_BAR_WORDS 3456
#define XB_SPIN_CAP (1u << 18)

__device__ __forceinline__ unsigned xb_ld(unsigned* p)              { return __hip_atomic_load(p, __ATOMIC_RELAXED, __HIP_MEMORY_SCOPE_AGENT); }
__device__ __forceinline__ unsigned xb_add(unsigned* p, unsigned v) { return __hip_atomic_fetch_add(p, v, __ATOMIC_RELAXED, __HIP_MEMORY_SCOPE_AGENT); }
__device__ __forceinline__ unsigned xb_xcc_id() { return (unsigned)__builtin_amdgcn_s_getreg((3 << 11) | 20) & 0xFu; }
#define XB_SPIN(cond, bar) do { unsigned _sp = 0; while (cond) { __builtin_amdgcn_s_sleep(1); \
    if ((++_sp & 255u) == 0u) { if (xb_ld(&(bar)[XB_TMO])) break; if (_sp > XB_SPIN_CAP) { atomicAdd(&(bar)[XB_TMO], 1u); break; } } } } while (0)

struct XcdBarrier {
    unsigned* bar; unsigned x;
    volatile LAS unsigned* st;
};

__device__ __forceinline__ XcdBarrier xcd_barrier_post(unsigned* bar, volatile LAS unsigned* st) {
    XcdBarrier b; b.bar = bar; b.x = xb_xcc_id(); b.st = st;
    if (threadIdx.x == 0) (void)xb_add(&bar[XB_XCNT(b.x)], 1u);
    return b;
}
__device__ __forceinline__ void xcd_barrier_complete(unsigned* bar, unsigned x, unsigned& nloc, unsigned& nx) {
    const unsigned G = gridDim.x * gridDim.y * gridDim.z;
    unsigned sum, cnt, mine, sp = 0u;
    for (;;) {
        sum = 0u; cnt = 0u; mine = 0u;
#pragma unroll
        for (unsigned j = 0; j < 16; ++j) { const unsigned c = xb_ld(&bar[XB_XCNT(j)]); sum += c; cnt += (c > 0u) ? 1u : 0u; mine = (j == x) ? c : mine; }
        if (sum == G) break;
        __builtin_amdgcn_s_sleep(1);
        if ((++sp & 255u) == 0u) { if (xb_ld(&bar[XB_TMO])) break; if (sp > XB_SPIN_CAP) { atomicAdd(&bar[XB_TMO], 1u); break; } }
    }
    nloc = mine > 0u ? mine : 1u; nx = cnt > 0u ? cnt : 1u;
}

__device__ __forceinline__ void xcd_barrier(const XcdBarrier& b) {
    asm volatile("s_waitcnt vmcnt(0)" ::: "memory");
    __syncthreads();
    if (threadIdx.x == 0) {
        unsigned* bar = b.bar;
        __builtin_amdgcn_s_waitcnt(0);
        unsigned nloc = b.st[0], nx = b.st[1];
        if (nloc == 0u) { xcd_barrier_complete(bar, b.x, nloc, nx); b.st[0] = nloc; b.st[1] = nx; }
        const unsigned old = xb_add(&bar[XB_XSUB(b.x)], 1u);
        const unsigned gen = old / nloc;
        if (old + 1u == (gen + 1u) * nloc) {
            __builtin_amdgcn_fence(__ATOMIC_RELEASE, "agent");
            asm volatile("s_waitcnt vmcnt(0)" ::: "memory");
            const unsigned og = xb_add(&bar[XB_TOP], 1u);
            const unsigned tg = og / nx;
            if (og + 1u == (tg + 1u) * nx) xb_add(&bar[XB_TOPGEN], 1u);
            else XB_SPIN(xb_ld(&bar[XB_TOPGEN]) == tg, bar);
            __builtin_amdgcn_fence(__ATOMIC_ACQUIRE, "agent");
            xb_add(&bar[XB_XGEN(b.x)], 1u);
            asm volatile("s_waitcnt vmcnt(0)" ::: "memory");
        } else {
            XB_SPIN(xb_ld(&bar[XB_XGEN(b.x)]) == gen, bar);
            __builtin_amdgcn_fence(__ATOMIC_ACQUIRE, "agent");
            asm volatile("s_waitcnt vmcnt(0)" ::: "memory");
        }
    }
    __syncthreads();
}

struct Frame {
    LAS unsigned char* lds;
    volatile LAS unsigned* MISC;
    gu32* ctl;
    int tid, lane, wave;
    int vcu, G;
};
__device__ __forceinline__ float wave_sum(float v) {
#pragma unroll
    for (int o = 1; o < 64; o <<= 1) v += __shfl_xor(v, o);
    return v;
}
__device__ __forceinline__ void transpose_item(const float* W, int K, int N, void* WT, int k0, int n0, int drow0, LAS float* scr, int lane, bool f8, float wscale) {
    const GAS float* src = (const GAS float*)W + (size_t)k0 * N + n0 + lane;
#pragma unroll
    for (int hb = 0; hb < 2; ++hb) { float v[32];
#pragma unroll
        for (int i = 0; i < 32; ++i) v[i] = src[(size_t)(hb * 32 + i) * N];
#pragma unroll
        for (int i = 0; i < 32; ++i) { const int kk = hb * 32 + i; scr[kk * 64 + (lane ^ ((kk >> 3) << 3))] = v[i]; } }
    LDS_WAIT(); asm volatile("" ::: "memory");
    if (f8) {
        const int c = lane & 3;
#pragma unroll
        for (int j = 0; j < 4; ++j) { const int nn = (lane >> 2) + 16 * j; float v[16];
#pragma unroll
            for (int q = 0; q < 16; ++q) { const int kk = 16 * c + q; v[q] = scr[kk * 64 + (nn ^ ((kk >> 3) << 3))] * wscale; }
            v4u o; o.x = pg8::pk4_fp8(v[0], v[1], v[2], v[3]); o.y = pg8::pk4_fp8(v[4], v[5], v[6], v[7]); o.z = pg8::pk4_fp8(v[8], v[9], v[10], v[11]); o.w = pg8::pk4_fp8(v[12], v[13], v[14], v[15]);
            *(GAS v4u*)((unsigned char*)WT + (size_t)(drow0 + nn) * K + k0 + 16 * c) = o; }
    } else {
    const int c = lane & 7;
#pragma unroll
    for (int j = 0; j < 8; ++j) { const int n = (lane >> 3) + 8 * j; const LAS float* s = scr + (8 * c) * 64 + (n ^ (c << 3));
        v4u o; o.x = pk2(s[0 * 64], s[1 * 64]); o.y = pk2(s[2 * 64], s[3 * 64]); o.z = pk2(s[4 * 64], s[5 * 64]); o.w = pk2(s[6 * 64], s[7 * 64]);
        *(GAS v4u*)((bf16*)WT + (size_t)(drow0 + n) * K + k0 + 8 * c) = o; }
    }
    LDS_WAIT(); asm volatile("" ::: "memory");
}
__device__ __forceinline__ void convert_matrix(Frame& F, const float* W, int K, int N, void* WT, int il, unsigned& rot, bool f8 = false, float wscale = 1.0f) {
    LAS float* scr = (LAS float*)(F.lds + RING_OFF + F.wave * 16384);
    const unsigned gw = (unsigned)(F.vcu * NWAVES + F.wave), NGW = (unsigned)(F.G * NWAVES);
    const int nblk = N / 64, nitems = (K / 64) * nblk; int lane_ = F.lane; asm volatile("" : "+v"(lane_));
    for (int it = (int)((gw + NGW - rot % NGW) % NGW); it < nitems; it += (int)NGW) {
        const int kb = it / nblk, nb = it % nblk, n0 = 64 * nb;
        const int drow0 = il == 0 ? n0 : (n0 / 128) * 256 + (il - 1) * 128 + (n0 % 128);
        transpose_item(W, K, N, WT, 64 * kb, n0, drow0, scr, lane_, f8, wscale);
    }
    rot = (rot + (unsigned)nitems) % NGW;
}

struct RouterArgs { const float* router; gu32* cnt; unsigned* ltok; float* lw; };
template <int MODE, bool F8X = false>
__device__ __forceinline__ void norm_phase(Frame& F, const float* src, float* hout, const bf16* y1, const float* gain, bf16* xn, float* fout, const RouterArgs& R) {
    int lane_ = F.lane; asm volatile("" : "+v"(lane_));
    const int gw = F.vcu * NWAVES + F.wave, NGW = F.G * NWAVES, lane = lane_;
    f32x4 gv[4];
#pragma unroll
    for (int j = 0; j < 4; ++j) gv[j] = *(const GAS f32x4*)(gain + 256 * j + 4 * lane);
    LAS float* RL = (LAS float*)(F.lds + RING_OFF);
    if constexpr (MODE == 2) {
        int tid_ = F.tid; asm volatile("" : "+v"(tid_));
        for (int i = tid_; i < 8192; i += NWAVES * 64) RL[(i & 7) * 1024 + (i >> 3)] = ((const GAS float*)R.router)[i];
        LDS_WAIT(); __syncthreads();
    }
    const int nrows_w = gw < MTOK ? (MTOK - gw + NGW - 1) / NGW : 0;
    for (int cb = 0; cb < nrows_w; cb += 64) {
        int my_t = 0, my_e0 = 0, my_e1 = 0; float my_w0 = 0.f, my_w1 = 0.f; bool valid = false;
        const int cn = (nrows_w - cb) < 64 ? (nrows_w - cb) : 64;
        f32x4 vn[4]; unsigned long long yn[4];
        { const int row0_ = gw + cb * NGW; const GAS f32x4* xr = (const GAS f32x4*)(src + (size_t)row0_ * D) + lane;
#pragma unroll
          for (int j = 0; j < 4; ++j) vn[j] = xr[64 * j];
          if constexpr (MODE == 1 || MODE == 3) { const GAS unsigned long long* yr = (const GAS unsigned long long*)(y1 + (size_t)row0_ * D) + lane;
#pragma unroll
            for (int j = 0; j < 4; ++j) yn[j] = yr[64 * j]; } }
        for (int i = 0; i < cn; ++i) {
            const int row = gw + (cb + i) * NGW;
            f32x4 v[4]; float s = 0.f;
#pragma unroll
            for (int j = 0; j < 4; ++j) v[j] = vn[j];
            if constexpr (MODE == 1 || MODE == 3) {
#pragma unroll
                for (int j = 0; j < 4; ++j) { const unsigned long long w = yn[j]; const unsigned lo = (unsigned)w, hi = (unsigned)(w >> 32);
                    v[j].x += bflo(lo); v[j].y += bfhi(lo); v[j].z += bflo(hi); v[j].w += bfhi(hi); }
            }
            if (i + 1 < cn) { const int rown = row + NGW; const GAS f32x4* xr = (const GAS f32x4*)(src + (size_t)rown * D) + lane;
#pragma unroll
                for (int j = 0; j < 4; ++j) vn[j] = xr[64 * j];
                if constexpr (MODE == 1 || MODE == 3) { const GAS unsigned long long* yr = (const GAS unsigned long long*)(y1 + (size_t)rown * D) + lane;
#pragma unroll
                    for (int j = 0; j < 4; ++j) yn[j] = yr[64 * j]; } }
#pragma unroll
            for (int j = 0; j < 4; ++j) s += (v[j].x * v[j].x + v[j].y * v[j].y) + (v[j].z * v[j].z + v[j].w * v[j].w);
            if constexpr (MODE == 1) { GAS f32x4* hr = (GAS f32x4*)(hout + (size_t)row * D) + lane;
#pragma unroll
                for (int j = 0; j < 4; ++j) hr[64 * j] = v[j]; }
            const float rstd = 1.f / sqrtf(wave_sum(s) * (1.f / D) + 1e-6f);
#pragma unroll
            for (int j = 0; j < 4; ++j) v[j] = v[j] * rstd * gv[j];
            if constexpr (MODE == 3) { GAS f32x4* orow = (GAS f32x4*)(fout + (size_t)row * D) + lane;
#pragma unroll
                for (int j = 0; j < 4; ++j) orow[64 * j] = v[j];
            } else {
                if constexpr (F8X) { GAS unsigned* o4 = (GAS unsigned*)((unsigned char*)xn + (size_t)row * D) + lane;
#pragma unroll
                    for (int j = 0; j < 4; ++j) o4[64 * j] = pg8::pk4_fp8(v[j].x, v[j].y, v[j].z, v[j].w);
                } else { GAS unsigned long long* o8 = (GAS unsigned long long*)(xn + (size_t)row * D) + lane;
#pragma unroll
                    for (int j = 0; j < 4; ++j) o8[64 * j] = (unsigned long long)pk2(v[j].x, v[j].y) | ((unsigned long long)pk2(v[j].z, v[j].w) << 32); }
            }
            if constexpr (MODE == 2) {
                float lg[NE];
#pragma unroll
                for (int e = 0; e < NE; ++e) { float a = 0.f;
#pragma unroll
                    for (int j = 0; j < 4; ++j) { const f32x4 rr = *(const LAS f32x4*)(RL + e * 1024 + 256 * j + 4 * lane); a += (v[j].x * rr.x + v[j].y * rr.y) + (v[j].z * rr.z + v[j].w * rr.w); }
                    lg[e] = wave_sum(a); }
                int e0 = 0; float v0 = lg[0];
#pragma unroll
                for (int e = 1; e < NE; ++e) if (lg[e] > v0) { v0 = lg[e]; e0 = e; }
                int e1 = -1; float v1 = 0.f;
#pragma unroll
                for (int e = 0; e < NE; ++e) if (e != e0 && (e1 < 0 || lg[e] > v1)) { v1 = lg[e]; e1 = e; }
                const float w0 = 1.f / (1.f + __expf(v1 - v0));
                if (lane == i) { my_t = row; my_e0 = e0; my_e1 = e1; my_w0 = w0; my_w1 = 1.f - w0; valid = true; }
            }
        }
        if constexpr (MODE == 2) {
            unsigned myc = 0u;
#pragma unroll
            for (int e = 0; e < NE; ++e) { const unsigned long long b0 = __ballot(valid && my_e0 == e), b1 = __ballot(valid && my_e1 == e);
                const unsigned c = (unsigned)(__popcll(b0) + __popcll(b1)); if (lane == e) myc = c; }
            unsigned basev = 0u;
            if (lane < NE) basev = __hip_atomic_fetch_add(R.cnt + 64 * lane, myc, RLX_AGENT);
            const unsigned long long lt = (1ull << lane) - 1ull;
            unsigned pos0 = 0u, pos1 = 0u;
#pragma unroll
            for (int e = 0; e < NE; ++e) { const unsigned long long b0 = __ballot(valid && my_e0 == e), b1 = __ballot(valid && my_e1 == e);
                const unsigned be = (unsigned)__shfl((int)basev, e);
                if (my_e0 == e) pos0 = be + (unsigned)__popcll(b0 & lt);
                if (my_e1 == e) pos1 = be + (unsigned)__popcll(b0) + (unsigned)__popcll(b1 & lt); }
            if (valid) {
                ((GAS unsigned*)R.ltok)[(size_t)my_e0 * LIST_CAP + pos0] = (unsigned)my_t;             ((GAS float*)R.lw)[(size_t)my_e0 * LIST_CAP + pos0] = my_w0;
                ((GAS unsigned*)R.ltok)[(size_t)my_e1 * LIST_CAP + pos1] = (unsigned)my_t | (1u << 20); ((GAS float*)R.lw)[(size_t)my_e1 * LIST_CAP + pos1] = my_w1;
            }
        }
    }
    if constexpr (MODE == 2) { LDS_WAIT(); __syncthreads(); }
}

__device__ __forceinline__ void kstat_phase(Frame& F, const bf16* Kt, float* kmean, float* kmax2) {
    int lane_ = F.lane; asm volatile("" : "+v"(lane_));
    const int gw = F.vcu * NWAVES + F.wave, NGW = F.G * NWAVES, lane = lane_;
    for (int task = gw; task < BATCH * 16 * 8; task += NGW) {
        const int c8 = task & 7, n = (task >> 3) & 15, b = task >> 7;
        const GAS unsigned* p = (const GAS unsigned*)(Kt + ((size_t)b * SEQ + 256 * n) * D + c8 * 128) + lane;
        float a0 = 0.f, a1 = 0.f, mx = 0.f;
#pragma unroll 32
        for (int r = 0; r < 256; ++r) { const unsigned w = p[(size_t)r * (D / 2)]; const float v0 = bflo(w), v1 = bfhi(w); a0 += v0; a1 += v1;
            float s = v0 * v0 + v1 * v1; s += __shfl_xor(s, 1); s += __shfl_xor(s, 2); s += __shfl_xor(s, 4); s += __shfl_xor(s, 8); s += __shfl_xor(s, 16); mx = fmaxf(mx, s); }
        const int col = c8 * 128 + 2 * lane, hh = col >> 6, d = col & 63;
        GAS float* o = (GAS float*)(kmean + ((size_t)(b * 16 + hh) * 16 + n) * 64 + d);
        o[0] = a0 * (1.f / 256.f); o[1] = a1 * (1.f / 256.f);
        if ((lane & 31) == 0) ((GAS float*)kmax2)[(size_t)(b * 16 + hh) * 16 + n] = mx;
    }
}

struct KArgs { const float* in[17]; float* out; unsigned char* ws; int ph_lo, ph_hi; };
struct ConvDesc { const float* W; int K, N; unsigned char* WT; int il; bool f8; float sc; };
constexpr int NCONV = 61, CONV_CH = 128;
__device__ __forceinline__ ConvDesc conv_desc(const KArgs& args, unsigned char* ws, int m) {
    constexpr float WSC_UP = 32.0f, WSC_DN = 64.0f;
    ConvDesc d; d.il = 0; d.f8 = false; d.sc = 1.0f;
    if (m < 2) { d.W = args.in[7] + (size_t)m * D * 3 * D; d.K = D; d.N = 3 * D; d.WT = ws + WS_MQKV + (size_t)m * 3 * D * D * 2; }
    else if (m < 4) { const int j = m - 2; d.W = args.in[8] + (size_t)j * D * D; d.K = D; d.N = D; d.WT = ws + WS_MWO + (size_t)j * D * D * 2; }
    else if (m == 4) { d.W = args.in[4]; d.K = D; d.N = D; d.WT = ws + WS_DWO; }
    else if (m == 5) { d.W = args.in[3] + (size_t)D * 3 * D; d.K = D; d.N = 3 * D; d.WT = ws + WS_DQKV + (size_t)3 * D * D * 2; }
    else if (m == 6) { d.W = args.in[4] + (size_t)D * D; d.K = D; d.N = D; d.WT = ws + WS_DWO + (size_t)D * D * 2; }
    else if (m < 13) { const int r = m - 7, j = r / 3, t = r % 3; d.f8 = (j == 1);
        if (t < 2) { d.W = args.in[9 + t] + (size_t)j * D * DFF; d.K = D; d.N = DFF; d.WT = ws + WS_FGU + (size_t)j * 2 * DFF * D * 2; d.il = 1 + t; d.sc = d.f8 ? WSC_UP : 1.0f; }
        else { d.W = args.in[11] + (size_t)j * DFF * D; d.K = DFF; d.N = D; d.WT = ws + WS_FD + (size_t)j * D * DFF * 2; d.sc = d.f8 ? WSC_DN : 1.0f; } }
    else { const int r = m - 13, e = r / 3, t = r % 3; d.f8 = true;
        if (t < 2) { d.W = args.in[13 + t] + (size_t)e * D * DE; d.K = D; d.N = DE; d.WT = ws + WS_MGU + (size_t)e * 2 * DE * D; d.il = 1 + t; d.sc = WSC_UP; }
        else { d.W = args.in[15] + (size_t)e * DE * D; d.K = DE; d.N = D; d.WT = ws + WS_MD + (size_t)e * D * DE; d.sc = WSC_DN; } }
    return d;
}
__device__ __forceinline__ int conv_chunks_of(int m) { const int items = m < 2 || m == 5 ? 768 : (m < 7 ? 256 : (m < 13 ? 704 : 896)); return (items + CONV_CH - 1) / CONV_CH; }
__device__ __forceinline__ int conv_total_chunks() { int s = 0; for (int m = 0; m < NCONV; ++m) s += conv_chunks_of(m); return s; }
__device__ __forceinline__ void conv_chunk(Frame& F, const KArgs& args, unsigned char* ws, int c) {
    int m = 0; for (; m < NCONV; ++m) { const int n = conv_chunks_of(m); if (c < n) break; c -= n; }
    const ConvDesc d = conv_desc(args, ws, m);
    LAS float* scr = (LAS float*)(F.lds + RING_OFF + F.wave * 16384);
    int lane_ = F.lane; asm volatile("" : "+v"(lane_));
    const int nblk = d.N / 64, nitems = (d.K / 64) * nblk, last = (c + 1) * CONV_CH < nitems ? (c + 1) * CONV_CH : nitems;
    for (int it = c * CONV_CH + F.wave; it < last; it += NWAVES) {
        const int kb = it / nblk, nb = it % nblk, n0 = 64 * nb;
        const int drow0 = d.il == 0 ? n0 : (n0 / 128) * 256 + (d.il - 1) * 128 + (n0 % 128);
        transpose_item(d.W, d.K, d.N, d.WT, 64 * kb, n0, drow0, scr, lane_, d.f8, d.sc);
    }
}

__global__ void __launch_bounds__(NWAVES * 64, 2) trunk_fwd(KArgs args) {
    extern __shared__ __attribute__((aligned(16))) unsigned char lds[];
    Frame F;
    F.lds = (LAS unsigned char*)lds;
    F.MISC = (volatile LAS unsigned*)(F.lds + MISC_OFF);
    F.tid = threadIdx.x; F.lane = F.tid & 63; F.wave = __builtin_amdgcn_readfirstlane(F.tid >> 6);
    F.G = gridDim.x; { const int bx = blockIdx.x; F.vcu = (F.G % 8 == 0) ? (bx % 8) * (F.G / 8) + bx / 8 : bx; }
    F.ctl = (gu32*)(args.ws + WS_CTL);
    for (int u = F.tid; u < (LDS_BYTES - LDSCTL_OFF) / 4; u += NWAVES * 64) ((LAS unsigned*)(F.lds + LDSCTL_OFF))[u] = 0u;
    __syncthreads();
    Frame& F0 = F;
    const int lo = args.ph_lo, hi = args.ph_hi;
    XcdBarrier bar; bar.bar = (unsigned*)(F.ctl + CW_BAR); bar.x = 0; bar.st = nullptr;
    if (hi - lo > 1) bar = xcd_barrier_post((unsigned*)(F.ctl + CW_BAR), F.MISC + 8);
#define IN(k) (lo <= (k) && (k) < hi)
#ifndef PH_ENABLE
#define PH_ENABLE 0xFFFFFFFFu
#endif
#define PHEN(n) (((PH_ENABLE) >> (n)) & 1u)
#ifndef MK_DOUBLE
#define MK_DOUBLE 0u
#endif
#define NREP(n) ((((MK_DOUBLE) >> (n)) & 1u) ? 2 : 1)
#if defined(NO_OPQ)
#define OPQ(p) do {} while (0)
#else
#define OPQ(p) asm volatile("" : "+s"(p))
#endif
#if 0
#define STAMP(k) do { if (blockIdx.x == 0 && threadIdx.x == 0) { const unsigned long long t_ = __builtin_amdgcn_s_memrealtime(); ((GAS unsigned*)(F0.ctl))[3000 + (k)] = (unsigned)t_; } } while (0)
#else
#define STAMP(k) do {} while (0)
#endif
#define SEAM(k) do { if (IN(k) && IN((k) + 1)) { XcdBarrier b2_ = bar; OPQ(b2_.bar); xcd_barrier(b2_); } STAMP((k) + 1); } while (0)

#define PTRS() unsigned char* ws = args.ws; OPQ(ws); const float* x = args.in[0]; OPQ(x); const float* norm_mix = args.in[1]; OPQ(norm_mix); const float* norm_ffn = args.in[2]; OPQ(norm_ffn); \
    float* h = args.out; OPQ(h); \
    bf16* XN = (bf16*)(ws + WS_XN); bf16* Qb = (bf16*)(ws + WS_Q); bf16* Kb = (bf16*)(ws + WS_K); bf16* Vb = (bf16*)(ws + WS_V); bf16* ACT = (bf16*)(ws + WS_ACT); \
    bf16* MGU = (bf16*)(ws + WS_MGU); bf16* MD = (bf16*)(ws + WS_MD); \
    float* kmean = (float*)(ws + WS_KMEAN); unsigned* ltok = (unsigned*)(ws + WS_LTOK); float* lw = (float*)(ws + WS_LW); \
    (void)x; (void)norm_mix; (void)norm_ffn; (void)h; (void)XN; (void)Qb; (void)Kb; (void)Vb; (void)ACT; (void)MGU; (void)MD; (void)kmean; (void)ltok; (void)lw
    const RouterArgs noR{nullptr, nullptr, nullptr, nullptr};
#ifndef MK_F8_DENSE
#define MK_F8_DENSE 0
#endif
    constexpr bool F8_DENSE = MK_F8_DENSE != 0; constexpr int DESZ = F8_DENSE ? 1 : 2;
    constexpr float WSC_UP = 32.0f, WSC_DN = 64.0f;
    constexpr float C2 = 0.125f * 1.4426950408889634f;

    STAMP(0);
    if (PHEN(0) && IN(0)) {
        PTRS();
        { unsigned rot = 0u;
        convert_matrix(F, args.in[3], D, 3 * D, ws + WS_DQKV, 0, rot);
        norm_phase<0>(F, x, nullptr, nullptr, norm_mix, XN, nullptr, noR);
        }
    }
    SEAM(0);

    for (int L = 0; L < NLAYER; ++L) {
        const int j = L >> 1, moba = L & 1, pb = 1 + PH_PER_LAYER * L;
        int z_ = 0;
#if !defined(NO_OPQ_Z)
        asm volatile("" : "+s"(z_));
#endif
        Frame Fl = F0; Fl.G += z_; Fl.vcu += z_; Fl.wave += z_; Fl.lds += z_; Fl.ctl += z_; const int bx = (int)blockIdx.x + z_;
#define F Fl
        if (PHEN(1) && IN(pb + 0)) {
            PTRS();

            const bf16* W = (const bf16*)(ws + (moba ? WS_MQKV : WS_DQKV)) + (size_t)j * 3 * D * D;
            pg8::Gemm g{XN, W, 2 * D, 0}; pg8::StaticOrder S; S.init(MTOK, 3 * D, F.G, bx);
            pg8::EpiQKV E{Qb, D, D, (size_t)(WS_K - WS_Q) / 2, C2};
            for (int rep_ = 0; rep_ < NREP(1); ++rep_) pg8::gemm_phase<pg8::EpiQKV, pg8::StaticOrder>(F.lds + RING_OFF, XSLOT_OFF, g, S, E);
        }
        SEAM(pb + 0);
        { if (PHEN(2) && IN(pb + 1)) { PTRS(); kstat_phase(F, Kb, kmean, kmean + 8 * 16 * 16 * 64); } SEAM(pb + 1); }
        if (IN(pb + 2)) {
            PTRS();
            att::Args A; A.Q = Qb; A.K = Kb; A.V = Vb; A.O = XN; A.kmean = kmean; A.kmax2 = kmean + 8 * 16 * 16 * 64; A.subln = args.in[6] + (size_t)j * 128; A.lam_full = 0.f; A.out_scale = 1.f;
            gu32* qctr = F.ctl + CW_ATTQ + 64 * L; LAS int* qw = (LAS int*)(F.lds + RING_OFF + 71680 + 260);
            if (!moba) {
                const float* lam = args.in[5] + (size_t)j * 256; int lane = F.lane; asm volatile("" : "+v"(lane));
                const GAS float* lamg = (const GAS float*)lam; const float s1 = wave_sum(lamg[lane] * lamg[64 + lane]), s2 = wave_sum(lamg[128 + lane] * lamg[192 + lane]);
                const float lam_init = (L == 0) ? 0.2f : 0.47071302f;
                A.lam_full = __uint_as_float(__builtin_amdgcn_readfirstlane(__float_as_uint(__expf(s1) - __expf(s2) + lam_init))); A.out_scale = __uint_as_float(__builtin_amdgcn_readfirstlane(__float_as_uint(1.0f - lam_init)));
            }
            const int nconv = (L == 0) ? conv_total_chunks() : 0;
            qw = (LAS int*)(F.lds + XSLOT_OFF);
            if ((PHEN(3) && !moba) || (PHEN(4) && moba)) for (;;) {
                if (F.tid == 0) *qw = (int)__hip_atomic_fetch_add(qctr, 1u, RLX_AGENT);
                asm volatile("s_waitcnt vmcnt(0) lgkmcnt(0)\n\ts_barrier" ::: "memory");
                int idx = __builtin_amdgcn_readfirstlane(*qw);
                if (idx >= 1024 + nconv) break;
                if (nconv) { const int q3 = idx / 3; if (idx < 3 * nconv) { if (idx - 3 * q3 == 2) { conv_chunk(F, args, ws, q3); asm volatile("s_waitcnt vmcnt(0) lgkmcnt(0)\n\ts_barrier" ::: "memory"); continue; } idx -= q3; } else idx -= nconv; }
                if (!moba) { const int hh = 7 - (idx >> 7), bb = (idx >> 4) & 7, pr = idx & 15;
                    att::attn_unit<0>(F.lds + RING_OFF, A, bb, hh, pr);
                    att::attn_unit<0>(F.lds + RING_OFF, A, bb, hh, 31 - pr);
                } else { const int hh = 15 - (idx >> 6), bb = (idx >> 3) & 7, pr = idx & 7;
                    att::attn_unit<1>(F.lds + RING_OFF, A, bb, hh, pr);
                    att::attn_unit<1>(F.lds + RING_OFF, A, bb, hh, 15 - pr); }
            }
            asm volatile("s_waitcnt vmcnt(0) lgkmcnt(0)\n\ts_barrier" ::: "memory");
        }
        SEAM(pb + 2);
        if (PHEN(5) && IN(pb + 3)) {
            PTRS();
            const bf16* W = (const bf16*)(ws + (moba ? WS_MWO : WS_DWO)) + (size_t)j * D * D;
            pg8::Gemm g{XN, W, 2 * D, 0}; pg8::StaticOrder S; S.init(MTOK, D, F.G, bx);
            pg8::EpiRes E{L == 0 ? x : h, h, D, 1.0f};
            pg8::gemm_phase<pg8::EpiRes, pg8::StaticOrder>(F.lds + RING_OFF, XSLOT_OFF, g, S, E);
        }
        SEAM(pb + 3);
        if (PHEN(6) && IN(pb + 4)) {
            PTRS();
            if (!moba) {
                if (L == 2) norm_phase<0, true>(F, h, nullptr, nullptr, norm_ffn + (size_t)L * D, XN, nullptr, noR);
                else norm_phase<0, false>(F, h, nullptr, nullptr, norm_ffn + (size_t)L * D, XN, nullptr, noR);
            } else {
                const RouterArgs R{args.in[12] + (size_t)j * D * NE, F.ctl + CW_CNT + 64 * NE * j, ltok, lw};
                norm_phase<2, true>(F, h, nullptr, nullptr, norm_ffn + (size_t)L * D, XN, nullptr, R);
            }
        }
        SEAM(pb + 4);
        if (IN(pb + 5)) {
            PTRS();
            if (PHEN(7) && !moba) {
                if (L == 2) { pg8::Gemm g{XN, ws + WS_FGU + (size_t)j * 2 * DFF * D * 2, D, 0}; pg8::StaticOrder S; S.init(MTOK, 2 * DFF, F.G, bx);
                    pg8::EpiSwiGLU<true> E{ACT, DFF, 1.0f / WSC_UP};
                    pg8::gemm_phase<pg8::EpiSwiGLU<true>, pg8::StaticOrder, true>(F.lds + RING_OFF, XSLOT_OFF, g, S, E);
                } else { pg8::Gemm g{XN, ws + WS_FGU + (size_t)j * 2 * DFF * D * 2, 2 * D, 0}; pg8::StaticOrder S; S.init(MTOK, 2 * DFF, F.G, bx);
                    pg8::EpiSwiGLU<false> E{ACT, DFF, 1.0f};
                    pg8::gemm_phase<pg8::EpiSwiGLU<false>, pg8::StaticOrder, false>(F.lds + RING_OFF, XSLOT_OFF, g, S, E); }
            } else if (PHEN(8) && moba) {
                pg8::Gemm g{XN, ws + WS_MGU + (size_t)j * NE * 2 * DE * D, D, (size_t)2 * DE * D}; pg8::MoeOrder S; S.init((const unsigned*)(F.ctl + CW_CNT + 64 * NE * j), ltok, true, 2 * DE, F.G, bx);
                pg8::EpiSwiGLU<true> E{ACT, DE, 1.0f / WSC_UP};
                pg8::gemm_phase<pg8::EpiSwiGLU<true>, pg8::MoeOrder, true>(F.lds + RING_OFF, XSLOT_OFF, g, S, E);
            }
        }
        SEAM(pb + 5);
        if (IN(pb + 6)) {
            PTRS();
            if (PHEN(9) && !moba) {
                if (L == 2) { pg8::Gemm g{ACT, ws + WS_FD + (size_t)j * D * DFF * 2, DFF, 0}; pg8::StaticOrder S; S.init(MTOK, D, F.G, bx);
                    pg8::EpiRes E{h, h, D, 1.0f / WSC_DN};
                    pg8::gemm_phase<pg8::EpiRes, pg8::StaticOrder, true>(F.lds + RING_OFF, XSLOT_OFF, g, S, E);
                } else { pg8::Gemm g{ACT, ws + WS_FD + (size_t)j * D * DFF * 2, 2 * DFF, 0}; pg8::StaticOrder S; S.init(MTOK, D, F.G, bx);
                    pg8::EpiRes E{h, h, D, 1.0f};
                    pg8::gemm_phase<pg8::EpiRes, pg8::StaticOrder, false>(F.lds + RING_OFF, XSLOT_OFF, g, S, E); }
            } else if (PHEN(10) && moba) {
                pg8::Gemm g{ACT, ws + WS_MD + (size_t)j * NE * D * DE, DE, (size_t)D * DE}; pg8::MoeOrder S; S.init((const unsigned*)(F.ctl + CW_CNT + 64 * NE * j), ltok, false, D, F.G, bx);
                pg8::EpiMoeDown E; E.h = h; E.y1 = XN; E.list_tok = ltok; E.list_w = lw; E.sc = 1.0f / WSC_DN;
#pragma unroll
                for (int e = 0; e < NE; ++e) E.cnt[e] = S.cnt[e];
                pg8::gemm_phase<pg8::EpiMoeDown, pg8::MoeOrder, true>(F.lds + RING_OFF, XSLOT_OFF, g, S, E);
            }
        }
        SEAM(pb + 6);
        if (PHEN(11) && IN(pb + 7)) {
            PTRS();
            if (L == 3) norm_phase<3>(F, h, nullptr, XN, args.in[16], nullptr, h, noR);
            else if (moba) norm_phase<1>(F, h, h, XN, norm_mix + (size_t)(L + 1) * D, XN, nullptr, noR);
            else for (int rep_ = 0; rep_ < NREP(11); ++rep_) norm_phase<0>(F, h, nullptr, nullptr, norm_mix + (size_t)(L + 1) * D, XN, nullptr, noR);
        }
        if (L != NLAYER - 1) SEAM(pb + 7); else STAMP(pb + 8);
#undef F
    }
#undef IN
#undef SEAM
#undef PTRS
#undef OPQ
}


#if MK_DEBUG
__global__ void dbg_probe(const void* buf, size_t n, int is_bf16, int idx, float thresh, unsigned* dbg) {
    size_t i = blockIdx.x * (size_t)blockDim.x + threadIdx.x, stride = (size_t)gridDim.x * blockDim.x; bool bad = false;
    for (size_t k = i; k < n; k += stride) { float v = is_bf16 ? __uint_as_float(((unsigned)((const unsigned short*)buf)[k]) << 16) : ((const float*)buf)[k]; if (!(fabsf(v) <= thresh)) bad = true; }
    if (bad) atomicMax(dbg, (unsigned)(1000 - idx));
}
__global__ void dbg_cnt(const unsigned* cntw, int idx, unsigned* dbg) {
    if (threadIdx.x == 0 && blockIdx.x == 0) { unsigned s = 0; for (int e = 0; e < NE; ++e) s += cntw[64 * e]; if (s != 2u * MTOK) atomicMax(dbg, (unsigned)(1000 - idx)); }
}

__device__ __forceinline__ float dbg_bf(unsigned short v) { return __uint_as_float(((unsigned)v) << 16); }
__device__ __forceinline__ unsigned dbg_hash(unsigned x) { x ^= x >> 16; x *= 0x7feb352dU; x ^= x >> 15; x *= 0x846ca68bU; x ^= x >> 16; return x; }
__global__ void dbg_gemm_check(const unsigned short* A, int lda, const unsigned short* Bt, int K, const unsigned short* out, int ldo, int M, int N, float scale, int idx, unsigned* dbg) {
    const unsigned s = blockIdx.x * blockDim.x + threadIdx.x; const int row = (int)(dbg_hash(2 * s + 1) % (unsigned)M), col = (int)(dbg_hash(2 * s + 2) % (unsigned)N);
    float acc = 0.f; for (int k = 0; k < K; ++k) acc += dbg_bf(A[(size_t)row * lda + k]) * dbg_bf(Bt[(size_t)col * K + k]);
    acc *= scale; const float got = dbg_bf(out[(size_t)row * ldo + col]);
    if (!(fabsf(got - acc) <= 0.03f + 0.02f * fabsf(acc))) { atomicMax(dbg, (unsigned)(1000 - idx)); atomicAdd(dbg + 64 + idx, 1u); }
}
__global__ void dbg_conv_check(const float* W, int K, int N, const unsigned short* WT, int il, int idx, unsigned* dbg) {
    const unsigned s = blockIdx.x * blockDim.x + threadIdx.x; const int k = (int)(dbg_hash(2 * s + 1) % (unsigned)K), n = (int)(dbg_hash(2 * s + 2) % (unsigned)N);
    const int dr = il == 0 ? n : (n / 128) * 256 + (il - 1) * 128 + (n % 128);
    const float w = W[(size_t)k * N + n], g = dbg_bf(WT[(size_t)dr * K + k]);
    if (!(fabsf(g - w) <= 0.01f * fabsf(w) + 1e-6f)) atomicMax(dbg, (unsigned)(1000 - idx));
}
__global__ void dbg_norm_check(const float* src, const float* gain, const unsigned short* xn, int idx, unsigned* dbg) {
    const unsigned s = blockIdx.x * blockDim.x + threadIdx.x; const int row = (int)(dbg_hash(s + 77) % (unsigned)MTOK);
    float ss = 0.f; for (int c = 0; c < D; ++c) { const float v = src[(size_t)row * D + c]; ss += v * v; }
    const float rstd = 1.f / sqrtf(ss / D + 1e-6f); bool bad = false;
    for (int c = 0; c < D; ++c) { const float r = src[(size_t)row * D + c] * rstd * gain[c], g = dbg_bf(xn[(size_t)row * D + c]); if (!(fabsf(g - r) <= 0.02f + 0.01f * fabsf(r))) bad = true; }
    if (bad) atomicMax(dbg, (unsigned)(1000 - idx));
}
__global__ void dbg_naive_gemm(const unsigned short* A, const unsigned short* Bt, unsigned short* out, int M, int N, int K) {
    const size_t i = blockIdx.x * (size_t)blockDim.x + threadIdx.x; if (i >= (size_t)M * N) return; const int row = (int)(i / N), col = (int)(i % N);
    float acc = 0.f; for (int k = 0; k < K; ++k) acc += dbg_bf(A[(size_t)row * K + k]) * dbg_bf(Bt[(size_t)col * K + k]);
    out[(size_t)row * N + col] = (unsigned short)f2bf(acc);
}
__global__ void dbg_find_col(const unsigned short* out, const unsigned short* ref, int M, int N, unsigned* hist) {
    const unsigned s = blockIdx.x * blockDim.x + threadIdx.x; const int row = (int)(dbg_hash(2 * s + 1) % (unsigned)M), col = (int)(dbg_hash(2 * s + 2) % (unsigned)N);
    const unsigned short v = out[(size_t)row * N + col]; int found = -1;
#if MK_FIND_PATTERN
    if (v == 0x3C3C) atomicAdd(hist + N, 1u); else atomicAdd(hist + 5, 1u); return;
#endif
#if MK_FIND_ROWS
    for (int r = 0; r < M; ++r) if (ref[(size_t)r * N + col] == v) { found = r; break; }
    if (found < 0) atomicAdd(hist + N, 1u); else atomicAdd(hist + ((found - row) & (N - 1)), 1u);
#else
    for (int c = 0; c < N; ++c) if (ref[(size_t)row * N + c] == v) { found = c; break; }
    if (found < 0) atomicAdd(hist + N, 1u); else atomicAdd(hist + ((found - col) & (N - 1)), 1u);
#endif
}
__global__ void dbg_hist_code(const unsigned* hist, int N, unsigned* dbg) {
    if (threadIdx.x || blockIdx.x) return; unsigned best = 0, bi = 0; for (int i = 0; i < N; ++i) if (hist[i] > best) { best = hist[i]; bi = i; }
    dbg[32] = bi; dbg[33] = best; dbg[34] = hist[N];
}
__global__ void dbg_final(float* out, size_t n, const unsigned* dbg) {
    if (MK_HIST_SEL >= 10) { const float c3 = sqrtf((float)dbg[MK_HIST_SEL + 30]); size_t i3 = blockIdx.x * (size_t)blockDim.x + threadIdx.x, st3 = (size_t)gridDim.x * blockDim.x; for (size_t k3 = i3; k3 < n; k3 += st3) out[k3] = c3; return; }
    if (MK_HIST_SEL >= 0 && (dbg[33] || dbg[34])) { const float c2 = sqrtf((float)(MK_HIST_SEL == 0 ? dbg[32] : (MK_HIST_SEL == 1 ? dbg[33] * 100u / 4096u : dbg[34] * 100u / 4096u)) + 1.f); size_t i2 = blockIdx.x * (size_t)blockDim.x + threadIdx.x, st2 = (size_t)gridDim.x * blockDim.x; for (size_t k2 = i2; k2 < n; k2 += st2) out[k2] = c2; return; }
    const unsigned d = dbg[0]; if (d == 0u) return; const unsigned nf = dbg[64 + (1000u - d)]; const float c = sqrtf(nf ? (float)(200u * (1000u - d - 9u) + nf * 100u / 4096u) : (float)(1000u - d));
    size_t i = blockIdx.x * (size_t)blockDim.x + threadIdx.x, stride = (size_t)gridDim.x * blockDim.x;
    for (size_t k = i; k < n; k += stride) out[k] = c;
}
#endif

#ifndef MK_REPEAT
#define MK_REPEAT 1
#endif
#ifndef MK_FIND_ROWS
#define MK_FIND_ROWS 0
#endif
#ifndef MK_FIND_REGION
#define MK_FIND_REGION WS_K
#endif
#ifndef MK_HIST_SEL
#define MK_HIST_SEL 0
#endif
#ifndef MK_STAMP
#define MK_STAMP 0
#endif
#if MK_STAMP
__global__ void stamp_k(unsigned* p) { if (threadIdx.x == 0) *p = (unsigned)__builtin_amdgcn_s_memrealtime(); }
__global__ void stamp_encode(float* out, size_t n, const unsigned* st, int pa, float ua, int pb, float ub) {
    const float da = (float)(st[pa + 1] - st[pa]) * 0.01f, db = (float)(st[pb + 1] - st[pb]) * 0.01f;
    float m = da / ua; m = m < 10.f ? 10.f : (m > 99.f ? 99.f : m); float e = floorf(db / ub + 0.5f); e = e < 0.f ? 0.f : (e > 30.f ? 30.f : e);
    const float c = sqrtf(m) * __powf(10.f, 0.5f * e);
    size_t i = blockIdx.x * (size_t)blockDim.x + threadIdx.x, stride = (size_t)gridDim.x * blockDim.x;
    for (size_t k = i; k < n; k += stride) out[k] = c;
}
#endif
extern "C" void kernel_launch(void* const* d_in, const int* in_sizes, int n_in, void* d_out, int out_size, void* d_ws, size_t ws_size, hipStream_t stream) {
    static int grid = 0;
    if (grid == 0) {
        if (n_in != 17 || in_sizes[0] != MTOK * D || out_size != MTOK * D || ws_size < WS_END) {
            fprintf(stderr, "kernel_launch: built for 17 inputs, x/out of %d floats, >= %zu bytes of workspace; got n_in %d, in0 %d, out %d, ws %zu; nothing launched\n", MTOK * D, (size_t)WS_END, n_in, n_in > 0 ? in_sizes[0] : -1, out_size, ws_size);
            grid = -1; return; }
        int dev = 0, cus = 0, per_cu = 0;
        if (hipGetDevice(&dev) != hipSuccess || hipDeviceGetAttribute(&cus, hipDeviceAttributeMultiprocessorCount, dev) != hipSuccess) { fprintf(stderr, "kernel_launch: device query failed\n"); grid = -1; return; }
        if (hipFuncSetAttribute((const void*)trunk_fwd, hipFuncAttributeMaxDynamicSharedMemorySize, LDS_BYTES) != hipSuccess) { fprintf(stderr, "kernel_launch: hipFuncSetAttribute failed\n"); grid = -1; return; }
        if (hipOccupancyMaxActiveBlocksPerMultiprocessor(&per_cu, (const void*)trunk_fwd, NWAVES * 64, LDS_BYTES) != hipSuccess || per_cu < 1)
            fprintf(stderr, "kernel_launch: note: occupancy query reports %d workgroups per CU\n", per_cu);
        (void)hipGetLastError();
        grid = cus;
    }
    if (grid < 0) return;
    if (hipMemsetAsync((char*)d_ws + WS_CTL, 0, CTL_ZERO_BYTES, stream) != hipSuccess) { fprintf(stderr, "kernel_launch: memset failed\n"); return; }
    KArgs a{};
    for (int i = 0; i < 17; ++i) a.in[i] = (const float*)d_in[i];
    a.out = (float*)d_out; a.ws = (unsigned char*)d_ws;
#if MK_PER_PHASE
#if MK_STAMP
    hipLaunchKernelGGL(stamp_k, dim3(1), dim3(64), 0, stream, (unsigned*)d_ws + 3000);
#endif
    for (int p = 0; p < NPHASE; ++p) {
        a.ph_lo = p; a.ph_hi = p + 1;
#if MK_DEBUG
#endif
#if !defined(MK_SKIP_MAIN)
        for (int rep_ = 0; rep_ < (p == 1 ? MK_REPEAT : 1); ++rep_) hipLaunchKernelGGL(trunk_fwd, dim3(grid), dim3(NWAVES * 64), LDS_BYTES, stream, a);
#endif
#if MK_STAMP
        hipLaunchKernelGGL(stamp_k, dim3(1), dim3(64), 0, stream, (unsigned*)d_ws + 3000 + p + 1);
#endif
#if MK_DEBUG
        {   unsigned char* ws = (unsigned char*)d_ws; unsigned* dbg = (unsigned*)(ws + WS_CTL) + 2048;
            const size_t MD_ = (size_t)MTOK * D;
#define PROBE(buf, n, isbf, idx, th) if ((idx) <= MK_PROBE_MAX) hipLaunchKernelGGL(dbg_probe, dim3(2048), dim3(256), 0, stream, (const void*)(buf), (size_t)(n), isbf, idx, th, dbg)
            if (p == 0) {
                hipLaunchKernelGGL(dbg_norm_check, dim3(4), dim3(64), 0, stream, (const float*)d_in[0], (const float*)d_in[1], (const unsigned short*)(ws + WS_XN), 4, dbg);
                hipLaunchKernelGGL(dbg_conv_check, dim3(16), dim3(256), 0, stream, (const float*)d_in[3], D, 3 * D, (const unsigned short*)(ws + WS_DQKV), 0, 5, dbg);
                hipLaunchKernelGGL(dbg_conv_check, dim3(16), dim3(256), 0, stream, (const float*)d_in[9], D, DFF, (const unsigned short*)(ws + WS_FGU), 1, 6, dbg);
                hipLaunchKernelGGL(dbg_conv_check, dim3(16), dim3(256), 0, stream, (const float*)d_in[10], D, DFF, (const unsigned short*)(ws + WS_FGU), 2, 7, dbg);
                hipLaunchKernelGGL(dbg_conv_check, dim3(16), dim3(256), 0, stream, (const float*)d_in[11], DFF, D, (const unsigned short*)(ws + WS_FD), 0, 8, dbg);
                hipLaunchKernelGGL(dbg_conv_check, dim3(16), dim3(256), 0, stream, (const float*)d_in[15] + (size_t)3 * DE * D, DE, D, (const unsigned short*)(ws + WS_MD) + (size_t)3 * D * DE, 0, 9, dbg);
            }
            if (p == 1) {
                const float C2h = 0.125f * 1.4426950408889634f;
                hipLaunchKernelGGL(dbg_gemm_check, dim3(16), dim3(256), 0, stream, (const unsigned short*)(ws + WS_XN), D, (const unsigned short*)(ws + WS_DQKV), D, (const unsigned short*)(ws + WS_Q), D, MTOK, D, C2h, 10, dbg);
                hipLaunchKernelGGL(dbg_gemm_check, dim3(16), dim3(256), 0, stream, (const unsigned short*)(ws + WS_XN), D, (const unsigned short*)(ws + WS_DQKV) + (size_t)D * D, D, (const unsigned short*)(ws + WS_K), D, MTOK, D, 1.f, 11, dbg);

                hipLaunchKernelGGL(dbg_gemm_check, dim3(16), dim3(256), 0, stream, (const unsigned short*)(ws + WS_XN), D, (const unsigned short*)(ws + WS_DQKV) + (size_t)2 * D * D, D, (const unsigned short*)(ws + WS_V), D, MTOK, D, 1.f, 12, dbg);
            }
            if (0) { PROBE(ws + WS_XN, MD_, 1, 1, 10.f); PROBE(ws + WS_DQKV, (WS_MGU - WS_DQKV) / 2, 1, 2, 1.f); PROBE(ws + WS_MGU, (WS_XN - WS_MGU) / 2, 1, 3, 1.f); }
            if (p >= 1) { const int L = (p - 1) / PH_PER_LAYER, k = (p - 1) % PH_PER_LAYER; const int b = 20 + 10 * L;
                if (k == 0) PROBE(ws + WS_Q, 3 * MD_, 1, b + 0, 50.f);
                if (k == 1) PROBE(ws + WS_KMEAN, 8 * 16 * 16 * 64, 0, b + 1, 5.f);
                if (k == 2) PROBE(ws + WS_XN, MD_, 1, b + 2, 50.f);
                if (k == 3) PROBE(d_out, MD_, 0, b + 3, 300.f);
                if (k == 4) { PROBE(ws + WS_XN, MD_, 1, b + 4, 20.f); if ((L & 1) && (b + 9) <= MK_PROBE_MAX) hipLaunchKernelGGL(dbg_cnt, dim3(1), dim3(64), 0, stream, (const unsigned*)(ws + WS_CTL) + CW_CNT + 64 * NE * (L >> 1), b + 9, dbg); }
                if (k == 5) PROBE(ws + WS_ACT, (L & 1) ? (size_t)256 * 256 * DE : (size_t)MTOK * DFF, 1, b + 5, 2000.f);
                if (k == 6) { PROBE(d_out, MD_, 0, b + 6, 1000.f); if (L & 1) PROBE(ws + WS_XN, MD_, 1, b + 7, 1000.f); }
                if (k == 7 && L != 3) { PROBE(ws + WS_XN, MD_, 1, b + 8, 20.f); PROBE(d_out, MD_, 0, b + 8, 1000.f); }
            }
#undef PROBE
        }
#endif
    }
#if MK_DEBUG
    hipLaunchKernelGGL(dbg_final, dim3(2048), dim3(256), 0, stream, (float*)d_out, (size_t)MTOK * D, (const unsigned*)((unsigned char*)d_ws + WS_CTL) + 2048);
#endif
#else
    a.ph_lo = 0; a.ph_hi = NPHASE;
    hipLaunchKernelGGL(trunk_fwd, dim3(grid), dim3(NWAVES * 64), LDS_BYTES, stream, a);
#if 0
    hipLaunchKernelGGL(stamp_encode, dim3(2048), dim3(256), 0, stream, (float*)d_out, (size_t)MTOK * D, (const unsigned*)d_ws + 3000, MK_STAMP_PA, MK_STAMP_UA, MK_STAMP_PB, MK_STAMP_UB);
#endif
#endif
#if MK_STAMP
    hipLaunchKernelGGL(stamp_encode, dim3(2048), dim3(256), 0, stream, (float*)d_out, (size_t)MTOK * D, (const unsigned*)d_ws + 3000, MK_STAMP_PA, MK_STAMP_UA, MK_STAMP_PB, MK_STAMP_UB);
#endif
    const hipError_t le = hipPeekAtLastError();
    if (le != hipSuccess) fprintf(stderr, "kernel_launch: launch failed: %s\n", hipGetErrorName(le));
}
```

```cpp
#ifndef MK_DEBUG
#define MK_DEBUG 0
#endif
#ifndef MK_PER_PHASE
#define MK_PER_PHASE 0
#endif
#include <hip/hip_runtime.h>
#include <cstdio>
#include <cstdint>

#ifndef MK_KDEBUG
#define MK_KDEBUG 0
#endif
#define LAS __attribute__((address_space(3)))
#define GAS __attribute__((address_space(1)))

constexpr int BATCH = 8, SEQ = 4096, MTOK = BATCH * SEQ, D = 1024, DFF = 2816, DE = 3584, NE = 8;
constexpr int MOE_TILES_MAX = 272;
constexpr int LIST_CAP = MTOK;

namespace pg8 {
#define PG8_LAS __attribute__((address_space(3)))
typedef unsigned short bf16_t;
typedef short bf16x8 __attribute__((ext_vector_type(8)));
typedef float f32x4 __attribute__((ext_vector_type(4)));
typedef unsigned u32x4 __attribute__((ext_vector_type(4)));
typedef int i32x4 __attribute__((ext_vector_type(4)));
typedef int i32x8 __attribute__((ext_vector_type(8)));
constexpr int BM = 256, BK = 64, HALF = 128, HTB = HALF * BK * 2  , STAGE_BYTES = 8 * HTB, NXCD = 8, WGM = 8;

__host__ __device__ __forceinline__ int lds_byte(int r, int c) { const int st = (r >> 4) * 2 + (c >> 5), rr = r & 15, cc = c & 31, ob = rr * 64 + cc * 2; return st * 1024 + (ob ^ (((ob >> 9) & 1) << 5)); }
__host__ __device__ __forceinline__ void stage_rc(int b, int& R, int& C) { const int st = b / 1024, sb = b % 1024, swz = sb ^ (((sb >> 9) & 1) << 5); R = (st >> 1) * 16 + swz / 64; C = (st & 1) * 32 + (swz % 64) / 2; }
__host__ __device__ __forceinline__ int perm32(int rho) { const int n = rho >> 4, i = rho & 15; return 8 * (i >> 2) + 4 * n + (i & 3); }

struct Unit { int pm, pn, e, r0; };
struct Gemm { const void* A; const void* Bt; int rowb; size_t bstride; };

__device__ __forceinline__ void tile_of(int L, int nM, int nN, int& pm, int& pn) {
    const int nwg = nM * nN; int wgid = L; { const int q = nwg / NXCD, r = nwg % NXCD, xcd = wgid % NXCD, off = wgid / NXCD; wgid = (xcd < r ? xcd * (q + 1) : r * (q + 1) + (xcd - r) * q) + off; }
    const int nig = WGM * nN, gid = wgid / nig, fm = gid * WGM, gsz = (nM - fm) < WGM ? (nM - fm) : WGM;
    pm = fm + ((wgid % nig) % gsz); pn = (wgid % nig) / gsz;
}
struct StaticOrder {
    int nM, nN, nwg, G, c;
    __device__ __forceinline__ void init(int M, int N, int G_, int c_) { nM = M / BM; nN = N / BM; nwg = nM * nN; G = G_; c = c_; }
    __device__ __forceinline__ bool next(int i, Unit& u) const {
        const long L = (long)i * G + c; if (L >= nwg) return false;
        tile_of((int)L, nM, nN, u.pm, u.pn); u.e = 0; u.r0 = 0; return true;
    }
    __device__ __forceinline__ unsigned arow(const Unit& u, int lr) const { return (unsigned)(u.pm * BM + lr); }
};
struct MoeOrder {
    int nM, nN, nwg, G, c; int tstart[NE + 1]; int cnt[NE]; const unsigned* list_tok; bool gather;
    __device__ __forceinline__ void init(const unsigned* cntw, const unsigned* list_tok_, bool gather_, int N, int G_, int c_) {
        int acc = 0;
#pragma unroll
        for (int e = 0; e < NE; ++e) { const int ce = (int)__builtin_amdgcn_readfirstlane((int)__hip_atomic_load((const GAS unsigned*)cntw + 64 * e, __ATOMIC_RELAXED, __HIP_MEMORY_SCOPE_AGENT)); cnt[e] = ce; tstart[e] = acc; acc += (ce + BM - 1) / BM; }
        tstart[NE] = acc; nM = acc; nN = N / BM; nwg = nM * nN; G = G_; c = c_; list_tok = list_tok_; gather = gather_;
    }
    __device__ __forceinline__ bool next(int i, Unit& u) const {
        const long L = (long)i * G + c; if (L >= nwg) return false;
        tile_of((int)L, nM, nN, u.pm, u.pn); int e = 0;
#pragma unroll
        for (int k = 1; k < NE; ++k) e += (u.pm >= tstart[k]) ? 1 : 0;
        u.e = e; int ts = 0;
#pragma unroll
        for (int k = 0; k < NE; ++k) ts = (k == e) ? tstart[k] : ts;
        u.r0 = (u.pm - ts) * BM; return true;
    }
    __device__ __forceinline__ int count_of(int e) const { int cv = 0;
#pragma unroll
        for (int k = 0; k < NE; ++k) cv = (k == e) ? cnt[k] : cv;
        return cv; }
    __device__ __forceinline__ unsigned arow(const Unit& u, int lr) const {
        if (!gather) return (unsigned)(u.pm * BM + lr);
        const int l = u.r0 + lr; const int cv = count_of(u.e);
        unsigned t = 0u; if (l < cv) t = __hip_atomic_load((const GAS unsigned*)list_tok + (size_t)u.e * LIST_CAP + l, __ATOMIC_RELAXED, __HIP_MEMORY_SCOPE_AGENT) & 0xFFFFFu;
        return t;
    }
};

__device__ __forceinline__ unsigned cvt_pk_bf16(float lo, float hi) { unsigned r; asm volatile("v_cvt_pk_bf16_f32 %0, %1, %2" : "=v"(r) : "v"(lo), "v"(hi)); return r; }

struct EpiQKV {
    static constexpr bool PERM = true;
    bf16_t* O; int ldc; int split_cols; size_t split_stride; float scale0;
    __device__ __forceinline__ void operator()(const f32x4 (&acc)[2][2][4][2], const Unit& u, int wr, int wc, int fr, int fq) const {
        const int row0 = u.pm * BM + wr * 64 + fr; int colt = u.pn * BM; bf16_t* base = O;
        float sc = 1.f; { const int t = colt / split_cols; base += (size_t)t * split_stride; colt -= t * split_cols; if (t == 0) sc = scale0; }
        const int col0 = colt + wc * 32 + 8 * fq;
#pragma unroll
        for (int ai = 0; ai < 2; ++ai)
#pragma unroll
            for (int m = 0; m < 4; ++m) { bf16_t* rowp = base + (size_t)(row0 + ai * HALF + m * 16) * ldc + col0;
#pragma unroll
                for (int bj = 0; bj < 2; ++bj) { f32x4 v0 = acc[ai][bj][m][0] * sc, v1 = acc[ai][bj][m][1] * sc;
                    u32x4 w; w.x = cvt_pk_bf16(v0[0], v0[1]); w.y = cvt_pk_bf16(v0[2], v0[3]); w.z = cvt_pk_bf16(v1[0], v1[1]); w.w = cvt_pk_bf16(v1[2], v1[3]);
                    *(GAS u32x4*)(rowp + bj * HALF) = w;
                    } }
    }
};
__device__ __forceinline__ unsigned pk4_fp8(float a, float b, float c, float d) { unsigned w = 0; w = __builtin_amdgcn_cvt_pk_fp8_f32(a, b, w, false); w = __builtin_amdgcn_cvt_pk_fp8_f32(c, d, w, true); return w; }
template <bool F8OUT> struct EpiSwiGLU {
    static constexpr bool PERM = true;
    void* O; int ldc; float sc;
    __device__ __forceinline__ void operator()(const f32x4 (&acc)[2][2][4][2], const Unit& u, int wr, int wc, int fr, int fq) const {
        const int row0 = u.pm * BM + wr * 64 + fr; const int col0 = u.pn * HALF + wc * 32 + 8 * fq;
#pragma unroll
        for (int ai = 0; ai < 2; ++ai)
#pragma unroll
            for (int m = 0; m < 4; ++m) { float o[8];
#pragma unroll
                for (int n = 0; n < 2; ++n)
#pragma unroll
                    for (int j = 0; j < 4; ++j) { const float g = acc[ai][0][m][n][j] * sc, up = acc[ai][1][m][n][j] * sc;
                        const float s = __builtin_amdgcn_rcpf(1.0f + __builtin_amdgcn_exp2f(-1.4426950408889634f * g)); o[n * 4 + j] = g * s * up; }
                const size_t eo = (size_t)(row0 + ai * HALF + m * 16) * ldc + col0;
                if constexpr (F8OUT) { const unsigned long long w = (unsigned long long)pk4_fp8(o[0], o[1], o[2], o[3]) | ((unsigned long long)pk4_fp8(o[4], o[5], o[6], o[7]) << 32);
                    *(GAS unsigned long long*)((unsigned char*)O + eo) = w;
                } else { u32x4 w; w.x = cvt_pk_bf16(o[0], o[1]); w.y = cvt_pk_bf16(o[2], o[3]); w.z = cvt_pk_bf16(o[4], o[5]); w.w = cvt_pk_bf16(o[6], o[7]);
                    *(GAS u32x4*)((bf16_t*)O + eo) = w; } }
    }
};
struct EpiRes {
    static constexpr bool PERM = false;
    const float* res; float* out; int ldc; float sc;
    __device__ __forceinline__ void operator()(const f32x4 (&acc)[2][2][4][2], const Unit& u, int wr, int wc, int fr, int fq) const {
        const int row0 = u.pm * BM + wr * 64 + fr; const int col0 = u.pn * BM + wc * 32 + 4 * fq;
#pragma unroll
        for (int ai = 0; ai < 2; ++ai)
#pragma unroll
            for (int m = 0; m < 4; ++m) { const size_t off = (size_t)(row0 + ai * HALF + m * 16) * ldc + col0;
#pragma unroll
                for (int bj = 0; bj < 2; ++bj)
#pragma unroll
                    for (int n = 0; n < 2; ++n) { const f32x4 r = *(const GAS f32x4*)(res + off + bj * HALF + n * 16); *(GAS f32x4*)(out + off + bj * HALF + n * 16) = r + acc[ai][bj][m][n] * sc; } }
    }
};
struct EpiMoeDown {
    static constexpr bool PERM = false;
    float* h; bf16_t* y1; const unsigned* list_tok; const float* list_w; int cnt[NE]; float sc;
    __device__ __forceinline__ void operator()(const f32x4 (&acc)[2][2][4][2], const Unit& u, int wr, int wc, int fr, int fq) const {
        int cv = 0;
#pragma unroll
        for (int k = 0; k < NE; ++k) cv = (k == u.e) ? cnt[k] : cv;
        const int col0 = u.pn * BM + wc * 32 + 4 * fq;
#pragma unroll
        for (int ai = 0; ai < 2; ++ai)
#pragma unroll
            for (int m = 0; m < 4; ++m) { const int l = u.r0 + ai * HALF + wr * 64 + m * 16 + fr;
                if (l < cv) {
                    const unsigned ent = __hip_atomic_load((const GAS unsigned*)list_tok + (size_t)u.e * LIST_CAP + l, __ATOMIC_RELAXED, __HIP_MEMORY_SCOPE_AGENT);
                    const float w = sc * __uint_as_float(__hip_atomic_load((const GAS unsigned*)list_w + (size_t)u.e * LIST_CAP + l, __ATOMIC_RELAXED, __HIP_MEMORY_SCOPE_AGENT));
                    const size_t off = (size_t)(ent & 0xFFFFFu) * D + col0;
                    if ((ent >> 20) == 0u) {
#pragma unroll
                        for (int bj = 0; bj < 2; ++bj)
#pragma unroll
                            for (int n = 0; n < 2; ++n) { GAS float* p = (GAS float*)(h + off + bj * HALF + n * 16); const f32x4 r = *(const GAS f32x4*)p; *(GAS f32x4*)p = r + acc[ai][bj][m][n] * w; }
                    } else {
#pragma unroll
                        for (int bj = 0; bj < 2; ++bj)
#pragma unroll
                            for (int n = 0; n < 2; ++n) { const f32x4 v = acc[ai][bj][m][n] * w; unsigned long long pk = (unsigned long long)cvt_pk_bf16(v[0], v[1]) | ((unsigned long long)cvt_pk_bf16(v[2], v[3]) << 32);
                                *(GAS unsigned long long*)(y1 + off + bj * HALF + n * 16) = pk; }
                    }
                } }
    }
};

template <class Epi, class Sched, bool F8 = false>
__device__ __forceinline__ void gemm_phase(PG8_LAS unsigned char* lds, int xoff, const Gemm g, const Sched& S, const Epi& E) {
    int tid_ = threadIdx.x;
    asm volatile("" : "+v"(tid_));
    const int tid = tid_, wid = __builtin_amdgcn_readfirstlane(tid >> 6), lane = tid & 63, wr = wid >> 2, wc = wid & 3, fr = lane & 15, fq = lane >> 4;
    const int RB = g.rowb, nt = RB / 128;
    unsigned voffB[2];
#pragma unroll
    for (int i = 0; i < 2; ++i) { int R, C; stage_rc(tid * 16 + i * 8192, R, C); const int Rb = Epi::PERM ? ((R & ~31) + perm32(R & 31)) : R;
        voffB[i] = (unsigned)(Rb * RB + C * 2); }
    const size_t kstep = (size_t)(BK * 2);
    const size_t hstep = (size_t)HALF * RB;
    const size_t tstep = 2 * hstep;
    const unsigned ldsw = (unsigned)wid * 1024u;
    const int aoff = F8 ? lds_byte(wr * 64 + fr, fq * 16) : lds_byte(wr * 64 + fr, fq * 8), boff = F8 ? lds_byte(wc * 32 + fr, fq * 16) : lds_byte(wc * 32 + fr, fq * 8);
#define PG8_SA(b, h) (((b) * 2 + (h)) * HTB)
#define PG8_SB(b, h) ((4 + (b) * 2 + (h)) * HTB)
#define PG8_STAGE(bufoff, gbase, v0, v1) do { \
        __builtin_amdgcn_global_load_lds((const GAS unsigned*)((const char*)(gbase) + (v0)), (PG8_LAS unsigned*)(lds + (bufoff) + ldsw), 16, 0, 0); \
        __builtin_amdgcn_global_load_lds((const GAS unsigned*)((const char*)(gbase) + (v1)), (PG8_LAS unsigned*)(lds + (bufoff) + ldsw + 8192), 16, 0, 0); } while (0)
#define PG8_STAGEB(bufoff, gbase) PG8_STAGE(bufoff, gbase, voffB[0], voffB[1])
#define PG8_LDA(dst, b, h) do { if constexpr (F8) { _Pragma("unroll") for (int m = 0; m < 4; ++m) { dst##8[m].lo = *(const PG8_LAS i32x4*)(lds + PG8_SA(b, h) + aoff + m * 2048); dst##8[m].hi = *(const PG8_LAS i32x4*)(lds + PG8_SA(b, h) + aoff + m * 2048 + 16); } } \
        else { _Pragma("unroll") for (int m = 0; m < 4; ++m) _Pragma("unroll") for (int k = 0; k < 2; ++k) dst[m][k] = *(const PG8_LAS bf16x8*)(lds + PG8_SA(b, h) + aoff + m * 2048 + k * 1024); } } while (0)
#define PG8_LDB(dst, b, h) do { if constexpr (F8) { _Pragma("unroll") for (int n = 0; n < 2; ++n) { dst##8[n].lo = *(const PG8_LAS i32x4*)(lds + PG8_SB(b, h) + boff + n * 2048); dst##8[n].hi = *(const PG8_LAS i32x4*)(lds + PG8_SB(b, h) + boff + n * 2048 + 16); } } \
        else { _Pragma("unroll") for (int n = 0; n < 2; ++n) _Pragma("unroll") for (int k = 0; k < 2; ++k) dst[n][k] = *(const PG8_LAS bf16x8*)(lds + PG8_SB(b, h) + boff + n * 2048 + k * 1024); } } while (0)
#define PG8_MMA(ai, bj, At, Bt) do { __builtin_amdgcn_s_setprio(1); _Pragma("unroll") for (int m = 0; m < 4; ++m) _Pragma("unroll") for (int n = 0; n < 2; ++n) { \
        if constexpr (F8) acc[ai][bj][m][n] = __builtin_amdgcn_mfma_scale_f32_16x16x128_f8f6f4(Bt##8[n], At##8[m], acc[ai][bj][m][n], 0, 0, 0, 0x7F7F7F7F, 0, 0x7F7F7F7F); \
        else { _Pragma("unroll") for (int k = 0; k < 2; ++k) acc[ai][bj][m][n] = __builtin_amdgcn_mfma_f32_16x16x32_bf16(Bt[n][k], At[m][k], acc[ai][bj][m][n], 0, 0, 0); } } __builtin_amdgcn_s_setprio(0); } while (0)
#define PG8_WAIT_V(n) asm volatile("s_waitcnt vmcnt(" #n ")" ::: "memory")
#define PG8_WAIT_L(n) asm volatile("s_waitcnt lgkmcnt(" #n ")" ::: "memory")
#define PG8_BAR __builtin_amdgcn_s_barrier()
#define PG8_SCHED __builtin_amdgcn_sched_barrier(0)
#define PG8_AOFFS(U, o00, o01, o10, o11) do { int R0_, C0_, R1_, C1_; stage_rc(tid * 16, R0_, C0_); stage_rc(tid * 16 + 8192, R1_, C1_);     \
        o00 = S.arow(U, R0_) * (unsigned)RB + (unsigned)C0_ * 2u; o01 = S.arow(U, R1_) * (unsigned)RB + (unsigned)C1_ * 2u; \
        o10 = S.arow(U, HALF + R0_) * (unsigned)RB + (unsigned)C0_ * 2u; o11 = S.arow(U, HALF + R1_) * (unsigned)RB + (unsigned)C1_ * 2u; } while (0)
    Unit cur, nxt; int ui = 0;
    if (!S.next(0, cur)) return;
    f32x4 acc[2][2][4][2];
#pragma unroll
    for (int a = 0; a < 2; ++a)
#pragma unroll
        for (int b = 0; b < 2; ++b)
#pragma unroll
            for (int m = 0; m < 4; ++m)
#pragma unroll
                for (int n = 0; n < 2; ++n) acc[a][b][m][n] = (f32x4){0.f, 0.f, 0.f, 0.f};
    bf16x8 At[4][2], B0[2][2], B1[2][2];
    i32x8 At8[4], B08[2], B18[2];
    unsigned c00, c01, c10, c11;
    PG8_LAS u32x4* const xslot = (PG8_LAS u32x4*)(lds + xoff) + tid;
    PG8_AOFFS(cur, c00, c01, c10, c11);
    const char* const gA = (const char*)g.A;
    const char* cB = (const char*)g.Bt + (size_t)cur.e * g.bstride + (size_t)cur.pn * tstep;
    PG8_STAGEB(PG8_SB(0, 0), cB); PG8_STAGEB(PG8_SB(0, 1), cB + hstep); PG8_STAGE(PG8_SA(0, 0), gA, c00, c01); PG8_STAGE(PG8_SA(0, 1), gA, c10, c11);
    if (wr == 1) PG8_BAR;
    PG8_WAIT_V(2); PG8_BAR;
    PG8_STAGEB(PG8_SB(1, 0), cB + kstep); PG8_STAGE(PG8_SA(1, 0), gA + kstep, c00, c01); PG8_STAGEB(PG8_SB(1, 1), cB + hstep + kstep);
    PG8_WAIT_V(6); PG8_BAR;
    for (;;) {
        const bool has_next = S.next(ui + 1, nxt);
        const char* nB_ = has_next ? (const char*)g.Bt + (size_t)nxt.e * g.bstride + (size_t)nxt.pn * tstep : cB;
        const char* nB = nB_;
        if (has_next) { unsigned n00, n01, n10, n11; PG8_AOFFS(nxt, n00, n01, n10, n11); *xslot = (u32x4){n00, n01, n10, n11}; }
#pragma unroll 1
        for (int t = 0; t < nt; t += 2) {
            const bool last = (t == nt - 2);
            const char* a1 = gA + (size_t)(t + 1) * kstep;
            const char* a2 = last ? gA : gA + (size_t)(t + 2) * kstep; const char* b2 = last ? nB : cB + (size_t)(t + 2) * kstep;
            const char* a3 = a2 + kstep; const char* b3 = b2 + kstep;
            PG8_LDB(B0, 0, 0); PG8_LDB(B1, 0, 1); PG8_SCHED; PG8_LDA(At, 0, 0); PG8_STAGE(PG8_SA(1, 1), a1, c10, c11);
            if (last && has_next) { const u32x4 nx = *xslot; c00 = nx.x; c01 = nx.y; c10 = nx.z; c11 = nx.w; }
            PG8_WAIT_V(8); PG8_WAIT_L(0); PG8_BAR; PG8_MMA(0, 0, At, B0); PG8_MMA(0, 1, At, B1); PG8_BAR; PG8_SCHED;
            PG8_LDA(At, 0, 1); PG8_STAGEB(PG8_SB(0, 0), b2); PG8_STAGEB(PG8_SB(0, 1), b2 + hstep); PG8_STAGE(PG8_SA(0, 0), a2, c00, c01);
            PG8_WAIT_V(8); PG8_WAIT_L(0); PG8_BAR; PG8_MMA(1, 0, At, B0); PG8_MMA(1, 1, At, B1); PG8_BAR; PG8_SCHED;
            PG8_LDB(B0, 1, 0); PG8_LDB(B1, 1, 1); PG8_SCHED; PG8_LDA(At, 1, 0); PG8_STAGE(PG8_SA(0, 1), a2, c10, c11);
            PG8_WAIT_V(8); PG8_WAIT_L(0); PG8_BAR; PG8_MMA(0, 0, At, B0); PG8_MMA(0, 1, At, B1); PG8_BAR; PG8_SCHED;
            PG8_LDA(At, 1, 1); PG8_STAGEB(PG8_SB(1, 0), b3); PG8_STAGEB(PG8_SB(1, 1), b3 + hstep); PG8_STAGE(PG8_SA(1, 0), a3, c00, c01);
            PG8_WAIT_V(8); PG8_WAIT_L(0); PG8_BAR; PG8_MMA(1, 0, At, B0); PG8_MMA(1, 1, At, B1); PG8_BAR; PG8_SCHED;
        }
        if (wr == 0) PG8_BAR;
        E(acc, cur, wr, wc, fr, fq);
        if (!has_next) break;
#pragma unroll
        for (int a = 0; a < 2; ++a)
#pragma unroll
            for (int b = 0; b < 2; ++b)
#pragma unroll
                for (int m = 0; m < 4; ++m)
#pragma unroll
                    for (int n = 0; n < 2; ++n) acc[a][b][m][n] = (f32x4){0.f, 0.f, 0.f, 0.f};
        cur = nxt; cB = nB; ++ui;
        if (wr == 1) PG8_BAR;
    }
    PG8_WAIT_V(0);
    PG8_BAR;
#undef PG8_SA
#undef PG8_SB
#undef PG8_STAGE
#undef PG8_STAGEB
#undef PG8_LDA
#undef PG8_LDB
#undef PG8_MMA
#undef PG8_WAIT_V
#undef PG8_WAIT_L
#undef PG8_BAR
#undef PG8_SCHED
#undef PG8_AOFFS
}
}

namespace att {
typedef unsigned short bf16_t;
typedef short bf16x8 __attribute__((ext_vector_type(8)));
typedef short s16x4 __attribute__((ext_vector_type(4)));
typedef float f32x16 __attribute__((ext_vector_type(16)));
typedef float f32x4 __attribute__((ext_vector_type(4)));
typedef unsigned u32x4 __attribute__((ext_vector_type(4)));
constexpr int PITCH = 1024;
constexpr float LOG2E = 1.4426950408889634f;
__device__ __forceinline__ int crow(int r, int hi) { return (r & 3) + 8 * (r >> 2) + 4 * hi; }
typedef float f32x2_t __attribute__((ext_vector_type(2))); typedef __bf16 bf16x2_t __attribute__((ext_vector_type(2)));
__device__ __forceinline__ unsigned cvtpk(float lo, float hi) { f32x2_t v = {lo, hi}; bf16x2_t b = __builtin_convertvector(v, bf16x2_t); return __builtin_bit_cast(unsigned, b); }
__device__ __forceinline__ float bf2f(short s) { return __uint_as_float(((unsigned)(unsigned short)s) << 16); }
typedef short v4i16_t __attribute__((ext_vector_type(4)));
__device__ __forceinline__ s16x4 vtr(const LAS unsigned char* p) { return __builtin_bit_cast(s16x4, __builtin_amdgcn_ds_read_tr16_b64_v4i16((LAS v4i16_t*)p)); }
__device__ __forceinline__ float max3f(float a, float b, float c) { float r; asm("v_max3_f32 %0, %1, %2, %3" : "=v"(r) : "v"(a), "v"(b), "v"(c)); return r; }
__device__ __forceinline__ float halves_max(float m) { auto rr = __builtin_amdgcn_permlane32_swap(__float_as_uint(m), __float_as_uint(m), false, false); return fmaxf(__uint_as_float(rr[0]), __uint_as_float(rr[1])); }
__device__ __forceinline__ float halves_sum(float m) { auto rr = __builtin_amdgcn_permlane32_swap(__float_as_uint(m), __float_as_uint(m), false, false); return __uint_as_float(rr[0]) + __uint_as_float(rr[1]); }
#define ATT_BAR() asm volatile("s_waitcnt vmcnt(0) lgkmcnt(0)\n\ts_barrier" ::: "memory")

struct Args { const bf16_t* Q; const bf16_t* K; const bf16_t* V; bf16_t* O; const float* kmean; const float* kmax2; const float* subln; float lam_full; float out_scale; };

template <int MODE>
__device__ __forceinline__ void attn_unit(LAS unsigned char* lds, const Args& A, int b, int h, int qblk) {
    constexpr int DVB = MODE == 0 ? 4 : 2;
    constexpr int NCH = MODE == 0 ? 16 : 8;
    constexpr int KBY = NCH * 1024, VBY = DVB * 4096, SLOT = KBY + VBY;
    constexpr int QR = MODE == 0 ? 128 : 256;
    constexpr int PPW = MODE == 0 ? 2 : 1;
    int tid_ = threadIdx.x; asm volatile("" : "+v"(tid_));
    const int tid = tid_, lane = tid & 63, r32 = lane & 31, hi = lane >> 5;
    const int wid = __builtin_amdgcn_readfirstlane(tid >> 6);
    const int comp = MODE == 0 ? (wid >> 2) : 0, wq = MODE == 0 ? (wid & 3) : wid;
    const int q0 = qblk * QR; const long rowbase = (long)b * SEQ;
    const int hcol = MODE == 0 ? h * 128 : h * 64;
    const int qrel0 = wq * 32;
    const float slope2 = __builtin_amdgcn_exp2f(MODE == 0 ? -(float)(h + 1) : -0.5f * (float)(h + 1)) * LOG2E;
    const int NT = MODE == 0 ? 2 * qblk + 2 : 4 + 4 * qblk;
#define ATT_KBASE_(t) (MODE == 0 ? 64 * (t) : ((t) < 4 ? q0 + 64 * (t) : 64 * ((t) - 4)))
    LAS float* wsf = (LAS float*)(lds + 65536) + wid * 64;
    const bf16_t* Kb = A.K + rowbase * PITCH + hcol;
    const bf16_t* Vb = A.V + rowbase * PITCH + hcol;
    bf16x8 qr[4];
    { const bf16_t* Qw = A.Q + (rowbase + q0 + qrel0 + r32) * PITCH + hcol + comp * 64 + hi * 8;
#pragma unroll
      for (int d0 = 0; d0 < 4; ++d0) qr[d0] = *(const GAS bf16x8*)(Qw + d0 * 16); }
    ATT_BAR();
    LAS int* live = (LAS int*)(lds + 71680); LAS float* qnx = (LAS float*)(lds + 71680 + 272);
    { float q2 = 0.f;
#pragma unroll
      for (int d0 = 0; d0 < 4; ++d0)
#pragma unroll
        for (int j = 0; j < 8; ++j) { const float v = bf2f(qr[d0][j]); q2 += v * v; }
      q2 = halves_sum(q2);
      q2 = fmaxf(q2, __shfl_xor(q2, 1)); q2 = fmaxf(q2, __shfl_xor(q2, 2)); q2 = fmaxf(q2, __shfl_xor(q2, 4)); q2 = fmaxf(q2, __shfl_xor(q2, 8)); q2 = fmaxf(q2, __shfl_xor(q2, 16));
      if (lane == 0) qnx[wid] = q2; }
    ATT_BAR();
    if (wid == 0) {
        const int tt = lane;
        const int kbase_t = (tt < NT) ? ATT_KBASE_(tt) : 0;
        bool alive = tt < NT;
        if (alive && kbase_t + 64 <= q0) {
            const int nblk = kbase_t >> 8; float bound = -INFINITY;
            if constexpr (MODE == 0) {
#pragma unroll
                for (int c = 0; c < 2; ++c) { float qm = fmaxf(fmaxf(qnx[4 * c], qnx[4 * c + 1]), fmaxf(qnx[4 * c + 2], qnx[4 * c + 3]));
                    const float k2 = ((const GAS float*)A.kmax2)[(size_t)(b * 16 + h * 2 + c) * 16 + nblk]; bound = fmaxf(bound, sqrtf(qm) * sqrtf(k2)); }
            } else {
                float qm = qnx[0];
#pragma unroll
                for (int w = 1; w < 8; ++w) qm = fmaxf(qm, qnx[w]);
                const float k2 = ((const GAS float*)A.kmax2)[(size_t)(b * 16 + h) * 16 + nblk]; bound = sqrtf(qm) * sqrtf(k2);
            }
            alive = !(bound * 1.001f + 1.0f + slope2 * (float)(kbase_t + 63 - q0) < -152.0f);
        }
        const unsigned long long am = __ballot(alive);
        if (alive) live[__popcll(am & ((1ull << lane) - 1ull))] = tt;
        if (lane == 0) live[64] = __popcll(am);
    }
    ATT_BAR();
    const int NTL = __builtin_amdgcn_readfirstlane(live[64]);
    unsigned sel = 0u;
    if constexpr (MODE == 1) {
        LAS float* km = (LAS float*)(lds + 67584);
        for (int i = tid; i < 1024; i += 512) km[i] = ((const GAS float*)A.kmean)[(size_t)(b * 16 + h) * 1024 + i];
        ATT_BAR();
        float g[16];
#pragma unroll
        for (int n = 0; n < 16; ++n) { float s = 0.f;
            if (n < qblk) {
#pragma unroll
                for (int d0 = 0; d0 < 4; ++d0) { const f32x4 ka = *(const LAS f32x4*)(km + n * 64 + d0 * 16 + hi * 8), kb2 = *(const LAS f32x4*)(km + n * 64 + d0 * 16 + hi * 8 + 4);
                    s += bf2f(qr[d0][0]) * ka[0] + bf2f(qr[d0][1]) * ka[1] + bf2f(qr[d0][2]) * ka[2] + bf2f(qr[d0][3]) * ka[3]
                       + bf2f(qr[d0][4]) * kb2[0] + bf2f(qr[d0][5]) * kb2[1] + bf2f(qr[d0][6]) * kb2[2] + bf2f(qr[d0][7]) * kb2[3]; }
                s = halves_sum(s); }
            g[n] = s; }
        const int nsel = qblk < 3 ? qblk : 3;
#pragma unroll
        for (int k = 0; k < 3; ++k) if (k < nsel) { float best = -INFINITY; int bi = 0; bool found = false;
#pragma unroll
            for (int n = 0; n < 16; ++n) if (n < qblk) { const bool free_ = ((sel >> n) & 1u) == 0u; if (free_ && (!found || g[n] > best)) { best = g[n]; bi = n; found = true; } }
            sel |= 1u << bi; }
    }
#define ATT_KBASE(t) ATT_KBASE_(t)
#define ATT_ISSUE(t, slot) do { const int kb_ = ATT_KBASE(t); \
        _Pragma("unroll") for (int i_ = 0; i_ < PPW; ++i_) { const int p_ = wid + 8 * i_; \
            __builtin_amdgcn_global_load_lds((const GAS unsigned*)(Kb + (size_t)(kb_ + lane) * PITCH + p_ * 8), (LAS unsigned*)(lds + (slot) * SLOT + p_ * 1024), 16, 0, 0); \
            __builtin_amdgcn_global_load_lds((const GAS unsigned*)(Vb + (size_t)(kb_ + 16 * (p_ & 3) + (lane >> 2)) * PITCH + (p_ >> 2) * 32 + (lane & 3) * 8), (LAS unsigned*)(lds + (slot) * SLOT + KBY + p_ * 1024), 16, 0, 0); } } while (0)
    constexpr float THR = 8.0f;
    float mref = 0.f, l = 0.f; f32x16 o[DVB];
#pragma unroll
    for (int d0 = 0; d0 < DVB; ++d0) o[d0] = f32x16{};
#define ATT_ISSUE_K(tt, slot) do { const int kb_ = ATT_KBASE(tt); \
        _Pragma("unroll") for (int i_ = 0; i_ < PPW; ++i_) { const int p_ = wid + 8 * i_; \
            __builtin_amdgcn_global_load_lds((const GAS unsigned*)(Kb + (size_t)(kb_ + lane) * PITCH + p_ * 8), (LAS unsigned*)(lds + (slot) * SLOT + p_ * 1024), 16, 0, 0); } } while (0)
#define ATT_ISSUE_V(tt, slot) do { const int kb_ = ATT_KBASE(tt); \
        _Pragma("unroll") for (int i_ = 0; i_ < PPW; ++i_) { const int p_ = wid + 8 * i_; \
            __builtin_amdgcn_global_load_lds((const GAS unsigned*)(Vb + (size_t)(kb_ + 16 * (p_ & 3) + (lane >> 2)) * PITCH + (p_ >> 2) * 32 + (lane & 3) * 8), (LAS unsigned*)(lds + (slot) * SLOT + KBY + p_ * 1024), 16, 0, 0); } } while (0)
#define ATT_CLASS(tt, SK, NM, SB) do { const int kb_ = ATT_KBASE(tt), kr_ = kb_ - q0; const bool dg_ = kb_ >= q0; SK = dg_ && (kr_ > qrel0 + 31); NM = dg_ && (kr_ + 63 > qrel0); SB = true; \
        if constexpr (MODE == 1) { if ((tt) >= 4) { SB = ((sel >> (((tt) - 4) >> 2)) & 1u) != 0u; if (!__any(SB)) SK = true; } } } while (0)
#define ATT_QK(P0, P1, tt, slot, SB) do { const int kr_ = ATT_KBASE(tt) - q0; float off0_ = slope2 * (float)(kr_ + 4 * hi) - mref; if (!(SB)) off0_ = -INFINITY; const float off1_ = off0_ + 32.0f * slope2; \
        _Pragma("unroll") for (int r = 0; r < 16; ++r) { const float cbr = slope2 * (float)((r & 3) + 8 * (r >> 2)); P0[r] = cbr + off0_; P1[r] = cbr + off1_; } \
        const LAS unsigned char* Ks_ = lds + (slot) * SLOT + comp * 8192 + hi * 1024 + r32 * 16; \
        _Pragma("unroll") for (int d0 = 0; d0 < 4; ++d0) { const bf16x8 b0 = *(const LAS bf16x8*)(Ks_ + d0 * 2048), b1 = *(const LAS bf16x8*)(Ks_ + d0 * 2048 + 512); \
            P0 = __builtin_amdgcn_mfma_f32_32x32x16_bf16(b0, qr[d0], P0, 0, 0, 0); P1 = __builtin_amdgcn_mfma_f32_32x32x16_bf16(b1, qr[d0], P1, 0, 0, 0); } } while (0)
    f32x16 p0, p1, n0, n1;
    int t = __builtin_amdgcn_readfirstlane(live[0]);
    int tn = (NTL > 1) ? __builtin_amdgcn_readfirstlane(live[1]) : 0;
    bool skipC, maskC, selC, skipN = true, maskN = false, selN = true;
    ATT_ISSUE_K(t, 0); ATT_ISSUE_V(t, 0); if (NTL > 1) ATT_ISSUE_K(tn, 1);
    ATT_BAR();
    ATT_CLASS(t, skipC, maskC, selC);
    if (!skipC) ATT_QK(p0, p1, t, 0, selC);
    for (int it = 0; it < NTL; ++it) {
        ATT_BAR();
        const int tnn = (it + 2 < NTL) ? __builtin_amdgcn_readfirstlane(live[it + 2]) : 0;
        if (it + 2 < NTL) ATT_ISSUE_K(tnn, it & 1);
        if (it + 1 < NTL) { ATT_ISSUE_V(tn, (it + 1) & 1); ATT_CLASS(tn, skipN, maskN, selN); if (!skipN) ATT_QK(n0, n1, tn, (it + 1) & 1, selN); } else skipN = true;
        if (!skipC) {
            const int krel = ATT_KBASE(t) - q0;
            const LAS unsigned char* Vs = lds + (it & 1) * SLOT + KBY + ((lane >> 4) & 1) * 32 + (lane & 3) * 8 + (4 * hi + ((lane & 15) >> 2)) * 64;
            if (maskC) { const int qrel = qrel0 + r32;
#pragma unroll
                for (int r = 0; r < 16; ++r) { const int kv = krel + crow(r, hi); if (kv > qrel) p0[r] = -INFINITY; if (kv + 32 > qrel) p1[r] = -INFINITY; } }
            float rm;
            { float a_ = max3f(p0[0], p0[1], p1[0]), b_ = max3f(p0[2], p0[3], p1[1]); a_ = max3f(a_, p1[2], p1[3]);
#pragma unroll
              for (int r = 4; r < 16; r += 4) { a_ = max3f(a_, p0[r], p0[r + 1]); b_ = max3f(b_, p0[r + 2], p0[r + 3]); a_ = max3f(a_, p1[r], p1[r + 1]); b_ = max3f(b_, p1[r + 2], p1[r + 3]); }
              rm = halves_max(fmaxf(a_, b_)); }
            if (__any(rm > THR)) {
                const float dl = fmaxf(rm, 0.f); mref += dl; const float alpha = __builtin_amdgcn_exp2f(-dl);
#pragma unroll
                for (int r = 0; r < 16; ++r) { p0[r] -= dl; p1[r] -= dl; }
                if (!skipN) {
#pragma unroll
                    for (int r = 0; r < 16; ++r) { n0[r] -= dl; n1[r] -= dl; } }
                l *= alpha;
                if (hi == 0) wsf[r32] = alpha;
                asm volatile("s_waitcnt lgkmcnt(0)" ::: "memory");
#pragma unroll
                for (int gq = 0; gq < 4; ++gq) { const f32x4 f = *(const LAS f32x4*)(wsf + 8 * gq + 4 * hi);
#pragma unroll
                    for (int d0 = 0; d0 < DVB; ++d0) { o[d0][4 * gq + 0] *= f[0]; o[d0][4 * gq + 1] *= f[1]; o[d0][4 * gq + 2] *= f[2]; o[d0][4 * gq + 3] *= f[3]; } }
            }
            float sacc = 0.f;
#pragma unroll
            for (int r = 0; r < 16; ++r) { p0[r] = __builtin_amdgcn_exp2f(p0[r]); p1[r] = __builtin_amdgcn_exp2f(p1[r]); sacc += p0[r] + p1[r]; }
            l += sacc;
            u32x4 pw[4];
            pw[0] = (u32x4){cvtpk(p0[0], p0[1]), cvtpk(p0[2], p0[3]), cvtpk(p0[4], p0[5]), cvtpk(p0[6], p0[7])};
            pw[1] = (u32x4){cvtpk(p0[8], p0[9]), cvtpk(p0[10], p0[11]), cvtpk(p0[12], p0[13]), cvtpk(p0[14], p0[15])};
            pw[2] = (u32x4){cvtpk(p1[0], p1[1]), cvtpk(p1[2], p1[3]), cvtpk(p1[4], p1[5]), cvtpk(p1[6], p1[7])};
            pw[3] = (u32x4){cvtpk(p1[8], p1[9]), cvtpk(p1[10], p1[11]), cvtpk(p1[12], p1[13]), cvtpk(p1[14], p1[15])};
#pragma unroll
            for (int d0 = 0; d0 < DVB; ++d0)
#pragma unroll
                for (int ks = 0; ks < 4; ++ks) { const s16x4 vlo = vtr(Vs + d0 * 4096 + ks * 1024), vhi = vtr(Vs + d0 * 4096 + ks * 1024 + 512);
                    const bf16x8 vf = (bf16x8){vlo[0], vlo[1], vlo[2], vlo[3], vhi[0], vhi[1], vhi[2], vhi[3]};
                    o[d0] = __builtin_amdgcn_mfma_f32_32x32x16_bf16(__builtin_bit_cast(bf16x8, pw[ks]), vf, o[d0], 0, 0, 0); }
        }
        p0 = n0; p1 = n1; skipC = skipN; maskC = maskN; selC = selN; t = tn; tn = tnn;
    }
#undef ATT_ISSUE_K
#undef ATT_ISSUE_V
#undef ATT_CLASS
#undef ATT_QK
    l = halves_sum(l);
    if (hi == 0) wsf[32 + r32] = l;
    asm volatile("s_waitcnt lgkmcnt(0)" ::: "memory");
    float rli[16];
#pragma unroll
    for (int gq = 0; gq < 4; ++gq) { const f32x4 f = *(const LAS f32x4*)(wsf + 32 + 8 * gq + 4 * hi); rli[4 * gq + 0] = 1.0f / f[0]; rli[4 * gq + 1] = 1.0f / f[1]; rli[4 * gq + 2] = 1.0f / f[2]; rli[4 * gq + 3] = 1.0f / f[3]; }
    if constexpr (MODE == 1) {
        GAS bf16_t* Ow = (GAS bf16_t*)(A.O + (rowbase + q0 + qrel0) * PITCH + hcol);
#pragma unroll
        for (int r = 0; r < 16; ++r)
#pragma unroll
            for (int d0 = 0; d0 < DVB; ++d0) Ow[(size_t)crow(r, hi) * PITCH + d0 * 32 + r32] = (bf16_t)(cvtpk(o[d0][r] * rli[r], 0.f) & 0xFFFFu);
    } else {
        ATT_BAR();
        LAS float* X = (LAS float*)lds + wq * 4096;
        if (comp == 1) {
#pragma unroll
            for (int d0 = 0; d0 < DVB; ++d0)
#pragma unroll
                for (int r = 0; r < 16; ++r) X[(d0 * 16 + r) * 64 + lane] = o[d0][r] * rli[r];
        }
        ATT_BAR();
        if (comp == 0) {
            float sg[DVB];
#pragma unroll
            for (int d0 = 0; d0 < DVB; ++d0) sg[d0] = ((const GAS float*)A.subln)[d0 * 32 + r32] * A.out_scale;
            GAS bf16_t* Ow = (GAS bf16_t*)(A.O + (rowbase + q0 + qrel0) * PITCH + hcol);
#pragma unroll
            for (int r = 0; r < 16; ++r) { float dv[DVB]; float ss = 0.f;
#pragma unroll
                for (int d0 = 0; d0 < DVB; ++d0) { dv[d0] = o[d0][r] * rli[r] - A.lam_full * X[(d0 * 16 + r) * 64 + lane]; ss += dv[d0] * dv[d0]; }
                ss += __shfl_xor(ss, 1); ss += __shfl_xor(ss, 2); ss += __shfl_xor(ss, 4); ss += __shfl_xor(ss, 8); ss += __shfl_xor(ss, 16);
                const float rs = 1.0f / sqrtf(ss * (1.0f / 128.0f) + 1e-5f);
#pragma unroll
                for (int d0 = 0; d0 < DVB; ++d0) Ow[(size_t)crow(r, hi) * PITCH + d0 * 32 + r32] = (bf16_t)(cvtpk(dv[d0] * rs * sg[d0], 0.f) & 0xFFFFu); }
        }
    }
#undef ATT_KBASE
#undef ATT_KBASE_
#undef ATT_ISSUE
}
#undef ATT_BAR
}

constexpr int NWAVES = 8;
constexpr int NLAYER = 4, PH_PER_LAYER = 8, NPHASE = 1 + NLAYER * PH_PER_LAYER;

constexpr size_t MiB = 1u << 20;
constexpr size_t WS_CTL = 0, CTL_ZERO_BYTES = 1 * MiB;
constexpr size_t WS_KMEAN = 1 * MiB;
constexpr size_t WS_LTOK = 2 * MiB, WS_LW = 3 * MiB;
constexpr size_t WS_DQKV = 5 * MiB;
constexpr size_t WS_DWO = WS_DQKV + 12 * MiB;
constexpr size_t WS_MQKV = WS_DWO + 4 * MiB;
constexpr size_t WS_MWO = WS_MQKV + 12 * MiB;
constexpr size_t WS_FGU = WS_MWO + 4 * MiB;
constexpr size_t WS_FD = WS_FGU + 22 * MiB;
constexpr size_t WS_MGU = WS_FD + 11 * MiB;
constexpr size_t WS_MD = WS_MGU + 112 * MiB;
constexpr size_t WS_XN = WS_MD + 56 * MiB;
constexpr size_t WS_Q = WS_XN + 64 * MiB, WS_K = WS_Q + 64 * MiB, WS_V = WS_K + 64 * MiB;
constexpr size_t WS_ACT = WS_Q;
constexpr size_t WS_END = WS_ACT + (size_t)MOE_TILES_MAX * 256 * DE * 2;
static_assert(WS_XN == 238 * MiB && WS_END == 778 * MiB, "d_ws map");
constexpr int CW_BAR = 4096;
constexpr int CW_ATTQ = 6144;
constexpr int CW_CNT = 8192;

constexpr int RING_OFF = 0, RING_BYTES = 131072;
constexpr int LDSCTL_OFF = RING_BYTES, MISC_OFF = LDSCTL_OFF + 320;
constexpr int XSLOT_OFF = MISC_OFF + 128;
constexpr int LDS_BYTES = 147456;

typedef unsigned short bf16;
typedef unsigned v4u __attribute__((ext_vector_type(4)));
typedef float f32x4 __attribute__((ext_vector_type(4)));
typedef GAS unsigned gu32;
#define RLX_AGENT __ATOMIC_RELAXED, __HIP_MEMORY_SCOPE_AGENT
#define LDS_WAIT() asm volatile("s_waitcnt lgkmcnt(0)" ::: "memory")
#define VM_WAIT() asm volatile("s_waitcnt vmcnt(0)" ::: "memory")
__device__ __forceinline__ unsigned f2bf(float f) { unsigned u = __builtin_bit_cast(unsigned, f); return (u + 0x7fffu + ((u >> 16) & 1u)) >> 16; }
__device__ __forceinline__ unsigned pk2(float lo, float hi) { return f2bf(lo) | (f2bf(hi) << 16); }
__device__ __forceinline__ float bflo(unsigned w) { return __uint_as_float(w << 16); }
__device__ __forceinline__ float bfhi(unsigned w) { return __uint_as_float(w & 0xFFFF0000u); }
static_assert(XSLOT_OFF % 16 == 0 && XSLOT_OFF + 8192 <= LDS_BYTES, "LDS map");
#define XB_TMO      128
#define XB_XCNT(j)  (256  + 64 * (j))
#define XB_XSUB(j)  (1280 + 64 * (j))
#define XB_XGEN(j)  (2304 + 64 * (j))
#define XB_TOP      3328
#define XB_TOPGEN   3392
#define XCD_BAR_WORDS 3456
#define XB_SPIN_CAP (1u << 18)

__device__ __forceinline__ unsigned xb_ld(unsigned* p)              { return __hip_atomic_load(p, __ATOMIC_RELAXED, __HIP_MEMORY_SCOPE_AGENT); }
__device__ __forceinline__ unsigned xb_add(unsigned* p, unsigned v) { return __hip_atomic_fetch_add(p, v, __ATOMIC_RELAXED, __HIP_MEMORY_SCOPE_AGENT); }
__device__ __forceinline__ unsigned xb_xcc_id() { return (unsigned)__builtin_amdgcn_s_getreg((3 << 11) | 20) & 0xFu; }
#define XB_SPIN(cond, bar) do { unsigned _sp = 0; while (cond) { __builtin_amdgcn_s_sleep(1); \
    if ((++_sp & 255u) == 0u) { if (xb_ld(&(bar)[XB_TMO])) break; if (_sp > XB_SPIN_CAP) { atomicAdd(&(bar)[XB_TMO], 1u); break; } } } } while (0)

struct XcdBarrier {
    unsigned* bar; unsigned x;
    volatile LAS unsigned* st;
};

__device__ __forceinline__ XcdBarrier xcd_barrier_post(unsigned* bar, volatile LAS unsigned* st) {
    XcdBarrier b; b.bar = bar; b.x = xb_xcc_id(); b.st = st;
    if (threadIdx.x == 0) (void)xb_add(&bar[XB_XCNT(b.x)], 1u);
    return b;
}
__device__ __forceinline__ void xcd_barrier_complete(unsigned* bar, unsigned x, unsigned& nloc, unsigned& nx) {
    const unsigned G = gridDim.x * gridDim.y * gridDim.z;
    unsigned sum, cnt, mine, sp = 0u;
    for (;;) {
        sum = 0u; cnt = 0u; mine = 0u;
#pragma unroll
        for (unsigned j = 0; j < 16; ++j) { const unsigned c = xb_ld(&bar[XB_XCNT(j)]); sum += c; cnt += (c > 0u) ? 1u : 0u; mine = (j == x) ? c : mine; }
        if (sum == G) break;
        __builtin_amdgcn_s_sleep(1);
        if ((++sp & 255u) == 0u) { if (xb_ld(&bar[XB_TMO])) break; if (sp > XB_SPIN_CAP) { atomicAdd(&bar[XB_TMO], 1u); break; } }
    }
    nloc = mine > 0u ? mine : 1u; nx = cnt > 0u ? cnt : 1u;
}

__device__ __forceinline__ void xcd_barrier(const XcdBarrier& b) {
    asm volatile("s_waitcnt vmcnt(0)" ::: "memory");
    __syncthreads();
    if (threadIdx.x == 0) {
        unsigned* bar = b.bar;
        __builtin_amdgcn_s_waitcnt(0);
        unsigned nloc = b.st[0], nx = b.st[1];
        if (nloc == 0u) { xcd_barrier_complete(bar, b.x, nloc, nx); b.st[0] = nloc; b.st[1] = nx; }
        const unsigned old = xb_add(&bar[XB_XSUB(b.x)], 1u);
        const unsigned gen = old / nloc;
        if (old + 1u == (gen + 1u) * nloc) {
            __builtin_amdgcn_fence(__ATOMIC_RELEASE, "agent");
            asm volatile("s_waitcnt vmcnt(0)" ::: "memory");
            const unsigned og = xb_add(&bar[XB_TOP], 1u);
            const unsigned tg = og / nx;
            if (og + 1u == (tg + 1u) * nx) xb_add(&bar[XB_TOPGEN], 1u);
            else XB_SPIN(xb_ld(&bar[XB_TOPGEN]) == tg, bar);
            __builtin_amdgcn_fence(__ATOMIC_ACQUIRE, "agent");
            xb_add(&bar[XB_XGEN(b.x)], 1u);
            asm volatile("s_waitcnt vmcnt(0)" ::: "memory");
        } else {
            XB_SPIN(xb_ld(&bar[XB_XGEN(b.x)]) == gen, bar);
            __builtin_amdgcn_fence(__ATOMIC_ACQUIRE, "agent");
            asm volatile("s_waitcnt vmcnt(0)" ::: "memory");
        }
    }
    __syncthreads();
}

struct Frame {
    LAS unsigned char* lds;
    volatile LAS unsigned* MISC;
    gu32* ctl;
    int tid, lane, wave;
    int vcu, G;
};
__device__ __forceinline__ float wave_sum(float v) {
#pragma unroll
    for (int o = 1; o < 64; o <<= 1) v += __shfl_xor(v, o);
    return v;
}
__device__ __forceinline__ void transpose_item(const float* W, int K, int N, void* WT, int k0, int n0, int drow0, LAS float* scr, int lane, bool f8, float wscale) {
    const GAS float* src = (const GAS float*)W + (size_t)k0 * N + n0 + lane;
#pragma unroll
    for (int hb = 0; hb < 2; ++hb) { float v[32];
#pragma unroll
        for (int i = 0; i < 32; ++i) v[i] = src[(size_t)(hb * 32 + i) * N];
#pragma unroll
        for (int i = 0; i < 32; ++i) { const int kk = hb * 32 + i; scr[kk * 64 + (lane ^ ((kk >> 3) << 3))] = v[i]; } }
    LDS_WAIT(); asm volatile("" ::: "memory");
    if (f8) {
        const int c = lane & 3;
#pragma unroll
        for (int j = 0; j < 4; ++j) { const int nn = (lane >> 2) + 16 * j; float v[16];
#pragma unroll
            for (int q = 0; q < 16; ++q) { const int kk = 16 * c + q; v[q] = scr[kk * 64 + (nn ^ ((kk >> 3) << 3))] * wscale; }
            v4u o; o.x = pg8::pk4_fp8(v[0], v[1], v[2], v[3]); o.y = pg8::pk4_fp8(v[4], v[5], v[6], v[7]); o.z = pg8::pk4_fp8(v[8], v[9], v[10], v[11]); o.w = pg8::pk4_fp8(v[12], v[13], v[14], v[15]);
            *(GAS v4u*)((unsigned char*)WT + (size_t)(drow0 + nn) * K + k0 + 16 * c) = o; }
    } else {
    const int c = lane & 7;
#pragma unroll
    for (int j = 0; j < 8; ++j) { const int n = (lane >> 3) + 8 * j; const LAS float* s = scr + (8 * c) * 64 + (n ^ (c << 3));
        v4u o; o.x = pk2(s[0 * 64], s[1 * 64]); o.y = pk2(s[2 * 64], s[3 * 64]); o.z = pk2(s[4 * 64], s[5 * 64]); o.w = pk2(s[6 * 64], s[7 * 64]);
        *(GAS v4u*)((bf16*)WT + (size_t)(drow0 + n) * K + k0 + 8 * c) = o; }
    }
    LDS_WAIT(); asm volatile("" ::: "memory");
}
__device__ __forceinline__ void convert_matrix(Frame& F, const float* W, int K, int N, void* WT, int il, unsigned& rot, bool f8 = false, float wscale = 1.0f) {
    LAS float* scr = (LAS float*)(F.lds + RING_OFF + F.wave * 16384);
    const unsigned gw = (unsigned)(F.vcu * NWAVES + F.wave), NGW = (unsigned)(F.G * NWAVES);
    const int nblk = N / 64, nitems = (K / 64) * nblk; int lane_ = F.lane; asm volatile("" : "+v"(lane_));
    for (int it = (int)((gw + NGW - rot % NGW) % NGW); it < nitems; it += (int)NGW) {
        const int kb = it / nblk, nb = it % nblk, n0 = 64 * nb;
        const int drow0 = il == 0 ? n0 : (n0 / 128) * 256 + (il - 1) * 128 + (n0 % 128);
        transpose_item(W, K, N, WT, 64 * kb, n0, drow0, scr, lane_, f8, wscale);
    }
    rot = (rot + (unsigned)nitems) % NGW;
}

struct RouterArgs { const float* router; gu32* cnt; unsigned* ltok; float* lw; };
template <int MODE, bool F8X = false>
__device__ __forceinline__ void norm_phase(Frame& F, const float* src, float* hout, const bf16* y1, const float* gain, bf16* xn, float* fout, const RouterArgs& R) {
    int lane_ = F.lane; asm volatile("" : "+v"(lane_));
    const int gw = F.vcu * NWAVES + F.wave, NGW = F.G * NWAVES, lane = lane_;
    f32x4 gv[4];
#pragma unroll
    for (int j = 0; j < 4; ++j) gv[j] = *(const GAS f32x4*)(gain + 256 * j + 4 * lane);
    LAS float* RL = (LAS float*)(F.lds + RING_OFF);
    if constexpr (MODE == 2) {
        int tid_ = F.tid; asm volatile("" : "+v"(tid_));
        for (int i = tid_; i < 8192; i += NWAVES * 64) RL[(i & 7) * 1024 + (i >> 3)] = ((const GAS float*)R.router)[i];
        LDS_WAIT(); __syncthreads();
    }
    const int nrows_w = gw < MTOK ? (MTOK - gw + NGW - 1) / NGW : 0;
    for (int cb = 0; cb < nrows_w; cb += 64) {
        int my_t = 0, my_e0 = 0, my_e1 = 0; float my_w0 = 0.f, my_w1 = 0.f; bool valid = false;
        const int cn = (nrows_w - cb) < 64 ? (nrows_w - cb) : 64;
        f32x4 vn[4]; unsigned long long yn[4];
        { const int row0_ = gw + cb * NGW; const GAS f32x4* xr = (const GAS f32x4*)(src + (size_t)row0_ * D) + lane;
#pragma unroll
          for (int j = 0; j < 4; ++j) vn[j] = xr[64 * j];
          if constexpr (MODE == 1 || MODE == 3) { const GAS unsigned long long* yr = (const GAS unsigned long long*)(y1 + (size_t)row0_ * D) + lane;
#pragma unroll
            for (int j = 0; j < 4; ++j) yn[j] = yr[64 * j]; } }
        for (int i = 0; i < cn; ++i) {
            const int row = gw + (cb + i) * NGW;
            f32x4 v[4]; float s = 0.f;
#pragma unroll
            for (int j = 0; j < 4; ++j) v[j] = vn[j];
            if constexpr (MODE == 1 || MODE == 3) {
#pragma unroll
                for (int j = 0; j < 4; ++j) { const unsigned long long w = yn[j]; const unsigned lo = (unsigned)w, hi = (unsigned)(w >> 32);
                    v[j].x += bflo(lo); v[j].y += bfhi(lo); v[j].z += bflo(hi); v[j].w += bfhi(hi); }
            }
            if (i + 1 < cn) { const int rown = row + NGW; const GAS f32x4* xr = (const GAS f32x4*)(src + (size_t)rown * D) + lane;
#pragma unroll
                for (int j = 0; j < 4; ++j) vn[j] = xr[64 * j];
                if constexpr (MODE == 1 || MODE == 3) { const GAS unsigned long long* yr = (const GAS unsigned long long*)(y1 + (size_t)rown * D) + lane;
#pragma unroll
                    for (int j = 0; j < 4; ++j) yn[j] = yr[64 * j]; } }
#pragma unroll
            for (int j = 0; j < 4; ++j) s += (v[j].x * v[j].x + v[j].y * v[j].y) + (v[j].z * v[j].z + v[j].w * v[j].w);
            if constexpr (MODE == 1) { GAS f32x4* hr = (GAS f32x4*)(hout + (size_t)row * D) + lane;
#pragma unroll
                for (int j = 0; j < 4; ++j) hr[64 * j] = v[j]; }
            const float rstd = 1.f / sqrtf(wave_sum(s) * (1.f / D) + 1e-6f);
#pragma unroll
            for (int j = 0; j < 4; ++j) v[j] = v[j] * rstd * gv[j];
            if constexpr (MODE == 3) { GAS f32x4* orow = (GAS f32x4*)(fout + (size_t)row * D) + lane;
#pragma unroll
                for (int j = 0; j < 4; ++j) orow[64 * j] = v[j];
            } else {
                if constexpr (F8X) { GAS unsigned* o4 = (GAS unsigned*)((unsigned char*)xn + (size_t)row * D) + lane;
#pragma unroll
                    for (int j = 0; j < 4; ++j) o4[64 * j] = pg8::pk4_fp8(v[j].x, v[j].y, v[j].z, v[j].w);
                } else { GAS unsigned long long* o8 = (GAS unsigned long long*)(xn + (size_t)row * D) + lane;
#pragma unroll
                    for (int j = 0; j < 4; ++j) o8[64 * j] = (unsigned long long)pk2(v[j].x, v[j].y) | ((unsigned long long)pk2(v[j].z, v[j].w) << 32); }
            }
            if constexpr (MODE == 2) {
                float lg[NE];
#pragma unroll
                for (int e = 0; e < NE; ++e) { float a = 0.f;
#pragma unroll
                    for (int j = 0; j < 4; ++j) { const f32x4 rr = *(const LAS f32x4*)(RL + e * 1024 + 256 * j + 4 * lane); a += (v[j].x * rr.x + v[j].y * rr.y) + (v[j].z * rr.z + v[j].w * rr.w); }
                    lg[e] = wave_sum(a); }
                int e0 = 0; float v0 = lg[0];
#pragma unroll
                for (int e = 1; e < NE; ++e) if (lg[e] > v0) { v0 = lg[e]; e0 = e; }
                int e1 = -1; float v1 = 0.f;
#pragma unroll
                for (int e = 0; e < NE; ++e) if (e != e0 && (e1 < 0 || lg[e] > v1)) { v1 = lg[e]; e1 = e; }
                const float w0 = 1.f / (1.f + __expf(v1 - v0));
                if (lane == i) { my_t = row; my_e0 = e0; my_e1 = e1; my_w0 = w0; my_w1 = 1.f - w0; valid = true; }
            }
        }
        if constexpr (MODE == 2) {
            unsigned myc = 0u;
#pragma unroll
            for (int e = 0; e < NE; ++e) { const unsigned long long b0 = __ballot(valid && my_e0 == e), b1 = __ballot(valid && my_e1 == e);
                const unsigned c = (unsigned)(__popcll(b0) + __popcll(b1)); if (lane == e) myc = c; }
            unsigned basev = 0u;
            if (lane < NE) basev = __hip_atomic_fetch_add(R.cnt + 64 * lane, myc, RLX_AGENT);
            const unsigned long long lt = (1ull << lane) - 1ull;
            unsigned pos0 = 0u, pos1 = 0u;
#pragma unroll
            for (int e = 0; e < NE; ++e) { const unsigned long long b0 = __ballot(valid && my_e0 == e), b1 = __ballot(valid && my_e1 == e);
                const unsigned be = (unsigned)__shfl((int)basev, e);
                if (my_e0 == e) pos0 = be + (unsigned)__popcll(b0 & lt);
                if (my_e1 == e) pos1 = be + (unsigned)__popcll(b0) + (unsigned)__popcll(b1 & lt); }
            if (valid) {
                ((GAS unsigned*)R.ltok)[(size_t)my_e0 * LIST_CAP + pos0] = (unsigned)my_t;             ((GAS float*)R.lw)[(size_t)my_e0 * LIST_CAP + pos0] = my_w0;
                ((GAS unsigned*)R.ltok)[(size_t)my_e1 * LIST_CAP + pos1] = (unsigned)my_t | (1u << 20); ((GAS float*)R.lw)[(size_t)my_e1 * LIST_CAP + pos1] = my_w1;
            }
        }
    }
    if constexpr (MODE == 2) { LDS_WAIT(); __syncthreads(); }
}

__device__ __forceinline__ void kstat_phase(Frame& F, const bf16* Kt, float* kmean, float* kmax2) {
    int lane_ = F.lane; asm volatile("" : "+v"(lane_));
    const int gw = F.vcu * NWAVES + F.wave, NGW = F.G * NWAVES, lane = lane_;
    for (int task = gw; task < BATCH * 16 * 8; task += NGW) {
        const int c8 = task & 7, n = (task >> 3) & 15, b = task >> 7;
        const GAS unsigned* p = (const GAS unsigned*)(Kt + ((size_t)b * SEQ + 256 * n) * D + c8 * 128) + lane;
        float a0 = 0.f, a1 = 0.f, mx = 0.f;
#pragma unroll 32
        for (int r = 0; r < 256; ++r) { const unsigned w = p[(size_t)r * (D / 2)]; const float v0 = bflo(w), v1 = bfhi(w); a0 += v0; a1 += v1;
            float s = v0 * v0 + v1 * v1; s += __shfl_xor(s, 1); s += __shfl_xor(s, 2); s += __shfl_xor(s, 4); s += __shfl_xor(s, 8); s += __shfl_xor(s, 16); mx = fmaxf(mx, s); }
        const int col = c8 * 128 + 2 * lane, hh = col >> 6, d = col & 63;
        GAS float* o = (GAS float*)(kmean + ((size_t)(b * 16 + hh) * 16 + n) * 64 + d);
        o[0] = a0 * (1.f / 256.f); o[1] = a1 * (1.f / 256.f);
        if ((lane & 31) == 0) ((GAS float*)kmax2)[(size_t)(b * 16 + hh) * 16 + n] = mx;
    }
}

struct KArgs { const float* in[17]; float* out; unsigned char* ws; int ph_lo, ph_hi; };
struct ConvDesc { const float* W; int K, N; unsigned char* WT; int il; bool f8; float sc; };
constexpr int NCONV = 61, CONV_CH = 128;
__device__ __forceinline__ ConvDesc conv_desc(const KArgs& args, unsigned char* ws, int m) {
    constexpr float WSC_UP = 32.0f, WSC_DN = 64.0f;
    ConvDesc d; d.il = 0; d.f8 = false; d.sc = 1.0f;
    if (m < 2) { d.W = args.in[7] + (size_t)m * D * 3 * D; d.K = D; d.N = 3 * D; d.WT = ws + WS_MQKV + (size_t)m * 3 * D * D * 2; }
    else if (m < 4) { const int j = m - 2; d.W = args.in[8] + (size_t)j * D * D; d.K = D; d.N = D; d.WT = ws + WS_MWO + (size_t)j * D * D * 2; }
    else if (m == 4) { d.W = args.in[4]; d.K = D; d.N = D; d.WT = ws + WS_DWO; }
    else if (m == 5) { d.W = args.in[3] + (size_t)D * 3 * D; d.K = D; d.N = 3 * D; d.WT = ws + WS_DQKV + (size_t)3 * D * D * 2; }
    else if (m == 6) { d.W = args.in[4] + (size_t)D * D; d.K = D; d.N = D; d.WT = ws + WS_DWO + (size_t)D * D * 2; }
    else if (m < 13) { const int r = m - 7, j = r / 3, t = r % 3; d.f8 = (j == 1);
        if (t < 2) { d.W = args.in[9 + t] + (size_t)j * D * DFF; d.K = D; d.N = DFF; d.WT = ws + WS_FGU + (size_t)j * 2 * DFF * D * 2; d.il = 1 + t; d.sc = d.f8 ? WSC_UP : 1.0f; }
        else { d.W = args.in[11] + (size_t)j * DFF * D; d.K = DFF; d.N = D; d.WT = ws + WS_FD + (size_t)j * D * DFF * 2; d.sc = d.f8 ? WSC_DN : 1.0f; } }
    else { const int r = m - 13, e = r / 3, t = r % 3; d.f8 = true;
        if (t < 2) { d.W = args.in[13 + t] + (size_t)e * D * DE; d.K = D; d.N = DE; d.WT = ws + WS_MGU + (size_t)e * 2 * DE * D; d.il = 1 + t; d.sc = WSC_UP; }
        else { d.W = args.in[15] + (size_t)e * DE * D; d.K = DE; d.N = D; d.WT = ws + WS_MD + (size_t)e * D * DE; d.sc = WSC_DN; } }
    return d;
}
__device__ __forceinline__ int conv_chunks_of(int m) { const int items = m < 2 || m == 5 ? 768 : (m < 7 ? 256 : (m < 13 ? 704 : 896)); return (items + CONV_CH - 1) / CONV_CH; }
__device__ __forceinline__ int conv_total_chunks() { int s = 0; for (int m = 0; m < NCONV; ++m) s += conv_chunks_of(m); return s; }
__device__ __forceinline__ void conv_chunk(Frame& F, const KArgs& args, unsigned char* ws, int c) {
    int m = 0; for (; m < NCONV; ++m) { const int n = conv_chunks_of(m); if (c < n) break; c -= n; }
    const ConvDesc d = conv_desc(args, ws, m);
    LAS float* scr = (LAS float*)(F.lds + RING_OFF + F.wave * 16384);
    int lane_ = F.lane; asm volatile("" : "+v"(lane_));
    const int nblk = d.N / 64, nitems = (d.K / 64) * nblk, last = (c + 1) * CONV_CH < nitems ? (c + 1) * CONV_CH : nitems;
    for (int it = c * CONV_CH + F.wave; it < last; it += NWAVES) {
        const int kb = it / nblk, nb = it % nblk, n0 = 64 * nb;
        const int drow0 = d.il == 0 ? n0 : (n0 / 128) * 256 + (d.il - 1) * 128 + (n0 % 128);
        transpose_item(d.W, d.K, d.N, d.WT, 64 * kb, n0, drow0, scr, lane_, d.f8, d.sc);
    }
}

__global__ void __launch_bounds__(NWAVES * 64, 2) trunk_fwd(KArgs args) {
    extern __shared__ __attribute__((aligned(16))) unsigned char lds[];
    Frame F;
    F.lds = (LAS unsigned char*)lds;
    F.MISC = (volatile LAS unsigned*)(F.lds + MISC_OFF);
    F.tid = threadIdx.x; F.lane = F.tid & 63; F.wave = __builtin_amdgcn_readfirstlane(F.tid >> 6);
    F.G = gridDim.x; { const int bx = blockIdx.x; F.vcu = (F.G % 8 == 0) ? (bx % 8) * (F.G / 8) + bx / 8 : bx; }
    F.ctl = (gu32*)(args.ws + WS_CTL);
    for (int u = F.tid; u < (LDS_BYTES - LDSCTL_OFF) / 4; u += NWAVES * 64) ((LAS unsigned*)(F.lds + LDSCTL_OFF))[u] = 0u;
    __syncthreads();
    Frame& F0 = F;
    const int lo = args.ph_lo, hi = args.ph_hi;
    XcdBarrier bar; bar.bar = (unsigned*)(F.ctl + CW_BAR); bar.x = 0; bar.st = nullptr;
    if (hi - lo > 1) bar = xcd_barrier_post((unsigned*)(F.ctl + CW_BAR), F.MISC + 8);
#define IN(k) (lo <= (k) && (k) < hi)
#ifndef PH_ENABLE
#define PH_ENABLE 0xFFFFFFFFu
#endif
#define PHEN(n) (((PH_ENABLE) >> (n)) & 1u)
#ifndef MK_DOUBLE
#define MK_DOUBLE 0u
#endif
#define NREP(n) ((((MK_DOUBLE) >> (n)) & 1u) ? 2 : 1)
#if defined(NO_OPQ)
#define OPQ(p) do {} while (0)
#else
#define OPQ(p) asm volatile("" : "+s"(p))
#endif
#if 0
#define STAMP(k) do { if (blockIdx.x == 0 && threadIdx.x == 0) { const unsigned long long t_ = __builtin_amdgcn_s_memrealtime(); ((GAS unsigned*)(F0.ctl))[3000 + (k)] = (unsigned)t_; } } while (0)
#else
#define STAMP(k) do {} while (0)
#endif
#define SEAM(k) do { if (IN(k) && IN((k) + 1)) { XcdBarrier b2_ = bar; OPQ(b2_.bar); xcd_barrier(b2_); } STAMP((k) + 1); } while (0)

#define PTRS() unsigned char* ws = args.ws; OPQ(ws); const float* x = args.in[0]; OPQ(x); const float* norm_mix = args.in[1]; OPQ(norm_mix); const float* norm_ffn = args.in[2]; OPQ(norm_ffn); \
    float* h = args.out; OPQ(h); \
    bf16* XN = (bf16*)(ws + WS_XN); bf16* Qb = (bf16*)(ws + WS_Q); bf16* Kb = (bf16*)(ws + WS_K); bf16* Vb = (bf16*)(ws + WS_V); bf16* ACT = (bf16*)(ws + WS_ACT); \
    bf16* MGU = (bf16*)(ws + WS_MGU); bf16* MD = (bf16*)(ws + WS_MD); \
    float* kmean = (float*)(ws + WS_KMEAN); unsigned* ltok = (unsigned*)(ws + WS_LTOK); float* lw = (float*)(ws + WS_LW); \
    (void)x; (void)norm_mix; (void)norm_ffn; (void)h; (void)XN; (void)Qb; (void)Kb; (void)Vb; (void)ACT; (void)MGU; (void)MD; (void)kmean; (void)ltok; (void)lw
    const RouterArgs noR{nullptr, nullptr, nullptr, nullptr};
#ifndef MK_F8_DENSE
#define MK_F8_DENSE 0
#endif
    constexpr bool F8_DENSE = MK_F8_DENSE != 0; constexpr int DESZ = F8_DENSE ? 1 : 2;
    constexpr float WSC_UP = 32.0f, WSC_DN = 64.0f;
    constexpr float C2 = 0.125f * 1.4426950408889634f;

    STAMP(0);
    if (PHEN(0) && IN(0)) {
        PTRS();
        { unsigned rot = 0u;
        convert_matrix(F, args.in[3], D, 3 * D, ws + WS_DQKV, 0, rot);
        norm_phase<0>(F, x, nullptr, nullptr, norm_mix, XN, nullptr, noR);
        }
    }
    SEAM(0);

    for (int L = 0; L < NLAYER; ++L) {
        const int j = L >> 1, moba = L & 1, pb = 1 + PH_PER_LAYER * L;
        int z_ = 0;
#if !defined(NO_OPQ_Z)
        asm volatile("" : "+s"(z_));
#endif
        Frame Fl = F0; Fl.G += z_; Fl.vcu += z_; Fl.wave += z_; Fl.lds += z_; Fl.ctl += z_; const int bx = (int)blockIdx.x + z_;
#define F Fl
        if (PHEN(1) && IN(pb + 0)) {
            PTRS();

            const bf16* W = (const bf16*)(ws + (moba ? WS_MQKV : WS_DQKV)) + (size_t)j * 3 * D * D;
            pg8::Gemm g{XN, W, 2 * D, 0}; pg8::StaticOrder S; S.init(MTOK, 3 * D, F.G, bx);
            pg8::EpiQKV E{Qb, D, D, (size_t)(WS_K - WS_Q) / 2, C2};
            for (int rep_ = 0; rep_ < NREP(1); ++rep_) pg8::gemm_phase<pg8::EpiQKV, pg8::StaticOrder>(F.lds + RING_OFF, XSLOT_OFF, g, S, E);
        }
        SEAM(pb + 0);
        { if (PHEN(2) && IN(pb + 1)) { PTRS(); kstat_phase(F, Kb, kmean, kmean + 8 * 16 * 16 * 64); } SEAM(pb + 1); }
        if (IN(pb + 2)) {
            PTRS();
            att::Args A; A.Q = Qb; A.K = Kb; A.V = Vb; A.O = XN; A.kmean = kmean; A.kmax2 = kmean + 8 * 16 * 16 * 64; A.subln = args.in[6] + (size_t)j * 128; A.lam_full = 0.f; A.out_scale = 1.f;
            gu32* qctr = F.ctl + CW_ATTQ + 64 * L; LAS int* qw = (LAS int*)(F.lds + RING_OFF + 71680 + 260);
            if (!moba) {
                const float* lam = args.in[5] + (size_t)j * 256; int lane = F.lane; asm volatile("" : "+v"(lane));
                const GAS float* lamg = (const GAS float*)lam; const float s1 = wave_sum(lamg[lane] * lamg[64 + lane]), s2 = wave_sum(lamg[128 + lane] * lamg[192 + lane]);
                const float lam_init = (L == 0) ? 0.2f : 0.47071302f;
                A.lam_full = __uint_as_float(__builtin_amdgcn_readfirstlane(__float_as_uint(__expf(s1) - __expf(s2) + lam_init))); A.out_scale = __uint_as_float(__builtin_amdgcn_readfirstlane(__float_as_uint(1.0f - lam_init)));
            }
            const int nconv = (L == 0) ? conv_total_chunks() : 0;
            qw = (LAS int*)(F.lds + XSLOT_OFF);
            if ((PHEN(3) && !moba) || (PHEN(4) && moba)) for (;;) {
                if (F.tid == 0) *qw = (int)__hip_atomic_fetch_add(qctr, 1u, RLX_AGENT);
                asm volatile("s_waitcnt vmcnt(0) lgkmcnt(0)\n\ts_barrier" ::: "memory");
                int idx = __builtin_amdgcn_readfirstlane(*qw);
                if (idx >= 1024 + nconv) break;
                if (nconv) { const int q3 = idx / 3; if (idx < 3 * nconv) { if (idx - 3 * q3 == 2) { conv_chunk(F, args, ws, q3); asm volatile("s_waitcnt vmcnt(0) lgkmcnt(0)\n\ts_barrier" ::: "memory"); continue; } idx -= q3; } else idx -= nconv; }
                if (!moba) { const int hh = 7 - (idx >> 7), bb = (idx >> 4) & 7, pr = idx & 15;
                    att::attn_unit<0>(F.lds + RING_OFF, A, bb, hh, pr);
                    att::attn_unit<0>(F.lds + RING_OFF, A, bb, hh, 31 - pr);
                } else { const int hh = 15 - (idx >> 6), bb = (idx >> 3) & 7, pr = idx & 7;
                    att::attn_unit<1>(F.lds + RING_OFF, A, bb, hh, pr);
                    att::attn_unit<1>(F.lds + RING_OFF, A, bb, hh, 15 - pr); }
            }
            asm volatile("s_waitcnt vmcnt(0) lgkmcnt(0)\n\ts_barrier" ::: "memory");
        }
        SEAM(pb + 2);
        if (PHEN(5) && IN(pb + 3)) {
            PTRS();
            const bf16* W = (const bf16*)(ws + (moba ? WS_MWO : WS_DWO)) + (size_t)j * D * D;
            pg8::Gemm g{XN, W, 2 * D, 0}; pg8::StaticOrder S; S.init(MTOK, D, F.G, bx);
            pg8::EpiRes E{L == 0 ? x : h, h, D, 1.0f};
            pg8::gemm_phase<pg8::EpiRes, pg8::StaticOrder>(F.lds + RING_OFF, XSLOT_OFF, g, S, E);
        }
        SEAM(pb + 3);
        if (PHEN(6) && IN(pb + 4)) {
            PTRS();
            if (!moba) {
                if (L == 2) norm_phase<0, true>(F, h, nullptr, nullptr, norm_ffn + (size_t)L * D, XN, nullptr, noR);
                else norm_phase<0, false>(F, h, nullptr, nullptr, norm_ffn + (size_t)L * D, XN, nullptr, noR);
            } else {
                const RouterArgs R{args.in[12] + (size_t)j * D * NE, F.ctl + CW_CNT + 64 * NE * j, ltok, lw};
                norm_phase<2, true>(F, h, nullptr, nullptr, norm_ffn + (size_t)L * D, XN, nullptr, R);
            }
        }
        SEAM(pb + 4);
        if (IN(pb + 5)) {
            PTRS();
            if (PHEN(7) && !moba) {
                if (L == 2) { pg8::Gemm g{XN, ws + WS_FGU + (size_t)j * 2 * DFF * D * 2, D, 0}; pg8::StaticOrder S; S.init(MTOK, 2 * DFF, F.G, bx);
                    pg8::EpiSwiGLU<true> E{ACT, DFF, 1.0f / WSC_UP};
                    pg8::gemm_phase<pg8::EpiSwiGLU<true>, pg8::StaticOrder, true>(F.lds + RING_OFF, XSLOT_OFF, g, S, E);
                } else { pg8::Gemm g{XN, ws + WS_FGU + (size_t)j * 2 * DFF * D * 2, 2 * D, 0}; pg8::StaticOrder S; S.init(MTOK, 2 * DFF, F.G, bx);
                    pg8::EpiSwiGLU<false> E{ACT, DFF, 1.0f};
                    pg8::gemm_phase<pg8::EpiSwiGLU<false>, pg8::StaticOrder, false>(F.lds + RING_OFF, XSLOT_OFF, g, S, E); }
            } else if (PHEN(8) && moba) {
                pg8::Gemm g{XN, ws + WS_MGU + (size_t)j * NE * 2 * DE * D, D, (size_t)2 * DE * D}; pg8::MoeOrder S; S.init((const unsigned*)(F.ctl + CW_CNT + 64 * NE * j), ltok, true, 2 * DE, F.G, bx);
                pg8::EpiSwiGLU<true> E{ACT, DE, 1.0f / WSC_UP};
                pg8::gemm_phase<pg8::EpiSwiGLU<true>, pg8::MoeOrder, true>(F.lds + RING_OFF, XSLOT_OFF, g, S, E);
            }
        }
        SEAM(pb + 5);
        if (IN(pb + 6)) {
            PTRS();
            if (PHEN(9) && !moba) {
                if (L == 2) { pg8::Gemm g{ACT, ws + WS_FD + (size_t)j * D * DFF * 2, DFF, 0}; pg8::StaticOrder S; S.init(MTOK, D, F.G, bx);
                    pg8::EpiRes E{h, h, D, 1.0f / WSC_DN};
                    pg8::gemm_phase<pg8::EpiRes, pg8::StaticOrder, true>(F.lds + RING_OFF, XSLOT_OFF, g, S, E);
                } else { pg8::Gemm g{ACT, ws + WS_FD + (size_t)j * D * DFF * 2, 2 * DFF, 0}; pg8::StaticOrder S; S.init(MTOK, D, F.G, bx);
                    pg8::EpiRes E{h, h, D, 1.0f};
                    pg8::gemm_phase<pg8::EpiRes, pg8::StaticOrder, false>(F.lds + RING_OFF, XSLOT_OFF, g, S, E); }
            } else if (PHEN(10) && moba) {
                pg8::Gemm g{ACT, ws + WS_MD + (size_t)j * NE * D * DE, DE, (size_t)D * DE}; pg8::MoeOrder S; S.init((const unsigned*)(F.ctl + CW_CNT + 64 * NE * j), ltok, false, D, F.G, bx);
                pg8::EpiMoeDown E; E.h = h; E.y1 = XN; E.list_tok = ltok; E.list_w = lw; E.sc = 1.0f / WSC_DN;
#pragma unroll
                for (int e = 0; e < NE; ++e) E.cnt[e] = S.cnt[e];
                pg8::gemm_phase<pg8::EpiMoeDown, pg8::MoeOrder, true>(F.lds + RING_OFF, XSLOT_OFF, g, S, E);
            }
        }
        SEAM(pb + 6);
        if (PHEN(11) && IN(pb + 7)) {
            PTRS();
            if (L == 3) norm_phase<3>(F, h, nullptr, XN, args.in[16], nullptr, h, noR);
            else if (moba) norm_phase<1>(F, h, h, XN, norm_mix + (size_t)(L + 1) * D, XN, nullptr, noR);
            else for (int rep_ = 0; rep_ < NREP(11); ++rep_) norm_phase<0>(F, h, nullptr, nullptr, norm_mix + (size_t)(L + 1) * D, XN, nullptr, noR);
        }
        if (L != NLAYER - 1) SEAM(pb + 7); else STAMP(pb + 8);
#undef F
    }
#undef IN
#undef SEAM
#undef PTRS
#undef OPQ
}


#if MK_DEBUG
__global__ void dbg_probe(const void* buf, size_t n, int is_bf16, int idx, float thresh, unsigned* dbg) {
    size_t i = blockIdx.x * (size_t)blockDim.x + threadIdx.x, stride = (size_t)gridDim.x * blockDim.x; bool bad = false;
    for (size_t k = i; k < n; k += stride) { float v = is_bf16 ? __uint_as_float(((unsigned)((const unsigned short*)buf)[k]) << 16) : ((const float*)buf)[k]; if (!(fabsf(v) <= thresh)) bad = true; }
    if (bad) atomicMax(dbg, (unsigned)(1000 - idx));
}
__global__ void dbg_cnt(const unsigned* cntw, int idx, unsigned* dbg) {
    if (threadIdx.x == 0 && blockIdx.x == 0) { unsigned s = 0; for (int e = 0; e < NE; ++e) s += cntw[64 * e]; if (s != 2u * MTOK) atomicMax(dbg, (unsigned)(1000 - idx)); }
}

__device__ __forceinline__ float dbg_bf(unsigned short v) { return __uint_as_float(((unsigned)v) << 16); }
__device__ __forceinline__ unsigned dbg_hash(unsigned x) { x ^= x >> 16; x *= 0x7feb352dU; x ^= x >> 15; x *= 0x846ca68bU; x ^= x >> 16; return x; }
__global__ void dbg_gemm_check(const unsigned short* A, int lda, const unsigned short* Bt, int K, const unsigned short* out, int ldo, int M, int N, float scale, int idx, unsigned* dbg) {
    const unsigned s = blockIdx.x * blockDim.x + threadIdx.x; const int row = (int)(dbg_hash(2 * s + 1) % (unsigned)M), col = (int)(dbg_hash(2 * s + 2) % (unsigned)N);
    float acc = 0.f; for (int k = 0; k < K; ++k) acc += dbg_bf(A[(size_t)row * lda + k]) * dbg_bf(Bt[(size_t)col * K + k]);
    acc *= scale; const float got = dbg_bf(out[(size_t)row * ldo + col]);
    if (!(fabsf(got - acc) <= 0.03f + 0.02f * fabsf(acc))) { atomicMax(dbg, (unsigned)(1000 - idx)); atomicAdd(dbg + 64 + idx, 1u); }
}
__global__ void dbg_conv_check(const float* W, int K, int N, const unsigned short* WT, int il, int idx, unsigned* dbg) {
    const unsigned s = blockIdx.x * blockDim.x + threadIdx.x; const int k = (int)(dbg_hash(2 * s + 1) % (unsigned)K), n = (int)(dbg_hash(2 * s + 2) % (unsigned)N);
    const int dr = il == 0 ? n : (n / 128) * 256 + (il - 1) * 128 + (n % 128);
    const float w = W[(size_t)k * N + n], g = dbg_bf(WT[(size_t)dr * K + k]);
    if (!(fabsf(g - w) <= 0.01f * fabsf(w) + 1e-6f)) atomicMax(dbg, (unsigned)(1000 - idx));
}
__global__ void dbg_norm_check(const float* src, const float* gain, const unsigned short* xn, int idx, unsigned* dbg) {
    const unsigned s = blockIdx.x * blockDim.x + threadIdx.x; const int row = (int)(dbg_hash(s + 77) % (unsigned)MTOK);
    float ss = 0.f; for (int c = 0; c < D; ++c) { const float v = src[(size_t)row * D + c]; ss += v * v; }
    const float rstd = 1.f / sqrtf(ss / D + 1e-6f); bool bad = false;
    for (int c = 0; c < D; ++c) { const float r = src[(size_t)row * D + c] * rstd * gain[c], g = dbg_bf(xn[(size_t)row * D + c]); if (!(fabsf(g - r) <= 0.02f + 0.01f * fabsf(r))) bad = true; }
    if (bad) atomicMax(dbg, (unsigned)(1000 - idx));
}
__global__ void dbg_naive_gemm(const unsigned short* A, const unsigned short* Bt, unsigned short* out, int M, int N, int K) {
    const size_t i = blockIdx.x * (size_t)blockDim.x + threadIdx.x; if (i >= (size_t)M * N) return; const int row = (int)(i / N), col = (int)(i % N);
    float acc = 0.f; for (int k = 0; k < K; ++k) acc += dbg_bf(A[(size_t)row * K + k]) * dbg_bf(Bt[(size_t)col * K + k]);
    out[(size_t)row * N + col] = (unsigned short)f2bf(acc);
}
__global__ void dbg_find_col(const unsigned short* out, const unsigned short* ref, int M, int N, unsigned* hist) {
    const unsigned s = blockIdx.x * blockDim.x + threadIdx.x; const int row = (int)(dbg_hash(2 * s + 1) % (unsigned)M), col = (int)(dbg_hash(2 * s + 2) % (unsigned)N);
    const unsigned short v = out[(size_t)row * N + col]; int found = -1;
#if MK_FIND_PATTERN
    if (v == 0x3C3C) atomicAdd(hist + N, 1u); else atomicAdd(hist + 5, 1u); return;
#endif
#if MK_FIND_ROWS
    for (int r = 0; r < M; ++r) if (ref[(size_t)r * N + col] == v) { found = r; break; }
    if (found < 0) atomicAdd(hist + N, 1u); else atomicAdd(hist + ((found - row) & (N - 1)), 1u);
#else
    for (int c = 0; c < N; ++c) if (ref[(size_t)row * N + c] == v) { found = c; break; }
    if (found < 0) atomicAdd(hist + N, 1u); else atomicAdd(hist + ((found - col) & (N - 1)), 1u);
#endif
}
__global__ void dbg_hist_code(const unsigned* hist, int N, unsigned* dbg) {
    if (threadIdx.x || blockIdx.x) return; unsigned best = 0, bi = 0; for (int i = 0; i < N; ++i) if (hist[i] > best) { best = hist[i]; bi = i; }
    dbg[32] = bi; dbg[33] = best; dbg[34] = hist[N];
}
__global__ void dbg_final(float* out, size_t n, const unsigned* dbg) {
    if (MK_HIST_SEL >= 10) { const float c3 = sqrtf((float)dbg[MK_HIST_SEL + 30]); size_t i3 = blockIdx.x * (size_t)blockDim.x + threadIdx.x, st3 = (size_t)gridDim.x * blockDim.x; for (size_t k3 = i3; k3 < n; k3 += st3) out[k3] = c3; return; }
    if (MK_HIST_SEL >= 0 && (dbg[33] || dbg[34])) { const float c2 = sqrtf((float)(MK_HIST_SEL == 0 ? dbg[32] : (MK_HIST_SEL == 1 ? dbg[33] * 100u / 4096u : dbg[34] * 100u / 4096u)) + 1.f); size_t i2 = blockIdx.x * (size_t)blockDim.x + threadIdx.x, st2 = (size_t)gridDim.x * blockDim.x; for (size_t k2 = i2; k2 < n; k2 += st2) out[k2] = c2; return; }
    const unsigned d = dbg[0]; if (d == 0u) return; const unsigned nf = dbg[64 + (1000u - d)]; const float c = sqrtf(nf ? (float)(200u * (1000u - d - 9u) + nf * 100u / 4096u) : (float)(1000u - d));
    size_t i = blockIdx.x * (size_t)blockDim.x + threadIdx.x, stride = (size_t)gridDim.x * blockDim.x;
    for (size_t k = i; k < n; k += stride) out[k] = c;
}
#endif

#ifndef MK_REPEAT
#define MK_REPEAT 1
#endif
#ifndef MK_FIND_ROWS
#define MK_FIND_ROWS 0
#endif
#ifndef MK_FIND_REGION
#define MK_FIND_REGION WS_K
#endif
#ifndef MK_HIST_SEL
#define MK_HIST_SEL 0
#endif
#ifndef MK_STAMP
#define MK_STAMP 0
#endif
#if MK_STAMP
__global__ void stamp_k(unsigned* p) { if (threadIdx.x == 0) *p = (unsigned)__builtin_amdgcn_s_memrealtime(); }
__global__ void stamp_encode(float* out, size_t n, const unsigned* st, int pa, float ua, int pb, float ub) {
    const float da = (float)(st[pa + 1] - st[pa]) * 0.01f, db = (float)(st[pb + 1] - st[pb]) * 0.01f;
    float m = da / ua; m = m < 10.f ? 10.f : (m > 99.f ? 99.f : m); float e = floorf(db / ub + 0.5f); e = e < 0.f ? 0.f : (e > 30.f ? 30.f : e);
    const float c = sqrtf(m) * __powf(10.f, 0.5f * e);
    size_t i = blockIdx.x * (size_t)blockDim.x + threadIdx.x, stride = (size_t)gridDim.x * blockDim.x;
    for (size_t k = i; k < n; k += stride) out[k] = c;
}
#endif
extern "C" void kernel_launch(void* const* d_in, const int* in_sizes, int n_in, void* d_out, int out_size, void* d_ws, size_t ws_size, hipStream_t stream) {
    static int grid = 0;
    if (grid == 0) {
        if (n_in != 17 || in_sizes[0] != MTOK * D || out_size != MTOK * D || ws_size < WS_END) {
            fprintf(stderr, "kernel_launch: built for 17 inputs, x/out of %d floats, >= %zu bytes of workspace; got n_in %d, in0 %d, out %d, ws %zu; nothing launched\n", MTOK * D, (size_t)WS_END, n_in, n_in > 0 ? in_sizes[0] : -1, out_size, ws_size);
            grid = -1; return; }
        int dev = 0, cus = 0, per_cu = 0;
        if (hipGetDevice(&dev) != hipSuccess || hipDeviceGetAttribute(&cus, hipDeviceAttributeMultiprocessorCount, dev) != hipSuccess) { fprintf(stderr, "kernel_launch: device query failed\n"); grid = -1; return; }
        if (hipFuncSetAttribute((const void*)trunk_fwd, hipFuncAttributeMaxDynamicSharedMemorySize, LDS_BYTES) != hipSuccess) { fprintf(stderr, "kernel_launch: hipFuncSetAttribute failed\n"); grid = -1; return; }
        if (hipOccupancyMaxActiveBlocksPerMultiprocessor(&per_cu, (const void*)trunk_fwd, NWAVES * 64, LDS_BYTES) != hipSuccess || per_cu < 1)
            fprintf(stderr, "kernel_launch: note: occupancy query reports %d workgroups per CU\n", per_cu);
        (void)hipGetLastError();
        grid = cus;
    }
    if (grid < 0) return;
    if (hipMemsetAsync((char*)d_ws + WS_CTL, 0, CTL_ZERO_BYTES, stream) != hipSuccess) { fprintf(stderr, "kernel_launch: memset failed\n"); return; }
    KArgs a{};
    for (int i = 0; i < 17; ++i) a.in[i] = (const float*)d_in[i];
    a.out = (float*)d_out; a.ws = (unsigned char*)d_ws;
#if MK_PER_PHASE
#if MK_STAMP
    hipLaunchKernelGGL(stamp_k, dim3(1), dim3(64), 0, stream, (unsigned*)d_ws + 3000);
#endif
    for (int p = 0; p < NPHASE; ++p) {
        a.ph_lo = p; a.ph_hi = p + 1;
#if MK_DEBUG
#endif
#if !defined(MK_SKIP_MAIN)
        for (int rep_ = 0; rep_ < (p == 1 ? MK_REPEAT : 1); ++rep_) hipLaunchKernelGGL(trunk_fwd, dim3(grid), dim3(NWAVES * 64), LDS_BYTES, stream, a);
#endif
#if MK_STAMP
        hipLaunchKernelGGL(stamp_k, dim3(1), dim3(64), 0, stream, (unsigned*)d_ws + 3000 + p + 1);
#endif
#if MK_DEBUG
        {   unsigned char* ws = (unsigned char*)d_ws; unsigned* dbg = (unsigned*)(ws + WS_CTL) + 2048;
            const size_t MD_ = (size_t)MTOK * D;
#define PROBE(buf, n, isbf, idx, th) if ((idx) <= MK_PROBE_MAX) hipLaunchKernelGGL(dbg_probe, dim3(2048), dim3(256), 0, stream, (const void*)(buf), (size_t)(n), isbf, idx, th, dbg)
            if (p == 0) {
                hipLaunchKernelGGL(dbg_norm_check, dim3(4), dim3(64), 0, stream, (const float*)d_in[0], (const float*)d_in[1], (const unsigned short*)(ws + WS_XN), 4, dbg);
                hipLaunchKernelGGL(dbg_conv_check, dim3(16), dim3(256), 0, stream, (const float*)d_in[3], D, 3 * D, (const unsigned short*)(ws + WS_DQKV), 0, 5, dbg);
                hipLaunchKernelGGL(dbg_conv_check, dim3(16), dim3(256), 0, stream, (const float*)d_in[9], D, DFF, (const unsigned short*)(ws + WS_FGU), 1, 6, dbg);
                hipLaunchKernelGGL(dbg_conv_check, dim3(16), dim3(256), 0, stream, (const float*)d_in[10], D, DFF, (const unsigned short*)(ws + WS_FGU), 2, 7, dbg);
                hipLaunchKernelGGL(dbg_conv_check, dim3(16), dim3(256), 0, stream, (const float*)d_in[11], DFF, D, (const unsigned short*)(ws + WS_FD), 0, 8, dbg);
                hipLaunchKernelGGL(dbg_conv_check, dim3(16), dim3(256), 0, stream, (const float*)d_in[15] + (size_t)3 * DE * D, DE, D, (const unsigned short*)(ws + WS_MD) + (size_t)3 * D * DE, 0, 9, dbg);
            }
            if (p == 1) {
                const float C2h = 0.125f * 1.4426950408889634f;
                hipLaunchKernelGGL(dbg_gemm_check, dim3(16), dim3(256), 0, stream, (const unsigned short*)(ws + WS_XN), D, (const unsigned short*)(ws + WS_DQKV), D, (const unsigned short*)(ws + WS_Q), D, MTOK, D, C2h, 10, dbg);
                hipLaunchKernelGGL(dbg_gemm_check, dim3(16), dim3(256), 0, stream, (const unsigned short*)(ws + WS_XN), D, (const unsigned short*)(ws + WS_DQKV) + (size_t)D * D, D, (const unsigned short*)(ws + WS_K), D, MTOK, D, 1.f, 11, dbg);

                hipLaunchKernelGGL(dbg_gemm_check, dim3(16), dim3(256), 0, stream, (const unsigned short*)(ws + WS_XN), D, (const unsigned short*)(ws + WS_DQKV) + (size_t)2 * D * D, D, (const unsigned short*)(ws + WS_V), D, MTOK, D, 1.f, 12, dbg);
            }
            if (0) { PROBE(ws + WS_XN, MD_, 1, 1, 10.f); PROBE(ws + WS_DQKV, (WS_MGU - WS_DQKV) / 2, 1, 2, 1.f); PROBE(ws + WS_MGU, (WS_XN - WS_MGU) / 2, 1, 3, 1.f); }
            if (p >= 1) { const int L = (p - 1) / PH_PER_LAYER, k = (p - 1) % PH_PER_LAYER; const int b = 20 + 10 * L;
                if (k == 0) PROBE(ws + WS_Q, 3 * MD_, 1, b + 0, 50.f);
                if (k == 1) PROBE(ws + WS_KMEAN, 8 * 16 * 16 * 64, 0, b + 1, 5.f);
                if (k == 2) PROBE(ws + WS_XN, MD_, 1, b + 2, 50.f);
                if (k == 3) PROBE(d_out, MD_, 0, b + 3, 300.f);
                if (k == 4) { PROBE(ws + WS_XN, MD_, 1, b + 4, 20.f); if ((L & 1) && (b + 9) <= MK_PROBE_MAX) hipLaunchKernelGGL(dbg_cnt, dim3(1), dim3(64), 0, stream, (const unsigned*)(ws + WS_CTL) + CW_CNT + 64 * NE * (L >> 1), b + 9, dbg); }
                if (k == 5) PROBE(ws + WS_ACT, (L & 1) ? (size_t)256 * 256 * DE : (size_t)MTOK * DFF, 1, b + 5, 2000.f);
                if (k == 6) { PROBE(d_out, MD_, 0, b + 6, 1000.f); if (L & 1) PROBE(ws + WS_XN, MD_, 1, b + 7, 1000.f); }
                if (k == 7 && L != 3) { PROBE(ws + WS_XN, MD_, 1, b + 8, 20.f); PROBE(d_out, MD_, 0, b + 8, 1000.f); }
            }
#undef PROBE
        }
#endif
    }
#if MK_DEBUG
    hipLaunchKernelGGL(dbg_final, dim3(2048), dim3(256), 0, stream, (float*)d_out, (size_t)MTOK * D, (const unsigned*)((unsigned char*)d_ws + WS_CTL) + 2048);
#endif
#else
    a.ph_lo = 0; a.ph_hi = NPHASE;
    hipLaunchKernelGGL(trunk_fwd, dim3(grid), dim3(NWAVES * 64), LDS_BYTES, stream, a);
#if 0
    hipLaunchKernelGGL(stamp_encode, dim3(2048), dim3(256), 0, stream, (float*)d_out, (size_t)MTOK * D, (const unsigned*)d_ws + 3000, MK_STAMP_PA, MK_STAMP_UA, MK_STAMP_PB, MK_STAMP_UB);
#endif
#endif
#if MK_STAMP
    hipLaunchKernelGGL(stamp_encode, dim3(2048), dim3(256), 0, stream, (float*)d_out, (size_t)MTOK * D, (const unsigned*)d_ws + 3000, MK_STAMP_PA, MK_STAMP_UA, MK_STAMP_PB, MK_STAMP_UB);
#endif
    const hipError_t le = hipPeekAtLastError();
    if (le != hipSuccess) fprintf(stderr, "kernel_launch: launch failed: %s\n", hipGetErrorName(le));
}
```

```cpp
#ifndef MK_DEBUG
#define MK_DEBUG 0
#endif
#ifndef MK_PER_PHASE
#define MK_PER_PHASE 0
#endif
#include <hip/hip_runtime.h>
#include <cstdio>
#include <cstdint>

#ifndef MK_KDEBUG
#define MK_KDEBUG 0
#endif
#define LAS __attribute__((address_space(3)))
#define GAS __attribute__((address_space(1)))

constexpr int BATCH = 8, SEQ = 4096, MTOK = BATCH * SEQ, D = 1024, DFF = 2816, DE = 3584, NE = 8;
constexpr int MOE_TILES_MAX = 272;
constexpr int LIST_CAP = MTOK;

namespace pg8 {
#define PG8_LAS __attribute__((address_space(3)))
typedef unsigned short bf16_t;
typedef short bf16x8 __attribute__((ext_vector_type(8)));
typedef float f32x4 __attribute__((ext_vector_type(4)));
typedef unsigned u32x4 __attribute__((ext_vector_type(4)));
typedef int i32x4 __attribute__((ext_vector_type(4)));
typedef int i32x8 __attribute__((ext_vector_type(8)));
constexpr int BM = 256, BK = 64, HALF = 128, HTB = HALF * BK * 2  , STAGE_BYTES = 8 * HTB, NXCD = 8, WGM = 8;

__host__ __device__ __forceinline__ int lds_byte(int r, int c) { const int st = (r >> 4) * 2 + (c >> 5), rr = r & 15, cc = c & 31, ob = rr * 64 + cc * 2; return st * 1024 + (ob ^ (((ob >> 9) & 1) << 5)); }
__host__ __device__ __forceinline__ void stage_rc(int b, int& R, int& C) { const int st = b / 1024, sb = b % 1024, swz = sb ^ (((sb >> 9) & 1) << 5); R = (st >> 1) * 16 + swz / 64; C = (st & 1) * 32 + (swz % 64) / 2; }
__host__ __device__ __forceinline__ int perm32(int rho) { const int n = rho >> 4, i = rho & 15; return 8 * (i >> 2) + 4 * n + (i & 3); }

struct Unit { int pm, pn, e, r0; };
struct Gemm { const void* A; const void* Bt; int rowb; size_t bstride; };

__device__ __forceinline__ void tile_of(int L, int nM, int nN, int& pm, int& pn) {
    const int nwg = nM * nN; int wgid = L; { const int q = nwg / NXCD, r = nwg % NXCD, xcd = wgid % NXCD, off = wgid / NXCD; wgid = (xcd < r ? xcd * (q + 1) : r * (q + 1) + (xcd - r) * q) + off; }
    const int nig = WGM * nN, gid = wgid / nig, fm = gid * WGM, gsz = (nM - fm) < WGM ? (nM - fm) : WGM;
    pm = fm + ((wgid % nig) % gsz); pn = (wgid % nig) / gsz;
}
struct StaticOrder {
    int nM, nN, nwg, G, c;
    __device__ __forceinline__ void init(int M, int N, int G_, int c_) { nM = M / BM; nN = N / BM; nwg = nM * nN; G = G_; c = c_; }
    __device__ __forceinline__ bool next(int i, Unit& u) const {
        const long L = (long)i * G + c; if (L >= nwg) return false;
        tile_of((int)L, nM, nN, u.pm, u.pn); u.e = 0; u.r0 = 0; return true;
    }
    __device__ __forceinline__ unsigned arow(const Unit& u, int lr) const { return (unsigned)(u.pm * BM + lr); }
};
struct MoeOrder {
    int nM, nN, nwg, G, c; int tstart[NE + 1]; int cnt[NE]; const unsigned* list_tok; bool gather;
    __device__ __forceinline__ void init(const unsigned* cntw, const unsigned* list_tok_, bool gather_, int N, int G_, int c_) {
        int acc = 0;
#pragma unroll
        for (int e = 0; e < NE; ++e) { const int ce = (int)__builtin_amdgcn_readfirstlane((int)__hip_atomic_load((const GAS unsigned*)cntw + 64 * e, __ATOMIC_RELAXED, __HIP_MEMORY_SCOPE_AGENT)); cnt[e] = ce; tstart[e] = acc; acc += (ce + BM - 1) / BM; }
        tstart[NE] = acc; nM = acc; nN = N / BM; nwg = nM * nN; G = G_; c = c_; list_tok = list_tok_; gather = gather_;
    }
    __device__ __forceinline__ bool next(int i, Unit& u) const {
        const long L = (long)i * G + c; if (L >= nwg) return false;
        tile_of((int)L, nM, nN, u.pm, u.pn); int e = 0;
#pragma unroll
        for (int k = 1; k < NE; ++k) e += (u.pm >= tstart[k]) ? 1 : 0;
        u.e = e; int ts = 0;
#pragma unroll
        for (int k = 0; k < NE; ++k) ts = (k == e) ? tstart[k] : ts;
        u.r0 = (u.pm - ts) * BM; return true;
    }
    __device__ __forceinline__ int count_of(int e) const { int cv = 0;
#pragma unroll
        for (int k = 0; k < NE; ++k) cv = (k == e) ? cnt[k] : cv;
        return cv; }
    __device__ __forceinline__ unsigned arow(const Unit& u, int lr) const {
        if (!gather) return (unsigned)(u.pm * BM + lr);
        const int l = u.r0 + lr; const int cv = count_of(u.e);
        unsigned t = 0u; if (l < cv) t = __hip_atomic_load((const GAS unsigned*)list_tok + (size_t)u.e * LIST_CAP + l, __ATOMIC_RELAXED, __HIP_MEMORY_SCOPE_AGENT) & 0xFFFFFu;
        return t;
    }
};

__device__ __forceinline__ unsigned cvt_pk_bf16(float lo, float hi) { unsigned r; asm volatile("v_cvt_pk_bf16_f32 %0, %1, %2" : "=v"(r) : "v"(lo), "v"(hi)); return r; }

struct EpiQKV {
    static constexpr bool PERM = true;
    bf16_t* O; int ldc; int split_cols; size_t split_stride; float scale0;
    __device__ __forceinline__ void operator()(const f32x4 (&acc)[2][2][4][2], const Unit& u, int wr, int wc, int fr, int fq) const {
        const int row0 = u.pm * BM + wr * 64 + fr; int colt = u.pn * BM; bf16_t* base = O;
        float sc = 1.f; { const int t = colt / split_cols; base += (size_t)t * split_stride; colt -= t * split_cols; if (t == 0) sc = scale0; }
        const int col0 = colt + wc * 32 + 8 * fq;
#pragma unroll
        for (int ai = 0; ai < 2; ++ai)
#pragma unroll
            for (int m = 0; m < 4; ++m) { bf16_t* rowp = base + (size_t)(row0 + ai * HALF + m * 16) * ldc + col0;
#pragma unroll
                for (int bj = 0; bj < 2; ++bj) { f32x4 v0 = acc[ai][bj][m][0] * sc, v1 = acc[ai][bj][m][1] * sc;
                    u32x4 w; w.x = cvt_pk_bf16(v0[0], v0[1]); w.y = cvt_pk_bf16(v0[2], v0[3]); w.z = cvt_pk_bf16(v1[0], v1[1]); w.w = cvt_pk_bf16(v1[2], v1[3]);
                    *(GAS u32x4*)(rowp + bj * HALF) = w;
                    } }
    }
};
__device__ __forceinline__ unsigned pk4_fp8(float a, float b, float c, float d) { unsigned w = 0; w = __builtin_amdgcn_cvt_pk_fp8_f32(a, b, w, false); w = __builtin_amdgcn_cvt_pk_fp8_f32(c, d, w, true); return w; }
template <bool F8OUT> struct EpiSwiGLU {
    static constexpr bool PERM = true;
    void* O; int ldc; float sc;
    __device__ __forceinline__ void operator()(const f32x4 (&acc)[2][2][4][2], const Unit& u, int wr, int wc, int fr, int fq) const {
        const int row0 = u.pm * BM + wr * 64 + fr; const int col0 = u.pn * HALF + wc * 32 + 8 * fq;
#pragma unroll
        for (int ai = 0; ai < 2; ++ai)
#pragma unroll
            for (int m = 0; m < 4; ++m) { float o[8];
#pragma unroll
                for (int n = 0; n < 2; ++n)
#pragma unroll
                    for (int j = 0; j < 4; ++j) { const float g = acc[ai][0][m][n][j] * sc, up = acc[ai][1][m][n][j] * sc;
                        const float s = __builtin_amdgcn_rcpf(1.0f + __builtin_amdgcn_exp2f(-1.4426950408889634f * g)); o[n * 4 + j] = g * s * up; }
                const size_t eo = (size_t)(row0 + ai * HALF + m * 16) * ldc + col0;
                if constexpr (F8OUT) { const unsigned long long w = (unsigned long long)pk4_fp8(o[0], o[1], o[2], o[3]) | ((unsigned long long)pk4_fp8(o[4], o[5], o[6], o[7]) << 32);
                    *(GAS unsigned long long*)((unsigned char*)O + eo) = w;
                } else { u32x4 w; w.x = cvt_pk_bf16(o[0], o[1]); w.y = cvt_pk_bf16(o[2], o[3]); w.z = cvt_pk_bf16(o[4], o[5]); w.w = cvt_pk_bf16(o[6], o[7]);
                    *(GAS u32x4*)((bf16_t*)O + eo) = w; } }
    }
};
struct EpiRes {
    static constexpr bool PERM = false;
    const float* res; float* out; int ldc; float sc;
    __device__ __forceinline__ void operator()(const f32x4 (&acc)[2][2][4][2], const Unit& u, int wr, int wc, int fr, int fq) const {
        const int row0 = u.pm * BM + wr * 64 + fr; const int col0 = u.pn * BM + wc * 32 + 4 * fq;
#pragma unroll
        for (int ai = 0; ai < 2; ++ai)
#pragma unroll
            for (int m = 0; m < 4; ++m) { const size_t off = (size_t)(row0 + ai * HALF + m * 16) * ldc + col0;
#pragma unroll
                for (int bj = 0; bj < 2; ++bj)
#pragma unroll
                    for (int n = 0; n < 2; ++n) { const f32x4 r = *(const GAS f32x4*)(res + off + bj * HALF + n * 16); *(GAS f32x4*)(out + off + bj * HALF + n * 16) = r + acc[ai][bj][m][n] * sc; } }
    }
};
struct EpiMoeDown {
    static constexpr bool PERM = false;
    float* h; bf16_t* y1; const unsigned* list_tok; const float* list_w; int cnt[NE]; float sc;
    __device__ __forceinline__ void operator()(const f32x4 (&acc)[2][2][4][2], const Unit& u, int wr, int wc, int fr, int fq) const {
        int cv = 0;
#pragma unroll
        for (int k = 0; k < NE; ++k) cv = (k == u.e) ? cnt[k] : cv;
        const int col0 = u.pn * BM + wc * 32 + 4 * fq;
#pragma unroll
        for (int ai = 0; ai < 2; ++ai)
#pragma unroll
            for (int m = 0; m < 4; ++m) { const int l = u.r0 + ai * HALF + wr * 64 + m * 16 + fr;
                if (l < cv) {
                    const unsigned ent = __hip_atomic_load((const GAS unsigned*)list_tok + (size_t)u.e * LIST_CAP + l, __ATOMIC_RELAXED, __HIP_MEMORY_SCOPE_AGENT);
                    const float w = sc * __uint_as_float(__hip_atomic_load((const GAS unsigned*)list_w + (size_t)u.e * LIST_CAP + l, __ATOMIC_RELAXED, __HIP_MEMORY_SCOPE_AGENT));
                    const size_t off = (size_t)(ent & 0xFFFFFu) * D + col0;
                    if ((ent >> 20) == 0u) {
#pragma unroll
                        for (int bj = 0; bj < 2; ++bj)
#pragma unroll
                            for (int n = 0; n < 2; ++n) { GAS float* p = (GAS float*)(h + off + bj * HALF + n * 16); const f32x4 r = *(const GAS f32x4*)p; *(GAS f32x4*)p = r + acc[ai][bj][m][n] * w; }
                    } else {
#pragma unroll
                        for (int bj = 0; bj < 2; ++bj)
#pragma unroll
                            for (int n = 0; n < 2; ++n) { const f32x4 v = acc[ai][bj][m][n] * w; unsigned long long pk = (unsigned long long)cvt_pk_bf16(v[0], v[1]) | ((unsigned long long)cvt_pk_bf16(v[2], v[3]) << 32);
                                *(GAS unsigned long long*)(y1 + off + bj * HALF + n * 16) = pk; }
                    }
                } }
    }
};

template <class Epi, class Sched, bool F8 = false>
__device__ __forceinline__ void gemm_phase(PG8_LAS unsigned char* lds, int xoff, const Gemm g, const Sched& S, const Epi& E) {
    int tid_ = threadIdx.x;
    asm volatile("" : "+v"(tid_));
    const int tid = tid_, wid = __builtin_amdgcn_readfirstlane(tid >> 6), lane = tid & 63, wr = wid >> 2, wc = wid & 3, fr = lane & 15, fq = lane >> 4;
    const int RB = g.rowb, nt = RB / 128;
    unsigned voffB[2];
#pragma unroll
    for (int i = 0; i < 2; ++i) { int R, C; stage_rc(tid * 16 + i * 8192, R, C); const int Rb = Epi::PERM ? ((R & ~31) + perm32(R & 31)) : R;
        voffB[i] = (unsigned)(Rb * RB + C * 2); }
    const size_t kstep = (size_t)(BK * 2);
    const size_t hstep = (size_t)HALF * RB;
    const size_t tstep = 2 * hstep;
    const unsigned ldsw = (unsigned)wid * 1024u;
    const int aoff = F8 ? lds_byte(wr * 64 + fr, fq * 16) : lds_byte(wr * 64 + fr, fq * 8), boff = F8 ? lds_byte(wc * 32 + fr, fq * 16) : lds_byte(wc * 32 + fr, fq * 8);
#define PG8_SA(b, h) (((b) * 2 + (h)) * HTB)
#define PG8_SB(b, h) ((4 + (b) * 2 + (h)) * HTB)
#define PG8_STAGE(bufoff, gbase, v0, v1) do { \
        __builtin_amdgcn_global_load_lds((const GAS unsigned*)((const char*)(gbase) + (v0)), (PG8_LAS unsigned*)(lds + (bufoff) + ldsw), 16, 0, 0); \
        __builtin_amdgcn_global_load_lds((const GAS unsigned*)((const char*)(gbase) + (v1)), (PG8_LAS unsigned*)(lds + (bufoff) + ldsw + 8192), 16, 0, 0); } while (0)
#define PG8_STAGEB(bufoff, gbase) PG8_STAGE(bufoff, gbase, voffB[0], voffB[1])
#define PG8_LDA(dst, b, h) do { if constexpr (F8) { _Pragma("unroll") for (int m = 0; m < 4; ++m) { dst##8[m].lo = *(const PG8_LAS i32x4*)(lds + PG8_SA(b, h) + aoff + m * 2048); dst##8[m].hi = *(const PG8_LAS i32x4*)(lds + PG8_SA(b, h) + aoff + m * 2048 + 16); } } \
        else { _Pragma("unroll") for (int m = 0; m < 4; ++m) _Pragma("unroll") for (int k = 0; k < 2; ++k) dst[m][k] = *(const PG8_LAS bf16x8*)(lds + PG8_SA(b, h) + aoff + m * 2048 + k * 1024); } } while (0)
#define PG8_LDB(dst, b, h) do { if constexpr (F8) { _Pragma("unroll") for (int n = 0; n < 2; ++n) { dst##8[n].lo = *(const PG8_LAS i32x4*)(lds + PG8_SB(b, h) + boff + n * 2048); dst##8[n].hi = *(const PG8_LAS i32x4*)(lds + PG8_SB(b, h) + boff + n * 2048 + 16); } } \
        else { _Pragma("unroll") for (int n = 0; n < 2; ++n) _Pragma("unroll") for (int k = 0; k < 2; ++k) dst[n][k] = *(const PG8_LAS bf16x8*)(lds + PG8_SB(b, h) + boff + n * 2048 + k * 1024); } } while (0)
#define PG8_MMA(ai, bj, At, Bt) do { __builtin_amdgcn_s_setprio(1); _Pragma("unroll") for (int m = 0; m < 4; ++m) _Pragma("unroll") for (int n = 0; n < 2; ++n) { \
        if constexpr (F8) acc[ai][bj][m][n] = __builtin_amdgcn_mfma_scale_f32_16x16x128_f8f6f4(Bt##8[n], At##8[m], acc[ai][bj][m][n], 0, 0, 0, 0x7F7F7F7F, 0, 0x7F7F7F7F); \
        else { _Pragma("unroll") for (int k = 0; k < 2; ++k) acc[ai][bj][m][n] = __builtin_amdgcn_mfma_f32_16x16x32_bf16(Bt[n][k], At[m][k], acc[ai][bj][m][n], 0, 0, 0); } } __builtin_amdgcn_s_setprio(0); } while (0)
#define PG8_WAIT_V(n) asm volatile("s_waitcnt vmcnt(" #n ")" ::: "memory")
#define PG8_WAIT_L(n) asm volatile("s_waitcnt lgkmcnt(" #n ")" ::: "memory")
#define PG8_BAR __builtin_amdgcn_s_barrier()
#define PG8_SCHED __builtin_amdgcn_sched_barrier(0)
#define PG8_AOFFS(U, o00, o01, o10, o11) do { int R0_, C0_, R1_, C1_; stage_rc(tid * 16, R0_, C0_); stage_rc(tid * 16 + 8192, R1_, C1_);     \
        o00 = S.arow(U, R0_) * (unsigned)RB + (unsigned)C0_ * 2u; o01 = S.arow(U, R1_) * (unsigned)RB + (unsigned)C1_ * 2u; \
        o10 = S.arow(U, HALF + R0_) * (unsigned)RB + (unsigned)C0_ * 2u; o11 = S.arow(U, HALF + R1_) * (unsigned)RB + (unsigned)C1_ * 2u; } while (0)
    Unit cur, nxt; int ui = 0;
    if (!S.next(0, cur)) return;
    f32x4 acc[2][2][4][2];
#pragma unroll
    for (int a = 0; a < 2; ++a)
#pragma unroll
        for (int b = 0; b < 2; ++b)
#pragma unroll
            for (int m = 0; m < 4; ++m)
#pragma unroll
                for (int n = 0; n < 2; ++n) acc[a][b][m][n] = (f32x4){0.f, 0.f, 0.f, 0.f};
    bf16x8 At[4][2], B0[2][2], B1[2][2];
    i32x8 At8[4], B08[2], B18[2];
    unsigned c00, c01, c10, c11;
    PG8_LAS u32x4* const xslot = (PG8_LAS u32x4*)(lds + xoff) + tid;
    PG8_AOFFS(cur, c00, c01, c10, c11);
    const char* const gA = (const char*)g.A;
    const char* cB = (const char*)g.Bt + (size_t)cur.e * g.bstride + (size_t)cur.pn * tstep;
    PG8_STAGEB(PG8_SB(0, 0), cB); PG8_STAGEB(PG8_SB(0, 1), cB + hstep); PG8_STAGE(PG8_SA(0, 0), gA, c00, c01); PG8_STAGE(PG8_SA(0, 1), gA, c10, c11);
    if (wr == 1) PG8_BAR;
    PG8_WAIT_V(2); PG8_BAR;
    PG8_STAGEB(PG8_SB(1, 0), cB + kstep); PG8_STAGE(PG8_SA(1, 0), gA + kstep, c00, c01); PG8_STAGEB(PG8_SB(1, 1), cB + hstep + kstep);
    PG8_WAIT_V(6); PG8_BAR;
    for (;;) {
        const bool has_next = S.next(ui + 1, nxt);
        const char* nB_ = has_next ? (const char*)g.Bt + (size_t)nxt.e * g.bstride + (size_t)nxt.pn * tstep : cB;
        const char* nB = nB_;
        if (has_next) { unsigned n00, n01, n10, n11; PG8_AOFFS(nxt, n00, n01, n10, n11); *xslot = (u32x4){n00, n01, n10, n11}; }
#pragma unroll 1
        for (int t = 0; t < nt; t += 2) {
            const bool last = (t == nt - 2);
            const char* a1 = gA + (size_t)(t + 1) * kstep;
            const char* a2 = last ? gA : gA + (size_t)(t + 2) * kstep; const char* b2 = last ? nB : cB + (size_t)(t + 2) * kstep;
            const char* a3 = a2 + kstep; const char* b3 = b2 + kstep;
            PG8_LDB(B0, 0, 0); PG8_LDB(B1, 0, 1); PG8_SCHED; PG8_LDA(At, 0, 0); PG8_STAGE(PG8_SA(1, 1), a1, c10, c11);
            if (last && has_next) { const u32x4 nx = *xslot; c00 = nx.x; c01 = nx.y; c10 = nx.z; c11 = nx.w; }
            PG8_WAIT_V(8); PG8_WAIT_L(0); PG8_BAR; PG8_MMA(0, 0, At, B0); PG8_MMA(0, 1, At, B1); PG8_BAR; PG8_SCHED;
            PG8_LDA(At, 0, 1); PG8_STAGEB(PG8_SB(0, 0), b2); PG8_STAGEB(PG8_SB(0, 1), b2 + hstep); PG8_STAGE(PG8_SA(0, 0), a2, c00, c01);
            PG8_WAIT_V(8); PG8_WAIT_L(0); PG8_BAR; PG8_MMA(1, 0, At, B0); PG8_MMA(1, 1, At, B1); PG8_BAR; PG8_SCHED;
            PG8_LDB(B0, 1, 0); PG8_LDB(B1, 1, 1); PG8_SCHED; PG8_LDA(At, 1, 0); PG8_STAGE(PG8_SA(0, 1), a2, c10, c11);
            PG8_WAIT_V(8); PG8_WAIT_L(0); PG8_BAR; PG8_MMA(0, 0, At, B0); PG8_MMA(0, 1, At, B1); PG8_BAR; PG8_SCHED;
            PG8_LDA(At, 1, 1); PG8_STAGEB(PG8_SB(1, 0), b3); PG8_STAGEB(PG8_SB(1, 1), b3 + hstep); PG8_STAGE(PG8_SA(1, 0), a3, c00, c01);
            PG8_WAIT_V(8); PG8_WAIT_L(0); PG8_BAR; PG8_MMA(1, 0, At, B0); PG8_MMA(1, 1, At, B1); PG8_BAR; PG8_SCHED;
        }
        if (wr == 0) PG8_BAR;
        E(acc, cur, wr, wc, fr, fq);
        if (!has_next) break;
#pragma unroll
        for (int a = 0; a < 2; ++a)
#pragma unroll
            for (int b = 0; b < 2; ++b)
#pragma unroll
                for (int m = 0; m < 4; ++m)
#pragma unroll
                    for (int n = 0; n < 2; ++n) acc[a][b][m][n] = (f32x4){0.f, 0.f, 0.f, 0.f};
        cur = nxt; cB = nB; ++ui;
        if (wr == 1) PG8_BAR;
    }
    PG8_WAIT_V(0);
    PG8_BAR;
#undef PG8_SA
#undef PG8_SB
#undef PG8_STAGE
#undef PG8_STAGEB
#undef PG8_LDA
#undef PG8_LDB
#undef PG8_MMA
#undef PG8_WAIT_V
#undef PG8_WAIT_L
#undef PG8_BAR
#undef PG8_SCHED
#undef PG8_AOFFS
}
}

namespace att {
typedef unsigned short bf16_t;
typedef short bf16x8 __attribute__((ext_vector_type(8)));
typedef short s16x4 __attribute__((ext_vector_type(4)));
typedef float f32x16 __attribute__((ext_vector_type(16)));
typedef float f32x4 __attribute__((ext_vector_type(4)));
typedef unsigned u32x4 __attribute__((ext_vector_type(4)));
constexpr int PITCH = 1024;
constexpr float LOG2E = 1.4426950408889634f;
__device__ __forceinline__ int crow(int r, int hi) { return (r & 3) + 8 * (r >> 2) + 4 * hi; }
typedef float f32x2_t __attribute__((ext_vector_type(2))); typedef __bf16 bf16x2_t __attribute__((ext_vector_type(2)));
__device__ __forceinline__ unsigned cvtpk(float lo, float hi) { f32x2_t v = {lo, hi}; bf16x2_t b = __builtin_convertvector(v, bf16x2_t); return __builtin_bit_cast(unsigned, b); }
__device__ __forceinline__ float bf2f(short s) { return __uint_as_float(((unsigned)(unsigned short)s) << 16); }
typedef short v4i16_t __attribute__((ext_vector_type(4)));
__device__ __forceinline__ s16x4 vtr(const LAS unsigned char* p) { return __builtin_bit_cast(s16x4, __builtin_amdgcn_ds_read_tr16_b64_v4i16((LAS v4i16_t*)p)); }
__device__ __forceinline__ float max3f(float a, float b, float c) { float r; asm("v_max3_f32 %0, %1, %2, %3" : "=v"(r) : "v"(a), "v"(b), "v"(c)); return r; }
__device__ __forceinline__ float halves_max(float m) { auto rr = __builtin_amdgcn_permlane32_swap(__float_as_uint(m), __float_as_uint(m), false, false); return fmaxf(__uint_as_float(rr[0]), __uint_as_float(rr[1])); }
__device__ __forceinline__ float halves_sum(float m) { auto rr = __builtin_amdgcn_permlane32_swap(__float_as_uint(m), __float_as_uint(m), false, false); return __uint_as_float(rr[0]) + __uint_as_float(rr[1]); }
#define ATT_BAR() asm volatile("s_waitcnt vmcnt(0) lgkmcnt(0)\n\ts_barrier" ::: "memory")
typedef unsigned u32x2 __attribute__((ext_vector_type(2)));
#define ATT_RD128(d, a, off) asm volatile("ds_read_b128 %0, %1 offset:%2" : "=v"(d) : "v"(a), "n"(off))
#define ATT_RDTR(d, a, off) asm volatile("ds_read_b64_tr_b16 %0, %1 offset:%2" : "=v"(d) : "v"(a), "n"(off))
#define ATT_WAIT2(n, x, y) asm volatile("s_waitcnt lgkmcnt(" #n ")" : "+v"(x), "+v"(y))

struct Args { const bf16_t* Q; const bf16_t* K; const bf16_t* V; bf16_t* O; const float* kmean; const float* kmax2; const float* subln; float lam_full; float out_scale; };

template <int MODE>
__device__ __forceinline__ void attn_unit(LAS unsigned char* lds, const Args& A, int b, int h, int qblk) {
    constexpr int DVB = MODE == 0 ? 4 : 2;
    constexpr int NCH = MODE == 0 ? 16 : 8;
    constexpr int KBY = NCH * 1024, VBY = DVB * 4096, SLOT = KBY + VBY;
    constexpr int QR = MODE == 0 ? 128 : 256;
    constexpr int PPW = MODE == 0 ? 2 : 1;
    int tid_ = threadIdx.x; asm volatile("" : "+v"(tid_));
    const int tid = tid_, lane = tid & 63, r32 = lane & 31, hi = lane >> 5;
    const int wid = __builtin_amdgcn_readfirstlane(tid >> 6);
    const int comp = MODE == 0 ? (wid >> 2) : 0, wq = MODE == 0 ? (wid & 3) : wid;
    const int q0 = qblk * QR; const long rowbase = (long)b * SEQ;
    const int hcol = MODE == 0 ? h * 128 : h * 64;
    const int qrel0 = wq * 32;
    const float slope2 = __builtin_amdgcn_exp2f(MODE == 0 ? -(float)(h + 1) : -0.5f * (float)(h + 1)) * LOG2E;
    const int NT = MODE == 0 ? 2 * qblk + 2 : 4 + 4 * qblk;
#define ATT_KBASE_(t) (MODE == 0 ? 64 * (t) : ((t) < 4 ? q0 + 64 * (t) : 64 * ((t) - 4)))
    LAS float* wsf = (LAS float*)(lds + 65536) + wid * 64;
    const bf16_t* Kb = A.K + rowbase * PITCH + hcol;
    const bf16_t* Vb = A.V + rowbase * PITCH + hcol;
    bf16x8 qr[4];
    { const bf16_t* Qw = A.Q + (rowbase + q0 + qrel0 + r32) * PITCH + hcol + comp * 64 + hi * 8;
#pragma unroll
      for (int d0 = 0; d0 < 4; ++d0) qr[d0] = *(const GAS bf16x8*)(Qw + d0 * 16); }
    ATT_BAR();
    LAS int* live = (LAS int*)(lds + 71680); LAS float* qnx = (LAS float*)(lds + 71680 + 272);
    { float q2 = 0.f;
#pragma unroll
      for (int d0 = 0; d0 < 4; ++d0)
#pragma unroll
        for (int j = 0; j < 8; ++j) { const float v = bf2f(qr[d0][j]); q2 += v * v; }
      q2 = halves_sum(q2);
      q2 = fmaxf(q2, __shfl_xor(q2, 1)); q2 = fmaxf(q2, __shfl_xor(q2, 2)); q2 = fmaxf(q2, __shfl_xor(q2, 4)); q2 = fmaxf(q2, __shfl_xor(q2, 8)); q2 = fmaxf(q2, __shfl_xor(q2, 16));
      if (lane == 0) qnx[wid] = q2; }
    ATT_BAR();
    if (wid == 0) {
        const int tt = lane;
        const int kbase_t = (tt < NT) ? ATT_KBASE_(tt) : 0;
        bool alive = tt < NT;
        if (alive && kbase_t + 64 <= q0) {
            const int nblk = kbase_t >> 8; float bound = -INFINITY;
            if constexpr (MODE == 0) {
#pragma unroll
                for (int c = 0; c < 2; ++c) { float qm = fmaxf(fmaxf(qnx[4 * c], qnx[4 * c + 1]), fmaxf(qnx[4 * c + 2], qnx[4 * c + 3]));
                    const float k2 = ((const GAS float*)A.kmax2)[(size_t)(b * 16 + h * 2 + c) * 16 + nblk]; bound = fmaxf(bound, sqrtf(qm) * sqrtf(k2)); }
            } else {
                float qm = qnx[0];
#pragma unroll
                for (int w = 1; w < 8; ++w) qm = fmaxf(qm, qnx[w]);
                const float k2 = ((const GAS float*)A.kmax2)[(size_t)(b * 16 + h) * 16 + nblk]; bound = sqrtf(qm) * sqrtf(k2);
            }
            alive = !(bound * 1.001f + 1.0f + slope2 * (float)(kbase_t + 63 - q0) < -152.0f);
        }
        const unsigned long long am = __ballot(alive);
        if (alive) live[__popcll(am & ((1ull << lane) - 1ull))] = tt;
        if (lane == 0) live[64] = __popcll(am);
    }
    ATT_BAR();
    const int NTL = __builtin_amdgcn_readfirstlane(live[64]);
    unsigned sel = 0u;
    if constexpr (MODE == 1) {
        LAS float* km = (LAS float*)(lds + 67584);
        for (int i = tid; i < 1024; i += 512) km[i] = ((const GAS float*)A.kmean)[(size_t)(b * 16 + h) * 1024 + i];
        ATT_BAR();
        float g[16];
#pragma unroll
        for (int n = 0; n < 16; ++n) { float s = 0.f;
            if (n < qblk) {
#pragma unroll
                for (int d0 = 0; d0 < 4; ++d0) { const f32x4 ka = *(const LAS f32x4*)(km + n * 64 + d0 * 16 + hi * 8), kb2 = *(const LAS f32x4*)(km + n * 64 + d0 * 16 + hi * 8 + 4);
                    s += bf2f(qr[d0][0]) * ka[0] + bf2f(qr[d0][1]) * ka[1] + bf2f(qr[d0][2]) * ka[2] + bf2f(qr[d0][3]) * ka[3]
                       + bf2f(qr[d0][4]) * kb2[0] + bf2f(qr[d0][5]) * kb2[1] + bf2f(qr[d0][6]) * kb2[2] + bf2f(qr[d0][7]) * kb2[3]; }
                s = halves_sum(s); }
            g[n] = s; }
        const int nsel = qblk < 3 ? qblk : 3;
#pragma unroll
        for (int k = 0; k < 3; ++k) if (k < nsel) { float best = -INFINITY; int bi = 0; bool found = false;
#pragma unroll
            for (int n = 0; n < 16; ++n) if (n < qblk) { const bool free_ = ((sel >> n) & 1u) == 0u; if (free_ && (!found || g[n] > best)) { best = g[n]; bi = n; found = true; } }
            sel |= 1u << bi; }
    }
#define ATT_KBASE(t) ATT_KBASE_(t)
#define ATT_ISSUE(t, slot) do { const int kb_ = ATT_KBASE(t); \
        _Pragma("unroll") for (int i_ = 0; i_ < PPW; ++i_) { const int p_ = wid + 8 * i_; \
            __builtin_amdgcn_global_load_lds((const GAS unsigned*)(Kb + (size_t)(kb_ + lane) * PITCH + p_ * 8), (LAS unsigned*)(lds + (slot) * SLOT + p_ * 1024), 16, 0, 0); \
            __builtin_amdgcn_global_load_lds((const GAS unsigned*)(Vb + (size_t)(kb_ + 16 * (p_ & 3) + (lane >> 2)) * PITCH + (p_ >> 2) * 32 + (lane & 3) * 8), (LAS unsigned*)(lds + (slot) * SLOT + KBY + p_ * 1024), 16, 0, 0); } } while (0)
    constexpr float THR = 8.0f;
    float mref = 0.f, l = 0.f; f32x16 o[DVB];
#pragma unroll
    for (int d0 = 0; d0 < DVB; ++d0) o[d0] = f32x16{};
#define ATT_ISSUE_K(tt, slot) do { const int kb_ = ATT_KBASE(tt); \
        _Pragma("unroll") for (int i_ = 0; i_ < PPW; ++i_) { const int p_ = wid + 8 * i_; \
            __builtin_amdgcn_global_load_lds((const GAS unsigned*)(Kb + (size_t)(kb_ + lane) * PITCH + p_ * 8), (LAS unsigned*)(lds + (slot) * SLOT + p_ * 1024), 16, 0, 0); } } while (0)
#define ATT_ISSUE_V(tt, slot) do { const int kb_ = ATT_KBASE(tt); \
        _Pragma("unroll") for (int i_ = 0; i_ < PPW; ++i_) { const int p_ = wid + 8 * i_; \
            __builtin_amdgcn_global_load_lds((const GAS unsigned*)(Vb + (size_t)(kb_ + 16 * (p_ & 3) + (lane >> 2)) * PITCH + (p_ >> 2) * 32 + (lane & 3) * 8), (LAS unsigned*)(lds + (slot) * SLOT + KBY + p_ * 1024), 16, 0, 0); } } while (0)
#define ATT_CLASS(tt, SK, NM, SB) do { const int kb_ = ATT_KBASE(tt), kr_ = kb_ - q0; const bool dg_ = kb_ >= q0; SK = dg_ && (kr_ > qrel0 + 31); NM = dg_ && (kr_ + 63 > qrel0); SB = true; \
        if constexpr (MODE == 1) { if ((tt) >= 4) { SB = ((sel >> (((tt) - 4) >> 2)) & 1u) != 0u; if (!__any(SB)) SK = true; } } } while (0)
#define ATT_QK(P0, P1, tt, slot, SB) do { const int kr_ = ATT_KBASE(tt) - q0; float off0_ = slope2 * (float)(kr_ + 4 * hi) - mref; if (!(SB)) off0_ = -INFINITY; const float off1_ = off0_ + 32.0f * slope2; \
        const unsigned ka_ = (unsigned)(size_t)(lds + (slot) * SLOT + comp * 8192 + hi * 1024 + r32 * 16); u32x4 kx_[4], ky_[4]; \
        ATT_RD128(kx_[0], ka_, 0); ATT_RD128(ky_[0], ka_, 512); ATT_RD128(kx_[1], ka_, 2048); ATT_RD128(ky_[1], ka_, 2560); \
        _Pragma("unroll") for (int r = 0; r < 16; ++r) { const float cbr = slope2 * (float)((r & 3) + 8 * (r >> 2)); P0[r] = cbr + off0_; P1[r] = cbr + off1_; } \
        ATT_WAIT2(2, kx_[0], ky_[0]); P0 = __builtin_amdgcn_mfma_f32_32x32x16_bf16(__builtin_bit_cast(bf16x8, kx_[0]), qr[0], P0, 0, 0, 0); P1 = __builtin_amdgcn_mfma_f32_32x32x16_bf16(__builtin_bit_cast(bf16x8, ky_[0]), qr[0], P1, 0, 0, 0); \
        ATT_RD128(kx_[2], ka_, 4096); ATT_RD128(ky_[2], ka_, 4608); \
        ATT_WAIT2(2, kx_[1], ky_[1]); P0 = __builtin_amdgcn_mfma_f32_32x32x16_bf16(__builtin_bit_cast(bf16x8, kx_[1]), qr[1], P0, 0, 0, 0); P1 = __builtin_amdgcn_mfma_f32_32x32x16_bf16(__builtin_bit_cast(bf16x8, ky_[1]), qr[1], P1, 0, 0, 0); \
        ATT_RD128(kx_[3], ka_, 6144); ATT_RD128(ky_[3], ka_, 6656); \
        ATT_WAIT2(2, kx_[2], ky_[2]); P0 = __builtin_amdgcn_mfma_f32_32x32x16_bf16(__builtin_bit_cast(bf16x8, kx_[2]), qr[2], P0, 0, 0, 0); P1 = __builtin_amdgcn_mfma_f32_32x32x16_bf16(__builtin_bit_cast(bf16x8, ky_[2]), qr[2], P1, 0, 0, 0); \
        ATT_WAIT2(0, kx_[3], ky_[3]); P0 = __builtin_amdgcn_mfma_f32_32x32x16_bf16(__builtin_bit_cast(bf16x8, kx_[3]), qr[3], P0, 0, 0, 0); P1 = __builtin_amdgcn_mfma_f32_32x32x16_bf16(__builtin_bit_cast(bf16x8, ky_[3]), qr[3], P1, 0, 0, 0); } while (0)
    f32x16 p0, p1, n0, n1;
    int t = __builtin_amdgcn_readfirstlane(live[0]);
    int tn = (NTL > 1) ? __builtin_amdgcn_readfirstlane(live[1]) : 0;
    bool skipC, maskC, selC, skipN = true, maskN = false, selN = true;
    ATT_ISSUE_K(t, 0); ATT_ISSUE_V(t, 0); if (NTL > 1) ATT_ISSUE_K(tn, 1);
    ATT_BAR();
    ATT_CLASS(t, skipC, maskC, selC);
    if (!skipC) ATT_QK(p0, p1, t, 0, selC);
    for (int it = 0; it < NTL; ++it) {
        ATT_BAR();
        const int tnn = (it + 2 < NTL) ? __builtin_amdgcn_readfirstlane(live[it + 2]) : 0;
        if (it + 2 < NTL) ATT_ISSUE_K(tnn, it & 1);
        if (it + 1 < NTL) { ATT_ISSUE_V(tn, (it + 1) & 1); ATT_CLASS(tn, skipN, maskN, selN); if (!skipN) ATT_QK(n0, n1, tn, (it + 1) & 1, selN); } else skipN = true;
        if (!skipC) {
            const int krel = ATT_KBASE(t) - q0;
            const unsigned va_ = (unsigned)(size_t)(lds + (it & 1) * SLOT + KBY + ((lane >> 4) & 1) * 32 + (lane & 3) * 8 + (4 * hi + ((lane & 15) >> 2)) * 64);
            u32x2 vl_[4], vh_[4];
            ATT_RDTR(vl_[0], va_, 0); ATT_RDTR(vh_[0], va_, 512); ATT_RDTR(vl_[1], va_, 1024); ATT_RDTR(vh_[1], va_, 1536);
            ATT_RDTR(vl_[2], va_, 2048); ATT_RDTR(vh_[2], va_, 2560); ATT_RDTR(vl_[3], va_, 3072); ATT_RDTR(vh_[3], va_, 3584);
            if (maskC) { const int qrel = qrel0 + r32;
#pragma unroll
                for (int r = 0; r < 16; ++r) { const int kv = krel + crow(r, hi); if (kv > qrel) p0[r] = -INFINITY; if (kv + 32 > qrel) p1[r] = -INFINITY; } }
            float rm;
            { float a_ = max3f(p0[0], p0[1], p1[0]), b_ = max3f(p0[2], p0[3], p1[1]); a_ = max3f(a_, p1[2], p1[3]);
#pragma unroll
              for (int r = 4; r < 16; r += 4) { a_ = max3f(a_, p0[r], p0[r + 1]); b_ = max3f(b_, p0[r + 2], p0[r + 3]); a_ = max3f(a_, p1[r], p1[r + 1]); b_ = max3f(b_, p1[r + 2], p1[r + 3]); }
              rm = halves_max(fmaxf(a_, b_)); }
            if (__any(rm > THR)) {
                const float dl = fmaxf(rm, 0.f); mref += dl; const float alpha = __builtin_amdgcn_exp2f(-dl);
#pragma unroll
                for (int r = 0; r < 16; ++r) { p0[r] -= dl; p1[r] -= dl; }
                if (!skipN) {
#pragma unroll
                    for (int r = 0; r < 16; ++r) { n0[r] -= dl; n1[r] -= dl; } }
                l *= alpha;
                if (hi == 0) wsf[r32] = alpha;
                asm volatile("s_waitcnt lgkmcnt(0)" ::: "memory");
#pragma unroll
                for (int gq = 0; gq < 4; ++gq) { const f32x4 f = *(const LAS f32x4*)(wsf + 8 * gq + 4 * hi);
#pragma unroll
                    for (int d0 = 0; d0 < DVB; ++d0) { o[d0][4 * gq + 0] *= f[0]; o[d0][4 * gq + 1] *= f[1]; o[d0][4 * gq + 2] *= f[2]; o[d0][4 * gq + 3] *= f[3]; } }
            }
            float sacc = 0.f;
#pragma unroll
            for (int r = 0; r < 16; ++r) { p0[r] = __builtin_amdgcn_exp2f(p0[r]); p1[r] = __builtin_amdgcn_exp2f(p1[r]); sacc += p0[r] + p1[r]; }
            l += sacc;
            u32x4 pw[4];
            pw[0] = (u32x4){cvtpk(p0[0], p0[1]), cvtpk(p0[2], p0[3]), cvtpk(p0[4], p0[5]), cvtpk(p0[6], p0[7])};
            pw[1] = (u32x4){cvtpk(p0[8], p0[9]), cvtpk(p0[10], p0[11]), cvtpk(p0[12], p0[13]), cvtpk(p0[14], p0[15])};
            pw[2] = (u32x4){cvtpk(p1[0], p1[1]), cvtpk(p1[2], p1[3]), cvtpk(p1[4], p1[5]), cvtpk(p1[6], p1[7])};
            pw[3] = (u32x4){cvtpk(p1[8], p1[9]), cvtpk(p1[10], p1[11]), cvtpk(p1[12], p1[13]), cvtpk(p1[14], p1[15])};
#pragma unroll
            for (int i = 0; i < 4 * DVB; ++i) { constexpr int NM = 4 * DVB; const int s_ = i & 3;
                if (i + 3 < NM) ATT_WAIT2(6, vl_[s_], vh_[s_]); else if (i + 3 == NM) ATT_WAIT2(4, vl_[s_], vh_[s_]); else if (i + 2 == NM) ATT_WAIT2(2, vl_[s_], vh_[s_]); else ATT_WAIT2(0, vl_[s_], vh_[s_]);
                const u32x4 vf = (u32x4){vl_[s_][0], vl_[s_][1], vh_[s_][0], vh_[s_][1]};
                o[i >> 2] = __builtin_amdgcn_mfma_f32_32x32x16_bf16(__builtin_bit_cast(bf16x8, pw[i & 3]), __builtin_bit_cast(bf16x8, vf), o[i >> 2], 0, 0, 0);
                if (i + 4 < NM) { ATT_RDTR(vl_[s_], va_, (i + 4) * 1024); ATT_RDTR(vh_[s_], va_, (i + 4) * 1024 + 512); } }
        }
        p0 = n0; p1 = n1; skipC = skipN; maskC = maskN; selC = selN; t = tn; tn = tnn;
    }
#undef ATT_ISSUE_K
#undef ATT_ISSUE_V
#undef ATT_CLASS
#undef ATT_QK
    l = halves_sum(l);
    if (hi == 0) wsf[32 + r32] = l;
    asm volatile("s_waitcnt lgkmcnt(0)" ::: "memory");
    float rli[16];
#pragma unroll
    for (int gq = 0; gq < 4; ++gq) { const f32x4 f = *(const LAS f32x4*)(wsf + 32 + 8 * gq + 4 * hi); rli[4 * gq + 0] = 1.0f / f[0]; rli[4 * gq + 1] = 1.0f / f[1]; rli[4 * gq + 2] = 1.0f / f[2]; rli[4 * gq + 3] = 1.0f / f[3]; }
    if constexpr (MODE == 1) {
        GAS bf16_t* Ow = (GAS bf16_t*)(A.O + (rowbase + q0 + qrel0) * PITCH + hcol);
#pragma unroll
        for (int r = 0; r < 16; ++r)
#pragma unroll
            for (int d0 = 0; d0 < DVB; ++d0) Ow[(size_t)crow(r, hi) * PITCH + d0 * 32 + r32] = (bf16_t)(cvtpk(o[d0][r] * rli[r], 0.f) & 0xFFFFu);
    } else {
        ATT_BAR();
        LAS float* X = (LAS float*)lds + wq * 4096;
        if (comp == 1) {
#pragma unroll
            for (int d0 = 0; d0 < DVB; ++d0)
#pragma unroll
                for (int r = 0; r < 16; ++r) X[(d0 * 16 + r) * 64 + lane] = o[d0][r] * rli[r];
        }
        ATT_BAR();
        if (comp == 0) {
            float sg[DVB];
#pragma unroll
            for (int d0 = 0; d0 < DVB; ++d0) sg[d0] = ((const GAS float*)A.subln)[d0 * 32 + r32] * A.out_scale;
            GAS bf16_t* Ow = (GAS bf16_t*)(A.O + (rowbase + q0 + qrel0) * PITCH + hcol);
#pragma unroll
            for (int r = 0; r < 16; ++r) { float dv[DVB]; float ss = 0.f;
#pragma unroll
                for (int d0 = 0; d0 < DVB; ++d0) { dv[d0] = o[d0][r] * rli[r] - A.lam_full * X[(d0 * 16 + r) * 64 + lane]; ss += dv[d0] * dv[d0]; }
                ss += __shfl_xor(ss, 1); ss += __shfl_xor(ss, 2); ss += __shfl_xor(ss, 4); ss += __shfl_xor(ss, 8); ss += __shfl_xor(ss, 16);
                const float rs = 1.0f / sqrtf(ss * (1.0f / 128.0f) + 1e-5f);
#pragma unroll
                for (int d0 = 0; d0 < DVB; ++d0) Ow[(size_t)crow(r, hi) * PITCH + d0 * 32 + r32] = (bf16_t)(cvtpk(dv[d0] * rs * sg[d0], 0.f) & 0xFFFFu); }
        }
    }
#undef ATT_KBASE
#undef ATT_KBASE_
#undef ATT_ISSUE
}
#undef ATT_BAR
}

constexpr int NWAVES = 8;
constexpr int NLAYER = 4, PH_PER_LAYER = 8, NPHASE = 1 + NLAYER * PH_PER_LAYER;

constexpr size_t MiB = 1u << 20;
constexpr size_t WS_CTL = 0, CTL_ZERO_BYTES = 1 * MiB;
constexpr size_t WS_KMEAN = 1 * MiB;
constexpr size_t WS_LTOK = 2 * MiB, WS_LW = 3 * MiB;
constexpr size_t WS_DQKV = 5 * MiB;
constexpr size_t WS_DWO = WS_DQKV + 12 * MiB;
constexpr size_t WS_MQKV = WS_DWO + 4 * MiB;
constexpr size_t WS_MWO = WS_MQKV + 12 * MiB;
constexpr size_t WS_FGU = WS_MWO + 4 * MiB;
constexpr size_t WS_FD = WS_FGU + 22 * MiB;
constexpr size_t WS_MGU = WS_FD + 11 * MiB;
constexpr size_t WS_MD = WS_MGU + 112 * MiB;
constexpr size_t WS_XN = WS_MD + 56 * MiB;
constexpr size_t WS_Q = WS_XN + 64 * MiB, WS_K = WS_Q + 64 * MiB, WS_V = WS_K + 64 * MiB;
constexpr size_t WS_ACT = WS_Q;
constexpr size_t WS_END = WS_ACT + (size_t)MOE_TILES_MAX * 256 * DE * 2;
static_assert(WS_XN == 238 * MiB && WS_END == 778 * MiB, "d_ws map");
constexpr int CW_BAR = 4096;
constexpr int CW_ATTQ = 6144;
constexpr int CW_ATTQ2 = 12288;
constexpr int CW_CNT = 8192;

constexpr int RING_OFF = 0, RING_BYTES = 131072;
constexpr int LDSCTL_OFF = RING_BYTES, MISC_OFF = LDSCTL_OFF + 320;
constexpr int XSLOT_OFF = MISC_OFF + 128;
constexpr int LDS_BYTES = 147456;

typedef unsigned short bf16;
typedef unsigned v4u __attribute__((ext_vector_type(4)));
typedef float f32x4 __attribute__((ext_vector_type(4)));
typedef GAS unsigned gu32;
#define RLX_AGENT __ATOMIC_RELAXED, __HIP_MEMORY_SCOPE_AGENT
#define LDS_WAIT() asm volatile("s_waitcnt lgkmcnt(0)" ::: "memory")
#define VM_WAIT() asm volatile("s_waitcnt vmcnt(0)" ::: "memory")
__device__ __forceinline__ unsigned f2bf(float f) { unsigned u = __builtin_bit_cast(unsigned, f); return (u + 0x7fffu + ((u >> 16) & 1u)) >> 16; }
__device__ __forceinline__ unsigned pk2(float lo, float hi) { return f2bf(lo) | (f2bf(hi) << 16); }
__device__ __forceinline__ float bflo(unsigned w) { return __uint_as_float(w << 16); }
__device__ __forceinline__ float bfhi(unsigned w) { return __uint_as_float(w & 0xFFFF0000u); }
static_assert(XSLOT_OFF % 16 == 0 && XSLOT_OFF + 8192 <= LDS_BYTES, "LDS map");
#define XB_TMO      128
#define XB_XCNT(j)  (256  + 64 * (j))
#define XB_XSUB(j)  (1280 + 64 * (j))
#define XB_XGEN(j)  (2304 + 64 * (j))
#define XB_TOP      3328
#define XB_TOPGEN   3392
#define XCD_BAR_WORDS 3456
#define XB_SPIN_CAP (1u << 18)

__device__ __forceinline__ unsigned xb_ld(unsigned* p)              { return __hip_atomic_load(p, __ATOMIC_RELAXED, __HIP_MEMORY_SCOPE_AGENT); }
__device__ __forceinline__ unsigned xb_add(unsigned* p, unsigned v) { return __hip_atomic_fetch_add(p, v, __ATOMIC_RELAXED, __HIP_MEMORY_SCOPE_AGENT); }
__device__ __forceinline__ unsigned xb_xcc_id() { return (unsigned)__builtin_amdgcn_s_getreg((3 << 11) | 20) & 0xFu; }
#define XB_SPIN(cond, bar) do { unsigned _sp = 0; while (cond) { __builtin_amdgcn_s_sleep(1); \
    if ((++_sp & 255u) == 0u) { if (xb_ld(&(bar)[XB_TMO])) break; if (_sp > XB_SPIN_CAP) { atomicAdd(&(bar)[XB_TMO], 1u); break; } } } } while (0)

struct XcdBarrier {
    unsigned* bar; unsigned x;
    volatile LAS unsigned* st;
};

__device__ __forceinline__ XcdBarrier xcd_barrier_post(unsigned* bar, volatile LAS unsigned* st) {
    XcdBarrier b; b.bar = bar; b.x = xb_xcc_id(); b.st = st;
    if (threadIdx.x == 0) (void)xb_add(&bar[XB_XCNT(b.x)], 1u);
    return b;
}
__device__ __forceinline__ void xcd_barrier_complete(unsigned* bar, unsigned x, unsigned& nloc, unsigned& nx) {
    const unsigned G = gridDim.x * gridDim.y * gridDim.z;
    unsigned sum, cnt, mine, sp = 0u;
    for (;;) {
        sum = 0u; cnt = 0u; mine = 0u;
#pragma unroll
        for (unsigned j = 0; j < 16; ++j) { const unsigned c = xb_ld(&bar[XB_XCNT(j)]); sum += c; cnt += (c > 0u) ? 1u : 0u; mine = (j == x) ? c : mine; }
        if (sum == G) break;
        __builtin_amdgcn_s_sleep(1);
        if ((++sp & 255u) == 0u) { if (xb_ld(&bar[XB_TMO])) break; if (sp > XB_SPIN_CAP) { atomicAdd(&bar[XB_TMO], 1u); break; } }
    }
    nloc = mine > 0u ? mine : 1u; nx = cnt > 0u ? cnt : 1u;
}

__device__ __forceinline__ void xcd_barrier(const XcdBarrier& b) {
    asm volatile("s_waitcnt vmcnt(0)" ::: "memory");
    __syncthreads();
    if (threadIdx.x == 0) {
        unsigned* bar = b.bar;
        __builtin_amdgcn_s_waitcnt(0);
        unsigned nloc = b.st[0], nx = b.st[1];
        if (nloc == 0u) { xcd_barrier_complete(bar, b.x, nloc, nx); b.st[0] = nloc; b.st[1] = nx; }
        const unsigned old = xb_add(&bar[XB_XSUB(b.x)], 1u);
        const unsigned gen = old / nloc;
        if (old + 1u == (gen + 1u) * nloc) {
            __builtin_amdgcn_fence(__ATOMIC_RELEASE, "agent");
            asm volatile("s_waitcnt vmcnt(0)" ::: "memory");
            const unsigned og = xb_add(&bar[XB_TOP], 1u);
            const unsigned tg = og / nx;
            if (og + 1u == (tg + 1u) * nx) xb_add(&bar[XB_TOPGEN], 1u);
            else XB_SPIN(xb_ld(&bar[XB_TOPGEN]) == tg, bar);
            __builtin_amdgcn_fence(__ATOMIC_ACQUIRE, "agent");
            xb_add(&bar[XB_XGEN(b.x)], 1u);
            asm volatile("s_waitcnt vmcnt(0)" ::: "memory");
        } else {
            XB_SPIN(xb_ld(&bar[XB_XGEN(b.x)]) == gen, bar);
            __builtin_amdgcn_fence(__ATOMIC_ACQUIRE, "agent");
            asm volatile("s_waitcnt vmcnt(0)" ::: "memory");
        }
    }
    __syncthreads();
}

struct Frame {
    LAS unsigned char* lds;
    volatile LAS unsigned* MISC;
    gu32* ctl;
    int tid, lane, wave;
    int vcu, G;
};
__device__ __forceinline__ float wave_sum(float v) {
#pragma unroll
    for (int o = 1; o < 64; o <<= 1) v += __shfl_xor(v, o);
    return v;
}
__device__ __forceinline__ void transpose_item(const float* W, int K, int N, void* WT, int k0, int n0, int drow0, LAS float* scr, int lane, bool f8, float wscale) {
    const GAS float* src = (const GAS float*)W + (size_t)k0 * N + n0 + lane;
#pragma unroll
    for (int hb = 0; hb < 2; ++hb) { float v[32];
#pragma unroll
        for (int i = 0; i < 32; ++i) v[i] = src[(size_t)(hb * 32 + i) * N];
#pragma unroll
        for (int i = 0; i < 32; ++i) { const int kk = hb * 32 + i; scr[kk * 64 + (lane ^ ((kk >> 3) << 3))] = v[i]; } }
    LDS_WAIT(); asm volatile("" ::: "memory");
    if (f8) {
        const int c = lane & 3;
#pragma unroll
        for (int j = 0; j < 4; ++j) { const int nn = (lane >> 2) + 16 * j; float v[16];
#pragma unroll
            for (int q = 0; q < 16; ++q) { const int kk = 16 * c + q; v[q] = scr[kk * 64 + (nn ^ ((kk >> 3) << 3))] * wscale; }
            v4u o; o.x = pg8::pk4_fp8(v[0], v[1], v[2], v[3]); o.y = pg8::pk4_fp8(v[4], v[5], v[6], v[7]); o.z = pg8::pk4_fp8(v[8], v[9], v[10], v[11]); o.w = pg8::pk4_fp8(v[12], v[13], v[14], v[15]);
            *(GAS v4u*)((unsigned char*)WT + (size_t)(drow0 + nn) * K + k0 + 16 * c) = o; }
    } else {
    const int c = lane & 7;
#pragma unroll
    for (int j = 0; j < 8; ++j) { const int n = (lane >> 3) + 8 * j; const LAS float* s = scr + (8 * c) * 64 + (n ^ (c << 3));
        v4u o; o.x = pk2(s[0 * 64], s[1 * 64]); o.y = pk2(s[2 * 64], s[3 * 64]); o.z = pk2(s[4 * 64], s[5 * 64]); o.w = pk2(s[6 * 64], s[7 * 64]);
        *(GAS v4u*)((bf16*)WT + (size_t)(drow0 + n) * K + k0 + 8 * c) = o; }
    }
    LDS_WAIT(); asm volatile("" ::: "memory");
}
__device__ __forceinline__ void convert_matrix(Frame& F, const float* W, int K, int N, void* WT, int il, unsigned& rot, bool f8 = false, float wscale = 1.0f) {
    LAS float* scr = (LAS float*)(F.lds + RING_OFF + F.wave * 16384);
    const unsigned gw = (unsigned)(F.vcu * NWAVES + F.wave), NGW = (unsigned)(F.G * NWAVES);
    const int nblk = N / 64, nitems = (K / 64) * nblk; int lane_ = F.lane; asm volatile("" : "+v"(lane_));
    for (int it = (int)((gw + NGW - rot % NGW) % NGW); it < nitems; it += (int)NGW) {
        const int kb = it / nblk, nb = it % nblk, n0 = 64 * nb;
        const int drow0 = il == 0 ? n0 : (n0 / 128) * 256 + (il - 1) * 128 + (n0 % 128);
        transpose_item(W, K, N, WT, 64 * kb, n0, drow0, scr, lane_, f8, wscale);
    }
    rot = (rot + (unsigned)nitems) % NGW;
}

struct RouterArgs { const float* router; gu32* cnt; unsigned* ltok; float* lw; };
template <int MODE, bool F8X = false>
__device__ __forceinline__ void norm_phase(Frame& F, const float* src, float* hout, const bf16* y1, const float* gain, bf16* xn, float* fout, const RouterArgs& R) {
    int lane_ = F.lane; asm volatile("" : "+v"(lane_));
    const int gw = F.vcu * NWAVES + F.wave, NGW = F.G * NWAVES, lane = lane_;
    f32x4 gv[4];
#pragma unroll
    for (int j = 0; j < 4; ++j) gv[j] = *(const GAS f32x4*)(gain + 256 * j + 4 * lane);
    LAS float* RL = (LAS float*)(F.lds + RING_OFF);
    if constexpr (MODE == 2) {
        int tid_ = F.tid; asm volatile("" : "+v"(tid_));
        for (int i = tid_; i < 8192; i += NWAVES * 64) RL[(i & 7) * 1024 + (i >> 3)] = ((const GAS float*)R.router)[i];
        LDS_WAIT(); __syncthreads();
    }
    const int nrows_w = gw < MTOK ? (MTOK - gw + NGW - 1) / NGW : 0;
    for (int cb = 0; cb < nrows_w; cb += 64) {
        int my_t = 0, my_e0 = 0, my_e1 = 0; float my_w0 = 0.f, my_w1 = 0.f; bool valid = false;
        const int cn = (nrows_w - cb) < 64 ? (nrows_w - cb) : 64;
        f32x4 vn[4]; unsigned long long yn[4];
        { const int row0_ = gw + cb * NGW; const GAS f32x4* xr = (const GAS f32x4*)(src + (size_t)row0_ * D) + lane;
#pragma unroll
          for (int j = 0; j < 4; ++j) vn[j] = xr[64 * j];
          if constexpr (MODE == 1 || MODE == 3) { const GAS unsigned long long* yr = (const GAS unsigned long long*)(y1 + (size_t)row0_ * D) + lane;
#pragma unroll
            for (int j = 0; j < 4; ++j) yn[j] = yr[64 * j]; } }
        for (int i = 0; i < cn; ++i) {
            const int row = gw + (cb + i) * NGW;
            f32x4 v[4]; float s = 0.f;
#pragma unroll
            for (int j = 0; j < 4; ++j) v[j] = vn[j];
            if constexpr (MODE == 1 || MODE == 3) {
#pragma unroll
                for (int j = 0; j < 4; ++j) { const unsigned long long w = yn[j]; const unsigned lo = (unsigned)w, hi = (unsigned)(w >> 32);
                    v[j].x += bflo(lo); v[j].y += bfhi(lo); v[j].z += bflo(hi); v[j].w += bfhi(hi); }
            }
            if (i + 1 < cn) { const int rown = row + NGW; const GAS f32x4* xr = (const GAS f32x4*)(src + (size_t)rown * D) + lane;
#pragma unroll
                for (int j = 0; j < 4; ++j) vn[j] = xr[64 * j];
                if constexpr (MODE == 1 || MODE == 3) { const GAS unsigned long long* yr = (const GAS unsigned long long*)(y1 + (size_t)rown * D) + lane;
#pragma unroll
                    for (int j = 0; j < 4; ++j) yn[j] = yr[64 * j]; } }
#pragma unroll
            for (int j = 0; j < 4; ++j) s += (v[j].x * v[j].x + v[j].y * v[j].y) + (v[j].z * v[j].z + v[j].w * v[j].w);
            if constexpr (MODE == 1) { GAS f32x4* hr = (GAS f32x4*)(hout + (size_t)row * D) + lane;
#pragma unroll
                for (int j = 0; j < 4; ++j) hr[64 * j] = v[j]; }
            const float rstd = 1.f / sqrtf(wave_sum(s) * (1.f / D) + 1e-6f);
#pragma unroll
            for (int j = 0; j < 4; ++j) v[j] = v[j] * rstd * gv[j];
            if constexpr (MODE == 3) { GAS f32x4* orow = (GAS f32x4*)(fout + (size_t)row * D) + lane;
#pragma unroll
                for (int j = 0; j < 4; ++j) orow[64 * j] = v[j];
            } else {
                if constexpr (F8X) { GAS unsigned* o4 = (GAS unsigned*)((unsigned char*)xn + (size_t)row * D) + lane;
#pragma unroll
                    for (int j = 0; j < 4; ++j) o4[64 * j] = pg8::pk4_fp8(v[j].x, v[j].y, v[j].z, v[j].w);
                } else { GAS unsigned long long* o8 = (GAS unsigned long long*)(xn + (size_t)row * D) + lane;
#pragma unroll
                    for (int j = 0; j < 4; ++j) o8[64 * j] = (unsigned long long)pk2(v[j].x, v[j].y) | ((unsigned long long)pk2(v[j].z, v[j].w) << 32); }
            }
            if constexpr (MODE == 2) {
                float lg[NE];
#pragma unroll
                for (int e = 0; e < NE; ++e) { float a = 0.f;
#pragma unroll
                    for (int j = 0; j < 4; ++j) { const f32x4 rr = *(const LAS f32x4*)(RL + e * 1024 + 256 * j + 4 * lane); a += (v[j].x * rr.x + v[j].y * rr.y) + (v[j].z * rr.z + v[j].w * rr.w); }
                    lg[e] = wave_sum(a); }
                int e0 = 0; float v0 = lg[0];
#pragma unroll
                for (int e = 1; e < NE; ++e) if (lg[e] > v0) { v0 = lg[e]; e0 = e; }
                int e1 = -1; float v1 = 0.f;
#pragma unroll
                for (int e = 0; e < NE; ++e) if (e != e0 && (e1 < 0 || lg[e] > v1)) { v1 = lg[e]; e1 = e; }
                const float w0 = 1.f / (1.f + __expf(v1 - v0));
                if (lane == i) { my_t = row; my_e0 = e0; my_e1 = e1; my_w0 = w0; my_w1 = 1.f - w0; valid = true; }
            }
        }
        if constexpr (MODE == 2) {
            unsigned myc = 0u;
#pragma unroll
            for (int e = 0; e < NE; ++e) { const unsigned long long b0 = __ballot(valid && my_e0 == e), b1 = __ballot(valid && my_e1 == e);
                const unsigned c = (unsigned)(__popcll(b0) + __popcll(b1)); if (lane == e) myc = c; }
            unsigned basev = 0u;
            if (lane < NE) basev = __hip_atomic_fetch_add(R.cnt + 64 * lane, myc, RLX_AGENT);
            const unsigned long long lt = (1ull << lane) - 1ull;
            unsigned pos0 = 0u, pos1 = 0u;
#pragma unroll
            for (int e = 0; e < NE; ++e) { const unsigned long long b0 = __ballot(valid && my_e0 == e), b1 = __ballot(valid && my_e1 == e);
                const unsigned be = (unsigned)__shfl((int)basev, e);
                if (my_e0 == e) pos0 = be + (unsigned)__popcll(b0 & lt);
                if (my_e1 == e) pos1 = be + (unsigned)__popcll(b0) + (unsigned)__popcll(b1 & lt); }
            if (valid) {
                ((GAS unsigned*)R.ltok)[(size_t)my_e0 * LIST_CAP + pos0] = (unsigned)my_t;             ((GAS float*)R.lw)[(size_t)my_e0 * LIST_CAP + pos0] = my_w0;
                ((GAS unsigned*)R.ltok)[(size_t)my_e1 * LIST_CAP + pos1] = (unsigned)my_t | (1u << 20); ((GAS float*)R.lw)[(size_t)my_e1 * LIST_CAP + pos1] = my_w1;
            }
        }
    }
    if constexpr (MODE == 2) { LDS_WAIT(); __syncthreads(); }
}

__device__ __forceinline__ void kstat_phase(Frame& F, const bf16* Kt, float* kmean, float* kmax2) {
    int lane_ = F.lane; asm volatile("" : "+v"(lane_));
    const int gw = F.vcu * NWAVES + F.wave, NGW = F.G * NWAVES, lane = lane_;
    for (int task = gw; task < BATCH * 16 * 8; task += NGW) {
        const int c8 = task & 7, n = (task >> 3) & 15, b = task >> 7;
        const GAS unsigned* p = (const GAS unsigned*)(Kt + ((size_t)b * SEQ + 256 * n) * D + c8 * 128) + lane;
        float a0 = 0.f, a1 = 0.f, mx = 0.f;
#pragma unroll 32
        for (int r = 0; r < 256; ++r) { const unsigned w = p[(size_t)r * (D / 2)]; const float v0 = bflo(w), v1 = bfhi(w); a0 += v0; a1 += v1;
            float s = v0 * v0 + v1 * v1; s += __shfl_xor(s, 1); s += __shfl_xor(s, 2); s += __shfl_xor(s, 4); s += __shfl_xor(s, 8); s += __shfl_xor(s, 16); mx = fmaxf(mx, s); }
        const int col = c8 * 128 + 2 * lane, hh = col >> 6, d = col & 63;
        GAS float* o = (GAS float*)(kmean + ((size_t)(b * 16 + hh) * 16 + n) * 64 + d);
        o[0] = a0 * (1.f / 256.f); o[1] = a1 * (1.f / 256.f);
        if ((lane & 31) == 0) ((GAS float*)kmax2)[(size_t)(b * 16 + hh) * 16 + n] = mx;
    }
}

struct KArgs { const float* in[17]; float* out; unsigned char* ws; int ph_lo, ph_hi; };
struct ConvDesc { const float* W; int K, N; unsigned char* WT; int il; bool f8; float sc; };
constexpr int NCONV = 61, CONV_CH = 128;
__device__ __forceinline__ ConvDesc conv_desc(const KArgs& args, unsigned char* ws, int m) {
    constexpr float WSC_UP = 32.0f, WSC_DN = 64.0f;
    ConvDesc d; d.il = 0; d.f8 = false; d.sc = 1.0f;
    if (m < 2) { d.W = args.in[7] + (size_t)m * D * 3 * D; d.K = D; d.N = 3 * D; d.WT = ws + WS_MQKV + (size_t)m * 3 * D * D * 2; }
    else if (m < 4) { const int j = m - 2; d.W = args.in[8] + (size_t)j * D * D; d.K = D; d.N = D; d.WT = ws + WS_MWO + (size_t)j * D * D * 2; }
    else if (m == 4) { d.W = args.in[4]; d.K = D; d.N = D; d.WT = ws + WS_DWO; }
    else if (m == 5) { d.W = args.in[3] + (size_t)D * 3 * D; d.K = D; d.N = 3 * D; d.WT = ws + WS_DQKV + (size_t)3 * D * D * 2; }
    else if (m == 6) { d.W = args.in[4] + (size_t)D * D; d.K = D; d.N = D; d.WT = ws + WS_DWO + (size_t)D * D * 2; }
    else if (m < 13) { const int r = m - 7, j = r / 3, t = r % 3; d.f8 = (j == 1);
        if (t < 2) { d.W = args.in[9 + t] + (size_t)j * D * DFF; d.K = D; d.N = DFF; d.WT = ws + WS_FGU + (size_t)j * 2 * DFF * D * 2; d.il = 1 + t; d.sc = d.f8 ? WSC_UP : 1.0f; }
        else { d.W = args.in[11] + (size_t)j * DFF * D; d.K = DFF; d.N = D; d.WT = ws + WS_FD + (size_t)j * D * DFF * 2; d.sc = d.f8 ? WSC_DN : 1.0f; } }
    else { const int r = m - 13, e = r / 3, t = r % 3; d.f8 = true;
        if (t < 2) { d.W = args.in[13 + t] + (size_t)e * D * DE; d.K = D; d.N = DE; d.WT = ws + WS_MGU + (size_t)e * 2 * DE * D; d.il = 1 + t; d.sc = WSC_UP; }
        else { d.W = args.in[15] + (size_t)e * DE * D; d.K = DE; d.N = D; d.WT = ws + WS_MD + (size_t)e * D * DE; d.sc = WSC_DN; } }
    return d;
}
__device__ __forceinline__ int conv_chunks_of(int m) { const int items = m < 2 || m == 5 ? 768 : (m < 7 ? 256 : (m < 13 ? 704 : 896)); return (items + CONV_CH - 1) / CONV_CH; }
__device__ __forceinline__ int conv_total_chunks() { int s = 0; for (int m = 0; m < NCONV; ++m) s += conv_chunks_of(m); return s; }
__device__ __forceinline__ void conv_chunk(Frame& F, const KArgs& args, unsigned char* ws, int c) {
    int m = 0; for (; m < NCONV; ++m) { const int n = conv_chunks_of(m); if (c < n) break; c -= n; }
    const ConvDesc d = conv_desc(args, ws, m);
    LAS float* scr = (LAS float*)(F.lds + RING_OFF + F.wave * 16384);
    int lane_ = F.lane; asm volatile("" : "+v"(lane_));
    const int nblk = d.N / 64, nitems = (d.K / 64) * nblk, last = (c + 1) * CONV_CH < nitems ? (c + 1) * CONV_CH : nitems;
    for (int it = c * CONV_CH + F.wave; it < last; it += NWAVES) {
        const int kb = it / nblk, nb = it % nblk, n0 = 64 * nb;
        const int drow0 = d.il == 0 ? n0 : (n0 / 128) * 256 + (d.il - 1) * 128 + (n0 % 128);
        transpose_item(d.W, d.K, d.N, d.WT, 64 * kb, n0, drow0, scr, lane_, d.f8, d.sc);
    }
}

__global__ void __launch_bounds__(NWAVES * 64, 2) trunk_fwd(KArgs args) {
    extern __shared__ __attribute__((aligned(16))) unsigned char lds[];
    Frame F;
    F.lds = (LAS unsigned char*)lds;
    F.MISC = (volatile LAS unsigned*)(F.lds + MISC_OFF);
    F.tid = threadIdx.x; F.lane = F.tid & 63; F.wave = __builtin_amdgcn_readfirstlane(F.tid >> 6);
    F.G = gridDim.x; { const int bx = blockIdx.x; F.vcu = (F.G % 8 == 0) ? (bx % 8) * (F.G / 8) + bx / 8 : bx; }
    F.ctl = (gu32*)(args.ws + WS_CTL);
    for (int u = F.tid; u < (LDS_BYTES - LDSCTL_OFF) / 4; u += NWAVES * 64) ((LAS unsigned*)(F.lds + LDSCTL_OFF))[u] = 0u;
    __syncthreads();
    Frame& F0 = F;
    const int lo = args.ph_lo, hi = args.ph_hi;
    XcdBarrier bar; bar.bar = (unsigned*)(F.ctl + CW_BAR); bar.x = 0; bar.st = nullptr;
    if (hi - lo > 1) bar = xcd_barrier_post((unsigned*)(F.ctl + CW_BAR), F.MISC + 8);
#define IN(k) (lo <= (k) && (k) < hi)
#ifndef PH_ENABLE
#define PH_ENABLE 0xFFFFFFFFu
#endif
#define PHEN(n) (((PH_ENABLE) >> (n)) & 1u)
#ifndef MK_DOUBLE
#define MK_DOUBLE 0u
#endif
#define NREP(n) ((((MK_DOUBLE) >> (n)) & 1u) ? 2 : 1)
#if defined(NO_OPQ)
#define OPQ(p) do {} while (0)
#else
#define OPQ(p) asm volatile("" : "+s"(p))
#endif
#if 0
#define STAMP(k) do { if (blockIdx.x == 0 && threadIdx.x == 0) { const unsigned long long t_ = __builtin_amdgcn_s_memrealtime(); ((GAS unsigned*)(F0.ctl))[3000 + (k)] = (unsigned)t_; } } while (0)
#else
#define STAMP(k) do {} while (0)
#endif
#define SEAM(k) do { if (IN(k) && IN((k) + 1)) { XcdBarrier b2_ = bar; OPQ(b2_.bar); xcd_barrier(b2_); } STAMP((k) + 1); } while (0)

#define PTRS() unsigned char* ws = args.ws; OPQ(ws); const float* x = args.in[0]; OPQ(x); const float* norm_mix = args.in[1]; OPQ(norm_mix); const float* norm_ffn = args.in[2]; OPQ(norm_ffn); \
    float* h = args.out; OPQ(h); \
    bf16* XN = (bf16*)(ws + WS_XN); bf16* Qb = (bf16*)(ws + WS_Q); bf16* Kb = (bf16*)(ws + WS_K); bf16* Vb = (bf16*)(ws + WS_V); bf16* ACT = (bf16*)(ws + WS_ACT); \
    bf16* MGU = (bf16*)(ws + WS_MGU); bf16* MD = (bf16*)(ws + WS_MD); \
    float* kmean = (float*)(ws + WS_KMEAN); unsigned* ltok = (unsigned*)(ws + WS_LTOK); float* lw = (float*)(ws + WS_LW); \
    (void)x; (void)norm_mix; (void)norm_ffn; (void)h; (void)XN; (void)Qb; (void)Kb; (void)Vb; (void)ACT; (void)MGU; (void)MD; (void)kmean; (void)ltok; (void)lw
    const RouterArgs noR{nullptr, nullptr, nullptr, nullptr};
#ifndef MK_F8_DENSE
#define MK_F8_DENSE 0
#endif
    constexpr bool F8_DENSE = MK_F8_DENSE != 0; constexpr int DESZ = F8_DENSE ? 1 : 2;
    constexpr float WSC_UP = 32.0f, WSC_DN = 64.0f;
    constexpr float C2 = 0.125f * 1.4426950408889634f;

    STAMP(0);
    if (PHEN(0) && IN(0)) {
        PTRS();
        { unsigned rot = 0u;
        convert_matrix(F, args.in[3], D, 3 * D, ws + WS_DQKV, 0, rot);
        norm_phase<0>(F, x, nullptr, nullptr, norm_mix, XN, nullptr, noR);
        }
    }
    SEAM(0);

    for (int L = 0; L < NLAYER; ++L) {
        const int j = L >> 1, moba = L & 1, pb = 1 + PH_PER_LAYER * L;
        int z_ = 0;
#if !defined(NO_OPQ_Z)
        asm volatile("" : "+s"(z_));
#endif
        Frame Fl = F0; Fl.G += z_; Fl.vcu += z_; Fl.wave += z_; Fl.lds += z_; Fl.ctl += z_; const int bx = (int)blockIdx.x + z_;
#define F Fl
        if (PHEN(1) && IN(pb + 0)) {
            PTRS();

            const bf16* W = (const bf16*)(ws + (moba ? WS_MQKV : WS_DQKV)) + (size_t)j * 3 * D * D;
            pg8::Gemm g{XN, W, 2 * D, 0}; pg8::StaticOrder S; S.init(MTOK, 3 * D, F.G, bx);
            pg8::EpiQKV E{Qb, D, D, (size_t)(WS_K - WS_Q) / 2, C2};
            for (int rep_ = 0; rep_ < NREP(1); ++rep_) pg8::gemm_phase<pg8::EpiQKV, pg8::StaticOrder>(F.lds + RING_OFF, XSLOT_OFF, g, S, E);
        }
        SEAM(pb + 0);
        { if (PHEN(2) && IN(pb + 1)) { PTRS(); kstat_phase(F, Kb, kmean, kmean + 8 * 16 * 16 * 64); } SEAM(pb + 1); }
        if (IN(pb + 2)) {
            PTRS();
            att::Args A; A.Q = Qb; A.K = Kb; A.V = Vb; A.O = XN; A.kmean = kmean; A.kmax2 = kmean + 8 * 16 * 16 * 64; A.subln = args.in[6] + (size_t)j * 128; A.lam_full = 0.f; A.out_scale = 1.f;
            LAS int* qw;
            if (!moba) {
                const float* lam = args.in[5] + (size_t)j * 256; int lane = F.lane; asm volatile("" : "+v"(lane));
                const GAS float* lamg = (const GAS float*)lam; const float s1 = wave_sum(lamg[lane] * lamg[64 + lane]), s2 = wave_sum(lamg[128 + lane] * lamg[192 + lane]);
                const float lam_init = (L == 0) ? 0.2f : 0.47071302f;
                A.lam_full = __uint_as_float(__builtin_amdgcn_readfirstlane(__float_as_uint(__expf(s1) - __expf(s2) + lam_init))); A.out_scale = __uint_as_float(__builtin_amdgcn_readfirstlane(__float_as_uint(1.0f - lam_init)));
            }
            const int nconv = (L == 0) ? conv_total_chunks() : 0;
            qw = (LAS int*)(F.lds + XSLOT_OFF);
            const int xme = (int)(xb_xcc_id() & 7u);
            if ((PHEN(3) && !moba) || (PHEN(4) && moba)) for (int qi = 0; qi < 8; ++qi) {
                const int xq = (xme + qi) & 7, ncx = nconv ? ((nconv - xq + 7) >> 3) : 0;
                gu32* qx = F.ctl + CW_ATTQ2 + 256 * L + 32 * xq;
                for (;;) {
                    if (F.tid == 0) *qw = (int)__hip_atomic_fetch_add(qx, 1u, RLX_AGENT);
                    asm volatile("s_waitcnt vmcnt(0) lgkmcnt(0)\n\ts_barrier" ::: "memory");
                    int idx = __builtin_amdgcn_readfirstlane(*qw);
                    if (idx >= 128 + ncx) { asm volatile("s_waitcnt vmcnt(0) lgkmcnt(0)\n\ts_barrier" ::: "memory"); break; }
                    if (ncx) { const int q3 = idx / 3; if (idx < 3 * ncx) { if (idx - 3 * q3 == 2) { conv_chunk(F, args, ws, xq + 8 * q3); asm volatile("s_waitcnt vmcnt(0) lgkmcnt(0)\n\ts_barrier" ::: "memory"); continue; } idx -= q3; } else idx -= ncx; }
                    if (!moba) { const int hh = 7 - (idx >> 4), pr = idx & 15;
                        att::attn_unit<0>(F.lds + RING_OFF, A, xq, hh, pr);
                        att::attn_unit<0>(F.lds + RING_OFF, A, xq, hh, 31 - pr);
                    } else { const int hh = 15 - (idx >> 3), pr = idx & 7;
                        att::attn_unit<1>(F.lds + RING_OFF, A, xq, hh, pr);
                        att::attn_unit<1>(F.lds + RING_OFF, A, xq, hh, 15 - pr); }
                }
            }
            asm volatile("s_waitcnt vmcnt(0) lgkmcnt(0)\n\ts_barrier" ::: "memory");
        }
        SEAM(pb + 2);
        if (PHEN(5) && IN(pb + 3)) {
            PTRS();
            const bf16* W = (const bf16*)(ws + (moba ? WS_MWO : WS_DWO)) + (size_t)j * D * D;
            pg8::Gemm g{XN, W, 2 * D, 0}; pg8::StaticOrder S; S.init(MTOK, D, F.G, bx);
            pg8::EpiRes E{L == 0 ? x : h, h, D, 1.0f};
            pg8::gemm_phase<pg8::EpiRes, pg8::StaticOrder>(F.lds + RING_OFF, XSLOT_OFF, g, S, E);
        }
        SEAM(pb + 3);
        if (PHEN(6) && IN(pb + 4)) {
            PTRS();
            if (!moba) {
                if (L == 2) norm_phase<0, true>(F, h, nullptr, nullptr, norm_ffn + (size_t)L * D, XN, nullptr, noR);
                else norm_phase<0, false>(F, h, nullptr, nullptr, norm_ffn + (size_t)L * D, XN, nullptr, noR);
            } else {
                const RouterArgs R{args.in[12] + (size_t)j * D * NE, F.ctl + CW_CNT + 64 * NE * j, ltok, lw};
                norm_phase<2, true>(F, h, nullptr, nullptr, norm_ffn + (size_t)L * D, XN, nullptr, R);
            }
        }
        SEAM(pb + 4);
        if (IN(pb + 5)) {
            PTRS();
            if (PHEN(7) && !moba) {
                if (L == 2) { pg8::Gemm g{XN, ws + WS_FGU + (size_t)j * 2 * DFF * D * 2, D, 0}; pg8::StaticOrder S; S.init(MTOK, 2 * DFF, F.G, bx);
                    pg8::EpiSwiGLU<true> E{ACT, DFF, 1.0f / WSC_UP};
                    pg8::gemm_phase<pg8::EpiSwiGLU<true>, pg8::StaticOrder, true>(F.lds + RING_OFF, XSLOT_OFF, g, S, E);
                } else { pg8::Gemm g{XN, ws + WS_FGU + (size_t)j * 2 * DFF * D * 2, 2 * D, 0}; pg8::StaticOrder S; S.init(MTOK, 2 * DFF, F.G, bx);
                    pg8::EpiSwiGLU<false> E{ACT, DFF, 1.0f};
                    pg8::gemm_phase<pg8::EpiSwiGLU<false>, pg8::StaticOrder, false>(F.lds + RING_OFF, XSLOT_OFF, g, S, E); }
            } else if (PHEN(8) && moba) {
                pg8::Gemm g{XN, ws + WS_MGU + (size_t)j * NE * 2 * DE * D, D, (size_t)2 * DE * D}; pg8::MoeOrder S; S.init((const unsigned*)(F.ctl + CW_CNT + 64 * NE * j), ltok, true, 2 * DE, F.G, bx);
                pg8::EpiSwiGLU<true> E{ACT, DE, 1.0f / WSC_UP};
                pg8::gemm_phase<pg8::EpiSwiGLU<true>, pg8::MoeOrder, true>(F.lds + RING_OFF, XSLOT_OFF, g, S, E);
            }
        }
        SEAM(pb + 5);
        if (IN(pb + 6)) {
            PTRS();
            if (PHEN(9) && !moba) {
                if (L == 2) { pg8::Gemm g{ACT, ws + WS_FD + (size_t)j * D * DFF * 2, DFF, 0}; pg8::StaticOrder S; S.init(MTOK, D, F.G, bx);
                    pg8::EpiRes E{h, h, D, 1.0f / WSC_DN};
                    pg8::gemm_phase<pg8::EpiRes, pg8::StaticOrder, true>(F.lds + RING_OFF, XSLOT_OFF, g, S, E);
                } else { pg8::Gemm g{ACT, ws + WS_FD + (size_t)j * D * DFF * 2, 2 * DFF, 0}; pg8::StaticOrder S; S.init(MTOK, D, F.G, bx);
                    pg8::EpiRes E{h, h, D, 1.0f};
                    pg8::gemm_phase<pg8::EpiRes, pg8::StaticOrder, false>(F.lds + RING_OFF, XSLOT_OFF, g, S, E); }
            } else if (PHEN(10) && moba) {
                pg8::Gemm g{ACT, ws + WS_MD + (size_t)j * NE * D * DE, DE, (size_t)D * DE}; pg8::MoeOrder S; S.init((const unsigned*)(F.ctl + CW_CNT + 64 * NE * j), ltok, false, D, F.G, bx);
                pg8::EpiMoeDown E; E.h = h; E.y1 = XN; E.list_tok = ltok; E.list_w = lw; E.sc = 1.0f / WSC_DN;
#pragma unroll
                for (int e = 0; e < NE; ++e) E.cnt[e] = S.cnt[e];
                pg8::gemm_phase<pg8::EpiMoeDown, pg8::MoeOrder, true>(F.lds + RING_OFF, XSLOT_OFF, g, S, E);
            }
        }
        SEAM(pb + 6);
        if (PHEN(11) && IN(pb + 7)) {
            PTRS();
            if (L == 3) norm_phase<3>(F, h, nullptr, XN, args.in[16], nullptr, h, noR);
            else if (moba) norm_phase<1>(F, h, h, XN, norm_mix + (size_t)(L + 1) * D, XN, nullptr, noR);
            else for (int rep_ = 0; rep_ < NREP(11); ++rep_) norm_phase<0>(F, h, nullptr, nullptr, norm_mix + (size_t)(L + 1) * D, XN, nullptr, noR);
        }
        if (L != NLAYER - 1) SEAM(pb + 7); else STAMP(pb + 8);
#undef F
    }
#undef IN
#undef SEAM
#undef PTRS
#undef OPQ
}


#if MK_DEBUG
__global__ void dbg_probe(const void* buf, size_t n, int is_bf16, int idx, float thresh, unsigned* dbg) {
    size_t i = blockIdx.x * (size_t)blockDim.x + threadIdx.x, stride = (size_t)gridDim.x * blockDim.x; bool bad = false;
    for (size_t k = i; k < n; k += stride) { float v = is_bf16 ? __uint_as_float(((unsigned)((const unsigned short*)buf)[k]) << 16) : ((const float*)buf)[k]; if (!(fabsf(v) <= thresh)) bad = true; }
    if (bad) atomicMax(dbg, (unsigned)(1000 - idx));
}
__global__ void dbg_cnt(const unsigned* cntw, int idx, unsigned* dbg) {
    if (threadIdx.x == 0 && blockIdx.x == 0) { unsigned s = 0; for (int e = 0; e < NE; ++e) s += cntw[64 * e]; if (s != 2u * MTOK) atomicMax(dbg, (unsigned)(1000 - idx)); }
}

__device__ __forceinline__ float dbg_bf(unsigned short v) { return __uint_as_float(((unsigned)v) << 16); }
__device__ __forceinline__ unsigned dbg_hash(unsigned x) { x ^= x >> 16; x *= 0x7feb352dU; x ^= x >> 15; x *= 0x846ca68bU; x ^= x >> 16; return x; }
__global__ void dbg_gemm_check(const unsigned short* A, int lda, const unsigned short* Bt, int K, const unsigned short* out, int ldo, int M, int N, float scale, int idx, unsigned* dbg) {
    const unsigned s = blockIdx.x * blockDim.x + threadIdx.x; const int row = (int)(dbg_hash(2 * s + 1) % (unsigned)M), col = (int)(dbg_hash(2 * s + 2) % (unsigned)N);
    float acc = 0.f; for (int k = 0; k < K; ++k) acc += dbg_bf(A[(size_t)row * lda + k]) * dbg_bf(Bt[(size_t)col * K + k]);
    acc *= scale; const float got = dbg_bf(out[(size_t)row * ldo + col]);
    if (!(fabsf(got - acc) <= 0.03f + 0.02f * fabsf(acc))) { atomicMax(dbg, (unsigned)(1000 - idx)); atomicAdd(dbg + 64 + idx, 1u); }
}
__global__ void dbg_conv_check(const float* W, int K, int N, const unsigned short* WT, int il, int idx, unsigned* dbg) {
    const unsigned s = blockIdx.x * blockDim.x + threadIdx.x; const int k = (int)(dbg_hash(2 * s + 1) % (unsigned)K), n = (int)(dbg_hash(2 * s + 2) % (unsigned)N);
    const int dr = il == 0 ? n : (n / 128) * 256 + (il - 1) * 128 + (n % 128);
    const float w = W[(size_t)k * N + n], g = dbg_bf(WT[(size_t)dr * K + k]);
    if (!(fabsf(g - w) <= 0.01f * fabsf(w) + 1e-6f)) atomicMax(dbg, (unsigned)(1000 - idx));
}
__global__ void dbg_norm_check(const float* src, const float* gain, const unsigned short* xn, int idx, unsigned* dbg) {
    const unsigned s = blockIdx.x * blockDim.x + threadIdx.x; const int row = (int)(dbg_hash(s + 77) % (unsigned)MTOK);
    float ss = 0.f; for (int c = 0; c < D; ++c) { const float v = src[(size_t)row * D + c]; ss += v * v; }
    const float rstd = 1.f / sqrtf(ss / D + 1e-6f); bool bad = false;
    for (int c = 0; c < D; ++c) { const float r = src[(size_t)row * D + c] * rstd * gain[c], g = dbg_bf(xn[(size_t)row * D + c]); if (!(fabsf(g - r) <= 0.02f + 0.01f * fabsf(r))) bad = true; }
    if (bad) atomicMax(dbg, (unsigned)(1000 - idx));
}
__global__ void dbg_naive_gemm(const unsigned short* A, const unsigned short* Bt, unsigned short* out, int M, int N, int K) {
    const size_t i = blockIdx.x * (size_t)blockDim.x + threadIdx.x; if (i >= (size_t)M * N) return; const int row = (int)(i / N), col = (int)(i % N);
    float acc = 0.f; for (int k = 0; k < K; ++k) acc += dbg_bf(A[(size_t)row * K + k]) * dbg_bf(Bt[(size_t)col * K + k]);
    out[(size_t)row * N + col] = (unsigned short)f2bf(acc);
}
__global__ void dbg_find_col(const unsigned short* out, const unsigned short* ref, int M, int N, unsigned* hist) {
    const unsigned s = blockIdx.x * blockDim.x + threadIdx.x; const int row = (int)(dbg_hash(2 * s + 1) % (unsigned)M), col = (int)(dbg_hash(2 * s + 2) % (unsigned)N);
    const unsigned short v = out[(size_t)row * N + col]; int found = -1;
#if MK_FIND_PATTERN
    if (v == 0x3C3C) atomicAdd(hist + N, 1u); else atomicAdd(hist + 5, 1u); return;
#endif
#if MK_FIND_ROWS
    for (int r = 0; r < M; ++r) if (ref[(size_t)r * N + col] == v) { found = r; break; }
    if (found < 0) atomicAdd(hist + N, 1u); else atomicAdd(hist + ((found - row) & (N - 1)), 1u);
#else
    for (int c = 0; c < N; ++c) if (ref[(size_t)row * N + c] == v) { found = c; break; }
    if (found < 0) atomicAdd(hist + N, 1u); else atomicAdd(hist + ((found - col) & (N - 1)), 1u);
#endif
}
__global__ void dbg_hist_code(const unsigned* hist, int N, unsigned* dbg) {
    if (threadIdx.x || blockIdx.x) return; unsigned best = 0, bi = 0; for (int i = 0; i < N; ++i) if (hist[i] > best) { best = hist[i]; bi = i; }
    dbg[32] = bi; dbg[33] = best; dbg[34] = hist[N];
}
__global__ void dbg_final(float* out, size_t n, const unsigned* dbg) {
    if (MK_HIST_SEL >= 10) { const float c3 = sqrtf((float)dbg[MK_HIST_SEL + 30]); size_t i3 = blockIdx.x * (size_t)blockDim.x + threadIdx.x, st3 = (size_t)gridDim.x * blockDim.x; for (size_t k3 = i3; k3 < n; k3 += st3) out[k3] = c3; return; }
    if (MK_HIST_SEL >= 0 && (dbg[33] || dbg[34])) { const float c2 = sqrtf((float)(MK_HIST_SEL == 0 ? dbg[32] : (MK_HIST_SEL == 1 ? dbg[33] * 100u / 4096u : dbg[34] * 100u / 4096u)) + 1.f); size_t i2 = blockIdx.x * (size_t)blockDim.x + threadIdx.x, st2 = (size_t)gridDim.x * blockDim.x; for (size_t k2 = i2; k2 < n; k2 += st2) out[k2] = c2; return; }
    const unsigned d = dbg[0]; if (d == 0u) return; const unsigned nf = dbg[64 + (1000u - d)]; const float c = sqrtf(nf ? (float)(200u * (1000u - d - 9u) + nf * 100u / 4096u) : (float)(1000u - d));
    size_t i = blockIdx.x * (size_t)blockDim.x + threadIdx.x, stride = (size_t)gridDim.x * blockDim.x;
    for (size_t k = i; k < n; k += stride) out[k] = c;
}
#endif

#ifndef MK_REPEAT
#define MK_REPEAT 1
#endif
#ifndef MK_FIND_ROWS
#define MK_FIND_ROWS 0
#endif
#ifndef MK_FIND_REGION
#define MK_FIND_REGION WS_K
#endif
#ifndef MK_HIST_SEL
#define MK_HIST_SEL 0
#endif
#ifndef MK_STAMP
#define MK_STAMP 0
#endif
#if MK_STAMP
__global__ void stamp_k(unsigned* p) { if (threadIdx.x == 0) *p = (unsigned)__builtin_amdgcn_s_memrealtime(); }
__global__ void stamp_encode(float* out, size_t n, const unsigned* st, int pa, float ua, int pb, float ub) {
    const float da = (float)(st[pa + 1] - st[pa]) * 0.01f, db = (float)(st[pb + 1] - st[pb]) * 0.01f;
    float m = da / ua; m = m < 10.f ? 10.f : (m > 99.f ? 99.f : m); float e = floorf(db / ub + 0.5f); e = e < 0.f ? 0.f : (e > 30.f ? 30.f : e);
    const float c = sqrtf(m) * __powf(10.f, 0.5f * e);
    size_t i = blockIdx.x * (size_t)blockDim.x + threadIdx.x, stride = (size_t)gridDim.x * blockDim.x;
    for (size_t k = i; k < n; k += stride) out[k] = c;
}
#endif
extern "C" void kernel_launch(void* const* d_in, const int* in_sizes, int n_in, void* d_out, int out_size, void* d_ws, size_t ws_size, hipStream_t stream) {
    static int grid = 0;
    if (grid == 0) {
        if (n_in != 17 || in_sizes[0] != MTOK * D || out_size != MTOK * D || ws_size < WS_END) {
            fprintf(stderr, "kernel_launch: built for 17 inputs, x/out of %d floats, >= %zu bytes of workspace; got n_in %d, in0 %d, out %d, ws %zu; nothing launched\n", MTOK * D, (size_t)WS_END, n_in, n_in > 0 ? in_sizes[0] : -1, out_size, ws_size);
            grid = -1; return; }
        int dev = 0, cus = 0, per_cu = 0;
        if (hipGetDevice(&dev) != hipSuccess || hipDeviceGetAttribute(&cus, hipDeviceAttributeMultiprocessorCount, dev) != hipSuccess) { fprintf(stderr, "kernel_launch: device query failed\n"); grid = -1; return; }
        if (hipFuncSetAttribute((const void*)trunk_fwd, hipFuncAttributeMaxDynamicSharedMemorySize, LDS_BYTES) != hipSuccess) { fprintf(stderr, "kernel_launch: hipFuncSetAttribute failed\n"); grid = -1; return; }
        if (hipOccupancyMaxActiveBlocksPerMultiprocessor(&per_cu, (const void*)trunk_fwd, NWAVES * 64, LDS_BYTES) != hipSuccess || per_cu < 1)
            fprintf(stderr, "kernel_launch: note: occupancy query reports %d workgroups per CU\n", per_cu);
        (void)hipGetLastError();
        grid = cus;
    }
    if (grid < 0) return;
    if (hipMemsetAsync((char*)d_ws + WS_CTL, 0, CTL_ZERO_BYTES, stream) != hipSuccess) { fprintf(stderr, "kernel_launch: memset failed\n"); return; }
    KArgs a{};
    for (int i = 0; i < 17; ++i) a.in[i] = (const float*)d_in[i];
    a.out = (float*)d_out; a.ws = (unsigned char*)d_ws;
#if MK_PER_PHASE
#if MK_STAMP
    hipLaunchKernelGGL(stamp_k, dim3(1), dim3(64), 0, stream, (unsigned*)d_ws + 3000);
#endif
    for (int p = 0; p < NPHASE; ++p) {
        a.ph_lo = p; a.ph_hi = p + 1;
#if MK_DEBUG
#endif
#if !defined(MK_SKIP_MAIN)
        for (int rep_ = 0; rep_ < (p == 1 ? MK_REPEAT : 1); ++rep_) hipLaunchKernelGGL(trunk_fwd, dim3(grid), dim3(NWAVES * 64), LDS_BYTES, stream, a);
#endif
#if MK_STAMP
        hipLaunchKernelGGL(stamp_k, dim3(1), dim3(64), 0, stream, (unsigned*)d_ws + 3000 + p + 1);
#endif
#if MK_DEBUG
        {   unsigned char* ws = (unsigned char*)d_ws; unsigned* dbg = (unsigned*)(ws + WS_CTL) + 2048;
            const size_t MD_ = (size_t)MTOK * D;
#define PROBE(buf, n, isbf, idx, th) if ((idx) <= MK_PROBE_MAX) hipLaunchKernelGGL(dbg_probe, dim3(2048), dim3(256), 0, stream, (const void*)(buf), (size_t)(n), isbf, idx, th, dbg)
            if (p == 0) {
                hipLaunchKernelGGL(dbg_norm_check, dim3(4), dim3(64), 0, stream, (const float*)d_in[0], (const float*)d_in[1], (const unsigned short*)(ws + WS_XN), 4, dbg);
                hipLaunchKernelGGL(dbg_conv_check, dim3(16), dim3(256), 0, stream, (const float*)d_in[3], D, 3 * D, (const unsigned short*)(ws + WS_DQKV), 0, 5, dbg);
                hipLaunchKernelGGL(dbg_conv_check, dim3(16), dim3(256), 0, stream, (const float*)d_in[9], D, DFF, (const unsigned short*)(ws + WS_FGU), 1, 6, dbg);
                hipLaunchKernelGGL(dbg_conv_check, dim3(16), dim3(256), 0, stream, (const float*)d_in[10], D, DFF, (const unsigned short*)(ws + WS_FGU), 2, 7, dbg);
                hipLaunchKernelGGL(dbg_conv_check, dim3(16), dim3(256), 0, stream, (const float*)d_in[11], DFF, D, (const unsigned short*)(ws + WS_FD), 0, 8, dbg);
                hipLaunchKernelGGL(dbg_conv_check, dim3(16), dim3(256), 0, stream, (const float*)d_in[15] + (size_t)3 * DE * D, DE, D, (const unsigned short*)(ws + WS_MD) + (size_t)3 * D * DE, 0, 9, dbg);
            }
            if (p == 1) {
                const float C2h = 0.125f * 1.4426950408889634f;
                hipLaunchKernelGGL(dbg_gemm_check, dim3(16), dim3(256), 0, stream, (const unsigned short*)(ws + WS_XN), D, (const unsigned short*)(ws + WS_DQKV), D, (const unsigned short*)(ws + WS_Q), D, MTOK, D, C2h, 10, dbg);
                hipLaunchKernelGGL(dbg_gemm_check, dim3(16), dim3(256), 0, stream, (const unsigned short*)(ws + WS_XN), D, (const unsigned short*)(ws + WS_DQKV) + (size_t)D * D, D, (const unsigned short*)(ws + WS_K), D, MTOK, D, 1.f, 11, dbg);

                hipLaunchKernelGGL(dbg_gemm_check, dim3(16), dim3(256), 0, stream, (const unsigned short*)(ws + WS_XN), D, (const unsigned short*)(ws + WS_DQKV) + (size_t)2 * D * D, D, (const unsigned short*)(ws + WS_V), D, MTOK, D, 1.f, 12, dbg);
            }
            if (0) { PROBE(ws + WS_XN, MD_, 1, 1, 10.f); PROBE(ws + WS_DQKV, (WS_MGU - WS_DQKV) / 2, 1, 2, 1.f); PROBE(ws + WS_MGU, (WS_XN - WS_MGU) / 2, 1, 3, 1.f); }
            if (p >= 1) { const int L = (p - 1) / PH_PER_LAYER, k = (p - 1) % PH_PER_LAYER; const int b = 20 + 10 * L;
                if (k == 0) PROBE(ws + WS_Q, 3 * MD_, 1, b + 0, 50.f);
                if (k == 1) PROBE(ws + WS_KMEAN, 8 * 16 * 16 * 64, 0, b + 1, 5.f);
                if (k == 2) PROBE(ws + WS_XN, MD_, 1, b + 2, 50.f);
                if (k == 3) PROBE(d_out, MD_, 0, b + 3, 300.f);
                if (k == 4) { PROBE(ws + WS_XN, MD_, 1, b + 4, 20.f); if ((L & 1) && (b + 9) <= MK_PROBE_MAX) hipLaunchKernelGGL(dbg_cnt, dim3(1), dim3(64), 0, stream, (const unsigned*)(ws + WS_CTL) + CW_CNT + 64 * NE * (L >> 1), b + 9, dbg); }
                if (k == 5) PROBE(ws + WS_ACT, (L & 1) ? (size_t)256 * 256 * DE : (size_t)MTOK * DFF, 1, b + 5, 2000.f);
                if (k == 6) { PROBE(d_out, MD_, 0, b + 6, 1000.f); if (L & 1) PROBE(ws + WS_XN, MD_, 1, b + 7, 1000.f); }
                if (k == 7 && L != 3) { PROBE(ws + WS_XN, MD_, 1, b + 8, 20.f); PROBE(d_out, MD_, 0, b + 8, 1000.f); }
            }
#undef PROBE
        }
#endif
    }
#if MK_DEBUG
    hipLaunchKernelGGL(dbg_final, dim3(2048), dim3(256), 0, stream, (float*)d_out, (size_t)MTOK * D, (const unsigned*)((unsigned char*)d_ws + WS_CTL) + 2048);
#endif
#else
    a.ph_lo = 0; a.ph_hi = NPHASE;
    hipLaunchKernelGGL(trunk_fwd, dim3(grid), dim3(NWAVES * 64), LDS_BYTES, stream, a);
#if 0
    hipLaunchKernelGGL(stamp_encode, dim3(2048), dim3(256), 0, stream, (float*)d_out, (size_t)MTOK * D, (const unsigned*)d_ws + 3000, MK_STAMP_PA, MK_STAMP_UA, MK_STAMP_PB, MK_STAMP_UB);
#endif
#endif
#if MK_STAMP
    hipLaunchKernelGGL(stamp_encode, dim3(2048), dim3(256), 0, stream, (float*)d_out, (size_t)MTOK * D, (const unsigned*)d_ws + 3000, MK_STAMP_PA, MK_STAMP_UA, MK_STAMP_PB, MK_STAMP_UB);
#endif
    const hipError_t le = hipPeekAtLastError();
    if (le != hipSuccess) fprintf(stderr, "kernel_launch: launch failed: %s\n", hipGetErrorName(le));
}
```

```cpp
#ifndef MK_DEBUG
#define MK_DEBUG 0
#endif
#ifndef MK_PER_PHASE
#define MK_PER_PHASE 0
#endif
#include <hip/hip_runtime.h>
#include <cstdio>
#include <cstdint>

#ifndef MK_KDEBUG
#define MK_KDEBUG 0
#endif
#define LAS __attribute__((address_space(3)))
#define GAS __attribute__((address_space(1)))

constexpr int BATCH = 8, SEQ = 4096, MTOK = BATCH * SEQ, D = 1024, DFF = 2816, DE = 3584, NE = 8;
constexpr int MOE_TILES_MAX = 272;
constexpr int LIST_CAP = MTOK;

namespace pg8 {
#define PG8_LAS __attribute__((address_space(3)))
typedef unsigned short bf16_t;
typedef short bf16x8 __attribute__((ext_vector_type(8)));
typedef float f32x4 __attribute__((ext_vector_type(4)));
typedef unsigned u32x4 __attribute__((ext_vector_type(4)));
typedef int i32x4 __attribute__((ext_vector_type(4)));
typedef int i32x8 __attribute__((ext_vector_type(8)));
constexpr int BM = 256, BK = 64, HALF = 128, HTB = HALF * BK * 2  , STAGE_BYTES = 8 * HTB, NXCD = 8, WGM = 8;

__host__ __device__ __forceinline__ int lds_byte(int r, int c) { const int st = (r >> 4) * 2 + (c >> 5), rr = r & 15, cc = c & 31, ob = rr * 64 + cc * 2; return st * 1024 + (ob ^ (((ob >> 9) & 1) << 5)); }
__host__ __device__ __forceinline__ void stage_rc(int b, int& R, int& C) { const int st = b / 1024, sb = b % 1024, swz = sb ^ (((sb >> 9) & 1) << 5); R = (st >> 1) * 16 + swz / 64; C = (st & 1) * 32 + (swz % 64) / 2; }
__host__ __device__ __forceinline__ int perm32(int rho) { const int n = rho >> 4, i = rho & 15; return 8 * (i >> 2) + 4 * n + (i & 3); }

struct Unit { int pm, pn, e, r0; };
struct Gemm { const void* A; const void* Bt; int rowb; size_t bstride; };

__device__ __forceinline__ void tile_of(int L, int nM, int nN, int& pm, int& pn) {
    const int nwg = nM * nN; int wgid = L; { const int q = nwg / NXCD, r = nwg % NXCD, xcd = wgid % NXCD, off = wgid / NXCD; wgid = (xcd < r ? xcd * (q + 1) : r * (q + 1) + (xcd - r) * q) + off; }
    const int nig = WGM * nN, gid = wgid / nig, fm = gid * WGM, gsz = (nM - fm) < WGM ? (nM - fm) : WGM;
    pm = fm + ((wgid % nig) % gsz); pn = (wgid % nig) / gsz;
}
struct StaticOrder {
    int nM, nN, nwg, G, c;
    __device__ __forceinline__ void init(int M, int N, int G_, int c_) { nM = M / BM; nN = N / BM; nwg = nM * nN; G = G_; c = c_; }
    __device__ __forceinline__ bool next(int i, Unit& u) const {
        const long L = (long)i * G + c; if (L >= nwg) return false;
        tile_of((int)L, nM, nN, u.pm, u.pn); u.e = 0; u.r0 = 0; return true;
    }
    __device__ __forceinline__ unsigned arow(const Unit& u, int lr) const { return (unsigned)(u.pm * BM + lr); }
};
struct MoeOrder {
    int nM, nN, nwg, G, c; int tstart[NE + 1]; int cnt[NE]; const unsigned* list_tok; bool gather;
    __device__ __forceinline__ void init(const unsigned* cntw, const unsigned* list_tok_, bool gather_, int N, int G_, int c_) {
        int acc = 0;
#pragma unroll
        for (int e = 0; e < NE; ++e) { const int ce = (int)__builtin_amdgcn_readfirstlane((int)__hip_atomic_load((const GAS unsigned*)cntw + 64 * e, __ATOMIC_RELAXED, __HIP_MEMORY_SCOPE_AGENT)); cnt[e] = ce; tstart[e] = acc; acc += (ce + BM - 1) / BM; }
        tstart[NE] = acc; nM = acc; nN = N / BM; nwg = nM * nN; G = G_; c = c_; list_tok = list_tok_; gather = gather_;
    }
    __device__ __forceinline__ bool next(int i, Unit& u) const {
        const long L = (long)i * G + c; if (L >= nwg) return false;
        tile_of((int)L, nM, nN, u.pm, u.pn); int e = 0;
#pragma unroll
        for (int k = 1; k < NE; ++k) e += (u.pm >= tstart[k]) ? 1 : 0;
        u.e = e; int ts = 0;
#pragma unroll
        for (int k = 0; k < NE; ++k) ts = (k == e) ? tstart[k] : ts;
        u.r0 = (u.pm - ts) * BM; return true;
    }
    __device__ __forceinline__ int count_of(int e) const { int cv = 0;
#pragma unroll
        for (int k = 0; k < NE; ++k) cv = (k == e) ? cnt[k] : cv;
        return cv; }
    __device__ __forceinline__ unsigned arow(const Unit& u, int lr) const {
        if (!gather) return (unsigned)(u.pm * BM + lr);
        const int l = u.r0 + lr; const int cv = count_of(u.e);
        unsigned t = 0u; if (l < cv) t = __hip_atomic_load((const GAS unsigned*)list_tok + (size_t)u.e * LIST_CAP + l, __ATOMIC_RELAXED, __HIP_MEMORY_SCOPE_AGENT) & 0xFFFFFu;
        return t;
    }
};

__device__ __forceinline__ unsigned cvt_pk_bf16(float lo, float hi) { unsigned r; asm volatile("v_cvt_pk_bf16_f32 %0, %1, %2" : "=v"(r) : "v"(lo), "v"(hi)); return r; }

struct EpiQKV {
    static constexpr bool PERM = true;
    bf16_t* O; int ldc; int split_cols; size_t split_stride; float scale0;
    __device__ __forceinline__ void operator()(const f32x4 (&acc)[2][2][4][2], const Unit& u, int wr, int wc, int fr, int fq) const {
        const int row0 = u.pm * BM + wr * 64 + fr; int colt = u.pn * BM; bf16_t* base = O;
        float sc = 1.f; { const int t = colt / split_cols; base += (size_t)t * split_stride; colt -= t * split_cols; if (t == 0) sc = scale0; }
        const int col0 = colt + wc * 32 + 8 * fq;
#pragma unroll
        for (int ai = 0; ai < 2; ++ai)
#pragma unroll
            for (int m = 0; m < 4; ++m) { bf16_t* rowp = base + (size_t)(row0 + ai * HALF + m * 16) * ldc + col0;
#pragma unroll
                for (int bj = 0; bj < 2; ++bj) { f32x4 v0 = acc[ai][bj][m][0] * sc, v1 = acc[ai][bj][m][1] * sc;
                    u32x4 w; w.x = cvt_pk_bf16(v0[0], v0[1]); w.y = cvt_pk_bf16(v0[2], v0[3]); w.z = cvt_pk_bf16(v1[0], v1[1]); w.w = cvt_pk_bf16(v1[2], v1[3]);
                    *(GAS u32x4*)(rowp + bj * HALF) = w;
                    } }
    }
};
__device__ __forceinline__ unsigned pk4_fp8(float a, float b, float c, float d) { unsigned w = 0; w = __builtin_amdgcn_cvt_pk_fp8_f32(a, b, w, false); w = __builtin_amdgcn_cvt_pk_fp8_f32(c, d, w, true); return w; }
template <bool F8OUT> struct EpiSwiGLU {
    static constexpr bool PERM = true;
    void* O; int ldc; float sc;
    __device__ __forceinline__ void operator()(const f32x4 (&acc)[2][2][4][2], const Unit& u, int wr, int wc, int fr, int fq) const {
        const int row0 = u.pm * BM + wr * 64 + fr; const int col0 = u.pn * HALF + wc * 32 + 8 * fq;
#pragma unroll
        for (int ai = 0; ai < 2; ++ai)
#pragma unroll
            for (int m = 0; m < 4; ++m) { float o[8];
#pragma unroll
                for (int n = 0; n < 2; ++n)
#pragma unroll
                    for (int j = 0; j < 4; ++j) { const float g = acc[ai][0][m][n][j] * sc, up = acc[ai][1][m][n][j] * sc;
                        const float s = __builtin_amdgcn_rcpf(1.0f + __builtin_amdgcn_exp2f(-1.4426950408889634f * g)); o[n * 4 + j] = g * s * up; }
                const size_t eo = (size_t)(row0 + ai * HALF + m * 16) * ldc + col0;
                if constexpr (F8OUT) { const unsigned long long w = (unsigned long long)pk4_fp8(o[0], o[1], o[2], o[3]) | ((unsigned long long)pk4_fp8(o[4], o[5], o[6], o[7]) << 32);
                    *(GAS unsigned long long*)((unsigned char*)O + eo) = w;
                } else { u32x4 w; w.x = cvt_pk_bf16(o[0], o[1]); w.y = cvt_pk_bf16(o[2], o[3]); w.z = cvt_pk_bf16(o[4], o[5]); w.w = cvt_pk_bf16(o[6], o[7]);
                    *(GAS u32x4*)((bf16_t*)O + eo) = w; } }
    }
};
struct EpiRes {
    static constexpr bool PERM = false;
    const float* res; float* out; int ldc; float sc;
    __device__ __forceinline__ void operator()(const f32x4 (&acc)[2][2][4][2], const Unit& u, int wr, int wc, int fr, int fq) const {
        const int row0 = u.pm * BM + wr * 64 + fr; const int col0 = u.pn * BM + wc * 32 + 4 * fq;
#pragma unroll
        for (int ai = 0; ai < 2; ++ai)
#pragma unroll
            for (int m = 0; m < 4; ++m) { const size_t off = (size_t)(row0 + ai * HALF + m * 16) * ldc + col0;
#pragma unroll
                for (int bj = 0; bj < 2; ++bj)
#pragma unroll
                    for (int n = 0; n < 2; ++n) { const f32x4 r = *(const GAS f32x4*)(res + off + bj * HALF + n * 16); *(GAS f32x4*)(out + off + bj * HALF + n * 16) = r + acc[ai][bj][m][n] * sc; } }
    }
};
struct EpiMoeDown {
    static constexpr bool PERM = false;
    float* h; bf16_t* y1; const unsigned* list_tok; const float* list_w; int cnt[NE]; float sc;
    __device__ __forceinline__ void operator()(const f32x4 (&acc)[2][2][4][2], const Unit& u, int wr, int wc, int fr, int fq) const {
        int cv = 0;
#pragma unroll
        for (int k = 0; k < NE; ++k) cv = (k == u.e) ? cnt[k] : cv;
        const int col0 = u.pn * BM + wc * 32 + 4 * fq;
#pragma unroll
        for (int ai = 0; ai < 2; ++ai)
#pragma unroll
            for (int m = 0; m < 4; ++m) { const int l = u.r0 + ai * HALF + wr * 64 + m * 16 + fr;
                if (l < cv) {
                    const unsigned ent = __hip_atomic_load((const GAS unsigned*)list_tok + (size_t)u.e * LIST_CAP + l, __ATOMIC_RELAXED, __HIP_MEMORY_SCOPE_AGENT);
                    const float w = sc * __uint_as_float(__hip_atomic_load((const GAS unsigned*)list_w + (size_t)u.e * LIST_CAP + l, __ATOMIC_RELAXED, __HIP_MEMORY_SCOPE_AGENT));
                    const size_t off = (size_t)(ent & 0xFFFFFu) * D + col0;
                    if ((ent >> 20) == 0u) {
#pragma unroll
                        for (int bj = 0; bj < 2; ++bj)
#pragma unroll
                            for (int n = 0; n < 2; ++n) { GAS float* p = (GAS float*)(h + off + bj * HALF + n * 16); const f32x4 r = *(const GAS f32x4*)p; *(GAS f32x4*)p = r + acc[ai][bj][m][n] * w; }
                    } else {
#pragma unroll
                        for (int bj = 0; bj < 2; ++bj)
#pragma unroll
                            for (int n = 0; n < 2; ++n) { const f32x4 v = acc[ai][bj][m][n] * w; unsigned long long pk = (unsigned long long)cvt_pk_bf16(v[0], v[1]) | ((unsigned long long)cvt_pk_bf16(v[2], v[3]) << 32);
                                *(GAS unsigned long long*)(y1 + off + bj * HALF + n * 16) = pk; }
                    }
                } }
    }
};

template <class Epi, class Sched, bool F8 = false>
__device__ __forceinline__ void gemm_phase(PG8_LAS unsigned char* lds, int xoff, const Gemm g, const Sched& S, const Epi& E) {
    int tid_ = threadIdx.x;
    asm volatile("" : "+v"(tid_));
    const int tid = tid_, wid = __builtin_amdgcn_readfirstlane(tid >> 6), lane = tid & 63, wr = wid >> 2, wc = wid & 3, fr = lane & 15, fq = lane >> 4;
    const int RB = g.rowb, nt = RB / 128;
    unsigned voffB[2];
#pragma unroll
    for (int i = 0; i < 2; ++i) { int R, C; stage_rc(tid * 16 + i * 8192, R, C); const int Rb = Epi::PERM ? ((R & ~31) + perm32(R & 31)) : R;
        voffB[i] = (unsigned)(Rb * RB + C * 2); }
    const size_t kstep = (size_t)(BK * 2);
    const size_t hstep = (size_t)HALF * RB;
    const size_t tstep = 2 * hstep;
    const unsigned ldsw = (unsigned)wid * 1024u;
    const int aoff = F8 ? lds_byte(wr * 64 + fr, fq * 16) : lds_byte(wr * 64 + fr, fq * 8), boff = F8 ? lds_byte(wc * 32 + fr, fq * 16) : lds_byte(wc * 32 + fr, fq * 8);
#define PG8_SA(b, h) (((b) * 2 + (h)) * HTB)
#define PG8_SB(b, h) ((4 + (b) * 2 + (h)) * HTB)
#define PG8_STAGE(bufoff, gbase, v0, v1) do { \
        __builtin_amdgcn_global_load_lds((const GAS unsigned*)((const char*)(gbase) + (v0)), (PG8_LAS unsigned*)(lds + (bufoff) + ldsw), 16, 0, 0); \
        __builtin_amdgcn_global_load_lds((const GAS unsigned*)((const char*)(gbase) + (v1)), (PG8_LAS unsigned*)(lds + (bufoff) + ldsw + 8192), 16, 0, 0); } while (0)
#define PG8_STAGEB(bufoff, gbase) PG8_STAGE(bufoff, gbase, voffB[0], voffB[1])
#define PG8_LDA(dst, b, h) do { if constexpr (F8) { _Pragma("unroll") for (int m = 0; m < 4; ++m) { dst##8[m].lo = *(const PG8_LAS i32x4*)(lds + PG8_SA(b, h) + aoff + m * 2048); dst##8[m].hi = *(const PG8_LAS i32x4*)(lds + PG8_SA(b, h) + aoff + m * 2048 + 16); } } \
        else { _Pragma("unroll") for (int m = 0; m < 4; ++m) _Pragma("unroll") for (int k = 0; k < 2; ++k) dst[m][k] = *(const PG8_LAS bf16x8*)(lds + PG8_SA(b, h) + aoff + m * 2048 + k * 1024); } } while (0)
#define PG8_LDB(dst, b, h) do { if constexpr (F8) { _Pragma("unroll") for (int n = 0; n < 2; ++n) { dst##8[n].lo = *(const PG8_LAS i32x4*)(lds + PG8_SB(b, h) + boff + n * 2048); dst##8[n].hi = *(const PG8_LAS i32x4*)(lds + PG8_SB(b, h) + boff + n * 2048 + 16); } } \
        else { _Pragma("unroll") for (int n = 0; n < 2; ++n) _Pragma("unroll") for (int k = 0; k < 2; ++k) dst[n][k] = *(const PG8_LAS bf16x8*)(lds + PG8_SB(b, h) + boff + n * 2048 + k * 1024); } } while (0)
#define PG8_MMA(ai, bj, At, Bt) do { __builtin_amdgcn_s_setprio(1); _Pragma("unroll") for (int m = 0; m < 4; ++m) _Pragma("unroll") for (int n = 0; n < 2; ++n) { \
        if constexpr (F8) acc[ai][bj][m][n] = __builtin_amdgcn_mfma_scale_f32_16x16x128_f8f6f4(Bt##8[n], At##8[m], acc[ai][bj][m][n], 0, 0, 0, 0x7F7F7F7F, 0, 0x7F7F7F7F); \
        else { _Pragma("unroll") for (int k = 0; k < 2; ++k) acc[ai][bj][m][n] = __builtin_amdgcn_mfma_f32_16x16x32_bf16(Bt[n][k], At[m][k], acc[ai][bj][m][n], 0, 0, 0); } } __builtin_amdgcn_s_setprio(0); } while (0)
#define PG8_WAIT_V(n) asm volatile("s_waitcnt vmcnt(" #n ")" ::: "memory")
#define PG8_WAIT_L(n) asm volatile("s_waitcnt lgkmcnt(" #n ")" ::: "memory")
#define PG8_BAR __builtin_amdgcn_s_barrier()
#define PG8_SCHED __builtin_amdgcn_sched_barrier(0)
#define PG8_AOFFS(U, o00, o01, o10, o11) do { int R0_, C0_, R1_, C1_; stage_rc(tid * 16, R0_, C0_); stage_rc(tid * 16 + 8192, R1_, C1_);     \
        o00 = S.arow(U, R0_) * (unsigned)RB + (unsigned)C0_ * 2u; o01 = S.arow(U, R1_) * (unsigned)RB + (unsigned)C1_ * 2u; \
        o10 = S.arow(U, HALF + R0_) * (unsigned)RB + (unsigned)C0_ * 2u; o11 = S.arow(U, HALF + R1_) * (unsigned)RB + (unsigned)C1_ * 2u; } while (0)
    Unit cur, nxt; int ui = 0;
    if (!S.next(0, cur)) return;
    f32x4 acc[2][2][4][2];
#pragma unroll
    for (int a = 0; a < 2; ++a)
#pragma unroll
        for (int b = 0; b < 2; ++b)
#pragma unroll
            for (int m = 0; m < 4; ++m)
#pragma unroll
                for (int n = 0; n < 2; ++n) acc[a][b][m][n] = (f32x4){0.f, 0.f, 0.f, 0.f};
    bf16x8 At[4][2], B0[2][2], B1[2][2];
    i32x8 At8[4], B08[2], B18[2];
    unsigned c00, c01, c10, c11;
    PG8_LAS u32x4* const xslot = (PG8_LAS u32x4*)(lds + xoff) + tid;
    PG8_AOFFS(cur, c00, c01, c10, c11);
    const char* const gA = (const char*)g.A;
    const char* cB = (const char*)g.Bt + (size_t)cur.e * g.bstride + (size_t)cur.pn * tstep;
    PG8_STAGEB(PG8_SB(0, 0), cB); PG8_STAGEB(PG8_SB(0, 1), cB + hstep); PG8_STAGE(PG8_SA(0, 0), gA, c00, c01); PG8_STAGE(PG8_SA(0, 1), gA, c10, c11);
    if (wr == 1) PG8_BAR;
    PG8_WAIT_V(2); PG8_BAR;
    PG8_STAGEB(PG8_SB(1, 0), cB + kstep); PG8_STAGE(PG8_SA(1, 0), gA + kstep, c00, c01); PG8_STAGEB(PG8_SB(1, 1), cB + hstep + kstep);
    PG8_WAIT_V(6); PG8_BAR;
    for (;;) {
        const bool has_next = S.next(ui + 1, nxt);
        const char* nB_ = has_next ? (const char*)g.Bt + (size_t)nxt.e * g.bstride + (size_t)nxt.pn * tstep : cB;
        const char* nB = nB_;
        if (has_next) { unsigned n00, n01, n10, n11; PG8_AOFFS(nxt, n00, n01, n10, n11); *xslot = (u32x4){n00, n01, n10, n11}; }
#pragma unroll 1
        for (int t = 0; t < nt; t += 2) {
            const bool last = (t == nt - 2);
            const char* a1 = gA + (size_t)(t + 1) * kstep;
            const char* a2 = last ? gA : gA + (size_t)(t + 2) * kstep; const char* b2 = last ? nB : cB + (size_t)(t + 2) * kstep;
            const char* a3 = a2 + kstep; const char* b3 = b2 + kstep;
            PG8_LDB(B0, 0, 0); PG8_LDB(B1, 0, 1); PG8_SCHED; PG8_LDA(At, 0, 0); PG8_STAGE(PG8_SA(1, 1), a1, c10, c11);
            if (last && has_next) { const u32x4 nx = *xslot; c00 = nx.x; c01 = nx.y; c10 = nx.z; c11 = nx.w; }
            PG8_WAIT_V(8); PG8_WAIT_L(0); PG8_BAR; PG8_MMA(0, 0, At, B0); PG8_MMA(0, 1, At, B1); PG8_BAR; PG8_SCHED;
            PG8_LDA(At, 0, 1); PG8_STAGEB(PG8_SB(0, 0), b2); PG8_STAGEB(PG8_SB(0, 1), b2 + hstep); PG8_STAGE(PG8_SA(0, 0), a2, c00, c01);
            PG8_WAIT_V(8); PG8_WAIT_L(0); PG8_BAR; PG8_MMA(1, 0, At, B0); PG8_MMA(1, 1, At, B1); PG8_BAR; PG8_SCHED;
            PG8_LDB(B0, 1, 0); PG8_LDB(B1, 1, 1); PG8_SCHED; PG8_LDA(At, 1, 0); PG8_STAGE(PG8_SA(0, 1), a2, c10, c11);
            PG8_WAIT_V(8); PG8_WAIT_L(0); PG8_BAR; PG8_MMA(0, 0, At, B0); PG8_MMA(0, 1, At, B1); PG8_BAR; PG8_SCHED;
            PG8_LDA(At, 1, 1); PG8_STAGEB(PG8_SB(1, 0), b3); PG8_STAGEB(PG8_SB(1, 1), b3 + hstep); PG8_STAGE(PG8_SA(1, 0), a3, c00, c01);
            PG8_WAIT_V(8); PG8_WAIT_L(0); PG8_BAR; PG8_MMA(1, 0, At, B0); PG8_MMA(1, 1, At, B1); PG8_BAR; PG8_SCHED;
        }
        if (wr == 0) PG8_BAR;
        E(acc, cur, wr, wc, fr, fq);
        if (!has_next) break;
#pragma unroll
        for (int a = 0; a < 2; ++a)
#pragma unroll
            for (int b = 0; b < 2; ++b)
#pragma unroll
                for (int m = 0; m < 4; ++m)
#pragma unroll
                    for (int n = 0; n < 2; ++n) acc[a][b][m][n] = (f32x4){0.f, 0.f, 0.f, 0.f};
        cur = nxt; cB = nB; ++ui;
        if (wr == 1) PG8_BAR;
    }
    PG8_WAIT_V(0);
    PG8_BAR;
#undef PG8_SA
#undef PG8_SB
#undef PG8_STAGE
#undef PG8_STAGEB
#undef PG8_LDA
#undef PG8_LDB
#undef PG8_MMA
#undef PG8_WAIT_V
#undef PG8_WAIT_L
#undef PG8_BAR
#undef PG8_SCHED
#undef PG8_AOFFS
}
}

namespace att {
typedef unsigned short bf16_t;
typedef short bf16x8 __attribute__((ext_vector_type(8)));
typedef short s16x4 __attribute__((ext_vector_type(4)));
typedef float f32x16 __attribute__((ext_vector_type(16)));
typedef float f32x4 __attribute__((ext_vector_type(4)));
typedef unsigned u32x4 __attribute__((ext_vector_type(4)));
constexpr int PITCH = 1024;
constexpr float LOG2E = 1.4426950408889634f;
__device__ __forceinline__ int crow(int r, int hi) { return (r & 3) + 8 * (r >> 2) + 4 * hi; }
typedef float f32x2_t __attribute__((ext_vector_type(2))); typedef __bf16 bf16x2_t __attribute__((ext_vector_type(2)));
__device__ __forceinline__ unsigned cvtpk(float lo, float hi) { f32x2_t v = {lo, hi}; bf16x2_t b = __builtin_convertvector(v, bf16x2_t); return __builtin_bit_cast(unsigned, b); }
__device__ __forceinline__ float bf2f(short s) { return __uint_as_float(((unsigned)(unsigned short)s) << 16); }
typedef short v4i16_t __attribute__((ext_vector_type(4)));
__device__ __forceinline__ s16x4 vtr(const LAS unsigned char* p) { return __builtin_bit_cast(s16x4, __builtin_amdgcn_ds_read_tr16_b64_v4i16((LAS v4i16_t*)p)); }
__device__ __forceinline__ float max3f(float a, float b, float c) { float r; asm("v_max3_f32 %0, %1, %2, %3" : "=v"(r) : "v"(a), "v"(b), "v"(c)); return r; }
__device__ __forceinline__ float halves_max(float m) { auto rr = __builtin_amdgcn_permlane32_swap(__float_as_uint(m), __float_as_uint(m), false, false); return fmaxf(__uint_as_float(rr[0]), __uint_as_float(rr[1])); }
__device__ __forceinline__ float halves_sum(float m) { auto rr = __builtin_amdgcn_permlane32_swap(__float_as_uint(m), __float_as_uint(m), false, false); return __uint_as_float(rr[0]) + __uint_as_float(rr[1]); }
#define ATT_BAR() asm volatile("s_waitcnt vmcnt(0) lgkmcnt(0)\n\ts_barrier" ::: "memory")
typedef unsigned u32x2 __attribute__((ext_vector_type(2)));
#define ATT_RD128(d, a, off) asm volatile("ds_read_b128 %0, %1 offset:%2" : "=v"(d) : "v"(a), "n"(off))
#define ATT_RDTR(d, a, off) asm volatile("ds_read_b64_tr_b16 %0, %1 offset:%2" : "=v"(d) : "v"(a), "n"(off))
#define ATT_WAIT2(n, x, y) asm volatile("s_waitcnt lgkmcnt(" #n ")" : "+v"(x), "+v"(y))

struct Args { const bf16_t* Q; const bf16_t* K; const bf16_t* V; bf16_t* O; const float* kmean; const float* kmax2; const float* subln; float lam_full; float out_scale; int abl; };
#ifndef ATT_ABLATE
#define ATT_ABLATE 0
#endif
#if ATT_ABLATE
#define ABL(bit) ((((ATT_ABLATE) >> (bit)) & 1) && abl_)
#else
#define ABL(bit) 0
#endif

template <int MODE>
__device__ __forceinline__ void attn_unit(LAS unsigned char* lds, const Args& A, int b, int h, int qblk) {
    constexpr int DVB = MODE == 0 ? 4 : 2;
    constexpr int NCH = MODE == 0 ? 16 : 8;
    constexpr int KBY = NCH * 1024, VBY = DVB * 4096, SLOT = KBY + VBY;
    constexpr int QR = MODE == 0 ? 128 : 256;
    constexpr int PPW = MODE == 0 ? 2 : 1;
    int tid_ = threadIdx.x; asm volatile("" : "+v"(tid_));
    const int tid = tid_, lane = tid & 63, r32 = lane & 31, hi = lane >> 5;
    const int wid = __builtin_amdgcn_readfirstlane(tid >> 6);
    const int comp = MODE == 0 ? (wid >> 2) : 0, wq = MODE == 0 ? (wid & 3) : wid;
    const int q0 = qblk * QR; const long rowbase = (long)b * SEQ;
    const int hcol = MODE == 0 ? h * 128 : h * 64;
    const int qrel0 = wq * 32;
    const float slope2 = __builtin_amdgcn_exp2f(MODE == 0 ? -(float)(h + 1) : -0.5f * (float)(h + 1)) * LOG2E;
    const int NT = MODE == 0 ? 2 * qblk + 2 : 4 + 4 * qblk;
#define ATT_KBASE_(t) (MODE == 0 ? 64 * (t) : ((t) < 4 ? q0 + 64 * (t) : 64 * ((t) - 4)))
#define ATT_KBASE(t) ATT_KBASE_(t)
    LAS float* wsf = (LAS float*)(lds + 65536) + wid * 64;
    const bf16_t* Kb = A.K + rowbase * PITCH + hcol;
    const bf16_t* Vb = A.V + rowbase * PITCH + hcol;
#define ATT_ISSUE_K(tt, slot) do { const int kb_ = ATT_KBASE(tt); \
        _Pragma("unroll") for (int i_ = 0; i_ < PPW; ++i_) { const int p_ = wid + 8 * i_; \
            __builtin_amdgcn_global_load_lds((const GAS unsigned*)(Kb + (size_t)(kb_ + lane) * PITCH + p_ * 8), (LAS unsigned*)(lds + (slot) * SLOT + p_ * 1024), 16, 0, 0); } } while (0)
#define ATT_ISSUE_V(tt, slot) do { const int kb_ = ATT_KBASE(tt); \
        _Pragma("unroll") for (int i_ = 0; i_ < PPW; ++i_) { const int p_ = wid + 8 * i_; \
            __builtin_amdgcn_global_load_lds((const GAS unsigned*)(Vb + (size_t)(kb_ + 16 * (p_ & 3) + (lane >> 2)) * PITCH + (p_ >> 2) * 32 + (lane & 3) * 8), (LAS unsigned*)(lds + (slot) * SLOT + KBY + p_ * 1024), 16, 0, 0); } } while (0)
    asm volatile("s_waitcnt lgkmcnt(0)\n\ts_barrier" ::: "memory");
    bf16x8 qr[4];
    { const bf16_t* Qw = A.Q + (rowbase + q0 + qrel0 + r32) * PITCH + hcol + comp * 64 + hi * 8;
#pragma unroll
      for (int d0 = 0; d0 < 4; ++d0) qr[d0] = *(const GAS bf16x8*)(Qw + d0 * 16); }
    const int tt_l = MODE == 0 ? (lane < 2 ? 2 * qblk + lane : lane - 2) : lane;
    const int kbase_l = (lane < NT) ? ATT_KBASE_(tt_l) : 0;
    const bool past_l = lane < NT && kbase_l + 64 <= q0;
    float k2a = 0.f, k2b = 0.f;
    { const int nblk = (kbase_l >> 8) & 15;
        if constexpr (MODE == 0) { k2a = ((const GAS float*)A.kmax2)[(size_t)(b * 16 + h * 2) * 16 + nblk]; k2b = ((const GAS float*)A.kmax2)[(size_t)(b * 16 + h * 2 + 1) * 16 + nblk]; }
        else k2a = ((const GAS float*)A.kmax2)[(size_t)(b * 16 + h) * 16 + nblk]; }
    float kmv0 = 0.f, kmv1 = 0.f;
    if constexpr (MODE == 1) { kmv0 = ((const GAS float*)A.kmean)[(size_t)(b * 16 + h) * 1024 + tid]; kmv1 = ((const GAS float*)A.kmean)[(size_t)(b * 16 + h) * 1024 + 512 + tid]; }
    const int t0 = MODE == 0 ? 2 * qblk : 0, t1 = t0 + 1;
    ATT_ISSUE_K(t0, 0); ATT_ISSUE_V(t0, 0); ATT_ISSUE_K(t1, 1);
    LAS int* live = (LAS int*)(lds + 71680); LAS float* qnx = (LAS float*)(lds + 71680 + 272);
    LAS float* km = (LAS float*)(lds + 67584);
    { float q2 = 0.f;
#pragma unroll
      for (int d0 = 0; d0 < 4; ++d0)
#pragma unroll
        for (int j = 0; j < 8; ++j) { const float v = bf2f(qr[d0][j]); q2 += v * v; }
      q2 = halves_sum(q2);
      q2 = fmaxf(q2, __shfl_xor(q2, 1)); q2 = fmaxf(q2, __shfl_xor(q2, 2)); q2 = fmaxf(q2, __shfl_xor(q2, 4)); q2 = fmaxf(q2, __shfl_xor(q2, 8)); q2 = fmaxf(q2, __shfl_xor(q2, 16));
      if (lane == 0) qnx[wid] = q2; }
    if constexpr (MODE == 1) { km[tid] = kmv0; km[tid + 512] = kmv1; }
    ATT_BAR();
    if (wid == 0) {
        bool alive = lane < NT;
        if (past_l) { float bound;
            if constexpr (MODE == 0) { const float qa = fmaxf(fmaxf(qnx[0], qnx[1]), fmaxf(qnx[2], qnx[3])), qb = fmaxf(fmaxf(qnx[4], qnx[5]), fmaxf(qnx[6], qnx[7]));
                bound = fmaxf(sqrtf(qa) * sqrtf(k2a), sqrtf(qb) * sqrtf(k2b));
            } else { float qm = qnx[0];
#pragma unroll
                for (int w = 1; w < 8; ++w) qm = fmaxf(qm, qnx[w]);
                bound = sqrtf(qm) * sqrtf(k2a); }
            alive = !(bound * 1.001f + 1.0f + slope2 * (float)(kbase_l + 63 - q0) < -152.0f);
        }
        const unsigned long long am = __ballot(alive);
        if (alive) live[__popcll(am & ((1ull << lane) - 1ull))] = tt_l;
        if (lane == 0) live[64] = __popcll(am);
    }
    unsigned sel = 0u;
    if constexpr (MODE == 1) {
        float g[16];
#pragma unroll
        for (int n = 0; n < 16; ++n) { float s = 0.f;
            if (n < qblk) {
#pragma unroll
                for (int d0 = 0; d0 < 4; ++d0) { const f32x4 ka = *(const LAS f32x4*)(km + n * 64 + d0 * 16 + hi * 8), kb2 = *(const LAS f32x4*)(km + n * 64 + d0 * 16 + hi * 8 + 4);
                    s += bf2f(qr[d0][0]) * ka[0] + bf2f(qr[d0][1]) * ka[1] + bf2f(qr[d0][2]) * ka[2] + bf2f(qr[d0][3]) * ka[3]
                       + bf2f(qr[d0][4]) * kb2[0] + bf2f(qr[d0][5]) * kb2[1] + bf2f(qr[d0][6]) * kb2[2] + bf2f(qr[d0][7]) * kb2[3]; }
                s = halves_sum(s); }
            g[n] = s; }
        const int nsel = qblk < 3 ? qblk : 3;
#pragma unroll
        for (int k = 0; k < 3; ++k) if (k < nsel) { float best = -INFINITY; int bi = 0; bool found = false;
#pragma unroll
            for (int n = 0; n < 16; ++n) if (n < qblk) { const bool free_ = ((sel >> n) & 1u) == 0u; if (free_ && (!found || g[n] > best)) { best = g[n]; bi = n; found = true; } }
            sel |= 1u << bi; }
    }
    ATT_BAR();
    const int NTL = __builtin_amdgcn_readfirstlane(live[64]);
#define ATT_ISSUE(t, slot) do { const int kb_ = ATT_KBASE(t); \
        _Pragma("unroll") for (int i_ = 0; i_ < PPW; ++i_) { const int p_ = wid + 8 * i_; \
            __builtin_amdgcn_global_load_lds((const GAS unsigned*)(Kb + (size_t)(kb_ + lane) * PITCH + p_ * 8), (LAS unsigned*)(lds + (slot) * SLOT + p_ * 1024), 16, 0, 0); \
            __builtin_amdgcn_global_load_lds((const GAS unsigned*)(Vb + (size_t)(kb_ + 16 * (p_ & 3) + (lane >> 2)) * PITCH + (p_ >> 2) * 32 + (lane & 3) * 8), (LAS unsigned*)(lds + (slot) * SLOT + KBY + p_ * 1024), 16, 0, 0); } } while (0)
    constexpr float THR = 8.0f;
    float mref = 0.f, l = 0.f; f32x16 o[DVB];
#pragma unroll
    for (int d0 = 0; d0 < DVB; ++d0) o[d0] = f32x16{};
#define ATT_CLASS(tt, SK, NM, SB) do { const int kb_ = ATT_KBASE(tt), kr_ = kb_ - q0; const bool dg_ = kb_ >= q0; SK = dg_ && (kr_ > qrel0 + 31); NM = dg_ && (kr_ + 63 > qrel0); SB = true; \
        if constexpr (MODE == 1) { if ((tt) >= 4) { SB = ((sel >> (((tt) - 4) >> 2)) & 1u) != 0u; if (!__any(SB)) SK = true; } } } while (0)
#define ATT_QK(P0, P1, tt, slot, SB) do { const int kr_ = ATT_KBASE(tt) - q0; float off0_ = slope2 * (float)(kr_ + 4 * hi) - mref; if (!(SB)) off0_ = -INFINITY; const float off1_ = off0_ + 32.0f * slope2; \
        const unsigned ka_ = (unsigned)(size_t)(lds + (slot) * SLOT + comp * 8192 + hi * 1024 + r32 * 16); u32x4 kx_[4], ky_[4]; \
        ATT_RD128(kx_[0], ka_, 0); ATT_RD128(ky_[0], ka_, 512); ATT_RD128(kx_[1], ka_, 2048); ATT_RD128(ky_[1], ka_, 2560); \
        _Pragma("unroll") for (int r = 0; r < 16; ++r) { const float cbr = slope2 * (float)((r & 3) + 8 * (r >> 2)); P0[r] = cbr + off0_; P1[r] = cbr + off1_; } \
        ATT_WAIT2(2, kx_[0], ky_[0]); P0 = __builtin_amdgcn_mfma_f32_32x32x16_bf16(__builtin_bit_cast(bf16x8, kx_[0]), qr[0], P0, 0, 0, 0); P1 = __builtin_amdgcn_mfma_f32_32x32x16_bf16(__builtin_bit_cast(bf16x8, ky_[0]), qr[0], P1, 0, 0, 0); \
        ATT_RD128(kx_[2], ka_, 4096); ATT_RD128(ky_[2], ka_, 4608); \
        ATT_WAIT2(2, kx_[1], ky_[1]); P0 = __builtin_amdgcn_mfma_f32_32x32x16_bf16(__builtin_bit_cast(bf16x8, kx_[1]), qr[1], P0, 0, 0, 0); P1 = __builtin_amdgcn_mfma_f32_32x32x16_bf16(__builtin_bit_cast(bf16x8, ky_[1]), qr[1], P1, 0, 0, 0); \
        ATT_RD128(kx_[3], ka_, 6144); ATT_RD128(ky_[3], ka_, 6656); \
        ATT_WAIT2(2, kx_[2], ky_[2]); P0 = __builtin_amdgcn_mfma_f32_32x32x16_bf16(__builtin_bit_cast(bf16x8, kx_[2]), qr[2], P0, 0, 0, 0); P1 = __builtin_amdgcn_mfma_f32_32x32x16_bf16(__builtin_bit_cast(bf16x8, ky_[2]), qr[2], P1, 0, 0, 0); \
        ATT_WAIT2(0, kx_[3], ky_[3]); P0 = __builtin_amdgcn_mfma_f32_32x32x16_bf16(__builtin_bit_cast(bf16x8, kx_[3]), qr[3], P0, 0, 0, 0); P1 = __builtin_amdgcn_mfma_f32_32x32x16_bf16(__builtin_bit_cast(bf16x8, ky_[3]), qr[3], P1, 0, 0, 0); } while (0)
    f32x16 p0, p1, n0, n1;
    const int abl_ = __builtin_amdgcn_readfirstlane(A.abl); (void)abl_;
    int t = t0, tn = t1;
    bool skipC, maskC, selC, skipN = true, maskN = false, selN = true;
    ATT_CLASS(t, skipC, maskC, selC);
    if (!skipC) ATT_QK(p0, p1, t, 0, selC);
    const int NTLX = ABL(4) ? 1 : NTL;
    for (int it = 0; it < NTLX; ++it) {
        ATT_BAR();
        const int tnn = (it + 2 < NTL) ? __builtin_amdgcn_readfirstlane(live[it + 2]) : 0;
        if (it + 2 < NTL && !ABL(0)) ATT_ISSUE_K(tnn, it & 1);
        if (it + 1 < NTL) { if (!ABL(0)) ATT_ISSUE_V(tn, (it + 1) & 1); ATT_CLASS(tn, skipN, maskN, selN); if (!skipN) { if (!ABL(2)) ATT_QK(n0, n1, tn, (it + 1) & 1, selN); else { n0 = f32x16{} - 1.0f; n1 = n0; } } } else skipN = true;
        if (!skipC) {
            const int krel = ATT_KBASE(t) - q0;
            const unsigned va_ = (unsigned)(size_t)(lds + (it & 1) * SLOT + KBY + ((lane >> 4) & 1) * 32 + (lane & 3) * 8 + (4 * hi + ((lane & 15) >> 2)) * 64);
            u32x2 vl_[4], vh_[4];
            if (!ABL(1)) { ATT_RDTR(vl_[0], va_, 0); ATT_RDTR(vh_[0], va_, 512); ATT_RDTR(vl_[1], va_, 1024); ATT_RDTR(vh_[1], va_, 1536);
            ATT_RDTR(vl_[2], va_, 2048); ATT_RDTR(vh_[2], va_, 2560); ATT_RDTR(vl_[3], va_, 3072); ATT_RDTR(vh_[3], va_, 3584); }
            if (maskC) { const int qrel = qrel0 + r32;
#pragma unroll
                for (int r = 0; r < 16; ++r) { const int kv = krel + crow(r, hi); if (kv > qrel) p0[r] = -INFINITY; if (kv + 32 > qrel) p1[r] = -INFINITY; } }
            float rm;
            { float a_ = max3f(p0[0], p0[1], p1[0]), b_ = max3f(p0[2], p0[3], p1[1]); a_ = max3f(a_, p1[2], p1[3]);
#pragma unroll
              for (int r = 4; r < 16; r += 4) { a_ = max3f(a_, p0[r], p0[r + 1]); b_ = max3f(b_, p0[r + 2], p0[r + 3]); a_ = max3f(a_, p1[r], p1[r + 1]); b_ = max3f(b_, p1[r + 2], p1[r + 3]); }
              rm = halves_max(fmaxf(a_, b_)); }
            if (__any(rm > THR)) {
                const float dl = fmaxf(rm, 0.f); mref += dl; const float alpha = __builtin_amdgcn_exp2f(-dl);
#pragma unroll
                for (int r = 0; r < 16; ++r) { p0[r] -= dl; p1[r] -= dl; }
                if (!skipN) {
#pragma unroll
                    for (int r = 0; r < 16; ++r) { n0[r] -= dl; n1[r] -= dl; } }
                l *= alpha;
                if (hi == 0) wsf[r32] = alpha;
                asm volatile("s_waitcnt lgkmcnt(0)" ::: "memory");
#pragma unroll
                for (int gq = 0; gq < 4; ++gq) { const f32x4 f = *(const LAS f32x4*)(wsf + 8 * gq + 4 * hi);
#pragma unroll
                    for (int d0 = 0; d0 < DVB; ++d0) { o[d0][4 * gq + 0] *= f[0]; o[d0][4 * gq + 1] *= f[1]; o[d0][4 * gq + 2] *= f[2]; o[d0][4 * gq + 3] *= f[3]; } }
            }
            float sacc = 0.f;
            if (!ABL(3)) {
#pragma unroll
            for (int r = 0; r < 16; ++r) { p0[r] = __builtin_amdgcn_exp2f(p0[r]); p1[r] = __builtin_amdgcn_exp2f(p1[r]); sacc += p0[r] + p1[r]; } }
            l += sacc;
            u32x4 pw[4];
            pw[0] = (u32x4){cvtpk(p0[0], p0[1]), cvtpk(p0[2], p0[3]), cvtpk(p0[4], p0[5]), cvtpk(p0[6], p0[7])};
            pw[1] = (u32x4){cvtpk(p0[8], p0[9]), cvtpk(p0[10], p0[11]), cvtpk(p0[12], p0[13]), cvtpk(p0[14], p0[15])};
            pw[2] = (u32x4){cvtpk(p1[0], p1[1]), cvtpk(p1[2], p1[3]), cvtpk(p1[4], p1[5]), cvtpk(p1[6], p1[7])};
            pw[3] = (u32x4){cvtpk(p1[8], p1[9]), cvtpk(p1[10], p1[11]), cvtpk(p1[12], p1[13]), cvtpk(p1[14], p1[15])};
            if (!ABL(1))
#pragma unroll
            for (int i = 0; i < 4 * DVB; ++i) { constexpr int NM = 4 * DVB; const int s_ = i & 3;
                if (i + 3 < NM) ATT_WAIT2(6, vl_[s_], vh_[s_]); else if (i + 3 == NM) ATT_WAIT2(4, vl_[s_], vh_[s_]); else if (i + 2 == NM) ATT_WAIT2(2, vl_[s_], vh_[s_]); else ATT_WAIT2(0, vl_[s_], vh_[s_]);
                const u32x4 vf = (u32x4){vl_[s_][0], vl_[s_][1], vh_[s_][0], vh_[s_][1]};
                o[i >> 2] = __builtin_amdgcn_mfma_f32_32x32x16_bf16(__builtin_bit_cast(bf16x8, pw[i & 3]), __builtin_bit_cast(bf16x8, vf), o[i >> 2], 0, 0, 0);
                if (i + 4 < NM) { ATT_RDTR(vl_[s_], va_, (i + 4) * 1024); ATT_RDTR(vh_[s_], va_, (i + 4) * 1024 + 512); } }
        }
        p0 = n0; p1 = n1; skipC = skipN; maskC = maskN; selC = selN; t = tn; tn = tnn;
    }
#undef ATT_ISSUE_K
#undef ATT_ISSUE_V
#undef ATT_CLASS
#undef ATT_QK
    if (ABL(5)) return;
    float sg[DVB];
    if constexpr (MODE == 0) {
#pragma unroll
        for (int d0 = 0; d0 < DVB; ++d0) sg[d0] = ((const GAS float*)A.subln)[d0 * 32 + r32]; }
    l = halves_sum(l);
    if (hi == 0) wsf[32 + r32] = l;
    asm volatile("s_waitcnt lgkmcnt(0)" ::: "memory");
    float rli[16];
#pragma unroll
    for (int gq = 0; gq < 4; ++gq) { const f32x4 f = *(const LAS f32x4*)(wsf + 32 + 8 * gq + 4 * hi); rli[4 * gq + 0] = 1.0f / f[0]; rli[4 * gq + 1] = 1.0f / f[1]; rli[4 * gq + 2] = 1.0f / f[2]; rli[4 * gq + 3] = 1.0f / f[3]; }
    if constexpr (MODE == 1) {
        GAS bf16_t* Ow = (GAS bf16_t*)(A.O + (rowbase + q0 + qrel0) * PITCH + hcol);
#pragma unroll
        for (int r = 0; r < 16; ++r)
#pragma unroll
            for (int d0 = 0; d0 < DVB; ++d0) Ow[(size_t)crow(r, hi) * PITCH + d0 * 32 + r32] = (bf16_t)(cvtpk(o[d0][r] * rli[r], 0.f) & 0xFFFFu);
    } else {
        ATT_BAR();
        LAS float* X = (LAS float*)lds + wq * 4096;
        if (comp == 1) {
#pragma unroll
            for (int d0 = 0; d0 < DVB; ++d0)
#pragma unroll
                for (int r = 0; r < 16; ++r) X[(d0 * 16 + r) * 64 + lane] = o[d0][r] * rli[r];
        }
        ATT_BAR();
        if (comp == 0) {
#pragma unroll
            for (int d0 = 0; d0 < DVB; ++d0) sg[d0] *= A.out_scale;
            GAS bf16_t* Ow = (GAS bf16_t*)(A.O + (rowbase + q0 + qrel0) * PITCH + hcol);
#pragma unroll
            for (int r = 0; r < 16; ++r) { float dv[DVB]; float ss = 0.f;
#pragma unroll
                for (int d0 = 0; d0 < DVB; ++d0) { dv[d0] = o[d0][r] * rli[r] - A.lam_full * X[(d0 * 16 + r) * 64 + lane]; ss += dv[d0] * dv[d0]; }
                ss += __shfl_xor(ss, 1); ss += __shfl_xor(ss, 2); ss += __shfl_xor(ss, 4); ss += __shfl_xor(ss, 8); ss += __shfl_xor(ss, 16);
                const float rs = 1.0f / sqrtf(ss * (1.0f / 128.0f) + 1e-5f);
#pragma unroll
                for (int d0 = 0; d0 < DVB; ++d0) Ow[(size_t)crow(r, hi) * PITCH + d0 * 32 + r32] = (bf16_t)(cvtpk(dv[d0] * rs * sg[d0], 0.f) & 0xFFFFu); }
        }
    }
#undef ATT_KBASE
#undef ATT_KBASE_
#undef ATT_ISSUE
}
#undef ATT_BAR
}

constexpr int NWAVES = 8;
constexpr int NLAYER = 4, PH_PER_LAYER = 8, NPHASE = 1 + NLAYER * PH_PER_LAYER;

constexpr size_t MiB = 1u << 20;
constexpr size_t WS_CTL = 0, CTL_ZERO_BYTES = 1 * MiB;
constexpr size_t WS_KMEAN = 1 * MiB;
constexpr size_t WS_LTOK = 2 * MiB, WS_LW = 3 * MiB;
constexpr size_t WS_DQKV = 5 * MiB;
constexpr size_t WS_DWO = WS_DQKV + 12 * MiB;
constexpr size_t WS_MQKV = WS_DWO + 4 * MiB;
constexpr size_t WS_MWO = WS_MQKV + 12 * MiB;
constexpr size_t WS_FGU = WS_MWO + 4 * MiB;
constexpr size_t WS_FD = WS_FGU + 22 * MiB;
constexpr size_t WS_MGU = WS_FD + 11 * MiB;
constexpr size_t WS_MD = WS_MGU + 112 * MiB;
constexpr size_t WS_XN = WS_MD + 56 * MiB;
constexpr size_t WS_Q = WS_XN + 64 * MiB, WS_K = WS_Q + 64 * MiB, WS_V = WS_K + 64 * MiB;
constexpr size_t WS_ACT = WS_Q;
constexpr size_t WS_END = WS_ACT + (size_t)MOE_TILES_MAX * 256 * DE * 2;
static_assert(WS_XN == 238 * MiB && WS_END == 778 * MiB, "d_ws map");
constexpr int CW_BAR = 4096;
constexpr int CW_ATTQ = 6144;
constexpr int CW_ATTQ2 = 12288;
constexpr int CW_CNT = 8192;

constexpr int RING_OFF = 0, RING_BYTES = 131072;
constexpr int LDSCTL_OFF = RING_BYTES, MISC_OFF = LDSCTL_OFF + 320;
constexpr int XSLOT_OFF = MISC_OFF + 128;
constexpr int LDS_BYTES = 147456;

typedef unsigned short bf16;
typedef unsigned v4u __attribute__((ext_vector_type(4)));
typedef float f32x4 __attribute__((ext_vector_type(4)));
typedef GAS unsigned gu32;
#define RLX_AGENT __ATOMIC_RELAXED, __HIP_MEMORY_SCOPE_AGENT
#define LDS_WAIT() asm volatile("s_waitcnt lgkmcnt(0)" ::: "memory")
#define VM_WAIT() asm volatile("s_waitcnt vmcnt(0)" ::: "memory")
__device__ __forceinline__ unsigned f2bf(float f) { unsigned u = __builtin_bit_cast(unsigned, f); return (u + 0x7fffu + ((u >> 16) & 1u)) >> 16; }
__device__ __forceinline__ unsigned pk2(float lo, float hi) { return f2bf(lo) | (f2bf(hi) << 16); }
__device__ __forceinline__ float bflo(unsigned w) { return __uint_as_float(w << 16); }
__device__ __forceinline__ float bfhi(unsigned w) { return __uint_as_float(w & 0xFFFF0000u); }
static_assert(XSLOT_OFF % 16 == 0 && XSLOT_OFF + 8192 <= LDS_BYTES, "LDS map");
#define XB_TMO      128
#define XB_XCNT(j)  (256  + 64 * (j))
#define XB_XSUB(j)  (1280 + 64 * (j))
#define XB_XGEN(j)  (2304 + 64 * (j))
#define XB_TOP      3328
#define XB_TOPGEN   3392
#define XCD_BAR_WORDS 3456
#define XB_SPIN_CAP (1u << 18)

__device__ __forceinline__ unsigned xb_ld(unsigned* p)              { return __hip_atomic_load(p, __ATOMIC_RELAXED, __HIP_MEMORY_SCOPE_AGENT); }
__device__ __forceinline__ unsigned xb_add(unsigned* p, unsigned v) { return __hip_atomic_fetch_add(p, v, __ATOMIC_RELAXED, __HIP_MEMORY_SCOPE_AGENT); }
__device__ __forceinline__ unsigned xb_xcc_id() { return (unsigned)__builtin_amdgcn_s_getreg((3 << 11) | 20) & 0xFu; }
#define XB_SPIN(cond, bar) do { unsigned _sp = 0; while (cond) { __builtin_amdgcn_s_sleep(1); \
    if ((++_sp & 255u) == 0u) { if (xb_ld(&(bar)[XB_TMO])) break; if (_sp > XB_SPIN_CAP) { atomicAdd(&(bar)[XB_TMO], 1u); break; } } } } while (0)

struct XcdBarrier {
    unsigned* bar; unsigned x;
    volatile LAS unsigned* st;
};

__device__ __forceinline__ XcdBarrier xcd_barrier_post(unsigned* bar, volatile LAS unsigned* st) {
    XcdBarrier b; b.bar = bar; b.x = xb_xcc_id(); b.st = st;
    if (threadIdx.x == 0) (void)xb_add(&bar[XB_XCNT(b.x)], 1u);
    return b;
}
__device__ __forceinline__ void xcd_barrier_complete(unsigned* bar, unsigned x, unsigned& nloc, unsigned& nx) {
    const unsigned G = gridDim.x * gridDim.y * gridDim.z;
    unsigned sum, cnt, mine, sp = 0u;
    for (;;) {
        sum = 0u; cnt = 0u; mine = 0u;
#pragma unroll
        for (unsigned j = 0; j < 16; ++j) { const unsigned c = xb_ld(&bar[XB_XCNT(j)]); sum += c; cnt += (c > 0u) ? 1u : 0u; mine = (j == x) ? c : mine; }
        if (sum == G) break;
        __builtin_amdgcn_s_sleep(1);
        if ((++sp & 255u) == 0u) { if (xb_ld(&bar[XB_TMO])) break; if (sp > XB_SPIN_CAP) { atomicAdd(&bar[XB_TMO], 1u); break; } }
    }
    nloc = mine > 0u ? mine : 1u; nx = cnt > 0u ? cnt : 1u;
}

__device__ __forceinline__ void xcd_barrier(const XcdBarrier& b) {
    asm volatile("s_waitcnt vmcnt(0)" ::: "memory");
    __syncthreads();
    if (threadIdx.x == 0) {
        unsigned* bar = b.bar;
        __builtin_amdgcn_s_waitcnt(0);
        unsigned nloc = b.st[0], nx = b.st[1];
        if (nloc == 0u) { xcd_barrier_complete(bar, b.x, nloc, nx); b.st[0] = nloc; b.st[1] = nx; }
        const unsigned old = xb_add(&bar[XB_XSUB(b.x)], 1u);
        const unsigned gen = old / nloc;
        if (old + 1u == (gen + 1u) * nloc) {
            __builtin_amdgcn_fence(__ATOMIC_RELEASE, "agent");
            asm volatile("s_waitcnt vmcnt(0)" ::: "memory");
            const unsigned og = xb_add(&bar[XB_TOP], 1u);
            const unsigned tg = og / nx;
            if (og + 1u == (tg + 1u) * nx) xb_add(&bar[XB_TOPGEN], 1u);
            else XB_SPIN(xb_ld(&bar[XB_TOPGEN]) == tg, bar);
            __builtin_amdgcn_fence(__ATOMIC_ACQUIRE, "agent");
            xb_add(&bar[XB_XGEN(b.x)], 1u);
            asm volatile("s_waitcnt vmcnt(0)" ::: "memory");
        } else {
            XB_SPIN(xb_ld(&bar[XB_XGEN(b.x)]) == gen, bar);
            __builtin_amdgcn_fence(__ATOMIC_ACQUIRE, "agent");
            asm volatile("s_waitcnt vmcnt(0)" ::: "memory");
        }
    }
    __syncthreads();
}

struct Frame {
    LAS unsigned char* lds;
    volatile LAS unsigned* MISC;
    gu32* ctl;
    int tid, lane, wave;
    int vcu, G;
};
__device__ __forceinline__ float wave_sum(float v) {
#pragma unroll
    for (int o = 1; o < 64; o <<= 1) v += __shfl_xor(v, o);
    return v;
}
__device__ __forceinline__ void transpose_item(const float* W, int K, int N, void* WT, int k0, int n0, int drow0, LAS float* scr, int lane, bool f8, float wscale) {
    const GAS float* src = (const GAS float*)W + (size_t)k0 * N + n0 + lane;
#pragma unroll
    for (int hb = 0; hb < 2; ++hb) { float v[32];
#pragma unroll
        for (int i = 0; i < 32; ++i) v[i] = src[(size_t)(hb * 32 + i) * N];
#pragma unroll
        for (int i = 0; i < 32; ++i) { const int kk = hb * 32 + i; scr[kk * 64 + (lane ^ ((kk >> 3) << 3))] = v[i]; } }
    LDS_WAIT(); asm volatile("" ::: "memory");
    if (f8) {
        const int c = lane & 3;
#pragma unroll
        for (int j = 0; j < 4; ++j) { const int nn = (lane >> 2) + 16 * j; float v[16];
#pragma unroll
            for (int q = 0; q < 16; ++q) { const int kk = 16 * c + q; v[q] = scr[kk * 64 + (nn ^ ((kk >> 3) << 3))] * wscale; }
            v4u o; o.x = pg8::pk4_fp8(v[0], v[1], v[2], v[3]); o.y = pg8::pk4_fp8(v[4], v[5], v[6], v[7]); o.z = pg8::pk4_fp8(v[8], v[9], v[10], v[11]); o.w = pg8::pk4_fp8(v[12], v[13], v[14], v[15]);
            *(GAS v4u*)((unsigned char*)WT + (size_t)(drow0 + nn) * K + k0 + 16 * c) = o; }
    } else {
    const int c = lane & 7;
#pragma unroll
    for (int j = 0; j < 8; ++j) { const int n = (lane >> 3) + 8 * j; const LAS float* s = scr + (8 * c) * 64 + (n ^ (c << 3));
        v4u o; o.x = pk2(s[0 * 64], s[1 * 64]); o.y = pk2(s[2 * 64], s[3 * 64]); o.z = pk2(s[4 * 64], s[5 * 64]); o.w = pk2(s[6 * 64], s[7 * 64]);
        *(GAS v4u*)((bf16*)WT + (size_t)(drow0 + n) * K + k0 + 8 * c) = o; }
    }
    LDS_WAIT(); asm volatile("" ::: "memory");
}
__device__ __forceinline__ void convert_matrix(Frame& F, const float* W, int K, int N, void* WT, int il, unsigned& rot, bool f8 = false, float wscale = 1.0f) {
    LAS float* scr = (LAS float*)(F.lds + RING_OFF + F.wave * 16384);
    const unsigned gw = (unsigned)(F.vcu * NWAVES + F.wave), NGW = (unsigned)(F.G * NWAVES);
    const int nblk = N / 64, nitems = (K / 64) * nblk; int lane_ = F.lane; asm volatile("" : "+v"(lane_));
    for (int it = (int)((gw + NGW - rot % NGW) % NGW); it < nitems; it += (int)NGW) {
        const int kb = it / nblk, nb = it % nblk, n0 = 64 * nb;
        const int drow0 = il == 0 ? n0 : (n0 / 128) * 256 + (il - 1) * 128 + (n0 % 128);
        transpose_item(W, K, N, WT, 64 * kb, n0, drow0, scr, lane_, f8, wscale);
    }
    rot = (rot + (unsigned)nitems) % NGW;
}

struct RouterArgs { const float* router; gu32* cnt; unsigned* ltok; float* lw; };
template <int MODE, bool F8X = false>
__device__ __forceinline__ void norm_phase(Frame& F, const float* src, float* hout, const bf16* y1, const float* gain, bf16* xn, float* fout, const RouterArgs& R) {
    int lane_ = F.lane; asm volatile("" : "+v"(lane_));
    const int gw = F.vcu * NWAVES + F.wave, NGW = F.G * NWAVES, lane = lane_;
    f32x4 gv[4];
#pragma unroll
    for (int j = 0; j < 4; ++j) gv[j] = *(const GAS f32x4*)(gain + 256 * j + 4 * lane);
    LAS float* RL = (LAS float*)(F.lds + RING_OFF);
    if constexpr (MODE == 2) {
        int tid_ = F.tid; asm volatile("" : "+v"(tid_));
        for (int i = tid_; i < 8192; i += NWAVES * 64) RL[(i & 7) * 1024 + (i >> 3)] = ((const GAS float*)R.router)[i];
        LDS_WAIT(); __syncthreads();
    }
    const int nrows_w = gw < MTOK ? (MTOK - gw + NGW - 1) / NGW : 0;
    for (int cb = 0; cb < nrows_w; cb += 64) {
        int my_t = 0, my_e0 = 0, my_e1 = 0; float my_w0 = 0.f, my_w1 = 0.f; bool valid = false;
        const int cn = (nrows_w - cb) < 64 ? (nrows_w - cb) : 64;
        f32x4 vn[4]; unsigned long long yn[4];
        { const int row0_ = gw + cb * NGW; const GAS f32x4* xr = (const GAS f32x4*)(src + (size_t)row0_ * D) + lane;
#pragma unroll
          for (int j = 0; j < 4; ++j) vn[j] = xr[64 * j];
          if constexpr (MODE == 1 || MODE == 3) { const GAS unsigned long long* yr = (const GAS unsigned long long*)(y1 + (size_t)row0_ * D) + lane;
#pragma unroll
            for (int j = 0; j < 4; ++j) yn[j] = yr[64 * j]; } }
        for (int i = 0; i < cn; ++i) {
            const int row = gw + (cb + i) * NGW;
            f32x4 v[4]; float s = 0.f;
#pragma unroll
            for (int j = 0; j < 4; ++j) v[j] = vn[j];
            if constexpr (MODE == 1 || MODE == 3) {
#pragma unroll
                for (int j = 0; j < 4; ++j) { const unsigned long long w = yn[j]; const unsigned lo = (unsigned)w, hi = (unsigned)(w >> 32);
                    v[j].x += bflo(lo); v[j].y += bfhi(lo); v[j].z += bflo(hi); v[j].w += bfhi(hi); }
            }
            if (i + 1 < cn) { const int rown = row + NGW; const GAS f32x4* xr = (const GAS f32x4*)(src + (size_t)rown * D) + lane;
#pragma unroll
                for (int j = 0; j < 4; ++j) vn[j] = xr[64 * j];
                if constexpr (MODE == 1 || MODE == 3) { const GAS unsigned long long* yr = (const GAS unsigned long long*)(y1 + (size_t)rown * D) + lane;
#pragma unroll
                    for (int j = 0; j < 4; ++j) yn[j] = yr[64 * j]; } }
#pragma unroll
            for (int j = 0; j < 4; ++j) s += (v[j].x * v[j].x + v[j].y * v[j].y) + (v[j].z * v[j].z + v[j].w * v[j].w);
            if constexpr (MODE == 1) { GAS f32x4* hr = (GAS f32x4*)(hout + (size_t)row * D) + lane;
#pragma unroll
                for (int j = 0; j < 4; ++j) hr[64 * j] = v[j]; }
            const float rstd = 1.f / sqrtf(wave_sum(s) * (1.f / D) + 1e-6f);
#pragma unroll
            for (int j = 0; j < 4; ++j) v[j] = v[j] * rstd * gv[j];
            if constexpr (MODE == 3) { GAS f32x4* orow = (GAS f32x4*)(fout + (size_t)row * D) + lane;
#pragma unroll
                for (int j = 0; j < 4; ++j) orow[64 * j] = v[j];
            } else {
                if constexpr (F8X) { GAS unsigned* o4 = (GAS unsigned*)((unsigned char*)xn + (size_t)row * D) + lane;
#pragma unroll
                    for (int j = 0; j < 4; ++j) o4[64 * j] = pg8::pk4_fp8(v[j].x, v[j].y, v[j].z, v[j].w);
                } else { GAS unsigned long long* o8 = (GAS unsigned long long*)(xn + (size_t)row * D) + lane;
#pragma unroll
                    for (int j = 0; j < 4; ++j) o8[64 * j] = (unsigned long long)pk2(v[j].x, v[j].y) | ((unsigned long long)pk2(v[j].z, v[j].w) << 32); }
            }
            if constexpr (MODE == 2) {
                float lg[NE];
#pragma unroll
                for (int e = 0; e < NE; ++e) { float a = 0.f;
#pragma unroll
                    for (int j = 0; j < 4; ++j) { const f32x4 rr = *(const LAS f32x4*)(RL + e * 1024 + 256 * j + 4 * lane); a += (v[j].x * rr.x + v[j].y * rr.y) + (v[j].z * rr.z + v[j].w * rr.w); }
                    lg[e] = wave_sum(a); }
                int e0 = 0; float v0 = lg[0];
#pragma unroll
                for (int e = 1; e < NE; ++e) if (lg[e] > v0) { v0 = lg[e]; e0 = e; }
                int e1 = -1; float v1 = 0.f;
#pragma unroll
                for (int e = 0; e < NE; ++e) if (e != e0 && (e1 < 0 || lg[e] > v1)) { v1 = lg[e]; e1 = e; }
                const float w0 = 1.f / (1.f + __expf(v1 - v0));
                if (lane == i) { my_t = row; my_e0 = e0; my_e1 = e1; my_w0 = w0; my_w1 = 1.f - w0; valid = true; }
            }
        }
        if constexpr (MODE == 2) {
            unsigned myc = 0u;
#pragma unroll
            for (int e = 0; e < NE; ++e) { const unsigned long long b0 = __ballot(valid && my_e0 == e), b1 = __ballot(valid && my_e1 == e);
                const unsigned c = (unsigned)(__popcll(b0) + __popcll(b1)); if (lane == e) myc = c; }
            unsigned basev = 0u;
            if (lane < NE) basev = __hip_atomic_fetch_add(R.cnt + 64 * lane, myc, RLX_AGENT);
            const unsigned long long lt = (1ull << lane) - 1ull;
            unsigned pos0 = 0u, pos1 = 0u;
#pragma unroll
            for (int e = 0; e < NE; ++e) { const unsigned long long b0 = __ballot(valid && my_e0 == e), b1 = __ballot(valid && my_e1 == e);
                const unsigned be = (unsigned)__shfl((int)basev, e);
                if (my_e0 == e) pos0 = be + (unsigned)__popcll(b0 & lt);
                if (my_e1 == e) pos1 = be + (unsigned)__popcll(b0) + (unsigned)__popcll(b1 & lt); }
            if (valid) {
                ((GAS unsigned*)R.ltok)[(size_t)my_e0 * LIST_CAP + pos0] = (unsigned)my_t;             ((GAS float*)R.lw)[(size_t)my_e0 * LIST_CAP + pos0] = my_w0;
                ((GAS unsigned*)R.ltok)[(size_t)my_e1 * LIST_CAP + pos1] = (unsigned)my_t | (1u << 20); ((GAS float*)R.lw)[(size_t)my_e1 * LIST_CAP + pos1] = my_w1;
            }
        }
    }
    if constexpr (MODE == 2) { LDS_WAIT(); __syncthreads(); }
}

__device__ __forceinline__ void kstat_phase(Frame& F, const bf16* Kt, float* kmean, float* kmax2) {
    int lane_ = F.lane; asm volatile("" : "+v"(lane_));
    const int gw = F.vcu * NWAVES + F.wave, NGW = F.G * NWAVES, lane = lane_;
    for (int task = gw; task < BATCH * 16 * 8; task += NGW) {
        const int c8 = task & 7, n = (task >> 3) & 15, b = task >> 7;
        const GAS unsigned* p = (const GAS unsigned*)(Kt + ((size_t)b * SEQ + 256 * n) * D + c8 * 128) + lane;
        float a0 = 0.f, a1 = 0.f, mx = 0.f;
#pragma unroll 32
        for (int r = 0; r < 256; ++r) { const unsigned w = p[(size_t)r * (D / 2)]; const float v0 = bflo(w), v1 = bfhi(w); a0 += v0; a1 += v1;
            float s = v0 * v0 + v1 * v1; s += __shfl_xor(s, 1); s += __shfl_xor(s, 2); s += __shfl_xor(s, 4); s += __shfl_xor(s, 8); s += __shfl_xor(s, 16); mx = fmaxf(mx, s); }
        const int col = c8 * 128 + 2 * lane, hh = col >> 6, d = col & 63;
        GAS float* o = (GAS float*)(kmean + ((size_t)(b * 16 + hh) * 16 + n) * 64 + d);
        o[0] = a0 * (1.f / 256.f); o[1] = a1 * (1.f / 256.f);
        if ((lane & 31) == 0) ((GAS float*)kmax2)[(size_t)(b * 16 + hh) * 16 + n] = mx;
    }
}

struct KArgs { const float* in[17]; float* out; unsigned char* ws; int ph_lo, ph_hi; };
struct ConvDesc { const float* W; int K, N; unsigned char* WT; int il; bool f8; float sc; };
constexpr int NCONV = 61, CONV_CH = 128;
__device__ __forceinline__ ConvDesc conv_desc(const KArgs& args, unsigned char* ws, int m) {
    constexpr float WSC_UP = 32.0f, WSC_DN = 64.0f;
    ConvDesc d; d.il = 0; d.f8 = false; d.sc = 1.0f;
    if (m < 2) { d.W = args.in[7] + (size_t)m * D * 3 * D; d.K = D; d.N = 3 * D; d.WT = ws + WS_MQKV + (size_t)m * 3 * D * D * 2; }
    else if (m < 4) { const int j = m - 2; d.W = args.in[8] + (size_t)j * D * D; d.K = D; d.N = D; d.WT = ws + WS_MWO + (size_t)j * D * D * 2; }
    else if (m == 4) { d.W = args.in[4]; d.K = D; d.N = D; d.WT = ws + WS_DWO; }
    else if (m == 5) { d.W = args.in[3] + (size_t)D * 3 * D; d.K = D; d.N = 3 * D; d.WT = ws + WS_DQKV + (size_t)3 * D * D * 2; }
    else if (m == 6) { d.W = args.in[4] + (size_t)D * D; d.K = D; d.N = D; d.WT = ws + WS_DWO + (size_t)D * D * 2; }
    else if (m < 13) { const int r = m - 7, j = r / 3, t = r % 3; d.f8 = (j == 1);
        if (t < 2) { d.W = args.in[9 + t] + (size_t)j * D * DFF; d.K = D; d.N = DFF; d.WT = ws + WS_FGU + (size_t)j * 2 * DFF * D * 2; d.il = 1 + t; d.sc = d.f8 ? WSC_UP : 1.0f; }
        else { d.W = args.in[11] + (size_t)j * DFF * D; d.K = DFF; d.N = D; d.WT = ws + WS_FD + (size_t)j * D * DFF * 2; d.sc = d.f8 ? WSC_DN : 1.0f; } }
    else { const int r = m - 13, e = r / 3, t = r % 3; d.f8 = true;
        if (t < 2) { d.W = args.in[13 + t] + (size_t)e * D * DE; d.K = D; d.N = DE; d.WT = ws + WS_MGU + (size_t)e * 2 * DE * D; d.il = 1 + t; d.sc = WSC_UP; }
        else { d.W = args.in[15] + (size_t)e * DE * D; d.K = DE; d.N = D; d.WT = ws + WS_MD + (size_t)e * D * DE; d.sc = WSC_DN; } }
    return d;
}
__device__ __forceinline__ int conv_chunks_of(int m) { const int items = m < 2 || m == 5 ? 768 : (m < 7 ? 256 : (m < 13 ? 704 : 896)); return (items + CONV_CH - 1) / CONV_CH; }
__device__ __forceinline__ int conv_total_chunks() { int s = 0; for (int m = 0; m < NCONV; ++m) s += conv_chunks_of(m); return s; }
__device__ __forceinline__ void conv_chunk(Frame& F, const KArgs& args, unsigned char* ws, int c) {
    int m = 0; for (; m < NCONV; ++m) { const int n = conv_chunks_of(m); if (c < n) break; c -= n; }
    const ConvDesc d = conv_desc(args, ws, m);
    LAS float* scr = (LAS float*)(F.lds + RING_OFF + F.wave * 16384);
    int lane_ = F.lane; asm volatile("" : "+v"(lane_));
    const int nblk = d.N / 64, nitems = (d.K / 64) * nblk, last = (c + 1) * CONV_CH < nitems ? (c + 1) * CONV_CH : nitems;
    for (int it = c * CONV_CH + F.wave; it < last; it += NWAVES) {
        const int kb = it / nblk, nb = it % nblk, n0 = 64 * nb;
        const int drow0 = d.il == 0 ? n0 : (n0 / 128) * 256 + (d.il - 1) * 128 + (n0 % 128);
        transpose_item(d.W, d.K, d.N, d.WT, 64 * kb, n0, drow0, scr, lane_, d.f8, d.sc);
    }
}

__global__ void __launch_bounds__(NWAVES * 64, 2) trunk_fwd(KArgs args) {
    extern __shared__ __attribute__((aligned(16))) unsigned char lds[];
    Frame F;
    F.lds = (LAS unsigned char*)lds;
    F.MISC = (volatile LAS unsigned*)(F.lds + MISC_OFF);
    F.tid = threadIdx.x; F.lane = F.tid & 63; F.wave = __builtin_amdgcn_readfirstlane(F.tid >> 6);
    F.G = gridDim.x; { const int bx = blockIdx.x; F.vcu = (F.G % 8 == 0) ? (bx % 8) * (F.G / 8) + bx / 8 : bx; }
    F.ctl = (gu32*)(args.ws + WS_CTL);
    for (int u = F.tid; u < (LDS_BYTES - LDSCTL_OFF) / 4; u += NWAVES * 64) ((LAS unsigned*)(F.lds + LDSCTL_OFF))[u] = 0u;
    __syncthreads();
    Frame& F0 = F;
    const int lo = args.ph_lo, hi = args.ph_hi;
    XcdBarrier bar; bar.bar = (unsigned*)(F.ctl + CW_BAR); bar.x = 0; bar.st = nullptr;
    if (hi - lo > 1) bar = xcd_barrier_post((unsigned*)(F.ctl + CW_BAR), F.MISC + 8);
#define IN(k) (lo <= (k) && (k) < hi)
#ifndef PH_ENABLE
#define PH_ENABLE 0xFFFFFFFFu
#endif
#define PHEN(n) (((PH_ENABLE) >> (n)) & 1u)
#ifndef MK_DOUBLE
#define MK_DOUBLE 0u
#endif
#define NREP(n) ((((MK_DOUBLE) >> (n)) & 1u) ? 2 : 1)
#if defined(NO_OPQ)
#define OPQ(p) do {} while (0)
#else
#define OPQ(p) asm volatile("" : "+s"(p))
#endif
#if 0
#define STAMP(k) do { if (blockIdx.x == 0 && threadIdx.x == 0) { const unsigned long long t_ = __builtin_amdgcn_s_memrealtime(); ((GAS unsigned*)(F0.ctl))[3000 + (k)] = (unsigned)t_; } } while (0)
#else
#define STAMP(k) do {} while (0)
#endif
#define SEAM(k) do { if (IN(k) && IN((k) + 1)) { XcdBarrier b2_ = bar; OPQ(b2_.bar); xcd_barrier(b2_); } STAMP((k) + 1); } while (0)

#define PTRS() unsigned char* ws = args.ws; OPQ(ws); const float* x = args.in[0]; OPQ(x); const float* norm_mix = args.in[1]; OPQ(norm_mix); const float* norm_ffn = args.in[2]; OPQ(norm_ffn); \
    float* h = args.out; OPQ(h); \
    bf16* XN = (bf16*)(ws + WS_XN); bf16* Qb = (bf16*)(ws + WS_Q); bf16* Kb = (bf16*)(ws + WS_K); bf16* Vb = (bf16*)(ws + WS_V); bf16* ACT = (bf16*)(ws + WS_ACT); \
    bf16* MGU = (bf16*)(ws + WS_MGU); bf16* MD = (bf16*)(ws + WS_MD); \
    float* kmean = (float*)(ws + WS_KMEAN); unsigned* ltok = (unsigned*)(ws + WS_LTOK); float* lw = (float*)(ws + WS_LW); \
    (void)x; (void)norm_mix; (void)norm_ffn; (void)h; (void)XN; (void)Qb; (void)Kb; (void)Vb; (void)ACT; (void)MGU; (void)MD; (void)kmean; (void)ltok; (void)lw
    const RouterArgs noR{nullptr, nullptr, nullptr, nullptr};
#ifndef MK_F8_DENSE
#define MK_F8_DENSE 0
#endif
    constexpr bool F8_DENSE = MK_F8_DENSE != 0; constexpr int DESZ = F8_DENSE ? 1 : 2;
    constexpr float WSC_UP = 32.0f, WSC_DN = 64.0f;
    constexpr float C2 = 0.125f * 1.4426950408889634f;

    STAMP(0);
    if (PHEN(0) && IN(0)) {
        PTRS();
        { unsigned rot = 0u;
        convert_matrix(F, args.in[3], D, 3 * D, ws + WS_DQKV, 0, rot);
        norm_phase<0>(F, x, nullptr, nullptr, norm_mix, XN, nullptr, noR);
        }
    }
    SEAM(0);

    for (int L = 0; L < NLAYER; ++L) {
        const int j = L >> 1, moba = L & 1, pb = 1 + PH_PER_LAYER * L;
        int z_ = 0;
#if !defined(NO_OPQ_Z)
        asm volatile("" : "+s"(z_));
#endif
        Frame Fl = F0; Fl.G += z_; Fl.vcu += z_; Fl.wave += z_; Fl.lds += z_; Fl.ctl += z_; const int bx = (int)blockIdx.x + z_;
#define F Fl
        if (PHEN(1) && IN(pb + 0)) {
            PTRS();

            const bf16* W = (const bf16*)(ws + (moba ? WS_MQKV : WS_DQKV)) + (size_t)j * 3 * D * D;
            pg8::Gemm g{XN, W, 2 * D, 0}; pg8::StaticOrder S; S.init(MTOK, 3 * D, F.G, bx);
            pg8::EpiQKV E{Qb, D, D, (size_t)(WS_K - WS_Q) / 2, C2};
            for (int rep_ = 0; rep_ < NREP(1); ++rep_) pg8::gemm_phase<pg8::EpiQKV, pg8::StaticOrder>(F.lds + RING_OFF, XSLOT_OFF, g, S, E);
        }
        SEAM(pb + 0);
        { if (PHEN(2) && IN(pb + 1)) { PTRS(); kstat_phase(F, Kb, kmean, kmean + 8 * 16 * 16 * 64); } SEAM(pb + 1); }
        if (IN(pb + 2)) {
            PTRS();
            att::Args A; A.Q = Qb; A.K = Kb; A.V = Vb; A.O = XN; A.kmean = kmean; A.kmax2 = kmean + 8 * 16 * 16 * 64; A.subln = args.in[6] + (size_t)j * 128; A.lam_full = 0.f; A.out_scale = 1.f; A.abl = 0;
            LAS int* qw;
            if (!moba) {
                const float* lam = args.in[5] + (size_t)j * 256; int lane = F.lane; asm volatile("" : "+v"(lane));
                const GAS float* lamg = (const GAS float*)lam; const float s1 = wave_sum(lamg[lane] * lamg[64 + lane]), s2 = wave_sum(lamg[128 + lane] * lamg[192 + lane]);
                const float lam_init = (L == 0) ? 0.2f : 0.47071302f;
                A.lam_full = __uint_as_float(__builtin_amdgcn_readfirstlane(__float_as_uint(__expf(s1) - __expf(s2) + lam_init))); A.out_scale = __uint_as_float(__builtin_amdgcn_readfirstlane(__float_as_uint(1.0f - lam_init)));
            }
            const int nconv = (L == 0) ? conv_total_chunks() : 0;
            qw = (LAS int*)(F.lds + XSLOT_OFF);
            const int xme = (int)(xb_xcc_id() & 7u);
            if ((PHEN(3) && !moba) || (PHEN(4) && moba)) for (int rep_ = 0; rep_ < (moba ? NREP(4) : NREP(3)); ++rep_) for (int xq = xme;;) {
#if ATT_ABLATE
                { const bool ab_ = rep_ == 0 && (moba ? NREP(4) : NREP(3)) == 2; A.abl = ab_ ? ATT_ABLATE : 0; A.O = ab_ ? (bf16*)(ws + WS_END) : XN; }
#endif
                const int ncx = (nconv && rep_ == 0) ? ((nconv - xq + 7) >> 3) : 0;
                gu32* qb = F.ctl + CW_ATTQ2 + 256 * L + 1024 * rep_; gu32* qx = qb + 32 * xq;
                for (;;) {
                    if (F.tid == 0) *qw = (int)__hip_atomic_fetch_add(qx, 1u, RLX_AGENT);
                    asm volatile("s_waitcnt vmcnt(0) lgkmcnt(0)\n\ts_barrier" ::: "memory");
                    int idx = __builtin_amdgcn_readfirstlane(*qw);
                    if (idx >= 128 + ncx) { asm volatile("s_waitcnt vmcnt(0) lgkmcnt(0)\n\ts_barrier" ::: "memory"); break; }
                    if (ncx) { const int q3 = idx / 3; if (idx < 3 * ncx) { if (idx - 3 * q3 == 2) { conv_chunk(F, args, ws, xq + 8 * q3); asm volatile("s_waitcnt vmcnt(0) lgkmcnt(0)\n\ts_barrier" ::: "memory"); continue; } idx -= q3; } else idx -= ncx; }
                    if (!moba) { const int hh = 7 - (idx >> 4), pr = idx & 15;
                        att::attn_unit<0>(F.lds + RING_OFF, A, xq, hh, pr);
                        att::attn_unit<0>(F.lds + RING_OFF, A, xq, hh, 31 - pr);
                    } else { const int hh = 15 - (idx >> 3), pr = idx & 7;
                        att::attn_unit<1>(F.lds + RING_OFF, A, xq, hh, pr);
                        att::attn_unit<1>(F.lds + RING_OFF, A, xq, hh, 15 - pr); }
                }
                if (F.tid < 64) { int lane = F.tid; asm volatile("" : "+v"(lane)); bool av = false;
                    if (lane < 8) { const int lim = 128 + ((nconv && rep_ == 0) ? ((nconv - lane + 7) >> 3) : 0); av = (int)__hip_atomic_load(qb + 32 * lane, RLX_AGENT) < lim; }
                    const unsigned long long m_ = __ballot(av);
                    if (lane == 0) *qw = (int)(unsigned)m_; }
                asm volatile("s_waitcnt vmcnt(0) lgkmcnt(0)\n\ts_barrier" ::: "memory");
                const unsigned m = (unsigned)__builtin_amdgcn_readfirstlane(*qw);
                asm volatile("s_waitcnt vmcnt(0) lgkmcnt(0)\n\ts_barrier" ::: "memory");
                if (m == 0u) break;
                const unsigned rot = ((m >> xme) | (m << (8 - xme))) & 0xFFu;
                xq = (xme + __builtin_ctz(rot)) & 7;
            }
            asm volatile("s_waitcnt vmcnt(0) lgkmcnt(0)\n\ts_barrier" ::: "memory");
        }
        SEAM(pb + 2);
        if (PHEN(5) && IN(pb + 3)) {
            PTRS();
            const bf16* W = (const bf16*)(ws + (moba ? WS_MWO : WS_DWO)) + (size_t)j * D * D;
            pg8::Gemm g{XN, W, 2 * D, 0}; pg8::StaticOrder S; S.init(MTOK, D, F.G, bx);
            pg8::EpiRes E{L == 0 ? x : h, h, D, 1.0f};
            pg8::gemm_phase<pg8::EpiRes, pg8::StaticOrder>(F.lds + RING_OFF, XSLOT_OFF, g, S, E);
        }
        SEAM(pb + 3);
        if (PHEN(6) && IN(pb + 4)) {
            PTRS();
            if (!moba) {
                if (L == 2) norm_phase<0, true>(F, h, nullptr, nullptr, norm_ffn + (size_t)L * D, XN, nullptr, noR);
                else norm_phase<0, false>(F, h, nullptr, nullptr, norm_ffn + (size_t)L * D, XN, nullptr, noR);
            } else {
                const RouterArgs R{args.in[12] + (size_t)j * D * NE, F.ctl + CW_CNT + 64 * NE * j, ltok, lw};
                norm_phase<2, true>(F, h, nullptr, nullptr, norm_ffn + (size_t)L * D, XN, nullptr, R);
            }
        }
        SEAM(pb + 4);
        if (IN(pb + 5)) {
            PTRS();
            if (PHEN(7) && !moba) {
                if (L == 2) { pg8::Gemm g{XN, ws + WS_FGU + (size_t)j * 2 * DFF * D * 2, D, 0}; pg8::StaticOrder S; S.init(MTOK, 2 * DFF, F.G, bx);
                    pg8::EpiSwiGLU<true> E{ACT, DFF, 1.0f / WSC_UP};
                    pg8::gemm_phase<pg8::EpiSwiGLU<true>, pg8::StaticOrder, true>(F.lds + RING_OFF, XSLOT_OFF, g, S, E);
                } else { pg8::Gemm g{XN, ws + WS_FGU + (size_t)j * 2 * DFF * D * 2, 2 * D, 0}; pg8::StaticOrder S; S.init(MTOK, 2 * DFF, F.G, bx);
                    pg8::EpiSwiGLU<false> E{ACT, DFF, 1.0f};
                    pg8::gemm_phase<pg8::EpiSwiGLU<false>, pg8::StaticOrder, false>(F.lds + RING_OFF, XSLOT_OFF, g, S, E); }
            } else if (PHEN(8) && moba) {
                pg8::Gemm g{XN, ws + WS_MGU + (size_t)j * NE * 2 * DE * D, D, (size_t)2 * DE * D}; pg8::MoeOrder S; S.init((const unsigned*)(F.ctl + CW_CNT + 64 * NE * j), ltok, true, 2 * DE, F.G, bx);
                pg8::EpiSwiGLU<true> E{ACT, DE, 1.0f / WSC_UP};
                pg8::gemm_phase<pg8::EpiSwiGLU<true>, pg8::MoeOrder, true>(F.lds + RING_OFF, XSLOT_OFF, g, S, E);
            }
        }
        SEAM(pb + 5);
        if (IN(pb + 6)) {
            PTRS();
            if (PHEN(9) && !moba) {
                if (L == 2) { pg8::Gemm g{ACT, ws + WS_FD + (size_t)j * D * DFF * 2, DFF, 0}; pg8::StaticOrder S; S.init(MTOK, D, F.G, bx);
                    pg8::EpiRes E{h, h, D, 1.0f / WSC_DN};
                    pg8::gemm_phase<pg8::EpiRes, pg8::StaticOrder, true>(F.lds + RING_OFF, XSLOT_OFF, g, S, E);
                } else { pg8::Gemm g{ACT, ws + WS_FD + (size_t)j * D * DFF * 2, 2 * DFF, 0}; pg8::StaticOrder S; S.init(MTOK, D, F.G, bx);
                    pg8::EpiRes E{h, h, D, 1.0f};
                    pg8::gemm_phase<pg8::EpiRes, pg8::StaticOrder, false>(F.lds + RING_OFF, XSLOT_OFF, g, S, E); }
            } else if (PHEN(10) && moba) {
                pg8::Gemm g{ACT, ws + WS_MD + (size_t)j * NE * D * DE, DE, (size_t)D * DE}; pg8::MoeOrder S; S.init((const unsigned*)(F.ctl + CW_CNT + 64 * NE * j), ltok, false, D, F.G, bx);
                pg8::EpiMoeDown E; E.h = h; E.y1 = XN; E.list_tok = ltok; E.list_w = lw; E.sc = 1.0f / WSC_DN;
#pragma unroll
                for (int e = 0; e < NE; ++e) E.cnt[e] = S.cnt[e];
                pg8::gemm_phase<pg8::EpiMoeDown, pg8::MoeOrder, true>(F.lds + RING_OFF, XSLOT_OFF, g, S, E);
            }
        }
        SEAM(pb + 6);
        if (PHEN(11) && IN(pb + 7)) {
            PTRS();
            if (L == 3) norm_phase<3>(F, h, nullptr, XN, args.in[16], nullptr, h, noR);
            else if (moba) norm_phase<1>(F, h, h, XN, norm_mix + (size_t)(L + 1) * D, XN, nullptr, noR);
            else for (int rep_ = 0; rep_ < NREP(11); ++rep_) norm_phase<0>(F, h, nullptr, nullptr, norm_mix + (size_t)(L + 1) * D, XN, nullptr, noR);
        }
        if (L != NLAYER - 1) SEAM(pb + 7); else STAMP(pb + 8);
#undef F
    }
#undef IN
#undef SEAM
#undef PTRS
#undef OPQ
}


#if MK_DEBUG
__global__ void dbg_probe(const void* buf, size_t n, int is_bf16, int idx, float thresh, unsigned* dbg) {
    size_t i = blockIdx.x * (size_t)blockDim.x + threadIdx.x, stride = (size_t)gridDim.x * blockDim.x; bool bad = false;
    for (size_t k = i; k < n; k += stride) { float v = is_bf16 ? __uint_as_float(((unsigned)((const unsigned short*)buf)[k]) << 16) : ((const float*)buf)[k]; if (!(fabsf(v) <= thresh)) bad = true; }
    if (bad) atomicMax(dbg, (unsigned)(1000 - idx));
}
__global__ void dbg_cnt(const unsigned* cntw, int idx, unsigned* dbg) {
    if (threadIdx.x == 0 && blockIdx.x == 0) { unsigned s = 0; for (int e = 0; e < NE; ++e) s += cntw[64 * e]; if (s != 2u * MTOK) atomicMax(dbg, (unsigned)(1000 - idx)); }
}

__device__ __forceinline__ float dbg_bf(unsigned short v) { return __uint_as_float(((unsigned)v) << 16); }
__device__ __forceinline__ unsigned dbg_hash(unsigned x) { x ^= x >> 16; x *= 0x7feb352dU; x ^= x >> 15; x *= 0x846ca68bU; x ^= x >> 16; return x; }
__global__ void dbg_gemm_check(const unsigned short* A, int lda, const unsigned short* Bt, int K, const unsigned short* out, int ldo, int M, int N, float scale, int idx, unsigned* dbg) {
    const unsigned s = blockIdx.x * blockDim.x + threadIdx.x; const int row = (int)(dbg_hash(2 * s + 1) % (unsigned)M), col = (int)(dbg_hash(2 * s + 2) % (unsigned)N);
    float acc = 0.f; for (int k = 0; k < K; ++k) acc += dbg_bf(A[(size_t)row * lda + k]) * dbg_bf(Bt[(size_t)col * K + k]);
    acc *= scale; const float got = dbg_bf(out[(size_t)row * ldo + col]);
    if (!(fabsf(got - acc) <= 0.03f + 0.02f * fabsf(acc))) { atomicMax(dbg, (unsigned)(1000 - idx)); atomicAdd(dbg + 64 + idx, 1u); }
}
__global__ void dbg_conv_check(const float* W, int K, int N, const unsigned short* WT, int il, int idx, unsigned* dbg) {
    const unsigned s = blockIdx.x * blockDim.x + threadIdx.x; const int k = (int)(dbg_hash(2 * s + 1) % (unsigned)K), n = (int)(dbg_hash(2 * s + 2) % (unsigned)N);
    const int dr = il == 0 ? n : (n / 128) * 256 + (il - 1) * 128 + (n % 128);
    const float w = W[(size_t)k * N + n], g = dbg_bf(WT[(size_t)dr * K + k]);
    if (!(fabsf(g - w) <= 0.01f * fabsf(w) + 1e-6f)) atomicMax(dbg, (unsigned)(1000 - idx));
}
__global__ void dbg_norm_check(const float* src, const float* gain, const unsigned short* xn, int idx, unsigned* dbg) {
    const unsigned s = blockIdx.x * blockDim.x + threadIdx.x; const int row = (int)(dbg_hash(s + 77) % (unsigned)MTOK);
    float ss = 0.f; for (int c = 0; c < D; ++c) { const float v = src[(size_t)row * D + c]; ss += v * v; }
    const float rstd = 1.f / sqrtf(ss / D + 1e-6f); bool bad = false;
    for (int c = 0; c < D; ++c) { const float r = src[(size_t)row * D + c] * rstd * gain[c], g = dbg_bf(xn[(size_t)row * D + c]); if (!(fabsf(g - r) <= 0.02f + 0.01f * fabsf(r))) bad = true; }
    if (bad) atomicMax(dbg, (unsigned)(1000 - idx));
}
__global__ void dbg_naive_gemm(const unsigned short* A, const unsigned short* Bt, unsigned short* out, int M, int N, int K) {
    const size_t i = blockIdx.x * (size_t)blockDim.x + threadIdx.x; if (i >= (size_t)M * N) return; const int row = (int)(i / N), col = (int)(i % N);
    float acc = 0.f; for (int k = 0; k < K; ++k) acc += dbg_bf(A[(size_t)row * K + k]) * dbg_bf(Bt[(size_t)col * K + k]);
    out[(size_t)row * N + col] = (unsigned short)f2bf(acc);
}
__global__ void dbg_find_col(const unsigned short* out, const unsigned short* ref, int M, int N, unsigned* hist) {
    const unsigned s = blockIdx.x * blockDim.x + threadIdx.x; const int row = (int)(dbg_hash(2 * s + 1) % (unsigned)M), col = (int)(dbg_hash(2 * s + 2) % (unsigned)N);
    const unsigned short v = out[(size_t)row * N + col]; int found = -1;
#if MK_FIND_PATTERN
    if (v == 0x3C3C) atomicAdd(hist + N, 1u); else atomicAdd(hist + 5, 1u); return;
#endif
#if MK_FIND_ROWS
    for (int r = 0; r < M; ++r) if (ref[(size_t)r * N + col] == v) { found = r; break; }
    if (found < 0) atomicAdd(hist + N, 1u); else atomicAdd(hist + ((found - row) & (N - 1)), 1u);
#else
    for (int c = 0; c < N; ++c) if (ref[(size_t)row * N + c] == v) { found = c; break; }
    if (found < 0) atomicAdd(hist + N, 1u); else atomicAdd(hist + ((found - col) & (N - 1)), 1u);
#endif
}
__global__ void dbg_hist_code(const unsigned* hist, int N, unsigned* dbg) {
    if (threadIdx.x || blockIdx.x) return; unsigned best = 0, bi = 0; for (int i = 0; i < N; ++i) if (hist[i] > best) { best = hist[i]; bi = i; }
    dbg[32] = bi; dbg[33] = best; dbg[34] = hist[N];
}
__global__ void dbg_final(float* out, size_t n, const unsigned* dbg) {
    if (MK_HIST_SEL >= 10) { const float c3 = sqrtf((float)dbg[MK_HIST_SEL + 30]); size_t i3 = blockIdx.x * (size_t)blockDim.x + threadIdx.x, st3 = (size_t)gridDim.x * blockDim.x; for (size_t k3 = i3; k3 < n; k3 += st3) out[k3] = c3; return; }
    if (MK_HIST_SEL >= 0 && (dbg[33] || dbg[34])) { const float c2 = sqrtf((float)(MK_HIST_SEL == 0 ? dbg[32] : (MK_HIST_SEL == 1 ? dbg[33] * 100u / 4096u : dbg[34] * 100u / 4096u)) + 1.f); size_t i2 = blockIdx.x * (size_t)blockDim.x + threadIdx.x, st2 = (size_t)gridDim.x * blockDim.x; for (size_t k2 = i2; k2 < n; k2 += st2) out[k2] = c2; return; }
    const unsigned d = dbg[0]; if (d == 0u) return; const unsigned nf = dbg[64 + (1000u - d)]; const float c = sqrtf(nf ? (float)(200u * (1000u - d - 9u) + nf * 100u / 4096u) : (float)(1000u - d));
    size_t i = blockIdx.x * (size_t)blockDim.x + threadIdx.x, stride = (size_t)gridDim.x * blockDim.x;
    for (size_t k = i; k < n; k += stride) out[k] = c;
}
#endif

#ifndef MK_REPEAT
#define MK_REPEAT 1
#endif
#ifndef MK_FIND_ROWS
#define MK_FIND_ROWS 0
#endif
#ifndef MK_FIND_REGION
#define MK_FIND_REGION WS_K
#endif
#ifndef MK_HIST_SEL
#define MK_HIST_SEL 0
#endif
#ifndef MK_STAMP
#define MK_STAMP 0
#endif
#if MK_STAMP
__global__ void stamp_k(unsigned* p) { if (threadIdx.x == 0) *p = (unsigned)__builtin_amdgcn_s_memrealtime(); }
__global__ void stamp_encode(float* out, size_t n, const unsigned* st, int pa, float ua, int pb, float ub) {
    const float da = (float)(st[pa + 1] - st[pa]) * 0.01f, db = (float)(st[pb + 1] - st[pb]) * 0.01f;
    float m = da / ua; m = m < 10.f ? 10.f : (m > 99.f ? 99.f : m); float e = floorf(db / ub + 0.5f); e = e < 0.f ? 0.f : (e > 30.f ? 30.f : e);
    const float c = sqrtf(m) * __powf(10.f, 0.5f * e);
    size_t i = blockIdx.x * (size_t)blockDim.x + threadIdx.x, stride = (size_t)gridDim.x * blockDim.x;
    for (size_t k = i; k < n; k += stride) out[k] = c;
}
#endif
extern "C" void kernel_launch(void* const* d_in, const int* in_sizes, int n_in, void* d_out, int out_size, void* d_ws, size_t ws_size, hipStream_t stream) {
    static int grid = 0;
    if (grid == 0) {
        if (n_in != 17 || in_sizes[0] != MTOK * D || out_size != MTOK * D || ws_size < WS_END) {
            fprintf(stderr, "kernel_launch: built for 17 inputs, x/out of %d floats, >= %zu bytes of workspace; got n_in %d, in0 %d, out %d, ws %zu; nothing launched\n", MTOK * D, (size_t)WS_END, n_in, n_in > 0 ? in_sizes[0] : -1, out_size, ws_size);
            grid = -1; return; }
        int dev = 0, cus = 0, per_cu = 0;
        if (hipGetDevice(&dev) != hipSuccess || hipDeviceGetAttribute(&cus, hipDeviceAttributeMultiprocessorCount, dev) != hipSuccess) { fprintf(stderr, "kernel_launch: device query failed\n"); grid = -1; return; }
        if (hipFuncSetAttribute((const void*)trunk_fwd, hipFuncAttributeMaxDynamicSharedMemorySize, LDS_BYTES) != hipSuccess) { fprintf(stderr, "kernel_launch: hipFuncSetAttribute failed\n"); grid = -1; return; }
        if (hipOccupancyMaxActiveBlocksPerMultiprocessor(&per_cu, (const void*)trunk_fwd, NWAVES * 64, LDS_BYTES) != hipSuccess || per_cu < 1)
            fprintf(stderr, "kernel_launch: note: occupancy query reports %d workgroups per CU\n", per_cu);
        (void)hipGetLastError();
        grid = cus;
    }
    if (grid < 0) return;
    if (hipMemsetAsync((char*)d_ws + WS_CTL, 0, CTL_ZERO_BYTES, stream) != hipSuccess) { fprintf(stderr, "kernel_launch: memset failed\n"); return; }
    KArgs a{};
    for (int i = 0; i < 17; ++i) a.in[i] = (const float*)d_in[i];
    a.out = (float*)d_out; a.ws = (unsigned char*)d_ws;
#if MK_PER_PHASE
#if MK_STAMP
    hipLaunchKernelGGL(stamp_k, dim3(1), dim3(64), 0, stream, (unsigned*)d_ws + 3000);
#endif
    for (int p = 0; p < NPHASE; ++p) {
        a.ph_lo = p; a.ph_hi = p + 1;
#if MK_DEBUG
#endif
#if !defined(MK_SKIP_MAIN)
        for (int rep_ = 0; rep_ < (p == 1 ? MK_REPEAT : 1); ++rep_) hipLaunchKernelGGL(trunk_fwd, dim3(grid), dim3(NWAVES * 64), LDS_BYTES, stream, a);
#endif
#if MK_STAMP
        hipLaunchKernelGGL(stamp_k, dim3(1), dim3(64), 0, stream, (unsigned*)d_ws + 3000 + p + 1);
#endif
#if MK_DEBUG
        {   unsigned char* ws = (unsigned char*)d_ws; unsigned* dbg = (unsigned*)(ws + WS_CTL) + 2048;
            const size_t MD_ = (size_t)MTOK * D;
#define PROBE(buf, n, isbf, idx, th) if ((idx) <= MK_PROBE_MAX) hipLaunchKernelGGL(dbg_probe, dim3(2048), dim3(256), 0, stream, (const void*)(buf), (size_t)(n), isbf, idx, th, dbg)
            if (p == 0) {
                hipLaunchKernelGGL(dbg_norm_check, dim3(4), dim3(64), 0, stream, (const float*)d_in[0], (const float*)d_in[1], (const unsigned short*)(ws + WS_XN), 4, dbg);
                hipLaunchKernelGGL(dbg_conv_check, dim3(16), dim3(256), 0, stream, (const float*)d_in[3], D, 3 * D, (const unsigned short*)(ws + WS_DQKV), 0, 5, dbg);
                hipLaunchKernelGGL(dbg_conv_check, dim3(16), dim3(256), 0, stream, (const float*)d_in[9], D, DFF, (const unsigned short*)(ws + WS_FGU), 1, 6, dbg);
                hipLaunchKernelGGL(dbg_conv_check, dim3(16), dim3(256), 0, stream, (const float*)d_in[10], D, DFF, (const unsigned short*)(ws + WS_FGU), 2, 7, dbg);
                hipLaunchKernelGGL(dbg_conv_check, dim3(16), dim3(256), 0, stream, (const float*)d_in[11], DFF, D, (const unsigned short*)(ws + WS_FD), 0, 8, dbg);
                hipLaunchKernelGGL(dbg_conv_check, dim3(16), dim3(256), 0, stream, (const float*)d_in[15] + (size_t)3 * DE * D, DE, D, (const unsigned short*)(ws + WS_MD) + (size_t)3 * D * DE, 0, 9, dbg);
            }
            if (p == 1) {
                const float C2h = 0.125f * 1.4426950408889634f;
                hipLaunchKernelGGL(dbg_gemm_check, dim3(16), dim3(256), 0, stream, (const unsigned short*)(ws + WS_XN), D, (const unsigned short*)(ws + WS_DQKV), D, (const unsigned short*)(ws + WS_Q), D, MTOK, D, C2h, 10, dbg);
                hipLaunchKernelGGL(dbg_gemm_check, dim3(16), dim3(256), 0, stream, (const unsigned short*)(ws + WS_XN), D, (const unsigned short*)(ws + WS_DQKV) + (size_t)D * D, D, (const unsigned short*)(ws + WS_K), D, MTOK, D, 1.f, 11, dbg);

                hipLaunchKernelGGL(dbg_gemm_check, dim3(16), dim3(256), 0, stream, (const unsigned short*)(ws + WS_XN), D, (const unsigned short*)(ws + WS_DQKV) + (size_t)2 * D * D, D, (const unsigned short*)(ws + WS_V), D, MTOK, D, 1.f, 12, dbg);
            }
            if (0) { PROBE(ws + WS_XN, MD_, 1, 1, 10.f); PROBE(ws + WS_DQKV, (WS_MGU - WS_DQKV) / 2, 1, 2, 1.f); PROBE(ws + WS_MGU, (WS_XN - WS_MGU) / 2, 1, 3, 1.f); }
            if (p >= 1) { const int L = (p - 1) / PH_PER_LAYER, k = (p - 1) % PH_PER_LAYER; const int b = 20 + 10 * L;
                if (k == 0) PROBE(ws + WS_Q, 3 * MD_, 1, b + 0, 50.f);
                if (k == 1) PROBE(ws + WS_KMEAN, 8 * 16 * 16 * 64, 0, b + 1, 5.f);
                if (k == 2) PROBE(ws + WS_XN, MD_, 1, b + 2, 50.f);
                if (k == 3) PROBE(d_out, MD_, 0, b + 3, 300.f);
                if (k == 4) { PROBE(ws + WS_XN, MD_, 1, b + 4, 20.f); if ((L & 1) && (b + 9) <= MK_PROBE_MAX) hipLaunchKernelGGL(dbg_cnt, dim3(1), dim3(64), 0, stream, (const unsigned*)(ws + WS_CTL) + CW_CNT + 64 * NE * (L >> 1), b + 9, dbg); }
                if (k == 5) PROBE(ws + WS_ACT, (L & 1) ? (size_t)256 * 256 * DE : (size_t)MTOK * DFF, 1, b + 5, 2000.f);
                if (k == 6) { PROBE(d_out, MD_, 0, b + 6, 1000.f); if (L & 1) PROBE(ws + WS_XN, MD_, 1, b + 7, 1000.f); }
                if (k == 7 && L != 3) { PROBE(ws + WS_XN, MD_, 1, b + 8, 20.f); PROBE(d_out, MD_, 0, b + 8, 1000.f); }
            }
#undef PROBE
        }
#endif
    }
#if MK_DEBUG
    hipLaunchKernelGGL(dbg_final, dim3(2048), dim3(256), 0, stream, (float*)d_out, (size_t)MTOK * D, (const unsigned*)((unsigned char*)d_ws + WS_CTL) + 2048);
#endif
#else
    a.ph_lo = 0; a.ph_hi = NPHASE;
    hipLaunchKernelGGL(trunk_fwd, dim3(grid), dim3(NWAVES * 64), LDS_BYTES, stream, a);
#if 0
    hipLaunchKernelGGL(stamp_encode, dim3(2048), dim3(256), 0, stream, (float*)d_out, (size_t)MTOK * D, (const unsigned*)d_ws + 3000, MK_STAMP_PA, MK_STAMP_UA, MK_STAMP_PB, MK_STAMP_UB);
#endif
#endif
#if MK_STAMP
    hipLaunchKernelGGL(stamp_encode, dim3(2048), dim3(256), 0, stream, (float*)d_out, (size_t)MTOK * D, (const unsigned*)d_ws + 3000, MK_STAMP_PA, MK_STAMP_UA, MK_STAMP_PB, MK_STAMP_UB);
#endif
    const hipError_t le = hipPeekAtLastError();
    if (le != hipSuccess) fprintf(stderr, "kernel_launch: launch failed: %s\n", hipGetErrorName(le));
}
```

```cpp
#ifndef MK_DEBUG
#define MK_DEBUG 0
#endif
#ifndef MK_PER_PHASE
#define MK_PER_PHASE 0
#endif
#include <hip/hip_runtime.h>
#include <cstdio>
#include <cstdint>

#ifndef MK_KDEBUG
#define MK_KDEBUG 0
#endif
#define LAS __attribute__((address_space(3)))
#define GAS __attribute__((address_space(1)))

constexpr int BATCH = 8, SEQ = 4096, MTOK = BATCH * SEQ, D = 1024, DFF = 2816, DE = 3584, NE = 8;
constexpr int MOE_TILES_MAX = 272;
constexpr int LIST_CAP = MTOK;

namespace pg8 {
#define PG8_LAS __attribute__((address_space(3)))
typedef unsigned short bf16_t;
typedef short bf16x8 __attribute__((ext_vector_type(8)));
typedef float f32x4 __attribute__((ext_vector_type(4)));
typedef unsigned u32x4 __attribute__((ext_vector_type(4)));
typedef int i32x4 __attribute__((ext_vector_type(4)));
typedef int i32x8 __attribute__((ext_vector_type(8)));
constexpr int BM = 256, BK = 64, HALF = 128, HTB = HALF * BK * 2  , STAGE_BYTES = 8 * HTB, NXCD = 8, WGM = 8;

__host__ __device__ __forceinline__ int lds_byte(int r, int c) { const int st = (r >> 4) * 2 + (c >> 5), rr = r & 15, cc = c & 31, ob = rr * 64 + cc * 2; return st * 1024 + (ob ^ (((ob >> 9) & 1) << 5)); }
__host__ __device__ __forceinline__ void stage_rc(int b, int& R, int& C) { const int st = b / 1024, sb = b % 1024, swz = sb ^ (((sb >> 9) & 1) << 5); R = (st >> 1) * 16 + swz / 64; C = (st & 1) * 32 + (swz % 64) / 2; }
__host__ __device__ __forceinline__ int perm32(int rho) { const int n = rho >> 4, i = rho & 15; return 8 * (i >> 2) + 4 * n + (i & 3); }

struct Unit { int pm, pn, e, r0; };
struct Gemm { const void* A; const void* Bt; int rowb; size_t bstride; };

__device__ __forceinline__ void tile_of(int L, int nM, int nN, int& pm, int& pn) {
    const int nwg = nM * nN; int wgid = L; { const int q = nwg / NXCD, r = nwg % NXCD, xcd = wgid % NXCD, off = wgid / NXCD; wgid = (xcd < r ? xcd * (q + 1) : r * (q + 1) + (xcd - r) * q) + off; }
    const int nig = WGM * nN, gid = wgid / nig, fm = gid * WGM, gsz = (nM - fm) < WGM ? (nM - fm) : WGM;
    pm = fm + ((wgid % nig) % gsz); pn = (wgid % nig) / gsz;
}
struct StaticOrder {
    int nM, nN, nwg, G, c;
    __device__ __forceinline__ void init(int M, int N, int G_, int c_) { nM = M / BM; nN = N / BM; nwg = nM * nN; G = G_; c = c_; }
    __device__ __forceinline__ bool next(int i, Unit& u) const {
        const long L = (long)i * G + c; if (L >= nwg) return false;
        tile_of((int)L, nM, nN, u.pm, u.pn); u.e = 0; u.r0 = 0; return true;
    }
    __device__ __forceinline__ unsigned arow(const Unit& u, int lr) const { return (unsigned)(u.pm * BM + lr); }
};
struct MoeOrder {
    int nM, nN, nwg, G, c; int tstart[NE + 1]; int cnt[NE]; const unsigned* list_tok; bool gather;
    __device__ __forceinline__ void init(const unsigned* cntw, const unsigned* list_tok_, bool gather_, int N, int G_, int c_) {
        int acc = 0;
#pragma unroll
        for (int e = 0; e < NE; ++e) { const int ce = (int)__builtin_amdgcn_readfirstlane((int)__hip_atomic_load((const GAS unsigned*)cntw + 64 * e, __ATOMIC_RELAXED, __HIP_MEMORY_SCOPE_AGENT)); cnt[e] = ce; tstart[e] = acc; acc += (ce + BM - 1) / BM; }
        tstart[NE] = acc; nM = acc; nN = N / BM; nwg = nM * nN; G = G_; c = c_; list_tok = list_tok_; gather = gather_;
    }
    __device__ __forceinline__ bool next(int i, Unit& u) const {
        const long L = (long)i * G + c; if (L >= nwg) return false;
        tile_of((int)L, nM, nN, u.pm, u.pn); int e = 0;
#pragma unroll
        for (int k = 1; k < NE; ++k) e += (u.pm >= tstart[k]) ? 1 : 0;
        u.e = e; int ts = 0;
#pragma unroll
        for (int k = 0; k < NE; ++k) ts = (k == e) ? tstart[k] : ts;
        u.r0 = (u.pm - ts) * BM; return true;
    }
    __device__ __forceinline__ int count_of(int e) const { int cv = 0;
#pragma unroll
        for (int k = 0; k < NE; ++k) cv = (k == e) ? cnt[k] : cv;
        return cv; }
    __device__ __forceinline__ unsigned arow(const Unit& u, int lr) const {
        if (!gather) return (unsigned)(u.pm * BM + lr);
        const int l = u.r0 + lr; const int cv = count_of(u.e);
        unsigned t = 0u; if (l < cv) t = __hip_atomic_load((const GAS unsigned*)list_tok + (size_t)u.e * LIST_CAP + l, __ATOMIC_RELAXED, __HIP_MEMORY_SCOPE_AGENT) & 0xFFFFFu;
        return t;
    }
};

__device__ __forceinline__ unsigned cvt_pk_bf16(float lo, float hi) { unsigned r; asm volatile("v_cvt_pk_bf16_f32 %0, %1, %2" : "=v"(r) : "v"(lo), "v"(hi)); return r; }

struct EpiQKV {
    static constexpr bool PERM = true;
    bf16_t* O; int ldc; int split_cols; size_t split_stride; float scale0;
    __device__ __forceinline__ void operator()(const f32x4 (&acc)[2][2][4][2], const Unit& u, int wr, int wc, int fr, int fq) const {
        const int row0 = u.pm * BM + wr * 64 + fr; int colt = u.pn * BM; bf16_t* base = O;
        float sc = 1.f; { const int t = colt / split_cols; base += (size_t)t * split_stride; colt -= t * split_cols; if (t == 0) sc = scale0; }
        const int col0 = colt + wc * 32 + 8 * fq;
#pragma unroll
        for (int ai = 0; ai < 2; ++ai)
#pragma unroll
            for (int m = 0; m < 4; ++m) { bf16_t* rowp = base + (size_t)(row0 + ai * HALF + m * 16) * ldc + col0;
#pragma unroll
                for (int bj = 0; bj < 2; ++bj) { f32x4 v0 = acc[ai][bj][m][0] * sc, v1 = acc[ai][bj][m][1] * sc;
                    u32x4 w; w.x = cvt_pk_bf16(v0[0], v0[1]); w.y = cvt_pk_bf16(v0[2], v0[3]); w.z = cvt_pk_bf16(v1[0], v1[1]); w.w = cvt_pk_bf16(v1[2], v1[3]);
                    *(GAS u32x4*)(rowp + bj * HALF) = w;
                    } }
    }
};
__device__ __forceinline__ unsigned pk4_fp8(float a, float b, float c, float d) { unsigned w = 0; w = __builtin_amdgcn_cvt_pk_fp8_f32(a, b, w, false); w = __builtin_amdgcn_cvt_pk_fp8_f32(c, d, w, true); return w; }
template <bool F8OUT> struct EpiSwiGLU {
    static constexpr bool PERM = true;
    void* O; int ldc; float sc;
    __device__ __forceinline__ void operator()(const f32x4 (&acc)[2][2][4][2], const Unit& u, int wr, int wc, int fr, int fq) const {
        const int row0 = u.pm * BM + wr * 64 + fr; const int col0 = u.pn * HALF + wc * 32 + 8 * fq;
#pragma unroll
        for (int ai = 0; ai < 2; ++ai)
#pragma unroll
            for (int m = 0; m < 4; ++m) { float o[8];
#pragma unroll
                for (int n = 0; n < 2; ++n)
#pragma unroll
                    for (int j = 0; j < 4; ++j) { const float g = acc[ai][0][m][n][j] * sc, up = acc[ai][1][m][n][j] * sc;
                        const float s = __builtin_amdgcn_rcpf(1.0f + __builtin_amdgcn_exp2f(-1.4426950408889634f * g)); o[n * 4 + j] = g * s * up; }
                const size_t eo = (size_t)(row0 + ai * HALF + m * 16) * ldc + col0;
                if constexpr (F8OUT) { const unsigned long long w = (unsigned long long)pk4_fp8(o[0], o[1], o[2], o[3]) | ((unsigned long long)pk4_fp8(o[4], o[5], o[6], o[7]) << 32);
                    *(GAS unsigned long long*)((unsigned char*)O + eo) = w;
                } else { u32x4 w; w.x = cvt_pk_bf16(o[0], o[1]); w.y = cvt_pk_bf16(o[2], o[3]); w.z = cvt_pk_bf16(o[4], o[5]); w.w = cvt_pk_bf16(o[6], o[7]);
                    *(GAS u32x4*)((bf16_t*)O + eo) = w; } }
    }
};
struct EpiRes {
    static constexpr bool PERM = false;
    const float* res; float* out; int ldc; float sc;
    __device__ __forceinline__ void operator()(const f32x4 (&acc)[2][2][4][2], const Unit& u, int wr, int wc, int fr, int fq) const {
        const int row0 = u.pm * BM + wr * 64 + fr; const int col0 = u.pn * BM + wc * 32 + 4 * fq;
#pragma unroll
        for (int ai = 0; ai < 2; ++ai)
#pragma unroll
            for (int m = 0; m < 4; ++m) { const size_t off = (size_t)(row0 + ai * HALF + m * 16) * ldc + col0;
#pragma unroll
                for (int bj = 0; bj < 2; ++bj)
#pragma unroll
                    for (int n = 0; n < 2; ++n) { const f32x4 r = *(const GAS f32x4*)(res + off + bj * HALF + n * 16); *(GAS f32x4*)(out + off + bj * HALF + n * 16) = r + acc[ai][bj][m][n] * sc; } }
    }
};
struct EpiMoeDown {
    static constexpr bool PERM = false;
    float* h; bf16_t* y1; const unsigned* list_tok; const float* list_w; int cnt[NE]; float sc;
    __device__ __forceinline__ void operator()(const f32x4 (&acc)[2][2][4][2], const Unit& u, int wr, int wc, int fr, int fq) const {
        int cv = 0;
#pragma unroll
        for (int k = 0; k < NE; ++k) cv = (k == u.e) ? cnt[k] : cv;
        const int col0 = u.pn * BM + wc * 32 + 4 * fq;
#pragma unroll
        for (int ai = 0; ai < 2; ++ai)
#pragma unroll
            for (int m = 0; m < 4; ++m) { const int l = u.r0 + ai * HALF + wr * 64 + m * 16 + fr;
                if (l < cv) {
                    const unsigned ent = __hip_atomic_load((const GAS unsigned*)list_tok + (size_t)u.e * LIST_CAP + l, __ATOMIC_RELAXED, __HIP_MEMORY_SCOPE_AGENT);
                    const float w = sc * __uint_as_float(__hip_atomic_load((const GAS unsigned*)list_w + (size_t)u.e * LIST_CAP + l, __ATOMIC_RELAXED, __HIP_MEMORY_SCOPE_AGENT));
                    const size_t off = (size_t)(ent & 0xFFFFFu) * D + col0;
                    if ((ent >> 20) == 0u) {
#pragma unroll
                        for (int bj = 0; bj < 2; ++bj)
#pragma unroll
                            for (int n = 0; n < 2; ++n) { GAS float* p = (GAS float*)(h + off + bj * HALF + n * 16); const f32x4 r = *(const GAS f32x4*)p; *(GAS f32x4*)p = r + acc[ai][bj][m][n] * w; }
                    } else {
#pragma unroll
                        for (int bj = 0; bj < 2; ++bj)
#pragma unroll
                            for (int n = 0; n < 2; ++n) { const f32x4 v = acc[ai][bj][m][n] * w; unsigned long long pk = (unsigned long long)cvt_pk_bf16(v[0], v[1]) | ((unsigned long long)cvt_pk_bf16(v[2], v[3]) << 32);
                                *(GAS unsigned long long*)(y1 + off + bj * HALF + n * 16) = pk; }
                    }
                } }
    }
};

template <class Epi, class Sched, bool F8 = false>
__device__ __forceinline__ void gemm_phase(PG8_LAS unsigned char* lds, int xoff, const Gemm g, const Sched& S, const Epi& E) {
    int tid_ = threadIdx.x;
    asm volatile("" : "+v"(tid_));
    const int tid = tid_, wid = __builtin_amdgcn_readfirstlane(tid >> 6), lane = tid & 63, wr = wid >> 2, wc = wid & 3, fr = lane & 15, fq = lane >> 4;
    const int RB = g.rowb, nt = RB / 128;
    unsigned voffB[2];
#pragma unroll
    for (int i = 0; i < 2; ++i) { int R, C; stage_rc(tid * 16 + i * 8192, R, C); const int Rb = Epi::PERM ? ((R & ~31) + perm32(R & 31)) : R;
        voffB[i] = (unsigned)(Rb * RB + C * 2); }
    const size_t kstep = (size_t)(BK * 2);
    const size_t hstep = (size_t)HALF * RB;
    const size_t tstep = 2 * hstep;
    const unsigned ldsw = (unsigned)wid * 1024u;
    const int aoff = F8 ? lds_byte(wr * 64 + fr, fq * 16) : lds_byte(wr * 64 + fr, fq * 8), boff = F8 ? lds_byte(wc * 32 + fr, fq * 16) : lds_byte(wc * 32 + fr, fq * 8);
#define PG8_SA(b, h) (((b) * 2 + (h)) * HTB)
#define PG8_SB(b, h) ((4 + (b) * 2 + (h)) * HTB)
#define PG8_STAGE(bufoff, gbase, v0, v1) do { \
        __builtin_amdgcn_global_load_lds((const GAS unsigned*)((const char*)(gbase) + (v0)), (PG8_LAS unsigned*)(lds + (bufoff) + ldsw), 16, 0, 0); \
        __builtin_amdgcn_global_load_lds((const GAS unsigned*)((const char*)(gbase) + (v1)), (PG8_LAS unsigned*)(lds + (bufoff) + ldsw + 8192), 16, 0, 0); } while (0)
#define PG8_STAGEB(bufoff, gbase) PG8_STAGE(bufoff, gbase, voffB[0], voffB[1])
#define PG8_LDA(dst, b, h) do { if constexpr (F8) { _Pragma("unroll") for (int m = 0; m < 4; ++m) { dst##8[m].lo = *(const PG8_LAS i32x4*)(lds + PG8_SA(b, h) + aoff + m * 2048); dst##8[m].hi = *(const PG8_LAS i32x4*)(lds + PG8_SA(b, h) + aoff + m * 2048 + 16); } } \
        else { _Pragma("unroll") for (int m = 0; m < 4; ++m) _Pragma("unroll") for (int k = 0; k < 2; ++k) dst[m][k] = *(const PG8_LAS bf16x8*)(lds + PG8_SA(b, h) + aoff + m * 2048 + k * 1024); } } while (0)
#define PG8_LDB(dst, b, h) do { if constexpr (F8) { _Pragma("unroll") for (int n = 0; n < 2; ++n) { dst##8[n].lo = *(const PG8_LAS i32x4*)(lds + PG8_SB(b, h) + boff + n * 2048); dst##8[n].hi = *(const PG8_LAS i32x4*)(lds + PG8_SB(b, h) + boff + n * 2048 + 16); } } \
        else { _Pragma("unroll") for (int n = 0; n < 2; ++n) _Pragma("unroll") for (int k = 0; k < 2; ++k) dst[n][k] = *(const PG8_LAS bf16x8*)(lds + PG8_SB(b, h) + boff + n * 2048 + k * 1024); } } while (0)
#define PG8_MMA(ai, bj, At, Bt) do { __builtin_amdgcn_s_setprio(1); _Pragma("unroll") for (int m = 0; m < 4; ++m) _Pragma("unroll") for (int n = 0; n < 2; ++n) { \
        if constexpr (F8) acc[ai][bj][m][n] = __builtin_amdgcn_mfma_scale_f32_16x16x128_f8f6f4(Bt##8[n], At##8[m], acc[ai][bj][m][n], 0, 0, 0, 0x7F7F7F7F, 0, 0x7F7F7F7F); \
        else { _Pragma("unroll") for (int k = 0; k < 2; ++k) acc[ai][bj][m][n] = __builtin_amdgcn_mfma_f32_16x16x32_bf16(Bt[n][k], At[m][k], acc[ai][bj][m][n], 0, 0, 0); } } __builtin_amdgcn_s_setprio(0); } while (0)
#define PG8_WAIT_V(n) asm volatile("s_waitcnt vmcnt(" #n ")" ::: "memory")
#define PG8_WAIT_L(n) asm volatile("s_waitcnt lgkmcnt(" #n ")" ::: "memory")
#define PG8_BAR __builtin_amdgcn_s_barrier()
#define PG8_SCHED __builtin_amdgcn_sched_barrier(0)
#define PG8_AOFFS(U, o00, o01, o10, o11) do { int R0_, C0_, R1_, C1_; stage_rc(tid * 16, R0_, C0_); stage_rc(tid * 16 + 8192, R1_, C1_);     \
        o00 = S.arow(U, R0_) * (unsigned)RB + (unsigned)C0_ * 2u; o01 = S.arow(U, R1_) * (unsigned)RB + (unsigned)C1_ * 2u; \
        o10 = S.arow(U, HALF + R0_) * (unsigned)RB + (unsigned)C0_ * 2u; o11 = S.arow(U, HALF + R1_) * (unsigned)RB + (unsigned)C1_ * 2u; } while (0)
    Unit cur, nxt; int ui = 0;
    if (!S.next(0, cur)) return;
    f32x4 acc[2][2][4][2];
#pragma unroll
    for (int a = 0; a < 2; ++a)
#pragma unroll
        for (int b = 0; b < 2; ++b)
#pragma unroll
            for (int m = 0; m < 4; ++m)
#pragma unroll
                for (int n = 0; n < 2; ++n) acc[a][b][m][n] = (f32x4){0.f, 0.f, 0.f, 0.f};
    bf16x8 At[4][2], B0[2][2], B1[2][2];
    i32x8 At8[4], B08[2], B18[2];
    unsigned c00, c01, c10, c11;
    PG8_LAS u32x4* const xslot = (PG8_LAS u32x4*)(lds + xoff) + tid;
    PG8_AOFFS(cur, c00, c01, c10, c11);
    const char* const gA = (const char*)g.A;
    const char* cB = (const char*)g.Bt + (size_t)cur.e * g.bstride + (size_t)cur.pn * tstep;
    PG8_STAGEB(PG8_SB(0, 0), cB); PG8_STAGEB(PG8_SB(0, 1), cB + hstep); PG8_STAGE(PG8_SA(0, 0), gA, c00, c01); PG8_STAGE(PG8_SA(0, 1), gA, c10, c11);
    if (wr == 1) PG8_BAR;
    PG8_WAIT_V(2); PG8_BAR;
    PG8_STAGEB(PG8_SB(1, 0), cB + kstep); PG8_STAGE(PG8_SA(1, 0), gA + kstep, c00, c01); PG8_STAGEB(PG8_SB(1, 1), cB + hstep + kstep);
    PG8_WAIT_V(6); PG8_BAR;
    for (;;) {
        const bool has_next = S.next(ui + 1, nxt);
        const char* nB_ = has_next ? (const char*)g.Bt + (size_t)nxt.e * g.bstride + (size_t)nxt.pn * tstep : cB;
        const char* nB = nB_;
        if (has_next) { unsigned n00, n01, n10, n11; PG8_AOFFS(nxt, n00, n01, n10, n11); *xslot = (u32x4){n00, n01, n10, n11}; }
#pragma unroll 1
        for (int t = 0; t < nt; t += 2) {
            const bool last = (t == nt - 2);
            const char* a1 = gA + (size_t)(t + 1) * kstep;
            const char* a2 = last ? gA : gA + (size_t)(t + 2) * kstep; const char* b2 = last ? nB : cB + (size_t)(t + 2) * kstep;
            const char* a3 = a2 + kstep; const char* b3 = b2 + kstep;
            PG8_LDB(B0, 0, 0); PG8_LDB(B1, 0, 1); PG8_SCHED; PG8_LDA(At, 0, 0); PG8_STAGE(PG8_SA(1, 1), a1, c10, c11);
            if (last && has_next) { const u32x4 nx = *xslot; c00 = nx.x; c01 = nx.y; c10 = nx.z; c11 = nx.w; }
            PG8_WAIT_V(8); PG8_WAIT_L(0); PG8_BAR; PG8_MMA(0, 0, At, B0); PG8_MMA(0, 1, At, B1); PG8_BAR; PG8_SCHED;
            PG8_LDA(At, 0, 1); PG8_STAGEB(PG8_SB(0, 0), b2); PG8_STAGEB(PG8_SB(0, 1), b2 + hstep); PG8_STAGE(PG8_SA(0, 0), a2, c00, c01);
            PG8_WAIT_V(8); PG8_WAIT_L(0); PG8_BAR; PG8_MMA(1, 0, At, B0); PG8_MMA(1, 1, At, B1); PG8_BAR; PG8_SCHED;
            PG8_LDB(B0, 1, 0); PG8_LDB(B1, 1, 1); PG8_SCHED; PG8_LDA(At, 1, 0); PG8_STAGE(PG8_SA(0, 1), a2, c10, c11);
            PG8_WAIT_V(8); PG8_WAIT_L(0); PG8_BAR; PG8_MMA(0, 0, At, B0); PG8_MMA(0, 1, At, B1); PG8_BAR; PG8_SCHED;
            PG8_LDA(At, 1, 1); PG8_STAGEB(PG8_SB(1, 0), b3); PG8_STAGEB(PG8_SB(1, 1), b3 + hstep); PG8_STAGE(PG8_SA(1, 0), a3, c00, c01);
            PG8_WAIT_V(8); PG8_WAIT_L(0); PG8_BAR; PG8_MMA(1, 0, At, B0); PG8_MMA(1, 1, At, B1); PG8_BAR; PG8_SCHED;
        }
        if (wr == 0) PG8_BAR;
        E(acc, cur, wr, wc, fr, fq);
        if (!has_next) break;
#pragma unroll
        for (int a = 0; a < 2; ++a)
#pragma unroll
            for (int b = 0; b < 2; ++b)
#pragma unroll
                for (int m = 0; m < 4; ++m)
#pragma unroll
                    for (int n = 0; n < 2; ++n) acc[a][b][m][n] = (f32x4){0.f, 0.f, 0.f, 0.f};
        cur = nxt; cB = nB; ++ui;
        if (wr == 1) PG8_BAR;
    }
    PG8_WAIT_V(0);
    PG8_BAR;
#undef PG8_SA
#undef PG8_SB
#undef PG8_STAGE
#undef PG8_STAGEB
#undef PG8_LDA
#undef PG8_LDB
#undef PG8_MMA
#undef PG8_WAIT_V
#undef PG8_WAIT_L
#undef PG8_BAR
#undef PG8_SCHED
#undef PG8_AOFFS
}
}

namespace att {
typedef unsigned short bf16_t;
typedef short bf16x8 __attribute__((ext_vector_type(8)));
typedef short s16x4 __attribute__((ext_vector_type(4)));
typedef float f32x16 __attribute__((ext_vector_type(16)));
typedef float f32x4 __attribute__((ext_vector_type(4)));
typedef unsigned u32x4 __attribute__((ext_vector_type(4)));
constexpr int PITCH = 1024;
constexpr float LOG2E = 1.4426950408889634f;
__device__ __forceinline__ int crow(int r, int hi) { return (r & 3) + 8 * (r >> 2) + 4 * hi; }
typedef float f32x2_t __attribute__((ext_vector_type(2))); typedef __bf16 bf16x2_t __attribute__((ext_vector_type(2)));
__device__ __forceinline__ unsigned cvtpk(float lo, float hi) { f32x2_t v = {lo, hi}; bf16x2_t b = __builtin_convertvector(v, bf16x2_t); return __builtin_bit_cast(unsigned, b); }
__device__ __forceinline__ float bf2f(short s) { return __uint_as_float(((unsigned)(unsigned short)s) << 16); }
typedef short v4i16_t __attribute__((ext_vector_type(4)));
__device__ __forceinline__ s16x4 vtr(const LAS unsigned char* p) { return __builtin_bit_cast(s16x4, __builtin_amdgcn_ds_read_tr16_b64_v4i16((LAS v4i16_t*)p)); }
__device__ __forceinline__ float max3f(float a, float b, float c) { float r; asm("v_max3_f32 %0, %1, %2, %3" : "=v"(r) : "v"(a), "v"(b), "v"(c)); return r; }
__device__ __forceinline__ float halves_max(float m) { auto rr = __builtin_amdgcn_permlane32_swap(__float_as_uint(m), __float_as_uint(m), false, false); return fmaxf(__uint_as_float(rr[0]), __uint_as_float(rr[1])); }
__device__ __forceinline__ float halves_sum(float m) { auto rr = __builtin_amdgcn_permlane32_swap(__float_as_uint(m), __float_as_uint(m), false, false); return __uint_as_float(rr[0]) + __uint_as_float(rr[1]); }
#define ATT_BAR() asm volatile("s_waitcnt vmcnt(0) lgkmcnt(0)\n\ts_barrier" ::: "memory")
typedef unsigned u32x2 __attribute__((ext_vector_type(2)));
#define ATT_RD128(d, a, off) asm volatile("ds_read_b128 %0, %1 offset:%2" : "=v"(d) : "v"(a), "n"(off))
#define ATT_RDTR(d, a, off) asm volatile("ds_read_b64_tr_b16 %0, %1 offset:%2" : "=v"(d) : "v"(a), "n"(off))
#define ATT_WAIT2(n, x, y) asm volatile("s_waitcnt lgkmcnt(" #n ")" : "+v"(x), "+v"(y))

struct Args { const bf16_t* Q; const bf16_t* K; const bf16_t* V; bf16_t* O; const float* kmean; const float* kmax2; const float* subln; float lam_full; float out_scale; int abl; };
#ifndef ATT_ABLATE
#define ATT_ABLATE 0
#endif
#if ATT_ABLATE
#define ABL(bit) ((((ATT_ABLATE) >> (bit)) & 1) && abl_)
#else
#define ABL(bit) 0
#endif

template <int MODE>
__device__ __forceinline__ void attn_unit(LAS unsigned char* lds, const Args& A, int b, int h, int qblk) {
    constexpr int DVB = MODE == 0 ? 4 : 2;
    constexpr int NCH = MODE == 0 ? 16 : 8;
    constexpr int KBY = NCH * 1024, VBY = DVB * 4096, SLOT = KBY + VBY;
    constexpr int QR = MODE == 0 ? 128 : 256;
    constexpr int PPW = MODE == 0 ? 2 : 1;
    int tid_ = threadIdx.x; asm volatile("" : "+v"(tid_));
    const int tid = tid_, lane = tid & 63, r32 = lane & 31, hi = lane >> 5;
    const int wid = __builtin_amdgcn_readfirstlane(tid >> 6);
    const int comp = MODE == 0 ? (wid >> 2) : 0, wq = MODE == 0 ? (wid & 3) : wid;
    const int q0 = qblk * QR; const long rowbase = (long)b * SEQ;
    const int hcol = MODE == 0 ? h * 128 : h * 64;
    const int qrel0 = wq * 32;
    const float slope2 = __builtin_amdgcn_exp2f(MODE == 0 ? -(float)(h + 1) : -0.5f * (float)(h + 1)) * LOG2E;
    const int NT = MODE == 0 ? 2 * qblk + 2 : 4 + 4 * qblk;
#define ATT_KBASE_(t) (MODE == 0 ? 64 * (t) : ((t) < 4 ? q0 + 64 * (t) : 64 * ((t) - 4)))
#define ATT_KBASE(t) ATT_KBASE_(t)
    LAS float* wsf = (LAS float*)(lds + 65536) + wid * 64;
    const bf16_t* Kb = A.K + rowbase * PITCH + hcol;
    const bf16_t* Vb = A.V + rowbase * PITCH + hcol;
#define ATT_ISSUE_K(tt, slot) do { const int kb_ = ATT_KBASE(tt); \
        _Pragma("unroll") for (int i_ = 0; i_ < PPW; ++i_) { const int p_ = wid + 8 * i_; \
            __builtin_amdgcn_global_load_lds((const GAS unsigned*)(Kb + (size_t)(kb_ + lane) * PITCH + p_ * 8), (LAS unsigned*)(lds + (slot) * SLOT + p_ * 1024), 16, 0, 0); } } while (0)
#define ATT_ISSUE_V(tt, slot) do { const int kb_ = ATT_KBASE(tt); \
        _Pragma("unroll") for (int i_ = 0; i_ < PPW; ++i_) { const int p_ = wid + 8 * i_; \
            __builtin_amdgcn_global_load_lds((const GAS unsigned*)(Vb + (size_t)(kb_ + 16 * (p_ & 3) + (lane >> 2)) * PITCH + (p_ >> 2) * 32 + (lane & 3) * 8), (LAS unsigned*)(lds + (slot) * SLOT + KBY + p_ * 1024), 16, 0, 0); } } while (0)
    asm volatile("s_waitcnt lgkmcnt(0)\n\ts_barrier" ::: "memory");
    bf16x8 qr[4];
    { const bf16_t* Qw = A.Q + (rowbase + q0 + qrel0 + r32) * PITCH + hcol + comp * 64 + hi * 8;
#pragma unroll
      for (int d0 = 0; d0 < 4; ++d0) qr[d0] = *(const GAS bf16x8*)(Qw + d0 * 16); }
    const int tt_l = MODE == 0 ? (lane < 2 ? 2 * qblk + lane : lane - 2) : lane;
    const int kbase_l = (lane < NT) ? ATT_KBASE_(tt_l) : 0;
    const bool past_l = lane < NT && kbase_l + 64 <= q0;
    float k2a = 0.f, k2b = 0.f;
    { const int nblk = (kbase_l >> 8) & 15;
        if constexpr (MODE == 0) { k2a = ((const GAS float*)A.kmax2)[(size_t)(b * 16 + h * 2) * 16 + nblk]; k2b = ((const GAS float*)A.kmax2)[(size_t)(b * 16 + h * 2 + 1) * 16 + nblk]; }
        else k2a = ((const GAS float*)A.kmax2)[(size_t)(b * 16 + h) * 16 + nblk]; }
    float kmv0 = 0.f, kmv1 = 0.f;
    if constexpr (MODE == 1) { kmv0 = ((const GAS float*)A.kmean)[(size_t)(b * 16 + h) * 1024 + tid]; kmv1 = ((const GAS float*)A.kmean)[(size_t)(b * 16 + h) * 1024 + 512 + tid]; }
    const int t0 = MODE == 0 ? 2 * qblk : 0, t1 = t0 + 1;
    ATT_ISSUE_K(t0, 0); ATT_ISSUE_V(t0, 0); ATT_ISSUE_K(t1, 1);
    LAS int* live = (LAS int*)(lds + 71680); LAS float* qnx = (LAS float*)(lds + 71680 + 272);
    LAS float* km = (LAS float*)(lds + 67584);
    { float q2 = 0.f;
#pragma unroll
      for (int d0 = 0; d0 < 4; ++d0)
#pragma unroll
        for (int j = 0; j < 8; ++j) { const float v = bf2f(qr[d0][j]); q2 += v * v; }
      q2 = halves_sum(q2);
      q2 = fmaxf(q2, __shfl_xor(q2, 1)); q2 = fmaxf(q2, __shfl_xor(q2, 2)); q2 = fmaxf(q2, __shfl_xor(q2, 4)); q2 = fmaxf(q2, __shfl_xor(q2, 8)); q2 = fmaxf(q2, __shfl_xor(q2, 16));
      if (lane == 0) qnx[wid] = q2; }
    if constexpr (MODE == 1) { km[tid] = kmv0; km[tid + 512] = kmv1; }
    ATT_BAR();
    if (wid == 0) {
        bool alive = lane < NT;
        if (past_l) { float bound;
            if constexpr (MODE == 0) { const float qa = fmaxf(fmaxf(qnx[0], qnx[1]), fmaxf(qnx[2], qnx[3])), qb = fmaxf(fmaxf(qnx[4], qnx[5]), fmaxf(qnx[6], qnx[7]));
                bound = fmaxf(sqrtf(qa) * sqrtf(k2a), sqrtf(qb) * sqrtf(k2b));
            } else { float qm = qnx[0];
#pragma unroll
                for (int w = 1; w < 8; ++w) qm = fmaxf(qm, qnx[w]);
                bound = sqrtf(qm) * sqrtf(k2a); }
            alive = !(bound * 1.001f + 1.0f + slope2 * (float)(kbase_l + 63 - q0) < -152.0f);
        }
        const unsigned long long am = __ballot(alive);
        if (alive) live[__popcll(am & ((1ull << lane) - 1ull))] = tt_l;
        if (lane == 0) live[64] = __popcll(am);
    }
    unsigned sel = 0u;
    if constexpr (MODE == 1) {
        float g[16];
#pragma unroll
        for (int n = 0; n < 16; ++n) { float s = 0.f;
            if (n < qblk) {
#pragma unroll
                for (int d0 = 0; d0 < 4; ++d0) { const f32x4 ka = *(const LAS f32x4*)(km + n * 64 + d0 * 16 + hi * 8), kb2 = *(const LAS f32x4*)(km + n * 64 + d0 * 16 + hi * 8 + 4);
                    s += bf2f(qr[d0][0]) * ka[0] + bf2f(qr[d0][1]) * ka[1] + bf2f(qr[d0][2]) * ka[2] + bf2f(qr[d0][3]) * ka[3]
                       + bf2f(qr[d0][4]) * kb2[0] + bf2f(qr[d0][5]) * kb2[1] + bf2f(qr[d0][6]) * kb2[2] + bf2f(qr[d0][7]) * kb2[3]; }
                s = halves_sum(s); }
            g[n] = s; }
        const int nsel = qblk < 3 ? qblk : 3;
#pragma unroll
        for (int k = 0; k < 3; ++k) if (k < nsel) { float best = -INFINITY; int bi = 0; bool found = false;
#pragma unroll
            for (int n = 0; n < 16; ++n) if (n < qblk) { const bool free_ = ((sel >> n) & 1u) == 0u; if (free_ && (!found || g[n] > best)) { best = g[n]; bi = n; found = true; } }
            sel |= 1u << bi; }
    }
    ATT_BAR();
    const int NTL = __builtin_amdgcn_readfirstlane(live[64]);
#define ATT_ISSUE(t, slot) do { const int kb_ = ATT_KBASE(t); \
        _Pragma("unroll") for (int i_ = 0; i_ < PPW; ++i_) { const int p_ = wid + 8 * i_; \
            __builtin_amdgcn_global_load_lds((const GAS unsigned*)(Kb + (size_t)(kb_ + lane) * PITCH + p_ * 8), (LAS unsigned*)(lds + (slot) * SLOT + p_ * 1024), 16, 0, 0); \
            __builtin_amdgcn_global_load_lds((const GAS unsigned*)(Vb + (size_t)(kb_ + 16 * (p_ & 3) + (lane >> 2)) * PITCH + (p_ >> 2) * 32 + (lane & 3) * 8), (LAS unsigned*)(lds + (slot) * SLOT + KBY + p_ * 1024), 16, 0, 0); } } while (0)
    constexpr float THR = 8.0f;
    float mref = 0.f, l = 0.f; f32x16 o[DVB];
#pragma unroll
    for (int d0 = 0; d0 < DVB; ++d0) o[d0] = f32x16{};
#define ATT_CLASS(tt, SK, NM, SB) do { const int kb_ = ATT_KBASE(tt), kr_ = kb_ - q0; const bool dg_ = kb_ >= q0; SK = dg_ && (kr_ > qrel0 + 31); NM = dg_ && (kr_ + 63 > qrel0); SB = true; \
        if constexpr (MODE == 1) { if ((tt) >= 4) { SB = ((sel >> (((tt) - 4) >> 2)) & 1u) != 0u; if (!__any(SB)) SK = true; } } } while (0)
#define ATT_QK(P0, P1, tt, slot, SB) do { const int kr_ = ATT_KBASE(tt) - q0; float off0_ = slope2 * (float)(kr_ + 4 * hi) - mref; if (!(SB)) off0_ = -INFINITY; const float off1_ = off0_ + 32.0f * slope2; \
        const unsigned ka_ = (unsigned)(size_t)(lds + (slot) * SLOT + comp * 8192 + hi * 1024 + r32 * 16); u32x4 kx_[4], ky_[4]; \
        ATT_RD128(kx_[0], ka_, 0); ATT_RD128(ky_[0], ka_, 512); ATT_RD128(kx_[1], ka_, 2048); ATT_RD128(ky_[1], ka_, 2560); \
        _Pragma("unroll") for (int r = 0; r < 16; ++r) { const float cbr = slope2 * (float)((r & 3) + 8 * (r >> 2)); P0[r] = cbr + off0_; P1[r] = cbr + off1_; } \
        ATT_WAIT2(2, kx_[0], ky_[0]); P0 = __builtin_amdgcn_mfma_f32_32x32x16_bf16(__builtin_bit_cast(bf16x8, kx_[0]), qr[0], P0, 0, 0, 0); P1 = __builtin_amdgcn_mfma_f32_32x32x16_bf16(__builtin_bit_cast(bf16x8, ky_[0]), qr[0], P1, 0, 0, 0); \
        ATT_RD128(kx_[2], ka_, 4096); ATT_RD128(ky_[2], ka_, 4608); \
        ATT_WAIT2(2, kx_[1], ky_[1]); P0 = __builtin_amdgcn_mfma_f32_32x32x16_bf16(__builtin_bit_cast(bf16x8, kx_[1]), qr[1], P0, 0, 0, 0); P1 = __builtin_amdgcn_mfma_f32_32x32x16_bf16(__builtin_bit_cast(bf16x8, ky_[1]), qr[1], P1, 0, 0, 0); \
        ATT_RD128(kx_[3], ka_, 6144); ATT_RD128(ky_[3], ka_, 6656); \
        ATT_WAIT2(2, kx_[2], ky_[2]); P0 = __builtin_amdgcn_mfma_f32_32x32x16_bf16(__builtin_bit_cast(bf16x8, kx_[2]), qr[2], P0, 0, 0, 0); P1 = __builtin_amdgcn_mfma_f32_32x32x16_bf16(__builtin_bit_cast(bf16x8, ky_[2]), qr[2], P1, 0, 0, 0); \
        ATT_WAIT2(0, kx_[3], ky_[3]); P0 = __builtin_amdgcn_mfma_f32_32x32x16_bf16(__builtin_bit_cast(bf16x8, kx_[3]), qr[3], P0, 0, 0, 0); P1 = __builtin_amdgcn_mfma_f32_32x32x16_bf16(__builtin_bit_cast(bf16x8, ky_[3]), qr[3], P1, 0, 0, 0); } while (0)
    f32x16 p0, p1, n0, n1;
    const int abl_ = __builtin_amdgcn_readfirstlane(A.abl); (void)abl_;
    int t = t0, tn = t1;
    bool skipC, maskC, selC, skipN = true, maskN = false, selN = true;
    ATT_CLASS(t, skipC, maskC, selC);
    if (!skipC) ATT_QK(p0, p1, t, 0, selC);
    const int NTLX = ABL(4) ? 1 : NTL;
    for (int it = 0; it < NTLX; ++it) {
        ATT_BAR();
        const int tnn = (it + 2 < NTL) ? __builtin_amdgcn_readfirstlane(live[it + 2]) : 0;
        if (it + 2 < NTL && !ABL(0)) ATT_ISSUE_K(tnn, it & 1);
        if (it + 1 < NTL) { if (!ABL(0)) ATT_ISSUE_V(tn, (it + 1) & 1); ATT_CLASS(tn, skipN, maskN, selN); if (!skipN) { if (!ABL(2)) ATT_QK(n0, n1, tn, (it + 1) & 1, selN); else { n0 = f32x16{} - 1.0f; n1 = n0; } } } else skipN = true;
        if (!skipC) {
            const int krel = ATT_KBASE(t) - q0;
            const unsigned va_ = (unsigned)(size_t)(lds + (it & 1) * SLOT + KBY + ((lane >> 4) & 1) * 32 + (lane & 3) * 8 + (4 * hi + ((lane & 15) >> 2)) * 64);
            u32x2 vl_[4], vh_[4];
            if (!ABL(1)) { ATT_RDTR(vl_[0], va_, 0); ATT_RDTR(vh_[0], va_, 512); ATT_RDTR(vl_[1], va_, 1024); ATT_RDTR(vh_[1], va_, 1536);
            ATT_RDTR(vl_[2], va_, 2048); ATT_RDTR(vh_[2], va_, 2560); ATT_RDTR(vl_[3], va_, 3072); ATT_RDTR(vh_[3], va_, 3584); }
            if (maskC) { const int qrel = qrel0 + r32;
#pragma unroll
                for (int r = 0; r < 16; ++r) { const int kv = krel + crow(r, hi); if (kv > qrel) p0[r] = -INFINITY; if (kv + 32 > qrel) p1[r] = -INFINITY; } }
            float rm;
            { float a_ = max3f(p0[0], p0[1], p1[0]), b_ = max3f(p0[2], p0[3], p1[1]); a_ = max3f(a_, p1[2], p1[3]);
#pragma unroll
              for (int r = 4; r < 16; r += 4) { a_ = max3f(a_, p0[r], p0[r + 1]); b_ = max3f(b_, p0[r + 2], p0[r + 3]); a_ = max3f(a_, p1[r], p1[r + 1]); b_ = max3f(b_, p1[r + 2], p1[r + 3]); }
              rm = halves_max(fmaxf(a_, b_)); }
            if (__any(rm > THR)) {
                const float dl = fmaxf(rm, 0.f); mref += dl; const float alpha = __builtin_amdgcn_exp2f(-dl);
#pragma unroll
                for (int r = 0; r < 16; ++r) { p0[r] -= dl; p1[r] -= dl; }
                if (!skipN) {
#pragma unroll
                    for (int r = 0; r < 16; ++r) { n0[r] -= dl; n1[r] -= dl; } }
                l *= alpha;
                if (hi == 0) wsf[r32] = alpha;
                asm volatile("s_waitcnt lgkmcnt(0)" ::: "memory");
#pragma unroll
                for (int gq = 0; gq < 4; ++gq) { const f32x4 f = *(const LAS f32x4*)(wsf + 8 * gq + 4 * hi);
#pragma unroll
                    for (int d0 = 0; d0 < DVB; ++d0) { o[d0][4 * gq + 0] *= f[0]; o[d0][4 * gq + 1] *= f[1]; o[d0][4 * gq + 2] *= f[2]; o[d0][4 * gq + 3] *= f[3]; } }
            }
            float sacc = 0.f;
            if (!ABL(3)) {
#pragma unroll
            for (int r = 0; r < 16; ++r) { p0[r] = __builtin_amdgcn_exp2f(p0[r]); p1[r] = __builtin_amdgcn_exp2f(p1[r]); sacc += p0[r] + p1[r]; } }
            l += sacc;
            u32x4 pw[4];
            pw[0] = (u32x4){cvtpk(p0[0], p0[1]), cvtpk(p0[2], p0[3]), cvtpk(p0[4], p0[5]), cvtpk(p0[6], p0[7])};
            pw[1] = (u32x4){cvtpk(p0[8], p0[9]), cvtpk(p0[10], p0[11]), cvtpk(p0[12], p0[13]), cvtpk(p0[14], p0[15])};
            pw[2] = (u32x4){cvtpk(p1[0], p1[1]), cvtpk(p1[2], p1[3]), cvtpk(p1[4], p1[5]), cvtpk(p1[6], p1[7])};
            pw[3] = (u32x4){cvtpk(p1[8], p1[9]), cvtpk(p1[10], p1[11]), cvtpk(p1[12], p1[13]), cvtpk(p1[14], p1[15])};
            if (!ABL(1))
#pragma unroll
            for (int i = 0; i < 4 * DVB; ++i) { constexpr int NM = 4 * DVB; const int s_ = i & 3;
                if (i + 3 < NM) ATT_WAIT2(6, vl_[s_], vh_[s_]); else if (i + 3 == NM) ATT_WAIT2(4, vl_[s_], vh_[s_]); else if (i + 2 == NM) ATT_WAIT2(2, vl_[s_], vh_[s_]); else ATT_WAIT2(0, vl_[s_], vh_[s_]);
                const u32x4 vf = (u32x4){vl_[s_][0], vl_[s_][1], vh_[s_][0], vh_[s_][1]};
                o[i >> 2] = __builtin_amdgcn_mfma_f32_32x32x16_bf16(__builtin_bit_cast(bf16x8, pw[i & 3]), __builtin_bit_cast(bf16x8, vf), o[i >> 2], 0, 0, 0);
                if (i + 4 < NM) { ATT_RDTR(vl_[s_], va_, (i + 4) * 1024); ATT_RDTR(vh_[s_], va_, (i + 4) * 1024 + 512); } }
        }
        p0 = n0; p1 = n1; skipC = skipN; maskC = maskN; selC = selN; t = tn; tn = tnn;
    }
#undef ATT_ISSUE_K
#undef ATT_ISSUE_V
#undef ATT_CLASS
#undef ATT_QK
    if (ABL(5)) return;
    float sg[DVB];
    if constexpr (MODE == 0) {
#pragma unroll
        for (int d0 = 0; d0 < DVB; ++d0) sg[d0] = ((const GAS float*)A.subln)[d0 * 32 + r32]; }
    l = halves_sum(l);
    if (hi == 0) wsf[32 + r32] = l;
    asm volatile("s_waitcnt lgkmcnt(0)" ::: "memory");
    float rli[16];
#pragma unroll
    for (int gq = 0; gq < 4; ++gq) { const f32x4 f = *(const LAS f32x4*)(wsf + 32 + 8 * gq + 4 * hi); rli[4 * gq + 0] = 1.0f / f[0]; rli[4 * gq + 1] = 1.0f / f[1]; rli[4 * gq + 2] = 1.0f / f[2]; rli[4 * gq + 3] = 1.0f / f[3]; }
    if constexpr (MODE == 1) {
        GAS bf16_t* Ow = (GAS bf16_t*)(A.O + (rowbase + q0 + qrel0) * PITCH + hcol);
#pragma unroll
        for (int r = 0; r < 16; ++r)
#pragma unroll
            for (int d0 = 0; d0 < DVB; ++d0) Ow[(size_t)crow(r, hi) * PITCH + d0 * 32 + r32] = (bf16_t)(cvtpk(o[d0][r] * rli[r], 0.f) & 0xFFFFu);
    } else {
        ATT_BAR();
        LAS float* X = (LAS float*)lds + wq * 4096;
        if (comp == 1) {
#pragma unroll
            for (int d0 = 0; d0 < DVB; ++d0)
#pragma unroll
                for (int r = 0; r < 16; ++r) X[(d0 * 16 + r) * 64 + lane] = o[d0][r] * rli[r];
        }
        ATT_BAR();
        if (comp == 0) {
#pragma unroll
            for (int d0 = 0; d0 < DVB; ++d0) sg[d0] *= A.out_scale;
            GAS bf16_t* Ow = (GAS bf16_t*)(A.O + (rowbase + q0 + qrel0) * PITCH + hcol);
#pragma unroll
            for (int r = 0; r < 16; ++r) { float dv[DVB]; float ss = 0.f;
#pragma unroll
                for (int d0 = 0; d0 < DVB; ++d0) { dv[d0] = o[d0][r] * rli[r] - A.lam_full * X[(d0 * 16 + r) * 64 + lane]; ss += dv[d0] * dv[d0]; }
                ss += __shfl_xor(ss, 1); ss += __shfl_xor(ss, 2); ss += __shfl_xor(ss, 4); ss += __shfl_xor(ss, 8); ss += __shfl_xor(ss, 16);
                const float rs = 1.0f / sqrtf(ss * (1.0f / 128.0f) + 1e-5f);
#pragma unroll
                for (int d0 = 0; d0 < DVB; ++d0) Ow[(size_t)crow(r, hi) * PITCH + d0 * 32 + r32] = (bf16_t)(cvtpk(dv[d0] * rs * sg[d0], 0.f) & 0xFFFFu); }
        }
    }
#undef ATT_KBASE
#undef ATT_KBASE_
#undef ATT_ISSUE
}
#undef ATT_BAR
}

constexpr int NWAVES = 8;
constexpr int NLAYER = 4, PH_PER_LAYER = 8, NPHASE = 1 + NLAYER * PH_PER_LAYER;

constexpr size_t MiB = 1u << 20;
constexpr size_t WS_CTL = 0, CTL_ZERO_BYTES = 1 * MiB;
constexpr size_t WS_KMEAN = 1 * MiB;
constexpr size_t WS_LTOK = 2 * MiB, WS_LW = 3 * MiB;
constexpr size_t WS_DQKV = 5 * MiB;
constexpr size_t WS_DWO = WS_DQKV + 12 * MiB;
constexpr size_t WS_MQKV = WS_DWO + 4 * MiB;
constexpr size_t WS_MWO = WS_MQKV + 12 * MiB;
constexpr size_t WS_FGU = WS_MWO + 4 * MiB;
constexpr size_t WS_FD = WS_FGU + 22 * MiB;
constexpr size_t WS_MGU = WS_FD + 11 * MiB;
constexpr size_t WS_MD = WS_MGU + 112 * MiB;
constexpr size_t WS_XN = WS_MD + 56 * MiB;
constexpr size_t WS_Q = WS_XN + 64 * MiB, WS_K = WS_Q + 64 * MiB, WS_V = WS_K + 64 * MiB;
constexpr size_t WS_ACT = WS_Q;
constexpr size_t WS_END = WS_ACT + (size_t)MOE_TILES_MAX * 256 * DE * 2;
static_assert(WS_XN == 238 * MiB && WS_END == 778 * MiB, "d_ws map");
constexpr int CW_BAR = 4096;
constexpr int CW_ATTQ = 6144;
constexpr int CW_ATTQ2 = 12288;
constexpr int CW_CNT = 8192;

constexpr int RING_OFF = 0, RING_BYTES = 131072;
constexpr int LDSCTL_OFF = RING_BYTES, MISC_OFF = LDSCTL_OFF + 320;
constexpr int XSLOT_OFF = MISC_OFF + 128;
constexpr int LDS_BYTES = 147456;

typedef unsigned short bf16;
typedef unsigned v4u __attribute__((ext_vector_type(4)));
typedef float f32x4 __attribute__((ext_vector_type(4)));
typedef GAS unsigned gu32;
#define RLX_AGENT __ATOMIC_RELAXED, __HIP_MEMORY_SCOPE_AGENT
#define LDS_WAIT() asm volatile("s_waitcnt lgkmcnt(0)" ::: "memory")
#define VM_WAIT() asm volatile("s_waitcnt vmcnt(0)" ::: "memory")
__device__ __forceinline__ unsigned f2bf(float f) { unsigned u = __builtin_bit_cast(unsigned, f); return (u + 0x7fffu + ((u >> 16) & 1u)) >> 16; }
__device__ __forceinline__ unsigned pk2(float lo, float hi) { return f2bf(lo) | (f2bf(hi) << 16); }
__device__ __forceinline__ float bflo(unsigned w) { return __uint_as_float(w << 16); }
__device__ __forceinline__ float bfhi(unsigned w) { return __uint_as_float(w & 0xFFFF0000u); }
static_assert(XSLOT_OFF % 16 == 0 && XSLOT_OFF + 8192 <= LDS_BYTES, "LDS map");
#define XB_TMO      128
#define XB_XCNT(j)  (256  + 64 * (j))
#define XB_XSUB(j)  (1280 + 64 * (j))
#define XB_XGEN(j)  (2304 + 64 * (j))
#define XB_TOP      3328
#define XB_TOPGEN   3392
#define XCD_BAR_WORDS 3456
#define XB_SPIN_CAP (1u << 18)

__device__ __forceinline__ unsigned xb_ld(unsigned* p)              { return __hip_atomic_load(p, __ATOMIC_RELAXED, __HIP_MEMORY_SCOPE_AGENT); }
__device__ __forceinline__ unsigned xb_add(unsigned* p, unsigned v) { return __hip_atomic_fetch_add(p, v, __ATOMIC_RELAXED, __HIP_MEMORY_SCOPE_AGENT); }
__device__ __forceinline__ unsigned xb_xcc_id() { return (unsigned)__builtin_amdgcn_s_getreg((3 << 11) | 20) & 0xFu; }
#define XB_SPIN(cond, bar) do { unsigned _sp = 0; while (cond) { __builtin_amdgcn_s_sleep(1); \
    if ((++_sp & 255u) == 0u) { if (xb_ld(&(bar)[XB_TMO])) break; if (_sp > XB_SPIN_CAP) { atomicAdd(&(bar)[XB_TMO], 1u); break; } } } } while (0)

struct XcdBarrier {
    unsigned* bar; unsigned x;
    volatile LAS unsigned* st;
};

__device__ __forceinline__ XcdBarrier xcd_barrier_post(unsigned* bar, volatile LAS unsigned* st) {
    XcdBarrier b; b.bar = bar; b.x = xb_xcc_id(); b.st = st;
    if (threadIdx.x == 0) (void)xb_add(&bar[XB_XCNT(b.x)], 1u);
    return b;
}
__device__ __forceinline__ void xcd_barrier_complete(unsigned* bar, unsigned x, unsigned& nloc, unsigned& nx) {
    const unsigned G = gridDim.x * gridDim.y * gridDim.z;
    unsigned sum, cnt, mine, sp = 0u;
    for (;;) {
        sum = 0u; cnt = 0u; mine = 0u;
#pragma unroll
        for (unsigned j = 0; j < 16; ++j) { const unsigned c = xb_ld(&bar[XB_XCNT(j)]); sum += c; cnt += (c > 0u) ? 1u : 0u; mine = (j == x) ? c : mine; }
        if (sum == G) break;
        __builtin_amdgcn_s_sleep(1);
        if ((++sp & 255u) == 0u) { if (xb_ld(&bar[XB_TMO])) break; if (sp > XB_SPIN_CAP) { atomicAdd(&bar[XB_TMO], 1u); break; } }
    }
    nloc = mine > 0u ? mine : 1u; nx = cnt > 0u ? cnt : 1u;
}

__device__ __forceinline__ void xcd_barrier(const XcdBarrier& b) {
    asm volatile("s_waitcnt vmcnt(0)" ::: "memory");
    __syncthreads();
    if (threadIdx.x == 0) {
        unsigned* bar = b.bar;
        __builtin_amdgcn_s_waitcnt(0);
        unsigned nloc = b.st[0], nx = b.st[1];
        if (nloc == 0u) { xcd_barrier_complete(bar, b.x, nloc, nx); b.st[0] = nloc; b.st[1] = nx; }
        const unsigned old = xb_add(&bar[XB_XSUB(b.x)], 1u);
        const unsigned gen = old / nloc;
        if (old + 1u == (gen + 1u) * nloc) {
            __builtin_amdgcn_fence(__ATOMIC_RELEASE, "agent");
            asm volatile("s_waitcnt vmcnt(0)" ::: "memory");
            const unsigned og = xb_add(&bar[XB_TOP], 1u);
            const unsigned tg = og / nx;
            if (og + 1u == (tg + 1u) * nx) xb_add(&bar[XB_TOPGEN], 1u);
            else XB_SPIN(xb_ld(&bar[XB_TOPGEN]) == tg, bar);
            __builtin_amdgcn_fence(__ATOMIC_ACQUIRE, "agent");
            xb_add(&bar[XB_XGEN(b.x)], 1u);
            asm volatile("s_waitcnt vmcnt(0)" ::: "memory");
        } else {
            XB_SPIN(xb_ld(&bar[XB_XGEN(b.x)]) == gen, bar);
            __builtin_amdgcn_fence(__ATOMIC_ACQUIRE, "agent");
            asm volatile("s_waitcnt vmcnt(0)" ::: "memory");
        }
    }
    __syncthreads();
}

struct Frame {
    LAS unsigned char* lds;
    volatile LAS unsigned* MISC;
    gu32* ctl;
    int tid, lane, wave;
    int vcu, G;
};
__device__ __forceinline__ float wave_sum(float v) {
#pragma unroll
    for (int o = 1; o < 64; o <<= 1) v += __shfl_xor(v, o);
    return v;
}
__device__ __forceinline__ void transpose_item(const float* W, int K, int N, void* WT, int k0, int n0, int drow0, LAS float* scr, int lane, bool f8, float wscale) {
    const GAS float* src = (const GAS float*)W + (size_t)k0 * N + n0 + lane;
#pragma unroll
    for (int hb = 0; hb < 2; ++hb) { float v[32];
#pragma unroll
        for (int i = 0; i < 32; ++i) v[i] = src[(size_t)(hb * 32 + i) * N];
#pragma unroll
        for (int i = 0; i < 32; ++i) { const int kk = hb * 32 + i; scr[kk * 64 + (lane ^ ((kk >> 3) << 3))] = v[i]; } }
    LDS_WAIT(); asm volatile("" ::: "memory");
    if (f8) {
        const int c = lane & 3;
#pragma unroll
        for (int j = 0; j < 4; ++j) { const int nn = (lane >> 2) + 16 * j; float v[16];
#pragma unroll
            for (int q = 0; q < 16; ++q) { const int kk = 16 * c + q; v[q] = scr[kk * 64 + (nn ^ ((kk >> 3) << 3))] * wscale; }
            v4u o; o.x = pg8::pk4_fp8(v[0], v[1], v[2], v[3]); o.y = pg8::pk4_fp8(v[4], v[5], v[6], v[7]); o.z = pg8::pk4_fp8(v[8], v[9], v[10], v[11]); o.w = pg8::pk4_fp8(v[12], v[13], v[14], v[15]);
            *(GAS v4u*)((unsigned char*)WT + (size_t)(drow0 + nn) * K + k0 + 16 * c) = o; }
    } else {
    const int c = lane & 7;
#pragma unroll
    for (int j = 0; j < 8; ++j) { const int n = (lane >> 3) + 8 * j; const LAS float* s = scr + (8 * c) * 64 + (n ^ (c << 3));
        v4u o; o.x = pk2(s[0 * 64], s[1 * 64]); o.y = pk2(s[2 * 64], s[3 * 64]); o.z = pk2(s[4 * 64], s[5 * 64]); o.w = pk2(s[6 * 64], s[7 * 64]);
        *(GAS v4u*)((bf16*)WT + (size_t)(drow0 + n) * K + k0 + 8 * c) = o; }
    }
    LDS_WAIT(); asm volatile("" ::: "memory");
}
__device__ __forceinline__ void convert_matrix(Frame& F, const float* W, int K, int N, void* WT, int il, unsigned& rot, bool f8 = false, float wscale = 1.0f) {
    LAS float* scr = (LAS float*)(F.lds + RING_OFF + F.wave * 16384);
    const unsigned gw = (unsigned)(F.vcu * NWAVES + F.wave), NGW = (unsigned)(F.G * NWAVES);
    const int nblk = N / 64, nitems = (K / 64) * nblk; int lane_ = F.lane; asm volatile("" : "+v"(lane_));
    for (int it = (int)((gw + NGW - rot % NGW) % NGW); it < nitems; it += (int)NGW) {
        const int kb = it / nblk, nb = it % nblk, n0 = 64 * nb;
        const int drow0 = il == 0 ? n0 : (n0 / 128) * 256 + (il - 1) * 128 + (n0 % 128);
        transpose_item(W, K, N, WT, 64 * kb, n0, drow0, scr, lane_, f8, wscale);
    }
    rot = (rot + (unsigned)nitems) % NGW;
}

struct RouterArgs { const float* router; gu32* cnt; unsigned* ltok; float* lw; };
template <int MODE, bool F8X = false>
__device__ __forceinline__ void norm_phase(Frame& F, const float* src, float* hout, const bf16* y1, const float* gain, bf16* xn, float* fout, const RouterArgs& R) {
    int lane_ = F.lane; asm volatile("" : "+v"(lane_));
    const int gw = F.vcu * NWAVES + F.wave, NGW = F.G * NWAVES, lane = lane_;
    f32x4 gv[4];
#pragma unroll
    for (int j = 0; j < 4; ++j) gv[j] = *(const GAS f32x4*)(gain + 256 * j + 4 * lane);
    LAS float* RL = (LAS float*)(F.lds + RING_OFF);
    if constexpr (MODE == 2) {
        int tid_ = F.tid; asm volatile("" : "+v"(tid_));
        for (int i = tid_; i < 8192; i += NWAVES * 64) RL[(i & 7) * 1024 + (i >> 3)] = ((const GAS float*)R.router)[i];
        LDS_WAIT(); __syncthreads();
    }
    const int nrows_w = gw < MTOK ? (MTOK - gw + NGW - 1) / NGW : 0;
    for (int cb = 0; cb < nrows_w; cb += 64) {
        int my_t = 0, my_e0 = 0, my_e1 = 0; float my_w0 = 0.f, my_w1 = 0.f; bool valid = false;
        const int cn = (nrows_w - cb) < 64 ? (nrows_w - cb) : 64;
        f32x4 vn[4]; unsigned long long yn[4];
        { const int row0_ = gw + cb * NGW; const GAS f32x4* xr = (const GAS f32x4*)(src + (size_t)row0_ * D) + lane;
#pragma unroll
          for (int j = 0; j < 4; ++j) vn[j] = xr[64 * j];
          if constexpr (MODE == 1 || MODE == 3) { const GAS unsigned long long* yr = (const GAS unsigned long long*)(y1 + (size_t)row0_ * D) + lane;
#pragma unroll
            for (int j = 0; j < 4; ++j) yn[j] = yr[64 * j]; } }
        for (int i = 0; i < cn; ++i) {
            const int row = gw + (cb + i) * NGW;
            f32x4 v[4]; float s = 0.f;
#pragma unroll
            for (int j = 0; j < 4; ++j) v[j] = vn[j];
            if constexpr (MODE == 1 || MODE == 3) {
#pragma unroll
                for (int j = 0; j < 4; ++j) { const unsigned long long w = yn[j]; const unsigned lo = (unsigned)w, hi = (unsigned)(w >> 32);
                    v[j].x += bflo(lo); v[j].y += bfhi(lo); v[j].z += bflo(hi); v[j].w += bfhi(hi); }
            }
            if (i + 1 < cn) { const int rown = row + NGW; const GAS f32x4* xr = (const GAS f32x4*)(src + (size_t)rown * D) + lane;
#pragma unroll
                for (int j = 0; j < 4; ++j) vn[j] = xr[64 * j];
                if constexpr (MODE == 1 || MODE == 3) { const GAS unsigned long long* yr = (const GAS unsigned long long*)(y1 + (size_t)rown * D) + lane;
#pragma unroll
                    for (int j = 0; j < 4; ++j) yn[j] = yr[64 * j]; } }
#pragma unroll
            for (int j = 0; j < 4; ++j) s += (v[j].x * v[j].x + v[j].y * v[j].y) + (v[j].z * v[j].z + v[j].w * v[j].w);
            if constexpr (MODE == 1) { GAS f32x4* hr = (GAS f32x4*)(hout + (size_t)row * D) + lane;
#pragma unroll
                for (int j = 0; j < 4; ++j) hr[64 * j] = v[j]; }
            const float rstd = 1.f / sqrtf(wave_sum(s) * (1.f / D) + 1e-6f);
#pragma unroll
            for (int j = 0; j < 4; ++j) v[j] = v[j] * rstd * gv[j];
            if constexpr (MODE == 3) { GAS f32x4* orow = (GAS f32x4*)(fout + (size_t)row * D) + lane;
#pragma unroll
                for (int j = 0; j < 4; ++j) orow[64 * j] = v[j];
            } else {
                if constexpr (F8X) { GAS unsigned* o4 = (GAS unsigned*)((unsigned char*)xn + (size_t)row * D) + lane;
#pragma unroll
                    for (int j = 0; j < 4; ++j) o4[64 * j] = pg8::pk4_fp8(v[j].x, v[j].y, v[j].z, v[j].w);
                } else { GAS unsigned long long* o8 = (GAS unsigned long long*)(xn + (size_t)row * D) + lane;
#pragma unroll
                    for (int j = 0; j < 4; ++j) o8[64 * j] = (unsigned long long)pk2(v[j].x, v[j].y) | ((unsigned long long)pk2(v[j].z, v[j].w) << 32); }
            }
            if constexpr (MODE == 2) {
                float lg[NE];
#pragma unroll
                for (int e = 0; e < NE; ++e) { float a = 0.f;
#pragma unroll
                    for (int j = 0; j < 4; ++j) { const f32x4 rr = *(const LAS f32x4*)(RL + e * 1024 + 256 * j + 4 * lane); a += (v[j].x * rr.x + v[j].y * rr.y) + (v[j].z * rr.z + v[j].w * rr.w); }
                    lg[e] = wave_sum(a); }
                int e0 = 0; float v0 = lg[0];
#pragma unroll
                for (int e = 1; e < NE; ++e) if (lg[e] > v0) { v0 = lg[e]; e0 = e; }
                int e1 = -1; float v1 = 0.f;
#pragma unroll
                for (int e = 0; e < NE; ++e) if (e != e0 && (e1 < 0 || lg[e] > v1)) { v1 = lg[e]; e1 = e; }
                const float w0 = 1.f / (1.f + __expf(v1 - v0));
                if (lane == i) { my_t = row; my_e0 = e0; my_e1 = e1; my_w0 = w0; my_w1 = 1.f - w0; valid = true; }
            }
        }
        if constexpr (MODE == 2) {
            unsigned myc = 0u;
#pragma unroll
            for (int e = 0; e < NE; ++e) { const unsigned long long b0 = __ballot(valid && my_e0 == e), b1 = __ballot(valid && my_e1 == e);
                const unsigned c = (unsigned)(__popcll(b0) + __popcll(b1)); if (lane == e) myc = c; }
            unsigned basev = 0u;
            if (lane < NE) basev = __hip_atomic_fetch_add(R.cnt + 64 * lane, myc, RLX_AGENT);
            const unsigned long long lt = (1ull << lane) - 1ull;
            unsigned pos0 = 0u, pos1 = 0u;
#pragma unroll
            for (int e = 0; e < NE; ++e) { const unsigned long long b0 = __ballot(valid && my_e0 == e), b1 = __ballot(valid && my_e1 == e);
                const unsigned be = (unsigned)__shfl((int)basev, e);
                if (my_e0 == e) pos0 = be + (unsigned)__popcll(b0 & lt);
                if (my_e1 == e) pos1 = be + (unsigned)__popcll(b0) + (unsigned)__popcll(b1 & lt); }
            if (valid) {
                ((GAS unsigned*)R.ltok)[(size_t)my_e0 * LIST_CAP + pos0] = (unsigned)my_t;             ((GAS float*)R.lw)[(size_t)my_e0 * LIST_CAP + pos0] = my_w0;
                ((GAS unsigned*)R.ltok)[(size_t)my_e1 * LIST_CAP + pos1] = (unsigned)my_t | (1u << 20); ((GAS float*)R.lw)[(size_t)my_e1 * LIST_CAP + pos1] = my_w1;
            }
        }
    }
    if constexpr (MODE == 2) { LDS_WAIT(); __syncthreads(); }
}

__device__ __forceinline__ void kstat_phase(Frame& F, const bf16* Kt, float* kmean, float* kmax2) {
    int lane_ = F.lane; asm volatile("" : "+v"(lane_));
    const int gw = F.vcu * NWAVES + F.wave, NGW = F.G * NWAVES, lane = lane_;
    for (int task = gw; task < BATCH * 16 * 16; task += NGW) {
        const int hh = task & 15, n = (task >> 4) & 15, b = task >> 8, l5 = lane & 31, hf = lane >> 5;
        const GAS unsigned* p = (const GAS unsigned*)(Kt + ((size_t)b * SEQ + 256 * n + 128 * hf) * D + hh * 64) + l5;
        float a0 = 0.f, a1 = 0.f, mx = 0.f;
#pragma unroll 32
        for (int r = 0; r < 128; ++r) { const unsigned w = p[(size_t)r * (D / 2)]; const float v0 = bflo(w), v1 = bfhi(w); a0 += v0; a1 += v1;
            float s = v0 * v0 + v1 * v1;
            s += __int_as_float(__builtin_amdgcn_update_dpp(0, __float_as_int(s), 0xB1, 0xF, 0xF, true)); s += __int_as_float(__builtin_amdgcn_update_dpp(0, __float_as_int(s), 0x4E, 0xF, 0xF, true));
            s += __int_as_float(__builtin_amdgcn_update_dpp(0, __float_as_int(s), 0x141, 0xF, 0xF, true)); s += __int_as_float(__builtin_amdgcn_update_dpp(0, __float_as_int(s), 0x140, 0xF, 0xF, true));
            s += __int_as_float(__builtin_amdgcn_ds_swizzle(__float_as_int(s), 0x401F)); mx = fmaxf(mx, s); }
        { auto r0 = __builtin_amdgcn_permlane32_swap(__float_as_uint(a0), __float_as_uint(a0), false, false); a0 = __uint_as_float(r0[0]) + __uint_as_float(r0[1]);
          auto r1 = __builtin_amdgcn_permlane32_swap(__float_as_uint(a1), __float_as_uint(a1), false, false); a1 = __uint_as_float(r1[0]) + __uint_as_float(r1[1]);
          auto r2 = __builtin_amdgcn_permlane32_swap(__float_as_uint(mx), __float_as_uint(mx), false, false); mx = fmaxf(__uint_as_float(r2[0]), __uint_as_float(r2[1])); }
        if (hf == 0) { GAS float* o = (GAS float*)(kmean + ((size_t)(b * 16 + hh) * 16 + n) * 64 + 2 * l5);
            o[0] = a0 * (1.f / 256.f); o[1] = a1 * (1.f / 256.f); }
        if (lane == 0) ((GAS float*)kmax2)[(size_t)(b * 16 + hh) * 16 + n] = mx;
    }
}

struct KArgs { const float* in[17]; float* out; unsigned char* ws; int ph_lo, ph_hi; };
struct ConvDesc { const float* W; int K, N; unsigned char* WT; int il; bool f8; float sc; };
constexpr int NCONV = 61, CONV_CH = 128;
__device__ __forceinline__ ConvDesc conv_desc(const KArgs& args, unsigned char* ws, int m) {
    constexpr float WSC_UP = 32.0f, WSC_DN = 64.0f;
    ConvDesc d; d.il = 0; d.f8 = false; d.sc = 1.0f;
    if (m < 2) { d.W = args.in[7] + (size_t)m * D * 3 * D; d.K = D; d.N = 3 * D; d.WT = ws + WS_MQKV + (size_t)m * 3 * D * D * 2; }
    else if (m < 4) { const int j = m - 2; d.W = args.in[8] + (size_t)j * D * D; d.K = D; d.N = D; d.WT = ws + WS_MWO + (size_t)j * D * D * 2; }
    else if (m == 4) { d.W = args.in[4]; d.K = D; d.N = D; d.WT = ws + WS_DWO; }
    else if (m == 5) { d.W = args.in[3] + (size_t)D * 3 * D; d.K = D; d.N = 3 * D; d.WT = ws + WS_DQKV + (size_t)3 * D * D * 2; }
    else if (m == 6) { d.W = args.in[4] + (size_t)D * D; d.K = D; d.N = D; d.WT = ws + WS_DWO + (size_t)D * D * 2; }
    else if (m < 13) { const int r = m - 7, j = r / 3, t = r % 3; d.f8 = (j == 1);
        if (t < 2) { d.W = args.in[9 + t] + (size_t)j * D * DFF; d.K = D; d.N = DFF; d.WT = ws + WS_FGU + (size_t)j * 2 * DFF * D * 2; d.il = 1 + t; d.sc = d.f8 ? WSC_UP : 1.0f; }
        else { d.W = args.in[11] + (size_t)j * DFF * D; d.K = DFF; d.N = D; d.WT = ws + WS_FD + (size_t)j * D * DFF * 2; d.sc = d.f8 ? WSC_DN : 1.0f; } }
    else { const int r = m - 13, e = r / 3, t = r % 3; d.f8 = true;
        if (t < 2) { d.W = args.in[13 + t] + (size_t)e * D * DE; d.K = D; d.N = DE; d.WT = ws + WS_MGU + (size_t)e * 2 * DE * D; d.il = 1 + t; d.sc = WSC_UP; }
        else { d.W = args.in[15] + (size_t)e * DE * D; d.K = DE; d.N = D; d.WT = ws + WS_MD + (size_t)e * D * DE; d.sc = WSC_DN; } }
    return d;
}
__device__ __forceinline__ int conv_chunks_of(int m) { const int items = m < 2 || m == 5 ? 768 : (m < 7 ? 256 : (m < 13 ? 704 : 896)); return (items + CONV_CH - 1) / CONV_CH; }
__device__ __forceinline__ int conv_total_chunks() { int s = 0; for (int m = 0; m < NCONV; ++m) s += conv_chunks_of(m); return s; }
__device__ __forceinline__ void conv_chunk(Frame& F, const KArgs& args, unsigned char* ws, int c) {
    int m = 0; for (; m < NCONV; ++m) { const int n = conv_chunks_of(m); if (c < n) break; c -= n; }
    const ConvDesc d = conv_desc(args, ws, m);
    LAS float* scr = (LAS float*)(F.lds + RING_OFF + F.wave * 16384);
    int lane_ = F.lane; asm volatile("" : "+v"(lane_));
    const int nblk = d.N / 64, nitems = (d.K / 64) * nblk, last = (c + 1) * CONV_CH < nitems ? (c + 1) * CONV_CH : nitems;
    for (int it = c * CONV_CH + F.wave; it < last; it += NWAVES) {
        const int kb = it / nblk, nb = it % nblk, n0 = 64 * nb;
        const int drow0 = d.il == 0 ? n0 : (n0 / 128) * 256 + (d.il - 1) * 128 + (n0 % 128);
        transpose_item(d.W, d.K, d.N, d.WT, 64 * kb, n0, drow0, scr, lane_, d.f8, d.sc);
    }
}

__global__ void __launch_bounds__(NWAVES * 64, 2) trunk_fwd(KArgs args) {
    extern __shared__ __attribute__((aligned(16))) unsigned char lds[];
    Frame F;
    F.lds = (LAS unsigned char*)lds;
    F.MISC = (volatile LAS unsigned*)(F.lds + MISC_OFF);
    F.tid = threadIdx.x; F.lane = F.tid & 63; F.wave = __builtin_amdgcn_readfirstlane(F.tid >> 6);
    F.G = gridDim.x; { const int bx = blockIdx.x; F.vcu = (F.G % 8 == 0) ? (bx % 8) * (F.G / 8) + bx / 8 : bx; }
    F.ctl = (gu32*)(args.ws + WS_CTL);
    for (int u = F.tid; u < (LDS_BYTES - LDSCTL_OFF) / 4; u += NWAVES * 64) ((LAS unsigned*)(F.lds + LDSCTL_OFF))[u] = 0u;
    __syncthreads();
    Frame& F0 = F;
    const int lo = args.ph_lo, hi = args.ph_hi;
    XcdBarrier bar; bar.bar = (unsigned*)(F.ctl + CW_BAR); bar.x = 0; bar.st = nullptr;
    if (hi - lo > 1) bar = xcd_barrier_post((unsigned*)(F.ctl + CW_BAR), F.MISC + 8);
#define IN(k) (lo <= (k) && (k) < hi)
#ifndef PH_ENABLE
#define PH_ENABLE 0xFFFFFFFFu
#endif
#define PHEN(n) (((PH_ENABLE) >> (n)) & 1u)
#ifndef MK_DOUBLE
#define MK_DOUBLE 0u
#endif
#define NREP(n) ((((MK_DOUBLE) >> (n)) & 1u) ? 2 : 1)
#if defined(NO_OPQ)
#define OPQ(p) do {} while (0)
#else
#define OPQ(p) asm volatile("" : "+s"(p))
#endif
#if 0
#define STAMP(k) do { if (blockIdx.x == 0 && threadIdx.x == 0) { const unsigned long long t_ = __builtin_amdgcn_s_memrealtime(); ((GAS unsigned*)(F0.ctl))[3000 + (k)] = (unsigned)t_; } } while (0)
#else
#define STAMP(k) do {} while (0)
#endif
#define SEAM(k) do { if (IN(k) && IN((k) + 1)) { XcdBarrier b2_ = bar; OPQ(b2_.bar); xcd_barrier(b2_); } STAMP((k) + 1); } while (0)

#define PTRS() unsigned char* ws = args.ws; OPQ(ws); const float* x = args.in[0]; OPQ(x); const float* norm_mix = args.in[1]; OPQ(norm_mix); const float* norm_ffn = args.in[2]; OPQ(norm_ffn); \
    float* h = args.out; OPQ(h); \
    bf16* XN = (bf16*)(ws + WS_XN); bf16* Qb = (bf16*)(ws + WS_Q); bf16* Kb = (bf16*)(ws + WS_K); bf16* Vb = (bf16*)(ws + WS_V); bf16* ACT = (bf16*)(ws + WS_ACT); \
    bf16* MGU = (bf16*)(ws + WS_MGU); bf16* MD = (bf16*)(ws + WS_MD); \
    float* kmean = (float*)(ws + WS_KMEAN); unsigned* ltok = (unsigned*)(ws + WS_LTOK); float* lw = (float*)(ws + WS_LW); \
    (void)x; (void)norm_mix; (void)norm_ffn; (void)h; (void)XN; (void)Qb; (void)Kb; (void)Vb; (void)ACT; (void)MGU; (void)MD; (void)kmean; (void)ltok; (void)lw
    const RouterArgs noR{nullptr, nullptr, nullptr, nullptr};
#ifndef MK_F8_DENSE
#define MK_F8_DENSE 0
#endif
    constexpr bool F8_DENSE = MK_F8_DENSE != 0; constexpr int DESZ = F8_DENSE ? 1 : 2;
    constexpr float WSC_UP = 32.0f, WSC_DN = 64.0f;
    constexpr float C2 = 0.125f * 1.4426950408889634f;

    STAMP(0);
    if (PHEN(0) && IN(0)) {
        PTRS();
        { unsigned rot = 0u;
        convert_matrix(F, args.in[3], D, 3 * D, ws + WS_DQKV, 0, rot);
        norm_phase<0>(F, x, nullptr, nullptr, norm_mix, XN, nullptr, noR);
        }
    }
    SEAM(0);

    for (int L = 0; L < NLAYER; ++L) {
        const int j = L >> 1, moba = L & 1, pb = 1 + PH_PER_LAYER * L;
        int z_ = 0;
#if !defined(NO_OPQ_Z)
        asm volatile("" : "+s"(z_));
#endif
        Frame Fl = F0; Fl.G += z_; Fl.vcu += z_; Fl.wave += z_; Fl.lds += z_; Fl.ctl += z_; const int bx = (int)blockIdx.x + z_;
#define F Fl
        if (PHEN(1) && IN(pb + 0)) {
            PTRS();

            const bf16* W = (const bf16*)(ws + (moba ? WS_MQKV : WS_DQKV)) + (size_t)j * 3 * D * D;
            pg8::Gemm g{XN, W, 2 * D, 0}; pg8::StaticOrder S; S.init(MTOK, 3 * D, F.G, bx);
            pg8::EpiQKV E{Qb, D, D, (size_t)(WS_K - WS_Q) / 2, C2};
            for (int rep_ = 0; rep_ < NREP(1); ++rep_) pg8::gemm_phase<pg8::EpiQKV, pg8::StaticOrder>(F.lds + RING_OFF, XSLOT_OFF, g, S, E);
        }
        SEAM(pb + 0);
        { if (PHEN(2) && IN(pb + 1)) { PTRS(); kstat_phase(F, Kb, kmean, kmean + 8 * 16 * 16 * 64); } SEAM(pb + 1); }
        if (IN(pb + 2)) {
            PTRS();
            att::Args A; A.Q = Qb; A.K = Kb; A.V = Vb; A.O = XN; A.kmean = kmean; A.kmax2 = kmean + 8 * 16 * 16 * 64; A.subln = args.in[6] + (size_t)j * 128; A.lam_full = 0.f; A.out_scale = 1.f; A.abl = 0;
            LAS int* qw;
            if (!moba) {
                const float* lam = args.in[5] + (size_t)j * 256; int lane = F.lane; asm volatile("" : "+v"(lane));
                const GAS float* lamg = (const GAS float*)lam; const float s1 = wave_sum(lamg[lane] * lamg[64 + lane]), s2 = wave_sum(lamg[128 + lane] * lamg[192 + lane]);
                const float lam_init = (L == 0) ? 0.2f : 0.47071302f;
                A.lam_full = __uint_as_float(__builtin_amdgcn_readfirstlane(__float_as_uint(__expf(s1) - __expf(s2) + lam_init))); A.out_scale = __uint_as_float(__builtin_amdgcn_readfirstlane(__float_as_uint(1.0f - lam_init)));
            }
            const int nconv = (L == 0) ? conv_total_chunks() : 0;
            qw = (LAS int*)(F.lds + XSLOT_OFF);
            const int xme = (int)(xb_xcc_id() & 7u);
            if ((PHEN(3) && !moba) || (PHEN(4) && moba)) for (int rep_ = 0; rep_ < (moba ? NREP(4) : NREP(3)); ++rep_) for (int xq = xme;;) {
#if ATT_ABLATE
                { const bool ab_ = rep_ == 0 && (moba ? NREP(4) : NREP(3)) == 2; A.abl = ab_ ? ATT_ABLATE : 0; A.O = ab_ ? (bf16*)(ws + WS_END) : XN; }
#endif
                const int ncx = (nconv && rep_ == 0) ? ((nconv - xq + 7) >> 3) : 0;
                gu32* qb = F.ctl + CW_ATTQ2 + 256 * L + 1024 * rep_; gu32* qx = qb + 32 * xq;
                for (;;) {
                    if (F.tid == 0) *qw = (int)__hip_atomic_fetch_add(qx, 1u, RLX_AGENT);
                    asm volatile("s_waitcnt vmcnt(0) lgkmcnt(0)\n\ts_barrier" ::: "memory");
                    int idx = __builtin_amdgcn_readfirstlane(*qw);
                    if (idx >= 128 + ncx) { asm volatile("s_waitcnt vmcnt(0) lgkmcnt(0)\n\ts_barrier" ::: "memory"); break; }
                    if (ncx) { const int q3 = idx / 3; if (idx < 3 * ncx) { if (idx - 3 * q3 == 2) { conv_chunk(F, args, ws, xq + 8 * q3); asm volatile("s_waitcnt vmcnt(0) lgkmcnt(0)\n\ts_barrier" ::: "memory"); continue; } idx -= q3; } else idx -= ncx; }
                    if (!moba) { const int hh = 7 - (idx >> 4), pr = idx & 15;
                        att::attn_unit<0>(F.lds + RING_OFF, A, xq, hh, pr);
                        att::attn_unit<0>(F.lds + RING_OFF, A, xq, hh, 31 - pr);
                    } else { const int hh = 15 - (idx >> 3), pr = idx & 7;
                        att::attn_unit<1>(F.lds + RING_OFF, A, xq, hh, pr);
                        att::attn_unit<1>(F.lds + RING_OFF, A, xq, hh, 15 - pr); }
                }
                if (F.tid < 64) { int lane = F.tid; asm volatile("" : "+v"(lane)); bool av = false;
                    if (lane < 8) { const int lim = 128 + ((nconv && rep_ == 0) ? ((nconv - lane + 7) >> 3) : 0); av = (int)__hip_atomic_load(qb + 32 * lane, RLX_AGENT) < lim; }
                    const unsigned long long m_ = __ballot(av);
                    if (lane == 0) *qw = (int)(unsigned)m_; }
                asm volatile("s_waitcnt vmcnt(0) lgkmcnt(0)\n\ts_barrier" ::: "memory");
                const unsigned m = (unsigned)__builtin_amdgcn_readfirstlane(*qw);
                asm volatile("s_waitcnt vmcnt(0) lgkmcnt(0)\n\ts_barrier" ::: "memory");
                if (m == 0u) break;
                const unsigned rot = ((m >> xme) | (m << (8 - xme))) & 0xFFu;
                xq = (xme + __builtin_ctz(rot)) & 7;
            }
            asm volatile("s_waitcnt vmcnt(0) lgkmcnt(0)\n\ts_barrier" ::: "memory");
        }
        SEAM(pb + 2);
        if (PHEN(5) && IN(pb + 3)) {
            PTRS();
            const bf16* W = (const bf16*)(ws + (moba ? WS_MWO : WS_DWO)) + (size_t)j * D * D;
            pg8::Gemm g{XN, W, 2 * D, 0}; pg8::StaticOrder S; S.init(MTOK, D, F.G, bx);
            pg8::EpiRes E{L == 0 ? x : h, h, D, 1.0f};
            pg8::gemm_phase<pg8::EpiRes, pg8::StaticOrder>(F.lds + RING_OFF, XSLOT_OFF, g, S, E);
        }
        SEAM(pb + 3);
        if (PHEN(6) && IN(pb + 4)) {
            PTRS();
            if (!moba) {
                if (L == 2) norm_phase<0, true>(F, h, nullptr, nullptr, norm_ffn + (size_t)L * D, XN, nullptr, noR);
                else norm_phase<0, false>(F, h, nullptr, nullptr, norm_ffn + (size_t)L * D, XN, nullptr, noR);
            } else {
                const RouterArgs R{args.in[12] + (size_t)j * D * NE, F.ctl + CW_CNT + 64 * NE * j, ltok, lw};
                norm_phase<2, true>(F, h, nullptr, nullptr, norm_ffn + (size_t)L * D, XN, nullptr, R);
            }
        }
        SEAM(pb + 4);
        if (IN(pb + 5)) {
            PTRS();
            if (PHEN(7) && !moba) {
                if (L == 2) { pg8::Gemm g{XN, ws + WS_FGU + (size_t)j * 2 * DFF * D * 2, D, 0}; pg8::StaticOrder S; S.init(MTOK, 2 * DFF, F.G, bx);
                    pg8::EpiSwiGLU<true> E{ACT, DFF, 1.0f / WSC_UP};
                    pg8::gemm_phase<pg8::EpiSwiGLU<true>, pg8::StaticOrder, true>(F.lds + RING_OFF, XSLOT_OFF, g, S, E);
                } else { pg8::Gemm g{XN, ws + WS_FGU + (size_t)j * 2 * DFF * D * 2, 2 * D, 0}; pg8::StaticOrder S; S.init(MTOK, 2 * DFF, F.G, bx);
                    pg8::EpiSwiGLU<false> E{ACT, DFF, 1.0f};
                    pg8::gemm_phase<pg8::EpiSwiGLU<false>, pg8::StaticOrder, false>(F.lds + RING_OFF, XSLOT_OFF, g, S, E); }
            } else if (PHEN(8) && moba) {
                pg8::Gemm g{XN, ws + WS_MGU + (size_t)j * NE * 2 * DE * D, D, (size_t)2 * DE * D}; pg8::MoeOrder S; S.init((const unsigned*)(F.ctl + CW_CNT + 64 * NE * j), ltok, true, 2 * DE, F.G, bx);
                pg8::EpiSwiGLU<true> E{ACT, DE, 1.0f / WSC_UP};
                pg8::gemm_phase<pg8::EpiSwiGLU<true>, pg8::MoeOrder, true>(F.lds + RING_OFF, XSLOT_OFF, g, S, E);
            }
        }
        SEAM(pb + 5);
        if (IN(pb + 6)) {
            PTRS();
            if (PHEN(9) && !moba) {
                if (L == 2) { pg8::Gemm g{ACT, ws + WS_FD + (size_t)j * D * DFF * 2, DFF, 0}; pg8::StaticOrder S; S.init(MTOK, D, F.G, bx);
                    pg8::EpiRes E{h, h, D, 1.0f / WSC_DN};
                    pg8::gemm_phase<pg8::EpiRes, pg8::StaticOrder, true>(F.lds + RING_OFF, XSLOT_OFF, g, S, E);
                } else { pg8::Gemm g{ACT, ws + WS_FD + (size_t)j * D * DFF * 2, 2 * DFF, 0}; pg8::StaticOrder S; S.init(MTOK, D, F.G, bx);
                    pg8::EpiRes E{h, h, D, 1.0f};
                    pg8::gemm_phase<pg8::EpiRes, pg8::StaticOrder, false>(F.lds + RING_OFF, XSLOT_OFF, g, S, E); }
            } else if (PHEN(10) && moba) {
                pg8::Gemm g{ACT, ws + WS_MD + (size_t)j * NE * D * DE, DE, (size_t)D * DE}; pg8::MoeOrder S; S.init((const unsigned*)(F.ctl + CW_CNT + 64 * NE * j), ltok, false, D, F.G, bx);
                pg8::EpiMoeDown E; E.h = h; E.y1 = XN; E.list_tok = ltok; E.list_w = lw; E.sc = 1.0f / WSC_DN;
#pragma unroll
                for (int e = 0; e < NE; ++e) E.cnt[e] = S.cnt[e];
                pg8::gemm_phase<pg8::EpiMoeDown, pg8::MoeOrder, true>(F.lds + RING_OFF, XSLOT_OFF, g, S, E);
            }
        }
        SEAM(pb + 6);
        if (PHEN(11) && IN(pb + 7)) {
            PTRS();
            if (L == 3) norm_phase<3>(F, h, nullptr, XN, args.in[16], nullptr, h, noR);
            else if (moba) norm_phase<1>(F, h, h, XN, norm_mix + (size_t)(L + 1) * D, XN, nullptr, noR);
            else for (int rep_ = 0; rep_ < NREP(11); ++rep_) norm_phase<0>(F, h, nullptr, nullptr, norm_mix + (size_t)(L + 1) * D, XN, nullptr, noR);
        }
        if (L != NLAYER - 1) SEAM(pb + 7); else STAMP(pb + 8);
#undef F
    }
#undef IN
#undef SEAM
#undef PTRS
#undef OPQ
}


#if MK_DEBUG
__global__ void dbg_probe(const void* buf, size_t n, int is_bf16, int idx, float thresh, unsigned* dbg) {
    size_t i = blockIdx.x * (size_t)blockDim.x + threadIdx.x, stride = (size_t)gridDim.x * blockDim.x; bool bad = false;
    for (size_t k = i; k < n; k += stride) { float v = is_bf16 ? __uint_as_float(((unsigned)((const unsigned short*)buf)[k]) << 16) : ((const float*)buf)[k]; if (!(fabsf(v) <= thresh)) bad = true; }
    if (bad) atomicMax(dbg, (unsigned)(1000 - idx));
}
__global__ void dbg_cnt(const unsigned* cntw, int idx, unsigned* dbg) {
    if (threadIdx.x == 0 && blockIdx.x == 0) { unsigned s = 0; for (int e = 0; e < NE; ++e) s += cntw[64 * e]; if (s != 2u * MTOK) atomicMax(dbg, (unsigned)(1000 - idx)); }
}

__device__ __forceinline__ float dbg_bf(unsigned short v) { return __uint_as_float(((unsigned)v) << 16); }
__device__ __forceinline__ unsigned dbg_hash(unsigned x) { x ^= x >> 16; x *= 0x7feb352dU; x ^= x >> 15; x *= 0x846ca68bU; x ^= x >> 16; return x; }
__global__ void dbg_gemm_check(const unsigned short* A, int lda, const unsigned short* Bt, int K, const unsigned short* out, int ldo, int M, int N, float scale, int idx, unsigned* dbg) {
    const unsigned s = blockIdx.x * blockDim.x + threadIdx.x; const int row = (int)(dbg_hash(2 * s + 1) % (unsigned)M), col = (int)(dbg_hash(2 * s + 2) % (unsigned)N);
    float acc = 0.f; for (int k = 0; k < K; ++k) acc += dbg_bf(A[(size_t)row * lda + k]) * dbg_bf(Bt[(size_t)col * K + k]);
    acc *= scale; const float got = dbg_bf(out[(size_t)row * ldo + col]);
    if (!(fabsf(got - acc) <= 0.03f + 0.02f * fabsf(acc))) { atomicMax(dbg, (unsigned)(1000 - idx)); atomicAdd(dbg + 64 + idx, 1u); }
}
__global__ void dbg_conv_check(const float* W, int K, int N, const unsigned short* WT, int il, int idx, unsigned* dbg) {
    const unsigned s = blockIdx.x * blockDim.x + threadIdx.x; const int k = (int)(dbg_hash(2 * s + 1) % (unsigned)K), n = (int)(dbg_hash(2 * s + 2) % (unsigned)N);
    const int dr = il == 0 ? n : (n / 128) * 256 + (il - 1) * 128 + (n % 128);
    const float w = W[(size_t)k * N + n], g = dbg_bf(WT[(size_t)dr * K + k]);
    if (!(fabsf(g - w) <= 0.01f * fabsf(w) + 1e-6f)) atomicMax(dbg, (unsigned)(1000 - idx));
}
__global__ void dbg_norm_check(const float* src, const float* gain, const unsigned short* xn, int idx, unsigned* dbg) {
    const unsigned s = blockIdx.x * blockDim.x + threadIdx.x; const int row = (int)(dbg_hash(s + 77) % (unsigned)MTOK);
    float ss = 0.f; for (int c = 0; c < D; ++c) { const float v = src[(size_t)row * D + c]; ss += v * v; }
    const float rstd = 1.f / sqrtf(ss / D + 1e-6f); bool bad = false;
    for (int c = 0; c < D; ++c) { const float r = src[(size_t)row * D + c] * rstd * gain[c], g = dbg_bf(xn[(size_t)row * D + c]); if (!(fabsf(g - r) <= 0.02f + 0.01f * fabsf(r))) bad = true; }
    if (bad) atomicMax(dbg, (unsigned)(1000 - idx));
}
__global__ void dbg_naive_gemm(const unsigned short* A, const unsigned short* Bt, unsigned short* out, int M, int N, int K) {
    const size_t i = blockIdx.x * (size_t)blockDim.x + threadIdx.x; if (i >= (size_t)M * N) return; const int row = (int)(i / N), col = (int)(i % N);
    float acc = 0.f; for (int k = 0; k < K; ++k) acc += dbg_bf(A[(size_t)row * K + k]) * dbg_bf(Bt[(size_t)col * K + k]);
    out[(size_t)row * N + col] = (unsigned short)f2bf(acc);
}
__global__ void dbg_find_col(const unsigned short* out, const unsigned short* ref, int M, int N, unsigned* hist) {
    const unsigned s = blockIdx.x * blockDim.x + threadIdx.x; const int row = (int)(dbg_hash(2 * s + 1) % (unsigned)M), col = (int)(dbg_hash(2 * s + 2) % (unsigned)N);
    const unsigned short v = out[(size_t)row * N + col]; int found = -1;
#if MK_FIND_PATTERN
    if (v == 0x3C3C) atomicAdd(hist + N, 1u); else atomicAdd(hist + 5, 1u); return;
#endif
#if MK_FIND_ROWS
    for (int r = 0; r < M; ++r) if (ref[(size_t)r * N + col] == v) { found = r; break; }
    if (found < 0) atomicAdd(hist + N, 1u); else atomicAdd(hist + ((found - row) & (N - 1)), 1u);
#else
    for (int c = 0; c < N; ++c) if (ref[(size_t)row * N + c] == v) { found = c; break; }
    if (found < 0) atomicAdd(hist + N, 1u); else atomicAdd(hist + ((found - col) & (N - 1)), 1u);
#endif
}
__global__ void dbg_hist_code(const unsigned* hist, int N, unsigned* dbg) {
    if (threadIdx.x || blockIdx.x) return; unsigned best = 0, bi = 0; for (int i = 0; i < N; ++i) if (hist[i] > best) { best = hist[i]; bi = i; }
    dbg[32] = bi; dbg[33] = best; dbg[34] = hist[N];
}
__global__ void dbg_final(float* out, size_t n, const unsigned* dbg) {
    if (MK_HIST_SEL >= 10) { const float c3 = sqrtf((float)dbg[MK_HIST_SEL + 30]); size_t i3 = blockIdx.x * (size_t)blockDim.x + threadIdx.x, st3 = (size_t)gridDim.x * blockDim.x; for (size_t k3 = i3; k3 < n; k3 += st3) out[k3] = c3; return; }
    if (MK_HIST_SEL >= 0 && (dbg[33] || dbg[34])) { const float c2 = sqrtf((float)(MK_HIST_SEL == 0 ? dbg[32] : (MK_HIST_SEL == 1 ? dbg[33] * 100u / 4096u : dbg[34] * 100u / 4096u)) + 1.f); size_t i2 = blockIdx.x * (size_t)blockDim.x + threadIdx.x, st2 = (size_t)gridDim.x * blockDim.x; for (size_t k2 = i2; k2 < n; k2 += st2) out[k2] = c2; return; }
    const unsigned d = dbg[0]; if (d == 0u) return; const unsigned nf = dbg[64 + (1000u - d)]; const float c = sqrtf(nf ? (float)(200u * (1000u - d - 9u) + nf * 100u / 4096u) : (float)(1000u - d));
    size_t i = blockIdx.x * (size_t)blockDim.x + threadIdx.x, stride = (size_t)gridDim.x * blockDim.x;
    for (size_t k = i; k < n; k += stride) out[k] = c;
}
#endif

#ifndef MK_REPEAT
#define MK_REPEAT 1
#endif
#ifndef MK_FIND_ROWS
#define MK_FIND_ROWS 0
#endif
#ifndef MK_FIND_REGION
#define MK_FIND_REGION WS_K
#endif
#ifndef MK_HIST_SEL
#define MK_HIST_SEL 0
#endif
#ifndef MK_STAMP
#define MK_STAMP 0
#endif
#if MK_STAMP
__global__ void stamp_k(unsigned* p) { if (threadIdx.x == 0) *p = (unsigned)__builtin_amdgcn_s_memrealtime(); }
__global__ void stamp_encode(float* out, size_t n, const unsigned* st, int pa, float ua, int pb, float ub) {
    const float da = (float)(st[pa + 1] - st[pa]) * 0.01f, db = (float)(st[pb + 1] - st[pb]) * 0.01f;
    float m = da / ua; m = m < 10.f ? 10.f : (m > 99.f ? 99.f : m); float e = floorf(db / ub + 0.5f); e = e < 0.f ? 0.f : (e > 30.f ? 30.f : e);
    const float c = sqrtf(m) * __powf(10.f, 0.5f * e);
    size_t i = blockIdx.x * (size_t)blockDim.x + threadIdx.x, stride = (size_t)gridDim.x * blockDim.x;
    for (size_t k = i; k < n; k += stride) out[k] = c;
}
#endif
extern "C" void kernel_launch(void* const* d_in, const int* in_sizes, int n_in, void* d_out, int out_size, void* d_ws, size_t ws_size, hipStream_t stream) {
    static int grid = 0;
    if (grid == 0) {
        if (n_in != 17 || in_sizes[0] != MTOK * D || out_size != MTOK * D || ws_size < WS_END) {
            fprintf(stderr, "kernel_launch: built for 17 inputs, x/out of %d floats, >= %zu bytes of workspace; got n_in %d, in0 %d, out %d, ws %zu; nothing launched\n", MTOK * D, (size_t)WS_END, n_in, n_in > 0 ? in_sizes[0] : -1, out_size, ws_size);
            grid = -1; return; }
        int dev = 0, cus = 0, per_cu = 0;
        if (hipGetDevice(&dev) != hipSuccess || hipDeviceGetAttribute(&cus, hipDeviceAttributeMultiprocessorCount, dev) != hipSuccess) { fprintf(stderr, "kernel_launch: device query failed\n"); grid = -1; return; }
        if (hipFuncSetAttribute((const void*)trunk_fwd, hipFuncAttributeMaxDynamicSharedMemorySize, LDS_BYTES) != hipSuccess) { fprintf(stderr, "kernel_launch: hipFuncSetAttribute failed\n"); grid = -1; return; }
        if (hipOccupancyMaxActiveBlocksPerMultiprocessor(&per_cu, (const void*)trunk_fwd, NWAVES * 64, LDS_BYTES) != hipSuccess || per_cu < 1)
            fprintf(stderr, "kernel_launch: note: occupancy query reports %d workgroups per CU\n", per_cu);
        (void)hipGetLastError();
        grid = cus;
    }
    if (grid < 0) return;
    if (hipMemsetAsync((char*)d_ws + WS_CTL, 0, CTL_ZERO_BYTES, stream) != hipSuccess) { fprintf(stderr, "kernel_launch: memset failed\n"); return; }
    KArgs a{};
    for (int i = 0; i < 17; ++i) a.in[i] = (const float*)d_in[i];
    a.out = (float*)d_out; a.ws = (unsigned char*)d_ws;
#if MK_PER_PHASE
#if MK_STAMP
    hipLaunchKernelGGL(stamp_k, dim3(1), dim3(64), 0, stream, (unsigned*)d_ws + 3000);
#endif
    for (int p = 0; p < NPHASE; ++p) {
        a.ph_lo = p; a.ph_hi = p + 1;
#if MK_DEBUG
#endif
#if !defined(MK_SKIP_MAIN)
        for (int rep_ = 0; rep_ < (p == 1 ? MK_REPEAT : 1); ++rep_) hipLaunchKernelGGL(trunk_fwd, dim3(grid), dim3(NWAVES * 64), LDS_BYTES, stream, a);
#endif
#if MK_STAMP
        hipLaunchKernelGGL(stamp_k, dim3(1), dim3(64), 0, stream, (unsigned*)d_ws + 3000 + p + 1);
#endif
#if MK_DEBUG
        {   unsigned char* ws = (unsigned char*)d_ws; unsigned* dbg = (unsigned*)(ws + WS_CTL) + 2048;
            const size_t MD_ = (size_t)MTOK * D;
#define PROBE(buf, n, isbf, idx, th) if ((idx) <= MK_PROBE_MAX) hipLaunchKernelGGL(dbg_probe, dim3(2048), dim3(256), 0, stream, (const void*)(buf), (size_t)(n), isbf, idx, th, dbg)
            if (p == 0) {
                hipLaunchKernelGGL(dbg_norm_check, dim3(4), dim3(64), 0, stream, (const float*)d_in[0], (const float*)d_in[1], (const unsigned short*)(ws + WS_XN), 4, dbg);
                hipLaunchKernelGGL(dbg_conv_check, dim3(16), dim3(256), 0, stream, (const float*)d_in[3], D, 3 * D, (const unsigned short*)(ws + WS_DQKV), 0, 5, dbg);
                hipLaunchKernelGGL(dbg_conv_check, dim3(16), dim3(256), 0, stream, (const float*)d_in[9], D, DFF, (const unsigned short*)(ws + WS_FGU), 1, 6, dbg);
                hipLaunchKernelGGL(dbg_conv_check, dim3(16), dim3(256), 0, stream, (const float*)d_in[10], D, DFF, (const unsigned short*)(ws + WS_FGU), 2, 7, dbg);
                hipLaunchKernelGGL(dbg_conv_check, dim3(16), dim3(256), 0, stream, (const float*)d_in[11], DFF, D, (const unsigned short*)(ws + WS_FD), 0, 8, dbg);
                hipLaunchKernelGGL(dbg_conv_check, dim3(16), dim3(256), 0, stream, (const float*)d_in[15] + (size_t)3 * DE * D, DE, D, (const unsigned short*)(ws + WS_MD) + (size_t)3 * D * DE, 0, 9, dbg);
            }
            if (p == 1) {
                const float C2h = 0.125f * 1.4426950408889634f;
                hipLaunchKernelGGL(dbg_gemm_check, dim3(16), dim3(256), 0, stream, (const unsigned short*)(ws + WS_XN), D, (const unsigned short*)(ws + WS_DQKV), D, (const unsigned short*)(ws + WS_Q), D, MTOK, D, C2h, 10, dbg);
                hipLaunchKernelGGL(dbg_gemm_check, dim3(16), dim3(256), 0, stream, (const unsigned short*)(ws + WS_XN), D, (const unsigned short*)(ws + WS_DQKV) + (size_t)D * D, D, (const unsigned short*)(ws + WS_K), D, MTOK, D, 1.f, 11, dbg);

                hipLaunchKernelGGL(dbg_gemm_check, dim3(16), dim3(256), 0, stream, (const unsigned short*)(ws + WS_XN), D, (const unsigned short*)(ws + WS_DQKV) + (size_t)2 * D * D, D, (const unsigned short*)(ws + WS_V), D, MTOK, D, 1.f, 12, dbg);
            }
            if (0) { PROBE(ws + WS_XN, MD_, 1, 1, 10.f); PROBE(ws + WS_DQKV, (WS_MGU - WS_DQKV) / 2, 1, 2, 1.f); PROBE(ws + WS_MGU, (WS_XN - WS_MGU) / 2, 1, 3, 1.f); }
            if (p >= 1) { const int L = (p - 1) / PH_PER_LAYER, k = (p - 1) % PH_PER_LAYER; const int b = 20 + 10 * L;
                if (k == 0) PROBE(ws + WS_Q, 3 * MD_, 1, b + 0, 50.f);
                if (k == 1) PROBE(ws + WS_KMEAN, 8 * 16 * 16 * 64, 0, b + 1, 5.f);
                if (k == 2) PROBE(ws + WS_XN, MD_, 1, b + 2, 50.f);
                if (k == 3) PROBE(d_out, MD_, 0, b + 3, 300.f);
                if (k == 4) { PROBE(ws + WS_XN, MD_, 1, b + 4, 20.f); if ((L & 1) && (b + 9) <= MK_PROBE_MAX) hipLaunchKernelGGL(dbg_cnt, dim3(1), dim3(64), 0, stream, (const unsigned*)(ws + WS_CTL) + CW_CNT + 64 * NE * (L >> 1), b + 9, dbg); }
                if (k == 5) PROBE(ws + WS_ACT, (L & 1) ? (size_t)256 * 256 * DE : (size_t)MTOK * DFF, 1, b + 5, 2000.f);
                if (k == 6) { PROBE(d_out, MD_, 0, b + 6, 1000.f); if (L & 1) PROBE(ws + WS_XN, MD_, 1, b + 7, 1000.f); }
                if (k == 7 && L != 3) { PROBE(ws + WS_XN, MD_, 1, b + 8, 20.f); PROBE(d_out, MD_, 0, b + 8, 1000.f); }
            }
#undef PROBE
        }
#endif
    }
#if MK_DEBUG
    hipLaunchKernelGGL(dbg_final, dim3(2048), dim3(256), 0, stream, (float*)d_out, (size_t)MTOK * D, (const unsigned*)((unsigned char*)d_ws + WS_CTL) + 2048);
#endif
#else
    a.ph_lo = 0; a.ph_hi = NPHASE;
    hipLaunchKernelGGL(trunk_fwd, dim3(grid), dim3(NWAVES * 64), LDS_BYTES, stream, a);
#if 0
    hipLaunchKernelGGL(stamp_encode, dim3(2048), dim3(256), 0, stream, (float*)d_out, (size_t)MTOK * D, (const unsigned*)d_ws + 3000, MK_STAMP_PA, MK_STAMP_UA, MK_STAMP_PB, MK_STAMP_UB);
#endif
#endif
#if MK_STAMP
    hipLaunchKernelGGL(stamp_encode, dim3(2048), dim3(256), 0, stream, (float*)d_out, (size_t)MTOK * D, (const unsigned*)d_ws + 3000, MK_STAMP_PA, MK_STAMP_UA, MK_STAMP_PB, MK_STAMP_UB);
#endif
    const hipError_t le = hipPeekAtLastError();
    if (le != hipSuccess) fprintf(stderr, "kernel_launch: launch failed: %s\n", hipGetErrorName(le));
}
```

```cpp
#ifndef MK_DEBUG
#define MK_DEBUG 0
#endif
#ifndef MK_PER_PHASE
#define MK_PER_PHASE 0
#endif
#include <hip/hip_runtime.h>
#include <cstdio>
#include <cstdint>

#ifndef MK_KDEBUG
#define MK_KDEBUG 0
#endif
#define LAS __attribute__((address_space(3)))
#define GAS __attribute__((address_space(1)))

constexpr int BATCH = 8, SEQ = 4096, MTOK = BATCH * SEQ, D = 1024, DFF = 2816, DE = 3584, NE = 8;
constexpr int MOE_TILES_MAX = 272;
constexpr int LIST_CAP = MTOK;

namespace pg8 {
#define PG8_LAS __attribute__((address_space(3)))
typedef unsigned short bf16_t;
typedef short bf16x8 __attribute__((ext_vector_type(8)));
typedef float f32x4 __attribute__((ext_vector_type(4)));
typedef unsigned u32x4 __attribute__((ext_vector_type(4)));
typedef int i32x4 __attribute__((ext_vector_type(4)));
typedef int i32x8 __attribute__((ext_vector_type(8)));
constexpr int BM = 256, BK = 64, HALF = 128, HTB = HALF * BK * 2  , STAGE_BYTES = 8 * HTB, NXCD = 8, WGM = 8;

__host__ __device__ __forceinline__ int lds_byte(int r, int c) { const int st = (r >> 4) * 2 + (c >> 5), rr = r & 15, cc = c & 31, ob = rr * 64 + cc * 2; return st * 1024 + (ob ^ (((ob >> 9) & 1) << 5)); }
__host__ __device__ __forceinline__ void stage_rc(int b, int& R, int& C) { const int st = b / 1024, sb = b % 1024, swz = sb ^ (((sb >> 9) & 1) << 5); R = (st >> 1) * 16 + swz / 64; C = (st & 1) * 32 + (swz % 64) / 2; }
__host__ __device__ __forceinline__ int perm32(int rho) { const int n = rho >> 4, i = rho & 15; return 8 * (i >> 2) + 4 * n + (i & 3); }

struct Unit { int pm, pn, e, r0; };
struct Gemm { const void* A; const void* Bt; int rowb; size_t bstride; };

__device__ __forceinline__ void tile_of(int L, int nM, int nN, int& pm, int& pn) {
    const int nwg = nM * nN; int wgid = L; { const int q = nwg / NXCD, r = nwg % NXCD, xcd = wgid % NXCD, off = wgid / NXCD; wgid = (xcd < r ? xcd * (q + 1) : r * (q + 1) + (xcd - r) * q) + off; }
    const int nig = WGM * nN, gid = wgid / nig, fm = gid * WGM, gsz = (nM - fm) < WGM ? (nM - fm) : WGM;
    pm = fm + ((wgid % nig) % gsz); pn = (wgid % nig) / gsz;
}
struct StaticOrder {
    int nM, nN, nwg, G, c;
    __device__ __forceinline__ void init(int M, int N, int G_, int c_) { nM = M / BM; nN = N / BM; nwg = nM * nN; G = G_; c = c_; }
    __device__ __forceinline__ bool next(int i, Unit& u) const {
        const long L = (long)i * G + c; if (L >= nwg) return false;
        tile_of((int)L, nM, nN, u.pm, u.pn); u.e = 0; u.r0 = 0; return true;
    }
    __device__ __forceinline__ unsigned arow(const Unit& u, int lr) const { return (unsigned)(u.pm * BM + lr); }
};
struct MoeOrder {
    int nM, nN, nwg, G, c; int tstart[NE + 1]; int cnt[NE]; const unsigned* list_tok; bool gather;
    __device__ __forceinline__ void init(const unsigned* cntw, const unsigned* list_tok_, bool gather_, int N, int G_, int c_) {
        int acc = 0;
#pragma unroll
        for (int e = 0; e < NE; ++e) { const int ce = (int)__builtin_amdgcn_readfirstlane((int)__hip_atomic_load((const GAS unsigned*)cntw + 64 * e, __ATOMIC_RELAXED, __HIP_MEMORY_SCOPE_AGENT)); cnt[e] = ce; tstart[e] = acc; acc += (ce + BM - 1) / BM; }
        tstart[NE] = acc; nM = acc; nN = N / BM; nwg = nM * nN; G = G_; c = c_; list_tok = list_tok_; gather = gather_;
    }
    __device__ __forceinline__ bool next(int i, Unit& u) const {
        const long L = (long)i * G + c; if (L >= nwg) return false;
        tile_of((int)L, nM, nN, u.pm, u.pn); int e = 0;
#pragma unroll
        for (int k = 1; k < NE; ++k) e += (u.pm >= tstart[k]) ? 1 : 0;
        u.e = e; int ts = 0;
#pragma unroll
        for (int k = 0; k < NE; ++k) ts = (k == e) ? tstart[k] : ts;
        u.r0 = (u.pm - ts) * BM; return true;
    }
    __device__ __forceinline__ int count_of(int e) const { int cv = 0;
#pragma unroll
        for (int k = 0; k < NE; ++k) cv = (k == e) ? cnt[k] : cv;
        return cv; }
    __device__ __forceinline__ unsigned arow(const Unit& u, int lr) const {
        if (!gather) return (unsigned)(u.pm * BM + lr);
        const int l = u.r0 + lr; const int cv = count_of(u.e);
        unsigned t = 0u; if (l < cv) t = __hip_atomic_load((const GAS unsigned*)list_tok + (size_t)u.e * LIST_CAP + l, __ATOMIC_RELAXED, __HIP_MEMORY_SCOPE_AGENT) & 0xFFFFFu;
        return t;
    }
};

__device__ __forceinline__ unsigned cvt_pk_bf16(float lo, float hi) { unsigned r; asm volatile("v_cvt_pk_bf16_f32 %0, %1, %2" : "=v"(r) : "v"(lo), "v"(hi)); return r; }

struct EpiQKV {
    static constexpr bool PERM = true;
    bf16_t* O; int ldc; int split_cols; size_t split_stride; float scale0;
    __device__ __forceinline__ void operator()(const f32x4 (&acc)[2][2][4][2], const Unit& u, int wr, int wc, int fr, int fq) const {
        const int row0 = u.pm * BM + wr * 64 + fr; int colt = u.pn * BM; bf16_t* base = O;
        float sc = 1.f; { const int t = colt / split_cols; base += (size_t)t * split_stride; colt -= t * split_cols; if (t == 0) sc = scale0; }
        const int col0 = colt + wc * 32 + 8 * fq;
#pragma unroll
        for (int ai = 0; ai < 2; ++ai)
#pragma unroll
            for (int m = 0; m < 4; ++m) { bf16_t* rowp = base + (size_t)(row0 + ai * HALF + m * 16) * ldc + col0;
#pragma unroll
                for (int bj = 0; bj < 2; ++bj) { f32x4 v0 = acc[ai][bj][m][0] * sc, v1 = acc[ai][bj][m][1] * sc;
                    u32x4 w; w.x = cvt_pk_bf16(v0[0], v0[1]); w.y = cvt_pk_bf16(v0[2], v0[3]); w.z = cvt_pk_bf16(v1[0], v1[1]); w.w = cvt_pk_bf16(v1[2], v1[3]);
                    *(GAS u32x4*)(rowp + bj * HALF) = w;
                    } }
    }
};
__device__ __forceinline__ unsigned pk4_fp8(float a, float b, float c, float d) { unsigned w = 0; w = __builtin_amdgcn_cvt_pk_fp8_f32(a, b, w, false); w = __builtin_amdgcn_cvt_pk_fp8_f32(c, d, w, true); return w; }
template <bool F8OUT> struct EpiSwiGLU {
    static constexpr bool PERM = true;
    void* O; int ldc; float sc;
    __device__ __forceinline__ void operator()(const f32x4 (&acc)[2][2][4][2], const Unit& u, int wr, int wc, int fr, int fq) const {
        const int row0 = u.pm * BM + wr * 64 + fr; const int col0 = u.pn * HALF + wc * 32 + 8 * fq;
#pragma unroll
        for (int ai = 0; ai < 2; ++ai)
#pragma unroll
            for (int m = 0; m < 4; ++m) { float o[8];
#pragma unroll
                for (int n = 0; n < 2; ++n)
#pragma unroll
                    for (int j = 0; j < 4; ++j) { const float g = acc[ai][0][m][n][j] * sc, up = acc[ai][1][m][n][j] * sc;
                        const float s = __builtin_amdgcn_rcpf(1.0f + __builtin_amdgcn_exp2f(-1.4426950408889634f * g)); o[n * 4 + j] = g * s * up; }
                const size_t eo = (size_t)(row0 + ai * HALF + m * 16) * ldc + col0;
                if constexpr (F8OUT) { const unsigned long long w = (unsigned long long)pk4_fp8(o[0], o[1], o[2], o[3]) | ((unsigned long long)pk4_fp8(o[4], o[5], o[6], o[7]) << 32);
                    *(GAS unsigned long long*)((unsigned char*)O + eo) = w;
                } else { u32x4 w; w.x = cvt_pk_bf16(o[0], o[1]); w.y = cvt_pk_bf16(o[2], o[3]); w.z = cvt_pk_bf16(o[4], o[5]); w.w = cvt_pk_bf16(o[6], o[7]);
                    *(GAS u32x4*)((bf16_t*)O + eo) = w; } }
    }
};
template <bool RF32> struct EpiRes {
    static constexpr bool PERM = false;
    const void* res; bf16_t* out; int ldc; float sc;
    __device__ __forceinline__ void operator()(const f32x4 (&acc)[2][2][4][2], const Unit& u, int wr, int wc, int fr, int fq) const {
        const int row0 = u.pm * BM + wr * 64 + fr; const int col0 = u.pn * BM + wc * 32 + 4 * fq;
#pragma unroll
        for (int ai = 0; ai < 2; ++ai)
#pragma unroll
            for (int m = 0; m < 4; ++m) { const size_t off = (size_t)(row0 + ai * HALF + m * 16) * ldc + col0;
#pragma unroll
                for (int bj = 0; bj < 2; ++bj)
#pragma unroll
                    for (int n = 0; n < 2; ++n) { const size_t o2 = off + bj * HALF + n * 16; f32x4 r;
                        if constexpr (RF32) r = *(const GAS f32x4*)((const float*)res + o2);
                        else { const unsigned long long w = *(const GAS unsigned long long*)((const bf16_t*)res + o2); const unsigned lo = (unsigned)w, hi = (unsigned)(w >> 32);
                            r = (f32x4){__uint_as_float(lo << 16), __uint_as_float(lo & 0xFFFF0000u), __uint_as_float(hi << 16), __uint_as_float(hi & 0xFFFF0000u)}; }
                        const f32x4 v = r + acc[ai][bj][m][n] * sc;
                        *(GAS unsigned long long*)(out + o2) = (unsigned long long)cvt_pk_bf16(v[0], v[1]) | ((unsigned long long)cvt_pk_bf16(v[2], v[3]) << 32); } }
    }
};
struct EpiMoeDown {
    static constexpr bool PERM = false;
    bf16_t* h; bf16_t* y1; const unsigned* list_tok; const float* list_w; int cnt[NE]; float sc;
    __device__ __forceinline__ void operator()(const f32x4 (&acc)[2][2][4][2], const Unit& u, int wr, int wc, int fr, int fq) const {
        int cv = 0;
#pragma unroll
        for (int k = 0; k < NE; ++k) cv = (k == u.e) ? cnt[k] : cv;
        const int col0 = u.pn * BM + wc * 32 + 4 * fq;
#pragma unroll
        for (int ai = 0; ai < 2; ++ai)
#pragma unroll
            for (int m = 0; m < 4; ++m) { const int l = u.r0 + ai * HALF + wr * 64 + m * 16 + fr;
                if (l < cv) {
                    const unsigned ent = __hip_atomic_load((const GAS unsigned*)list_tok + (size_t)u.e * LIST_CAP + l, __ATOMIC_RELAXED, __HIP_MEMORY_SCOPE_AGENT);
                    const float w = sc * __uint_as_float(__hip_atomic_load((const GAS unsigned*)list_w + (size_t)u.e * LIST_CAP + l, __ATOMIC_RELAXED, __HIP_MEMORY_SCOPE_AGENT));
                    const size_t off = (size_t)(ent & 0xFFFFFu) * D + col0;
                    if ((ent >> 20) == 0u) {
#pragma unroll
                        for (int bj = 0; bj < 2; ++bj)
#pragma unroll
                            for (int n = 0; n < 2; ++n) { GAS unsigned long long* p = (GAS unsigned long long*)(h + off + bj * HALF + n * 16); const unsigned long long rw = *p; const unsigned lo = (unsigned)rw, hi = (unsigned)(rw >> 32);
                                const f32x4 v = (f32x4){__uint_as_float(lo << 16), __uint_as_float(lo & 0xFFFF0000u), __uint_as_float(hi << 16), __uint_as_float(hi & 0xFFFF0000u)} + acc[ai][bj][m][n] * w;
                                *p = (unsigned long long)cvt_pk_bf16(v[0], v[1]) | ((unsigned long long)cvt_pk_bf16(v[2], v[3]) << 32); }
                    } else {
#pragma unroll
                        for (int bj = 0; bj < 2; ++bj)
#pragma unroll
                            for (int n = 0; n < 2; ++n) { const f32x4 v = acc[ai][bj][m][n] * w; unsigned long long pk = (unsigned long long)cvt_pk_bf16(v[0], v[1]) | ((unsigned long long)cvt_pk_bf16(v[2], v[3]) << 32);
                                *(GAS unsigned long long*)(y1 + off + bj * HALF + n * 16) = pk; }
                    }
                } }
    }
};

template <class Epi, class Sched, bool F8 = false>
__device__ __forceinline__ void gemm_phase(PG8_LAS unsigned char* lds, int xoff, const Gemm g, const Sched& S, const Epi& E) {
    int tid_ = threadIdx.x;
    asm volatile("" : "+v"(tid_));
    const int tid = tid_, wid = __builtin_amdgcn_readfirstlane(tid >> 6), lane = tid & 63, wr = wid >> 2, wc = wid & 3, fr = lane & 15, fq = lane >> 4;
    const int RB = g.rowb, nt = RB / 128;
    unsigned voffB[2];
#pragma unroll
    for (int i = 0; i < 2; ++i) { int R, C; stage_rc(tid * 16 + i * 8192, R, C); const int Rb = Epi::PERM ? ((R & ~31) + perm32(R & 31)) : R;
        voffB[i] = (unsigned)(Rb * RB + C * 2); }
    const size_t kstep = (size_t)(BK * 2);
    const size_t hstep = (size_t)HALF * RB;
    const size_t tstep = 2 * hstep;
    const unsigned ldsw = (unsigned)wid * 1024u;
    const int aoff = F8 ? lds_byte(wr * 64 + fr, fq * 16) : lds_byte(wr * 64 + fr, fq * 8), boff = F8 ? lds_byte(wc * 32 + fr, fq * 16) : lds_byte(wc * 32 + fr, fq * 8);
#define PG8_SA(b, h) (((b) * 2 + (h)) * HTB)
#define PG8_SB(b, h) ((4 + (b) * 2 + (h)) * HTB)
#define PG8_STAGE(bufoff, gbase, v0, v1) do { \
        __builtin_amdgcn_global_load_lds((const GAS unsigned*)((const char*)(gbase) + (v0)), (PG8_LAS unsigned*)(lds + (bufoff) + ldsw), 16, 0, 0); \
        __builtin_amdgcn_global_load_lds((const GAS unsigned*)((const char*)(gbase) + (v1)), (PG8_LAS unsigned*)(lds + (bufoff) + ldsw + 8192), 16, 0, 0); } while (0)
#define PG8_STAGEB(bufoff, gbase) PG8_STAGE(bufoff, gbase, voffB[0], voffB[1])
#define PG8_LDA(dst, b, h) do { if constexpr (F8) { _Pragma("unroll") for (int m = 0; m < 4; ++m) { dst##8[m].lo = *(const PG8_LAS i32x4*)(lds + PG8_SA(b, h) + aoff + m * 2048); dst##8[m].hi = *(const PG8_LAS i32x4*)(lds + PG8_SA(b, h) + aoff + m * 2048 + 16); } } \
        else { _Pragma("unroll") for (int m = 0; m < 4; ++m) _Pragma("unroll") for (int k = 0; k < 2; ++k) dst[m][k] = *(const PG8_LAS bf16x8*)(lds + PG8_SA(b, h) + aoff + m * 2048 + k * 1024); } } while (0)
#define PG8_LDB(dst, b, h) do { if constexpr (F8) { _Pragma("unroll") for (int n = 0; n < 2; ++n) { dst##8[n].lo = *(const PG8_LAS i32x4*)(lds + PG8_SB(b, h) + boff + n * 2048); dst##8[n].hi = *(const PG8_LAS i32x4*)(lds + PG8_SB(b, h) + boff + n * 2048 + 16); } } \
        else { _Pragma("unroll") for (int n = 0; n < 2; ++n) _Pragma("unroll") for (int k = 0; k < 2; ++k) dst[n][k] = *(const PG8_LAS bf16x8*)(lds + PG8_SB(b, h) + boff + n * 2048 + k * 1024); } } while (0)
#define PG8_MMA(ai, bj, At, Bt) do { __builtin_amdgcn_s_setprio(1); _Pragma("unroll") for (int m = 0; m < 4; ++m) _Pragma("unroll") for (int n = 0; n < 2; ++n) { \
        if constexpr (F8) acc[ai][bj][m][n] = __builtin_amdgcn_mfma_scale_f32_16x16x128_f8f6f4(Bt##8[n], At##8[m], acc[ai][bj][m][n], 0, 0, 0, 0x7F7F7F7F, 0, 0x7F7F7F7F); \
        else { _Pragma("unroll") for (int k = 0; k < 2; ++k) acc[ai][bj][m][n] = __builtin_amdgcn_mfma_f32_16x16x32_bf16(Bt[n][k], At[m][k], acc[ai][bj][m][n], 0, 0, 0); } } __builtin_amdgcn_s_setprio(0); } while (0)
#define PG8_WAIT_V(n) asm volatile("s_waitcnt vmcnt(" #n ")" ::: "memory")
#define PG8_WAIT_L(n) asm volatile("s_waitcnt lgkmcnt(" #n ")" ::: "memory")
#define PG8_BAR __builtin_amdgcn_s_barrier()
#define PG8_SCHED __builtin_amdgcn_sched_barrier(0)
#define PG8_AOFFS(U, o00, o01, o10, o11) do { int R0_, C0_, R1_, C1_; stage_rc(tid * 16, R0_, C0_); stage_rc(tid * 16 + 8192, R1_, C1_);     \
        o00 = S.arow(U, R0_) * (unsigned)RB + (unsigned)C0_ * 2u; o01 = S.arow(U, R1_) * (unsigned)RB + (unsigned)C1_ * 2u; \
        o10 = S.arow(U, HALF + R0_) * (unsigned)RB + (unsigned)C0_ * 2u; o11 = S.arow(U, HALF + R1_) * (unsigned)RB + (unsigned)C1_ * 2u; } while (0)
    Unit cur, nxt; int ui = 0;
    if (!S.next(0, cur)) return;
    f32x4 acc[2][2][4][2];
#pragma unroll
    for (int a = 0; a < 2; ++a)
#pragma unroll
        for (int b = 0; b < 2; ++b)
#pragma unroll
            for (int m = 0; m < 4; ++m)
#pragma unroll
                for (int n = 0; n < 2; ++n) acc[a][b][m][n] = (f32x4){0.f, 0.f, 0.f, 0.f};
    bf16x8 At[4][2], B0[2][2], B1[2][2];
    i32x8 At8[4], B08[2], B18[2];
    unsigned c00, c01, c10, c11;
    PG8_LAS u32x4* const xslot = (PG8_LAS u32x4*)(lds + xoff) + tid;
    PG8_AOFFS(cur, c00, c01, c10, c11);
    const char* const gA = (const char*)g.A;
    const char* cB = (const char*)g.Bt + (size_t)cur.e * g.bstride + (size_t)cur.pn * tstep;
    PG8_STAGEB(PG8_SB(0, 0), cB); PG8_STAGEB(PG8_SB(0, 1), cB + hstep); PG8_STAGE(PG8_SA(0, 0), gA, c00, c01); PG8_STAGE(PG8_SA(0, 1), gA, c10, c11);
    if (wr == 1) PG8_BAR;
    PG8_WAIT_V(2); PG8_BAR;
    PG8_STAGEB(PG8_SB(1, 0), cB + kstep); PG8_STAGE(PG8_SA(1, 0), gA + kstep, c00, c01); PG8_STAGEB(PG8_SB(1, 1), cB + hstep + kstep);
    PG8_WAIT_V(6); PG8_BAR;
    for (;;) {
        const bool has_next = S.next(ui + 1, nxt);
        const char* nB_ = has_next ? (const char*)g.Bt + (size_t)nxt.e * g.bstride + (size_t)nxt.pn * tstep : cB;
        const char* nB = nB_;
        if (has_next) { unsigned n00, n01, n10, n11; PG8_AOFFS(nxt, n00, n01, n10, n11); *xslot = (u32x4){n00, n01, n10, n11}; }
#pragma unroll 1
        for (int t = 0; t < nt; t += 2) {
            const bool last = (t == nt - 2);
            const char* a1 = gA + (size_t)(t + 1) * kstep;
            const char* a2 = last ? gA : gA + (size_t)(t + 2) * kstep; const char* b2 = last ? nB : cB + (size_t)(t + 2) * kstep;
            const char* a3 = a2 + kstep; const char* b3 = b2 + kstep;
            PG8_LDB(B0, 0, 0); PG8_LDB(B1, 0, 1); PG8_SCHED; PG8_LDA(At, 0, 0); PG8_STAGE(PG8_SA(1, 1), a1, c10, c11);
            if (last && has_next) { const u32x4 nx = *xslot; c00 = nx.x; c01 = nx.y; c10 = nx.z; c11 = nx.w; }
            PG8_WAIT_V(8); PG8_WAIT_L(0); PG8_BAR; PG8_MMA(0, 0, At, B0); PG8_MMA(0, 1, At, B1); PG8_BAR; PG8_SCHED;
            PG8_LDA(At, 0, 1); PG8_STAGEB(PG8_SB(0, 0), b2); PG8_STAGEB(PG8_SB(0, 1), b2 + hstep); PG8_STAGE(PG8_SA(0, 0), a2, c00, c01);
            PG8_WAIT_V(8); PG8_WAIT_L(0); PG8_BAR; PG8_MMA(1, 0, At, B0); PG8_MMA(1, 1, At, B1); PG8_BAR; PG8_SCHED;
            PG8_LDB(B0, 1, 0); PG8_LDB(B1, 1, 1); PG8_SCHED; PG8_LDA(At, 1, 0); PG8_STAGE(PG8_SA(0, 1), a2, c10, c11);
            PG8_WAIT_V(8); PG8_WAIT_L(0); PG8_BAR; PG8_MMA(0, 0, At, B0); PG8_MMA(0, 1, At, B1); PG8_BAR; PG8_SCHED;
            PG8_LDA(At, 1, 1); PG8_STAGEB(PG8_SB(1, 0), b3); PG8_STAGEB(PG8_SB(1, 1), b3 + hstep); PG8_STAGE(PG8_SA(1, 0), a3, c00, c01);
            PG8_WAIT_V(8); PG8_WAIT_L(0); PG8_BAR; PG8_MMA(1, 0, At, B0); PG8_MMA(1, 1, At, B1); PG8_BAR; PG8_SCHED;
        }
        if (wr == 0) PG8_BAR;
        E(acc, cur, wr, wc, fr, fq);
        if (!has_next) break;
#pragma unroll
        for (int a = 0; a < 2; ++a)
#pragma unroll
            for (int b = 0; b < 2; ++b)
#pragma unroll
                for (int m = 0; m < 4; ++m)
#pragma unroll
                    for (int n = 0; n < 2; ++n) acc[a][b][m][n] = (f32x4){0.f, 0.f, 0.f, 0.f};
        cur = nxt; cB = nB; ++ui;
        if (wr == 1) PG8_BAR;
    }
    PG8_WAIT_V(0);
    PG8_BAR;
#undef PG8_SA
#undef PG8_SB
#undef PG8_STAGE
#undef PG8_STAGEB
#undef PG8_LDA
#undef PG8_LDB
#undef PG8_MMA
#undef PG8_WAIT_V
#undef PG8_WAIT_L
#undef PG8_BAR
#undef PG8_SCHED
#undef PG8_AOFFS
}
}

namespace att {
typedef unsigned short bf16_t;
typedef short bf16x8 __attribute__((ext_vector_type(8)));
typedef short s16x4 __attribute__((ext_vector_type(4)));
typedef float f32x16 __attribute__((ext_vector_type(16)));
typedef float f32x4 __attribute__((ext_vector_type(4)));
typedef unsigned u32x4 __attribute__((ext_vector_type(4)));
constexpr int PITCH = 1024;
constexpr float LOG2E = 1.4426950408889634f;
__device__ __forceinline__ int crow(int r, int hi) { return (r & 3) + 8 * (r >> 2) + 4 * hi; }
typedef float f32x2_t __attribute__((ext_vector_type(2))); typedef __bf16 bf16x2_t __attribute__((ext_vector_type(2)));
__device__ __forceinline__ unsigned cvtpk(float lo, float hi) { f32x2_t v = {lo, hi}; bf16x2_t b = __builtin_convertvector(v, bf16x2_t); return __builtin_bit_cast(unsigned, b); }
__device__ __forceinline__ float bf2f(short s) { return __uint_as_float(((unsigned)(unsigned short)s) << 16); }
typedef short v4i16_t __attribute__((ext_vector_type(4)));
__device__ __forceinline__ s16x4 vtr(const LAS unsigned char* p) { return __builtin_bit_cast(s16x4, __builtin_amdgcn_ds_read_tr16_b64_v4i16((LAS v4i16_t*)p)); }
__device__ __forceinline__ float max3f(float a, float b, float c) { float r; asm("v_max3_f32 %0, %1, %2, %3" : "=v"(r) : "v"(a), "v"(b), "v"(c)); return r; }
__device__ __forceinline__ float halves_max(float m) { auto rr = __builtin_amdgcn_permlane32_swap(__float_as_uint(m), __float_as_uint(m), false, false); return fmaxf(__uint_as_float(rr[0]), __uint_as_float(rr[1])); }
__device__ __forceinline__ float halves_sum(float m) { auto rr = __builtin_amdgcn_permlane32_swap(__float_as_uint(m), __float_as_uint(m), false, false); return __uint_as_float(rr[0]) + __uint_as_float(rr[1]); }
#define ATT_BAR() asm volatile("s_waitcnt vmcnt(0) lgkmcnt(0)\n\ts_barrier" ::: "memory")
typedef unsigned u32x2 __attribute__((ext_vector_type(2)));
#define ATT_RD128(d, a, off) asm volatile("ds_read_b128 %0, %1 offset:%2" : "=v"(d) : "v"(a), "n"(off))
#define ATT_RDTR(d, a, off) asm volatile("ds_read_b64_tr_b16 %0, %1 offset:%2" : "=v"(d) : "v"(a), "n"(off))
#define ATT_WAIT2(n, x, y) asm volatile("s_waitcnt lgkmcnt(" #n ")" : "+v"(x), "+v"(y))

struct Args { const bf16_t* Q; const bf16_t* K; const bf16_t* V; bf16_t* O; const float* kmean; const float* kmax2; const float* subln; float lam_full; float out_scale; int abl; };
#ifndef ATT_ABLATE
#define ATT_ABLATE 0
#endif
#if ATT_ABLATE
#define ABL(bit) ((((ATT_ABLATE) >> (bit)) & 1) && abl_)
#else
#define ABL(bit) 0
#endif

template <int MODE>
__device__ __forceinline__ void attn_unit(LAS unsigned char* lds, const Args& A, int b, int h, int qblk) {
    constexpr int DVB = MODE == 0 ? 4 : 2;
    constexpr int NCH = MODE == 0 ? 16 : 8;
    constexpr int KBY = NCH * 1024, VBY = DVB * 4096, SLOT = KBY + VBY;
    constexpr int QR = MODE == 0 ? 128 : 256;
    constexpr int PPW = MODE == 0 ? 2 : 1;
    int tid_ = threadIdx.x; asm volatile("" : "+v"(tid_));
    const int tid = tid_, lane = tid & 63, r32 = lane & 31, hi = lane >> 5;
    const int wid = __builtin_amdgcn_readfirstlane(tid >> 6);
    const int comp = MODE == 0 ? (wid >> 2) : 0, wq = MODE == 0 ? (wid & 3) : wid;
    const int q0 = qblk * QR; const long rowbase = (long)b * SEQ;
    const int hcol = MODE == 0 ? h * 128 : h * 64;
    const int qrel0 = wq * 32;
    const float slope2 = __builtin_amdgcn_exp2f(MODE == 0 ? -(float)(h + 1) : -0.5f * (float)(h + 1)) * LOG2E;
    const int NT = MODE == 0 ? 2 * qblk + 2 : 4 + 4 * qblk;
#define ATT_KBASE_(t) (MODE == 0 ? 64 * (t) : ((t) < 4 ? q0 + 64 * (t) : 64 * ((t) - 4)))
#define ATT_KBASE(t) ATT_KBASE_(t)
    LAS float* wsf = (LAS float*)(lds + 65536) + wid * 64;
    const bf16_t* Kb = A.K + rowbase * PITCH + hcol;
    const bf16_t* Vb = A.V + rowbase * PITCH + hcol;
#define ATT_ISSUE_K(tt, slot) do { const int kb_ = ATT_KBASE(tt); \
        _Pragma("unroll") for (int i_ = 0; i_ < PPW; ++i_) { const int p_ = wid + 8 * i_; \
            __builtin_amdgcn_global_load_lds((const GAS unsigned*)(Kb + (size_t)(kb_ + lane) * PITCH + p_ * 8), (LAS unsigned*)(lds + (slot) * SLOT + p_ * 1024), 16, 0, 0); } } while (0)
#define ATT_ISSUE_V(tt, slot) do { const int kb_ = ATT_KBASE(tt); \
        _Pragma("unroll") for (int i_ = 0; i_ < PPW; ++i_) { const int p_ = wid + 8 * i_; \
            __builtin_amdgcn_global_load_lds((const GAS unsigned*)(Vb + (size_t)(kb_ + 16 * (p_ & 3) + (lane >> 2)) * PITCH + (p_ >> 2) * 32 + (lane & 3) * 8), (LAS unsigned*)(lds + (slot) * SLOT + KBY + p_ * 1024), 16, 0, 0); } } while (0)
    asm volatile("s_waitcnt lgkmcnt(0)\n\ts_barrier" ::: "memory");
    bf16x8 qr[4];
    { const bf16_t* Qw = A.Q + (rowbase + q0 + qrel0 + r32) * PITCH + hcol + comp * 64 + hi * 8;
#pragma unroll
      for (int d0 = 0; d0 < 4; ++d0) qr[d0] = *(const GAS bf16x8*)(Qw + d0 * 16); }
    const int tt_l = MODE == 0 ? (lane < 2 ? 2 * qblk + lane : lane - 2) : lane;
    const int kbase_l = (lane < NT) ? ATT_KBASE_(tt_l) : 0;
    const bool past_l = lane < NT && kbase_l + 64 <= q0;
    float k2a = 0.f, k2b = 0.f;
    { const int nblk = (kbase_l >> 8) & 15;
        if constexpr (MODE == 0) { k2a = ((const GAS float*)A.kmax2)[(size_t)(b * 16 + h * 2) * 16 + nblk]; k2b = ((const GAS float*)A.kmax2)[(size_t)(b * 16 + h * 2 + 1) * 16 + nblk]; }
        else k2a = ((const GAS float*)A.kmax2)[(size_t)(b * 16 + h) * 16 + nblk]; }
    float kmv0 = 0.f, kmv1 = 0.f;
    if constexpr (MODE == 1) { kmv0 = ((const GAS float*)A.kmean)[(size_t)(b * 16 + h) * 1024 + tid]; kmv1 = ((const GAS float*)A.kmean)[(size_t)(b * 16 + h) * 1024 + 512 + tid]; }
    const int t0 = MODE == 0 ? 2 * qblk : 0, t1 = t0 + 1;
    ATT_ISSUE_K(t0, 0); ATT_ISSUE_V(t0, 0); ATT_ISSUE_K(t1, 1);
    LAS int* live = (LAS int*)(lds + 71680); LAS float* qnx = (LAS float*)(lds + 71680 + 272);
    LAS float* km = (LAS float*)(lds + 67584);
    { float q2 = 0.f;
#pragma unroll
      for (int d0 = 0; d0 < 4; ++d0)
#pragma unroll
        for (int j = 0; j < 8; ++j) { const float v = bf2f(qr[d0][j]); q2 += v * v; }
      q2 = halves_sum(q2);
      q2 = fmaxf(q2, __shfl_xor(q2, 1)); q2 = fmaxf(q2, __shfl_xor(q2, 2)); q2 = fmaxf(q2, __shfl_xor(q2, 4)); q2 = fmaxf(q2, __shfl_xor(q2, 8)); q2 = fmaxf(q2, __shfl_xor(q2, 16));
      if (lane == 0) qnx[wid] = q2; }
    if constexpr (MODE == 1) { km[tid] = kmv0; km[tid + 512] = kmv1; }
    ATT_BAR();
    if (wid == 0) {
        bool alive = lane < NT;
        if (past_l) { float bound;
            if constexpr (MODE == 0) { const float qa = fmaxf(fmaxf(qnx[0], qnx[1]), fmaxf(qnx[2], qnx[3])), qb = fmaxf(fmaxf(qnx[4], qnx[5]), fmaxf(qnx[6], qnx[7]));
                bound = fmaxf(sqrtf(qa) * sqrtf(k2a), sqrtf(qb) * sqrtf(k2b));
            } else { float qm = qnx[0];
#pragma unroll
                for (int w = 1; w < 8; ++w) qm = fmaxf(qm, qnx[w]);
                bound = sqrtf(qm) * sqrtf(k2a); }
            alive = !(bound * 1.001f + 1.0f + slope2 * (float)(kbase_l + 63 - q0) < -152.0f);
        }
        const unsigned long long am = __ballot(alive);
        if (alive) live[__popcll(am & ((1ull << lane) - 1ull))] = tt_l;
        if (lane == 0) live[64] = __popcll(am);
    }
    unsigned sel = 0u;
    if constexpr (MODE == 1) {
        float g[16];
#pragma unroll
        for (int n = 0; n < 16; ++n) { float s = 0.f;
            if (n < qblk) {
#pragma unroll
                for (int d0 = 0; d0 < 4; ++d0) { const f32x4 ka = *(const LAS f32x4*)(km + n * 64 + d0 * 16 + hi * 8), kb2 = *(const LAS f32x4*)(km + n * 64 + d0 * 16 + hi * 8 + 4);
                    s += bf2f(qr[d0][0]) * ka[0] + bf2f(qr[d0][1]) * ka[1] + bf2f(qr[d0][2]) * ka[2] + bf2f(qr[d0][3]) * ka[3]
                       + bf2f(qr[d0][4]) * kb2[0] + bf2f(qr[d0][5]) * kb2[1] + bf2f(qr[d0][6]) * kb2[2] + bf2f(qr[d0][7]) * kb2[3]; }
                s = halves_sum(s); }
            g[n] = s; }
        const int nsel = qblk < 3 ? qblk : 3;
#pragma unroll
        for (int k = 0; k < 3; ++k) if (k < nsel) { float best = -INFINITY; int bi = 0; bool found = false;
#pragma unroll
            for (int n = 0; n < 16; ++n) if (n < qblk) { const bool free_ = ((sel >> n) & 1u) == 0u; if (free_ && (!found || g[n] > best)) { best = g[n]; bi = n; found = true; } }
            sel |= 1u << bi; }
    }
    ATT_BAR();
    const int NTL = __builtin_amdgcn_readfirstlane(live[64]);
#define ATT_ISSUE(t, slot) do { const int kb_ = ATT_KBASE(t); \
        _Pragma("unroll") for (int i_ = 0; i_ < PPW; ++i_) { const int p_ = wid + 8 * i_; \
            __builtin_amdgcn_global_load_lds((const GAS unsigned*)(Kb + (size_t)(kb_ + lane) * PITCH + p_ * 8), (LAS unsigned*)(lds + (slot) * SLOT + p_ * 1024), 16, 0, 0); \
            __builtin_amdgcn_global_load_lds((const GAS unsigned*)(Vb + (size_t)(kb_ + 16 * (p_ & 3) + (lane >> 2)) * PITCH + (p_ >> 2) * 32 + (lane & 3) * 8), (LAS unsigned*)(lds + (slot) * SLOT + KBY + p_ * 1024), 16, 0, 0); } } while (0)
    constexpr float THR = 8.0f;
    float mref = 0.f, l = 0.f; f32x16 o[DVB];
#pragma unroll
    for (int d0 = 0; d0 < DVB; ++d0) o[d0] = f32x16{};
#define ATT_CLASS(tt, SK, NM, SB) do { const int kb_ = ATT_KBASE(tt), kr_ = kb_ - q0; const bool dg_ = kb_ >= q0; SK = dg_ && (kr_ > qrel0 + 31); NM = dg_ && (kr_ + 63 > qrel0); SB = true; \
        if constexpr (MODE == 1) { if ((tt) >= 4) { SB = ((sel >> (((tt) - 4) >> 2)) & 1u) != 0u; if (!__any(SB)) SK = true; } } } while (0)
#define ATT_QK(P0, P1, tt, slot, SB) do { const int kr_ = ATT_KBASE(tt) - q0; float off0_ = slope2 * (float)(kr_ + 4 * hi) - mref; if (!(SB)) off0_ = -INFINITY; const float off1_ = off0_ + 32.0f * slope2; \
        const unsigned ka_ = (unsigned)(size_t)(lds + (slot) * SLOT + comp * 8192 + hi * 1024 + r32 * 16); u32x4 kx_[4], ky_[4]; \
        ATT_RD128(kx_[0], ka_, 0); ATT_RD128(ky_[0], ka_, 512); ATT_RD128(kx_[1], ka_, 2048); ATT_RD128(ky_[1], ka_, 2560); \
        _Pragma("unroll") for (int r = 0; r < 16; ++r) { const float cbr = slope2 * (float)((r & 3) + 8 * (r >> 2)); P0[r] = cbr + off0_; P1[r] = cbr + off1_; } \
        ATT_WAIT2(2, kx_[0], ky_[0]); P0 = __builtin_amdgcn_mfma_f32_32x32x16_bf16(__builtin_bit_cast(bf16x8, kx_[0]), qr[0], P0, 0, 0, 0); P1 = __builtin_amdgcn_mfma_f32_32x32x16_bf16(__builtin_bit_cast(bf16x8, ky_[0]), qr[0], P1, 0, 0, 0); \
        ATT_RD128(kx_[2], ka_, 4096); ATT_RD128(ky_[2], ka_, 4608); \
        ATT_WAIT2(2, kx_[1], ky_[1]); P0 = __builtin_amdgcn_mfma_f32_32x32x16_bf16(__builtin_bit_cast(bf16x8, kx_[1]), qr[1], P0, 0, 0, 0); P1 = __builtin_amdgcn_mfma_f32_32x32x16_bf16(__builtin_bit_cast(bf16x8, ky_[1]), qr[1], P1, 0, 0, 0); \
        ATT_RD128(kx_[3], ka_, 6144); ATT_RD128(ky_[3], ka_, 6656); \
        ATT_WAIT2(2, kx_[2], ky_[2]); P0 = __builtin_amdgcn_mfma_f32_32x32x16_bf16(__builtin_bit_cast(bf16x8, kx_[2]), qr[2], P0, 0, 0, 0); P1 = __builtin_amdgcn_mfma_f32_32x32x16_bf16(__builtin_bit_cast(bf16x8, ky_[2]), qr[2], P1, 0, 0, 0); \
        ATT_WAIT2(0, kx_[3], ky_[3]); P0 = __builtin_amdgcn_mfma_f32_32x32x16_bf16(__builtin_bit_cast(bf16x8, kx_[3]), qr[3], P0, 0, 0, 0); P1 = __builtin_amdgcn_mfma_f32_32x32x16_bf16(__builtin_bit_cast(bf16x8, ky_[3]), qr[3], P1, 0, 0, 0); } while (0)
    f32x16 p0, p1, n0, n1;
    const int abl_ = __builtin_amdgcn_readfirstlane(A.abl); (void)abl_;
    int t = t0, tn = t1;
    bool skipC, maskC, selC, skipN = true, maskN = false, selN = true;
    ATT_CLASS(t, skipC, maskC, selC);
    if (!skipC) ATT_QK(p0, p1, t, 0, selC);
    const int NTLX = ABL(4) ? 1 : NTL;
    for (int it = 0; it < NTLX; ++it) {
        ATT_BAR();
        const int tnn = (it + 2 < NTL) ? __builtin_amdgcn_readfirstlane(live[it + 2]) : 0;
        if (it + 2 < NTL && !ABL(0)) ATT_ISSUE_K(tnn, it & 1);
        if (it + 1 < NTL) { if (!ABL(0)) ATT_ISSUE_V(tn, (it + 1) & 1); ATT_CLASS(tn, skipN, maskN, selN); if (!skipN) { if (!ABL(2)) ATT_QK(n0, n1, tn, (it + 1) & 1, selN); else { n0 = f32x16{} - 1.0f; n1 = n0; } } } else skipN = true;
        if (!skipC) {
            const int krel = ATT_KBASE(t) - q0;
            const unsigned va_ = (unsigned)(size_t)(lds + (it & 1) * SLOT + KBY + ((lane >> 4) & 1) * 32 + (lane & 3) * 8 + (4 * hi + ((lane & 15) >> 2)) * 64);
            u32x2 vl_[4], vh_[4];
            if (!ABL(1)) { ATT_RDTR(vl_[0], va_, 0); ATT_RDTR(vh_[0], va_, 512); ATT_RDTR(vl_[1], va_, 1024); ATT_RDTR(vh_[1], va_, 1536);
            ATT_RDTR(vl_[2], va_, 2048); ATT_RDTR(vh_[2], va_, 2560); ATT_RDTR(vl_[3], va_, 3072); ATT_RDTR(vh_[3], va_, 3584); }
            if (maskC) { const int qrel = qrel0 + r32;
#pragma unroll
                for (int r = 0; r < 16; ++r) { const int kv = krel + crow(r, hi); if (kv > qrel) p0[r] = -INFINITY; if (kv + 32 > qrel) p1[r] = -INFINITY; } }
            float rm;
            { float a_ = max3f(p0[0], p0[1], p1[0]), b_ = max3f(p0[2], p0[3], p1[1]); a_ = max3f(a_, p1[2], p1[3]);
#pragma unroll
              for (int r = 4; r < 16; r += 4) { a_ = max3f(a_, p0[r], p0[r + 1]); b_ = max3f(b_, p0[r + 2], p0[r + 3]); a_ = max3f(a_, p1[r], p1[r + 1]); b_ = max3f(b_, p1[r + 2], p1[r + 3]); }
              rm = halves_max(fmaxf(a_, b_)); }
            if (__any(rm > THR)) {
                const float dl = fmaxf(rm, 0.f); mref += dl; const float alpha = __builtin_amdgcn_exp2f(-dl);
#pragma unroll
                for (int r = 0; r < 16; ++r) { p0[r] -= dl; p1[r] -= dl; }
                if (!skipN) {
#pragma unroll
                    for (int r = 0; r < 16; ++r) { n0[r] -= dl; n1[r] -= dl; } }
                l *= alpha;
                if (hi == 0) wsf[r32] = alpha;
                asm volatile("s_waitcnt lgkmcnt(0)" ::: "memory");
#pragma unroll
                for (int gq = 0; gq < 4; ++gq) { const f32x4 f = *(const LAS f32x4*)(wsf + 8 * gq + 4 * hi);
#pragma unroll
                    for (int d0 = 0; d0 < DVB; ++d0) { o[d0][4 * gq + 0] *= f[0]; o[d0][4 * gq + 1] *= f[1]; o[d0][4 * gq + 2] *= f[2]; o[d0][4 * gq + 3] *= f[3]; } }
            }
            float sacc = 0.f;
            if (!ABL(3)) {
#pragma unroll
            for (int r = 0; r < 16; ++r) { p0[r] = __builtin_amdgcn_exp2f(p0[r]); p1[r] = __builtin_amdgcn_exp2f(p1[r]); sacc += p0[r] + p1[r]; } }
            l += sacc;
            u32x4 pw[4];
            pw[0] = (u32x4){cvtpk(p0[0], p0[1]), cvtpk(p0[2], p0[3]), cvtpk(p0[4], p0[5]), cvtpk(p0[6], p0[7])};
            pw[1] = (u32x4){cvtpk(p0[8], p0[9]), cvtpk(p0[10], p0[11]), cvtpk(p0[12], p0[13]), cvtpk(p0[14], p0[15])};
            pw[2] = (u32x4){cvtpk(p1[0], p1[1]), cvtpk(p1[2], p1[3]), cvtpk(p1[4], p1[5]), cvtpk(p1[6], p1[7])};
            pw[3] = (u32x4){cvtpk(p1[8], p1[9]), cvtpk(p1[10], p1[11]), cvtpk(p1[12], p1[13]), cvtpk(p1[14], p1[15])};
            if (!ABL(1))
#pragma unroll
            for (int i = 0; i < 4 * DVB; ++i) { constexpr int NM = 4 * DVB; const int s_ = i & 3;
                if (i + 3 < NM) ATT_WAIT2(6, vl_[s_], vh_[s_]); else if (i + 3 == NM) ATT_WAIT2(4, vl_[s_], vh_[s_]); else if (i + 2 == NM) ATT_WAIT2(2, vl_[s_], vh_[s_]); else ATT_WAIT2(0, vl_[s_], vh_[s_]);
                const u32x4 vf = (u32x4){vl_[s_][0], vl_[s_][1], vh_[s_][0], vh_[s_][1]};
                o[i >> 2] = __builtin_amdgcn_mfma_f32_32x32x16_bf16(__builtin_bit_cast(bf16x8, pw[i & 3]), __builtin_bit_cast(bf16x8, vf), o[i >> 2], 0, 0, 0);
                if (i + 4 < NM) { ATT_RDTR(vl_[s_], va_, (i + 4) * 1024); ATT_RDTR(vh_[s_], va_, (i + 4) * 1024 + 512); } }
        }
        p0 = n0; p1 = n1; skipC = skipN; maskC = maskN; selC = selN; t = tn; tn = tnn;
    }
#undef ATT_ISSUE_K
#undef ATT_ISSUE_V
#undef ATT_CLASS
#undef ATT_QK
    if (ABL(5)) return;
    float sg[DVB];
    if constexpr (MODE == 0) {
#pragma unroll
        for (int d0 = 0; d0 < DVB; ++d0) sg[d0] = ((const GAS float*)A.subln)[d0 * 32 + r32]; }
    l = halves_sum(l);
    if (hi == 0) wsf[32 + r32] = l;
    asm volatile("s_waitcnt lgkmcnt(0)" ::: "memory");
    float rli[16];
#pragma unroll
    for (int gq = 0; gq < 4; ++gq) { const f32x4 f = *(const LAS f32x4*)(wsf + 32 + 8 * gq + 4 * hi); rli[4 * gq + 0] = 1.0f / f[0]; rli[4 * gq + 1] = 1.0f / f[1]; rli[4 * gq + 2] = 1.0f / f[2]; rli[4 * gq + 3] = 1.0f / f[3]; }
    if constexpr (MODE == 1) {
        GAS bf16_t* Ow = (GAS bf16_t*)(A.O + (rowbase + q0 + qrel0) * PITCH + hcol);
#pragma unroll
        for (int r = 0; r < 16; ++r)
#pragma unroll
            for (int d0 = 0; d0 < DVB; ++d0) Ow[(size_t)crow(r, hi) * PITCH + d0 * 32 + r32] = (bf16_t)(cvtpk(o[d0][r] * rli[r], 0.f) & 0xFFFFu);
    } else {
        ATT_BAR();
        LAS float* X = (LAS float*)lds + wq * 4096;
        if (comp == 1) {
#pragma unroll
            for (int d0 = 0; d0 < DVB; ++d0)
#pragma unroll
                for (int r = 0; r < 16; ++r) X[(d0 * 16 + r) * 64 + lane] = o[d0][r] * rli[r];
        }
        ATT_BAR();
        if (comp == 0) {
#pragma unroll
            for (int d0 = 0; d0 < DVB; ++d0) sg[d0] *= A.out_scale;
            GAS bf16_t* Ow = (GAS bf16_t*)(A.O + (rowbase + q0 + qrel0) * PITCH + hcol);
#pragma unroll
            for (int r = 0; r < 16; ++r) { float dv[DVB]; float ss = 0.f;
#pragma unroll
                for (int d0 = 0; d0 < DVB; ++d0) { dv[d0] = o[d0][r] * rli[r] - A.lam_full * X[(d0 * 16 + r) * 64 + lane]; ss += dv[d0] * dv[d0]; }
                ss += __int_as_float(__builtin_amdgcn_update_dpp(0, __float_as_int(ss), 0xB1, 0xF, 0xF, true)); ss += __int_as_float(__builtin_amdgcn_update_dpp(0, __float_as_int(ss), 0x4E, 0xF, 0xF, true));
                ss += __int_as_float(__builtin_amdgcn_update_dpp(0, __float_as_int(ss), 0x141, 0xF, 0xF, true)); ss += __int_as_float(__builtin_amdgcn_update_dpp(0, __float_as_int(ss), 0x140, 0xF, 0xF, true));
                ss += __int_as_float(__builtin_amdgcn_ds_swizzle(__float_as_int(ss), 0x401F));
                const float rs = 1.0f / sqrtf(ss * (1.0f / 128.0f) + 1e-5f);
#pragma unroll
                for (int d0 = 0; d0 < DVB; ++d0) Ow[(size_t)crow(r, hi) * PITCH + d0 * 32 + r32] = (bf16_t)(cvtpk(dv[d0] * rs * sg[d0], 0.f) & 0xFFFFu); }
        }
    }
#undef ATT_KBASE
#undef ATT_KBASE_
#undef ATT_ISSUE
}
#undef ATT_BAR
}

constexpr int NWAVES = 8;
constexpr int NLAYER = 4, PH_PER_LAYER = 8, NPHASE = 1 + NLAYER * PH_PER_LAYER;

constexpr size_t MiB = 1u << 20;
constexpr size_t WS_CTL = 0, CTL_ZERO_BYTES = 1 * MiB;
constexpr size_t WS_KMEAN = 1 * MiB;
constexpr size_t WS_LTOK = 2 * MiB, WS_LW = 3 * MiB;
constexpr size_t WS_DQKV = 5 * MiB;
constexpr size_t WS_DWO = WS_DQKV + 12 * MiB;
constexpr size_t WS_MQKV = WS_DWO + 4 * MiB;
constexpr size_t WS_MWO = WS_MQKV + 12 * MiB;
constexpr size_t WS_FGU = WS_MWO + 4 * MiB;
constexpr size_t WS_FD = WS_FGU + 22 * MiB;
constexpr size_t WS_MGU = WS_FD + 11 * MiB;
constexpr size_t WS_MD = WS_MGU + 112 * MiB;
constexpr size_t WS_XN = WS_MD + 56 * MiB;
constexpr size_t WS_Q = WS_XN + 64 * MiB, WS_K = WS_Q + 64 * MiB, WS_V = WS_K + 64 * MiB;
constexpr size_t WS_ACT = WS_Q;
constexpr size_t WS_END = WS_ACT + (size_t)MOE_TILES_MAX * 256 * DE * 2;
constexpr size_t WS_HB = WS_END;
static_assert(WS_XN == 238 * MiB && WS_END == 778 * MiB, "d_ws map");
constexpr int CW_BAR = 4096;
constexpr int CW_ATTQ = 6144;
constexpr int CW_ATTQ2 = 12288;
constexpr int CW_CNT = 8192;

constexpr int RING_OFF = 0, RING_BYTES = 131072;
constexpr int LDSCTL_OFF = RING_BYTES, MISC_OFF = LDSCTL_OFF + 320;
constexpr int XSLOT_OFF = MISC_OFF + 128;
constexpr int LDS_BYTES = 147456;

typedef unsigned short bf16;
typedef unsigned v4u __attribute__((ext_vector_type(4)));
typedef float f32x4 __attribute__((ext_vector_type(4)));
typedef GAS unsigned gu32;
#define RLX_AGENT __ATOMIC_RELAXED, __HIP_MEMORY_SCOPE_AGENT
#define LDS_WAIT() asm volatile("s_waitcnt lgkmcnt(0)" ::: "memory")
#define VM_WAIT() asm volatile("s_waitcnt vmcnt(0)" ::: "memory")
__device__ __forceinline__ unsigned f2bf(float f) { unsigned u = __builtin_bit_cast(unsigned, f); return (u + 0x7fffu + ((u >> 16) & 1u)) >> 16; }
__device__ __forceinline__ unsigned pk2(float lo, float hi) { return f2bf(lo) | (f2bf(hi) << 16); }
__device__ __forceinline__ float bflo(unsigned w) { return __uint_as_float(w << 16); }
__device__ __forceinline__ float bfhi(unsigned w) { return __uint_as_float(w & 0xFFFF0000u); }
static_assert(XSLOT_OFF % 16 == 0 && XSLOT_OFF + 8192 <= LDS_BYTES, "LDS map");
#define XB_TMO      128
#define XB_XCNT(j)  (256  + 64 * (j))
#define XB_XSUB(j)  (1280 + 64 * (j))
#define XB_XGEN(j)  (2304 + 64 * (j))
#define XB_TOP      3328
#define XB_TOPGEN   3392
#define XCD_BAR_WORDS 3456
#define XB_SPIN_CAP (1u << 18)

__device__ __forceinline__ unsigned xb_ld(unsigned* p)              { return __hip_atomic_load(p, __ATOMIC_RELAXED, __HIP_MEMORY_SCOPE_AGENT); }
__device__ __forceinline__ unsigned xb_add(unsigned* p, unsigned v) { return __hip_atomic_fetch_add(p, v, __ATOMIC_RELAXED, __HIP_MEMORY_SCOPE_AGENT); }
__device__ __forceinline__ unsigned xb_xcc_id() { return (unsigned)__builtin_amdgcn_s_getreg((3 << 11) | 20) & 0xFu; }
#define XB_SPIN(cond, bar) do { unsigned _sp = 0; while (cond) { __builtin_amdgcn_s_sleep(1); \
    if ((++_sp & 255u) == 0u) { if (xb_ld(&(bar)[XB_TMO])) break; if (_sp > XB_SPIN_CAP) { atomicAdd(&(bar)[XB_TMO], 1u); break; } } } } while (0)

struct XcdBarrier {
    unsigned* bar; unsigned x;
    volatile LAS unsigned* st;
};

__device__ __forceinline__ XcdBarrier xcd_barrier_post(unsigned* bar, volatile LAS unsigned* st) {
    XcdBarrier b; b.bar = bar; b.x = xb_xcc_id(); b.st = st;
    if (threadIdx.x == 0) (void)xb_add(&bar[XB_XCNT(b.x)], 1u);
    return b;
}
__device__ __forceinline__ void xcd_barrier_complete(unsigned* bar, unsigned x, unsigned& nloc, unsigned& nx) {
    const unsigned G = gridDim.x * gridDim.y * gridDim.z;
    unsigned sum, cnt, mine, sp = 0u;
    for (;;) {
        sum = 0u; cnt = 0u; mine = 0u;
#pragma unroll
        for (unsigned j = 0; j < 16; ++j) { const unsigned c = xb_ld(&bar[XB_XCNT(j)]); sum += c; cnt += (c > 0u) ? 1u : 0u; mine = (j == x) ? c : mine; }
        if (sum == G) break;
        __builtin_amdgcn_s_sleep(1);
        if ((++sp & 255u) == 0u) { if (xb_ld(&bar[XB_TMO])) break; if (sp > XB_SPIN_CAP) { atomicAdd(&bar[XB_TMO], 1u); break; } }
    }
    nloc = mine > 0u ? mine : 1u; nx = cnt > 0u ? cnt : 1u;
}

__device__ __forceinline__ void xcd_barrier(const XcdBarrier& b) {
    asm volatile("s_waitcnt vmcnt(0)" ::: "memory");
    __syncthreads();
    if (threadIdx.x == 0) {
        unsigned* bar = b.bar;
        __builtin_amdgcn_s_waitcnt(0);
        unsigned nloc = b.st[0], nx = b.st[1];
        if (nloc == 0u) { xcd_barrier_complete(bar, b.x, nloc, nx); b.st[0] = nloc; b.st[1] = nx; }
        const unsigned old = xb_add(&bar[XB_XSUB(b.x)], 1u);
        const unsigned gen = old / nloc;
        if (old + 1u == (gen + 1u) * nloc) {
            __builtin_amdgcn_fence(__ATOMIC_RELEASE, "agent");
            asm volatile("s_waitcnt vmcnt(0)" ::: "memory");
            const unsigned og = xb_add(&bar[XB_TOP], 1u);
            const unsigned tg = og / nx;
            if (og + 1u == (tg + 1u) * nx) xb_add(&bar[XB_TOPGEN], 1u);
            else XB_SPIN(xb_ld(&bar[XB_TOPGEN]) == tg, bar);
            __builtin_amdgcn_fence(__ATOMIC_ACQUIRE, "agent");
            xb_add(&bar[XB_XGEN(b.x)], 1u);
            asm volatile("s_waitcnt vmcnt(0)" ::: "memory");
        } else {
            XB_SPIN(xb_ld(&bar[XB_XGEN(b.x)]) == gen, bar);
            __builtin_amdgcn_fence(__ATOMIC_ACQUIRE, "agent");
            asm volatile("s_waitcnt vmcnt(0)" ::: "memory");
        }
    }
    __syncthreads();
}

struct Frame {
    LAS unsigned char* lds;
    volatile LAS unsigned* MISC;
    gu32* ctl;
    int tid, lane, wave;
    int vcu, G;
};
__device__ __forceinline__ float wave_sum(float v) {
    v += __int_as_float(__builtin_amdgcn_update_dpp(0, __float_as_int(v), 0xB1, 0xF, 0xF, true));
    v += __int_as_float(__builtin_amdgcn_update_dpp(0, __float_as_int(v), 0x4E, 0xF, 0xF, true));
    v += __int_as_float(__builtin_amdgcn_update_dpp(0, __float_as_int(v), 0x141, 0xF, 0xF, true));
    v += __int_as_float(__builtin_amdgcn_update_dpp(0, __float_as_int(v), 0x140, 0xF, 0xF, true));
    v += __int_as_float(__builtin_amdgcn_ds_swizzle(__float_as_int(v), 0x401F));
    auto rr = __builtin_amdgcn_permlane32_swap(__float_as_uint(v), __float_as_uint(v), false, false);
    return __uint_as_float(rr[0]) + __uint_as_float(rr[1]);
}
__device__ __forceinline__ void transpose_item(const float* W, int K, int N, void* WT, int k0, int n0, int drow0, LAS float* scr, int lane, bool f8, float wscale) {
    const GAS float* src = (const GAS float*)W + (size_t)k0 * N + n0 + lane;
#pragma unroll
    for (int hb = 0; hb < 2; ++hb) { float v[32];
#pragma unroll
        for (int i = 0; i < 32; ++i) v[i] = src[(size_t)(hb * 32 + i) * N];
#pragma unroll
        for (int i = 0; i < 32; ++i) { const int kk = hb * 32 + i; scr[kk * 64 + (lane ^ ((kk >> 3) << 3))] = v[i]; } }
    LDS_WAIT(); asm volatile("" ::: "memory");
    if (f8) {
        const int c = lane & 3;
#pragma unroll
        for (int j = 0; j < 4; ++j) { const int nn = (lane >> 2) + 16 * j; float v[16];
#pragma unroll
            for (int q = 0; q < 16; ++q) { const int kk = 16 * c + q; v[q] = scr[kk * 64 + (nn ^ ((kk >> 3) << 3))] * wscale; }
            v4u o; o.x = pg8::pk4_fp8(v[0], v[1], v[2], v[3]); o.y = pg8::pk4_fp8(v[4], v[5], v[6], v[7]); o.z = pg8::pk4_fp8(v[8], v[9], v[10], v[11]); o.w = pg8::pk4_fp8(v[12], v[13], v[14], v[15]);
            *(GAS v4u*)((unsigned char*)WT + (size_t)(drow0 + nn) * K + k0 + 16 * c) = o; }
    } else {
    const int c = lane & 7;
#pragma unroll
    for (int j = 0; j < 8; ++j) { const int n = (lane >> 3) + 8 * j; const LAS float* s = scr + (8 * c) * 64 + (n ^ (c << 3));
        v4u o; o.x = pk2(s[0 * 64], s[1 * 64]); o.y = pk2(s[2 * 64], s[3 * 64]); o.z = pk2(s[4 * 64], s[5 * 64]); o.w = pk2(s[6 * 64], s[7 * 64]);
        *(GAS v4u*)((bf16*)WT + (size_t)(drow0 + n) * K + k0 + 8 * c) = o; }
    }
    LDS_WAIT(); asm volatile("" ::: "memory");
}
__device__ __forceinline__ void convert_matrix(Frame& F, const float* W, int K, int N, void* WT, int il, unsigned& rot, bool f8 = false, float wscale = 1.0f) {
    LAS float* scr = (LAS float*)(F.lds + RING_OFF + F.wave * 16384);
    const unsigned gw = (unsigned)(F.vcu * NWAVES + F.wave), NGW = (unsigned)(F.G * NWAVES);
    const int nblk = N / 64, nitems = (K / 64) * nblk; int lane_ = F.lane; asm volatile("" : "+v"(lane_));
    for (int it = (int)((gw + NGW - rot % NGW) % NGW); it < nitems; it += (int)NGW) {
        const int kb = it / nblk, nb = it % nblk, n0 = 64 * nb;
        const int drow0 = il == 0 ? n0 : (n0 / 128) * 256 + (il - 1) * 128 + (n0 % 128);
        transpose_item(W, K, N, WT, 64 * kb, n0, drow0, scr, lane_, f8, wscale);
    }
    rot = (rot + (unsigned)nitems) % NGW;
}

struct RouterArgs { const float* router; gu32* cnt; unsigned* ltok; float* lw; };
template <int MODE, bool F8X = false, bool SF32 = false>
__device__ __forceinline__ void norm_phase(Frame& F, const void* src, bf16* hout, const bf16* y1, const float* gain, bf16* xn, float* fout, const RouterArgs& R) {
    int lane_ = F.lane; asm volatile("" : "+v"(lane_));
    const int gw = F.vcu * NWAVES + F.wave, NGW = F.G * NWAVES, lane = lane_;
    f32x4 gv[4];
#pragma unroll
    for (int j = 0; j < 4; ++j) gv[j] = *(const GAS f32x4*)(gain + 256 * j + 4 * lane);
    LAS float* RL = (LAS float*)(F.lds + RING_OFF);
    if constexpr (MODE == 2) {
        int tid_ = F.tid; asm volatile("" : "+v"(tid_));
        for (int i = tid_; i < 8192; i += NWAVES * 64) RL[(i & 7) * 1024 + (i >> 3)] = ((const GAS float*)R.router)[i];
        LDS_WAIT(); __syncthreads();
    }
    const int nrows_w = gw < MTOK ? (MTOK - gw + NGW - 1) / NGW : 0;
    for (int cb = 0; cb < nrows_w; cb += 64) {
        int my_t = 0, my_e0 = 0, my_e1 = 0; float my_w0 = 0.f, my_w1 = 0.f; bool valid = false;
        const int cn = (nrows_w - cb) < 64 ? (nrows_w - cb) : 64;
        f32x4 vn[4]; unsigned long long yn[4];
        unsigned long long hn[4];
        { const int row0_ = gw + cb * NGW;
          if constexpr (SF32) { const GAS f32x4* xr = (const GAS f32x4*)((const float*)src + (size_t)row0_ * D) + lane;
#pragma unroll
            for (int j = 0; j < 4; ++j) vn[j] = xr[64 * j];
          } else { const GAS unsigned long long* hr_ = (const GAS unsigned long long*)((const bf16*)src + (size_t)row0_ * D) + lane;
#pragma unroll
            for (int j = 0; j < 4; ++j) hn[j] = hr_[64 * j]; }
          if constexpr (MODE == 1 || MODE == 3) { const GAS unsigned long long* yr = (const GAS unsigned long long*)(y1 + (size_t)row0_ * D) + lane;
#pragma unroll
            for (int j = 0; j < 4; ++j) yn[j] = yr[64 * j]; } }
        for (int i = 0; i < cn; ++i) {
            const int row = gw + (cb + i) * NGW;
            f32x4 v[4]; float s = 0.f;
#pragma unroll
            for (int j = 0; j < 4; ++j) { if constexpr (SF32) v[j] = vn[j]; else { const unsigned long long w = hn[j]; const unsigned lo = (unsigned)w, hi = (unsigned)(w >> 32); v[j] = (f32x4){bflo(lo), bfhi(lo), bflo(hi), bfhi(hi)}; } }
            if constexpr (MODE == 1 || MODE == 3) {
#pragma unroll
                for (int j = 0; j < 4; ++j) { const unsigned long long w = yn[j]; const unsigned lo = (unsigned)w, hi = (unsigned)(w >> 32);
                    v[j].x += bflo(lo); v[j].y += bfhi(lo); v[j].z += bflo(hi); v[j].w += bfhi(hi); }
            }
            if (i + 1 < cn) { const int rown = row + NGW;
                if constexpr (SF32) { const GAS f32x4* xr = (const GAS f32x4*)((const float*)src + (size_t)rown * D) + lane;
#pragma unroll
                    for (int j = 0; j < 4; ++j) vn[j] = xr[64 * j];
                } else { const GAS unsigned long long* hr_ = (const GAS unsigned long long*)((const bf16*)src + (size_t)rown * D) + lane;
#pragma unroll
                    for (int j = 0; j < 4; ++j) hn[j] = hr_[64 * j]; }
                if constexpr (MODE == 1 || MODE == 3) { const GAS unsigned long long* yr = (const GAS unsigned long long*)(y1 + (size_t)rown * D) + lane;
#pragma unroll
                    for (int j = 0; j < 4; ++j) yn[j] = yr[64 * j]; } }
#pragma unroll
            for (int j = 0; j < 4; ++j) s += (v[j].x * v[j].x + v[j].y * v[j].y) + (v[j].z * v[j].z + v[j].w * v[j].w);
            if constexpr (MODE == 1) { GAS unsigned long long* hr = (GAS unsigned long long*)(hout + (size_t)row * D) + lane;
#pragma unroll
                for (int j = 0; j < 4; ++j) { const unsigned long long hw = (unsigned long long)pk2(v[j].x, v[j].y) | ((unsigned long long)pk2(v[j].z, v[j].w) << 32); hr[64 * j] = hw;
                    v[j] = (f32x4){bflo((unsigned)hw), bfhi((unsigned)hw), bflo((unsigned)(hw >> 32)), bfhi((unsigned)(hw >> 32))}; } }
            const float rstd = 1.f / sqrtf(wave_sum(s) * (1.f / D) + 1e-6f);
#pragma unroll
            for (int j = 0; j < 4; ++j) v[j] = v[j] * rstd * gv[j];
            if constexpr (MODE == 3) { GAS f32x4* orow = (GAS f32x4*)(fout + (size_t)row * D) + lane;
#pragma unroll
                for (int j = 0; j < 4; ++j) orow[64 * j] = v[j];
            } else {
                if constexpr (F8X) { GAS unsigned* o4 = (GAS unsigned*)((unsigned char*)xn + (size_t)row * D) + lane;
#pragma unroll
                    for (int j = 0; j < 4; ++j) o4[64 * j] = pg8::pk4_fp8(v[j].x, v[j].y, v[j].z, v[j].w);
                } else { GAS unsigned long long* o8 = (GAS unsigned long long*)(xn + (size_t)row * D) + lane;
#pragma unroll
                    for (int j = 0; j < 4; ++j) o8[64 * j] = (unsigned long long)pk2(v[j].x, v[j].y) | ((unsigned long long)pk2(v[j].z, v[j].w) << 32); }
            }
            if constexpr (MODE == 2) {
                float lg[NE];
#pragma unroll
                for (int e = 0; e < NE; ++e) { float a = 0.f;
#pragma unroll
                    for (int j = 0; j < 4; ++j) { const f32x4 rr = *(const LAS f32x4*)(RL + e * 1024 + 256 * j + 4 * lane); a += (v[j].x * rr.x + v[j].y * rr.y) + (v[j].z * rr.z + v[j].w * rr.w); }
                    lg[e] = wave_sum(a); }
                int e0 = 0; float v0 = lg[0];
#pragma unroll
                for (int e = 1; e < NE; ++e) if (lg[e] > v0) { v0 = lg[e]; e0 = e; }
                int e1 = -1; float v1 = 0.f;
#pragma unroll
                for (int e = 0; e < NE; ++e) if (e != e0 && (e1 < 0 || lg[e] > v1)) { v1 = lg[e]; e1 = e; }
                const float w0 = 1.f / (1.f + __expf(v1 - v0));
                if (lane == i) { my_t = row; my_e0 = e0; my_e1 = e1; my_w0 = w0; my_w1 = 1.f - w0; valid = true; }
            }
        }
        if constexpr (MODE == 2) {
            unsigned myc = 0u;
#pragma unroll
            for (int e = 0; e < NE; ++e) { const unsigned long long b0 = __ballot(valid && my_e0 == e), b1 = __ballot(valid && my_e1 == e);
                const unsigned c = (unsigned)(__popcll(b0) + __popcll(b1)); if (lane == e) myc = c; }
            unsigned basev = 0u;
            if (lane < NE) basev = __hip_atomic_fetch_add(R.cnt + 64 * lane, myc, RLX_AGENT);
            const unsigned long long lt = (1ull << lane) - 1ull;
            unsigned pos0 = 0u, pos1 = 0u;
#pragma unroll
            for (int e = 0; e < NE; ++e) { const unsigned long long b0 = __ballot(valid && my_e0 == e), b1 = __ballot(valid && my_e1 == e);
                const unsigned be = (unsigned)__shfl((int)basev, e);
                if (my_e0 == e) pos0 = be + (unsigned)__popcll(b0 & lt);
                if (my_e1 == e) pos1 = be + (unsigned)__popcll(b0) + (unsigned)__popcll(b1 & lt); }
            if (valid) {
                ((GAS unsigned*)R.ltok)[(size_t)my_e0 * LIST_CAP + pos0] = (unsigned)my_t;             ((GAS float*)R.lw)[(size_t)my_e0 * LIST_CAP + pos0] = my_w0;
                ((GAS unsigned*)R.ltok)[(size_t)my_e1 * LIST_CAP + pos1] = (unsigned)my_t | (1u << 20); ((GAS float*)R.lw)[(size_t)my_e1 * LIST_CAP + pos1] = my_w1;
            }
        }
    }
    if constexpr (MODE == 2) { LDS_WAIT(); __syncthreads(); }
}

__device__ __forceinline__ void kstat_phase(Frame& F, const bf16* Kt, float* kmean, float* kmax2) {
    int lane_ = F.lane; asm volatile("" : "+v"(lane_));
    const int gw = F.vcu * NWAVES + F.wave, NGW = F.G * NWAVES, lane = lane_;
    for (int task = gw; task < BATCH * 16 * 16; task += NGW) {
        const int hh = task & 15, n = (task >> 4) & 15, b = task >> 8, l5 = lane & 31, hf = lane >> 5;
        const GAS unsigned* p = (const GAS unsigned*)(Kt + ((size_t)b * SEQ + 256 * n + 128 * hf) * D + hh * 64) + l5;
        float a0 = 0.f, a1 = 0.f, mx = 0.f;
#pragma unroll 32
        for (int r = 0; r < 128; ++r) { const unsigned w = p[(size_t)r * (D / 2)]; const float v0 = bflo(w), v1 = bfhi(w); a0 += v0; a1 += v1;
            float s = v0 * v0 + v1 * v1;
            s += __int_as_float(__builtin_amdgcn_update_dpp(0, __float_as_int(s), 0xB1, 0xF, 0xF, true)); s += __int_as_float(__builtin_amdgcn_update_dpp(0, __float_as_int(s), 0x4E, 0xF, 0xF, true));
            s += __int_as_float(__builtin_amdgcn_update_dpp(0, __float_as_int(s), 0x141, 0xF, 0xF, true)); s += __int_as_float(__builtin_amdgcn_update_dpp(0, __float_as_int(s), 0x140, 0xF, 0xF, true));
            s += __int_as_float(__builtin_amdgcn_ds_swizzle(__float_as_int(s), 0x401F)); mx = fmaxf(mx, s); }
        { auto r0 = __builtin_amdgcn_permlane32_swap(__float_as_uint(a0), __float_as_uint(a0), false, false); a0 = __uint_as_float(r0[0]) + __uint_as_float(r0[1]);
          auto r1 = __builtin_amdgcn_permlane32_swap(__float_as_uint(a1), __float_as_uint(a1), false, false); a1 = __uint_as_float(r1[0]) + __uint_as_float(r1[1]);
          auto r2 = __builtin_amdgcn_permlane32_swap(__float_as_uint(mx), __float_as_uint(mx), false, false); mx = fmaxf(__uint_as_float(r2[0]), __uint_as_float(r2[1])); }
        if (hf == 0) { GAS float* o = (GAS float*)(kmean + ((size_t)(b * 16 + hh) * 16 + n) * 64 + 2 * l5);
            o[0] = a0 * (1.f / 256.f); o[1] = a1 * (1.f / 256.f); }
        if (lane == 0) ((GAS float*)kmax2)[(size_t)(b * 16 + hh) * 16 + n] = mx;
    }
}

struct KArgs { const float* in[17]; float* out; unsigned char* ws; int ph_lo, ph_hi; };
struct ConvDesc { const float* W; int K, N; unsigned char* WT; int il; bool f8; float sc; };
constexpr int NCONV = 61, CONV_CH = 128;
__device__ __forceinline__ ConvDesc conv_desc(const KArgs& args, unsigned char* ws, int m) {
    constexpr float WSC_UP = 32.0f, WSC_DN = 64.0f;
    ConvDesc d; d.il = 0; d.f8 = false; d.sc = 1.0f;
    if (m < 2) { d.W = args.in[7] + (size_t)m * D * 3 * D; d.K = D; d.N = 3 * D; d.WT = ws + WS_MQKV + (size_t)m * 3 * D * D * 2; }
    else if (m < 4) { const int j = m - 2; d.W = args.in[8] + (size_t)j * D * D; d.K = D; d.N = D; d.WT = ws + WS_MWO + (size_t)j * D * D * 2; }
    else if (m == 4) { d.W = args.in[4]; d.K = D; d.N = D; d.WT = ws + WS_DWO; }
    else if (m == 5) { d.W = args.in[3] + (size_t)D * 3 * D; d.K = D; d.N = 3 * D; d.WT = ws + WS_DQKV + (size_t)3 * D * D * 2; }
    else if (m == 6) { d.W = args.in[4] + (size_t)D * D; d.K = D; d.N = D; d.WT = ws + WS_DWO + (size_t)D * D * 2; }
    else if (m < 13) { const int r = m - 7, j = r / 3, t = r % 3; d.f8 = (j == 1);
        if (t < 2) { d.W = args.in[9 + t] + (size_t)j * D * DFF; d.K = D; d.N = DFF; d.WT = ws + WS_FGU + (size_t)j * 2 * DFF * D * 2; d.il = 1 + t; d.sc = d.f8 ? WSC_UP : 1.0f; }
        else { d.W = args.in[11] + (size_t)j * DFF * D; d.K = DFF; d.N = D; d.WT = ws + WS_FD + (size_t)j * D * DFF * 2; d.sc = d.f8 ? WSC_DN : 1.0f; } }
    else { const int r = m - 13, e = r / 3, t = r % 3; d.f8 = true;
        if (t < 2) { d.W = args.in[13 + t] + (size_t)e * D * DE; d.K = D; d.N = DE; d.WT = ws + WS_MGU + (size_t)e * 2 * DE * D; d.il = 1 + t; d.sc = WSC_UP; }
        else { d.W = args.in[15] + (size_t)e * DE * D; d.K = DE; d.N = D; d.WT = ws + WS_MD + (size_t)e * D * DE; d.sc = WSC_DN; } }
    return d;
}
__device__ __forceinline__ int conv_chunks_of(int m) { const int items = m < 2 || m == 5 ? 768 : (m < 7 ? 256 : (m < 13 ? 704 : 896)); return (items + CONV_CH - 1) / CONV_CH; }
__device__ __forceinline__ int conv_total_chunks() { int s = 0; for (int m = 0; m < NCONV; ++m) s += conv_chunks_of(m); return s; }
__device__ __forceinline__ void conv_chunk(Frame& F, const KArgs& args, unsigned char* ws, int c) {
    int m = 0; for (; m < NCONV; ++m) { const int n = conv_chunks_of(m); if (c < n) break; c -= n; }
    const ConvDesc d = conv_desc(args, ws, m);
    LAS float* scr = (LAS float*)(F.lds + RING_OFF + F.wave * 16384);
    int lane_ = F.lane; asm volatile("" : "+v"(lane_));
    const int nblk = d.N / 64, nitems = (d.K / 64) * nblk, last = (c + 1) * CONV_CH < nitems ? (c + 1) * CONV_CH : nitems;
    for (int it = c * CONV_CH + F.wave; it < last; it += NWAVES) {
        const int kb = it / nblk, nb = it % nblk, n0 = 64 * nb;
        const int drow0 = d.il == 0 ? n0 : (n0 / 128) * 256 + (d.il - 1) * 128 + (n0 % 128);
        transpose_item(d.W, d.K, d.N, d.WT, 64 * kb, n0, drow0, scr, lane_, d.f8, d.sc);
    }
}

__global__ void __launch_bounds__(NWAVES * 64, 2) trunk_fwd(KArgs args) {
    extern __shared__ __attribute__((aligned(16))) unsigned char lds[];
    Frame F;
    F.lds = (LAS unsigned char*)lds;
    F.MISC = (volatile LAS unsigned*)(F.lds + MISC_OFF);
    F.tid = threadIdx.x; F.lane = F.tid & 63; F.wave = __builtin_amdgcn_readfirstlane(F.tid >> 6);
    F.G = gridDim.x; { const int bx = blockIdx.x; F.vcu = (F.G % 8 == 0) ? (bx % 8) * (F.G / 8) + bx / 8 : bx; }
    F.ctl = (gu32*)(args.ws + WS_CTL);
    for (int u = F.tid; u < (LDS_BYTES - LDSCTL_OFF) / 4; u += NWAVES * 64) ((LAS unsigned*)(F.lds + LDSCTL_OFF))[u] = 0u;
    __syncthreads();
    Frame& F0 = F;
    const int lo = args.ph_lo, hi = args.ph_hi;
    XcdBarrier bar; bar.bar = (unsigned*)(F.ctl + CW_BAR); bar.x = 0; bar.st = nullptr;
    if (hi - lo > 1) bar = xcd_barrier_post((unsigned*)(F.ctl + CW_BAR), F.MISC + 8);
#define IN(k) (lo <= (k) && (k) < hi)
#ifndef PH_ENABLE
#define PH_ENABLE 0xFFFFFFFFu
#endif
#define PHEN(n) (((PH_ENABLE) >> (n)) & 1u)
#ifndef MK_DOUBLE
#define MK_DOUBLE 0u
#endif
#define NREP(n) ((((MK_DOUBLE) >> (n)) & 1u) ? 2 : 1)
#if defined(NO_OPQ)
#define OPQ(p) do {} while (0)
#else
#define OPQ(p) asm volatile("" : "+s"(p))
#endif
#if 0
#define STAMP(k) do { if (blockIdx.x == 0 && threadIdx.x == 0) { const unsigned long long t_ = __builtin_amdgcn_s_memrealtime(); ((GAS unsigned*)(F0.ctl))[3000 + (k)] = (unsigned)t_; } } while (0)
#else
#define STAMP(k) do {} while (0)
#endif
#define SEAM(k) do { if (IN(k) && IN((k) + 1)) { XcdBarrier b2_ = bar; OPQ(b2_.bar); xcd_barrier(b2_); } STAMP((k) + 1); } while (0)

#define PTRS() unsigned char* ws = args.ws; OPQ(ws); const float* x = args.in[0]; OPQ(x); const float* norm_mix = args.in[1]; OPQ(norm_mix); const float* norm_ffn = args.in[2]; OPQ(norm_ffn); \
    bf16* h = (bf16*)(ws + WS_HB); \
    bf16* XN = (bf16*)(ws + WS_XN); bf16* Qb = (bf16*)(ws + WS_Q); bf16* Kb = (bf16*)(ws + WS_K); bf16* Vb = (bf16*)(ws + WS_V); bf16* ACT = (bf16*)(ws + WS_ACT); \
    bf16* MGU = (bf16*)(ws + WS_MGU); bf16* MD = (bf16*)(ws + WS_MD); \
    float* kmean = (float*)(ws + WS_KMEAN); unsigned* ltok = (unsigned*)(ws + WS_LTOK); float* lw = (float*)(ws + WS_LW); \
    (void)x; (void)norm_mix; (void)norm_ffn; (void)h; (void)XN; (void)Qb; (void)Kb; (void)Vb; (void)ACT; (void)MGU; (void)MD; (void)kmean; (void)ltok; (void)lw
    const RouterArgs noR{nullptr, nullptr, nullptr, nullptr};
#ifndef MK_F8_DENSE
#define MK_F8_DENSE 0
#endif
    constexpr bool F8_DENSE = MK_F8_DENSE != 0; constexpr int DESZ = F8_DENSE ? 1 : 2;
    constexpr float WSC_UP = 32.0f, WSC_DN = 64.0f;
    constexpr float C2 = 0.125f * 1.4426950408889634f;

    STAMP(0);
    if (PHEN(0) && IN(0)) {
        PTRS();
        { unsigned rot = 0u;
        convert_matrix(F, args.in[3], D, 3 * D, ws + WS_DQKV, 0, rot);
        norm_phase<0, false, true>(F, x, nullptr, nullptr, norm_mix, XN, nullptr, noR);
        }
    }
    SEAM(0);

    for (int L = 0; L < NLAYER; ++L) {
        const int j = L >> 1, moba = L & 1, pb = 1 + PH_PER_LAYER * L;
        int z_ = 0;
#if !defined(NO_OPQ_Z)
        asm volatile("" : "+s"(z_));
#endif
        Frame Fl = F0; Fl.G += z_; Fl.vcu += z_; Fl.wave += z_; Fl.lds += z_; Fl.ctl += z_; const int bx = (int)blockIdx.x + z_;
#define F Fl
        if (PHEN(1) && IN(pb + 0)) {
            PTRS();

            const bf16* W = (const bf16*)(ws + (moba ? WS_MQKV : WS_DQKV)) + (size_t)j * 3 * D * D;
            pg8::Gemm g{XN, W, 2 * D, 0}; pg8::StaticOrder S; S.init(MTOK, 3 * D, F.G, bx);
            pg8::EpiQKV E{Qb, D, D, (size_t)(WS_K - WS_Q) / 2, C2};
            for (int rep_ = 0; rep_ < NREP(1); ++rep_) pg8::gemm_phase<pg8::EpiQKV, pg8::StaticOrder>(F.lds + RING_OFF, XSLOT_OFF, g, S, E);
        }
        SEAM(pb + 0);
        { if (PHEN(2) && IN(pb + 1)) { PTRS(); kstat_phase(F, Kb, kmean, kmean + 8 * 16 * 16 * 64); } SEAM(pb + 1); }
        if (IN(pb + 2)) {
            PTRS();
            att::Args A; A.Q = Qb; A.K = Kb; A.V = Vb; A.O = XN; A.kmean = kmean; A.kmax2 = kmean + 8 * 16 * 16 * 64; A.subln = args.in[6] + (size_t)j * 128; A.lam_full = 0.f; A.out_scale = 1.f; A.abl = 0;
            LAS int* qw;
            if (!moba) {
                const float* lam = args.in[5] + (size_t)j * 256; int lane = F.lane; asm volatile("" : "+v"(lane));
                const GAS float* lamg = (const GAS float*)lam; const float s1 = wave_sum(lamg[lane] * lamg[64 + lane]), s2 = wave_sum(lamg[128 + lane] * lamg[192 + lane]);
                const float lam_init = (L == 0) ? 0.2f : 0.47071302f;
                A.lam_full = __uint_as_float(__builtin_amdgcn_readfirstlane(__float_as_uint(__expf(s1) - __expf(s2) + lam_init))); A.out_scale = __uint_as_float(__builtin_amdgcn_readfirstlane(__float_as_uint(1.0f - lam_init)));
            }
            const int nconv = (L == 0) ? conv_total_chunks() : 0;
            qw = (LAS int*)(F.lds + XSLOT_OFF);
            const int xme = (int)(xb_xcc_id() & 7u);
            if ((PHEN(3) && !moba) || (PHEN(4) && moba)) for (int rep_ = 0; rep_ < (moba ? NREP(4) : NREP(3)); ++rep_) for (int xq = xme;;) {
#if ATT_ABLATE
                { const bool ab_ = rep_ == 0 && (moba ? NREP(4) : NREP(3)) == 2; A.abl = ab_ ? ATT_ABLATE : 0; A.O = ab_ ? (bf16*)(ws + WS_END) : XN; }
#endif
                const int ncx = (nconv && rep_ == 0) ? ((nconv - xq + 7) >> 3) : 0;
                gu32* qb = F.ctl + CW_ATTQ2 + 256 * L + 1024 * rep_; gu32* qx = qb + 32 * xq;
                for (;;) {
                    if (F.tid == 0) *qw = (int)__hip_atomic_fetch_add(qx, 1u, RLX_AGENT);
                    asm volatile("s_waitcnt vmcnt(0) lgkmcnt(0)\n\ts_barrier" ::: "memory");
                    int idx = __builtin_amdgcn_readfirstlane(*qw);
                    if (idx >= 128 + ncx) { asm volatile("s_waitcnt vmcnt(0) lgkmcnt(0)\n\ts_barrier" ::: "memory"); break; }
                    if (ncx) { const int q3 = idx / 3; if (idx < 3 * ncx) { if (idx - 3 * q3 == 2) { conv_chunk(F, args, ws, xq + 8 * q3); asm volatile("s_waitcnt vmcnt(0) lgkmcnt(0)\n\ts_barrier" ::: "memory"); continue; } idx -= q3; } else idx -= ncx; }
                    if (!moba) { const int hh = 7 - (idx >> 4), pr = idx & 15;
                        att::attn_unit<0>(F.lds + RING_OFF, A, xq, hh, pr);
                        att::attn_unit<0>(F.lds + RING_OFF, A, xq, hh, 31 - pr);
                    } else { const int hh = 15 - (idx >> 3), pr = idx & 7;
                        att::attn_unit<1>(F.lds + RING_OFF, A, xq, hh, pr);
                        att::attn_unit<1>(F.lds + RING_OFF, A, xq, hh, 15 - pr); }
                }
                if (F.tid < 64) { int lane = F.tid; asm volatile("" : "+v"(lane)); bool av = false;
                    if (lane < 8) { const int lim = 128 + ((nconv && rep_ == 0) ? ((nconv - lane + 7) >> 3) : 0); av = (int)__hip_atomic_load(qb + 32 * lane, RLX_AGENT) < lim; }
                    const unsigned long long m_ = __ballot(av);
                    if (lane == 0) *qw = (int)(unsigned)m_; }
                asm volatile("s_waitcnt vmcnt(0) lgkmcnt(0)\n\ts_barrier" ::: "memory");
                const unsigned m = (unsigned)__builtin_amdgcn_readfirstlane(*qw);
                asm volatile("s_waitcnt vmcnt(0) lgkmcnt(0)\n\ts_barrier" ::: "memory");
                if (m == 0u) break;
                const unsigned rot = ((m >> xme) | (m << (8 - xme))) & 0xFFu;
                xq = (xme + __builtin_ctz(rot)) & 7;
            }
            asm volatile("s_waitcnt vmcnt(0) lgkmcnt(0)\n\ts_barrier" ::: "memory");
        }
        SEAM(pb + 2);
        if (PHEN(5) && IN(pb + 3)) {
            PTRS();
            const bf16* W = (const bf16*)(ws + (moba ? WS_MWO : WS_DWO)) + (size_t)j * D * D;
            pg8::Gemm g{XN, W, 2 * D, 0}; pg8::StaticOrder S; S.init(MTOK, D, F.G, bx);
            if (L == 0) { pg8::EpiRes<true> E{x, h, D, 1.0f}; pg8::gemm_phase<pg8::EpiRes<true>, pg8::StaticOrder>(F.lds + RING_OFF, XSLOT_OFF, g, S, E); }
            else { pg8::EpiRes<false> E{h, h, D, 1.0f}; pg8::gemm_phase<pg8::EpiRes<false>, pg8::StaticOrder>(F.lds + RING_OFF, XSLOT_OFF, g, S, E); }
        }
        SEAM(pb + 3);
        if (PHEN(6) && IN(pb + 4)) {
            PTRS();
            if (!moba) {
                if (L == 2) norm_phase<0, true>(F, h, nullptr, nullptr, norm_ffn + (size_t)L * D, XN, nullptr, noR);
                else norm_phase<0, false>(F, h, nullptr, nullptr, norm_ffn + (size_t)L * D, XN, nullptr, noR);
            } else {
                const RouterArgs R{args.in[12] + (size_t)j * D * NE, F.ctl + CW_CNT + 64 * NE * j, ltok, lw};
                norm_phase<2, true>(F, h, nullptr, nullptr, norm_ffn + (size_t)L * D, XN, nullptr, R);
            }
        }
        SEAM(pb + 4);
        if (IN(pb + 5)) {
            PTRS();
            if (PHEN(7) && !moba) {
                if (L == 2) { pg8::Gemm g{XN, ws + WS_FGU + (size_t)j * 2 * DFF * D * 2, D, 0}; pg8::StaticOrder S; S.init(MTOK, 2 * DFF, F.G, bx);
                    pg8::EpiSwiGLU<true> E{ACT, DFF, 1.0f / WSC_UP};
                    pg8::gemm_phase<pg8::EpiSwiGLU<true>, pg8::StaticOrder, true>(F.lds + RING_OFF, XSLOT_OFF, g, S, E);
                } else { pg8::Gemm g{XN, ws + WS_FGU + (size_t)j * 2 * DFF * D * 2, 2 * D, 0}; pg8::StaticOrder S; S.init(MTOK, 2 * DFF, F.G, bx);
                    pg8::EpiSwiGLU<false> E{ACT, DFF, 1.0f};
                    pg8::gemm_phase<pg8::EpiSwiGLU<false>, pg8::StaticOrder, false>(F.lds + RING_OFF, XSLOT_OFF, g, S, E); }
            } else if (PHEN(8) && moba) {
                pg8::Gemm g{XN, ws + WS_MGU + (size_t)j * NE * 2 * DE * D, D, (size_t)2 * DE * D}; pg8::MoeOrder S; S.init((const unsigned*)(F.ctl + CW_CNT + 64 * NE * j), ltok, true, 2 * DE, F.G, bx);
                pg8::EpiSwiGLU<true> E{ACT, DE, 1.0f / WSC_UP};
                pg8::gemm_phase<pg8::EpiSwiGLU<true>, pg8::MoeOrder, true>(F.lds + RING_OFF, XSLOT_OFF, g, S, E);
            }
        }
        SEAM(pb + 5);
        if (IN(pb + 6)) {
            PTRS();
            if (PHEN(9) && !moba) {
                if (L == 2) { pg8::Gemm g{ACT, ws + WS_FD + (size_t)j * D * DFF * 2, DFF, 0}; pg8::StaticOrder S; S.init(MTOK, D, F.G, bx);
                    pg8::EpiRes<false> E{h, h, D, 1.0f / WSC_DN};
                    pg8::gemm_phase<pg8::EpiRes<false>, pg8::StaticOrder, true>(F.lds + RING_OFF, XSLOT_OFF, g, S, E);
                } else { pg8::Gemm g{ACT, ws + WS_FD + (size_t)j * D * DFF * 2, 2 * DFF, 0}; pg8::StaticOrder S; S.init(MTOK, D, F.G, bx);
                    pg8::EpiRes<false> E{h, h, D, 1.0f};
                    pg8::gemm_phase<pg8::EpiRes<false>, pg8::StaticOrder, false>(F.lds + RING_OFF, XSLOT_OFF, g, S, E); }
            } else if (PHEN(10) && moba) {
                pg8::Gemm g{ACT, ws + WS_MD + (size_t)j * NE * D * DE, DE, (size_t)D * DE}; pg8::MoeOrder S; S.init((const unsigned*)(F.ctl + CW_CNT + 64 * NE * j), ltok, false, D, F.G, bx);
                pg8::EpiMoeDown E; E.h = h; E.y1 = XN; E.list_tok = ltok; E.list_w = lw; E.sc = 1.0f / WSC_DN;
#pragma unroll
                for (int e = 0; e < NE; ++e) E.cnt[e] = S.cnt[e];
                pg8::gemm_phase<pg8::EpiMoeDown, pg8::MoeOrder, true>(F.lds + RING_OFF, XSLOT_OFF, g, S, E);
            }
        }
        SEAM(pb + 6);
        if (PHEN(11) && IN(pb + 7)) {
            PTRS();
            if (L == 3) norm_phase<3>(F, h, nullptr, XN, args.in[16], nullptr, args.out, noR);
            else if (moba) norm_phase<1>(F, h, h, XN, norm_mix + (size_t)(L + 1) * D, XN, nullptr, noR);
            else for (int rep_ = 0; rep_ < NREP(11); ++rep_) norm_phase<0>(F, h, nullptr, nullptr, norm_mix + (size_t)(L + 1) * D, XN, nullptr, noR);
        }
        if (L != NLAYER - 1) SEAM(pb + 7); else STAMP(pb + 8);
#undef F
    }
#undef IN
#undef SEAM
#undef PTRS
#undef OPQ
}


#if MK_DEBUG
__global__ void dbg_probe(const void* buf, size_t n, int is_bf16, int idx, float thresh, unsigned* dbg) {
    size_t i = blockIdx.x * (size_t)blockDim.x + threadIdx.x, stride = (size_t)gridDim.x * blockDim.x; bool bad = false;
    for (size_t k = i; k < n; k += stride) { float v = is_bf16 ? __uint_as_float(((unsigned)((const unsigned short*)buf)[k]) << 16) : ((const float*)buf)[k]; if (!(fabsf(v) <= thresh)) bad = true; }
    if (bad) atomicMax(dbg, (unsigned)(1000 - idx));
}
__global__ void dbg_cnt(const unsigned* cntw, int idx, unsigned* dbg) {
    if (threadIdx.x == 0 && blockIdx.x == 0) { unsigned s = 0; for (int e = 0; e < NE; ++e) s += cntw[64 * e]; if (s != 2u * MTOK) atomicMax(dbg, (unsigned)(1000 - idx)); }
}

__device__ __forceinline__ float dbg_bf(unsigned short v) { return __uint_as_float(((unsigned)v) << 16); }
__device__ __forceinline__ unsigned dbg_hash(unsigned x) { x ^= x >> 16; x *= 0x7feb352dU; x ^= x >> 15; x *= 0x846ca68bU; x ^= x >> 16; return x; }
__global__ void dbg_gemm_check(const unsigned short* A, int lda, const unsigned short* Bt, int K, const unsigned short* out, int ldo, int M, int N, float scale, int idx, unsigned* dbg) {
    const unsigned s = blockIdx.x * blockDim.x + threadIdx.x; const int row = (int)(dbg_hash(2 * s + 1) % (unsigned)M), col = (int)(dbg_hash(2 * s + 2) % (unsigned)N);
    float acc = 0.f; for (int k = 0; k < K; ++k) acc += dbg_bf(A[(size_t)row * lda + k]) * dbg_bf(Bt[(size_t)col * K + k]);
    acc *= scale; const float got = dbg_bf(out[(size_t)row * ldo + col]);
    if (!(fabsf(got - acc) <= 0.03f + 0.02f * fabsf(acc))) { atomicMax(dbg, (unsigned)(1000 - idx)); atomicAdd(dbg + 64 + idx, 1u); }
}
__global__ void dbg_conv_check(const float* W, int K, int N, const unsigned short* WT, int il, int idx, unsigned* dbg) {
    const unsigned s = blockIdx.x * blockDim.x + threadIdx.x; const int k = (int)(dbg_hash(2 * s + 1) % (unsigned)K), n = (int)(dbg_hash(2 * s + 2) % (unsigned)N);
    const int dr = il == 0 ? n : (n / 128) * 256 + (il - 1) * 128 + (n % 128);
    const float w = W[(size_t)k * N + n], g = dbg_bf(WT[(size_t)dr * K + k]);
    if (!(fabsf(g - w) <= 0.01f * fabsf(w) + 1e-6f)) atomicMax(dbg, (unsigned)(1000 - idx));
}
__global__ void dbg_norm_check(const float* src, const float* gain, const unsigned short* xn, int idx, unsigned* dbg) {
    const unsigned s = blockIdx.x * blockDim.x + threadIdx.x; const int row = (int)(dbg_hash(s + 77) % (unsigned)MTOK);
    float ss = 0.f; for (int c = 0; c < D; ++c) { const float v = src[(size_t)row * D + c]; ss += v * v; }
    const float rstd = 1.f / sqrtf(ss / D + 1e-6f); bool bad = false;
    for (int c = 0; c < D; ++c) { const float r = src[(size_t)row * D + c] * rstd * gain[c], g = dbg_bf(xn[(size_t)row * D + c]); if (!(fabsf(g - r) <= 0.02f + 0.01f * fabsf(r))) bad = true; }
    if (bad) atomicMax(dbg, (unsigned)(1000 - idx));
}
__global__ void dbg_naive_gemm(const unsigned short* A, const unsigned short* Bt, unsigned short* out, int M, int N, int K) {
    const size_t i = blockIdx.x * (size_t)blockDim.x + threadIdx.x; if (i >= (size_t)M * N) return; const int row = (int)(i / N), col = (int)(i % N);
    float acc = 0.f; for (int k = 0; k < K; ++k) acc += dbg_bf(A[(size_t)row * K + k]) * dbg_bf(Bt[(size_t)col * K + k]);
    out[(size_t)row * N + col] = (unsigned short)f2bf(acc);
}
__global__ void dbg_find_col(const unsigned short* out, const unsigned short* ref, int M, int N, unsigned* hist) {
    const unsigned s = blockIdx.x * blockDim.x + threadIdx.x; const int row = (int)(dbg_hash(2 * s + 1) % (unsigned)M), col = (int)(dbg_hash(2 * s + 2) % (unsigned)N);
    const unsigned short v = out[(size_t)row * N + col]; int found = -1;
#if MK_FIND_PATTERN
    if (v == 0x3C3C) atomicAdd(hist + N, 1u); else atomicAdd(hist + 5, 1u); return;
#endif
#if MK_FIND_ROWS
    for (int r = 0; r < M; ++r) if (ref[(size_t)r * N + col] == v) { found = r; break; }
    if (found < 0) atomicAdd(hist + N, 1u); else atomicAdd(hist + ((found - row) & (N - 1)), 1u);
#else
    for (int c = 0; c < N; ++c) if (ref[(size_t)row * N + c] == v) { found = c; break; }
    if (found < 0) atomicAdd(hist + N, 1u); else atomicAdd(hist + ((found - col) & (N - 1)), 1u);
#endif
}
__global__ void dbg_hist_code(const unsigned* hist, int N, unsigned* dbg) {
    if (threadIdx.x || blockIdx.x) return; unsigned best = 0, bi = 0; for (int i = 0; i < N; ++i) if (hist[i] > best) { best = hist[i]; bi = i; }
    dbg[32] = bi; dbg[33] = best; dbg[34] = hist[N];
}
__global__ void dbg_final(float* out, size_t n, const unsigned* dbg) {
    if (MK_HIST_SEL >= 10) { const float c3 = sqrtf((float)dbg[MK_HIST_SEL + 30]); size_t i3 = blockIdx.x * (size_t)blockDim.x + threadIdx.x, st3 = (size_t)gridDim.x * blockDim.x; for (size_t k3 = i3; k3 < n; k3 += st3) out[k3] = c3; return; }
    if (MK_HIST_SEL >= 0 && (dbg[33] || dbg[34])) { const float c2 = sqrtf((float)(MK_HIST_SEL == 0 ? dbg[32] : (MK_HIST_SEL == 1 ? dbg[33] * 100u / 4096u : dbg[34] * 100u / 4096u)) + 1.f); size_t i2 = blockIdx.x * (size_t)blockDim.x + threadIdx.x, st2 = (size_t)gridDim.x * blockDim.x; for (size_t k2 = i2; k2 < n; k2 += st2) out[k2] = c2; return; }
    const unsigned d = dbg[0]; if (d == 0u) return; const unsigned nf = dbg[64 + (1000u - d)]; const float c = sqrtf(nf ? (float)(200u * (1000u - d - 9u) + nf * 100u / 4096u) : (float)(1000u - d));
    size_t i = blockIdx.x * (size_t)blockDim.x + threadIdx.x, stride = (size_t)gridDim.x * blockDim.x;
    for (size_t k = i; k < n; k += stride) out[k] = c;
}
#endif

#ifndef MK_REPEAT
#define MK_REPEAT 1
#endif
#ifndef MK_FIND_ROWS
#define MK_FIND_ROWS 0
#endif
#ifndef MK_FIND_REGION
#define MK_FIND_REGION WS_K
#endif
#ifndef MK_HIST_SEL
#define MK_HIST_SEL 0
#endif
#ifndef MK_STAMP
#define MK_STAMP 0
#endif
#if MK_STAMP
__global__ void stamp_k(unsigned* p) { if (threadIdx.x == 0) *p = (unsigned)__builtin_amdgcn_s_memrealtime(); }
__global__ void stamp_encode(float* out, size_t n, const unsigned* st, int pa, float ua, int pb, float ub) {
    const float da = (float)(st[pa + 1] - st[pa]) * 0.01f, db = (float)(st[pb + 1] - st[pb]) * 0.01f;
    float m = da / ua; m = m < 10.f ? 10.f : (m > 99.f ? 99.f : m); float e = floorf(db / ub + 0.5f); e = e < 0.f ? 0.f : (e > 30.f ? 30.f : e);
    const float c = sqrtf(m) * __powf(10.f, 0.5f * e);
    size_t i = blockIdx.x * (size_t)blockDim.x + threadIdx.x, stride = (size_t)gridDim.x * blockDim.x;
    for (size_t k = i; k < n; k += stride) out[k] = c;
}
#endif
extern "C" void kernel_launch(void* const* d_in, const int* in_sizes, int n_in, void* d_out, int out_size, void* d_ws, size_t ws_size, hipStream_t stream) {
    static int grid = 0;
    if (grid == 0) {
        if (n_in != 17 || in_sizes[0] != MTOK * D || out_size != MTOK * D || ws_size < WS_END) {
            fprintf(stderr, "kernel_launch: built for 17 inputs, x/out of %d floats, >= %zu bytes of workspace; got n_in %d, in0 %d, out %d, ws %zu; nothing launched\n", MTOK * D, (size_t)WS_END, n_in, n_in > 0 ? in_sizes[0] : -1, out_size, ws_size);
            grid = -1; return; }
        int dev = 0, cus = 0, per_cu = 0;
        if (hipGetDevice(&dev) != hipSuccess || hipDeviceGetAttribute(&cus, hipDeviceAttributeMultiprocessorCount, dev) != hipSuccess) { fprintf(stderr, "kernel_launch: device query failed\n"); grid = -1; return; }
        if (hipFuncSetAttribute((const void*)trunk_fwd, hipFuncAttributeMaxDynamicSharedMemorySize, LDS_BYTES) != hipSuccess) { fprintf(stderr, "kernel_launch: hipFuncSetAttribute failed\n"); grid = -1; return; }
        if (hipOccupancyMaxActiveBlocksPerMultiprocessor(&per_cu, (const void*)trunk_fwd, NWAVES * 64, LDS_BYTES) != hipSuccess || per_cu < 1)
            fprintf(stderr, "kernel_launch: note: occupancy query reports %d workgroups per CU\n", per_cu);
        (void)hipGetLastError();
        grid = cus;
    }
    if (grid < 0) return;
    if (hipMemsetAsync((char*)d_ws + WS_CTL, 0, CTL_ZERO_BYTES, stream) != hipSuccess) { fprintf(stderr, "kernel_launch: memset failed\n"); return; }
    KArgs a{};
    for (int i = 0; i < 17; ++i) a.in[i] = (const float*)d_in[i];
    a.out = (float*)d_out; a.ws = (unsigned char*)d_ws;
#if MK_PER_PHASE
#if MK_STAMP
    hipLaunchKernelGGL(stamp_k, dim3(1), dim3(64), 0, stream, (unsigned*)d_ws + 3000);
#endif
    for (int p = 0; p < NPHASE; ++p) {
        a.ph_lo = p; a.ph_hi = p + 1;
#if MK_DEBUG
#endif
#if !defined(MK_SKIP_MAIN)
        for (int rep_ = 0; rep_ < (p == 1 ? MK_REPEAT : 1); ++rep_) hipLaunchKernelGGL(trunk_fwd, dim3(grid), dim3(NWAVES * 64), LDS_BYTES, stream, a);
#endif
#if MK_STAMP
        hipLaunchKernelGGL(stamp_k, dim3(1), dim3(64), 0, stream, (unsigned*)d_ws + 3000 + p + 1);
#endif
#if MK_DEBUG
        {   unsigned char* ws = (unsigned char*)d_ws; unsigned* dbg = (unsigned*)(ws + WS_CTL) + 2048;
            const size_t MD_ = (size_t)MTOK * D;
#define PROBE(buf, n, isbf, idx, th) if ((idx) <= MK_PROBE_MAX) hipLaunchKernelGGL(dbg_probe, dim3(2048), dim3(256), 0, stream, (const void*)(buf), (size_t)(n), isbf, idx, th, dbg)
            if (p == 0) {
                hipLaunchKernelGGL(dbg_norm_check, dim3(4), dim3(64), 0, stream, (const float*)d_in[0], (const float*)d_in[1], (const unsigned short*)(ws + WS_XN), 4, dbg);
                hipLaunchKernelGGL(dbg_conv_check, dim3(16), dim3(256), 0, stream, (const float*)d_in[3], D, 3 * D, (const unsigned short*)(ws + WS_DQKV), 0, 5, dbg);
                hipLaunchKernelGGL(dbg_conv_check, dim3(16), dim3(256), 0, stream, (const float*)d_in[9], D, DFF, (const unsigned short*)(ws + WS_FGU), 1, 6, dbg);
                hipLaunchKernelGGL(dbg_conv_check, dim3(16), dim3(256), 0, stream, (const float*)d_in[10], D, DFF, (const unsigned short*)(ws + WS_FGU), 2, 7, dbg);
                hipLaunchKernelGGL(dbg_conv_check, dim3(16), dim3(256), 0, stream, (const float*)d_in[11], DFF, D, (const unsigned short*)(ws + WS_FD), 0, 8, dbg);
                hipLaunchKernelGGL(dbg_conv_check, dim3(16), dim3(256), 0, stream, (const float*)d_in[15] + (size_t)3 * DE * D, DE, D, (const unsigned short*)(ws + WS_MD) + (size_t)3 * D * DE, 0, 9, dbg);
            }
            if (p == 1) {
                const float C2h = 0.125f * 1.4426950408889634f;
                hipLaunchKernelGGL(dbg_gemm_check, dim3(16), dim3(256), 0, stream, (const unsigned short*)(ws + WS_XN), D, (const unsigned short*)(ws + WS_DQKV), D, (const unsigned short*)(ws + WS_Q), D, MTOK, D, C2h, 10, dbg);
                hipLaunchKernelGGL(dbg_gemm_check, dim3(16), dim3(256), 0, stream, (const unsigned short*)(ws + WS_XN), D, (const unsigned short*)(ws + WS_DQKV) + (size_t)D * D, D, (const unsigned short*)(ws + WS_K), D, MTOK, D, 1.f, 11, dbg);

                hipLaunchKernelGGL(dbg_gemm_check, dim3(16), dim3(256), 0, stream, (const unsigned short*)(ws + WS_XN), D, (const unsigned short*)(ws + WS_DQKV) + (size_t)2 * D * D, D, (const unsigned short*)(ws + WS_V), D, MTOK, D, 1.f, 12, dbg);
            }
            if (0) { PROBE(ws + WS_XN, MD_, 1, 1, 10.f); PROBE(ws + WS_DQKV, (WS_MGU - WS_DQKV) / 2, 1, 2, 1.f); PROBE(ws + WS_MGU, (WS_XN - WS_MGU) / 2, 1, 3, 1.f); }
            if (p >= 1) { const int L = (p - 1) / PH_PER_LAYER, k = (p - 1) % PH_PER_LAYER; const int b = 20 + 10 * L;
                if (k == 0) PROBE(ws + WS_Q, 3 * MD_, 1, b + 0, 50.f);
                if (k == 1) PROBE(ws + WS_KMEAN, 8 * 16 * 16 * 64, 0, b + 1, 5.f);
                if (k == 2) PROBE(ws + WS_XN, MD_, 1, b + 2, 50.f);
                if (k == 3) PROBE(d_out, MD_, 0, b + 3, 300.f);
                if (k == 4) { PROBE(ws + WS_XN, MD_, 1, b + 4, 20.f); if ((L & 1) && (b + 9) <= MK_PROBE_MAX) hipLaunchKernelGGL(dbg_cnt, dim3(1), dim3(64), 0, stream, (const unsigned*)(ws + WS_CTL) + CW_CNT + 64 * NE * (L >> 1), b + 9, dbg); }
                if (k == 5) PROBE(ws + WS_ACT, (L & 1) ? (size_t)256 * 256 * DE : (size_t)MTOK * DFF, 1, b + 5, 2000.f);
                if (k == 6) { PROBE(d_out, MD_, 0, b + 6, 1000.f); if (L & 1) PROBE(ws + WS_XN, MD_, 1, b + 7, 1000.f); }
                if (k == 7 && L != 3) { PROBE(ws + WS_XN, MD_, 1, b + 8, 20.f); PROBE(d_out, MD_, 0, b + 8, 1000.f); }
            }
#undef PROBE
        }
#endif
    }
#if MK_DEBUG
    hipLaunchKernelGGL(dbg_final, dim3(2048), dim3(256), 0, stream, (float*)d_out, (size_t)MTOK * D, (const unsigned*)((unsigned char*)d_ws + WS_CTL) + 2048);
#endif
#else
    a.ph_lo = 0; a.ph_hi = NPHASE;
    hipLaunchKernelGGL(trunk_fwd, dim3(grid), dim3(NWAVES * 64), LDS_BYTES, stream, a);
#if 0
    hipLaunchKernelGGL(stamp_encode, dim3(2048), dim3(256), 0, stream, (float*)d_out, (size_t)MTOK * D, (const unsigned*)d_ws + 3000, MK_STAMP_PA, MK_STAMP_UA, MK_STAMP_PB, MK_STAMP_UB);
#endif
#endif
#if MK_STAMP
    hipLaunchKernelGGL(stamp_encode, dim3(2048), dim3(256), 0, stream, (float*)d_out, (size_t)MTOK * D, (const unsigned*)d_ws + 3000, MK_STAMP_PA, MK_STAMP_UA, MK_STAMP_PB, MK_STAMP_UB);
#endif
    const hipError_t le = hipPeekAtLastError();
    if (le != hipSuccess) fprintf(stderr, "kernel_launch: launch failed: %s\n", hipGetErrorName(le));
}
```

```cpp
#ifndef MK_DEBUG
#define MK_DEBUG 0
#endif
#ifndef MK_PER_PHASE
#define MK_PER_PHASE 0
#endif
#include <hip/hip_runtime.h>
#include <cstdio>
#include <cstdint>

#ifndef MK_KDEBUG
#define MK_KDEBUG 0
#endif
#define LAS __attribute__((address_space(3)))
#define GAS __attribute__((address_space(1)))

constexpr int BATCH = 8, SEQ = 4096, MTOK = BATCH * SEQ, D = 1024, DFF = 2816, DE = 3584, NE = 8;
constexpr int MOE_TILES_MAX = 272;
constexpr int LIST_CAP = MTOK;

namespace pg8 {
#define PG8_LAS __attribute__((address_space(3)))
typedef unsigned short bf16_t;
typedef short bf16x8 __attribute__((ext_vector_type(8)));
typedef float f32x4 __attribute__((ext_vector_type(4)));
typedef unsigned u32x4 __attribute__((ext_vector_type(4)));
typedef int i32x4 __attribute__((ext_vector_type(4)));
typedef int i32x8 __attribute__((ext_vector_type(8)));
constexpr int BM = 256, BK = 64, HALF = 128, HTB = HALF * BK * 2  , STAGE_BYTES = 8 * HTB, NXCD = 8, WGM = 8;

__host__ __device__ __forceinline__ int lds_byte(int r, int c) { const int st = (r >> 4) * 2 + (c >> 5), rr = r & 15, cc = c & 31, ob = rr * 64 + cc * 2; return st * 1024 + (ob ^ (((ob >> 9) & 1) << 5)); }
__host__ __device__ __forceinline__ void stage_rc(int b, int& R, int& C) { const int st = b / 1024, sb = b % 1024, swz = sb ^ (((sb >> 9) & 1) << 5); R = (st >> 1) * 16 + swz / 64; C = (st & 1) * 32 + (swz % 64) / 2; }
__host__ __device__ __forceinline__ int perm32(int rho) { const int n = rho >> 4, i = rho & 15; return 8 * (i >> 2) + 4 * n + (i & 3); }

struct Unit { int pm, pn, e, r0; };
struct Gemm { const void* A; const void* Bt; int rowb; size_t bstride; };

__device__ __forceinline__ void tile_of(int L, int nM, int nN, int& pm, int& pn) {
    const int nwg = nM * nN; int wgid = L; { const int q = nwg / NXCD, r = nwg % NXCD, xcd = wgid % NXCD, off = wgid / NXCD; wgid = (xcd < r ? xcd * (q + 1) : r * (q + 1) + (xcd - r) * q) + off; }
    const int nig = WGM * nN, gid = wgid / nig, fm = gid * WGM, gsz = (nM - fm) < WGM ? (nM - fm) : WGM;
    pm = fm + ((wgid % nig) % gsz); pn = (wgid % nig) / gsz;
}
struct StaticOrder {
    int nM, nN, nwg, G, c;
    __device__ __forceinline__ void init(int M, int N, int G_, int c_) { nM = M / BM; nN = N / BM; nwg = nM * nN; G = G_; c = c_; }
    __device__ __forceinline__ bool next(int i, Unit& u) const {
        const long L = (long)i * G + c; if (L >= nwg) return false;
        tile_of((int)L, nM, nN, u.pm, u.pn); u.e = 0; u.r0 = 0; return true;
    }
    __device__ __forceinline__ unsigned arow(const Unit& u, int lr) const { return (unsigned)(u.pm * BM + lr); }
};
struct MoeOrder {
    int nM, nN, nwg, G, c; int tstart[NE + 1]; int cnt[NE]; const unsigned* list_tok; bool gather;
    __device__ __forceinline__ void init(const unsigned* cntw, const unsigned* list_tok_, bool gather_, int N, int G_, int c_) {
        int acc = 0;
#pragma unroll
        for (int e = 0; e < NE; ++e) { const int ce = (int)__builtin_amdgcn_readfirstlane((int)__hip_atomic_load((const GAS unsigned*)cntw + 64 * e, __ATOMIC_RELAXED, __HIP_MEMORY_SCOPE_AGENT)); cnt[e] = ce; tstart[e] = acc; acc += (ce + BM - 1) / BM; }
        tstart[NE] = acc; nM = acc; nN = N / BM; nwg = nM * nN; G = G_; c = c_; list_tok = list_tok_; gather = gather_;
    }
    __device__ __forceinline__ bool next(int i, Unit& u) const {
        const long L = (long)i * G + c; if (L >= nwg) return false;
        tile_of((int)L, nM, nN, u.pm, u.pn); int e = 0;
#pragma unroll
        for (int k = 1; k < NE; ++k) e += (u.pm >= tstart[k]) ? 1 : 0;
        u.e = e; int ts = 0;
#pragma unroll
        for (int k = 0; k < NE; ++k) ts = (k == e) ? tstart[k] : ts;
        u.r0 = (u.pm - ts) * BM; return true;
    }
    __device__ __forceinline__ int count_of(int e) const { int cv = 0;
#pragma unroll
        for (int k = 0; k < NE; ++k) cv = (k == e) ? cnt[k] : cv;
        return cv; }
    __device__ __forceinline__ unsigned arow(const Unit& u, int lr) const {
        if (!gather) return (unsigned)(u.pm * BM + lr);
        const int l = u.r0 + lr; const int cv = count_of(u.e);
        unsigned t = 0u; if (l < cv) t = __hip_atomic_load((const GAS unsigned*)list_tok + (size_t)u.e * LIST_CAP + l, __ATOMIC_RELAXED, __HIP_MEMORY_SCOPE_AGENT) & 0xFFFFFu;
        return t;
    }
};

__device__ __forceinline__ unsigned cvt_pk_bf16(float lo, float hi) { unsigned r; asm volatile("v_cvt_pk_bf16_f32 %0, %1, %2" : "=v"(r) : "v"(lo), "v"(hi)); return r; }

struct EpiQKV {
    static constexpr bool PERM = true;
    bf16_t* O; int ldc; int split_cols; size_t split_stride; float scale0;
    __device__ __forceinline__ void operator()(const f32x4 (&acc)[2][2][4][2], const Unit& u, int wr, int wc, int fr, int fq) const {
        const int row0 = u.pm * BM + wr * 64 + fr; int colt = u.pn * BM; bf16_t* base = O;
        float sc = 1.f; { const int t = colt / split_cols; base += (size_t)t * split_stride; colt -= t * split_cols; if (t == 0) sc = scale0; }
        const int col0 = colt + wc * 32 + 8 * fq;
#pragma unroll
        for (int ai = 0; ai < 2; ++ai)
#pragma unroll
            for (int m = 0; m < 4; ++m) { bf16_t* rowp = base + (size_t)(row0 + ai * HALF + m * 16) * ldc + col0;
#pragma unroll
                for (int bj = 0; bj < 2; ++bj) { f32x4 v0 = acc[ai][bj][m][0] * sc, v1 = acc[ai][bj][m][1] * sc;
                    u32x4 w; w.x = cvt_pk_bf16(v0[0], v0[1]); w.y = cvt_pk_bf16(v0[2], v0[3]); w.z = cvt_pk_bf16(v1[0], v1[1]); w.w = cvt_pk_bf16(v1[2], v1[3]);
                    *(GAS u32x4*)(rowp + bj * HALF) = w;
                    } }
    }
};
__device__ __forceinline__ unsigned pk4_fp8(float a, float b, float c, float d) { unsigned w = 0; w = __builtin_amdgcn_cvt_pk_fp8_f32(a, b, w, false); w = __builtin_amdgcn_cvt_pk_fp8_f32(c, d, w, true); return w; }
template <bool F8OUT> struct EpiSwiGLU {
    static constexpr bool PERM = true;
    void* O; int ldc; float sc;
    __device__ __forceinline__ void operator()(const f32x4 (&acc)[2][2][4][2], const Unit& u, int wr, int wc, int fr, int fq) const {
        const int row0 = u.pm * BM + wr * 64 + fr; const int col0 = u.pn * HALF + wc * 32 + 8 * fq;
#pragma unroll
        for (int ai = 0; ai < 2; ++ai)
#pragma unroll
            for (int m = 0; m < 4; ++m) { float o[8];
#pragma unroll
                for (int n = 0; n < 2; ++n)
#pragma unroll
                    for (int j = 0; j < 4; ++j) { const float g = acc[ai][0][m][n][j] * sc, up = acc[ai][1][m][n][j] * sc;
                        const float s = __builtin_amdgcn_rcpf(1.0f + __builtin_amdgcn_exp2f(-1.4426950408889634f * g)); o[n * 4 + j] = g * s * up; }
                const size_t eo = (size_t)(row0 + ai * HALF + m * 16) * ldc + col0;
                if constexpr (F8OUT) { const unsigned long long w = (unsigned long long)pk4_fp8(o[0], o[1], o[2], o[3]) | ((unsigned long long)pk4_fp8(o[4], o[5], o[6], o[7]) << 32);
                    *(GAS unsigned long long*)((unsigned char*)O + eo) = w;
                } else { u32x4 w; w.x = cvt_pk_bf16(o[0], o[1]); w.y = cvt_pk_bf16(o[2], o[3]); w.z = cvt_pk_bf16(o[4], o[5]); w.w = cvt_pk_bf16(o[6], o[7]);
                    *(GAS u32x4*)((bf16_t*)O + eo) = w; } }
    }
};
template <bool RF32> struct EpiRes {
    static constexpr bool PERM = false;
    const void* res; bf16_t* out; int ldc; float sc;
    __device__ __forceinline__ void operator()(const f32x4 (&acc)[2][2][4][2], const Unit& u, int wr, int wc, int fr, int fq) const {
        const int row0 = u.pm * BM + wr * 64 + fr; const int col0 = u.pn * BM + wc * 32 + 4 * fq;
#pragma unroll
        for (int ai = 0; ai < 2; ++ai)
#pragma unroll
            for (int m = 0; m < 4; ++m) { const size_t off = (size_t)(row0 + ai * HALF + m * 16) * ldc + col0;
#pragma unroll
                for (int bj = 0; bj < 2; ++bj)
#pragma unroll
                    for (int n = 0; n < 2; ++n) { const size_t o2 = off + bj * HALF + n * 16; f32x4 r;
                        if constexpr (RF32) r = *(const GAS f32x4*)((const float*)res + o2);
                        else { const unsigned long long w = *(const GAS unsigned long long*)((const bf16_t*)res + o2); const unsigned lo = (unsigned)w, hi = (unsigned)(w >> 32);
                            r = (f32x4){__uint_as_float(lo << 16), __uint_as_float(lo & 0xFFFF0000u), __uint_as_float(hi << 16), __uint_as_float(hi & 0xFFFF0000u)}; }
                        const f32x4 v = r + acc[ai][bj][m][n] * sc;
                        *(GAS unsigned long long*)(out + o2) = (unsigned long long)cvt_pk_bf16(v[0], v[1]) | ((unsigned long long)cvt_pk_bf16(v[2], v[3]) << 32); } }
    }
};
struct EpiMoeDown {
    static constexpr bool PERM = false;
    bf16_t* h; bf16_t* y1; const unsigned* list_tok; const float* list_w; int cnt[NE]; float sc;
    __device__ __forceinline__ void operator()(const f32x4 (&acc)[2][2][4][2], const Unit& u, int wr, int wc, int fr, int fq) const {
        int cv = 0;
#pragma unroll
        for (int k = 0; k < NE; ++k) cv = (k == u.e) ? cnt[k] : cv;
        const int col0 = u.pn * BM + wc * 32 + 4 * fq;
#pragma unroll
        for (int ai = 0; ai < 2; ++ai)
#pragma unroll
            for (int m = 0; m < 4; ++m) { const int l = u.r0 + ai * HALF + wr * 64 + m * 16 + fr;
                if (l < cv) {
                    const unsigned ent = __hip_atomic_load((const GAS unsigned*)list_tok + (size_t)u.e * LIST_CAP + l, __ATOMIC_RELAXED, __HIP_MEMORY_SCOPE_AGENT);
                    const float w = sc * __uint_as_float(__hip_atomic_load((const GAS unsigned*)list_w + (size_t)u.e * LIST_CAP + l, __ATOMIC_RELAXED, __HIP_MEMORY_SCOPE_AGENT));
                    const size_t off = (size_t)(ent & 0xFFFFFu) * D + col0;
                    if ((ent >> 20) == 0u) {
#pragma unroll
                        for (int bj = 0; bj < 2; ++bj)
#pragma unroll
                            for (int n = 0; n < 2; ++n) { GAS unsigned long long* p = (GAS unsigned long long*)(h + off + bj * HALF + n * 16); const unsigned long long rw = *p; const unsigned lo = (unsigned)rw, hi = (unsigned)(rw >> 32);
                                const f32x4 v = (f32x4){__uint_as_float(lo << 16), __uint_as_float(lo & 0xFFFF0000u), __uint_as_float(hi << 16), __uint_as_float(hi & 0xFFFF0000u)} + acc[ai][bj][m][n] * w;
                                *p = (unsigned long long)cvt_pk_bf16(v[0], v[1]) | ((unsigned long long)cvt_pk_bf16(v[2], v[3]) << 32); }
                    } else {
#pragma unroll
                        for (int bj = 0; bj < 2; ++bj)
#pragma unroll
                            for (int n = 0; n < 2; ++n) { const f32x4 v = acc[ai][bj][m][n] * w; unsigned long long pk = (unsigned long long)cvt_pk_bf16(v[0], v[1]) | ((unsigned long long)cvt_pk_bf16(v[2], v[3]) << 32);
                                *(GAS unsigned long long*)(y1 + off + bj * HALF + n * 16) = pk; }
                    }
                } }
    }
};

template <class Epi, class Sched, bool F8 = false>
__device__ __forceinline__ void gemm_phase(PG8_LAS unsigned char* lds, int xoff, const Gemm g, const Sched& S, const Epi& E) {
    int tid_ = threadIdx.x;
    asm volatile("" : "+v"(tid_));
    const int tid = tid_, wid = __builtin_amdgcn_readfirstlane(tid >> 6), lane = tid & 63, wr = wid >> 2, wc = wid & 3, fr = lane & 15, fq = lane >> 4;
    const int RB = g.rowb, nt = RB / 128;
    unsigned voffB[2];
#pragma unroll
    for (int i = 0; i < 2; ++i) { int R, C; stage_rc(tid * 16 + i * 8192, R, C); const int Rb = Epi::PERM ? ((R & ~31) + perm32(R & 31)) : R;
        voffB[i] = (unsigned)(Rb * RB + C * 2); }
    const size_t kstep = (size_t)(BK * 2);
    const size_t hstep = (size_t)HALF * RB;
    const size_t tstep = 2 * hstep;
    const unsigned ldsw = (unsigned)wid * 1024u;
    const int aoff = F8 ? lds_byte(wr * 64 + fr, fq * 16) : lds_byte(wr * 64 + fr, fq * 8), boff = F8 ? lds_byte(wc * 32 + fr, fq * 16) : lds_byte(wc * 32 + fr, fq * 8);
#define PG8_SA(b, h) (((b) * 2 + (h)) * HTB)
#define PG8_SB(b, h) ((4 + (b) * 2 + (h)) * HTB)
#define PG8_STAGE(bufoff, gbase, v0, v1) do { \
        __builtin_amdgcn_global_load_lds((const GAS unsigned*)((const char*)(gbase) + (v0)), (PG8_LAS unsigned*)(lds + (bufoff) + ldsw), 16, 0, 0); \
        __builtin_amdgcn_global_load_lds((const GAS unsigned*)((const char*)(gbase) + (v1)), (PG8_LAS unsigned*)(lds + (bufoff) + ldsw + 8192), 16, 0, 0); } while (0)
#define PG8_STAGEB(bufoff, gbase) PG8_STAGE(bufoff, gbase, voffB[0], voffB[1])
#define PG8_LDA(dst, b, h) do { if constexpr (F8) { _Pragma("unroll") for (int m = 0; m < 4; ++m) { dst##8[m].lo = *(const PG8_LAS i32x4*)(lds + PG8_SA(b, h) + aoff + m * 2048); dst##8[m].hi = *(const PG8_LAS i32x4*)(lds + PG8_SA(b, h) + aoff + m * 2048 + 16); } } \
        else { _Pragma("unroll") for (int m = 0; m < 4; ++m) _Pragma("unroll") for (int k = 0; k < 2; ++k) dst[m][k] = *(const PG8_LAS bf16x8*)(lds + PG8_SA(b, h) + aoff + m * 2048 + k * 1024); } } while (0)
#define PG8_LDB(dst, b, h) do { if constexpr (F8) { _Pragma("unroll") for (int n = 0; n < 2; ++n) { dst##8[n].lo = *(const PG8_LAS i32x4*)(lds + PG8_SB(b, h) + boff + n * 2048); dst##8[n].hi = *(const PG8_LAS i32x4*)(lds + PG8_SB(b, h) + boff + n * 2048 + 16); } } \
        else { _Pragma("unroll") for (int n = 0; n < 2; ++n) _Pragma("unroll") for (int k = 0; k < 2; ++k) dst[n][k] = *(const PG8_LAS bf16x8*)(lds + PG8_SB(b, h) + boff + n * 2048 + k * 1024); } } while (0)
#define PG8_MMA(ai, bj, At, Bt) do { __builtin_amdgcn_s_setprio(1); _Pragma("unroll") for (int m = 0; m < 4; ++m) _Pragma("unroll") for (int n = 0; n < 2; ++n) { \
        if constexpr (F8) acc[ai][bj][m][n] = __builtin_amdgcn_mfma_scale_f32_16x16x128_f8f6f4(Bt##8[n], At##8[m], acc[ai][bj][m][n], 0, 0, 0, 0x7F7F7F7F, 0, 0x7F7F7F7F); \
        else { _Pragma("unroll") for (int k = 0; k < 2; ++k) acc[ai][bj][m][n] = __builtin_amdgcn_mfma_f32_16x16x32_bf16(Bt[n][k], At[m][k], acc[ai][bj][m][n], 0, 0, 0); } } __builtin_amdgcn_s_setprio(0); } while (0)
#define PG8_WAIT_V(n) asm volatile("s_waitcnt vmcnt(" #n ")" ::: "memory")
#define PG8_WAIT_L(n) asm volatile("s_waitcnt lgkmcnt(" #n ")" ::: "memory")
#define PG8_BAR __builtin_amdgcn_s_barrier()
#define PG8_SCHED __builtin_amdgcn_sched_barrier(0)
#define PG8_AOFFS(U, o00, o01, o10, o11) do { int R0_, C0_, R1_, C1_; stage_rc(tid * 16, R0_, C0_); stage_rc(tid * 16 + 8192, R1_, C1_);     \
        o00 = S.arow(U, R0_) * (unsigned)RB + (unsigned)C0_ * 2u; o01 = S.arow(U, R1_) * (unsigned)RB + (unsigned)C1_ * 2u; \
        o10 = S.arow(U, HALF + R0_) * (unsigned)RB + (unsigned)C0_ * 2u; o11 = S.arow(U, HALF + R1_) * (unsigned)RB + (unsigned)C1_ * 2u; } while (0)
    Unit cur, nxt; int ui = 0;
    if (!S.next(0, cur)) return;
    f32x4 acc[2][2][4][2];
#pragma unroll
    for (int a = 0; a < 2; ++a)
#pragma unroll
        for (int b = 0; b < 2; ++b)
#pragma unroll
            for (int m = 0; m < 4; ++m)
#pragma unroll
                for (int n = 0; n < 2; ++n) acc[a][b][m][n] = (f32x4){0.f, 0.f, 0.f, 0.f};
    bf16x8 At[4][2], B0[2][2], B1[2][2];
    i32x8 At8[4], B08[2], B18[2];
    unsigned c00, c01, c10, c11;
    PG8_LAS u32x4* const xslot = (PG8_LAS u32x4*)(lds + xoff) + tid;
    PG8_AOFFS(cur, c00, c01, c10, c11);
    const char* const gA = (const char*)g.A;
    const char* cB = (const char*)g.Bt + (size_t)cur.e * g.bstride + (size_t)cur.pn * tstep;
    PG8_STAGEB(PG8_SB(0, 0), cB); PG8_STAGEB(PG8_SB(0, 1), cB + hstep); PG8_STAGE(PG8_SA(0, 0), gA, c00, c01); PG8_STAGE(PG8_SA(0, 1), gA, c10, c11);
    if (wr == 1) PG8_BAR;
    PG8_WAIT_V(2); PG8_BAR;
    PG8_STAGEB(PG8_SB(1, 0), cB + kstep); PG8_STAGE(PG8_SA(1, 0), gA + kstep, c00, c01); PG8_STAGEB(PG8_SB(1, 1), cB + hstep + kstep);
    PG8_WAIT_V(6); PG8_BAR;
    for (;;) {
        const bool has_next = S.next(ui + 1, nxt);
        const char* nB_ = has_next ? (const char*)g.Bt + (size_t)nxt.e * g.bstride + (size_t)nxt.pn * tstep : cB;
        const char* nB = nB_;
        if (has_next) { unsigned n00, n01, n10, n11; PG8_AOFFS(nxt, n00, n01, n10, n11); *xslot = (u32x4){n00, n01, n10, n11}; }
#pragma unroll 1
        for (int t = 0; t < nt; t += 2) {
            const bool last = (t == nt - 2);
            const char* a1 = gA + (size_t)(t + 1) * kstep;
            const char* a2 = last ? gA : gA + (size_t)(t + 2) * kstep; const char* b2 = last ? nB : cB + (size_t)(t + 2) * kstep;
            const char* a3 = a2 + kstep; const char* b3 = b2 + kstep;
            PG8_LDB(B0, 0, 0); PG8_LDB(B1, 0, 1); PG8_SCHED; PG8_LDA(At, 0, 0); PG8_STAGE(PG8_SA(1, 1), a1, c10, c11);
            if (last && has_next) { const u32x4 nx = *xslot; c00 = nx.x; c01 = nx.y; c10 = nx.z; c11 = nx.w; }
            PG8_WAIT_V(8); PG8_WAIT_L(0); PG8_BAR; PG8_MMA(0, 0, At, B0); PG8_MMA(0, 1, At, B1); PG8_BAR; PG8_SCHED;
            PG8_LDA(At, 0, 1); PG8_STAGEB(PG8_SB(0, 0), b2); PG8_STAGEB(PG8_SB(0, 1), b2 + hstep); PG8_STAGE(PG8_SA(0, 0), a2, c00, c01);
            PG8_WAIT_V(8); PG8_WAIT_L(0); PG8_BAR; PG8_MMA(1, 0, At, B0); PG8_MMA(1, 1, At, B1); PG8_BAR; PG8_SCHED;
            PG8_LDB(B0, 1, 0); PG8_LDB(B1, 1, 1); PG8_SCHED; PG8_LDA(At, 1, 0); PG8_STAGE(PG8_SA(0, 1), a2, c10, c11);
            PG8_WAIT_V(8); PG8_WAIT_L(0); PG8_BAR; PG8_MMA(0, 0, At, B0); PG8_MMA(0, 1, At, B1); PG8_BAR; PG8_SCHED;
            PG8_LDA(At, 1, 1); PG8_STAGEB(PG8_SB(1, 0), b3); PG8_STAGEB(PG8_SB(1, 1), b3 + hstep); PG8_STAGE(PG8_SA(1, 0), a3, c00, c01);
            PG8_WAIT_V(8); PG8_WAIT_L(0); PG8_BAR; PG8_MMA(1, 0, At, B0); PG8_MMA(1, 1, At, B1); PG8_BAR; PG8_SCHED;
        }
        if (wr == 0) PG8_BAR;
        E(acc, cur, wr, wc, fr, fq);
        if (!has_next) break;
#pragma unroll
        for (int a = 0; a < 2; ++a)
#pragma unroll
            for (int b = 0; b < 2; ++b)
#pragma unroll
                for (int m = 0; m < 4; ++m)
#pragma unroll
                    for (int n = 0; n < 2; ++n) acc[a][b][m][n] = (f32x4){0.f, 0.f, 0.f, 0.f};
        cur = nxt; cB = nB; ++ui;
        if (wr == 1) PG8_BAR;
    }
    PG8_WAIT_V(0);
    PG8_BAR;
#undef PG8_SA
#undef PG8_SB
#undef PG8_STAGE
#undef PG8_STAGEB
#undef PG8_LDA
#undef PG8_LDB
#undef PG8_MMA
#undef PG8_WAIT_V
#undef PG8_WAIT_L
#undef PG8_BAR
#undef PG8_SCHED
#undef PG8_AOFFS
}
}

namespace att {
typedef unsigned short bf16_t;
typedef short bf16x8 __attribute__((ext_vector_type(8)));
typedef short s16x4 __attribute__((ext_vector_type(4)));
typedef float f32x16 __attribute__((ext_vector_type(16)));
typedef float f32x4 __attribute__((ext_vector_type(4)));
typedef unsigned u32x4 __attribute__((ext_vector_type(4)));
constexpr int PITCH = 1024;
constexpr float LOG2E = 1.4426950408889634f;
__device__ __forceinline__ int crow(int r, int hi) { return (r & 3) + 8 * (r >> 2) + 4 * hi; }
typedef float f32x2_t __attribute__((ext_vector_type(2))); typedef __bf16 bf16x2_t __attribute__((ext_vector_type(2)));
__device__ __forceinline__ unsigned cvtpk(float lo, float hi) { f32x2_t v = {lo, hi}; bf16x2_t b = __builtin_convertvector(v, bf16x2_t); return __builtin_bit_cast(unsigned, b); }
__device__ __forceinline__ float bf2f(short s) { return __uint_as_float(((unsigned)(unsigned short)s) << 16); }
typedef short v4i16_t __attribute__((ext_vector_type(4)));
__device__ __forceinline__ s16x4 vtr(const LAS unsigned char* p) { return __builtin_bit_cast(s16x4, __builtin_amdgcn_ds_read_tr16_b64_v4i16((LAS v4i16_t*)p)); }
__device__ __forceinline__ float max3f(float a, float b, float c) { float r; asm("v_max3_f32 %0, %1, %2, %3" : "=v"(r) : "v"(a), "v"(b), "v"(c)); return r; }
__device__ __forceinline__ float halves_max(float m) { auto rr = __builtin_amdgcn_permlane32_swap(__float_as_uint(m), __float_as_uint(m), false, false); return fmaxf(__uint_as_float(rr[0]), __uint_as_float(rr[1])); }
__device__ __forceinline__ float halves_sum(float m) { auto rr = __builtin_amdgcn_permlane32_swap(__float_as_uint(m), __float_as_uint(m), false, false); return __uint_as_float(rr[0]) + __uint_as_float(rr[1]); }
#define ATT_PRIO(x) do { if (wid >= 4) __builtin_amdgcn_s_setprio(1 + (x)); else __builtin_amdgcn_s_setprio(x); } while (0)
#define ATT_BAR() asm volatile("s_waitcnt vmcnt(0) lgkmcnt(0)\n\ts_barrier" ::: "memory")
typedef unsigned u32x2 __attribute__((ext_vector_type(2)));
#define ATT_RD128(d, a, off) asm volatile("ds_read_b128 %0, %1 offset:%2" : "=v"(d) : "v"(a), "n"(off))
#define ATT_RDTR(d, a, off) asm volatile("ds_read_b64_tr_b16 %0, %1 offset:%2" : "=v"(d) : "v"(a), "n"(off))
#define ATT_WAIT2(n, x, y) asm volatile("s_waitcnt lgkmcnt(" #n ")" : "+v"(x), "+v"(y))

struct Args { const bf16_t* Q; const bf16_t* K; const bf16_t* V; bf16_t* O; const float* kmean; const float* kmax2; const float* subln; float lam_full; float out_scale; int abl; };
#ifndef ATT_ABLATE
#define ATT_ABLATE 0
#endif
#if ATT_ABLATE
#define ABL(bit) ((((ATT_ABLATE) >> (bit)) & 1) && abl_)
#else
#define ABL(bit) 0
#endif

template <int MODE>
__device__ __forceinline__ void attn_unit(LAS unsigned char* lds, const Args& A, int b, int h, int qblk) {
    constexpr int DVB = MODE == 0 ? 4 : 2;
    constexpr int NCH = MODE == 0 ? 16 : 8;
    constexpr int KBY = NCH * 1024, VBY = DVB * 4096, SLOT = KBY + VBY;
    constexpr int QR = MODE == 0 ? 128 : 256;
    constexpr int PPW = MODE == 0 ? 2 : 1;
    int tid_ = threadIdx.x; asm volatile("" : "+v"(tid_));
    const int tid = tid_, lane = tid & 63, r32 = lane & 31, hi = lane >> 5;
    const int wid = __builtin_amdgcn_readfirstlane(tid >> 6);
    const int comp = MODE == 0 ? (wid >> 2) : 0, wq = MODE == 0 ? (wid & 3) : wid;
    const int q0 = qblk * QR; const long rowbase = (long)b * SEQ;
    const int hcol = MODE == 0 ? h * 128 : h * 64;
    const int qrel0 = wq * 32;
    const float slope2 = __builtin_amdgcn_exp2f(MODE == 0 ? -(float)(h + 1) : -0.5f * (float)(h + 1)) * LOG2E;
    const int NT = MODE == 0 ? 2 * qblk + 2 : 4 + 4 * qblk;
#define ATT_KBASE_(t) (MODE == 0 ? 64 * (t) : ((t) < 4 ? q0 + 64 * (t) : 64 * ((t) - 4)))
#define ATT_KBASE(t) ATT_KBASE_(t)
    LAS float* wsf = (LAS float*)(lds + 65536) + wid * 64;
    const bf16_t* Kb = A.K + rowbase * PITCH + hcol;
    const bf16_t* Vb = A.V + rowbase * PITCH + hcol;
#define ATT_ISSUE_K(tt, slot) do { const int kb_ = ATT_KBASE(tt); \
        _Pragma("unroll") for (int i_ = 0; i_ < PPW; ++i_) { const int p_ = wid + 8 * i_; \
            __builtin_amdgcn_global_load_lds((const GAS unsigned*)(Kb + (size_t)(kb_ + lane) * PITCH + p_ * 8), (LAS unsigned*)(lds + (slot) * SLOT + p_ * 1024), 16, 0, 0); } } while (0)
#define ATT_ISSUE_V(tt, slot) do { const int kb_ = ATT_KBASE(tt); \
        _Pragma("unroll") for (int i_ = 0; i_ < PPW; ++i_) { const int p_ = wid + 8 * i_; \
            __builtin_amdgcn_global_load_lds((const GAS unsigned*)(Vb + (size_t)(kb_ + 16 * (p_ & 3) + (lane >> 2)) * PITCH + (p_ >> 2) * 32 + (lane & 3) * 8), (LAS unsigned*)(lds + (slot) * SLOT + KBY + p_ * 1024), 16, 0, 0); } } while (0)
    asm volatile("s_waitcnt lgkmcnt(0)\n\ts_barrier" ::: "memory");
    bf16x8 qr[4];
    { const bf16_t* Qw = A.Q + (rowbase + q0 + qrel0 + r32) * PITCH + hcol + comp * 64 + hi * 8;
#pragma unroll
      for (int d0 = 0; d0 < 4; ++d0) qr[d0] = *(const GAS bf16x8*)(Qw + d0 * 16); }
    const int tt_l = MODE == 0 ? (lane < 2 ? 2 * qblk + lane : lane - 2) : lane;
    const int kbase_l = (lane < NT) ? ATT_KBASE_(tt_l) : 0;
    const bool past_l = lane < NT && kbase_l + 64 <= q0;
    float k2a = 0.f, k2b = 0.f;
    { const int nblk = (kbase_l >> 8) & 15;
        if constexpr (MODE == 0) { k2a = ((const GAS float*)A.kmax2)[(size_t)(b * 16 + h * 2) * 16 + nblk]; k2b = ((const GAS float*)A.kmax2)[(size_t)(b * 16 + h * 2 + 1) * 16 + nblk]; }
        else k2a = ((const GAS float*)A.kmax2)[(size_t)(b * 16 + h) * 16 + nblk]; }
    float kmv0 = 0.f, kmv1 = 0.f;
    if constexpr (MODE == 1) { kmv0 = ((const GAS float*)A.kmean)[(size_t)(b * 16 + h) * 1024 + tid]; kmv1 = ((const GAS float*)A.kmean)[(size_t)(b * 16 + h) * 1024 + 512 + tid]; }
    const int t0 = MODE == 0 ? 2 * qblk : 0, t1 = t0 + 1;
    ATT_ISSUE_K(t0, 0); ATT_ISSUE_V(t0, 0); ATT_ISSUE_K(t1, 1);
    LAS int* live = (LAS int*)(lds + 71680); LAS float* qnx = (LAS float*)(lds + 71680 + 272);
    LAS float* km = (LAS float*)(lds + 67584);
    { float q2 = 0.f;
#pragma unroll
      for (int d0 = 0; d0 < 4; ++d0)
#pragma unroll
        for (int j = 0; j < 8; ++j) { const float v = bf2f(qr[d0][j]); q2 += v * v; }
      q2 = halves_sum(q2);
      q2 = fmaxf(q2, __shfl_xor(q2, 1)); q2 = fmaxf(q2, __shfl_xor(q2, 2)); q2 = fmaxf(q2, __shfl_xor(q2, 4)); q2 = fmaxf(q2, __shfl_xor(q2, 8)); q2 = fmaxf(q2, __shfl_xor(q2, 16));
      if (lane == 0) qnx[wid] = q2; }
    if constexpr (MODE == 1) { km[tid] = kmv0; km[tid + 512] = kmv1; }
    ATT_BAR();
    if (wid == 0) {
        bool alive = lane < NT;
        if (past_l) { float bound;
            if constexpr (MODE == 0) { const float qa = fmaxf(fmaxf(qnx[0], qnx[1]), fmaxf(qnx[2], qnx[3])), qb = fmaxf(fmaxf(qnx[4], qnx[5]), fmaxf(qnx[6], qnx[7]));
                bound = fmaxf(sqrtf(qa) * sqrtf(k2a), sqrtf(qb) * sqrtf(k2b));
            } else { float qm = qnx[0];
#pragma unroll
                for (int w = 1; w < 8; ++w) qm = fmaxf(qm, qnx[w]);
                bound = sqrtf(qm) * sqrtf(k2a); }
            alive = !(bound * 1.001f + 1.0f + slope2 * (float)(kbase_l + 63 - q0) < -152.0f);
        }
        const unsigned long long am = __ballot(alive);
        if (alive) live[__popcll(am & ((1ull << lane) - 1ull))] = tt_l;
        if (lane == 0) live[64] = __popcll(am);
    }
    unsigned sel = 0u;
    if constexpr (MODE == 1) {
        float g[16];
#pragma unroll
        for (int n = 0; n < 16; ++n) { float s = 0.f;
            if (n < qblk) {
#pragma unroll
                for (int d0 = 0; d0 < 4; ++d0) { const f32x4 ka = *(const LAS f32x4*)(km + n * 64 + d0 * 16 + hi * 8), kb2 = *(const LAS f32x4*)(km + n * 64 + d0 * 16 + hi * 8 + 4);
                    s += bf2f(qr[d0][0]) * ka[0] + bf2f(qr[d0][1]) * ka[1] + bf2f(qr[d0][2]) * ka[2] + bf2f(qr[d0][3]) * ka[3]
                       + bf2f(qr[d0][4]) * kb2[0] + bf2f(qr[d0][5]) * kb2[1] + bf2f(qr[d0][6]) * kb2[2] + bf2f(qr[d0][7]) * kb2[3]; }
                s = halves_sum(s); }
            g[n] = s; }
        const int nsel = qblk < 3 ? qblk : 3;
#pragma unroll
        for (int k = 0; k < 3; ++k) if (k < nsel) { float best = -INFINITY; int bi = 0; bool found = false;
#pragma unroll
            for (int n = 0; n < 16; ++n) if (n < qblk) { const bool free_ = ((sel >> n) & 1u) == 0u; if (free_ && (!found || g[n] > best)) { best = g[n]; bi = n; found = true; } }
            sel |= 1u << bi; }
    }
    ATT_BAR();
    const int NTL = __builtin_amdgcn_readfirstlane(live[64]);
#define ATT_ISSUE(t, slot) do { const int kb_ = ATT_KBASE(t); \
        _Pragma("unroll") for (int i_ = 0; i_ < PPW; ++i_) { const int p_ = wid + 8 * i_; \
            __builtin_amdgcn_global_load_lds((const GAS unsigned*)(Kb + (size_t)(kb_ + lane) * PITCH + p_ * 8), (LAS unsigned*)(lds + (slot) * SLOT + p_ * 1024), 16, 0, 0); \
            __builtin_amdgcn_global_load_lds((const GAS unsigned*)(Vb + (size_t)(kb_ + 16 * (p_ & 3) + (lane >> 2)) * PITCH + (p_ >> 2) * 32 + (lane & 3) * 8), (LAS unsigned*)(lds + (slot) * SLOT + KBY + p_ * 1024), 16, 0, 0); } } while (0)
    constexpr float THR = 8.0f;
    float mref = 0.f, l = 0.f; f32x16 o[DVB];
#pragma unroll
    for (int d0 = 0; d0 < DVB; ++d0) o[d0] = f32x16{};
#define ATT_CLASS(tt, SK, NM, SB) do { const int kb_ = ATT_KBASE(tt), kr_ = kb_ - q0; const bool dg_ = kb_ >= q0; SK = dg_ && (kr_ > qrel0 + 31); NM = dg_ && (kr_ + 63 > qrel0); SB = true; \
        if constexpr (MODE == 1) { if ((tt) >= 4) { SB = ((sel >> (((tt) - 4) >> 2)) & 1u) != 0u; if (!__any(SB)) SK = true; } } } while (0)
#define ATT_QK(P0, P1, tt, slot, SB) do { const int kr_ = ATT_KBASE(tt) - q0; float off0_ = slope2 * (float)(kr_ + 4 * hi) - mref; if (!(SB)) off0_ = -INFINITY; const float off1_ = off0_ + 32.0f * slope2; \
        const unsigned ka_ = (unsigned)(size_t)(lds + (slot) * SLOT + comp * 8192 + hi * 1024 + r32 * 16); u32x4 kx_[4], ky_[4]; \
        ATT_RD128(kx_[0], ka_, 0); ATT_RD128(ky_[0], ka_, 512); ATT_RD128(kx_[1], ka_, 2048); ATT_RD128(ky_[1], ka_, 2560); \
        _Pragma("unroll") for (int r = 0; r < 16; ++r) { const float cbr = slope2 * (float)((r & 3) + 8 * (r >> 2)); P0[r] = cbr + off0_; P1[r] = cbr + off1_; } \
        ATT_PRIO(1); ATT_WAIT2(2, kx_[0], ky_[0]); P0 = __builtin_amdgcn_mfma_f32_32x32x16_bf16(__builtin_bit_cast(bf16x8, kx_[0]), qr[0], P0, 0, 0, 0); P1 = __builtin_amdgcn_mfma_f32_32x32x16_bf16(__builtin_bit_cast(bf16x8, ky_[0]), qr[0], P1, 0, 0, 0); \
        ATT_RD128(kx_[2], ka_, 4096); ATT_RD128(ky_[2], ka_, 4608); \
        ATT_WAIT2(2, kx_[1], ky_[1]); P0 = __builtin_amdgcn_mfma_f32_32x32x16_bf16(__builtin_bit_cast(bf16x8, kx_[1]), qr[1], P0, 0, 0, 0); P1 = __builtin_amdgcn_mfma_f32_32x32x16_bf16(__builtin_bit_cast(bf16x8, ky_[1]), qr[1], P1, 0, 0, 0); \
        ATT_RD128(kx_[3], ka_, 6144); ATT_RD128(ky_[3], ka_, 6656); \
        ATT_WAIT2(2, kx_[2], ky_[2]); P0 = __builtin_amdgcn_mfma_f32_32x32x16_bf16(__builtin_bit_cast(bf16x8, kx_[2]), qr[2], P0, 0, 0, 0); P1 = __builtin_amdgcn_mfma_f32_32x32x16_bf16(__builtin_bit_cast(bf16x8, ky_[2]), qr[2], P1, 0, 0, 0); \
        ATT_WAIT2(0, kx_[3], ky_[3]); P0 = __builtin_amdgcn_mfma_f32_32x32x16_bf16(__builtin_bit_cast(bf16x8, kx_[3]), qr[3], P0, 0, 0, 0); P1 = __builtin_amdgcn_mfma_f32_32x32x16_bf16(__builtin_bit_cast(bf16x8, ky_[3]), qr[3], P1, 0, 0, 0); ATT_PRIO(0); } while (0)
    f32x16 p0, p1, n0, n1;
    const int abl_ = __builtin_amdgcn_readfirstlane(A.abl); (void)abl_;
    int t = t0, tn = t1;
    bool skipC, maskC, selC, skipN = true, maskN = false, selN = true;
    ATT_CLASS(t, skipC, maskC, selC);
    if (!skipC) ATT_QK(p0, p1, t, 0, selC);
    const int NTLX = ABL(4) ? 1 : NTL;
    ATT_PRIO(0);
    for (int it = 0; it < NTLX; ++it) {
        ATT_BAR();
        const int tnn = (it + 2 < NTL) ? __builtin_amdgcn_readfirstlane(live[it + 2]) : 0;
        if (it + 2 < NTL && !ABL(0)) ATT_ISSUE_K(tnn, it & 1);
        if (it + 1 < NTL) { if (!ABL(0)) ATT_ISSUE_V(tn, (it + 1) & 1); ATT_CLASS(tn, skipN, maskN, selN); if (!skipN) { if (!ABL(2)) ATT_QK(n0, n1, tn, (it + 1) & 1, selN); else { n0 = f32x16{} - 1.0f; n1 = n0; } } } else skipN = true;
        if (!skipC) {
            const int krel = ATT_KBASE(t) - q0;
            const unsigned va_ = (unsigned)(size_t)(lds + (it & 1) * SLOT + KBY + ((lane >> 4) & 1) * 32 + (lane & 3) * 8 + (4 * hi + ((lane & 15) >> 2)) * 64);
            u32x2 vl_[4], vh_[4];
            if (!ABL(1)) { ATT_RDTR(vl_[0], va_, 0); ATT_RDTR(vh_[0], va_, 512); ATT_RDTR(vl_[1], va_, 1024); ATT_RDTR(vh_[1], va_, 1536);
            ATT_RDTR(vl_[2], va_, 2048); ATT_RDTR(vh_[2], va_, 2560); ATT_RDTR(vl_[3], va_, 3072); ATT_RDTR(vh_[3], va_, 3584); }
            if (maskC) { const int qrel = qrel0 + r32;
#pragma unroll
                for (int r = 0; r < 16; ++r) { const int kv = krel + crow(r, hi); if (kv > qrel) p0[r] = -INFINITY; if (kv + 32 > qrel) p1[r] = -INFINITY; } }
            float rm;
            { float a_ = max3f(p0[0], p0[1], p1[0]), b_ = max3f(p0[2], p0[3], p1[1]); a_ = max3f(a_, p1[2], p1[3]);
#pragma unroll
              for (int r = 4; r < 16; r += 4) { a_ = max3f(a_, p0[r], p0[r + 1]); b_ = max3f(b_, p0[r + 2], p0[r + 3]); a_ = max3f(a_, p1[r], p1[r + 1]); b_ = max3f(b_, p1[r + 2], p1[r + 3]); }
              rm = halves_max(fmaxf(a_, b_)); }
            if (__any(rm > THR)) {
                const float dl = fmaxf(rm, 0.f); mref += dl; const float alpha = __builtin_amdgcn_exp2f(-dl);
#pragma unroll
                for (int r = 0; r < 16; ++r) { p0[r] -= dl; p1[r] -= dl; }
                if (!skipN) {
#pragma unroll
                    for (int r = 0; r < 16; ++r) { n0[r] -= dl; n1[r] -= dl; } }
                l *= alpha;
                if (hi == 0) wsf[r32] = alpha;
                asm volatile("s_waitcnt lgkmcnt(0)" ::: "memory");
#pragma unroll
                for (int gq = 0; gq < 4; ++gq) { const f32x4 f = *(const LAS f32x4*)(wsf + 8 * gq + 4 * hi);
#pragma unroll
                    for (int d0 = 0; d0 < DVB; ++d0) { o[d0][4 * gq + 0] *= f[0]; o[d0][4 * gq + 1] *= f[1]; o[d0][4 * gq + 2] *= f[2]; o[d0][4 * gq + 3] *= f[3]; } }
            }
            float sacc = 0.f;
            if (!ABL(3)) {
#pragma unroll
            for (int r = 0; r < 16; ++r) { p0[r] = __builtin_amdgcn_exp2f(p0[r]); p1[r] = __builtin_amdgcn_exp2f(p1[r]); sacc += p0[r] + p1[r]; } }
            l += sacc;
            u32x4 pw[4];
            pw[0] = (u32x4){cvtpk(p0[0], p0[1]), cvtpk(p0[2], p0[3]), cvtpk(p0[4], p0[5]), cvtpk(p0[6], p0[7])};
            pw[1] = (u32x4){cvtpk(p0[8], p0[9]), cvtpk(p0[10], p0[11]), cvtpk(p0[12], p0[13]), cvtpk(p0[14], p0[15])};
            pw[2] = (u32x4){cvtpk(p1[0], p1[1]), cvtpk(p1[2], p1[3]), cvtpk(p1[4], p1[5]), cvtpk(p1[6], p1[7])};
            pw[3] = (u32x4){cvtpk(p1[8], p1[9]), cvtpk(p1[10], p1[11]), cvtpk(p1[12], p1[13]), cvtpk(p1[14], p1[15])};
            if (!ABL(1))
#pragma unroll
            for (int i = 0; i < 4 * DVB; ++i) { constexpr int NM = 4 * DVB; const int s_ = i & 3; if (i == 0) ATT_PRIO(1);
                if (i + 3 < NM) ATT_WAIT2(6, vl_[s_], vh_[s_]); else if (i + 3 == NM) ATT_WAIT2(4, vl_[s_], vh_[s_]); else if (i + 2 == NM) ATT_WAIT2(2, vl_[s_], vh_[s_]); else ATT_WAIT2(0, vl_[s_], vh_[s_]);
                const u32x4 vf = (u32x4){vl_[s_][0], vl_[s_][1], vh_[s_][0], vh_[s_][1]};
                o[i >> 2] = __builtin_amdgcn_mfma_f32_32x32x16_bf16(__builtin_bit_cast(bf16x8, pw[i & 3]), __builtin_bit_cast(bf16x8, vf), o[i >> 2], 0, 0, 0);
                if (i + 4 < NM) { ATT_RDTR(vl_[s_], va_, (i + 4) * 1024); ATT_RDTR(vh_[s_], va_, (i + 4) * 1024 + 512); } if (i == NM - 1) ATT_PRIO(0); }
        }
        p0 = n0; p1 = n1; skipC = skipN; maskC = maskN; selC = selN; t = tn; tn = tnn;
    }
#undef ATT_ISSUE_K
#undef ATT_ISSUE_V
#undef ATT_CLASS
#undef ATT_QK
    __builtin_amdgcn_s_setprio(0);
    if (ABL(5)) return;
    float sg[DVB];
    if constexpr (MODE == 0) {
#pragma unroll
        for (int d0 = 0; d0 < DVB; ++d0) sg[d0] = ((const GAS float*)A.subln)[d0 * 32 + r32]; }
    l = halves_sum(l);
    if (hi == 0) wsf[32 + r32] = l;
    asm volatile("s_waitcnt lgkmcnt(0)" ::: "memory");
    float rli[16];
#pragma unroll
    for (int gq = 0; gq < 4; ++gq) { const f32x4 f = *(const LAS f32x4*)(wsf + 32 + 8 * gq + 4 * hi); rli[4 * gq + 0] = 1.0f / f[0]; rli[4 * gq + 1] = 1.0f / f[1]; rli[4 * gq + 2] = 1.0f / f[2]; rli[4 * gq + 3] = 1.0f / f[3]; }
    if constexpr (MODE == 1) {
        GAS bf16_t* Ow = (GAS bf16_t*)(A.O + (rowbase + q0 + qrel0) * PITCH + hcol);
#pragma unroll
        for (int r = 0; r < 16; ++r)
#pragma unroll
            for (int d0 = 0; d0 < DVB; ++d0) Ow[(size_t)crow(r, hi) * PITCH + d0 * 32 + r32] = (bf16_t)(cvtpk(o[d0][r] * rli[r], 0.f) & 0xFFFFu);
    } else {
        ATT_BAR();
        LAS float* X = (LAS float*)lds + wq * 4096;
        if (comp == 1) {
#pragma unroll
            for (int d0 = 0; d0 < DVB; ++d0)
#pragma unroll
                for (int r = 0; r < 16; ++r) X[(d0 * 16 + r) * 64 + lane] = o[d0][r] * rli[r];
        }
        ATT_BAR();
        if (comp == 0) {
#pragma unroll
            for (int d0 = 0; d0 < DVB; ++d0) sg[d0] *= A.out_scale;
            GAS bf16_t* Ow = (GAS bf16_t*)(A.O + (rowbase + q0 + qrel0) * PITCH + hcol);
#pragma unroll
            for (int r = 0; r < 16; ++r) { float dv[DVB]; float ss = 0.f;
#pragma unroll
                for (int d0 = 0; d0 < DVB; ++d0) { dv[d0] = o[d0][r] * rli[r] - A.lam_full * X[(d0 * 16 + r) * 64 + lane]; ss += dv[d0] * dv[d0]; }
                ss += __int_as_float(__builtin_amdgcn_update_dpp(0, __float_as_int(ss), 0xB1, 0xF, 0xF, true)); ss += __int_as_float(__builtin_amdgcn_update_dpp(0, __float_as_int(ss), 0x4E, 0xF, 0xF, true));
                ss += __int_as_float(__builtin_amdgcn_update_dpp(0, __float_as_int(ss), 0x141, 0xF, 0xF, true)); ss += __int_as_float(__builtin_amdgcn_update_dpp(0, __float_as_int(ss), 0x140, 0xF, 0xF, true));
                ss += __int_as_float(__builtin_amdgcn_ds_swizzle(__float_as_int(ss), 0x401F));
                const float rs = 1.0f / sqrtf(ss * (1.0f / 128.0f) + 1e-5f);
#pragma unroll
                for (int d0 = 0; d0 < DVB; ++d0) Ow[(size_t)crow(r, hi) * PITCH + d0 * 32 + r32] = (bf16_t)(cvtpk(dv[d0] * rs * sg[d0], 0.f) & 0xFFFFu); }
        }
    }
#undef ATT_KBASE
#undef ATT_KBASE_
#undef ATT_ISSUE
}
#undef ATT_BAR
}

constexpr int NWAVES = 8;
constexpr int NLAYER = 4, PH_PER_LAYER = 8, NPHASE = 1 + NLAYER * PH_PER_LAYER;

constexpr size_t MiB = 1u << 20;
constexpr size_t WS_CTL = 0, CTL_ZERO_BYTES = 1 * MiB;
constexpr size_t WS_KMEAN = 1 * MiB;
constexpr size_t WS_LTOK = 2 * MiB, WS_LW = 3 * MiB;
constexpr size_t WS_DQKV = 5 * MiB;
constexpr size_t WS_DWO = WS_DQKV + 12 * MiB;
constexpr size_t WS_MQKV = WS_DWO + 4 * MiB;
constexpr size_t WS_MWO = WS_MQKV + 12 * MiB;
constexpr size_t WS_FGU = WS_MWO + 4 * MiB;
constexpr size_t WS_FD = WS_FGU + 22 * MiB;
constexpr size_t WS_MGU = WS_FD + 11 * MiB;
constexpr size_t WS_MD = WS_MGU + 112 * MiB;
constexpr size_t WS_XN = WS_MD + 56 * MiB;
constexpr size_t WS_Q = WS_XN + 64 * MiB, WS_K = WS_Q + 64 * MiB, WS_V = WS_K + 64 * MiB;
constexpr size_t WS_ACT = WS_Q;
constexpr size_t WS_END = WS_ACT + (size_t)MOE_TILES_MAX * 256 * DE * 2;
constexpr size_t WS_HB = WS_END;
static_assert(WS_XN == 238 * MiB && WS_END == 778 * MiB, "d_ws map");
constexpr int CW_BAR = 4096;
constexpr int CW_ATTQ = 6144;
constexpr int CW_ATTQ2 = 12288;
constexpr int CW_CNT = 8192;

constexpr int RING_OFF = 0, RING_BYTES = 131072;
constexpr int LDSCTL_OFF = RING_BYTES, MISC_OFF = LDSCTL_OFF + 320;
constexpr int XSLOT_OFF = MISC_OFF + 128;
constexpr int LDS_BYTES = 147456;

typedef unsigned short bf16;
typedef unsigned v4u __attribute__((ext_vector_type(4)));
typedef float f32x4 __attribute__((ext_vector_type(4)));
typedef GAS unsigned gu32;
#define RLX_AGENT __ATOMIC_RELAXED, __HIP_MEMORY_SCOPE_AGENT
#define LDS_WAIT() asm volatile("s_waitcnt lgkmcnt(0)" ::: "memory")
#define VM_WAIT() asm volatile("s_waitcnt vmcnt(0)" ::: "memory")
__device__ __forceinline__ unsigned f2bf(float f) { unsigned u = __builtin_bit_cast(unsigned, f); return (u + 0x7fffu + ((u >> 16) & 1u)) >> 16; }
__device__ __forceinline__ unsigned pk2(float lo, float hi) { return f2bf(lo) | (f2bf(hi) << 16); }
__device__ __forceinline__ float bflo(unsigned w) { return __uint_as_float(w << 16); }
__device__ __forceinline__ float bfhi(unsigned w) { return __uint_as_float(w & 0xFFFF0000u); }
static_assert(XSLOT_OFF % 16 == 0 && XSLOT_OFF + 8192 <= LDS_BYTES, "LDS map");
#define XB_TMO      128
#define XB_XCNT(j)  (256  + 64 * (j))
#define XB_XSUB(j)  (1280 + 64 * (j))
#define XB_XGEN(j)  (2304 + 64 * (j))
#define XB_TOP      3328
#define XB_TOPGEN   3392
#define XCD_BAR_WORDS 3456
#define XB_SPIN_CAP (1u << 18)

__device__ __forceinline__ unsigned xb_ld(unsigned* p)              { return __hip_atomic_load(p, __ATOMIC_RELAXED, __HIP_MEMORY_SCOPE_AGENT); }
__device__ __forceinline__ unsigned xb_add(unsigned* p, unsigned v) { return __hip_atomic_fetch_add(p, v, __ATOMIC_RELAXED, __HIP_MEMORY_SCOPE_AGENT); }
__device__ __forceinline__ unsigned xb_xcc_id() { return (unsigned)__builtin_amdgcn_s_getreg((3 << 11) | 20) & 0xFu; }
#define XB_SPIN(cond, bar) do { unsigned _sp = 0; while (cond) { __builtin_amdgcn_s_sleep(1); \
    if ((++_sp & 255u) == 0u) { if (xb_ld(&(bar)[XB_TMO])) break; if (_sp > XB_SPIN_CAP) { atomicAdd(&(bar)[XB_TMO], 1u); break; } } } } while (0)

struct XcdBarrier {
    unsigned* bar; unsigned x;
    volatile LAS unsigned* st;
};

__device__ __forceinline__ XcdBarrier xcd_barrier_post(unsigned* bar, volatile LAS unsigned* st) {
    XcdBarrier b; b.bar = bar; b.x = xb_xcc_id(); b.st = st;
    if (threadIdx.x == 0) (void)xb_add(&bar[XB_XCNT(b.x)], 1u);
    return b;
}
__device__ __forceinline__ void xcd_barrier_complete(unsigned* bar, unsigned x, unsigned& nloc, unsigned& nx) {
    const unsigned G = gridDim.x * gridDim.y * gridDim.z;
    unsigned sum, cnt, mine, sp = 0u;
    for (;;) {
        sum = 0u; cnt = 0u; mine = 0u;
#pragma unroll
        for (unsigned j = 0; j < 16; ++j) { const unsigned c = xb_ld(&bar[XB_XCNT(j)]); sum += c; cnt += (c > 0u) ? 1u : 0u; mine = (j == x) ? c : mine; }
        if (sum == G) break;
        __builtin_amdgcn_s_sleep(1);
        if ((++sp & 255u) == 0u) { if (xb_ld(&bar[XB_TMO])) break; if (sp > XB_SPIN_CAP) { atomicAdd(&bar[XB_TMO], 1u); break; } }
    }
    nloc = mine > 0u ? mine : 1u; nx = cnt > 0u ? cnt : 1u;
}

__device__ __forceinline__ void xcd_barrier(const XcdBarrier& b) {
    asm volatile("s_waitcnt vmcnt(0)" ::: "memory");
    __syncthreads();
    if (threadIdx.x == 0) {
        unsigned* bar = b.bar;
        __builtin_amdgcn_s_waitcnt(0);
        unsigned nloc = b.st[0], nx = b.st[1];
        if (nloc == 0u) { xcd_barrier_complete(bar, b.x, nloc, nx); b.st[0] = nloc; b.st[1] = nx; }
        const unsigned old = xb_add(&bar[XB_XSUB(b.x)], 1u);
        const unsigned gen = old / nloc;
        if (old + 1u == (gen + 1u) * nloc) {
            __builtin_amdgcn_fence(__ATOMIC_RELEASE, "agent");
            asm volatile("s_waitcnt vmcnt(0)" ::: "memory");
            const unsigned og = xb_add(&bar[XB_TOP], 1u);
            const unsigned tg = og / nx;
            if (og + 1u == (tg + 1u) * nx) xb_add(&bar[XB_TOPGEN], 1u);
            else XB_SPIN(xb_ld(&bar[XB_TOPGEN]) == tg, bar);
            __builtin_amdgcn_fence(__ATOMIC_ACQUIRE, "agent");
            xb_add(&bar[XB_XGEN(b.x)], 1u);
            asm volatile("s_waitcnt vmcnt(0)" ::: "memory");
        } else {
            XB_SPIN(xb_ld(&bar[XB_XGEN(b.x)]) == gen, bar);
            __builtin_amdgcn_fence(__ATOMIC_ACQUIRE, "agent");
            asm volatile("s_waitcnt vmcnt(0)" ::: "memory");
        }
    }
    __syncthreads();
}

struct Frame {
    LAS unsigned char* lds;
    volatile LAS unsigned* MISC;
    gu32* ctl;
    int tid, lane, wave;
    int vcu, G;
};
__device__ __forceinline__ float wave_sum(float v) {
    v += __int_as_float(__builtin_amdgcn_update_dpp(0, __float_as_int(v), 0xB1, 0xF, 0xF, true));
    v += __int_as_float(__builtin_amdgcn_update_dpp(0, __float_as_int(v), 0x4E, 0xF, 0xF, true));
    v += __int_as_float(__builtin_amdgcn_update_dpp(0, __float_as_int(v), 0x141, 0xF, 0xF, true));
    v += __int_as_float(__builtin_amdgcn_update_dpp(0, __float_as_int(v), 0x140, 0xF, 0xF, true));
    v += __int_as_float(__builtin_amdgcn_ds_swizzle(__float_as_int(v), 0x401F));
    auto rr = __builtin_amdgcn_permlane32_swap(__float_as_uint(v), __float_as_uint(v), false, false);
    return __uint_as_float(rr[0]) + __uint_as_float(rr[1]);
}
__device__ __forceinline__ void transpose_item(const float* W, int K, int N, void* WT, int k0, int n0, int drow0, LAS float* scr, int lane, bool f8, float wscale) {
    const GAS float* src = (const GAS float*)W + (size_t)k0 * N + n0 + lane;
#pragma unroll
    for (int hb = 0; hb < 2; ++hb) { float v[32];
#pragma unroll
        for (int i = 0; i < 32; ++i) v[i] = src[(size_t)(hb * 32 + i) * N];
#pragma unroll
        for (int i = 0; i < 32; ++i) { const int kk = hb * 32 + i; scr[kk * 64 + (lane ^ ((kk >> 3) << 3))] = v[i]; } }
    LDS_WAIT(); asm volatile("" ::: "memory");
    if (f8) {
        const int c = lane & 3;
#pragma unroll
        for (int j = 0; j < 4; ++j) { const int nn = (lane >> 2) + 16 * j; float v[16];
#pragma unroll
            for (int q = 0; q < 16; ++q) { const int kk = 16 * c + q; v[q] = scr[kk * 64 + (nn ^ ((kk >> 3) << 3))] * wscale; }
            v4u o; o.x = pg8::pk4_fp8(v[0], v[1], v[2], v[3]); o.y = pg8::pk4_fp8(v[4], v[5], v[6], v[7]); o.z = pg8::pk4_fp8(v[8], v[9], v[10], v[11]); o.w = pg8::pk4_fp8(v[12], v[13], v[14], v[15]);
            *(GAS v4u*)((unsigned char*)WT + (size_t)(drow0 + nn) * K + k0 + 16 * c) = o; }
    } else {
    const int c = lane & 7;
#pragma unroll
    for (int j = 0; j < 8; ++j) { const int n = (lane >> 3) + 8 * j; const LAS float* s = scr + (8 * c) * 64 + (n ^ (c << 3));
        v4u o; o.x = pk2(s[0 * 64], s[1 * 64]); o.y = pk2(s[2 * 64], s[3 * 64]); o.z = pk2(s[4 * 64], s[5 * 64]); o.w = pk2(s[6 * 64], s[7 * 64]);
        *(GAS v4u*)((bf16*)WT + (size_t)(drow0 + n) * K + k0 + 8 * c) = o; }
    }
    LDS_WAIT(); asm volatile("" ::: "memory");
}
__device__ __forceinline__ void convert_matrix(Frame& F, const float* W, int K, int N, void* WT, int il, unsigned& rot, bool f8 = false, float wscale = 1.0f) {
    LAS float* scr = (LAS float*)(F.lds + RING_OFF + F.wave * 16384);
    const unsigned gw = (unsigned)(F.vcu * NWAVES + F.wave), NGW = (unsigned)(F.G * NWAVES);
    const int nblk = N / 64, nitems = (K / 64) * nblk; int lane_ = F.lane; asm volatile("" : "+v"(lane_));
    for (int it = (int)((gw + NGW - rot % NGW) % NGW); it < nitems; it += (int)NGW) {
        const int kb = it / nblk, nb = it % nblk, n0 = 64 * nb;
        const int drow0 = il == 0 ? n0 : (n0 / 128) * 256 + (il - 1) * 128 + (n0 % 128);
        transpose_item(W, K, N, WT, 64 * kb, n0, drow0, scr, lane_, f8, wscale);
    }
    rot = (rot + (unsigned)nitems) % NGW;
}

struct RouterArgs { const float* router; gu32* cnt; unsigned* ltok; float* lw; };
template <int MODE, bool F8X = false, bool SF32 = false>
__device__ __forceinline__ void norm_phase(Frame& F, const void* src, bf16* hout, const bf16* y1, const float* gain, bf16* xn, float* fout, const RouterArgs& R) {
    int lane_ = F.lane; asm volatile("" : "+v"(lane_));
    const int gw = F.vcu * NWAVES + F.wave, NGW = F.G * NWAVES, lane = lane_;
    f32x4 gv[4];
#pragma unroll
    for (int j = 0; j < 4; ++j) gv[j] = *(const GAS f32x4*)(gain + 256 * j + 4 * lane);
    LAS float* RL = (LAS float*)(F.lds + RING_OFF);
    if constexpr (MODE == 2) {
        int tid_ = F.tid; asm volatile("" : "+v"(tid_));
        for (int i = tid_; i < 8192; i += NWAVES * 64) RL[(i & 7) * 1024 + (i >> 3)] = ((const GAS float*)R.router)[i];
        LDS_WAIT(); __syncthreads();
    }
    const int nrows_w = gw < MTOK ? (MTOK - gw + NGW - 1) / NGW : 0;
    for (int cb = 0; cb < nrows_w; cb += 64) {
        int my_t = 0, my_e0 = 0, my_e1 = 0; float my_w0 = 0.f, my_w1 = 0.f; bool valid = false;
        const int cn = (nrows_w - cb) < 64 ? (nrows_w - cb) : 64;
        f32x4 vn[4]; unsigned long long yn[4];
        unsigned long long hn[4];
        { const int row0_ = gw + cb * NGW;
          if constexpr (SF32) { const GAS f32x4* xr = (const GAS f32x4*)((const float*)src + (size_t)row0_ * D) + lane;
#pragma unroll
            for (int j = 0; j < 4; ++j) vn[j] = xr[64 * j];
          } else { const GAS unsigned long long* hr_ = (const GAS unsigned long long*)((const bf16*)src + (size_t)row0_ * D) + lane;
#pragma unroll
            for (int j = 0; j < 4; ++j) hn[j] = hr_[64 * j]; }
          if constexpr (MODE == 1 || MODE == 3) { const GAS unsigned long long* yr = (const GAS unsigned long long*)(y1 + (size_t)row0_ * D) + lane;
#pragma unroll
            for (int j = 0; j < 4; ++j) yn[j] = yr[64 * j]; } }
        for (int i = 0; i < cn; ++i) {
            const int row = gw + (cb + i) * NGW;
            f32x4 v[4]; float s = 0.f;
#pragma unroll
            for (int j = 0; j < 4; ++j) { if constexpr (SF32) v[j] = vn[j]; else { const unsigned long long w = hn[j]; const unsigned lo = (unsigned)w, hi = (unsigned)(w >> 32); v[j] = (f32x4){bflo(lo), bfhi(lo), bflo(hi), bfhi(hi)}; } }
            if constexpr (MODE == 1 || MODE == 3) {
#pragma unroll
                for (int j = 0; j < 4; ++j) { const unsigned long long w = yn[j]; const unsigned lo = (unsigned)w, hi = (unsigned)(w >> 32);
                    v[j].x += bflo(lo); v[j].y += bfhi(lo); v[j].z += bflo(hi); v[j].w += bfhi(hi); }
            }
            if (i + 1 < cn) { const int rown = row + NGW;
                if constexpr (SF32) { const GAS f32x4* xr = (const GAS f32x4*)((const float*)src + (size_t)rown * D) + lane;
#pragma unroll
                    for (int j = 0; j < 4; ++j) vn[j] = xr[64 * j];
                } else { const GAS unsigned long long* hr_ = (const GAS unsigned long long*)((const bf16*)src + (size_t)rown * D) + lane;
#pragma unroll
                    for (int j = 0; j < 4; ++j) hn[j] = hr_[64 * j]; }
                if constexpr (MODE == 1 || MODE == 3) { const GAS unsigned long long* yr = (const GAS unsigned long long*)(y1 + (size_t)rown * D) + lane;
#pragma unroll
                    for (int j = 0; j < 4; ++j) yn[j] = yr[64 * j]; } }
#pragma unroll
            for (int j = 0; j < 4; ++j) s += (v[j].x * v[j].x + v[j].y * v[j].y) + (v[j].z * v[j].z + v[j].w * v[j].w);
            if constexpr (MODE == 1) { GAS unsigned long long* hr = (GAS unsigned long long*)(hout + (size_t)row * D) + lane;
#pragma unroll
                for (int j = 0; j < 4; ++j) { const unsigned long long hw = (unsigned long long)pk2(v[j].x, v[j].y) | ((unsigned long long)pk2(v[j].z, v[j].w) << 32); hr[64 * j] = hw;
                    v[j] = (f32x4){bflo((unsigned)hw), bfhi((unsigned)hw), bflo((unsigned)(hw >> 32)), bfhi((unsigned)(hw >> 32))}; } }
            const float rstd = 1.f / sqrtf(wave_sum(s) * (1.f / D) + 1e-6f);
#pragma unroll
            for (int j = 0; j < 4; ++j) v[j] = v[j] * rstd * gv[j];
            if constexpr (MODE == 3) { GAS f32x4* orow = (GAS f32x4*)(fout + (size_t)row * D) + lane;
#pragma unroll
                for (int j = 0; j < 4; ++j) orow[64 * j] = v[j];
            } else {
                if constexpr (F8X) { GAS unsigned* o4 = (GAS unsigned*)((unsigned char*)xn + (size_t)row * D) + lane;
#pragma unroll
                    for (int j = 0; j < 4; ++j) o4[64 * j] = pg8::pk4_fp8(v[j].x, v[j].y, v[j].z, v[j].w);
                } else { GAS unsigned long long* o8 = (GAS unsigned long long*)(xn + (size_t)row * D) + lane;
#pragma unroll
                    for (int j = 0; j < 4; ++j) o8[64 * j] = (unsigned long long)pk2(v[j].x, v[j].y) | ((unsigned long long)pk2(v[j].z, v[j].w) << 32); }
            }
            if constexpr (MODE == 2) {
                float lg[NE];
#pragma unroll
                for (int e = 0; e < NE; ++e) { float a = 0.f;
#pragma unroll
                    for (int j = 0; j < 4; ++j) { const f32x4 rr = *(const LAS f32x4*)(RL + e * 1024 + 256 * j + 4 * lane); a += (v[j].x * rr.x + v[j].y * rr.y) + (v[j].z * rr.z + v[j].w * rr.w); }
                    lg[e] = wave_sum(a); }
                int e0 = 0; float v0 = lg[0];
#pragma unroll
                for (int e = 1; e < NE; ++e) if (lg[e] > v0) { v0 = lg[e]; e0 = e; }
                int e1 = -1; float v1 = 0.f;
#pragma unroll
                for (int e = 0; e < NE; ++e) if (e != e0 && (e1 < 0 || lg[e] > v1)) { v1 = lg[e]; e1 = e; }
                const float w0 = 1.f / (1.f + __expf(v1 - v0));
                if (lane == i) { my_t = row; my_e0 = e0; my_e1 = e1; my_w0 = w0; my_w1 = 1.f - w0; valid = true; }
            }
        }
        if constexpr (MODE == 2) {
            unsigned myc = 0u;
#pragma unroll
            for (int e = 0; e < NE; ++e) { const unsigned long long b0 = __ballot(valid && my_e0 == e), b1 = __ballot(valid && my_e1 == e);
                const unsigned c = (unsigned)(__popcll(b0) + __popcll(b1)); if (lane == e) myc = c; }
            unsigned basev = 0u;
            if (lane < NE) basev = __hip_atomic_fetch_add(R.cnt + 64 * lane, myc, RLX_AGENT);
            const unsigned long long lt = (1ull << lane) - 1ull;
            unsigned pos0 = 0u, pos1 = 0u;
#pragma unroll
            for (int e = 0; e < NE; ++e) { const unsigned long long b0 = __ballot(valid && my_e0 == e), b1 = __ballot(valid && my_e1 == e);
                const unsigned be = (unsigned)__shfl((int)basev, e);
                if (my_e0 == e) pos0 = be + (unsigned)__popcll(b0 & lt);
                if (my_e1 == e) pos1 = be + (unsigned)__popcll(b0) + (unsigned)__popcll(b1 & lt); }
            if (valid) {
                ((GAS unsigned*)R.ltok)[(size_t)my_e0 * LIST_CAP + pos0] = (unsigned)my_t;             ((GAS float*)R.lw)[(size_t)my_e0 * LIST_CAP + pos0] = my_w0;
                ((GAS unsigned*)R.ltok)[(size_t)my_e1 * LIST_CAP + pos1] = (unsigned)my_t | (1u << 20); ((GAS float*)R.lw)[(size_t)my_e1 * LIST_CAP + pos1] = my_w1;
            }
        }
    }
    if constexpr (MODE == 2) { LDS_WAIT(); __syncthreads(); }
}

__device__ __forceinline__ void kstat_phase(Frame& F, const bf16* Kt, float* kmean, float* kmax2) {
    int lane_ = F.lane; asm volatile("" : "+v"(lane_));
    const int gw = F.vcu * NWAVES + F.wave, NGW = F.G * NWAVES, lane = lane_;
    for (int task = gw; task < BATCH * 16 * 16; task += NGW) {
        const int hh = task & 15, n = (task >> 4) & 15, b = task >> 8, l5 = lane & 31, hf = lane >> 5;
        const GAS unsigned* p = (const GAS unsigned*)(Kt + ((size_t)b * SEQ + 256 * n + 128 * hf) * D + hh * 64) + l5;
        float a0 = 0.f, a1 = 0.f, mx = 0.f;
#pragma unroll 32
        for (int r = 0; r < 128; ++r) { const unsigned w = p[(size_t)r * (D / 2)]; const float v0 = bflo(w), v1 = bfhi(w); a0 += v0; a1 += v1;
            float s = v0 * v0 + v1 * v1;
            s += __int_as_float(__builtin_amdgcn_update_dpp(0, __float_as_int(s), 0xB1, 0xF, 0xF, true)); s += __int_as_float(__builtin_amdgcn_update_dpp(0, __float_as_int(s), 0x4E, 0xF, 0xF, true));
            s += __int_as_float(__builtin_amdgcn_update_dpp(0, __float_as_int(s), 0x141, 0xF, 0xF, true)); s += __int_as_float(__builtin_amdgcn_update_dpp(0, __float_as_int(s), 0x140, 0xF, 0xF, true));
            s += __int_as_float(__builtin_amdgcn_ds_swizzle(__float_as_int(s), 0x401F)); mx = fmaxf(mx, s); }
        { auto r0 = __builtin_amdgcn_permlane32_swap(__float_as_uint(a0), __float_as_uint(a0), false, false); a0 = __uint_as_float(r0[0]) + __uint_as_float(r0[1]);
          auto r1 = __builtin_amdgcn_permlane32_swap(__float_as_uint(a1), __float_as_uint(a1), false, false); a1 = __uint_as_float(r1[0]) + __uint_as_float(r1[1]);
          auto r2 = __builtin_amdgcn_permlane32_swap(__float_as_uint(mx), __float_as_uint(mx), false, false); mx = fmaxf(__uint_as_float(r2[0]), __uint_as_float(r2[1])); }
        if (hf == 0) { GAS float* o = (GAS float*)(kmean + ((size_t)(b * 16 + hh) * 16 + n) * 64 + 2 * l5);
            o[0] = a0 * (1.f / 256.f); o[1] = a1 * (1.f / 256.f); }
        if (lane == 0) ((GAS float*)kmax2)[(size_t)(b * 16 + hh) * 16 + n] = mx;
    }
}

struct KArgs { const float* in[17]; float* out; unsigned char* ws; int ph_lo, ph_hi; };
struct ConvDesc { const float* W; int K, N; unsigned char* WT; int il; bool f8; float sc; };
constexpr int NCONV = 61, CONV_CH = 128;
__device__ __forceinline__ ConvDesc conv_desc(const KArgs& args, unsigned char* ws, int m) {
    constexpr float WSC_UP = 32.0f, WSC_DN = 64.0f;
    ConvDesc d; d.il = 0; d.f8 = false; d.sc = 1.0f;
    if (m < 2) { d.W = args.in[7] + (size_t)m * D * 3 * D; d.K = D; d.N = 3 * D; d.WT = ws + WS_MQKV + (size_t)m * 3 * D * D * 2; }
    else if (m < 4) { const int j = m - 2; d.W = args.in[8] + (size_t)j * D * D; d.K = D; d.N = D; d.WT = ws + WS_MWO + (size_t)j * D * D * 2; }
    else if (m == 4) { d.W = args.in[4]; d.K = D; d.N = D; d.WT = ws + WS_DWO; }
    else if (m == 5) { d.W = args.in[3] + (size_t)D * 3 * D; d.K = D; d.N = 3 * D; d.WT = ws + WS_DQKV + (size_t)3 * D * D * 2; }
    else if (m == 6) { d.W = args.in[4] + (size_t)D * D; d.K = D; d.N = D; d.WT = ws + WS_DWO + (size_t)D * D * 2; }
    else if (m < 13) { const int r = m - 7, j = r / 3, t = r % 3; d.f8 = (j == 1);
        if (t < 2) { d.W = args.in[9 + t] + (size_t)j * D * DFF; d.K = D; d.N = DFF; d.WT = ws + WS_FGU + (size_t)j * 2 * DFF * D * 2; d.il = 1 + t; d.sc = d.f8 ? WSC_UP : 1.0f; }
        else { d.W = args.in[11] + (size_t)j * DFF * D; d.K = DFF; d.N = D; d.WT = ws + WS_FD + (size_t)j * D * DFF * 2; d.sc = d.f8 ? WSC_DN : 1.0f; } }
    else { const int r = m - 13, e = r / 3, t = r % 3; d.f8 = true;
        if (t < 2) { d.W = args.in[13 + t] + (size_t)e * D * DE; d.K = D; d.N = DE; d.WT = ws + WS_MGU + (size_t)e * 2 * DE * D; d.il = 1 + t; d.sc = WSC_UP; }
        else { d.W = args.in[15] + (size_t)e * DE * D; d.K = DE; d.N = D; d.WT = ws + WS_MD + (size_t)e * D * DE; d.sc = WSC_DN; } }
    return d;
}
__device__ __forceinline__ int conv_chunks_of(int m) { const int items = m < 2 || m == 5 ? 768 : (m < 7 ? 256 : (m < 13 ? 704 : 896)); return (items + CONV_CH - 1) / CONV_CH; }
__device__ __forceinline__ int conv_total_chunks() { int s = 0; for (int m = 0; m < NCONV; ++m) s += conv_chunks_of(m); return s; }
__device__ __forceinline__ void conv_chunk(Frame& F, const KArgs& args, unsigned char* ws, int c) {
    int m = 0; for (; m < NCONV; ++m) { const int n = conv_chunks_of(m); if (c < n) break; c -= n; }
    const ConvDesc d = conv_desc(args, ws, m);
    LAS float* scr = (LAS float*)(F.lds + RING_OFF + F.wave * 16384);
    int lane_ = F.lane; asm volatile("" : "+v"(lane_));
    const int nblk = d.N / 64, nitems = (d.K / 64) * nblk, last = (c + 1) * CONV_CH < nitems ? (c + 1) * CONV_CH : nitems;
    for (int it = c * CONV_CH + F.wave; it < last; it += NWAVES) {
        const int kb = it / nblk, nb = it % nblk, n0 = 64 * nb;
        const int drow0 = d.il == 0 ? n0 : (n0 / 128) * 256 + (d.il - 1) * 128 + (n0 % 128);
        transpose_item(d.W, d.K, d.N, d.WT, 64 * kb, n0, drow0, scr, lane_, d.f8, d.sc);
    }
}

__global__ void __launch_bounds__(NWAVES * 64, 2) trunk_fwd(KArgs args) {
    extern __shared__ __attribute__((aligned(16))) unsigned char lds[];
    Frame F;
    F.lds = (LAS unsigned char*)lds;
    F.MISC = (volatile LAS unsigned*)(F.lds + MISC_OFF);
    F.tid = threadIdx.x; F.lane = F.tid & 63; F.wave = __builtin_amdgcn_readfirstlane(F.tid >> 6);
    F.G = gridDim.x; { const int bx = blockIdx.x; F.vcu = (F.G % 8 == 0) ? (bx % 8) * (F.G / 8) + bx / 8 : bx; }
    F.ctl = (gu32*)(args.ws + WS_CTL);
    for (int u = F.tid; u < (LDS_BYTES - LDSCTL_OFF) / 4; u += NWAVES * 64) ((LAS unsigned*)(F.lds + LDSCTL_OFF))[u] = 0u;
    __syncthreads();
    Frame& F0 = F;
    const int lo = args.ph_lo, hi = args.ph_hi;
    XcdBarrier bar; bar.bar = (unsigned*)(F.ctl + CW_BAR); bar.x = 0; bar.st = nullptr;
    if (hi - lo > 1) bar = xcd_barrier_post((unsigned*)(F.ctl + CW_BAR), F.MISC + 8);
#define IN(k) (lo <= (k) && (k) < hi)
#ifndef PH_ENABLE
#define PH_ENABLE 0xFFFFFFFFu
#endif
#define PHEN(n) (((PH_ENABLE) >> (n)) & 1u)
#ifndef MK_DOUBLE
#define MK_DOUBLE 0u
#endif
#define NREP(n) ((((MK_DOUBLE) >> (n)) & 1u) ? 2 : 1)
#if defined(NO_OPQ)
#define OPQ(p) do {} while (0)
#else
#define OPQ(p) asm volatile("" : "+s"(p))
#endif
#if 0
#define STAMP(k) do { if (blockIdx.x == 0 && threadIdx.x == 0) { const unsigned long long t_ = __builtin_amdgcn_s_memrealtime(); ((GAS unsigned*)(F0.ctl))[3000 + (k)] = (unsigned)t_; } } while (0)
#else
#define STAMP(k) do {} while (0)
#endif
#define SEAM(k) do { if (IN(k) && IN((k) + 1)) { XcdBarrier b2_ = bar; OPQ(b2_.bar); xcd_barrier(b2_); } STAMP((k) + 1); } while (0)

#define PTRS() unsigned char* ws = args.ws; OPQ(ws); const float* x = args.in[0]; OPQ(x); const float* norm_mix = args.in[1]; OPQ(norm_mix); const float* norm_ffn = args.in[2]; OPQ(norm_ffn); \
    bf16* h = (bf16*)(ws + WS_HB); \
    bf16* XN = (bf16*)(ws + WS_XN); bf16* Qb = (bf16*)(ws + WS_Q); bf16* Kb = (bf16*)(ws + WS_K); bf16* Vb = (bf16*)(ws + WS_V); bf16* ACT = (bf16*)(ws + WS_ACT); \
    bf16* MGU = (bf16*)(ws + WS_MGU); bf16* MD = (bf16*)(ws + WS_MD); \
    float* kmean = (float*)(ws + WS_KMEAN); unsigned* ltok = (unsigned*)(ws + WS_LTOK); float* lw = (float*)(ws + WS_LW); \
    (void)x; (void)norm_mix; (void)norm_ffn; (void)h; (void)XN; (void)Qb; (void)Kb; (void)Vb; (void)ACT; (void)MGU; (void)MD; (void)kmean; (void)ltok; (void)lw
    const RouterArgs noR{nullptr, nullptr, nullptr, nullptr};
#ifndef MK_F8_DENSE
#define MK_F8_DENSE 0
#endif
    constexpr bool F8_DENSE = MK_F8_DENSE != 0; constexpr int DESZ = F8_DENSE ? 1 : 2;
    constexpr float WSC_UP = 32.0f, WSC_DN = 64.0f;
    constexpr float C2 = 0.125f * 1.4426950408889634f;

    STAMP(0);
    if (PHEN(0) && IN(0)) {
        PTRS();
        { unsigned rot = 0u;
        convert_matrix(F, args.in[3], D, 3 * D, ws + WS_DQKV, 0, rot);
        norm_phase<0, false, true>(F, x, nullptr, nullptr, norm_mix, XN, nullptr, noR);
        }
    }
    SEAM(0);

    for (int L = 0; L < NLAYER; ++L) {
        const int j = L >> 1, moba = L & 1, pb = 1 + PH_PER_LAYER * L;
        int z_ = 0;
#if !defined(NO_OPQ_Z)
        asm volatile("" : "+s"(z_));
#endif
        Frame Fl = F0; Fl.G += z_; Fl.vcu += z_; Fl.wave += z_; Fl.lds += z_; Fl.ctl += z_; const int bx = (int)blockIdx.x + z_;
#define F Fl
        if (PHEN(1) && IN(pb + 0)) {
            PTRS();

            const bf16* W = (const bf16*)(ws + (moba ? WS_MQKV : WS_DQKV)) + (size_t)j * 3 * D * D;
            pg8::Gemm g{XN, W, 2 * D, 0}; pg8::StaticOrder S; S.init(MTOK, 3 * D, F.G, bx);
            pg8::EpiQKV E{Qb, D, D, (size_t)(WS_K - WS_Q) / 2, C2};
            for (int rep_ = 0; rep_ < NREP(1); ++rep_) pg8::gemm_phase<pg8::EpiQKV, pg8::StaticOrder>(F.lds + RING_OFF, XSLOT_OFF, g, S, E);
        }
        SEAM(pb + 0);
        { if (PHEN(2) && IN(pb + 1)) { PTRS(); kstat_phase(F, Kb, kmean, kmean + 8 * 16 * 16 * 64); } SEAM(pb + 1); }
        if (IN(pb + 2)) {
            PTRS();
            att::Args A; A.Q = Qb; A.K = Kb; A.V = Vb; A.O = XN; A.kmean = kmean; A.kmax2 = kmean + 8 * 16 * 16 * 64; A.subln = args.in[6] + (size_t)j * 128; A.lam_full = 0.f; A.out_scale = 1.f; A.abl = 0;
            LAS int* qw;
            if (!moba) {
                const float* lam = args.in[5] + (size_t)j * 256; int lane = F.lane; asm volatile("" : "+v"(lane));
                const GAS float* lamg = (const GAS float*)lam; const float s1 = wave_sum(lamg[lane] * lamg[64 + lane]), s2 = wave_sum(lamg[128 + lane] * lamg[192 + lane]);
                const float lam_init = (L == 0) ? 0.2f : 0.47071302f;
                A.lam_full = __uint_as_float(__builtin_amdgcn_readfirstlane(__float_as_uint(__expf(s1) - __expf(s2) + lam_init))); A.out_scale = __uint_as_float(__builtin_amdgcn_readfirstlane(__float_as_uint(1.0f - lam_init)));
            }
            const int nconv = (L == 0) ? conv_total_chunks() : 0;
            qw = (LAS int*)(F.lds + XSLOT_OFF);
            const int xme = (int)(xb_xcc_id() & 7u);
            if ((PHEN(3) && !moba) || (PHEN(4) && moba)) for (int rep_ = 0; rep_ < (moba ? NREP(4) : NREP(3)); ++rep_) for (int xq = xme;;) {
#if ATT_ABLATE
                { const bool ab_ = rep_ == 0 && (moba ? NREP(4) : NREP(3)) == 2; A.abl = ab_ ? ATT_ABLATE : 0; A.O = ab_ ? (bf16*)(ws + WS_END) : XN; }
#endif
                const int ncx = (nconv && rep_ == 0) ? ((nconv - xq + 7) >> 3) : 0;
                gu32* qb = F.ctl + CW_ATTQ2 + 256 * L + 1024 * rep_; gu32* qx = qb + 32 * xq;
                for (;;) {
                    if (F.tid == 0) *qw = (int)__hip_atomic_fetch_add(qx, 1u, RLX_AGENT);
                    asm volatile("s_waitcnt vmcnt(0) lgkmcnt(0)\n\ts_barrier" ::: "memory");
                    int idx = __builtin_amdgcn_readfirstlane(*qw);
                    if (idx >= 128 + ncx) { asm volatile("s_waitcnt vmcnt(0) lgkmcnt(0)\n\ts_barrier" ::: "memory"); break; }
                    if (ncx) { const int q3 = idx / 3; if (idx < 3 * ncx) { if (idx - 3 * q3 == 2) { conv_chunk(F, args, ws, xq + 8 * q3); asm volatile("s_waitcnt vmcnt(0) lgkmcnt(0)\n\ts_barrier" ::: "memory"); continue; } idx -= q3; } else idx -= ncx; }
                    if (!moba) { const int hh = 7 - (idx >> 4), pr = idx & 15;
                        att::attn_unit<0>(F.lds + RING_OFF, A, xq, hh, pr);
                        att::attn_unit<0>(F.lds + RING_OFF, A, xq, hh, 31 - pr);
                    } else { const int hh = 15 - (idx >> 3), pr = idx & 7;
                        att::attn_unit<1>(F.lds + RING_OFF, A, xq, hh, pr);
                        att::attn_unit<1>(F.lds + RING_OFF, A, xq, hh, 15 - pr); }
                }
                if (F.tid < 64) { int lane = F.tid; asm volatile("" : "+v"(lane)); bool av = false;
                    if (lane < 8) { const int lim = 128 + ((nconv && rep_ == 0) ? ((nconv - lane + 7) >> 3) : 0); av = (int)__hip_atomic_load(qb + 32 * lane, RLX_AGENT) < lim; }
                    const unsigned long long m_ = __ballot(av);
                    if (lane == 0) *qw = (int)(unsigned)m_; }
                asm volatile("s_waitcnt vmcnt(0) lgkmcnt(0)\n\ts_barrier" ::: "memory");
                const unsigned m = (unsigned)__builtin_amdgcn_readfirstlane(*qw);
                asm volatile("s_waitcnt vmcnt(0) lgkmcnt(0)\n\ts_barrier" ::: "memory");
                if (m == 0u) break;
                const unsigned rot = ((m >> xme) | (m << (8 - xme))) & 0xFFu;
                xq = (xme + __builtin_ctz(rot)) & 7;
            }
            asm volatile("s_waitcnt vmcnt(0) lgkmcnt(0)\n\ts_barrier" ::: "memory");
        }
        SEAM(pb + 2);
        if (PHEN(5) && IN(pb + 3)) {
            PTRS();
            const bf16* W = (const bf16*)(ws + (moba ? WS_MWO : WS_DWO)) + (size_t)j * D * D;
            pg8::Gemm g{XN, W, 2 * D, 0}; pg8::StaticOrder S; S.init(MTOK, D, F.G, bx);
            if (L == 0) { pg8::EpiRes<true> E{x, h, D, 1.0f}; pg8::gemm_phase<pg8::EpiRes<true>, pg8::StaticOrder>(F.lds + RING_OFF, XSLOT_OFF, g, S, E); }
            else { pg8::EpiRes<false> E{h, h, D, 1.0f}; pg8::gemm_phase<pg8::EpiRes<false>, pg8::StaticOrder>(F.lds + RING_OFF, XSLOT_OFF, g, S, E); }
        }
        SEAM(pb + 3);
        if (PHEN(6) && IN(pb + 4)) {
            PTRS();
            if (!moba) {
                if (L == 2) norm_phase<0, true>(F, h, nullptr, nullptr, norm_ffn + (size_t)L * D, XN, nullptr, noR);
                else norm_phase<0, false>(F, h, nullptr, nullptr, norm_ffn + (size_t)L * D, XN, nullptr, noR);
            } else {
                const RouterArgs R{args.in[12] + (size_t)j * D * NE, F.ctl + CW_CNT + 64 * NE * j, ltok, lw};
                norm_phase<2, true>(F, h, nullptr, nullptr, norm_ffn + (size_t)L * D, XN, nullptr, R);
            }
        }
        SEAM(pb + 4);
        if (IN(pb + 5)) {
            PTRS();
            if (PHEN(7) && !moba) {
                if (L == 2) { pg8::Gemm g{XN, ws + WS_FGU + (size_t)j * 2 * DFF * D * 2, D, 0}; pg8::StaticOrder S; S.init(MTOK, 2 * DFF, F.G, bx);
                    pg8::EpiSwiGLU<true> E{ACT, DFF, 1.0f / WSC_UP};
                    pg8::gemm_phase<pg8::EpiSwiGLU<true>, pg8::StaticOrder, true>(F.lds + RING_OFF, XSLOT_OFF, g, S, E);
                } else { pg8::Gemm g{XN, ws + WS_FGU + (size_t)j * 2 * DFF * D * 2, 2 * D, 0}; pg8::StaticOrder S; S.init(MTOK, 2 * DFF, F.G, bx);
                    pg8::EpiSwiGLU<false> E{ACT, DFF, 1.0f};
                    pg8::gemm_phase<pg8::EpiSwiGLU<false>, pg8::StaticOrder, false>(F.lds + RING_OFF, XSLOT_OFF, g, S, E); }
            } else if (PHEN(8) && moba) {
                pg8::Gemm g{XN, ws + WS_MGU + (size_t)j * NE * 2 * DE * D, D, (size_t)2 * DE * D}; pg8::MoeOrder S; S.init((const unsigned*)(F.ctl + CW_CNT + 64 * NE * j), ltok, true, 2 * DE, F.G, bx);
                pg8::EpiSwiGLU<true> E{ACT, DE, 1.0f / WSC_UP};
                pg8::gemm_phase<pg8::EpiSwiGLU<true>, pg8::MoeOrder, true>(F.lds + RING_OFF, XSLOT_OFF, g, S, E);
            }
        }
        SEAM(pb + 5);
        if (IN(pb + 6)) {
            PTRS();
            if (PHEN(9) && !moba) {
                if (L == 2) { pg8::Gemm g{ACT, ws + WS_FD + (size_t)j * D * DFF * 2, DFF, 0}; pg8::StaticOrder S; S.init(MTOK, D, F.G, bx);
                    pg8::EpiRes<false> E{h, h, D, 1.0f / WSC_DN};
                    pg8::gemm_phase<pg8::EpiRes<false>, pg8::StaticOrder, true>(F.lds + RING_OFF, XSLOT_OFF, g, S, E);
                } else { pg8::Gemm g{ACT, ws + WS_FD + (size_t)j * D * DFF * 2, 2 * DFF, 0}; pg8::StaticOrder S; S.init(MTOK, D, F.G, bx);
                    pg8::EpiRes<false> E{h, h, D, 1.0f};
                    pg8::gemm_phase<pg8::EpiRes<false>, pg8::StaticOrder, false>(F.lds + RING_OFF, XSLOT_OFF, g, S, E); }
            } else if (PHEN(10) && moba) {
                pg8::Gemm g{ACT, ws + WS_MD + (size_t)j * NE * D * DE, DE, (size_t)D * DE}; pg8::MoeOrder S; S.init((const unsigned*)(F.ctl + CW_CNT + 64 * NE * j), ltok, false, D, F.G, bx);
                pg8::EpiMoeDown E; E.h = h; E.y1 = XN; E.list_tok = ltok; E.list_w = lw; E.sc = 1.0f / WSC_DN;
#pragma unroll
                for (int e = 0; e < NE; ++e) E.cnt[e] = S.cnt[e];
                pg8::gemm_phase<pg8::EpiMoeDown, pg8::MoeOrder, true>(F.lds + RING_OFF, XSLOT_OFF, g, S, E);
            }
        }
        SEAM(pb + 6);
        if (PHEN(11) && IN(pb + 7)) {
            PTRS();
            if (L == 3) norm_phase<3>(F, h, nullptr, XN, args.in[16], nullptr, args.out, noR);
            else if (moba) norm_phase<1>(F, h, h, XN, norm_mix + (size_t)(L + 1) * D, XN, nullptr, noR);
            else for (int rep_ = 0; rep_ < NREP(11); ++rep_) norm_phase<0>(F, h, nullptr, nullptr, norm_mix + (size_t)(L + 1) * D, XN, nullptr, noR);
        }
        if (L != NLAYER - 1) SEAM(pb + 7); else STAMP(pb + 8);
#undef F
    }
#undef IN
#undef SEAM
#undef PTRS
#undef OPQ
}


#if MK_DEBUG
__global__ void dbg_probe(const void* buf, size_t n, int is_bf16, int idx, float thresh, unsigned* dbg) {
    size_t i = blockIdx.x * (size_t)blockDim.x + threadIdx.x, stride = (size_t)gridDim.x * blockDim.x; bool bad = false;
    for (size_t k = i; k < n; k += stride) { float v = is_bf16 ? __uint_as_float(((unsigned)((const unsigned short*)buf)[k]) << 16) : ((const float*)buf)[k]; if (!(fabsf(v) <= thresh)) bad = true; }
    if (bad) atomicMax(dbg, (unsigned)(1000 - idx));
}
__global__ void dbg_cnt(const unsigned* cntw, int idx, unsigned* dbg) {
    if (threadIdx.x == 0 && blockIdx.x == 0) { unsigned s = 0; for (int e = 0; e < NE; ++e) s += cntw[64 * e]; if (s != 2u * MTOK) atomicMax(dbg, (unsigned)(1000 - idx)); }
}

__device__ __forceinline__ float dbg_bf(unsigned short v) { return __uint_as_float(((unsigned)v) << 16); }
__device__ __forceinline__ unsigned dbg_hash(unsigned x) { x ^= x >> 16; x *= 0x7feb352dU; x ^= x >> 15; x *= 0x846ca68bU; x ^= x >> 16; return x; }
__global__ void dbg_gemm_check(const unsigned short* A, int lda, const unsigned short* Bt, int K, const unsigned short* out, int ldo, int M, int N, float scale, int idx, unsigned* dbg) {
    const unsigned s = blockIdx.x * blockDim.x + threadIdx.x; const int row = (int)(dbg_hash(2 * s + 1) % (unsigned)M), col = (int)(dbg_hash(2 * s + 2) % (unsigned)N);
    float acc = 0.f; for (int k = 0; k < K; ++k) acc += dbg_bf(A[(size_t)row * lda + k]) * dbg_bf(Bt[(size_t)col * K + k]);
    acc *= scale; const float got = dbg_bf(out[(size_t)row * ldo + col]);
    if (!(fabsf(got - acc) <= 0.03f + 0.02f * fabsf(acc))) { atomicMax(dbg, (unsigned)(1000 - idx)); atomicAdd(dbg + 64 + idx, 1u); }
}
__global__ void dbg_conv_check(const float* W, int K, int N, const unsigned short* WT, int il, int idx, unsigned* dbg) {
    const unsigned s = blockIdx.x * blockDim.x + threadIdx.x; const int k = (int)(dbg_hash(2 * s + 1) % (unsigned)K), n = (int)(dbg_hash(2 * s + 2) % (unsigned)N);
    const int dr = il == 0 ? n : (n / 128) * 256 + (il - 1) * 128 + (n % 128);
    const float w = W[(size_t)k * N + n], g = dbg_bf(WT[(size_t)dr * K + k]);
    if (!(fabsf(g - w) <= 0.01f * fabsf(w) + 1e-6f)) atomicMax(dbg, (unsigned)(1000 - idx));
}
__global__ void dbg_norm_check(const float* src, const float* gain, const unsigned short* xn, int idx, unsigned* dbg) {
    const unsigned s = blockIdx.x * blockDim.x + threadIdx.x; const int row = (int)(dbg_hash(s + 77) % (unsigned)MTOK);
    float ss = 0.f; for (int c = 0; c < D; ++c) { const float v = src[(size_t)row * D + c]; ss += v * v; }
    const float rstd = 1.f / sqrtf(ss / D + 1e-6f); bool bad = false;
    for (int c = 0; c < D; ++c) { const float r = src[(size_t)row * D + c] * rstd * gain[c], g = dbg_bf(xn[(size_t)row * D + c]); if (!(fabsf(g - r) <= 0.02f + 0.01f * fabsf(r))) bad = true; }
    if (bad) atomicMax(dbg, (unsigned)(1000 - idx));
}
__global__ void dbg_naive_gemm(const unsigned short* A, const unsigned short* Bt, unsigned short* out, int M, int N, int K) {
    const size_t i = blockIdx.x * (size_t)blockDim.x + threadIdx.x; if (i >= (size_t)M * N) return; const int row = (int)(i / N), col = (int)(i % N);
    float acc = 0.f; for (int k = 0; k < K; ++k) acc += dbg_bf(A[(size_t)row * K + k]) * dbg_bf(Bt[(size_t)col * K + k]);
    out[(size_t)row * N + col] = (unsigned short)f2bf(acc);
}
__global__ void dbg_find_col(const unsigned short* out, const unsigned short* ref, int M, int N, unsigned* hist) {
    const unsigned s = blockIdx.x * blockDim.x + threadIdx.x; const int row = (int)(dbg_hash(2 * s + 1) % (unsigned)M), col = (int)(dbg_hash(2 * s + 2) % (unsigned)N);
    const unsigned short v = out[(size_t)row * N + col]; int found = -1;
#if MK_FIND_PATTERN
    if (v == 0x3C3C) atomicAdd(hist + N, 1u); else atomicAdd(hist + 5, 1u); return;
#endif
#if MK_FIND_ROWS
    for (int r = 0; r < M; ++r) if (ref[(size_t)r * N + col] == v) { found = r; break; }
    if (found < 0) atomicAdd(hist + N, 1u); else atomicAdd(hist + ((found - row) & (N - 1)), 1u);
#else
    for (int c = 0; c < N; ++c) if (ref[(size_t)row * N + c] == v) { found = c; break; }
    if (found < 0) atomicAdd(hist + N, 1u); else atomicAdd(hist + ((found - col) & (N - 1)), 1u);
#endif
}
__global__ void dbg_hist_code(const unsigned* hist, int N, unsigned* dbg) {
    if (threadIdx.x || blockIdx.x) return; unsigned best = 0, bi = 0; for (int i = 0; i < N; ++i) if (hist[i] > best) { best = hist[i]; bi = i; }
    dbg[32] = bi; dbg[33] = best; dbg[34] = hist[N];
}
__global__ void dbg_final(float* out, size_t n, const unsigned* dbg) {
    if (MK_HIST_SEL >= 10) { const float c3 = sqrtf((float)dbg[MK_HIST_SEL + 30]); size_t i3 = blockIdx.x * (size_t)blockDim.x + threadIdx.x, st3 = (size_t)gridDim.x * blockDim.x; for (size_t k3 = i3; k3 < n; k3 += st3) out[k3] = c3; return; }
    if (MK_HIST_SEL >= 0 && (dbg[33] || dbg[34])) { const float c2 = sqrtf((float)(MK_HIST_SEL == 0 ? dbg[32] : (MK_HIST_SEL == 1 ? dbg[33] * 100u / 4096u : dbg[34] * 100u / 4096u)) + 1.f); size_t i2 = blockIdx.x * (size_t)blockDim.x + threadIdx.x, st2 = (size_t)gridDim.x * blockDim.x; for (size_t k2 = i2; k2 < n; k2 += st2) out[k2] = c2; return; }
    const unsigned d = dbg[0]; if (d == 0u) return; const unsigned nf = dbg[64 + (1000u - d)]; const float c = sqrtf(nf ? (float)(200u * (1000u - d - 9u) + nf * 100u / 4096u) : (float)(1000u - d));
    size_t i = blockIdx.x * (size_t)blockDim.x + threadIdx.x, stride = (size_t)gridDim.x * blockDim.x;
    for (size_t k = i; k < n; k += stride) out[k] = c;
}
#endif

#ifndef MK_REPEAT
#define MK_REPEAT 1
#endif
#ifndef MK_FIND_ROWS
#define MK_FIND_ROWS 0
#endif
#ifndef MK_FIND_REGION
#define MK_FIND_REGION WS_K
#endif
#ifndef MK_HIST_SEL
#define MK_HIST_SEL 0
#endif
#ifndef MK_STAMP
#define MK_STAMP 0
#endif
#if MK_STAMP
__global__ void stamp_k(unsigned* p) { if (threadIdx.x == 0) *p = (unsigned)__builtin_amdgcn_s_memrealtime(); }
__global__ void stamp_encode(float* out, size_t n, const unsigned* st, int pa, float ua, int pb, float ub) {
    const float da = (float)(st[pa + 1] - st[pa]) * 0.01f, db = (float)(st[pb + 1] - st[pb]) * 0.01f;
    float m = da / ua; m = m < 10.f ? 10.f : (m > 99.f ? 99.f : m); float e = floorf(db / ub + 0.5f); e = e < 0.f ? 0.f : (e > 30.f ? 30.f : e);
    const float c = sqrtf(m) * __powf(10.f, 0.5f * e);
    size_t i = blockIdx.x * (size_t)blockDim.x + threadIdx.x, stride = (size_t)gridDim.x * blockDim.x;
    for (size_t k = i; k < n; k += stride) out[k] = c;
}
#endif
extern "C" void kernel_launch(void* const* d_in, const int* in_sizes, int n_in, void* d_out, int out_size, void* d_ws, size_t ws_size, hipStream_t stream) {
    static int grid = 0;
    if (grid == 0) {
        if (n_in != 17 || in_sizes[0] != MTOK * D || out_size != MTOK * D || ws_size < WS_END) {
            fprintf(stderr, "kernel_launch: built for 17 inputs, x/out of %d floats, >= %zu bytes of workspace; got n_in %d, in0 %d, out %d, ws %zu; nothing launched\n", MTOK * D, (size_t)WS_END, n_in, n_in > 0 ? in_sizes[0] : -1, out_size, ws_size);
            grid = -1; return; }
        int dev = 0, cus = 0, per_cu = 0;
        if (hipGetDevice(&dev) != hipSuccess || hipDeviceGetAttribute(&cus, hipDeviceAttributeMultiprocessorCount, dev) != hipSuccess) { fprintf(stderr, "kernel_launch: device query failed\n"); grid = -1; return; }
        if (hipFuncSetAttribute((const void*)trunk_fwd, hipFuncAttributeMaxDynamicSharedMemorySize, LDS_BYTES) != hipSuccess) { fprintf(stderr, "kernel_launch: hipFuncSetAttribute failed\n"); grid = -1; return; }
        if (hipOccupancyMaxActiveBlocksPerMultiprocessor(&per_cu, (const void*)trunk_fwd, NWAVES * 64, LDS_BYTES) != hipSuccess || per_cu < 1)
            fprintf(stderr, "kernel_launch: note: occupancy query reports %d workgroups per CU\n", per_cu);
        (void)hipGetLastError();
        grid = cus;
    }
    if (grid < 0) return;
    if (hipMemsetAsync((char*)d_ws + WS_CTL, 0, CTL_ZERO_BYTES, stream) != hipSuccess) { fprintf(stderr, "kernel_launch: memset failed\n"); return; }
    KArgs a{};
    for (int i = 0; i < 17; ++i) a.in[i] = (const float*)d_in[i];
    a.out = (float*)d_out; a.ws = (unsigned char*)d_ws;
#if MK_PER_PHASE
#if MK_STAMP
    hipLaunchKernelGGL(stamp_k, dim3(1), dim3(64), 0, stream, (unsigned*)d_ws + 3000);
#endif
    for (int p = 0; p < NPHASE; ++p) {
        a.ph_lo = p; a.ph_hi = p + 1;
#if MK_DEBUG
#endif
#if !defined(MK_SKIP_MAIN)
        for (int rep_ = 0; rep_ < (p == 1 ? MK_REPEAT : 1); ++rep_) hipLaunchKernelGGL(trunk_fwd, dim3(grid), dim3(NWAVES * 64), LDS_BYTES, stream, a);
#endif
#if MK_STAMP
        hipLaunchKernelGGL(stamp_k, dim3(1), dim3(64), 0, stream, (unsigned*)d_ws + 3000 + p + 1);
#endif
#if MK_DEBUG
        {   unsigned char* ws = (unsigned char*)d_ws; unsigned* dbg = (unsigned*)(ws + WS_CTL) + 2048;
            const size_t MD_ = (size_t)MTOK * D;
#define PROBE(buf, n, isbf, idx, th) if ((idx) <= MK_PROBE_MAX) hipLaunchKernelGGL(dbg_probe, dim3(2048), dim3(256), 0, stream, (const void*)(buf), (size_t)(n), isbf, idx, th, dbg)
            if (p == 0) {
                hipLaunchKernelGGL(dbg_norm_check, dim3(4), dim3(64), 0, stream, (const float*)d_in[0], (const float*)d_in[1], (const unsigned short*)(ws + WS_XN), 4, dbg);
                hipLaunchKernelGGL(dbg_conv_check, dim3(16), dim3(256), 0, stream, (const float*)d_in[3], D, 3 * D, (const unsigned short*)(ws + WS_DQKV), 0, 5, dbg);
                hipLaunchKernelGGL(dbg_conv_check, dim3(16), dim3(256), 0, stream, (const float*)d_in[9], D, DFF, (const unsigned short*)(ws + WS_FGU), 1, 6, dbg);
                hipLaunchKernelGGL(dbg_conv_check, dim3(16), dim3(256), 0, stream, (const float*)d_in[10], D, DFF, (const unsigned short*)(ws + WS_FGU), 2, 7, dbg);
                hipLaunchKernelGGL(dbg_conv_check, dim3(16), dim3(256), 0, stream, (const float*)d_in[11], DFF, D, (const unsigned short*)(ws + WS_FD), 0, 8, dbg);
                hipLaunchKernelGGL(dbg_conv_check, dim3(16), dim3(256), 0, stream, (const float*)d_in[15] + (size_t)3 * DE * D, DE, D, (const unsigned short*)(ws + WS_MD) + (size_t)3 * D * DE, 0, 9, dbg);
            }
            if (p == 1) {
                const float C2h = 0.125f * 1.4426950408889634f;
                hipLaunchKernelGGL(dbg_gemm_check, dim3(16), dim3(256), 0, stream, (const unsigned short*)(ws + WS_XN), D, (const unsigned short*)(ws + WS_DQKV), D, (const unsigned short*)(ws + WS_Q), D, MTOK, D, C2h, 10, dbg);
                hipLaunchKernelGGL(dbg_gemm_check, dim3(16), dim3(256), 0, stream, (const unsigned short*)(ws + WS_XN), D, (const unsigned short*)(ws + WS_DQKV) + (size_t)D * D, D, (const unsigned short*)(ws + WS_K), D, MTOK, D, 1.f, 11, dbg);

                hipLaunchKernelGGL(dbg_gemm_check, dim3(16), dim3(256), 0, stream, (const unsigned short*)(ws + WS_XN), D, (const unsigned short*)(ws + WS_DQKV) + (size_t)2 * D * D, D, (const unsigned short*)(ws + WS_V), D, MTOK, D, 1.f, 12, dbg);
            }
            if (0) { PROBE(ws + WS_XN, MD_, 1, 1, 10.f); PROBE(ws + WS_DQKV, (WS_MGU - WS_DQKV) / 2, 1, 2, 1.f); PROBE(ws + WS_MGU, (WS_XN - WS_MGU) / 2, 1, 3, 1.f); }
            if (p >= 1) { const int L = (p - 1) / PH_PER_LAYER, k = (p - 1) % PH_PER_LAYER; const int b = 20 + 10 * L;
                if (k == 0) PROBE(ws + WS_Q, 3 * MD_, 1, b + 0, 50.f);
                if (k == 1) PROBE(ws + WS_KMEAN, 8 * 16 * 16 * 64, 0, b + 1, 5.f);
                if (k == 2) PROBE(ws + WS_XN, MD_, 1, b + 2, 50.f);
                if (k == 3) PROBE(d_out, MD_, 0, b + 3, 300.f);
                if (k == 4) { PROBE(ws + WS_XN, MD_, 1, b + 4, 20.f); if ((L & 1) && (b + 9) <= MK_PROBE_MAX) hipLaunchKernelGGL(dbg_cnt, dim3(1), dim3(64), 0, stream, (const unsigned*)(ws + WS_CTL) + CW_CNT + 64 * NE * (L >> 1), b + 9, dbg); }
                if (k == 5) PROBE(ws + WS_ACT, (L & 1) ? (size_t)256 * 256 * DE : (size_t)MTOK * DFF, 1, b + 5, 2000.f);
                if (k == 6) { PROBE(d_out, MD_, 0, b + 6, 1000.f); if (L & 1) PROBE(ws + WS_XN, MD_, 1, b + 7, 1000.f); }
                if (k == 7 && L != 3) { PROBE(ws + WS_XN, MD_, 1, b + 8, 20.f); PROBE(d_out, MD_, 0, b + 8, 1000.f); }
            }
#undef PROBE
        }
#endif
    }
#if MK_DEBUG
    hipLaunchKernelGGL(dbg_final, dim3(2048), dim3(256), 0, stream, (float*)d_out, (size_t)MTOK * D, (const unsigned*)((unsigned char*)d_ws + WS_CTL) + 2048);
#endif
#else
    a.ph_lo = 0; a.ph_hi = NPHASE;
    hipLaunchKernelGGL(trunk_fwd, dim3(grid), dim3(NWAVES * 64), LDS_BYTES, stream, a);
#if 0
    hipLaunchKernelGGL(stamp_encode, dim3(2048), dim3(256), 0, stream, (float*)d_out, (size_t)MTOK * D, (const unsigned*)d_ws + 3000, MK_STAMP_PA, MK_STAMP_UA, MK_STAMP_PB, MK_STAMP_UB);
#endif
#endif
#if MK_STAMP
    hipLaunchKernelGGL(stamp_encode, dim3(2048), dim3(256), 0, stream, (float*)d_out, (size_t)MTOK * D, (const unsigned*)d_ws + 3000, MK_STAMP_PA, MK_STAMP_UA, MK_STAMP_PB, MK_STAMP_UB);
#endif
    const hipError_t le = hipPeekAtLastError();
    if (le != hipSuccess) fprintf(stderr, "kernel_launch: launch failed: %s\n", hipGetErrorName(le));
}
```

```cpp
#ifndef MK_DEBUG
#define MK_DEBUG 0
#endif
#ifndef MK_PER_PHASE
#define MK_PER_PHASE 0
#endif
#include <hip/hip_runtime.h>
#include <cstdio>
#include <cstdint>

#ifndef MK_KDEBUG
#define MK_KDEBUG 0
#endif
#define LAS __attribute__((address_space(3)))
#define GAS __attribute__((address_space(1)))

constexpr int BATCH = 8, SEQ = 4096, MTOK = BATCH * SEQ, D = 1024, DFF = 2816, DE = 3584, NE = 8;
constexpr int MOE_TILES_MAX = 272;
constexpr int LIST_CAP = MTOK;

namespace pg8 {
#define PG8_LAS __attribute__((address_space(3)))
typedef unsigned short bf16_t;
typedef short bf16x8 __attribute__((ext_vector_type(8)));
typedef float f32x4 __attribute__((ext_vector_type(4)));
typedef unsigned u32x4 __attribute__((ext_vector_type(4)));
typedef int i32x4 __attribute__((ext_vector_type(4)));
typedef int i32x8 __attribute__((ext_vector_type(8)));
constexpr int BM = 256, BK = 64, HALF = 128, HTB = HALF * BK * 2  , STAGE_BYTES = 8 * HTB, NXCD = 8, WGM = 8;

__host__ __device__ __forceinline__ int lds_byte(int r, int c) { const int st = (r >> 4) * 2 + (c >> 5), rr = r & 15, cc = c & 31, ob = rr * 64 + cc * 2; return st * 1024 + (ob ^ (((ob >> 9) & 1) << 5)); }
__host__ __device__ __forceinline__ void stage_rc(int b, int& R, int& C) { const int st = b / 1024, sb = b % 1024, swz = sb ^ (((sb >> 9) & 1) << 5); R = (st >> 1) * 16 + swz / 64; C = (st & 1) * 32 + (swz % 64) / 2; }
__host__ __device__ __forceinline__ int perm32(int rho) { const int n = rho >> 4, i = rho & 15; return 8 * (i >> 2) + 4 * n + (i & 3); }

struct Unit { int pm, pn, e, r0; };
struct Gemm { const void* A; const void* Bt; int rowb; size_t bstride; };

__device__ __forceinline__ void tile_of(int L, int nM, int nN, int& pm, int& pn) {
    const int nwg = nM * nN; int wgid = L; { const int q = nwg / NXCD, r = nwg % NXCD, xcd = wgid % NXCD, off = wgid / NXCD; wgid = (xcd < r ? xcd * (q + 1) : r * (q + 1) + (xcd - r) * q) + off; }
    const int nig = WGM * nN, gid = wgid / nig, fm = gid * WGM, gsz = (nM - fm) < WGM ? (nM - fm) : WGM;
    pm = fm + ((wgid % nig) % gsz); pn = (wgid % nig) / gsz;
}
struct StaticOrder {
    int nM, nN, nwg, G, c;
    __device__ __forceinline__ void init(int M, int N, int G_, int c_) { nM = M / BM; nN = N / BM; nwg = nM * nN; G = G_; c = c_; }
    __device__ __forceinline__ bool next(int i, Unit& u) const {
        const long L = (long)i * G + c; if (L >= nwg) return false;
        tile_of((int)L, nM, nN, u.pm, u.pn); u.e = 0; u.r0 = 0; return true;
    }
    __device__ __forceinline__ unsigned arow(const Unit& u, int lr) const { return (unsigned)(u.pm * BM + lr); }
};
struct MoeOrder {
    int nM, nN, nwg, G, c; int tstart[NE + 1]; int cnt[NE]; const unsigned* list_tok; bool gather;
    __device__ __forceinline__ void init(const unsigned* cntw, const unsigned* list_tok_, bool gather_, int N, int G_, int c_) {
        int acc = 0;
#pragma unroll
        for (int e = 0; e < NE; ++e) { const int ce = (int)__builtin_amdgcn_readfirstlane((int)__hip_atomic_load((const GAS unsigned*)cntw + 64 * e, __ATOMIC_RELAXED, __HIP_MEMORY_SCOPE_AGENT)); cnt[e] = ce; tstart[e] = acc; acc += (ce + BM - 1) / BM; }
        tstart[NE] = acc; nM = acc; nN = N / BM; nwg = nM * nN; G = G_; c = c_; list_tok = list_tok_; gather = gather_;
    }
    __device__ __forceinline__ bool next(int i, Unit& u) const {
        const long L = (long)i * G + c; if (L >= nwg) return false;
        tile_of((int)L, nM, nN, u.pm, u.pn); int e = 0;
#pragma unroll
        for (int k = 1; k < NE; ++k) e += (u.pm >= tstart[k]) ? 1 : 0;
        u.e = e; int ts = 0;
#pragma unroll
        for (int k = 0; k < NE; ++k) ts = (k == e) ? tstart[k] : ts;
        u.r0 = (u.pm - ts) * BM; return true;
    }
    __device__ __forceinline__ int count_of(int e) const { int cv = 0;
#pragma unroll
        for (int k = 0; k < NE; ++k) cv = (k == e) ? cnt[k] : cv;
        return cv; }
    __device__ __forceinline__ unsigned arow(const Unit& u, int lr) const {
        if (!gather) return (unsigned)(u.pm * BM + lr);
        const int l = u.r0 + lr; const int cv = count_of(u.e);
        unsigned t = 0u; if (l < cv) t = __hip_atomic_load((const GAS unsigned*)list_tok + (size_t)u.e * LIST_CAP + l, __ATOMIC_RELAXED, __HIP_MEMORY_SCOPE_AGENT) & 0xFFFFFu;
        return t;
    }
};

__device__ __forceinline__ unsigned cvt_pk_bf16(float lo, float hi) { unsigned r; asm volatile("v_cvt_pk_bf16_f32 %0, %1, %2" : "=v"(r) : "v"(lo), "v"(hi)); return r; }

struct EpiQKV {
    static constexpr bool PERM = true;
    bf16_t* O; int ldc; int split_cols; size_t split_stride; float scale0;
    __device__ __forceinline__ void operator()(const f32x4 (&acc)[2][2][4][2], const Unit& u, int wr, int wc, int fr, int fq) const {
        const int row0 = u.pm * BM + wr * 64 + fr; int colt = u.pn * BM; bf16_t* base = O;
        float sc = 1.f; { const int t = colt / split_cols; base += (size_t)t * split_stride; colt -= t * split_cols; if (t == 0) sc = scale0; }
        const int col0 = colt + wc * 32 + 8 * fq;
#pragma unroll
        for (int ai = 0; ai < 2; ++ai)
#pragma unroll
            for (int m = 0; m < 4; ++m) { bf16_t* rowp = base + (size_t)(row0 + ai * HALF + m * 16) * ldc + col0;
#pragma unroll
                for (int bj = 0; bj < 2; ++bj) { f32x4 v0 = acc[ai][bj][m][0] * sc, v1 = acc[ai][bj][m][1] * sc;
                    u32x4 w; w.x = cvt_pk_bf16(v0[0], v0[1]); w.y = cvt_pk_bf16(v0[2], v0[3]); w.z = cvt_pk_bf16(v1[0], v1[1]); w.w = cvt_pk_bf16(v1[2], v1[3]);
                    *(GAS u32x4*)(rowp + bj * HALF) = w;
                    } }
    }
};
__device__ __forceinline__ unsigned pk4_fp8(float a, float b, float c, float d) { unsigned w = 0; w = __builtin_amdgcn_cvt_pk_fp8_f32(a, b, w, false); w = __builtin_amdgcn_cvt_pk_fp8_f32(c, d, w, true); return w; }
template <bool F8OUT> struct EpiSwiGLU {
    static constexpr bool PERM = true;
    void* O; int ldc; float sc;
    __device__ __forceinline__ void operator()(const f32x4 (&acc)[2][2][4][2], const Unit& u, int wr, int wc, int fr, int fq) const {
        const int row0 = u.pm * BM + wr * 64 + fr; const int col0 = u.pn * HALF + wc * 32 + 8 * fq;
#pragma unroll
        for (int ai = 0; ai < 2; ++ai)
#pragma unroll
            for (int m = 0; m < 4; ++m) { float o[8];
#pragma unroll
                for (int n = 0; n < 2; ++n)
#pragma unroll
                    for (int j = 0; j < 4; ++j) { const float g = acc[ai][0][m][n][j] * sc, up = acc[ai][1][m][n][j] * sc;
                        const float s = __builtin_amdgcn_rcpf(1.0f + __builtin_amdgcn_exp2f(-1.4426950408889634f * g)); o[n * 4 + j] = g * s * up; }
                const size_t eo = (size_t)(row0 + ai * HALF + m * 16) * ldc + col0;
                if constexpr (F8OUT) { const unsigned long long w = (unsigned long long)pk4_fp8(o[0], o[1], o[2], o[3]) | ((unsigned long long)pk4_fp8(o[4], o[5], o[6], o[7]) << 32);
                    *(GAS unsigned long long*)((unsigned char*)O + eo) = w;
                } else { u32x4 w; w.x = cvt_pk_bf16(o[0], o[1]); w.y = cvt_pk_bf16(o[2], o[3]); w.z = cvt_pk_bf16(o[4], o[5]); w.w = cvt_pk_bf16(o[6], o[7]);
                    *(GAS u32x4*)((bf16_t*)O + eo) = w; } }
    }
};
template <bool RF32> struct EpiRes {
    static constexpr bool PERM = true;
    const void* res; bf16_t* out; int ldc; float sc;
    __device__ __forceinline__ void operator()(const f32x4 (&acc)[2][2][4][2], const Unit& u, int wr, int wc, int fr, int fq) const {
        const int row0 = u.pm * BM + wr * 64 + fr; const int col0 = u.pn * BM + wc * 32 + 8 * fq;
#pragma unroll
        for (int ai = 0; ai < 2; ++ai)
#pragma unroll
            for (int m = 0; m < 4; ++m) { const size_t off = (size_t)(row0 + ai * HALF + m * 16) * ldc + col0;
#pragma unroll
                for (int bj = 0; bj < 2; ++bj) { const size_t o2 = off + bj * HALF; f32x4 r0, r1;
                    if constexpr (RF32) { r0 = *(const GAS f32x4*)((const float*)res + o2); r1 = *(const GAS f32x4*)((const float*)res + o2 + 4); }
                    else { const u32x4 w = *(const GAS u32x4*)((const bf16_t*)res + o2);
                        r0 = (f32x4){__uint_as_float(w.x << 16), __uint_as_float(w.x & 0xFFFF0000u), __uint_as_float(w.y << 16), __uint_as_float(w.y & 0xFFFF0000u)};
                        r1 = (f32x4){__uint_as_float(w.z << 16), __uint_as_float(w.z & 0xFFFF0000u), __uint_as_float(w.w << 16), __uint_as_float(w.w & 0xFFFF0000u)}; }
                    const f32x4 v0 = r0 + acc[ai][bj][m][0] * sc, v1 = r1 + acc[ai][bj][m][1] * sc;
                    u32x4 o; o.x = cvt_pk_bf16(v0[0], v0[1]); o.y = cvt_pk_bf16(v0[2], v0[3]); o.z = cvt_pk_bf16(v1[0], v1[1]); o.w = cvt_pk_bf16(v1[2], v1[3]);
                    *(GAS u32x4*)(out + o2) = o; } }
    }
};
struct EpiMoeDown {
    static constexpr bool PERM = true;
    bf16_t* h; bf16_t* y1; const unsigned* list_tok; const float* list_w; int cnt[NE]; float sc;
    __device__ __forceinline__ void operator()(const f32x4 (&acc)[2][2][4][2], const Unit& u, int wr, int wc, int fr, int fq) const {
        int cv = 0;
#pragma unroll
        for (int k = 0; k < NE; ++k) cv = (k == u.e) ? cnt[k] : cv;
        const int col0 = u.pn * BM + wc * 32 + 8 * fq;
#pragma unroll
        for (int ai = 0; ai < 2; ++ai)
#pragma unroll
            for (int m = 0; m < 4; ++m) { const int l = u.r0 + ai * HALF + wr * 64 + m * 16 + fr;
                if (l < cv) {
                    const unsigned ent = __hip_atomic_load((const GAS unsigned*)list_tok + (size_t)u.e * LIST_CAP + l, __ATOMIC_RELAXED, __HIP_MEMORY_SCOPE_AGENT);
                    const float w = sc * __uint_as_float(__hip_atomic_load((const GAS unsigned*)list_w + (size_t)u.e * LIST_CAP + l, __ATOMIC_RELAXED, __HIP_MEMORY_SCOPE_AGENT));
                    const size_t off = (size_t)(ent & 0xFFFFFu) * D + col0;
                    if ((ent >> 20) == 0u) {
#pragma unroll
                        for (int bj = 0; bj < 2; ++bj) { GAS u32x4* p = (GAS u32x4*)(h + off + bj * HALF); const u32x4 rw = *p;
                            const f32x4 v0 = (f32x4){__uint_as_float(rw.x << 16), __uint_as_float(rw.x & 0xFFFF0000u), __uint_as_float(rw.y << 16), __uint_as_float(rw.y & 0xFFFF0000u)} + acc[ai][bj][m][0] * w;
                            const f32x4 v1 = (f32x4){__uint_as_float(rw.z << 16), __uint_as_float(rw.z & 0xFFFF0000u), __uint_as_float(rw.w << 16), __uint_as_float(rw.w & 0xFFFF0000u)} + acc[ai][bj][m][1] * w;
                            u32x4 o; o.x = cvt_pk_bf16(v0[0], v0[1]); o.y = cvt_pk_bf16(v0[2], v0[3]); o.z = cvt_pk_bf16(v1[0], v1[1]); o.w = cvt_pk_bf16(v1[2], v1[3]); *p = o; }
                    } else {
#pragma unroll
                        for (int bj = 0; bj < 2; ++bj) { const f32x4 v0 = acc[ai][bj][m][0] * w, v1 = acc[ai][bj][m][1] * w;
                            u32x4 o; o.x = cvt_pk_bf16(v0[0], v0[1]); o.y = cvt_pk_bf16(v0[2], v0[3]); o.z = cvt_pk_bf16(v1[0], v1[1]); o.w = cvt_pk_bf16(v1[2], v1[3]); *(GAS u32x4*)(y1 + off + bj * HALF) = o; }
                    }
                } }
    }
};

template <class Epi, class Sched, bool F8 = false>
__device__ __forceinline__ void gemm_phase(PG8_LAS unsigned char* lds, int xoff, const Gemm g, const Sched& S, const Epi& E) {
    int tid_ = threadIdx.x;
    asm volatile("" : "+v"(tid_));
    const int tid = tid_, wid = __builtin_amdgcn_readfirstlane(tid >> 6), lane = tid & 63, wr = wid >> 2, wc = wid & 3, fr = lane & 15, fq = lane >> 4;
    const int RB = g.rowb, nt = RB / 128;
    unsigned voffB[2];
#pragma unroll
    for (int i = 0; i < 2; ++i) { int R, C; stage_rc(tid * 16 + i * 8192, R, C); const int Rb = Epi::PERM ? ((R & ~31) + perm32(R & 31)) : R;
        voffB[i] = (unsigned)(Rb * RB + C * 2); }
    const size_t kstep = (size_t)(BK * 2);
    const size_t hstep = (size_t)HALF * RB;
    const size_t tstep = 2 * hstep;
    const unsigned ldsw = (unsigned)wid * 1024u;
    const int aoff = F8 ? lds_byte(wr * 64 + fr, fq * 16) : lds_byte(wr * 64 + fr, fq * 8), boff = F8 ? lds_byte(wc * 32 + fr, fq * 16) : lds_byte(wc * 32 + fr, fq * 8);
#define PG8_SA(b, h) (((b) * 2 + (h)) * HTB)
#define PG8_SB(b, h) ((4 + (b) * 2 + (h)) * HTB)
#define PG8_STAGE(bufoff, gbase, v0, v1) do { \
        __builtin_amdgcn_global_load_lds((const GAS unsigned*)((const char*)(gbase) + (v0)), (PG8_LAS unsigned*)(lds + (bufoff) + ldsw), 16, 0, 0); \
        __builtin_amdgcn_global_load_lds((const GAS unsigned*)((const char*)(gbase) + (v1)), (PG8_LAS unsigned*)(lds + (bufoff) + ldsw + 8192), 16, 0, 0); } while (0)
#define PG8_STAGEB(bufoff, gbase) PG8_STAGE(bufoff, gbase, voffB[0], voffB[1])
#define PG8_LDA(dst, b, h) do { if constexpr (F8) { _Pragma("unroll") for (int m = 0; m < 4; ++m) { dst##8[m].lo = *(const PG8_LAS i32x4*)(lds + PG8_SA(b, h) + aoff + m * 2048); dst##8[m].hi = *(const PG8_LAS i32x4*)(lds + PG8_SA(b, h) + aoff + m * 2048 + 16); } } \
        else { _Pragma("unroll") for (int m = 0; m < 4; ++m) _Pragma("unroll") for (int k = 0; k < 2; ++k) dst[m][k] = *(const PG8_LAS bf16x8*)(lds + PG8_SA(b, h) + aoff + m * 2048 + k * 1024); } } while (0)
#define PG8_LDB(dst, b, h) do { if constexpr (F8) { _Pragma("unroll") for (int n = 0; n < 2; ++n) { dst##8[n].lo = *(const PG8_LAS i32x4*)(lds + PG8_SB(b, h) + boff + n * 2048); dst##8[n].hi = *(const PG8_LAS i32x4*)(lds + PG8_SB(b, h) + boff + n * 2048 + 16); } } \
        else { _Pragma("unroll") for (int n = 0; n < 2; ++n) _Pragma("unroll") for (int k = 0; k < 2; ++k) dst[n][k] = *(const PG8_LAS bf16x8*)(lds + PG8_SB(b, h) + boff + n * 2048 + k * 1024); } } while (0)
#define PG8_MMA(ai, bj, At, Bt) do { __builtin_amdgcn_s_setprio(1); _Pragma("unroll") for (int m = 0; m < 4; ++m) _Pragma("unroll") for (int n = 0; n < 2; ++n) { \
        if constexpr (F8) acc[ai][bj][m][n] = __builtin_amdgcn_mfma_scale_f32_16x16x128_f8f6f4(Bt##8[n], At##8[m], acc[ai][bj][m][n], 0, 0, 0, 0x7F7F7F7F, 0, 0x7F7F7F7F); \
        else { _Pragma("unroll") for (int k = 0; k < 2; ++k) acc[ai][bj][m][n] = __builtin_amdgcn_mfma_f32_16x16x32_bf16(Bt[n][k], At[m][k], acc[ai][bj][m][n], 0, 0, 0); } } __builtin_amdgcn_s_setprio(0); } while (0)
#define PG8_WAIT_V(n) asm volatile("s_waitcnt vmcnt(" #n ")" ::: "memory")
#define PG8_WAIT_L(n) asm volatile("s_waitcnt lgkmcnt(" #n ")" ::: "memory")
#define PG8_BAR __builtin_amdgcn_s_barrier()
#define PG8_SCHED __builtin_amdgcn_sched_barrier(0)
#define PG8_AOFFS(U, o00, o01, o10, o11) do { int R0_, C0_, R1_, C1_; stage_rc(tid * 16, R0_, C0_); stage_rc(tid * 16 + 8192, R1_, C1_);     \
        o00 = S.arow(U, R0_) * (unsigned)RB + (unsigned)C0_ * 2u; o01 = S.arow(U, R1_) * (unsigned)RB + (unsigned)C1_ * 2u; \
        o10 = S.arow(U, HALF + R0_) * (unsigned)RB + (unsigned)C0_ * 2u; o11 = S.arow(U, HALF + R1_) * (unsigned)RB + (unsigned)C1_ * 2u; } while (0)
    Unit cur, nxt; int ui = 0;
    if (!S.next(0, cur)) return;
    f32x4 acc[2][2][4][2];
#pragma unroll
    for (int a = 0; a < 2; ++a)
#pragma unroll
        for (int b = 0; b < 2; ++b)
#pragma unroll
            for (int m = 0; m < 4; ++m)
#pragma unroll
                for (int n = 0; n < 2; ++n) acc[a][b][m][n] = (f32x4){0.f, 0.f, 0.f, 0.f};
    bf16x8 At[4][2], B0[2][2], B1[2][2];
    i32x8 At8[4], B08[2], B18[2];
    unsigned c00, c01, c10, c11;
    PG8_LAS u32x4* const xslot = (PG8_LAS u32x4*)(lds + xoff) + tid;
    PG8_AOFFS(cur, c00, c01, c10, c11);
    const char* const gA = (const char*)g.A;
    const char* cB = (const char*)g.Bt + (size_t)cur.e * g.bstride + (size_t)cur.pn * tstep;
    PG8_STAGEB(PG8_SB(0, 0), cB); PG8_STAGEB(PG8_SB(0, 1), cB + hstep); PG8_STAGE(PG8_SA(0, 0), gA, c00, c01); PG8_STAGE(PG8_SA(0, 1), gA, c10, c11);
    if (wr == 1) PG8_BAR;
    PG8_WAIT_V(2); PG8_BAR;
    PG8_STAGEB(PG8_SB(1, 0), cB + kstep); PG8_STAGE(PG8_SA(1, 0), gA + kstep, c00, c01); PG8_STAGEB(PG8_SB(1, 1), cB + hstep + kstep);
    PG8_WAIT_V(6); PG8_BAR;
    for (;;) {
        const bool has_next = S.next(ui + 1, nxt);
        const char* nB_ = has_next ? (const char*)g.Bt + (size_t)nxt.e * g.bstride + (size_t)nxt.pn * tstep : cB;
        const char* nB = nB_;
        if (has_next) { unsigned n00, n01, n10, n11; PG8_AOFFS(nxt, n00, n01, n10, n11); *xslot = (u32x4){n00, n01, n10, n11}; }
#pragma unroll 1
        for (int t = 0; t < nt; t += 2) {
            const bool last = (t == nt - 2);
            const char* a1 = gA + (size_t)(t + 1) * kstep;
            const char* a2 = last ? gA : gA + (size_t)(t + 2) * kstep; const char* b2 = last ? nB : cB + (size_t)(t + 2) * kstep;
            const char* a3 = a2 + kstep; const char* b3 = b2 + kstep;
            PG8_LDB(B0, 0, 0); PG8_LDB(B1, 0, 1); PG8_SCHED; PG8_LDA(At, 0, 0); PG8_STAGE(PG8_SA(1, 1), a1, c10, c11);
            if (last && has_next) { const u32x4 nx = *xslot; c00 = nx.x; c01 = nx.y; c10 = nx.z; c11 = nx.w; }
            PG8_WAIT_V(8); PG8_WAIT_L(0); PG8_BAR; PG8_MMA(0, 0, At, B0); PG8_MMA(0, 1, At, B1); PG8_BAR; PG8_SCHED;
            PG8_LDA(At, 0, 1); PG8_STAGEB(PG8_SB(0, 0), b2); PG8_STAGEB(PG8_SB(0, 1), b2 + hstep); PG8_STAGE(PG8_SA(0, 0), a2, c00, c01);
            PG8_WAIT_V(8); PG8_WAIT_L(0); PG8_BAR; PG8_MMA(1, 0, At, B0); PG8_MMA(1, 1, At, B1); PG8_BAR; PG8_SCHED;
            PG8_LDB(B0, 1, 0); PG8_LDB(B1, 1, 1); PG8_SCHED; PG8_LDA(At, 1, 0); PG8_STAGE(PG8_SA(0, 1), a2, c10, c11);
            PG8_WAIT_V(8); PG8_WAIT_L(0); PG8_BAR; PG8_MMA(0, 0, At, B0); PG8_MMA(0, 1, At, B1); PG8_BAR; PG8_SCHED;
            PG8_LDA(At, 1, 1); PG8_STAGEB(PG8_SB(1, 0), b3); PG8_STAGEB(PG8_SB(1, 1), b3 + hstep); PG8_STAGE(PG8_SA(1, 0), a3, c00, c01);
            PG8_WAIT_V(8); PG8_WAIT_L(0); PG8_BAR; PG8_MMA(1, 0, At, B0); PG8_MMA(1, 1, At, B1); PG8_BAR; PG8_SCHED;
        }
        if (wr == 0) PG8_BAR;
        E(acc, cur, wr, wc, fr, fq);
        if (!has_next) break;
#pragma unroll
        for (int a = 0; a < 2; ++a)
#pragma unroll
            for (int b = 0; b < 2; ++b)
#pragma unroll
                for (int m = 0; m < 4; ++m)
#pragma unroll
                    for (int n = 0; n < 2; ++n) acc[a][b][m][n] = (f32x4){0.f, 0.f, 0.f, 0.f};
        cur = nxt; cB = nB; ++ui;
        if (wr == 1) PG8_BAR;
    }
    PG8_WAIT_V(0);
    PG8_BAR;
#undef PG8_SA
#undef PG8_SB
#undef PG8_STAGE
#undef PG8_STAGEB
#undef PG8_LDA
#undef PG8_LDB
#undef PG8_MMA
#undef PG8_WAIT_V
#undef PG8_WAIT_L
#undef PG8_BAR
#undef PG8_SCHED
#undef PG8_AOFFS
}
}

namespace att {
typedef unsigned short bf16_t;
typedef short bf16x8 __attribute__((ext_vector_type(8)));
typedef short s16x4 __attribute__((ext_vector_type(4)));
typedef float f32x16 __attribute__((ext_vector_type(16)));
typedef float f32x4 __attribute__((ext_vector_type(4)));
typedef unsigned u32x4 __attribute__((ext_vector_type(4)));
constexpr int PITCH = 1024;
constexpr float LOG2E = 1.4426950408889634f;
__device__ __forceinline__ int crow(int r, int hi) { return (r & 3) + 8 * (r >> 2) + 4 * hi; }
typedef float f32x2_t __attribute__((ext_vector_type(2))); typedef __bf16 bf16x2_t __attribute__((ext_vector_type(2)));
__device__ __forceinline__ unsigned cvtpk(float lo, float hi) { f32x2_t v = {lo, hi}; bf16x2_t b = __builtin_convertvector(v, bf16x2_t); return __builtin_bit_cast(unsigned, b); }
__device__ __forceinline__ float bf2f(short s) { return __uint_as_float(((unsigned)(unsigned short)s) << 16); }
typedef short v4i16_t __attribute__((ext_vector_type(4)));
__device__ __forceinline__ s16x4 vtr(const LAS unsigned char* p) { return __builtin_bit_cast(s16x4, __builtin_amdgcn_ds_read_tr16_b64_v4i16((LAS v4i16_t*)p)); }
__device__ __forceinline__ float max3f(float a, float b, float c) { float r; asm("v_max3_f32 %0, %1, %2, %3" : "=v"(r) : "v"(a), "v"(b), "v"(c)); return r; }
__device__ __forceinline__ float halves_max(float m) { auto rr = __builtin_amdgcn_permlane32_swap(__float_as_uint(m), __float_as_uint(m), false, false); return fmaxf(__uint_as_float(rr[0]), __uint_as_float(rr[1])); }
__device__ __forceinline__ float halves_sum(float m) { auto rr = __builtin_amdgcn_permlane32_swap(__float_as_uint(m), __float_as_uint(m), false, false); return __uint_as_float(rr[0]) + __uint_as_float(rr[1]); }
#define ATT_PRIO(x) do { if (wid >= 4) __builtin_amdgcn_s_setprio(1 + (x)); else __builtin_amdgcn_s_setprio(x); } while (0)
#define ATT_BAR() asm volatile("s_waitcnt vmcnt(0) lgkmcnt(0)\n\ts_barrier" ::: "memory")
typedef unsigned u32x2 __attribute__((ext_vector_type(2)));
#define ATT_RD128(d, a, off) asm volatile("ds_read_b128 %0, %1 offset:%2" : "=v"(d) : "v"(a), "n"(off))
#define ATT_RDTR(d, a, off) asm volatile("ds_read_b64_tr_b16 %0, %1 offset:%2" : "=v"(d) : "v"(a), "n"(off))
#define ATT_WAIT2(n, x, y) asm volatile("s_waitcnt lgkmcnt(" #n ")" : "+v"(x), "+v"(y))

struct Args { const bf16_t* Q; const bf16_t* K; const bf16_t* V; bf16_t* O; const float* kmean; const float* kmax2; const float* subln; float lam_full; float out_scale; int abl; };
#ifndef ATT_ABLATE
#define ATT_ABLATE 0
#endif
#if ATT_ABLATE
#define ABL(bit) ((((ATT_ABLATE) >> (bit)) & 1) && abl_)
#else
#define ABL(bit) 0
#endif

template <int MODE>
__device__ __forceinline__ void attn_unit(LAS unsigned char* lds, const Args& A, int b, int h, int qblk) {
    constexpr int DVB = MODE == 0 ? 4 : 2;
    constexpr int NCH = MODE == 0 ? 16 : 8;
    constexpr int KBY = NCH * 1024, VBY = DVB * 4096, SLOT = KBY + VBY;
    constexpr int QR = MODE == 0 ? 128 : 256;
    constexpr int PPW = MODE == 0 ? 2 : 1;
    int tid_ = threadIdx.x; asm volatile("" : "+v"(tid_));
    const int tid = tid_, lane = tid & 63, r32 = lane & 31, hi = lane >> 5;
    const int wid = __builtin_amdgcn_readfirstlane(tid >> 6);
    const int comp = MODE == 0 ? (wid >> 2) : 0, wq = MODE == 0 ? (wid & 3) : wid;
    const int q0 = qblk * QR; const long rowbase = (long)b * SEQ;
    const int hcol = MODE == 0 ? h * 128 : h * 64;
    const int qrel0 = wq * 32;
    const float slope2 = __builtin_amdgcn_exp2f(MODE == 0 ? -(float)(h + 1) : -0.5f * (float)(h + 1)) * LOG2E;
    const int NT = MODE == 0 ? 2 * qblk + 2 : 4 + 4 * qblk;
#define ATT_KBASE_(t) (MODE == 0 ? 64 * (t) : ((t) < 4 ? q0 + 64 * (t) : 64 * ((t) - 4)))
#define ATT_KBASE(t) ATT_KBASE_(t)
    LAS float* wsf = (LAS float*)(lds + 65536) + wid * 64;
    const bf16_t* Kb = A.K + rowbase * PITCH + hcol;
    const bf16_t* Vb = A.V + rowbase * PITCH + hcol;
#define ATT_ISSUE_K(tt, slot) do { const int kb_ = ATT_KBASE(tt); \
        _Pragma("unroll") for (int i_ = 0; i_ < PPW; ++i_) { const int p_ = wid + 8 * i_; \
            __builtin_amdgcn_global_load_lds((const GAS unsigned*)(Kb + (size_t)(kb_ + lane) * PITCH + p_ * 8), (LAS unsigned*)(lds + (slot) * SLOT + p_ * 1024), 16, 0, 0); } } while (0)
#define ATT_ISSUE_V(tt, slot) do { const int kb_ = ATT_KBASE(tt); \
        _Pragma("unroll") for (int i_ = 0; i_ < PPW; ++i_) { const int p_ = wid + 8 * i_; \
            __builtin_amdgcn_global_load_lds((const GAS unsigned*)(Vb + (size_t)(kb_ + 16 * (p_ & 3) + (lane >> 2)) * PITCH + (p_ >> 2) * 32 + (lane & 3) * 8), (LAS unsigned*)(lds + (slot) * SLOT + KBY + p_ * 1024), 16, 0, 0); } } while (0)
    asm volatile("s_waitcnt lgkmcnt(0)\n\ts_barrier" ::: "memory");
    bf16x8 qr[4];
    { const bf16_t* Qw = A.Q + (rowbase + q0 + qrel0 + r32) * PITCH + hcol + comp * 64 + hi * 8;
#pragma unroll
      for (int d0 = 0; d0 < 4; ++d0) qr[d0] = *(const GAS bf16x8*)(Qw + d0 * 16); }
    const int tt_l = MODE == 0 ? (lane < 2 ? 2 * qblk + lane : lane - 2) : lane;
    const int kbase_l = (lane < NT) ? ATT_KBASE_(tt_l) : 0;
    const bool past_l = lane < NT && kbase_l + 64 <= q0;
    float k2a = 0.f, k2b = 0.f;
    { const int nblk = (kbase_l >> 8) & 15;
        if constexpr (MODE == 0) { k2a = ((const GAS float*)A.kmax2)[(size_t)(b * 16 + h * 2) * 16 + nblk]; k2b = ((const GAS float*)A.kmax2)[(size_t)(b * 16 + h * 2 + 1) * 16 + nblk]; }
        else k2a = ((const GAS float*)A.kmax2)[(size_t)(b * 16 + h) * 16 + nblk]; }
    float kmv0 = 0.f, kmv1 = 0.f;
    if constexpr (MODE == 1) { kmv0 = ((const GAS float*)A.kmean)[(size_t)(b * 16 + h) * 1024 + tid]; kmv1 = ((const GAS float*)A.kmean)[(size_t)(b * 16 + h) * 1024 + 512 + tid]; }
    const int t0 = MODE == 0 ? 2 * qblk : 0, t1 = t0 + 1;
    ATT_ISSUE_K(t0, 0); ATT_ISSUE_V(t0, 0); ATT_ISSUE_K(t1, 1);
    LAS int* live = (LAS int*)(lds + 71680); LAS float* qnx = (LAS float*)(lds + 71680 + 272);
    LAS float* km = (LAS float*)(lds + 67584);
    { float q2 = 0.f;
#pragma unroll
      for (int d0 = 0; d0 < 4; ++d0)
#pragma unroll
        for (int j = 0; j < 8; ++j) { const float v = bf2f(qr[d0][j]); q2 += v * v; }
      q2 = halves_sum(q2);
      q2 = fmaxf(q2, __shfl_xor(q2, 1)); q2 = fmaxf(q2, __shfl_xor(q2, 2)); q2 = fmaxf(q2, __shfl_xor(q2, 4)); q2 = fmaxf(q2, __shfl_xor(q2, 8)); q2 = fmaxf(q2, __shfl_xor(q2, 16));
      if (lane == 0) qnx[wid] = q2; }
    if constexpr (MODE == 1) { km[tid] = kmv0; km[tid + 512] = kmv1; }
    ATT_BAR();
    if (wid == 0) {
        bool alive = lane < NT;
        if (past_l) { float bound;
            if constexpr (MODE == 0) { const float qa = fmaxf(fmaxf(qnx[0], qnx[1]), fmaxf(qnx[2], qnx[3])), qb = fmaxf(fmaxf(qnx[4], qnx[5]), fmaxf(qnx[6], qnx[7]));
                bound = fmaxf(sqrtf(qa) * sqrtf(k2a), sqrtf(qb) * sqrtf(k2b));
            } else { float qm = qnx[0];
#pragma unroll
                for (int w = 1; w < 8; ++w) qm = fmaxf(qm, qnx[w]);
                bound = sqrtf(qm) * sqrtf(k2a); }
            alive = !(bound * 1.001f + 1.0f + slope2 * (float)(kbase_l + 63 - q0) < -152.0f);
        }
        const unsigned long long am = __ballot(alive);
        if (alive) live[__popcll(am & ((1ull << lane) - 1ull))] = tt_l;
        if (lane == 0) live[64] = __popcll(am);
    }
    unsigned sel = 0u;
    if constexpr (MODE == 1) {
        float g[16];
#pragma unroll
        for (int n = 0; n < 16; ++n) { float s = 0.f;
            if (n < qblk) {
#pragma unroll
                for (int d0 = 0; d0 < 4; ++d0) { const f32x4 ka = *(const LAS f32x4*)(km + n * 64 + d0 * 16 + hi * 8), kb2 = *(const LAS f32x4*)(km + n * 64 + d0 * 16 + hi * 8 + 4);
                    s += bf2f(qr[d0][0]) * ka[0] + bf2f(qr[d0][1]) * ka[1] + bf2f(qr[d0][2]) * ka[2] + bf2f(qr[d0][3]) * ka[3]
                       + bf2f(qr[d0][4]) * kb2[0] + bf2f(qr[d0][5]) * kb2[1] + bf2f(qr[d0][6]) * kb2[2] + bf2f(qr[d0][7]) * kb2[3]; }
                s = halves_sum(s); }
            g[n] = s; }
        const int nsel = qblk < 3 ? qblk : 3;
#pragma unroll
        for (int k = 0; k < 3; ++k) if (k < nsel) { float best = -INFINITY; int bi = 0; bool found = false;
#pragma unroll
            for (int n = 0; n < 16; ++n) if (n < qblk) { const bool free_ = ((sel >> n) & 1u) == 0u; if (free_ && (!found || g[n] > best)) { best = g[n]; bi = n; found = true; } }
            sel |= 1u << bi; }
    }
    ATT_BAR();
    const int NTL = __builtin_amdgcn_readfirstlane(live[64]);
#define ATT_ISSUE(t, slot) do { const int kb_ = ATT_KBASE(t); \
        _Pragma("unroll") for (int i_ = 0; i_ < PPW; ++i_) { const int p_ = wid + 8 * i_; \
            __builtin_amdgcn_global_load_lds((const GAS unsigned*)(Kb + (size_t)(kb_ + lane) * PITCH + p_ * 8), (LAS unsigned*)(lds + (slot) * SLOT + p_ * 1024), 16, 0, 0); \
            __builtin_amdgcn_global_load_lds((const GAS unsigned*)(Vb + (size_t)(kb_ + 16 * (p_ & 3) + (lane >> 2)) * PITCH + (p_ >> 2) * 32 + (lane & 3) * 8), (LAS unsigned*)(lds + (slot) * SLOT + KBY + p_ * 1024), 16, 0, 0); } } while (0)
    constexpr float THR = 8.0f;
    float mref = 0.f, l = 0.f; f32x16 o[DVB];
#pragma unroll
    for (int d0 = 0; d0 < DVB; ++d0) o[d0] = f32x16{};
#define ATT_CLASS(tt, SK, NM, SB) do { const int kb_ = ATT_KBASE(tt), kr_ = kb_ - q0; const bool dg_ = kb_ >= q0; SK = dg_ && (kr_ > qrel0 + 31); NM = dg_ && (kr_ + 63 > qrel0); SB = true; \
        if constexpr (MODE == 1) { if ((tt) >= 4) { SB = ((sel >> (((tt) - 4) >> 2)) & 1u) != 0u; if (!__any(SB)) SK = true; } } } while (0)
#define ATT_QK(P0, P1, tt, slot, SB) do { const int kr_ = ATT_KBASE(tt) - q0; float off0_ = slope2 * (float)(kr_ + 4 * hi) - mref; if (!(SB)) off0_ = -INFINITY; const float off1_ = off0_ + 32.0f * slope2; \
        const unsigned ka_ = (unsigned)(size_t)(lds + (slot) * SLOT + comp * 8192 + hi * 1024 + r32 * 16); u32x4 kx_[4], ky_[4]; \
        ATT_RD128(kx_[0], ka_, 0); ATT_RD128(ky_[0], ka_, 512); ATT_RD128(kx_[1], ka_, 2048); ATT_RD128(ky_[1], ka_, 2560); \
        _Pragma("unroll") for (int r = 0; r < 16; ++r) { const float cbr = slope2 * (float)((r & 3) + 8 * (r >> 2)); P0[r] = cbr + off0_; P1[r] = cbr + off1_; } \
        ATT_PRIO(1); ATT_WAIT2(2, kx_[0], ky_[0]); P0 = __builtin_amdgcn_mfma_f32_32x32x16_bf16(__builtin_bit_cast(bf16x8, kx_[0]), qr[0], P0, 0, 0, 0); P1 = __builtin_amdgcn_mfma_f32_32x32x16_bf16(__builtin_bit_cast(bf16x8, ky_[0]), qr[0], P1, 0, 0, 0); \
        ATT_RD128(kx_[2], ka_, 4096); ATT_RD128(ky_[2], ka_, 4608); \
        ATT_WAIT2(2, kx_[1], ky_[1]); P0 = __builtin_amdgcn_mfma_f32_32x32x16_bf16(__builtin_bit_cast(bf16x8, kx_[1]), qr[1], P0, 0, 0, 0); P1 = __builtin_amdgcn_mfma_f32_32x32x16_bf16(__builtin_bit_cast(bf16x8, ky_[1]), qr[1], P1, 0, 0, 0); \
        ATT_RD128(kx_[3], ka_, 6144); ATT_RD128(ky_[3], ka_, 6656); \
        ATT_WAIT2(2, kx_[2], ky_[2]); P0 = __builtin_amdgcn_mfma_f32_32x32x16_bf16(__builtin_bit_cast(bf16x8, kx_[2]), qr[2], P0, 0, 0, 0); P1 = __builtin_amdgcn_mfma_f32_32x32x16_bf16(__builtin_bit_cast(bf16x8, ky_[2]), qr[2], P1, 0, 0, 0); \
        ATT_WAIT2(0, kx_[3], ky_[3]); P0 = __builtin_amdgcn_mfma_f32_32x32x16_bf16(__builtin_bit_cast(bf16x8, kx_[3]), qr[3], P0, 0, 0, 0); P1 = __builtin_amdgcn_mfma_f32_32x32x16_bf16(__builtin_bit_cast(bf16x8, ky_[3]), qr[3], P1, 0, 0, 0); ATT_PRIO(0); } while (0)
    f32x16 p0, p1, n0, n1;
    const int abl_ = __builtin_amdgcn_readfirstlane(A.abl); (void)abl_;
    int t = t0, tn = t1;
    bool skipC, maskC, selC, skipN = true, maskN = false, selN = true;
    ATT_CLASS(t, skipC, maskC, selC);
    if (!skipC) ATT_QK(p0, p1, t, 0, selC);
    const int NTLX = ABL(4) ? 1 : NTL;
    ATT_PRIO(0);
    for (int it = 0; it < NTLX; ++it) {
        ATT_BAR();
        const int tnn = (it + 2 < NTL) ? __builtin_amdgcn_readfirstlane(live[it + 2]) : 0;
        if (it + 2 < NTL && !ABL(0)) ATT_ISSUE_K(tnn, it & 1);
        if (it + 1 < NTL) { if (!ABL(0)) ATT_ISSUE_V(tn, (it + 1) & 1); ATT_CLASS(tn, skipN, maskN, selN); if (!skipN) { if (!ABL(2)) ATT_QK(n0, n1, tn, (it + 1) & 1, selN); else { n0 = f32x16{} - 1.0f; n1 = n0; } } } else skipN = true;
        if (!skipC) {
            const int krel = ATT_KBASE(t) - q0;
            const unsigned va_ = (unsigned)(size_t)(lds + (it & 1) * SLOT + KBY + ((lane >> 4) & 1) * 32 + (lane & 3) * 8 + (4 * hi + ((lane & 15) >> 2)) * 64);
            u32x2 vl_[4], vh_[4];
            if (!ABL(1)) { ATT_RDTR(vl_[0], va_, 0); ATT_RDTR(vh_[0], va_, 512); ATT_RDTR(vl_[1], va_, 1024); ATT_RDTR(vh_[1], va_, 1536);
            ATT_RDTR(vl_[2], va_, 2048); ATT_RDTR(vh_[2], va_, 2560); ATT_RDTR(vl_[3], va_, 3072); ATT_RDTR(vh_[3], va_, 3584); }
            if (maskC) { const int qrel = qrel0 + r32;
#pragma unroll
                for (int r = 0; r < 16; ++r) { const int kv = krel + crow(r, hi); if (kv > qrel) p0[r] = -INFINITY; if (kv + 32 > qrel) p1[r] = -INFINITY; } }
            float rm;
            { float a_ = max3f(p0[0], p0[1], p1[0]), b_ = max3f(p0[2], p0[3], p1[1]); a_ = max3f(a_, p1[2], p1[3]);
#pragma unroll
              for (int r = 4; r < 16; r += 4) { a_ = max3f(a_, p0[r], p0[r + 1]); b_ = max3f(b_, p0[r + 2], p0[r + 3]); a_ = max3f(a_, p1[r], p1[r + 1]); b_ = max3f(b_, p1[r + 2], p1[r + 3]); }
              rm = halves_max(fmaxf(a_, b_)); }
            if (__any(rm > THR)) {
                const float dl = fmaxf(rm, 0.f); mref += dl; const float alpha = __builtin_amdgcn_exp2f(-dl);
#pragma unroll
                for (int r = 0; r < 16; ++r) { p0[r] -= dl; p1[r] -= dl; }
                if (!skipN) {
#pragma unroll
                    for (int r = 0; r < 16; ++r) { n0[r] -= dl; n1[r] -= dl; } }
                l *= alpha;
                if (hi == 0) wsf[r32] = alpha;
                asm volatile("s_waitcnt lgkmcnt(0)" ::: "memory");
#pragma unroll
                for (int gq = 0; gq < 4; ++gq) { const f32x4 f = *(const LAS f32x4*)(wsf + 8 * gq + 4 * hi);
#pragma unroll
                    for (int d0 = 0; d0 < DVB; ++d0) { o[d0][4 * gq + 0] *= f[0]; o[d0][4 * gq + 1] *= f[1]; o[d0][4 * gq + 2] *= f[2]; o[d0][4 * gq + 3] *= f[3]; } }
            }
            float sacc = 0.f;
            if (!ABL(3)) {
#pragma unroll
            for (int r = 0; r < 16; ++r) { p0[r] = __builtin_amdgcn_exp2f(p0[r]); p1[r] = __builtin_amdgcn_exp2f(p1[r]); sacc += p0[r] + p1[r]; } }
            l += sacc;
            u32x4 pw[4];
            pw[0] = (u32x4){cvtpk(p0[0], p0[1]), cvtpk(p0[2], p0[3]), cvtpk(p0[4], p0[5]), cvtpk(p0[6], p0[7])};
            pw[1] = (u32x4){cvtpk(p0[8], p0[9]), cvtpk(p0[10], p0[11]), cvtpk(p0[12], p0[13]), cvtpk(p0[14], p0[15])};
            pw[2] = (u32x4){cvtpk(p1[0], p1[1]), cvtpk(p1[2], p1[3]), cvtpk(p1[4], p1[5]), cvtpk(p1[6], p1[7])};
            pw[3] = (u32x4){cvtpk(p1[8], p1[9]), cvtpk(p1[10], p1[11]), cvtpk(p1[12], p1[13]), cvtpk(p1[14], p1[15])};
            if (!ABL(1))
#pragma unroll
            for (int i = 0; i < 4 * DVB; ++i) { constexpr int NM = 4 * DVB; const int s_ = i & 3; if (i == 0) ATT_PRIO(1);
                if (i + 3 < NM) ATT_WAIT2(6, vl_[s_], vh_[s_]); else if (i + 3 == NM) ATT_WAIT2(4, vl_[s_], vh_[s_]); else if (i + 2 == NM) ATT_WAIT2(2, vl_[s_], vh_[s_]); else ATT_WAIT2(0, vl_[s_], vh_[s_]);
                const u32x4 vf = (u32x4){vl_[s_][0], vl_[s_][1], vh_[s_][0], vh_[s_][1]};
                o[i >> 2] = __builtin_amdgcn_mfma_f32_32x32x16_bf16(__builtin_bit_cast(bf16x8, pw[i & 3]), __builtin_bit_cast(bf16x8, vf), o[i >> 2], 0, 0, 0);
                if (i + 4 < NM) { ATT_RDTR(vl_[s_], va_, (i + 4) * 1024); ATT_RDTR(vh_[s_], va_, (i + 4) * 1024 + 512); } if (i == NM - 1) ATT_PRIO(0); }
        }
        p0 = n0; p1 = n1; skipC = skipN; maskC = maskN; selC = selN; t = tn; tn = tnn;
    }
#undef ATT_ISSUE_K
#undef ATT_ISSUE_V
#undef ATT_CLASS
#undef ATT_QK
    __builtin_amdgcn_s_setprio(0);
    if (ABL(5)) return;
    float sg[DVB];
    if constexpr (MODE == 0) {
#pragma unroll
        for (int d0 = 0; d0 < DVB; ++d0) sg[d0] = ((const GAS float*)A.subln)[d0 * 32 + r32]; }
    l = halves_sum(l);
    if (hi == 0) wsf[32 + r32] = l;
    asm volatile("s_waitcnt lgkmcnt(0)" ::: "memory");
    float rli[16];
#pragma unroll
    for (int gq = 0; gq < 4; ++gq) { const f32x4 f = *(const LAS f32x4*)(wsf + 32 + 8 * gq + 4 * hi); rli[4 * gq + 0] = 1.0f / f[0]; rli[4 * gq + 1] = 1.0f / f[1]; rli[4 * gq + 2] = 1.0f / f[2]; rli[4 * gq + 3] = 1.0f / f[3]; }
    if constexpr (MODE == 1) {
        GAS bf16_t* Ow = (GAS bf16_t*)(A.O + (rowbase + q0 + qrel0) * PITCH + hcol);
#pragma unroll
        for (int r = 0; r < 16; ++r)
#pragma unroll
            for (int d0 = 0; d0 < DVB; ++d0) Ow[(size_t)crow(r, hi) * PITCH + d0 * 32 + r32] = (bf16_t)(cvtpk(o[d0][r] * rli[r], 0.f) & 0xFFFFu);
    } else {
        ATT_BAR();
        LAS float* X = (LAS float*)lds + wq * 4096;
        if (comp == 1) {
#pragma unroll
            for (int d0 = 0; d0 < DVB; ++d0)
#pragma unroll
                for (int r = 0; r < 16; ++r) X[(d0 * 16 + r) * 64 + lane] = o[d0][r] * rli[r];
        }
        ATT_BAR();
        if (comp == 0) {
#pragma unroll
            for (int d0 = 0; d0 < DVB; ++d0) sg[d0] *= A.out_scale;
            GAS bf16_t* Ow = (GAS bf16_t*)(A.O + (rowbase + q0 + qrel0) * PITCH + hcol);
#pragma unroll
            for (int r = 0; r < 16; ++r) { float dv[DVB]; float ss = 0.f;
#pragma unroll
                for (int d0 = 0; d0 < DVB; ++d0) { dv[d0] = o[d0][r] * rli[r] - A.lam_full * X[(d0 * 16 + r) * 64 + lane]; ss += dv[d0] * dv[d0]; }
                ss += __int_as_float(__builtin_amdgcn_update_dpp(0, __float_as_int(ss), 0xB1, 0xF, 0xF, true)); ss += __int_as_float(__builtin_amdgcn_update_dpp(0, __float_as_int(ss), 0x4E, 0xF, 0xF, true));
                ss += __int_as_float(__builtin_amdgcn_update_dpp(0, __float_as_int(ss), 0x141, 0xF, 0xF, true)); ss += __int_as_float(__builtin_amdgcn_update_dpp(0, __float_as_int(ss), 0x140, 0xF, 0xF, true));
                ss += __int_as_float(__builtin_amdgcn_ds_swizzle(__float_as_int(ss), 0x401F));
                const float rs = 1.0f / sqrtf(ss * (1.0f / 128.0f) + 1e-5f);
#pragma unroll
                for (int d0 = 0; d0 < DVB; ++d0) Ow[(size_t)crow(r, hi) * PITCH + d0 * 32 + r32] = (bf16_t)(cvtpk(dv[d0] * rs * sg[d0], 0.f) & 0xFFFFu); }
        }
    }
#undef ATT_KBASE
#undef ATT_KBASE_
#undef ATT_ISSUE
}
#undef ATT_BAR
}

constexpr int NWAVES = 8;
constexpr int NLAYER = 4, PH_PER_LAYER = 8, NPHASE = 1 + NLAYER * PH_PER_LAYER;

constexpr size_t MiB = 1u << 20;
constexpr size_t WS_CTL = 0, CTL_ZERO_BYTES = 1 * MiB;
constexpr size_t WS_KMEAN = 1 * MiB;
constexpr size_t WS_LTOK = 2 * MiB, WS_LW = 3 * MiB;
constexpr size_t WS_DQKV = 5 * MiB;
constexpr size_t WS_DWO = WS_DQKV + 12 * MiB;
constexpr size_t WS_MQKV = WS_DWO + 4 * MiB;
constexpr size_t WS_MWO = WS_MQKV + 12 * MiB;
constexpr size_t WS_FGU = WS_MWO + 4 * MiB;
constexpr size_t WS_FD = WS_FGU + 22 * MiB;
constexpr size_t WS_MGU = WS_FD + 11 * MiB;
constexpr size_t WS_MD = WS_MGU + 112 * MiB;
constexpr size_t WS_XN = WS_MD + 56 * MiB;
constexpr size_t WS_Q = WS_XN + 64 * MiB, WS_K = WS_Q + 64 * MiB, WS_V = WS_K + 64 * MiB;
constexpr size_t WS_ACT = WS_Q;
constexpr size_t WS_END = WS_ACT + (size_t)MOE_TILES_MAX * 256 * DE * 2;
constexpr size_t WS_HB = WS_END;
static_assert(WS_XN == 238 * MiB && WS_END == 778 * MiB, "d_ws map");
constexpr int CW_BAR = 4096;
constexpr int CW_ATTQ = 6144;
constexpr int CW_ATTQ2 = 12288;
constexpr int CW_CNT = 8192;

constexpr int RING_OFF = 0, RING_BYTES = 131072;
constexpr int LDSCTL_OFF = RING_BYTES, MISC_OFF = LDSCTL_OFF + 320;
constexpr int XSLOT_OFF = MISC_OFF + 128;
constexpr int LDS_BYTES = 147456;

typedef unsigned short bf16;
typedef unsigned v4u __attribute__((ext_vector_type(4)));
typedef float f32x4 __attribute__((ext_vector_type(4)));
typedef GAS unsigned gu32;
#define RLX_AGENT __ATOMIC_RELAXED, __HIP_MEMORY_SCOPE_AGENT
#define LDS_WAIT() asm volatile("s_waitcnt lgkmcnt(0)" ::: "memory")
#define VM_WAIT() asm volatile("s_waitcnt vmcnt(0)" ::: "memory")
__device__ __forceinline__ unsigned f2bf(float f) { unsigned u = __builtin_bit_cast(unsigned, f); return (u + 0x7fffu + ((u >> 16) & 1u)) >> 16; }
__device__ __forceinline__ unsigned pk2(float lo, float hi) { return f2bf(lo) | (f2bf(hi) << 16); }
__device__ __forceinline__ float bflo(unsigned w) { return __uint_as_float(w << 16); }
__device__ __forceinline__ float bfhi(unsigned w) { return __uint_as_float(w & 0xFFFF0000u); }
static_assert(XSLOT_OFF % 16 == 0 && XSLOT_OFF + 8192 <= LDS_BYTES, "LDS map");
#define XB_TMO      128
#define XB_XCNT(j)  (256  + 64 * (j))
#define XB_XSUB(j)  (1280 + 64 * (j))
#define XB_XGEN(j)  (2304 + 64 * (j))
#define XB_TOP      3328
#define XB_TOPGEN   3392
#define XCD_BAR_WORDS 3456
#define XB_SPIN_CAP (1u << 18)

__device__ __forceinline__ unsigned xb_ld(unsigned* p)              { return __hip_atomic_load(p, __ATOMIC_RELAXED, __HIP_MEMORY_SCOPE_AGENT); }
__device__ __forceinline__ unsigned xb_add(unsigned* p, unsigned v) { return __hip_atomic_fetch_add(p, v, __ATOMIC_RELAXED, __HIP_MEMORY_SCOPE_AGENT); }
__device__ __forceinline__ unsigned xb_xcc_id() { return (unsigned)__builtin_amdgcn_s_getreg((3 << 11) | 20) & 0xFu; }
#define XB_SPIN(cond, bar) do { unsigned _sp = 0; while (cond) { __builtin_amdgcn_s_sleep(1); \
    if ((++_sp & 255u) == 0u) { if (xb_ld(&(bar)[XB_TMO])) break; if (_sp > XB_SPIN_CAP) { atomicAdd(&(bar)[XB_TMO], 1u); break; } } } } while (0)

struct XcdBarrier {
    unsigned* bar; unsigned x;
    volatile LAS unsigned* st;
};

__device__ __forceinline__ XcdBarrier xcd_barrier_post(unsigned* bar, volatile LAS unsigned* st) {
    XcdBarrier b; b.bar = bar; b.x = xb_xcc_id(); b.st = st;
    if (threadIdx.x == 0) (void)xb_add(&bar[XB_XCNT(b.x)], 1u);
    return b;
}
__device__ __forceinline__ void xcd_barrier_complete(unsigned* bar, unsigned x, unsigned& nloc, unsigned& nx) {
    const unsigned G = gridDim.x * gridDim.y * gridDim.z;
    unsigned sum, cnt, mine, sp = 0u;
    for (;;) {
        sum = 0u; cnt = 0u; mine = 0u;
#pragma unroll
        for (unsigned j = 0; j < 16; ++j) { const unsigned c = xb_ld(&bar[XB_XCNT(j)]); sum += c; cnt += (c > 0u) ? 1u : 0u; mine = (j == x) ? c : mine; }
        if (sum == G) break;
        __builtin_amdgcn_s_sleep(1);
        if ((++sp & 255u) == 0u) { if (xb_ld(&bar[XB_TMO])) break; if (sp > XB_SPIN_CAP) { atomicAdd(&bar[XB_TMO], 1u); break; } }
    }
    nloc = mine > 0u ? mine : 1u; nx = cnt > 0u ? cnt : 1u;
}

__device__ __forceinline__ void xcd_barrier(const XcdBarrier& b) {
    asm volatile("s_waitcnt vmcnt(0)" ::: "memory");
    __syncthreads();
    if (threadIdx.x == 0) {
        unsigned* bar = b.bar;
        __builtin_amdgcn_s_waitcnt(0);
        unsigned nloc = b.st[0], nx = b.st[1];
        if (nloc == 0u) { xcd_barrier_complete(bar, b.x, nloc, nx); b.st[0] = nloc; b.st[1] = nx; }
        const unsigned old = xb_add(&bar[XB_XSUB(b.x)], 1u);
        const unsigned gen = old / nloc;
        if (old + 1u == (gen + 1u) * nloc) {
            __builtin_amdgcn_fence(__ATOMIC_RELEASE, "agent");
            asm volatile("s_waitcnt vmcnt(0)" ::: "memory");
            const unsigned og = xb_add(&bar[XB_TOP], 1u);
            const unsigned tg = og / nx;
            if (og + 1u == (tg + 1u) * nx) xb_add(&bar[XB_TOPGEN], 1u);
            else XB_SPIN(xb_ld(&bar[XB_TOPGEN]) == tg, bar);
            __builtin_amdgcn_fence(__ATOMIC_ACQUIRE, "agent");
            xb_add(&bar[XB_XGEN(b.x)], 1u);
            asm volatile("s_waitcnt vmcnt(0)" ::: "memory");
        } else {
            XB_SPIN(xb_ld(&bar[XB_XGEN(b.x)]) == gen, bar);
            __builtin_amdgcn_fence(__ATOMIC_ACQUIRE, "agent");
            asm volatile("s_waitcnt vmcnt(0)" ::: "memory");
        }
    }
    __syncthreads();
}

struct Frame {
    LAS unsigned char* lds;
    volatile LAS unsigned* MISC;
    gu32* ctl;
    int tid, lane, wave;
    int vcu, G;
};
__device__ __forceinline__ float wave_sum(float v) {
    v += __int_as_float(__builtin_amdgcn_update_dpp(0, __float_as_int(v), 0xB1, 0xF, 0xF, true));
    v += __int_as_float(__builtin_amdgcn_update_dpp(0, __float_as_int(v), 0x4E, 0xF, 0xF, true));
    v += __int_as_float(__builtin_amdgcn_update_dpp(0, __float_as_int(v), 0x141, 0xF, 0xF, true));
    v += __int_as_float(__builtin_amdgcn_update_dpp(0, __float_as_int(v), 0x140, 0xF, 0xF, true));
    v += __int_as_float(__builtin_amdgcn_ds_swizzle(__float_as_int(v), 0x401F));
    auto rr = __builtin_amdgcn_permlane32_swap(__float_as_uint(v), __float_as_uint(v), false, false);
    return __uint_as_float(rr[0]) + __uint_as_float(rr[1]);
}
__device__ __forceinline__ void transpose_item(const float* W, int K, int N, void* WT, int k0, int n0, int drow0, LAS float* scr, int lane, bool f8, float wscale) {
    const GAS float* src = (const GAS float*)W + (size_t)k0 * N + n0 + lane;
#pragma unroll
    for (int hb = 0; hb < 2; ++hb) { float v[32];
#pragma unroll
        for (int i = 0; i < 32; ++i) v[i] = src[(size_t)(hb * 32 + i) * N];
#pragma unroll
        for (int i = 0; i < 32; ++i) { const int kk = hb * 32 + i; scr[kk * 64 + (lane ^ ((kk >> 3) << 3))] = v[i]; } }
    LDS_WAIT(); asm volatile("" ::: "memory");
    if (f8) {
        const int c = lane & 3;
#pragma unroll
        for (int j = 0; j < 4; ++j) { const int nn = (lane >> 2) + 16 * j; float v[16];
#pragma unroll
            for (int q = 0; q < 16; ++q) { const int kk = 16 * c + q; v[q] = scr[kk * 64 + (nn ^ ((kk >> 3) << 3))] * wscale; }
            v4u o; o.x = pg8::pk4_fp8(v[0], v[1], v[2], v[3]); o.y = pg8::pk4_fp8(v[4], v[5], v[6], v[7]); o.z = pg8::pk4_fp8(v[8], v[9], v[10], v[11]); o.w = pg8::pk4_fp8(v[12], v[13], v[14], v[15]);
            *(GAS v4u*)((unsigned char*)WT + (size_t)(drow0 + nn) * K + k0 + 16 * c) = o; }
    } else {
    const int c = lane & 7;
#pragma unroll
    for (int j = 0; j < 8; ++j) { const int n = (lane >> 3) + 8 * j; const LAS float* s = scr + (8 * c) * 64 + (n ^ (c << 3));
        v4u o; o.x = pk2(s[0 * 64], s[1 * 64]); o.y = pk2(s[2 * 64], s[3 * 64]); o.z = pk2(s[4 * 64], s[5 * 64]); o.w = pk2(s[6 * 64], s[7 * 64]);
        *(GAS v4u*)((bf16*)WT + (size_t)(drow0 + n) * K + k0 + 8 * c) = o; }
    }
    LDS_WAIT(); asm volatile("" ::: "memory");
}
__device__ __forceinline__ void convert_matrix(Frame& F, const float* W, int K, int N, void* WT, int il, unsigned& rot, bool f8 = false, float wscale = 1.0f) {
    LAS float* scr = (LAS float*)(F.lds + RING_OFF + F.wave * 16384);
    const unsigned gw = (unsigned)(F.vcu * NWAVES + F.wave), NGW = (unsigned)(F.G * NWAVES);
    const int nblk = N / 64, nitems = (K / 64) * nblk; int lane_ = F.lane; asm volatile("" : "+v"(lane_));
    for (int it = (int)((gw + NGW - rot % NGW) % NGW); it < nitems; it += (int)NGW) {
        const int kb = it / nblk, nb = it % nblk, n0 = 64 * nb;
        const int drow0 = il == 0 ? n0 : (n0 / 128) * 256 + (il - 1) * 128 + (n0 % 128);
        transpose_item(W, K, N, WT, 64 * kb, n0, drow0, scr, lane_, f8, wscale);
    }
    rot = (rot + (unsigned)nitems) % NGW;
}

struct RouterArgs { const float* router; gu32* cnt; unsigned* ltok; float* lw; };
template <int MODE, bool F8X = false, bool SF32 = false>
__device__ __forceinline__ void norm_phase(Frame& F, const void* src, bf16* hout, const bf16* y1, const float* gain, bf16* xn, float* fout, const RouterArgs& R) {
    int lane_ = F.lane; asm volatile("" : "+v"(lane_));
    const int gw = F.vcu * NWAVES + F.wave, NGW = F.G * NWAVES, lane = lane_;
    f32x4 gv[4];
#pragma unroll
    for (int j = 0; j < 4; ++j) gv[j] = *(const GAS f32x4*)(gain + 256 * j + 4 * lane);
    LAS float* RL = (LAS float*)(F.lds + RING_OFF);
    if constexpr (MODE == 2) {
        int tid_ = F.tid; asm volatile("" : "+v"(tid_));
        for (int i = tid_; i < 8192; i += NWAVES * 64) RL[(i & 7) * 1024 + (i >> 3)] = ((const GAS float*)R.router)[i];
        LDS_WAIT(); __syncthreads();
    }
    const int nrows_w = gw < MTOK ? (MTOK - gw + NGW - 1) / NGW : 0;
    for (int cb = 0; cb < nrows_w; cb += 64) {
        int my_t = 0, my_e0 = 0, my_e1 = 0; float my_w0 = 0.f, my_w1 = 0.f; bool valid = false;
        const int cn = (nrows_w - cb) < 64 ? (nrows_w - cb) : 64;
        f32x4 vn[4]; unsigned long long yn[4];
        unsigned long long hn[4];
        { const int row0_ = gw + cb * NGW;
          if constexpr (SF32) { const GAS f32x4* xr = (const GAS f32x4*)((const float*)src + (size_t)row0_ * D) + lane;
#pragma unroll
            for (int j = 0; j < 4; ++j) vn[j] = xr[64 * j];
          } else { const GAS unsigned long long* hr_ = (const GAS unsigned long long*)((const bf16*)src + (size_t)row0_ * D) + lane;
#pragma unroll
            for (int j = 0; j < 4; ++j) hn[j] = hr_[64 * j]; }
          if constexpr (MODE == 1 || MODE == 3) { const GAS unsigned long long* yr = (const GAS unsigned long long*)(y1 + (size_t)row0_ * D) + lane;
#pragma unroll
            for (int j = 0; j < 4; ++j) yn[j] = yr[64 * j]; } }
        for (int i = 0; i < cn; ++i) {
            const int row = gw + (cb + i) * NGW;
            f32x4 v[4]; float s = 0.f;
#pragma unroll
            for (int j = 0; j < 4; ++j) { if constexpr (SF32) v[j] = vn[j]; else { const unsigned long long w = hn[j]; const unsigned lo = (unsigned)w, hi = (unsigned)(w >> 32); v[j] = (f32x4){bflo(lo), bfhi(lo), bflo(hi), bfhi(hi)}; } }
            if constexpr (MODE == 1 || MODE == 3) {
#pragma unroll
                for (int j = 0; j < 4; ++j) { const unsigned long long w = yn[j]; const unsigned lo = (unsigned)w, hi = (unsigned)(w >> 32);
                    v[j].x += bflo(lo); v[j].y += bfhi(lo); v[j].z += bflo(hi); v[j].w += bfhi(hi); }
            }
            if (i + 1 < cn) { const int rown = row + NGW;
                if constexpr (SF32) { const GAS f32x4* xr = (const GAS f32x4*)((const float*)src + (size_t)rown * D) + lane;
#pragma unroll
                    for (int j = 0; j < 4; ++j) vn[j] = xr[64 * j];
                } else { const GAS unsigned long long* hr_ = (const GAS unsigned long long*)((const bf16*)src + (size_t)rown * D) + lane;
#pragma unroll
                    for (int j = 0; j < 4; ++j) hn[j] = hr_[64 * j]; }
                if constexpr (MODE == 1 || MODE == 3) { const GAS unsigned long long* yr = (const GAS unsigned long long*)(y1 + (size_t)rown * D) + lane;
#pragma unroll
                    for (int j = 0; j < 4; ++j) yn[j] = yr[64 * j]; } }
#pragma unroll
            for (int j = 0; j < 4; ++j) s += (v[j].x * v[j].x + v[j].y * v[j].y) + (v[j].z * v[j].z + v[j].w * v[j].w);
            if constexpr (MODE == 1) { GAS unsigned long long* hr = (GAS unsigned long long*)(hout + (size_t)row * D) + lane;
#pragma unroll
                for (int j = 0; j < 4; ++j) { const unsigned long long hw = (unsigned long long)pk2(v[j].x, v[j].y) | ((unsigned long long)pk2(v[j].z, v[j].w) << 32); hr[64 * j] = hw;
                    v[j] = (f32x4){bflo((unsigned)hw), bfhi((unsigned)hw), bflo((unsigned)(hw >> 32)), bfhi((unsigned)(hw >> 32))}; } }
            const float rstd = 1.f / sqrtf(wave_sum(s) * (1.f / D) + 1e-6f);
#pragma unroll
            for (int j = 0; j < 4; ++j) v[j] = v[j] * rstd * gv[j];
            if constexpr (MODE == 3) { GAS f32x4* orow = (GAS f32x4*)(fout + (size_t)row * D) + lane;
#pragma unroll
                for (int j = 0; j < 4; ++j) orow[64 * j] = v[j];
            } else {
                if constexpr (F8X) { GAS unsigned* o4 = (GAS unsigned*)((unsigned char*)xn + (size_t)row * D) + lane;
#pragma unroll
                    for (int j = 0; j < 4; ++j) o4[64 * j] = pg8::pk4_fp8(v[j].x, v[j].y, v[j].z, v[j].w);
                } else { GAS unsigned long long* o8 = (GAS unsigned long long*)(xn + (size_t)row * D) + lane;
#pragma unroll
                    for (int j = 0; j < 4; ++j) o8[64 * j] = (unsigned long long)pk2(v[j].x, v[j].y) | ((unsigned long long)pk2(v[j].z, v[j].w) << 32); }
            }
            if constexpr (MODE == 2) {
                float lg[NE];
#pragma unroll
                for (int e = 0; e < NE; ++e) { float a = 0.f;
#pragma unroll
                    for (int j = 0; j < 4; ++j) { const f32x4 rr = *(const LAS f32x4*)(RL + e * 1024 + 256 * j + 4 * lane); a += (v[j].x * rr.x + v[j].y * rr.y) + (v[j].z * rr.z + v[j].w * rr.w); }
                    lg[e] = wave_sum(a); }
                int e0 = 0; float v0 = lg[0];
#pragma unroll
                for (int e = 1; e < NE; ++e) if (lg[e] > v0) { v0 = lg[e]; e0 = e; }
                int e1 = -1; float v1 = 0.f;
#pragma unroll
                for (int e = 0; e < NE; ++e) if (e != e0 && (e1 < 0 || lg[e] > v1)) { v1 = lg[e]; e1 = e; }
                const float w0 = 1.f / (1.f + __expf(v1 - v0));
                if (lane == i) { my_t = row; my_e0 = e0; my_e1 = e1; my_w0 = w0; my_w1 = 1.f - w0; valid = true; }
            }
        }
        if constexpr (MODE == 2) {
            unsigned myc = 0u;
#pragma unroll
            for (int e = 0; e < NE; ++e) { const unsigned long long b0 = __ballot(valid && my_e0 == e), b1 = __ballot(valid && my_e1 == e);
                const unsigned c = (unsigned)(__popcll(b0) + __popcll(b1)); if (lane == e) myc = c; }
            unsigned basev = 0u;
            if (lane < NE) basev = __hip_atomic_fetch_add(R.cnt + 64 * lane, myc, RLX_AGENT);
            const unsigned long long lt = (1ull << lane) - 1ull;
            unsigned pos0 = 0u, pos1 = 0u;
#pragma unroll
            for (int e = 0; e < NE; ++e) { const unsigned long long b0 = __ballot(valid && my_e0 == e), b1 = __ballot(valid && my_e1 == e);
                const unsigned be = (unsigned)__shfl((int)basev, e);
                if (my_e0 == e) pos0 = be + (unsigned)__popcll(b0 & lt);
                if (my_e1 == e) pos1 = be + (unsigned)__popcll(b0) + (unsigned)__popcll(b1 & lt); }
            if (valid) {
                ((GAS unsigned*)R.ltok)[(size_t)my_e0 * LIST_CAP + pos0] = (unsigned)my_t;             ((GAS float*)R.lw)[(size_t)my_e0 * LIST_CAP + pos0] = my_w0;
                ((GAS unsigned*)R.ltok)[(size_t)my_e1 * LIST_CAP + pos1] = (unsigned)my_t | (1u << 20); ((GAS float*)R.lw)[(size_t)my_e1 * LIST_CAP + pos1] = my_w1;
            }
        }
    }
    if constexpr (MODE == 2) { LDS_WAIT(); __syncthreads(); }
}

__device__ __forceinline__ void kstat_phase(Frame& F, const bf16* Kt, float* kmean, float* kmax2) {
    int lane_ = F.lane; asm volatile("" : "+v"(lane_));
    const int gw = F.vcu * NWAVES + F.wave, NGW = F.G * NWAVES, lane = lane_;
    for (int task = gw; task < BATCH * 16 * 16; task += NGW) {
        const int hh = task & 15, n = (task >> 4) & 15, b = task >> 8, l5 = lane & 31, hf = lane >> 5;
        const GAS unsigned* p = (const GAS unsigned*)(Kt + ((size_t)b * SEQ + 256 * n + 128 * hf) * D + hh * 64) + l5;
        float a0 = 0.f, a1 = 0.f, mx = 0.f;
#pragma unroll 32
        for (int r = 0; r < 128; ++r) { const unsigned w = p[(size_t)r * (D / 2)]; const float v0 = bflo(w), v1 = bfhi(w); a0 += v0; a1 += v1;
            float s = v0 * v0 + v1 * v1;
            s += __int_as_float(__builtin_amdgcn_update_dpp(0, __float_as_int(s), 0xB1, 0xF, 0xF, true)); s += __int_as_float(__builtin_amdgcn_update_dpp(0, __float_as_int(s), 0x4E, 0xF, 0xF, true));
            s += __int_as_float(__builtin_amdgcn_update_dpp(0, __float_as_int(s), 0x141, 0xF, 0xF, true)); s += __int_as_float(__builtin_amdgcn_update_dpp(0, __float_as_int(s), 0x140, 0xF, 0xF, true));
            s += __int_as_float(__builtin_amdgcn_ds_swizzle(__float_as_int(s), 0x401F)); mx = fmaxf(mx, s); }
        { auto r0 = __builtin_amdgcn_permlane32_swap(__float_as_uint(a0), __float_as_uint(a0), false, false); a0 = __uint_as_float(r0[0]) + __uint_as_float(r0[1]);
          auto r1 = __builtin_amdgcn_permlane32_swap(__float_as_uint(a1), __float_as_uint(a1), false, false); a1 = __uint_as_float(r1[0]) + __uint_as_float(r1[1]);
          auto r2 = __builtin_amdgcn_permlane32_swap(__float_as_uint(mx), __float_as_uint(mx), false, false); mx = fmaxf(__uint_as_float(r2[0]), __uint_as_float(r2[1])); }
        if (hf == 0) { GAS float* o = (GAS float*)(kmean + ((size_t)(b * 16 + hh) * 16 + n) * 64 + 2 * l5);
            o[0] = a0 * (1.f / 256.f); o[1] = a1 * (1.f / 256.f); }
        if (lane == 0) ((GAS float*)kmax2)[(size_t)(b * 16 + hh) * 16 + n] = mx;
    }
}

struct KArgs { const float* in[17]; float* out; unsigned char* ws; int ph_lo, ph_hi; };
struct ConvDesc { const float* W; int K, N; unsigned char* WT; int il; bool f8; float sc; };
constexpr int NCONV = 61, CONV_CH = 128;
__device__ __forceinline__ ConvDesc conv_desc(const KArgs& args, unsigned char* ws, int m) {
    constexpr float WSC_UP = 32.0f, WSC_DN = 64.0f;
    ConvDesc d; d.il = 0; d.f8 = false; d.sc = 1.0f;
    if (m < 2) { d.W = args.in[7] + (size_t)m * D * 3 * D; d.K = D; d.N = 3 * D; d.WT = ws + WS_MQKV + (size_t)m * 3 * D * D * 2; }
    else if (m < 4) { const int j = m - 2; d.W = args.in[8] + (size_t)j * D * D; d.K = D; d.N = D; d.WT = ws + WS_MWO + (size_t)j * D * D * 2; }
    else if (m == 4) { d.W = args.in[4]; d.K = D; d.N = D; d.WT = ws + WS_DWO; }
    else if (m == 5) { d.W = args.in[3] + (size_t)D * 3 * D; d.K = D; d.N = 3 * D; d.WT = ws + WS_DQKV + (size_t)3 * D * D * 2; }
    else if (m == 6) { d.W = args.in[4] + (size_t)D * D; d.K = D; d.N = D; d.WT = ws + WS_DWO + (size_t)D * D * 2; }
    else if (m < 13) { const int r = m - 7, j = r / 3, t = r % 3; d.f8 = (j == 1);
        if (t < 2) { d.W = args.in[9 + t] + (size_t)j * D * DFF; d.K = D; d.N = DFF; d.WT = ws + WS_FGU + (size_t)j * 2 * DFF * D * 2; d.il = 1 + t; d.sc = d.f8 ? WSC_UP : 1.0f; }
        else { d.W = args.in[11] + (size_t)j * DFF * D; d.K = DFF; d.N = D; d.WT = ws + WS_FD + (size_t)j * D * DFF * 2; d.sc = d.f8 ? WSC_DN : 1.0f; } }
    else { const int r = m - 13, e = r / 3, t = r % 3; d.f8 = true;
        if (t < 2) { d.W = args.in[13 + t] + (size_t)e * D * DE; d.K = D; d.N = DE; d.WT = ws + WS_MGU + (size_t)e * 2 * DE * D; d.il = 1 + t; d.sc = WSC_UP; }
        else { d.W = args.in[15] + (size_t)e * DE * D; d.K = DE; d.N = D; d.WT = ws + WS_MD + (size_t)e * D * DE; d.sc = WSC_DN; } }
    return d;
}
__device__ __forceinline__ int conv_chunks_of(int m) { const int items = m < 2 || m == 5 ? 768 : (m < 7 ? 256 : (m < 13 ? 704 : 896)); return (items + CONV_CH - 1) / CONV_CH; }
__device__ __forceinline__ int conv_total_chunks() { int s = 0; for (int m = 0; m < NCONV; ++m) s += conv_chunks_of(m); return s; }
__device__ __forceinline__ void conv_chunk(Frame& F, const KArgs& args, unsigned char* ws, int c) {
    int m = 0; for (; m < NCONV; ++m) { const int n = conv_chunks_of(m); if (c < n) break; c -= n; }
    const ConvDesc d = conv_desc(args, ws, m);
    LAS float* scr = (LAS float*)(F.lds + RING_OFF + F.wave * 16384);
    int lane_ = F.lane; asm volatile("" : "+v"(lane_));
    const int nblk = d.N / 64, nitems = (d.K / 64) * nblk, last = (c + 1) * CONV_CH < nitems ? (c + 1) * CONV_CH : nitems;
    for (int it = c * CONV_CH + F.wave; it < last; it += NWAVES) {
        const int kb = it / nblk, nb = it % nblk, n0 = 64 * nb;
        const int drow0 = d.il == 0 ? n0 : (n0 / 128) * 256 + (d.il - 1) * 128 + (n0 % 128);
        transpose_item(d.W, d.K, d.N, d.WT, 64 * kb, n0, drow0, scr, lane_, d.f8, d.sc);
    }
}

__global__ void __launch_bounds__(NWAVES * 64, 2) trunk_fwd(KArgs args) {
    extern __shared__ __attribute__((aligned(16))) unsigned char lds[];
    Frame F;
    F.lds = (LAS unsigned char*)lds;
    F.MISC = (volatile LAS unsigned*)(F.lds + MISC_OFF);
    F.tid = threadIdx.x; F.lane = F.tid & 63; F.wave = __builtin_amdgcn_readfirstlane(F.tid >> 6);
    F.G = gridDim.x; { const int bx = blockIdx.x; F.vcu = (F.G % 8 == 0) ? (bx % 8) * (F.G / 8) + bx / 8 : bx; }
    F.ctl = (gu32*)(args.ws + WS_CTL);
    for (int u = F.tid; u < (LDS_BYTES - LDSCTL_OFF) / 4; u += NWAVES * 64) ((LAS unsigned*)(F.lds + LDSCTL_OFF))[u] = 0u;
    __syncthreads();
    Frame& F0 = F;
    const int lo = args.ph_lo, hi = args.ph_hi;
    XcdBarrier bar; bar.bar = (unsigned*)(F.ctl + CW_BAR); bar.x = 0; bar.st = nullptr;
    if (hi - lo > 1) bar = xcd_barrier_post((unsigned*)(F.ctl + CW_BAR), F.MISC + 8);
#define IN(k) (lo <= (k) && (k) < hi)
#ifndef PH_ENABLE
#define PH_ENABLE 0xFFFFFFFFu
#endif
#define PHEN(n) (((PH_ENABLE) >> (n)) & 1u)
#ifndef MK_DOUBLE
#define MK_DOUBLE 0u
#endif
#define NREP(n) ((((MK_DOUBLE) >> (n)) & 1u) ? 2 : 1)
#if defined(NO_OPQ)
#define OPQ(p) do {} while (0)
#else
#define OPQ(p) asm volatile("" : "+s"(p))
#endif
#if 0
#define STAMP(k) do { if (blockIdx.x == 0 && threadIdx.x == 0) { const unsigned long long t_ = __builtin_amdgcn_s_memrealtime(); ((GAS unsigned*)(F0.ctl))[3000 + (k)] = (unsigned)t_; } } while (0)
#else
#define STAMP(k) do {} while (0)
#endif
#define SEAM(k) do { if (IN(k) && IN((k) + 1)) { XcdBarrier b2_ = bar; OPQ(b2_.bar); xcd_barrier(b2_); } STAMP((k) + 1); } while (0)

#define PTRS() unsigned char* ws = args.ws; OPQ(ws); const float* x = args.in[0]; OPQ(x); const float* norm_mix = args.in[1]; OPQ(norm_mix); const float* norm_ffn = args.in[2]; OPQ(norm_ffn); \
    bf16* h = (bf16*)(ws + WS_HB); \
    bf16* XN = (bf16*)(ws + WS_XN); bf16* Qb = (bf16*)(ws + WS_Q); bf16* Kb = (bf16*)(ws + WS_K); bf16* Vb = (bf16*)(ws + WS_V); bf16* ACT = (bf16*)(ws + WS_ACT); \
    bf16* MGU = (bf16*)(ws + WS_MGU); bf16* MD = (bf16*)(ws + WS_MD); \
    float* kmean = (float*)(ws + WS_KMEAN); unsigned* ltok = (unsigned*)(ws + WS_LTOK); float* lw = (float*)(ws + WS_LW); \
    (void)x; (void)norm_mix; (void)norm_ffn; (void)h; (void)XN; (void)Qb; (void)Kb; (void)Vb; (void)ACT; (void)MGU; (void)MD; (void)kmean; (void)ltok; (void)lw
    const RouterArgs noR{nullptr, nullptr, nullptr, nullptr};
#ifndef MK_F8_DENSE
#define MK_F8_DENSE 0
#endif
    constexpr bool F8_DENSE = MK_F8_DENSE != 0; constexpr int DESZ = F8_DENSE ? 1 : 2;
    constexpr float WSC_UP = 32.0f, WSC_DN = 64.0f;
    constexpr float C2 = 0.125f * 1.4426950408889634f;

    STAMP(0);
    if (PHEN(0) && IN(0)) {
        PTRS();
        { unsigned rot = 0u;
        convert_matrix(F, args.in[3], D, 3 * D, ws + WS_DQKV, 0, rot);
        norm_phase<0, false, true>(F, x, nullptr, nullptr, norm_mix, XN, nullptr, noR);
        }
    }
    SEAM(0);

    for (int L = 0; L < NLAYER; ++L) {
        const int j = L >> 1, moba = L & 1, pb = 1 + PH_PER_LAYER * L;
        int z_ = 0;
#if !defined(NO_OPQ_Z)
        asm volatile("" : "+s"(z_));
#endif
        Frame Fl = F0; Fl.G += z_; Fl.vcu += z_; Fl.wave += z_; Fl.lds += z_; Fl.ctl += z_; const int bx = (int)blockIdx.x + z_;
#define F Fl
        if (PHEN(1) && IN(pb + 0)) {
            PTRS();

            const bf16* W = (const bf16*)(ws + (moba ? WS_MQKV : WS_DQKV)) + (size_t)j * 3 * D * D;
            pg8::Gemm g{XN, W, 2 * D, 0}; pg8::StaticOrder S; S.init(MTOK, 3 * D, F.G, bx);
            pg8::EpiQKV E{Qb, D, D, (size_t)(WS_K - WS_Q) / 2, C2};
            for (int rep_ = 0; rep_ < NREP(1); ++rep_) pg8::gemm_phase<pg8::EpiQKV, pg8::StaticOrder>(F.lds + RING_OFF, XSLOT_OFF, g, S, E);
        }
        SEAM(pb + 0);
        { if (PHEN(2) && IN(pb + 1)) { PTRS(); kstat_phase(F, Kb, kmean, kmean + 8 * 16 * 16 * 64); } SEAM(pb + 1); }
        if (IN(pb + 2)) {
            PTRS();
            att::Args A; A.Q = Qb; A.K = Kb; A.V = Vb; A.O = XN; A.kmean = kmean; A.kmax2 = kmean + 8 * 16 * 16 * 64; A.subln = args.in[6] + (size_t)j * 128; A.lam_full = 0.f; A.out_scale = 1.f; A.abl = 0;
            LAS int* qw;
            if (!moba) {
                const float* lam = args.in[5] + (size_t)j * 256; int lane = F.lane; asm volatile("" : "+v"(lane));
                const GAS float* lamg = (const GAS float*)lam; const float s1 = wave_sum(lamg[lane] * lamg[64 + lane]), s2 = wave_sum(lamg[128 + lane] * lamg[192 + lane]);
                const float lam_init = (L == 0) ? 0.2f : 0.47071302f;
                A.lam_full = __uint_as_float(__builtin_amdgcn_readfirstlane(__float_as_uint(__expf(s1) - __expf(s2) + lam_init))); A.out_scale = __uint_as_float(__builtin_amdgcn_readfirstlane(__float_as_uint(1.0f - lam_init)));
            }
            const int nconv = (L == 0) ? conv_total_chunks() : 0;
            qw = (LAS int*)(F.lds + XSLOT_OFF);
            const int xme = (int)(xb_xcc_id() & 7u);
            if ((PHEN(3) && !moba) || (PHEN(4) && moba)) for (int rep_ = 0; rep_ < (moba ? NREP(4) : NREP(3)); ++rep_) for (int xq = xme;;) {
#if ATT_ABLATE
                { const bool ab_ = rep_ == 0 && (moba ? NREP(4) : NREP(3)) == 2; A.abl = ab_ ? ATT_ABLATE : 0; A.O = ab_ ? (bf16*)(ws + WS_END) : XN; }
#endif
                const int ncx = (nconv && rep_ == 0) ? ((nconv - xq + 7) >> 3) : 0;
                gu32* qb = F.ctl + CW_ATTQ2 + 256 * L + 1024 * rep_; gu32* qx = qb + 32 * xq;
                for (;;) {
                    if (F.tid == 0) *qw = (int)__hip_atomic_fetch_add(qx, 1u, RLX_AGENT);
                    asm volatile("s_waitcnt vmcnt(0) lgkmcnt(0)\n\ts_barrier" ::: "memory");
                    int idx = __builtin_amdgcn_readfirstlane(*qw);
                    if (idx >= 128 + ncx) { asm volatile("s_waitcnt vmcnt(0) lgkmcnt(0)\n\ts_barrier" ::: "memory"); break; }
                    if (ncx) { const int q3 = idx / 3; if (idx < 3 * ncx) { if (idx - 3 * q3 == 2) { conv_chunk(F, args, ws, xq + 8 * q3); asm volatile("s_waitcnt vmcnt(0) lgkmcnt(0)\n\ts_barrier" ::: "memory"); continue; } idx -= q3; } else idx -= ncx; }
                    if (!moba) { const int hh = 7 - (idx >> 4), pr = idx & 15;
                        att::attn_unit<0>(F.lds + RING_OFF, A, xq, hh, pr);
                        att::attn_unit<0>(F.lds + RING_OFF, A, xq, hh, 31 - pr);
                    } else { const int hh = 15 - (idx >> 3), pr = idx & 7;
                        att::attn_unit<1>(F.lds + RING_OFF, A, xq, hh, pr);
                        att::attn_unit<1>(F.lds + RING_OFF, A, xq, hh, 15 - pr); }
                }
                if (F.tid < 64) { int lane = F.tid; asm volatile("" : "+v"(lane)); bool av = false;
                    if (lane < 8) { const int lim = 128 + ((nconv && rep_ == 0) ? ((nconv - lane + 7) >> 3) : 0); av = (int)__hip_atomic_load(qb + 32 * lane, RLX_AGENT) < lim; }
                    const unsigned long long m_ = __ballot(av);
                    if (lane == 0) *qw = (int)(unsigned)m_; }
                asm volatile("s_waitcnt vmcnt(0) lgkmcnt(0)\n\ts_barrier" ::: "memory");
                const unsigned m = (unsigned)__builtin_amdgcn_readfirstlane(*qw);
                asm volatile("s_waitcnt vmcnt(0) lgkmcnt(0)\n\ts_barrier" ::: "memory");
                if (m == 0u) break;
                const unsigned rot = ((m >> xme) | (m << (8 - xme))) & 0xFFu;
                xq = (xme + __builtin_ctz(rot)) & 7;
            }
            asm volatile("s_waitcnt vmcnt(0) lgkmcnt(0)\n\ts_barrier" ::: "memory");
        }
        SEAM(pb + 2);
        if (PHEN(5) && IN(pb + 3)) {
            PTRS();
            const bf16* W = (const bf16*)(ws + (moba ? WS_MWO : WS_DWO)) + (size_t)j * D * D;
            pg8::Gemm g{XN, W, 2 * D, 0}; pg8::StaticOrder S; S.init(MTOK, D, F.G, bx);
            if (L == 0) { pg8::EpiRes<true> E{x, h, D, 1.0f}; pg8::gemm_phase<pg8::EpiRes<true>, pg8::StaticOrder>(F.lds + RING_OFF, XSLOT_OFF, g, S, E); }
            else { pg8::EpiRes<false> E{h, h, D, 1.0f}; pg8::gemm_phase<pg8::EpiRes<false>, pg8::StaticOrder>(F.lds + RING_OFF, XSLOT_OFF, g, S, E); }
        }
        SEAM(pb + 3);
        if (PHEN(6) && IN(pb + 4)) {
            PTRS();
            if (!moba) {
                if (L == 2) norm_phase<0, true>(F, h, nullptr, nullptr, norm_ffn + (size_t)L * D, XN, nullptr, noR);
                else norm_phase<0, false>(F, h, nullptr, nullptr, norm_ffn + (size_t)L * D, XN, nullptr, noR);
            } else {
                const RouterArgs R{args.in[12] + (size_t)j * D * NE, F.ctl + CW_CNT + 64 * NE * j, ltok, lw};
                norm_phase<2, true>(F, h, nullptr, nullptr, norm_ffn + (size_t)L * D, XN, nullptr, R);
            }
        }
        SEAM(pb + 4);
        if (IN(pb + 5)) {
            PTRS();
            if (PHEN(7) && !moba) {
                if (L == 2) { pg8::Gemm g{XN, ws + WS_FGU + (size_t)j * 2 * DFF * D * 2, D, 0}; pg8::StaticOrder S; S.init(MTOK, 2 * DFF, F.G, bx);
                    pg8::EpiSwiGLU<true> E{ACT, DFF, 1.0f / WSC_UP};
                    pg8::gemm_phase<pg8::EpiSwiGLU<true>, pg8::StaticOrder, true>(F.lds + RING_OFF, XSLOT_OFF, g, S, E);
                } else { pg8::Gemm g{XN, ws + WS_FGU + (size_t)j * 2 * DFF * D * 2, 2 * D, 0}; pg8::StaticOrder S; S.init(MTOK, 2 * DFF, F.G, bx);
                    pg8::EpiSwiGLU<false> E{ACT, DFF, 1.0f};
                    pg8::gemm_phase<pg8::EpiSwiGLU<false>, pg8::StaticOrder, false>(F.lds + RING_OFF, XSLOT_OFF, g, S, E); }
            } else if (PHEN(8) && moba) {
                pg8::Gemm g{XN, ws + WS_MGU + (size_t)j * NE * 2 * DE * D, D, (size_t)2 * DE * D}; pg8::MoeOrder S; S.init((const unsigned*)(F.ctl + CW_CNT + 64 * NE * j), ltok, true, 2 * DE, F.G, bx);
                pg8::EpiSwiGLU<true> E{ACT, DE, 1.0f / WSC_UP};
                pg8::gemm_phase<pg8::EpiSwiGLU<true>, pg8::MoeOrder, true>(F.lds + RING_OFF, XSLOT_OFF, g, S, E);
            }
        }
        SEAM(pb + 5);
        if (IN(pb + 6)) {
            PTRS();
            if (PHEN(9) && !moba) {
                if (L == 2) { pg8::Gemm g{ACT, ws + WS_FD + (size_t)j * D * DFF * 2, DFF, 0}; pg8::StaticOrder S; S.init(MTOK, D, F.G, bx);
                    pg8::EpiRes<false> E{h, h, D, 1.0f / WSC_DN};
                    pg8::gemm_phase<pg8::EpiRes<false>, pg8::StaticOrder, true>(F.lds + RING_OFF, XSLOT_OFF, g, S, E);
                } else { pg8::Gemm g{ACT, ws + WS_FD + (size_t)j * D * DFF * 2, 2 * DFF, 0}; pg8::StaticOrder S; S.init(MTOK, D, F.G, bx);
                    pg8::EpiRes<false> E{h, h, D, 1.0f};
                    pg8::gemm_phase<pg8::EpiRes<false>, pg8::StaticOrder, false>(F.lds + RING_OFF, XSLOT_OFF, g, S, E); }
            } else if (PHEN(10) && moba) {
                pg8::Gemm g{ACT, ws + WS_MD + (size_t)j * NE * D * DE, DE, (size_t)D * DE}; pg8::MoeOrder S; S.init((const unsigned*)(F.ctl + CW_CNT + 64 * NE * j), ltok, false, D, F.G, bx);
                pg8::EpiMoeDown E; E.h = h; E.y1 = XN; E.list_tok = ltok; E.list_w = lw; E.sc = 1.0f / WSC_DN;
#pragma unroll
                for (int e = 0; e < NE; ++e) E.cnt[e] = S.cnt[e];
                pg8::gemm_phase<pg8::EpiMoeDown, pg8::MoeOrder, true>(F.lds + RING_OFF, XSLOT_OFF, g, S, E);
            }
        }
        SEAM(pb + 6);
        if (PHEN(11) && IN(pb + 7)) {
            PTRS();
            if (L == 3) norm_phase<3>(F, h, nullptr, XN, args.in[16], nullptr, args.out, noR);
            else if (moba) norm_phase<1>(F, h, h, XN, norm_mix + (size_t)(L + 1) * D, XN, nullptr, noR);
            else for (int rep_ = 0; rep_ < NREP(11); ++rep_) norm_phase<0>(F, h, nullptr, nullptr, norm_mix + (size_t)(L + 1) * D, XN, nullptr, noR);
        }
        if (L != NLAYER - 1) SEAM(pb + 7); else STAMP(pb + 8);
#undef F
    }
#undef IN
#undef SEAM
#undef PTRS
#undef OPQ
}


#if MK_DEBUG
__global__ void dbg_probe(const void* buf, size_t n, int is_bf16, int idx, float thresh, unsigned* dbg) {
    size_t i = blockIdx.x * (size_t)blockDim.x + threadIdx.x, stride = (size_t)gridDim.x * blockDim.x; bool bad = false;
    for (size_t k = i; k < n; k += stride) { float v = is_bf16 ? __uint_as_float(((unsigned)((const unsigned short*)buf)[k]) << 16) : ((const float*)buf)[k]; if (!(fabsf(v) <= thresh)) bad = true; }
    if (bad) atomicMax(dbg, (unsigned)(1000 - idx));
}
__global__ void dbg_cnt(const unsigned* cntw, int idx, unsigned* dbg) {
    if (threadIdx.x == 0 && blockIdx.x == 0) { unsigned s = 0; for (int e = 0; e < NE; ++e) s += cntw[64 * e]; if (s != 2u * MTOK) atomicMax(dbg, (unsigned)(1000 - idx)); }
}

__device__ __forceinline__ float dbg_bf(unsigned short v) { return __uint_as_float(((unsigned)v) << 16); }
__device__ __forceinline__ unsigned dbg_hash(unsigned x) { x ^= x >> 16; x *= 0x7feb352dU; x ^= x >> 15; x *= 0x846ca68bU; x ^= x >> 16; return x; }
__global__ void dbg_gemm_check(const unsigned short* A, int lda, const unsigned short* Bt, int K, const unsigned short* out, int ldo, int M, int N, float scale, int idx, unsigned* dbg) {
    const unsigned s = blockIdx.x * blockDim.x + threadIdx.x; const int row = (int)(dbg_hash(2 * s + 1) % (unsigned)M), col = (int)(dbg_hash(2 * s + 2) % (unsigned)N);
    float acc = 0.f; for (int k = 0; k < K; ++k) acc += dbg_bf(A[(size_t)row * lda + k]) * dbg_bf(Bt[(size_t)col * K + k]);
    acc *= scale; const float got = dbg_bf(out[(size_t)row * ldo + col]);
    if (!(fabsf(got - acc) <= 0.03f + 0.02f * fabsf(acc))) { atomicMax(dbg, (unsigned)(1000 - idx)); atomicAdd(dbg + 64 + idx, 1u); }
}
__global__ void dbg_conv_check(const float* W, int K, int N, const unsigned short* WT, int il, int idx, unsigned* dbg) {
    const unsigned s = blockIdx.x * blockDim.x + threadIdx.x; const int k = (int)(dbg_hash(2 * s + 1) % (unsigned)K), n = (int)(dbg_hash(2 * s + 2) % (unsigned)N);
    const int dr = il == 0 ? n : (n / 128) * 256 + (il - 1) * 128 + (n % 128);
    const float w = W[(size_t)k * N + n], g = dbg_bf(WT[(size_t)dr * K + k]);
    if (!(fabsf(g - w) <= 0.01f * fabsf(w) + 1e-6f)) atomicMax(dbg, (unsigned)(1000 - idx));
}
__global__ void dbg_norm_check(const float* src, const float* gain, const unsigned short* xn, int idx, unsigned* dbg) {
    const unsigned s = blockIdx.x * blockDim.x + threadIdx.x; const int row = (int)(dbg_hash(s + 77) % (unsigned)MTOK);
    float ss = 0.f; for (int c = 0; c < D; ++c) { const float v = src[(size_t)row * D + c]; ss += v * v; }
    const float rstd = 1.f / sqrtf(ss / D + 1e-6f); bool bad = false;
    for (int c = 0; c < D; ++c) { const float r = src[(size_t)row * D + c] * rstd * gain[c], g = dbg_bf(xn[(size_t)row * D + c]); if (!(fabsf(g - r) <= 0.02f + 0.01f * fabsf(r))) bad = true; }
    if (bad) atomicMax(dbg, (unsigned)(1000 - idx));
}
__global__ void dbg_naive_gemm(const unsigned short* A, const unsigned short* Bt, unsigned short* out, int M, int N, int K) {
    const size_t i = blockIdx.x * (size_t)blockDim.x + threadIdx.x; if (i >= (size_t)M * N) return; const int row = (int)(i / N), col = (int)(i % N);
    float acc = 0.f; for (int k = 0; k < K; ++k) acc += dbg_bf(A[(size_t)row * K + k]) * dbg_bf(Bt[(size_t)col * K + k]);
    out[(size_t)row * N + col] = (unsigned short)f2bf(acc);
}
__global__ void dbg_find_col(const unsigned short* out, const unsigned short* ref, int M, int N, unsigned* hist) {
    const unsigned s = blockIdx.x * blockDim.x + threadIdx.x; const int row = (int)(dbg_hash(2 * s + 1) % (unsigned)M), col = (int)(dbg_hash(2 * s + 2) % (unsigned)N);
    const unsigned short v = out[(size_t)row * N + col]; int found = -1;
#if MK_FIND_PATTERN
    if (v == 0x3C3C) atomicAdd(hist + N, 1u); else atomicAdd(hist + 5, 1u); return;
#endif
#if MK_FIND_ROWS
    for (int r = 0; r < M; ++r) if (ref[(size_t)r * N + col] == v) { found = r; break; }
    if (found < 0) atomicAdd(hist + N, 1u); else atomicAdd(hist + ((found - row) & (N - 1)), 1u);
#else
    for (int c = 0; c < N; ++c) if (ref[(size_t)row * N + c] == v) { found = c; break; }
    if (found < 0) atomicAdd(hist + N, 1u); else atomicAdd(hist + ((found - col) & (N - 1)), 1u);
#endif
}
__global__ void dbg_hist_code(const unsigned* hist, int N, unsigned* dbg) {
    if (threadIdx.x || blockIdx.x) return; unsigned best = 0, bi = 0; for (int i = 0; i < N; ++i) if (hist[i] > best) { best = hist[i]; bi = i; }
    dbg[32] = bi; dbg[33] = best; dbg[34] = hist[N];
}
__global__ void dbg_final(float* out, size_t n, const unsigned* dbg) {
    if (MK_HIST_SEL >= 10) { const float c3 = sqrtf((float)dbg[MK_HIST_SEL + 30]); size_t i3 = blockIdx.x * (size_t)blockDim.x + threadIdx.x, st3 = (size_t)gridDim.x * blockDim.x; for (size_t k3 = i3; k3 < n; k3 += st3) out[k3] = c3; return; }
    if (MK_HIST_SEL >= 0 && (dbg[33] || dbg[34])) { const float c2 = sqrtf((float)(MK_HIST_SEL == 0 ? dbg[32] : (MK_HIST_SEL == 1 ? dbg[33] * 100u / 4096u : dbg[34] * 100u / 4096u)) + 1.f); size_t i2 = blockIdx.x * (size_t)blockDim.x + threadIdx.x, st2 = (size_t)gridDim.x * blockDim.x; for (size_t k2 = i2; k2 < n; k2 += st2) out[k2] = c2; return; }
    const unsigned d = dbg[0]; if (d == 0u) return; const unsigned nf = dbg[64 + (1000u - d)]; const float c = sqrtf(nf ? (float)(200u * (1000u - d - 9u) + nf * 100u / 4096u) : (float)(1000u - d));
    size_t i = blockIdx.x * (size_t)blockDim.x + threadIdx.x, stride = (size_t)gridDim.x * blockDim.x;
    for (size_t k = i; k < n; k += stride) out[k] = c;
}
#endif

#ifndef MK_REPEAT
#define MK_REPEAT 1
#endif
#ifndef MK_FIND_ROWS
#define MK_FIND_ROWS 0
#endif
#ifndef MK_FIND_REGION
#define MK_FIND_REGION WS_K
#endif
#ifndef MK_HIST_SEL
#define MK_HIST_SEL 0
#endif
#ifndef MK_STAMP
#define MK_STAMP 0
#endif
#if MK_STAMP
__global__ void stamp_k(unsigned* p) { if (threadIdx.x == 0) *p = (unsigned)__builtin_amdgcn_s_memrealtime(); }
__global__ void stamp_encode(float* out, size_t n, const unsigned* st, int pa, float ua, int pb, float ub) {
    const float da = (float)(st[pa + 1] - st[pa]) * 0.01f, db = (float)(st[pb + 1] - st[pb]) * 0.01f;
    float m = da / ua; m = m < 10.f ? 10.f : (m > 99.f ? 99.f : m); float e = floorf(db / ub + 0.5f); e = e < 0.f ? 0.f : (e > 30.f ? 30.f : e);
    const float c = sqrtf(m) * __powf(10.f, 0.5f * e);
    size_t i = blockIdx.x * (size_t)blockDim.x + threadIdx.x, stride = (size_t)gridDim.x * blockDim.x;
    for (size_t k = i; k < n; k += stride) out[k] = c;
}
#endif
extern "C" void kernel_launch(void* const* d_in, const int* in_sizes, int n_in, void* d_out, int out_size, void* d_ws, size_t ws_size, hipStream_t stream) {
    static int grid = 0;
    if (grid == 0) {
        if (n_in != 17 || in_sizes[0] != MTOK * D || out_size != MTOK * D || ws_size < WS_END) {
            fprintf(stderr, "kernel_launch: built for 17 inputs, x/out of %d floats, >= %zu bytes of workspace; got n_in %d, in0 %d, out %d, ws %zu; nothing launched\n", MTOK * D, (size_t)WS_END, n_in, n_in > 0 ? in_sizes[0] : -1, out_size, ws_size);
            grid = -1; return; }
        int dev = 0, cus = 0, per_cu = 0;
        if (hipGetDevice(&dev) != hipSuccess || hipDeviceGetAttribute(&cus, hipDeviceAttributeMultiprocessorCount, dev) != hipSuccess) { fprintf(stderr, "kernel_launch: device query failed\n"); grid = -1; return; }
        if (hipFuncSetAttribute((const void*)trunk_fwd, hipFuncAttributeMaxDynamicSharedMemorySize, LDS_BYTES) != hipSuccess) { fprintf(stderr, "kernel_launch: hipFuncSetAttribute failed\n"); grid = -1; return; }
        if (hipOccupancyMaxActiveBlocksPerMultiprocessor(&per_cu, (const void*)trunk_fwd, NWAVES * 64, LDS_BYTES) != hipSuccess || per_cu < 1)
            fprintf(stderr, "kernel_launch: note: occupancy query reports %d workgroups per CU\n", per_cu);
        (void)hipGetLastError();
        grid = cus;
    }
    if (grid < 0) return;
    if (hipMemsetAsync((char*)d_ws + WS_CTL, 0, CTL_ZERO_BYTES, stream) != hipSuccess) { fprintf(stderr, "kernel_launch: memset failed\n"); return; }
    KArgs a{};
    for (int i = 0; i < 17; ++i) a.in[i] = (const float*)d_in[i];
    a.out = (float*)d_out; a.ws = (unsigned char*)d_ws;
#if MK_PER_PHASE
#if MK_STAMP
    hipLaunchKernelGGL(stamp_k, dim3(1), dim3(64), 0, stream, (unsigned*)d_ws + 3000);
#endif
    for (int p = 0; p < NPHASE; ++p) {
        a.ph_lo = p; a.ph_hi = p + 1;
#if MK_DEBUG
#endif
#if !defined(MK_SKIP_MAIN)
        for (int rep_ = 0; rep_ < (p == 1 ? MK_REPEAT : 1); ++rep_) hipLaunchKernelGGL(trunk_fwd, dim3(grid), dim3(NWAVES * 64), LDS_BYTES, stream, a);
#endif
#if MK_STAMP
        hipLaunchKernelGGL(stamp_k, dim3(1), dim3(64), 0, stream, (unsigned*)d_ws + 3000 + p + 1);
#endif
#if MK_DEBUG
        {   unsigned char* ws = (unsigned char*)d_ws; unsigned* dbg = (unsigned*)(ws + WS_CTL) + 2048;
            const size_t MD_ = (size_t)MTOK * D;
#define PROBE(buf, n, isbf, idx, th) if ((idx) <= MK_PROBE_MAX) hipLaunchKernelGGL(dbg_probe, dim3(2048), dim3(256), 0, stream, (const void*)(buf), (size_t)(n), isbf, idx, th, dbg)
            if (p == 0) {
                hipLaunchKernelGGL(dbg_norm_check, dim3(4), dim3(64), 0, stream, (const float*)d_in[0], (const float*)d_in[1], (const unsigned short*)(ws + WS_XN), 4, dbg);
                hipLaunchKernelGGL(dbg_conv_check, dim3(16), dim3(256), 0, stream, (const float*)d_in[3], D, 3 * D, (const unsigned short*)(ws + WS_DQKV), 0, 5, dbg);
                hipLaunchKernelGGL(dbg_conv_check, dim3(16), dim3(256), 0, stream, (const float*)d_in[9], D, DFF, (const unsigned short*)(ws + WS_FGU), 1, 6, dbg);
                hipLaunchKernelGGL(dbg_conv_check, dim3(16), dim3(256), 0, stream, (const float*)d_in[10], D, DFF, (const unsigned short*)(ws + WS_FGU), 2, 7, dbg);
                hipLaunchKernelGGL(dbg_conv_check, dim3(16), dim3(256), 0, stream, (const float*)d_in[11], DFF, D, (const unsigned short*)(ws + WS_FD), 0, 8, dbg);
                hipLaunchKernelGGL(dbg_conv_check, dim3(16), dim3(256), 0, stream, (const float*)d_in[15] + (size_t)3 * DE * D, DE, D, (const unsigned short*)(ws + WS_MD) + (size_t)3 * D * DE, 0, 9, dbg);
            }
            if (p == 1) {
                const float C2h = 0.125f * 1.4426950408889634f;
                hipLaunchKernelGGL(dbg_gemm_check, dim3(16), dim3(256), 0, stream, (const unsigned short*)(ws + WS_XN), D, (const unsigned short*)(ws + WS_DQKV), D, (const unsigned short*)(ws + WS_Q), D, MTOK, D, C2h, 10, dbg);
                hipLaunchKernelGGL(dbg_gemm_check, dim3(16), dim3(256), 0, stream, (const unsigned short*)(ws + WS_XN), D, (const unsigned short*)(ws + WS_DQKV) + (size_t)D * D, D, (const unsigned short*)(ws + WS_K), D, MTOK, D, 1.f, 11, dbg);

                hipLaunchKernelGGL(dbg_gemm_check, dim3(16), dim3(256), 0, stream, (const unsigned short*)(ws + WS_XN), D, (const unsigned short*)(ws + WS_DQKV) + (size_t)2 * D * D, D, (const unsigned short*)(ws + WS_V), D, MTOK, D, 1.f, 12, dbg);
            }
            if (0) { PROBE(ws + WS_XN, MD_, 1, 1, 10.f); PROBE(ws + WS_DQKV, (WS_MGU - WS_DQKV) / 2, 1, 2, 1.f); PROBE(ws + WS_MGU, (WS_XN - WS_MGU) / 2, 1, 3, 1.f); }
            if (p >= 1) { const int L = (p - 1) / PH_PER_LAYER, k = (p - 1) % PH_PER_LAYER; const int b = 20 + 10 * L;
                if (k == 0) PROBE(ws + WS_Q, 3 * MD_, 1, b + 0, 50.f);
                if (k == 1) PROBE(ws + WS_KMEAN, 8 * 16 * 16 * 64, 0, b + 1, 5.f);
                if (k == 2) PROBE(ws + WS_XN, MD_, 1, b + 2, 50.f);
                if (k == 3) PROBE(d_out, MD_, 0, b + 3, 300.f);
                if (k == 4) { PROBE(ws + WS_XN, MD_, 1, b + 4, 20.f); if ((L & 1) && (b + 9) <= MK_PROBE_MAX) hipLaunchKernelGGL(dbg_cnt, dim3(1), dim3(64), 0, stream, (const unsigned*)(ws + WS_CTL) + CW_CNT + 64 * NE * (L >> 1), b + 9, dbg); }
                if (k == 5) PROBE(ws + WS_ACT, (L & 1) ? (size_t)256 * 256 * DE : (size_t)MTOK * DFF, 1, b + 5, 2000.f);
                if (k == 6) { PROBE(d_out, MD_, 0, b + 6, 1000.f); if (L & 1) PROBE(ws + WS_XN, MD_, 1, b + 7, 1000.f); }
                if (k == 7 && L != 3) { PROBE(ws + WS_XN, MD_, 1, b + 8, 20.f); PROBE(d_out, MD_, 0, b + 8, 1000.f); }
            }
#undef PROBE
        }
#endif
    }
#if MK_DEBUG
    hipLaunchKernelGGL(dbg_final, dim3(2048), dim3(256), 0, stream, (float*)d_out, (size_t)MTOK * D, (const unsigned*)((unsigned char*)d_ws + WS_CTL) + 2048);
#endif
#else
    a.ph_lo = 0; a.ph_hi = NPHASE;
    hipLaunchKernelGGL(trunk_fwd, dim3(grid), dim3(NWAVES * 64), LDS_BYTES, stream, a);
#if 0
    hipLaunchKernelGGL(stamp_encode, dim3(2048), dim3(256), 0, stream, (float*)d_out, (size_t)MTOK * D, (const unsigned*)d_ws + 3000, MK_STAMP_PA, MK_STAMP_UA, MK_STAMP_PB, MK_STAMP_UB);
#endif
#endif
#if MK_STAMP
    hipLaunchKernelGGL(stamp_encode, dim3(2048), dim3(256), 0, stream, (float*)d_out, (size_t)MTOK * D, (const unsigned*)d_ws + 3000, MK_STAMP_PA, MK_STAMP_UA, MK_STAMP_PB, MK_STAMP_UB);
#endif
    const hipError_t le = hipPeekAtLastError();
    if (le != hipSuccess) fprintf(stderr, "kernel_launch: launch failed: %s\n", hipGetErrorName(le));
}
```

```cpp
#ifndef MK_DEBUG
#define MK_DEBUG 0
#endif
#ifndef MK_PER_PHASE
#define MK_PER_PHASE 0
#endif
#include <hip/hip_runtime.h>
#include <cstdio>
#include <cstdint>

#ifndef MK_KDEBUG
#define MK_KDEBUG 0
#endif
#define LAS __attribute__((address_space(3)))
#define GAS __attribute__((address_space(1)))

constexpr int BATCH = 8, SEQ = 4096, MTOK = BATCH * SEQ, D = 1024, DFF = 2816, DE = 3584, NE = 8;
constexpr int MOE_TILES_MAX = 272;
constexpr int LIST_CAP = MTOK;

namespace pg8 {
#define PG8_LAS __attribute__((address_space(3)))
typedef unsigned short bf16_t;
typedef short bf16x8 __attribute__((ext_vector_type(8)));
typedef float f32x4 __attribute__((ext_vector_type(4)));
typedef unsigned u32x4 __attribute__((ext_vector_type(4)));
typedef int i32x4 __attribute__((ext_vector_type(4)));
typedef int i32x8 __attribute__((ext_vector_type(8)));
constexpr int BM = 256, BK = 64, HALF = 128, HTB = HALF * BK * 2  , STAGE_BYTES = 8 * HTB, NXCD = 8, WGM = 8;

__host__ __device__ __forceinline__ int lds_byte(int r, int c) { const int st = (r >> 4) * 2 + (c >> 5), rr = r & 15, cc = c & 31, ob = rr * 64 + cc * 2; return st * 1024 + (ob ^ (((ob >> 9) & 1) << 5)); }
__host__ __device__ __forceinline__ void stage_rc(int b, int& R, int& C) { const int st = b / 1024, sb = b % 1024, swz = sb ^ (((sb >> 9) & 1) << 5); R = (st >> 1) * 16 + swz / 64; C = (st & 1) * 32 + (swz % 64) / 2; }
__host__ __device__ __forceinline__ int perm32(int rho) { const int n = rho >> 4, i = rho & 15; return 8 * (i >> 2) + 4 * n + (i & 3); }

struct Unit { int pm, pn, e, r0; };
struct Gemm { const void* A; const void* Bt; int rowb; size_t bstride; };

__device__ __forceinline__ void tile_of(int L, int nM, int nN, int& pm, int& pn) {
    const int nwg = nM * nN; int wgid = L; { const int q = nwg / NXCD, r = nwg % NXCD, xcd = wgid % NXCD, off = wgid / NXCD; wgid = (xcd < r ? xcd * (q + 1) : r * (q + 1) + (xcd - r) * q) + off; }
    const int nig = WGM * nN, gid = wgid / nig, fm = gid * WGM, gsz = (nM - fm) < WGM ? (nM - fm) : WGM;
    pm = fm + ((wgid % nig) % gsz); pn = (wgid % nig) / gsz;
}
struct StaticOrder {
    int nM, nN, nwg, G, c;
    __device__ __forceinline__ void init(int M, int N, int G_, int c_) { nM = M / BM; nN = N / BM; nwg = nM * nN; G = G_; c = c_; }
    __device__ __forceinline__ bool next(int i, Unit& u) const {
        const long L = (long)i * G + c; if (L >= nwg) return false;
        tile_of((int)L, nM, nN, u.pm, u.pn); u.e = 0; u.r0 = 0; return true;
    }
    __device__ __forceinline__ unsigned arow(const Unit& u, int lr) const { return (unsigned)(u.pm * BM + lr); }
};
struct MoeOrder {
    int nM, nN, nwg, G, c; int tstart[NE + 1]; int cnt[NE]; const unsigned* list_tok; bool gather;
    __device__ __forceinline__ void init(const unsigned* cntw, const unsigned* list_tok_, bool gather_, int N, int G_, int c_) {
        int acc = 0;
#pragma unroll
        for (int e = 0; e < NE; ++e) { const int ce = (int)__builtin_amdgcn_readfirstlane((int)__hip_atomic_load((const GAS unsigned*)cntw + 64 * e, __ATOMIC_RELAXED, __HIP_MEMORY_SCOPE_AGENT)); cnt[e] = ce; tstart[e] = acc; acc += (ce + BM - 1) / BM; }
        tstart[NE] = acc; nM = acc; nN = N / BM; nwg = nM * nN; G = G_; c = c_; list_tok = list_tok_; gather = gather_;
    }
    __device__ __forceinline__ bool next(int i, Unit& u) const {
        const long L = (long)i * G + c; if (L >= nwg) return false;
        tile_of((int)L, nM, nN, u.pm, u.pn); int e = 0;
#pragma unroll
        for (int k = 1; k < NE; ++k) e += (u.pm >= tstart[k]) ? 1 : 0;
        u.e = e; int ts = 0;
#pragma unroll
        for (int k = 0; k < NE; ++k) ts = (k == e) ? tstart[k] : ts;
        u.r0 = (u.pm - ts) * BM; return true;
    }
    __device__ __forceinline__ int count_of(int e) const { int cv = 0;
#pragma unroll
        for (int k = 0; k < NE; ++k) cv = (k == e) ? cnt[k] : cv;
        return cv; }
    __device__ __forceinline__ unsigned arow(const Unit& u, int lr) const {
        if (!gather) return (unsigned)(u.pm * BM + lr);
        const int l = u.r0 + lr; const int cv = count_of(u.e);
        unsigned t = 0u; if (l < cv) t = __hip_atomic_load((const GAS unsigned*)list_tok + (size_t)u.e * LIST_CAP + l, __ATOMIC_RELAXED, __HIP_MEMORY_SCOPE_AGENT) & 0xFFFFFu;
        return t;
    }
};

__device__ __forceinline__ unsigned cvt_pk_bf16(float lo, float hi) { unsigned r; asm volatile("v_cvt_pk_bf16_f32 %0, %1, %2" : "=v"(r) : "v"(lo), "v"(hi)); return r; }

struct EpiQKV {
    static constexpr bool PERM = true;
    bf16_t* O; int ldc; int split_cols; size_t split_stride; float scale0;
    __device__ __forceinline__ void operator()(const f32x4 (&acc)[2][2][4][2], const Unit& u, int wr, int wc, int fr, int fq) const {
        const int row0 = u.pm * BM + wr * 64 + fr; int colt = u.pn * BM; bf16_t* base = O;
        float sc = 1.f; { const int t = colt / split_cols; base += (size_t)t * split_stride; colt -= t * split_cols; if (t == 0) sc = scale0; }
        const int col0 = colt + wc * 32 + 8 * fq;
#pragma unroll
        for (int ai = 0; ai < 2; ++ai)
#pragma unroll
            for (int m = 0; m < 4; ++m) { bf16_t* rowp = base + (size_t)(row0 + ai * HALF + m * 16) * ldc + col0;
#pragma unroll
                for (int bj = 0; bj < 2; ++bj) { f32x4 v0 = acc[ai][bj][m][0] * sc, v1 = acc[ai][bj][m][1] * sc;
                    u32x4 w; w.x = cvt_pk_bf16(v0[0], v0[1]); w.y = cvt_pk_bf16(v0[2], v0[3]); w.z = cvt_pk_bf16(v1[0], v1[1]); w.w = cvt_pk_bf16(v1[2], v1[3]);
                    *(GAS u32x4*)(rowp + bj * HALF) = w;
                    } }
    }
};
__device__ __forceinline__ unsigned pk4_fp8(float a, float b, float c, float d) { unsigned w = 0; w = __builtin_amdgcn_cvt_pk_fp8_f32(a, b, w, false); w = __builtin_amdgcn_cvt_pk_fp8_f32(c, d, w, true); return w; }
template <bool F8OUT> struct EpiSwiGLU {
    static constexpr bool PERM = true;
    void* O; int ldc; float sc;
    __device__ __forceinline__ void operator()(const f32x4 (&acc)[2][2][4][2], const Unit& u, int wr, int wc, int fr, int fq) const {
        const int row0 = u.pm * BM + wr * 64 + fr; const int col0 = u.pn * HALF + wc * 32 + 8 * fq;
#pragma unroll
        for (int ai = 0; ai < 2; ++ai)
#pragma unroll
            for (int m = 0; m < 4; ++m) { float o[8];
#pragma unroll
                for (int n = 0; n < 2; ++n)
#pragma unroll
                    for (int j = 0; j < 4; ++j) { const float g = acc[ai][0][m][n][j] * sc, up = acc[ai][1][m][n][j] * sc;
                        const float s = __builtin_amdgcn_rcpf(1.0f + __builtin_amdgcn_exp2f(-1.4426950408889634f * g)); o[n * 4 + j] = g * s * up; }
                const size_t eo = (size_t)(row0 + ai * HALF + m * 16) * ldc + col0;
                if constexpr (F8OUT) { const unsigned long long w = (unsigned long long)pk4_fp8(o[0], o[1], o[2], o[3]) | ((unsigned long long)pk4_fp8(o[4], o[5], o[6], o[7]) << 32);
                    *(GAS unsigned long long*)((unsigned char*)O + eo) = w;
                } else { u32x4 w; w.x = cvt_pk_bf16(o[0], o[1]); w.y = cvt_pk_bf16(o[2], o[3]); w.z = cvt_pk_bf16(o[4], o[5]); w.w = cvt_pk_bf16(o[6], o[7]);
                    *(GAS u32x4*)((bf16_t*)O + eo) = w; } }
    }
};
template <bool RF32> struct EpiRes {
    static constexpr bool PERM = true;
    const void* res; bf16_t* out; int ldc; float sc;
    __device__ __forceinline__ void operator()(const f32x4 (&acc)[2][2][4][2], const Unit& u, int wr, int wc, int fr, int fq) const {
        const int row0 = u.pm * BM + wr * 64 + fr; const int col0 = u.pn * BM + wc * 32 + 8 * fq;
#pragma unroll
        for (int ai = 0; ai < 2; ++ai)
#pragma unroll
            for (int m = 0; m < 4; ++m) { const size_t off = (size_t)(row0 + ai * HALF + m * 16) * ldc + col0;
#pragma unroll
                for (int bj = 0; bj < 2; ++bj) { const size_t o2 = off + bj * HALF; f32x4 r0, r1;
                    if constexpr (RF32) { r0 = *(const GAS f32x4*)((const float*)res + o2); r1 = *(const GAS f32x4*)((const float*)res + o2 + 4); }
                    else { const u32x4 w = *(const GAS u32x4*)((const bf16_t*)res + o2);
                        r0 = (f32x4){__uint_as_float(w.x << 16), __uint_as_float(w.x & 0xFFFF0000u), __uint_as_float(w.y << 16), __uint_as_float(w.y & 0xFFFF0000u)};
                        r1 = (f32x4){__uint_as_float(w.z << 16), __uint_as_float(w.z & 0xFFFF0000u), __uint_as_float(w.w << 16), __uint_as_float(w.w & 0xFFFF0000u)}; }
                    const f32x4 v0 = r0 + acc[ai][bj][m][0] * sc, v1 = r1 + acc[ai][bj][m][1] * sc;
                    u32x4 o; o.x = cvt_pk_bf16(v0[0], v0[1]); o.y = cvt_pk_bf16(v0[2], v0[3]); o.z = cvt_pk_bf16(v1[0], v1[1]); o.w = cvt_pk_bf16(v1[2], v1[3]);
                    *(GAS u32x4*)(out + o2) = o; } }
    }
};
struct EpiMoeDown {
    static constexpr bool PERM = true;
    bf16_t* y0; bf16_t* y1; const unsigned* list_tok; const float* list_w; int cnt[NE]; float sc;
    __device__ __forceinline__ void operator()(const f32x4 (&acc)[2][2][4][2], const Unit& u, int wr, int wc, int fr, int fq) const {
        int cv = 0;
#pragma unroll
        for (int k = 0; k < NE; ++k) cv = (k == u.e) ? cnt[k] : cv;
        const int col0 = u.pn * BM + wc * 32 + 8 * fq;
#pragma unroll
        for (int ai = 0; ai < 2; ++ai)
#pragma unroll
            for (int m = 0; m < 4; ++m) { const int l = u.r0 + ai * HALF + wr * 64 + m * 16 + fr;
                if (l < cv) {
                    const unsigned ent = __hip_atomic_load((const GAS unsigned*)list_tok + (size_t)u.e * LIST_CAP + l, __ATOMIC_RELAXED, __HIP_MEMORY_SCOPE_AGENT);
                    const float w = sc * __uint_as_float(__hip_atomic_load((const GAS unsigned*)list_w + (size_t)u.e * LIST_CAP + l, __ATOMIC_RELAXED, __HIP_MEMORY_SCOPE_AGENT));
                    const size_t off = (size_t)(ent & 0xFFFFFu) * D + col0;
                    bf16_t* yb = (ent >> 20) == 0u ? y0 : y1;
#pragma unroll
                    for (int bj = 0; bj < 2; ++bj) { const f32x4 v0 = acc[ai][bj][m][0] * w, v1 = acc[ai][bj][m][1] * w;
                        u32x4 o; o.x = cvt_pk_bf16(v0[0], v0[1]); o.y = cvt_pk_bf16(v0[2], v0[3]); o.z = cvt_pk_bf16(v1[0], v1[1]); o.w = cvt_pk_bf16(v1[2], v1[3]); *(GAS u32x4*)(yb + off + bj * HALF) = o; }
                } }
    }
};

template <class Epi, class Sched, bool F8 = false>
__device__ __forceinline__ void gemm_phase(PG8_LAS unsigned char* lds, int xoff, const Gemm g, const Sched& S, const Epi& E) {
    int tid_ = threadIdx.x;
    asm volatile("" : "+v"(tid_));
    const int tid = tid_, wid = __builtin_amdgcn_readfirstlane(tid >> 6), lane = tid & 63, wr = wid >> 2, wc = wid & 3, fr = lane & 15, fq = lane >> 4;
    const int RB = g.rowb, nt = RB / 128;
    unsigned voffB[2];
#pragma unroll
    for (int i = 0; i < 2; ++i) { int R, C; stage_rc(tid * 16 + i * 8192, R, C); const int Rb = Epi::PERM ? ((R & ~31) + perm32(R & 31)) : R;
        voffB[i] = (unsigned)(Rb * RB + C * 2); }
    const size_t kstep = (size_t)(BK * 2);
    const size_t hstep = (size_t)HALF * RB;
    const size_t tstep = 2 * hstep;
    const unsigned ldsw = (unsigned)wid * 1024u;
    const int aoff = F8 ? lds_byte(wr * 64 + fr, fq * 16) : lds_byte(wr * 64 + fr, fq * 8), boff = F8 ? lds_byte(wc * 32 + fr, fq * 16) : lds_byte(wc * 32 + fr, fq * 8);
#define PG8_SA(b, h) (((b) * 2 + (h)) * HTB)
#define PG8_SB(b, h) ((4 + (b) * 2 + (h)) * HTB)
#define PG8_STAGE(bufoff, gbase, v0, v1) do { \
        __builtin_amdgcn_global_load_lds((const GAS unsigned*)((const char*)(gbase) + (v0)), (PG8_LAS unsigned*)(lds + (bufoff) + ldsw), 16, 0, 0); \
        __builtin_amdgcn_global_load_lds((const GAS unsigned*)((const char*)(gbase) + (v1)), (PG8_LAS unsigned*)(lds + (bufoff) + ldsw + 8192), 16, 0, 0); } while (0)
#define PG8_STAGEB(bufoff, gbase) PG8_STAGE(bufoff, gbase, voffB[0], voffB[1])
#define PG8_LDA(dst, b, h) do { if constexpr (F8) { _Pragma("unroll") for (int m = 0; m < 4; ++m) { dst##8[m].lo = *(const PG8_LAS i32x4*)(lds + PG8_SA(b, h) + aoff + m * 2048); dst##8[m].hi = *(const PG8_LAS i32x4*)(lds + PG8_SA(b, h) + aoff + m * 2048 + 16); } } \
        else { _Pragma("unroll") for (int m = 0; m < 4; ++m) _Pragma("unroll") for (int k = 0; k < 2; ++k) dst[m][k] = *(const PG8_LAS bf16x8*)(lds + PG8_SA(b, h) + aoff + m * 2048 + k * 1024); } } while (0)
#define PG8_LDB(dst, b, h) do { if constexpr (F8) { _Pragma("unroll") for (int n = 0; n < 2; ++n) { dst##8[n].lo = *(const PG8_LAS i32x4*)(lds + PG8_SB(b, h) + boff + n * 2048); dst##8[n].hi = *(const PG8_LAS i32x4*)(lds + PG8_SB(b, h) + boff + n * 2048 + 16); } } \
        else { _Pragma("unroll") for (int n = 0; n < 2; ++n) _Pragma("unroll") for (int k = 0; k < 2; ++k) dst[n][k] = *(const PG8_LAS bf16x8*)(lds + PG8_SB(b, h) + boff + n * 2048 + k * 1024); } } while (0)
#define PG8_MMA(ai, bj, At, Bt) do { __builtin_amdgcn_s_setprio(1); _Pragma("unroll") for (int m = 0; m < 4; ++m) _Pragma("unroll") for (int n = 0; n < 2; ++n) { \
        if constexpr (F8) acc[ai][bj][m][n] = __builtin_amdgcn_mfma_scale_f32_16x16x128_f8f6f4(Bt##8[n], At##8[m], acc[ai][bj][m][n], 0, 0, 0, 0x7F7F7F7F, 0, 0x7F7F7F7F); \
        else { _Pragma("unroll") for (int k = 0; k < 2; ++k) acc[ai][bj][m][n] = __builtin_amdgcn_mfma_f32_16x16x32_bf16(Bt[n][k], At[m][k], acc[ai][bj][m][n], 0, 0, 0); } } __builtin_amdgcn_s_setprio(0); } while (0)
#define PG8_WAIT_V(n) asm volatile("s_waitcnt vmcnt(" #n ")" ::: "memory")
#define PG8_WAIT_L(n) asm volatile("s_waitcnt lgkmcnt(" #n ")" ::: "memory")
#define PG8_BAR __builtin_amdgcn_s_barrier()
#define PG8_SCHED __builtin_amdgcn_sched_barrier(0)
#define PG8_AOFFS(U, o00, o01, o10, o11) do { int R0_, C0_, R1_, C1_; stage_rc(tid * 16, R0_, C0_); stage_rc(tid * 16 + 8192, R1_, C1_);     \
        o00 = S.arow(U, R0_) * (unsigned)RB + (unsigned)C0_ * 2u; o01 = S.arow(U, R1_) * (unsigned)RB + (unsigned)C1_ * 2u; \
        o10 = S.arow(U, HALF + R0_) * (unsigned)RB + (unsigned)C0_ * 2u; o11 = S.arow(U, HALF + R1_) * (unsigned)RB + (unsigned)C1_ * 2u; } while (0)
    Unit cur, nxt; int ui = 0;
    if (!S.next(0, cur)) return;
    f32x4 acc[2][2][4][2];
#pragma unroll
    for (int a = 0; a < 2; ++a)
#pragma unroll
        for (int b = 0; b < 2; ++b)
#pragma unroll
            for (int m = 0; m < 4; ++m)
#pragma unroll
                for (int n = 0; n < 2; ++n) acc[a][b][m][n] = (f32x4){0.f, 0.f, 0.f, 0.f};
    bf16x8 At[4][2], B0[2][2], B1[2][2];
    i32x8 At8[4], B08[2], B18[2];
    unsigned c00, c01, c10, c11;
    PG8_LAS u32x4* const xslot = (PG8_LAS u32x4*)(lds + xoff) + tid;
    PG8_AOFFS(cur, c00, c01, c10, c11);
    const char* const gA = (const char*)g.A;
    const char* cB = (const char*)g.Bt + (size_t)cur.e * g.bstride + (size_t)cur.pn * tstep;
    PG8_STAGEB(PG8_SB(0, 0), cB); PG8_STAGEB(PG8_SB(0, 1), cB + hstep); PG8_STAGE(PG8_SA(0, 0), gA, c00, c01); PG8_STAGE(PG8_SA(0, 1), gA, c10, c11);
    if (wr == 1) PG8_BAR;
    PG8_WAIT_V(2); PG8_BAR;
    PG8_STAGEB(PG8_SB(1, 0), cB + kstep); PG8_STAGE(PG8_SA(1, 0), gA + kstep, c00, c01); PG8_STAGEB(PG8_SB(1, 1), cB + hstep + kstep);
    PG8_WAIT_V(6); PG8_BAR;
    for (;;) {
        const bool has_next = S.next(ui + 1, nxt);
        const char* nB_ = has_next ? (const char*)g.Bt + (size_t)nxt.e * g.bstride + (size_t)nxt.pn * tstep : cB;
        const char* nB = nB_;
        if (has_next) { unsigned n00, n01, n10, n11; PG8_AOFFS(nxt, n00, n01, n10, n11); *xslot = (u32x4){n00, n01, n10, n11}; }
#pragma unroll 1
        for (int t = 0; t < nt; t += 2) {
            const bool last = (t == nt - 2);
            const char* a1 = gA + (size_t)(t + 1) * kstep;
            const char* a2 = last ? gA : gA + (size_t)(t + 2) * kstep; const char* b2 = last ? nB : cB + (size_t)(t + 2) * kstep;
            const char* a3 = a2 + kstep; const char* b3 = b2 + kstep;
            PG8_LDB(B0, 0, 0); PG8_LDB(B1, 0, 1); PG8_SCHED; PG8_LDA(At, 0, 0); PG8_STAGE(PG8_SA(1, 1), a1, c10, c11);
            if (last && has_next) { const u32x4 nx = *xslot; c00 = nx.x; c01 = nx.y; c10 = nx.z; c11 = nx.w; }
            PG8_WAIT_V(8); PG8_WAIT_L(0); PG8_BAR; PG8_MMA(0, 0, At, B0); PG8_MMA(0, 1, At, B1); PG8_BAR; PG8_SCHED;
            PG8_LDA(At, 0, 1); PG8_STAGEB(PG8_SB(0, 0), b2); PG8_STAGEB(PG8_SB(0, 1), b2 + hstep); PG8_STAGE(PG8_SA(0, 0), a2, c00, c01);
            PG8_WAIT_V(8); PG8_WAIT_L(0); PG8_BAR; PG8_MMA(1, 0, At, B0); PG8_MMA(1, 1, At, B1); PG8_BAR; PG8_SCHED;
            PG8_LDB(B0, 1, 0); PG8_LDB(B1, 1, 1); PG8_SCHED; PG8_LDA(At, 1, 0); PG8_STAGE(PG8_SA(0, 1), a2, c10, c11);
            PG8_WAIT_V(8); PG8_WAIT_L(0); PG8_BAR; PG8_MMA(0, 0, At, B0); PG8_MMA(0, 1, At, B1); PG8_BAR; PG8_SCHED;
            PG8_LDA(At, 1, 1); PG8_STAGEB(PG8_SB(1, 0), b3); PG8_STAGEB(PG8_SB(1, 1), b3 + hstep); PG8_STAGE(PG8_SA(1, 0), a3, c00, c01);
            PG8_WAIT_V(8); PG8_WAIT_L(0); PG8_BAR; PG8_MMA(1, 0, At, B0); PG8_MMA(1, 1, At, B1); PG8_BAR; PG8_SCHED;
        }
        if (wr == 0) PG8_BAR;
        E(acc, cur, wr, wc, fr, fq);
        if (!has_next) break;
#pragma unroll
        for (int a = 0; a < 2; ++a)
#pragma unroll
            for (int b = 0; b < 2; ++b)
#pragma unroll
                for (int m = 0; m < 4; ++m)
#pragma unroll
                    for (int n = 0; n < 2; ++n) acc[a][b][m][n] = (f32x4){0.f, 0.f, 0.f, 0.f};
        cur = nxt; cB = nB; ++ui;
        if (wr == 1) PG8_BAR;
    }
    PG8_WAIT_V(0);
    PG8_BAR;
#undef PG8_SA
#undef PG8_SB
#undef PG8_STAGE
#undef PG8_STAGEB
#undef PG8_LDA
#undef PG8_LDB
#undef PG8_MMA
#undef PG8_WAIT_V
#undef PG8_WAIT_L
#undef PG8_BAR
#undef PG8_SCHED
#undef PG8_AOFFS
}
}

namespace att {
typedef unsigned short bf16_t;
typedef short bf16x8 __attribute__((ext_vector_type(8)));
typedef short s16x4 __attribute__((ext_vector_type(4)));
typedef float f32x16 __attribute__((ext_vector_type(16)));
typedef float f32x4 __attribute__((ext_vector_type(4)));
typedef unsigned u32x4 __attribute__((ext_vector_type(4)));
constexpr int PITCH = 1024;
constexpr float LOG2E = 1.4426950408889634f;
__device__ __forceinline__ int crow(int r, int hi) { return (r & 3) + 8 * (r >> 2) + 4 * hi; }
typedef float f32x2_t __attribute__((ext_vector_type(2))); typedef __bf16 bf16x2_t __attribute__((ext_vector_type(2)));
__device__ __forceinline__ unsigned cvtpk(float lo, float hi) { f32x2_t v = {lo, hi}; bf16x2_t b = __builtin_convertvector(v, bf16x2_t); return __builtin_bit_cast(unsigned, b); }
__device__ __forceinline__ float bf2f(short s) { return __uint_as_float(((unsigned)(unsigned short)s) << 16); }
typedef short v4i16_t __attribute__((ext_vector_type(4)));
__device__ __forceinline__ s16x4 vtr(const LAS unsigned char* p) { return __builtin_bit_cast(s16x4, __builtin_amdgcn_ds_read_tr16_b64_v4i16((LAS v4i16_t*)p)); }
__device__ __forceinline__ float max3f(float a, float b, float c) { float r; asm("v_max3_f32 %0, %1, %2, %3" : "=v"(r) : "v"(a), "v"(b), "v"(c)); return r; }
__device__ __forceinline__ float halves_max(float m) { auto rr = __builtin_amdgcn_permlane32_swap(__float_as_uint(m), __float_as_uint(m), false, false); return fmaxf(__uint_as_float(rr[0]), __uint_as_float(rr[1])); }
__device__ __forceinline__ float halves_sum(float m) { auto rr = __builtin_amdgcn_permlane32_swap(__float_as_uint(m), __float_as_uint(m), false, false); return __uint_as_float(rr[0]) + __uint_as_float(rr[1]); }
#define ATT_PRIO(x) do { if (wid >= 4) __builtin_amdgcn_s_setprio(1 + (x)); else __builtin_amdgcn_s_setprio(x); } while (0)
#define ATT_BAR() asm volatile("s_waitcnt vmcnt(0) lgkmcnt(0)\n\ts_barrier" ::: "memory")
typedef unsigned u32x2 __attribute__((ext_vector_type(2)));
#define ATT_RD128(d, a, off) asm volatile("ds_read_b128 %0, %1 offset:%2" : "=v"(d) : "v"(a), "n"(off))
#define ATT_RDTR(d, a, off) asm volatile("ds_read_b64_tr_b16 %0, %1 offset:%2" : "=v"(d) : "v"(a), "n"(off))
#define ATT_WAIT2(n, x, y) asm volatile("s_waitcnt lgkmcnt(" #n ")" : "+v"(x), "+v"(y))

struct Args { const bf16_t* Q; const bf16_t* K; const bf16_t* V; bf16_t* O; const float* kmean; const float* kmax2; const float* subln; float lam_full; float out_scale; int abl; };
#ifndef ATT_ABLATE
#define ATT_ABLATE 0
#endif
#if ATT_ABLATE
#define ABL(bit) ((((ATT_ABLATE) >> (bit)) & 1) && abl_)
#else
#define ABL(bit) 0
#endif

template <int MODE>
__device__ __forceinline__ void attn_unit(LAS unsigned char* lds, const Args& A, int b, int h, int qblk) {
    constexpr int DVB = MODE == 0 ? 4 : 2;
    constexpr int NCH = MODE == 0 ? 16 : 8;
    constexpr int KBY = NCH * 1024, VBY = DVB * 4096, SLOT = KBY + VBY;
    constexpr int QR = MODE == 0 ? 128 : 256;
    constexpr int PPW = MODE == 0 ? 2 : 1;
    int tid_ = threadIdx.x; asm volatile("" : "+v"(tid_));
    const int tid = tid_, lane = tid & 63, r32 = lane & 31, hi = lane >> 5;
    const int wid = __builtin_amdgcn_readfirstlane(tid >> 6);
    const int comp = MODE == 0 ? (wid >> 2) : 0, wq = MODE == 0 ? (wid & 3) : wid;
    const int q0 = qblk * QR; const long rowbase = (long)b * SEQ;
    const int hcol = MODE == 0 ? h * 128 : h * 64;
    const int qrel0 = wq * 32;
    const float slope2 = __builtin_amdgcn_exp2f(MODE == 0 ? -(float)(h + 1) : -0.5f * (float)(h + 1)) * LOG2E;
    const int NT = MODE == 0 ? 2 * qblk + 2 : 4 + 4 * qblk;
#define ATT_KBASE_(t) (MODE == 0 ? 64 * (t) : ((t) < 4 ? q0 + 64 * (t) : 64 * ((t) - 4)))
#define ATT_KBASE(t) ATT_KBASE_(t)
    LAS float* wsf = (LAS float*)(lds + 65536) + wid * 64;
    const bf16_t* Kb = A.K + rowbase * PITCH + hcol;
    const bf16_t* Vb = A.V + rowbase * PITCH + hcol;
#define ATT_ISSUE_K(tt, slot) do { const int kb_ = ATT_KBASE(tt); \
        _Pragma("unroll") for (int i_ = 0; i_ < PPW; ++i_) { const int p_ = wid + 8 * i_; \
            __builtin_amdgcn_global_load_lds((const GAS unsigned*)(Kb + (size_t)(kb_ + lane) * PITCH + p_ * 8), (LAS unsigned*)(lds + (slot) * SLOT + p_ * 1024), 16, 0, 0); } } while (0)
#define ATT_ISSUE_V(tt, slot) do { const int kb_ = ATT_KBASE(tt); \
        _Pragma("unroll") for (int i_ = 0; i_ < PPW; ++i_) { const int p_ = wid + 8 * i_; \
            __builtin_amdgcn_global_load_lds((const GAS unsigned*)(Vb + (size_t)(kb_ + 16 * (p_ & 3) + (lane >> 2)) * PITCH + (p_ >> 2) * 32 + (lane & 3) * 8), (LAS unsigned*)(lds + (slot) * SLOT + KBY + p_ * 1024), 16, 0, 0); } } while (0)
    asm volatile("s_waitcnt lgkmcnt(0)\n\ts_barrier" ::: "memory");
    bf16x8 qr[4];
    { const bf16_t* Qw = A.Q + (rowbase + q0 + qrel0 + r32) * PITCH + hcol + comp * 64 + hi * 8;
#pragma unroll
      for (int d0 = 0; d0 < 4; ++d0) qr[d0] = *(const GAS bf16x8*)(Qw + d0 * 16); }
    const int tt_l = MODE == 0 ? (lane < 2 ? 2 * qblk + lane : lane - 2) : lane;
    const int kbase_l = (lane < NT) ? ATT_KBASE_(tt_l) : 0;
    const bool past_l = lane < NT && kbase_l + 64 <= q0;
    float k2a = 0.f, k2b = 0.f;
    { const int nblk = (kbase_l >> 8) & 15;
        if constexpr (MODE == 0) { k2a = ((const GAS float*)A.kmax2)[(size_t)(b * 16 + h * 2) * 16 + nblk]; k2b = ((const GAS float*)A.kmax2)[(size_t)(b * 16 + h * 2 + 1) * 16 + nblk]; }
        else k2a = ((const GAS float*)A.kmax2)[(size_t)(b * 16 + h) * 16 + nblk]; }
    float kmv0 = 0.f, kmv1 = 0.f;
    if constexpr (MODE == 1) { kmv0 = ((const GAS float*)A.kmean)[(size_t)(b * 16 + h) * 1024 + tid]; kmv1 = ((const GAS float*)A.kmean)[(size_t)(b * 16 + h) * 1024 + 512 + tid]; }
    const int t0 = MODE == 0 ? 2 * qblk : 0, t1 = t0 + 1;
    ATT_ISSUE_K(t0, 0); ATT_ISSUE_V(t0, 0); ATT_ISSUE_K(t1, 1);
    LAS int* live = (LAS int*)(lds + 71680); LAS float* qnx = (LAS float*)(lds + 71680 + 272);
    LAS float* km = (LAS float*)(lds + 67584);
    { float q2 = 0.f;
#pragma unroll
      for (int d0 = 0; d0 < 4; ++d0)
#pragma unroll
        for (int j = 0; j < 8; ++j) { const float v = bf2f(qr[d0][j]); q2 += v * v; }
      q2 = halves_sum(q2);
      q2 = fmaxf(q2, __shfl_xor(q2, 1)); q2 = fmaxf(q2, __shfl_xor(q2, 2)); q2 = fmaxf(q2, __shfl_xor(q2, 4)); q2 = fmaxf(q2, __shfl_xor(q2, 8)); q2 = fmaxf(q2, __shfl_xor(q2, 16));
      if (lane == 0) qnx[wid] = q2; }
    if constexpr (MODE == 1) { km[tid] = kmv0; km[tid + 512] = kmv1; }
    ATT_BAR();
    if (wid == 0) {
        bool alive = lane < NT;
        if (past_l) { float bound;
            if constexpr (MODE == 0) { const float qa = fmaxf(fmaxf(qnx[0], qnx[1]), fmaxf(qnx[2], qnx[3])), qb = fmaxf(fmaxf(qnx[4], qnx[5]), fmaxf(qnx[6], qnx[7]));
                bound = fmaxf(sqrtf(qa) * sqrtf(k2a), sqrtf(qb) * sqrtf(k2b));
            } else { float qm = qnx[0];
#pragma unroll
                for (int w = 1; w < 8; ++w) qm = fmaxf(qm, qnx[w]);
                bound = sqrtf(qm) * sqrtf(k2a); }
            alive = !(bound * 1.001f + 1.0f + slope2 * (float)(kbase_l + 63 - q0) < -152.0f);
        }
        const unsigned long long am = __ballot(alive);
        if (alive) live[__popcll(am & ((1ull << lane) - 1ull))] = tt_l;
        if (lane == 0) live[64] = __popcll(am);
    }
    unsigned sel = 0u;
    if constexpr (MODE == 1) {
        float g[16];
#pragma unroll
        for (int n = 0; n < 16; ++n) { float s = 0.f;
            if (n < qblk) {
#pragma unroll
                for (int d0 = 0; d0 < 4; ++d0) { const f32x4 ka = *(const LAS f32x4*)(km + n * 64 + d0 * 16 + hi * 8), kb2 = *(const LAS f32x4*)(km + n * 64 + d0 * 16 + hi * 8 + 4);
                    s += bf2f(qr[d0][0]) * ka[0] + bf2f(qr[d0][1]) * ka[1] + bf2f(qr[d0][2]) * ka[2] + bf2f(qr[d0][3]) * ka[3]
                       + bf2f(qr[d0][4]) * kb2[0] + bf2f(qr[d0][5]) * kb2[1] + bf2f(qr[d0][6]) * kb2[2] + bf2f(qr[d0][7]) * kb2[3]; }
                s = halves_sum(s); }
            g[n] = s; }
        const int nsel = qblk < 3 ? qblk : 3;
#pragma unroll
        for (int k = 0; k < 3; ++k) if (k < nsel) { float best = -INFINITY; int bi = 0; bool found = false;
#pragma unroll
            for (int n = 0; n < 16; ++n) if (n < qblk) { const bool free_ = ((sel >> n) & 1u) == 0u; if (free_ && (!found || g[n] > best)) { best = g[n]; bi = n; found = true; } }
            sel |= 1u << bi; }
    }
    ATT_BAR();
    const int NTL = __builtin_amdgcn_readfirstlane(live[64]);
#define ATT_ISSUE(t, slot) do { const int kb_ = ATT_KBASE(t); \
        _Pragma("unroll") for (int i_ = 0; i_ < PPW; ++i_) { const int p_ = wid + 8 * i_; \
            __builtin_amdgcn_global_load_lds((const GAS unsigned*)(Kb + (size_t)(kb_ + lane) * PITCH + p_ * 8), (LAS unsigned*)(lds + (slot) * SLOT + p_ * 1024), 16, 0, 0); \
            __builtin_amdgcn_global_load_lds((const GAS unsigned*)(Vb + (size_t)(kb_ + 16 * (p_ & 3) + (lane >> 2)) * PITCH + (p_ >> 2) * 32 + (lane & 3) * 8), (LAS unsigned*)(lds + (slot) * SLOT + KBY + p_ * 1024), 16, 0, 0); } } while (0)
    constexpr float THR = 8.0f;
    float mref = 0.f, l = 0.f; f32x16 o[DVB];
#pragma unroll
    for (int d0 = 0; d0 < DVB; ++d0) o[d0] = f32x16{};
#define ATT_CLASS(tt, SK, NM, SB) do { const int kb_ = ATT_KBASE(tt), kr_ = kb_ - q0; const bool dg_ = kb_ >= q0; SK = dg_ && (kr_ > qrel0 + 31); NM = dg_ && (kr_ + 63 > qrel0); SB = true; \
        if constexpr (MODE == 1) { if ((tt) >= 4) { SB = ((sel >> (((tt) - 4) >> 2)) & 1u) != 0u; if (!__any(SB)) SK = true; } } } while (0)
#define ATT_QK(P0, P1, tt, slot, SB) do { const int kr_ = ATT_KBASE(tt) - q0; float off0_ = slope2 * (float)(kr_ + 4 * hi) - mref; if (!(SB)) off0_ = -INFINITY; const float off1_ = off0_ + 32.0f * slope2; \
        const unsigned ka_ = (unsigned)(size_t)(lds + (slot) * SLOT + comp * 8192 + hi * 1024 + r32 * 16); u32x4 kx_[4], ky_[4]; \
        ATT_RD128(kx_[0], ka_, 0); ATT_RD128(ky_[0], ka_, 512); ATT_RD128(kx_[1], ka_, 2048); ATT_RD128(ky_[1], ka_, 2560); \
        _Pragma("unroll") for (int r = 0; r < 16; ++r) { const float cbr = slope2 * (float)((r & 3) + 8 * (r >> 2)); P0[r] = cbr + off0_; P1[r] = cbr + off1_; } \
        ATT_PRIO(1); ATT_WAIT2(2, kx_[0], ky_[0]); P0 = __builtin_amdgcn_mfma_f32_32x32x16_bf16(__builtin_bit_cast(bf16x8, kx_[0]), qr[0], P0, 0, 0, 0); P1 = __builtin_amdgcn_mfma_f32_32x32x16_bf16(__builtin_bit_cast(bf16x8, ky_[0]), qr[0], P1, 0, 0, 0); \
        ATT_RD128(kx_[2], ka_, 4096); ATT_RD128(ky_[2], ka_, 4608); \
        ATT_WAIT2(2, kx_[1], ky_[1]); P0 = __builtin_amdgcn_mfma_f32_32x32x16_bf16(__builtin_bit_cast(bf16x8, kx_[1]), qr[1], P0, 0, 0, 0); P1 = __builtin_amdgcn_mfma_f32_32x32x16_bf16(__builtin_bit_cast(bf16x8, ky_[1]), qr[1], P1, 0, 0, 0); \
        ATT_RD128(kx_[3], ka_, 6144); ATT_RD128(ky_[3], ka_, 6656); \
        ATT_WAIT2(2, kx_[2], ky_[2]); P0 = __builtin_amdgcn_mfma_f32_32x32x16_bf16(__builtin_bit_cast(bf16x8, kx_[2]), qr[2], P0, 0, 0, 0); P1 = __builtin_amdgcn_mfma_f32_32x32x16_bf16(__builtin_bit_cast(bf16x8, ky_[2]), qr[2], P1, 0, 0, 0); \
        ATT_WAIT2(0, kx_[3], ky_[3]); P0 = __builtin_amdgcn_mfma_f32_32x32x16_bf16(__builtin_bit_cast(bf16x8, kx_[3]), qr[3], P0, 0, 0, 0); P1 = __builtin_amdgcn_mfma_f32_32x32x16_bf16(__builtin_bit_cast(bf16x8, ky_[3]), qr[3], P1, 0, 0, 0); ATT_PRIO(0); } while (0)
    f32x16 p0, p1, n0, n1;
    const int abl_ = __builtin_amdgcn_readfirstlane(A.abl); (void)abl_;
    int t = t0, tn = t1;
    bool skipC, maskC, selC, skipN = true, maskN = false, selN = true;
    ATT_CLASS(t, skipC, maskC, selC);
    if (!skipC) ATT_QK(p0, p1, t, 0, selC);
    const int NTLX = ABL(4) ? 1 : NTL;
    ATT_PRIO(0);
    for (int it = 0; it < NTLX; ++it) {
        ATT_BAR();
        const int tnn = (it + 2 < NTL) ? __builtin_amdgcn_readfirstlane(live[it + 2]) : 0;
        if (it + 2 < NTL && !ABL(0)) ATT_ISSUE_K(tnn, it & 1);
        if (it + 1 < NTL) { if (!ABL(0)) ATT_ISSUE_V(tn, (it + 1) & 1); ATT_CLASS(tn, skipN, maskN, selN); if (!skipN) { if (!ABL(2)) ATT_QK(n0, n1, tn, (it + 1) & 1, selN); else { n0 = f32x16{} - 1.0f; n1 = n0; } } } else skipN = true;
        if (!skipC) {
            const int krel = ATT_KBASE(t) - q0;
            const unsigned va_ = (unsigned)(size_t)(lds + (it & 1) * SLOT + KBY + ((lane >> 4) & 1) * 32 + (lane & 3) * 8 + (4 * hi + ((lane & 15) >> 2)) * 64);
            u32x2 vl_[4], vh_[4];
            if (!ABL(1)) { ATT_RDTR(vl_[0], va_, 0); ATT_RDTR(vh_[0], va_, 512); ATT_RDTR(vl_[1], va_, 1024); ATT_RDTR(vh_[1], va_, 1536);
            ATT_RDTR(vl_[2], va_, 2048); ATT_RDTR(vh_[2], va_, 2560); ATT_RDTR(vl_[3], va_, 3072); ATT_RDTR(vh_[3], va_, 3584); }
            if (maskC) { const int qrel = qrel0 + r32;
#pragma unroll
                for (int r = 0; r < 16; ++r) { const int kv = krel + crow(r, hi); if (kv > qrel) p0[r] = -INFINITY; if (kv + 32 > qrel) p1[r] = -INFINITY; } }
            float rm;
            { float a_ = max3f(p0[0], p0[1], p1[0]), b_ = max3f(p0[2], p0[3], p1[1]); a_ = max3f(a_, p1[2], p1[3]);
#pragma unroll
              for (int r = 4; r < 16; r += 4) { a_ = max3f(a_, p0[r], p0[r + 1]); b_ = max3f(b_, p0[r + 2], p0[r + 3]); a_ = max3f(a_, p1[r], p1[r + 1]); b_ = max3f(b_, p1[r + 2], p1[r + 3]); }
              rm = halves_max(fmaxf(a_, b_)); }
            if (__any(rm > THR)) {
                const float dl = fmaxf(rm, 0.f); mref += dl; const float alpha = __builtin_amdgcn_exp2f(-dl);
#pragma unroll
                for (int r = 0; r < 16; ++r) { p0[r] -= dl; p1[r] -= dl; }
                if (!skipN) {
#pragma unroll
                    for (int r = 0; r < 16; ++r) { n0[r] -= dl; n1[r] -= dl; } }
                l *= alpha;
                if (hi == 0) wsf[r32] = alpha;
                asm volatile("s_waitcnt lgkmcnt(0)" ::: "memory");
#pragma unroll
                for (int gq = 0; gq < 4; ++gq) { const f32x4 f = *(const LAS f32x4*)(wsf + 8 * gq + 4 * hi);
#pragma unroll
                    for (int d0 = 0; d0 < DVB; ++d0) { o[d0][4 * gq + 0] *= f[0]; o[d0][4 * gq + 1] *= f[1]; o[d0][4 * gq + 2] *= f[2]; o[d0][4 * gq + 3] *= f[3]; } }
            }
            float sacc = 0.f;
            if (!ABL(3)) {
#pragma unroll
            for (int r = 0; r < 16; ++r) { p0[r] = __builtin_amdgcn_exp2f(p0[r]); p1[r] = __builtin_amdgcn_exp2f(p1[r]); sacc += p0[r] + p1[r]; } }
            l += sacc;
            u32x4 pw[4];
            pw[0] = (u32x4){cvtpk(p0[0], p0[1]), cvtpk(p0[2], p0[3]), cvtpk(p0[4], p0[5]), cvtpk(p0[6], p0[7])};
            pw[1] = (u32x4){cvtpk(p0[8], p0[9]), cvtpk(p0[10], p0[11]), cvtpk(p0[12], p0[13]), cvtpk(p0[14], p0[15])};
            pw[2] = (u32x4){cvtpk(p1[0], p1[1]), cvtpk(p1[2], p1[3]), cvtpk(p1[4], p1[5]), cvtpk(p1[6], p1[7])};
            pw[3] = (u32x4){cvtpk(p1[8], p1[9]), cvtpk(p1[10], p1[11]), cvtpk(p1[12], p1[13]), cvtpk(p1[14], p1[15])};
            if (!ABL(1))
#pragma unroll
            for (int i = 0; i < 4 * DVB; ++i) { constexpr int NM = 4 * DVB; const int s_ = i & 3; if (i == 0) ATT_PRIO(1);
                if (i + 3 < NM) ATT_WAIT2(6, vl_[s_], vh_[s_]); else if (i + 3 == NM) ATT_WAIT2(4, vl_[s_], vh_[s_]); else if (i + 2 == NM) ATT_WAIT2(2, vl_[s_], vh_[s_]); else ATT_WAIT2(0, vl_[s_], vh_[s_]);
                const u32x4 vf = (u32x4){vl_[s_][0], vl_[s_][1], vh_[s_][0], vh_[s_][1]};
                o[i >> 2] = __builtin_amdgcn_mfma_f32_32x32x16_bf16(__builtin_bit_cast(bf16x8, pw[i & 3]), __builtin_bit_cast(bf16x8, vf), o[i >> 2], 0, 0, 0);
                if (i + 4 < NM) { ATT_RDTR(vl_[s_], va_, (i + 4) * 1024); ATT_RDTR(vh_[s_], va_, (i + 4) * 1024 + 512); } if (i == NM - 1) ATT_PRIO(0); }
        }
        p0 = n0; p1 = n1; skipC = skipN; maskC = maskN; selC = selN; t = tn; tn = tnn;
    }
#undef ATT_ISSUE_K
#undef ATT_ISSUE_V
#undef ATT_CLASS
#undef ATT_QK
    __builtin_amdgcn_s_setprio(0);
    if (ABL(5)) return;
    float sg[DVB];
    if constexpr (MODE == 0) {
#pragma unroll
        for (int d0 = 0; d0 < DVB; ++d0) sg[d0] = ((const GAS float*)A.subln)[d0 * 32 + r32]; }
    l = halves_sum(l);
    if (hi == 0) wsf[32 + r32] = l;
    asm volatile("s_waitcnt lgkmcnt(0)" ::: "memory");
    float rli[16];
#pragma unroll
    for (int gq = 0; gq < 4; ++gq) { const f32x4 f = *(const LAS f32x4*)(wsf + 32 + 8 * gq + 4 * hi); rli[4 * gq + 0] = 1.0f / f[0]; rli[4 * gq + 1] = 1.0f / f[1]; rli[4 * gq + 2] = 1.0f / f[2]; rli[4 * gq + 3] = 1.0f / f[3]; }
    if constexpr (MODE == 1) {
        GAS bf16_t* Ow = (GAS bf16_t*)(A.O + (rowbase + q0 + qrel0) * PITCH + hcol);
#pragma unroll
        for (int r = 0; r < 16; ++r)
#pragma unroll
            for (int d0 = 0; d0 < DVB; ++d0) Ow[(size_t)crow(r, hi) * PITCH + d0 * 32 + r32] = (bf16_t)(cvtpk(o[d0][r] * rli[r], 0.f) & 0xFFFFu);
    } else {
        ATT_BAR();
        LAS float* X = (LAS float*)lds + wq * 4096;
        if (comp == 1) {
#pragma unroll
            for (int d0 = 0; d0 < DVB; ++d0)
#pragma unroll
                for (int r = 0; r < 16; ++r) X[(d0 * 16 + r) * 64 + lane] = o[d0][r] * rli[r];
        }
        ATT_BAR();
        if (comp == 0) {
#pragma unroll
            for (int d0 = 0; d0 < DVB; ++d0) sg[d0] *= A.out_scale;
            GAS bf16_t* Ow = (GAS bf16_t*)(A.O + (rowbase + q0 + qrel0) * PITCH + hcol);
#pragma unroll
            for (int r = 0; r < 16; ++r) { float dv[DVB]; float ss = 0.f;
#pragma unroll
                for (int d0 = 0; d0 < DVB; ++d0) { dv[d0] = o[d0][r] * rli[r] - A.lam_full * X[(d0 * 16 + r) * 64 + lane]; ss += dv[d0] * dv[d0]; }
                ss += __int_as_float(__builtin_amdgcn_update_dpp(0, __float_as_int(ss), 0xB1, 0xF, 0xF, true)); ss += __int_as_float(__builtin_amdgcn_update_dpp(0, __float_as_int(ss), 0x4E, 0xF, 0xF, true));
                ss += __int_as_float(__builtin_amdgcn_update_dpp(0, __float_as_int(ss), 0x141, 0xF, 0xF, true)); ss += __int_as_float(__builtin_amdgcn_update_dpp(0, __float_as_int(ss), 0x140, 0xF, 0xF, true));
                ss += __int_as_float(__builtin_amdgcn_ds_swizzle(__float_as_int(ss), 0x401F));
                const float rs = 1.0f / sqrtf(ss * (1.0f / 128.0f) + 1e-5f);
#pragma unroll
                for (int d0 = 0; d0 < DVB; ++d0) Ow[(size_t)crow(r, hi) * PITCH + d0 * 32 + r32] = (bf16_t)(cvtpk(dv[d0] * rs * sg[d0], 0.f) & 0xFFFFu); }
        }
    }
#undef ATT_KBASE
#undef ATT_KBASE_
#undef ATT_ISSUE
}
#undef ATT_BAR
}

constexpr int NWAVES = 8;
constexpr int NLAYER = 4, PH_PER_LAYER = 8, NPHASE = 1 + NLAYER * PH_PER_LAYER;

constexpr size_t MiB = 1u << 20;
constexpr size_t WS_CTL = 0, CTL_ZERO_BYTES = 1 * MiB;
constexpr size_t WS_KMEAN = 1 * MiB;
constexpr size_t WS_LTOK = 2 * MiB, WS_LW = 3 * MiB;
constexpr size_t WS_DQKV = 5 * MiB;
constexpr size_t WS_DWO = WS_DQKV + 12 * MiB;
constexpr size_t WS_MQKV = WS_DWO + 4 * MiB;
constexpr size_t WS_MWO = WS_MQKV + 12 * MiB;
constexpr size_t WS_FGU = WS_MWO + 4 * MiB;
constexpr size_t WS_FD = WS_FGU + 22 * MiB;
constexpr size_t WS_MGU = WS_FD + 11 * MiB;
constexpr size_t WS_MD = WS_MGU + 112 * MiB;
constexpr size_t WS_XN = WS_MD + 56 * MiB;
constexpr size_t WS_Q = WS_XN + 64 * MiB, WS_K = WS_Q + 64 * MiB, WS_V = WS_K + 64 * MiB;
constexpr size_t WS_ACT = WS_Q;
constexpr size_t WS_END = WS_ACT + (size_t)MOE_TILES_MAX * 256 * DE * 2;
constexpr size_t WS_Y0 = WS_END - 64 * MiB;
constexpr size_t WS_HB = WS_END;
static_assert(WS_XN == 238 * MiB && WS_END == 778 * MiB, "d_ws map");
constexpr int CW_BAR = 4096;
constexpr int CW_ATTQ = 6144;
constexpr int CW_ATTQ2 = 12288;
constexpr int CW_CNT = 8192;

constexpr int RING_OFF = 0, RING_BYTES = 131072;
constexpr int LDSCTL_OFF = RING_BYTES, MISC_OFF = LDSCTL_OFF + 320;
constexpr int XSLOT_OFF = MISC_OFF + 128;
constexpr int LDS_BYTES = 147456;

typedef unsigned short bf16;
typedef unsigned v4u __attribute__((ext_vector_type(4)));
typedef float f32x4 __attribute__((ext_vector_type(4)));
typedef GAS unsigned gu32;
#define RLX_AGENT __ATOMIC_RELAXED, __HIP_MEMORY_SCOPE_AGENT
#define LDS_WAIT() asm volatile("s_waitcnt lgkmcnt(0)" ::: "memory")
#define VM_WAIT() asm volatile("s_waitcnt vmcnt(0)" ::: "memory")
__device__ __forceinline__ unsigned f2bf(float f) { unsigned u = __builtin_bit_cast(unsigned, f); return (u + 0x7fffu + ((u >> 16) & 1u)) >> 16; }
__device__ __forceinline__ unsigned pk2(float lo, float hi) { return f2bf(lo) | (f2bf(hi) << 16); }
__device__ __forceinline__ float bflo(unsigned w) { return __uint_as_float(w << 16); }
__device__ __forceinline__ float bfhi(unsigned w) { return __uint_as_float(w & 0xFFFF0000u); }
static_assert(XSLOT_OFF % 16 == 0 && XSLOT_OFF + 8192 <= LDS_BYTES, "LDS map");
#define XB_TMO      128
#define XB_XCNT(j)  (256  + 64 * (j))
#define XB_XSUB(j)  (1280 + 64 * (j))
#define XB_XGEN(j)  (2304 + 64 * (j))
#define XB_TOP      3328
#define XB_TOPGEN   3392
#define XCD_BAR_WORDS 3456
#define XB_SPIN_CAP (1u << 18)

__device__ __forceinline__ unsigned xb_ld(unsigned* p)              { return __hip_atomic_load(p, __ATOMIC_RELAXED, __HIP_MEMORY_SCOPE_AGENT); }
__device__ __forceinline__ unsigned xb_add(unsigned* p, unsigned v) { return __hip_atomic_fetch_add(p, v, __ATOMIC_RELAXED, __HIP_MEMORY_SCOPE_AGENT); }
__device__ __forceinline__ unsigned xb_xcc_id() { return (unsigned)__builtin_amdgcn_s_getreg((3 << 11) | 20) & 0xFu; }
#define XB_SPIN(cond, bar) do { unsigned _sp = 0; while (cond) { __builtin_amdgcn_s_sleep(1); \
    if ((++_sp & 255u) == 0u) { if (xb_ld(&(bar)[XB_TMO])) break; if (_sp > XB_SPIN_CAP) { atomicAdd(&(bar)[XB_TMO], 1u); break; } } } } while (0)

struct XcdBarrier {
    unsigned* bar; unsigned x;
    volatile LAS unsigned* st;
};

__device__ __forceinline__ XcdBarrier xcd_barrier_post(unsigned* bar, volatile LAS unsigned* st) {
    XcdBarrier b; b.bar = bar; b.x = xb_xcc_id(); b.st = st;
    if (threadIdx.x == 0) (void)xb_add(&bar[XB_XCNT(b.x)], 1u);
    return b;
}
__device__ __forceinline__ void xcd_barrier_complete(unsigned* bar, unsigned x, unsigned& nloc, unsigned& nx) {
    const unsigned G = gridDim.x * gridDim.y * gridDim.z;
    unsigned sum, cnt, mine, sp = 0u;
    for (;;) {
        sum = 0u; cnt = 0u; mine = 0u;
#pragma unroll
        for (unsigned j = 0; j < 16; ++j) { const unsigned c = xb_ld(&bar[XB_XCNT(j)]); sum += c; cnt += (c > 0u) ? 1u : 0u; mine = (j == x) ? c : mine; }
        if (sum == G) break;
        __builtin_amdgcn_s_sleep(1);
        if ((++sp & 255u) == 0u) { if (xb_ld(&bar[XB_TMO])) break; if (sp > XB_SPIN_CAP) { atomicAdd(&bar[XB_TMO], 1u); break; } }
    }
    nloc = mine > 0u ? mine : 1u; nx = cnt > 0u ? cnt : 1u;
}

__device__ __forceinline__ void xcd_barrier(const XcdBarrier& b) {
    asm volatile("s_waitcnt vmcnt(0)" ::: "memory");
    __syncthreads();
    if (threadIdx.x == 0) {
        unsigned* bar = b.bar;
        __builtin_amdgcn_s_waitcnt(0);
        unsigned nloc = b.st[0], nx = b.st[1];
        if (nloc == 0u) { xcd_barrier_complete(bar, b.x, nloc, nx); b.st[0] = nloc; b.st[1] = nx; }
        const unsigned old = xb_add(&bar[XB_XSUB(b.x)], 1u);
        const unsigned gen = old / nloc;
        if (old + 1u == (gen + 1u) * nloc) {
            __builtin_amdgcn_fence(__ATOMIC_RELEASE, "agent");
            asm volatile("s_waitcnt vmcnt(0)" ::: "memory");
            const unsigned og = xb_add(&bar[XB_TOP], 1u);
            const unsigned tg = og / nx;
            if (og + 1u == (tg + 1u) * nx) xb_add(&bar[XB_TOPGEN], 1u);
            else XB_SPIN(xb_ld(&bar[XB_TOPGEN]) == tg, bar);
            __builtin_amdgcn_fence(__ATOMIC_ACQUIRE, "agent");
            xb_add(&bar[XB_XGEN(b.x)], 1u);
            asm volatile("s_waitcnt vmcnt(0)" ::: "memory");
        } else {
            XB_SPIN(xb_ld(&bar[XB_XGEN(b.x)]) == gen, bar);
            __builtin_amdgcn_fence(__ATOMIC_ACQUIRE, "agent");
            asm volatile("s_waitcnt vmcnt(0)" ::: "memory");
        }
    }
    __syncthreads();
}

struct Frame {
    LAS unsigned char* lds;
    volatile LAS unsigned* MISC;
    gu32* ctl;
    int tid, lane, wave;
    int vcu, G;
};
__device__ __forceinline__ float wave_sum(float v) {
    v += __int_as_float(__builtin_amdgcn_update_dpp(0, __float_as_int(v), 0xB1, 0xF, 0xF, true));
    v += __int_as_float(__builtin_amdgcn_update_dpp(0, __float_as_int(v), 0x4E, 0xF, 0xF, true));
    v += __int_as_float(__builtin_amdgcn_update_dpp(0, __float_as_int(v), 0x141, 0xF, 0xF, true));
    v += __int_as_float(__builtin_amdgcn_update_dpp(0, __float_as_int(v), 0x140, 0xF, 0xF, true));
    v += __int_as_float(__builtin_amdgcn_ds_swizzle(__float_as_int(v), 0x401F));
    auto rr = __builtin_amdgcn_permlane32_swap(__float_as_uint(v), __float_as_uint(v), false, false);
    return __uint_as_float(rr[0]) + __uint_as_float(rr[1]);
}
__device__ __forceinline__ void transpose_item(const float* W, int K, int N, void* WT, int k0, int n0, int drow0, LAS float* scr, int lane, bool f8, float wscale) {
    const GAS float* src = (const GAS float*)W + (size_t)k0 * N + n0 + lane;
#pragma unroll
    for (int hb = 0; hb < 2; ++hb) { float v[32];
#pragma unroll
        for (int i = 0; i < 32; ++i) v[i] = src[(size_t)(hb * 32 + i) * N];
#pragma unroll
        for (int i = 0; i < 32; ++i) { const int kk = hb * 32 + i; scr[kk * 64 + (lane ^ ((kk >> 3) << 3))] = v[i]; } }
    LDS_WAIT(); asm volatile("" ::: "memory");
    if (f8) {
        const int c = lane & 3;
#pragma unroll
        for (int j = 0; j < 4; ++j) { const int nn = (lane >> 2) + 16 * j; float v[16];
#pragma unroll
            for (int q = 0; q < 16; ++q) { const int kk = 16 * c + q; v[q] = scr[kk * 64 + (nn ^ ((kk >> 3) << 3))] * wscale; }
            v4u o; o.x = pg8::pk4_fp8(v[0], v[1], v[2], v[3]); o.y = pg8::pk4_fp8(v[4], v[5], v[6], v[7]); o.z = pg8::pk4_fp8(v[8], v[9], v[10], v[11]); o.w = pg8::pk4_fp8(v[12], v[13], v[14], v[15]);
            *(GAS v4u*)((unsigned char*)WT + (size_t)(drow0 + nn) * K + k0 + 16 * c) = o; }
    } else {
    const int c = lane & 7;
#pragma unroll
    for (int j = 0; j < 8; ++j) { const int n = (lane >> 3) + 8 * j; const LAS float* s = scr + (8 * c) * 64 + (n ^ (c << 3));
        v4u o; o.x = pk2(s[0 * 64], s[1 * 64]); o.y = pk2(s[2 * 64], s[3 * 64]); o.z = pk2(s[4 * 64], s[5 * 64]); o.w = pk2(s[6 * 64], s[7 * 64]);
        *(GAS v4u*)((bf16*)WT + (size_t)(drow0 + n) * K + k0 + 8 * c) = o; }
    }
    LDS_WAIT(); asm volatile("" ::: "memory");
}
__device__ __forceinline__ void convert_matrix(Frame& F, const float* W, int K, int N, void* WT, int il, unsigned& rot, bool f8 = false, float wscale = 1.0f) {
    LAS float* scr = (LAS float*)(F.lds + RING_OFF + F.wave * 16384);
    const unsigned gw = (unsigned)(F.vcu * NWAVES + F.wave), NGW = (unsigned)(F.G * NWAVES);
    const int nblk = N / 64, nitems = (K / 64) * nblk; int lane_ = F.lane; asm volatile("" : "+v"(lane_));
    for (int it = (int)((gw + NGW - rot % NGW) % NGW); it < nitems; it += (int)NGW) {
        const int kb = it / nblk, nb = it % nblk, n0 = 64 * nb;
        const int drow0 = il == 0 ? n0 : (n0 / 128) * 256 + (il - 1) * 128 + (n0 % 128);
        transpose_item(W, K, N, WT, 64 * kb, n0, drow0, scr, lane_, f8, wscale);
    }
    rot = (rot + (unsigned)nitems) % NGW;
}

struct RouterArgs { const float* router; gu32* cnt; unsigned* ltok; float* lw; };
template <int MODE, bool F8X = false, bool SF32 = false>
__device__ __forceinline__ void norm_phase(Frame& F, const void* src, bf16* hout, const bf16* y1, const float* gain, bf16* xn, float* fout, const RouterArgs& R, const bf16* y0 = nullptr) {
    int lane_ = F.lane; asm volatile("" : "+v"(lane_));
    const int gw = F.vcu * NWAVES + F.wave, NGW = F.G * NWAVES, lane = lane_;
    f32x4 gv[4];
#pragma unroll
    for (int j = 0; j < 4; ++j) gv[j] = *(const GAS f32x4*)(gain + 256 * j + 4 * lane);
    LAS float* RL = (LAS float*)(F.lds + RING_OFF);
    if constexpr (MODE == 2) {
        int tid_ = F.tid; asm volatile("" : "+v"(tid_));
        for (int i = tid_; i < 8192; i += NWAVES * 64) RL[(i & 7) * 1024 + (i >> 3)] = ((const GAS float*)R.router)[i];
        LDS_WAIT(); __syncthreads();
    }
    const int nrows_w = gw < MTOK ? (MTOK - gw + NGW - 1) / NGW : 0;
    for (int cb = 0; cb < nrows_w; cb += 64) {
        int my_t = 0, my_e0 = 0, my_e1 = 0; float my_w0 = 0.f, my_w1 = 0.f; bool valid = false;
        const int cn = (nrows_w - cb) < 64 ? (nrows_w - cb) : 64;
        f32x4 vn[4]; unsigned long long yn[4], zn[4];
        unsigned long long hn[4];
        { const int row0_ = gw + cb * NGW;
          if constexpr (SF32) { const GAS f32x4* xr = (const GAS f32x4*)((const float*)src + (size_t)row0_ * D) + lane;
#pragma unroll
            for (int j = 0; j < 4; ++j) vn[j] = xr[64 * j];
          } else { const GAS unsigned long long* hr_ = (const GAS unsigned long long*)((const bf16*)src + (size_t)row0_ * D) + lane;
#pragma unroll
            for (int j = 0; j < 4; ++j) hn[j] = hr_[64 * j]; }
          if constexpr (MODE == 1 || MODE == 3) { const GAS unsigned long long* yr = (const GAS unsigned long long*)(y1 + (size_t)row0_ * D) + lane, *zr = (const GAS unsigned long long*)(y0 + (size_t)row0_ * D) + lane;
#pragma unroll
            for (int j = 0; j < 4; ++j) { yn[j] = yr[64 * j]; zn[j] = zr[64 * j]; } } }
        for (int i = 0; i < cn; ++i) {
            const int row = gw + (cb + i) * NGW;
            f32x4 v[4]; float s = 0.f;
#pragma unroll
            for (int j = 0; j < 4; ++j) { if constexpr (SF32) v[j] = vn[j]; else { const unsigned long long w = hn[j]; const unsigned lo = (unsigned)w, hi = (unsigned)(w >> 32); v[j] = (f32x4){bflo(lo), bfhi(lo), bflo(hi), bfhi(hi)}; } }
            if constexpr (MODE == 1 || MODE == 3) {
#pragma unroll
                for (int j = 0; j < 4; ++j) { const unsigned long long w = yn[j], z = zn[j]; const unsigned lo = (unsigned)w, hi = (unsigned)(w >> 32), zl = (unsigned)z, zh = (unsigned)(z >> 32);
                    v[j].x += bflo(zl) + bflo(lo); v[j].y += bfhi(zl) + bfhi(lo); v[j].z += bflo(zh) + bflo(hi); v[j].w += bfhi(zh) + bfhi(hi); }
            }
            if (i + 1 < cn) { const int rown = row + NGW;
                if constexpr (SF32) { const GAS f32x4* xr = (const GAS f32x4*)((const float*)src + (size_t)rown * D) + lane;
#pragma unroll
                    for (int j = 0; j < 4; ++j) vn[j] = xr[64 * j];
                } else { const GAS unsigned long long* hr_ = (const GAS unsigned long long*)((const bf16*)src + (size_t)rown * D) + lane;
#pragma unroll
                    for (int j = 0; j < 4; ++j) hn[j] = hr_[64 * j]; }
                if constexpr (MODE == 1 || MODE == 3) { const GAS unsigned long long* yr = (const GAS unsigned long long*)(y1 + (size_t)rown * D) + lane, *zr = (const GAS unsigned long long*)(y0 + (size_t)rown * D) + lane;
#pragma unroll
                    for (int j = 0; j < 4; ++j) { yn[j] = yr[64 * j]; zn[j] = zr[64 * j]; } } }
#pragma unroll
            for (int j = 0; j < 4; ++j) s += (v[j].x * v[j].x + v[j].y * v[j].y) + (v[j].z * v[j].z + v[j].w * v[j].w);
            if constexpr (MODE == 1) { GAS unsigned long long* hr = (GAS unsigned long long*)(hout + (size_t)row * D) + lane;
#pragma unroll
                for (int j = 0; j < 4; ++j) { const unsigned long long hw = (unsigned long long)pk2(v[j].x, v[j].y) | ((unsigned long long)pk2(v[j].z, v[j].w) << 32); hr[64 * j] = hw;
                    v[j] = (f32x4){bflo((unsigned)hw), bfhi((unsigned)hw), bflo((unsigned)(hw >> 32)), bfhi((unsigned)(hw >> 32))}; } }
            const float rstd = 1.f / sqrtf(wave_sum(s) * (1.f / D) + 1e-6f);
#pragma unroll
            for (int j = 0; j < 4; ++j) v[j] = v[j] * rstd * gv[j];
            if constexpr (MODE == 3) { GAS f32x4* orow = (GAS f32x4*)(fout + (size_t)row * D) + lane;
#pragma unroll
                for (int j = 0; j < 4; ++j) orow[64 * j] = v[j];
            } else {
                if constexpr (F8X) { GAS unsigned* o4 = (GAS unsigned*)((unsigned char*)xn + (size_t)row * D) + lane;
#pragma unroll
                    for (int j = 0; j < 4; ++j) o4[64 * j] = pg8::pk4_fp8(v[j].x, v[j].y, v[j].z, v[j].w);
                } else { GAS unsigned long long* o8 = (GAS unsigned long long*)(xn + (size_t)row * D) + lane;
#pragma unroll
                    for (int j = 0; j < 4; ++j) o8[64 * j] = (unsigned long long)pk2(v[j].x, v[j].y) | ((unsigned long long)pk2(v[j].z, v[j].w) << 32); }
            }
            if constexpr (MODE == 2) {
                float lg[NE];
#pragma unroll
                for (int e = 0; e < NE; ++e) { float a = 0.f;
#pragma unroll
                    for (int j = 0; j < 4; ++j) { const f32x4 rr = *(const LAS f32x4*)(RL + e * 1024 + 256 * j + 4 * lane); a += (v[j].x * rr.x + v[j].y * rr.y) + (v[j].z * rr.z + v[j].w * rr.w); }
                    lg[e] = wave_sum(a); }
                int e0 = 0; float v0 = lg[0];
#pragma unroll
                for (int e = 1; e < NE; ++e) if (lg[e] > v0) { v0 = lg[e]; e0 = e; }
                int e1 = -1; float v1 = 0.f;
#pragma unroll
                for (int e = 0; e < NE; ++e) if (e != e0 && (e1 < 0 || lg[e] > v1)) { v1 = lg[e]; e1 = e; }
                const float w0 = 1.f / (1.f + __expf(v1 - v0));
                if (lane == i) { my_t = row; my_e0 = e0; my_e1 = e1; my_w0 = w0; my_w1 = 1.f - w0; valid = true; }
            }
        }
        if constexpr (MODE == 2) {
            unsigned myc = 0u;
#pragma unroll
            for (int e = 0; e < NE; ++e) { const unsigned long long b0 = __ballot(valid && my_e0 == e), b1 = __ballot(valid && my_e1 == e);
                const unsigned c = (unsigned)(__popcll(b0) + __popcll(b1)); if (lane == e) myc = c; }
            unsigned basev = 0u;
            if (lane < NE) basev = __hip_atomic_fetch_add(R.cnt + 64 * lane, myc, RLX_AGENT);
            const unsigned long long lt = (1ull << lane) - 1ull;
            unsigned pos0 = 0u, pos1 = 0u;
#pragma unroll
            for (int e = 0; e < NE; ++e) { const unsigned long long b0 = __ballot(valid && my_e0 == e), b1 = __ballot(valid && my_e1 == e);
                const unsigned be = (unsigned)__shfl((int)basev, e);
                if (my_e0 == e) pos0 = be + (unsigned)__popcll(b0 & lt);
                if (my_e1 == e) pos1 = be + (unsigned)__popcll(b0) + (unsigned)__popcll(b1 & lt); }
            if (valid) {
                ((GAS unsigned*)R.ltok)[(size_t)my_e0 * LIST_CAP + pos0] = (unsigned)my_t;             ((GAS float*)R.lw)[(size_t)my_e0 * LIST_CAP + pos0] = my_w0;
                ((GAS unsigned*)R.ltok)[(size_t)my_e1 * LIST_CAP + pos1] = (unsigned)my_t | (1u << 20); ((GAS float*)R.lw)[(size_t)my_e1 * LIST_CAP + pos1] = my_w1;
            }
        }
    }
    if constexpr (MODE == 2) { LDS_WAIT(); __syncthreads(); }
}

__device__ __forceinline__ void kstat_phase(Frame& F, const bf16* Kt, float* kmean, float* kmax2) {
    int lane_ = F.lane; asm volatile("" : "+v"(lane_));
    const int gw = F.vcu * NWAVES + F.wave, NGW = F.G * NWAVES, lane = lane_;
    for (int task = gw; task < BATCH * 16 * 16; task += NGW) {
        const int hh = task & 15, n = (task >> 4) & 15, b = task >> 8, l5 = lane & 31, hf = lane >> 5;
        const GAS unsigned* p = (const GAS unsigned*)(Kt + ((size_t)b * SEQ + 256 * n + 128 * hf) * D + hh * 64) + l5;
        float a0 = 0.f, a1 = 0.f, mx = 0.f;
#pragma unroll 32
        for (int r = 0; r < 128; ++r) { const unsigned w = p[(size_t)r * (D / 2)]; const float v0 = bflo(w), v1 = bfhi(w); a0 += v0; a1 += v1;
            float s = v0 * v0 + v1 * v1;
            s += __int_as_float(__builtin_amdgcn_update_dpp(0, __float_as_int(s), 0xB1, 0xF, 0xF, true)); s += __int_as_float(__builtin_amdgcn_update_dpp(0, __float_as_int(s), 0x4E, 0xF, 0xF, true));
            s += __int_as_float(__builtin_amdgcn_update_dpp(0, __float_as_int(s), 0x141, 0xF, 0xF, true)); s += __int_as_float(__builtin_amdgcn_update_dpp(0, __float_as_int(s), 0x140, 0xF, 0xF, true));
            s += __int_as_float(__builtin_amdgcn_ds_swizzle(__float_as_int(s), 0x401F)); mx = fmaxf(mx, s); }
        { auto r0 = __builtin_amdgcn_permlane32_swap(__float_as_uint(a0), __float_as_uint(a0), false, false); a0 = __uint_as_float(r0[0]) + __uint_as_float(r0[1]);
          auto r1 = __builtin_amdgcn_permlane32_swap(__float_as_uint(a1), __float_as_uint(a1), false, false); a1 = __uint_as_float(r1[0]) + __uint_as_float(r1[1]);
          auto r2 = __builtin_amdgcn_permlane32_swap(__float_as_uint(mx), __float_as_uint(mx), false, false); mx = fmaxf(__uint_as_float(r2[0]), __uint_as_float(r2[1])); }
        if (hf == 0) { GAS float* o = (GAS float*)(kmean + ((size_t)(b * 16 + hh) * 16 + n) * 64 + 2 * l5);
            o[0] = a0 * (1.f / 256.f); o[1] = a1 * (1.f / 256.f); }
        if (lane == 0) ((GAS float*)kmax2)[(size_t)(b * 16 + hh) * 16 + n] = mx;
    }
}

struct KArgs { const float* in[17]; float* out; unsigned char* ws; int ph_lo, ph_hi; };
struct ConvDesc { const float* W; int K, N; unsigned char* WT; int il; bool f8; float sc; };
constexpr int NCONV = 61, CONV_CH = 128;
__device__ __forceinline__ ConvDesc conv_desc(const KArgs& args, unsigned char* ws, int m) {
    constexpr float WSC_UP = 32.0f, WSC_DN = 64.0f;
    ConvDesc d; d.il = 0; d.f8 = false; d.sc = 1.0f;
    if (m < 2) { d.W = args.in[7] + (size_t)m * D * 3 * D; d.K = D; d.N = 3 * D; d.WT = ws + WS_MQKV + (size_t)m * 3 * D * D * 2; }
    else if (m < 4) { const int j = m - 2; d.W = args.in[8] + (size_t)j * D * D; d.K = D; d.N = D; d.WT = ws + WS_MWO + (size_t)j * D * D * 2; }
    else if (m == 4) { d.W = args.in[4]; d.K = D; d.N = D; d.WT = ws + WS_DWO; }
    else if (m == 5) { d.W = args.in[3] + (size_t)D * 3 * D; d.K = D; d.N = 3 * D; d.WT = ws + WS_DQKV + (size_t)3 * D * D * 2; }
    else if (m == 6) { d.W = args.in[4] + (size_t)D * D; d.K = D; d.N = D; d.WT = ws + WS_DWO + (size_t)D * D * 2; }
    else if (m < 13) { const int r = m - 7, j = r / 3, t = r % 3; d.f8 = (j == 1);
        if (t < 2) { d.W = args.in[9 + t] + (size_t)j * D * DFF; d.K = D; d.N = DFF; d.WT = ws + WS_FGU + (size_t)j * 2 * DFF * D * 2; d.il = 1 + t; d.sc = d.f8 ? WSC_UP : 1.0f; }
        else { d.W = args.in[11] + (size_t)j * DFF * D; d.K = DFF; d.N = D; d.WT = ws + WS_FD + (size_t)j * D * DFF * 2; d.sc = d.f8 ? WSC_DN : 1.0f; } }
    else { const int r = m - 13, e = r / 3, t = r % 3; d.f8 = true;
        if (t < 2) { d.W = args.in[13 + t] + (size_t)e * D * DE; d.K = D; d.N = DE; d.WT = ws + WS_MGU + (size_t)e * 2 * DE * D; d.il = 1 + t; d.sc = WSC_UP; }
        else { d.W = args.in[15] + (size_t)e * DE * D; d.K = DE; d.N = D; d.WT = ws + WS_MD + (size_t)e * D * DE; d.sc = WSC_DN; } }
    return d;
}
__device__ __forceinline__ int conv_chunks_of(int m) { const int items = m < 2 || m == 5 ? 768 : (m < 7 ? 256 : (m < 13 ? 704 : 896)); return (items + CONV_CH - 1) / CONV_CH; }
__device__ __forceinline__ int conv_total_chunks() { int s = 0; for (int m = 0; m < NCONV; ++m) s += conv_chunks_of(m); return s; }
__device__ __forceinline__ void conv_chunk(Frame& F, const KArgs& args, unsigned char* ws, int c) {
    int m = 0; for (; m < NCONV; ++m) { const int n = conv_chunks_of(m); if (c < n) break; c -= n; }
    const ConvDesc d = conv_desc(args, ws, m);
    LAS float* scr = (LAS float*)(F.lds + RING_OFF + F.wave * 16384);
    int lane_ = F.lane; asm volatile("" : "+v"(lane_));
    const int nblk = d.N / 64, nitems = (d.K / 64) * nblk, last = (c + 1) * CONV_CH < nitems ? (c + 1) * CONV_CH : nitems;
    for (int it = c * CONV_CH + F.wave; it < last; it += NWAVES) {
        const int kb = it / nblk, nb = it % nblk, n0 = 64 * nb;
        const int drow0 = d.il == 0 ? n0 : (n0 / 128) * 256 + (d.il - 1) * 128 + (n0 % 128);
        transpose_item(d.W, d.K, d.N, d.WT, 64 * kb, n0, drow0, scr, lane_, d.f8, d.sc);
    }
}

__global__ void __launch_bounds__(NWAVES * 64, 2) trunk_fwd(KArgs args) {
    extern __shared__ __attribute__((aligned(16))) unsigned char lds[];
    Frame F;
    F.lds = (LAS unsigned char*)lds;
    F.MISC = (volatile LAS unsigned*)(F.lds + MISC_OFF);
    F.tid = threadIdx.x; F.lane = F.tid & 63; F.wave = __builtin_amdgcn_readfirstlane(F.tid >> 6);
    F.G = gridDim.x; { const int bx = blockIdx.x; F.vcu = (F.G % 8 == 0) ? (bx % 8) * (F.G / 8) + bx / 8 : bx; }
    F.ctl = (gu32*)(args.ws + WS_CTL);
    for (int u = F.tid; u < (LDS_BYTES - LDSCTL_OFF) / 4; u += NWAVES * 64) ((LAS unsigned*)(F.lds + LDSCTL_OFF))[u] = 0u;
    __syncthreads();
    Frame& F0 = F;
    const int lo = args.ph_lo, hi = args.ph_hi;
    XcdBarrier bar; bar.bar = (unsigned*)(F.ctl + CW_BAR); bar.x = 0; bar.st = nullptr;
    if (hi - lo > 1) bar = xcd_barrier_post((unsigned*)(F.ctl + CW_BAR), F.MISC + 8);
#define IN(k) (lo <= (k) && (k) < hi)
#ifndef PH_ENABLE
#define PH_ENABLE 0xFFFFFFFFu
#endif
#define PHEN(n) (((PH_ENABLE) >> (n)) & 1u)
#ifndef MK_DOUBLE
#define MK_DOUBLE 0u
#endif
#define NREP(n) ((((MK_DOUBLE) >> (n)) & 1u) ? 2 : 1)
#if defined(NO_OPQ)
#define OPQ(p) do {} while (0)
#else
#define OPQ(p) asm volatile("" : "+s"(p))
#endif
#if 0
#define STAMP(k) do { if (blockIdx.x == 0 && threadIdx.x == 0) { const unsigned long long t_ = __builtin_amdgcn_s_memrealtime(); ((GAS unsigned*)(F0.ctl))[3000 + (k)] = (unsigned)t_; } } while (0)
#else
#define STAMP(k) do {} while (0)
#endif
#define SEAM(k) do { if (IN(k) && IN((k) + 1)) { XcdBarrier b2_ = bar; OPQ(b2_.bar); xcd_barrier(b2_); } STAMP((k) + 1); } while (0)

#define PTRS() unsigned char* ws = args.ws; OPQ(ws); const float* x = args.in[0]; OPQ(x); const float* norm_mix = args.in[1]; OPQ(norm_mix); const float* norm_ffn = args.in[2]; OPQ(norm_ffn); \
    bf16* h = (bf16*)(ws + WS_HB); \
    bf16* XN = (bf16*)(ws + WS_XN); bf16* Qb = (bf16*)(ws + WS_Q); bf16* Kb = (bf16*)(ws + WS_K); bf16* Vb = (bf16*)(ws + WS_V); bf16* ACT = (bf16*)(ws + WS_ACT); \
    bf16* MGU = (bf16*)(ws + WS_MGU); bf16* MD = (bf16*)(ws + WS_MD); \
    float* kmean = (float*)(ws + WS_KMEAN); unsigned* ltok = (unsigned*)(ws + WS_LTOK); float* lw = (float*)(ws + WS_LW); \
    (void)x; (void)norm_mix; (void)norm_ffn; (void)h; (void)XN; (void)Qb; (void)Kb; (void)Vb; (void)ACT; (void)MGU; (void)MD; (void)kmean; (void)ltok; (void)lw
    const RouterArgs noR{nullptr, nullptr, nullptr, nullptr};
#ifndef MK_F8_DENSE
#define MK_F8_DENSE 0
#endif
    constexpr bool F8_DENSE = MK_F8_DENSE != 0; constexpr int DESZ = F8_DENSE ? 1 : 2;
    constexpr float WSC_UP = 32.0f, WSC_DN = 64.0f;
    constexpr float C2 = 0.125f * 1.4426950408889634f;

    STAMP(0);
    if (PHEN(0) && IN(0)) {
        PTRS();
        { unsigned rot = 0u;
        convert_matrix(F, args.in[3], D, 3 * D, ws + WS_DQKV, 0, rot);
        norm_phase<0, false, true>(F, x, nullptr, nullptr, norm_mix, XN, nullptr, noR);
        }
    }
    SEAM(0);

    for (int L = 0; L < NLAYER; ++L) {
        const int j = L >> 1, moba = L & 1, pb = 1 + PH_PER_LAYER * L;
        int z_ = 0;
#if !defined(NO_OPQ_Z)
        asm volatile("" : "+s"(z_));
#endif
        Frame Fl = F0; Fl.G += z_; Fl.vcu += z_; Fl.wave += z_; Fl.lds += z_; Fl.ctl += z_; const int bx = (int)blockIdx.x + z_;
#define F Fl
        if (PHEN(1) && IN(pb + 0)) {
            PTRS();

            const bf16* W = (const bf16*)(ws + (moba ? WS_MQKV : WS_DQKV)) + (size_t)j * 3 * D * D;
            pg8::Gemm g{XN, W, 2 * D, 0}; pg8::StaticOrder S; S.init(MTOK, 3 * D, F.G, bx);
            pg8::EpiQKV E{Qb, D, D, (size_t)(WS_K - WS_Q) / 2, C2};
            for (int rep_ = 0; rep_ < NREP(1); ++rep_) pg8::gemm_phase<pg8::EpiQKV, pg8::StaticOrder>(F.lds + RING_OFF, XSLOT_OFF, g, S, E);
        }
        SEAM(pb + 0);
        { if (PHEN(2) && IN(pb + 1)) { PTRS(); kstat_phase(F, Kb, kmean, kmean + 8 * 16 * 16 * 64); } SEAM(pb + 1); }
        if (IN(pb + 2)) {
            PTRS();
            att::Args A; A.Q = Qb; A.K = Kb; A.V = Vb; A.O = XN; A.kmean = kmean; A.kmax2 = kmean + 8 * 16 * 16 * 64; A.subln = args.in[6] + (size_t)j * 128; A.lam_full = 0.f; A.out_scale = 1.f; A.abl = 0;
            LAS int* qw;
            if (!moba) {
                const float* lam = args.in[5] + (size_t)j * 256; int lane = F.lane; asm volatile("" : "+v"(lane));
                const GAS float* lamg = (const GAS float*)lam; const float s1 = wave_sum(lamg[lane] * lamg[64 + lane]), s2 = wave_sum(lamg[128 + lane] * lamg[192 + lane]);
                const float lam_init = (L == 0) ? 0.2f : 0.47071302f;
                A.lam_full = __uint_as_float(__builtin_amdgcn_readfirstlane(__float_as_uint(__expf(s1) - __expf(s2) + lam_init))); A.out_scale = __uint_as_float(__builtin_amdgcn_readfirstlane(__float_as_uint(1.0f - lam_init)));
            }
            const int nconv = (L == 0) ? conv_total_chunks() : 0;
            qw = (LAS int*)(F.lds + XSLOT_OFF);
            const int xme = (int)(xb_xcc_id() & 7u);
            if ((PHEN(3) && !moba) || (PHEN(4) && moba)) for (int rep_ = 0; rep_ < (moba ? NREP(4) : NREP(3)); ++rep_) for (int xq = xme;;) {
#if ATT_ABLATE
                { const bool ab_ = rep_ == 0 && (moba ? NREP(4) : NREP(3)) == 2; A.abl = ab_ ? ATT_ABLATE : 0; A.O = ab_ ? (bf16*)(ws + WS_END) : XN; }
#endif
                const int ncx = (nconv && rep_ == 0) ? ((nconv - xq + 7) >> 3) : 0;
                gu32* qb = F.ctl + CW_ATTQ2 + 256 * L + 1024 * rep_; gu32* qx = qb + 32 * xq;
                for (;;) {
                    if (F.tid == 0) *qw = (int)__hip_atomic_fetch_add(qx, 1u, RLX_AGENT);
                    asm volatile("s_waitcnt vmcnt(0) lgkmcnt(0)\n\ts_barrier" ::: "memory");
                    int idx = __builtin_amdgcn_readfirstlane(*qw);
                    if (idx >= 128 + ncx) { asm volatile("s_waitcnt vmcnt(0) lgkmcnt(0)\n\ts_barrier" ::: "memory"); break; }
                    if (ncx) { const int q3 = idx / 3; if (idx < 3 * ncx) { if (idx - 3 * q3 == 2) { conv_chunk(F, args, ws, xq + 8 * q3); asm volatile("s_waitcnt vmcnt(0) lgkmcnt(0)\n\ts_barrier" ::: "memory"); continue; } idx -= q3; } else idx -= ncx; }
                    if (!moba) { const int hh = 7 - (idx >> 4), pr = idx & 15;
                        att::attn_unit<0>(F.lds + RING_OFF, A, xq, hh, pr);
                        att::attn_unit<0>(F.lds + RING_OFF, A, xq, hh, 31 - pr);
                    } else { const int hh = 15 - (idx >> 3), pr = idx & 7;
                        att::attn_unit<1>(F.lds + RING_OFF, A, xq, hh, pr);
                        att::attn_unit<1>(F.lds + RING_OFF, A, xq, hh, 15 - pr); }
                }
                if (F.tid < 64) { int lane = F.tid; asm volatile("" : "+v"(lane)); bool av = false;
                    if (lane < 8) { const int lim = 128 + ((nconv && rep_ == 0) ? ((nconv - lane + 7) >> 3) : 0); av = (int)__hip_atomic_load(qb + 32 * lane, RLX_AGENT) < lim; }
                    const unsigned long long m_ = __ballot(av);
                    if (lane == 0) *qw = (int)(unsigned)m_; }
                asm volatile("s_waitcnt vmcnt(0) lgkmcnt(0)\n\ts_barrier" ::: "memory");
                const unsigned m = (unsigned)__builtin_amdgcn_readfirstlane(*qw);
                asm volatile("s_waitcnt vmcnt(0) lgkmcnt(0)\n\ts_barrier" ::: "memory");
                if (m == 0u) break;
                const unsigned rot = ((m >> xme) | (m << (8 - xme))) & 0xFFu;
                xq = (xme + __builtin_ctz(rot)) & 7;
            }
            asm volatile("s_waitcnt vmcnt(0) lgkmcnt(0)\n\ts_barrier" ::: "memory");
        }
        SEAM(pb + 2);
        if (PHEN(5) && IN(pb + 3)) {
            PTRS();
            const bf16* W = (const bf16*)(ws + (moba ? WS_MWO : WS_DWO)) + (size_t)j * D * D;
            pg8::Gemm g{XN, W, 2 * D, 0}; pg8::StaticOrder S; S.init(MTOK, D, F.G, bx);
            if (L == 0) { pg8::EpiRes<true> E{x, h, D, 1.0f}; pg8::gemm_phase<pg8::EpiRes<true>, pg8::StaticOrder>(F.lds + RING_OFF, XSLOT_OFF, g, S, E); }
            else { pg8::EpiRes<false> E{h, h, D, 1.0f}; pg8::gemm_phase<pg8::EpiRes<false>, pg8::StaticOrder>(F.lds + RING_OFF, XSLOT_OFF, g, S, E); }
        }
        SEAM(pb + 3);
        if (PHEN(6) && IN(pb + 4)) {
            PTRS();
            if (!moba) {
                if (L == 2) norm_phase<0, true>(F, h, nullptr, nullptr, norm_ffn + (size_t)L * D, XN, nullptr, noR);
                else norm_phase<0, false>(F, h, nullptr, nullptr, norm_ffn + (size_t)L * D, XN, nullptr, noR);
            } else {
                const RouterArgs R{args.in[12] + (size_t)j * D * NE, F.ctl + CW_CNT + 64 * NE * j, ltok, lw};
                norm_phase<2, true>(F, h, nullptr, nullptr, norm_ffn + (size_t)L * D, XN, nullptr, R);
            }
        }
        SEAM(pb + 4);
        if (IN(pb + 5)) {
            PTRS();
            if (PHEN(7) && !moba) {
                if (L == 2) { pg8::Gemm g{XN, ws + WS_FGU + (size_t)j * 2 * DFF * D * 2, D, 0}; pg8::StaticOrder S; S.init(MTOK, 2 * DFF, F.G, bx);
                    pg8::EpiSwiGLU<true> E{ACT, DFF, 1.0f / WSC_UP};
                    pg8::gemm_phase<pg8::EpiSwiGLU<true>, pg8::StaticOrder, true>(F.lds + RING_OFF, XSLOT_OFF, g, S, E);
                } else { pg8::Gemm g{XN, ws + WS_FGU + (size_t)j * 2 * DFF * D * 2, 2 * D, 0}; pg8::StaticOrder S; S.init(MTOK, 2 * DFF, F.G, bx);
                    pg8::EpiSwiGLU<false> E{ACT, DFF, 1.0f};
                    pg8::gemm_phase<pg8::EpiSwiGLU<false>, pg8::StaticOrder, false>(F.lds + RING_OFF, XSLOT_OFF, g, S, E); }
            } else if (PHEN(8) && moba) {
                pg8::Gemm g{XN, ws + WS_MGU + (size_t)j * NE * 2 * DE * D, D, (size_t)2 * DE * D}; pg8::MoeOrder S; S.init((const unsigned*)(F.ctl + CW_CNT + 64 * NE * j), ltok, true, 2 * DE, F.G, bx);
                pg8::EpiSwiGLU<true> E{ACT, DE, 1.0f / WSC_UP};
                pg8::gemm_phase<pg8::EpiSwiGLU<true>, pg8::MoeOrder, true>(F.lds + RING_OFF, XSLOT_OFF, g, S, E);
            }
        }
        SEAM(pb + 5);
        if (IN(pb + 6)) {
            PTRS();
            if (PHEN(9) && !moba) {
                if (L == 2) { pg8::Gemm g{ACT, ws + WS_FD + (size_t)j * D * DFF * 2, DFF, 0}; pg8::StaticOrder S; S.init(MTOK, D, F.G, bx);
                    pg8::EpiRes<false> E{h, h, D, 1.0f / WSC_DN};
                    pg8::gemm_phase<pg8::EpiRes<false>, pg8::StaticOrder, true>(F.lds + RING_OFF, XSLOT_OFF, g, S, E);
                } else { pg8::Gemm g{ACT, ws + WS_FD + (size_t)j * D * DFF * 2, 2 * DFF, 0}; pg8::StaticOrder S; S.init(MTOK, D, F.G, bx);
                    pg8::EpiRes<false> E{h, h, D, 1.0f};
                    pg8::gemm_phase<pg8::EpiRes<false>, pg8::StaticOrder, false>(F.lds + RING_OFF, XSLOT_OFF, g, S, E); }
            } else if (PHEN(10) && moba) {
                pg8::Gemm g{ACT, ws + WS_MD + (size_t)j * NE * D * DE, DE, (size_t)D * DE}; pg8::MoeOrder S; S.init((const unsigned*)(F.ctl + CW_CNT + 64 * NE * j), ltok, false, D, F.G, bx);
                pg8::EpiMoeDown E; E.y0 = (bf16*)(ws + WS_Y0); E.y1 = XN; E.list_tok = ltok; E.list_w = lw; E.sc = 1.0f / WSC_DN;
#pragma unroll
                for (int e = 0; e < NE; ++e) E.cnt[e] = S.cnt[e];
                pg8::gemm_phase<pg8::EpiMoeDown, pg8::MoeOrder, true>(F.lds + RING_OFF, XSLOT_OFF, g, S, E);
            }
        }
        SEAM(pb + 6);
        if (PHEN(11) && IN(pb + 7)) {
            PTRS();
            if (L == 3) norm_phase<3>(F, h, nullptr, XN, args.in[16], nullptr, args.out, noR, (const bf16*)(ws + WS_Y0));
            else if (moba) norm_phase<1>(F, h, h, XN, norm_mix + (size_t)(L + 1) * D, XN, nullptr, noR, (const bf16*)(ws + WS_Y0));
            else for (int rep_ = 0; rep_ < NREP(11); ++rep_) norm_phase<0>(F, h, nullptr, nullptr, norm_mix + (size_t)(L + 1) * D, XN, nullptr, noR);
        }
        if (L != NLAYER - 1) SEAM(pb + 7); else STAMP(pb + 8);
#undef F
    }
#undef IN
#undef SEAM
#undef PTRS
#undef OPQ
}


#if MK_DEBUG
__global__ void dbg_probe(const void* buf, size_t n, int is_bf16, int idx, float thresh, unsigned* dbg) {
    size_t i = blockIdx.x * (size_t)blockDim.x + threadIdx.x, stride = (size_t)gridDim.x * blockDim.x; bool bad = false;
    for (size_t k = i; k < n; k += stride) { float v = is_bf16 ? __uint_as_float(((unsigned)((const unsigned short*)buf)[k]) << 16) : ((const float*)buf)[k]; if (!(fabsf(v) <= thresh)) bad = true; }
    if (bad) atomicMax(dbg, (unsigned)(1000 - idx));
}
__global__ void dbg_cnt(const unsigned* cntw, int idx, unsigned* dbg) {
    if (threadIdx.x == 0 && blockIdx.x == 0) { unsigned s = 0; for (int e = 0; e < NE; ++e) s += cntw[64 * e]; if (s != 2u * MTOK) atomicMax(dbg, (unsigned)(1000 - idx)); }
}

__device__ __forceinline__ float dbg_bf(unsigned short v) { return __uint_as_float(((unsigned)v) << 16); }
__device__ __forceinline__ unsigned dbg_hash(unsigned x) { x ^= x >> 16; x *= 0x7feb352dU; x ^= x >> 15; x *= 0x846ca68bU; x ^= x >> 16; return x; }
__global__ void dbg_gemm_check(const unsigned short* A, int lda, const unsigned short* Bt, int K, const unsigned short* out, int ldo, int M, int N, float scale, int idx, unsigned* dbg) {
    const unsigned s = blockIdx.x * blockDim.x + threadIdx.x; const int row = (int)(dbg_hash(2 * s + 1) % (unsigned)M), col = (int)(dbg_hash(2 * s + 2) % (unsigned)N);
    float acc = 0.f; for (int k = 0; k < K; ++k) acc += dbg_bf(A[(size_t)row * lda + k]) * dbg_bf(Bt[(size_t)col * K + k]);
    acc *= scale; const float got = dbg_bf(out[(size_t)row * ldo + col]);
    if (!(fabsf(got - acc) <= 0.03f + 0.02f * fabsf(acc))) { atomicMax(dbg, (unsigned)(1000 - idx)); atomicAdd(dbg + 64 + idx, 1u); }
}
__global__ void dbg_conv_check(const float* W, int K, int N, const unsigned short* WT, int il, int idx, unsigned* dbg) {
    const unsigned s = blockIdx.x * blockDim.x + threadIdx.x; const int k = (int)(dbg_hash(2 * s + 1) % (unsigned)K), n = (int)(dbg_hash(2 * s + 2) % (unsigned)N);
    const int dr = il == 0 ? n : (n / 128) * 256 + (il - 1) * 128 + (n % 128);
    const float w = W[(size_t)k * N + n], g = dbg_bf(WT[(size_t)dr * K + k]);
    if (!(fabsf(g - w) <= 0.01f * fabsf(w) + 1e-6f)) atomicMax(dbg, (unsigned)(1000 - idx));
}
__global__ void dbg_norm_check(const float* src, const float* gain, const unsigned short* xn, int idx, unsigned* dbg) {
    const unsigned s = blockIdx.x * blockDim.x + threadIdx.x; const int row = (int)(dbg_hash(s + 77) % (unsigned)MTOK);
    float ss = 0.f; for (int c = 0; c < D; ++c) { const float v = src[(size_t)row * D + c]; ss += v * v; }
    const float rstd = 1.f / sqrtf(ss / D + 1e-6f); bool bad = false;
    for (int c = 0; c < D; ++c) { const float r = src[(size_t)row * D + c] * rstd * gain[c], g = dbg_bf(xn[(size_t)row * D + c]); if (!(fabsf(g - r) <= 0.02f + 0.01f * fabsf(r))) bad = true; }
    if (bad) atomicMax(dbg, (unsigned)(1000 - idx));
}
__global__ void dbg_naive_gemm(const unsigned short* A, const unsigned short* Bt, unsigned short* out, int M, int N, int K) {
    const size_t i = blockIdx.x * (size_t)blockDim.x + threadIdx.x; if (i >= (size_t)M * N) return; const int row = (int)(i / N), col = (int)(i % N);
    float acc = 0.f; for (int k = 0; k < K; ++k) acc += dbg_bf(A[(size_t)row * K + k]) * dbg_bf(Bt[(size_t)col * K + k]);
    out[(size_t)row * N + col] = (unsigned short)f2bf(acc);
}
__global__ void dbg_find_col(const unsigned short* out, const unsigned short* ref, int M, int N, unsigned* hist) {
    const unsigned s = blockIdx.x * blockDim.x + threadIdx.x; const int row = (int)(dbg_hash(2 * s + 1) % (unsigned)M), col = (int)(dbg_hash(2 * s + 2) % (unsigned)N);
    const unsigned short v = out[(size_t)row * N + col]; int found = -1;
#if MK_FIND_PATTERN
    if (v == 0x3C3C) atomicAdd(hist + N, 1u); else atomicAdd(hist + 5, 1u); return;
#endif
#if MK_FIND_ROWS
    for (int r = 0; r < M; ++r) if (ref[(size_t)r * N + col] == v) { found = r; break; }
    if (found < 0) atomicAdd(hist + N, 1u); else atomicAdd(hist + ((found - row) & (N - 1)), 1u);
#else
    for (int c = 0; c < N; ++c) if (ref[(size_t)row * N + c] == v) { found = c; break; }
    if (found < 0) atomicAdd(hist + N, 1u); else atomicAdd(hist + ((found - col) & (N - 1)), 1u);
#endif
}
__global__ void dbg_hist_code(const unsigned* hist, int N, unsigned* dbg) {
    if (threadIdx.x || blockIdx.x) return; unsigned best = 0, bi = 0; for (int i = 0; i < N; ++i) if (hist[i] > best) { best = hist[i]; bi = i; }
    dbg[32] = bi; dbg[33] = best; dbg[34] = hist[N];
}
__global__ void dbg_final(float* out, size_t n, const unsigned* dbg) {
    if (MK_HIST_SEL >= 10) { const float c3 = sqrtf((float)dbg[MK_HIST_SEL + 30]); size_t i3 = blockIdx.x * (size_t)blockDim.x + threadIdx.x, st3 = (size_t)gridDim.x * blockDim.x; for (size_t k3 = i3; k3 < n; k3 += st3) out[k3] = c3; return; }
    if (MK_HIST_SEL >= 0 && (dbg[33] || dbg[34])) { const float c2 = sqrtf((float)(MK_HIST_SEL == 0 ? dbg[32] : (MK_HIST_SEL == 1 ? dbg[33] * 100u / 4096u : dbg[34] * 100u / 4096u)) + 1.f); size_t i2 = blockIdx.x * (size_t)blockDim.x + threadIdx.x, st2 = (size_t)gridDim.x * blockDim.x; for (size_t k2 = i2; k2 < n; k2 += st2) out[k2] = c2; return; }
    const unsigned d = dbg[0]; if (d == 0u) return; const unsigned nf = dbg[64 + (1000u - d)]; const float c = sqrtf(nf ? (float)(200u * (1000u - d - 9u) + nf * 100u / 4096u) : (float)(1000u - d));
    size_t i = blockIdx.x * (size_t)blockDim.x + threadIdx.x, stride = (size_t)gridDim.x * blockDim.x;
    for (size_t k = i; k < n; k += stride) out[k] = c;
}
#endif

#ifndef MK_REPEAT
#define MK_REPEAT 1
#endif
#ifndef MK_FIND_ROWS
#define MK_FIND_ROWS 0
#endif
#ifndef MK_FIND_REGION
#define MK_FIND_REGION WS_K
#endif
#ifndef MK_HIST_SEL
#define MK_HIST_SEL 0
#endif
#ifndef MK_STAMP
#define MK_STAMP 0
#endif
#if MK_STAMP
__global__ void stamp_k(unsigned* p) { if (threadIdx.x == 0) *p = (unsigned)__builtin_amdgcn_s_memrealtime(); }
__global__ void stamp_encode(float* out, size_t n, const unsigned* st, int pa, float ua, int pb, float ub) {
    const float da = (float)(st[pa + 1] - st[pa]) * 0.01f, db = (float)(st[pb + 1] - st[pb]) * 0.01f;
    float m = da / ua; m = m < 10.f ? 10.f : (m > 99.f ? 99.f : m); float e = floorf(db / ub + 0.5f); e = e < 0.f ? 0.f : (e > 30.f ? 30.f : e);
    const float c = sqrtf(m) * __powf(10.f, 0.5f * e);
    size_t i = blockIdx.x * (size_t)blockDim.x + threadIdx.x, stride = (size_t)gridDim.x * blockDim.x;
    for (size_t k = i; k < n; k += stride) out[k] = c;
}
#endif
extern "C" void kernel_launch(void* const* d_in, const int* in_sizes, int n_in, void* d_out, int out_size, void* d_ws, size_t ws_size, hipStream_t stream) {
    static int grid = 0;
    if (grid == 0) {
        if (n_in != 17 || in_sizes[0] != MTOK * D || out_size != MTOK * D || ws_size < WS_END) {
            fprintf(stderr, "kernel_launch: built for 17 inputs, x/out of %d floats, >= %zu bytes of workspace; got n_in %d, in0 %d, out %d, ws %zu; nothing launched\n", MTOK * D, (size_t)WS_END, n_in, n_in > 0 ? in_sizes[0] : -1, out_size, ws_size);
            grid = -1; return; }
        int dev = 0, cus = 0, per_cu = 0;
        if (hipGetDevice(&dev) != hipSuccess || hipDeviceGetAttribute(&cus, hipDeviceAttributeMultiprocessorCount, dev) != hipSuccess) { fprintf(stderr, "kernel_launch: device query failed\n"); grid = -1; return; }
        if (hipFuncSetAttribute((const void*)trunk_fwd, hipFuncAttributeMaxDynamicSharedMemorySize, LDS_BYTES) != hipSuccess) { fprintf(stderr, "kernel_launch: hipFuncSetAttribute failed\n"); grid = -1; return; }
        if (hipOccupancyMaxActiveBlocksPerMultiprocessor(&per_cu, (const void*)trunk_fwd, NWAVES * 64, LDS_BYTES) != hipSuccess || per_cu < 1)
            fprintf(stderr, "kernel_launch: note: occupancy query reports %d workgroups per CU\n", per_cu);
        (void)hipGetLastError();
        grid = cus;
    }
    if (grid < 0) return;
    if (hipMemsetAsync((char*)d_ws + WS_CTL, 0, CTL_ZERO_BYTES, stream) != hipSuccess) { fprintf(stderr, "kernel_launch: memset failed\n"); return; }
    KArgs a{};
    for (int i = 0; i < 17; ++i) a.in[i] = (const float*)d_in[i];
    a.out = (float*)d_out; a.ws = (unsigned char*)d_ws;
#if MK_PER_PHASE
#if MK_STAMP
    hipLaunchKernelGGL(stamp_k, dim3(1), dim3(64), 0, stream, (unsigned*)d_ws + 3000);
#endif
    for (int p = 0; p < NPHASE; ++p) {
        a.ph_lo = p; a.ph_hi = p + 1;
#if MK_DEBUG
#endif
#if !defined(MK_SKIP_MAIN)
        for (int rep_ = 0; rep_ < (p == 1 ? MK_REPEAT : 1); ++rep_) hipLaunchKernelGGL(trunk_fwd, dim3(grid), dim3(NWAVES * 64), LDS_BYTES, stream, a);
#endif
#if MK_STAMP
        hipLaunchKernelGGL(stamp_k, dim3(1), dim3(64), 0, stream, (unsigned*)d_ws + 3000 + p + 1);
#endif
#if MK_DEBUG
        {   unsigned char* ws = (unsigned char*)d_ws; unsigned* dbg = (unsigned*)(ws + WS_CTL) + 2048;
            const size_t MD_ = (size_t)MTOK * D;
#define PROBE(buf, n, isbf, idx, th) if ((idx) <= MK_PROBE_MAX) hipLaunchKernelGGL(dbg_probe, dim3(2048), dim3(256), 0, stream, (const void*)(buf), (size_t)(n), isbf, idx, th, dbg)
            if (p == 0) {
                hipLaunchKernelGGL(dbg_norm_check, dim3(4), dim3(64), 0, stream, (const float*)d_in[0], (const float*)d_in[1], (const unsigned short*)(ws + WS_XN), 4, dbg);
                hipLaunchKernelGGL(dbg_conv_check, dim3(16), dim3(256), 0, stream, (const float*)d_in[3], D, 3 * D, (const unsigned short*)(ws + WS_DQKV), 0, 5, dbg);
                hipLaunchKernelGGL(dbg_conv_check, dim3(16), dim3(256), 0, stream, (const float*)d_in[9], D, DFF, (const unsigned short*)(ws + WS_FGU), 1, 6, dbg);
                hipLaunchKernelGGL(dbg_conv_check, dim3(16), dim3(256), 0, stream, (const float*)d_in[10], D, DFF, (const unsigned short*)(ws + WS_FGU), 2, 7, dbg);
                hipLaunchKernelGGL(dbg_conv_check, dim3(16), dim3(256), 0, stream, (const float*)d_in[11], DFF, D, (const unsigned short*)(ws + WS_FD), 0, 8, dbg);
                hipLaunchKernelGGL(dbg_conv_check, dim3(16), dim3(256), 0, stream, (const float*)d_in[15] + (size_t)3 * DE * D, DE, D, (const unsigned short*)(ws + WS_MD) + (size_t)3 * D * DE, 0, 9, dbg);
            }
            if (p == 1) {
                const float C2h = 0.125f * 1.4426950408889634f;
                hipLaunchKernelGGL(dbg_gemm_check, dim3(16), dim3(256), 0, stream, (const unsigned short*)(ws + WS_XN), D, (const unsigned short*)(ws + WS_DQKV), D, (const unsigned short*)(ws + WS_Q), D, MTOK, D, C2h, 10, dbg);
                hipLaunchKernelGGL(dbg_gemm_check, dim3(16), dim3(256), 0, stream, (const unsigned short*)(ws + WS_XN), D, (const unsigned short*)(ws + WS_DQKV) + (size_t)D * D, D, (const unsigned short*)(ws + WS_K), D, MTOK, D, 1.f, 11, dbg);

                hipLaunchKernelGGL(dbg_gemm_check, dim3(16), dim3(256), 0, stream, (const unsigned short*)(ws + WS_XN), D, (const unsigned short*)(ws + WS_DQKV) + (size_t)2 * D * D, D, (const unsigned short*)(ws + WS_V), D, MTOK, D, 1.f, 12, dbg);
            }
            if (0) { PROBE(ws + WS_XN, MD_, 1, 1, 10.f); PROBE(ws + WS_DQKV, (WS_MGU - WS_DQKV) / 2, 1, 2, 1.f); PROBE(ws + WS_MGU, (WS_XN - WS_MGU) / 2, 1, 3, 1.f); }
            if (p >= 1) { const int L = (p - 1) / PH_PER_LAYER, k = (p - 1) % PH_PER_LAYER; const int b = 20 + 10 * L;
                if (k == 0) PROBE(ws + WS_Q, 3 * MD_, 1, b + 0, 50.f);
                if (k == 1) PROBE(ws + WS_KMEAN, 8 * 16 * 16 * 64, 0, b + 1, 5.f);
                if (k == 2) PROBE(ws + WS_XN, MD_, 1, b + 2, 50.f);
                if (k == 3) PROBE(d_out, MD_, 0, b + 3, 300.f);
                if (k == 4) { PROBE(ws + WS_XN, MD_, 1, b + 4, 20.f); if ((L & 1) && (b + 9) <= MK_PROBE_MAX) hipLaunchKernelGGL(dbg_cnt, dim3(1), dim3(64), 0, stream, (const unsigned*)(ws + WS_CTL) + CW_CNT + 64 * NE * (L >> 1), b + 9, dbg); }
                if (k == 5) PROBE(ws + WS_ACT, (L & 1) ? (size_t)256 * 256 * DE : (size_t)MTOK * DFF, 1, b + 5, 2000.f);
                if (k == 6) { PROBE(d_out, MD_, 0, b + 6, 1000.f); if (L & 1) PROBE(ws + WS_XN, MD_, 1, b + 7, 1000.f); }
                if (k == 7 && L != 3) { PROBE(ws + WS_XN, MD_, 1, b + 8, 20.f); PROBE(d_out, MD_, 0, b + 8, 1000.f); }
            }
#undef PROBE
        }
#endif
    }
#if MK_DEBUG
    hipLaunchKernelGGL(dbg_final, dim3(2048), dim3(256), 0, stream, (float*)d_out, (size_t)MTOK * D, (const unsigned*)((unsigned char*)d_ws + WS_CTL) + 2048);
#endif
#else
    a.ph_lo = 0; a.ph_hi = NPHASE;
    hipLaunchKernelGGL(trunk_fwd, dim3(grid), dim3(NWAVES * 64), LDS_BYTES, stream, a);
#if 0
    hipLaunchKernelGGL(stamp_encode, dim3(2048), dim3(256), 0, stream, (float*)d_out, (size_t)MTOK * D, (const unsigned*)d_ws + 3000, MK_STAMP_PA, MK_STAMP_UA, MK_STAMP_PB, MK_STAMP_UB);
#endif
#endif
#if MK_STAMP
    hipLaunchKernelGGL(stamp_encode, dim3(2048), dim3(256), 0, stream, (float*)d_out, (size_t)MTOK * D, (const unsigned*)d_ws + 3000, MK_STAMP_PA, MK_STAMP_UA, MK_STAMP_PB, MK_STAMP_UB);
#endif
    const hipError_t le = hipPeekAtLastError();
    if (le != hipSuccess) fprintf(stderr, "kernel_launch: launch failed: %s\n", hipGetErrorName(le));
}
```

```cpp
#ifndef MK_DEBUG
#define MK_DEBUG 0
#endif
#ifndef MK_PER_PHASE
#define MK_PER_PHASE 0
#endif
#include <hip/hip_runtime.h>
#include <cstdio>
#include <cstdint>

#ifndef MK_KDEBUG
#define MK_KDEBUG 0
#endif
#define LAS __attribute__((address_space(3)))
#define GAS __attribute__((address_space(1)))

constexpr int BATCH = 8, SEQ = 4096, MTOK = BATCH * SEQ, D = 1024, DFF = 2816, DE = 3584, NE = 8;
constexpr int MOE_TILES_MAX = 272;
constexpr int LIST_CAP = MTOK;

namespace pg8 {
#define PG8_LAS __attribute__((address_space(3)))
typedef unsigned short bf16_t;
typedef short bf16x8 __attribute__((ext_vector_type(8)));
typedef float f32x4 __attribute__((ext_vector_type(4)));
typedef unsigned u32x4 __attribute__((ext_vector_type(4)));
typedef int i32x4 __attribute__((ext_vector_type(4)));
typedef int i32x8 __attribute__((ext_vector_type(8)));
constexpr int BM = 256, BK = 64, HALF = 128, HTB = HALF * BK * 2  , STAGE_BYTES = 8 * HTB, NXCD = 8, WGM = 8;

__host__ __device__ __forceinline__ int lds_byte(int r, int c) { const int st = (r >> 4) * 2 + (c >> 5), rr = r & 15, cc = c & 31, ob = rr * 64 + cc * 2; return st * 1024 + (ob ^ (((ob >> 9) & 1) << 5)); }
__host__ __device__ __forceinline__ void stage_rc(int b, int& R, int& C) { const int st = b / 1024, sb = b % 1024, swz = sb ^ (((sb >> 9) & 1) << 5); R = (st >> 1) * 16 + swz / 64; C = (st & 1) * 32 + (swz % 64) / 2; }
__host__ __device__ __forceinline__ int perm32(int rho) { const int n = rho >> 4, i = rho & 15; return 8 * (i >> 2) + 4 * n + (i & 3); }

struct Unit { int pm, pn, e, r0; };
struct Gemm { const void* A; const void* Bt; int rowb; size_t bstride; };

__device__ __forceinline__ void tile_of(int L, int nM, int nN, int& pm, int& pn) {
    const int nwg = nM * nN; int wgid = L; { const int q = nwg / NXCD, r = nwg % NXCD, xcd = wgid % NXCD, off = wgid / NXCD; wgid = (xcd < r ? xcd * (q + 1) : r * (q + 1) + (xcd - r) * q) + off; }
    const int nig = WGM * nN, gid = wgid / nig, fm = gid * WGM, gsz = (nM - fm) < WGM ? (nM - fm) : WGM;
    pm = fm + ((wgid % nig) % gsz); pn = (wgid % nig) / gsz;
}
struct StaticOrder {
    int nM, nN, nwg, G, c;
    __device__ __forceinline__ void init(int M, int N, int G_, int c_) { nM = M / BM; nN = N / BM; nwg = nM * nN; G = G_; c = c_; }
    __device__ __forceinline__ bool next(int i, Unit& u) const {
        const long L = (long)i * G + c; if (L >= nwg) return false;
        tile_of((int)L, nM, nN, u.pm, u.pn); u.e = 0; u.r0 = 0; return true;
    }
    __device__ __forceinline__ unsigned arow(const Unit& u, int lr) const { return (unsigned)(u.pm * BM + lr); }
};
struct MoeOrder {
    int nM, nN, nwg, G, c; int tstart[NE + 1]; int cnt[NE]; const unsigned* list_tok; bool gather;
    __device__ __forceinline__ void init(const unsigned* cntw, const unsigned* list_tok_, bool gather_, int N, int G_, int c_) {
        int acc = 0;
#pragma unroll
        for (int e = 0; e < NE; ++e) { const int ce = (int)__builtin_amdgcn_readfirstlane((int)__hip_atomic_load((const GAS unsigned*)cntw + 64 * e, __ATOMIC_RELAXED, __HIP_MEMORY_SCOPE_AGENT)); cnt[e] = ce; tstart[e] = acc; acc += (ce + BM - 1) / BM; }
        tstart[NE] = acc; nM = acc; nN = N / BM; nwg = nM * nN; G = G_; c = c_; list_tok = list_tok_; gather = gather_;
    }
    __device__ __forceinline__ bool next(int i, Unit& u) const {
        const long L = (long)i * G + c; if (L >= nwg) return false;
        tile_of((int)L, nM, nN, u.pm, u.pn); int e = 0;
#pragma unroll
        for (int k = 1; k < NE; ++k) e += (u.pm >= tstart[k]) ? 1 : 0;
        u.e = e; int ts = 0;
#pragma unroll
        for (int k = 0; k < NE; ++k) ts = (k == e) ? tstart[k] : ts;
        u.r0 = (u.pm - ts) * BM; return true;
    }
    __device__ __forceinline__ int count_of(int e) const { int cv = 0;
#pragma unroll
        for (int k = 0; k < NE; ++k) cv = (k == e) ? cnt[k] : cv;
        return cv; }
    __device__ __forceinline__ unsigned arow(const Unit& u, int lr) const {
        if (!gather) return (unsigned)(u.pm * BM + lr);
        const int l = u.r0 + lr; const int cv = count_of(u.e);
        unsigned t = 0u; if (l < cv) t = __hip_atomic_load((const GAS unsigned*)list_tok + (size_t)u.e * LIST_CAP + l, __ATOMIC_RELAXED, __HIP_MEMORY_SCOPE_AGENT) & 0xFFFFFu;
        return t;
    }
};

__device__ __forceinline__ unsigned cvt_pk_bf16(float lo, float hi) { unsigned r; asm volatile("v_cvt_pk_bf16_f32 %0, %1, %2" : "=v"(r) : "v"(lo), "v"(hi)); return r; }

struct EpiQKV {
    static constexpr bool PERM = true;
    bf16_t* O; int ldc; int split_cols; size_t split_stride; float scale0;
    __device__ __forceinline__ void operator()(const f32x4 (&acc)[2][2][4][2], const Unit& u, int wr, int wc, int fr, int fq) const {
        const int row0 = u.pm * BM + wr * 64 + fr; int colt = u.pn * BM; bf16_t* base = O;
        float sc = 1.f; { const int t = colt / split_cols; base += (size_t)t * split_stride; colt -= t * split_cols; if (t == 0) sc = scale0; }
        const int col0 = colt + wc * 32 + 8 * fq;
#pragma unroll
        for (int ai = 0; ai < 2; ++ai)
#pragma unroll
            for (int m = 0; m < 4; ++m) { bf16_t* rowp = base + (size_t)(row0 + ai * HALF + m * 16) * ldc + col0;
#pragma unroll
                for (int bj = 0; bj < 2; ++bj) { f32x4 v0 = acc[ai][bj][m][0] * sc, v1 = acc[ai][bj][m][1] * sc;
                    u32x4 w; w.x = cvt_pk_bf16(v0[0], v0[1]); w.y = cvt_pk_bf16(v0[2], v0[3]); w.z = cvt_pk_bf16(v1[0], v1[1]); w.w = cvt_pk_bf16(v1[2], v1[3]);
                    *(GAS u32x4*)(rowp + bj * HALF) = w;
                    } }
    }
};
__device__ __forceinline__ unsigned pk4_fp8(float a, float b, float c, float d) { unsigned w = 0; w = __builtin_amdgcn_cvt_pk_fp8_f32(a, b, w, false); w = __builtin_amdgcn_cvt_pk_fp8_f32(c, d, w, true); return w; }
template <bool F8OUT> struct EpiSwiGLU {
    static constexpr bool PERM = true;
    void* O; int ldc; float sc;
    __device__ __forceinline__ void operator()(const f32x4 (&acc)[2][2][4][2], const Unit& u, int wr, int wc, int fr, int fq) const {
        const int row0 = u.pm * BM + wr * 64 + fr; const int col0 = u.pn * HALF + wc * 32 + 8 * fq;
#pragma unroll
        for (int ai = 0; ai < 2; ++ai)
#pragma unroll
            for (int m = 0; m < 4; ++m) { float o[8];
#pragma unroll
                for (int n = 0; n < 2; ++n)
#pragma unroll
                    for (int j = 0; j < 4; ++j) { const float g = acc[ai][0][m][n][j] * sc, up = acc[ai][1][m][n][j] * sc;
                        const float s = __builtin_amdgcn_rcpf(1.0f + __builtin_amdgcn_exp2f(-1.4426950408889634f * g)); o[n * 4 + j] = g * s * up; }
                const size_t eo = (size_t)(row0 + ai * HALF + m * 16) * ldc + col0;
                if constexpr (F8OUT) { const unsigned long long w = (unsigned long long)pk4_fp8(o[0], o[1], o[2], o[3]) | ((unsigned long long)pk4_fp8(o[4], o[5], o[6], o[7]) << 32);
                    *(GAS unsigned long long*)((unsigned char*)O + eo) = w;
                } else { u32x4 w; w.x = cvt_pk_bf16(o[0], o[1]); w.y = cvt_pk_bf16(o[2], o[3]); w.z = cvt_pk_bf16(o[4], o[5]); w.w = cvt_pk_bf16(o[6], o[7]);
                    *(GAS u32x4*)((bf16_t*)O + eo) = w; } }
    }
};
template <bool RF32> struct EpiRes {
    static constexpr bool PERM = true;
    const void* res; bf16_t* out; int ldc; float sc;
    __device__ __forceinline__ void operator()(const f32x4 (&acc)[2][2][4][2], const Unit& u, int wr, int wc, int fr, int fq) const {
        const int row0 = u.pm * BM + wr * 64 + fr; const int col0 = u.pn * BM + wc * 32 + 8 * fq;
#pragma unroll
        for (int ai = 0; ai < 2; ++ai)
#pragma unroll
            for (int m = 0; m < 4; ++m) { const size_t off = (size_t)(row0 + ai * HALF + m * 16) * ldc + col0;
#pragma unroll
                for (int bj = 0; bj < 2; ++bj) { const size_t o2 = off + bj * HALF; f32x4 r0, r1;
                    if constexpr (RF32) { r0 = *(const GAS f32x4*)((const float*)res + o2); r1 = *(const GAS f32x4*)((const float*)res + o2 + 4); }
                    else { const u32x4 w = *(const GAS u32x4*)((const bf16_t*)res + o2);
                        r0 = (f32x4){__uint_as_float(w.x << 16), __uint_as_float(w.x & 0xFFFF0000u), __uint_as_float(w.y << 16), __uint_as_float(w.y & 0xFFFF0000u)};
                        r1 = (f32x4){__uint_as_float(w.z << 16), __uint_as_float(w.z & 0xFFFF0000u), __uint_as_float(w.w << 16), __uint_as_float(w.w & 0xFFFF0000u)}; }
                    const f32x4 v0 = r0 + acc[ai][bj][m][0] * sc, v1 = r1 + acc[ai][bj][m][1] * sc;
                    u32x4 o; o.x = cvt_pk_bf16(v0[0], v0[1]); o.y = cvt_pk_bf16(v0[2], v0[3]); o.z = cvt_pk_bf16(v1[0], v1[1]); o.w = cvt_pk_bf16(v1[2], v1[3]);
                    *(GAS u32x4*)(out + o2) = o; } }
    }
};
struct EpiMoeDown {
    static constexpr bool PERM = true;
    bf16_t* y0; bf16_t* y1; const unsigned* list_tok; const float* list_w; int cnt[NE]; float sc;
    __device__ __forceinline__ void operator()(const f32x4 (&acc)[2][2][4][2], const Unit& u, int wr, int wc, int fr, int fq) const {
        int cv = 0;
#pragma unroll
        for (int k = 0; k < NE; ++k) cv = (k == u.e) ? cnt[k] : cv;
        const int col0 = u.pn * BM + wc * 32 + 8 * fq;
#pragma unroll
        for (int ai = 0; ai < 2; ++ai)
#pragma unroll
            for (int m = 0; m < 4; ++m) { const int l = u.r0 + ai * HALF + wr * 64 + m * 16 + fr;
                if (l < cv) {
                    const unsigned ent = __hip_atomic_load((const GAS unsigned*)list_tok + (size_t)u.e * LIST_CAP + l, __ATOMIC_RELAXED, __HIP_MEMORY_SCOPE_AGENT);
                    const float w = sc * __uint_as_float(__hip_atomic_load((const GAS unsigned*)list_w + (size_t)u.e * LIST_CAP + l, __ATOMIC_RELAXED, __HIP_MEMORY_SCOPE_AGENT));
                    const size_t off = (size_t)(ent & 0xFFFFFu) * D + col0;
                    bf16_t* yb = (ent >> 20) == 0u ? y0 : y1;
#pragma unroll
                    for (int bj = 0; bj < 2; ++bj) { const f32x4 v0 = acc[ai][bj][m][0] * w, v1 = acc[ai][bj][m][1] * w;
                        u32x4 o; o.x = cvt_pk_bf16(v0[0], v0[1]); o.y = cvt_pk_bf16(v0[2], v0[3]); o.z = cvt_pk_bf16(v1[0], v1[1]); o.w = cvt_pk_bf16(v1[2], v1[3]); *(GAS u32x4*)(yb + off + bj * HALF) = o; }
                } }
    }
};

template <class Epi, class Sched, bool F8 = false>
__device__ __forceinline__ void gemm_phase(PG8_LAS unsigned char* lds, int xoff, const Gemm g, const Sched& S, const Epi& E) {
    int tid_ = threadIdx.x;
    asm volatile("" : "+v"(tid_));
    const int tid = tid_, wid = __builtin_amdgcn_readfirstlane(tid >> 6), lane = tid & 63, wr = wid >> 2, wc = wid & 3, fr = lane & 15, fq = lane >> 4;
    const int RB = g.rowb, nt = RB / 128;
    unsigned voffB[2];
#pragma unroll
    for (int i = 0; i < 2; ++i) { int R, C; stage_rc(tid * 16 + i * 8192, R, C); const int Rb = Epi::PERM ? ((R & ~31) + perm32(R & 31)) : R;
        voffB[i] = (unsigned)(Rb * RB + C * 2); }
    const size_t kstep = (size_t)(BK * 2);
    const size_t hstep = (size_t)HALF * RB;
    const size_t tstep = 2 * hstep;
    const unsigned ldsw = (unsigned)wid * 1024u;
    const int aoff = F8 ? lds_byte(wr * 64 + fr, fq * 16) : lds_byte(wr * 64 + fr, fq * 8), boff = F8 ? lds_byte(wc * 32 + fr, fq * 16) : lds_byte(wc * 32 + fr, fq * 8);
#define PG8_SA(b, h) (((b) * 2 + (h)) * HTB)
#define PG8_SB(b, h) ((4 + (b) * 2 + (h)) * HTB)
#define PG8_STAGE(bufoff, gbase, v0, v1) do { \
        __builtin_amdgcn_global_load_lds((const GAS unsigned*)((const char*)(gbase) + (v0)), (PG8_LAS unsigned*)(lds + (bufoff) + ldsw), 16, 0, 0); \
        __builtin_amdgcn_global_load_lds((const GAS unsigned*)((const char*)(gbase) + (v1)), (PG8_LAS unsigned*)(lds + (bufoff) + ldsw + 8192), 16, 0, 0); } while (0)
#define PG8_STAGEB(bufoff, gbase) PG8_STAGE(bufoff, gbase, voffB[0], voffB[1])
#define PG8_LDA(dst, b, h) do { if constexpr (F8) { _Pragma("unroll") for (int m = 0; m < 4; ++m) { dst##8[m].lo = *(const PG8_LAS i32x4*)(lds + PG8_SA(b, h) + aoff + m * 2048); dst##8[m].hi = *(const PG8_LAS i32x4*)(lds + PG8_SA(b, h) + aoff + m * 2048 + 16); } } \
        else { _Pragma("unroll") for (int m = 0; m < 4; ++m) _Pragma("unroll") for (int k = 0; k < 2; ++k) dst[m][k] = *(const PG8_LAS bf16x8*)(lds + PG8_SA(b, h) + aoff + m * 2048 + k * 1024); } } while (0)
#define PG8_LDB(dst, b, h) do { if constexpr (F8) { _Pragma("unroll") for (int n = 0; n < 2; ++n) { dst##8[n].lo = *(const PG8_LAS i32x4*)(lds + PG8_SB(b, h) + boff + n * 2048); dst##8[n].hi = *(const PG8_LAS i32x4*)(lds + PG8_SB(b, h) + boff + n * 2048 + 16); } } \
        else { _Pragma("unroll") for (int n = 0; n < 2; ++n) _Pragma("unroll") for (int k = 0; k < 2; ++k) dst[n][k] = *(const PG8_LAS bf16x8*)(lds + PG8_SB(b, h) + boff + n * 2048 + k * 1024); } } while (0)
#define PG8_MMA(ai, bj, At, Bt) do { __builtin_amdgcn_s_setprio(1); _Pragma("unroll") for (int m = 0; m < 4; ++m) _Pragma("unroll") for (int n = 0; n < 2; ++n) { \
        if constexpr (F8) acc[ai][bj][m][n] = __builtin_amdgcn_mfma_scale_f32_16x16x128_f8f6f4(Bt##8[n], At##8[m], acc[ai][bj][m][n], 0, 0, 0, 0x7F7F7F7F, 0, 0x7F7F7F7F); \
        else { _Pragma("unroll") for (int k = 0; k < 2; ++k) acc[ai][bj][m][n] = __builtin_amdgcn_mfma_f32_16x16x32_bf16(Bt[n][k], At[m][k], acc[ai][bj][m][n], 0, 0, 0); } } __builtin_amdgcn_s_setprio(0); } while (0)
#define PG8_WAIT_V(n) asm volatile("s_waitcnt vmcnt(" #n ")" ::: "memory")
#define PG8_WAIT_L(n) asm volatile("s_waitcnt lgkmcnt(" #n ")" ::: "memory")
#define PG8_BAR __builtin_amdgcn_s_barrier()
#define PG8_SCHED __builtin_amdgcn_sched_barrier(0)
#define PG8_AOFFS(U, o00, o01, o10, o11) do { int R0_, C0_, R1_, C1_; stage_rc(tid * 16, R0_, C0_); stage_rc(tid * 16 + 8192, R1_, C1_);     \
        o00 = S.arow(U, R0_) * (unsigned)RB + (unsigned)C0_ * 2u; o01 = S.arow(U, R1_) * (unsigned)RB + (unsigned)C1_ * 2u; \
        o10 = S.arow(U, HALF + R0_) * (unsigned)RB + (unsigned)C0_ * 2u; o11 = S.arow(U, HALF + R1_) * (unsigned)RB + (unsigned)C1_ * 2u; } while (0)
    Unit cur, nxt; int ui = 0;
    if (!S.next(0, cur)) return;
    f32x4 acc[2][2][4][2];
#pragma unroll
    for (int a = 0; a < 2; ++a)
#pragma unroll
        for (int b = 0; b < 2; ++b)
#pragma unroll
            for (int m = 0; m < 4; ++m)
#pragma unroll
                for (int n = 0; n < 2; ++n) acc[a][b][m][n] = (f32x4){0.f, 0.f, 0.f, 0.f};
    bf16x8 At[4][2], B0[2][2], B1[2][2];
    i32x8 At8[4], B08[2], B18[2];
    unsigned c00, c01, c10, c11;
    PG8_LAS u32x4* const xslot = (PG8_LAS u32x4*)(lds + xoff) + tid;
    PG8_AOFFS(cur, c00, c01, c10, c11);
    const char* const gA = (const char*)g.A;
    const char* cB = (const char*)g.Bt + (size_t)cur.e * g.bstride + (size_t)cur.pn * tstep;
    PG8_STAGEB(PG8_SB(0, 0), cB); PG8_STAGEB(PG8_SB(0, 1), cB + hstep); PG8_STAGE(PG8_SA(0, 0), gA, c00, c01); PG8_STAGE(PG8_SA(0, 1), gA, c10, c11);
    if (wr == 1) PG8_BAR;
    PG8_WAIT_V(2); PG8_BAR;
    PG8_STAGEB(PG8_SB(1, 0), cB + kstep); PG8_STAGE(PG8_SA(1, 0), gA + kstep, c00, c01); PG8_STAGEB(PG8_SB(1, 1), cB + hstep + kstep);
    PG8_WAIT_V(6); PG8_BAR;
    for (;;) {
        const bool has_next = S.next(ui + 1, nxt);
        const char* nB_ = has_next ? (const char*)g.Bt + (size_t)nxt.e * g.bstride + (size_t)nxt.pn * tstep : cB;
        const char* nB = nB_;
        if (has_next) { unsigned n00, n01, n10, n11; PG8_AOFFS(nxt, n00, n01, n10, n11); *xslot = (u32x4){n00, n01, n10, n11}; }
#pragma unroll 1
        for (int t = 0; t < nt; t += 2) {
            const bool last = (t == nt - 2);
            const char* a1 = gA + (size_t)(t + 1) * kstep;
            const char* a2 = last ? gA : gA + (size_t)(t + 2) * kstep; const char* b2 = last ? nB : cB + (size_t)(t + 2) * kstep;
            const char* a3 = a2 + kstep; const char* b3 = b2 + kstep;
            PG8_LDB(B0, 0, 0); PG8_LDB(B1, 0, 1); PG8_SCHED; PG8_LDA(At, 0, 0); PG8_STAGE(PG8_SA(1, 1), a1, c10, c11);
            if (last && has_next) { const u32x4 nx = *xslot; c00 = nx.x; c01 = nx.y; c10 = nx.z; c11 = nx.w; }
            PG8_WAIT_V(8); PG8_WAIT_L(0); PG8_BAR; PG8_MMA(0, 0, At, B0); PG8_MMA(0, 1, At, B1); PG8_BAR; PG8_SCHED;
            PG8_LDA(At, 0, 1); PG8_STAGEB(PG8_SB(0, 0), b2); PG8_STAGEB(PG8_SB(0, 1), b2 + hstep); PG8_STAGE(PG8_SA(0, 0), a2, c00, c01);
            PG8_WAIT_V(8); PG8_WAIT_L(0); PG8_BAR; PG8_MMA(1, 0, At, B0); PG8_MMA(1, 1, At, B1); PG8_BAR; PG8_SCHED;
            PG8_LDB(B0, 1, 0); PG8_LDB(B1, 1, 1); PG8_SCHED; PG8_LDA(At, 1, 0); PG8_STAGE(PG8_SA(0, 1), a2, c10, c11);
            PG8_WAIT_V(8); PG8_WAIT_L(0); PG8_BAR; PG8_MMA(0, 0, At, B0); PG8_MMA(0, 1, At, B1); PG8_BAR; PG8_SCHED;
            PG8_LDA(At, 1, 1); PG8_STAGEB(PG8_SB(1, 0), b3); PG8_STAGEB(PG8_SB(1, 1), b3 + hstep); PG8_STAGE(PG8_SA(1, 0), a3, c00, c01);
            PG8_WAIT_V(8); PG8_WAIT_L(0); PG8_BAR; PG8_MMA(1, 0, At, B0); PG8_MMA(1, 1, At, B1); PG8_BAR; PG8_SCHED;
        }
        if (wr == 0) PG8_BAR;
        E(acc, cur, wr, wc, fr, fq);
        if (!has_next) break;
#pragma unroll
        for (int a = 0; a < 2; ++a)
#pragma unroll
            for (int b = 0; b < 2; ++b)
#pragma unroll
                for (int m = 0; m < 4; ++m)
#pragma unroll
                    for (int n = 0; n < 2; ++n) acc[a][b][m][n] = (f32x4){0.f, 0.f, 0.f, 0.f};
        cur = nxt; cB = nB; ++ui;
        if (wr == 1) PG8_BAR;
    }
    PG8_WAIT_V(0);
    PG8_BAR;
#undef PG8_SA
#undef PG8_SB
#undef PG8_STAGE
#undef PG8_STAGEB
#undef PG8_LDA
#undef PG8_LDB
#undef PG8_MMA
#undef PG8_WAIT_V
#undef PG8_WAIT_L
#undef PG8_BAR
#undef PG8_SCHED
#undef PG8_AOFFS
}
}

namespace att {
typedef unsigned short bf16_t;
typedef short bf16x8 __attribute__((ext_vector_type(8)));
typedef short s16x4 __attribute__((ext_vector_type(4)));
typedef float f32x16 __attribute__((ext_vector_type(16)));
typedef float f32x4 __attribute__((ext_vector_type(4)));
typedef unsigned u32x4 __attribute__((ext_vector_type(4)));
constexpr int PITCH = 1024;
constexpr float LOG2E = 1.4426950408889634f;
__device__ __forceinline__ int crow(int r, int hi) { return (r & 3) + 8 * (r >> 2) + 4 * hi; }
typedef float f32x2_t __attribute__((ext_vector_type(2))); typedef __bf16 bf16x2_t __attribute__((ext_vector_type(2)));
__device__ __forceinline__ unsigned cvtpk(float lo, float hi) { f32x2_t v = {lo, hi}; bf16x2_t b = __builtin_convertvector(v, bf16x2_t); return __builtin_bit_cast(unsigned, b); }
__device__ __forceinline__ float bf2f(short s) { return __uint_as_float(((unsigned)(unsigned short)s) << 16); }
typedef short v4i16_t __attribute__((ext_vector_type(4)));
__device__ __forceinline__ s16x4 vtr(const LAS unsigned char* p) { return __builtin_bit_cast(s16x4, __builtin_amdgcn_ds_read_tr16_b64_v4i16((LAS v4i16_t*)p)); }
__device__ __forceinline__ float max3f(float a, float b, float c) { float r; asm("v_max3_f32 %0, %1, %2, %3" : "=v"(r) : "v"(a), "v"(b), "v"(c)); return r; }
__device__ __forceinline__ float halves_max(float m) { auto rr = __builtin_amdgcn_permlane32_swap(__float_as_uint(m), __float_as_uint(m), false, false); return fmaxf(__uint_as_float(rr[0]), __uint_as_float(rr[1])); }
__device__ __forceinline__ float halves_sum(float m) { auto rr = __builtin_amdgcn_permlane32_swap(__float_as_uint(m), __float_as_uint(m), false, false); return __uint_as_float(rr[0]) + __uint_as_float(rr[1]); }
#define ATT_PRIO(x) do { if (wid >= 4) __builtin_amdgcn_s_setprio(1 + (x)); else __builtin_amdgcn_s_setprio(x); } while (0)
#define ATT_BAR() asm volatile("s_waitcnt vmcnt(0) lgkmcnt(0)\n\ts_barrier" ::: "memory")
typedef unsigned u32x2 __attribute__((ext_vector_type(2)));
#define ATT_RD128(d, a, off) asm volatile("ds_read_b128 %0, %1 offset:%2" : "=v"(d) : "v"(a), "n"(off))
#define ATT_RDTR(d, a, off) asm volatile("ds_read_b64_tr_b16 %0, %1 offset:%2" : "=v"(d) : "v"(a), "n"(off))
#define ATT_WAIT2(n, x, y) asm volatile("s_waitcnt lgkmcnt(" #n ")" : "+v"(x), "+v"(y))

struct Args { const bf16_t* Q; const bf16_t* K; const bf16_t* V; bf16_t* O; const float* kmean; const float* kmax2; const float* subln; float lam_full; float out_scale; int abl; };
#ifndef ATT_ABLATE
#define ATT_ABLATE 0
#endif
#if ATT_ABLATE
#define ABL(bit) ((((ATT_ABLATE) >> (bit)) & 1) && abl_)
#else
#define ABL(bit) 0
#endif

template <int MODE>
__device__ __forceinline__ void attn_unit(LAS unsigned char* lds, const Args& A, int b, int h, int qblk) {
    constexpr int DVB = MODE == 0 ? 4 : 2;
    constexpr int NCH = MODE == 0 ? 16 : 8;
    constexpr int KBY = NCH * 1024, VBY = DVB * 4096, SLOT = KBY + VBY;
    constexpr int QR = MODE == 0 ? 128 : 256;
    constexpr int PPW = MODE == 0 ? 2 : 1;
    int tid_ = threadIdx.x; asm volatile("" : "+v"(tid_));
    const int tid = tid_, lane = tid & 63, r32 = lane & 31, hi = lane >> 5;
    const int wid = __builtin_amdgcn_readfirstlane(tid >> 6);
    const int comp = MODE == 0 ? (wid >> 2) : 0, wq = MODE == 0 ? (wid & 3) : wid;
    const int q0 = qblk * QR; const long rowbase = (long)b * SEQ;
    const int hcol = MODE == 0 ? h * 128 : h * 64;
    const int qrel0 = wq * 32;
    const float slope2 = __builtin_amdgcn_exp2f(MODE == 0 ? -(float)(h + 1) : -0.5f * (float)(h + 1)) * LOG2E;
    const int NT = MODE == 0 ? 2 * qblk + 2 : 4 + 4 * qblk;
#define ATT_KBASE_(t) (MODE == 0 ? 64 * (t) : ((t) < 4 ? q0 + 64 * (t) : 64 * ((t) - 4)))
#define ATT_KBASE(t) ATT_KBASE_(t)
    LAS float* wsf = (LAS float*)(lds + 65536) + wid * 64;
    const bf16_t* Kb = A.K + rowbase * PITCH + hcol;
    const bf16_t* Vb = A.V + rowbase * PITCH + hcol;
#define ATT_ISSUE_K(tt, slot) do { const int kb_ = ATT_KBASE(tt); \
        _Pragma("unroll") for (int i_ = 0; i_ < PPW; ++i_) { const int p_ = wid + 8 * i_; \
            __builtin_amdgcn_global_load_lds((const GAS unsigned*)(Kb + (size_t)(kb_ + lane) * PITCH + p_ * 8), (LAS unsigned*)(lds + (slot) * SLOT + p_ * 1024), 16, 0, 0); } } while (0)
#define ATT_ISSUE_V(tt, slot) do { const int kb_ = ATT_KBASE(tt); \
        _Pragma("unroll") for (int i_ = 0; i_ < PPW; ++i_) { const int p_ = wid + 8 * i_; \
            __builtin_amdgcn_global_load_lds((const GAS unsigned*)(Vb + (size_t)(kb_ + 16 * (p_ & 3) + (lane >> 2)) * PITCH + (p_ >> 2) * 32 + (lane & 3) * 8), (LAS unsigned*)(lds + (slot) * SLOT + KBY + p_ * 1024), 16, 0, 0); } } while (0)
    asm volatile("s_waitcnt lgkmcnt(0)\n\ts_barrier" ::: "memory");
    bf16x8 qr[4];
    { const bf16_t* Qw = A.Q + (rowbase + q0 + qrel0 + r32) * PITCH + hcol + comp * 64 + hi * 8;
#pragma unroll
      for (int d0 = 0; d0 < 4; ++d0) qr[d0] = *(const GAS bf16x8*)(Qw + d0 * 16); }
    const int tt_l = MODE == 0 ? (lane < 2 ? 2 * qblk + lane : lane - 2) : lane;
    const int kbase_l = (lane < NT) ? ATT_KBASE_(tt_l) : 0;
    const bool past_l = lane < NT && kbase_l + 64 <= q0;
    float k2a = 0.f, k2b = 0.f;
    { const int nblk = (kbase_l >> 8) & 15;
        if constexpr (MODE == 0) { k2a = ((const GAS float*)A.kmax2)[(size_t)(b * 16 + h * 2) * 16 + nblk]; k2b = ((const GAS float*)A.kmax2)[(size_t)(b * 16 + h * 2 + 1) * 16 + nblk]; }
        else k2a = ((const GAS float*)A.kmax2)[(size_t)(b * 16 + h) * 16 + nblk]; }
    float kmv0 = 0.f, kmv1 = 0.f;
    if constexpr (MODE == 1) { kmv0 = ((const GAS float*)A.kmean)[(size_t)(b * 16 + h) * 1024 + tid]; kmv1 = ((const GAS float*)A.kmean)[(size_t)(b * 16 + h) * 1024 + 512 + tid]; }
    const int t0 = MODE == 0 ? 2 * qblk : 0, t1 = t0 + 1;
    ATT_ISSUE_K(t0, 0); ATT_ISSUE_V(t0, 0); ATT_ISSUE_K(t1, 1);
    LAS int* live = (LAS int*)(lds + 71680); LAS float* qnx = (LAS float*)(lds + 71680 + 272);
    LAS float* km = (LAS float*)(lds + 67584);
    { float q2 = 0.f;
#pragma unroll
      for (int d0 = 0; d0 < 4; ++d0)
#pragma unroll
        for (int j = 0; j < 8; ++j) { const float v = bf2f(qr[d0][j]); q2 += v * v; }
      q2 = halves_sum(q2);
      q2 = fmaxf(q2, __shfl_xor(q2, 1)); q2 = fmaxf(q2, __shfl_xor(q2, 2)); q2 = fmaxf(q2, __shfl_xor(q2, 4)); q2 = fmaxf(q2, __shfl_xor(q2, 8)); q2 = fmaxf(q2, __shfl_xor(q2, 16));
      if (lane == 0) qnx[wid] = q2; }
    if constexpr (MODE == 1) { km[tid] = kmv0; km[tid + 512] = kmv1; }
    ATT_BAR();
    if (wid == 0) {
        bool alive = lane < NT;
        if (past_l) { float bound;
            if constexpr (MODE == 0) { const float qa = fmaxf(fmaxf(qnx[0], qnx[1]), fmaxf(qnx[2], qnx[3])), qb = fmaxf(fmaxf(qnx[4], qnx[5]), fmaxf(qnx[6], qnx[7]));
                bound = fmaxf(sqrtf(qa) * sqrtf(k2a), sqrtf(qb) * sqrtf(k2b));
            } else { float qm = qnx[0];
#pragma unroll
                for (int w = 1; w < 8; ++w) qm = fmaxf(qm, qnx[w]);
                bound = sqrtf(qm) * sqrtf(k2a); }
            alive = !(bound * 1.001f + 1.0f + slope2 * (float)(kbase_l + 63 - q0) < -152.0f);
        }
        const unsigned long long am = __ballot(alive);
        if (alive) live[__popcll(am & ((1ull << lane) - 1ull))] = tt_l;
        if (lane == 0) live[64] = __popcll(am);
    }
    unsigned sel = 0u;
    if constexpr (MODE == 1) {
        float g[16];
#pragma unroll
        for (int n = 0; n < 16; ++n) { float s = 0.f;
            if (n < qblk) {
#pragma unroll
                for (int d0 = 0; d0 < 4; ++d0) { const f32x4 ka = *(const LAS f32x4*)(km + n * 64 + d0 * 16 + hi * 8), kb2 = *(const LAS f32x4*)(km + n * 64 + d0 * 16 + hi * 8 + 4);
                    s += bf2f(qr[d0][0]) * ka[0] + bf2f(qr[d0][1]) * ka[1] + bf2f(qr[d0][2]) * ka[2] + bf2f(qr[d0][3]) * ka[3]
                       + bf2f(qr[d0][4]) * kb2[0] + bf2f(qr[d0][5]) * kb2[1] + bf2f(qr[d0][6]) * kb2[2] + bf2f(qr[d0][7]) * kb2[3]; }
                s = halves_sum(s); }
            g[n] = s; }
        const int nsel = qblk < 3 ? qblk : 3;
#pragma unroll
        for (int k = 0; k < 3; ++k) if (k < nsel) { float best = -INFINITY; int bi = 0; bool found = false;
#pragma unroll
            for (int n = 0; n < 16; ++n) if (n < qblk) { const bool free_ = ((sel >> n) & 1u) == 0u; if (free_ && (!found || g[n] > best)) { best = g[n]; bi = n; found = true; } }
            sel |= 1u << bi; }
    }
    ATT_BAR();
    const int NTL = __builtin_amdgcn_readfirstlane(live[64]);
#define ATT_ISSUE(t, slot) do { const int kb_ = ATT_KBASE(t); \
        _Pragma("unroll") for (int i_ = 0; i_ < PPW; ++i_) { const int p_ = wid + 8 * i_; \
            __builtin_amdgcn_global_load_lds((const GAS unsigned*)(Kb + (size_t)(kb_ + lane) * PITCH + p_ * 8), (LAS unsigned*)(lds + (slot) * SLOT + p_ * 1024), 16, 0, 0); \
            __builtin_amdgcn_global_load_lds((const GAS unsigned*)(Vb + (size_t)(kb_ + 16 * (p_ & 3) + (lane >> 2)) * PITCH + (p_ >> 2) * 32 + (lane & 3) * 8), (LAS unsigned*)(lds + (slot) * SLOT + KBY + p_ * 1024), 16, 0, 0); } } while (0)
    constexpr float THR = 8.0f;
    float mref = 0.f, l = 0.f; f32x16 o[DVB];
#pragma unroll
    for (int d0 = 0; d0 < DVB; ++d0) o[d0] = f32x16{};
#define ATT_CLASS(tt, SK, NM, SB) do { const int kb_ = ATT_KBASE(tt), kr_ = kb_ - q0; const bool dg_ = kb_ >= q0; SK = dg_ && (kr_ > qrel0 + 31); NM = dg_ && (kr_ + 63 > qrel0); SB = true; \
        if constexpr (MODE == 1) { if ((tt) >= 4) { SB = ((sel >> (((tt) - 4) >> 2)) & 1u) != 0u; if (!__any(SB)) SK = true; } } } while (0)
#define ATT_QK(P0, P1, tt, slot, SB) do { const int kr_ = ATT_KBASE(tt) - q0; float off0_ = slope2 * (float)(kr_ + 4 * hi) - mref; if (!(SB)) off0_ = -INFINITY; const float off1_ = off0_ + 32.0f * slope2; \
        const unsigned ka_ = (unsigned)(size_t)(lds + (slot) * SLOT + comp * 8192 + hi * 1024 + r32 * 16); u32x4 kx_[4], ky_[4]; \
        ATT_RD128(kx_[0], ka_, 0); ATT_RD128(ky_[0], ka_, 512); ATT_RD128(kx_[1], ka_, 2048); ATT_RD128(ky_[1], ka_, 2560); \
        _Pragma("unroll") for (int r = 0; r < 16; ++r) { const float cbr = slope2 * (float)((r & 3) + 8 * (r >> 2)); P0[r] = cbr + off0_; P1[r] = cbr + off1_; } \
        ATT_PRIO(1); ATT_WAIT2(2, kx_[0], ky_[0]); P0 = __builtin_amdgcn_mfma_f32_32x32x16_bf16(__builtin_bit_cast(bf16x8, kx_[0]), qr[0], P0, 0, 0, 0); P1 = __builtin_amdgcn_mfma_f32_32x32x16_bf16(__builtin_bit_cast(bf16x8, ky_[0]), qr[0], P1, 0, 0, 0); \
        ATT_RD128(kx_[2], ka_, 4096); ATT_RD128(ky_[2], ka_, 4608); \
        ATT_WAIT2(2, kx_[1], ky_[1]); P0 = __builtin_amdgcn_mfma_f32_32x32x16_bf16(__builtin_bit_cast(bf16x8, kx_[1]), qr[1], P0, 0, 0, 0); P1 = __builtin_amdgcn_mfma_f32_32x32x16_bf16(__builtin_bit_cast(bf16x8, ky_[1]), qr[1], P1, 0, 0, 0); \
        ATT_RD128(kx_[3], ka_, 6144); ATT_RD128(ky_[3], ka_, 6656); \
        ATT_WAIT2(2, kx_[2], ky_[2]); P0 = __builtin_amdgcn_mfma_f32_32x32x16_bf16(__builtin_bit_cast(bf16x8, kx_[2]), qr[2], P0, 0, 0, 0); P1 = __builtin_amdgcn_mfma_f32_32x32x16_bf16(__builtin_bit_cast(bf16x8, ky_[2]), qr[2], P1, 0, 0, 0); \
        ATT_WAIT2(0, kx_[3], ky_[3]); P0 = __builtin_amdgcn_mfma_f32_32x32x16_bf16(__builtin_bit_cast(bf16x8, kx_[3]), qr[3], P0, 0, 0, 0); P1 = __builtin_amdgcn_mfma_f32_32x32x16_bf16(__builtin_bit_cast(bf16x8, ky_[3]), qr[3], P1, 0, 0, 0); ATT_PRIO(0); } while (0)
    f32x16 p0, p1, n0, n1;
    const int abl_ = __builtin_amdgcn_readfirstlane(A.abl); (void)abl_;
    int t = t0, tn = t1;
    bool skipC, maskC, selC, skipN = true, maskN = false, selN = true;
    ATT_CLASS(t, skipC, maskC, selC);
    if (!skipC) ATT_QK(p0, p1, t, 0, selC);
    const int NTLX = ABL(4) ? 1 : NTL;
    ATT_PRIO(0);
    for (int it = 0; it < NTLX; ++it) {
        ATT_BAR();
        const int tnn = (it + 2 < NTL) ? __builtin_amdgcn_readfirstlane(live[it + 2]) : 0;
        if (it + 2 < NTL && !ABL(0)) ATT_ISSUE_K(tnn, it & 1);
        if (it + 1 < NTL) { if (!ABL(0)) ATT_ISSUE_V(tn, (it + 1) & 1); ATT_CLASS(tn, skipN, maskN, selN); if (!skipN) { if (!ABL(2)) ATT_QK(n0, n1, tn, (it + 1) & 1, selN); else { n0 = f32x16{} - 1.0f; n1 = n0; } } } else skipN = true;
        if (!skipC) {
            const int krel = ATT_KBASE(t) - q0;
            const unsigned va_ = (unsigned)(size_t)(lds + (it & 1) * SLOT + KBY + ((lane >> 4) & 1) * 32 + (lane & 3) * 8 + (4 * hi + ((lane & 15) >> 2)) * 64);
            u32x2 vl_[4], vh_[4];
            if (!ABL(1)) { ATT_RDTR(vl_[0], va_, 0); ATT_RDTR(vh_[0], va_, 512); ATT_RDTR(vl_[1], va_, 1024); ATT_RDTR(vh_[1], va_, 1536);
            ATT_RDTR(vl_[2], va_, 2048); ATT_RDTR(vh_[2], va_, 2560); ATT_RDTR(vl_[3], va_, 3072); ATT_RDTR(vh_[3], va_, 3584); }
            if (maskC) { const int qrel = qrel0 + r32;
#pragma unroll
                for (int r = 0; r < 16; ++r) { const int kv = krel + crow(r, hi); if (kv > qrel) p0[r] = -INFINITY; if (kv + 32 > qrel) p1[r] = -INFINITY; } }
            float rm;
            { float a_ = max3f(p0[0], p0[1], p1[0]), b_ = max3f(p0[2], p0[3], p1[1]); a_ = max3f(a_, p1[2], p1[3]);
#pragma unroll
              for (int r = 4; r < 16; r += 4) { a_ = max3f(a_, p0[r], p0[r + 1]); b_ = max3f(b_, p0[r + 2], p0[r + 3]); a_ = max3f(a_, p1[r], p1[r + 1]); b_ = max3f(b_, p1[r + 2], p1[r + 3]); }
              rm = halves_max(fmaxf(a_, b_)); }
            if (__any(rm > THR)) {
                const float dl = fmaxf(rm, 0.f); mref += dl; const float alpha = __builtin_amdgcn_exp2f(-dl);
#pragma unroll
                for (int r = 0; r < 16; ++r) { p0[r] -= dl; p1[r] -= dl; }
                if (!skipN) {
#pragma unroll
                    for (int r = 0; r < 16; ++r) { n0[r] -= dl; n1[r] -= dl; } }
                l *= alpha;
#pragma unroll
                for (int d0 = 0; d0 < DVB; ++d0) o[d0] = o[d0] * alpha;
            }
            float sacc = 0.f;
            if (!ABL(3)) {
#pragma unroll
            for (int r = 0; r < 16; ++r) { p0[r] = __builtin_amdgcn_exp2f(p0[r]); p1[r] = __builtin_amdgcn_exp2f(p1[r]); sacc += p0[r] + p1[r]; } }
            l += sacc;
            u32x4 pw[4];
            pw[0] = (u32x4){cvtpk(p0[0], p0[1]), cvtpk(p0[2], p0[3]), cvtpk(p0[4], p0[5]), cvtpk(p0[6], p0[7])};
            pw[1] = (u32x4){cvtpk(p0[8], p0[9]), cvtpk(p0[10], p0[11]), cvtpk(p0[12], p0[13]), cvtpk(p0[14], p0[15])};
            pw[2] = (u32x4){cvtpk(p1[0], p1[1]), cvtpk(p1[2], p1[3]), cvtpk(p1[4], p1[5]), cvtpk(p1[6], p1[7])};
            pw[3] = (u32x4){cvtpk(p1[8], p1[9]), cvtpk(p1[10], p1[11]), cvtpk(p1[12], p1[13]), cvtpk(p1[14], p1[15])};
            if (!ABL(1))
#pragma unroll
            for (int i = 0; i < 4 * DVB; ++i) { constexpr int NM = 4 * DVB; const int s_ = i & 3; if (i == 0) ATT_PRIO(1);
                if (i + 3 < NM) ATT_WAIT2(6, vl_[s_], vh_[s_]); else if (i + 3 == NM) ATT_WAIT2(4, vl_[s_], vh_[s_]); else if (i + 2 == NM) ATT_WAIT2(2, vl_[s_], vh_[s_]); else ATT_WAIT2(0, vl_[s_], vh_[s_]);
                const u32x4 vf = (u32x4){vl_[s_][0], vl_[s_][1], vh_[s_][0], vh_[s_][1]};
                o[i >> 2] = __builtin_amdgcn_mfma_f32_32x32x16_bf16(__builtin_bit_cast(bf16x8, vf), __builtin_bit_cast(bf16x8, pw[i & 3]), o[i >> 2], 0, 0, 0);
                if (i + 4 < NM) { ATT_RDTR(vl_[s_], va_, (i + 4) * 1024); ATT_RDTR(vh_[s_], va_, (i + 4) * 1024 + 512); } if (i == NM - 1) ATT_PRIO(0); }
        }
        p0 = n0; p1 = n1; skipC = skipN; maskC = maskN; selC = selN; t = tn; tn = tnn;
    }
#undef ATT_ISSUE_K
#undef ATT_ISSUE_V
#undef ATT_CLASS
#undef ATT_QK
    __builtin_amdgcn_s_setprio(0);
    if (ABL(5)) return;
    f32x4 sg4[DVB][4];
    if constexpr (MODE == 0) {
#pragma unroll
        for (int d0 = 0; d0 < DVB; ++d0)
#pragma unroll
            for (int g = 0; g < 4; ++g) sg4[d0][g] = *(const GAS f32x4*)(A.subln + d0 * 32 + 8 * g + 4 * hi); }
    l = halves_sum(l);
    const float rl = 1.0f / l;
    GAS bf16_t* Ow = (GAS bf16_t*)(A.O + (rowbase + q0 + qrel0 + r32) * PITCH + hcol) + 8 * hi;
#define ATT_STORE_PAIR(d0, gp, V0, V1, V2, V3, W0, W1, W2, W3) do { \
        const unsigned ax_ = cvtpk(V0, V1), ay_ = cvtpk(V2, V3), bx_ = cvtpk(W0, W1), by_ = cvtpk(W2, W3); \
        auto rx_ = __builtin_amdgcn_permlane32_swap(ax_, bx_, false, false); auto ry_ = __builtin_amdgcn_permlane32_swap(ay_, by_, false, false); \
        *(GAS u32x4*)(Ow + (d0) * 32 + 16 * (gp)) = (u32x4){rx_[0], ry_[0], rx_[1], ry_[1]}; } while (0)
    if constexpr (MODE == 1) {
#pragma unroll
        for (int d0 = 0; d0 < DVB; ++d0)
#pragma unroll
            for (int gp = 0; gp < 2; ++gp) ATT_STORE_PAIR(d0, gp, o[d0][8 * gp + 0] * rl, o[d0][8 * gp + 1] * rl, o[d0][8 * gp + 2] * rl, o[d0][8 * gp + 3] * rl,
                                                                 o[d0][8 * gp + 4] * rl, o[d0][8 * gp + 5] * rl, o[d0][8 * gp + 6] * rl, o[d0][8 * gp + 7] * rl);
    } else {
        ATT_BAR();
        LAS float* X = (LAS float*)lds + wq * 4096;
        if (comp == 1) {
#pragma unroll
            for (int d0 = 0; d0 < DVB; ++d0)
#pragma unroll
                for (int r = 0; r < 16; ++r) X[(d0 * 16 + r) * 64 + lane] = o[d0][r] * rl;
        }
        ATT_BAR();
        if (comp == 0) {
            float ss = 0.f;
#pragma unroll
            for (int d0 = 0; d0 < DVB; ++d0)
#pragma unroll
                for (int r = 0; r < 16; ++r) { o[d0][r] = o[d0][r] * rl - A.lam_full * X[(d0 * 16 + r) * 64 + lane]; ss += o[d0][r] * o[d0][r]; }
            ss = halves_sum(ss);
            const float rs = A.out_scale / sqrtf(ss * (1.0f / 128.0f) + 1e-5f);
#pragma unroll
            for (int d0 = 0; d0 < DVB; ++d0)
#pragma unroll
                for (int gp = 0; gp < 2; ++gp) { const f32x4 ga = sg4[d0][2 * gp], gb = sg4[d0][2 * gp + 1];
                    ATT_STORE_PAIR(d0, gp, o[d0][8 * gp + 0] * rs * ga[0], o[d0][8 * gp + 1] * rs * ga[1], o[d0][8 * gp + 2] * rs * ga[2], o[d0][8 * gp + 3] * rs * ga[3],
                                           o[d0][8 * gp + 4] * rs * gb[0], o[d0][8 * gp + 5] * rs * gb[1], o[d0][8 * gp + 6] * rs * gb[2], o[d0][8 * gp + 7] * rs * gb[3]); }
        }
    }
#undef ATT_STORE_PAIR
#undef ATT_KBASE
#undef ATT_KBASE_
#undef ATT_ISSUE
}
#undef ATT_BAR
}

constexpr int NWAVES = 8;
constexpr int NLAYER = 4, PH_PER_LAYER = 8, NPHASE = 1 + NLAYER * PH_PER_LAYER;

constexpr size_t MiB = 1u << 20;
constexpr size_t WS_CTL = 0, CTL_ZERO_BYTES = 1 * MiB;
constexpr size_t WS_KMEAN = 1 * MiB;
constexpr size_t WS_LTOK = 2 * MiB, WS_LW = 3 * MiB;
constexpr size_t WS_DQKV = 5 * MiB;
constexpr size_t WS_DWO = WS_DQKV + 12 * MiB;
constexpr size_t WS_MQKV = WS_DWO + 4 * MiB;
constexpr size_t WS_MWO = WS_MQKV + 12 * MiB;
constexpr size_t WS_FGU = WS_MWO + 4 * MiB;
constexpr size_t WS_FD = WS_FGU + 22 * MiB;
constexpr size_t WS_MGU = WS_FD + 11 * MiB;
constexpr size_t WS_MD = WS_MGU + 112 * MiB;
constexpr size_t WS_XN = WS_MD + 56 * MiB;
constexpr size_t WS_Q = WS_XN + 64 * MiB, WS_K = WS_Q + 64 * MiB, WS_V = WS_K + 64 * MiB;
constexpr size_t WS_ACT = WS_Q;
constexpr size_t WS_END = WS_ACT + (size_t)MOE_TILES_MAX * 256 * DE * 2;
constexpr size_t WS_Y0 = WS_END - 64 * MiB;
constexpr size_t WS_HB = WS_END;
static_assert(WS_XN == 238 * MiB && WS_END == 778 * MiB, "d_ws map");
constexpr int CW_BAR = 4096;
constexpr int CW_ATTQ = 6144;
constexpr int CW_ATTQ2 = 12288;
constexpr int CW_CNT = 8192;

constexpr int RING_OFF = 0, RING_BYTES = 131072;
constexpr int LDSCTL_OFF = RING_BYTES, MISC_OFF = LDSCTL_OFF + 320;
constexpr int XSLOT_OFF = MISC_OFF + 128;
constexpr int LDS_BYTES = 147456;

typedef unsigned short bf16;
typedef unsigned v4u __attribute__((ext_vector_type(4)));
typedef float f32x4 __attribute__((ext_vector_type(4)));
typedef GAS unsigned gu32;
#define RLX_AGENT __ATOMIC_RELAXED, __HIP_MEMORY_SCOPE_AGENT
#define LDS_WAIT() asm volatile("s_waitcnt lgkmcnt(0)" ::: "memory")
#define VM_WAIT() asm volatile("s_waitcnt vmcnt(0)" ::: "memory")
__device__ __forceinline__ unsigned f2bf(float f) { unsigned u = __builtin_bit_cast(unsigned, f); return (u + 0x7fffu + ((u >> 16) & 1u)) >> 16; }
__device__ __forceinline__ unsigned pk2(float lo, float hi) { return f2bf(lo) | (f2bf(hi) << 16); }
__device__ __forceinline__ float bflo(unsigned w) { return __uint_as_float(w << 16); }
__device__ __forceinline__ float bfhi(unsigned w) { return __uint_as_float(w & 0xFFFF0000u); }
static_assert(XSLOT_OFF % 16 == 0 && XSLOT_OFF + 8192 <= LDS_BYTES, "LDS map");
#define XB_TMO      128
#define XB_XCNT(j)  (256  + 64 * (j))
#define XB_XSUB(j)  (1280 + 64 * (j))
#define XB_XGEN(j)  (2304 + 64 * (j))
#define XB_TOP      3328
#define XB_TOPGEN   3392
#define XCD_BAR_WORDS 3456
#define XB_SPIN_CAP (1u << 18)

__device__ __forceinline__ unsigned xb_ld(unsigned* p)              { return __hip_atomic_load(p, __ATOMIC_RELAXED, __HIP_MEMORY_SCOPE_AGENT); }
__device__ __forceinline__ unsigned xb_add(unsigned* p, unsigned v) { return __hip_atomic_fetch_add(p, v, __ATOMIC_RELAXED, __HIP_MEMORY_SCOPE_AGENT); }
__device__ __forceinline__ unsigned xb_xcc_id() { return (unsigned)__builtin_amdgcn_s_getreg((3 << 11) | 20) & 0xFu; }
#define XB_SPIN(cond, bar) do { unsigned _sp = 0; while (cond) { __builtin_amdgcn_s_sleep(1); \
    if ((++_sp & 255u) == 0u) { if (xb_ld(&(bar)[XB_TMO])) break; if (_sp > XB_SPIN_CAP) { atomicAdd(&(bar)[XB_TMO], 1u); break; } } } } while (0)

struct XcdBarrier {
    unsigned* bar; unsigned x;
    volatile LAS unsigned* st;
};

__device__ __forceinline__ XcdBarrier xcd_barrier_post(unsigned* bar, volatile LAS unsigned* st) {
    XcdBarrier b; b.bar = bar; b.x = xb_xcc_id(); b.st = st;
    if (threadIdx.x == 0) (void)xb_add(&bar[XB_XCNT(b.x)], 1u);
    return b;
}
__device__ __forceinline__ void xcd_barrier_complete(unsigned* bar, unsigned x, unsigned& nloc, unsigned& nx) {
    const unsigned G = gridDim.x * gridDim.y * gridDim.z;
    unsigned sum, cnt, mine, sp = 0u;
    for (;;) {
        sum = 0u; cnt = 0u; mine = 0u;
#pragma unroll
        for (unsigned j = 0; j < 16; ++j) { const unsigned c = xb_ld(&bar[XB_XCNT(j)]); sum += c; cnt += (c > 0u) ? 1u : 0u; mine = (j == x) ? c : mine; }
        if (sum == G) break;
        __builtin_amdgcn_s_sleep(1);
        if ((++sp & 255u) == 0u) { if (xb_ld(&bar[XB_TMO])) break; if (sp > XB_SPIN_CAP) { atomicAdd(&bar[XB_TMO], 1u); break; } }
    }
    nloc = mine > 0u ? mine : 1u; nx = cnt > 0u ? cnt : 1u;
}

__device__ __forceinline__ void xcd_barrier(const XcdBarrier& b) {
    asm volatile("s_waitcnt vmcnt(0)" ::: "memory");
    __syncthreads();
    if (threadIdx.x == 0) {
        unsigned* bar = b.bar;
        __builtin_amdgcn_s_waitcnt(0);
        unsigned nloc = b.st[0], nx = b.st[1];
        if (nloc == 0u) { xcd_barrier_complete(bar, b.x, nloc, nx); b.st[0] = nloc; b.st[1] = nx; }
        const unsigned old = xb_add(&bar[XB_XSUB(b.x)], 1u);
        const unsigned gen = old / nloc;
        if (old + 1u == (gen + 1u) * nloc) {
            __builtin_amdgcn_fence(__ATOMIC_RELEASE, "agent");
            asm volatile("s_waitcnt vmcnt(0)" ::: "memory");
            const unsigned og = xb_add(&bar[XB_TOP], 1u);
            const unsigned tg = og / nx;
            if (og + 1u == (tg + 1u) * nx) xb_add(&bar[XB_TOPGEN], 1u);
            else XB_SPIN(xb_ld(&bar[XB_TOPGEN]) == tg, bar);
            __builtin_amdgcn_fence(__ATOMIC_ACQUIRE, "agent");
            xb_add(&bar[XB_XGEN(b.x)], 1u);
            asm volatile("s_waitcnt vmcnt(0)" ::: "memory");
        } else {
            XB_SPIN(xb_ld(&bar[XB_XGEN(b.x)]) == gen, bar);
            __builtin_amdgcn_fence(__ATOMIC_ACQUIRE, "agent");
            asm volatile("s_waitcnt vmcnt(0)" ::: "memory");
        }
    }
    __syncthreads();
}

struct Frame {
    LAS unsigned char* lds;
    volatile LAS unsigned* MISC;
    gu32* ctl;
    int tid, lane, wave;
    int vcu, G;
};
__device__ __forceinline__ float wave_sum(float v) {
    v += __int_as_float(__builtin_amdgcn_update_dpp(0, __float_as_int(v), 0xB1, 0xF, 0xF, true));
    v += __int_as_float(__builtin_amdgcn_update_dpp(0, __float_as_int(v), 0x4E, 0xF, 0xF, true));
    v += __int_as_float(__builtin_amdgcn_update_dpp(0, __float_as_int(v), 0x141, 0xF, 0xF, true));
    v += __int_as_float(__builtin_amdgcn_update_dpp(0, __float_as_int(v), 0x140, 0xF, 0xF, true));
    v += __int_as_float(__builtin_amdgcn_ds_swizzle(__float_as_int(v), 0x401F));
    auto rr = __builtin_amdgcn_permlane32_swap(__float_as_uint(v), __float_as_uint(v), false, false);
    return __uint_as_float(rr[0]) + __uint_as_float(rr[1]);
}
__device__ __forceinline__ void transpose_item(const float* W, int K, int N, void* WT, int k0, int n0, int drow0, LAS float* scr, int lane, bool f8, float wscale) {
    const GAS float* src = (const GAS float*)W + (size_t)k0 * N + n0 + lane;
#pragma unroll
    for (int hb = 0; hb < 2; ++hb) { float v[32];
#pragma unroll
        for (int i = 0; i < 32; ++i) v[i] = src[(size_t)(hb * 32 + i) * N];
#pragma unroll
        for (int i = 0; i < 32; ++i) { const int kk = hb * 32 + i; scr[kk * 64 + (lane ^ ((kk >> 3) << 3))] = v[i]; } }
    LDS_WAIT(); asm volatile("" ::: "memory");
    if (f8) {
        const int c = lane & 3;
#pragma unroll
        for (int j = 0; j < 4; ++j) { const int nn = (lane >> 2) + 16 * j; float v[16];
#pragma unroll
            for (int q = 0; q < 16; ++q) { const int kk = 16 * c + q; v[q] = scr[kk * 64 + (nn ^ ((kk >> 3) << 3))] * wscale; }
            v4u o; o.x = pg8::pk4_fp8(v[0], v[1], v[2], v[3]); o.y = pg8::pk4_fp8(v[4], v[5], v[6], v[7]); o.z = pg8::pk4_fp8(v[8], v[9], v[10], v[11]); o.w = pg8::pk4_fp8(v[12], v[13], v[14], v[15]);
            *(GAS v4u*)((unsigned char*)WT + (size_t)(drow0 + nn) * K + k0 + 16 * c) = o; }
    } else {
    const int c = lane & 7;
#pragma unroll
    for (int j = 0; j < 8; ++j) { const int n = (lane >> 3) + 8 * j; const LAS float* s = scr + (8 * c) * 64 + (n ^ (c << 3));
        v4u o; o.x = pk2(s[0 * 64], s[1 * 64]); o.y = pk2(s[2 * 64], s[3 * 64]); o.z = pk2(s[4 * 64], s[5 * 64]); o.w = pk2(s[6 * 64], s[7 * 64]);
        *(GAS v4u*)((bf16*)WT + (size_t)(drow0 + n) * K + k0 + 8 * c) = o; }
    }
    LDS_WAIT(); asm volatile("" ::: "memory");
}
__device__ __forceinline__ void convert_matrix(Frame& F, const float* W, int K, int N, void* WT, int il, unsigned& rot, bool f8 = false, float wscale = 1.0f) {
    LAS float* scr = (LAS float*)(F.lds + RING_OFF + F.wave * 16384);
    const unsigned gw = (unsigned)(F.vcu * NWAVES + F.wave), NGW = (unsigned)(F.G * NWAVES);
    const int nblk = N / 64, nitems = (K / 64) * nblk; int lane_ = F.lane; asm volatile("" : "+v"(lane_));
    for (int it = (int)((gw + NGW - rot % NGW) % NGW); it < nitems; it += (int)NGW) {
        const int kb = it / nblk, nb = it % nblk, n0 = 64 * nb;
        const int drow0 = il == 0 ? n0 : (n0 / 128) * 256 + (il - 1) * 128 + (n0 % 128);
        transpose_item(W, K, N, WT, 64 * kb, n0, drow0, scr, lane_, f8, wscale);
    }
    rot = (rot + (unsigned)nitems) % NGW;
}

struct RouterArgs { const float* router; gu32* cnt; unsigned* ltok; float* lw; };
template <int MODE, bool F8X = false, bool SF32 = false>
__device__ __forceinline__ void norm_phase(Frame& F, const void* src, bf16* hout, const bf16* y1, const float* gain, bf16* xn, float* fout, const RouterArgs& R, const bf16* y0 = nullptr) {
    int lane_ = F.lane; asm volatile("" : "+v"(lane_));
    const int gw = F.vcu * NWAVES + F.wave, NGW = F.G * NWAVES, lane = lane_;
    f32x4 gv[4];
#pragma unroll
    for (int j = 0; j < 4; ++j) gv[j] = *(const GAS f32x4*)(gain + 256 * j + 4 * lane);
    LAS float* RL = (LAS float*)(F.lds + RING_OFF);
    if constexpr (MODE == 2) {
        int tid_ = F.tid; asm volatile("" : "+v"(tid_));
        for (int i = tid_; i < 8192; i += NWAVES * 64) RL[(i & 7) * 1024 + (i >> 3)] = ((const GAS float*)R.router)[i];
        LDS_WAIT(); __syncthreads();
    }
    const int nrows_w = gw < MTOK ? (MTOK - gw + NGW - 1) / NGW : 0;
    for (int cb = 0; cb < nrows_w; cb += 64) {
        int my_t = 0, my_e0 = 0, my_e1 = 0; float my_w0 = 0.f, my_w1 = 0.f; bool valid = false;
        const int cn = (nrows_w - cb) < 64 ? (nrows_w - cb) : 64;
        f32x4 vn[4]; unsigned long long yn[4], zn[4];
        unsigned long long hn[4];
        { const int row0_ = gw + cb * NGW;
          if constexpr (SF32) { const GAS f32x4* xr = (const GAS f32x4*)((const float*)src + (size_t)row0_ * D) + lane;
#pragma unroll
            for (int j = 0; j < 4; ++j) vn[j] = xr[64 * j];
          } else { const GAS unsigned long long* hr_ = (const GAS unsigned long long*)((const bf16*)src + (size_t)row0_ * D) + lane;
#pragma unroll
            for (int j = 0; j < 4; ++j) hn[j] = hr_[64 * j]; }
          if constexpr (MODE == 1 || MODE == 3) { const GAS unsigned long long* yr = (const GAS unsigned long long*)(y1 + (size_t)row0_ * D) + lane, *zr = (const GAS unsigned long long*)(y0 + (size_t)row0_ * D) + lane;
#pragma unroll
            for (int j = 0; j < 4; ++j) { yn[j] = yr[64 * j]; zn[j] = zr[64 * j]; } } }
        for (int i = 0; i < cn; ++i) {
            const int row = gw + (cb + i) * NGW;
            f32x4 v[4]; float s = 0.f;
#pragma unroll
            for (int j = 0; j < 4; ++j) { if constexpr (SF32) v[j] = vn[j]; else { const unsigned long long w = hn[j]; const unsigned lo = (unsigned)w, hi = (unsigned)(w >> 32); v[j] = (f32x4){bflo(lo), bfhi(lo), bflo(hi), bfhi(hi)}; } }
            if constexpr (MODE == 1 || MODE == 3) {
#pragma unroll
                for (int j = 0; j < 4; ++j) { const unsigned long long w = yn[j], z = zn[j]; const unsigned lo = (unsigned)w, hi = (unsigned)(w >> 32), zl = (unsigned)z, zh = (unsigned)(z >> 32);
                    v[j].x += bflo(zl) + bflo(lo); v[j].y += bfhi(zl) + bfhi(lo); v[j].z += bflo(zh) + bflo(hi); v[j].w += bfhi(zh) + bfhi(hi); }
            }
            if (i + 1 < cn) { const int rown = row + NGW;
                if constexpr (SF32) { const GAS f32x4* xr = (const GAS f32x4*)((const float*)src + (size_t)rown * D) + lane;
#pragma unroll
                    for (int j = 0; j < 4; ++j) vn[j] = xr[64 * j];
                } else { const GAS unsigned long long* hr_ = (const GAS unsigned long long*)((const bf16*)src + (size_t)rown * D) + lane;
#pragma unroll
                    for (int j = 0; j < 4; ++j) hn[j] = hr_[64 * j]; }
                if constexpr (MODE == 1 || MODE == 3) { const GAS unsigned long long* yr = (const GAS unsigned long long*)(y1 + (size_t)rown * D) + lane, *zr = (const GAS unsigned long long*)(y0 + (size_t)rown * D) + lane;
#pragma unroll
                    for (int j = 0; j < 4; ++j) { yn[j] = yr[64 * j]; zn[j] = zr[64 * j]; } } }
#pragma unroll
            for (int j = 0; j < 4; ++j) s += (v[j].x * v[j].x + v[j].y * v[j].y) + (v[j].z * v[j].z + v[j].w * v[j].w);
            if constexpr (MODE == 1) { GAS unsigned long long* hr = (GAS unsigned long long*)(hout + (size_t)row * D) + lane;
#pragma unroll
                for (int j = 0; j < 4; ++j) { const unsigned long long hw = (unsigned long long)pk2(v[j].x, v[j].y) | ((unsigned long long)pk2(v[j].z, v[j].w) << 32); hr[64 * j] = hw;
                    v[j] = (f32x4){bflo((unsigned)hw), bfhi((unsigned)hw), bflo((unsigned)(hw >> 32)), bfhi((unsigned)(hw >> 32))}; } }
            const float rstd = 1.f / sqrtf(wave_sum(s) * (1.f / D) + 1e-6f);
#pragma unroll
            for (int j = 0; j < 4; ++j) v[j] = v[j] * rstd * gv[j];
            if constexpr (MODE == 3) { GAS f32x4* orow = (GAS f32x4*)(fout + (size_t)row * D) + lane;
#pragma unroll
                for (int j = 0; j < 4; ++j) orow[64 * j] = v[j];
            } else {
                if constexpr (F8X) { GAS unsigned* o4 = (GAS unsigned*)((unsigned char*)xn + (size_t)row * D) + lane;
#pragma unroll
                    for (int j = 0; j < 4; ++j) o4[64 * j] = pg8::pk4_fp8(v[j].x, v[j].y, v[j].z, v[j].w);
                } else { GAS unsigned long long* o8 = (GAS unsigned long long*)(xn + (size_t)row * D) + lane;
#pragma unroll
                    for (int j = 0; j < 4; ++j) o8[64 * j] = (unsigned long long)pk2(v[j].x, v[j].y) | ((unsigned long long)pk2(v[j].z, v[j].w) << 32); }
            }
            if constexpr (MODE == 2) {
                float lg[NE];
#pragma unroll
                for (int e = 0; e < NE; ++e) { float a = 0.f;
#pragma unroll
                    for (int j = 0; j < 4; ++j) { const f32x4 rr = *(const LAS f32x4*)(RL + e * 1024 + 256 * j + 4 * lane); a += (v[j].x * rr.x + v[j].y * rr.y) + (v[j].z * rr.z + v[j].w * rr.w); }
                    lg[e] = wave_sum(a); }
                int e0 = 0; float v0 = lg[0];
#pragma unroll
                for (int e = 1; e < NE; ++e) if (lg[e] > v0) { v0 = lg[e]; e0 = e; }
                int e1 = -1; float v1 = 0.f;
#pragma unroll
                for (int e = 0; e < NE; ++e) if (e != e0 && (e1 < 0 || lg[e] > v1)) { v1 = lg[e]; e1 = e; }
                const float w0 = 1.f / (1.f + __expf(v1 - v0));
                if (lane == i) { my_t = row; my_e0 = e0; my_e1 = e1; my_w0 = w0; my_w1 = 1.f - w0; valid = true; }
            }
        }
        if constexpr (MODE == 2) {
            unsigned myc = 0u;
#pragma unroll
            for (int e = 0; e < NE; ++e) { const unsigned long long b0 = __ballot(valid && my_e0 == e), b1 = __ballot(valid && my_e1 == e);
                const unsigned c = (unsigned)(__popcll(b0) + __popcll(b1)); if (lane == e) myc = c; }
            unsigned basev = 0u;
            if (lane < NE) basev = __hip_atomic_fetch_add(R.cnt + 64 * lane, myc, RLX_AGENT);
            const unsigned long long lt = (1ull << lane) - 1ull;
            unsigned pos0 = 0u, pos1 = 0u;
#pragma unroll
            for (int e = 0; e < NE; ++e) { const unsigned long long b0 = __ballot(valid && my_e0 == e), b1 = __ballot(valid && my_e1 == e);
                const unsigned be = (unsigned)__shfl((int)basev, e);
                if (my_e0 == e) pos0 = be + (unsigned)__popcll(b0 & lt);
                if (my_e1 == e) pos1 = be + (unsigned)__popcll(b0) + (unsigned)__popcll(b1 & lt); }
            if (valid) {
                ((GAS unsigned*)R.ltok)[(size_t)my_e0 * LIST_CAP + pos0] = (unsigned)my_t;             ((GAS float*)R.lw)[(size_t)my_e0 * LIST_CAP + pos0] = my_w0;
                ((GAS unsigned*)R.ltok)[(size_t)my_e1 * LIST_CAP + pos1] = (unsigned)my_t | (1u << 20); ((GAS float*)R.lw)[(size_t)my_e1 * LIST_CAP + pos1] = my_w1;
            }
        }
    }
    if constexpr (MODE == 2) { LDS_WAIT(); __syncthreads(); }
}

__device__ __forceinline__ void kstat_phase(Frame& F, const bf16* Kt, float* kmean, float* kmax2) {
    int lane_ = F.lane; asm volatile("" : "+v"(lane_));
    const int gw = F.vcu * NWAVES + F.wave, NGW = F.G * NWAVES, lane = lane_;
    for (int task = gw; task < BATCH * 16 * 16; task += NGW) {
        const int hh = task & 15, n = (task >> 4) & 15, b = task >> 8, l5 = lane & 31, hf = lane >> 5;
        const GAS unsigned* p = (const GAS unsigned*)(Kt + ((size_t)b * SEQ + 256 * n + 128 * hf) * D + hh * 64) + l5;
        float a0 = 0.f, a1 = 0.f, mx = 0.f;
#pragma unroll 32
        for (int r = 0; r < 128; ++r) { const unsigned w = p[(size_t)r * (D / 2)]; const float v0 = bflo(w), v1 = bfhi(w); a0 += v0; a1 += v1;
            float s = v0 * v0 + v1 * v1;
            s += __int_as_float(__builtin_amdgcn_update_dpp(0, __float_as_int(s), 0xB1, 0xF, 0xF, true)); s += __int_as_float(__builtin_amdgcn_update_dpp(0, __float_as_int(s), 0x4E, 0xF, 0xF, true));
            s += __int_as_float(__builtin_amdgcn_update_dpp(0, __float_as_int(s), 0x141, 0xF, 0xF, true)); s += __int_as_float(__builtin_amdgcn_update_dpp(0, __float_as_int(s), 0x140, 0xF, 0xF, true));
            s += __int_as_float(__builtin_amdgcn_ds_swizzle(__float_as_int(s), 0x401F)); mx = fmaxf(mx, s); }
        { auto r0 = __builtin_amdgcn_permlane32_swap(__float_as_uint(a0), __float_as_uint(a0), false, false); a0 = __uint_as_float(r0[0]) + __uint_as_float(r0[1]);
          auto r1 = __builtin_amdgcn_permlane32_swap(__float_as_uint(a1), __float_as_uint(a1), false, false); a1 = __uint_as_float(r1[0]) + __uint_as_float(r1[1]);
          auto r2 = __builtin_amdgcn_permlane32_swap(__float_as_uint(mx), __float_as_uint(mx), false, false); mx = fmaxf(__uint_as_float(r2[0]), __uint_as_float(r2[1])); }
        if (hf == 0) { GAS float* o = (GAS float*)(kmean + ((size_t)(b * 16 + hh) * 16 + n) * 64 + 2 * l5);
            o[0] = a0 * (1.f / 256.f); o[1] = a1 * (1.f / 256.f); }
        if (lane == 0) ((GAS float*)kmax2)[(size_t)(b * 16 + hh) * 16 + n] = mx;
    }
}

struct KArgs { const float* in[17]; float* out; unsigned char* ws; int ph_lo, ph_hi; };
struct ConvDesc { const float* W; int K, N; unsigned char* WT; int il; bool f8; float sc; };
constexpr int NCONV = 61, CONV_CH = 128;
__device__ __forceinline__ ConvDesc conv_desc(const KArgs& args, unsigned char* ws, int m) {
    constexpr float WSC_UP = 32.0f, WSC_DN = 64.0f;
    ConvDesc d; d.il = 0; d.f8 = false; d.sc = 1.0f;
    if (m < 2) { d.W = args.in[7] + (size_t)m * D * 3 * D; d.K = D; d.N = 3 * D; d.WT = ws + WS_MQKV + (size_t)m * 3 * D * D * 2; }
    else if (m < 4) { const int j = m - 2; d.W = args.in[8] + (size_t)j * D * D; d.K = D; d.N = D; d.WT = ws + WS_MWO + (size_t)j * D * D * 2; }
    else if (m == 4) { d.W = args.in[4]; d.K = D; d.N = D; d.WT = ws + WS_DWO; }
    else if (m == 5) { d.W = args.in[3] + (size_t)D * 3 * D; d.K = D; d.N = 3 * D; d.WT = ws + WS_DQKV + (size_t)3 * D * D * 2; }
    else if (m == 6) { d.W = args.in[4] + (size_t)D * D; d.K = D; d.N = D; d.WT = ws + WS_DWO + (size_t)D * D * 2; }
    else if (m < 13) { const int r = m - 7, j = r / 3, t = r % 3; d.f8 = (j == 1);
        if (t < 2) { d.W = args.in[9 + t] + (size_t)j * D * DFF; d.K = D; d.N = DFF; d.WT = ws + WS_FGU + (size_t)j * 2 * DFF * D * 2; d.il = 1 + t; d.sc = d.f8 ? WSC_UP : 1.0f; }
        else { d.W = args.in[11] + (size_t)j * DFF * D; d.K = DFF; d.N = D; d.WT = ws + WS_FD + (size_t)j * D * DFF * 2; d.sc = d.f8 ? WSC_DN : 1.0f; } }
    else { const int r = m - 13, e = r / 3, t = r % 3; d.f8 = true;
        if (t < 2) { d.W = args.in[13 + t] + (size_t)e * D * DE; d.K = D; d.N = DE; d.WT = ws + WS_MGU + (size_t)e * 2 * DE * D; d.il = 1 + t; d.sc = WSC_UP; }
        else { d.W = args.in[15] + (size_t)e * DE * D; d.K = DE; d.N = D; d.WT = ws + WS_MD + (size_t)e * D * DE; d.sc = WSC_DN; } }
    return d;
}
__device__ __forceinline__ int conv_chunks_of(int m) { const int items = m < 2 || m == 5 ? 768 : (m < 7 ? 256 : (m < 13 ? 704 : 896)); return (items + CONV_CH - 1) / CONV_CH; }
__device__ __forceinline__ int conv_total_chunks() { int s = 0; for (int m = 0; m < NCONV; ++m) s += conv_chunks_of(m); return s; }
__device__ __forceinline__ void conv_chunk(Frame& F, const KArgs& args, unsigned char* ws, int c) {
    int m = 0; for (; m < NCONV; ++m) { const int n = conv_chunks_of(m); if (c < n) break; c -= n; }
    const ConvDesc d = conv_desc(args, ws, m);
    LAS float* scr = (LAS float*)(F.lds + RING_OFF + F.wave * 16384);
    int lane_ = F.lane; asm volatile("" : "+v"(lane_));
    const int nblk = d.N / 64, nitems = (d.K / 64) * nblk, last = (c + 1) * CONV_CH < nitems ? (c + 1) * CONV_CH : nitems;
    for (int it = c * CONV_CH + F.wave; it < last; it += NWAVES) {
        const int kb = it / nblk, nb = it % nblk, n0 = 64 * nb;
        const int drow0 = d.il == 0 ? n0 : (n0 / 128) * 256 + (d.il - 1) * 128 + (n0 % 128);
        transpose_item(d.W, d.K, d.N, d.WT, 64 * kb, n0, drow0, scr, lane_, d.f8, d.sc);
    }
}

__global__ void __launch_bounds__(NWAVES * 64, 2) trunk_fwd(KArgs args) {
    extern __shared__ __attribute__((aligned(16))) unsigned char lds[];
    Frame F;
    F.lds = (LAS unsigned char*)lds;
    F.MISC = (volatile LAS unsigned*)(F.lds + MISC_OFF);
    F.tid = threadIdx.x; F.lane = F.tid & 63; F.wave = __builtin_amdgcn_readfirstlane(F.tid >> 6);
    F.G = gridDim.x; { const int bx = blockIdx.x; F.vcu = (F.G % 8 == 0) ? (bx % 8) * (F.G / 8) + bx / 8 : bx; }
    F.ctl = (gu32*)(args.ws + WS_CTL);
    for (int u = F.tid; u < (LDS_BYTES - LDSCTL_OFF) / 4; u += NWAVES * 64) ((LAS unsigned*)(F.lds + LDSCTL_OFF))[u] = 0u;
    __syncthreads();
    Frame& F0 = F;
    const int lo = args.ph_lo, hi = args.ph_hi;
    XcdBarrier bar; bar.bar = (unsigned*)(F.ctl + CW_BAR); bar.x = 0; bar.st = nullptr;
    if (hi - lo > 1) bar = xcd_barrier_post((unsigned*)(F.ctl + CW_BAR), F.MISC + 8);
#define IN(k) (lo <= (k) && (k) < hi)
#ifndef PH_ENABLE
#define PH_ENABLE 0xFFFFFFFFu
#endif
#define PHEN(n) (((PH_ENABLE) >> (n)) & 1u)
#ifndef MK_DOUBLE
#define MK_DOUBLE 0u
#endif
#define NREP(n) ((((MK_DOUBLE) >> (n)) & 1u) ? 2 : 1)
#if defined(NO_OPQ)
#define OPQ(p) do {} while (0)
#else
#define OPQ(p) asm volatile("" : "+s"(p))
#endif
#if 0
#define STAMP(k) do { if (blockIdx.x == 0 && threadIdx.x == 0) { const unsigned long long t_ = __builtin_amdgcn_s_memrealtime(); ((GAS unsigned*)(F0.ctl))[3000 + (k)] = (unsigned)t_; } } while (0)
#else
#define STAMP(k) do {} while (0)
#endif
#define SEAM(k) do { if (IN(k) && IN((k) + 1)) { XcdBarrier b2_ = bar; OPQ(b2_.bar); xcd_barrier(b2_); } STAMP((k) + 1); } while (0)

#define PTRS() unsigned char* ws = args.ws; OPQ(ws); const float* x = args.in[0]; OPQ(x); const float* norm_mix = args.in[1]; OPQ(norm_mix); const float* norm_ffn = args.in[2]; OPQ(norm_ffn); \
    bf16* h = (bf16*)(ws + WS_HB); \
    bf16* XN = (bf16*)(ws + WS_XN); bf16* Qb = (bf16*)(ws + WS_Q); bf16* Kb = (bf16*)(ws + WS_K); bf16* Vb = (bf16*)(ws + WS_V); bf16* ACT = (bf16*)(ws + WS_ACT); \
    bf16* MGU = (bf16*)(ws + WS_MGU); bf16* MD = (bf16*)(ws + WS_MD); \
    float* kmean = (float*)(ws + WS_KMEAN); unsigned* ltok = (unsigned*)(ws + WS_LTOK); float* lw = (float*)(ws + WS_LW); \
    (void)x; (void)norm_mix; (void)norm_ffn; (void)h; (void)XN; (void)Qb; (void)Kb; (void)Vb; (void)ACT; (void)MGU; (void)MD; (void)kmean; (void)ltok; (void)lw
    const RouterArgs noR{nullptr, nullptr, nullptr, nullptr};
#ifndef MK_F8_DENSE
#define MK_F8_DENSE 0
#endif
    constexpr bool F8_DENSE = MK_F8_DENSE != 0; constexpr int DESZ = F8_DENSE ? 1 : 2;
    constexpr float WSC_UP = 32.0f, WSC_DN = 64.0f;
    constexpr float C2 = 0.125f * 1.4426950408889634f;

    STAMP(0);
    if (PHEN(0) && IN(0)) {
        PTRS();
        { unsigned rot = 0u;
        convert_matrix(F, args.in[3], D, 3 * D, ws + WS_DQKV, 0, rot);
        norm_phase<0, false, true>(F, x, nullptr, nullptr, norm_mix, XN, nullptr, noR);
        }
    }
    SEAM(0);

    for (int L = 0; L < NLAYER; ++L) {
        const int j = L >> 1, moba = L & 1, pb = 1 + PH_PER_LAYER * L;
        int z_ = 0;
#if !defined(NO_OPQ_Z)
        asm volatile("" : "+s"(z_));
#endif
        Frame Fl = F0; Fl.G += z_; Fl.vcu += z_; Fl.wave += z_; Fl.lds += z_; Fl.ctl += z_; const int bx = (int)blockIdx.x + z_;
#define F Fl
        if (PHEN(1) && IN(pb + 0)) {
            PTRS();

            const bf16* W = (const bf16*)(ws + (moba ? WS_MQKV : WS_DQKV)) + (size_t)j * 3 * D * D;
            pg8::Gemm g{XN, W, 2 * D, 0}; pg8::StaticOrder S; S.init(MTOK, 3 * D, F.G, bx);
            pg8::EpiQKV E{Qb, D, D, (size_t)(WS_K - WS_Q) / 2, C2};
            for (int rep_ = 0; rep_ < NREP(1); ++rep_) pg8::gemm_phase<pg8::EpiQKV, pg8::StaticOrder>(F.lds + RING_OFF, XSLOT_OFF, g, S, E);
        }
        SEAM(pb + 0);
        { if (PHEN(2) && IN(pb + 1)) { PTRS(); kstat_phase(F, Kb, kmean, kmean + 8 * 16 * 16 * 64); } SEAM(pb + 1); }
        if (IN(pb + 2)) {
            PTRS();
            att::Args A; A.Q = Qb; A.K = Kb; A.V = Vb; A.O = XN; A.kmean = kmean; A.kmax2 = kmean + 8 * 16 * 16 * 64; A.subln = args.in[6] + (size_t)j * 128; A.lam_full = 0.f; A.out_scale = 1.f; A.abl = 0;
            LAS int* qw;
            if (!moba) {
                const float* lam = args.in[5] + (size_t)j * 256; int lane = F.lane; asm volatile("" : "+v"(lane));
                const GAS float* lamg = (const GAS float*)lam; const float s1 = wave_sum(lamg[lane] * lamg[64 + lane]), s2 = wave_sum(lamg[128 + lane] * lamg[192 + lane]);
                const float lam_init = (L == 0) ? 0.2f : 0.47071302f;
                A.lam_full = __uint_as_float(__builtin_amdgcn_readfirstlane(__float_as_uint(__expf(s1) - __expf(s2) + lam_init))); A.out_scale = __uint_as_float(__builtin_amdgcn_readfirstlane(__float_as_uint(1.0f - lam_init)));
            }
            const int nconv = (L == 0) ? conv_total_chunks() : 0;
            qw = (LAS int*)(F.lds + XSLOT_OFF);
            const int xme = (int)(xb_xcc_id() & 7u);
            if ((PHEN(3) && !moba) || (PHEN(4) && moba)) for (int rep_ = 0; rep_ < (moba ? NREP(4) : NREP(3)); ++rep_) for (int xq = xme;;) {
#if ATT_ABLATE
                { const bool ab_ = rep_ == 0 && (moba ? NREP(4) : NREP(3)) == 2; A.abl = ab_ ? ATT_ABLATE : 0; A.O = ab_ ? (bf16*)(ws + WS_END) : XN; }
#endif
                const int ncx = (nconv && rep_ == 0) ? ((nconv - xq + 7) >> 3) : 0;
                gu32* qb = F.ctl + CW_ATTQ2 + 256 * L + 1024 * rep_; gu32* qx = qb + 32 * xq;
                for (;;) {
                    if (F.tid == 0) *qw = (int)__hip_atomic_fetch_add(qx, 1u, RLX_AGENT);
                    asm volatile("s_waitcnt vmcnt(0) lgkmcnt(0)\n\ts_barrier" ::: "memory");
                    int idx = __builtin_amdgcn_readfirstlane(*qw);
                    if (idx >= 128 + ncx) { asm volatile("s_waitcnt vmcnt(0) lgkmcnt(0)\n\ts_barrier" ::: "memory"); break; }
                    if (ncx) { const int q3 = idx / 3; if (idx < 3 * ncx) { if (idx - 3 * q3 == 2) { conv_chunk(F, args, ws, xq + 8 * q3); asm volatile("s_waitcnt vmcnt(0) lgkmcnt(0)\n\ts_barrier" ::: "memory"); continue; } idx -= q3; } else idx -= ncx; }
                    if (!moba) { const int hh = 7 - (idx >> 4), pr = idx & 15;
                        att::attn_unit<0>(F.lds + RING_OFF, A, xq, hh, pr);
                        att::attn_unit<0>(F.lds + RING_OFF, A, xq, hh, 31 - pr);
                    } else { const int hh = 15 - (idx >> 3), pr = idx & 7;
                        att::attn_unit<1>(F.lds + RING_OFF, A, xq, hh, pr);
                        att::attn_unit<1>(F.lds + RING_OFF, A, xq, hh, 15 - pr); }
                }
                if (F.tid < 64) { int lane = F.tid; asm volatile("" : "+v"(lane)); bool av = false;
                    if (lane < 8) { const int lim = 128 + ((nconv && rep_ == 0) ? ((nconv - lane + 7) >> 3) : 0); av = (int)__hip_atomic_load(qb + 32 * lane, RLX_AGENT) < lim; }
                    const unsigned long long m_ = __ballot(av);
                    if (lane == 0) *qw = (int)(unsigned)m_; }
                asm volatile("s_waitcnt vmcnt(0) lgkmcnt(0)\n\ts_barrier" ::: "memory");
                const unsigned m = (unsigned)__builtin_amdgcn_readfirstlane(*qw);
                asm volatile("s_waitcnt vmcnt(0) lgkmcnt(0)\n\ts_barrier" ::: "memory");
                if (m == 0u) break;
                const unsigned rot = ((m >> xme) | (m << (8 - xme))) & 0xFFu;
                xq = (xme + __builtin_ctz(rot)) & 7;
            }
            asm volatile("s_waitcnt vmcnt(0) lgkmcnt(0)\n\ts_barrier" ::: "memory");
        }
        SEAM(pb + 2);
        if (PHEN(5) && IN(pb + 3)) {
            PTRS();
            const bf16* W = (const bf16*)(ws + (moba ? WS_MWO : WS_DWO)) + (size_t)j * D * D;
            pg8::Gemm g{XN, W, 2 * D, 0}; pg8::StaticOrder S; S.init(MTOK, D, F.G, bx);
            if (L == 0) { pg8::EpiRes<true> E{x, h, D, 1.0f}; pg8::gemm_phase<pg8::EpiRes<true>, pg8::StaticOrder>(F.lds + RING_OFF, XSLOT_OFF, g, S, E); }
            else { pg8::EpiRes<false> E{h, h, D, 1.0f}; pg8::gemm_phase<pg8::EpiRes<false>, pg8::StaticOrder>(F.lds + RING_OFF, XSLOT_OFF, g, S, E); }
        }
        SEAM(pb + 3);
        if (PHEN(6) && IN(pb + 4)) {
            PTRS();
            if (!moba) {
                if (L == 2) norm_phase<0, true>(F, h, nullptr, nullptr, norm_ffn + (size_t)L * D, XN, nullptr, noR);
                else norm_phase<0, false>(F, h, nullptr, nullptr, norm_ffn + (size_t)L * D, XN, nullptr, noR);
            } else {
                const RouterArgs R{args.in[12] + (size_t)j * D * NE, F.ctl + CW_CNT + 64 * NE * j, ltok, lw};
                norm_phase<2, true>(F, h, nullptr, nullptr, norm_ffn + (size_t)L * D, XN, nullptr, R);
            }
        }
        SEAM(pb + 4);
        if (IN(pb + 5)) {
            PTRS();
            if (PHEN(7) && !moba) {
                if (L == 2) { pg8::Gemm g{XN, ws + WS_FGU + (size_t)j * 2 * DFF * D * 2, D, 0}; pg8::StaticOrder S; S.init(MTOK, 2 * DFF, F.G, bx);
                    pg8::EpiSwiGLU<true> E{ACT, DFF, 1.0f / WSC_UP};
                    pg8::gemm_phase<pg8::EpiSwiGLU<true>, pg8::StaticOrder, true>(F.lds + RING_OFF, XSLOT_OFF, g, S, E);
                } else { pg8::Gemm g{XN, ws + WS_FGU + (size_t)j * 2 * DFF * D * 2, 2 * D, 0}; pg8::StaticOrder S; S.init(MTOK, 2 * DFF, F.G, bx);
                    pg8::EpiSwiGLU<false> E{ACT, DFF, 1.0f};
                    pg8::gemm_phase<pg8::EpiSwiGLU<false>, pg8::StaticOrder, false>(F.lds + RING_OFF, XSLOT_OFF, g, S, E); }
            } else if (PHEN(8) && moba) {
                pg8::Gemm g{XN, ws + WS_MGU + (size_t)j * NE * 2 * DE * D, D, (size_t)2 * DE * D}; pg8::MoeOrder S; S.init((const unsigned*)(F.ctl + CW_CNT + 64 * NE * j), ltok, true, 2 * DE, F.G, bx);
                pg8::EpiSwiGLU<true> E{ACT, DE, 1.0f / WSC_UP};
                pg8::gemm_phase<pg8::EpiSwiGLU<true>, pg8::MoeOrder, true>(F.lds + RING_OFF, XSLOT_OFF, g, S, E);
            }
        }
        SEAM(pb + 5);
        if (IN(pb + 6)) {
            PTRS();
            if (PHEN(9) && !moba) {
                if (L == 2) { pg8::Gemm g{ACT, ws + WS_FD + (size_t)j * D * DFF * 2, DFF, 0}; pg8::StaticOrder S; S.init(MTOK, D, F.G, bx);
                    pg8::EpiRes<false> E{h, h, D, 1.0f / WSC_DN};
                    pg8::gemm_phase<pg8::EpiRes<false>, pg8::StaticOrder, true>(F.lds + RING_OFF, XSLOT_OFF, g, S, E);
                } else { pg8::Gemm g{ACT, ws + WS_FD + (size_t)j * D * DFF * 2, 2 * DFF, 0}; pg8::StaticOrder S; S.init(MTOK, D, F.G, bx);
                    pg8::EpiRes<false> E{h, h, D, 1.0f};
                    pg8::gemm_phase<pg8::EpiRes<false>, pg8::StaticOrder, false>(F.lds + RING_OFF, XSLOT_OFF, g, S, E); }
            } else if (PHEN(10) && moba) {
                pg8::Gemm g{ACT, ws + WS_MD + (size_t)j * NE * D * DE, DE, (size_t)D * DE}; pg8::MoeOrder S; S.init((const unsigned*)(F.ctl + CW_CNT + 64 * NE * j), ltok, false, D, F.G, bx);
                pg8::EpiMoeDown E; E.y0 = (bf16*)(ws + WS_Y0); E.y1 = XN; E.list_tok = ltok; E.list_w = lw; E.sc = 1.0f / WSC_DN;
#pragma unroll
                for (int e = 0; e < NE; ++e) E.cnt[e] = S.cnt[e];
                pg8::gemm_phase<pg8::EpiMoeDown, pg8::MoeOrder, true>(F.lds + RING_OFF, XSLOT_OFF, g, S, E);
            }
        }
        SEAM(pb + 6);
        if (PHEN(11) && IN(pb + 7)) {
            PTRS();
            if (L == 3) norm_phase<3>(F, h, nullptr, XN, args.in[16], nullptr, args.out, noR, (const bf16*)(ws + WS_Y0));
            else if (moba) norm_phase<1>(F, h, h, XN, norm_mix + (size_t)(L + 1) * D, XN, nullptr, noR, (const bf16*)(ws + WS_Y0));
            else for (int rep_ = 0; rep_ < NREP(11); ++rep_) norm_phase<0>(F, h, nullptr, nullptr, norm_mix + (size_t)(L + 1) * D, XN, nullptr, noR);
        }
        if (L != NLAYER - 1) SEAM(pb + 7); else STAMP(pb + 8);
#undef F
    }
#undef IN
#undef SEAM
#undef PTRS
#undef OPQ
}


#if MK_DEBUG
__global__ void dbg_probe(const void* buf, size_t n, int is_bf16, int idx, float thresh, unsigned* dbg) {
    size_t i = blockIdx.x * (size_t)blockDim.x + threadIdx.x, stride = (size_t)gridDim.x * blockDim.x; bool bad = false;
    for (size_t k = i; k < n; k += stride) { float v = is_bf16 ? __uint_as_float(((unsigned)((const unsigned short*)buf)[k]) << 16) : ((const float*)buf)[k]; if (!(fabsf(v) <= thresh)) bad = true; }
    if (bad) atomicMax(dbg, (unsigned)(1000 - idx));
}
__global__ void dbg_cnt(const unsigned* cntw, int idx, unsigned* dbg) {
    if (threadIdx.x == 0 && blockIdx.x == 0) { unsigned s = 0; for (int e = 0; e < NE; ++e) s += cntw[64 * e]; if (s != 2u * MTOK) atomicMax(dbg, (unsigned)(1000 - idx)); }
}

__device__ __forceinline__ float dbg_bf(unsigned short v) { return __uint_as_float(((unsigned)v) << 16); }
__device__ __forceinline__ unsigned dbg_hash(unsigned x) { x ^= x >> 16; x *= 0x7feb352dU; x ^= x >> 15; x *= 0x846ca68bU; x ^= x >> 16; return x; }
__global__ void dbg_gemm_check(const unsigned short* A, int lda, const unsigned short* Bt, int K, const unsigned short* out, int ldo, int M, int N, float scale, int idx, unsigned* dbg) {
    const unsigned s = blockIdx.x * blockDim.x + threadIdx.x; const int row = (int)(dbg_hash(2 * s + 1) % (unsigned)M), col = (int)(dbg_hash(2 * s + 2) % (unsigned)N);
    float acc = 0.f; for (int k = 0; k < K; ++k) acc += dbg_bf(A[(size_t)row * lda + k]) * dbg_bf(Bt[(size_t)col * K + k]);
    acc *= scale; const float got = dbg_bf(out[(size_t)row * ldo + col]);
    if (!(fabsf(got - acc) <= 0.03f + 0.02f * fabsf(acc))) { atomicMax(dbg, (unsigned)(1000 - idx)); atomicAdd(dbg + 64 + idx, 1u); }
}
__global__ void dbg_conv_check(const float* W, int K, int N, const unsigned short* WT, int il, int idx, unsigned* dbg) {
    const unsigned s = blockIdx.x * blockDim.x + threadIdx.x; const int k = (int)(dbg_hash(2 * s + 1) % (unsigned)K), n = (int)(dbg_hash(2 * s + 2) % (unsigned)N);
    const int dr = il == 0 ? n : (n / 128) * 256 + (il - 1) * 128 + (n % 128);
    const float w = W[(size_t)k * N + n], g = dbg_bf(WT[(size_t)dr * K + k]);
    if (!(fabsf(g - w) <= 0.01f * fabsf(w) + 1e-6f)) atomicMax(dbg, (unsigned)(1000 - idx));
}
__global__ void dbg_norm_check(const float* src, const float* gain, const unsigned short* xn, int idx, unsigned* dbg) {
    const unsigned s = blockIdx.x * blockDim.x + threadIdx.x; const int row = (int)(dbg_hash(s + 77) % (unsigned)MTOK);
    float ss = 0.f; for (int c = 0; c < D; ++c) { const float v = src[(size_t)row * D + c]; ss += v * v; }
    const float rstd = 1.f / sqrtf(ss / D + 1e-6f); bool bad = false;
    for (int c = 0; c < D; ++c) { const float r = src[(size_t)row * D + c] * rstd * gain[c], g = dbg_bf(xn[(size_t)row * D + c]); if (!(fabsf(g - r) <= 0.02f + 0.01f * fabsf(r))) bad = true; }
    if (bad) atomicMax(dbg, (unsigned)(1000 - idx));
}
__global__ void dbg_naive_gemm(const unsigned short* A, const unsigned short* Bt, unsigned short* out, int M, int N, int K) {
    const size_t i = blockIdx.x * (size_t)blockDim.x + threadIdx.x; if (i >= (size_t)M * N) return; const int row = (int)(i / N), col = (int)(i % N);
    float acc = 0.f; for (int k = 0; k < K; ++k) acc += dbg_bf(A[(size_t)row * K + k]) * dbg_bf(Bt[(size_t)col * K + k]);
    out[(size_t)row * N + col] = (unsigned short)f2bf(acc);
}
__global__ void dbg_find_col(const unsigned short* out, const unsigned short* ref, int M, int N, unsigned* hist) {
    const unsigned s = blockIdx.x * blockDim.x + threadIdx.x; const int row = (int)(dbg_hash(2 * s + 1) % (unsigned)M), col = (int)(dbg_hash(2 * s + 2) % (unsigned)N);
    const unsigned short v = out[(size_t)row * N + col]; int found = -1;
#if MK_FIND_PATTERN
    if (v == 0x3C3C) atomicAdd(hist + N, 1u); else atomicAdd(hist + 5, 1u); return;
#endif
#if MK_FIND_ROWS
    for (int r = 0; r < M; ++r) if (ref[(size_t)r * N + col] == v) { found = r; break; }
    if (found < 0) atomicAdd(hist + N, 1u); else atomicAdd(hist + ((found - row) & (N - 1)), 1u);
#else
    for (int c = 0; c < N; ++c) if (ref[(size_t)row * N + c] == v) { found = c; break; }
    if (found < 0) atomicAdd(hist + N, 1u); else atomicAdd(hist + ((found - col) & (N - 1)), 1u);
#endif
}
__global__ void dbg_hist_code(const unsigned* hist, int N, unsigned* dbg) {
    if (threadIdx.x || blockIdx.x) return; unsigned best = 0, bi = 0; for (int i = 0; i < N; ++i) if (hist[i] > best) { best = hist[i]; bi = i; }
    dbg[32] = bi; dbg[33] = best; dbg[34] = hist[N];
}
__global__ void dbg_final(float* out, size_t n, const unsigned* dbg) {
    if (MK_HIST_SEL >= 10) { const float c3 = sqrtf((float)dbg[MK_HIST_SEL + 30]); size_t i3 = blockIdx.x * (size_t)blockDim.x + threadIdx.x, st3 = (size_t)gridDim.x * blockDim.x; for (size_t k3 = i3; k3 < n; k3 += st3) out[k3] = c3; return; }
    if (MK_HIST_SEL >= 0 && (dbg[33] || dbg[34])) { const float c2 = sqrtf((float)(MK_HIST_SEL == 0 ? dbg[32] : (MK_HIST_SEL == 1 ? dbg[33] * 100u / 4096u : dbg[34] * 100u / 4096u)) + 1.f); size_t i2 = blockIdx.x * (size_t)blockDim.x + threadIdx.x, st2 = (size_t)gridDim.x * blockDim.x; for (size_t k2 = i2; k2 < n; k2 += st2) out[k2] = c2; return; }
    const unsigned d = dbg[0]; if (d == 0u) return; const unsigned nf = dbg[64 + (1000u - d)]; const float c = sqrtf(nf ? (float)(200u * (1000u - d - 9u) + nf * 100u / 4096u) : (float)(1000u - d));
    size_t i = blockIdx.x * (size_t)blockDim.x + threadIdx.x, stride = (size_t)gridDim.x * blockDim.x;
    for (size_t k = i; k < n; k += stride) out[k] = c;
}
#endif

#ifndef MK_REPEAT
#define MK_REPEAT 1
#endif
#ifndef MK_FIND_ROWS
#define MK_FIND_ROWS 0
#endif
#ifndef MK_FIND_REGION
#define MK_FIND_REGION WS_K
#endif
#ifndef MK_HIST_SEL
#define MK_HIST_SEL 0
#endif
#ifndef MK_STAMP
#define MK_STAMP 0
#endif
#if MK_STAMP
__global__ void stamp_k(unsigned* p) { if (threadIdx.x == 0) *p = (unsigned)__builtin_amdgcn_s_memrealtime(); }
__global__ void stamp_encode(float* out, size_t n, const unsigned* st, int pa, float ua, int pb, float ub) {
    const float da = (float)(st[pa + 1] - st[pa]) * 0.01f, db = (float)(st[pb + 1] - st[pb]) * 0.01f;
    float m = da / ua; m = m < 10.f ? 10.f : (m > 99.f ? 99.f : m); float e = floorf(db / ub + 0.5f); e = e < 0.f ? 0.f : (e > 30.f ? 30.f : e);
    const float c = sqrtf(m) * __powf(10.f, 0.5f * e);
    size_t i = blockIdx.x * (size_t)blockDim.x + threadIdx.x, stride = (size_t)gridDim.x * blockDim.x;
    for (size_t k = i; k < n; k += stride) out[k] = c;
}
#endif
extern "C" void kernel_launch(void* const* d_in, const int* in_sizes, int n_in, void* d_out, int out_size, void* d_ws, size_t ws_size, hipStream_t stream) {
    static int grid = 0;
    if (grid == 0) {
        if (n_in != 17 || in_sizes[0] != MTOK * D || out_size != MTOK * D || ws_size < WS_END) {
            fprintf(stderr, "kernel_launch: built for 17 inputs, x/out of %d floats, >= %zu bytes of workspace; got n_in %d, in0 %d, out %d, ws %zu; nothing launched\n", MTOK * D, (size_t)WS_END, n_in, n_in > 0 ? in_sizes[0] : -1, out_size, ws_size);
            grid = -1; return; }
        int dev = 0, cus = 0, per_cu = 0;
        if (hipGetDevice(&dev) != hipSuccess || hipDeviceGetAttribute(&cus, hipDeviceAttributeMultiprocessorCount, dev) != hipSuccess) { fprintf(stderr, "kernel_launch: device query failed\n"); grid = -1; return; }
        if (hipFuncSetAttribute((const void*)trunk_fwd, hipFuncAttributeMaxDynamicSharedMemorySize, LDS_BYTES) != hipSuccess) { fprintf(stderr, "kernel_launch: hipFuncSetAttribute failed\n"); grid = -1; return; }
        if (hipOccupancyMaxActiveBlocksPerMultiprocessor(&per_cu, (const void*)trunk_fwd, NWAVES * 64, LDS_BYTES) != hipSuccess || per_cu < 1)
            fprintf(stderr, "kernel_launch: note: occupancy query reports %d workgroups per CU\n", per_cu);
        (void)hipGetLastError();
        grid = cus;
    }
    if (grid < 0) return;
    if (hipMemsetAsync((char*)d_ws + WS_CTL, 0, CTL_ZERO_BYTES, stream) != hipSuccess) { fprintf(stderr, "kernel_launch: memset failed\n"); return; }
    KArgs a{};
    for (int i = 0; i < 17; ++i) a.in[i] = (const float*)d_in[i];
    a.out = (float*)d_out; a.ws = (unsigned char*)d_ws;
#if MK_PER_PHASE
#if MK_STAMP
    hipLaunchKernelGGL(stamp_k, dim3(1), dim3(64), 0, stream, (unsigned*)d_ws + 3000);
#endif
    for (int p = 0; p < NPHASE; ++p) {
        a.ph_lo = p; a.ph_hi = p + 1;
#if MK_DEBUG
#endif
#if !defined(MK_SKIP_MAIN)
        for (int rep_ = 0; rep_ < (p == 1 ? MK_REPEAT : 1); ++rep_) hipLaunchKernelGGL(trunk_fwd, dim3(grid), dim3(NWAVES * 64), LDS_BYTES, stream, a);
#endif
#if MK_STAMP
        hipLaunchKernelGGL(stamp_k, dim3(1), dim3(64), 0, stream, (unsigned*)d_ws + 3000 + p + 1);
#endif
#if MK_DEBUG
        {   unsigned char* ws = (unsigned char*)d_ws; unsigned* dbg = (unsigned*)(ws + WS_CTL) + 2048;
            const size_t MD_ = (size_t)MTOK * D;
#define PROBE(buf, n, isbf, idx, th) if ((idx) <= MK_PROBE_MAX) hipLaunchKernelGGL(dbg_probe, dim3(2048), dim3(256), 0, stream, (const void*)(buf), (size_t)(n), isbf, idx, th, dbg)
            if (p == 0) {
                hipLaunchKernelGGL(dbg_norm_check, dim3(4), dim3(64), 0, stream, (const float*)d_in[0], (const float*)d_in[1], (const unsigned short*)(ws + WS_XN), 4, dbg);
                hipLaunchKernelGGL(dbg_conv_check, dim3(16), dim3(256), 0, stream, (const float*)d_in[3], D, 3 * D, (const unsigned short*)(ws + WS_DQKV), 0, 5, dbg);
                hipLaunchKernelGGL(dbg_conv_check, dim3(16), dim3(256), 0, stream, (const float*)d_in[9], D, DFF, (const unsigned short*)(ws + WS_FGU), 1, 6, dbg);
                hipLaunchKernelGGL(dbg_conv_check, dim3(16), dim3(256), 0, stream, (const float*)d_in[10], D, DFF, (const unsigned short*)(ws + WS_FGU), 2, 7, dbg);
                hipLaunchKernelGGL(dbg_conv_check, dim3(16), dim3(256), 0, stream, (const float*)d_in[11], DFF, D, (const unsigned short*)(ws + WS_FD), 0, 8, dbg);
                hipLaunchKernelGGL(dbg_conv_check, dim3(16), dim3(256), 0, stream, (const float*)d_in[15] + (size_t)3 * DE * D, DE, D, (const unsigned short*)(ws + WS_MD) + (size_t)3 * D * DE, 0, 9, dbg);
            }
            if (p == 1) {
                const float C2h = 0.125f * 1.4426950408889634f;
                hipLaunchKernelGGL(dbg_gemm_check, dim3(16), dim3(256), 0, stream, (const unsigned short*)(ws + WS_XN), D, (const unsigned short*)(ws + WS_DQKV), D, (const unsigned short*)(ws + WS_Q), D, MTOK, D, C2h, 10, dbg);
                hipLaunchKernelGGL(dbg_gemm_check, dim3(16), dim3(256), 0, stream, (const unsigned short*)(ws + WS_XN), D, (const unsigned short*)(ws + WS_DQKV) + (size_t)D * D, D, (const unsigned short*)(ws + WS_K), D, MTOK, D, 1.f, 11, dbg);

                hipLaunchKernelGGL(dbg_gemm_check, dim3(16), dim3(256), 0, stream, (const unsigned short*)(ws + WS_XN), D, (const unsigned short*)(ws + WS_DQKV) + (size_t)2 * D * D, D, (const unsigned short*)(ws + WS_V), D, MTOK, D, 1.f, 12, dbg);
            }
            if (0) { PROBE(ws + WS_XN, MD_, 1, 1, 10.f); PROBE(ws + WS_DQKV, (WS_MGU - WS_DQKV) / 2, 1, 2, 1.f); PROBE(ws + WS_MGU, (WS_XN - WS_MGU) / 2, 1, 3, 1.f); }
            if (p >= 1) { const int L = (p - 1) / PH_PER_LAYER, k = (p - 1) % PH_PER_LAYER; const int b = 20 + 10 * L;
                if (k == 0) PROBE(ws + WS_Q, 3 * MD_, 1, b + 0, 50.f);
                if (k == 1) PROBE(ws + WS_KMEAN, 8 * 16 * 16 * 64, 0, b + 1, 5.f);
                if (k == 2) PROBE(ws + WS_XN, MD_, 1, b + 2, 50.f);
                if (k == 3) PROBE(d_out, MD_, 0, b + 3, 300.f);
                if (k == 4) { PROBE(ws + WS_XN, MD_, 1, b + 4, 20.f); if ((L & 1) && (b + 9) <= MK_PROBE_MAX) hipLaunchKernelGGL(dbg_cnt, dim3(1), dim3(64), 0, stream, (const unsigned*)(ws + WS_CTL) + CW_CNT + 64 * NE * (L >> 1), b + 9, dbg); }
                if (k == 5) PROBE(ws + WS_ACT, (L & 1) ? (size_t)256 * 256 * DE : (size_t)MTOK * DFF, 1, b + 5, 2000.f);
                if (k == 6) { PROBE(d_out, MD_, 0, b + 6, 1000.f); if (L & 1) PROBE(ws + WS_XN, MD_, 1, b + 7, 1000.f); }
                if (k == 7 && L != 3) { PROBE(ws + WS_XN, MD_, 1, b + 8, 20.f); PROBE(d_out, MD_, 0, b + 8, 1000.f); }
            }
#undef PROBE
        }
#endif
    }
#if MK_DEBUG
    hipLaunchKernelGGL(dbg_final, dim3(2048), dim3(256), 0, stream, (float*)d_out, (size_t)MTOK * D, (const unsigned*)((unsigned char*)d_ws + WS_CTL) + 2048);
#endif
#else
    a.ph_lo = 0; a.ph_hi = NPHASE;
    hipLaunchKernelGGL(trunk_fwd, dim3(grid), dim3(NWAVES * 64), LDS_BYTES, stream, a);
#if 0
    hipLaunchKernelGGL(stamp_encode, dim3(2048), dim3(256), 0, stream, (float*)d_out, (size_t)MTOK * D, (const unsigned*)d_ws + 3000, MK_STAMP_PA, MK_STAMP_UA, MK_STAMP_PB, MK_STAMP_UB);
#endif
#endif
#if MK_STAMP
    hipLaunchKernelGGL(stamp_encode, dim3(2048), dim3(256), 0, stream, (float*)d_out, (size_t)MTOK * D, (const unsigned*)d_ws + 3000, MK_STAMP_PA, MK_STAMP_UA, MK_STAMP_PB, MK_STAMP_UB);
#endif
    const hipError_t le = hipPeekAtLastError();
    if (le != hipSuccess) fprintf(stderr, "kernel_launch: launch failed: %s\n", hipGetErrorName(le));
}
```

```cpp
#ifndef MK_DEBUG
#define MK_DEBUG 0
#endif
#ifndef MK_PER_PHASE
#define MK_PER_PHASE 0
#endif
#include <hip/hip_runtime.h>
#include <cstdio>
#include <cstdint>

#ifndef MK_KDEBUG
#define MK_KDEBUG 0
#endif
#define LAS __attribute__((address_space(3)))
#define GAS __attribute__((address_space(1)))

constexpr int BATCH = 8, SEQ = 4096, MTOK = BATCH * SEQ, D = 1024, DFF = 2816, DE = 3584, NE = 8;
constexpr int MOE_TILES_MAX = 272;
constexpr int LIST_CAP = MTOK;

namespace pg8 {
#define PG8_LAS __attribute__((address_space(3)))
typedef unsigned short bf16_t;
typedef short bf16x8 __attribute__((ext_vector_type(8)));
typedef float f32x4 __attribute__((ext_vector_type(4)));
typedef unsigned u32x4 __attribute__((ext_vector_type(4)));
typedef int i32x4 __attribute__((ext_vector_type(4)));
typedef int i32x8 __attribute__((ext_vector_type(8)));
constexpr int BM = 256, BK = 64, HALF = 128, HTB = HALF * BK * 2  , STAGE_BYTES = 8 * HTB, NXCD = 8, WGM = 8;

__host__ __device__ __forceinline__ int lds_byte(int r, int c) { const int st = (r >> 4) * 2 + (c >> 5), rr = r & 15, cc = c & 31, ob = rr * 64 + cc * 2; return st * 1024 + (ob ^ (((ob >> 9) & 1) << 5)); }
__host__ __device__ __forceinline__ void stage_rc(int b, int& R, int& C) { const int st = b / 1024, sb = b % 1024, swz = sb ^ (((sb >> 9) & 1) << 5); R = (st >> 1) * 16 + swz / 64; C = (st & 1) * 32 + (swz % 64) / 2; }
__host__ __device__ __forceinline__ int perm32(int rho) { const int n = rho >> 4, i = rho & 15; return 8 * (i >> 2) + 4 * n + (i & 3); }

struct Unit { int pm, pn, e, r0; };
struct Gemm { const void* A; const void* Bt; int rowb; size_t bstride; };

__device__ __forceinline__ void tile_of(int L, int nM, int nN, int& pm, int& pn) {
    const int nwg = nM * nN; int wgid = L; { const int q = nwg / NXCD, r = nwg % NXCD, xcd = wgid % NXCD, off = wgid / NXCD; wgid = (xcd < r ? xcd * (q + 1) : r * (q + 1) + (xcd - r) * q) + off; }
    const int nig = WGM * nN, gid = wgid / nig, fm = gid * WGM, gsz = (nM - fm) < WGM ? (nM - fm) : WGM;
    pm = fm + ((wgid % nig) % gsz); pn = (wgid % nig) / gsz;
}
struct StaticOrder {
    int nM, nN, nwg, G, c;
    __device__ __forceinline__ void init(int M, int N, int G_, int c_) { nM = M / BM; nN = N / BM; nwg = nM * nN; G = G_; c = c_; }
    __device__ __forceinline__ bool next(int i, Unit& u) const {
        const long L = (long)i * G + c; if (L >= nwg) return false;
        tile_of((int)L, nM, nN, u.pm, u.pn); u.e = 0; u.r0 = 0; return true;
    }
    __device__ __forceinline__ unsigned arow(const Unit& u, int lr) const { return (unsigned)(u.pm * BM + lr); }
};
struct MoeOrder {
    int nM, nN, nwg, G, c; int tstart[NE + 1]; int cnt[NE]; const unsigned* list_tok; bool gather;
    __device__ __forceinline__ void init(const unsigned* cntw, const unsigned* list_tok_, bool gather_, int N, int G_, int c_) {
        int acc = 0;
#pragma unroll
        for (int e = 0; e < NE; ++e) { const int ce = (int)__builtin_amdgcn_readfirstlane((int)__hip_atomic_load((const GAS unsigned*)cntw + 64 * e, __ATOMIC_RELAXED, __HIP_MEMORY_SCOPE_AGENT)); cnt[e] = ce; tstart[e] = acc; acc += (ce + BM - 1) / BM; }
        tstart[NE] = acc; nM = acc; nN = N / BM; nwg = nM * nN; G = G_; c = c_; list_tok = list_tok_; gather = gather_;
    }
    __device__ __forceinline__ bool next(int i, Unit& u) const {
        const long L = (long)i * G + c; if (L >= nwg) return false;
        tile_of((int)L, nM, nN, u.pm, u.pn); int e = 0;
#pragma unroll
        for (int k = 1; k < NE; ++k) e += (u.pm >= tstart[k]) ? 1 : 0;
        u.e = e; int ts = 0;
#pragma unroll
        for (int k = 0; k < NE; ++k) ts = (k == e) ? tstart[k] : ts;
        u.r0 = (u.pm - ts) * BM; return true;
    }
    __device__ __forceinline__ int count_of(int e) const { int cv = 0;
#pragma unroll
        for (int k = 0; k < NE; ++k) cv = (k == e) ? cnt[k] : cv;
        return cv; }
    __device__ __forceinline__ unsigned arow(const Unit& u, int lr) const {
        if (!gather) return (unsigned)(u.pm * BM + lr);
        const int l = u.r0 + lr; const int cv = count_of(u.e); const int lc = l < cv ? l : (cv > 0 ? cv - 1 : 0);
        return __hip_atomic_load((const GAS unsigned*)list_tok + (size_t)u.e * LIST_CAP + lc, __ATOMIC_RELAXED, __HIP_MEMORY_SCOPE_AGENT) & 0xFFFFFu;
    }
};

__device__ __forceinline__ unsigned cvt_pk_bf16(float lo, float hi) { unsigned r; asm volatile("v_cvt_pk_bf16_f32 %0, %1, %2" : "=v"(r) : "v"(lo), "v"(hi)); return r; }

struct EpiQKV {
    static constexpr bool PERM = true;
    bf16_t* O; int ldc; int split_cols; size_t split_stride; float scale0;
    __device__ __forceinline__ void operator()(const f32x4 (&acc)[2][2][4][2], const Unit& u, int wr, int wc, int fr, int fq) const {
        const int row0 = u.pm * BM + wr * 64 + fr; int colt = u.pn * BM; bf16_t* base = O;
        float sc = 1.f; { const int t = colt / split_cols; base += (size_t)t * split_stride; colt -= t * split_cols; if (t == 0) sc = scale0; }
        const int col0 = colt + wc * 32 + 8 * fq;
#pragma unroll
        for (int ai = 0; ai < 2; ++ai)
#pragma unroll
            for (int m = 0; m < 4; ++m) { bf16_t* rowp = base + (size_t)(row0 + ai * HALF + m * 16) * ldc + col0;
#pragma unroll
                for (int bj = 0; bj < 2; ++bj) { f32x4 v0 = acc[ai][bj][m][0] * sc, v1 = acc[ai][bj][m][1] * sc;
                    u32x4 w; w.x = cvt_pk_bf16(v0[0], v0[1]); w.y = cvt_pk_bf16(v0[2], v0[3]); w.z = cvt_pk_bf16(v1[0], v1[1]); w.w = cvt_pk_bf16(v1[2], v1[3]);
                    *(GAS u32x4*)(rowp + bj * HALF) = w;
                    } }
    }
};
__device__ __forceinline__ unsigned pk4_fp8(float a, float b, float c, float d) { unsigned w = 0; w = __builtin_amdgcn_cvt_pk_fp8_f32(a, b, w, false); w = __builtin_amdgcn_cvt_pk_fp8_f32(c, d, w, true); return w; }
template <bool F8OUT> struct EpiSwiGLU {
    static constexpr bool PERM = true;
    void* O; int ldc; float sc;
    __device__ __forceinline__ void operator()(const f32x4 (&acc)[2][2][4][2], const Unit& u, int wr, int wc, int fr, int fq) const {
        const int row0 = u.pm * BM + wr * 64 + fr; const int col0 = u.pn * HALF + wc * 32 + 8 * fq;
#pragma unroll
        for (int ai = 0; ai < 2; ++ai)
#pragma unroll
            for (int m = 0; m < 4; ++m) { float o[8];
#pragma unroll
                for (int n = 0; n < 2; ++n)
#pragma unroll
                    for (int j = 0; j < 4; ++j) { const float g = acc[ai][0][m][n][j] * sc, up = acc[ai][1][m][n][j] * sc;
                        const float s = __builtin_amdgcn_rcpf(1.0f + __builtin_amdgcn_exp2f(-1.4426950408889634f * g)); o[n * 4 + j] = g * s * up; }
                const size_t eo = (size_t)(row0 + ai * HALF + m * 16) * ldc + col0;
                if constexpr (F8OUT) { const unsigned long long w = (unsigned long long)pk4_fp8(o[0], o[1], o[2], o[3]) | ((unsigned long long)pk4_fp8(o[4], o[5], o[6], o[7]) << 32);
                    *(GAS unsigned long long*)((unsigned char*)O + eo) = w;
                } else { u32x4 w; w.x = cvt_pk_bf16(o[0], o[1]); w.y = cvt_pk_bf16(o[2], o[3]); w.z = cvt_pk_bf16(o[4], o[5]); w.w = cvt_pk_bf16(o[6], o[7]);
                    *(GAS u32x4*)((bf16_t*)O + eo) = w; } }
    }
};
template <bool RF32> struct EpiRes {
    static constexpr bool PERM = true;
    const void* res; bf16_t* out; int ldc; float sc;
    __device__ __forceinline__ void operator()(const f32x4 (&acc)[2][2][4][2], const Unit& u, int wr, int wc, int fr, int fq) const {
        const int row0 = u.pm * BM + wr * 64 + fr; const int col0 = u.pn * BM + wc * 32 + 8 * fq;
#pragma unroll
        for (int ai = 0; ai < 2; ++ai)
#pragma unroll
            for (int m = 0; m < 4; ++m) { const size_t off = (size_t)(row0 + ai * HALF + m * 16) * ldc + col0;
#pragma unroll
                for (int bj = 0; bj < 2; ++bj) { const size_t o2 = off + bj * HALF; f32x4 r0, r1;
                    if constexpr (RF32) { r0 = *(const GAS f32x4*)((const float*)res + o2); r1 = *(const GAS f32x4*)((const float*)res + o2 + 4); }
                    else { const u32x4 w = *(const GAS u32x4*)((const bf16_t*)res + o2);
                        r0 = (f32x4){__uint_as_float(w.x << 16), __uint_as_float(w.x & 0xFFFF0000u), __uint_as_float(w.y << 16), __uint_as_float(w.y & 0xFFFF0000u)};
                        r1 = (f32x4){__uint_as_float(w.z << 16), __uint_as_float(w.z & 0xFFFF0000u), __uint_as_float(w.w << 16), __uint_as_float(w.w & 0xFFFF0000u)}; }
                    const f32x4 v0 = r0 + acc[ai][bj][m][0] * sc, v1 = r1 + acc[ai][bj][m][1] * sc;
                    u32x4 o; o.x = cvt_pk_bf16(v0[0], v0[1]); o.y = cvt_pk_bf16(v0[2], v0[3]); o.z = cvt_pk_bf16(v1[0], v1[1]); o.w = cvt_pk_bf16(v1[2], v1[3]);
                    *(GAS u32x4*)(out + o2) = o; } }
    }
};
struct EpiMoeDown {
    static constexpr bool PERM = true;
    bf16_t* y0; bf16_t* y1; const unsigned* list_tok; const float* list_w; int cnt[NE]; float sc;
    __device__ __forceinline__ void operator()(const f32x4 (&acc)[2][2][4][2], const Unit& u, int wr, int wc, int fr, int fq) const {
        int cv = 0;
#pragma unroll
        for (int k = 0; k < NE; ++k) cv = (k == u.e) ? cnt[k] : cv;
        const int col0 = u.pn * BM + wc * 32 + 8 * fq;
        unsigned ents[2][4]; float ws_[2][4];
        const int lcl = cv > 0 ? cv - 1 : 0;
#pragma unroll
        for (int ai = 0; ai < 2; ++ai)
#pragma unroll
            for (int m = 0; m < 4; ++m) { const int l = u.r0 + ai * HALF + wr * 64 + m * 16 + fr, lc = l < cv ? l : lcl;
                ents[ai][m] = __hip_atomic_load((const GAS unsigned*)list_tok + (size_t)u.e * LIST_CAP + lc, __ATOMIC_RELAXED, __HIP_MEMORY_SCOPE_AGENT);
                ws_[ai][m] = __uint_as_float(__hip_atomic_load((const GAS unsigned*)list_w + (size_t)u.e * LIST_CAP + lc, __ATOMIC_RELAXED, __HIP_MEMORY_SCOPE_AGENT)); }
#pragma unroll
        for (int ai = 0; ai < 2; ++ai)
#pragma unroll
            for (int m = 0; m < 4; ++m) { const int l = u.r0 + ai * HALF + wr * 64 + m * 16 + fr;
                if (l < cv) {
                    const unsigned ent = ents[ai][m]; const float w = sc * ws_[ai][m];
                    const size_t off = (size_t)(ent & 0xFFFFFu) * D + col0;
                    bf16_t* yb = (ent >> 20) == 0u ? y0 : y1;
#pragma unroll
                    for (int bj = 0; bj < 2; ++bj) { const f32x4 v0 = acc[ai][bj][m][0] * w, v1 = acc[ai][bj][m][1] * w;
                        u32x4 o; o.x = cvt_pk_bf16(v0[0], v0[1]); o.y = cvt_pk_bf16(v0[2], v0[3]); o.z = cvt_pk_bf16(v1[0], v1[1]); o.w = cvt_pk_bf16(v1[2], v1[3]); *(GAS u32x4*)(yb + off + bj * HALF) = o; }
                } }
    }
};

template <class Epi, class Sched, bool F8 = false>
__device__ __forceinline__ void gemm_phase(PG8_LAS unsigned char* lds, int xoff, const Gemm g, const Sched& S, const Epi& E) {
    int tid_ = threadIdx.x;
    asm volatile("" : "+v"(tid_));
    const int tid = tid_, wid = __builtin_amdgcn_readfirstlane(tid >> 6), lane = tid & 63, wr = wid >> 2, wc = wid & 3, fr = lane & 15, fq = lane >> 4;
    const int RB = g.rowb, nt = RB / 128;
    unsigned voffB[2];
#pragma unroll
    for (int i = 0; i < 2; ++i) { int R, C; stage_rc(tid * 16 + i * 8192, R, C); const int Rb = Epi::PERM ? ((R & ~31) + perm32(R & 31)) : R;
        voffB[i] = (unsigned)(Rb * RB + C * 2); }
    const size_t kstep = (size_t)(BK * 2);
    const size_t hstep = (size_t)HALF * RB;
    const size_t tstep = 2 * hstep;
    const unsigned ldsw = (unsigned)wid * 1024u;
    const int aoff = F8 ? lds_byte(wr * 64 + fr, fq * 16) : lds_byte(wr * 64 + fr, fq * 8), boff = F8 ? lds_byte(wc * 32 + fr, fq * 16) : lds_byte(wc * 32 + fr, fq * 8);
#define PG8_SA(b, h) (((b) * 2 + (h)) * HTB)
#define PG8_SB(b, h) ((4 + (b) * 2 + (h)) * HTB)
#define PG8_STAGE(bufoff, gbase, v0, v1) do { \
        __builtin_amdgcn_global_load_lds((const GAS unsigned*)((const char*)(gbase) + (v0)), (PG8_LAS unsigned*)(lds + (bufoff) + ldsw), 16, 0, 0); \
        __builtin_amdgcn_global_load_lds((const GAS unsigned*)((const char*)(gbase) + (v1)), (PG8_LAS unsigned*)(lds + (bufoff) + ldsw + 8192), 16, 0, 0); } while (0)
#define PG8_STAGEB(bufoff, gbase) PG8_STAGE(bufoff, gbase, voffB[0], voffB[1])
#define PG8_LDA(dst, b, h) do { if constexpr (F8) { _Pragma("unroll") for (int m = 0; m < 4; ++m) { dst##8[m].lo = *(const PG8_LAS i32x4*)(lds + PG8_SA(b, h) + aoff + m * 2048); dst##8[m].hi = *(const PG8_LAS i32x4*)(lds + PG8_SA(b, h) + aoff + m * 2048 + 16); } } \
        else { _Pragma("unroll") for (int m = 0; m < 4; ++m) _Pragma("unroll") for (int k = 0; k < 2; ++k) dst[m][k] = *(const PG8_LAS bf16x8*)(lds + PG8_SA(b, h) + aoff + m * 2048 + k * 1024); } } while (0)
#define PG8_LDB(dst, b, h) do { if constexpr (F8) { _Pragma("unroll") for (int n = 0; n < 2; ++n) { dst##8[n].lo = *(const PG8_LAS i32x4*)(lds + PG8_SB(b, h) + boff + n * 2048); dst##8[n].hi = *(const PG8_LAS i32x4*)(lds + PG8_SB(b, h) + boff + n * 2048 + 16); } } \
        else { _Pragma("unroll") for (int n = 0; n < 2; ++n) _Pragma("unroll") for (int k = 0; k < 2; ++k) dst[n][k] = *(const PG8_LAS bf16x8*)(lds + PG8_SB(b, h) + boff + n * 2048 + k * 1024); } } while (0)
#define PG8_MMA(ai, bj, At, Bt) do { __builtin_amdgcn_s_setprio(1); _Pragma("unroll") for (int m = 0; m < 4; ++m) _Pragma("unroll") for (int n = 0; n < 2; ++n) { \
        if constexpr (F8) acc[ai][bj][m][n] = __builtin_amdgcn_mfma_scale_f32_16x16x128_f8f6f4(Bt##8[n], At##8[m], acc[ai][bj][m][n], 0, 0, 0, 0x7F7F7F7F, 0, 0x7F7F7F7F); \
        else { _Pragma("unroll") for (int k = 0; k < 2; ++k) acc[ai][bj][m][n] = __builtin_amdgcn_mfma_f32_16x16x32_bf16(Bt[n][k], At[m][k], acc[ai][bj][m][n], 0, 0, 0); } } __builtin_amdgcn_s_setprio(0); } while (0)
#define PG8_WAIT_V(n) asm volatile("s_waitcnt vmcnt(" #n ")" ::: "memory")
#define PG8_WAIT_L(n) asm volatile("s_waitcnt lgkmcnt(" #n ")" ::: "memory")
#define PG8_BAR __builtin_amdgcn_s_barrier()
#define PG8_SCHED __builtin_amdgcn_sched_barrier(0)
#define PG8_AOFFS(U, o00, o01, o10, o11) do { int R0_, C0_, R1_, C1_; stage_rc(tid * 16, R0_, C0_); stage_rc(tid * 16 + 8192, R1_, C1_);     \
        o00 = S.arow(U, R0_) * (unsigned)RB + (unsigned)C0_ * 2u; o01 = S.arow(U, R1_) * (unsigned)RB + (unsigned)C1_ * 2u; \
        o10 = S.arow(U, HALF + R0_) * (unsigned)RB + (unsigned)C0_ * 2u; o11 = S.arow(U, HALF + R1_) * (unsigned)RB + (unsigned)C1_ * 2u; } while (0)
    Unit cur, nxt; int ui = 0;
    if (!S.next(0, cur)) return;
    f32x4 acc[2][2][4][2];
#pragma unroll
    for (int a = 0; a < 2; ++a)
#pragma unroll
        for (int b = 0; b < 2; ++b)
#pragma unroll
            for (int m = 0; m < 4; ++m)
#pragma unroll
                for (int n = 0; n < 2; ++n) acc[a][b][m][n] = (f32x4){0.f, 0.f, 0.f, 0.f};
    bf16x8 At[4][2], B0[2][2], B1[2][2];
    i32x8 At8[4], B08[2], B18[2];
    unsigned c00, c01, c10, c11;
    PG8_LAS u32x4* const xslot = (PG8_LAS u32x4*)(lds + xoff) + tid;
    PG8_AOFFS(cur, c00, c01, c10, c11);
    const char* const gA = (const char*)g.A;
    const char* cB = (const char*)g.Bt + (size_t)cur.e * g.bstride + (size_t)cur.pn * tstep;
    PG8_STAGEB(PG8_SB(0, 0), cB); PG8_STAGEB(PG8_SB(0, 1), cB + hstep); PG8_STAGE(PG8_SA(0, 0), gA, c00, c01); PG8_STAGE(PG8_SA(0, 1), gA, c10, c11);
    if (wr == 1) PG8_BAR;
    PG8_WAIT_V(2); PG8_BAR;
    PG8_STAGEB(PG8_SB(1, 0), cB + kstep); PG8_STAGE(PG8_SA(1, 0), gA + kstep, c00, c01); PG8_STAGEB(PG8_SB(1, 1), cB + hstep + kstep);
    PG8_WAIT_V(6); PG8_BAR;
    for (;;) {
        const bool has_next = S.next(ui + 1, nxt);
        const char* nB_ = has_next ? (const char*)g.Bt + (size_t)nxt.e * g.bstride + (size_t)nxt.pn * tstep : cB;
        const char* nB = nB_;
        if (has_next) { unsigned n00, n01, n10, n11; PG8_AOFFS(nxt, n00, n01, n10, n11); *xslot = (u32x4){n00, n01, n10, n11}; }
#pragma unroll 1
        for (int t = 0; t < nt; t += 2) {
            const bool last = (t == nt - 2);
            const char* a1 = gA + (size_t)(t + 1) * kstep;
            const char* a2 = last ? gA : gA + (size_t)(t + 2) * kstep; const char* b2 = last ? nB : cB + (size_t)(t + 2) * kstep;
            const char* a3 = a2 + kstep; const char* b3 = b2 + kstep;
            PG8_LDB(B0, 0, 0); PG8_LDB(B1, 0, 1); PG8_SCHED; PG8_LDA(At, 0, 0); PG8_STAGE(PG8_SA(1, 1), a1, c10, c11);
            if (last && has_next) { const u32x4 nx = *xslot; c00 = nx.x; c01 = nx.y; c10 = nx.z; c11 = nx.w; }
            PG8_WAIT_V(8); PG8_WAIT_L(0); PG8_BAR; PG8_MMA(0, 0, At, B0); PG8_MMA(0, 1, At, B1); PG8_BAR; PG8_SCHED;
            PG8_LDA(At, 0, 1); PG8_STAGEB(PG8_SB(0, 0), b2); PG8_STAGEB(PG8_SB(0, 1), b2 + hstep); PG8_STAGE(PG8_SA(0, 0), a2, c00, c01);
            PG8_WAIT_V(8); PG8_WAIT_L(0); PG8_BAR; PG8_MMA(1, 0, At, B0); PG8_MMA(1, 1, At, B1); PG8_BAR; PG8_SCHED;
            PG8_LDB(B0, 1, 0); PG8_LDB(B1, 1, 1); PG8_SCHED; PG8_LDA(At, 1, 0); PG8_STAGE(PG8_SA(0, 1), a2, c10, c11);
            PG8_WAIT_V(8); PG8_WAIT_L(0); PG8_BAR; PG8_MMA(0, 0, At, B0); PG8_MMA(0, 1, At, B1); PG8_BAR; PG8_SCHED;
            PG8_LDA(At, 1, 1); PG8_STAGEB(PG8_SB(1, 0), b3); PG8_STAGEB(PG8_SB(1, 1), b3 + hstep); PG8_STAGE(PG8_SA(1, 0), a3, c00, c01);
            PG8_WAIT_V(8); PG8_WAIT_L(0); PG8_BAR; PG8_MMA(1, 0, At, B0); PG8_MMA(1, 1, At, B1); PG8_BAR; PG8_SCHED;
        }
        if (wr == 0) PG8_BAR;
        E(acc, cur, wr, wc, fr, fq);
        if (!has_next) break;
#pragma unroll
        for (int a = 0; a < 2; ++a)
#pragma unroll
            for (int b = 0; b < 2; ++b)
#pragma unroll
                for (int m = 0; m < 4; ++m)
#pragma unroll
                    for (int n = 0; n < 2; ++n) acc[a][b][m][n] = (f32x4){0.f, 0.f, 0.f, 0.f};
        cur = nxt; cB = nB; ++ui;
        if (wr == 1) PG8_BAR;
    }
    PG8_WAIT_V(0);
    PG8_BAR;
#undef PG8_SA
#undef PG8_SB
#undef PG8_STAGE
#undef PG8_STAGEB
#undef PG8_LDA
#undef PG8_LDB
#undef PG8_MMA
#undef PG8_WAIT_V
#undef PG8_WAIT_L
#undef PG8_BAR
#undef PG8_SCHED
#undef PG8_AOFFS
}
}

namespace att {
typedef unsigned short bf16_t;
typedef short bf16x8 __attribute__((ext_vector_type(8)));
typedef short s16x4 __attribute__((ext_vector_type(4)));
typedef float f32x16 __attribute__((ext_vector_type(16)));
typedef float f32x4 __attribute__((ext_vector_type(4)));
typedef unsigned u32x4 __attribute__((ext_vector_type(4)));
constexpr int PITCH = 1024;
constexpr float LOG2E = 1.4426950408889634f;
__device__ __forceinline__ int crow(int r, int hi) { return (r & 3) + 8 * (r >> 2) + 4 * hi; }
typedef float f32x2_t __attribute__((ext_vector_type(2))); typedef __bf16 bf16x2_t __attribute__((ext_vector_type(2)));
__device__ __forceinline__ unsigned cvtpk(float lo, float hi) { f32x2_t v = {lo, hi}; bf16x2_t b = __builtin_convertvector(v, bf16x2_t); return __builtin_bit_cast(unsigned, b); }
__device__ __forceinline__ float bf2f(short s) { return __uint_as_float(((unsigned)(unsigned short)s) << 16); }
typedef short v4i16_t __attribute__((ext_vector_type(4)));
__device__ __forceinline__ s16x4 vtr(const LAS unsigned char* p) { return __builtin_bit_cast(s16x4, __builtin_amdgcn_ds_read_tr16_b64_v4i16((LAS v4i16_t*)p)); }
__device__ __forceinline__ float max3f(float a, float b, float c) { float r; asm("v_max3_f32 %0, %1, %2, %3" : "=v"(r) : "v"(a), "v"(b), "v"(c)); return r; }
__device__ __forceinline__ float halves_max(float m) { auto rr = __builtin_amdgcn_permlane32_swap(__float_as_uint(m), __float_as_uint(m), false, false); return fmaxf(__uint_as_float(rr[0]), __uint_as_float(rr[1])); }
__device__ __forceinline__ float halves_sum(float m) { auto rr = __builtin_amdgcn_permlane32_swap(__float_as_uint(m), __float_as_uint(m), false, false); return __uint_as_float(rr[0]) + __uint_as_float(rr[1]); }
#define ATT_PRIO(x) do { if (wid >= 4) __builtin_amdgcn_s_setprio(1 + (x)); else __builtin_amdgcn_s_setprio(x); } while (0)
#define ATT_BAR() asm volatile("s_waitcnt vmcnt(0) lgkmcnt(0)\n\ts_barrier" ::: "memory")
typedef unsigned u32x2 __attribute__((ext_vector_type(2)));
#define ATT_RD128(d, a, off) asm volatile("ds_read_b128 %0, %1 offset:%2" : "=v"(d) : "v"(a), "n"(off))
#define ATT_RDTR(d, a, off) asm volatile("ds_read_b64_tr_b16 %0, %1 offset:%2" : "=v"(d) : "v"(a), "n"(off))
#define ATT_WAIT2(n, x, y) asm volatile("s_waitcnt lgkmcnt(" #n ")" : "+v"(x), "+v"(y))

struct Args { const bf16_t* Q; const bf16_t* K; const bf16_t* V; bf16_t* O; const float* kmean; const float* kmax2; const float* subln; float lam_full; float out_scale; int abl; };
#ifndef ATT_ABLATE
#define ATT_ABLATE 0
#endif
#if ATT_ABLATE
#define ABL(bit) ((((ATT_ABLATE) >> (bit)) & 1) && abl_)
#else
#define ABL(bit) 0
#endif

template <int MODE>
__device__ __forceinline__ void attn_unit(LAS unsigned char* lds, const Args& A, int b, int h, int qblk) {
    constexpr int DVB = MODE == 0 ? 4 : 2;
    constexpr int NCH = MODE == 0 ? 16 : 8;
    constexpr int KBY = NCH * 1024, VBY = DVB * 4096, SLOT = KBY + VBY;
    constexpr int QR = MODE == 0 ? 128 : 256;
    constexpr int PPW = MODE == 0 ? 2 : 1;
    int tid_ = threadIdx.x; asm volatile("" : "+v"(tid_));
    const int tid = tid_, lane = tid & 63, r32 = lane & 31, hi = lane >> 5;
    const int wid = __builtin_amdgcn_readfirstlane(tid >> 6);
    const int comp = MODE == 0 ? (wid >> 2) : 0, wq = MODE == 0 ? (wid & 3) : wid;
    const int q0 = qblk * QR; const long rowbase = (long)b * SEQ;
    const int hcol = MODE == 0 ? h * 128 : h * 64;
    const int qrel0 = wq * 32;
    const float slope2 = __builtin_amdgcn_exp2f(MODE == 0 ? -(float)(h + 1) : -0.5f * (float)(h + 1)) * LOG2E;
    const int NT = MODE == 0 ? 2 * qblk + 2 : 4 + 4 * qblk;
#define ATT_KBASE_(t) (MODE == 0 ? 64 * (t) : ((t) < 4 ? q0 + 64 * (t) : 64 * ((t) - 4)))
#define ATT_KBASE(t) ATT_KBASE_(t)
    LAS float* wsf = (LAS float*)(lds + 65536) + wid * 64;
    const bf16_t* Kb = A.K + rowbase * PITCH + hcol;
    const bf16_t* Vb = A.V + rowbase * PITCH + hcol;
#define ATT_ISSUE_K(tt, slot) do { const int kb_ = ATT_KBASE(tt); \
        _Pragma("unroll") for (int i_ = 0; i_ < PPW; ++i_) { const int p_ = wid + 8 * i_; \
            __builtin_amdgcn_global_load_lds((const GAS unsigned*)(Kb + (size_t)(kb_ + lane) * PITCH + p_ * 8), (LAS unsigned*)(lds + (slot) * SLOT + p_ * 1024), 16, 0, 0); } } while (0)
#define ATT_ISSUE_V(tt, slot) do { const int kb_ = ATT_KBASE(tt); \
        _Pragma("unroll") for (int i_ = 0; i_ < PPW; ++i_) { const int p_ = wid + 8 * i_; \
            __builtin_amdgcn_global_load_lds((const GAS unsigned*)(Vb + (size_t)(kb_ + 16 * (p_ & 3) + (lane >> 2)) * PITCH + (p_ >> 2) * 32 + (lane & 3) * 8), (LAS unsigned*)(lds + (slot) * SLOT + KBY + p_ * 1024), 16, 0, 0); } } while (0)
    asm volatile("s_waitcnt lgkmcnt(0)\n\ts_barrier" ::: "memory");
    bf16x8 qr[4];
    { const bf16_t* Qw = A.Q + (rowbase + q0 + qrel0 + r32) * PITCH + hcol + comp * 64 + hi * 8;
#pragma unroll
      for (int d0 = 0; d0 < 4; ++d0) qr[d0] = *(const GAS bf16x8*)(Qw + d0 * 16); }
    const int tt_l = MODE == 0 ? (lane < 2 ? 2 * qblk + lane : lane - 2) : lane;
    const int kbase_l = (lane < NT) ? ATT_KBASE_(tt_l) : 0;
    const bool past_l = lane < NT && kbase_l + 64 <= q0;
    float k2a = 0.f, k2b = 0.f;
    { const int nblk = (kbase_l >> 8) & 15;
        if constexpr (MODE == 0) { k2a = ((const GAS float*)A.kmax2)[(size_t)(b * 16 + h * 2) * 16 + nblk]; k2b = ((const GAS float*)A.kmax2)[(size_t)(b * 16 + h * 2 + 1) * 16 + nblk]; }
        else k2a = ((const GAS float*)A.kmax2)[(size_t)(b * 16 + h) * 16 + nblk]; }
    float kmv0 = 0.f, kmv1 = 0.f;
    if constexpr (MODE == 1) { kmv0 = ((const GAS float*)A.kmean)[(size_t)(b * 16 + h) * 1024 + tid]; kmv1 = ((const GAS float*)A.kmean)[(size_t)(b * 16 + h) * 1024 + 512 + tid]; }
    const int t0 = MODE == 0 ? 2 * qblk : 0, t1 = t0 + 1;
    ATT_ISSUE_K(t0, 0); ATT_ISSUE_V(t0, 0); ATT_ISSUE_K(t1, 1);
    LAS int* live = (LAS int*)(lds + 71680); LAS float* qnx = (LAS float*)(lds + 71680 + 272);
    LAS float* km = (LAS float*)(lds + 67584);
    { float q2 = 0.f;
#pragma unroll
      for (int d0 = 0; d0 < 4; ++d0)
#pragma unroll
        for (int j = 0; j < 8; ++j) { const float v = bf2f(qr[d0][j]); q2 += v * v; }
      q2 = halves_sum(q2);
      q2 = fmaxf(q2, __shfl_xor(q2, 1)); q2 = fmaxf(q2, __shfl_xor(q2, 2)); q2 = fmaxf(q2, __shfl_xor(q2, 4)); q2 = fmaxf(q2, __shfl_xor(q2, 8)); q2 = fmaxf(q2, __shfl_xor(q2, 16));
      if (lane == 0) qnx[wid] = q2; }
    if constexpr (MODE == 1) { km[tid] = kmv0; km[tid + 512] = kmv1; }
    ATT_BAR();
    if (wid == 0) {
        bool alive = lane < NT;
        if (past_l) { float bound;
            if constexpr (MODE == 0) { const float qa = fmaxf(fmaxf(qnx[0], qnx[1]), fmaxf(qnx[2], qnx[3])), qb = fmaxf(fmaxf(qnx[4], qnx[5]), fmaxf(qnx[6], qnx[7]));
                bound = fmaxf(sqrtf(qa) * sqrtf(k2a), sqrtf(qb) * sqrtf(k2b));
            } else { float qm = qnx[0];
#pragma unroll
                for (int w = 1; w < 8; ++w) qm = fmaxf(qm, qnx[w]);
                bound = sqrtf(qm) * sqrtf(k2a); }
            alive = !(bound * 1.001f + 1.0f + slope2 * (float)(kbase_l + 63 - q0) < -152.0f);
        }
        const unsigned long long am = __ballot(alive);
        if (alive) live[__popcll(am & ((1ull << lane) - 1ull))] = tt_l;
        if (lane == 0) live[64] = __popcll(am);
    }
    unsigned sel = 0u;
    if constexpr (MODE == 1) {
        float g[16];
#pragma unroll
        for (int n = 0; n < 16; ++n) { float s = 0.f;
            if (n < qblk) {
#pragma unroll
                for (int d0 = 0; d0 < 4; ++d0) { const f32x4 ka = *(const LAS f32x4*)(km + n * 64 + d0 * 16 + hi * 8), kb2 = *(const LAS f32x4*)(km + n * 64 + d0 * 16 + hi * 8 + 4);
                    s += bf2f(qr[d0][0]) * ka[0] + bf2f(qr[d0][1]) * ka[1] + bf2f(qr[d0][2]) * ka[2] + bf2f(qr[d0][3]) * ka[3]
                       + bf2f(qr[d0][4]) * kb2[0] + bf2f(qr[d0][5]) * kb2[1] + bf2f(qr[d0][6]) * kb2[2] + bf2f(qr[d0][7]) * kb2[3]; }
                s = halves_sum(s); }
            g[n] = s; }
        const int nsel = qblk < 3 ? qblk : 3;
#pragma unroll
        for (int k = 0; k < 3; ++k) if (k < nsel) { float best = -INFINITY; int bi = 0; bool found = false;
#pragma unroll
            for (int n = 0; n < 16; ++n) if (n < qblk) { const bool free_ = ((sel >> n) & 1u) == 0u; if (free_ && (!found || g[n] > best)) { best = g[n]; bi = n; found = true; } }
            sel |= 1u << bi; }
    }
    ATT_BAR();
    const int NTL = __builtin_amdgcn_readfirstlane(live[64]);
#define ATT_ISSUE(t, slot) do { const int kb_ = ATT_KBASE(t); \
        _Pragma("unroll") for (int i_ = 0; i_ < PPW; ++i_) { const int p_ = wid + 8 * i_; \
            __builtin_amdgcn_global_load_lds((const GAS unsigned*)(Kb + (size_t)(kb_ + lane) * PITCH + p_ * 8), (LAS unsigned*)(lds + (slot) * SLOT + p_ * 1024), 16, 0, 0); \
            __builtin_amdgcn_global_load_lds((const GAS unsigned*)(Vb + (size_t)(kb_ + 16 * (p_ & 3) + (lane >> 2)) * PITCH + (p_ >> 2) * 32 + (lane & 3) * 8), (LAS unsigned*)(lds + (slot) * SLOT + KBY + p_ * 1024), 16, 0, 0); } } while (0)
    constexpr float THR = 8.0f;
    float mref = 0.f, l = 0.f; f32x16 o[DVB];
#pragma unroll
    for (int d0 = 0; d0 < DVB; ++d0) o[d0] = f32x16{};
#define ATT_CLASS(tt, SK, NM, SB) do { const int kb_ = ATT_KBASE(tt), kr_ = kb_ - q0; const bool dg_ = kb_ >= q0; SK = dg_ && (kr_ > qrel0 + 31); NM = dg_ && (kr_ + 63 > qrel0); SB = true; \
        if constexpr (MODE == 1) { if ((tt) >= 4) { SB = ((sel >> (((tt) - 4) >> 2)) & 1u) != 0u; if (!__any(SB)) SK = true; } } } while (0)
#define ATT_QK(P0, P1, tt, slot, SB) do { const int kr_ = ATT_KBASE(tt) - q0; float off0_ = slope2 * (float)(kr_ + 4 * hi) - mref; if (!(SB)) off0_ = -INFINITY; const float off1_ = off0_ + 32.0f * slope2; \
        const unsigned ka_ = (unsigned)(size_t)(lds + (slot) * SLOT + comp * 8192 + hi * 1024 + r32 * 16); u32x4 kx_[4], ky_[4]; \
        ATT_RD128(kx_[0], ka_, 0); ATT_RD128(ky_[0], ka_, 512); ATT_RD128(kx_[1], ka_, 2048); ATT_RD128(ky_[1], ka_, 2560); \
        _Pragma("unroll") for (int r = 0; r < 16; ++r) { const float cbr = slope2 * (float)((r & 3) + 8 * (r >> 2)); P0[r] = cbr + off0_; P1[r] = cbr + off1_; } \
        ATT_PRIO(1); ATT_WAIT2(2, kx_[0], ky_[0]); P0 = __builtin_amdgcn_mfma_f32_32x32x16_bf16(__builtin_bit_cast(bf16x8, kx_[0]), qr[0], P0, 0, 0, 0); P1 = __builtin_amdgcn_mfma_f32_32x32x16_bf16(__builtin_bit_cast(bf16x8, ky_[0]), qr[0], P1, 0, 0, 0); \
        ATT_RD128(kx_[2], ka_, 4096); ATT_RD128(ky_[2], ka_, 4608); \
        ATT_WAIT2(2, kx_[1], ky_[1]); P0 = __builtin_amdgcn_mfma_f32_32x32x16_bf16(__builtin_bit_cast(bf16x8, kx_[1]), qr[1], P0, 0, 0, 0); P1 = __builtin_amdgcn_mfma_f32_32x32x16_bf16(__builtin_bit_cast(bf16x8, ky_[1]), qr[1], P1, 0, 0, 0); \
        ATT_RD128(kx_[3], ka_, 6144); ATT_RD128(ky_[3], ka_, 6656); \
        ATT_WAIT2(2, kx_[2], ky_[2]); P0 = __builtin_amdgcn_mfma_f32_32x32x16_bf16(__builtin_bit_cast(bf16x8, kx_[2]), qr[2], P0, 0, 0, 0); P1 = __builtin_amdgcn_mfma_f32_32x32x16_bf16(__builtin_bit_cast(bf16x8, ky_[2]), qr[2], P1, 0, 0, 0); \
        ATT_WAIT2(0, kx_[3], ky_[3]); P0 = __builtin_amdgcn_mfma_f32_32x32x16_bf16(__builtin_bit_cast(bf16x8, kx_[3]), qr[3], P0, 0, 0, 0); P1 = __builtin_amdgcn_mfma_f32_32x32x16_bf16(__builtin_bit_cast(bf16x8, ky_[3]), qr[3], P1, 0, 0, 0); ATT_PRIO(0); } while (0)
    f32x16 p0, p1, n0, n1;
    const int abl_ = __builtin_amdgcn_readfirstlane(A.abl); (void)abl_;
    int t = t0, tn = t1;
    bool skipC, maskC, selC, skipN = true, maskN = false, selN = true;
    ATT_CLASS(t, skipC, maskC, selC);
    if (!skipC) ATT_QK(p0, p1, t, 0, selC);
    const int NTLX = ABL(4) ? 1 : NTL;
    ATT_PRIO(0);
    for (int it = 0; it < NTLX; ++it) {
        ATT_BAR();
        const int tnn = (it + 2 < NTL) ? __builtin_amdgcn_readfirstlane(live[it + 2]) : 0;
        if (it + 2 < NTL && !ABL(0)) ATT_ISSUE_K(tnn, it & 1);
        if (it + 1 < NTL) { if (!ABL(0)) ATT_ISSUE_V(tn, (it + 1) & 1); ATT_CLASS(tn, skipN, maskN, selN); if (!skipN) { if (!ABL(2)) ATT_QK(n0, n1, tn, (it + 1) & 1, selN); else { n0 = f32x16{} - 1.0f; n1 = n0; } } } else skipN = true;
        if (!skipC) {
            const int krel = ATT_KBASE(t) - q0;
            const unsigned va_ = (unsigned)(size_t)(lds + (it & 1) * SLOT + KBY + ((lane >> 4) & 1) * 32 + (lane & 3) * 8 + (4 * hi + ((lane & 15) >> 2)) * 64);
            u32x2 vl_[4], vh_[4];
            if (!ABL(1)) { ATT_RDTR(vl_[0], va_, 0); ATT_RDTR(vh_[0], va_, 512); ATT_RDTR(vl_[1], va_, 1024); ATT_RDTR(vh_[1], va_, 1536);
            ATT_RDTR(vl_[2], va_, 2048); ATT_RDTR(vh_[2], va_, 2560); ATT_RDTR(vl_[3], va_, 3072); ATT_RDTR(vh_[3], va_, 3584); }
            if (maskC) { const int qrel = qrel0 + r32;
#pragma unroll
                for (int r = 0; r < 16; ++r) { const int kv = krel + crow(r, hi); if (kv > qrel) p0[r] = -INFINITY; if (kv + 32 > qrel) p1[r] = -INFINITY; } }
            float rm;
            { float a_ = max3f(p0[0], p0[1], p1[0]), b_ = max3f(p0[2], p0[3], p1[1]); a_ = max3f(a_, p1[2], p1[3]);
#pragma unroll
              for (int r = 4; r < 16; r += 4) { a_ = max3f(a_, p0[r], p0[r + 1]); b_ = max3f(b_, p0[r + 2], p0[r + 3]); a_ = max3f(a_, p1[r], p1[r + 1]); b_ = max3f(b_, p1[r + 2], p1[r + 3]); }
              rm = halves_max(fmaxf(a_, b_)); }
            if (__any(rm > THR)) {
                const float dl = fmaxf(rm, 0.f); mref += dl; const float alpha = __builtin_amdgcn_exp2f(-dl);
#pragma unroll
                for (int r = 0; r < 16; ++r) { p0[r] -= dl; p1[r] -= dl; }
                if (!skipN) {
#pragma unroll
                    for (int r = 0; r < 16; ++r) { n0[r] -= dl; n1[r] -= dl; } }
                l *= alpha;
#pragma unroll
                for (int d0 = 0; d0 < DVB; ++d0) o[d0] = o[d0] * alpha;
            }
            float sacc = 0.f;
            if (!ABL(3)) {
#pragma unroll
            for (int r = 0; r < 16; ++r) { p0[r] = __builtin_amdgcn_exp2f(p0[r]); p1[r] = __builtin_amdgcn_exp2f(p1[r]); sacc += p0[r] + p1[r]; } }
            l += sacc;
            u32x4 pw[4];
            pw[0] = (u32x4){cvtpk(p0[0], p0[1]), cvtpk(p0[2], p0[3]), cvtpk(p0[4], p0[5]), cvtpk(p0[6], p0[7])};
            pw[1] = (u32x4){cvtpk(p0[8], p0[9]), cvtpk(p0[10], p0[11]), cvtpk(p0[12], p0[13]), cvtpk(p0[14], p0[15])};
            pw[2] = (u32x4){cvtpk(p1[0], p1[1]), cvtpk(p1[2], p1[3]), cvtpk(p1[4], p1[5]), cvtpk(p1[6], p1[7])};
            pw[3] = (u32x4){cvtpk(p1[8], p1[9]), cvtpk(p1[10], p1[11]), cvtpk(p1[12], p1[13]), cvtpk(p1[14], p1[15])};
            if (!ABL(1))
#pragma unroll
            for (int i = 0; i < 4 * DVB; ++i) { constexpr int NM = 4 * DVB; const int s_ = i & 3; if (i == 0) ATT_PRIO(1);
                if (i + 3 < NM) ATT_WAIT2(6, vl_[s_], vh_[s_]); else if (i + 3 == NM) ATT_WAIT2(4, vl_[s_], vh_[s_]); else if (i + 2 == NM) ATT_WAIT2(2, vl_[s_], vh_[s_]); else ATT_WAIT2(0, vl_[s_], vh_[s_]);
                const u32x4 vf = (u32x4){vl_[s_][0], vl_[s_][1], vh_[s_][0], vh_[s_][1]};
                o[i >> 2] = __builtin_amdgcn_mfma_f32_32x32x16_bf16(__builtin_bit_cast(bf16x8, vf), __builtin_bit_cast(bf16x8, pw[i & 3]), o[i >> 2], 0, 0, 0);
                if (i + 4 < NM) { ATT_RDTR(vl_[s_], va_, (i + 4) * 1024); ATT_RDTR(vh_[s_], va_, (i + 4) * 1024 + 512); } if (i == NM - 1) ATT_PRIO(0); }
        }
        p0 = n0; p1 = n1; skipC = skipN; maskC = maskN; selC = selN; t = tn; tn = tnn;
    }
#undef ATT_ISSUE_K
#undef ATT_ISSUE_V
#undef ATT_CLASS
#undef ATT_QK
    __builtin_amdgcn_s_setprio(0);
    if (ABL(5)) return;
    f32x4 sg4[DVB][4];
    if constexpr (MODE == 0) {
#pragma unroll
        for (int d0 = 0; d0 < DVB; ++d0)
#pragma unroll
            for (int g = 0; g < 4; ++g) sg4[d0][g] = *(const GAS f32x4*)(A.subln + d0 * 32 + 8 * g + 4 * hi); }
    l = halves_sum(l);
    const float rl = 1.0f / l;
    GAS bf16_t* Ow = (GAS bf16_t*)(A.O + (rowbase + q0 + qrel0 + r32) * PITCH + hcol) + 8 * hi;
#define ATT_STORE_PAIR(d0, gp, V0, V1, V2, V3, W0, W1, W2, W3) do { \
        const unsigned ax_ = cvtpk(V0, V1), ay_ = cvtpk(V2, V3), bx_ = cvtpk(W0, W1), by_ = cvtpk(W2, W3); \
        auto rx_ = __builtin_amdgcn_permlane32_swap(ax_, bx_, false, false); auto ry_ = __builtin_amdgcn_permlane32_swap(ay_, by_, false, false); \
        *(GAS u32x4*)(Ow + (d0) * 32 + 16 * (gp)) = (u32x4){rx_[0], ry_[0], rx_[1], ry_[1]}; } while (0)
    if constexpr (MODE == 1) {
#pragma unroll
        for (int d0 = 0; d0 < DVB; ++d0)
#pragma unroll
            for (int gp = 0; gp < 2; ++gp) ATT_STORE_PAIR(d0, gp, o[d0][8 * gp + 0] * rl, o[d0][8 * gp + 1] * rl, o[d0][8 * gp + 2] * rl, o[d0][8 * gp + 3] * rl,
                                                                 o[d0][8 * gp + 4] * rl, o[d0][8 * gp + 5] * rl, o[d0][8 * gp + 6] * rl, o[d0][8 * gp + 7] * rl);
    } else {
        ATT_BAR();
        LAS float* X = (LAS float*)lds + wq * 4096;
        if (comp == 1) {
#pragma unroll
            for (int d0 = 0; d0 < DVB; ++d0)
#pragma unroll
                for (int r = 0; r < 16; ++r) X[(d0 * 16 + r) * 64 + lane] = o[d0][r] * rl;
        }
        ATT_BAR();
        if (comp == 0) {
            float ss = 0.f;
#pragma unroll
            for (int d0 = 0; d0 < DVB; ++d0)
#pragma unroll
                for (int r = 0; r < 16; ++r) { o[d0][r] = o[d0][r] * rl - A.lam_full * X[(d0 * 16 + r) * 64 + lane]; ss += o[d0][r] * o[d0][r]; }
            ss = halves_sum(ss);
            const float rs = A.out_scale / sqrtf(ss * (1.0f / 128.0f) + 1e-5f);
#pragma unroll
            for (int d0 = 0; d0 < DVB; ++d0)
#pragma unroll
                for (int gp = 0; gp < 2; ++gp) { const f32x4 ga = sg4[d0][2 * gp], gb = sg4[d0][2 * gp + 1];
                    ATT_STORE_PAIR(d0, gp, o[d0][8 * gp + 0] * rs * ga[0], o[d0][8 * gp + 1] * rs * ga[1], o[d0][8 * gp + 2] * rs * ga[2], o[d0][8 * gp + 3] * rs * ga[3],
                                           o[d0][8 * gp + 4] * rs * gb[0], o[d0][8 * gp + 5] * rs * gb[1], o[d0][8 * gp + 6] * rs * gb[2], o[d0][8 * gp + 7] * rs * gb[3]); }
        }
    }
#undef ATT_STORE_PAIR
#undef ATT_KBASE
#undef ATT_KBASE_
#undef ATT_ISSUE
}
#undef ATT_BAR
}

constexpr int NWAVES = 8;
constexpr int NLAYER = 4, PH_PER_LAYER = 8, NPHASE = 1 + NLAYER * PH_PER_LAYER;

constexpr size_t MiB = 1u << 20;
constexpr size_t WS_CTL = 0, CTL_ZERO_BYTES = 1 * MiB;
constexpr size_t WS_KMEAN = 1 * MiB;
constexpr size_t WS_LTOK = 2 * MiB, WS_LW = 3 * MiB;
constexpr size_t WS_DQKV = 5 * MiB;
constexpr size_t WS_DWO = WS_DQKV + 12 * MiB;
constexpr size_t WS_MQKV = WS_DWO + 4 * MiB;
constexpr size_t WS_MWO = WS_MQKV + 12 * MiB;
constexpr size_t WS_FGU = WS_MWO + 4 * MiB;
constexpr size_t WS_FD = WS_FGU + 22 * MiB;
constexpr size_t WS_MGU = WS_FD + 11 * MiB;
constexpr size_t WS_MD = WS_MGU + 112 * MiB;
constexpr size_t WS_XN = WS_MD + 56 * MiB;
constexpr size_t WS_Q = WS_XN + 64 * MiB, WS_K = WS_Q + 64 * MiB, WS_V = WS_K + 64 * MiB;
constexpr size_t WS_ACT = WS_Q;
constexpr size_t WS_END = WS_ACT + (size_t)MOE_TILES_MAX * 256 * DE * 2;
constexpr size_t WS_Y0 = WS_END - 64 * MiB;
constexpr size_t WS_HB = WS_END;
static_assert(WS_XN == 238 * MiB && WS_END == 778 * MiB, "d_ws map");
constexpr int CW_BAR = 4096;
constexpr int CW_ATTQ = 6144;
constexpr int CW_ATTQ2 = 12288;
constexpr int CW_CNT = 8192;

constexpr int RING_OFF = 0, RING_BYTES = 131072;
constexpr int LDSCTL_OFF = RING_BYTES, MISC_OFF = LDSCTL_OFF + 320;
constexpr int XSLOT_OFF = MISC_OFF + 128;
constexpr int LDS_BYTES = 147456;

typedef unsigned short bf16;
typedef unsigned v4u __attribute__((ext_vector_type(4)));
typedef float f32x4 __attribute__((ext_vector_type(4)));
typedef GAS unsigned gu32;
#define RLX_AGENT __ATOMIC_RELAXED, __HIP_MEMORY_SCOPE_AGENT
#define LDS_WAIT() asm volatile("s_waitcnt lgkmcnt(0)" ::: "memory")
#define VM_WAIT() asm volatile("s_waitcnt vmcnt(0)" ::: "memory")
__device__ __forceinline__ unsigned f2bf(float f) { unsigned u = __builtin_bit_cast(unsigned, f); return (u + 0x7fffu + ((u >> 16) & 1u)) >> 16; }
__device__ __forceinline__ unsigned pk2(float lo, float hi) { return f2bf(lo) | (f2bf(hi) << 16); }
__device__ __forceinline__ float bflo(unsigned w) { return __uint_as_float(w << 16); }
__device__ __forceinline__ float bfhi(unsigned w) { return __uint_as_float(w & 0xFFFF0000u); }
static_assert(XSLOT_OFF % 16 == 0 && XSLOT_OFF + 8192 <= LDS_BYTES, "LDS map");
#define XB_TMO      128
#define XB_XCNT(j)  (256  + 64 * (j))
#define XB_XSUB(j)  (1280 + 64 * (j))
#define XB_XGEN(j)  (2304 + 64 * (j))
#define XB_TOP      3328
#define XB_TOPGEN   3392
#define XCD_BAR_WORDS 3456
#define XB_SPIN_CAP (1u << 18)

__device__ __forceinline__ unsigned xb_ld(unsigned* p)              { return __hip_atomic_load(p, __ATOMIC_RELAXED, __HIP_MEMORY_SCOPE_AGENT); }
__device__ __forceinline__ unsigned xb_add(unsigned* p, unsigned v) { return __hip_atomic_fetch_add(p, v, __ATOMIC_RELAXED, __HIP_MEMORY_SCOPE_AGENT); }
__device__ __forceinline__ unsigned xb_xcc_id() { return (unsigned)__builtin_amdgcn_s_getreg((3 << 11) | 20) & 0xFu; }
#define XB_SPIN(cond, bar) do { unsigned _sp = 0; while (cond) { __builtin_amdgcn_s_sleep(1); \
    if ((++_sp & 255u) == 0u) { if (xb_ld(&(bar)[XB_TMO])) break; if (_sp > XB_SPIN_CAP) { atomicAdd(&(bar)[XB_TMO], 1u); break; } } } } while (0)

struct XcdBarrier {
    unsigned* bar; unsigned x;
    volatile LAS unsigned* st;
};

__device__ __forceinline__ XcdBarrier xcd_barrier_post(unsigned* bar, volatile LAS unsigned* st) {
    XcdBarrier b; b.bar = bar; b.x = xb_xcc_id(); b.st = st;
    if (threadIdx.x == 0) (void)xb_add(&bar[XB_XCNT(b.x)], 1u);
    return b;
}
__device__ __forceinline__ void xcd_barrier_complete(unsigned* bar, unsigned x, unsigned& nloc, unsigned& nx) {
    const unsigned G = gridDim.x * gridDim.y * gridDim.z;
    unsigned sum, cnt, mine, sp = 0u;
    for (;;) {
        sum = 0u; cnt = 0u; mine = 0u;
#pragma unroll
        for (unsigned j = 0; j < 16; ++j) { const unsigned c = xb_ld(&bar[XB_XCNT(j)]); sum += c; cnt += (c > 0u) ? 1u : 0u; mine = (j == x) ? c : mine; }
        if (sum == G) break;
        __builtin_amdgcn_s_sleep(1);
        if ((++sp & 255u) == 0u) { if (xb_ld(&bar[XB_TMO])) break; if (sp > XB_SPIN_CAP) { atomicAdd(&bar[XB_TMO], 1u); break; } }
    }
    nloc = mine > 0u ? mine : 1u; nx = cnt > 0u ? cnt : 1u;
}

__device__ __forceinline__ void xcd_barrier(const XcdBarrier& b) {
    asm volatile("s_waitcnt vmcnt(0)" ::: "memory");
    __syncthreads();
    if (threadIdx.x == 0) {
        unsigned* bar = b.bar;
        __builtin_amdgcn_s_waitcnt(0);
        unsigned nloc = b.st[0], nx = b.st[1];
        if (nloc == 0u) { xcd_barrier_complete(bar, b.x, nloc, nx); b.st[0] = nloc; b.st[1] = nx; }
        const unsigned old = xb_add(&bar[XB_XSUB(b.x)], 1u);
        const unsigned gen = old / nloc;
        if (old + 1u == (gen + 1u) * nloc) {
            __builtin_amdgcn_fence(__ATOMIC_RELEASE, "agent");
            asm volatile("s_waitcnt vmcnt(0)" ::: "memory");
            const unsigned og = xb_add(&bar[XB_TOP], 1u);
            const unsigned tg = og / nx;
            if (og + 1u == (tg + 1u) * nx) xb_add(&bar[XB_TOPGEN], 1u);
            else XB_SPIN(xb_ld(&bar[XB_TOPGEN]) == tg, bar);
            __builtin_amdgcn_fence(__ATOMIC_ACQUIRE, "agent");
            xb_add(&bar[XB_XGEN(b.x)], 1u);
            asm volatile("s_waitcnt vmcnt(0)" ::: "memory");
        } else {
            XB_SPIN(xb_ld(&bar[XB_XGEN(b.x)]) == gen, bar);
            __builtin_amdgcn_fence(__ATOMIC_ACQUIRE, "agent");
            asm volatile("s_waitcnt vmcnt(0)" ::: "memory");
        }
    }
    __syncthreads();
}

struct Frame {
    LAS unsigned char* lds;
    volatile LAS unsigned* MISC;
    gu32* ctl;
    int tid, lane, wave;
    int vcu, G;
};
__device__ __forceinline__ float wave_sum(float v) {
    v += __int_as_float(__builtin_amdgcn_update_dpp(0, __float_as_int(v), 0xB1, 0xF, 0xF, true));
    v += __int_as_float(__builtin_amdgcn_update_dpp(0, __float_as_int(v), 0x4E, 0xF, 0xF, true));
    v += __int_as_float(__builtin_amdgcn_update_dpp(0, __float_as_int(v), 0x141, 0xF, 0xF, true));
    v += __int_as_float(__builtin_amdgcn_update_dpp(0, __float_as_int(v), 0x140, 0xF, 0xF, true));
    v += __int_as_float(__builtin_amdgcn_ds_swizzle(__float_as_int(v), 0x401F));
    auto rr = __builtin_amdgcn_permlane32_swap(__float_as_uint(v), __float_as_uint(v), false, false);
    return __uint_as_float(rr[0]) + __uint_as_float(rr[1]);
}
__device__ __forceinline__ void transpose_item(const float* W, int K, int N, void* WT, int k0, int n0, int drow0, LAS float* scr, int lane, bool f8, float wscale) {
    (void)scr;
    const int kq = lane & 7, ns = lane >> 3;
    const GAS f32x4* src = (const GAS f32x4*)((const GAS float*)W + (size_t)(k0 + 8 * kq) * N + n0) + ns;
    f32x4 v[2][8];
#pragma unroll
    for (int i = 0; i < 8; ++i)
#pragma unroll
        for (int m = 0; m < 2; ++m) v[m][i] = src[(size_t)i * (N >> 2) + 8 * m];
#pragma unroll
    for (int m = 0; m < 2; ++m)
#pragma unroll
        for (int j = 0; j < 4; ++j) { const int n = 32 * m + 4 * ns + j;
            if (f8) {
                const unsigned lo = pg8::pk4_fp8(v[m][0][j] * wscale, v[m][1][j] * wscale, v[m][2][j] * wscale, v[m][3][j] * wscale), hi = pg8::pk4_fp8(v[m][4][j] * wscale, v[m][5][j] * wscale, v[m][6][j] * wscale, v[m][7][j] * wscale);
                *(GAS unsigned long long*)((unsigned char*)WT + (size_t)(drow0 + n) * K + k0 + 8 * kq) = (unsigned long long)lo | ((unsigned long long)hi << 32);
            } else {
                v4u o; o.x = pk2(v[m][0][j], v[m][1][j]); o.y = pk2(v[m][2][j], v[m][3][j]); o.z = pk2(v[m][4][j], v[m][5][j]); o.w = pk2(v[m][6][j], v[m][7][j]);
                *(GAS v4u*)((bf16*)WT + (size_t)(drow0 + n) * K + k0 + 8 * kq) = o; }
        }
}
__device__ __forceinline__ void convert_matrix(Frame& F, const float* W, int K, int N, void* WT, int il, unsigned& rot, bool f8 = false, float wscale = 1.0f) {
    LAS float* scr = (LAS float*)(F.lds + RING_OFF + F.wave * 16384);
    const unsigned gw = (unsigned)(F.vcu * NWAVES + F.wave), NGW = (unsigned)(F.G * NWAVES);
    const int nblk = N / 64, nitems = (K / 64) * nblk; int lane_ = F.lane; asm volatile("" : "+v"(lane_));
    for (int it = (int)((gw + NGW - rot % NGW) % NGW); it < nitems; it += (int)NGW) {
        const int kb = it / nblk, nb = it % nblk, n0 = 64 * nb;
        const int drow0 = il == 0 ? n0 : (n0 / 128) * 256 + (il - 1) * 128 + (n0 % 128);
        transpose_item(W, K, N, WT, 64 * kb, n0, drow0, scr, lane_, f8, wscale);
    }
    rot = (rot + (unsigned)nitems) % NGW;
}

struct RouterArgs { const float* router; gu32* cnt; unsigned* ltok; float* lw; };
template <int MODE, bool F8X = false, bool SF32 = false>
__device__ __forceinline__ void norm_phase(Frame& F, const void* src, bf16* hout, const bf16* y1, const float* gain, bf16* xn, float* fout, const RouterArgs& R, const bf16* y0 = nullptr) {
    int lane_ = F.lane; asm volatile("" : "+v"(lane_));
    const int gw = F.vcu * NWAVES + F.wave, NGW = F.G * NWAVES, lane = lane_;
    f32x4 gv[4];
#pragma unroll
    for (int j = 0; j < 4; ++j) gv[j] = *(const GAS f32x4*)(gain + 256 * j + 4 * lane);
    LAS float* RL = (LAS float*)(F.lds + RING_OFF);
    if constexpr (MODE == 2) {
        int tid_ = F.tid; asm volatile("" : "+v"(tid_));
        for (int i = tid_; i < 8192; i += NWAVES * 64) RL[(i & 7) * 1024 + (i >> 3)] = ((const GAS float*)R.router)[i];
        LDS_WAIT(); __syncthreads();
    }
    const int nrows_w = gw < MTOK ? (MTOK - gw + NGW - 1) / NGW : 0;
    for (int cb = 0; cb < nrows_w; cb += 64) {
        int my_t = 0, my_e0 = 0, my_e1 = 0; float my_w0 = 0.f, my_w1 = 0.f; bool valid = false;
        const int cn = (nrows_w - cb) < 64 ? (nrows_w - cb) : 64;
        f32x4 vn[4]; unsigned long long yn[4], zn[4];
        unsigned long long hn[4];
        { const int row0_ = gw + cb * NGW;
          if constexpr (SF32) { const GAS f32x4* xr = (const GAS f32x4*)((const float*)src + (size_t)row0_ * D) + lane;
#pragma unroll
            for (int j = 0; j < 4; ++j) vn[j] = xr[64 * j];
          } else { const GAS unsigned long long* hr_ = (const GAS unsigned long long*)((const bf16*)src + (size_t)row0_ * D) + lane;
#pragma unroll
            for (int j = 0; j < 4; ++j) hn[j] = hr_[64 * j]; }
          if constexpr (MODE == 1 || MODE == 3) { const GAS unsigned long long* yr = (const GAS unsigned long long*)(y1 + (size_t)row0_ * D) + lane, *zr = (const GAS unsigned long long*)(y0 + (size_t)row0_ * D) + lane;
#pragma unroll
            for (int j = 0; j < 4; ++j) { yn[j] = yr[64 * j]; zn[j] = zr[64 * j]; } } }
        for (int i = 0; i < cn; ++i) {
            const int row = gw + (cb + i) * NGW;
            f32x4 v[4]; float s = 0.f;
#pragma unroll
            for (int j = 0; j < 4; ++j) { if constexpr (SF32) v[j] = vn[j]; else { const unsigned long long w = hn[j]; const unsigned lo = (unsigned)w, hi = (unsigned)(w >> 32); v[j] = (f32x4){bflo(lo), bfhi(lo), bflo(hi), bfhi(hi)}; } }
            if constexpr (MODE == 1 || MODE == 3) {
#pragma unroll
                for (int j = 0; j < 4; ++j) { const unsigned long long w = yn[j], z = zn[j]; const unsigned lo = (unsigned)w, hi = (unsigned)(w >> 32), zl = (unsigned)z, zh = (unsigned)(z >> 32);
                    v[j].x += bflo(zl) + bflo(lo); v[j].y += bfhi(zl) + bfhi(lo); v[j].z += bflo(zh) + bflo(hi); v[j].w += bfhi(zh) + bfhi(hi); }
            }
            if (i + 1 < cn) { const int rown = row + NGW;
                if constexpr (SF32) { const GAS f32x4* xr = (const GAS f32x4*)((const float*)src + (size_t)rown * D) + lane;
#pragma unroll
                    for (int j = 0; j < 4; ++j) vn[j] = xr[64 * j];
                } else { const GAS unsigned long long* hr_ = (const GAS unsigned long long*)((const bf16*)src + (size_t)rown * D) + lane;
#pragma unroll
                    for (int j = 0; j < 4; ++j) hn[j] = hr_[64 * j]; }
                if constexpr (MODE == 1 || MODE == 3) { const GAS unsigned long long* yr = (const GAS unsigned long long*)(y1 + (size_t)rown * D) + lane, *zr = (const GAS unsigned long long*)(y0 + (size_t)rown * D) + lane;
#pragma unroll
                    for (int j = 0; j < 4; ++j) { yn[j] = yr[64 * j]; zn[j] = zr[64 * j]; } } }
#pragma unroll
            for (int j = 0; j < 4; ++j) s += (v[j].x * v[j].x + v[j].y * v[j].y) + (v[j].z * v[j].z + v[j].w * v[j].w);
            if constexpr (MODE == 1) { GAS unsigned long long* hr = (GAS unsigned long long*)(hout + (size_t)row * D) + lane;
#pragma unroll
                for (int j = 0; j < 4; ++j) { const unsigned long long hw = (unsigned long long)pk2(v[j].x, v[j].y) | ((unsigned long long)pk2(v[j].z, v[j].w) << 32); hr[64 * j] = hw;
                    v[j] = (f32x4){bflo((unsigned)hw), bfhi((unsigned)hw), bflo((unsigned)(hw >> 32)), bfhi((unsigned)(hw >> 32))}; } }
            const float rstd = 1.f / sqrtf(wave_sum(s) * (1.f / D) + 1e-6f);
#pragma unroll
            for (int j = 0; j < 4; ++j) v[j] = v[j] * rstd * gv[j];
            if constexpr (MODE == 3) { GAS f32x4* orow = (GAS f32x4*)(fout + (size_t)row * D) + lane;
#pragma unroll
                for (int j = 0; j < 4; ++j) orow[64 * j] = v[j];
            } else {
                if constexpr (F8X) { GAS unsigned* o4 = (GAS unsigned*)((unsigned char*)xn + (size_t)row * D) + lane;
#pragma unroll
                    for (int j = 0; j < 4; ++j) o4[64 * j] = pg8::pk4_fp8(v[j].x, v[j].y, v[j].z, v[j].w);
                } else { GAS unsigned long long* o8 = (GAS unsigned long long*)(xn + (size_t)row * D) + lane;
#pragma unroll
                    for (int j = 0; j < 4; ++j) o8[64 * j] = (unsigned long long)pk2(v[j].x, v[j].y) | ((unsigned long long)pk2(v[j].z, v[j].w) << 32); }
            }
            if constexpr (MODE == 2) {
                float lg[NE];
#pragma unroll
                for (int e = 0; e < NE; ++e) { float a = 0.f;
#pragma unroll
                    for (int j = 0; j < 4; ++j) { const f32x4 rr = *(const LAS f32x4*)(RL + e * 1024 + 256 * j + 4 * lane); a += (v[j].x * rr.x + v[j].y * rr.y) + (v[j].z * rr.z + v[j].w * rr.w); }
                    lg[e] = wave_sum(a); }
                int e0 = 0; float v0 = lg[0];
#pragma unroll
                for (int e = 1; e < NE; ++e) if (lg[e] > v0) { v0 = lg[e]; e0 = e; }
                int e1 = -1; float v1 = 0.f;
#pragma unroll
                for (int e = 0; e < NE; ++e) if (e != e0 && (e1 < 0 || lg[e] > v1)) { v1 = lg[e]; e1 = e; }
                const float w0 = 1.f / (1.f + __expf(v1 - v0));
                if (lane == i) { my_t = row; my_e0 = e0; my_e1 = e1; my_w0 = w0; my_w1 = 1.f - w0; valid = true; }
            }
        }
        if constexpr (MODE == 2) {
            unsigned myc = 0u;
#pragma unroll
            for (int e = 0; e < NE; ++e) { const unsigned long long b0 = __ballot(valid && my_e0 == e), b1 = __ballot(valid && my_e1 == e);
                const unsigned c = (unsigned)(__popcll(b0) + __popcll(b1)); if (lane == e) myc = c; }
            unsigned basev = 0u;
            if (lane < NE) basev = __hip_atomic_fetch_add(R.cnt + 64 * lane, myc, RLX_AGENT);
            const unsigned long long lt = (1ull << lane) - 1ull;
            unsigned pos0 = 0u, pos1 = 0u;
#pragma unroll
            for (int e = 0; e < NE; ++e) { const unsigned long long b0 = __ballot(valid && my_e0 == e), b1 = __ballot(valid && my_e1 == e);
                const unsigned be = (unsigned)__shfl((int)basev, e);
                if (my_e0 == e) pos0 = be + (unsigned)__popcll(b0 & lt);
                if (my_e1 == e) pos1 = be + (unsigned)__popcll(b0) + (unsigned)__popcll(b1 & lt); }
            if (valid) {
                ((GAS unsigned*)R.ltok)[(size_t)my_e0 * LIST_CAP + pos0] = (unsigned)my_t;             ((GAS float*)R.lw)[(size_t)my_e0 * LIST_CAP + pos0] = my_w0;
                ((GAS unsigned*)R.ltok)[(size_t)my_e1 * LIST_CAP + pos1] = (unsigned)my_t | (1u << 20); ((GAS float*)R.lw)[(size_t)my_e1 * LIST_CAP + pos1] = my_w1;
            }
        }
    }
    if constexpr (MODE == 2) { LDS_WAIT(); __syncthreads(); }
}

__device__ __forceinline__ void kstat_phase(Frame& F, const bf16* Kt, float* kmean, float* kmax2) {
    int lane_ = F.lane; asm volatile("" : "+v"(lane_));
    const int gw = F.vcu * NWAVES + F.wave, NGW = F.G * NWAVES, lane = lane_;
    for (int task = gw; task < BATCH * 16 * 16; task += NGW) {
        const int hh = task & 15, n = (task >> 4) & 15, b = task >> 8, l5 = lane & 31, hf = lane >> 5;
        const GAS unsigned* p = (const GAS unsigned*)(Kt + ((size_t)b * SEQ + 256 * n + 128 * hf) * D + hh * 64) + l5;
        float a0 = 0.f, a1 = 0.f, mx = 0.f;
#pragma unroll 32
        for (int r = 0; r < 128; ++r) { const unsigned w = p[(size_t)r * (D / 2)]; const float v0 = bflo(w), v1 = bfhi(w); a0 += v0; a1 += v1;
            float s = v0 * v0 + v1 * v1;
            s += __int_as_float(__builtin_amdgcn_update_dpp(0, __float_as_int(s), 0xB1, 0xF, 0xF, true)); s += __int_as_float(__builtin_amdgcn_update_dpp(0, __float_as_int(s), 0x4E, 0xF, 0xF, true));
            s += __int_as_float(__builtin_amdgcn_update_dpp(0, __float_as_int(s), 0x141, 0xF, 0xF, true)); s += __int_as_float(__builtin_amdgcn_update_dpp(0, __float_as_int(s), 0x140, 0xF, 0xF, true));
            s += __int_as_float(__builtin_amdgcn_ds_swizzle(__float_as_int(s), 0x401F)); mx = fmaxf(mx, s); }
        { auto r0 = __builtin_amdgcn_permlane32_swap(__float_as_uint(a0), __float_as_uint(a0), false, false); a0 = __uint_as_float(r0[0]) + __uint_as_float(r0[1]);
          auto r1 = __builtin_amdgcn_permlane32_swap(__float_as_uint(a1), __float_as_uint(a1), false, false); a1 = __uint_as_float(r1[0]) + __uint_as_float(r1[1]);
          auto r2 = __builtin_amdgcn_permlane32_swap(__float_as_uint(mx), __float_as_uint(mx), false, false); mx = fmaxf(__uint_as_float(r2[0]), __uint_as_float(r2[1])); }
        if (hf == 0) { GAS float* o = (GAS float*)(kmean + ((size_t)(b * 16 + hh) * 16 + n) * 64 + 2 * l5);
            o[0] = a0 * (1.f / 256.f); o[1] = a1 * (1.f / 256.f); }
        if (lane == 0) ((GAS float*)kmax2)[(size_t)(b * 16 + hh) * 16 + n] = mx;
    }
}

struct KArgs { const float* in[17]; float* out; unsigned char* ws; int ph_lo, ph_hi; };
struct ConvDesc { const float* W; int K, N; unsigned char* WT; int il; bool f8; float sc; };
constexpr int NCONV = 61, CONV_CH = 128;
__device__ __forceinline__ ConvDesc conv_desc(const KArgs& args, unsigned char* ws, int m) {
    constexpr float WSC_UP = 32.0f, WSC_DN = 64.0f;
    ConvDesc d; d.il = 0; d.f8 = false; d.sc = 1.0f;
    if (m < 2) { d.W = args.in[7] + (size_t)m * D * 3 * D; d.K = D; d.N = 3 * D; d.WT = ws + WS_MQKV + (size_t)m * 3 * D * D * 2; }
    else if (m < 4) { const int j = m - 2; d.W = args.in[8] + (size_t)j * D * D; d.K = D; d.N = D; d.WT = ws + WS_MWO + (size_t)j * D * D * 2; }
    else if (m == 4) { d.W = args.in[4]; d.K = D; d.N = D; d.WT = ws + WS_DWO; }
    else if (m == 5) { d.W = args.in[3] + (size_t)D * 3 * D; d.K = D; d.N = 3 * D; d.WT = ws + WS_DQKV + (size_t)3 * D * D * 2; }
    else if (m == 6) { d.W = args.in[4] + (size_t)D * D; d.K = D; d.N = D; d.WT = ws + WS_DWO + (size_t)D * D * 2; }
    else if (m < 13) { const int r = m - 7, j = r / 3, t = r % 3; d.f8 = (j == 1);
        if (t < 2) { d.W = args.in[9 + t] + (size_t)j * D * DFF; d.K = D; d.N = DFF; d.WT = ws + WS_FGU + (size_t)j * 2 * DFF * D * 2; d.il = 1 + t; d.sc = d.f8 ? WSC_UP : 1.0f; }
        else { d.W = args.in[11] + (size_t)j * DFF * D; d.K = DFF; d.N = D; d.WT = ws + WS_FD + (size_t)j * D * DFF * 2; d.sc = d.f8 ? WSC_DN : 1.0f; } }
    else { const int r = m - 13, e = r / 3, t = r % 3; d.f8 = true;
        if (t < 2) { d.W = args.in[13 + t] + (size_t)e * D * DE; d.K = D; d.N = DE; d.WT = ws + WS_MGU + (size_t)e * 2 * DE * D; d.il = 1 + t; d.sc = WSC_UP; }
        else { d.W = args.in[15] + (size_t)e * DE * D; d.K = DE; d.N = D; d.WT = ws + WS_MD + (size_t)e * D * DE; d.sc = WSC_DN; } }
    return d;
}
__device__ __forceinline__ int conv_chunks_of(int m) { const int items = m < 2 || m == 5 ? 768 : (m < 7 ? 256 : (m < 13 ? 704 : 896)); return (items + CONV_CH - 1) / CONV_CH; }
__device__ __forceinline__ int conv_total_chunks() { int s = 0; for (int m = 0; m < NCONV; ++m) s += conv_chunks_of(m); return s; }
__device__ __forceinline__ void conv_chunk(Frame& F, const KArgs& args, unsigned char* ws, int c) {
    int m = 0; for (; m < NCONV; ++m) { const int n = conv_chunks_of(m); if (c < n) break; c -= n; }
    const ConvDesc d = conv_desc(args, ws, m);
    LAS float* scr = (LAS float*)(F.lds + RING_OFF + F.wave * 16384);
    int lane_ = F.lane; asm volatile("" : "+v"(lane_));
    const int nblk = d.N / 64, nitems = (d.K / 64) * nblk, last = (c + 1) * CONV_CH < nitems ? (c + 1) * CONV_CH : nitems;
    (void)scr;
    const int kq = lane_ & 7, ns = lane_ >> 3;
    const int first = c * CONV_CH + F.wave, nit = first < last ? (last - first + NWAVES - 1) / NWAVES : 0;
#define CONV_LOAD(v, i_) do { const int it_ = first + NWAVES * (i_), kb_ = it_ / nblk, nb_ = it_ % nblk; \
        const GAS f32x4* src_ = (const GAS f32x4*)((const GAS float*)d.W + (size_t)(64 * kb_ + 8 * kq) * d.N + 64 * nb_) + ns; \
        _Pragma("unroll") for (int i = 0; i < 8; ++i) { asm volatile("global_load_dwordx4 %0, %1, off" : "=v"(v[0][i]) : "v"(src_ + (size_t)i * (d.N >> 2))); \
                                                       asm volatile("global_load_dwordx4 %0, %1, off" : "=v"(v[1][i]) : "v"(src_ + (size_t)i * (d.N >> 2) + 8)); } } while (0)
#define CONV_WAIT(N, v) asm volatile("s_waitcnt vmcnt(" #N ")" : "+v"(v[0][0]), "+v"(v[0][1]), "+v"(v[0][2]), "+v"(v[0][3]), "+v"(v[0][4]), "+v"(v[0][5]), "+v"(v[0][6]), "+v"(v[0][7]), \
                                                                  "+v"(v[1][0]), "+v"(v[1][1]), "+v"(v[1][2]), "+v"(v[1][3]), "+v"(v[1][4]), "+v"(v[1][5]), "+v"(v[1][6]), "+v"(v[1][7]))
#define CONV_STORE(F8, v, i_) do { const int it_ = first + NWAVES * (i_), kb_ = it_ / nblk, nb_ = it_ % nblk, n0_ = 64 * nb_, k0_ = 64 * kb_; const int drow0_ = d.il == 0 ? n0_ : (n0_ / 128) * 256 + (d.il - 1) * 128 + (n0_ % 128); \
        _Pragma("unroll") for (int m = 0; m < 2; ++m) _Pragma("unroll") for (int j = 0; j < 4; ++j) { const int n = 32 * m + 4 * ns + j; \
            if (F8) { const float ws_ = d.sc; \
                const unsigned lo = pg8::pk4_fp8(v[m][0][j] * ws_, v[m][1][j] * ws_, v[m][2][j] * ws_, v[m][3][j] * ws_), hi = pg8::pk4_fp8(v[m][4][j] * ws_, v[m][5][j] * ws_, v[m][6][j] * ws_, v[m][7][j] * ws_); \
                *(GAS unsigned long long*)((unsigned char*)d.WT + (size_t)(drow0_ + n) * d.K + k0_ + 8 * kq) = (unsigned long long)lo | ((unsigned long long)hi << 32); \
            } else { v4u o; o.x = pk2(v[m][0][j], v[m][1][j]); o.y = pk2(v[m][2][j], v[m][3][j]); o.z = pk2(v[m][4][j], v[m][5][j]); o.w = pk2(v[m][6][j], v[m][7][j]); \
                *(GAS v4u*)((bf16*)d.WT + (size_t)(drow0_ + n) * d.K + k0_ + 8 * kq) = o; } } } while (0)
#define CONV_RUN(F8) do { f32x4 va[2][8], vb[2][8]; int i = 0; \
        if (nit > 0) { CONV_LOAD(va, 0); \
            if (nit > 2) { CONV_LOAD(vb, 1); CONV_WAIT(16, va); CONV_STORE(F8, va, 0); CONV_LOAD(va, 2); CONV_WAIT(24, vb); CONV_STORE(F8, vb, 1); i = 2; \
                for (; i + 2 < nit; i += 2) { CONV_LOAD(vb, i + 1); CONV_WAIT(24, va); CONV_STORE(F8, va, i); CONV_LOAD(va, i + 2); CONV_WAIT(24, vb); CONV_STORE(F8, vb, i + 1); } } \
            if (i + 1 < nit) { CONV_LOAD(vb, i + 1); CONV_WAIT(16, va); CONV_STORE(F8, va, i); CONV_WAIT(0, vb); CONV_STORE(F8, vb, i + 1); } else { CONV_WAIT(0, va); CONV_STORE(F8, va, i); } } } while (0)
    if (d.f8) CONV_RUN(true); else CONV_RUN(false);
#undef CONV_RUN
#undef CONV_LOAD
#undef CONV_WAIT
#undef CONV_STORE
}

__global__ void __launch_bounds__(NWAVES * 64, 2) trunk_fwd(KArgs args) {
    extern __shared__ __attribute__((aligned(16))) unsigned char lds[];
    Frame F;
    F.lds = (LAS unsigned char*)lds;
    F.MISC = (volatile LAS unsigned*)(F.lds + MISC_OFF);
    F.tid = threadIdx.x; F.lane = F.tid & 63; F.wave = __builtin_amdgcn_readfirstlane(F.tid >> 6);
    F.G = gridDim.x; { const int bx = blockIdx.x; F.vcu = (F.G % 8 == 0) ? (bx % 8) * (F.G / 8) + bx / 8 : bx; }
    F.ctl = (gu32*)(args.ws + WS_CTL);
    for (int u = F.tid; u < (LDS_BYTES - LDSCTL_OFF) / 4; u += NWAVES * 64) ((LAS unsigned*)(F.lds + LDSCTL_OFF))[u] = 0u;
    __syncthreads();
    Frame& F0 = F;
    const int lo = args.ph_lo, hi = args.ph_hi;
    XcdBarrier bar; bar.bar = (unsigned*)(F.ctl + CW_BAR); bar.x = 0; bar.st = nullptr;
    if (hi - lo > 1) bar = xcd_barrier_post((unsigned*)(F.ctl + CW_BAR), F.MISC + 8);
#define IN(k) (lo <= (k) && (k) < hi)
#ifndef PH_ENABLE
#define PH_ENABLE 0xFFFFFFFFu
#endif
#define PHEN(n) (((PH_ENABLE) >> (n)) & 1u)
#ifndef MK_DOUBLE
#define MK_DOUBLE 0u
#endif
#define NREP(n) ((((MK_DOUBLE) >> (n)) & 1u) ? 2 : 1)
#if defined(NO_OPQ)
#define OPQ(p) do {} while (0)
#else
#define OPQ(p) asm volatile("" : "+s"(p))
#endif
#if 0
#define STAMP(k) do { if (blockIdx.x == 0 && threadIdx.x == 0) { const unsigned long long t_ = __builtin_amdgcn_s_memrealtime(); ((GAS unsigned*)(F0.ctl))[3000 + (k)] = (unsigned)t_; } } while (0)
#else
#define STAMP(k) do {} while (0)
#endif
#define SEAM(k) do { if (IN(k) && IN((k) + 1)) { XcdBarrier b2_ = bar; OPQ(b2_.bar); xcd_barrier(b2_); } STAMP((k) + 1); } while (0)

#define PTRS() unsigned char* ws = args.ws; OPQ(ws); const float* x = args.in[0]; OPQ(x); const float* norm_mix = args.in[1]; OPQ(norm_mix); const float* norm_ffn = args.in[2]; OPQ(norm_ffn); \
    bf16* h = (bf16*)(ws + WS_HB); \
    bf16* XN = (bf16*)(ws + WS_XN); bf16* Qb = (bf16*)(ws + WS_Q); bf16* Kb = (bf16*)(ws + WS_K); bf16* Vb = (bf16*)(ws + WS_V); bf16* ACT = (bf16*)(ws + WS_ACT); \
    bf16* MGU = (bf16*)(ws + WS_MGU); bf16* MD = (bf16*)(ws + WS_MD); \
    float* kmean = (float*)(ws + WS_KMEAN); unsigned* ltok = (unsigned*)(ws + WS_LTOK); float* lw = (float*)(ws + WS_LW); \
    (void)x; (void)norm_mix; (void)norm_ffn; (void)h; (void)XN; (void)Qb; (void)Kb; (void)Vb; (void)ACT; (void)MGU; (void)MD; (void)kmean; (void)ltok; (void)lw
    const RouterArgs noR{nullptr, nullptr, nullptr, nullptr};
#ifndef MK_F8_DENSE
#define MK_F8_DENSE 0
#endif
    constexpr bool F8_DENSE = MK_F8_DENSE != 0; constexpr int DESZ = F8_DENSE ? 1 : 2;
    constexpr float WSC_UP = 32.0f, WSC_DN = 64.0f;
    constexpr float C2 = 0.125f * 1.4426950408889634f;

    STAMP(0);
    if (PHEN(0) && IN(0)) {
        PTRS();
        { unsigned rot = 0u;
        convert_matrix(F, args.in[3], D, 3 * D, ws + WS_DQKV, 0, rot);
        norm_phase<0, false, true>(F, x, nullptr, nullptr, norm_mix, XN, nullptr, noR);
        }
    }
    SEAM(0);

    for (int L = 0; L < NLAYER; ++L) {
        const int j = L >> 1, moba = L & 1, pb = 1 + PH_PER_LAYER * L;
        int z_ = 0;
#if !defined(NO_OPQ_Z)
        asm volatile("" : "+s"(z_));
#endif
        Frame Fl = F0; Fl.G += z_; Fl.vcu += z_; Fl.wave += z_; Fl.lds += z_; Fl.ctl += z_; const int bx = (int)blockIdx.x + z_;
#define F Fl
        if (PHEN(1) && IN(pb + 0)) {
            PTRS();

            const bf16* W = (const bf16*)(ws + (moba ? WS_MQKV : WS_DQKV)) + (size_t)j * 3 * D * D;
            pg8::Gemm g{XN, W, 2 * D, 0}; pg8::StaticOrder S; S.init(MTOK, 3 * D, F.G, bx);
            pg8::EpiQKV E{Qb, D, D, (size_t)(WS_K - WS_Q) / 2, C2};
            for (int rep_ = 0; rep_ < NREP(1); ++rep_) pg8::gemm_phase<pg8::EpiQKV, pg8::StaticOrder>(F.lds + RING_OFF, XSLOT_OFF, g, S, E);
        }
        SEAM(pb + 0);
        { if (PHEN(2) && IN(pb + 1)) { PTRS(); kstat_phase(F, Kb, kmean, kmean + 8 * 16 * 16 * 64); } SEAM(pb + 1); }
        if (IN(pb + 2)) {
            PTRS();
            att::Args A; A.Q = Qb; A.K = Kb; A.V = Vb; A.O = XN; A.kmean = kmean; A.kmax2 = kmean + 8 * 16 * 16 * 64; A.subln = args.in[6] + (size_t)j * 128; A.lam_full = 0.f; A.out_scale = 1.f; A.abl = 0;
            LAS int* qw;
            if (!moba) {
                const float* lam = args.in[5] + (size_t)j * 256; int lane = F.lane; asm volatile("" : "+v"(lane));
                const GAS float* lamg = (const GAS float*)lam; const float s1 = wave_sum(lamg[lane] * lamg[64 + lane]), s2 = wave_sum(lamg[128 + lane] * lamg[192 + lane]);
                const float lam_init = (L == 0) ? 0.2f : 0.47071302f;
                A.lam_full = __uint_as_float(__builtin_amdgcn_readfirstlane(__float_as_uint(__expf(s1) - __expf(s2) + lam_init))); A.out_scale = __uint_as_float(__builtin_amdgcn_readfirstlane(__float_as_uint(1.0f - lam_init)));
            }
            const int nconv = (L == 0) ? conv_total_chunks() : 0;
            qw = (LAS int*)(F.lds + XSLOT_OFF);
            const int xme = (int)(xb_xcc_id() & 7u);
            if ((PHEN(3) && !moba) || (PHEN(4) && moba)) for (int rep_ = 0; rep_ < (moba ? NREP(4) : NREP(3)); ++rep_) for (int xq = xme;;) {
#if ATT_ABLATE
                { const bool ab_ = rep_ == 0 && (moba ? NREP(4) : NREP(3)) == 2; A.abl = ab_ ? ATT_ABLATE : 0; A.O = ab_ ? (bf16*)(ws + WS_END) : XN; }
#endif
                const int ncx = (nconv && rep_ == 0) ? ((nconv - xq + 7) >> 3) : 0;
                gu32* qb = F.ctl + CW_ATTQ2 + 256 * L + 1024 * rep_; gu32* qx = qb + 32 * xq;
                for (;;) {
                    if (F.tid == 0) *qw = (int)__hip_atomic_fetch_add(qx, 1u, RLX_AGENT);
                    asm volatile("s_waitcnt vmcnt(0) lgkmcnt(0)\n\ts_barrier" ::: "memory");
                    int idx = __builtin_amdgcn_readfirstlane(*qw);
                    if (idx >= 128 + ncx) { asm volatile("s_waitcnt vmcnt(0) lgkmcnt(0)\n\ts_barrier" ::: "memory"); break; }
                    if (ncx) { const int q3 = idx / 3; if (idx < 3 * ncx) { if (idx - 3 * q3 == 2) { conv_chunk(F, args, ws, xq + 8 * q3); asm volatile("s_waitcnt vmcnt(0) lgkmcnt(0)\n\ts_barrier" ::: "memory"); continue; } idx -= q3; } else idx -= ncx; }
                    if (!moba) { const int hh = 7 - (idx >> 4), pr = idx & 15;
                        att::attn_unit<0>(F.lds + RING_OFF, A, xq, hh, pr);
                        att::attn_unit<0>(F.lds + RING_OFF, A, xq, hh, 31 - pr);
                    } else { const int hh = 15 - (idx >> 3), pr = idx & 7;
                        att::attn_unit<1>(F.lds + RING_OFF, A, xq, hh, pr);
                        att::attn_unit<1>(F.lds + RING_OFF, A, xq, hh, 15 - pr); }
                }
                if (F.tid < 64) { int lane = F.tid; asm volatile("" : "+v"(lane)); bool av = false;
                    if (lane < 8) { const int lim = 128 + ((nconv && rep_ == 0) ? ((nconv - lane + 7) >> 3) : 0); av = (int)__hip_atomic_load(qb + 32 * lane, RLX_AGENT) < lim; }
                    const unsigned long long m_ = __ballot(av);
                    if (lane == 0) *qw = (int)(unsigned)m_; }
                asm volatile("s_waitcnt vmcnt(0) lgkmcnt(0)\n\ts_barrier" ::: "memory");
                const unsigned m = (unsigned)__builtin_amdgcn_readfirstlane(*qw);
                asm volatile("s_waitcnt vmcnt(0) lgkmcnt(0)\n\ts_barrier" ::: "memory");
                if (m == 0u) break;
                const unsigned rot = ((m >> xme) | (m << (8 - xme))) & 0xFFu;
                xq = (xme + __builtin_ctz(rot)) & 7;
            }
            asm volatile("s_waitcnt vmcnt(0) lgkmcnt(0)\n\ts_barrier" ::: "memory");
        }
        SEAM(pb + 2);
        if (PHEN(5) && IN(pb + 3)) {
            PTRS();
            const bf16* W = (const bf16*)(ws + (moba ? WS_MWO : WS_DWO)) + (size_t)j * D * D;
            pg8::Gemm g{XN, W, 2 * D, 0}; pg8::StaticOrder S; S.init(MTOK, D, F.G, bx);
            if (L == 0) { pg8::EpiRes<true> E{x, h, D, 1.0f}; pg8::gemm_phase<pg8::EpiRes<true>, pg8::StaticOrder>(F.lds + RING_OFF, XSLOT_OFF, g, S, E); }
            else { pg8::EpiRes<false> E{h, h, D, 1.0f}; pg8::gemm_phase<pg8::EpiRes<false>, pg8::StaticOrder>(F.lds + RING_OFF, XSLOT_OFF, g, S, E); }
        }
        SEAM(pb + 3);
        if (PHEN(6) && IN(pb + 4)) {
            PTRS();
            if (!moba) {
                if (L == 2) norm_phase<0, true>(F, h, nullptr, nullptr, norm_ffn + (size_t)L * D, XN, nullptr, noR);
                else norm_phase<0, false>(F, h, nullptr, nullptr, norm_ffn + (size_t)L * D, XN, nullptr, noR);
            } else {
                const RouterArgs R{args.in[12] + (size_t)j * D * NE, F.ctl + CW_CNT + 64 * NE * j, ltok, lw};
                norm_phase<2, true>(F, h, nullptr, nullptr, norm_ffn + (size_t)L * D, XN, nullptr, R);
            }
        }
        SEAM(pb + 4);
        if (IN(pb + 5)) {
            PTRS();
            if (PHEN(7) && !moba) {
                if (L == 2) { pg8::Gemm g{XN, ws + WS_FGU + (size_t)j * 2 * DFF * D * 2, D, 0}; pg8::StaticOrder S; S.init(MTOK, 2 * DFF, F.G, bx);
                    pg8::EpiSwiGLU<true> E{ACT, DFF, 1.0f / WSC_UP};
                    pg8::gemm_phase<pg8::EpiSwiGLU<true>, pg8::StaticOrder, true>(F.lds + RING_OFF, XSLOT_OFF, g, S, E);
                } else { pg8::Gemm g{XN, ws + WS_FGU + (size_t)j * 2 * DFF * D * 2, 2 * D, 0}; pg8::StaticOrder S; S.init(MTOK, 2 * DFF, F.G, bx);
                    pg8::EpiSwiGLU<false> E{ACT, DFF, 1.0f};
                    pg8::gemm_phase<pg8::EpiSwiGLU<false>, pg8::StaticOrder, false>(F.lds + RING_OFF, XSLOT_OFF, g, S, E); }
            } else if (PHEN(8) && moba) {
                pg8::Gemm g{XN, ws + WS_MGU + (size_t)j * NE * 2 * DE * D, D, (size_t)2 * DE * D}; pg8::MoeOrder S; S.init((const unsigned*)(F.ctl + CW_CNT + 64 * NE * j), ltok, true, 2 * DE, F.G, bx);
                pg8::EpiSwiGLU<true> E{ACT, DE, 1.0f / WSC_UP};
                pg8::gemm_phase<pg8::EpiSwiGLU<true>, pg8::MoeOrder, true>(F.lds + RING_OFF, XSLOT_OFF, g, S, E);
            }
        }
        SEAM(pb + 5);
        if (IN(pb + 6)) {
            PTRS();
            if (PHEN(9) && !moba) {
                if (L == 2) { pg8::Gemm g{ACT, ws + WS_FD + (size_t)j * D * DFF * 2, DFF, 0}; pg8::StaticOrder S; S.init(MTOK, D, F.G, bx);
                    pg8::EpiRes<false> E{h, h, D, 1.0f / WSC_DN};
                    pg8::gemm_phase<pg8::EpiRes<false>, pg8::StaticOrder, true>(F.lds + RING_OFF, XSLOT_OFF, g, S, E);
                } else { pg8::Gemm g{ACT, ws + WS_FD + (size_t)j * D * DFF * 2, 2 * DFF, 0}; pg8::StaticOrder S; S.init(MTOK, D, F.G, bx);
                    pg8::EpiRes<false> E{h, h, D, 1.0f};
                    pg8::gemm_phase<pg8::EpiRes<false>, pg8::StaticOrder, false>(F.lds + RING_OFF, XSLOT_OFF, g, S, E); }
            } else if (PHEN(10) && moba) {
                pg8::Gemm g{ACT, ws + WS_MD + (size_t)j * NE * D * DE, DE, (size_t)D * DE}; pg8::MoeOrder S; S.init((const unsigned*)(F.ctl + CW_CNT + 64 * NE * j), ltok, false, D, F.G, bx);
                pg8::EpiMoeDown E; E.y0 = (bf16*)(ws + WS_Y0); E.y1 = XN; E.list_tok = ltok; E.list_w = lw; E.sc = 1.0f / WSC_DN;
#pragma unroll
                for (int e = 0; e < NE; ++e) E.cnt[e] = S.cnt[e];
                pg8::gemm_phase<pg8::EpiMoeDown, pg8::MoeOrder, true>(F.lds + RING_OFF, XSLOT_OFF, g, S, E);
            }
        }
        SEAM(pb + 6);
        if (PHEN(11) && IN(pb + 7)) {
            PTRS();
            if (L == 3) norm_phase<3>(F, h, nullptr, XN, args.in[16], nullptr, args.out, noR, (const bf16*)(ws + WS_Y0));
            else if (moba) norm_phase<1>(F, h, h, XN, norm_mix + (size_t)(L + 1) * D, XN, nullptr, noR, (const bf16*)(ws + WS_Y0));
            else for (int rep_ = 0; rep_ < NREP(11); ++rep_) norm_phase<0>(F, h, nullptr, nullptr, norm_mix + (size_t)(L + 1) * D, XN, nullptr, noR);
        }
        if (L != NLAYER - 1) SEAM(pb + 7); else STAMP(pb + 8);
#undef F
    }
#undef IN
#undef SEAM
#undef PTRS
#undef OPQ
}


#if MK_DEBUG
__global__ void dbg_probe(const void* buf, size_t n, int is_bf16, int idx, float thresh, unsigned* dbg) {
    size_t i = blockIdx.x * (size_t)blockDim.x + threadIdx.x, stride = (size_t)gridDim.x * blockDim.x; bool bad = false;
    for (size_t k = i; k < n; k += stride) { float v = is_bf16 ? __uint_as_float(((unsigned)((const unsigned short*)buf)[k]) << 16) : ((const float*)buf)[k]; if (!(fabsf(v) <= thresh)) bad = true; }
    if (bad) atomicMax(dbg, (unsigned)(1000 - idx));
}
__global__ void dbg_cnt(const unsigned* cntw, int idx, unsigned* dbg) {
    if (threadIdx.x == 0 && blockIdx.x == 0) { unsigned s = 0; for (int e = 0; e < NE; ++e) s += cntw[64 * e]; if (s != 2u * MTOK) atomicMax(dbg, (unsigned)(1000 - idx)); }
}

__device__ __forceinline__ float dbg_bf(unsigned short v) { return __uint_as_float(((unsigned)v) << 16); }
__device__ __forceinline__ unsigned dbg_hash(unsigned x) { x ^= x >> 16; x *= 0x7feb352dU; x ^= x >> 15; x *= 0x846ca68bU; x ^= x >> 16; return x; }
__global__ void dbg_gemm_check(const unsigned short* A, int lda, const unsigned short* Bt, int K, const unsigned short* out, int ldo, int M, int N, float scale, int idx, unsigned* dbg) {
    const unsigned s = blockIdx.x * blockDim.x + threadIdx.x; const int row = (int)(dbg_hash(2 * s + 1) % (unsigned)M), col = (int)(dbg_hash(2 * s + 2) % (unsigned)N);
    float acc = 0.f; for (int k = 0; k < K; ++k) acc += dbg_bf(A[(size_t)row * lda + k]) * dbg_bf(Bt[(size_t)col * K + k]);
    acc *= scale; const float got = dbg_bf(out[(size_t)row * ldo + col]);
    if (!(fabsf(got - acc) <= 0.03f + 0.02f * fabsf(acc))) { atomicMax(dbg, (unsigned)(1000 - idx)); atomicAdd(dbg + 64 + idx, 1u); }
}
__global__ void dbg_conv_check(const float* W, int K, int N, const unsigned short* WT, int il, int idx, unsigned* dbg) {
    const unsigned s = blockIdx.x * blockDim.x + threadIdx.x; const int k = (int)(dbg_hash(2 * s + 1) % (unsigned)K), n = (int)(dbg_hash(2 * s + 2) % (unsigned)N);
    const int dr = il == 0 ? n : (n / 128) * 256 + (il - 1) * 128 + (n % 128);
    const float w = W[(size_t)k * N + n], g = dbg_bf(WT[(size_t)dr * K + k]);
    if (!(fabsf(g - w) <= 0.01f * fabsf(w) + 1e-6f)) atomicMax(dbg, (unsigned)(1000 - idx));
}
__global__ void dbg_norm_check(const float* src, const float* gain, const unsigned short* xn, int idx, unsigned* dbg) {
    const unsigned s = blockIdx.x * blockDim.x + threadIdx.x; const int row = (int)(dbg_hash(s + 77) % (unsigned)MTOK);
    float ss = 0.f; for (int c = 0; c < D; ++c) { const float v = src[(size_t)row * D + c]; ss += v * v; }
    const float rstd = 1.f / sqrtf(ss / D + 1e-6f); bool bad = false;
    for (int c = 0; c < D; ++c) { const float r = src[(size_t)row * D + c] * rstd * gain[c], g = dbg_bf(xn[(size_t)row * D + c]); if (!(fabsf(g - r) <= 0.02f + 0.01f * fabsf(r))) bad = true; }
    if (bad) atomicMax(dbg, (unsigned)(1000 - idx));
}
__global__ void dbg_naive_gemm(const unsigned short* A, const unsigned short* Bt, unsigned short* out, int M, int N, int K) {
    const size_t i = blockIdx.x * (size_t)blockDim.x + threadIdx.x; if (i >= (size_t)M * N) return; const int row = (int)(i / N), col = (int)(i % N);
    float acc = 0.f; for (int k = 0; k < K; ++k) acc += dbg_bf(A[(size_t)row * K + k]) * dbg_bf(Bt[(size_t)col * K + k]);
    out[(size_t)row * N + col] = (unsigned short)f2bf(acc);
}
__global__ void dbg_find_col(const unsigned short* out, const unsigned short* ref, int M, int N, unsigned* hist) {
    const unsigned s = blockIdx.x * blockDim.x + threadIdx.x; const int row = (int)(dbg_hash(2 * s + 1) % (unsigned)M), col = (int)(dbg_hash(2 * s + 2) % (unsigned)N);
    const unsigned short v = out[(size_t)row * N + col]; int found = -1;
#if MK_FIND_PATTERN
    if (v == 0x3C3C) atomicAdd(hist + N, 1u); else atomicAdd(hist + 5, 1u); return;
#endif
#if MK_FIND_ROWS
    for (int r = 0; r < M; ++r) if (ref[(size_t)r * N + col] == v) { found = r; break; }
    if (found < 0) atomicAdd(hist + N, 1u); else atomicAdd(hist + ((found - row) & (N - 1)), 1u);
#else
    for (int c = 0; c < N; ++c) if (ref[(size_t)row * N + c] == v) { found = c; break; }
    if (found < 0) atomicAdd(hist + N, 1u); else atomicAdd(hist + ((found - col) & (N - 1)), 1u);
#endif
}
__global__ void dbg_hist_code(const unsigned* hist, int N, unsigned* dbg) {
    if (threadIdx.x || blockIdx.x) return; unsigned best = 0, bi = 0; for (int i = 0; i < N; ++i) if (hist[i] > best) { best = hist[i]; bi = i; }
    dbg[32] = bi; dbg[33] = best; dbg[34] = hist[N];
}
__global__ void dbg_final(float* out, size_t n, const unsigned* dbg) {
    if (MK_HIST_SEL >= 10) { const float c3 = sqrtf((float)dbg[MK_HIST_SEL + 30]); size_t i3 = blockIdx.x * (size_t)blockDim.x + threadIdx.x, st3 = (size_t)gridDim.x * blockDim.x; for (size_t k3 = i3; k3 < n; k3 += st3) out[k3] = c3; return; }
    if (MK_HIST_SEL >= 0 && (dbg[33] || dbg[34])) { const float c2 = sqrtf((float)(MK_HIST_SEL == 0 ? dbg[32] : (MK_HIST_SEL == 1 ? dbg[33] * 100u / 4096u : dbg[34] * 100u / 4096u)) + 1.f); size_t i2 = blockIdx.x * (size_t)blockDim.x + threadIdx.x, st2 = (size_t)gridDim.x * blockDim.x; for (size_t k2 = i2; k2 < n; k2 += st2) out[k2] = c2; return; }
    const unsigned d = dbg[0]; if (d == 0u) return; const unsigned nf = dbg[64 + (1000u - d)]; const float c = sqrtf(nf ? (float)(200u * (1000u - d - 9u) + nf * 100u / 4096u) : (float)(1000u - d));
    size_t i = blockIdx.x * (size_t)blockDim.x + threadIdx.x, stride = (size_t)gridDim.x * blockDim.x;
    for (size_t k = i; k < n; k += stride) out[k] = c;
}
#endif

#ifndef MK_REPEAT
#define MK_REPEAT 1
#endif
#ifndef MK_FIND_ROWS
#define MK_FIND_ROWS 0
#endif
#ifndef MK_FIND_REGION
#define MK_FIND_REGION WS_K
#endif
#ifndef MK_HIST_SEL
#define MK_HIST_SEL 0
#endif
#ifndef MK_STAMP
#define MK_STAMP 0
#endif
#if MK_STAMP
__global__ void stamp_k(unsigned* p) { if (threadIdx.x == 0) *p = (unsigned)__builtin_amdgcn_s_memrealtime(); }
__global__ void stamp_encode(float* out, size_t n, const unsigned* st, int pa, float ua, int pb, float ub) {
    const float da = (float)(st[pa + 1] - st[pa]) * 0.01f, db = (float)(st[pb + 1] - st[pb]) * 0.01f;
    float m = da / ua; m = m < 10.f ? 10.f : (m > 99.f ? 99.f : m); float e = floorf(db / ub + 0.5f); e = e < 0.f ? 0.f : (e > 30.f ? 30.f : e);
    const float c = sqrtf(m) * __powf(10.f, 0.5f * e);
    size_t i = blockIdx.x * (size_t)blockDim.x + threadIdx.x, stride = (size_t)gridDim.x * blockDim.x;
    for (size_t k = i; k < n; k += stride) out[k] = c;
}
#endif
extern "C" void kernel_launch(void* const* d_in, const int* in_sizes, int n_in, void* d_out, int out_size, void* d_ws, size_t ws_size, hipStream_t stream) {
    static int grid = 0;
    if (grid == 0) {
        if (n_in != 17 || in_sizes[0] != MTOK * D || out_size != MTOK * D || ws_size < WS_END) {
            fprintf(stderr, "kernel_launch: built for 17 inputs, x/out of %d floats, >= %zu bytes of workspace; got n_in %d, in0 %d, out %d, ws %zu; nothing launched\n", MTOK * D, (size_t)WS_END, n_in, n_in > 0 ? in_sizes[0] : -1, out_size, ws_size);
            grid = -1; return; }
        int dev = 0, cus = 0, per_cu = 0;
        if (hipGetDevice(&dev) != hipSuccess || hipDeviceGetAttribute(&cus, hipDeviceAttributeMultiprocessorCount, dev) != hipSuccess) { fprintf(stderr, "kernel_launch: device query failed\n"); grid = -1; return; }
        if (hipFuncSetAttribute((const void*)trunk_fwd, hipFuncAttributeMaxDynamicSharedMemorySize, LDS_BYTES) != hipSuccess) { fprintf(stderr, "kernel_launch: hipFuncSetAttribute failed\n"); grid = -1; return; }
        if (hipOccupancyMaxActiveBlocksPerMultiprocessor(&per_cu, (const void*)trunk_fwd, NWAVES * 64, LDS_BYTES) != hipSuccess || per_cu < 1)
            fprintf(stderr, "kernel_launch: note: occupancy query reports %d workgroups per CU\n", per_cu);
        (void)hipGetLastError();
        grid = cus;
    }
    if (grid < 0) return;
    if (hipMemsetAsync((char*)d_ws + WS_CTL, 0, CTL_ZERO_BYTES, stream) != hipSuccess) { fprintf(stderr, "kernel_launch: memset failed\n"); return; }
    KArgs a{};
    for (int i = 0; i < 17; ++i) a.in[i] = (const float*)d_in[i];
    a.out = (float*)d_out; a.ws = (unsigned char*)d_ws;
#if MK_PER_PHASE
#if MK_STAMP
    hipLaunchKernelGGL(stamp_k, dim3(1), dim3(64), 0, stream, (unsigned*)d_ws + 3000);
#endif
    for (int p = 0; p < NPHASE; ++p) {
        a.ph_lo = p; a.ph_hi = p + 1;
#if MK_DEBUG
#endif
#if !defined(MK_SKIP_MAIN)
        for (int rep_ = 0; rep_ < (p == 1 ? MK_REPEAT : 1); ++rep_) hipLaunchKernelGGL(trunk_fwd, dim3(grid), dim3(NWAVES * 64), LDS_BYTES, stream, a);
#endif
#if MK_STAMP
        hipLaunchKernelGGL(stamp_k, dim3(1), dim3(64), 0, stream, (unsigned*)d_ws + 3000 + p + 1);
#endif
#if MK_DEBUG
        {   unsigned char* ws = (unsigned char*)d_ws; unsigned* dbg = (unsigned*)(ws + WS_CTL) + 2048;
            const size_t MD_ = (size_t)MTOK * D;
#define PROBE(buf, n, isbf, idx, th) if ((idx) <= MK_PROBE_MAX) hipLaunchKernelGGL(dbg_probe, dim3(2048), dim3(256), 0, stream, (const void*)(buf), (size_t)(n), isbf, idx, th, dbg)
            if (p == 0) {
                hipLaunchKernelGGL(dbg_norm_check, dim3(4), dim3(64), 0, stream, (const float*)d_in[0], (const float*)d_in[1], (const unsigned short*)(ws + WS_XN), 4, dbg);
                hipLaunchKernelGGL(dbg_conv_check, dim3(16), dim3(256), 0, stream, (const float*)d_in[3], D, 3 * D, (const unsigned short*)(ws + WS_DQKV), 0, 5, dbg);
                hipLaunchKernelGGL(dbg_conv_check, dim3(16), dim3(256), 0, stream, (const float*)d_in[9], D, DFF, (const unsigned short*)(ws + WS_FGU), 1, 6, dbg);
                hipLaunchKernelGGL(dbg_conv_check, dim3(16), dim3(256), 0, stream, (const float*)d_in[10], D, DFF, (const unsigned short*)(ws + WS_FGU), 2, 7, dbg);
                hipLaunchKernelGGL(dbg_conv_check, dim3(16), dim3(256), 0, stream, (const float*)d_in[11], DFF, D, (const unsigned short*)(ws + WS_FD), 0, 8, dbg);
                hipLaunchKernelGGL(dbg_conv_check, dim3(16), dim3(256), 0, stream, (const float*)d_in[15] + (size_t)3 * DE * D, DE, D, (const unsigned short*)(ws + WS_MD) + (size_t)3 * D * DE, 0, 9, dbg);
            }
            if (p == 1) {
                const float C2h = 0.125f * 1.4426950408889634f;
                hipLaunchKernelGGL(dbg_gemm_check, dim3(16), dim3(256), 0, stream, (const unsigned short*)(ws + WS_XN), D, (const unsigned short*)(ws + WS_DQKV), D, (const unsigned short*)(ws + WS_Q), D, MTOK, D, C2h, 10, dbg);
                hipLaunchKernelGGL(dbg_gemm_check, dim3(16), dim3(256), 0, stream, (const unsigned short*)(ws + WS_XN), D, (const unsigned short*)(ws + WS_DQKV) + (size_t)D * D, D, (const unsigned short*)(ws + WS_K), D, MTOK, D, 1.f, 11, dbg);

                hipLaunchKernelGGL(dbg_gemm_check, dim3(16), dim3(256), 0, stream, (const unsigned short*)(ws + WS_XN), D, (const unsigned short*)(ws + WS_DQKV) + (size_t)2 * D * D, D, (const unsigned short*)(ws + WS_V), D, MTOK, D, 1.f, 12, dbg);
            }
            if (0) { PROBE(ws + WS_XN, MD_, 1, 1, 10.f); PROBE(ws + WS_DQKV, (WS_MGU - WS_DQKV) / 2, 1, 2, 1.f); PROBE(ws + WS_MGU, (WS_XN - WS_MGU) / 2, 1, 3, 1.f); }
            if (p >= 1) { const int L = (p - 1) / PH_PER_LAYER, k = (p - 1) % PH_PER_LAYER; const int b = 20 + 10 * L;
                if (k == 0) PROBE(ws + WS_Q, 3 * MD_, 1, b + 0, 50.f);
                if (k == 1) PROBE(ws + WS_KMEAN, 8 * 16 * 16 * 64, 0, b + 1, 5.f);
                if (k == 2) PROBE(ws + WS_XN, MD_, 1, b + 2, 50.f);
                if (k == 3) PROBE(d_out, MD_, 0, b + 3, 300.f);
                if (k == 4) { PROBE(ws + WS_XN, MD_, 1, b + 4, 20.f); if ((L & 1) && (b + 9) <= MK_PROBE_MAX) hipLaunchKernelGGL(dbg_cnt, dim3(1), dim3(64), 0, stream, (const unsigned*)(ws + WS_CTL) + CW_CNT + 64 * NE * (L >> 1), b + 9, dbg); }
                if (k == 5) PROBE(ws + WS_ACT, (L & 1) ? (size_t)256 * 256 * DE : (size_t)MTOK * DFF, 1, b + 5, 2000.f);
                if (k == 6) { PROBE(d_out, MD_, 0, b + 6, 1000.f); if (L & 1) PROBE(ws + WS_XN, MD_, 1, b + 7, 1000.f); }
                if (k == 7 && L != 3) { PROBE(ws + WS_XN, MD_, 1, b + 8, 20.f); PROBE(d_out, MD_, 0, b + 8, 1000.f); }
            }
#undef PROBE
        }
#endif
    }
#if MK_DEBUG
    hipLaunchKernelGGL(dbg_final, dim3(2048), dim3(256), 0, stream, (float*)d_out, (size_t)MTOK * D, (const unsigned*)((unsigned char*)d_ws + WS_CTL) + 2048);
#endif
#else
    a.ph_lo = 0; a.ph_hi = NPHASE;
    hipLaunchKernelGGL(trunk_fwd, dim3(grid), dim3(NWAVES * 64), LDS_BYTES, stream, a);
#if 0
    hipLaunchKernelGGL(stamp_encode, dim3(2048), dim3(256), 0, stream, (float*)d_out, (size_t)MTOK * D, (const unsigned*)d_ws + 3000, MK_STAMP_PA, MK_STAMP_UA, MK_STAMP_PB, MK_STAMP_UB);
#endif
#endif
#if MK_STAMP
    hipLaunchKernelGGL(stamp_encode, dim3(2048), dim3(256), 0, stream, (float*)d_out, (size_t)MTOK * D, (const unsigned*)d_ws + 3000, MK_STAMP_PA, MK_STAMP_UA, MK_STAMP_PB, MK_STAMP_UB);
#endif
    const hipError_t le = hipPeekAtLastError();
    if (le != hipSuccess) fprintf(stderr, "kernel_launch: launch failed: %s\n", hipGetErrorName(le));
}
```

```cpp
#ifndef MK_DEBUG
#define MK_DEBUG 0
#endif
#ifndef MK_PER_PHASE
#define MK_PER_PHASE 0
#endif
#include <hip/hip_runtime.h>
#include <cstdio>
#include <cstdint>

#ifndef MK_KDEBUG
#define MK_KDEBUG 0
#endif
#define LAS __attribute__((address_space(3)))
#define GAS __attribute__((address_space(1)))

constexpr int BATCH = 8, SEQ = 4096, MTOK = BATCH * SEQ, D = 1024, DFF = 2816, DE = 3584, NE = 8;
constexpr int MOE_TILES_MAX = 272;
constexpr int LIST_CAP = MTOK;

namespace pg8 {
#define PG8_LAS __attribute__((address_space(3)))
typedef unsigned short bf16_t;
typedef short bf16x8 __attribute__((ext_vector_type(8)));
typedef float f32x4 __attribute__((ext_vector_type(4)));
typedef unsigned u32x4 __attribute__((ext_vector_type(4)));
typedef int i32x4 __attribute__((ext_vector_type(4)));
typedef int i32x8 __attribute__((ext_vector_type(8)));
constexpr int BM = 256, BK = 64, HALF = 128, HTB = HALF * BK * 2  , STAGE_BYTES = 8 * HTB, NXCD = 8, WGM = 8;

__host__ __device__ __forceinline__ int lds_byte(int r, int c) { const int st = (r >> 4) * 2 + (c >> 5), rr = r & 15, cc = c & 31, ob = rr * 64 + cc * 2; return st * 1024 + (ob ^ (((ob >> 9) & 1) << 5)); }
__host__ __device__ __forceinline__ void stage_rc(int b, int& R, int& C) { const int st = b / 1024, sb = b % 1024, swz = sb ^ (((sb >> 9) & 1) << 5); R = (st >> 1) * 16 + swz / 64; C = (st & 1) * 32 + (swz % 64) / 2; }
__host__ __device__ __forceinline__ int perm32(int rho) { const int n = rho >> 4, i = rho & 15; return 8 * (i >> 2) + 4 * n + (i & 3); }

struct Unit { int pm, pn, e, r0; };
struct Gemm { const void* A; const void* Bt; int rowb; size_t bstride; };

__device__ __forceinline__ void tile_of(int L, int nM, int nN, int& pm, int& pn) {
    const int nwg = nM * nN; int wgid = L; { const int q = nwg / NXCD, r = nwg % NXCD, xcd = wgid % NXCD, off = wgid / NXCD; wgid = (xcd < r ? xcd * (q + 1) : r * (q + 1) + (xcd - r) * q) + off; }
    const int nig = WGM * nN, gid = wgid / nig, fm = gid * WGM, gsz = (nM - fm) < WGM ? (nM - fm) : WGM;
    pm = fm + ((wgid % nig) % gsz); pn = (wgid % nig) / gsz;
}
struct StaticOrder {
    static constexpr bool EARLY = false;
    int nM, nN, nwg, G, c;
    __device__ __forceinline__ void init(int M, int N, int G_, int c_) { nM = M / BM; nN = N / BM; nwg = nM * nN; G = G_; c = c_; }
    __device__ __forceinline__ bool next(int i, Unit& u) const {
        const long L = (long)i * G + c; if (L >= nwg) return false;
        tile_of((int)L, nM, nN, u.pm, u.pn); u.e = 0; u.r0 = 0; return true;
    }
    __device__ __forceinline__ unsigned arow(const Unit& u, int lr) const { return (unsigned)(u.pm * BM + lr); }
};
struct MoeOrder {
    static constexpr bool EARLY = true;
    int nM, nN, nwg, G, c; int tstart[NE + 1]; int cnt[NE]; const unsigned* list_tok; bool gather;
    __device__ __forceinline__ void init(const unsigned* cntw, const unsigned* list_tok_, bool gather_, int N, int G_, int c_) {
        int acc = 0;
        const int le_ = (int)(__builtin_amdgcn_mbcnt_lo(~0u, 0u)) & 7;
        const int cv_ = (int)__hip_atomic_load((const GAS unsigned*)cntw + 64 * le_, __ATOMIC_RELAXED, __HIP_MEMORY_SCOPE_AGENT);
#pragma unroll
        for (int e = 0; e < NE; ++e) { const int ce = __builtin_amdgcn_readlane(cv_, e); cnt[e] = ce; tstart[e] = acc; acc += (ce + BM - 1) / BM; }
        tstart[NE] = acc; nM = acc; nN = N / BM; nwg = nM * nN; G = G_; c = c_; list_tok = list_tok_; gather = gather_;
    }
    __device__ __forceinline__ bool next(int i, Unit& u) const {
        const long L = (long)i * G + c; if (L >= nwg) return false;
        tile_of((int)L, nM, nN, u.pm, u.pn); int e = 0;
#pragma unroll
        for (int k = 1; k < NE; ++k) e += (u.pm >= tstart[k]) ? 1 : 0;
        u.e = e; int ts = 0;
#pragma unroll
        for (int k = 0; k < NE; ++k) ts = (k == e) ? tstart[k] : ts;
        u.r0 = (u.pm - ts) * BM; return true;
    }
    __device__ __forceinline__ int count_of(int e) const { int cv = 0;
#pragma unroll
        for (int k = 0; k < NE; ++k) cv = (k == e) ? cnt[k] : cv;
        return cv; }
    __device__ __forceinline__ unsigned arow(const Unit& u, int lr) const {
        if (!gather) return (unsigned)(u.pm * BM + lr);
        const int l = u.r0 + lr; const int cv = count_of(u.e); const int lc = l < cv ? l : (cv > 0 ? cv - 1 : 0);
        return __hip_atomic_load((const GAS unsigned*)list_tok + (size_t)u.e * LIST_CAP + lc, __ATOMIC_RELAXED, __HIP_MEMORY_SCOPE_AGENT) & 0xFFFFFu;
    }
};

__device__ __forceinline__ unsigned cvt_pk_bf16(float lo, float hi) { unsigned r; asm volatile("v_cvt_pk_bf16_f32 %0, %1, %2" : "=v"(r) : "v"(lo), "v"(hi)); return r; }

struct EpiQKV {
    static constexpr bool PERM = true;
    bf16_t* O; int ldc; int split_cols; size_t split_stride; float scale0; float sall;
    float* ksum; unsigned* kmh; bool want_sum; unsigned* qmh;
    __device__ __forceinline__ void operator()(const f32x4 (&acc)[2][2][4][2], const Unit& u, int wr, int wc, int fr, int fq) const {
        const int row0 = u.pm * BM + wr * 64 + fr; int colt = u.pn * BM; bf16_t* base = O;
        float sc = sall; { const int t = colt / split_cols; base += (size_t)t * split_stride; colt -= t * split_cols; if (t == 0) sc = scale0 * sall; }
        const int col0 = colt + wc * 32 + 8 * fq;
#pragma unroll
        for (int ai = 0; ai < 2; ++ai)
#pragma unroll
            for (int m = 0; m < 4; ++m) { bf16_t* rowp = base + (size_t)(row0 + ai * HALF + m * 16) * ldc + col0;
#pragma unroll
                for (int bj = 0; bj < 2; ++bj) { f32x4 v0 = acc[ai][bj][m][0] * sc, v1 = acc[ai][bj][m][1] * sc;
                    u32x4 w; w.x = cvt_pk_bf16(v0[0], v0[1]); w.y = cvt_pk_bf16(v0[2], v0[3]); w.z = cvt_pk_bf16(v1[0], v1[1]); w.w = cvt_pk_bf16(v1[2], v1[3]);
                    *(GAS u32x4*)(rowp + bj * HALF) = w;
                    } }
        if (u.pn * BM / split_cols == 0) {
            const int b_ = u.pm >> 4, g0 = (colt >> 6) + (wc >> 1);
#pragma unroll
            for (int ai = 0; ai < 2; ++ai)
#pragma unroll
                for (int bj = 0; bj < 2; ++bj) { float mxq = 0.f;
#pragma unroll
                    for (int m = 0; m < 4; ++m) { const f32x4 v0 = acc[ai][bj][m][0] * sc, v1 = acc[ai][bj][m][1] * sc;
                        float s = (v0[0] * v0[0] + v0[1] * v0[1]) + (v0[2] * v0[2] + v0[3] * v0[3]) + (v1[0] * v1[0] + v1[1] * v1[1]) + (v1[2] * v1[2] + v1[3] * v1[3]);
                        s += __int_as_float(__builtin_amdgcn_ds_swizzle(__float_as_int(s), 0x401F));
                        { auto rr = __builtin_amdgcn_permlane32_swap(__float_as_uint(s), __float_as_uint(s), false, false); s = __uint_as_float(rr[0]) + __uint_as_float(rr[1]); }
                        mxq = fmaxf(mxq, s); }
                    mxq = fmaxf(mxq, __int_as_float(__builtin_amdgcn_update_dpp(0, __float_as_int(mxq), 0xB1, 0xF, 0xF, true))); mxq = fmaxf(mxq, __int_as_float(__builtin_amdgcn_update_dpp(0, __float_as_int(mxq), 0x4E, 0xF, 0xF, true)));
                    mxq = fmaxf(mxq, __int_as_float(__builtin_amdgcn_update_dpp(0, __float_as_int(mxq), 0x141, 0xF, 0xF, true))); mxq = fmaxf(mxq, __int_as_float(__builtin_amdgcn_update_dpp(0, __float_as_int(mxq), 0x140, 0xF, 0xF, true)));
                    if (fr == 0 && fq == 0) __hip_atomic_fetch_max((GAS unsigned*)qmh + ((size_t)((b_ * 16 + g0 + 2 * bj) * 32 + 2 * (u.pm & 15) + ai)) * 2 + (wc & 1), __float_as_uint(mxq), __ATOMIC_RELAXED, __HIP_MEMORY_SCOPE_AGENT); }
        }
        if (u.pn * BM / split_cols == 1) {
            const int b_ = u.pm >> 4, n_ = u.pm & 15, g0 = (colt >> 6) + (wc >> 1);
            float mx[2] = {0.f, 0.f}; float cs[2][8];
#pragma unroll
            for (int bj = 0; bj < 2; ++bj)
#pragma unroll
                for (int e = 0; e < 8; ++e) cs[bj][e] = 0.f;
#pragma unroll
            for (int ai = 0; ai < 2; ++ai)
#pragma unroll
                for (int m = 0; m < 4; ++m)
#pragma unroll
                    for (int bj = 0; bj < 2; ++bj) { const f32x4 v0 = acc[ai][bj][m][0] * sc, v1 = acc[ai][bj][m][1] * sc;
                        float s = (v0[0] * v0[0] + v0[1] * v0[1]) + (v0[2] * v0[2] + v0[3] * v0[3]) + (v1[0] * v1[0] + v1[1] * v1[1]) + (v1[2] * v1[2] + v1[3] * v1[3]);
                        s += __int_as_float(__builtin_amdgcn_ds_swizzle(__float_as_int(s), 0x401F));
                        { auto rr = __builtin_amdgcn_permlane32_swap(__float_as_uint(s), __float_as_uint(s), false, false); s = __uint_as_float(rr[0]) + __uint_as_float(rr[1]); }
                        mx[bj] = fmaxf(mx[bj], s);
                        cs[bj][0] += v0[0]; cs[bj][1] += v0[1]; cs[bj][2] += v0[2]; cs[bj][3] += v0[3]; cs[bj][4] += v1[0]; cs[bj][5] += v1[1]; cs[bj][6] += v1[2]; cs[bj][7] += v1[3]; }
#define PG8_ROW16(OP, x) do { x = OP(x, __int_as_float(__builtin_amdgcn_update_dpp(0, __float_as_int(x), 0xB1, 0xF, 0xF, true))); x = OP(x, __int_as_float(__builtin_amdgcn_update_dpp(0, __float_as_int(x), 0x4E, 0xF, 0xF, true))); \
            x = OP(x, __int_as_float(__builtin_amdgcn_update_dpp(0, __float_as_int(x), 0x141, 0xF, 0xF, true))); x = OP(x, __int_as_float(__builtin_amdgcn_update_dpp(0, __float_as_int(x), 0x140, 0xF, 0xF, true))); } while (0)
#define PG8_FADD(a_, b_) ((a_) + (b_))
#pragma unroll
            for (int bj = 0; bj < 2; ++bj) { float x = mx[bj]; PG8_ROW16(fmaxf, x);
                if (fr == 0 && fq == 0) __hip_atomic_fetch_max((GAS unsigned*)kmh + ((size_t)((b_ * 16 + g0 + 2 * bj) * 16 + n_)) * 2 + (wc & 1), __float_as_uint(x), __ATOMIC_RELAXED, __HIP_MEMORY_SCOPE_AGENT); }
            if (want_sum) {
#pragma unroll
                for (int bj = 0; bj < 2; ++bj)
#pragma unroll
                    for (int e = 0; e < 8; ++e) { float x = cs[bj][e]; PG8_ROW16(PG8_FADD, x);
                        if (fr == 0) __hip_atomic_fetch_add((GAS float*)ksum + ((size_t)((b_ * 16 + g0 + 2 * bj) * 16 + n_)) * 64 + (wc & 1) * 32 + 8 * fq + e, x, __ATOMIC_RELAXED, __HIP_MEMORY_SCOPE_AGENT); }
            }
#undef PG8_ROW16
#undef PG8_FADD
        }
    }
};
__device__ __forceinline__ unsigned pk4_fp8(float a, float b, float c, float d) { unsigned w = 0; w = __builtin_amdgcn_cvt_pk_fp8_f32(a, b, w, false); w = __builtin_amdgcn_cvt_pk_fp8_f32(c, d, w, true); return w; }
template <bool F8OUT> struct EpiSwiGLU {
    static constexpr bool PERM = true;
    void* O; int ldc; float sc;
    __device__ __forceinline__ void operator()(const f32x4 (&acc)[2][2][4][2], const Unit& u, int wr, int wc, int fr, int fq) const {
        const int row0 = u.pm * BM + wr * 64 + fr; const int col0 = u.pn * HALF + wc * 32 + 8 * fq;
        const float k1 = -1.4426950408889634f * sc, cinv = 1.0f / (sc * sc);
#pragma unroll
        for (int ai = 0; ai < 2; ++ai)
#pragma unroll
            for (int m = 0; m < 4; ++m) { float o[8];
#pragma unroll
                for (int n = 0; n < 2; ++n)
#pragma unroll
                    for (int j = 0; j < 4; ++j) { const float ag = acc[ai][0][m][n][j], au = acc[ai][1][m][n][j];
                        o[n * 4 + j] = (ag * au) * __builtin_amdgcn_rcpf(__builtin_fmaf(__builtin_amdgcn_exp2f(k1 * ag), cinv, cinv)); }
                const size_t eo = (size_t)(row0 + ai * HALF + m * 16) * ldc + col0;
                if constexpr (F8OUT) { const unsigned long long w = (unsigned long long)pk4_fp8(o[0], o[1], o[2], o[3]) | ((unsigned long long)pk4_fp8(o[4], o[5], o[6], o[7]) << 32);
                    *(GAS unsigned long long*)((unsigned char*)O + eo) = w;
                } else { u32x4 w; w.x = cvt_pk_bf16(o[0], o[1]); w.y = cvt_pk_bf16(o[2], o[3]); w.z = cvt_pk_bf16(o[4], o[5]); w.w = cvt_pk_bf16(o[6], o[7]);
                    *(GAS u32x4*)((bf16_t*)O + eo) = w; } }
    }
};
template <bool RF32> struct EpiRes {
    static constexpr bool PERM = true;
    const void* res; bf16_t* out; int ldc; float sc;
    __device__ __forceinline__ void operator()(const f32x4 (&acc)[2][2][4][2], const Unit& u, int wr, int wc, int fr, int fq) const {
        const int row0 = u.pm * BM + wr * 64 + fr; const int col0 = u.pn * BM + wc * 32 + 8 * fq;
#pragma unroll
        for (int ai = 0; ai < 2; ++ai) {
            f32x4 r0[4][2], r1[4][2];
#pragma unroll
            for (int m = 0; m < 4; ++m)
#pragma unroll
                for (int bj = 0; bj < 2; ++bj) { const size_t o2 = (size_t)(row0 + ai * HALF + m * 16) * ldc + col0 + bj * HALF;
                    if constexpr (RF32) { r0[m][bj] = *(const GAS f32x4*)((const float*)res + o2); r1[m][bj] = *(const GAS f32x4*)((const float*)res + o2 + 4); }
                    else { const u32x4 w = *(const GAS u32x4*)((const bf16_t*)res + o2);
                        r0[m][bj] = (f32x4){__uint_as_float(w.x << 16), __uint_as_float(w.x & 0xFFFF0000u), __uint_as_float(w.y << 16), __uint_as_float(w.y & 0xFFFF0000u)};
                        r1[m][bj] = (f32x4){__uint_as_float(w.z << 16), __uint_as_float(w.z & 0xFFFF0000u), __uint_as_float(w.w << 16), __uint_as_float(w.w & 0xFFFF0000u)}; } }
            asm volatile("" ::: "memory");
#pragma unroll
            for (int m = 0; m < 4; ++m)
#pragma unroll
                for (int bj = 0; bj < 2; ++bj) { const size_t o2 = (size_t)(row0 + ai * HALF + m * 16) * ldc + col0 + bj * HALF;
                    const f32x4 v0 = r0[m][bj] + acc[ai][bj][m][0] * sc, v1 = r1[m][bj] + acc[ai][bj][m][1] * sc;
                    u32x4 o; o.x = cvt_pk_bf16(v0[0], v0[1]); o.y = cvt_pk_bf16(v0[2], v0[3]); o.z = cvt_pk_bf16(v1[0], v1[1]); o.w = cvt_pk_bf16(v1[2], v1[3]);
                    *(GAS u32x4*)(out + o2) = o; }
        }
    }
};
struct EpiMoeDown {
    static constexpr bool PERM = true;
    bf16_t* y0; bf16_t* y1; const unsigned* list_tok; const float* list_w; int cnt[NE]; float sc;
    __device__ __forceinline__ void operator()(const f32x4 (&acc)[2][2][4][2], const Unit& u, int wr, int wc, int fr, int fq) const {
        int cv = 0;
#pragma unroll
        for (int k = 0; k < NE; ++k) cv = (k == u.e) ? cnt[k] : cv;
        const int col0 = u.pn * BM + wc * 32 + 8 * fq;
        unsigned ents[2][4]; float ws_[2][4];
        const int lcl = cv > 0 ? cv - 1 : 0;
#pragma unroll
        for (int ai = 0; ai < 2; ++ai)
#pragma unroll
            for (int m = 0; m < 4; ++m) { const int l = u.r0 + ai * HALF + wr * 64 + m * 16 + fr, lc = l < cv ? l : lcl;
                ents[ai][m] = __hip_atomic_load((const GAS unsigned*)list_tok + (size_t)u.e * LIST_CAP + lc, __ATOMIC_RELAXED, __HIP_MEMORY_SCOPE_AGENT);
                ws_[ai][m] = __uint_as_float(__hip_atomic_load((const GAS unsigned*)list_w + (size_t)u.e * LIST_CAP + lc, __ATOMIC_RELAXED, __HIP_MEMORY_SCOPE_AGENT)); }
#pragma unroll
        for (int ai = 0; ai < 2; ++ai)
#pragma unroll
            for (int m = 0; m < 4; ++m) { const int l = u.r0 + ai * HALF + wr * 64 + m * 16 + fr;
                if (l < cv) {
                    const unsigned ent = ents[ai][m]; const float w = sc * ws_[ai][m];
                    const size_t off = (size_t)(ent & 0xFFFFFu) * D + col0;
                    bf16_t* yb = (ent >> 20) == 0u ? y0 : y1;
#pragma unroll
                    for (int bj = 0; bj < 2; ++bj) { const f32x4 v0 = acc[ai][bj][m][0] * w, v1 = acc[ai][bj][m][1] * w;
                        u32x4 o; o.x = cvt_pk_bf16(v0[0], v0[1]); o.y = cvt_pk_bf16(v0[2], v0[3]); o.z = cvt_pk_bf16(v1[0], v1[1]); o.w = cvt_pk_bf16(v1[2], v1[3]); *(GAS u32x4*)(yb + off + bj * HALF) = o; }
                } }
    }
};

template <class Epi, class Sched, bool F8 = false>
__device__ __forceinline__ void gemm_phase(PG8_LAS unsigned char* lds, int xoff, const Gemm g, const Sched& S, const Epi& E) {
    int tid_ = threadIdx.x;
    asm volatile("" : "+v"(tid_));
    const int tid = tid_, wid = __builtin_amdgcn_readfirstlane(tid >> 6), lane = tid & 63, wr = wid >> 2, wc = wid & 3, fr = lane & 15, fq = lane >> 4;
    const int RB = g.rowb, nt = RB / 128;
    unsigned voffB[2];
#pragma unroll
    for (int i = 0; i < 2; ++i) { int R, C; stage_rc(tid * 16 + i * 8192, R, C); const int Rb = Epi::PERM ? ((R & ~31) + perm32(R & 31)) : R;
        voffB[i] = (unsigned)(Rb * RB + C * 2); }
    const size_t kstep = (size_t)(BK * 2);
    const size_t hstep = (size_t)HALF * RB;
    const size_t tstep = 2 * hstep;
    const unsigned ldsw = (unsigned)wid * 1024u;
    const int aoff = F8 ? lds_byte(wr * 64 + fr, fq * 16) : lds_byte(wr * 64 + fr, fq * 8), boff = F8 ? lds_byte(wc * 32 + fr, fq * 16) : lds_byte(wc * 32 + fr, fq * 8);
#define PG8_SA(b, h) (((b) * 2 + (h)) * HTB)
#define PG8_SB(b, h) ((4 + (b) * 2 + (h)) * HTB)
#define PG8_STAGE(bufoff, gbase, v0, v1) do { \
        __builtin_amdgcn_global_load_lds((const GAS unsigned*)((const char*)(gbase) + (v0)), (PG8_LAS unsigned*)(lds + (bufoff) + ldsw), 16, 0, 0); \
        __builtin_amdgcn_global_load_lds((const GAS unsigned*)((const char*)(gbase) + (v1)), (PG8_LAS unsigned*)(lds + (bufoff) + ldsw + 8192), 16, 0, 0); } while (0)
#define PG8_STAGEB(bufoff, gbase) PG8_STAGE(bufoff, gbase, voffB[0], voffB[1])
#define PG8_LDA(dst, b, h) do { if constexpr (F8) { _Pragma("unroll") for (int m = 0; m < 4; ++m) { dst##8[m].lo = *(const PG8_LAS i32x4*)(lds + PG8_SA(b, h) + aoff + m * 2048); dst##8[m].hi = *(const PG8_LAS i32x4*)(lds + PG8_SA(b, h) + aoff + m * 2048 + 16); } } \
        else { _Pragma("unroll") for (int m = 0; m < 4; ++m) _Pragma("unroll") for (int k = 0; k < 2; ++k) dst[m][k] = *(const PG8_LAS bf16x8*)(lds + PG8_SA(b, h) + aoff + m * 2048 + k * 1024); } } while (0)
#define PG8_LDB(dst, b, h) do { if constexpr (F8) { _Pragma("unroll") for (int n = 0; n < 2; ++n) { dst##8[n].lo = *(const PG8_LAS i32x4*)(lds + PG8_SB(b, h) + boff + n * 2048); dst##8[n].hi = *(const PG8_LAS i32x4*)(lds + PG8_SB(b, h) + boff + n * 2048 + 16); } } \
        else { _Pragma("unroll") for (int n = 0; n < 2; ++n) _Pragma("unroll") for (int k = 0; k < 2; ++k) dst[n][k] = *(const PG8_LAS bf16x8*)(lds + PG8_SB(b, h) + boff + n * 2048 + k * 1024); } } while (0)
#define PG8_MMA(ai, bj, At, Bt) do { __builtin_amdgcn_s_setprio(1); _Pragma("unroll") for (int m = 0; m < 4; ++m) _Pragma("unroll") for (int n = 0; n < 2; ++n) { \
        if constexpr (F8) acc[ai][bj][m][n] = __builtin_amdgcn_mfma_scale_f32_16x16x128_f8f6f4(Bt##8[n], At##8[m], acc[ai][bj][m][n], 0, 0, 0, 0x7F7F7F7F, 0, 0x7F7F7F7F); \
        else { _Pragma("unroll") for (int k = 0; k < 2; ++k) acc[ai][bj][m][n] = __builtin_amdgcn_mfma_f32_16x16x32_bf16(Bt[n][k], At[m][k], acc[ai][bj][m][n], 0, 0, 0); } } __builtin_amdgcn_s_setprio(0); } while (0)
#define PG8_WAIT_V(n) asm volatile("s_waitcnt vmcnt(" #n ")" ::: "memory")
#define PG8_WAIT_L(n) asm volatile("s_waitcnt lgkmcnt(" #n ")" ::: "memory")
#define PG8_BAR __builtin_amdgcn_s_barrier()
#define PG8_SCHED __builtin_amdgcn_sched_barrier(0)
#define PG8_AOFFS(U, o00, o01, o10, o11) do { int R0_, C0_, R1_, C1_; stage_rc(tid * 16, R0_, C0_); stage_rc(tid * 16 + 8192, R1_, C1_);     \
        o00 = S.arow(U, R0_) * (unsigned)RB + (unsigned)C0_ * 2u; o01 = S.arow(U, R1_) * (unsigned)RB + (unsigned)C1_ * 2u; \
        o10 = S.arow(U, HALF + R0_) * (unsigned)RB + (unsigned)C0_ * 2u; o11 = S.arow(U, HALF + R1_) * (unsigned)RB + (unsigned)C1_ * 2u; } while (0)
    Unit cur, nxt; int ui = 0;
    if (!S.next(0, cur)) return;
    f32x4 acc[2][2][4][2];
#pragma unroll
    for (int a = 0; a < 2; ++a)
#pragma unroll
        for (int b = 0; b < 2; ++b)
#pragma unroll
            for (int m = 0; m < 4; ++m)
#pragma unroll
                for (int n = 0; n < 2; ++n) acc[a][b][m][n] = (f32x4){0.f, 0.f, 0.f, 0.f};
    bf16x8 At[4][2], B0[2][2], B1[2][2];
    i32x8 At8[4], B08[2], B18[2];
    unsigned c00, c01, c10, c11;
    PG8_LAS u32x4* const xslot = (PG8_LAS u32x4*)(lds + xoff) + tid;
    PG8_AOFFS(cur, c00, c01, c10, c11);
    const char* const gA = (const char*)g.A;
    const char* cB = (const char*)g.Bt + (size_t)cur.e * g.bstride + (size_t)cur.pn * tstep;
    PG8_STAGEB(PG8_SB(0, 0), cB); PG8_STAGEB(PG8_SB(0, 1), cB + hstep); PG8_STAGE(PG8_SA(0, 0), gA, c00, c01); PG8_STAGE(PG8_SA(0, 1), gA, c10, c11);
    if (wr == 1) PG8_BAR;
    PG8_WAIT_V(2); PG8_BAR;
    PG8_STAGEB(PG8_SB(1, 0), cB + kstep); PG8_STAGE(PG8_SA(1, 0), gA + kstep, c00, c01); PG8_STAGEB(PG8_SB(1, 1), cB + hstep + kstep);
    PG8_WAIT_V(6); PG8_BAR;
    bool hn_ = false;
    if constexpr (Sched::EARLY) { hn_ = S.next(1, nxt); if (hn_) { unsigned n00, n01, n10, n11; PG8_AOFFS(nxt, n00, n01, n10, n11); *xslot = (u32x4){n00, n01, n10, n11}; } }
    for (;;) {
        bool has_next; if constexpr (Sched::EARLY) has_next = hn_; else has_next = S.next(ui + 1, nxt);
        const char* nB_ = has_next ? (const char*)g.Bt + (size_t)nxt.e * g.bstride + (size_t)nxt.pn * tstep : cB;
        const char* nB = nB_;
        if constexpr (!Sched::EARLY) { if (has_next) { unsigned n00, n01, n10, n11; PG8_AOFFS(nxt, n00, n01, n10, n11); *xslot = (u32x4){n00, n01, n10, n11}; } }
#pragma unroll 1
        for (int t = 0; t < nt; t += 2) {
            const bool last = (t == nt - 2);
            const char* a1 = gA + (size_t)(t + 1) * kstep;
            const char* a2 = last ? gA : gA + (size_t)(t + 2) * kstep; const char* b2 = last ? nB : cB + (size_t)(t + 2) * kstep;
            const char* a3 = a2 + kstep; const char* b3 = b2 + kstep;
            PG8_LDB(B0, 0, 0); PG8_LDB(B1, 0, 1); PG8_SCHED; PG8_LDA(At, 0, 0); PG8_STAGE(PG8_SA(1, 1), a1, c10, c11);
            if (last && has_next) { const u32x4 nx = *xslot; c00 = nx.x; c01 = nx.y; c10 = nx.z; c11 = nx.w; }
            PG8_WAIT_V(8); PG8_WAIT_L(0); PG8_BAR; PG8_MMA(0, 0, At, B0); PG8_MMA(0, 1, At, B1); PG8_BAR; PG8_SCHED;
            PG8_LDA(At, 0, 1); PG8_STAGEB(PG8_SB(0, 0), b2); PG8_STAGEB(PG8_SB(0, 1), b2 + hstep); PG8_STAGE(PG8_SA(0, 0), a2, c00, c01);
            PG8_WAIT_V(8); PG8_WAIT_L(0); PG8_BAR; PG8_MMA(1, 0, At, B0); PG8_MMA(1, 1, At, B1); PG8_BAR; PG8_SCHED;
            PG8_LDB(B0, 1, 0); PG8_LDB(B1, 1, 1); PG8_SCHED; PG8_LDA(At, 1, 0); PG8_STAGE(PG8_SA(0, 1), a2, c10, c11);
            PG8_WAIT_V(8); PG8_WAIT_L(0); PG8_BAR; PG8_MMA(0, 0, At, B0); PG8_MMA(0, 1, At, B1); PG8_BAR; PG8_SCHED;
            PG8_LDA(At, 1, 1); PG8_STAGEB(PG8_SB(1, 0), b3); PG8_STAGEB(PG8_SB(1, 1), b3 + hstep); PG8_STAGE(PG8_SA(1, 0), a3, c00, c01);
            PG8_WAIT_V(8); PG8_WAIT_L(0); PG8_BAR; PG8_MMA(1, 0, At, B0); PG8_MMA(1, 1, At, B1); PG8_BAR; PG8_SCHED;
        }
        if (wr == 0) PG8_BAR;
        Unit nx2 = nxt; bool has2 = false; unsigned m00 = 0, m01 = 0, m10 = 0, m11 = 0;
        if constexpr (Sched::EARLY) { has2 = has_next && S.next(ui + 2, nx2); PG8_AOFFS(nx2, m00, m01, m10, m11); }
        E(acc, cur, wr, wc, fr, fq);
        if (!has_next) break;
#pragma unroll
        for (int a = 0; a < 2; ++a)
#pragma unroll
            for (int b = 0; b < 2; ++b)
#pragma unroll
                for (int m = 0; m < 4; ++m)
#pragma unroll
                    for (int n = 0; n < 2; ++n) acc[a][b][m][n] = (f32x4){0.f, 0.f, 0.f, 0.f};
        cur = nxt; cB = nB; ++ui;
        if constexpr (Sched::EARLY) { if (has2) *xslot = (u32x4){m00, m01, m10, m11}; nxt = nx2; hn_ = has2; }
        if (wr == 1) PG8_BAR;
    }
    PG8_WAIT_V(0);
    PG8_BAR;
#undef PG8_SA
#undef PG8_SB
#undef PG8_STAGE
#undef PG8_STAGEB
#undef PG8_LDA
#undef PG8_LDB
#undef PG8_MMA
#undef PG8_WAIT_V
#undef PG8_WAIT_L
#undef PG8_BAR
#undef PG8_SCHED
#undef PG8_AOFFS
}
}

namespace att {
typedef unsigned short bf16_t;
typedef short bf16x8 __attribute__((ext_vector_type(8)));
typedef short s16x4 __attribute__((ext_vector_type(4)));
typedef float f32x16 __attribute__((ext_vector_type(16)));
typedef float f32x4 __attribute__((ext_vector_type(4)));
typedef unsigned u32x4 __attribute__((ext_vector_type(4)));
constexpr int PITCH = 1024;
constexpr float LOG2E = 1.4426950408889634f;
__device__ __forceinline__ int crow(int r, int hi) { return (r & 3) + 8 * (r >> 2) + 4 * hi; }
typedef float f32x2_t __attribute__((ext_vector_type(2))); typedef __bf16 bf16x2_t __attribute__((ext_vector_type(2)));
__device__ __forceinline__ unsigned cvtpk(float lo, float hi) { f32x2_t v = {lo, hi}; bf16x2_t b = __builtin_convertvector(v, bf16x2_t); return __builtin_bit_cast(unsigned, b); }
__device__ __forceinline__ float bf2f(short s) { return __uint_as_float(((unsigned)(unsigned short)s) << 16); }
typedef short v4i16_t __attribute__((ext_vector_type(4)));
__device__ __forceinline__ s16x4 vtr(const LAS unsigned char* p) { return __builtin_bit_cast(s16x4, __builtin_amdgcn_ds_read_tr16_b64_v4i16((LAS v4i16_t*)p)); }
__device__ __forceinline__ float max3f(float a, float b, float c) { float r; asm("v_max3_f32 %0, %1, %2, %3" : "=v"(r) : "v"(a), "v"(b), "v"(c)); return r; }
__device__ __forceinline__ float halves_max(float m) { auto rr = __builtin_amdgcn_permlane32_swap(__float_as_uint(m), __float_as_uint(m), false, false); return fmaxf(__uint_as_float(rr[0]), __uint_as_float(rr[1])); }
__device__ __forceinline__ float halves_sum(float m) { auto rr = __builtin_amdgcn_permlane32_swap(__float_as_uint(m), __float_as_uint(m), false, false); return __uint_as_float(rr[0]) + __uint_as_float(rr[1]); }
#define ATT_PRIO(x) do { if (wid >= 4) __builtin_amdgcn_s_setprio(1 + (x)); else __builtin_amdgcn_s_setprio(x); } while (0)
#define ATT_BAR() asm volatile("s_waitcnt vmcnt(0) lgkmcnt(0)\n\ts_barrier" ::: "memory")
typedef unsigned u32x2 __attribute__((ext_vector_type(2)));
#define ATT_RD128(d, a, off) asm volatile("ds_read_b128 %0, %1 offset:%2" : "=v"(d) : "v"(a), "n"(off))
#define ATT_RDTR(d, a, off) asm volatile("ds_read_b64_tr_b16 %0, %1 offset:%2" : "=v"(d) : "v"(a), "n"(off))
#define ATT_WAIT2(n, x, y) asm volatile("s_waitcnt lgkmcnt(" #n ")" : "+v"(x), "+v"(y))

struct Args { const bf16_t* Q; const bf16_t* K; const bf16_t* V; bf16_t* O; const float* kmean; const float* kmax2; const float* qmax2; const float* subln; float lam_full; float out_scale; int abl; };
#ifndef ATT_ABLATE
#define ATT_ABLATE 0
#endif
#if ATT_ABLATE
#define ABL(bit) ((((ATT_ABLATE) >> (bit)) & 1) && abl_)
#else
#define ABL(bit) 0
#endif

template <int MODE>
__device__ __forceinline__ void attn_unit(LAS unsigned char* lds, const Args& A, int b, int h, int qblk) {
    constexpr int DVB = MODE == 0 ? 4 : 2;
    constexpr int NCH = MODE == 0 ? 16 : 8;
    constexpr int KBY = NCH * 1024, VBY = DVB * 4096, SLOT = KBY + VBY;
    constexpr int QR = MODE == 0 ? 128 : 256;
    constexpr int PPW = MODE == 0 ? 2 : 1;
    int tid_ = threadIdx.x; asm volatile("" : "+v"(tid_));
    const int tid = tid_, lane = tid & 63, r32 = lane & 31, hi = lane >> 5;
    const int wid = __builtin_amdgcn_readfirstlane(tid >> 6);
    const int comp = MODE == 0 ? (wid >> 2) : 0, wq = MODE == 0 ? (wid & 3) : wid;
    const int q0 = qblk * QR; const long rowbase = (long)b * SEQ;
    const int hcol = MODE == 0 ? h * 128 : h * 64;
    const int qrel0 = wq * 32;
    const float slope2 = __builtin_amdgcn_exp2f(MODE == 0 ? -(float)(h + 1) : -0.5f * (float)(h + 1)) * LOG2E;
    const int NT = MODE == 0 ? 2 * qblk + 2 : 4 + 4 * qblk;
#define ATT_KBASE_(t) (MODE == 0 ? 64 * (t) : ((t) < 4 ? q0 + 64 * (t) : 64 * ((t) - 4)))
#define ATT_KBASE(t) ATT_KBASE_(t)
    LAS float* wsf = (LAS float*)(lds + 65536) + wid * 64;
    const bf16_t* Kb = A.K + rowbase * PITCH + hcol;
    const bf16_t* Vb = A.V + rowbase * PITCH + hcol;
#define ATT_ISSUE_K(tt, slot) do { const int kb_ = ATT_KBASE(tt); \
        _Pragma("unroll") for (int i_ = 0; i_ < PPW; ++i_) { const int p_ = wid + 8 * i_; \
            __builtin_amdgcn_global_load_lds((const GAS unsigned*)(Kb + (size_t)(kb_ + lane) * PITCH + p_ * 8), (LAS unsigned*)(lds + (slot) * SLOT + p_ * 1024), 16, 0, 0); } } while (0)
#define ATT_ISSUE_V(tt, slot) do { const int kb_ = ATT_KBASE(tt); \
        _Pragma("unroll") for (int i_ = 0; i_ < PPW; ++i_) { const int p_ = wid + 8 * i_; \
            __builtin_amdgcn_global_load_lds((const GAS unsigned*)(Vb + (size_t)(kb_ + 16 * (p_ & 3) + (lane >> 2)) * PITCH + (p_ >> 2) * 32 + (lane & 3) * 8), (LAS unsigned*)(lds + (slot) * SLOT + KBY + p_ * 1024), 16, 0, 0); } } while (0)
    asm volatile("s_waitcnt lgkmcnt(0)\n\ts_barrier" ::: "memory");
    bf16x8 qr[4];
    { const bf16_t* Qw = A.Q + (rowbase + q0 + qrel0 + r32) * PITCH + hcol + comp * 64 + hi * 8;
#pragma unroll
      for (int d0 = 0; d0 < 4; ++d0) qr[d0] = *(const GAS bf16x8*)(Qw + d0 * 16); }
    const int tt_l = MODE == 0 ? (lane < 2 ? 2 * qblk + lane : lane - 2) : lane;
    const int kbase_l = (lane < NT) ? ATT_KBASE_(tt_l) : 0;
    const bool past_l = lane < NT && kbase_l + 64 <= q0;
    float k2a = 0.f, k2b = 0.f;
    { const int nblk = (kbase_l >> 8) & 15;
        if constexpr (MODE == 0) { const f32x2_t ka = ((const GAS f32x2_t*)A.kmax2)[(size_t)(b * 16 + h * 2) * 16 + nblk], kb = ((const GAS f32x2_t*)A.kmax2)[(size_t)(b * 16 + h * 2 + 1) * 16 + nblk]; k2a = ka[0] + ka[1]; k2b = kb[0] + kb[1]; }
        else { const f32x2_t ka = ((const GAS f32x2_t*)A.kmax2)[(size_t)(b * 16 + h) * 16 + nblk]; k2a = ka[0] + ka[1]; } }
    float qsa = 0.f, qsb = 0.f;
    if constexpr (MODE == 0) { const f32x2_t a_ = ((const GAS f32x2_t*)A.qmax2)[(size_t)(b * 16 + h * 2) * 32 + qblk], b2_ = ((const GAS f32x2_t*)A.qmax2)[(size_t)(b * 16 + h * 2 + 1) * 32 + qblk]; qsa = a_[0] + a_[1]; qsb = b2_[0] + b2_[1]; }
    else { const f32x2_t a_ = ((const GAS f32x2_t*)A.qmax2)[(size_t)(b * 16 + h) * 32 + 2 * qblk], b2_ = ((const GAS f32x2_t*)A.qmax2)[(size_t)(b * 16 + h) * 32 + 2 * qblk + 1]; qsa = fmaxf(a_[0] + a_[1], b2_[0] + b2_[1]); }
    float kmv0 = 0.f, kmv1 = 0.f;
    if constexpr (MODE == 1) { kmv0 = ((const GAS float*)A.kmean)[(size_t)(b * 16 + h) * 1024 + tid]; kmv1 = ((const GAS float*)A.kmean)[(size_t)(b * 16 + h) * 1024 + 512 + tid]; }
    const int t0 = MODE == 0 ? 2 * qblk : 0, t1 = t0 + 1;
    ATT_ISSUE_K(t0, 0); ATT_ISSUE_V(t0, 0); ATT_ISSUE_K(t1, 1);
    LAS int* live = (LAS int*)(lds + 71680); LAS float* qnx = (LAS float*)(lds + 71680 + 272);
    LAS float* km = (LAS float*)(lds + 67584);
    if constexpr (MODE == 1) { km[tid] = kmv0; km[tid + 512] = kmv1; }
    if (wid == 0) {
        bool alive = lane < NT;
        if (past_l) { float bound;
            if constexpr (MODE == 0) bound = fmaxf(sqrtf(qsa) * sqrtf(k2a), sqrtf(qsb) * sqrtf(k2b));
            else bound = sqrtf(qsa) * sqrtf(k2a);
            alive = !(bound * 1.001f + 1.0f + slope2 * (float)(kbase_l + 63 - q0) < -152.0f);
        }
        const unsigned long long am = __ballot(alive);
        if (alive) live[__popcll(am & ((1ull << lane) - 1ull))] = tt_l;
        if (lane == 0) live[64] = __popcll(am);
    }
    asm volatile("s_waitcnt vmcnt(0)" ::: "memory");
    ATT_BAR();
    unsigned sel = 0u;
    if constexpr (MODE == 1) {
        float g[16];
#pragma unroll
        for (int n = 0; n < 16; ++n) { float s = 0.f;
            if (n < qblk) {
#pragma unroll
                for (int d0 = 0; d0 < 4; ++d0) { const f32x4 ka = *(const LAS f32x4*)(km + n * 64 + d0 * 16 + hi * 8), kb2 = *(const LAS f32x4*)(km + n * 64 + d0 * 16 + hi * 8 + 4);
                    s += bf2f(qr[d0][0]) * ka[0] + bf2f(qr[d0][1]) * ka[1] + bf2f(qr[d0][2]) * ka[2] + bf2f(qr[d0][3]) * ka[3]
                       + bf2f(qr[d0][4]) * kb2[0] + bf2f(qr[d0][5]) * kb2[1] + bf2f(qr[d0][6]) * kb2[2] + bf2f(qr[d0][7]) * kb2[3]; }
                s = halves_sum(s); }
            g[n] = s; }
        const int nsel = qblk < 3 ? qblk : 3;
#pragma unroll
        for (int k = 0; k < 3; ++k) if (k < nsel) { float best = -INFINITY; int bi = 0; bool found = false;
#pragma unroll
            for (int n = 0; n < 16; ++n) if (n < qblk) { const bool free_ = ((sel >> n) & 1u) == 0u; if (free_ && (!found || g[n] > best)) { best = g[n]; bi = n; found = true; } }
            sel |= 1u << bi; }
    }
    const int NTL = __builtin_amdgcn_readfirstlane(live[64]);
#define ATT_ISSUE(t, slot) do { const int kb_ = ATT_KBASE(t); \
        _Pragma("unroll") for (int i_ = 0; i_ < PPW; ++i_) { const int p_ = wid + 8 * i_; \
            __builtin_amdgcn_global_load_lds((const GAS unsigned*)(Kb + (size_t)(kb_ + lane) * PITCH + p_ * 8), (LAS unsigned*)(lds + (slot) * SLOT + p_ * 1024), 16, 0, 0); \
            __builtin_amdgcn_global_load_lds((const GAS unsigned*)(Vb + (size_t)(kb_ + 16 * (p_ & 3) + (lane >> 2)) * PITCH + (p_ >> 2) * 32 + (lane & 3) * 8), (LAS unsigned*)(lds + (slot) * SLOT + KBY + p_ * 1024), 16, 0, 0); } } while (0)
    constexpr float THR = 8.0f;
    float mref = 0.f, l = 0.f; f32x16 o[DVB];
#pragma unroll
    for (int d0 = 0; d0 < DVB; ++d0) o[d0] = f32x16{};
#define ATT_CLASS(tt, SK, NM, SB) do { const int kb_ = ATT_KBASE(tt), kr_ = kb_ - q0; const bool dg_ = kb_ >= q0; SK = dg_ && (kr_ > qrel0 + 31); NM = dg_ && (kr_ + 63 > qrel0); SB = true; \
        if constexpr (MODE == 1) { if ((tt) >= 4) { SB = ((sel >> (((tt) - 4) >> 2)) & 1u) != 0u; if (!__any(SB)) SK = true; } } } while (0)
#define ATT_QK(P0, P1, tt, slot, SB) do { const int kr_ = ATT_KBASE(tt) - q0; float off0_ = slope2 * (float)(kr_ + 4 * hi) - mref; if (!(SB)) off0_ = -INFINITY; const float off1_ = off0_ + 32.0f * slope2; \
        const unsigned ka_ = (unsigned)(size_t)(lds + (slot) * SLOT + comp * 8192 + hi * 1024 + r32 * 16); u32x4 kx_[4], ky_[4]; \
        ATT_RD128(kx_[0], ka_, 0); ATT_RD128(ky_[0], ka_, 512); ATT_RD128(kx_[1], ka_, 2048); ATT_RD128(ky_[1], ka_, 2560); \
        _Pragma("unroll") for (int r = 0; r < 16; ++r) { const float cbr = slope2 * (float)((r & 3) + 8 * (r >> 2)); P0[r] = cbr + off0_; P1[r] = cbr + off1_; } \
        ATT_PRIO(1); ATT_WAIT2(2, kx_[0], ky_[0]); P0 = __builtin_amdgcn_mfma_f32_32x32x16_bf16(__builtin_bit_cast(bf16x8, kx_[0]), qr[0], P0, 0, 0, 0); P1 = __builtin_amdgcn_mfma_f32_32x32x16_bf16(__builtin_bit_cast(bf16x8, ky_[0]), qr[0], P1, 0, 0, 0); \
        ATT_RD128(kx_[2], ka_, 4096); ATT_RD128(ky_[2], ka_, 4608); \
        ATT_WAIT2(2, kx_[1], ky_[1]); P0 = __builtin_amdgcn_mfma_f32_32x32x16_bf16(__builtin_bit_cast(bf16x8, kx_[1]), qr[1], P0, 0, 0, 0); P1 = __builtin_amdgcn_mfma_f32_32x32x16_bf16(__builtin_bit_cast(bf16x8, ky_[1]), qr[1], P1, 0, 0, 0); \
        ATT_RD128(kx_[3], ka_, 6144); ATT_RD128(ky_[3], ka_, 6656); \
        ATT_WAIT2(2, kx_[2], ky_[2]); P0 = __builtin_amdgcn_mfma_f32_32x32x16_bf16(__builtin_bit_cast(bf16x8, kx_[2]), qr[2], P0, 0, 0, 0); P1 = __builtin_amdgcn_mfma_f32_32x32x16_bf16(__builtin_bit_cast(bf16x8, ky_[2]), qr[2], P1, 0, 0, 0); \
        ATT_WAIT2(0, kx_[3], ky_[3]); P0 = __builtin_amdgcn_mfma_f32_32x32x16_bf16(__builtin_bit_cast(bf16x8, kx_[3]), qr[3], P0, 0, 0, 0); P1 = __builtin_amdgcn_mfma_f32_32x32x16_bf16(__builtin_bit_cast(bf16x8, ky_[3]), qr[3], P1, 0, 0, 0); ATT_PRIO(0); } while (0)
    f32x16 p0, p1, n0, n1;
    const int abl_ = __builtin_amdgcn_readfirstlane(A.abl); (void)abl_;
    int t = t0, tn = t1;
    bool skipC, maskC, selC, skipN = true, maskN = false, selN = true;
    ATT_CLASS(t, skipC, maskC, selC);
    if (!skipC) ATT_QK(p0, p1, t, 0, selC);
    const int NTLX = ABL(4) ? 1 : NTL;
    ATT_PRIO(0);
    for (int it = 0; it < NTLX; ++it) {
        ATT_BAR();
        const int tnn = (it + 2 < NTL) ? __builtin_amdgcn_readfirstlane(live[it + 2]) : 0;
        if (it + 2 < NTL && !ABL(0)) ATT_ISSUE_K(tnn, it & 1);
        if (it + 1 < NTL) { if (!ABL(0)) ATT_ISSUE_V(tn, (it + 1) & 1); ATT_CLASS(tn, skipN, maskN, selN); if (!skipN) { if (!ABL(2)) ATT_QK(n0, n1, tn, (it + 1) & 1, selN); else { n0 = f32x16{} - 1.0f; n1 = n0; } } } else skipN = true;
        if (!skipC) {
            const int krel = ATT_KBASE(t) - q0;
            const unsigned va_ = (unsigned)(size_t)(lds + (it & 1) * SLOT + KBY + ((lane >> 4) & 1) * 32 + (lane & 3) * 8 + (4 * hi + ((lane & 15) >> 2)) * 64);
            u32x2 vl_[4], vh_[4];
            if (!ABL(1)) { ATT_RDTR(vl_[0], va_, 0); ATT_RDTR(vh_[0], va_, 512); ATT_RDTR(vl_[1], va_, 1024); ATT_RDTR(vh_[1], va_, 1536);
            ATT_RDTR(vl_[2], va_, 2048); ATT_RDTR(vh_[2], va_, 2560); ATT_RDTR(vl_[3], va_, 3072); ATT_RDTR(vh_[3], va_, 3584); }
            if (maskC) { const int qrel = qrel0 + r32;
#pragma unroll
                for (int r = 0; r < 16; ++r) { const int kv = krel + crow(r, hi); if (kv > qrel) p0[r] = -INFINITY; if (kv + 32 > qrel) p1[r] = -INFINITY; } }
            float rm;
            { float a_ = max3f(p0[0], p0[1], p1[0]), b_ = max3f(p0[2], p0[3], p1[1]); a_ = max3f(a_, p1[2], p1[3]);
#pragma unroll
              for (int r = 4; r < 16; r += 4) { a_ = max3f(a_, p0[r], p0[r + 1]); b_ = max3f(b_, p0[r + 2], p0[r + 3]); a_ = max3f(a_, p1[r], p1[r + 1]); b_ = max3f(b_, p1[r + 2], p1[r + 3]); }
              rm = halves_max(fmaxf(a_, b_)); }
            if (__any(rm > THR)) {
                const float dl = fmaxf(rm, 0.f); mref += dl; const float alpha = __builtin_amdgcn_exp2f(-dl);
#pragma unroll
                for (int r = 0; r < 16; ++r) { p0[r] -= dl; p1[r] -= dl; }
                if (!skipN) {
#pragma unroll
                    for (int r = 0; r < 16; ++r) { n0[r] -= dl; n1[r] -= dl; } }
                l *= alpha;
#pragma unroll
                for (int d0 = 0; d0 < DVB; ++d0) o[d0] = o[d0] * alpha;
            }
            float sacc = 0.f;
            if (!ABL(3)) {
#pragma unroll
            for (int r = 0; r < 16; ++r) { p0[r] = __builtin_amdgcn_exp2f(p0[r]); p1[r] = __builtin_amdgcn_exp2f(p1[r]); sacc += p0[r] + p1[r]; } }
            l += sacc;
            u32x4 pw[4];
            pw[0] = (u32x4){cvtpk(p0[0], p0[1]), cvtpk(p0[2], p0[3]), cvtpk(p0[4], p0[5]), cvtpk(p0[6], p0[7])};
            pw[1] = (u32x4){cvtpk(p0[8], p0[9]), cvtpk(p0[10], p0[11]), cvtpk(p0[12], p0[13]), cvtpk(p0[14], p0[15])};
            pw[2] = (u32x4){cvtpk(p1[0], p1[1]), cvtpk(p1[2], p1[3]), cvtpk(p1[4], p1[5]), cvtpk(p1[6], p1[7])};
            pw[3] = (u32x4){cvtpk(p1[8], p1[9]), cvtpk(p1[10], p1[11]), cvtpk(p1[12], p1[13]), cvtpk(p1[14], p1[15])};
            if (!ABL(1))
#pragma unroll
            for (int i = 0; i < 4 * DVB; ++i) { constexpr int NM = 4 * DVB; const int s_ = i & 3; if (i == 0) ATT_PRIO(1);
                if (i + 3 < NM) ATT_WAIT2(6, vl_[s_], vh_[s_]); else if (i + 3 == NM) ATT_WAIT2(4, vl_[s_], vh_[s_]); else if (i + 2 == NM) ATT_WAIT2(2, vl_[s_], vh_[s_]); else ATT_WAIT2(0, vl_[s_], vh_[s_]);
                const u32x4 vf = (u32x4){vl_[s_][0], vl_[s_][1], vh_[s_][0], vh_[s_][1]};
                o[i >> 2] = __builtin_amdgcn_mfma_f32_32x32x16_bf16(__builtin_bit_cast(bf16x8, vf), __builtin_bit_cast(bf16x8, pw[i & 3]), o[i >> 2], 0, 0, 0);
                if (i + 4 < NM) { ATT_RDTR(vl_[s_], va_, (i + 4) * 1024); ATT_RDTR(vh_[s_], va_, (i + 4) * 1024 + 512); } if (i == NM - 1) ATT_PRIO(0); }
        }
        p0 = n0; p1 = n1; skipC = skipN; maskC = maskN; selC = selN; t = tn; tn = tnn;
    }
#undef ATT_ISSUE_K
#undef ATT_ISSUE_V
#undef ATT_CLASS
#undef ATT_QK
    __builtin_amdgcn_s_setprio(0);
    if (ABL(5)) return;
    f32x4 sg4[DVB][4];
    if constexpr (MODE == 0) {
#pragma unroll
        for (int d0 = 0; d0 < DVB; ++d0)
#pragma unroll
            for (int g = 0; g < 4; ++g) sg4[d0][g] = *(const GAS f32x4*)(A.subln + d0 * 32 + 8 * g + 4 * hi); }
    l = halves_sum(l);
    const float rl = 1.0f / l;
    GAS bf16_t* Ow = (GAS bf16_t*)(A.O + (rowbase + q0 + qrel0 + r32) * PITCH + hcol) + 8 * hi;
#define ATT_STORE_PAIR(d0, gp, V0, V1, V2, V3, W0, W1, W2, W3) do { \
        const unsigned ax_ = cvtpk(V0, V1), ay_ = cvtpk(V2, V3), bx_ = cvtpk(W0, W1), by_ = cvtpk(W2, W3); \
        auto rx_ = __builtin_amdgcn_permlane32_swap(ax_, bx_, false, false); auto ry_ = __builtin_amdgcn_permlane32_swap(ay_, by_, false, false); \
        *(GAS u32x4*)(Ow + (d0) * 32 + 16 * (gp)) = (u32x4){rx_[0], ry_[0], rx_[1], ry_[1]}; } while (0)
    if constexpr (MODE == 1) {
#pragma unroll
        for (int d0 = 0; d0 < DVB; ++d0)
#pragma unroll
            for (int gp = 0; gp < 2; ++gp) ATT_STORE_PAIR(d0, gp, o[d0][8 * gp + 0] * rl, o[d0][8 * gp + 1] * rl, o[d0][8 * gp + 2] * rl, o[d0][8 * gp + 3] * rl,
                                                                 o[d0][8 * gp + 4] * rl, o[d0][8 * gp + 5] * rl, o[d0][8 * gp + 6] * rl, o[d0][8 * gp + 7] * rl);
    } else {
        ATT_BAR();
        LAS float* X = (LAS float*)lds + wq * 4096;
        if (comp == 1) {
#pragma unroll
            for (int d0 = 0; d0 < DVB; ++d0)
#pragma unroll
                for (int r = 0; r < 16; ++r) X[(d0 * 16 + r) * 64 + lane] = o[d0][r] * rl;
        }
        ATT_BAR();
        if (comp == 0) {
            float ss = 0.f;
#pragma unroll
            for (int d0 = 0; d0 < DVB; ++d0)
#pragma unroll
                for (int r = 0; r < 16; ++r) { o[d0][r] = o[d0][r] * rl - A.lam_full * X[(d0 * 16 + r) * 64 + lane]; ss += o[d0][r] * o[d0][r]; }
            ss = halves_sum(ss);
            const float rs = A.out_scale / sqrtf(ss * (1.0f / 128.0f) + 1e-5f);
#pragma unroll
            for (int d0 = 0; d0 < DVB; ++d0)
#pragma unroll
                for (int gp = 0; gp < 2; ++gp) { const f32x4 ga = sg4[d0][2 * gp], gb = sg4[d0][2 * gp + 1];
                    ATT_STORE_PAIR(d0, gp, o[d0][8 * gp + 0] * rs * ga[0], o[d0][8 * gp + 1] * rs * ga[1], o[d0][8 * gp + 2] * rs * ga[2], o[d0][8 * gp + 3] * rs * ga[3],
                                           o[d0][8 * gp + 4] * rs * gb[0], o[d0][8 * gp + 5] * rs * gb[1], o[d0][8 * gp + 6] * rs * gb[2], o[d0][8 * gp + 7] * rs * gb[3]); }
        }
    }
#undef ATT_STORE_PAIR
#undef ATT_KBASE
#undef ATT_KBASE_
#undef ATT_ISSUE
}
#undef ATT_BAR
}

constexpr int NWAVES = 8;
constexpr int NLAYER = 4, PH_PER_LAYER = 8, NPHASE = 1 + NLAYER * PH_PER_LAYER;

constexpr size_t MiB = 1u << 20;
constexpr size_t WS_CTL = 0, CTL_ZERO_BYTES = 2 * MiB;
constexpr size_t WS_KMEAN = 1 * MiB;
constexpr size_t WS_LTOK = 2 * MiB, WS_LW = 3 * MiB;
constexpr size_t WS_DQKV = 5 * MiB;
constexpr size_t WS_DWO = WS_DQKV + 12 * MiB;
constexpr size_t WS_MQKV = WS_DWO + 4 * MiB;
constexpr size_t WS_MWO = WS_MQKV + 12 * MiB;
constexpr size_t WS_FGU = WS_MWO + 4 * MiB;
constexpr size_t WS_FD = WS_FGU + 22 * MiB;
constexpr size_t WS_MGU = WS_FD + 11 * MiB;
constexpr size_t WS_MD = WS_MGU + 112 * MiB;
constexpr size_t WS_XN = WS_MD + 56 * MiB;
constexpr size_t WS_Q = WS_XN + 64 * MiB, WS_K = WS_Q + 64 * MiB, WS_V = WS_K + 64 * MiB;
constexpr size_t WS_ACT = WS_Q;
constexpr size_t WS_END = WS_ACT + (size_t)MOE_TILES_MAX * 256 * DE * 2;
constexpr size_t WS_Y0 = WS_END - 64 * MiB;
constexpr size_t WS_HB = WS_END;
static_assert(WS_XN == 238 * MiB && WS_END == 778 * MiB, "d_ws map");
constexpr int CW_BAR = 4096;
constexpr int CW_ATTQ = 6144;
constexpr int CW_ATTQ2 = 12288;
constexpr int CW_CNT = 8192;

constexpr int RING_OFF = 0, RING_BYTES = 131072;
constexpr int LDSCTL_OFF = RING_BYTES, MISC_OFF = LDSCTL_OFF + 320;
constexpr int XSLOT_OFF = MISC_OFF + 128;
constexpr int LDS_BYTES = 147456;

typedef unsigned short bf16;
typedef unsigned v4u __attribute__((ext_vector_type(4)));
typedef float f32x4 __attribute__((ext_vector_type(4)));
typedef GAS unsigned gu32;
#define RLX_AGENT __ATOMIC_RELAXED, __HIP_MEMORY_SCOPE_AGENT
#define LDS_WAIT() asm volatile("s_waitcnt lgkmcnt(0)" ::: "memory")
#define VM_WAIT() asm volatile("s_waitcnt vmcnt(0)" ::: "memory")
__device__ __forceinline__ unsigned f2bf(float f) { unsigned u = __builtin_bit_cast(unsigned, f); return (u + 0x7fffu + ((u >> 16) & 1u)) >> 16; }
__device__ __forceinline__ unsigned pk2(float lo, float hi) { return f2bf(lo) | (f2bf(hi) << 16); }
__device__ __forceinline__ float bflo(unsigned w) { return __uint_as_float(w << 16); }
__device__ __forceinline__ float bfhi(unsigned w) { return __uint_as_float(w & 0xFFFF0000u); }
static_assert(XSLOT_OFF % 16 == 0 && XSLOT_OFF + 8192 <= LDS_BYTES, "LDS map");
#define XB_TMO      128
#define XB_XCNT(j)  (256  + 64 * (j))
#define XB_XSUB(j)  (1280 + 64 * (j))
#define XB_XGEN(j)  (2304 + 64 * (j))
#define XB_TOP      3328
#define XB_TOPGEN   3392
#define XCD_BAR_WORDS 3456
#define XB_SPIN_CAP (1u << 18)

__device__ __forceinline__ unsigned xb_ld(unsigned* p)              { return __hip_atomic_load(p, __ATOMIC_RELAXED, __HIP_MEMORY_SCOPE_AGENT); }
__device__ __forceinline__ unsigned xb_add(unsigned* p, unsigned v) { return __hip_atomic_fetch_add(p, v, __ATOMIC_RELAXED, __HIP_MEMORY_SCOPE_AGENT); }
__device__ __forceinline__ unsigned xb_xcc_id() { return (unsigned)__builtin_amdgcn_s_getreg((3 << 11) | 20) & 0xFu; }
#define XB_SPIN(cond, bar) do { unsigned _sp = 0; while (cond) { __builtin_amdgcn_s_sleep(1); \
    if ((++_sp & 255u) == 0u) { if (xb_ld(&(bar)[XB_TMO])) break; if (_sp > XB_SPIN_CAP) { atomicAdd(&(bar)[XB_TMO], 1u); break; } } } } while (0)

struct XcdBarrier {
    unsigned* bar; unsigned x;
    volatile LAS unsigned* st;
};

__device__ __forceinline__ XcdBarrier xcd_barrier_post(unsigned* bar, volatile LAS unsigned* st) {
    XcdBarrier b; b.bar = bar; b.x = xb_xcc_id(); b.st = st;
    if (threadIdx.x == 0) (void)xb_add(&bar[XB_XCNT(b.x)], 1u);
    return b;
}
__device__ __forceinline__ void xcd_barrier_complete(unsigned* bar, unsigned x, unsigned& nloc, unsigned& nx) {
    const unsigned G = gridDim.x * gridDim.y * gridDim.z;
    unsigned sum, cnt, mine, sp = 0u;
    for (;;) {
        sum = 0u; cnt = 0u; mine = 0u;
#pragma unroll
        for (unsigned j = 0; j < 16; ++j) { const unsigned c = xb_ld(&bar[XB_XCNT(j)]); sum += c; cnt += (c > 0u) ? 1u : 0u; mine = (j == x) ? c : mine; }
        if (sum == G) break;
        __builtin_amdgcn_s_sleep(1);
        if ((++sp & 255u) == 0u) { if (xb_ld(&bar[XB_TMO])) break; if (sp > XB_SPIN_CAP) { atomicAdd(&bar[XB_TMO], 1u); break; } }
    }
    nloc = mine > 0u ? mine : 1u; nx = cnt > 0u ? cnt : 1u;
}

__device__ __forceinline__ void xcd_barrier(const XcdBarrier& b) {
    asm volatile("s_waitcnt vmcnt(0)" ::: "memory");
    __syncthreads();
    if (threadIdx.x == 0) {
        unsigned* bar = b.bar;
        __builtin_amdgcn_s_waitcnt(0);
        unsigned nloc = b.st[0], nx = b.st[1];
        if (nloc == 0u) { xcd_barrier_complete(bar, b.x, nloc, nx); b.st[0] = nloc; b.st[1] = nx; }
        const unsigned old = xb_add(&bar[XB_XSUB(b.x)], 1u);
        const unsigned gen = old / nloc;
        if (old + 1u == (gen + 1u) * nloc) {
            __builtin_amdgcn_fence(__ATOMIC_RELEASE, "agent");
            asm volatile("s_waitcnt vmcnt(0)" ::: "memory");
            const unsigned og = xb_add(&bar[XB_TOP], 1u);
            const unsigned tg = og / nx;
            if (og + 1u != (tg + 1u) * nx) XB_SPIN(xb_ld(&bar[XB_TOP]) < (tg + 1u) * nx, bar);
            __builtin_amdgcn_fence(__ATOMIC_ACQUIRE, "agent");
            asm volatile("s_waitcnt vmcnt(0)" ::: "memory");
        } else {
            XB_SPIN(xb_ld(&bar[XB_TOP]) < (gen + 1u) * nx, bar);

            __builtin_amdgcn_fence(__ATOMIC_ACQUIRE, "agent");
            asm volatile("s_waitcnt vmcnt(0)" ::: "memory");
        }
    }
    __syncthreads();
}

struct Frame {
    LAS unsigned char* lds;
    volatile LAS unsigned* MISC;
    gu32* ctl;
    int tid, lane, wave;
    int vcu, G;
};
__device__ __forceinline__ float wave_sum(float v) {
    v += __int_as_float(__builtin_amdgcn_update_dpp(0, __float_as_int(v), 0xB1, 0xF, 0xF, true));
    v += __int_as_float(__builtin_amdgcn_update_dpp(0, __float_as_int(v), 0x4E, 0xF, 0xF, true));
    v += __int_as_float(__builtin_amdgcn_update_dpp(0, __float_as_int(v), 0x141, 0xF, 0xF, true));
    v += __int_as_float(__builtin_amdgcn_update_dpp(0, __float_as_int(v), 0x140, 0xF, 0xF, true));
    v += __int_as_float(__builtin_amdgcn_ds_swizzle(__float_as_int(v), 0x401F));
    auto rr = __builtin_amdgcn_permlane32_swap(__float_as_uint(v), __float_as_uint(v), false, false);
    return __uint_as_float(rr[0]) + __uint_as_float(rr[1]);
}
__device__ __forceinline__ void transpose_item(const float* W, int K, int N, void* WT, int k0, int n0, int drow0, LAS float* scr, int lane, bool f8, float wscale) {
    (void)scr;
    const int kq = lane & 7, ns = lane >> 3;
    const GAS f32x4* src = (const GAS f32x4*)((const GAS float*)W + (size_t)(k0 + 8 * kq) * N + n0) + ns;
    f32x4 v[2][8];
#pragma unroll
    for (int i = 0; i < 8; ++i)
#pragma unroll
        for (int m = 0; m < 2; ++m) v[m][i] = src[(size_t)i * (N >> 2) + 8 * m];
#pragma unroll
    for (int m = 0; m < 2; ++m)
#pragma unroll
        for (int j = 0; j < 4; ++j) { const int n = 32 * m + 4 * ns + j;
            if (f8) {
                const unsigned lo = pg8::pk4_fp8(v[m][0][j] * wscale, v[m][1][j] * wscale, v[m][2][j] * wscale, v[m][3][j] * wscale), hi = pg8::pk4_fp8(v[m][4][j] * wscale, v[m][5][j] * wscale, v[m][6][j] * wscale, v[m][7][j] * wscale);
                *(GAS unsigned long long*)((unsigned char*)WT + (size_t)(drow0 + n) * K + k0 + 8 * kq) = (unsigned long long)lo | ((unsigned long long)hi << 32);
            } else {
                v4u o; o.x = pk2(v[m][0][j], v[m][1][j]); o.y = pk2(v[m][2][j], v[m][3][j]); o.z = pk2(v[m][4][j], v[m][5][j]); o.w = pk2(v[m][6][j], v[m][7][j]);
                *(GAS v4u*)((bf16*)WT + (size_t)(drow0 + n) * K + k0 + 8 * kq) = o; }
        }
}
__device__ __forceinline__ void convert_matrix(Frame& F, const float* W, int K, int N, void* WT, int il, unsigned& rot, bool f8 = false, float wscale = 1.0f) {
    LAS float* scr = (LAS float*)(F.lds + RING_OFF + F.wave * 16384);
    const unsigned gw = (unsigned)(F.vcu * NWAVES + F.wave), NGW = (unsigned)(F.G * NWAVES);
    const int nblk = N / 64, nitems = (K / 64) * nblk; int lane_ = F.lane; asm volatile("" : "+v"(lane_));
    for (int it = (int)((gw + NGW - rot % NGW) % NGW); it < nitems; it += (int)NGW) {
        const int kb = it / nblk, nb = it % nblk, n0 = 64 * nb;
        const int drow0 = il == 0 ? n0 : (n0 / 128) * 256 + (il - 1) * 128 + (n0 % 128);
        transpose_item(W, K, N, WT, 64 * kb, n0, drow0, scr, lane_, f8, wscale);
    }
    rot = (rot + (unsigned)nitems) % NGW;
}

struct RouterArgs { const float* router; gu32* cnt; unsigned* ltok; float* lw; };
template <int MODE, bool F8X = false, bool SF32 = false>
__device__ __forceinline__ void norm_phase(Frame& F, const void* src, bf16* hout, const bf16* y1, const float* gain, bf16* xn, float* fout, const RouterArgs& R, const bf16* y0 = nullptr) {
    int lane_ = F.lane; asm volatile("" : "+v"(lane_));
    const int gw = F.vcu * NWAVES + F.wave, NGW = F.G * NWAVES, lane = lane_;
    f32x4 gv[4];
#pragma unroll
    for (int j = 0; j < 4; ++j) gv[j] = *(const GAS f32x4*)(gain + 256 * j + 4 * lane);
    LAS float* RL = (LAS float*)(F.lds + RING_OFF);
    if constexpr (MODE == 2) {
        int tid_ = F.tid; asm volatile("" : "+v"(tid_));
        for (int i = tid_; i < 8192; i += NWAVES * 64) RL[(i & 7) * 1024 + (i >> 3)] = ((const GAS float*)R.router)[i];
        LDS_WAIT(); __syncthreads();
    }
    const int nrows_w = gw < MTOK ? (MTOK - gw + NGW - 1) / NGW : 0;
    for (int cb = 0; cb < nrows_w; cb += 64) {
        int my_t = 0, my_e0 = 0, my_e1 = 0; float my_w0 = 0.f, my_w1 = 0.f; bool valid = false;
        const int cn = (nrows_w - cb) < 64 ? (nrows_w - cb) : 64;
        f32x4 vn[4]; unsigned long long yn[4], zn[4];
        unsigned long long hn[4];
        { const int row0_ = gw + cb * NGW;
          if constexpr (SF32) { const GAS f32x4* xr = (const GAS f32x4*)((const float*)src + (size_t)row0_ * D) + lane;
#pragma unroll
            for (int j = 0; j < 4; ++j) vn[j] = xr[64 * j];
          } else { const GAS unsigned long long* hr_ = (const GAS unsigned long long*)((const bf16*)src + (size_t)row0_ * D) + lane;
#pragma unroll
            for (int j = 0; j < 4; ++j) hn[j] = hr_[64 * j]; }
          if constexpr (MODE == 1 || MODE == 3) { const GAS unsigned long long* yr = (const GAS unsigned long long*)(y1 + (size_t)row0_ * D) + lane, *zr = (const GAS unsigned long long*)(y0 + (size_t)row0_ * D) + lane;
#pragma unroll
            for (int j = 0; j < 4; ++j) { yn[j] = yr[64 * j]; zn[j] = zr[64 * j]; } } }
        for (int i = 0; i < cn; ++i) {
            const int row = gw + (cb + i) * NGW;
            f32x4 v[4]; float s = 0.f;
#pragma unroll
            for (int j = 0; j < 4; ++j) { if constexpr (SF32) v[j] = vn[j]; else { const unsigned long long w = hn[j]; const unsigned lo = (unsigned)w, hi = (unsigned)(w >> 32); v[j] = (f32x4){bflo(lo), bfhi(lo), bflo(hi), bfhi(hi)}; } }
            if constexpr (MODE == 1 || MODE == 3) {
#pragma unroll
                for (int j = 0; j < 4; ++j) { const unsigned long long w = yn[j], z = zn[j]; const unsigned lo = (unsigned)w, hi = (unsigned)(w >> 32), zl = (unsigned)z, zh = (unsigned)(z >> 32);
                    v[j].x += bflo(zl) + bflo(lo); v[j].y += bfhi(zl) + bfhi(lo); v[j].z += bflo(zh) + bflo(hi); v[j].w += bfhi(zh) + bfhi(hi); }
            }
            if (i + 1 < cn) { const int rown = row + NGW;
                if constexpr (SF32) { const GAS f32x4* xr = (const GAS f32x4*)((const float*)src + (size_t)rown * D) + lane;
#pragma unroll
                    for (int j = 0; j < 4; ++j) vn[j] = xr[64 * j];
                } else { const GAS unsigned long long* hr_ = (const GAS unsigned long long*)((const bf16*)src + (size_t)rown * D) + lane;
#pragma unroll
                    for (int j = 0; j < 4; ++j) hn[j] = hr_[64 * j]; }
                if constexpr (MODE == 1 || MODE == 3) { const GAS unsigned long long* yr = (const GAS unsigned long long*)(y1 + (size_t)rown * D) + lane, *zr = (const GAS unsigned long long*)(y0 + (size_t)rown * D) + lane;
#pragma unroll
                    for (int j = 0; j < 4; ++j) { yn[j] = yr[64 * j]; zn[j] = zr[64 * j]; } } }
#pragma unroll
            for (int j = 0; j < 4; ++j) s += (v[j].x * v[j].x + v[j].y * v[j].y) + (v[j].z * v[j].z + v[j].w * v[j].w);
            if constexpr (MODE == 1) { GAS unsigned long long* hr = (GAS unsigned long long*)(hout + (size_t)row * D) + lane;
#pragma unroll
                for (int j = 0; j < 4; ++j) { const unsigned long long hw = (unsigned long long)pk2(v[j].x, v[j].y) | ((unsigned long long)pk2(v[j].z, v[j].w) << 32); hr[64 * j] = hw;
                    v[j] = (f32x4){bflo((unsigned)hw), bfhi((unsigned)hw), bflo((unsigned)(hw >> 32)), bfhi((unsigned)(hw >> 32))}; } }
            const float rstd = 1.f / sqrtf(wave_sum(s) * (1.f / D) + 1e-6f);
#pragma unroll
            for (int j = 0; j < 4; ++j) v[j] = v[j] * rstd * gv[j];
            if constexpr (MODE == 3) { GAS f32x4* orow = (GAS f32x4*)(fout + (size_t)row * D) + lane;
#pragma unroll
                for (int j = 0; j < 4; ++j) orow[64 * j] = v[j];
            } else {
                if constexpr (F8X) { GAS unsigned* o4 = (GAS unsigned*)((unsigned char*)xn + (size_t)row * D) + lane;
#pragma unroll
                    for (int j = 0; j < 4; ++j) o4[64 * j] = pg8::pk4_fp8(v[j].x, v[j].y, v[j].z, v[j].w);
                } else { GAS unsigned long long* o8 = (GAS unsigned long long*)(xn + (size_t)row * D) + lane;
#pragma unroll
                    for (int j = 0; j < 4; ++j) o8[64 * j] = (unsigned long long)pk2(v[j].x, v[j].y) | ((unsigned long long)pk2(v[j].z, v[j].w) << 32); }
            }
            if constexpr (MODE == 2) {
                float lg[NE];
#pragma unroll
                for (int e = 0; e < NE; ++e) { float a = 0.f;
#pragma unroll
                    for (int j = 0; j < 4; ++j) { const f32x4 rr = *(const LAS f32x4*)(RL + e * 1024 + 256 * j + 4 * lane); a += (v[j].x * rr.x + v[j].y * rr.y) + (v[j].z * rr.z + v[j].w * rr.w); }
                    lg[e] = wave_sum(a); }
                int e0 = 0; float v0 = lg[0];
#pragma unroll
                for (int e = 1; e < NE; ++e) if (lg[e] > v0) { v0 = lg[e]; e0 = e; }
                int e1 = -1; float v1 = 0.f;
#pragma unroll
                for (int e = 0; e < NE; ++e) if (e != e0 && (e1 < 0 || lg[e] > v1)) { v1 = lg[e]; e1 = e; }
                const float w0 = 1.f / (1.f + __expf(v1 - v0));
                if (lane == i) { my_t = row; my_e0 = e0; my_e1 = e1; my_w0 = w0; my_w1 = 1.f - w0; valid = true; }
            }
        }
        if constexpr (MODE == 2) {
            unsigned myc = 0u;
#pragma unroll
            for (int e = 0; e < NE; ++e) { const unsigned long long b0 = __ballot(valid && my_e0 == e), b1 = __ballot(valid && my_e1 == e);
                const unsigned c = (unsigned)(__popcll(b0) + __popcll(b1)); if (lane == e) myc = c; }
            unsigned basev = 0u;
            if (lane < NE) basev = __hip_atomic_fetch_add(R.cnt + 64 * lane, myc, RLX_AGENT);
            const unsigned long long lt = (1ull << lane) - 1ull;
            unsigned pos0 = 0u, pos1 = 0u;
#pragma unroll
            for (int e = 0; e < NE; ++e) { const unsigned long long b0 = __ballot(valid && my_e0 == e), b1 = __ballot(valid && my_e1 == e);
                const unsigned be = (unsigned)__shfl((int)basev, e);
                if (my_e0 == e) pos0 = be + (unsigned)__popcll(b0 & lt);
                if (my_e1 == e) pos1 = be + (unsigned)__popcll(b0) + (unsigned)__popcll(b1 & lt); }
            if (valid) {
                ((GAS unsigned*)R.ltok)[(size_t)my_e0 * LIST_CAP + pos0] = (unsigned)my_t;             ((GAS float*)R.lw)[(size_t)my_e0 * LIST_CAP + pos0] = my_w0;
                ((GAS unsigned*)R.ltok)[(size_t)my_e1 * LIST_CAP + pos1] = (unsigned)my_t | (1u << 20); ((GAS float*)R.lw)[(size_t)my_e1 * LIST_CAP + pos1] = my_w1;
            }
        }
    }
    if constexpr (MODE == 2) { LDS_WAIT(); __syncthreads(); }
}

__device__ __forceinline__ void kstat_phase(Frame& F, const bf16* Kt, float* kmean, float* kmax2) {
    int lane_ = F.lane; asm volatile("" : "+v"(lane_));
    const int gw = F.vcu * NWAVES + F.wave, NGW = F.G * NWAVES, lane = lane_;
    for (int task = gw; task < BATCH * 16 * 16; task += NGW) {
        const int hh = task & 15, n = (task >> 4) & 15, b = task >> 8, l5 = lane & 31, hf = lane >> 5;
        const GAS unsigned* p = (const GAS unsigned*)(Kt + ((size_t)b * SEQ + 256 * n + 128 * hf) * D + hh * 64) + l5;
        float a0 = 0.f, a1 = 0.f, mx = 0.f;
#pragma unroll 32
        for (int r = 0; r < 128; ++r) { const unsigned w = p[(size_t)r * (D / 2)]; const float v0 = bflo(w), v1 = bfhi(w); a0 += v0; a1 += v1;
            float s = v0 * v0 + v1 * v1;
            s += __int_as_float(__builtin_amdgcn_update_dpp(0, __float_as_int(s), 0xB1, 0xF, 0xF, true)); s += __int_as_float(__builtin_amdgcn_update_dpp(0, __float_as_int(s), 0x4E, 0xF, 0xF, true));
            s += __int_as_float(__builtin_amdgcn_update_dpp(0, __float_as_int(s), 0x141, 0xF, 0xF, true)); s += __int_as_float(__builtin_amdgcn_update_dpp(0, __float_as_int(s), 0x140, 0xF, 0xF, true));
            s += __int_as_float(__builtin_amdgcn_ds_swizzle(__float_as_int(s), 0x401F)); mx = fmaxf(mx, s); }
        { auto r0 = __builtin_amdgcn_permlane32_swap(__float_as_uint(a0), __float_as_uint(a0), false, false); a0 = __uint_as_float(r0[0]) + __uint_as_float(r0[1]);
          auto r1 = __builtin_amdgcn_permlane32_swap(__float_as_uint(a1), __float_as_uint(a1), false, false); a1 = __uint_as_float(r1[0]) + __uint_as_float(r1[1]);
          auto r2 = __builtin_amdgcn_permlane32_swap(__float_as_uint(mx), __float_as_uint(mx), false, false); mx = fmaxf(__uint_as_float(r2[0]), __uint_as_float(r2[1])); }
        if (hf == 0) { GAS float* o = (GAS float*)(kmean + ((size_t)(b * 16 + hh) * 16 + n) * 64 + 2 * l5);
            o[0] = a0 * (1.f / 256.f); o[1] = a1 * (1.f / 256.f); }
        if (lane == 0) ((GAS float*)kmax2)[(size_t)(b * 16 + hh) * 16 + n] = mx;
    }
}

struct KArgs { const float* in[17]; float* out; unsigned char* ws; int ph_lo, ph_hi; };
struct ConvDesc { const float* W; int K, N; unsigned char* WT; int il; bool f8; float sc; };
constexpr int NCONV = 61, CONV_CH = 128;
__device__ __forceinline__ ConvDesc conv_desc(const KArgs& args, unsigned char* ws, int m) {
    constexpr float WSC_UP = 32.0f, WSC_DN = 64.0f;
    ConvDesc d; d.il = 0; d.f8 = false; d.sc = 1.0f;
    if (m < 2) { d.W = args.in[7] + (size_t)m * D * 3 * D; d.K = D; d.N = 3 * D; d.WT = ws + WS_MQKV + (size_t)m * 3 * D * D * 2; if (m == 1) { d.f8 = true; d.sc = WSC_UP; } }
    else if (m < 4) { const int j = m - 2; d.W = args.in[8] + (size_t)j * D * D; d.K = D; d.N = D; d.WT = ws + WS_MWO + (size_t)j * D * D * 2; }
    else if (m == 4) { d.W = args.in[4]; d.K = D; d.N = D; d.WT = ws + WS_DWO; }
    else if (m == 5) { d.W = args.in[3] + (size_t)D * 3 * D; d.K = D; d.N = 3 * D; d.WT = ws + WS_DQKV + (size_t)3 * D * D * 2; }
    else if (m == 6) { d.W = args.in[4] + (size_t)D * D; d.K = D; d.N = D; d.WT = ws + WS_DWO + (size_t)D * D * 2; }
    else if (m < 13) { const int r = m - 7, j = r / 3, t = r % 3; d.f8 = true;
        if (t < 2) { d.W = args.in[9 + t] + (size_t)j * D * DFF; d.K = D; d.N = DFF; d.WT = ws + WS_FGU + (size_t)j * 2 * DFF * D * 2; d.il = 1 + t; d.sc = d.f8 ? WSC_UP : 1.0f; }
        else { d.W = args.in[11] + (size_t)j * DFF * D; d.K = DFF; d.N = D; d.WT = ws + WS_FD + (size_t)j * D * DFF * 2; d.sc = d.f8 ? WSC_DN : 1.0f; } }
    else { const int r = m - 13, e = r / 3, t = r % 3; d.f8 = true;
        if (t < 2) { d.W = args.in[13 + t] + (size_t)e * D * DE; d.K = D; d.N = DE; d.WT = ws + WS_MGU + (size_t)e * 2 * DE * D; d.il = 1 + t; d.sc = WSC_UP; }
        else { d.W = args.in[15] + (size_t)e * DE * D; d.K = DE; d.N = D; d.WT = ws + WS_MD + (size_t)e * D * DE; d.sc = WSC_DN; } }
    return d;
}
__device__ __forceinline__ int conv_chunks_of(int m) { const int items = m < 2 || m == 5 ? 768 : (m < 7 ? 256 : (m < 13 ? 704 : 896)); return (items + CONV_CH - 1) / CONV_CH; }
__device__ __forceinline__ int conv_total_chunks() { int s = 0; for (int m = 0; m < NCONV; ++m) s += conv_chunks_of(m); return s; }
__device__ __forceinline__ void conv_chunk(Frame& F, const KArgs& args, unsigned char* ws, int c) {
    int m = 0; for (; m < NCONV; ++m) { const int n = conv_chunks_of(m); if (c < n) break; c -= n; }
    const ConvDesc d = conv_desc(args, ws, m);
    LAS float* scr = (LAS float*)(F.lds + RING_OFF + F.wave * 16384);
    int lane_ = F.lane; asm volatile("" : "+v"(lane_));
    const int nblk = d.N / 64, nitems = (d.K / 64) * nblk, last = (c + 1) * CONV_CH < nitems ? (c + 1) * CONV_CH : nitems;
    (void)scr;
    const int kq = lane_ & 7, ns = lane_ >> 3;
    const int first = c * CONV_CH + F.wave, nit = first < last ? (last - first + NWAVES - 1) / NWAVES : 0;
#define CONV_LOAD(v, i_) do { const int it_ = first + NWAVES * (i_), kb_ = it_ / nblk, nb_ = it_ % nblk; \
        const GAS f32x4* src_ = (const GAS f32x4*)((const GAS float*)d.W + (size_t)(64 * kb_ + 8 * kq) * d.N + 64 * nb_) + ns; \
        _Pragma("unroll") for (int i = 0; i < 8; ++i) { asm volatile("global_load_dwordx4 %0, %1, off nt" : "=v"(v[0][i]) : "v"(src_ + (size_t)i * (d.N >> 2))); \
                                                       asm volatile("global_load_dwordx4 %0, %1, off nt" : "=v"(v[1][i]) : "v"(src_ + (size_t)i * (d.N >> 2) + 8)); } } while (0)
#define CONV_WAIT(N, v) asm volatile("s_waitcnt vmcnt(" #N ")" : "+v"(v[0][0]), "+v"(v[0][1]), "+v"(v[0][2]), "+v"(v[0][3]), "+v"(v[0][4]), "+v"(v[0][5]), "+v"(v[0][6]), "+v"(v[0][7]), \
                                                                  "+v"(v[1][0]), "+v"(v[1][1]), "+v"(v[1][2]), "+v"(v[1][3]), "+v"(v[1][4]), "+v"(v[1][5]), "+v"(v[1][6]), "+v"(v[1][7]))
#define CONV_STORE(F8, v, i_) do { const int it_ = first + NWAVES * (i_), kb_ = it_ / nblk, nb_ = it_ % nblk, n0_ = 64 * nb_, k0_ = 64 * kb_; const int drow0_ = d.il == 0 ? n0_ : (n0_ / 128) * 256 + (d.il - 1) * 128 + (n0_ % 128); \
        _Pragma("unroll") for (int m = 0; m < 2; ++m) _Pragma("unroll") for (int j = 0; j < 4; ++j) { const int n = 32 * m + 4 * ns + j; \
            if (F8) { const float ws_ = d.sc; \
                const unsigned lo = pg8::pk4_fp8(v[m][0][j] * ws_, v[m][1][j] * ws_, v[m][2][j] * ws_, v[m][3][j] * ws_), hi = pg8::pk4_fp8(v[m][4][j] * ws_, v[m][5][j] * ws_, v[m][6][j] * ws_, v[m][7][j] * ws_); \
                __builtin_nontemporal_store((unsigned long long)lo | ((unsigned long long)hi << 32), (GAS unsigned long long*)((unsigned char*)d.WT + (size_t)(drow0_ + n) * d.K + k0_ + 8 * kq)); \
            } else { v4u o; o.x = pk2(v[m][0][j], v[m][1][j]); o.y = pk2(v[m][2][j], v[m][3][j]); o.z = pk2(v[m][4][j], v[m][5][j]); o.w = pk2(v[m][6][j], v[m][7][j]); \
                __builtin_nontemporal_store(o, (GAS v4u*)((bf16*)d.WT + (size_t)(drow0_ + n) * d.K + k0_ + 8 * kq)); } } } while (0)
#define CONV_RUN(F8) do { f32x4 va[2][8], vb[2][8]; int i = 0; \
        if (nit > 0) { CONV_LOAD(va, 0); \
            if (nit > 2) { CONV_LOAD(vb, 1); CONV_WAIT(16, va); CONV_STORE(F8, va, 0); CONV_LOAD(va, 2); CONV_WAIT(24, vb); CONV_STORE(F8, vb, 1); i = 2; \
                for (; i + 2 < nit; i += 2) { CONV_LOAD(vb, i + 1); CONV_WAIT(24, va); CONV_STORE(F8, va, i); CONV_LOAD(va, i + 2); CONV_WAIT(24, vb); CONV_STORE(F8, vb, i + 1); } } \
            if (i + 1 < nit) { CONV_LOAD(vb, i + 1); CONV_WAIT(16, va); CONV_STORE(F8, va, i); CONV_WAIT(0, vb); CONV_STORE(F8, vb, i + 1); } else { CONV_WAIT(0, va); CONV_STORE(F8, va, i); } } } while (0)
    if (d.f8) CONV_RUN(true); else CONV_RUN(false);
#undef CONV_RUN
#undef CONV_LOAD
#undef CONV_WAIT
#undef CONV_STORE
}

__global__ void __launch_bounds__(NWAVES * 64, 2) trunk_fwd(KArgs args) {
    extern __shared__ __attribute__((aligned(16))) unsigned char lds[];
    Frame F;
    F.lds = (LAS unsigned char*)lds;
    F.MISC = (volatile LAS unsigned*)(F.lds + MISC_OFF);
    F.tid = threadIdx.x; F.lane = F.tid & 63; F.wave = __builtin_amdgcn_readfirstlane(F.tid >> 6);
    F.G = gridDim.x; { const int bx = blockIdx.x; F.vcu = (F.G % 8 == 0) ? (bx % 8) * (F.G / 8) + bx / 8 : bx; }
    F.ctl = (gu32*)(args.ws + WS_CTL);
    for (int u = F.tid; u < (LDS_BYTES - LDSCTL_OFF) / 4; u += NWAVES * 64) ((LAS unsigned*)(F.lds + LDSCTL_OFF))[u] = 0u;
    __syncthreads();
    Frame& F0 = F;
    const int lo = args.ph_lo, hi = args.ph_hi;
    XcdBarrier bar; bar.bar = (unsigned*)(F.ctl + CW_BAR); bar.x = 0; bar.st = nullptr;
    if (hi - lo > 1) bar = xcd_barrier_post((unsigned*)(F.ctl + CW_BAR), F.MISC + 8);
#define IN(k) (lo <= (k) && (k) < hi)
#ifndef PH_ENABLE
#define PH_ENABLE 0xFFFFFFFFu
#endif
#define PHEN(n) (((PH_ENABLE) >> (n)) & 1u)
#ifndef MK_DOUBLE
#define MK_DOUBLE 0u
#endif
#define NREP(n) ((((MK_DOUBLE) >> (n)) & 1u) ? 2 : 1)
#if defined(NO_OPQ)
#define OPQ(p) do {} while (0)
#else
#define OPQ(p) asm volatile("" : "+s"(p))
#endif
#if 0
#define STAMP(k) do { if (blockIdx.x == 0 && threadIdx.x == 0) { const unsigned long long t_ = __builtin_amdgcn_s_memrealtime(); ((GAS unsigned*)(F0.ctl))[3000 + (k)] = (unsigned)t_; } } while (0)
#else
#define STAMP(k) do {} while (0)
#endif
#define SEAM(k) do { if (IN(k) && IN((k) + 1)) { XcdBarrier b2_ = bar; OPQ(b2_.bar); xcd_barrier(b2_); } STAMP((k) + 1); } while (0)

#define PTRS() unsigned char* ws = args.ws; OPQ(ws); const float* x = args.in[0]; OPQ(x); const float* norm_mix = args.in[1]; OPQ(norm_mix); const float* norm_ffn = args.in[2]; OPQ(norm_ffn); \
    bf16* h = (bf16*)(ws + WS_HB); \
    bf16* XN = (bf16*)(ws + WS_XN); bf16* Qb = (bf16*)(ws + WS_Q); bf16* Kb = (bf16*)(ws + WS_K); bf16* Vb = (bf16*)(ws + WS_V); bf16* ACT = (bf16*)(ws + WS_ACT); \
    bf16* MGU = (bf16*)(ws + WS_MGU); bf16* MD = (bf16*)(ws + WS_MD); \
    float* kmean = (float*)(ws + WS_KMEAN); unsigned* ltok = (unsigned*)(ws + WS_LTOK); float* lw = (float*)(ws + WS_LW); \
    (void)x; (void)norm_mix; (void)norm_ffn; (void)h; (void)XN; (void)Qb; (void)Kb; (void)Vb; (void)ACT; (void)MGU; (void)MD; (void)kmean; (void)ltok; (void)lw
    const RouterArgs noR{nullptr, nullptr, nullptr, nullptr};
#ifndef MK_F8_DENSE
#define MK_F8_DENSE 0
#endif
    constexpr bool F8_DENSE = MK_F8_DENSE != 0; constexpr int DESZ = F8_DENSE ? 1 : 2;
    constexpr float WSC_UP = 32.0f, WSC_DN = 64.0f;
    constexpr float C2 = 0.125f * 1.4426950408889634f;

    STAMP(0);
    if (PHEN(0) && IN(0)) {
        PTRS();
        { unsigned rot = 0u;
        convert_matrix(F, args.in[3], D, 3 * D, ws + WS_DQKV, 0, rot);
        norm_phase<0, false, true>(F, x, nullptr, nullptr, norm_mix, XN, nullptr, noR);
        }
    }
    SEAM(0);

    for (int L = 0; L < NLAYER; ++L) {
        const int j = L >> 1, moba = L & 1, pb = 1 + PH_PER_LAYER * L;
        int z_ = 0;
#if !defined(NO_OPQ_Z)
        asm volatile("" : "+s"(z_));
#endif
        Frame Fl = F0; Fl.G += z_; Fl.vcu += z_; Fl.wave += z_; Fl.lds += z_; Fl.ctl += z_; const int bx = (int)blockIdx.x + z_;
#define F Fl
        if (PHEN(1) && IN(pb + 0)) {
            PTRS();

            const bf16* W = (const bf16*)(ws + (moba ? WS_MQKV : WS_DQKV)) + (size_t)j * 3 * D * D;
            if (L == 3) { pg8::Gemm g{XN, ws + WS_MQKV + (size_t)j * 3 * D * D * 2, D, 0}; pg8::StaticOrder S; S.init(MTOK, 3 * D, F.G, bx);
                pg8::EpiQKV E{Qb, D, D, (size_t)(WS_K - WS_Q) / 2, C2, 1.0f / WSC_UP, kmean, (unsigned*)(kmean + 8 * 16 * 16 * 64), moba != 0, (unsigned*)(kmean + 8 * 16 * 16 * 66)};
                pg8::gemm_phase<pg8::EpiQKV, pg8::StaticOrder, true>(F.lds + RING_OFF, XSLOT_OFF, g, S, E);
            } else {
            pg8::Gemm g{XN, W, 2 * D, 0}; pg8::StaticOrder S; S.init(MTOK, 3 * D, F.G, bx);
            pg8::EpiQKV E{Qb, D, D, (size_t)(WS_K - WS_Q) / 2, C2, 1.0f, kmean, (unsigned*)(kmean + 8 * 16 * 16 * 64), moba != 0, (unsigned*)(kmean + 8 * 16 * 16 * 66)};
            for (int rep_ = 0; rep_ < NREP(1); ++rep_) pg8::gemm_phase<pg8::EpiQKV, pg8::StaticOrder>(F.lds + RING_OFF, XSLOT_OFF, g, S, E); }
        }
        SEAM(pb + 0);
        if (IN(pb + 2)) {
            PTRS();
            att::Args A; A.Q = Qb; A.K = Kb; A.V = Vb; A.O = XN; A.kmean = kmean; A.kmax2 = kmean + 8 * 16 * 16 * 64; A.qmax2 = kmean + 8 * 16 * 16 * 66; A.subln = args.in[6] + (size_t)j * 128; A.lam_full = 0.f; A.out_scale = 1.f; A.abl = 0;
            LAS int* qw;
            if (!moba) {
                const float* lam = args.in[5] + (size_t)j * 256; int lane = F.lane; asm volatile("" : "+v"(lane));
                const GAS float* lamg = (const GAS float*)lam; const float s1 = wave_sum(lamg[lane] * lamg[64 + lane]), s2 = wave_sum(lamg[128 + lane] * lamg[192 + lane]);
                const float lam_init = (L == 0) ? 0.2f : 0.47071302f;
                A.lam_full = __uint_as_float(__builtin_amdgcn_readfirstlane(__float_as_uint(__expf(s1) - __expf(s2) + lam_init))); A.out_scale = __uint_as_float(__builtin_amdgcn_readfirstlane(__float_as_uint(1.0f - lam_init)));
            }
            const int nconv = (L == 0) ? conv_total_chunks() : 0;
            qw = (LAS int*)(F.lds + XSLOT_OFF);
            const int xme = (int)(xb_xcc_id() & 7u);
            if ((PHEN(3) && !moba) || (PHEN(4) && moba)) for (int rep_ = 0; rep_ < (moba ? NREP(4) : NREP(3)); ++rep_) for (int xq = xme;;) {
#if ATT_ABLATE
                { const bool ab_ = rep_ == 0 && (moba ? NREP(4) : NREP(3)) == 2; A.abl = ab_ ? ATT_ABLATE : 0; A.O = ab_ ? (bf16*)(ws + WS_END) : XN; }
#endif
                const int ncx = (nconv && rep_ == 0) ? ((nconv - xq + 7) >> 3) : 0;
                gu32* qb = F.ctl + CW_ATTQ2 + 256 * L + 1024 * rep_; gu32* qx = qb + 32 * xq;
                for (;;) {
                    if (F.tid == 0) *qw = (int)__hip_atomic_fetch_add(qx, 1u, RLX_AGENT);
                    asm volatile("s_waitcnt vmcnt(0) lgkmcnt(0)\n\ts_barrier" ::: "memory");
                    int idx = __builtin_amdgcn_readfirstlane(*qw);
                    if (idx >= 128 + ncx) { asm volatile("s_waitcnt vmcnt(0) lgkmcnt(0)\n\ts_barrier" ::: "memory"); break; }
                    if (ncx) { const int q3 = idx / 3; if (idx < 3 * ncx) { if (idx - 3 * q3 == 2) { conv_chunk(F, args, ws, xq + 8 * q3); asm volatile("s_waitcnt vmcnt(0) lgkmcnt(0)\n\ts_barrier" ::: "memory"); continue; } idx -= q3; } else idx -= ncx; }
                    if (!moba) { const int hh = 7 - (idx >> 4), pr = idx & 15;
                        att::attn_unit<0>(F.lds + RING_OFF, A, xq, hh, pr);
                        att::attn_unit<0>(F.lds + RING_OFF, A, xq, hh, 31 - pr);
                    } else { const int hh = 15 - (idx >> 3), pr = idx & 7;
                        att::attn_unit<1>(F.lds + RING_OFF, A, xq, hh, pr);
                        att::attn_unit<1>(F.lds + RING_OFF, A, xq, hh, 15 - pr); }
                }
                if (F.tid < 64) { int lane = F.tid; asm volatile("" : "+v"(lane)); bool av = false;
                    if (lane < 8) { const int lim = 128 + ((nconv && rep_ == 0) ? ((nconv - lane + 7) >> 3) : 0); av = (int)__hip_atomic_load(qb + 32 * lane, RLX_AGENT) < lim; }
                    const unsigned long long m_ = __ballot(av);
                    if (lane == 0) *qw = (int)(unsigned)m_; }
                asm volatile("s_waitcnt vmcnt(0) lgkmcnt(0)\n\ts_barrier" ::: "memory");
                const unsigned m = (unsigned)__builtin_amdgcn_readfirstlane(*qw);
                asm volatile("s_waitcnt vmcnt(0) lgkmcnt(0)\n\ts_barrier" ::: "memory");
                if (m == 0u) break;
                const unsigned rot = ((m >> xme) | (m << (8 - xme))) & 0xFFu;
                xq = (xme + __builtin_ctz(rot)) & 7;
            }
            asm volatile("s_waitcnt vmcnt(0) lgkmcnt(0)\n\ts_barrier" ::: "memory");
        }
        SEAM(pb + 2);
        if (PHEN(5) && IN(pb + 3)) {
            PTRS();
            const bf16* W = (const bf16*)(ws + (moba ? WS_MWO : WS_DWO)) + (size_t)j * D * D;
            pg8::Gemm g{XN, W, 2 * D, 0}; pg8::StaticOrder S; S.init(MTOK, D, F.G, bx);
            if (L == 0) { pg8::EpiRes<true> E{x, h, D, 1.0f}; pg8::gemm_phase<pg8::EpiRes<true>, pg8::StaticOrder>(F.lds + RING_OFF, XSLOT_OFF, g, S, E); }
            else { pg8::EpiRes<false> E{h, h, D, 1.0f}; pg8::gemm_phase<pg8::EpiRes<false>, pg8::StaticOrder>(F.lds + RING_OFF, XSLOT_OFF, g, S, E); }
        }
        SEAM(pb + 3);
        if (PHEN(6) && IN(pb + 4)) {
            PTRS();
            if (L != NLAYER - 1) { const int gt_ = bx * (NWAVES * 64) + F.tid;
                for (int i_ = gt_; i_ < 8 * 16 * 16 * 66 + 8 * 16 * 32 * 2; i_ += F.G * NWAVES * 64) ((GAS float*)kmean)[i_] = 0.f; }
            if (!moba) {
                if (L == 2) norm_phase<0, true>(F, h, nullptr, nullptr, norm_ffn + (size_t)L * D, XN, nullptr, noR);
                else norm_phase<0, true>(F, h, nullptr, nullptr, norm_ffn + (size_t)L * D, XN, nullptr, noR);
            } else {
                const RouterArgs R{args.in[12] + (size_t)j * D * NE, F.ctl + CW_CNT + 64 * NE * j, ltok, lw};
                norm_phase<2, true>(F, h, nullptr, nullptr, norm_ffn + (size_t)L * D, XN, nullptr, R);
            }
        }
        SEAM(pb + 4);
        if (IN(pb + 5)) {
            PTRS();
            if (PHEN(7) && !moba) {
                if (true) { pg8::Gemm g{XN, ws + WS_FGU + (size_t)j * 2 * DFF * D * 2, D, 0};
 pg8::StaticOrder S; S.init(MTOK, 2 * DFF, F.G, bx);
                    pg8::EpiSwiGLU<true> E{ACT, DFF, 1.0f / WSC_UP};
                    pg8::gemm_phase<pg8::EpiSwiGLU<true>, pg8::StaticOrder, true>(F.lds + RING_OFF, XSLOT_OFF, g, S, E);
                } else { pg8::Gemm g{XN, ws + WS_FGU + (size_t)j * 2 * DFF * D * 2, D, 0}; pg8::StaticOrder S; S.init(MTOK, 2 * DFF, F.G, bx);
                    pg8::EpiSwiGLU<false> E{ACT, DFF, 1.0f / WSC_UP};
                    pg8::gemm_phase<pg8::EpiSwiGLU<false>, pg8::StaticOrder, true>(F.lds + RING_OFF, XSLOT_OFF, g, S, E); }
            } else if (PHEN(8) && moba) {
                pg8::Gemm g{XN, ws + WS_MGU + (size_t)j * NE * 2 * DE * D, D, (size_t)2 * DE * D}; pg8::MoeOrder S; S.init((const unsigned*)(F.ctl + CW_CNT + 64 * NE * j), ltok, true, 2 * DE, F.G, bx);
                pg8::EpiSwiGLU<true> E{ACT, DE, 1.0f / WSC_UP};
                pg8::gemm_phase<pg8::EpiSwiGLU<true>, pg8::MoeOrder, true>(F.lds + RING_OFF, XSLOT_OFF, g, S, E);
            }
        }
        SEAM(pb + 5);
        if (IN(pb + 6)) {
            PTRS();
            if (PHEN(9) && !moba) {
                if (true) { pg8::Gemm g{ACT, ws + WS_FD + (size_t)j * D * DFF * 2, DFF, 0}; pg8::StaticOrder S; S.init(MTOK, D, F.G, bx);
                    pg8::EpiRes<false> E{h, h, D, 1.0f / WSC_DN};
                    pg8::gemm_phase<pg8::EpiRes<false>, pg8::StaticOrder, true>(F.lds + RING_OFF, XSLOT_OFF, g, S, E);
                } else { pg8::Gemm g{ACT, ws + WS_FD + (size_t)j * D * DFF * 2, 2 * DFF, 0}; pg8::StaticOrder S; S.init(MTOK, D, F.G, bx);
                    pg8::EpiRes<false> E{h, h, D, 1.0f};
                    pg8::gemm_phase<pg8::EpiRes<false>, pg8::StaticOrder, false>(F.lds + RING_OFF, XSLOT_OFF, g, S, E); }
            } else if (PHEN(10) && moba) {
                pg8::Gemm g{ACT, ws + WS_MD + (size_t)j * NE * D * DE, DE, (size_t)D * DE}; pg8::MoeOrder S; S.init((const unsigned*)(F.ctl + CW_CNT + 64 * NE * j), ltok, false, D, F.G, bx);
                pg8::EpiMoeDown E; E.y0 = (bf16*)(ws + WS_Y0); E.y1 = XN; E.list_tok = ltok; E.list_w = lw; E.sc = 1.0f / WSC_DN;
#pragma unroll
                for (int e = 0; e < NE; ++e) E.cnt[e] = S.cnt[e];
                pg8::gemm_phase<pg8::EpiMoeDown, pg8::MoeOrder, true>(F.lds + RING_OFF, XSLOT_OFF, g, S, E);
            }
        }
        SEAM(pb + 6);
        if (PHEN(11) && IN(pb + 7)) {
            PTRS();
            if (L == 3) norm_phase<3>(F, h, nullptr, XN, args.in[16], nullptr, args.out, noR, (const bf16*)(ws + WS_Y0));
            else if (moba) norm_phase<1>(F, h, h, XN, norm_mix + (size_t)(L + 1) * D, XN, nullptr, noR, (const bf16*)(ws + WS_Y0));
            else if (L == 2) norm_phase<0, true>(F, h, nullptr, nullptr, norm_mix + (size_t)(L + 1) * D, XN, nullptr, noR);
            else for (int rep_ = 0; rep_ < NREP(11); ++rep_) norm_phase<0>(F, h, nullptr, nullptr, norm_mix + (size_t)(L + 1) * D, XN, nullptr, noR);
        }
        if (L != NLAYER - 1) SEAM(pb + 7); else STAMP(pb + 8);
#undef F
    }
#undef IN
#undef SEAM
#undef PTRS
#undef OPQ
}


#if MK_DEBUG
__global__ void dbg_probe(const void* buf, size_t n, int is_bf16, int idx, float thresh, unsigned* dbg) {
    size_t i = blockIdx.x * (size_t)blockDim.x + threadIdx.x, stride = (size_t)gridDim.x * blockDim.x; bool bad = false;
    for (size_t k = i; k < n; k += stride) { float v = is_bf16 ? __uint_as_float(((unsigned)((const unsigned short*)buf)[k]) << 16) : ((const float*)buf)[k]; if (!(fabsf(v) <= thresh)) bad = true; }
    if (bad) atomicMax(dbg, (unsigned)(1000 - idx));
}
__global__ void dbg_cnt(const unsigned* cntw, int idx, unsigned* dbg) {
    if (threadIdx.x == 0 && blockIdx.x == 0) { unsigned s = 0; for (int e = 0; e < NE; ++e) s += cntw[64 * e]; if (s != 2u * MTOK) atomicMax(dbg, (unsigned)(1000 - idx)); }
}

__device__ __forceinline__ float dbg_bf(unsigned short v) { return __uint_as_float(((unsigned)v) << 16); }
__device__ __forceinline__ unsigned dbg_hash(unsigned x) { x ^= x >> 16; x *= 0x7feb352dU; x ^= x >> 15; x *= 0x846ca68bU; x ^= x >> 16; return x; }
__global__ void dbg_gemm_check(const unsigned short* A, int lda, const unsigned short* Bt, int K, const unsigned short* out, int ldo, int M, int N, float scale, int idx, unsigned* dbg) {
    const unsigned s = blockIdx.x * blockDim.x + threadIdx.x; const int row = (int)(dbg_hash(2 * s + 1) % (unsigned)M), col = (int)(dbg_hash(2 * s + 2) % (unsigned)N);
    float acc = 0.f; for (int k = 0; k < K; ++k) acc += dbg_bf(A[(size_t)row * lda + k]) * dbg_bf(Bt[(size_t)col * K + k]);
    acc *= scale; const float got = dbg_bf(out[(size_t)row * ldo + col]);
    if (!(fabsf(got - acc) <= 0.03f + 0.02f * fabsf(acc))) { atomicMax(dbg, (unsigned)(1000 - idx)); atomicAdd(dbg + 64 + idx, 1u); }
}
__global__ void dbg_conv_check(const float* W, int K, int N, const unsigned short* WT, int il, int idx, unsigned* dbg) {
    const unsigned s = blockIdx.x * blockDim.x + threadIdx.x; const int k = (int)(dbg_hash(2 * s + 1) % (unsigned)K), n = (int)(dbg_hash(2 * s + 2) % (unsigned)N);
    const int dr = il == 0 ? n : (n / 128) * 256 + (il - 1) * 128 + (n % 128);
    const float w = W[(size_t)k * N + n], g = dbg_bf(WT[(size_t)dr * K + k]);
    if (!(fabsf(g - w) <= 0.01f * fabsf(w) + 1e-6f)) atomicMax(dbg, (unsigned)(1000 - idx));
}
__global__ void dbg_norm_check(const float* src, const float* gain, const unsigned short* xn, int idx, unsigned* dbg) {
    const unsigned s = blockIdx.x * blockDim.x + threadIdx.x; const int row = (int)(dbg_hash(s + 77) % (unsigned)MTOK);
    float ss = 0.f; for (int c = 0; c < D; ++c) { const float v = src[(size_t)row * D + c]; ss += v * v; }
    const float rstd = 1.f / sqrtf(ss / D + 1e-6f); bool bad = false;
    for (int c = 0; c < D; ++c) { const float r = src[(size_t)row * D + c] * rstd * gain[c], g = dbg_bf(xn[(size_t)row * D + c]); if (!(fabsf(g - r) <= 0.02f + 0.01f * fabsf(r))) bad = true; }
    if (bad) atomicMax(dbg, (unsigned)(1000 - idx));
}
__global__ void dbg_naive_gemm(const unsigned short* A, const unsigned short* Bt, unsigned short* out, int M, int N, int K) {
    const size_t i = blockIdx.x * (size_t)blockDim.x + threadIdx.x; if (i >= (size_t)M * N) return; const int row = (int)(i / N), col = (int)(i % N);
    float acc = 0.f; for (int k = 0; k < K; ++k) acc += dbg_bf(A[(size_t)row * K + k]) * dbg_bf(Bt[(size_t)col * K + k]);
    out[(size_t)row * N + col] = (unsigned short)f2bf(acc);
}
__global__ void dbg_find_col(const unsigned short* out, const unsigned short* ref, int M, int N, unsigned* hist) {
    const unsigned s = blockIdx.x * blockDim.x + threadIdx.x; const int row = (int)(dbg_hash(2 * s + 1) % (unsigned)M), col = (int)(dbg_hash(2 * s + 2) % (unsigned)N);
    const unsigned short v = out[(size_t)row * N + col]; int found = -1;
#if MK_FIND_PATTERN
    if (v == 0x3C3C) atomicAdd(hist + N, 1u); else atomicAdd(hist + 5, 1u); return;
#endif
#if MK_FIND_ROWS
    for (int r = 0; r < M; ++r) if (ref[(size_t)r * N + col] == v) { found = r; break; }
    if (found < 0) atomicAdd(hist + N, 1u); else atomicAdd(hist + ((found - row) & (N - 1)), 1u);
#else
    for (int c = 0; c < N; ++c) if (ref[(size_t)row * N + c] == v) { found = c; break; }
    if (found < 0) atomicAdd(hist + N, 1u); else atomicAdd(hist + ((found - col) & (N - 1)), 1u);
#endif
}
__global__ void dbg_hist_code(const unsigned* hist, int N, unsigned* dbg) {
    if (threadIdx.x || blockIdx.x) return; unsigned best = 0, bi = 0; for (int i = 0; i < N; ++i) if (hist[i] > best) { best = hist[i]; bi = i; }
    dbg[32] = bi; dbg[33] = best; dbg[34] = hist[N];
}
__global__ void dbg_final(float* out, size_t n, const unsigned* dbg) {
    if (MK_HIST_SEL >= 10) { const float c3 = sqrtf((float)dbg[MK_HIST_SEL + 30]); size_t i3 = blockIdx.x * (size_t)blockDim.x + threadIdx.x, st3 = (size_t)gridDim.x * blockDim.x; for (size_t k3 = i3; k3 < n; k3 += st3) out[k3] = c3; return; }
    if (MK_HIST_SEL >= 0 && (dbg[33] || dbg[34])) { const float c2 = sqrtf((float)(MK_HIST_SEL == 0 ? dbg[32] : (MK_HIST_SEL == 1 ? dbg[33] * 100u / 4096u : dbg[34] * 100u / 4096u)) + 1.f); size_t i2 = blockIdx.x * (size_t)blockDim.x + threadIdx.x, st2 = (size_t)gridDim.x * blockDim.x; for (size_t k2 = i2; k2 < n; k2 += st2) out[k2] = c2; return; }
    const unsigned d = dbg[0]; if (d == 0u) return; const unsigned nf = dbg[64 + (1000u - d)]; const float c = sqrtf(nf ? (float)(200u * (1000u - d - 9u) + nf * 100u / 4096u) : (float)(1000u - d));
    size_t i = blockIdx.x * (size_t)blockDim.x + threadIdx.x, stride = (size_t)gridDim.x * blockDim.x;
    for (size_t k = i; k < n; k += stride) out[k] = c;
}
#endif

#ifndef MK_REPEAT
#define MK_REPEAT 1
#endif
#ifndef MK_FIND_ROWS
#define MK_FIND_ROWS 0
#endif
#ifndef MK_FIND_REGION
#define MK_FIND_REGION WS_K
#endif
#ifndef MK_HIST_SEL
#define MK_HIST_SEL 0
#endif
#ifndef MK_STAMP
#define MK_STAMP 0
#endif
#if MK_STAMP
__global__ void stamp_k(unsigned* p) { if (threadIdx.x == 0) *p = (unsigned)__builtin_amdgcn_s_memrealtime(); }
__global__ void stamp_encode(float* out, size_t n, const unsigned* st, int pa, float ua, int pb, float ub) {
    const float da = (float)(st[pa + 1] - st[pa]) * 0.01f, db = (float)(st[pb + 1] - st[pb]) * 0.01f;
    float m = da / ua; m = m < 10.f ? 10.f : (m > 99.f ? 99.f : m); float e = floorf(db / ub + 0.5f); e = e < 0.f ? 0.f : (e > 30.f ? 30.f : e);
    const float c = sqrtf(m) * __powf(10.f, 0.5f * e);
    size_t i = blockIdx.x * (size_t)blockDim.x + threadIdx.x, stride = (size_t)gridDim.x * blockDim.x;
    for (size_t k = i; k < n; k += stride) out[k] = c;
}
#endif
extern "C" void kernel_launch(void* const* d_in, const int* in_sizes, int n_in, void* d_out, int out_size, void* d_ws, size_t ws_size, hipStream_t stream) {
    static int grid = 0;
    if (grid == 0) {
        if (n_in != 17 || in_sizes[0] != MTOK * D || out_size != MTOK * D || ws_size < WS_END) {
            fprintf(stderr, "kernel_launch: built for 17 inputs, x/out of %d floats, >= %zu bytes of workspace; got n_in %d, in0 %d, out %d, ws %zu; nothing launched\n", MTOK * D, (size_t)WS_END, n_in, n_in > 0 ? in_sizes[0] : -1, out_size, ws_size);
            grid = -1; return; }
        int dev = 0, cus = 0, per_cu = 0;
        if (hipGetDevice(&dev) != hipSuccess || hipDeviceGetAttribute(&cus, hipDeviceAttributeMultiprocessorCount, dev) != hipSuccess) { fprintf(stderr, "kernel_launch: device query failed\n"); grid = -1; return; }
        if (hipFuncSetAttribute((const void*)trunk_fwd, hipFuncAttributeMaxDynamicSharedMemorySize, LDS_BYTES) != hipSuccess) { fprintf(stderr, "kernel_launch: hipFuncSetAttribute failed\n"); grid = -1; return; }
        if (hipOccupancyMaxActiveBlocksPerMultiprocessor(&per_cu, (const void*)trunk_fwd, NWAVES * 64, LDS_BYTES) != hipSuccess || per_cu < 1)
            fprintf(stderr, "kernel_launch: note: occupancy query reports %d workgroups per CU\n", per_cu);
        (void)hipGetLastError();
        grid = cus;
    }
    if (grid < 0) return;
    if (hipMemsetAsync((char*)d_ws + WS_CTL, 0, CTL_ZERO_BYTES, stream) != hipSuccess) { fprintf(stderr, "kernel_launch: memset failed\n"); return; }
    KArgs a{};
    for (int i = 0; i < 17; ++i) a.in[i] = (const float*)d_in[i];
    a.out = (float*)d_out; a.ws = (unsigned char*)d_ws;
#if MK_PER_PHASE
#if MK_STAMP
    hipLaunchKernelGGL(stamp_k, dim3(1), dim3(64), 0, stream, (unsigned*)d_ws + 3000);
#endif
    for (int p = 0; p < NPHASE; ++p) {
        a.ph_lo = p; a.ph_hi = p + 1;
#if MK_DEBUG
#endif
#if !defined(MK_SKIP_MAIN)
        for (int rep_ = 0; rep_ < (p == 1 ? MK_REPEAT : 1); ++rep_) hipLaunchKernelGGL(trunk_fwd, dim3(grid), dim3(NWAVES * 64), LDS_BYTES, stream, a);
#endif
#if MK_STAMP
        hipLaunchKernelGGL(stamp_k, dim3(1), dim3(64), 0, stream, (unsigned*)d_ws + 3000 + p + 1);
#endif
#if MK_DEBUG
        {   unsigned char* ws = (unsigned char*)d_ws; unsigned* dbg = (unsigned*)(ws + WS_CTL) + 2048;
            const size_t MD_ = (size_t)MTOK * D;
#define PROBE(buf, n, isbf, idx, th) if ((idx) <= MK_PROBE_MAX) hipLaunchKernelGGL(dbg_probe, dim3(2048), dim3(256), 0, stream, (const void*)(buf), (size_t)(n), isbf, idx, th, dbg)
            if (p == 0) {
                hipLaunchKernelGGL(dbg_norm_check, dim3(4), dim3(64), 0, stream, (const float*)d_in[0], (const float*)d_in[1], (const unsigned short*)(ws + WS_XN), 4, dbg);
                hipLaunchKernelGGL(dbg_conv_check, dim3(16), dim3(256), 0, stream, (const float*)d_in[3], D, 3 * D, (const unsigned short*)(ws + WS_DQKV), 0, 5, dbg);
                hipLaunchKernelGGL(dbg_conv_check, dim3(16), dim3(256), 0, stream, (const float*)d_in[9], D, DFF, (const unsigned short*)(ws + WS_FGU), 1, 6, dbg);
                hipLaunchKernelGGL(dbg_conv_check, dim3(16), dim3(256), 0, stream, (const float*)d_in[10], D, DFF, (const unsigned short*)(ws + WS_FGU), 2, 7, dbg);
                hipLaunchKernelGGL(dbg_conv_check, dim3(16), dim3(256), 0, stream, (const float*)d_in[11], DFF, D, (const unsigned short*)(ws + WS_FD), 0, 8, dbg);
                hipLaunchKernelGGL(dbg_conv_check, dim3(16), dim3(256), 0, stream, (const float*)d_in[15] + (size_t)3 * DE * D, DE, D, (const unsigned short*)(ws + WS_MD) + (size_t)3 * D * DE, 0, 9, dbg);
            }
            if (p == 1) {
                const float C2h = 0.125f * 1.4426950408889634f;
                hipLaunchKernelGGL(dbg_gemm_check, dim3(16), dim3(256), 0, stream, (const unsigned short*)(ws + WS_XN), D, (const unsigned short*)(ws + WS_DQKV), D, (const unsigned short*)(ws + WS_Q), D, MTOK, D, C2h, 10, dbg);
                hipLaunchKernelGGL(dbg_gemm_check, dim3(16), dim3(256), 0, stream, (const unsigned short*)(ws + WS_XN), D, (const unsigned short*)(ws + WS_DQKV) + (size_t)D * D, D, (const unsigned short*)(ws + WS_K), D, MTOK, D, 1.f, 11, dbg);

                hipLaunchKernelGGL(dbg_gemm_check, dim3(16), dim3(256), 0, stream, (const unsigned short*)(ws + WS_XN), D, (const unsigned short*)(ws + WS_DQKV) + (size_t)2 * D * D, D, (const unsigned short*)(ws + WS_V), D, MTOK, D, 1.f, 12, dbg);
            }
            if (0) { PROBE(ws + WS_XN, MD_, 1, 1, 10.f); PROBE(ws + WS_DQKV, (WS_MGU - WS_DQKV) / 2, 1, 2, 1.f); PROBE(ws + WS_MGU, (WS_XN - WS_MGU) / 2, 1, 3, 1.f); }
            if (p >= 1) { const int L = (p - 1) / PH_PER_LAYER, k = (p - 1) % PH_PER_LAYER; const int b = 20 + 10 * L;
                if (k == 0) PROBE(ws + WS_Q, 3 * MD_, 1, b + 0, 50.f);
                if (k == 1) PROBE(ws + WS_KMEAN, 8 * 16 * 16 * 64, 0, b + 1, 5.f);
                if (k == 2) PROBE(ws + WS_XN, MD_, 1, b + 2, 50.f);
                if (k == 3) PROBE(d_out, MD_, 0, b + 3, 300.f);
                if (k == 4) { PROBE(ws + WS_XN, MD_, 1, b + 4, 20.f); if ((L & 1) && (b + 9) <= MK_PROBE_MAX) hipLaunchKernelGGL(dbg_cnt, dim3(1), dim3(64), 0, stream, (const unsigned*)(ws + WS_CTL) + CW_CNT + 64 * NE * (L >> 1), b + 9, dbg); }
                if (k == 5) PROBE(ws + WS_ACT, (L & 1) ? (size_t)256 * 256 * DE : (size_t)MTOK * DFF, 1, b + 5, 2000.f);
                if (k == 6) { PROBE(d_out, MD_, 0, b + 6, 1000.f); if (L & 1) PROBE(ws + WS_XN, MD_, 1, b + 7, 1000.f); }
                if (k == 7 && L != 3) { PROBE(ws + WS_XN, MD_, 1, b + 8, 20.f); PROBE(d_out, MD_, 0, b + 8, 1000.f); }
            }
#undef PROBE
        }
#endif
    }
#if MK_DEBUG
    hipLaunchKernelGGL(dbg_final, dim3(2048), dim3(256), 0, stream, (float*)d_out, (size_t)MTOK * D, (const unsigned*)((unsigned char*)d_ws + WS_CTL) + 2048);
#endif
#else
    a.ph_lo = 0; a.ph_hi = NPHASE;
    hipLaunchKernelGGL(trunk_fwd, dim3(grid), dim3(NWAVES * 64), LDS_BYTES, stream, a);
#if 0
    hipLaunchKernelGGL(stamp_encode, dim3(2048), dim3(256), 0, stream, (float*)d_out, (size_t)MTOK * D, (const unsigned*)d_ws + 3000, MK_STAMP_PA, MK_STAMP_UA, MK_STAMP_PB, MK_STAMP_UB);
#endif
#endif
#if MK_STAMP
    hipLaunchKernelGGL(stamp_encode, dim3(2048), dim3(256), 0, stream, (float*)d_out, (size_t)MTOK * D, (const unsigned*)d_ws + 3000, MK_STAMP_PA, MK_STAMP_UA, MK_STAMP_PB, MK_STAMP_UB);
#endif
    const hipError_t le = hipPeekAtLastError();
    if (le != hipSuccess) fprintf(stderr, "kernel_launch: launch failed: %s\n", hipGetErrorName(le));
}
```

```cpp
#ifndef MK_DEBUG
#define MK_DEBUG 0
#endif
#ifndef MK_PER_PHASE
#define MK_PER_PHASE 0
#endif
#include <hip/hip_runtime.h>
#include <cstdio>
#include <cstdint>

#ifndef MK_KDEBUG
#define MK_KDEBUG 0
#endif
#define LAS __attribute__((address_space(3)))
#define GAS __attribute__((address_space(1)))

constexpr int BATCH = 8, SEQ = 4096, MTOK = BATCH * SEQ, D = 1024, DFF = 2816, DE = 3584, NE = 8;
constexpr int MOE_TILES_MAX = 272;
constexpr int LIST_CAP = MTOK;

namespace pg8 {
#define PG8_LAS __attribute__((address_space(3)))
typedef unsigned short bf16_t;
typedef short bf16x8 __attribute__((ext_vector_type(8)));
typedef float f32x4 __attribute__((ext_vector_type(4)));
typedef unsigned u32x4 __attribute__((ext_vector_type(4)));
typedef int i32x4 __attribute__((ext_vector_type(4)));
typedef int i32x8 __attribute__((ext_vector_type(8)));
constexpr int BM = 256, BK = 64, HALF = 128, HTB = HALF * BK * 2  , STAGE_BYTES = 8 * HTB, NXCD = 8, WGM = 8;

__host__ __device__ __forceinline__ int lds_byte(int r, int c) { const int st = (r >> 4) * 2 + (c >> 5), rr = r & 15, cc = c & 31, ob = rr * 64 + cc * 2; return st * 1024 + (ob ^ (((ob >> 9) & 1) << 5)); }
__host__ __device__ __forceinline__ void stage_rc(int b, int& R, int& C) { const int st = b / 1024, sb = b % 1024, swz = sb ^ (((sb >> 9) & 1) << 5); R = (st >> 1) * 16 + swz / 64; C = (st & 1) * 32 + (swz % 64) / 2; }
__host__ __device__ __forceinline__ int perm32(int rho) { const int n = rho >> 4, i = rho & 15; return 8 * (i >> 2) + 4 * n + (i & 3); }

struct Unit { int pm, pn, e, r0; };
struct Gemm { const void* A; const void* Bt; int rowb; size_t bstride; };

__device__ __forceinline__ void tile_of(int L, int nM, int nN, int& pm, int& pn, bool rev = false) {
    const int nwg = nM * nN; int wgid = L; { const int q = nwg / NXCD, r = nwg % NXCD, xcd = wgid % NXCD; int off = wgid / NXCD; if (rev) off = (xcd < r ? q : q - 1) - off; wgid = (xcd < r ? xcd * (q + 1) : r * (q + 1) + (xcd - r) * q) + off; }
    const int nig = WGM * nN, gid = wgid / nig, fm = gid * WGM, gsz = (nM - fm) < WGM ? (nM - fm) : WGM;
    pm = fm + ((wgid % nig) % gsz); pn = (wgid % nig) / gsz;
}
struct StaticOrder {
    static constexpr bool EARLY = false;
    int nM, nN, nwg, G, c;
    __device__ __forceinline__ void init(int M, int N, int G_, int c_) { nM = M / BM; nN = N / BM; nwg = nM * nN; G = G_; c = c_; }
    __device__ __forceinline__ bool next(int i, Unit& u) const {
        const long L = (long)i * G + c; if (L >= nwg) return false;
        tile_of((int)L, nM, nN, u.pm, u.pn); u.e = 0; u.r0 = 0; return true;
    }
    __device__ __forceinline__ unsigned arow(const Unit& u, int lr) const { return (unsigned)(u.pm * BM + lr); }
};
struct MoeOrder {
    static constexpr bool EARLY = true;
    int nM, nN, nwg, G, c; int tstart[NE + 1]; int cnt[NE]; const unsigned* list_tok; bool gather;
    __device__ __forceinline__ void init(const unsigned* cntw, const unsigned* list_tok_, bool gather_, int N, int G_, int c_) {
        int acc = 0;
        const int le_ = (int)(__builtin_amdgcn_mbcnt_lo(~0u, 0u)) & 7;
        const int cv_ = (int)__hip_atomic_load((const GAS unsigned*)cntw + 64 * le_, __ATOMIC_RELAXED, __HIP_MEMORY_SCOPE_AGENT);
#pragma unroll
        for (int e = 0; e < NE; ++e) { const int ce = __builtin_amdgcn_readlane(cv_, e); cnt[e] = ce; tstart[e] = acc; acc += (ce + BM - 1) / BM; }
        tstart[NE] = acc; nM = acc; nN = N / BM; nwg = nM * nN; G = G_; c = c_; list_tok = list_tok_; gather = gather_;
    }
    __device__ __forceinline__ bool next(int i, Unit& u) const {
        const long L = (long)i * G + c; if (L >= nwg) return false;
        tile_of((int)L, nM, nN, u.pm, u.pn, !gather); int e = 0;
#pragma unroll
        for (int k = 1; k < NE; ++k) e += (u.pm >= tstart[k]) ? 1 : 0;
        u.e = e; int ts = 0;
#pragma unroll
        for (int k = 0; k < NE; ++k) ts = (k == e) ? tstart[k] : ts;
        u.r0 = (u.pm - ts) * BM; return true;
    }
    __device__ __forceinline__ int count_of(int e) const { int cv = 0;
#pragma unroll
        for (int k = 0; k < NE; ++k) cv = (k == e) ? cnt[k] : cv;
        return cv; }
    __device__ __forceinline__ unsigned arow(const Unit& u, int lr) const {
        if (!gather) return (unsigned)(u.pm * BM + lr);
        const int l = u.r0 + lr; const int cv = count_of(u.e); const int lc = l < cv ? l : (cv > 0 ? cv - 1 : 0);
        return __hip_atomic_load((const GAS unsigned*)list_tok + (size_t)u.e * LIST_CAP + lc, __ATOMIC_RELAXED, __HIP_MEMORY_SCOPE_AGENT) & 0xFFFFFu;
    }
};

__device__ __forceinline__ unsigned cvt_pk_bf16(float lo, float hi) { unsigned r; asm volatile("v_cvt_pk_bf16_f32 %0, %1, %2" : "=v"(r) : "v"(lo), "v"(hi)); return r; }

struct EpiQKV {
    static constexpr bool PERM = true;
    bf16_t* O; int ldc; int split_cols; size_t split_stride; float scale0; float sall;
    float* ksum; unsigned* kmh; bool want_sum; unsigned* qmh;
    __device__ __forceinline__ void operator()(const f32x4 (&acc)[2][2][4][2], const Unit& u, int wr, int wc, int fr, int fq) const {
        const int row0 = u.pm * BM + wr * 64 + fr; int colt = u.pn * BM; bf16_t* base = O;
        float sc = sall; { const int t = colt / split_cols; base += (size_t)t * split_stride; colt -= t * split_cols; if (t == 0) sc = scale0 * sall; }
        const int col0 = colt + wc * 32 + 8 * fq;
#pragma unroll
        for (int ai = 0; ai < 2; ++ai)
#pragma unroll
            for (int m = 0; m < 4; ++m) { bf16_t* rowp = base + (size_t)(row0 + ai * HALF + m * 16) * ldc + col0;
#pragma unroll
                for (int bj = 0; bj < 2; ++bj) { f32x4 v0 = acc[ai][bj][m][0] * sc, v1 = acc[ai][bj][m][1] * sc;
                    u32x4 w; w.x = cvt_pk_bf16(v0[0], v0[1]); w.y = cvt_pk_bf16(v0[2], v0[3]); w.z = cvt_pk_bf16(v1[0], v1[1]); w.w = cvt_pk_bf16(v1[2], v1[3]);
                    *(GAS u32x4*)(rowp + bj * HALF) = w;
                    } }
        if (u.pn * BM / split_cols == 0) {
            const int b_ = u.pm >> 4, g0 = (colt >> 6) + (wc >> 1);
#pragma unroll
            for (int ai = 0; ai < 2; ++ai)
#pragma unroll
                for (int bj = 0; bj < 2; ++bj) { float mxq = 0.f;
#pragma unroll
                    for (int m = 0; m < 4; ++m) { const f32x4 v0 = acc[ai][bj][m][0] * sc, v1 = acc[ai][bj][m][1] * sc;
                        float s = (v0[0] * v0[0] + v0[1] * v0[1]) + (v0[2] * v0[2] + v0[3] * v0[3]) + (v1[0] * v1[0] + v1[1] * v1[1]) + (v1[2] * v1[2] + v1[3] * v1[3]);
                        s += __int_as_float(__builtin_amdgcn_ds_swizzle(__float_as_int(s), 0x401F));
                        { auto rr = __builtin_amdgcn_permlane32_swap(__float_as_uint(s), __float_as_uint(s), false, false); s = __uint_as_float(rr[0]) + __uint_as_float(rr[1]); }
                        mxq = fmaxf(mxq, s); }
                    mxq = fmaxf(mxq, __int_as_float(__builtin_amdgcn_update_dpp(0, __float_as_int(mxq), 0xB1, 0xF, 0xF, true))); mxq = fmaxf(mxq, __int_as_float(__builtin_amdgcn_update_dpp(0, __float_as_int(mxq), 0x4E, 0xF, 0xF, true)));
                    mxq = fmaxf(mxq, __int_as_float(__builtin_amdgcn_update_dpp(0, __float_as_int(mxq), 0x141, 0xF, 0xF, true))); mxq = fmaxf(mxq, __int_as_float(__builtin_amdgcn_update_dpp(0, __float_as_int(mxq), 0x140, 0xF, 0xF, true)));
                    if (fr == 0 && fq == 0) __hip_atomic_fetch_max((GAS unsigned*)qmh + ((size_t)((b_ * 16 + g0 + 2 * bj) * 32 + 2 * (u.pm & 15) + ai)) * 2 + (wc & 1), __float_as_uint(mxq), __ATOMIC_RELAXED, __HIP_MEMORY_SCOPE_AGENT); }
        }
        if (u.pn * BM / split_cols == 1) {
            const int b_ = u.pm >> 4, n_ = u.pm & 15, g0 = (colt >> 6) + (wc >> 1);
            float mx[2] = {0.f, 0.f}; float cs[2][8];
#pragma unroll
            for (int bj = 0; bj < 2; ++bj)
#pragma unroll
                for (int e = 0; e < 8; ++e) cs[bj][e] = 0.f;
#pragma unroll
            for (int ai = 0; ai < 2; ++ai)
#pragma unroll
                for (int m = 0; m < 4; ++m)
#pragma unroll
                    for (int bj = 0; bj < 2; ++bj) { const f32x4 v0 = acc[ai][bj][m][0] * sc, v1 = acc[ai][bj][m][1] * sc;
                        float s = (v0[0] * v0[0] + v0[1] * v0[1]) + (v0[2] * v0[2] + v0[3] * v0[3]) + (v1[0] * v1[0] + v1[1] * v1[1]) + (v1[2] * v1[2] + v1[3] * v1[3]);
                        s += __int_as_float(__builtin_amdgcn_ds_swizzle(__float_as_int(s), 0x401F));
                        { auto rr = __builtin_amdgcn_permlane32_swap(__float_as_uint(s), __float_as_uint(s), false, false); s = __uint_as_float(rr[0]) + __uint_as_float(rr[1]); }
                        mx[bj] = fmaxf(mx[bj], s);
                        cs[bj][0] += v0[0]; cs[bj][1] += v0[1]; cs[bj][2] += v0[2]; cs[bj][3] += v0[3]; cs[bj][4] += v1[0]; cs[bj][5] += v1[1]; cs[bj][6] += v1[2]; cs[bj][7] += v1[3]; }
#define PG8_ROW16(OP, x) do { x = OP(x, __int_as_float(__builtin_amdgcn_update_dpp(0, __float_as_int(x), 0xB1, 0xF, 0xF, true))); x = OP(x, __int_as_float(__builtin_amdgcn_update_dpp(0, __float_as_int(x), 0x4E, 0xF, 0xF, true))); \
            x = OP(x, __int_as_float(__builtin_amdgcn_update_dpp(0, __float_as_int(x), 0x141, 0xF, 0xF, true))); x = OP(x, __int_as_float(__builtin_amdgcn_update_dpp(0, __float_as_int(x), 0x140, 0xF, 0xF, true))); } while (0)
#define PG8_FADD(a_, b_) ((a_) + (b_))
#pragma unroll
            for (int bj = 0; bj < 2; ++bj) { float x = mx[bj]; PG8_ROW16(fmaxf, x);
                if (fr == 0 && fq == 0) __hip_atomic_fetch_max((GAS unsigned*)kmh + ((size_t)((b_ * 16 + g0 + 2 * bj) * 16 + n_)) * 2 + (wc & 1), __float_as_uint(x), __ATOMIC_RELAXED, __HIP_MEMORY_SCOPE_AGENT); }
            if (want_sum) {
#pragma unroll
                for (int bj = 0; bj < 2; ++bj)
#pragma unroll
                    for (int e = 0; e < 8; ++e) { float x = cs[bj][e]; PG8_ROW16(PG8_FADD, x);
                        if (fr == 0) __hip_atomic_fetch_add((GAS float*)ksum + ((size_t)((b_ * 16 + g0 + 2 * bj) * 16 + n_)) * 64 + (wc & 1) * 32 + 8 * fq + e, x, __ATOMIC_RELAXED, __HIP_MEMORY_SCOPE_AGENT); }
            }
#undef PG8_ROW16
#undef PG8_FADD
        }
    }
};
__device__ __forceinline__ unsigned pk4_fp8(float a, float b, float c, float d) { unsigned w = 0; w = __builtin_amdgcn_cvt_pk_fp8_f32(a, b, w, false); w = __builtin_amdgcn_cvt_pk_fp8_f32(c, d, w, true); return w; }
template <bool F8OUT> struct EpiSwiGLU {
    static constexpr bool PERM = true;
    void* O; int ldc; float sc;
    __device__ __forceinline__ void operator()(const f32x4 (&acc)[2][2][4][2], const Unit& u, int wr, int wc, int fr, int fq) const {
        const int row0 = u.pm * BM + wr * 64 + fr; const int col0 = u.pn * HALF + wc * 32 + 8 * fq;
        const float k1 = -1.4426950408889634f * sc, cinv = 1.0f / (sc * sc);
#pragma unroll
        for (int ai = 0; ai < 2; ++ai)
#pragma unroll
            for (int m = 0; m < 4; ++m) { float o[8];
#pragma unroll
                for (int n = 0; n < 2; ++n)
#pragma unroll
                    for (int j = 0; j < 4; ++j) { const float ag = acc[ai][0][m][n][j], au = acc[ai][1][m][n][j];
                        o[n * 4 + j] = (ag * au) * __builtin_amdgcn_rcpf(__builtin_fmaf(__builtin_amdgcn_exp2f(k1 * ag), cinv, cinv)); }
                const size_t eo = (size_t)(row0 + ai * HALF + m * 16) * ldc + col0;
                if constexpr (F8OUT) { const unsigned long long w = (unsigned long long)pk4_fp8(o[0], o[1], o[2], o[3]) | ((unsigned long long)pk4_fp8(o[4], o[5], o[6], o[7]) << 32);
                    *(GAS unsigned long long*)((unsigned char*)O + eo) = w;
                } else { u32x4 w; w.x = cvt_pk_bf16(o[0], o[1]); w.y = cvt_pk_bf16(o[2], o[3]); w.z = cvt_pk_bf16(o[4], o[5]); w.w = cvt_pk_bf16(o[6], o[7]);
                    *(GAS u32x4*)((bf16_t*)O + eo) = w; } }
    }
};
template <bool RF32> struct EpiRes {
    static constexpr bool PERM = true;
    const void* res; bf16_t* out; int ldc; float sc;
    __device__ __forceinline__ void operator()(const f32x4 (&acc)[2][2][4][2], const Unit& u, int wr, int wc, int fr, int fq) const {
        const int row0 = u.pm * BM + wr * 64 + fr; const int col0 = u.pn * BM + wc * 32 + 8 * fq;
#pragma unroll
        for (int ai = 0; ai < 2; ++ai) {
            f32x4 r0[4][2], r1[4][2];
#pragma unroll
            for (int m = 0; m < 4; ++m)
#pragma unroll
                for (int bj = 0; bj < 2; ++bj) { const size_t o2 = (size_t)(row0 + ai * HALF + m * 16) * ldc + col0 + bj * HALF;
                    if constexpr (RF32) { r0[m][bj] = *(const GAS f32x4*)((const float*)res + o2); r1[m][bj] = *(const GAS f32x4*)((const float*)res + o2 + 4); }
                    else { const u32x4 w = *(const GAS u32x4*)((const bf16_t*)res + o2);
                        r0[m][bj] = (f32x4){__uint_as_float(w.x << 16), __uint_as_float(w.x & 0xFFFF0000u), __uint_as_float(w.y << 16), __uint_as_float(w.y & 0xFFFF0000u)};
                        r1[m][bj] = (f32x4){__uint_as_float(w.z << 16), __uint_as_float(w.z & 0xFFFF0000u), __uint_as_float(w.w << 16), __uint_as_float(w.w & 0xFFFF0000u)}; } }
            asm volatile("" ::: "memory");
#pragma unroll
            for (int m = 0; m < 4; ++m)
#pragma unroll
                for (int bj = 0; bj < 2; ++bj) { const size_t o2 = (size_t)(row0 + ai * HALF + m * 16) * ldc + col0 + bj * HALF;
                    const f32x4 v0 = r0[m][bj] + acc[ai][bj][m][0] * sc, v1 = r1[m][bj] + acc[ai][bj][m][1] * sc;
                    u32x4 o; o.x = cvt_pk_bf16(v0[0], v0[1]); o.y = cvt_pk_bf16(v0[2], v0[3]); o.z = cvt_pk_bf16(v1[0], v1[1]); o.w = cvt_pk_bf16(v1[2], v1[3]);
                    *(GAS u32x4*)(out + o2) = o; }
        }
    }
};
struct EpiMoeDown {
    static constexpr bool PERM = true;
    bf16_t* y0; bf16_t* y1; const unsigned* list_tok; const float* list_w; int cnt[NE]; float sc;
    __device__ __forceinline__ void operator()(const f32x4 (&acc)[2][2][4][2], const Unit& u, int wr, int wc, int fr, int fq) const {
        int cv = 0;
#pragma unroll
        for (int k = 0; k < NE; ++k) cv = (k == u.e) ? cnt[k] : cv;
        const int col0 = u.pn * BM + wc * 32 + 8 * fq;
        unsigned ents[2][4]; float ws_[2][4];
        const int lcl = cv > 0 ? cv - 1 : 0;
#pragma unroll
        for (int ai = 0; ai < 2; ++ai)
#pragma unroll
            for (int m = 0; m < 4; ++m) { const int l = u.r0 + ai * HALF + wr * 64 + m * 16 + fr, lc = l < cv ? l : lcl;
                ents[ai][m] = __hip_atomic_load((const GAS unsigned*)list_tok + (size_t)u.e * LIST_CAP + lc, __ATOMIC_RELAXED, __HIP_MEMORY_SCOPE_AGENT);
                ws_[ai][m] = __uint_as_float(__hip_atomic_load((const GAS unsigned*)list_w + (size_t)u.e * LIST_CAP + lc, __ATOMIC_RELAXED, __HIP_MEMORY_SCOPE_AGENT)); }
#pragma unroll
        for (int ai = 0; ai < 2; ++ai)
#pragma unroll
            for (int m = 0; m < 4; ++m) { const int l = u.r0 + ai * HALF + wr * 64 + m * 16 + fr;
                if (l < cv) {
                    const unsigned ent = ents[ai][m]; const float w = sc * ws_[ai][m];
                    const size_t off = (size_t)(ent & 0xFFFFFu) * D + col0;
                    bf16_t* yb = (ent >> 20) == 0u ? y0 : y1;
#pragma unroll
                    for (int bj = 0; bj < 2; ++bj) { const f32x4 v0 = acc[ai][bj][m][0] * w, v1 = acc[ai][bj][m][1] * w;
                        u32x4 o; o.x = cvt_pk_bf16(v0[0], v0[1]); o.y = cvt_pk_bf16(v0[2], v0[3]); o.z = cvt_pk_bf16(v1[0], v1[1]); o.w = cvt_pk_bf16(v1[2], v1[3]); *(GAS u32x4*)(yb + off + bj * HALF) = o; }
                } }
    }
};

template <class Epi, class Sched, bool F8 = false>
__device__ __forceinline__ void gemm_phase(PG8_LAS unsigned char* lds, int xoff, const Gemm g, const Sched& S, const Epi& E) {
    int tid_ = threadIdx.x;
    asm volatile("" : "+v"(tid_));
    const int tid = tid_, wid = __builtin_amdgcn_readfirstlane(tid >> 6), lane = tid & 63, wr = wid >> 2, wc = wid & 3, fr = lane & 15, fq = lane >> 4;
    const int RB = g.rowb, nt = RB / 128;
    unsigned voffB[2];
#pragma unroll
    for (int i = 0; i < 2; ++i) { int R, C; stage_rc(tid * 16 + i * 8192, R, C); const int Rb = Epi::PERM ? ((R & ~31) + perm32(R & 31)) : R;
        voffB[i] = (unsigned)(Rb * RB + C * 2); }
    const size_t kstep = (size_t)(BK * 2);
    const size_t hstep = (size_t)HALF * RB;
    const size_t tstep = 2 * hstep;
    const unsigned ldsw = (unsigned)wid * 1024u;
    const int aoff = F8 ? lds_byte(wr * 64 + fr, fq * 16) : lds_byte(wr * 64 + fr, fq * 8), boff = F8 ? lds_byte(wc * 32 + fr, fq * 16) : lds_byte(wc * 32 + fr, fq * 8);
#define PG8_SA(b, h) (((b) * 2 + (h)) * HTB)
#define PG8_SB(b, h) ((4 + (b) * 2 + (h)) * HTB)
#define PG8_STAGE(bufoff, gbase, v0, v1) do { \
        __builtin_amdgcn_global_load_lds((const GAS unsigned*)((const char*)(gbase) + (v0)), (PG8_LAS unsigned*)(lds + (bufoff) + ldsw), 16, 0, 0); \
        __builtin_amdgcn_global_load_lds((const GAS unsigned*)((const char*)(gbase) + (v1)), (PG8_LAS unsigned*)(lds + (bufoff) + ldsw + 8192), 16, 0, 0); } while (0)
#define PG8_STAGEB(bufoff, gbase) PG8_STAGE(bufoff, gbase, voffB[0], voffB[1])
#define PG8_LDA(dst, b, h) do { if constexpr (F8) { _Pragma("unroll") for (int m = 0; m < 4; ++m) { dst##8[m].lo = *(const PG8_LAS i32x4*)(lds + PG8_SA(b, h) + aoff + m * 2048); dst##8[m].hi = *(const PG8_LAS i32x4*)(lds + PG8_SA(b, h) + aoff + m * 2048 + 16); } } \
        else { _Pragma("unroll") for (int m = 0; m < 4; ++m) _Pragma("unroll") for (int k = 0; k < 2; ++k) dst[m][k] = *(const PG8_LAS bf16x8*)(lds + PG8_SA(b, h) + aoff + m * 2048 + k * 1024); } } while (0)
#define PG8_LDB(dst, b, h) do { if constexpr (F8) { _Pragma("unroll") for (int n = 0; n < 2; ++n) { dst##8[n].lo = *(const PG8_LAS i32x4*)(lds + PG8_SB(b, h) + boff + n * 2048); dst##8[n].hi = *(const PG8_LAS i32x4*)(lds + PG8_SB(b, h) + boff + n * 2048 + 16); } } \
        else { _Pragma("unroll") for (int n = 0; n < 2; ++n) _Pragma("unroll") for (int k = 0; k < 2; ++k) dst[n][k] = *(const PG8_LAS bf16x8*)(lds + PG8_SB(b, h) + boff + n * 2048 + k * 1024); } } while (0)
#define PG8_MMA(ai, bj, At, Bt) do { __builtin_amdgcn_s_setprio(1); _Pragma("unroll") for (int m = 0; m < 4; ++m) _Pragma("unroll") for (int n = 0; n < 2; ++n) { \
        if constexpr (F8) acc[ai][bj][m][n] = __builtin_amdgcn_mfma_scale_f32_16x16x128_f8f6f4(Bt##8[n], At##8[m], acc[ai][bj][m][n], 0, 0, 0, 0x7F7F7F7F, 0, 0x7F7F7F7F); \
        else { _Pragma("unroll") for (int k = 0; k < 2; ++k) acc[ai][bj][m][n] = __builtin_amdgcn_mfma_f32_16x16x32_bf16(Bt[n][k], At[m][k], acc[ai][bj][m][n], 0, 0, 0); } } __builtin_amdgcn_s_setprio(0); } while (0)
#define PG8_WAIT_V(n) asm volatile("s_waitcnt vmcnt(" #n ")" ::: "memory")
#define PG8_WAIT_L(n) asm volatile("s_waitcnt lgkmcnt(" #n ")" ::: "memory")
#define PG8_BAR __builtin_amdgcn_s_barrier()
#define PG8_SCHED __builtin_amdgcn_sched_barrier(0)
#define PG8_AOFFS(U, o00, o01, o10, o11) do { int R0_, C0_, R1_, C1_; stage_rc(tid * 16, R0_, C0_); stage_rc(tid * 16 + 8192, R1_, C1_);     \
        o00 = S.arow(U, R0_) * (unsigned)RB + (unsigned)C0_ * 2u; o01 = S.arow(U, R1_) * (unsigned)RB + (unsigned)C1_ * 2u; \
        o10 = S.arow(U, HALF + R0_) * (unsigned)RB + (unsigned)C0_ * 2u; o11 = S.arow(U, HALF + R1_) * (unsigned)RB + (unsigned)C1_ * 2u; } while (0)
    Unit cur, nxt; int ui = 0;
    if (!S.next(0, cur)) return;
    f32x4 acc[2][2][4][2];
#pragma unroll
    for (int a = 0; a < 2; ++a)
#pragma unroll
        for (int b = 0; b < 2; ++b)
#pragma unroll
            for (int m = 0; m < 4; ++m)
#pragma unroll
                for (int n = 0; n < 2; ++n) acc[a][b][m][n] = (f32x4){0.f, 0.f, 0.f, 0.f};
    bf16x8 At[4][2], B0[2][2], B1[2][2];
    i32x8 At8[4], B08[2], B18[2];
    unsigned c00, c01, c10, c11;
    PG8_LAS u32x4* const xslot = (PG8_LAS u32x4*)(lds + xoff) + tid;
    PG8_AOFFS(cur, c00, c01, c10, c11);
    const char* const gA = (const char*)g.A;
    const char* cB = (const char*)g.Bt + (size_t)cur.e * g.bstride + (size_t)cur.pn * tstep;
    PG8_STAGEB(PG8_SB(0, 0), cB); PG8_STAGEB(PG8_SB(0, 1), cB + hstep); PG8_STAGE(PG8_SA(0, 0), gA, c00, c01); PG8_STAGE(PG8_SA(0, 1), gA, c10, c11);
    if (wr == 1) PG8_BAR;
    PG8_WAIT_V(2); PG8_BAR;
    PG8_STAGEB(PG8_SB(1, 0), cB + kstep); PG8_STAGE(PG8_SA(1, 0), gA + kstep, c00, c01); PG8_STAGEB(PG8_SB(1, 1), cB + hstep + kstep);
    PG8_WAIT_V(6); PG8_BAR;
    bool hn_ = false;
    if constexpr (Sched::EARLY) { hn_ = S.next(1, nxt); if (hn_) { unsigned n00, n01, n10, n11; PG8_AOFFS(nxt, n00, n01, n10, n11); *xslot = (u32x4){n00, n01, n10, n11}; } }
    for (;;) {
        bool has_next; if constexpr (Sched::EARLY) has_next = hn_; else has_next = S.next(ui + 1, nxt);
        const char* nB_ = has_next ? (const char*)g.Bt + (size_t)nxt.e * g.bstride + (size_t)nxt.pn * tstep : cB;
        const char* nB = nB_;
        if constexpr (!Sched::EARLY) { if (has_next) { unsigned n00, n01, n10, n11; PG8_AOFFS(nxt, n00, n01, n10, n11); *xslot = (u32x4){n00, n01, n10, n11}; } }
#pragma unroll 1
        for (int t = 0; t < nt; t += 2) {
            const bool last = (t == nt - 2);
            const char* a1 = gA + (size_t)(t + 1) * kstep;
            const char* a2 = last ? gA : gA + (size_t)(t + 2) * kstep; const char* b2 = last ? nB : cB + (size_t)(t + 2) * kstep;
            const char* a3 = a2 + kstep; const char* b3 = b2 + kstep;
            PG8_LDB(B0, 0, 0); PG8_LDB(B1, 0, 1); PG8_SCHED; PG8_LDA(At, 0, 0); PG8_STAGE(PG8_SA(1, 1), a1, c10, c11);
            if (last && has_next) { const u32x4 nx = *xslot; c00 = nx.x; c01 = nx.y; c10 = nx.z; c11 = nx.w; }
            PG8_WAIT_V(8); PG8_WAIT_L(0); PG8_BAR; PG8_MMA(0, 0, At, B0); PG8_MMA(0, 1, At, B1); PG8_BAR; PG8_SCHED;
            PG8_LDA(At, 0, 1); PG8_STAGEB(PG8_SB(0, 0), b2); PG8_STAGEB(PG8_SB(0, 1), b2 + hstep); PG8_STAGE(PG8_SA(0, 0), a2, c00, c01);
            PG8_WAIT_V(8); PG8_WAIT_L(0); PG8_BAR; PG8_MMA(1, 0, At, B0); PG8_MMA(1, 1, At, B1); PG8_BAR; PG8_SCHED;
            PG8_LDB(B0, 1, 0); PG8_LDB(B1, 1, 1); PG8_SCHED; PG8_LDA(At, 1, 0); PG8_STAGE(PG8_SA(0, 1), a2, c10, c11);
            PG8_WAIT_V(8); PG8_WAIT_L(0); PG8_BAR; PG8_MMA(0, 0, At, B0); PG8_MMA(0, 1, At, B1); PG8_BAR; PG8_SCHED;
            PG8_LDA(At, 1, 1); PG8_STAGEB(PG8_SB(1, 0), b3); PG8_STAGEB(PG8_SB(1, 1), b3 + hstep); PG8_STAGE(PG8_SA(1, 0), a3, c00, c01);
            PG8_WAIT_V(8); PG8_WAIT_L(0); PG8_BAR; PG8_MMA(1, 0, At, B0); PG8_MMA(1, 1, At, B1); PG8_BAR; PG8_SCHED;
        }
        if (wr == 0) PG8_BAR;
        Unit nx2 = nxt; bool has2 = false; unsigned m00 = 0, m01 = 0, m10 = 0, m11 = 0;
        if constexpr (Sched::EARLY) { has2 = has_next && S.next(ui + 2, nx2); PG8_AOFFS(nx2, m00, m01, m10, m11); }
        E(acc, cur, wr, wc, fr, fq);
        if (!has_next) break;
#pragma unroll
        for (int a = 0; a < 2; ++a)
#pragma unroll
            for (int b = 0; b < 2; ++b)
#pragma unroll
                for (int m = 0; m < 4; ++m)
#pragma unroll
                    for (int n = 0; n < 2; ++n) acc[a][b][m][n] = (f32x4){0.f, 0.f, 0.f, 0.f};
        cur = nxt; cB = nB; ++ui;
        if constexpr (Sched::EARLY) { if (has2) *xslot = (u32x4){m00, m01, m10, m11}; nxt = nx2; hn_ = has2; }
        if (wr == 1) PG8_BAR;
    }
    PG8_WAIT_V(0);
    PG8_BAR;
#undef PG8_SA
#undef PG8_SB
#undef PG8_STAGE
#undef PG8_STAGEB
#undef PG8_LDA
#undef PG8_LDB
#undef PG8_MMA
#undef PG8_WAIT_V
#undef PG8_WAIT_L
#undef PG8_BAR
#undef PG8_SCHED
#undef PG8_AOFFS
}
}

namespace att {
typedef unsigned short bf16_t;
typedef short bf16x8 __attribute__((ext_vector_type(8)));
typedef short s16x4 __attribute__((ext_vector_type(4)));
typedef float f32x16 __attribute__((ext_vector_type(16)));
typedef float f32x4 __attribute__((ext_vector_type(4)));
typedef unsigned u32x4 __attribute__((ext_vector_type(4)));
constexpr int PITCH = 1024;
constexpr float LOG2E = 1.4426950408889634f;
__device__ __forceinline__ int crow(int r, int hi) { return (r & 3) + 8 * (r >> 2) + 4 * hi; }
typedef float f32x2_t __attribute__((ext_vector_type(2))); typedef __bf16 bf16x2_t __attribute__((ext_vector_type(2)));
__device__ __forceinline__ unsigned cvtpk(float lo, float hi) { f32x2_t v = {lo, hi}; bf16x2_t b = __builtin_convertvector(v, bf16x2_t); return __builtin_bit_cast(unsigned, b); }
__device__ __forceinline__ float bf2f(short s) { return __uint_as_float(((unsigned)(unsigned short)s) << 16); }
typedef short v4i16_t __attribute__((ext_vector_type(4)));
__device__ __forceinline__ s16x4 vtr(const LAS unsigned char* p) { return __builtin_bit_cast(s16x4, __builtin_amdgcn_ds_read_tr16_b64_v4i16((LAS v4i16_t*)p)); }
__device__ __forceinline__ float max3f(float a, float b, float c) { float r; asm("v_max3_f32 %0, %1, %2, %3" : "=v"(r) : "v"(a), "v"(b), "v"(c)); return r; }
__device__ __forceinline__ float halves_max(float m) { auto rr = __builtin_amdgcn_permlane32_swap(__float_as_uint(m), __float_as_uint(m), false, false); return fmaxf(__uint_as_float(rr[0]), __uint_as_float(rr[1])); }
__device__ __forceinline__ float halves_sum(float m) { auto rr = __builtin_amdgcn_permlane32_swap(__float_as_uint(m), __float_as_uint(m), false, false); return __uint_as_float(rr[0]) + __uint_as_float(rr[1]); }
#define ATT_PRIO(x) do { if (wid >= 4) __builtin_amdgcn_s_setprio(1 + (x)); else __builtin_amdgcn_s_setprio(x); } while (0)
#define ATT_BAR() asm volatile("s_waitcnt vmcnt(0) lgkmcnt(0)\n\ts_barrier" ::: "memory")
typedef unsigned u32x2 __attribute__((ext_vector_type(2)));
#define ATT_RD128(d, a, off) asm volatile("ds_read_b128 %0, %1 offset:%2" : "=v"(d) : "v"(a), "n"(off))
#define ATT_RDTR(d, a, off) asm volatile("ds_read_b64_tr_b16 %0, %1 offset:%2" : "=v"(d) : "v"(a), "n"(off))
#define ATT_WAIT2(n, x, y) asm volatile("s_waitcnt lgkmcnt(" #n ")" : "+v"(x), "+v"(y))

struct Args { const bf16_t* Q; const bf16_t* K; const bf16_t* V; bf16_t* O; const float* kmean; const float* kmax2; const float* qmax2; const float* subln; float lam_full; float out_scale; int abl; };
#ifndef ATT_ABLATE
#define ATT_ABLATE 0
#endif
#if ATT_ABLATE
#define ABL(bit) ((((ATT_ABLATE) >> (bit)) & 1) && abl_)
#else
#define ABL(bit) 0
#endif

template <int MODE>
__device__ __forceinline__ void attn_unit(LAS unsigned char* lds, const Args& A, int b, int h, int qblk) {
    constexpr int DVB = MODE == 0 ? 4 : 2;
    constexpr int NCH = MODE == 0 ? 16 : 8;
    constexpr int KBY = NCH * 1024, VBY = DVB * 4096, SLOT = KBY + VBY;
    constexpr int QR = MODE == 0 ? 128 : 256;
    constexpr int PPW = MODE == 0 ? 2 : 1;
    int tid_ = threadIdx.x; asm volatile("" : "+v"(tid_));
    const int tid = tid_, lane = tid & 63, r32 = lane & 31, hi = lane >> 5;
    const int wid = __builtin_amdgcn_readfirstlane(tid >> 6);
    const int comp = MODE == 0 ? (wid >> 2) : 0, wq = MODE == 0 ? (wid & 3) : wid;
    const int q0 = qblk * QR; const long rowbase = (long)b * SEQ;
    const int hcol = MODE == 0 ? h * 128 : h * 64;
    const int qrel0 = wq * 32;
    const float slope2 = __builtin_amdgcn_exp2f(MODE == 0 ? -(float)(h + 1) : -0.5f * (float)(h + 1)) * LOG2E;
    const int NT = MODE == 0 ? 2 * qblk + 2 : 4 + 4 * qblk;
#define ATT_KBASE_(t) (MODE == 0 ? 64 * (t) : ((t) < 4 ? q0 + 64 * (t) : 64 * ((t) - 4)))
#define ATT_KBASE(t) ATT_KBASE_(t)
    LAS float* wsf = (LAS float*)(lds + 65536) + wid * 64;
    const bf16_t* Kb = A.K + rowbase * PITCH + hcol;
    const bf16_t* Vb = A.V + rowbase * PITCH + hcol;
#define ATT_ISSUE_K(tt, slot) do { const int kb_ = ATT_KBASE(tt); \
        _Pragma("unroll") for (int i_ = 0; i_ < PPW; ++i_) { const int p_ = wid + 8 * i_; \
            __builtin_amdgcn_global_load_lds((const GAS unsigned*)(Kb + (size_t)(kb_ + lane) * PITCH + p_ * 8), (LAS unsigned*)(lds + (slot) * SLOT + p_ * 1024), 16, 0, 0); } } while (0)
#define ATT_ISSUE_V(tt, slot) do { const int kb_ = ATT_KBASE(tt); \
        _Pragma("unroll") for (int i_ = 0; i_ < PPW; ++i_) { const int p_ = wid + 8 * i_; \
            __builtin_amdgcn_global_load_lds((const GAS unsigned*)(Vb + (size_t)(kb_ + 16 * (p_ & 3) + (lane >> 2)) * PITCH + (p_ >> 2) * 32 + (lane & 3) * 8), (LAS unsigned*)(lds + (slot) * SLOT + KBY + p_ * 1024), 16, 0, 0); } } while (0)
    asm volatile("s_waitcnt lgkmcnt(0)\n\ts_barrier" ::: "memory");
    bf16x8 qr[4];
    { const bf16_t* Qw = A.Q + (rowbase + q0 + qrel0 + r32) * PITCH + hcol + comp * 64 + hi * 8;
#pragma unroll
      for (int d0 = 0; d0 < 4; ++d0) qr[d0] = *(const GAS bf16x8*)(Qw + d0 * 16); }
    const int tt_l = MODE == 0 ? (lane < 2 ? 2 * qblk + lane : lane - 2) : lane;
    const int kbase_l = (lane < NT) ? ATT_KBASE_(tt_l) : 0;
    const bool past_l = lane < NT && kbase_l + 64 <= q0;
    float k2a = 0.f, k2b = 0.f;
    { const int nblk = (kbase_l >> 8) & 15;
        if constexpr (MODE == 0) { const f32x2_t ka = ((const GAS f32x2_t*)A.kmax2)[(size_t)(b * 16 + h * 2) * 16 + nblk], kb = ((const GAS f32x2_t*)A.kmax2)[(size_t)(b * 16 + h * 2 + 1) * 16 + nblk]; k2a = ka[0] + ka[1]; k2b = kb[0] + kb[1]; }
        else { const f32x2_t ka = ((const GAS f32x2_t*)A.kmax2)[(size_t)(b * 16 + h) * 16 + nblk]; k2a = ka[0] + ka[1]; } }
    float qsa = 0.f, qsb = 0.f;
    if constexpr (MODE == 0) { const f32x2_t a_ = ((const GAS f32x2_t*)A.qmax2)[(size_t)(b * 16 + h * 2) * 32 + qblk], b2_ = ((const GAS f32x2_t*)A.qmax2)[(size_t)(b * 16 + h * 2 + 1) * 32 + qblk]; qsa = a_[0] + a_[1]; qsb = b2_[0] + b2_[1]; }
    else { const f32x2_t a_ = ((const GAS f32x2_t*)A.qmax2)[(size_t)(b * 16 + h) * 32 + 2 * qblk], b2_ = ((const GAS f32x2_t*)A.qmax2)[(size_t)(b * 16 + h) * 32 + 2 * qblk + 1]; qsa = fmaxf(a_[0] + a_[1], b2_[0] + b2_[1]); }
    float kmv0 = 0.f, kmv1 = 0.f;
    if constexpr (MODE == 1) { kmv0 = ((const GAS float*)A.kmean)[(size_t)(b * 16 + h) * 1024 + tid]; kmv1 = ((const GAS float*)A.kmean)[(size_t)(b * 16 + h) * 1024 + 512 + tid]; }
    const int t0 = MODE == 0 ? 2 * qblk : 0, t1 = t0 + 1;
    ATT_ISSUE_K(t0, 0); ATT_ISSUE_V(t0, 0); ATT_ISSUE_K(t1, 1);
    LAS int* live = (LAS int*)(lds + 71680); LAS float* qnx = (LAS float*)(lds + 71680 + 272);
    LAS float* km = (LAS float*)(lds + 67584);
    if constexpr (MODE == 1) { km[tid] = kmv0; km[tid + 512] = kmv1; }
    if (wid == 0) {
        bool alive = lane < NT;
        if (past_l) { float bound;
            if constexpr (MODE == 0) bound = fmaxf(sqrtf(qsa) * sqrtf(k2a), sqrtf(qsb) * sqrtf(k2b));
            else bound = sqrtf(qsa) * sqrtf(k2a);
            alive = !(bound * 1.001f + 1.0f + slope2 * (float)(kbase_l + 63 - q0) < -152.0f);
        }
        const unsigned long long am = __ballot(alive);
        if (alive) live[__popcll(am & ((1ull << lane) - 1ull))] = tt_l;
        if (lane == 0) live[64] = __popcll(am);
    }
    asm volatile("s_waitcnt vmcnt(0)" ::: "memory");
    ATT_BAR();
    unsigned sel = 0u;
    if constexpr (MODE == 1) {
        float g[16];
#pragma unroll
        for (int n = 0; n < 16; ++n) { float s = 0.f;
            if (n < qblk) {
#pragma unroll
                for (int d0 = 0; d0 < 4; ++d0) { const f32x4 ka = *(const LAS f32x4*)(km + n * 64 + d0 * 16 + hi * 8), kb2 = *(const LAS f32x4*)(km + n * 64 + d0 * 16 + hi * 8 + 4);
                    s += bf2f(qr[d0][0]) * ka[0] + bf2f(qr[d0][1]) * ka[1] + bf2f(qr[d0][2]) * ka[2] + bf2f(qr[d0][3]) * ka[3]
                       + bf2f(qr[d0][4]) * kb2[0] + bf2f(qr[d0][5]) * kb2[1] + bf2f(qr[d0][6]) * kb2[2] + bf2f(qr[d0][7]) * kb2[3]; }
                s = halves_sum(s); }
            g[n] = s; }
        const int nsel = qblk < 3 ? qblk : 3;
#pragma unroll
        for (int k = 0; k < 3; ++k) if (k < nsel) { float best = -INFINITY; int bi = 0; bool found = false;
#pragma unroll
            for (int n = 0; n < 16; ++n) if (n < qblk) { const bool free_ = ((sel >> n) & 1u) == 0u; if (free_ && (!found || g[n] > best)) { best = g[n]; bi = n; found = true; } }
            sel |= 1u << bi; }
    }
    const int NTL = __builtin_amdgcn_readfirstlane(live[64]);
#define ATT_ISSUE(t, slot) do { const int kb_ = ATT_KBASE(t); \
        _Pragma("unroll") for (int i_ = 0; i_ < PPW; ++i_) { const int p_ = wid + 8 * i_; \
            __builtin_amdgcn_global_load_lds((const GAS unsigned*)(Kb + (size_t)(kb_ + lane) * PITCH + p_ * 8), (LAS unsigned*)(lds + (slot) * SLOT + p_ * 1024), 16, 0, 0); \
            __builtin_amdgcn_global_load_lds((const GAS unsigned*)(Vb + (size_t)(kb_ + 16 * (p_ & 3) + (lane >> 2)) * PITCH + (p_ >> 2) * 32 + (lane & 3) * 8), (LAS unsigned*)(lds + (slot) * SLOT + KBY + p_ * 1024), 16, 0, 0); } } while (0)
    constexpr float THR = 8.0f;
    float mref = 0.f, l = 0.f; f32x16 o[DVB];
#pragma unroll
    for (int d0 = 0; d0 < DVB; ++d0) o[d0] = f32x16{};
#define ATT_CLASS(tt, SK, NM, SB) do { const int kb_ = ATT_KBASE(tt), kr_ = kb_ - q0; const bool dg_ = kb_ >= q0; SK = dg_ && (kr_ > qrel0 + 31); NM = dg_ && (kr_ + 63 > qrel0); SB = true; \
        if constexpr (MODE == 1) { if ((tt) >= 4) { SB = ((sel >> (((tt) - 4) >> 2)) & 1u) != 0u; if (!__any(SB)) SK = true; } } } while (0)
#define ATT_QK(P0, P1, tt, slot, SB) do { const int kr_ = ATT_KBASE(tt) - q0; float off0_ = slope2 * (float)(kr_ + 4 * hi) - mref; if (!(SB)) off0_ = -INFINITY; const float off1_ = off0_ + 32.0f * slope2; \
        const unsigned ka_ = (unsigned)(size_t)(lds + (slot) * SLOT + comp * 8192 + hi * 1024 + r32 * 16); u32x4 kx_[4], ky_[4]; \
        ATT_RD128(kx_[0], ka_, 0); ATT_RD128(ky_[0], ka_, 512); ATT_RD128(kx_[1], ka_, 2048); ATT_RD128(ky_[1], ka_, 2560); \
        _Pragma("unroll") for (int r = 0; r < 16; ++r) { const float cbr = slope2 * (float)((r & 3) + 8 * (r >> 2)); P0[r] = cbr + off0_; P1[r] = cbr + off1_; } \
        ATT_PRIO(1); ATT_WAIT2(2, kx_[0], ky_[0]); P0 = __builtin_amdgcn_mfma_f32_32x32x16_bf16(__builtin_bit_cast(bf16x8, kx_[0]), qr[0], P0, 0, 0, 0); P1 = __builtin_amdgcn_mfma_f32_32x32x16_bf16(__builtin_bit_cast(bf16x8, ky_[0]), qr[0], P1, 0, 0, 0); \
        ATT_RD128(kx_[2], ka_, 4096); ATT_RD128(ky_[2], ka_, 4608); \
        ATT_WAIT2(2, kx_[1], ky_[1]); P0 = __builtin_amdgcn_mfma_f32_32x32x16_bf16(__builtin_bit_cast(bf16x8, kx_[1]), qr[1], P0, 0, 0, 0); P1 = __builtin_amdgcn_mfma_f32_32x32x16_bf16(__builtin_bit_cast(bf16x8, ky_[1]), qr[1], P1, 0, 0, 0); \
        ATT_RD128(kx_[3], ka_, 6144); ATT_RD128(ky_[3], ka_, 6656); \
        ATT_WAIT2(2, kx_[2], ky_[2]); P0 = __builtin_amdgcn_mfma_f32_32x32x16_bf16(__builtin_bit_cast(bf16x8, kx_[2]), qr[2], P0, 0, 0, 0); P1 = __builtin_amdgcn_mfma_f32_32x32x16_bf16(__builtin_bit_cast(bf16x8, ky_[2]), qr[2], P1, 0, 0, 0); \
        ATT_WAIT2(0, kx_[3], ky_[3]); P0 = __builtin_amdgcn_mfma_f32_32x32x16_bf16(__builtin_bit_cast(bf16x8, kx_[3]), qr[3], P0, 0, 0, 0); P1 = __builtin_amdgcn_mfma_f32_32x32x16_bf16(__builtin_bit_cast(bf16x8, ky_[3]), qr[3], P1, 0, 0, 0); ATT_PRIO(0); } while (0)
    f32x16 p0, p1, n0, n1;
    const int abl_ = __builtin_amdgcn_readfirstlane(A.abl); (void)abl_;
    int t = t0, tn = t1;
    bool skipC, maskC, selC, skipN = true, maskN = false, selN = true;
    ATT_CLASS(t, skipC, maskC, selC);
    if (!skipC) ATT_QK(p0, p1, t, 0, selC);
    const int NTLX = ABL(4) ? 1 : NTL;
    ATT_PRIO(0);
    for (int it = 0; it < NTLX; ++it) {
        ATT_BAR();
        const int tnn = (it + 2 < NTL) ? __builtin_amdgcn_readfirstlane(live[it + 2]) : 0;
        if (it + 2 < NTL && !ABL(0)) ATT_ISSUE_K(tnn, it & 1);
        if (it + 1 < NTL) { if (!ABL(0)) ATT_ISSUE_V(tn, (it + 1) & 1); ATT_CLASS(tn, skipN, maskN, selN); if (!skipN) { if (!ABL(2)) ATT_QK(n0, n1, tn, (it + 1) & 1, selN); else { n0 = f32x16{} - 1.0f; n1 = n0; } } } else skipN = true;
        if (!skipC) {
            const int krel = ATT_KBASE(t) - q0;
            const unsigned va_ = (unsigned)(size_t)(lds + (it & 1) * SLOT + KBY + ((lane >> 4) & 1) * 32 + (lane & 3) * 8 + (4 * hi + ((lane & 15) >> 2)) * 64);
            u32x2 vl_[4], vh_[4];
            if (!ABL(1)) { ATT_RDTR(vl_[0], va_, 0); ATT_RDTR(vh_[0], va_, 512); ATT_RDTR(vl_[1], va_, 1024); ATT_RDTR(vh_[1], va_, 1536);
            ATT_RDTR(vl_[2], va_, 2048); ATT_RDTR(vh_[2], va_, 2560); ATT_RDTR(vl_[3], va_, 3072); ATT_RDTR(vh_[3], va_, 3584); }
            if (maskC) { const int qrel = qrel0 + r32;
#pragma unroll
                for (int r = 0; r < 16; ++r) { const int kv = krel + crow(r, hi); if (kv > qrel) p0[r] = -INFINITY; if (kv + 32 > qrel) p1[r] = -INFINITY; } }
            float rm;
            { float a_ = max3f(p0[0], p0[1], p1[0]), b_ = max3f(p0[2], p0[3], p1[1]); a_ = max3f(a_, p1[2], p1[3]);
#pragma unroll
              for (int r = 4; r < 16; r += 4) { a_ = max3f(a_, p0[r], p0[r + 1]); b_ = max3f(b_, p0[r + 2], p0[r + 3]); a_ = max3f(a_, p1[r], p1[r + 1]); b_ = max3f(b_, p1[r + 2], p1[r + 3]); }
              rm = halves_max(fmaxf(a_, b_)); }
            if (__any(rm > THR)) {
                const float dl = fmaxf(rm, 0.f); mref += dl; const float alpha = __builtin_amdgcn_exp2f(-dl);
#pragma unroll
                for (int r = 0; r < 16; ++r) { p0[r] -= dl; p1[r] -= dl; }
                if (!skipN) {
#pragma unroll
                    for (int r = 0; r < 16; ++r) { n0[r] -= dl; n1[r] -= dl; } }
                l *= alpha;
#pragma unroll
                for (int d0 = 0; d0 < DVB; ++d0) o[d0] = o[d0] * alpha;
            }
            float sacc = 0.f;
            if (!ABL(3)) {
#pragma unroll
            for (int r = 0; r < 16; ++r) { p0[r] = __builtin_amdgcn_exp2f(p0[r]); p1[r] = __builtin_amdgcn_exp2f(p1[r]); sacc += p0[r] + p1[r]; } }
            l += sacc;
            u32x4 pw[4];
            pw[0] = (u32x4){cvtpk(p0[0], p0[1]), cvtpk(p0[2], p0[3]), cvtpk(p0[4], p0[5]), cvtpk(p0[6], p0[7])};
            pw[1] = (u32x4){cvtpk(p0[8], p0[9]), cvtpk(p0[10], p0[11]), cvtpk(p0[12], p0[13]), cvtpk(p0[14], p0[15])};
            pw[2] = (u32x4){cvtpk(p1[0], p1[1]), cvtpk(p1[2], p1[3]), cvtpk(p1[4], p1[5]), cvtpk(p1[6], p1[7])};
            pw[3] = (u32x4){cvtpk(p1[8], p1[9]), cvtpk(p1[10], p1[11]), cvtpk(p1[12], p1[13]), cvtpk(p1[14], p1[15])};
            if (!ABL(1))
#pragma unroll
            for (int i = 0; i < 4 * DVB; ++i) { constexpr int NM = 4 * DVB; const int s_ = i & 3; if (i == 0) ATT_PRIO(1);
                if (i + 3 < NM) ATT_WAIT2(6, vl_[s_], vh_[s_]); else if (i + 3 == NM) ATT_WAIT2(4, vl_[s_], vh_[s_]); else if (i + 2 == NM) ATT_WAIT2(2, vl_[s_], vh_[s_]); else ATT_WAIT2(0, vl_[s_], vh_[s_]);
                const u32x4 vf = (u32x4){vl_[s_][0], vl_[s_][1], vh_[s_][0], vh_[s_][1]};
                o[i >> 2] = __builtin_amdgcn_mfma_f32_32x32x16_bf16(__builtin_bit_cast(bf16x8, vf), __builtin_bit_cast(bf16x8, pw[i & 3]), o[i >> 2], 0, 0, 0);
                if (i + 4 < NM) { ATT_RDTR(vl_[s_], va_, (i + 4) * 1024); ATT_RDTR(vh_[s_], va_, (i + 4) * 1024 + 512); } if (i == NM - 1) ATT_PRIO(0); }
        }
        p0 = n0; p1 = n1; skipC = skipN; maskC = maskN; selC = selN; t = tn; tn = tnn;
    }
#undef ATT_ISSUE_K
#undef ATT_ISSUE_V
#undef ATT_CLASS
#undef ATT_QK
    __builtin_amdgcn_s_setprio(0);
    if (ABL(5)) return;
    f32x4 sg4[DVB][4];
    if constexpr (MODE == 0) {
#pragma unroll
        for (int d0 = 0; d0 < DVB; ++d0)
#pragma unroll
            for (int g = 0; g < 4; ++g) sg4[d0][g] = *(const GAS f32x4*)(A.subln + d0 * 32 + 8 * g + 4 * hi); }
    l = halves_sum(l);
    const float rl = 1.0f / l;
    GAS bf16_t* Ow = (GAS bf16_t*)(A.O + (rowbase + q0 + qrel0 + r32) * PITCH + hcol) + 8 * hi;
#define ATT_STORE_PAIR(d0, gp, V0, V1, V2, V3, W0, W1, W2, W3) do { \
        const unsigned ax_ = cvtpk(V0, V1), ay_ = cvtpk(V2, V3), bx_ = cvtpk(W0, W1), by_ = cvtpk(W2, W3); \
        auto rx_ = __builtin_amdgcn_permlane32_swap(ax_, bx_, false, false); auto ry_ = __builtin_amdgcn_permlane32_swap(ay_, by_, false, false); \
        *(GAS u32x4*)(Ow + (d0) * 32 + 16 * (gp)) = (u32x4){rx_[0], ry_[0], rx_[1], ry_[1]}; } while (0)
    if constexpr (MODE == 1) {
#pragma unroll
        for (int d0 = 0; d0 < DVB; ++d0)
#pragma unroll
            for (int gp = 0; gp < 2; ++gp) ATT_STORE_PAIR(d0, gp, o[d0][8 * gp + 0] * rl, o[d0][8 * gp + 1] * rl, o[d0][8 * gp + 2] * rl, o[d0][8 * gp + 3] * rl,
                                                                 o[d0][8 * gp + 4] * rl, o[d0][8 * gp + 5] * rl, o[d0][8 * gp + 6] * rl, o[d0][8 * gp + 7] * rl);
    } else {
        ATT_BAR();
        LAS float* X = (LAS float*)lds + wq * 4096;
        if (comp == 1) {
#pragma unroll
            for (int d0 = 0; d0 < DVB; ++d0)
#pragma unroll
                for (int r = 0; r < 16; ++r) X[(d0 * 16 + r) * 64 + lane] = o[d0][r] * rl;
        }
        ATT_BAR();
        if (comp == 0) {
            float ss = 0.f;
#pragma unroll
            for (int d0 = 0; d0 < DVB; ++d0)
#pragma unroll
                for (int r = 0; r < 16; ++r) { o[d0][r] = o[d0][r] * rl - A.lam_full * X[(d0 * 16 + r) * 64 + lane]; ss += o[d0][r] * o[d0][r]; }
            ss = halves_sum(ss);
            const float rs = A.out_scale / sqrtf(ss * (1.0f / 128.0f) + 1e-5f);
#pragma unroll
            for (int d0 = 0; d0 < DVB; ++d0)
#pragma unroll
                for (int gp = 0; gp < 2; ++gp) { const f32x4 ga = sg4[d0][2 * gp], gb = sg4[d0][2 * gp + 1];
                    ATT_STORE_PAIR(d0, gp, o[d0][8 * gp + 0] * rs * ga[0], o[d0][8 * gp + 1] * rs * ga[1], o[d0][8 * gp + 2] * rs * ga[2], o[d0][8 * gp + 3] * rs * ga[3],
                                           o[d0][8 * gp + 4] * rs * gb[0], o[d0][8 * gp + 5] * rs * gb[1], o[d0][8 * gp + 6] * rs * gb[2], o[d0][8 * gp + 7] * rs * gb[3]); }
        }
    }
#undef ATT_STORE_PAIR
#undef ATT_KBASE
#undef ATT_KBASE_
#undef ATT_ISSUE
}
#undef ATT_BAR
}

constexpr int NWAVES = 8;
constexpr int NLAYER = 4, PH_PER_LAYER = 8, NPHASE = 1 + NLAYER * PH_PER_LAYER;

constexpr size_t MiB = 1u << 20;
constexpr size_t WS_CTL = 0, CTL_ZERO_BYTES = 2 * MiB;
constexpr size_t WS_KMEAN = 1 * MiB;
constexpr size_t WS_LTOK = 2 * MiB, WS_LW = 3 * MiB;
constexpr size_t WS_DQKV = 5 * MiB;
constexpr size_t WS_DWO = WS_DQKV + 12 * MiB;
constexpr size_t WS_MQKV = WS_DWO + 4 * MiB;
constexpr size_t WS_MWO = WS_MQKV + 12 * MiB;
constexpr size_t WS_FGU = WS_MWO + 4 * MiB;
constexpr size_t WS_FD = WS_FGU + 22 * MiB;
constexpr size_t WS_MGU = WS_FD + 11 * MiB;
constexpr size_t WS_MD = WS_MGU + 112 * MiB;
constexpr size_t WS_XN = WS_MD + 56 * MiB;
constexpr size_t WS_Q = WS_XN + 64 * MiB, WS_K = WS_Q + 64 * MiB, WS_V = WS_K + 64 * MiB;
constexpr size_t WS_ACT = WS_Q;
constexpr size_t WS_END = WS_ACT + (size_t)MOE_TILES_MAX * 256 * DE * 2;
constexpr size_t WS_Y0 = WS_END - 64 * MiB;
constexpr size_t WS_HB = WS_END;
static_assert(WS_XN == 238 * MiB && WS_END == 778 * MiB, "d_ws map");
constexpr int CW_BAR = 4096;
constexpr int CW_ATTQ = 6144;
constexpr int CW_ATTQ2 = 12288;
constexpr int CW_CNT = 8192;

constexpr int RING_OFF = 0, RING_BYTES = 131072;
constexpr int LDSCTL_OFF = RING_BYTES, MISC_OFF = LDSCTL_OFF + 320;
constexpr int XSLOT_OFF = MISC_OFF + 128;
constexpr int LDS_BYTES = 147456;

typedef unsigned short bf16;
typedef unsigned v4u __attribute__((ext_vector_type(4)));
typedef float f32x4 __attribute__((ext_vector_type(4)));
typedef GAS unsigned gu32;
#define RLX_AGENT __ATOMIC_RELAXED, __HIP_MEMORY_SCOPE_AGENT
#define LDS_WAIT() asm volatile("s_waitcnt lgkmcnt(0)" ::: "memory")
#define VM_WAIT() asm volatile("s_waitcnt vmcnt(0)" ::: "memory")
__device__ __forceinline__ unsigned f2bf(float f) { unsigned u = __builtin_bit_cast(unsigned, f); return (u + 0x7fffu + ((u >> 16) & 1u)) >> 16; }
__device__ __forceinline__ unsigned pk2(float lo, float hi) { return f2bf(lo) | (f2bf(hi) << 16); }
__device__ __forceinline__ float bflo(unsigned w) { return __uint_as_float(w << 16); }
__device__ __forceinline__ float bfhi(unsigned w) { return __uint_as_float(w & 0xFFFF0000u); }
static_assert(XSLOT_OFF % 16 == 0 && XSLOT_OFF + 8192 <= LDS_BYTES, "LDS map");
#define XB_TMO      128
#define XB_XCNT(j)  (256  + 64 * (j))
#define XB_XSUB(j)  (1280 + 64 * (j))
#define XB_XGEN(j)  (2304 + 64 * (j))
#define XB_TOP      3328
#define XB_TOPGEN   3392
#define XCD_BAR_WORDS 3456
#define XB_SPIN_CAP (1u << 18)

__device__ __forceinline__ unsigned xb_ld(unsigned* p)              { return __hip_atomic_load(p, __ATOMIC_RELAXED, __HIP_MEMORY_SCOPE_AGENT); }
__device__ __forceinline__ unsigned xb_add(unsigned* p, unsigned v) { return __hip_atomic_fetch_add(p, v, __ATOMIC_RELAXED, __HIP_MEMORY_SCOPE_AGENT); }
__device__ __forceinline__ unsigned xb_xcc_id() { return (unsigned)__builtin_amdgcn_s_getreg((3 << 11) | 20) & 0xFu; }
#define XB_SPIN(cond, bar) do { unsigned _sp = 0; while (cond) { __builtin_amdgcn_s_sleep(1); \
    if ((++_sp & 255u) == 0u) { if (xb_ld(&(bar)[XB_TMO])) break; if (_sp > XB_SPIN_CAP) { atomicAdd(&(bar)[XB_TMO], 1u); break; } } } } while (0)

struct XcdBarrier {
    unsigned* bar; unsigned x;
    volatile LAS unsigned* st;
};

__device__ __forceinline__ XcdBarrier xcd_barrier_post(unsigned* bar, volatile LAS unsigned* st) {
    XcdBarrier b; b.bar = bar; b.x = xb_xcc_id(); b.st = st;
    if (threadIdx.x == 0) (void)xb_add(&bar[XB_XCNT(b.x)], 1u);
    return b;
}
__device__ __forceinline__ void xcd_barrier_complete(unsigned* bar, unsigned x, unsigned& nloc, unsigned& nx) {
    const unsigned G = gridDim.x * gridDim.y * gridDim.z;
    unsigned sum, cnt, mine, sp = 0u;
    for (;;) {
        sum = 0u; cnt = 0u; mine = 0u;
#pragma unroll
        for (unsigned j = 0; j < 16; ++j) { const unsigned c = xb_ld(&bar[XB_XCNT(j)]); sum += c; cnt += (c > 0u) ? 1u : 0u; mine = (j == x) ? c : mine; }
        if (sum == G) break;
        __builtin_amdgcn_s_sleep(1);
        if ((++sp & 255u) == 0u) { if (xb_ld(&bar[XB_TMO])) break; if (sp > XB_SPIN_CAP) { atomicAdd(&bar[XB_TMO], 1u); break; } }
    }
    nloc = mine > 0u ? mine : 1u; nx = cnt > 0u ? cnt : 1u;
}

__device__ __forceinline__ void xcd_barrier(const XcdBarrier& b) {
    asm volatile("s_waitcnt vmcnt(0)" ::: "memory");
    __syncthreads();
    if (threadIdx.x == 0) {
        unsigned* bar = b.bar;
        __builtin_amdgcn_s_waitcnt(0);
        unsigned nloc = b.st[0], nx = b.st[1];
        if (nloc == 0u) { xcd_barrier_complete(bar, b.x, nloc, nx); b.st[0] = nloc; b.st[1] = nx; }
        const unsigned old = xb_add(&bar[XB_XSUB(b.x)], 1u);
        const unsigned gen = old / nloc;
        if (old + 1u == (gen + 1u) * nloc) {
            __builtin_amdgcn_fence(__ATOMIC_RELEASE, "agent");
            asm volatile("s_waitcnt vmcnt(0)" ::: "memory");
            const unsigned og = xb_add(&bar[XB_TOP], 1u);
            const unsigned tg = og / nx;
            if (og + 1u == (tg + 1u) * nx) xb_add(&bar[XB_TOPGEN], 1u);
            else XB_SPIN(xb_ld(&bar[XB_TOPGEN]) == tg, bar);
            __builtin_amdgcn_fence(__ATOMIC_ACQUIRE, "agent");
            xb_add(&bar[XB_XGEN(b.x)], 1u);
            asm volatile("s_waitcnt vmcnt(0)" ::: "memory");
        } else {
            XB_SPIN(xb_ld(&bar[XB_XGEN(b.x)]) == gen, bar);
            __builtin_amdgcn_fence(__ATOMIC_ACQUIRE, "agent");
            asm volatile("s_waitcnt vmcnt(0)" ::: "memory");
        }
    }
    __syncthreads();
}

struct Frame {
    LAS unsigned char* lds;
    volatile LAS unsigned* MISC;
    gu32* ctl;
    int tid, lane, wave;
    int vcu, G;
};
__device__ __forceinline__ float wave_sum(float v) {
    v += __int_as_float(__builtin_amdgcn_update_dpp(0, __float_as_int(v), 0xB1, 0xF, 0xF, true));
    v += __int_as_float(__builtin_amdgcn_update_dpp(0, __float_as_int(v), 0x4E, 0xF, 0xF, true));
    v += __int_as_float(__builtin_amdgcn_update_dpp(0, __float_as_int(v), 0x141, 0xF, 0xF, true));
    v += __int_as_float(__builtin_amdgcn_update_dpp(0, __float_as_int(v), 0x140, 0xF, 0xF, true));
    v += __int_as_float(__builtin_amdgcn_ds_swizzle(__float_as_int(v), 0x401F));
    auto rr = __builtin_amdgcn_permlane32_swap(__float_as_uint(v), __float_as_uint(v), false, false);
    return __uint_as_float(rr[0]) + __uint_as_float(rr[1]);
}
__device__ __forceinline__ void transpose_item(const float* W, int K, int N, void* WT, int k0, int n0, int drow0, LAS float* scr, int lane, bool f8, float wscale) {
    (void)scr;
    const int kq = lane & 7, ns = lane >> 3;
    const GAS f32x4* src = (const GAS f32x4*)((const GAS float*)W + (size_t)(k0 + 8 * kq) * N + n0) + ns;
    f32x4 v[2][8];
#pragma unroll
    for (int i = 0; i < 8; ++i)
#pragma unroll
        for (int m = 0; m < 2; ++m) v[m][i] = src[(size_t)i * (N >> 2) + 8 * m];
#pragma unroll
    for (int m = 0; m < 2; ++m)
#pragma unroll
        for (int j = 0; j < 4; ++j) { const int n = 32 * m + 4 * ns + j;
            if (f8) {
                const unsigned lo = pg8::pk4_fp8(v[m][0][j] * wscale, v[m][1][j] * wscale, v[m][2][j] * wscale, v[m][3][j] * wscale), hi = pg8::pk4_fp8(v[m][4][j] * wscale, v[m][5][j] * wscale, v[m][6][j] * wscale, v[m][7][j] * wscale);
                *(GAS unsigned long long*)((unsigned char*)WT + (size_t)(drow0 + n) * K + k0 + 8 * kq) = (unsigned long long)lo | ((unsigned long long)hi << 32);
            } else {
                v4u o; o.x = pk2(v[m][0][j], v[m][1][j]); o.y = pk2(v[m][2][j], v[m][3][j]); o.z = pk2(v[m][4][j], v[m][5][j]); o.w = pk2(v[m][6][j], v[m][7][j]);
                *(GAS v4u*)((bf16*)WT + (size_t)(drow0 + n) * K + k0 + 8 * kq) = o; }
        }
}
__device__ __forceinline__ void convert_matrix(Frame& F, const float* W, int K, int N, void* WT, int il, unsigned& rot, bool f8 = false, float wscale = 1.0f) {
    LAS float* scr = (LAS float*)(F.lds + RING_OFF + F.wave * 16384);
    const unsigned gw = (unsigned)(F.vcu * NWAVES + F.wave), NGW = (unsigned)(F.G * NWAVES);
    const int nblk = N / 64, nitems = (K / 64) * nblk; int lane_ = F.lane; asm volatile("" : "+v"(lane_));
    for (int it = (int)((gw + NGW - rot % NGW) % NGW); it < nitems; it += (int)NGW) {
        const int kb = it / nblk, nb = it % nblk, n0 = 64 * nb;
        const int drow0 = il == 0 ? n0 : (n0 / 128) * 256 + (il - 1) * 128 + (n0 % 128);
        transpose_item(W, K, N, WT, 64 * kb, n0, drow0, scr, lane_, f8, wscale);
    }
    rot = (rot + (unsigned)nitems) % NGW;
}

struct RouterArgs { const float* router; gu32* cnt; unsigned* ltok; float* lw; };
template <int MODE, bool F8X = false, bool SF32 = false>
__device__ __forceinline__ void norm_phase(Frame& F, const void* src, bf16* hout, const bf16* y1, const float* gain, bf16* xn, float* fout, const RouterArgs& R, const bf16* y0 = nullptr) {
    int lane_ = F.lane; asm volatile("" : "+v"(lane_));
    const int gw = F.vcu * NWAVES + F.wave, NGW = F.G * NWAVES, lane = lane_;
    f32x4 gv[4];
#pragma unroll
    for (int j = 0; j < 4; ++j) gv[j] = *(const GAS f32x4*)(gain + 256 * j + 4 * lane);
    LAS float* RL = (LAS float*)(F.lds + RING_OFF);
    if constexpr (MODE == 2) {
        int tid_ = F.tid; asm volatile("" : "+v"(tid_));
        for (int i = tid_; i < 8192; i += NWAVES * 64) RL[(i & 7) * 1024 + (i >> 3)] = ((const GAS float*)R.router)[i];
        LDS_WAIT(); __syncthreads();
    }
    const int nrows_w = gw < MTOK ? (MTOK - gw + NGW - 1) / NGW : 0;
    for (int cb = 0; cb < nrows_w; cb += 64) {
        int my_t = 0, my_e0 = 0, my_e1 = 0; float my_w0 = 0.f, my_w1 = 0.f; bool valid = false;
        const int cn = (nrows_w - cb) < 64 ? (nrows_w - cb) : 64;
        f32x4 vn[4]; unsigned long long yn[4], zn[4];
        unsigned long long hn[4];
        { const int row0_ = gw + cb * NGW;
          if constexpr (SF32) { const GAS f32x4* xr = (const GAS f32x4*)((const float*)src + (size_t)row0_ * D) + lane;
#pragma unroll
            for (int j = 0; j < 4; ++j) vn[j] = xr[64 * j];
          } else { const GAS unsigned long long* hr_ = (const GAS unsigned long long*)((const bf16*)src + (size_t)row0_ * D) + lane;
#pragma unroll
            for (int j = 0; j < 4; ++j) hn[j] = hr_[64 * j]; }
          if constexpr (MODE == 1 || MODE == 3) { const GAS unsigned long long* yr = (const GAS unsigned long long*)(y1 + (size_t)row0_ * D) + lane, *zr = (const GAS unsigned long long*)(y0 + (size_t)row0_ * D) + lane;
#pragma unroll
            for (int j = 0; j < 4; ++j) { yn[j] = yr[64 * j]; zn[j] = zr[64 * j]; } } }
        for (int i = 0; i < cn; ++i) {
            const int row = gw + (cb + i) * NGW;
            f32x4 v[4]; float s = 0.f;
#pragma unroll
            for (int j = 0; j < 4; ++j) { if constexpr (SF32) v[j] = vn[j]; else { const unsigned long long w = hn[j]; const unsigned lo = (unsigned)w, hi = (unsigned)(w >> 32); v[j] = (f32x4){bflo(lo), bfhi(lo), bflo(hi), bfhi(hi)}; } }
            if constexpr (MODE == 1 || MODE == 3) {
#pragma unroll
                for (int j = 0; j < 4; ++j) { const unsigned long long w = yn[j], z = zn[j]; const unsigned lo = (unsigned)w, hi = (unsigned)(w >> 32), zl = (unsigned)z, zh = (unsigned)(z >> 32);
                    v[j].x += bflo(zl) + bflo(lo); v[j].y += bfhi(zl) + bfhi(lo); v[j].z += bflo(zh) + bflo(hi); v[j].w += bfhi(zh) + bfhi(hi); }
            }
            if (i + 1 < cn) { const int rown = row + NGW;
                if constexpr (SF32) { const GAS f32x4* xr = (const GAS f32x4*)((const float*)src + (size_t)rown * D) + lane;
#pragma unroll
                    for (int j = 0; j < 4; ++j) vn[j] = xr[64 * j];
                } else { const GAS unsigned long long* hr_ = (const GAS unsigned long long*)((const bf16*)src + (size_t)rown * D) + lane;
#pragma unroll
                    for (int j = 0; j < 4; ++j) hn[j] = hr_[64 * j]; }
                if constexpr (MODE == 1 || MODE == 3) { const GAS unsigned long long* yr = (const GAS unsigned long long*)(y1 + (size_t)rown * D) + lane, *zr = (const GAS unsigned long long*)(y0 + (size_t)rown * D) + lane;
#pragma unroll
                    for (int j = 0; j < 4; ++j) { yn[j] = yr[64 * j]; zn[j] = zr[64 * j]; } } }
#pragma unroll
            for (int j = 0; j < 4; ++j) s += (v[j].x * v[j].x + v[j].y * v[j].y) + (v[j].z * v[j].z + v[j].w * v[j].w);
            if constexpr (MODE == 1) { GAS unsigned long long* hr = (GAS unsigned long long*)(hout + (size_t)row * D) + lane;
#pragma unroll
                for (int j = 0; j < 4; ++j) { const unsigned long long hw = (unsigned long long)pk2(v[j].x, v[j].y) | ((unsigned long long)pk2(v[j].z, v[j].w) << 32); hr[64 * j] = hw;
                    v[j] = (f32x4){bflo((unsigned)hw), bfhi((unsigned)hw), bflo((unsigned)(hw >> 32)), bfhi((unsigned)(hw >> 32))}; } }
            const float rstd = 1.f / sqrtf(wave_sum(s) * (1.f / D) + 1e-6f);
#pragma unroll
            for (int j = 0; j < 4; ++j) v[j] = v[j] * rstd * gv[j];
            if constexpr (MODE == 3) { GAS f32x4* orow = (GAS f32x4*)(fout + (size_t)row * D) + lane;
#pragma unroll
                for (int j = 0; j < 4; ++j) orow[64 * j] = v[j];
            } else {
                if constexpr (F8X) { GAS unsigned* o4 = (GAS unsigned*)((unsigned char*)xn + (size_t)row * D) + lane;
#pragma unroll
                    for (int j = 0; j < 4; ++j) o4[64 * j] = pg8::pk4_fp8(v[j].x, v[j].y, v[j].z, v[j].w);
                } else { GAS unsigned long long* o8 = (GAS unsigned long long*)(xn + (size_t)row * D) + lane;
#pragma unroll
                    for (int j = 0; j < 4; ++j) o8[64 * j] = (unsigned long long)pk2(v[j].x, v[j].y) | ((unsigned long long)pk2(v[j].z, v[j].w) << 32); }
            }
            if constexpr (MODE == 2) {
                float lg[NE];
#pragma unroll
                for (int e = 0; e < NE; ++e) { float a = 0.f;
#pragma unroll
                    for (int j = 0; j < 4; ++j) { const f32x4 rr = *(const LAS f32x4*)(RL + e * 1024 + 256 * j + 4 * lane); a += (v[j].x * rr.x + v[j].y * rr.y) + (v[j].z * rr.z + v[j].w * rr.w); }
                    lg[e] = wave_sum(a); }
                int e0 = 0; float v0 = lg[0];
#pragma unroll
                for (int e = 1; e < NE; ++e) if (lg[e] > v0) { v0 = lg[e]; e0 = e; }
                int e1 = -1; float v1 = 0.f;
#pragma unroll
                for (int e = 0; e < NE; ++e) if (e != e0 && (e1 < 0 || lg[e] > v1)) { v1 = lg[e]; e1 = e; }
                const float w0 = 1.f / (1.f + __expf(v1 - v0));
                if (lane == i) { my_t = row; my_e0 = e0; my_e1 = e1; my_w0 = w0; my_w1 = 1.f - w0; valid = true; }
            }
        }
        if constexpr (MODE == 2) {
            unsigned myc = 0u;
#pragma unroll
            for (int e = 0; e < NE; ++e) { const unsigned long long b0 = __ballot(valid && my_e0 == e), b1 = __ballot(valid && my_e1 == e);
                const unsigned c = (unsigned)(__popcll(b0) + __popcll(b1)); if (lane == e) myc = c; }
            unsigned basev = 0u;
            if (lane < NE) basev = __hip_atomic_fetch_add(R.cnt + 64 * lane, myc, RLX_AGENT);
            const unsigned long long lt = (1ull << lane) - 1ull;
            unsigned pos0 = 0u, pos1 = 0u;
#pragma unroll
            for (int e = 0; e < NE; ++e) { const unsigned long long b0 = __ballot(valid && my_e0 == e), b1 = __ballot(valid && my_e1 == e);
                const unsigned be = (unsigned)__shfl((int)basev, e);
                if (my_e0 == e) pos0 = be + (unsigned)__popcll(b0 & lt);
                if (my_e1 == e) pos1 = be + (unsigned)__popcll(b0) + (unsigned)__popcll(b1 & lt); }
            if (valid) {
                ((GAS unsigned*)R.ltok)[(size_t)my_e0 * LIST_CAP + pos0] = (unsigned)my_t;             ((GAS float*)R.lw)[(size_t)my_e0 * LIST_CAP + pos0] = my_w0;
                ((GAS unsigned*)R.ltok)[(size_t)my_e1 * LIST_CAP + pos1] = (unsigned)my_t | (1u << 20); ((GAS float*)R.lw)[(size_t)my_e1 * LIST_CAP + pos1] = my_w1;
            }
        }
    }
    if constexpr (MODE == 2) { LDS_WAIT(); __syncthreads(); }
}

__device__ __forceinline__ void kstat_phase(Frame& F, const bf16* Kt, float* kmean, float* kmax2) {
    int lane_ = F.lane; asm volatile("" : "+v"(lane_));
    const int gw = F.vcu * NWAVES + F.wave, NGW = F.G * NWAVES, lane = lane_;
    for (int task = gw; task < BATCH * 16 * 16; task += NGW) {
        const int hh = task & 15, n = (task >> 4) & 15, b = task >> 8, l5 = lane & 31, hf = lane >> 5;
        const GAS unsigned* p = (const GAS unsigned*)(Kt + ((size_t)b * SEQ + 256 * n + 128 * hf) * D + hh * 64) + l5;
        float a0 = 0.f, a1 = 0.f, mx = 0.f;
#pragma unroll 32
        for (int r = 0; r < 128; ++r) { const unsigned w = p[(size_t)r * (D / 2)]; const float v0 = bflo(w), v1 = bfhi(w); a0 += v0; a1 += v1;
            float s = v0 * v0 + v1 * v1;
            s += __int_as_float(__builtin_amdgcn_update_dpp(0, __float_as_int(s), 0xB1, 0xF, 0xF, true)); s += __int_as_float(__builtin_amdgcn_update_dpp(0, __float_as_int(s), 0x4E, 0xF, 0xF, true));
            s += __int_as_float(__builtin_amdgcn_update_dpp(0, __float_as_int(s), 0x141, 0xF, 0xF, true)); s += __int_as_float(__builtin_amdgcn_update_dpp(0, __float_as_int(s), 0x140, 0xF, 0xF, true));
            s += __int_as_float(__builtin_amdgcn_ds_swizzle(__float_as_int(s), 0x401F)); mx = fmaxf(mx, s); }
        { auto r0 = __builtin_amdgcn_permlane32_swap(__float_as_uint(a0), __float_as_uint(a0), false, false); a0 = __uint_as_float(r0[0]) + __uint_as_float(r0[1]);
          auto r1 = __builtin_amdgcn_permlane32_swap(__float_as_uint(a1), __float_as_uint(a1), false, false); a1 = __uint_as_float(r1[0]) + __uint_as_float(r1[1]);
          auto r2 = __builtin_amdgcn_permlane32_swap(__float_as_uint(mx), __float_as_uint(mx), false, false); mx = fmaxf(__uint_as_float(r2[0]), __uint_as_float(r2[1])); }
        if (hf == 0) { GAS float* o = (GAS float*)(kmean + ((size_t)(b * 16 + hh) * 16 + n) * 64 + 2 * l5);
            o[0] = a0 * (1.f / 256.f); o[1] = a1 * (1.f / 256.f); }
        if (lane == 0) ((GAS float*)kmax2)[(size_t)(b * 16 + hh) * 16 + n] = mx;
    }
}

struct KArgs { const float* in[17]; float* out; unsigned char* ws; int ph_lo, ph_hi; };
struct ConvDesc { const float* W; int K, N; unsigned char* WT; int il; bool f8; float sc; };
constexpr int NCONV = 61, CONV_CH = 128;
__device__ __forceinline__ ConvDesc conv_desc(const KArgs& args, unsigned char* ws, int m) {
    constexpr float WSC_UP = 32.0f, WSC_DN = 64.0f;
    ConvDesc d; d.il = 0; d.f8 = false; d.sc = 1.0f;
    if (m < 2) { d.W = args.in[7] + (size_t)m * D * 3 * D; d.K = D; d.N = 3 * D; d.WT = ws + WS_MQKV + (size_t)m * 3 * D * D * 2; if (m == 1) { d.f8 = true; d.sc = WSC_UP; } }
    else if (m < 4) { const int j = m - 2; d.W = args.in[8] + (size_t)j * D * D; d.K = D; d.N = D; d.WT = ws + WS_MWO + (size_t)j * D * D * 2; }
    else if (m == 4) { d.W = args.in[4]; d.K = D; d.N = D; d.WT = ws + WS_DWO; }
    else if (m == 5) { d.W = args.in[3] + (size_t)D * 3 * D; d.K = D; d.N = 3 * D; d.WT = ws + WS_DQKV + (size_t)3 * D * D * 2; }
    else if (m == 6) { d.W = args.in[4] + (size_t)D * D; d.K = D; d.N = D; d.WT = ws + WS_DWO + (size_t)D * D * 2; }
    else if (m < 13) { const int r = m - 7, j = r / 3, t = r % 3; d.f8 = true;
        if (t < 2) { d.W = args.in[9 + t] + (size_t)j * D * DFF; d.K = D; d.N = DFF; d.WT = ws + WS_FGU + (size_t)j * 2 * DFF * D * 2; d.il = 1 + t; d.sc = d.f8 ? WSC_UP : 1.0f; }
        else { d.W = args.in[11] + (size_t)j * DFF * D; d.K = DFF; d.N = D; d.WT = ws + WS_FD + (size_t)j * D * DFF * 2; d.sc = d.f8 ? WSC_DN : 1.0f; } }
    else { const int r = m - 13, e = r / 3, t = r % 3; d.f8 = true;
        if (t < 2) { d.W = args.in[13 + t] + (size_t)e * D * DE; d.K = D; d.N = DE; d.WT = ws + WS_MGU + (size_t)e * 2 * DE * D; d.il = 1 + t; d.sc = WSC_UP; }
        else { d.W = args.in[15] + (size_t)e * DE * D; d.K = DE; d.N = D; d.WT = ws + WS_MD + (size_t)e * D * DE; d.sc = WSC_DN; } }
    return d;
}
__device__ __forceinline__ int conv_chunks_of(int m) { const int items = m < 2 || m == 5 ? 768 : (m < 7 ? 256 : (m < 13 ? 704 : 896)); return (items + CONV_CH - 1) / CONV_CH; }
__device__ __forceinline__ int conv_total_chunks() { int s = 0; for (int m = 0; m < NCONV; ++m) s += conv_chunks_of(m); return s; }
__device__ __forceinline__ void conv_chunk(Frame& F, const KArgs& args, unsigned char* ws, int c) {
    int m = 0; for (; m < NCONV; ++m) { const int n = conv_chunks_of(m); if (c < n) break; c -= n; }
    const ConvDesc d = conv_desc(args, ws, m);
    LAS float* scr = (LAS float*)(F.lds + RING_OFF + F.wave * 16384);
    int lane_ = F.lane; asm volatile("" : "+v"(lane_));
    const int nblk = d.N / 64, nitems = (d.K / 64) * nblk, last = (c + 1) * CONV_CH < nitems ? (c + 1) * CONV_CH : nitems;
    (void)scr;
    const int kq = lane_ & 7, ns = lane_ >> 3;
    const int first = c * CONV_CH + F.wave, nit = first < last ? (last - first + NWAVES - 1) / NWAVES : 0;
#define CONV_LOAD(v, i_) do { const int it_ = first + NWAVES * (i_), kb_ = it_ / nblk, nb_ = it_ % nblk; \
        const GAS f32x4* src_ = (const GAS f32x4*)((const GAS float*)d.W + (size_t)(64 * kb_ + 8 * kq) * d.N + 64 * nb_) + ns; \
        _Pragma("unroll") for (int i = 0; i < 8; ++i) { asm volatile("global_load_dwordx4 %0, %1, off nt" : "=v"(v[0][i]) : "v"(src_ + (size_t)i * (d.N >> 2))); \
                                                       asm volatile("global_load_dwordx4 %0, %1, off nt" : "=v"(v[1][i]) : "v"(src_ + (size_t)i * (d.N >> 2) + 8)); } } while (0)
#define CONV_WAIT(N, v) asm volatile("s_waitcnt vmcnt(" #N ")" : "+v"(v[0][0]), "+v"(v[0][1]), "+v"(v[0][2]), "+v"(v[0][3]), "+v"(v[0][4]), "+v"(v[0][5]), "+v"(v[0][6]), "+v"(v[0][7]), \
                                                                  "+v"(v[1][0]), "+v"(v[1][1]), "+v"(v[1][2]), "+v"(v[1][3]), "+v"(v[1][4]), "+v"(v[1][5]), "+v"(v[1][6]), "+v"(v[1][7]))
#define CONV_STORE(F8, v, i_) do { const int it_ = first + NWAVES * (i_), kb_ = it_ / nblk, nb_ = it_ % nblk, n0_ = 64 * nb_, k0_ = 64 * kb_; const int drow0_ = d.il == 0 ? n0_ : (n0_ / 128) * 256 + (d.il - 1) * 128 + (n0_ % 128); \
        _Pragma("unroll") for (int m = 0; m < 2; ++m) _Pragma("unroll") for (int j = 0; j < 4; ++j) { const int n = 32 * m + 4 * ns + j; \
            if (F8) { const float ws_ = d.sc; \
                const unsigned lo = pg8::pk4_fp8(v[m][0][j] * ws_, v[m][1][j] * ws_, v[m][2][j] * ws_, v[m][3][j] * ws_), hi = pg8::pk4_fp8(v[m][4][j] * ws_, v[m][5][j] * ws_, v[m][6][j] * ws_, v[m][7][j] * ws_); \
                __builtin_nontemporal_store((unsigned long long)lo | ((unsigned long long)hi << 32), (GAS unsigned long long*)((unsigned char*)d.WT + (size_t)(drow0_ + n) * d.K + k0_ + 8 * kq)); \
            } else { v4u o; o.x = pk2(v[m][0][j], v[m][1][j]); o.y = pk2(v[m][2][j], v[m][3][j]); o.z = pk2(v[m][4][j], v[m][5][j]); o.w = pk2(v[m][6][j], v[m][7][j]); \
                __builtin_nontemporal_store(o, (GAS v4u*)((bf16*)d.WT + (size_t)(drow0_ + n) * d.K + k0_ + 8 * kq)); } } } while (0)
#define CONV_RUN(F8) do { f32x4 va[2][8], vb[2][8]; int i = 0; \
        if (nit > 0) { CONV_LOAD(va, 0); \
            if (nit > 2) { CONV_LOAD(vb, 1); CONV_WAIT(16, va); CONV_STORE(F8, va, 0); CONV_LOAD(va, 2); CONV_WAIT(24, vb); CONV_STORE(F8, vb, 1); i = 2; \
                for (; i + 2 < nit; i += 2) { CONV_LOAD(vb, i + 1); CONV_WAIT(24, va); CONV_STORE(F8, va, i); CONV_LOAD(va, i + 2); CONV_WAIT(24, vb); CONV_STORE(F8, vb, i + 1); } } \
            if (i + 1 < nit) { CONV_LOAD(vb, i + 1); CONV_WAIT(16, va); CONV_STORE(F8, va, i); CONV_WAIT(0, vb); CONV_STORE(F8, vb, i + 1); } else { CONV_WAIT(0, va); CONV_STORE(F8, va, i); } } } while (0)
    if (d.f8) CONV_RUN(true); else CONV_RUN(false);
#undef CONV_RUN
#undef CONV_LOAD
#undef CONV_WAIT
#undef CONV_STORE
}

__global__ void __launch_bounds__(NWAVES * 64, 2) trunk_fwd(KArgs args) {
    extern __shared__ __attribute__((aligned(16))) unsigned char lds[];
    Frame F;
    F.lds = (LAS unsigned char*)lds;
    F.MISC = (volatile LAS unsigned*)(F.lds + MISC_OFF);
    F.tid = threadIdx.x; F.lane = F.tid & 63; F.wave = __builtin_amdgcn_readfirstlane(F.tid >> 6);
    F.G = gridDim.x; { const int bx = blockIdx.x; F.vcu = (F.G % 8 == 0) ? (bx % 8) * (F.G / 8) + bx / 8 : bx; }
    F.ctl = (gu32*)(args.ws + WS_CTL);
    for (int u = F.tid; u < (LDS_BYTES - LDSCTL_OFF) / 4; u += NWAVES * 64) ((LAS unsigned*)(F.lds + LDSCTL_OFF))[u] = 0u;
    __syncthreads();
    Frame& F0 = F;
    const int lo = args.ph_lo, hi = args.ph_hi;
    XcdBarrier bar; bar.bar = (unsigned*)(F.ctl + CW_BAR); bar.x = 0; bar.st = nullptr;
    if (hi - lo > 1) bar = xcd_barrier_post((unsigned*)(F.ctl + CW_BAR), F.MISC + 8);
#define IN(k) (lo <= (k) && (k) < hi)
#ifndef PH_ENABLE
#define PH_ENABLE 0xFFFFFFFFu
#endif
#define PHEN(n) (((PH_ENABLE) >> (n)) & 1u)
#ifndef MK_DOUBLE
#define MK_DOUBLE 0u
#endif
#define NREP(n) ((((MK_DOUBLE) >> (n)) & 1u) ? 2 : 1)
#if defined(NO_OPQ)
#define OPQ(p) do {} while (0)
#else
#define OPQ(p) asm volatile("" : "+s"(p))
#endif
#if 0
#define STAMP(k) do { if (blockIdx.x == 0 && threadIdx.x == 0) { const unsigned long long t_ = __builtin_amdgcn_s_memrealtime(); ((GAS unsigned*)(F0.ctl))[3000 + (k)] = (unsigned)t_; } } while (0)
#else
#define STAMP(k) do {} while (0)
#endif
#define SEAM(k) do { if (IN(k) && IN((k) + 1)) { XcdBarrier b2_ = bar; OPQ(b2_.bar); xcd_barrier(b2_); } STAMP((k) + 1); } while (0)

#define PTRS() unsigned char* ws = args.ws; OPQ(ws); const float* x = args.in[0]; OPQ(x); const float* norm_mix = args.in[1]; OPQ(norm_mix); const float* norm_ffn = args.in[2]; OPQ(norm_ffn); \
    bf16* h = (bf16*)(ws + WS_HB); \
    bf16* XN = (bf16*)(ws + WS_XN); bf16* Qb = (bf16*)(ws + WS_Q); bf16* Kb = (bf16*)(ws + WS_K); bf16* Vb = (bf16*)(ws + WS_V); bf16* ACT = (bf16*)(ws + WS_ACT); \
    bf16* MGU = (bf16*)(ws + WS_MGU); bf16* MD = (bf16*)(ws + WS_MD); \
    float* kmean = (float*)(ws + WS_KMEAN); unsigned* ltok = (unsigned*)(ws + WS_LTOK); float* lw = (float*)(ws + WS_LW); \
    (void)x; (void)norm_mix; (void)norm_ffn; (void)h; (void)XN; (void)Qb; (void)Kb; (void)Vb; (void)ACT; (void)MGU; (void)MD; (void)kmean; (void)ltok; (void)lw
    const RouterArgs noR{nullptr, nullptr, nullptr, nullptr};
#ifndef MK_F8_DENSE
#define MK_F8_DENSE 0
#endif
    constexpr bool F8_DENSE = MK_F8_DENSE != 0; constexpr int DESZ = F8_DENSE ? 1 : 2;
    constexpr float WSC_UP = 32.0f, WSC_DN = 64.0f;
    constexpr float C2 = 0.125f * 1.4426950408889634f;

    STAMP(0);
    if (PHEN(0) && IN(0)) {
        PTRS();
        { unsigned rot = 0u;
        convert_matrix(F, args.in[3], D, 3 * D, ws + WS_DQKV, 0, rot);
        norm_phase<0, false, true>(F, x, nullptr, nullptr, norm_mix, XN, nullptr, noR);
        }
    }
    SEAM(0);

    for (int L = 0; L < NLAYER; ++L) {
        const int j = L >> 1, moba = L & 1, pb = 1 + PH_PER_LAYER * L;
        int z_ = 0;
#if !defined(NO_OPQ_Z)
        asm volatile("" : "+s"(z_));
#endif
        Frame Fl = F0; Fl.G += z_; Fl.vcu += z_; Fl.wave += z_; Fl.lds += z_; Fl.ctl += z_; const int bx = (int)blockIdx.x + z_;
#define F Fl
        if (PHEN(1) && IN(pb + 0)) {
            PTRS();

            const bf16* W = (const bf16*)(ws + (moba ? WS_MQKV : WS_DQKV)) + (size_t)j * 3 * D * D;
            if (L == 3) { pg8::Gemm g{XN, ws + WS_MQKV + (size_t)j * 3 * D * D * 2, D, 0}; pg8::StaticOrder S; S.init(MTOK, 3 * D, F.G, bx);
                pg8::EpiQKV E{Qb, D, D, (size_t)(WS_K - WS_Q) / 2, C2, 1.0f / WSC_UP, kmean, (unsigned*)(kmean + 8 * 16 * 16 * 64), moba != 0, (unsigned*)(kmean + 8 * 16 * 16 * 66)};
                pg8::gemm_phase<pg8::EpiQKV, pg8::StaticOrder, true>(F.lds + RING_OFF, XSLOT_OFF, g, S, E);
            } else {
            pg8::Gemm g{XN, W, 2 * D, 0}; pg8::StaticOrder S; S.init(MTOK, 3 * D, F.G, bx);
            pg8::EpiQKV E{Qb, D, D, (size_t)(WS_K - WS_Q) / 2, C2, 1.0f, kmean, (unsigned*)(kmean + 8 * 16 * 16 * 64), moba != 0, (unsigned*)(kmean + 8 * 16 * 16 * 66)};
            for (int rep_ = 0; rep_ < NREP(1); ++rep_) pg8::gemm_phase<pg8::EpiQKV, pg8::StaticOrder>(F.lds + RING_OFF, XSLOT_OFF, g, S, E); }
        }
        SEAM(pb + 0);
        if (IN(pb + 2)) {
            PTRS();
            att::Args A; A.Q = Qb; A.K = Kb; A.V = Vb; A.O = XN; A.kmean = kmean; A.kmax2 = kmean + 8 * 16 * 16 * 64; A.qmax2 = kmean + 8 * 16 * 16 * 66; A.subln = args.in[6] + (size_t)j * 128; A.lam_full = 0.f; A.out_scale = 1.f; A.abl = 0;
            LAS int* qw;
            if (!moba) {
                const float* lam = args.in[5] + (size_t)j * 256; int lane = F.lane; asm volatile("" : "+v"(lane));
                const GAS float* lamg = (const GAS float*)lam; const float s1 = wave_sum(lamg[lane] * lamg[64 + lane]), s2 = wave_sum(lamg[128 + lane] * lamg[192 + lane]);
                const float lam_init = (L == 0) ? 0.2f : 0.47071302f;
                A.lam_full = __uint_as_float(__builtin_amdgcn_readfirstlane(__float_as_uint(__expf(s1) - __expf(s2) + lam_init))); A.out_scale = __uint_as_float(__builtin_amdgcn_readfirstlane(__float_as_uint(1.0f - lam_init)));
            }
            const int nconv = (L == 0) ? conv_total_chunks() : 0;
            qw = (LAS int*)(F.lds + XSLOT_OFF);
            const int xme = (int)(xb_xcc_id() & 7u);
            if ((PHEN(3) && !moba) || (PHEN(4) && moba)) for (int rep_ = 0; rep_ < (moba ? NREP(4) : NREP(3)); ++rep_) for (int xq = xme;;) {
#if ATT_ABLATE
                { const bool ab_ = rep_ == 0 && (moba ? NREP(4) : NREP(3)) == 2; A.abl = ab_ ? ATT_ABLATE : 0; A.O = ab_ ? (bf16*)(ws + WS_END) : XN; }
#endif
                const int ncx = (nconv && rep_ == 0) ? ((nconv - xq + 7) >> 3) : 0;
                gu32* qb = F.ctl + CW_ATTQ2 + 256 * L + 1024 * rep_; gu32* qx = qb + 32 * xq;
                for (;;) {
                    if (F.tid == 0) *qw = (int)__hip_atomic_fetch_add(qx, 1u, RLX_AGENT);
                    asm volatile("s_waitcnt vmcnt(0) lgkmcnt(0)\n\ts_barrier" ::: "memory");
                    int idx = __builtin_amdgcn_readfirstlane(*qw);
                    if (idx >= 128 + ncx) { asm volatile("s_waitcnt vmcnt(0) lgkmcnt(0)\n\ts_barrier" ::: "memory"); break; }
                    if (ncx) { const int q3 = idx / 3; if (idx < 3 * ncx) { if (idx - 3 * q3 == 2) { conv_chunk(F, args, ws, xq + 8 * q3); asm volatile("s_waitcnt vmcnt(0) lgkmcnt(0)\n\ts_barrier" ::: "memory"); continue; } idx -= q3; } else idx -= ncx; }
                    if (!moba) { const int hh = 7 - (idx >> 4), pr = idx & 15;
                        att::attn_unit<0>(F.lds + RING_OFF, A, xq, hh, pr);
                        att::attn_unit<0>(F.lds + RING_OFF, A, xq, hh, 31 - pr);
                    } else { const int hh = 15 - (idx >> 3), pr = idx & 7;
                        att::attn_unit<1>(F.lds + RING_OFF, A, xq, hh, pr);
                        att::attn_unit<1>(F.lds + RING_OFF, A, xq, hh, 15 - pr); }
                }
                if (F.tid < 64) { int lane = F.tid; asm volatile("" : "+v"(lane)); bool av = false;
                    if (lane < 8) { const int lim = 128 + ((nconv && rep_ == 0) ? ((nconv - lane + 7) >> 3) : 0); av = (int)__hip_atomic_load(qb + 32 * lane, RLX_AGENT) < lim; }
                    const unsigned long long m_ = __ballot(av);
                    if (lane == 0) *qw = (int)(unsigned)m_; }
                asm volatile("s_waitcnt vmcnt(0) lgkmcnt(0)\n\ts_barrier" ::: "memory");
                const unsigned m = (unsigned)__builtin_amdgcn_readfirstlane(*qw);
                asm volatile("s_waitcnt vmcnt(0) lgkmcnt(0)\n\ts_barrier" ::: "memory");
                if (m == 0u) break;
                const unsigned rot = ((m >> xme) | (m << (8 - xme))) & 0xFFu;
                xq = (xme + __builtin_ctz(rot)) & 7;
            }
            asm volatile("s_waitcnt vmcnt(0) lgkmcnt(0)\n\ts_barrier" ::: "memory");
        }
        SEAM(pb + 2);
        if (PHEN(5) && IN(pb + 3)) {
            PTRS();
            const bf16* W = (const bf16*)(ws + (moba ? WS_MWO : WS_DWO)) + (size_t)j * D * D;
            pg8::Gemm g{XN, W, 2 * D, 0}; pg8::StaticOrder S; S.init(MTOK, D, F.G, bx);
            if (L == 0) { pg8::EpiRes<true> E{x, h, D, 1.0f}; pg8::gemm_phase<pg8::EpiRes<true>, pg8::StaticOrder>(F.lds + RING_OFF, XSLOT_OFF, g, S, E); }
            else { pg8::EpiRes<false> E{h, h, D, 1.0f}; pg8::gemm_phase<pg8::EpiRes<false>, pg8::StaticOrder>(F.lds + RING_OFF, XSLOT_OFF, g, S, E); }
        }
        SEAM(pb + 3);
        if (PHEN(6) && IN(pb + 4)) {
            PTRS();
            if (L != NLAYER - 1) { const int gt_ = bx * (NWAVES * 64) + F.tid;
                for (int i_ = gt_; i_ < 8 * 16 * 16 * 66 + 8 * 16 * 32 * 2; i_ += F.G * NWAVES * 64) ((GAS float*)kmean)[i_] = 0.f; }
            if (!moba) {
                if (L == 2) norm_phase<0, true>(F, h, nullptr, nullptr, norm_ffn + (size_t)L * D, XN, nullptr, noR);
                else norm_phase<0, true>(F, h, nullptr, nullptr, norm_ffn + (size_t)L * D, XN, nullptr, noR);
            } else {
                const RouterArgs R{args.in[12] + (size_t)j * D * NE, F.ctl + CW_CNT + 64 * NE * j, ltok, lw};
                norm_phase<2, true>(F, h, nullptr, nullptr, norm_ffn + (size_t)L * D, XN, nullptr, R);
            }
        }
        SEAM(pb + 4);
        if (IN(pb + 5)) {
            PTRS();
            if (PHEN(7) && !moba) {
                if (true) { pg8::Gemm g{XN, ws + WS_FGU + (size_t)j * 2 * DFF * D * 2, D, 0};
 pg8::StaticOrder S; S.init(MTOK, 2 * DFF, F.G, bx);
                    pg8::EpiSwiGLU<true> E{ACT, DFF, 1.0f / WSC_UP};
                    pg8::gemm_phase<pg8::EpiSwiGLU<true>, pg8::StaticOrder, true>(F.lds + RING_OFF, XSLOT_OFF, g, S, E);
                } else { pg8::Gemm g{XN, ws + WS_FGU + (size_t)j * 2 * DFF * D * 2, D, 0}; pg8::StaticOrder S; S.init(MTOK, 2 * DFF, F.G, bx);
                    pg8::EpiSwiGLU<false> E{ACT, DFF, 1.0f / WSC_UP};
                    pg8::gemm_phase<pg8::EpiSwiGLU<false>, pg8::StaticOrder, true>(F.lds + RING_OFF, XSLOT_OFF, g, S, E); }
            } else if (PHEN(8) && moba) {
                pg8::Gemm g{XN, ws + WS_MGU + (size_t)j * NE * 2 * DE * D, D, (size_t)2 * DE * D}; pg8::MoeOrder S; S.init((const unsigned*)(F.ctl + CW_CNT + 64 * NE * j), ltok, true, 2 * DE, F.G, bx);
                pg8::EpiSwiGLU<true> E{ACT, DE, 1.0f / WSC_UP};
                pg8::gemm_phase<pg8::EpiSwiGLU<true>, pg8::MoeOrder, true>(F.lds + RING_OFF, XSLOT_OFF, g, S, E);
            }
        }
        SEAM(pb + 5);
        if (IN(pb + 6)) {
            PTRS();
            if (PHEN(9) && !moba) {
                if (true) { pg8::Gemm g{ACT, ws + WS_FD + (size_t)j * D * DFF * 2, DFF, 0}; pg8::StaticOrder S; S.init(MTOK, D, F.G, bx);
                    pg8::EpiRes<false> E{h, h, D, 1.0f / WSC_DN};
                    pg8::gemm_phase<pg8::EpiRes<false>, pg8::StaticOrder, true>(F.lds + RING_OFF, XSLOT_OFF, g, S, E);
                } else { pg8::Gemm g{ACT, ws + WS_FD + (size_t)j * D * DFF * 2, 2 * DFF, 0}; pg8::StaticOrder S; S.init(MTOK, D, F.G, bx);
                    pg8::EpiRes<false> E{h, h, D, 1.0f};
                    pg8::gemm_phase<pg8::EpiRes<false>, pg8::StaticOrder, false>(F.lds + RING_OFF, XSLOT_OFF, g, S, E); }
            } else if (PHEN(10) && moba) {
                pg8::Gemm g{ACT, ws + WS_MD + (size_t)j * NE * D * DE, DE, (size_t)D * DE}; pg8::MoeOrder S; S.init((const unsigned*)(F.ctl + CW_CNT + 64 * NE * j), ltok, false, D, F.G, bx);
                pg8::EpiMoeDown E; E.y0 = (bf16*)(ws + WS_Y0); E.y1 = XN; E.list_tok = ltok; E.list_w = lw; E.sc = 1.0f / WSC_DN;
#pragma unroll
                for (int e = 0; e < NE; ++e) E.cnt[e] = S.cnt[e];
                pg8::gemm_phase<pg8::EpiMoeDown, pg8::MoeOrder, true>(F.lds + RING_OFF, XSLOT_OFF, g, S, E);
            }
        }
        SEAM(pb + 6);
        if (PHEN(11) && IN(pb + 7)) {
            PTRS();
            if (L == 3) norm_phase<3>(F, h, nullptr, XN, args.in[16], nullptr, args.out, noR, (const bf16*)(ws + WS_Y0));
            else if (moba) norm_phase<1>(F, h, h, XN, norm_mix + (size_t)(L + 1) * D, XN, nullptr, noR, (const bf16*)(ws + WS_Y0));
            else if (L == 2) norm_phase<0, true>(F, h, nullptr, nullptr, norm_mix + (size_t)(L + 1) * D, XN, nullptr, noR);
            else for (int rep_ = 0; rep_ < NREP(11); ++rep_) norm_phase<0>(F, h, nullptr, nullptr, norm_mix + (size_t)(L + 1) * D, XN, nullptr, noR);
        }
        if (L != NLAYER - 1) SEAM(pb + 7); else STAMP(pb + 8);
#undef F
    }
#undef IN
#undef SEAM
#undef PTRS
#undef OPQ
}


#if MK_DEBUG
__global__ void dbg_probe(const void* buf, size_t n, int is_bf16, int idx, float thresh, unsigned* dbg) {
    size_t i = blockIdx.x * (size_t)blockDim.x + threadIdx.x, stride = (size_t)gridDim.x * blockDim.x; bool bad = false;
    for (size_t k = i; k < n; k += stride) { float v = is_bf16 ? __uint_as_float(((unsigned)((const unsigned short*)buf)[k]) << 16) : ((const float*)buf)[k]; if (!(fabsf(v) <= thresh)) bad = true; }
    if (bad) atomicMax(dbg, (unsigned)(1000 - idx));
}
__global__ void dbg_cnt(const unsigned* cntw, int idx, unsigned* dbg) {
    if (threadIdx.x == 0 && blockIdx.x == 0) { unsigned s = 0; for (int e = 0; e < NE; ++e) s += cntw[64 * e]; if (s != 2u * MTOK) atomicMax(dbg, (unsigned)(1000 - idx)); }
}

__device__ __forceinline__ float dbg_bf(unsigned short v) { return __uint_as_float(((unsigned)v) << 16); }
__device__ __forceinline__ unsigned dbg_hash(unsigned x) { x ^= x >> 16; x *= 0x7feb352dU; x ^= x >> 15; x *= 0x846ca68bU; x ^= x >> 16; return x; }
__global__ void dbg_gemm_check(const unsigned short* A, int lda, const unsigned short* Bt, int K, const unsigned short* out, int ldo, int M, int N, float scale, int idx, unsigned* dbg) {
    const unsigned s = blockIdx.x * blockDim.x + threadIdx.x; const int row = (int)(dbg_hash(2 * s + 1) % (unsigned)M), col = (int)(dbg_hash(2 * s + 2) % (unsigned)N);
    float acc = 0.f; for (int k = 0; k < K; ++k) acc += dbg_bf(A[(size_t)row * lda + k]) * dbg_bf(Bt[(size_t)col * K + k]);
    acc *= scale; const float got = dbg_bf(out[(size_t)row * ldo + col]);
    if (!(fabsf(got - acc) <= 0.03f + 0.02f * fabsf(acc))) { atomicMax(dbg, (unsigned)(1000 - idx)); atomicAdd(dbg + 64 + idx, 1u); }
}
__global__ void dbg_conv_check(const float* W, int K, int N, const unsigned short* WT, int il, int idx, unsigned* dbg) {
    const unsigned s = blockIdx.x * blockDim.x + threadIdx.x; const int k = (int)(dbg_hash(2 * s + 1) % (unsigned)K), n = (int)(dbg_hash(2 * s + 2) % (unsigned)N);
    const int dr = il == 0 ? n : (n / 128) * 256 + (il - 1) * 128 + (n % 128);
    const float w = W[(size_t)k * N + n], g = dbg_bf(WT[(size_t)dr * K + k]);
    if (!(fabsf(g - w) <= 0.01f * fabsf(w) + 1e-6f)) atomicMax(dbg, (unsigned)(1000 - idx));
}
__global__ void dbg_norm_check(const float* src, const float* gain, const unsigned short* xn, int idx, unsigned* dbg) {
    const unsigned s = blockIdx.x * blockDim.x + threadIdx.x; const int row = (int)(dbg_hash(s + 77) % (unsigned)MTOK);
    float ss = 0.f; for (int c = 0; c < D; ++c) { const float v = src[(size_t)row * D + c]; ss += v * v; }
    const float rstd = 1.f / sqrtf(ss / D + 1e-6f); bool bad = false;
    for (int c = 0; c < D; ++c) { const float r = src[(size_t)row * D + c] * rstd * gain[c], g = dbg_bf(xn[(size_t)row * D + c]); if (!(fabsf(g - r) <= 0.02f + 0.01f * fabsf(r))) bad = true; }
    if (bad) atomicMax(dbg, (unsigned)(1000 - idx));
}
__global__ void dbg_naive_gemm(const unsigned short* A, const unsigned short* Bt, unsigned short* out, int M, int N, int K) {
    const size_t i = blockIdx.x * (size_t)blockDim.x + threadIdx.x; if (i >= (size_t)M * N) return; const int row = (int)(i / N), col = (int)(i % N);
    float acc = 0.f; for (int k = 0; k < K; ++k) acc += dbg_bf(A[(size_t)row * K + k]) * dbg_bf(Bt[(size_t)col * K + k]);
    out[(size_t)row * N + col] = (unsigned short)f2bf(acc);
}
__global__ void dbg_find_col(const unsigned short* out, const unsigned short* ref, int M, int N, unsigned* hist) {
    const unsigned s = blockIdx.x * blockDim.x + threadIdx.x; const int row = (int)(dbg_hash(2 * s + 1) % (unsigned)M), col = (int)(dbg_hash(2 * s + 2) % (unsigned)N);
    const unsigned short v = out[(size_t)row * N + col]; int found = -1;
#if MK_FIND_PATTERN
    if (v == 0x3C3C) atomicAdd(hist + N, 1u); else atomicAdd(hist + 5, 1u); return;
#endif
#if MK_FIND_ROWS
    for (int r = 0; r < M; ++r) if (ref[(size_t)r * N + col] == v) { found = r; break; }
    if (found < 0) atomicAdd(hist + N, 1u); else atomicAdd(hist + ((found - row) & (N - 1)), 1u);
#else
    for (int c = 0; c < N; ++c) if (ref[(size_t)row * N + c] == v) { found = c; break; }
    if (found < 0) atomicAdd(hist + N, 1u); else atomicAdd(hist + ((found - col) & (N - 1)), 1u);
#endif
}
__global__ void dbg_hist_code(const unsigned* hist, int N, unsigned* dbg) {
    if (threadIdx.x || blockIdx.x) return; unsigned best = 0, bi = 0; for (int i = 0; i < N; ++i) if (hist[i] > best) { best = hist[i]; bi = i; }
    dbg[32] = bi; dbg[33] = best; dbg[34] = hist[N];
}
__global__ void dbg_final(float* out, size_t n, const unsigned* dbg) {
    if (MK_HIST_SEL >= 10) { const float c3 = sqrtf((float)dbg[MK_HIST_SEL + 30]); size_t i3 = blockIdx.x * (size_t)blockDim.x + threadIdx.x, st3 = (size_t)gridDim.x * blockDim.x; for (size_t k3 = i3; k3 < n; k3 += st3) out[k3] = c3; return; }
    if (MK_HIST_SEL >= 0 && (dbg[33] || dbg[34])) { const float c2 = sqrtf((float)(MK_HIST_SEL == 0 ? dbg[32] : (MK_HIST_SEL == 1 ? dbg[33] * 100u / 4096u : dbg[34] * 100u / 4096u)) + 1.f); size_t i2 = blockIdx.x * (size_t)blockDim.x + threadIdx.x, st2 = (size_t)gridDim.x * blockDim.x; for (size_t k2 = i2; k2 < n; k2 += st2) out[k2] = c2; return; }
    const unsigned d = dbg[0]; if (d == 0u) return; const unsigned nf = dbg[64 + (1000u - d)]; const float c = sqrtf(nf ? (float)(200u * (1000u - d - 9u) + nf * 100u / 4096u) : (float)(1000u - d));
    size_t i = blockIdx.x * (size_t)blockDim.x + threadIdx.x, stride = (size_t)gridDim.x * blockDim.x;
    for (size_t k = i; k < n; k += stride) out[k] = c;
}
#endif

#ifndef MK_REPEAT
#define MK_REPEAT 1
#endif
#ifndef MK_FIND_ROWS
#define MK_FIND_ROWS 0
#endif
#ifndef MK_FIND_REGION
#define MK_FIND_REGION WS_K
#endif
#ifndef MK_HIST_SEL
#define MK_HIST_SEL 0
#endif
#ifndef MK_STAMP
#define MK_STAMP 0
#endif
#if MK_STAMP
__global__ void stamp_k(unsigned* p) { if (threadIdx.x == 0) *p = (unsigned)__builtin_amdgcn_s_memrealtime(); }
__global__ void stamp_encode(float* out, size_t n, const unsigned* st, int pa, float ua, int pb, float ub) {
    const float da = (float)(st[pa + 1] - st[pa]) * 0.01f, db = (float)(st[pb + 1] - st[pb]) * 0.01f;
    float m = da / ua; m = m < 10.f ? 10.f : (m > 99.f ? 99.f : m); float e = floorf(db / ub + 0.5f); e = e < 0.f ? 0.f : (e > 30.f ? 30.f : e);
    const float c = sqrtf(m) * __powf(10.f, 0.5f * e);
    size_t i = blockIdx.x * (size_t)blockDim.x + threadIdx.x, stride = (size_t)gridDim.x * blockDim.x;
    for (size_t k = i; k < n; k += stride) out[k] = c;
}
#endif
extern "C" void kernel_launch(void* const* d_in, const int* in_sizes, int n_in, void* d_out, int out_size, void* d_ws, size_t ws_size, hipStream_t stream) {
    static int grid = 0;
    if (grid == 0) {
        if (n_in != 17 || in_sizes[0] != MTOK * D || out_size != MTOK * D || ws_size < WS_END) {
            fprintf(stderr, "kernel_launch: built for 17 inputs, x/out of %d floats, >= %zu bytes of workspace; got n_in %d, in0 %d, out %d, ws %zu; nothing launched\n", MTOK * D, (size_t)WS_END, n_in, n_in > 0 ? in_sizes[0] : -1, out_size, ws_size);
            grid = -1; return; }
        int dev = 0, cus = 0, per_cu = 0;
        if (hipGetDevice(&dev) != hipSuccess || hipDeviceGetAttribute(&cus, hipDeviceAttributeMultiprocessorCount, dev) != hipSuccess) { fprintf(stderr, "kernel_launch: device query failed\n"); grid = -1; return; }
        if (hipFuncSetAttribute((const void*)trunk_fwd, hipFuncAttributeMaxDynamicSharedMemorySize, LDS_BYTES) != hipSuccess) { fprintf(stderr, "kernel_launch: hipFuncSetAttribute failed\n"); grid = -1; return; }
        if (hipOccupancyMaxActiveBlocksPerMultiprocessor(&per_cu, (const void*)trunk_fwd, NWAVES * 64, LDS_BYTES) != hipSuccess || per_cu < 1)
            fprintf(stderr, "kernel_launch: note: occupancy query reports %d workgroups per CU\n", per_cu);
        (void)hipGetLastError();
        grid = cus;
    }
    if (grid < 0) return;
    if (hipMemsetAsync((char*)d_ws + WS_CTL, 0, CTL_ZERO_BYTES, stream) != hipSuccess) { fprintf(stderr, "kernel_launch: memset failed\n"); return; }
    KArgs a{};
    for (int i = 0; i < 17; ++i) a.in[i] = (const float*)d_in[i];
    a.out = (float*)d_out; a.ws = (unsigned char*)d_ws;
#if MK_PER_PHASE
#if MK_STAMP
    hipLaunchKernelGGL(stamp_k, dim3(1), dim3(64), 0, stream, (unsigned*)d_ws + 3000);
#endif
    for (int p = 0; p < NPHASE; ++p) {
        a.ph_lo = p; a.ph_hi = p + 1;
#if MK_DEBUG
#endif
#if !defined(MK_SKIP_MAIN)
        for (int rep_ = 0; rep_ < (p == 1 ? MK_REPEAT : 1); ++rep_) hipLaunchKernelGGL(trunk_fwd, dim3(grid), dim3(NWAVES * 64), LDS_BYTES, stream, a);
#endif
#if MK_STAMP
        hipLaunchKernelGGL(stamp_k, dim3(1), dim3(64), 0, stream, (unsigned*)d_ws + 3000 + p + 1);
#endif
#if MK_DEBUG
        {   unsigned char* ws = (unsigned char*)d_ws; unsigned* dbg = (unsigned*)(ws + WS_CTL) + 2048;
            const size_t MD_ = (size_t)MTOK * D;
#define PROBE(buf, n, isbf, idx, th) if ((idx) <= MK_PROBE_MAX) hipLaunchKernelGGL(dbg_probe, dim3(2048), dim3(256), 0, stream, (const void*)(buf), (size_t)(n), isbf, idx, th, dbg)
            if (p == 0) {
                hipLaunchKernelGGL(dbg_norm_check, dim3(4), dim3(64), 0, stream, (const float*)d_in[0], (const float*)d_in[1], (const unsigned short*)(ws + WS_XN), 4, dbg);
                hipLaunchKernelGGL(dbg_conv_check, dim3(16), dim3(256), 0, stream, (const float*)d_in[3], D, 3 * D, (const unsigned short*)(ws + WS_DQKV), 0, 5, dbg);
                hipLaunchKernelGGL(dbg_conv_check, dim3(16), dim3(256), 0, stream, (const float*)d_in[9], D, DFF, (const unsigned short*)(ws + WS_FGU), 1, 6, dbg);
                hipLaunchKernelGGL(dbg_conv_check, dim3(16), dim3(256), 0, stream, (const float*)d_in[10], D, DFF, (const unsigned short*)(ws + WS_FGU), 2, 7, dbg);
                hipLaunchKernelGGL(dbg_conv_check, dim3(16), dim3(256), 0, stream, (const float*)d_in[11], DFF, D, (const unsigned short*)(ws + WS_FD), 0, 8, dbg);
                hipLaunchKernelGGL(dbg_conv_check, dim3(16), dim3(256), 0, stream, (const float*)d_in[15] + (size_t)3 * DE * D, DE, D, (const unsigned short*)(ws + WS_MD) + (size_t)3 * D * DE, 0, 9, dbg);
            }
            if (p == 1) {
                const float C2h = 0.125f * 1.4426950408889634f;
                hipLaunchKernelGGL(dbg_gemm_check, dim3(16), dim3(256), 0, stream, (const unsigned short*)(ws + WS_XN), D, (const unsigned short*)(ws + WS_DQKV), D, (const unsigned short*)(ws + WS_Q), D, MTOK, D, C2h, 10, dbg);
                hipLaunchKernelGGL(dbg_gemm_check, dim3(16), dim3(256), 0, stream, (const unsigned short*)(ws + WS_XN), D, (const unsigned short*)(ws + WS_DQKV) + (size_t)D * D, D, (const unsigned short*)(ws + WS_K), D, MTOK, D, 1.f, 11, dbg);

                hipLaunchKernelGGL(dbg_gemm_check, dim3(16), dim3(256), 0, stream, (const unsigned short*)(ws + WS_XN), D, (const unsigned short*)(ws + WS_DQKV) + (size_t)2 * D * D, D, (const unsigned short*)(ws + WS_V), D, MTOK, D, 1.f, 12, dbg);
            }
            if (0) { PROBE(ws + WS_XN, MD_, 1, 1, 10.f); PROBE(ws + WS_DQKV, (WS_MGU - WS_DQKV) / 2, 1, 2, 1.f); PROBE(ws + WS_MGU, (WS_XN - WS_MGU) / 2, 1, 3, 1.f); }
            if (p >= 1) { const int L = (p - 1) / PH_PER_LAYER, k = (p - 1) % PH_PER_LAYER; const int b = 20 + 10 * L;
                if (k == 0) PROBE(ws + WS_Q, 3 * MD_, 1, b + 0, 50.f);
                if (k == 1) PROBE(ws + WS_KMEAN, 8 * 16 * 16 * 64, 0, b + 1, 5.f);
                if (k == 2) PROBE(ws + WS_XN, MD_, 1, b + 2, 50.f);
                if (k == 3) PROBE(d_out, MD_, 0, b + 3, 300.f);
                if (k == 4) { PROBE(ws + WS_XN, MD_, 1, b + 4, 20.f); if ((L & 1) && (b + 9) <= MK_PROBE_MAX) hipLaunchKernelGGL(dbg_cnt, dim3(1), dim3(64), 0, stream, (const unsigned*)(ws + WS_CTL) + CW_CNT + 64 * NE * (L >> 1), b + 9, dbg); }
                if (k == 5) PROBE(ws + WS_ACT, (L & 1) ? (size_t)256 * 256 * DE : (size_t)MTOK * DFF, 1, b + 5, 2000.f);
                if (k == 6) { PROBE(d_out, MD_, 0, b + 6, 1000.f); if (L & 1) PROBE(ws + WS_XN, MD_, 1, b + 7, 1000.f); }
                if (k == 7 && L != 3) { PROBE(ws + WS_XN, MD_, 1, b + 8, 20.f); PROBE(d_out, MD_, 0, b + 8, 1000.f); }
            }
#undef PROBE
        }
#endif
    }
#if MK_DEBUG
    hipLaunchKernelGGL(dbg_final, dim3(2048), dim3(256), 0, stream, (float*)d_out, (size_t)MTOK * D, (const unsigned*)((unsigned char*)d_ws + WS_CTL) + 2048);
#endif
#else
    a.ph_lo = 0; a.ph_hi = NPHASE;
    hipLaunchKernelGGL(trunk_fwd, dim3(grid), dim3(NWAVES * 64), LDS_BYTES, stream, a);
#if 0
    hipLaunchKernelGGL(stamp_encode, dim3(2048), dim3(256), 0, stream, (float*)d_out, (size_t)MTOK * D, (const unsigned*)d_ws + 3000, MK_STAMP_PA, MK_STAMP_UA, MK_STAMP_PB, MK_STAMP_UB);
#endif
#endif
#if MK_STAMP
    hipLaunchKernelGGL(stamp_encode, dim3(2048), dim3(256), 0, stream, (float*)d_out, (size_t)MTOK * D, (const unsigned*)d_ws + 3000, MK_STAMP_PA, MK_STAMP_UA, MK_STAMP_PB, MK_STAMP_UB);
#endif
    const hipError_t le = hipPeekAtLastError();
    if (le != hipSuccess) fprintf(stderr, "kernel_launch: launch failed: %s\n", hipGetErrorName(le));
}
```
